# Optimizing an MI355X kernel written in HIP

```python
import math
import jax, jax.numpy as jnp
from jax import lax
import numpy as np

D_MODEL = 1024
BATCH = 8
SEQ = 4096
DEPTH = 4

RET_HEADS = 4
RET_DK = 128
RET_DV = 128
RET_CHUNK = 128
RET_THETA = 10000.0
DIL_HEADS = 8
DIL_DH = 64
DIL_PATTERNS = ((128, 1), (512, 4), (2048, 16))
DIL_BLOCK = 128
ROPE_THETA = 500000.0
ROT_DIM = DIL_DH // 4
GLA_HEADS = 4
GLA_DK = (D_MODEL // 2) // GLA_HEADS
GLA_DV = D_MODEL // GLA_HEADS
GLA_LOWRANK = 16
GLA_TAU = 16.0
GLA_CHUNK = 64
FFN_HIDDEN = 2816
EPS = 1e-6

EVEN_SIZES = (RET_HEADS * RET_DK, RET_HEADS * RET_DK, RET_HEADS * RET_DV, RET_HEADS * RET_DV,
              DIL_HEADS * DIL_DH, DIL_HEADS * DIL_DH, DIL_HEADS * DIL_DH)
EVEN_IN = sum(EVEN_SIZES)
EVEN_MIX = RET_HEADS * RET_DV + DIL_HEADS * DIL_DH
GLA_SIZES = (GLA_HEADS * GLA_DK, GLA_HEADS * GLA_DK, GLA_HEADS * GLA_DV, GLA_HEADS * GLA_DV, GLA_LOWRANK)
GLA_IN = sum(GLA_SIZES)
GLA_MIX = GLA_HEADS * GLA_DV

kernel_name = "hybrid_retention_dilated_gla_macaron"


def _split(p, sizes):
    out, start = [], 0
    for s in sizes:
        out.append(p[..., start:start + s])
        start += s
    return out


def _rmsnorm(x, g):
    xf = x.astype(jnp.float32)
    y = xf * lax.rsqrt(jnp.mean(xf * xf, axis=-1, keepdims=True) + EPS)
    return (y * g.astype(jnp.float32)).astype(x.dtype)


def _head_norm(o):
    mu = jnp.mean(o, axis=-1, keepdims=True)
    var = jnp.mean(jnp.square(o - mu), axis=-1, keepdims=True)
    return (o - mu) * lax.rsqrt(var + EPS)


def _swiglu(h, wg, wu, wd):
    return (jax.nn.silu(h @ wg) * (h @ wu)) @ wd


def _rotary(x, inv_freq):
    rot = 2 * inv_freq.shape[0]
    pos = jnp.arange(x.shape[1], dtype=jnp.float32)
    ang = pos[:, None] * inv_freq[None, :]
    cos = jnp.cos(ang)[None, :, None, :].astype(x.dtype)
    sin = jnp.sin(ang)[None, :, None, :].astype(x.dtype)
    x1 = x[..., :rot // 2]
    x2 = x[..., rot // 2:rot]
    return jnp.concatenate([x1 * cos - x2 * sin, x2 * cos + x1 * sin, x[..., rot:]], axis=-1)


def _retention(q, k, v):
    B, S, H, Dk = q.shape
    Dv = v.shape[-1]
    C = RET_CHUNK
    N = S // C
    log_g = jnp.log(1.0 - 2.0 ** (-5.0 - jnp.arange(H, dtype=jnp.float32)))
    to_chunks = lambda t: t.reshape(B, N, C, H, t.shape[-1]).transpose(0, 3, 1, 2, 4)
    qc, kc, vc = to_chunks(q), to_chunks(k), to_chunks(v)
    i = jnp.arange(C, dtype=jnp.float32)
    rel = i[:, None] - i[None, :]
    dmask = jnp.where(rel >= 0, jnp.exp(log_g[:, None, None] * jnp.maximum(rel, 0.0)), 0.0)
    scores = jnp.einsum('bhnid,bhnjd->bhnij', qc, kc) * dmask[None, :, None]
    inner = jnp.einsum('bhnij,bhnje->bhnie', scores, vc)
    k_dec = kc * jnp.exp(log_g[:, None] * (C - 1 - i))[None, :, None, :, None]
    kv = jnp.einsum('bhnjd,bhnje->nbhde', k_dec, vc)
    chunk_decay = jnp.exp(log_g * C)[None, :, None, None]

    def step(s, kv_n):
        return s * chunk_decay + kv_n, s

    _, s_prev = lax.scan(step, jnp.zeros((B, H, Dk, Dv), jnp.float32), kv)
    q_dec = qc * jnp.exp(log_g[:, None] * (i + 1.0))[None, :, None, :, None]
    cross = jnp.einsum('bhnid,nbhde->bhnie', q_dec, s_prev)
    o = inner + cross
    return o.transpose(0, 2, 3, 1, 4).reshape(B, S, H, Dv)


def _dilated_branch(q, k, v, window, dil):
    B, S, H, Dh = q.shape
    L = S // dil
    W = window // dil
    c = DIL_BLOCK
    nb = -(-L // c)
    Lp = nb * c

    def split(t):
        return t.reshape(B, L, dil, H, Dh).transpose(0, 2, 3, 1, 4).reshape(B * dil, H, L, Dh)

    qs = jnp.pad(split(q), ((0, 0), (0, 0), (0, Lp - L), (0, 0))).reshape(B * dil, H, nb, c, Dh)

    def kblocks(t):
        t = jnp.pad(split(t), ((0, 0), (0, 0), (c, Lp - L), (0, 0))).reshape(B * dil, H, nb + 1, c, Dh)
        return jnp.concatenate([t[:, :, :-1], t[:, :, 1:]], axis=3)

    kb, vb = kblocks(k), kblocks(v)
    s = jnp.einsum('zhnqd,zhnkd->zhnqk', qs, kb).astype(jnp.float32) * (Dh ** -0.5)
    qi = jnp.arange(c)[:, None]
    kj = jnp.arange(2 * c)[None, :]
    dist = qi + c - kj
    blk = jnp.arange(nb)[:, None, None]
    valid = (dist >= 0) & (dist <= W) & (blk * c + kj - c >= 0)
    s = jnp.where(valid, s, -jnp.inf)
    m = jnp.max(s, axis=-1, keepdims=True)
    p = jnp.exp(s - m)
    l = jnp.sum(p, axis=-1, keepdims=True)
    o = jnp.einsum('zhnqk,zhnkd->zhnqd', p, vb.astype(jnp.float32)) / l
    lse = (m + jnp.log(l))[..., 0]
    o = o.reshape(B, dil, H, Lp, Dh)[:, :, :, :L].transpose(0, 3, 1, 2, 4).reshape(B, S, H, Dh)
    lse = lse.reshape(B, dil, H, Lp)[..., :L].transpose(0, 3, 1, 2).reshape(B, S, H)
    return o, lse


def _dilated_attention(q, k, v):
    outs, lses = [], []
    for window, dil in DIL_PATTERNS:
        o, lse = _dilated_branch(q, k, v, window, dil)
        outs.append(o)
        lses.append(lse)
    w = jax.nn.softmax(jnp.stack(lses, axis=0), axis=0)
    return jnp.sum(w[..., None] * jnp.stack(outs, axis=0), axis=0)


def _retention_dilated_mixer(h, w_in, w_out):
    B, S, _ = h.shape
    rq, rk, rv, rg, dq, dk, dv = _split(h @ w_in, EVEN_SIZES)
    ret_freq = RET_THETA ** (-jnp.linspace(0.0, 1.0, RET_DK // 2, dtype=jnp.float32))
    rq = _rotary(rq.reshape(B, S, RET_HEADS, RET_DK), ret_freq).astype(jnp.float32)
    rk = _rotary(rk.reshape(B, S, RET_HEADS, RET_DK), ret_freq).astype(jnp.float32) * (RET_DK ** -0.5)
    rv = rv.reshape(B, S, RET_HEADS, RET_DV).astype(jnp.float32)
    o_r = _head_norm(_retention(rq, rk, rv)).reshape(B, S, RET_HEADS * RET_DV)
    o_r = o_r * jax.nn.silu(rg.astype(jnp.float32))
    rope_freq = ROPE_THETA ** (-jnp.arange(0, ROT_DIM, 2, dtype=jnp.float32) / ROT_DIM)
    dq = _rotary(dq.reshape(B, S, DIL_HEADS, DIL_DH), rope_freq)
    dk = _rotary(dk.reshape(B, S, DIL_HEADS, DIL_DH), rope_freq)
    dv = dv.reshape(B, S, DIL_HEADS, DIL_DH)
    o_d = _dilated_attention(dq, dk, dv).reshape(B, S, DIL_HEADS * DIL_DH)
    cat = jnp.concatenate([o_r.astype(h.dtype), o_d.astype(h.dtype)], axis=-1)
    return cat @ w_out


def _gla(q, k, v, log_a):
    B, S, H, Dk = q.shape
    Dv = v.shape[-1]
    C = GLA_CHUNK
    N = S // C
    to_chunks = lambda t: t.reshape(B, N, C, H, t.shape[-1]).transpose(0, 3, 1, 2, 4)
    qc, kc, vc, lac = to_chunks(q), to_chunks(k), to_chunks(v), to_chunks(log_a)
    b = jnp.cumsum(lac, axis=3)
    b_last = b[:, :, :, -1:]
    q_t = qc * jnp.exp(b)
    k_t = kc * jnp.exp(-b)
    causal = jnp.tril(jnp.ones((C, C), dtype=bool))
    scores = jnp.where(causal, jnp.einsum('bhnid,bhnjd->bhnij', q_t, k_t), 0.0)
    inner = jnp.einsum('bhnij,bhnje->bhnie', scores, vc)
    kv = jnp.einsum('bhnjd,bhnje->nbhde', kc * jnp.exp(b_last - b), vc)
    decay = jnp.exp(b_last[:, :, :, 0]).transpose(2, 0, 1, 3)

    def step(s, inp):
        kv_n, d_n = inp
        return s * d_n[..., None] + kv_n, s

    _, s_prev = lax.scan(step, jnp.zeros((B, H, Dk, Dv), jnp.float32), (kv, decay))
    cross = jnp.einsum('bhnid,nbhde->bhnie', q_t, s_prev)
    o = inner + cross
    return o.transpose(0, 2, 3, 1, 4).reshape(B, S, H, Dv)


def _gla_mixer(h, w_in, w_a2, b_a, w_out):
    B, S, _ = h.shape
    q, k, v, r, a_low = _split(h @ w_in, GLA_SIZES)
    log_a = jax.nn.log_sigmoid((a_low @ w_a2 + b_a).astype(jnp.float32)) / GLA_TAU
    q = q.reshape(B, S, GLA_HEADS, GLA_DK).astype(jnp.float32) * (GLA_DK ** -0.5)
    k = k.reshape(B, S, GLA_HEADS, GLA_DK).astype(jnp.float32)
    v = v.reshape(B, S, GLA_HEADS, GLA_DV).astype(jnp.float32)
    log_a = log_a.reshape(B, S, GLA_HEADS, GLA_DK)
    o = _head_norm(_gla(q, k, v, log_a)).reshape(B, S, GLA_MIX)
    o = o * jax.nn.silu(r.astype(jnp.float32))
    return o.astype(h.dtype) @ w_out


def setup_inputs(seed: int = 0) -> dict:
    key = jax.random.key(seed)
    ks = jax.random.split(key, 24)
    n_even = (DEPTH + 1) // 2
    n_odd = DEPTH // 2
    f32 = jnp.float32

    def w(k, shape, fan_in):
        return jax.random.normal(k, shape, f32) * (fan_in ** -0.5)

    def gain(k, shape):
        return 1.0 + 0.05 * jax.random.normal(k, shape, f32)

    return {
        "x": jax.random.normal(ks[0], (BATCH, SEQ, D_MODEL), f32),
        "ffn_pre_norm": gain(ks[1], (DEPTH, D_MODEL)),
        "ffn_pre_w_gate": w(ks[2], (DEPTH, D_MODEL, FFN_HIDDEN), D_MODEL),
        "ffn_pre_w_up": w(ks[3], (DEPTH, D_MODEL, FFN_HIDDEN), D_MODEL),
        "ffn_pre_w_down": w(ks[4], (DEPTH, FFN_HIDDEN, D_MODEL), FFN_HIDDEN),
        "mix_norm": gain(ks[5], (DEPTH, D_MODEL)),
        "ab_w_in": w(ks[6], (n_even, D_MODEL, EVEN_IN), D_MODEL),
        "ab_w_out": w(ks[7], (n_even, EVEN_MIX, D_MODEL), EVEN_MIX),
        "gla_w_in": w(ks[8], (n_odd, D_MODEL, GLA_IN), D_MODEL),
        "gla_w_a2": w(ks[9], (n_odd, GLA_LOWRANK, GLA_HEADS * GLA_DK), GLA_LOWRANK),
        "gla_b_a": 0.1 * jax.random.normal(ks[10], (n_odd, GLA_HEADS * GLA_DK), f32),
        "gla_w_out": w(ks[11], (n_odd, GLA_MIX, D_MODEL), GLA_MIX),
        "ffn_post_norm": gain(ks[12], (DEPTH, D_MODEL)),
        "ffn_post_w_gate": w(ks[13], (DEPTH, D_MODEL, FFN_HIDDEN), D_MODEL),
        "ffn_post_w_up": w(ks[14], (DEPTH, D_MODEL, FFN_HIDDEN), D_MODEL),
        "ffn_post_w_down": w(ks[15], (DEPTH, FFN_HIDDEN, D_MODEL), FFN_HIDDEN),
        "final_norm": gain(ks[16], (D_MODEL,)),
    }


def reference(x, ffn_pre_norm, ffn_pre_w_gate, ffn_pre_w_up, ffn_pre_w_down, mix_norm,
              ab_w_in, ab_w_out, gla_w_in, gla_w_a2, gla_b_a, gla_w_out,
              ffn_post_norm, ffn_post_w_gate, ffn_post_w_up, ffn_post_w_down, final_norm):
    for l in range(DEPTH):
        h = _rmsnorm(x, ffn_pre_norm[l])
        x = x + 0.5 * _swiglu(h, ffn_pre_w_gate[l], ffn_pre_w_up[l], ffn_pre_w_down[l])
        h = _rmsnorm(x, mix_norm[l])
        if l % 2 == 0:
            x = x + _retention_dilated_mixer(h, ab_w_in[l // 2], ab_w_out[l // 2])
        else:
            x = x + _gla_mixer(h, gla_w_in[l // 2], gla_w_a2[l // 2], gla_b_a[l // 2], gla_w_out[l // 2])
        h = _rmsnorm(x, ffn_post_norm[l])
        x = x + 0.5 * _swiglu(h, ffn_post_w_gate[l], ffn_post_w_up[l], ffn_post_w_down[l])
    return _rmsnorm(x, final_norm)
```

```cpp
#include <hip/hip_runtime.h>
#include <cstdio>
#include <cstdint>
#include <cmath>
namespace pg8 {
#define PG8_LAS __attribute__((address_space(3)))
typedef unsigned short bf16_t;
typedef short bf16x8 __attribute__((ext_vector_type(8)));
typedef float f32x4 __attribute__((ext_vector_type(4)));
typedef unsigned u32x4 __attribute__((ext_vector_type(4)));
constexpr int BM = 256, BK = 64, HALF = 128, HTB = HALF * BK * 2  , STAGE_BYTES = 8 * HTB, NXCD = 8, WGM = 8;

__host__ __device__ __forceinline__ int lds_byte(int r, int c) { const int st = (r >> 4) * 2 + (c >> 5), rr = r & 15, cc = c & 31, ob = rr * 64 + cc * 2; return st * 1024 + (ob ^ (((ob >> 9) & 1) << 5)); }
__host__ __device__ __forceinline__ void stage_rc(int b, int& R, int& C) { const int st = b / 1024, sb = b % 1024, swz = sb ^ (((sb >> 9) & 1) << 5); R = (st >> 1) * 16 + swz / 64; C = (st & 1) * 32 + (swz % 64) / 2; }
__host__ __device__ __forceinline__ int perm32(int rho) { const int n = rho >> 4, i = rho & 15; return 8 * (i >> 2) + 4 * n + (i & 3); }

struct Unit { int pm, pn; };
struct Gemm { const bf16_t* A; const bf16_t* Bt; int M, N, K; };

struct StaticOrder {
    int nM, nN, nwg, G, c;
    __host__ __device__ void init(int M, int N, int G_, int c_) { nM = M / BM; nN = N / BM; nwg = nM * nN; G = G_; c = c_; }
    __host__ __device__ bool next(int i, Unit& u) const {
        const long L = (long)i * G + c; if (L >= nwg) return false;
        int wgid = (int)L; { const int q = nwg / NXCD, r = nwg % NXCD, xcd = wgid % NXCD, off = wgid / NXCD; wgid = (xcd < r ? xcd * (q + 1) : r * (q + 1) + (xcd - r) * q) + off; }
        const int nig = WGM * nN, gid = wgid / nig, fm = gid * WGM, gsz = (nM - fm) < WGM ? (nM - fm) : WGM;
        u.pm = fm + ((wgid % nig) % gsz); u.pn = (wgid % nig) / gsz; return true;
    }
    __device__ __forceinline__ void a_ready(const Unit&) const {}
    __device__ __forceinline__ void done(const Unit&) const {}
};

__device__ __forceinline__ unsigned cvt_pk_bf16(float lo, float hi) { unsigned r; asm volatile("v_cvt_pk_bf16_f32 %0, %1, %2" : "=v"(r) : "v"(lo), "v"(hi)); return r; }
constexpr int MROWS = 32768;
constexpr float RMS_EPS = 1e-6f;
__device__ __forceinline__ void row_rstd(float (&rs)[2][4], const float* ssp, const Unit& u, int wr, int fr, int fq) {
#pragma unroll
    for (int ai = 0; ai < 2; ++ai)
#pragma unroll
        for (int m = 0; m < 4; ++m) {
            const int row = u.pm * BM + ai * HALF + wr * 64 + m * 16 + fr;
            const f32x4 p = *(const f32x4*)(ssp + (size_t)row * 16 + 4 * fq);
            float s = (p[0] + p[1]) + (p[2] + p[3]);
            s += __shfl_xor(s, 16); s += __shfl_xor(s, 32);
            rs[ai][m] = 1.0f / sqrtf(s * (1.0f / 1024.0f) + RMS_EPS);
        }
}
__device__ __forceinline__ float silu_f(float g) { return g * __builtin_amdgcn_rcpf(1.0f + __builtin_amdgcn_exp2f(-1.4426950408889634f * g)); }

struct EpiSwiGLU {
    static constexpr bool PERM = true, AFTER_DRAIN = false;
    bf16_t* H; int ldh; const float* ssp;
    __device__ __forceinline__ void operator()(const f32x4 (&acc)[2][2][4][2], const Unit& u, int wr, int wc, int fr, int fq) const {
        float rs[2][4]; row_rstd(rs, ssp, u, wr, fr, fq);
        const int col0 = u.pn * HALF + wc * 32 + 8 * fq;
#pragma unroll
        for (int ai = 0; ai < 2; ++ai)
#pragma unroll
            for (int m = 0; m < 4; ++m) {
                const int row = u.pm * BM + ai * HALF + wr * 64 + m * 16 + fr; const float r = rs[ai][m];
                float h[8];
#pragma unroll
                for (int n = 0; n < 2; ++n)
#pragma unroll
                    for (int i = 0; i < 4; ++i) { const float g = acc[ai][0][m][n][i] * r, up = acc[ai][1][m][n][i] * r; h[4 * n + i] = silu_f(g) * up; }
                u32x4 w; w.x = cvt_pk_bf16(h[0], h[1]); w.y = cvt_pk_bf16(h[2], h[3]); w.z = cvt_pk_bf16(h[4], h[5]); w.w = cvt_pk_bf16(h[6], h[7]);
                *(u32x4*)(H + (size_t)row * ldh + col0) = w;
                asm volatile("" ::: "memory");
            }
    }
};
struct EpiScaleBf16 {
    static constexpr bool PERM = true, AFTER_DRAIN = false;
    bf16_t* O; int ldc; const float* ssp;
    __device__ __forceinline__ void operator()(const f32x4 (&acc)[2][2][4][2], const Unit& u, int wr, int wc, int fr, int fq) const {
        float rs[2][4]; row_rstd(rs, ssp, u, wr, fr, fq);
        const int col0 = u.pn * BM + wc * 32 + 8 * fq;
#pragma unroll
        for (int ai = 0; ai < 2; ++ai)
#pragma unroll
            for (int m = 0; m < 4; ++m) {
                const int row = u.pm * BM + ai * HALF + wr * 64 + m * 16 + fr; const float r = rs[ai][m];
#pragma unroll
                for (int bj = 0; bj < 2; ++bj) { const f32x4 v0 = acc[ai][bj][m][0] * r, v1 = acc[ai][bj][m][1] * r;
                    u32x4 w; w.x = cvt_pk_bf16(v0[0], v0[1]); w.y = cvt_pk_bf16(v0[2], v0[3]); w.z = cvt_pk_bf16(v1[0], v1[1]); w.w = cvt_pk_bf16(v1[2], v1[3]);
                    *(u32x4*)(O + (size_t)row * ldc + col0 + bj * HALF) = w; }
                asm volatile("" ::: "memory");
            }
    }
};
struct EpiResid {
    static constexpr bool PERM = true, AFTER_DRAIN = false;
    const float* xold; float* xnew; bf16_t* xb; float* ssp; float scale;
    __device__ __forceinline__ void operator()(const f32x4 (&acc)[2][2][4][2], const Unit& u, int wr, int wc, int fr, int fq) const {
        const int col0 = u.pn * BM + wc * 32 + 8 * fq;
#pragma unroll
        for (int ai = 0; ai < 2; ++ai)
#pragma unroll
            for (int m = 0; m < 4; ++m) {
                const int row = u.pm * BM + ai * HALF + wr * 64 + m * 16 + fr; float ss = 0.f;
#pragma unroll
                for (int bj = 0; bj < 2; ++bj) { const size_t off = (size_t)row * 1024 + col0 + bj * HALF;
                    const f32x4 o0 = *(const f32x4*)(xold + off), o1 = *(const f32x4*)(xold + off + 4);
                    const f32x4 v0 = o0 + acc[ai][bj][m][0] * scale, v1 = o1 + acc[ai][bj][m][1] * scale;
                    *(f32x4*)(xnew + off) = v0; *(f32x4*)(xnew + off + 4) = v1;
                    u32x4 w; w.x = cvt_pk_bf16(v0[0], v0[1]); w.y = cvt_pk_bf16(v0[2], v0[3]); w.z = cvt_pk_bf16(v1[0], v1[1]); w.w = cvt_pk_bf16(v1[2], v1[3]);
                    *(u32x4*)(xb + off) = w;
                    ss += (v0[0] * v0[0] + v0[1] * v0[1]) + (v0[2] * v0[2] + v0[3] * v0[3]) + (v1[0] * v1[0] + v1[1] * v1[1]) + (v1[2] * v1[2] + v1[3] * v1[3]); }
                ss += __shfl_xor(ss, 16); ss += __shfl_xor(ss, 32);
                if (fq == 0) ssp[(size_t)row * 16 + u.pn * 4 + wc] = ss;
                asm volatile("" ::: "memory");
            }
    }
};

template <class Epi, class Sched, bool ALIGN_EPI = false, bool SP2 = false>
__device__ __forceinline__ void gemm_phase(PG8_LAS unsigned char* lds, const Gemm g, const Sched& S, const Epi& E) {
    int tid_ = threadIdx.x; asm volatile("" : "+v"(tid_));
    const int tid = tid_, wid = __builtin_amdgcn_readfirstlane(tid >> 6), lane = tid & 63, wr = wid >> 2, wc = wid & 3, fr = lane & 15, fq = lane >> 4;
    const int K = g.K, nt = K / BK;
    unsigned voffA[2], voffB[2];
#pragma unroll
    for (int i = 0; i < 2; ++i) { int R, C; stage_rc(tid * 16 + i * 8192, R, C); const int Rb = Epi::PERM ? ((R & ~31) + perm32(R & 31)) : R;
        voffA[i] = (unsigned)(R * K + C) * 2u; voffB[i] = (unsigned)(Rb * K + C) * 2u; }
    const size_t kstep = (size_t)(BK * 2);
    const size_t hstep = (size_t)HALF * K * 2;
    const size_t tstep = 2 * hstep;
    const unsigned ldsw = (unsigned)wid * 1024u;
    const int aoff = lds_byte(wr * 64 + fr, fq * 8), boff = lds_byte(wc * 32 + fr, fq * 8);
#define PG8_SA(b, h) (((b) * 2 + (h)) * HTB)
#define PG8_SB(b, h) ((4 + (b) * 2 + (h)) * HTB)
#define PG8_STAGE(bufoff, gbase, voff) do { _Pragma("unroll") for (int _i = 0; _i < 2; ++_i) \
        __builtin_amdgcn_global_load_lds((const unsigned*)((const char*)(gbase) + (voff)[_i]), (PG8_LAS unsigned*)(lds + (bufoff) + ldsw + _i * 8192), 16, 0, 0); } while (0)
#define PG8_LDA(dst, b, h) do { _Pragma("unroll") for (int m = 0; m < 4; ++m) _Pragma("unroll") for (int k = 0; k < 2; ++k) dst[m][k] = *(const PG8_LAS bf16x8*)(lds + PG8_SA(b, h) + aoff + m * 2048 + k * 1024); } while (0)
#define PG8_LDB(dst, b, h) do { _Pragma("unroll") for (int n = 0; n < 2; ++n) _Pragma("unroll") for (int k = 0; k < 2; ++k) dst[n][k] = *(const PG8_LAS bf16x8*)(lds + PG8_SB(b, h) + boff + n * 2048 + k * 1024); } while (0)
#define PG8_MMA(ai, bj, At, Bt) do { __builtin_amdgcn_s_setprio(1); _Pragma("unroll") for (int m = 0; m < 4; ++m) _Pragma("unroll") for (int n = 0; n < 2; ++n) _Pragma("unroll") for (int k = 0; k < 2; ++k) \
        acc[ai][bj][m][n] = __builtin_amdgcn_mfma_f32_16x16x32_bf16(Bt[n][k], At[m][k], acc[ai][bj][m][n], 0, 0, 0); __builtin_amdgcn_s_setprio(0); } while (0)
#define PG8_WAIT_V(n) asm volatile("s_waitcnt vmcnt(" #n ")" ::: "memory")
#define PG8_WAIT_L(n) asm volatile("s_waitcnt lgkmcnt(" #n ")" ::: "memory")
#define PG8_BAR __builtin_amdgcn_s_barrier()
#define PG8_SCHED __builtin_amdgcn_sched_barrier(0)
    Unit cur, nxt; int ui = 0;
    if (!S.next(0, cur)) return;
    f32x4 acc[2][2][4][2];
#pragma unroll
    for (int a = 0; a < 2; ++a)
#pragma unroll
        for (int b = 0; b < 2; ++b)
#pragma unroll
            for (int m = 0; m < 4; ++m)
#pragma unroll
                for (int n = 0; n < 2; ++n) acc[a][b][m][n] = (f32x4){0.f, 0.f, 0.f, 0.f};
    bf16x8 At[4][2], B0[2][2], B1[2][2];
    const char* cA = (const char*)g.A + (size_t)cur.pm * tstep; const char* cB = (const char*)g.Bt + (size_t)cur.pn * tstep;
    S.a_ready(cur);
    if constexpr (SP2) {
        PG8_STAGE(PG8_SB(0, 0), cB, voffB); PG8_STAGE(PG8_SB(0, 1), cB + hstep, voffB); PG8_STAGE(PG8_SA(0, 0), cA, voffA); PG8_STAGE(PG8_SA(0, 1), cA + hstep, voffA);
        if (wr == 1) PG8_BAR;
        PG8_WAIT_V(2); PG8_BAR;
        PG8_STAGE(PG8_SB(1, 0), cB + kstep, voffB); PG8_STAGE(PG8_SA(1, 0), cA + kstep, voffA); PG8_STAGE(PG8_SB(1, 1), cB + hstep + kstep, voffB);
        PG8_WAIT_V(6); PG8_BAR;
    } else {
        PG8_STAGE(PG8_SB(0, 0), cB, voffB); PG8_STAGE(PG8_SA(0, 0), cA, voffA); PG8_STAGE(PG8_SB(0, 1), cB + hstep, voffB); PG8_STAGE(PG8_SA(0, 1), cA + hstep, voffA);
        if (wr == 1) PG8_BAR;
        PG8_WAIT_V(4); PG8_BAR;
        PG8_STAGE(PG8_SB(1, 0), cB + kstep, voffB); PG8_STAGE(PG8_SA(1, 0), cA + kstep, voffA); PG8_STAGE(PG8_SB(1, 1), cB + hstep + kstep, voffB);
        PG8_WAIT_V(6); PG8_BAR;
    }
    for (;;) {
        const bool has_next = S.next(ui + 1, nxt);
        const char* nA = has_next ? (const char*)g.A + (size_t)nxt.pm * tstep : cA; const char* nB = has_next ? (const char*)g.Bt + (size_t)nxt.pn * tstep : cB;
        for (int t = 0; t < nt; t += 2) {
            const bool last = (t == nt - 2);
            const char* a1 = cA + (size_t)(t + 1) * kstep;
            const char* a2 = last ? nA : cA + (size_t)(t + 2) * kstep; const char* b2 = last ? nB : cB + (size_t)(t + 2) * kstep;
            const char* a3 = a2 + kstep; const char* b3 = b2 + kstep;
            if (last && has_next) S.a_ready(nxt);
            if constexpr (SP2) {
            PG8_LDB(B0, 0, 0); PG8_LDB(B1, 0, 1); PG8_SCHED; PG8_LDA(At, 0, 0); PG8_STAGE(PG8_SA(1, 1), a1 + hstep, voffA);
            PG8_WAIT_V(8); PG8_WAIT_L(0); PG8_BAR; PG8_MMA(0, 0, At, B0); PG8_MMA(0, 1, At, B1); PG8_BAR; PG8_SCHED;
            PG8_LDA(At, 0, 1); PG8_STAGE(PG8_SB(0, 0), b2, voffB); PG8_STAGE(PG8_SB(0, 1), b2 + hstep, voffB); PG8_STAGE(PG8_SA(0, 0), a2, voffA);
            PG8_WAIT_V(8); PG8_WAIT_L(0); PG8_BAR; PG8_MMA(1, 0, At, B0); PG8_MMA(1, 1, At, B1); PG8_BAR; PG8_SCHED;
            PG8_LDB(B0, 1, 0); PG8_LDB(B1, 1, 1); PG8_SCHED; PG8_LDA(At, 1, 0); PG8_STAGE(PG8_SA(0, 1), a2 + hstep, voffA);
            PG8_WAIT_V(8); PG8_WAIT_L(0); PG8_BAR; PG8_MMA(0, 0, At, B0); PG8_MMA(0, 1, At, B1); PG8_BAR; PG8_SCHED;
            PG8_LDA(At, 1, 1); PG8_STAGE(PG8_SB(1, 0), b3, voffB); PG8_STAGE(PG8_SB(1, 1), b3 + hstep, voffB); PG8_STAGE(PG8_SA(1, 0), a3, voffA);
            PG8_WAIT_V(8); PG8_WAIT_L(0); PG8_BAR; PG8_MMA(1, 0, At, B0); PG8_MMA(1, 1, At, B1); PG8_BAR; PG8_SCHED;
            } else {
            PG8_LDB(B0, 0, 0); PG8_SCHED; PG8_LDA(At, 0, 0); PG8_STAGE(PG8_SA(1, 1), a1 + hstep, voffA);
            PG8_WAIT_L(8); PG8_BAR; PG8_WAIT_L(0); PG8_MMA(0, 0, At, B0); PG8_BAR; PG8_SCHED;
            PG8_LDB(B1, 0, 1); PG8_STAGE(PG8_SB(0, 0), b2, voffB);
            PG8_BAR; PG8_WAIT_L(0); PG8_MMA(0, 1, At, B1); PG8_BAR;
            PG8_LDA(At, 0, 1); PG8_STAGE(PG8_SA(0, 0), a2, voffA);
            PG8_BAR; PG8_WAIT_L(0); PG8_MMA(1, 0, At, B0); PG8_BAR; PG8_SCHED;
            PG8_STAGE(PG8_SB(0, 1), b2 + hstep, voffB);
            PG8_WAIT_V(6); PG8_BAR; PG8_MMA(1, 1, At, B1); PG8_BAR;
            PG8_LDB(B0, 1, 0); PG8_SCHED; PG8_LDA(At, 1, 0); PG8_STAGE(PG8_SA(0, 1), a2 + hstep, voffA);
            PG8_WAIT_L(8); PG8_BAR; PG8_WAIT_L(0); PG8_MMA(0, 0, At, B0); PG8_BAR; PG8_SCHED;
            PG8_LDB(B1, 1, 1); PG8_STAGE(PG8_SB(1, 0), b3, voffB);
            PG8_BAR; PG8_WAIT_L(0); PG8_MMA(0, 1, At, B1); PG8_BAR;
            PG8_LDA(At, 1, 1); PG8_STAGE(PG8_SA(1, 0), a3, voffA);
            PG8_BAR; PG8_WAIT_L(0); PG8_MMA(1, 0, At, B0); PG8_BAR; PG8_SCHED;
            PG8_STAGE(PG8_SB(1, 1), b3 + hstep, voffB);
            PG8_WAIT_V(6); PG8_BAR; PG8_MMA(1, 1, At, B1); PG8_BAR;
            }
        }
        if constexpr (ALIGN_EPI) { if (wr == 0) PG8_BAR; }
        if constexpr (!Epi::AFTER_DRAIN) { E(acc, cur, wr, wc, fr, fq); S.done(cur); }
        if (!has_next) break;
#pragma unroll
        for (int a = 0; a < 2; ++a)
#pragma unroll
            for (int b = 0; b < 2; ++b)
#pragma unroll
                for (int m = 0; m < 4; ++m)
#pragma unroll
                    for (int n = 0; n < 2; ++n) acc[a][b][m][n] = (f32x4){0.f, 0.f, 0.f, 0.f};
        cur = nxt; cA = nA; cB = nB; ++ui;
        if constexpr (ALIGN_EPI) { if (wr == 1) PG8_BAR; }
    }
    PG8_WAIT_V(0);
    if constexpr (!ALIGN_EPI) { if (wr == 0) PG8_BAR; }
    PG8_BAR;
    if constexpr (Epi::AFTER_DRAIN) { E.fused(acc, cur, wr, wc, fr, fq, lds, wid, lane); S.done(cur); }
#undef PG8_SA
#undef PG8_SB
#undef PG8_STAGE
#undef PG8_LDA
#undef PG8_LDB
#undef PG8_MMA
#undef PG8_WAIT_V
#undef PG8_WAIT_L
#undef PG8_BAR
#undef PG8_SCHED
}
}

constexpr int NWAVES = 8, NTHREADS = NWAVES * 64;
constexpr int BATCH = 8, SEQ = 4096, D = 1024, M = BATCH * SEQ, FF = 2816, DEPTH = 4;
constexpr int EVEN_IN = 3584, GLA_IN = 3088, GLA_INP = 3328;
static_assert(M == pg8::MROWS, "row count");
constexpr int E_RQ = 0, E_RK = 512, E_RV = 1024, E_RG = 1536, E_DQ = 2048, E_DK = 2560, E_DV = 3072;
constexpr int G_Q = 0, G_K = 512, G_V = 1024, G_R = 2048, G_A = 3072;
constexpr float EPS = 1e-6f;

constexpr size_t MiB = 1u << 20;
constexpr size_t WS_CTL = 0, CTL_ZERO_BYTES = 1 * MiB;
constexpr size_t WS_SSP = 1 * MiB;
constexpr size_t WS_TAB = 3 * MiB;
constexpr size_t TAB_RC = WS_TAB, TAB_RS = WS_TAB + 1 * MiB, TAB_DC = WS_TAB + 2 * MiB, TAB_DS = WS_TAB + 2 * MiB + 128 * 1024;
constexpr size_t WS_W = 8 * MiB;
constexpr size_t W_GU0 = WS_W, W_D0 = W_GU0 + (size_t)2 * FF * D * 2, W_GU1 = W_D0 + (size_t)D * FF * 2, W_D1 = W_GU1 + (size_t)2 * FF * D * 2,
                 W_IN = W_D1 + (size_t)D * FF * 2, W_OUT = W_IN + (size_t)EVEN_IN * D * 2, W_END = W_OUT + (size_t)D * D * 2;
constexpr size_t WS_XB = 56 * MiB;
constexpr size_t WS_ACT = 120 * MiB;
constexpr size_t WS_CAT = 344 * MiB;
constexpr size_t WS_END = 408 * MiB;
static_assert(W_END <= WS_XB && WS_XB + (size_t)M * D * 2 <= WS_ACT && WS_ACT + (size_t)M * EVEN_IN * 2 <= WS_CAT && WS_CAT + (size_t)M * D * 2 <= WS_END, "d_ws map");
constexpr int CW_BAR = 4096;

constexpr int RING_OFF = 0, RING_BYTES = 131072;
constexpr int LDSCTL_OFF = RING_BYTES, MISC_OFF = LDSCTL_OFF + 320, PTR_OFF = LDSCTL_OFF + 1024;
constexpr int LDS_BYTES = 147456;
static_assert(MISC_OFF + 128 <= LDS_BYTES, "LDS map");

#define GAS __attribute__((address_space(1)))
#define LAS __attribute__((address_space(3)))
typedef unsigned short bf16;
typedef unsigned v4u __attribute__((ext_vector_type(4)));
typedef float f32x4 __attribute__((ext_vector_type(4)));
typedef short bf16x8 __attribute__((ext_vector_type(8)));
typedef GAS unsigned gu32;
typedef GAS unsigned long long gu64;
#define RLX_AGENT __ATOMIC_RELAXED, __HIP_MEMORY_SCOPE_AGENT
#define LDS_WAIT() asm volatile("s_waitcnt lgkmcnt(0)" ::: "memory")
#define VM_WAIT() asm volatile("s_waitcnt vmcnt(0)" ::: "memory")
__device__ __forceinline__ unsigned long long rt() { return __builtin_amdgcn_s_memrealtime(); }
__device__ __forceinline__ unsigned f2bf(float f) { unsigned u = __builtin_bit_cast(unsigned, f); return (u + 0x7fffu + ((u >> 16) & 1u)) >> 16; }
__device__ __forceinline__ unsigned pk2(float lo, float hi) { return f2bf(lo) | (f2bf(hi) << 16); }

#define XB_TMO      128
#define XB_XCNT(j)  (256  + 64 * (j))
#define XB_XSUB(j)  (1280 + 64 * (j))
#define XB_XGEN(j)  (2304 + 64 * (j))
#define XB_TOP      3328
#define XB_TOPGEN   3392
#define XCD_BAR_WORDS 3456
#define XB_SPIN_CAP (1u << 18)

__device__ __forceinline__ unsigned xb_ld(unsigned* p)              { return __hip_atomic_load(p, __ATOMIC_RELAXED, __HIP_MEMORY_SCOPE_AGENT); }
__device__ __forceinline__ unsigned xb_add(unsigned* p, unsigned v) { return __hip_atomic_fetch_add(p, v, __ATOMIC_RELAXED, __HIP_MEMORY_SCOPE_AGENT); }
__device__ __forceinline__ unsigned xb_xcc_id() { return (unsigned)__builtin_amdgcn_s_getreg((3 << 11) | 20) & 0xFu; }
#define XB_SPIN(cond, bar) do { unsigned _sp = 0; while (cond) { __builtin_amdgcn_s_sleep(1); \
    if ((++_sp & 255u) == 0u) { if (xb_ld(&(bar)[XB_TMO])) break; if (_sp > XB_SPIN_CAP) { atomicAdd(&(bar)[XB_TMO], 1u); break; } } } } while (0)

struct XcdBarrier {
    unsigned* bar; unsigned x;
    volatile LAS unsigned* st;
};

__device__ __forceinline__ XcdBarrier xcd_barrier_post(unsigned* bar, volatile LAS unsigned* st) {
    XcdBarrier b; b.bar = bar; b.x = xb_xcc_id(); b.st = st;
    if (threadIdx.x == 0) (void)xb_add(&bar[XB_XCNT(b.x)], 1u);
    return b;
}
__device__ __forceinline__ void xcd_barrier_complete(unsigned* bar, unsigned x, unsigned& nloc, unsigned& nx) {
    const unsigned G = gridDim.x * gridDim.y * gridDim.z;
    unsigned sum, cnt, mine, sp = 0u;
    for (;;) {
        sum = 0u; cnt = 0u; mine = 0u;
#pragma unroll
        for (unsigned j = 0; j < 16; ++j) { const unsigned c = xb_ld(&bar[XB_XCNT(j)]); sum += c; cnt += (c > 0u) ? 1u : 0u; mine = (j == x) ? c : mine; }
        if (sum == G) break;
        __builtin_amdgcn_s_sleep(1);
        if ((++sp & 255u) == 0u) { if (xb_ld(&bar[XB_TMO])) break; if (sp > XB_SPIN_CAP) { atomicAdd(&bar[XB_TMO], 1u); break; } }
    }
    nloc = mine > 0u ? mine : 1u; nx = cnt > 0u ? cnt : 1u;
}

__device__ __forceinline__ void xcd_barrier(const XcdBarrier& b) {
    asm volatile("s_waitcnt vmcnt(0)" ::: "memory");
    __syncthreads();
    if (threadIdx.x == 0) {
        unsigned* bar = b.bar;
        __builtin_amdgcn_s_waitcnt(0);
        unsigned nloc = b.st[0], nx = b.st[1];
        if (nloc == 0u) { xcd_barrier_complete(bar, b.x, nloc, nx); b.st[0] = nloc; b.st[1] = nx; }
        const unsigned old = xb_add(&bar[XB_XSUB(b.x)], 1u);
        const unsigned gen = old / nloc;
        if (old + 1u == (gen + 1u) * nloc) {
            __builtin_amdgcn_fence(__ATOMIC_RELEASE, "agent");
            asm volatile("s_waitcnt vmcnt(0)" ::: "memory");
            const unsigned og = xb_add(&bar[XB_TOP], 1u);
            const unsigned tg = og / nx;
            if (og + 1u == (tg + 1u) * nx) xb_add(&bar[XB_TOPGEN], 1u);
            else XB_SPIN(xb_ld(&bar[XB_TOPGEN]) == tg, bar);
            __builtin_amdgcn_fence(__ATOMIC_ACQUIRE, "agent");
            xb_add(&bar[XB_XGEN(b.x)], 1u);
            asm volatile("s_waitcnt vmcnt(0)" ::: "memory");
        } else {
            XB_SPIN(xb_ld(&bar[XB_XGEN(b.x)]) == gen, bar);
            __builtin_amdgcn_fence(__ATOMIC_ACQUIRE, "agent");
            asm volatile("s_waitcnt vmcnt(0)" ::: "memory");
        }
    }
    __syncthreads();
}

__constant__ float RET_FREQ[64] = {1.000000000e+00f, 8.639884591e-01f, 7.464760542e-01f, 6.449466944e-01f, 5.572264791e-01f, 4.814372361e-01f, 4.159561992e-01f, 3.593813777e-01f, 3.105013371e-01f, 2.682695687e-01f, 2.317818105e-01f, 2.002568096e-01f, 1.730195731e-01f, 1.494869143e-01f, 1.291549653e-01f, 1.115883961e-01f, 9.641107172e-02f, 8.329805732e-02f, 7.196855545e-02f, 6.218000501e-02f, 5.372280627e-02f, 4.641588405e-02f, 4.010278732e-02f, 3.464834765e-02f, 2.993577160e-02f, 2.586415969e-02f, 2.234633639e-02f, 1.930697635e-02f, 1.668100432e-02f, 1.441219542e-02f, 1.245197095e-02f, 1.075835899e-02f, 9.295095690e-03f, 8.030855097e-03f, 6.938565988e-03f, 5.994840991e-03f, 5.179473665e-03f, 4.475005437e-03f, 3.866352839e-03f, 3.340484342e-03f, 2.886139788e-03f, 2.493591513e-03f, 2.154434333e-03f, 1.861406374e-03f, 1.608233666e-03f, 1.389495330e-03f, 1.200507861e-03f, 1.037224894e-03f, 8.961503627e-04f, 7.742635789e-04f, 6.689548027e-04f, 5.779692437e-04f, 4.993587499e-04f, 4.314401885e-04f, 3.727593285e-04f, 3.220597573e-04f, 2.782559313e-04f, 2.404099068e-04f, 2.077113895e-04f, 1.794602431e-04f, 1.550515735e-04f, 1.339627634e-04f, 1.157422885e-04f, 9.999999747e-05f};
__constant__ float ROPE_FREQ[8] = {1.000000000e+00f, 1.939227432e-01f, 3.760603070e-02f, 7.292664610e-03f, 1.414213562e-03f, 2.742481884e-04f, 5.318295734e-05f, 1.031338525e-05f};
struct Args { const float* in[17]; float* out; unsigned char* ws; };
enum { I_X = 0, I_PRE_NORM = 1, I_PRE_WG = 2, I_PRE_WU = 3, I_PRE_WD = 4, I_MIX_NORM = 5, I_AB_IN = 6, I_AB_OUT = 7, I_GLA_IN = 8, I_GLA_A2 = 9, I_GLA_BA = 10, I_GLA_OUT = 11,
       I_POST_NORM = 12, I_POST_WG = 13, I_POST_WU = 14, I_POST_WD = 15, I_FINAL = 16, I_OUT = 17, I_WS = 18, N_PTRS = 19 };
struct Frame {
    LAS unsigned char* lds;
    int tid, lane, wave, G, bid;
};
__device__ __forceinline__ unsigned char* tabp(const Frame& F, int idx) {
    const volatile LAS unsigned* T = (const volatile LAS unsigned*)(F.lds + PTR_OFF) + 2 * idx;
    const unsigned lo = __builtin_amdgcn_readfirstlane(T[0]), hi = __builtin_amdgcn_readfirstlane(T[1]);
    return (unsigned char*)(((unsigned long long)hi << 32) | (unsigned long long)lo);
}
#define AP(idx) ((const float*)tabp(F, idx))
#define WSP() tabp(F, I_WS)
#define OUTP() ((float*)tabp(F, I_OUT))
__device__ __forceinline__ Frame relaunder(const Frame& F0) { Frame F = F0; asm volatile("" : "+v"(F.tid)); asm volatile("" : "+s"(F.bid)); F.lane = F.tid & 63; F.wave = __builtin_amdgcn_readfirstlane(F.tid >> 6); return F; }
__device__ __forceinline__ float wave_sum(float v) {
#pragma unroll
    for (int o = 1; o < 64; o <<= 1) v += __shfl_xor(v, o);
    return v;
}
__device__ __forceinline__ float bf2f(bf16 h) { return __builtin_bit_cast(float, (unsigned)h << 16); }
__device__ __forceinline__ float bflo(unsigned w) { return __builtin_bit_cast(float, w << 16); }
__device__ __forceinline__ float bfhi(unsigned w) { return __builtin_bit_cast(float, w & 0xffff0000u); }
__device__ __forceinline__ bf16 f2bf_rne(float f) { return (bf16)f2bf(f); }

__device__ __forceinline__ void tr_item(const float* W, int K, int N, int Npad, const float* gain, bf16* WT, int gu, LAS float* scr, int item, int lane) {
    const int nblk = Npad / 32, kb = item / nblk, nb = item % nblk, k0 = 64 * kb, n0 = 32 * nb;
    const int nn = n0 + (lane & 31); const bool ok = nn < N;
#pragma unroll 8
    for (int i = 0; i < 32; ++i) { const int kk = 2 * i + (lane >> 5); float w = ok ? W[(size_t)(k0 + kk) * N + nn] : 0.f; if (gain) w *= gain[k0 + kk]; scr[kk * 33 + (lane & 31)] = w; }
    LDS_WAIT(); asm volatile("" ::: "memory");
    const int c = lane & 7;
#pragma unroll
    for (int j = 0; j < 4; ++j) { const int n = (lane >> 3) + 8 * j; const LAS float* s = scr + (8 * c) * 33 + n;
        v4u o; o.x = pk2(s[0 * 33], s[1 * 33]); o.y = pk2(s[2 * 33], s[3 * 33]); o.z = pk2(s[4 * 33], s[5 * 33]); o.w = pk2(s[6 * 33], s[7 * 33]);
        int drow = n0 + n; if (gu) drow = (drow >> 7) * 256 + (drow & 127) + (gu == 2 ? 128 : 0);
        *(GAS v4u*)(WT + (size_t)drow * K + k0 + 8 * c) = o; }
    LDS_WAIT(); asm volatile("" ::: "memory");
}
__device__ __forceinline__ void convert_weights(const Frame& F0, int l) {
    const Frame F = relaunder(F0);
    LAS float* scr = (LAS float*)(F.lds + RING_OFF + F.wave * 16384);
    const int gw = F.bid * NWAVES + F.wave, NGW = F.G * NWAVES;
    unsigned char* ws = WSP();
    constexpr int I_G = (D / 64) * (FF / 32), I_DN = (FF / 64) * (D / 32), I_O = (D / 64) * (D / 32);
    const bool odd = (l & 1) != 0; const int li = l >> 1;
    const int nin = odd ? GLA_IN : EVEN_IN, ninp = odd ? GLA_INP : EVEN_IN; const int I_IN = (D / 64) * (ninp / 32);
    const float* win = odd ? AP(I_GLA_IN) + (size_t)li * D * GLA_IN : AP(I_AB_IN) + (size_t)li * D * EVEN_IN;
    const float* wout = odd ? AP(I_GLA_OUT) + (size_t)li * D * D : AP(I_AB_OUT) + (size_t)li * D * D;
    const size_t fo = (size_t)l * D * FF;
    const int NITEMS = 6 * I_G + I_IN + I_O;
    static_assert(I_G == I_DN, "item counts");
    for (int it = gw; it < NITEMS; it += NGW) {
        int r = it;
        if (r < I_G) { tr_item(AP(I_PRE_WG) + fo, D, FF, FF, AP(I_PRE_NORM) + l * D, (bf16*)(ws + W_GU0), 1, scr, r, F.lane); continue; } r -= I_G;
        if (r < I_G) { tr_item(AP(I_PRE_WU) + fo, D, FF, FF, AP(I_PRE_NORM) + l * D, (bf16*)(ws + W_GU0), 2, scr, r, F.lane); continue; } r -= I_G;
        if (r < I_G) { tr_item(AP(I_PRE_WD) + fo, FF, D, D, nullptr, (bf16*)(ws + W_D0), 0, scr, r, F.lane); continue; } r -= I_G;
        if (r < I_G) { tr_item(AP(I_POST_WG) + fo, D, FF, FF, AP(I_POST_NORM) + l * D, (bf16*)(ws + W_GU1), 1, scr, r, F.lane); continue; } r -= I_G;
        if (r < I_G) { tr_item(AP(I_POST_WU) + fo, D, FF, FF, AP(I_POST_NORM) + l * D, (bf16*)(ws + W_GU1), 2, scr, r, F.lane); continue; } r -= I_G;
        if (r < I_G) { tr_item(AP(I_POST_WD) + fo, FF, D, D, nullptr, (bf16*)(ws + W_D1), 0, scr, r, F.lane); continue; } r -= I_G;
        if (r < I_IN) { tr_item(win, D, nin, ninp, AP(I_MIX_NORM) + l * D, (bf16*)(ws + W_IN), 0, scr, r, F.lane); continue; } r -= I_IN;
        tr_item(wout, D, D, D, nullptr, (bf16*)(ws + W_OUT), 0, scr, r, F.lane);
    }
}
__device__ __forceinline__ void prologue_rows(const Frame& F0) {
    const Frame F = relaunder(F0);
    unsigned char* ws = WSP();
    const int gw = F.bid * NWAVES + F.wave, NGW = F.G * NWAVES;
    bf16* XB = (bf16*)(ws + WS_XB); float* ssp = (float*)(ws + WS_SSP);
    for (int m = gw; m < M; m += NGW) {
        const GAS f32x4* xr = (const GAS f32x4*)(AP(I_X) + (size_t)m * D) + F.lane;
        GAS unsigned long long* o8 = (GAS unsigned long long*)(XB + (size_t)m * D) + F.lane;
        float s = 0.f;
#pragma unroll
        for (int j = 0; j < 4; ++j) { const f32x4 v = xr[64 * j]; s += (v.x * v.x + v.y * v.y) + (v.z * v.z + v.w * v.w);
            o8[64 * j] = (unsigned long long)pk2(v.x, v.y) | ((unsigned long long)pk2(v.z, v.w) << 32); }
        s = wave_sum(s);
        if (F.lane < 16) ssp[(size_t)m * 16 + F.lane] = (F.lane == 0) ? s : 0.f;
    }
    const int gt = F.bid * NTHREADS + F.tid, NGT = F.G * NTHREADS;
    float* rc = (float*)(ws + TAB_RC); float* rsn = (float*)(ws + TAB_RS); float* dc = (float*)(ws + TAB_DC); float* ds = (float*)(ws + TAB_DS);
    for (int e = gt; e < SEQ * 64; e += NGT) { const int t = e >> 6, i = e & 63; const float ang = (float)t * RET_FREQ[i];
        double rev = (double)ang * 0.15915494309189535; rev -= __builtin_rint(rev); const float r = (float)rev;
        rc[e] = __builtin_amdgcn_cosf(r); rsn[e] = __builtin_amdgcn_sinf(r); }
    for (int e = gt; e < SEQ * 8; e += NGT) { const int t = e >> 3, i = e & 7; const float ang = (float)t * ROPE_FREQ[i];
        double rev = (double)ang * 0.15915494309189535; rev -= __builtin_rint(rev); const float r = (float)rev;
        dc[e] = __builtin_amdgcn_cosf(r); ds[e] = __builtin_amdgcn_sinf(r); }
}

__device__ __forceinline__ void even_prep(const Frame& F0) {
    const Frame F = relaunder(F0);
    unsigned char* ws = WSP();
    const int gw = F.bid * NWAVES + F.wave, NGW = F.G * NWAVES;
    bf16* P = (bf16*)(ws + WS_ACT);
    const float* rc = (const float*)(ws + TAB_RC); const float* rsn = (const float*)(ws + TAB_RS); const float* dc = (const float*)(ws + TAB_DC); const float* ds = (const float*)(ws + TAB_DS);
    for (int m = gw; m < M; m += NGW) {
        const int pos = m & (SEQ - 1); bf16* row = P + (size_t)m * EVEN_IN;
        const float c = rc[pos * 64 + F.lane], s = rsn[pos * 64 + F.lane];
#pragma unroll
        for (int h = 0; h < 4; ++h) {
            { bf16* p1 = row + E_RQ + h * 128 + F.lane; bf16* p2 = p1 + 64; const float x1 = bf2f(*p1), x2 = bf2f(*p2); *p1 = f2bf_rne(x1 * c - x2 * s); *p2 = f2bf_rne(x2 * c + x1 * s); }
            { bf16* p1 = row + E_RK + h * 128 + F.lane; bf16* p2 = p1 + 64; const float x1 = bf2f(*p1), x2 = bf2f(*p2);
              *p1 = f2bf_rne((x1 * c - x2 * s) * 0.08838834764831845f); *p2 = f2bf_rne((x2 * c + x1 * s) * 0.08838834764831845f); }
        }
        { const int h = F.lane >> 3, i = F.lane & 7; const float c2 = dc[pos * 8 + i], s2 = ds[pos * 8 + i];
          { bf16* p1 = row + E_DQ + h * 64 + i; bf16* p2 = p1 + 8; const float x1 = bf2f(*p1), x2 = bf2f(*p2); *p1 = f2bf_rne(x1 * c2 - x2 * s2); *p2 = f2bf_rne(x2 * c2 + x1 * s2); }
          { bf16* p1 = row + E_DK + h * 64 + i; bf16* p2 = p1 + 8; const float x1 = bf2f(*p1), x2 = bf2f(*p2); *p1 = f2bf_rne(x1 * c2 - x2 * s2); *p2 = f2bf_rne(x2 * c2 + x1 * s2); } }
    }
}
__device__ __forceinline__ void even_core(const Frame& F0) {
    const Frame F = relaunder(F0);
    unsigned char* ws = WSP();
    const bf16* P = (const bf16*)(ws + WS_ACT);
    if (F.bid < 128) {
        const int b = F.bid >> 4, h = (F.bid >> 2) & 3, eg = F.bid & 3, e = eg * 32 + (F.tid >> 4), dq = F.tid & 15;
        const float g = 1.0f - exp2f(-5.0f - (float)h);
        float* oraw = (float*)(ws + WS_XB);
        const bf16* base = P + (size_t)b * SEQ * EVEN_IN;
        float S[8];
#pragma unroll
        for (int i = 0; i < 8; ++i) S[i] = 0.f;
        v4u qn = *(const GAS v4u*)(base + E_RQ + h * 128 + dq * 8), kn = *(const GAS v4u*)(base + E_RK + h * 128 + dq * 8); bf16 vn = base[E_RV + h * 128 + e];
        for (int t = 0; t < SEQ; ++t) {
            const v4u q = qn, k = kn; const float v = bf2f(vn);
            if (t + 1 < SEQ) { const bf16* nb = base + (size_t)(t + 1) * EVEN_IN; qn = *(const GAS v4u*)(nb + E_RQ + h * 128 + dq * 8); kn = *(const GAS v4u*)(nb + E_RK + h * 128 + dq * 8); vn = nb[E_RV + h * 128 + e]; }
            float o = 0.f;
#pragma unroll
            for (int i = 0; i < 4; ++i) { const unsigned qw = q[i], kw = k[i];
                S[2 * i] = g * S[2 * i] + bflo(kw) * v; S[2 * i + 1] = g * S[2 * i + 1] + bfhi(kw) * v;
                o += bflo(qw) * S[2 * i]; o += bfhi(qw) * S[2 * i + 1]; }
            o += __shfl_xor(o, 1); o += __shfl_xor(o, 2); o += __shfl_xor(o, 4); o += __shfl_xor(o, 8);
            if (dq == 0) oraw[((size_t)b * SEQ + t) * 512 + h * 128 + e] = o;
        }
    } else {
        bf16* CAT = (bf16*)(ws + WS_CAT);
        for (int it = F.bid - 128; it < BATCH * (SEQ / 64); it += F.G - 128) {
            const int b = it >> 6, t = (it & 63) * 64 + F.lane, h = F.wave;
            const bf16* base = P + (size_t)b * SEQ * EVEN_IN;
            float q[64];
            { const GAS v4u* qp = (const GAS v4u*)(base + (size_t)t * EVEN_IN + E_DQ + h * 64);
#pragma unroll
              for (int j = 0; j < 8; ++j) { const v4u w = qp[j];
#pragma unroll
                  for (int i = 0; i < 4; ++i) { q[8 * j + 2 * i] = bflo(w[i]) * (0.125f * 1.4426950408889634f); q[8 * j + 2 * i + 1] = bfhi(w[i]) * (0.125f * 1.4426950408889634f); } } }
            float o[64];
#pragma unroll
            for (int i = 0; i < 64; ++i) o[i] = 0.f;
            float mx = -INFINITY, l = 0.f;
            for (int p = 0; p < 3; ++p) {
                const int dil = (p == 0) ? 1 : (p == 1) ? 4 : 16;
                for (int j = 0; j <= 128; ++j) {
                    const int tk = t - j * dil;
                    if (tk >= 0) {
                        const GAS v4u* kp = (const GAS v4u*)(base + (size_t)tk * EVEN_IN + E_DK + h * 64);
                        const GAS v4u* vp = (const GAS v4u*)(base + (size_t)tk * EVEN_IN + E_DV + h * 64);
                        float s = 0.f;
#pragma unroll
                        for (int jj = 0; jj < 8; ++jj) { const v4u w = kp[jj];
#pragma unroll
                            for (int i = 0; i < 4; ++i) { s += q[8 * jj + 2 * i] * bflo(w[i]); s += q[8 * jj + 2 * i + 1] * bfhi(w[i]); } }
                        const float mn = fmaxf(mx, s), corr = __builtin_amdgcn_exp2f(mx - mn), pe = __builtin_amdgcn_exp2f(s - mn);
                        l = l * corr + pe; mx = mn;
#pragma unroll
                        for (int jj = 0; jj < 8; ++jj) { const v4u w = vp[jj];
#pragma unroll
                            for (int i = 0; i < 4; ++i) { o[8 * jj + 2 * i] = o[8 * jj + 2 * i] * corr + pe * bflo(w[i]); o[8 * jj + 2 * i + 1] = o[8 * jj + 2 * i + 1] * corr + pe * bfhi(w[i]); } }
                    }
                }
            }
            const float rl = 1.0f / l;
            GAS v4u* op = (GAS v4u*)(CAT + ((size_t)b * SEQ + t) * D + 512 + h * 64);
#pragma unroll
            for (int j = 0; j < 8; ++j) { v4u w; w.x = pk2(o[8 * j] * rl, o[8 * j + 1] * rl); w.y = pk2(o[8 * j + 2] * rl, o[8 * j + 3] * rl); w.z = pk2(o[8 * j + 4] * rl, o[8 * j + 5] * rl); w.w = pk2(o[8 * j + 6] * rl, o[8 * j + 7] * rl); op[j] = w; }
        }
    }
}
__device__ __forceinline__ void even_post(const Frame& F0) {
    const Frame F = relaunder(F0);
    unsigned char* ws = WSP();
    const int gw = F.bid * NWAVES + F.wave, NGW = F.G * NWAVES;
    const bf16* P = (const bf16*)(ws + WS_ACT); const float* oraw = (const float*)(ws + WS_XB); bf16* CAT = (bf16*)(ws + WS_CAT);
    for (int it = gw; it < M * 4; it += NGW) {
        const int m = it >> 2, h = it & 3;
        const float* op = oraw + (size_t)m * 512 + h * 128 + 2 * F.lane; const float o0 = op[0], o1 = op[1];
        const float mu = wave_sum(o0 + o1) * (1.0f / 128.0f); const float d0 = o0 - mu, d1 = o1 - mu;
        const float var = wave_sum(d0 * d0 + d1 * d1) * (1.0f / 128.0f); const float rstd = 1.0f / sqrtf(var + EPS);
        const unsigned gw2 = *(const unsigned*)(P + (size_t)m * EVEN_IN + E_RG + h * 128 + 2 * F.lane); const float g0 = bflo(gw2), g1 = bfhi(gw2);
        const float y0 = d0 * rstd * (g0 / (1.0f + expf(-g0))), y1 = d1 * rstd * (g1 / (1.0f + expf(-g1)));
        *(unsigned*)(CAT + (size_t)m * D + h * 128 + 2 * F.lane) = pk2(y0, y1);
    }
}
__device__ __forceinline__ void gla_prep(const Frame& F0, int li) {
    const Frame F = relaunder(F0);
    unsigned char* ws = WSP();
    const int gt = F.bid * NTHREADS + F.tid, NGT = F.G * NTHREADS;
    const bf16* P = (const bf16*)(ws + WS_ACT); float* A = (float*)(ws + WS_CAT);
    const float* w2 = AP(I_GLA_A2) + (size_t)li * 16 * 512; const float* ba = AP(I_GLA_BA) + (size_t)li * 512;
    for (int e = gt; e < M * 512; e += NGT) {
        const int m = e >> 9, c = e & 511; const bf16* al = P + (size_t)m * GLA_INP + G_A;
        float z = ba[c];
#pragma unroll
        for (int j = 0; j < 16; ++j) z += bf2f(al[j]) * w2[j * 512 + c];
        const float ls = fminf(z, 0.f) - log1pf(expf(-fabsf(z)));
        A[e] = expf(ls * (1.0f / 16.0f));
    }
}
__device__ __forceinline__ void gla_core(const Frame& F0) {
    const Frame F = relaunder(F0);
    unsigned char* ws = WSP();
    const bf16* P = (const bf16*)(ws + WS_ACT); const float* A = (const float*)(ws + WS_CAT); bf16* oraw = (bf16*)(ws + WS_XB);
    const int b = F.bid >> 5, h = (F.bid >> 3) & 3, eg = F.bid & 7, e = eg * 32 + (F.tid >> 4), dq = F.tid & 15;
    const bf16* base = P + (size_t)b * SEQ * GLA_INP; const float* abase = A + (size_t)b * SEQ * 512 + h * 128 + dq * 8;
    float S[8];
#pragma unroll
    for (int i = 0; i < 8; ++i) S[i] = 0.f;
    v4u qn = *(const GAS v4u*)(base + G_Q + h * 128 + dq * 8), kn = *(const GAS v4u*)(base + G_K + h * 128 + dq * 8); bf16 vn = base[G_V + h * 256 + e];
    f32x4 a0n = *(const GAS f32x4*)(abase), a1n = *(const GAS f32x4*)(abase + 4);
    for (int t = 0; t < SEQ; ++t) {
        const v4u q = qn, k = kn; const float v = bf2f(vn); const f32x4 a0 = a0n, a1 = a1n;
        if (t + 1 < SEQ) { const bf16* nb = base + (size_t)(t + 1) * GLA_INP; qn = *(const GAS v4u*)(nb + G_Q + h * 128 + dq * 8); kn = *(const GAS v4u*)(nb + G_K + h * 128 + dq * 8); vn = nb[G_V + h * 256 + e];
            a0n = *(const GAS f32x4*)(abase + (size_t)(t + 1) * 512); a1n = *(const GAS f32x4*)(abase + (size_t)(t + 1) * 512 + 4); }
        float o = 0.f;
#pragma unroll
        for (int i = 0; i < 4; ++i) { const unsigned qw = q[i], kw = k[i]; const float al = (i < 2) ? a0[2 * i] : a1[2 * i - 4], ah = (i < 2) ? a0[2 * i + 1] : a1[2 * i - 3];
            S[2 * i] = al * S[2 * i] + bflo(kw) * v; S[2 * i + 1] = ah * S[2 * i + 1] + bfhi(kw) * v;
            o += bflo(qw) * S[2 * i]; o += bfhi(qw) * S[2 * i + 1]; }
        o += __shfl_xor(o, 1); o += __shfl_xor(o, 2); o += __shfl_xor(o, 4); o += __shfl_xor(o, 8);
        if (dq == 0) oraw[((size_t)b * SEQ + t) * 1024 + h * 256 + e] = f2bf_rne(o * 0.08838834764831845f);
    }
}
__device__ __forceinline__ void gla_post(const Frame& F0) {
    const Frame F = relaunder(F0);
    unsigned char* ws = WSP();
    const int gw = F.bid * NWAVES + F.wave, NGW = F.G * NWAVES;
    const bf16* P = (const bf16*)(ws + WS_ACT); const bf16* oraw = (const bf16*)(ws + WS_XB); bf16* CAT = (bf16*)(ws + WS_CAT);
    for (int it = gw; it < M * 4; it += NGW) {
        const int m = it >> 2, h = it & 3;
        const unsigned long long ow = *(const unsigned long long*)(oraw + (size_t)m * 1024 + h * 256 + 4 * F.lane);
        const float o0 = bflo((unsigned)ow), o1 = bfhi((unsigned)ow), o2 = bflo((unsigned)(ow >> 32)), o3 = bfhi((unsigned)(ow >> 32));
        const float mu = wave_sum((o0 + o1) + (o2 + o3)) * (1.0f / 256.0f); const float d0 = o0 - mu, d1 = o1 - mu, d2 = o2 - mu, d3 = o3 - mu;
        const float var = wave_sum((d0 * d0 + d1 * d1) + (d2 * d2 + d3 * d3)) * (1.0f / 256.0f); const float rstd = 1.0f / sqrtf(var + EPS);
        const unsigned long long gw2 = *(const unsigned long long*)(P + (size_t)m * GLA_INP + G_R + h * 256 + 4 * F.lane);
        const float g0 = bflo((unsigned)gw2), g1 = bfhi((unsigned)gw2), g2 = bflo((unsigned)(gw2 >> 32)), g3 = bfhi((unsigned)(gw2 >> 32));
        const float y0 = d0 * rstd * (g0 / (1.0f + expf(-g0))), y1 = d1 * rstd * (g1 / (1.0f + expf(-g1))), y2 = d2 * rstd * (g2 / (1.0f + expf(-g2))), y3 = d3 * rstd * (g3 / (1.0f + expf(-g3)));
        *(unsigned long long*)(CAT + (size_t)m * D + h * 256 + 4 * F.lane) = (unsigned long long)pk2(y0, y1) | ((unsigned long long)pk2(y2, y3) << 32);
    }
}
__device__ __forceinline__ void final_norm(const Frame& F0) {
    const Frame F = relaunder(F0);
    const int gw = F.bid * NWAVES + F.wave, NGW = F.G * NWAVES;
    for (int m = gw; m < M; m += NGW) {
        GAS f32x4* xr = (GAS f32x4*)(OUTP() + (size_t)m * D) + F.lane; const GAS f32x4* gr = (const GAS f32x4*)AP(I_FINAL) + F.lane;
        f32x4 v[4]; float s = 0.f;
#pragma unroll
        for (int j = 0; j < 4; ++j) { v[j] = xr[64 * j]; s += (v[j].x * v[j].x + v[j].y * v[j].y) + (v[j].z * v[j].z + v[j].w * v[j].w); }
        const float rstd = 1.0f / sqrtf(wave_sum(s) * (1.0f / D) + EPS);
#pragma unroll
        for (int j = 0; j < 4; ++j) xr[64 * j] = v[j] * rstd * gr[64 * j];
    }
}

__global__ void __launch_bounds__(NTHREADS, 2) fwd_kernel(Args args) {
    extern __shared__ __attribute__((aligned(16))) unsigned char lds[];
    Frame F;
    F.lds = (LAS unsigned char*)lds;
    F.tid = threadIdx.x; F.lane = F.tid & 63; F.wave = __builtin_amdgcn_readfirstlane(F.tid >> 6); F.G = gridDim.x; F.bid = blockIdx.x;
    for (int u = F.tid; u < (LDS_BYTES - LDSCTL_OFF) / 4; u += NTHREADS) ((LAS unsigned*)(F.lds + LDSCTL_OFF))[u] = 0u;
    __syncthreads();
    if (F.tid < N_PTRS) { const unsigned long long v = (F.tid < 17) ? (unsigned long long)args.in[F.tid] : (F.tid == 17 ? (unsigned long long)args.out : (unsigned long long)args.ws);
        ((LAS unsigned*)(F.lds + PTR_OFF))[2 * F.tid] = (unsigned)v; ((LAS unsigned*)(F.lds + PTR_OFF))[2 * F.tid + 1] = (unsigned)(v >> 32); }
    __syncthreads();
    XcdBarrier bar = xcd_barrier_post((unsigned*)(WSP() + WS_CTL) + CW_BAR, (volatile LAS unsigned*)(F.lds + MISC_OFF) + 8);
#define GRID_BAR() xcd_barrier(bar)
#define XB ((bf16*)(WSP() + WS_XB))
#define ACT ((bf16*)(WSP() + WS_ACT))
#define CAT ((bf16*)(WSP() + WS_CAT))
#define SSP ((float*)(WSP() + WS_SSP))
#define WPTR(off) ((const bf16*)(WSP() + (off)))

#ifdef TEST_MIN
    {
        pg8::Gemm g{XB, WPTR(W_GU0), M, 2 * FF, D}; pg8::StaticOrder S; S.init(M, 2 * FF, F.G, F.bid);
        pg8::EpiSwiGLU E{ACT, FF, SSP};
        pg8::gemm_phase<pg8::EpiSwiGLU, pg8::StaticOrder, true, true>(F.lds + RING_OFF, g, S, E);
        GRID_BAR();
        return;
    }
#endif
    prologue_rows(F);
    convert_weights(F, 0);
    GRID_BAR();
    for (int s = 0; s < 8; ++s) {
        const int l = s >> 1; const bool post = (s & 1) != 0;
        {
            pg8::Gemm g{XB, WPTR(post ? W_GU1 : W_GU0), M, 2 * FF, D}; pg8::StaticOrder S; S.init(M, 2 * FF, F.G, F.bid);
            pg8::EpiSwiGLU E{ACT, FF, SSP};
#ifndef NO_F1
            pg8::gemm_phase<pg8::EpiSwiGLU, pg8::StaticOrder, true, true>(F.lds + RING_OFF, g, S, E);
#endif
        }
        GRID_BAR();
        {
            pg8::Gemm g{ACT, WPTR(post ? W_D1 : W_D0), M, D, FF}; pg8::StaticOrder S; S.init(M, D, F.G, F.bid);
            pg8::EpiResid E{s == 0 ? AP(I_X) : (const float*)OUTP(), OUTP(), XB, SSP, 0.5f};
#ifndef NO_F2
            pg8::gemm_phase<pg8::EpiResid, pg8::StaticOrder, true, true>(F.lds + RING_OFF, g, S, E);
#endif
        }
        GRID_BAR();
        if (!post) {
            const bool odd = (l & 1) != 0; const int nin = odd ? GLA_INP : EVEN_IN;
            {
                pg8::Gemm g{XB, WPTR(W_IN), M, nin, D}; pg8::StaticOrder S; S.init(M, nin, F.G, F.bid);
                pg8::EpiScaleBf16 E{ACT, nin, SSP};
#ifndef NO_M1
                pg8::gemm_phase<pg8::EpiScaleBf16, pg8::StaticOrder, true, true>(F.lds + RING_OFF, g, S, E);
#endif
            }
            GRID_BAR();
#ifndef NO_EVEN
            if (!odd) { even_prep(F); GRID_BAR(); even_core(F); GRID_BAR(); even_post(F); }
#endif
#ifndef NO_GLA
            if (odd) { gla_prep(F, l >> 1); GRID_BAR(); gla_core(F); GRID_BAR(); gla_post(F); }
#endif
            GRID_BAR();
            {
                pg8::Gemm g{CAT, WPTR(W_OUT), M, D, D}; pg8::StaticOrder S; S.init(M, D, F.G, F.bid);
                pg8::EpiResid E{(const float*)OUTP(), OUTP(), XB, SSP, 1.0f};
#ifndef NO_M5
                pg8::gemm_phase<pg8::EpiResid, pg8::StaticOrder, true, true>(F.lds + RING_OFF, g, S, E);
#endif
            }
            GRID_BAR();
        } else if (l + 1 < DEPTH) {
            convert_weights(F, l + 1);
            GRID_BAR();
        }
    }
    final_norm(F);
}

extern "C" void kernel_launch(void* const* d_in, const int* in_sizes, int n_in, void* d_out, int out_size, void* d_ws, size_t ws_size, hipStream_t stream) {
    static int grid = 0;
    if (grid == 0) {
        if (n_in != 17 || in_sizes[0] != M * D || out_size != M * D || ws_size < WS_END) { fprintf(stderr, "kernel_launch: unexpected shapes (n_in %d, in0 %d, out %d, ws %zu)\n", n_in, n_in > 0 ? in_sizes[0] : -1, out_size, ws_size); grid = -1; return; }
        int dev = 0, cus = 0, per_cu = 0;
        if (hipGetDevice(&dev) != hipSuccess || hipDeviceGetAttribute(&cus, hipDeviceAttributeMultiprocessorCount, dev) != hipSuccess) { grid = -1; return; }
        if (hipFuncSetAttribute((const void*)fwd_kernel, hipFuncAttributeMaxDynamicSharedMemorySize, LDS_BYTES) != hipSuccess) { fprintf(stderr, "kernel_launch: hipFuncSetAttribute failed\n"); grid = -1; return; }
        if (hipOccupancyMaxActiveBlocksPerMultiprocessor(&per_cu, (const void*)fwd_kernel, NTHREADS, LDS_BYTES) != hipSuccess || per_cu < 1) { fprintf(stderr, "kernel_launch: occupancy query reports %d\n", per_cu); }
        (void)hipGetLastError();
        grid = cus;
        if (grid != 256) fprintf(stderr, "kernel_launch: %d CUs (expected 256)\n", grid);
    }
    if (grid < 0) return;
    if (hipMemsetAsync((char*)d_ws + WS_CTL, 0, CTL_ZERO_BYTES, stream) != hipSuccess) return;
    Args a{};
    for (int i = 0; i < 17; ++i) a.in[i] = (const float*)d_in[i];
    a.out = (float*)d_out; a.ws = (unsigned char*)d_ws;
    hipLaunchKernelGGL(fwd_kernel, dim3(grid), dim3(NTHREADS), LDS_BYTES, stream, a);
}
```

```cpp
#include <hip/hip_runtime.h>
#include <cstdio>
#include <cstdint>
#include <cmath>
namespace pg8 {
#define PG8_LAS __attribute__((address_space(3)))
typedef unsigned short bf16_t;
typedef short bf16x8 __attribute__((ext_vector_type(8)));
typedef float f32x4 __attribute__((ext_vector_type(4)));
typedef unsigned u32x4 __attribute__((ext_vector_type(4)));
constexpr int BM = 256, BK = 64, HALF = 128, HTB = HALF * BK * 2  , STAGE_BYTES = 8 * HTB, NXCD = 8, WGM = 8;

__host__ __device__ __forceinline__ int lds_byte(int r, int c) { const int st = (r >> 4) * 2 + (c >> 5), rr = r & 15, cc = c & 31, ob = rr * 64 + cc * 2; return st * 1024 + (ob ^ (((ob >> 9) & 1) << 5)); }
__host__ __device__ __forceinline__ void stage_rc(int b, int& R, int& C) { const int st = b / 1024, sb = b % 1024, swz = sb ^ (((sb >> 9) & 1) << 5); R = (st >> 1) * 16 + swz / 64; C = (st & 1) * 32 + (swz % 64) / 2; }
__host__ __device__ __forceinline__ int perm32(int rho) { const int n = rho >> 4, i = rho & 15; return 8 * (i >> 2) + 4 * n + (i & 3); }

struct Unit { int pm, pn; };
struct Gemm { const bf16_t* A; const bf16_t* Bt; int M, N, K; };

struct StaticOrder {
    int nM, nN, nwg, G, c;
    __host__ __device__ void init(int M, int N, int G_, int c_) { nM = M / BM; nN = N / BM; nwg = nM * nN; G = G_; c = c_; }
    __host__ __device__ bool next(int i, Unit& u) const {
        const long L = (long)i * G + c; if (L >= nwg) return false;
        int wgid = (int)L; { const int q = nwg / NXCD, r = nwg % NXCD, xcd = wgid % NXCD, off = wgid / NXCD; wgid = (xcd < r ? xcd * (q + 1) : r * (q + 1) + (xcd - r) * q) + off; }
        const int nig = WGM * nN, gid = wgid / nig, fm = gid * WGM, gsz = (nM - fm) < WGM ? (nM - fm) : WGM;
        u.pm = fm + ((wgid % nig) % gsz); u.pn = (wgid % nig) / gsz; return true;
    }
    __device__ __forceinline__ void a_ready(const Unit&) const {}
    __device__ __forceinline__ void done(const Unit&) const {}
};

__device__ __forceinline__ unsigned cvt_pk_bf16(float lo, float hi) { unsigned r; asm volatile("v_cvt_pk_bf16_f32 %0, %1, %2" : "=v"(r) : "v"(lo), "v"(hi)); return r; }
constexpr int MROWS = 32768;
constexpr float RMS_EPS = 1e-6f;
__device__ __forceinline__ void row_rstd(float (&rs)[2][4], const float* ssp, const Unit& u, int wr, int fr, int fq) {
#pragma unroll
    for (int ai = 0; ai < 2; ++ai)
#pragma unroll
        for (int m = 0; m < 4; ++m) {
            const int row = u.pm * BM + ai * HALF + wr * 64 + m * 16 + fr;
            const f32x4 p = *(const f32x4*)(ssp + (size_t)row * 16 + 4 * fq);
            float s = (p[0] + p[1]) + (p[2] + p[3]);
            s += __shfl_xor(s, 16); s += __shfl_xor(s, 32);
            rs[ai][m] = 1.0f / sqrtf(s * (1.0f / 1024.0f) + RMS_EPS);
        }
}
__device__ __forceinline__ float silu_f(float g) { return g * __builtin_amdgcn_rcpf(1.0f + __builtin_amdgcn_exp2f(-1.4426950408889634f * g)); }

struct EpiSwiGLU {
    static constexpr bool PERM = true, AFTER_DRAIN = false;
    bf16_t* H; int ldh; const float* ssp;
    __device__ __forceinline__ void operator()(const f32x4 (&acc)[2][2][4][2], const Unit& u, int wr, int wc, int fr, int fq) const {
        float rs[2][4]; row_rstd(rs, ssp, u, wr, fr, fq);
        const int col0 = u.pn * HALF + wc * 32 + 8 * fq;
#pragma unroll
        for (int ai = 0; ai < 2; ++ai)
#pragma unroll
            for (int m = 0; m < 4; ++m) {
                const int row = u.pm * BM + ai * HALF + wr * 64 + m * 16 + fr; const float r = rs[ai][m];
                float h[8];
#pragma unroll
                for (int n = 0; n < 2; ++n)
#pragma unroll
                    for (int i = 0; i < 4; ++i) { const float g = acc[ai][0][m][n][i] * r, up = acc[ai][1][m][n][i] * r; h[4 * n + i] = silu_f(g) * up; }
                u32x4 w; w.x = cvt_pk_bf16(h[0], h[1]); w.y = cvt_pk_bf16(h[2], h[3]); w.z = cvt_pk_bf16(h[4], h[5]); w.w = cvt_pk_bf16(h[6], h[7]);
                *(u32x4*)(H + (size_t)row * ldh + col0) = w;
                asm volatile("" ::: "memory");
            }
    }
};
struct EpiScaleBf16 {
    static constexpr bool PERM = true, AFTER_DRAIN = false;
    bf16_t* O; int ldc; const float* ssp;
    __device__ __forceinline__ void operator()(const f32x4 (&acc)[2][2][4][2], const Unit& u, int wr, int wc, int fr, int fq) const {
        float rs[2][4]; row_rstd(rs, ssp, u, wr, fr, fq);
        const int col0 = u.pn * BM + wc * 32 + 8 * fq;
#pragma unroll
        for (int ai = 0; ai < 2; ++ai)
#pragma unroll
            for (int m = 0; m < 4; ++m) {
                const int row = u.pm * BM + ai * HALF + wr * 64 + m * 16 + fr; const float r = rs[ai][m];
#pragma unroll
                for (int bj = 0; bj < 2; ++bj) { const f32x4 v0 = acc[ai][bj][m][0] * r, v1 = acc[ai][bj][m][1] * r;
                    u32x4 w; w.x = cvt_pk_bf16(v0[0], v0[1]); w.y = cvt_pk_bf16(v0[2], v0[3]); w.z = cvt_pk_bf16(v1[0], v1[1]); w.w = cvt_pk_bf16(v1[2], v1[3]);
                    *(u32x4*)(O + (size_t)row * ldc + col0 + bj * HALF) = w; }
                asm volatile("" ::: "memory");
            }
    }
};
struct EpiResid {
    static constexpr bool PERM = true, AFTER_DRAIN = false;
    const float* xold; float* xnew; bf16_t* xb; float* ssp; float scale;
    __device__ __forceinline__ void operator()(const f32x4 (&acc)[2][2][4][2], const Unit& u, int wr, int wc, int fr, int fq) const {
        const int col0 = u.pn * BM + wc * 32 + 8 * fq;
#pragma unroll
        for (int ai = 0; ai < 2; ++ai)
#pragma unroll
            for (int m = 0; m < 4; ++m) {
                const int row = u.pm * BM + ai * HALF + wr * 64 + m * 16 + fr; float ss = 0.f;
#pragma unroll
                for (int bj = 0; bj < 2; ++bj) { const size_t off = (size_t)row * 1024 + col0 + bj * HALF;
                    const f32x4 o0 = *(const f32x4*)(xold + off), o1 = *(const f32x4*)(xold + off + 4);
                    const f32x4 v0 = o0 + acc[ai][bj][m][0] * scale, v1 = o1 + acc[ai][bj][m][1] * scale;
                    *(f32x4*)(xnew + off) = v0; *(f32x4*)(xnew + off + 4) = v1;
                    u32x4 w; w.x = cvt_pk_bf16(v0[0], v0[1]); w.y = cvt_pk_bf16(v0[2], v0[3]); w.z = cvt_pk_bf16(v1[0], v1[1]); w.w = cvt_pk_bf16(v1[2], v1[3]);
                    *(u32x4*)(xb + off) = w;
                    ss += (v0[0] * v0[0] + v0[1] * v0[1]) + (v0[2] * v0[2] + v0[3] * v0[3]) + (v1[0] * v1[0] + v1[1] * v1[1]) + (v1[2] * v1[2] + v1[3] * v1[3]); }
                ss += __shfl_xor(ss, 16); ss += __shfl_xor(ss, 32);
                if (fq == 0) ssp[(size_t)row * 16 + u.pn * 4 + wc] = ss;
                asm volatile("" ::: "memory");
            }
    }
};

template <class Epi, class Sched, bool ALIGN_EPI = false, bool SP2 = false>
__device__ __forceinline__ void gemm_phase(PG8_LAS unsigned char* lds, const Gemm g, const Sched& S, const Epi& E) {
    int tid_ = threadIdx.x; asm volatile("" : "+v"(tid_));
    const int tid = tid_, wid = __builtin_amdgcn_readfirstlane(tid >> 6), lane = tid & 63, wr = wid >> 2, wc = wid & 3, fr = lane & 15, fq = lane >> 4;
    const int K = g.K, nt = K / BK;
    unsigned voffA[2], voffB[2];
#pragma unroll
    for (int i = 0; i < 2; ++i) { int R, C; stage_rc(tid * 16 + i * 8192, R, C); const int Rb = Epi::PERM ? ((R & ~31) + perm32(R & 31)) : R;
        voffA[i] = (unsigned)(R * K + C) * 2u; voffB[i] = (unsigned)(Rb * K + C) * 2u; }
    const size_t kstep = (size_t)(BK * 2);
    const size_t hstep = (size_t)HALF * K * 2;
    const size_t tstep = 2 * hstep;
    const unsigned ldsw = (unsigned)wid * 1024u;
    const int aoff = lds_byte(wr * 64 + fr, fq * 8), boff = lds_byte(wc * 32 + fr, fq * 8);
#define PG8_SA(b, h) (((b) * 2 + (h)) * HTB)
#define PG8_SB(b, h) ((4 + (b) * 2 + (h)) * HTB)
#define PG8_STAGE(bufoff, gbase, voff) do { _Pragma("unroll") for (int _i = 0; _i < 2; ++_i) \
        __builtin_amdgcn_global_load_lds((const unsigned*)((const char*)(gbase) + (voff)[_i]), (PG8_LAS unsigned*)(lds + (bufoff) + ldsw + _i * 8192), 16, 0, 0); } while (0)
#define PG8_LDA(dst, b, h) do { _Pragma("unroll") for (int m = 0; m < 4; ++m) _Pragma("unroll") for (int k = 0; k < 2; ++k) dst[m][k] = *(const PG8_LAS bf16x8*)(lds + PG8_SA(b, h) + aoff + m * 2048 + k * 1024); } while (0)
#define PG8_LDB(dst, b, h) do { _Pragma("unroll") for (int n = 0; n < 2; ++n) _Pragma("unroll") for (int k = 0; k < 2; ++k) dst[n][k] = *(const PG8_LAS bf16x8*)(lds + PG8_SB(b, h) + boff + n * 2048 + k * 1024); } while (0)
#define PG8_MMA(ai, bj, At, Bt) do { __builtin_amdgcn_s_setprio(1); _Pragma("unroll") for (int m = 0; m < 4; ++m) _Pragma("unroll") for (int n = 0; n < 2; ++n) _Pragma("unroll") for (int k = 0; k < 2; ++k) \
        acc[ai][bj][m][n] = __builtin_amdgcn_mfma_f32_16x16x32_bf16(Bt[n][k], At[m][k], acc[ai][bj][m][n], 0, 0, 0); __builtin_amdgcn_s_setprio(0); } while (0)
#define PG8_WAIT_V(n) asm volatile("s_waitcnt vmcnt(" #n ")" ::: "memory")
#define PG8_WAIT_L(n) asm volatile("s_waitcnt lgkmcnt(" #n ")" ::: "memory")
#define PG8_BAR __builtin_amdgcn_s_barrier()
#define PG8_SCHED __builtin_amdgcn_sched_barrier(0)
    Unit cur, nxt; int ui = 0;
    if (!S.next(0, cur)) return;
    f32x4 acc[2][2][4][2];
#pragma unroll
    for (int a = 0; a < 2; ++a)
#pragma unroll
        for (int b = 0; b < 2; ++b)
#pragma unroll
            for (int m = 0; m < 4; ++m)
#pragma unroll
                for (int n = 0; n < 2; ++n) acc[a][b][m][n] = (f32x4){0.f, 0.f, 0.f, 0.f};
    bf16x8 At[4][2], B0[2][2], B1[2][2];
    const char* cA = (const char*)g.A + (size_t)cur.pm * tstep; const char* cB = (const char*)g.Bt + (size_t)cur.pn * tstep;
    S.a_ready(cur);
    if constexpr (SP2) {
        PG8_STAGE(PG8_SB(0, 0), cB, voffB); PG8_STAGE(PG8_SB(0, 1), cB + hstep, voffB); PG8_STAGE(PG8_SA(0, 0), cA, voffA); PG8_STAGE(PG8_SA(0, 1), cA + hstep, voffA);
        if (wr == 1) PG8_BAR;
        PG8_WAIT_V(2); PG8_BAR;
        PG8_STAGE(PG8_SB(1, 0), cB + kstep, voffB); PG8_STAGE(PG8_SA(1, 0), cA + kstep, voffA); PG8_STAGE(PG8_SB(1, 1), cB + hstep + kstep, voffB);
        PG8_WAIT_V(6); PG8_BAR;
    } else {
        PG8_STAGE(PG8_SB(0, 0), cB, voffB); PG8_STAGE(PG8_SA(0, 0), cA, voffA); PG8_STAGE(PG8_SB(0, 1), cB + hstep, voffB); PG8_STAGE(PG8_SA(0, 1), cA + hstep, voffA);
        if (wr == 1) PG8_BAR;
        PG8_WAIT_V(4); PG8_BAR;
        PG8_STAGE(PG8_SB(1, 0), cB + kstep, voffB); PG8_STAGE(PG8_SA(1, 0), cA + kstep, voffA); PG8_STAGE(PG8_SB(1, 1), cB + hstep + kstep, voffB);
        PG8_WAIT_V(6); PG8_BAR;
    }
    for (;;) {
        const bool has_next = S.next(ui + 1, nxt);
        const char* nA = has_next ? (const char*)g.A + (size_t)nxt.pm * tstep : cA; const char* nB = has_next ? (const char*)g.Bt + (size_t)nxt.pn * tstep : cB;
        for (int t = 0; t < nt; t += 2) {
            const bool last = (t == nt - 2);
            const char* a1 = cA + (size_t)(t + 1) * kstep;
            const char* a2 = last ? nA : cA + (size_t)(t + 2) * kstep; const char* b2 = last ? nB : cB + (size_t)(t + 2) * kstep;
            const char* a3 = a2 + kstep; const char* b3 = b2 + kstep;
            if (last && has_next) S.a_ready(nxt);
            if constexpr (SP2) {
            PG8_LDB(B0, 0, 0); PG8_LDB(B1, 0, 1); PG8_SCHED; PG8_LDA(At, 0, 0); PG8_STAGE(PG8_SA(1, 1), a1 + hstep, voffA);
            PG8_WAIT_V(8); PG8_WAIT_L(0); PG8_BAR; PG8_MMA(0, 0, At, B0); PG8_MMA(0, 1, At, B1); PG8_BAR; PG8_SCHED;
            PG8_LDA(At, 0, 1); PG8_STAGE(PG8_SB(0, 0), b2, voffB); PG8_STAGE(PG8_SB(0, 1), b2 + hstep, voffB); PG8_STAGE(PG8_SA(0, 0), a2, voffA);
            PG8_WAIT_V(8); PG8_WAIT_L(0); PG8_BAR; PG8_MMA(1, 0, At, B0); PG8_MMA(1, 1, At, B1); PG8_BAR; PG8_SCHED;
            PG8_LDB(B0, 1, 0); PG8_LDB(B1, 1, 1); PG8_SCHED; PG8_LDA(At, 1, 0); PG8_STAGE(PG8_SA(0, 1), a2 + hstep, voffA);
            PG8_WAIT_V(8); PG8_WAIT_L(0); PG8_BAR; PG8_MMA(0, 0, At, B0); PG8_MMA(0, 1, At, B1); PG8_BAR; PG8_SCHED;
            PG8_LDA(At, 1, 1); PG8_STAGE(PG8_SB(1, 0), b3, voffB); PG8_STAGE(PG8_SB(1, 1), b3 + hstep, voffB); PG8_STAGE(PG8_SA(1, 0), a3, voffA);
            PG8_WAIT_V(8); PG8_WAIT_L(0); PG8_BAR; PG8_MMA(1, 0, At, B0); PG8_MMA(1, 1, At, B1); PG8_BAR; PG8_SCHED;
            } else {
            PG8_LDB(B0, 0, 0); PG8_SCHED; PG8_LDA(At, 0, 0); PG8_STAGE(PG8_SA(1, 1), a1 + hstep, voffA);
            PG8_WAIT_L(8); PG8_BAR; PG8_WAIT_L(0); PG8_MMA(0, 0, At, B0); PG8_BAR; PG8_SCHED;
            PG8_LDB(B1, 0, 1); PG8_STAGE(PG8_SB(0, 0), b2, voffB);
            PG8_BAR; PG8_WAIT_L(0); PG8_MMA(0, 1, At, B1); PG8_BAR;
            PG8_LDA(At, 0, 1); PG8_STAGE(PG8_SA(0, 0), a2, voffA);
            PG8_BAR; PG8_WAIT_L(0); PG8_MMA(1, 0, At, B0); PG8_BAR; PG8_SCHED;
            PG8_STAGE(PG8_SB(0, 1), b2 + hstep, voffB);
            PG8_WAIT_V(6); PG8_BAR; PG8_MMA(1, 1, At, B1); PG8_BAR;
            PG8_LDB(B0, 1, 0); PG8_SCHED; PG8_LDA(At, 1, 0); PG8_STAGE(PG8_SA(0, 1), a2 + hstep, voffA);
            PG8_WAIT_L(8); PG8_BAR; PG8_WAIT_L(0); PG8_MMA(0, 0, At, B0); PG8_BAR; PG8_SCHED;
            PG8_LDB(B1, 1, 1); PG8_STAGE(PG8_SB(1, 0), b3, voffB);
            PG8_BAR; PG8_WAIT_L(0); PG8_MMA(0, 1, At, B1); PG8_BAR;
            PG8_LDA(At, 1, 1); PG8_STAGE(PG8_SA(1, 0), a3, voffA);
            PG8_BAR; PG8_WAIT_L(0); PG8_MMA(1, 0, At, B0); PG8_BAR; PG8_SCHED;
            PG8_STAGE(PG8_SB(1, 1), b3 + hstep, voffB);
            PG8_WAIT_V(6); PG8_BAR; PG8_MMA(1, 1, At, B1); PG8_BAR;
            }
        }
        if constexpr (ALIGN_EPI) { if (wr == 0) PG8_BAR; }
        if constexpr (!Epi::AFTER_DRAIN) { E(acc, cur, wr, wc, fr, fq); S.done(cur); }
        if (!has_next) break;
#pragma unroll
        for (int a = 0; a < 2; ++a)
#pragma unroll
            for (int b = 0; b < 2; ++b)
#pragma unroll
                for (int m = 0; m < 4; ++m)
#pragma unroll
                    for (int n = 0; n < 2; ++n) acc[a][b][m][n] = (f32x4){0.f, 0.f, 0.f, 0.f};
        cur = nxt; cA = nA; cB = nB; ++ui;
        if constexpr (ALIGN_EPI) { if (wr == 1) PG8_BAR; }
    }
    PG8_WAIT_V(0);
    if constexpr (!ALIGN_EPI) { if (wr == 0) PG8_BAR; }
    PG8_BAR;
    if constexpr (Epi::AFTER_DRAIN) { E.fused(acc, cur, wr, wc, fr, fq, lds, wid, lane); S.done(cur); }
#undef PG8_SA
#undef PG8_SB
#undef PG8_STAGE
#undef PG8_LDA
#undef PG8_LDB
#undef PG8_MMA
#undef PG8_WAIT_V
#undef PG8_WAIT_L
#undef PG8_BAR
#undef PG8_SCHED
}
}

constexpr int NWAVES = 8, NTHREADS = NWAVES * 64;
constexpr int BATCH = 8, SEQ = 4096, D = 1024, M = BATCH * SEQ, FF = 2816, DEPTH = 4;
constexpr int EVEN_IN = 3584, GLA_IN = 3088, GLA_INP = 3328;
static_assert(M == pg8::MROWS, "row count");
constexpr int E_RQ = 0, E_RK = 512, E_RV = 1024, E_RG = 1536, E_DQ = 2048, E_DK = 2560, E_DV = 3072;
constexpr int G_Q = 0, G_K = 512, G_V = 1024, G_R = 2048, G_A = 3072;
constexpr float EPS = 1e-6f;

constexpr size_t MiB = 1u << 20;
constexpr size_t WS_CTL = 0, CTL_ZERO_BYTES = 1 * MiB;
constexpr size_t WS_SSP = 1 * MiB;
constexpr size_t WS_TAB = 3 * MiB;
constexpr size_t TAB_RC = WS_TAB, TAB_RS = WS_TAB + 1 * MiB, TAB_DC = WS_TAB + 2 * MiB, TAB_DS = WS_TAB + 2 * MiB + 128 * 1024;
constexpr size_t WS_W = 8 * MiB;
constexpr size_t W_GU0 = WS_W, W_D0 = W_GU0 + (size_t)2 * FF * D * 2, W_GU1 = W_D0 + (size_t)D * FF * 2, W_D1 = W_GU1 + (size_t)2 * FF * D * 2,
                 W_IN = W_D1 + (size_t)D * FF * 2, W_OUT = W_IN + (size_t)EVEN_IN * D * 2, W_END = W_OUT + (size_t)D * D * 2;
constexpr size_t WS_XB = 56 * MiB;
constexpr size_t WS_ACT = 120 * MiB;
constexpr size_t WS_CAT = 344 * MiB;
constexpr size_t WS_END = 408 * MiB;
static_assert(W_END <= WS_XB && WS_XB + (size_t)M * D * 2 <= WS_ACT && WS_ACT + (size_t)M * EVEN_IN * 2 <= WS_CAT && WS_CAT + (size_t)M * D * 2 <= WS_END, "d_ws map");
constexpr int CW_BAR = 4096;

constexpr int RING_OFF = 0, RING_BYTES = 131072;
constexpr int LDSCTL_OFF = 161792, MISC_OFF = LDSCTL_OFF + 320, PTR_OFF = LDSCTL_OFF + 1024;
constexpr int LDS_BYTES = 163840;
static_assert(PTR_OFF + 19 * 8 <= LDS_BYTES && RING_BYTES <= LDSCTL_OFF, "LDS map");

#define GAS __attribute__((address_space(1)))
#define LAS __attribute__((address_space(3)))
typedef unsigned short bf16;
typedef unsigned v4u __attribute__((ext_vector_type(4)));
typedef float f32x4 __attribute__((ext_vector_type(4)));
typedef short bf16x8 __attribute__((ext_vector_type(8)));
typedef GAS unsigned gu32;
typedef GAS unsigned long long gu64;
#define RLX_AGENT __ATOMIC_RELAXED, __HIP_MEMORY_SCOPE_AGENT
#define LDS_WAIT() asm volatile("s_waitcnt lgkmcnt(0)" ::: "memory")
#define VM_WAIT() asm volatile("s_waitcnt vmcnt(0)" ::: "memory")
__device__ __forceinline__ unsigned long long rt() { return __builtin_amdgcn_s_memrealtime(); }
__device__ __forceinline__ unsigned f2bf(float f) { unsigned u = __builtin_bit_cast(unsigned, f); return (u + 0x7fffu + ((u >> 16) & 1u)) >> 16; }
__device__ __forceinline__ unsigned pk2(float lo, float hi) { return f2bf(lo) | (f2bf(hi) << 16); }

#define XB_TMO      128
#define XB_XCNT(j)  (256  + 64 * (j))
#define XB_XSUB(j)  (1280 + 64 * (j))
#define XB_XGEN(j)  (2304 + 64 * (j))
#define XB_TOP      3328
#define XB_TOPGEN   3392
#define XCD_BAR_WORDS 3456
#define XB_SPIN_CAP (1u << 18)

__device__ __forceinline__ unsigned xb_ld(unsigned* p)              { return __hip_atomic_load(p, __ATOMIC_RELAXED, __HIP_MEMORY_SCOPE_AGENT); }
__device__ __forceinline__ unsigned xb_add(unsigned* p, unsigned v) { return __hip_atomic_fetch_add(p, v, __ATOMIC_RELAXED, __HIP_MEMORY_SCOPE_AGENT); }
__device__ __forceinline__ unsigned xb_xcc_id() { return (unsigned)__builtin_amdgcn_s_getreg((3 << 11) | 20) & 0xFu; }
#define XB_SPIN(cond, bar) do { unsigned _sp = 0; while (cond) { __builtin_amdgcn_s_sleep(1); \
    if ((++_sp & 255u) == 0u) { if (xb_ld(&(bar)[XB_TMO])) break; if (_sp > XB_SPIN_CAP) { atomicAdd(&(bar)[XB_TMO], 1u); break; } } } } while (0)

struct XcdBarrier {
    unsigned* bar; unsigned x;
    volatile LAS unsigned* st;
};

__device__ __forceinline__ XcdBarrier xcd_barrier_post(unsigned* bar, volatile LAS unsigned* st) {
    XcdBarrier b; b.bar = bar; b.x = xb_xcc_id(); b.st = st;
    if (threadIdx.x == 0) (void)xb_add(&bar[XB_XCNT(b.x)], 1u);
    return b;
}
__device__ __forceinline__ void xcd_barrier_complete(unsigned* bar, unsigned x, unsigned& nloc, unsigned& nx) {
    const unsigned G = gridDim.x * gridDim.y * gridDim.z;
    unsigned sum, cnt, mine, sp = 0u;
    for (;;) {
        sum = 0u; cnt = 0u; mine = 0u;
#pragma unroll
        for (unsigned j = 0; j < 16; ++j) { const unsigned c = xb_ld(&bar[XB_XCNT(j)]); sum += c; cnt += (c > 0u) ? 1u : 0u; mine = (j == x) ? c : mine; }
        if (sum == G) break;
        __builtin_amdgcn_s_sleep(1);
        if ((++sp & 255u) == 0u) { if (xb_ld(&bar[XB_TMO])) break; if (sp > XB_SPIN_CAP) { atomicAdd(&bar[XB_TMO], 1u); break; } }
    }
    nloc = mine > 0u ? mine : 1u; nx = cnt > 0u ? cnt : 1u;
}

__device__ __forceinline__ void xcd_barrier(const XcdBarrier& b) {
    asm volatile("s_waitcnt vmcnt(0)" ::: "memory");
    __syncthreads();
    if (threadIdx.x == 0) {
        unsigned* bar = b.bar;
        __builtin_amdgcn_s_waitcnt(0);
        unsigned nloc = b.st[0], nx = b.st[1];
        if (nloc == 0u) { xcd_barrier_complete(bar, b.x, nloc, nx); b.st[0] = nloc; b.st[1] = nx; }
        const unsigned old = xb_add(&bar[XB_XSUB(b.x)], 1u);
        const unsigned gen = old / nloc;
        if (old + 1u == (gen + 1u) * nloc) {
            __builtin_amdgcn_fence(__ATOMIC_RELEASE, "agent");
            asm volatile("s_waitcnt vmcnt(0)" ::: "memory");
            const unsigned og = xb_add(&bar[XB_TOP], 1u);
            const unsigned tg = og / nx;
            if (og + 1u == (tg + 1u) * nx) xb_add(&bar[XB_TOPGEN], 1u);
            else XB_SPIN(xb_ld(&bar[XB_TOPGEN]) == tg, bar);
            __builtin_amdgcn_fence(__ATOMIC_ACQUIRE, "agent");
            xb_add(&bar[XB_XGEN(b.x)], 1u);
            asm volatile("s_waitcnt vmcnt(0)" ::: "memory");
        } else {
            XB_SPIN(xb_ld(&bar[XB_XGEN(b.x)]) == gen, bar);
            __builtin_amdgcn_fence(__ATOMIC_ACQUIRE, "agent");
            asm volatile("s_waitcnt vmcnt(0)" ::: "memory");
        }
    }
    __syncthreads();
}

__constant__ float RET_FREQ[64] = {1.000000000e+00f, 8.639884591e-01f, 7.464760542e-01f, 6.449466944e-01f, 5.572264791e-01f, 4.814372361e-01f, 4.159561992e-01f, 3.593813777e-01f, 3.105013371e-01f, 2.682695687e-01f, 2.317818105e-01f, 2.002568096e-01f, 1.730195731e-01f, 1.494869143e-01f, 1.291549653e-01f, 1.115883961e-01f, 9.641107172e-02f, 8.329805732e-02f, 7.196855545e-02f, 6.218000501e-02f, 5.372280627e-02f, 4.641588405e-02f, 4.010278732e-02f, 3.464834765e-02f, 2.993577160e-02f, 2.586415969e-02f, 2.234633639e-02f, 1.930697635e-02f, 1.668100432e-02f, 1.441219542e-02f, 1.245197095e-02f, 1.075835899e-02f, 9.295095690e-03f, 8.030855097e-03f, 6.938565988e-03f, 5.994840991e-03f, 5.179473665e-03f, 4.475005437e-03f, 3.866352839e-03f, 3.340484342e-03f, 2.886139788e-03f, 2.493591513e-03f, 2.154434333e-03f, 1.861406374e-03f, 1.608233666e-03f, 1.389495330e-03f, 1.200507861e-03f, 1.037224894e-03f, 8.961503627e-04f, 7.742635789e-04f, 6.689548027e-04f, 5.779692437e-04f, 4.993587499e-04f, 4.314401885e-04f, 3.727593285e-04f, 3.220597573e-04f, 2.782559313e-04f, 2.404099068e-04f, 2.077113895e-04f, 1.794602431e-04f, 1.550515735e-04f, 1.339627634e-04f, 1.157422885e-04f, 9.999999747e-05f};
__constant__ float ROPE_FREQ[8] = {1.000000000e+00f, 1.939227432e-01f, 3.760603070e-02f, 7.292664610e-03f, 1.414213562e-03f, 2.742481884e-04f, 5.318295734e-05f, 1.031338525e-05f};
struct Args { const float* in[17]; float* out; unsigned char* ws; };
enum { I_X = 0, I_PRE_NORM = 1, I_PRE_WG = 2, I_PRE_WU = 3, I_PRE_WD = 4, I_MIX_NORM = 5, I_AB_IN = 6, I_AB_OUT = 7, I_GLA_IN = 8, I_GLA_A2 = 9, I_GLA_BA = 10, I_GLA_OUT = 11,
       I_POST_NORM = 12, I_POST_WG = 13, I_POST_WU = 14, I_POST_WD = 15, I_FINAL = 16, I_OUT = 17, I_WS = 18, N_PTRS = 19 };
struct Frame {
    LAS unsigned char* lds;
    int tid, lane, wave, G, bid;
};
__device__ __forceinline__ unsigned char* tabp(const Frame& F, int idx) {
    const volatile LAS unsigned* T = (const volatile LAS unsigned*)(F.lds + PTR_OFF) + 2 * idx;
    const unsigned lo = __builtin_amdgcn_readfirstlane(T[0]), hi = __builtin_amdgcn_readfirstlane(T[1]);
    return (unsigned char*)(((unsigned long long)hi << 32) | (unsigned long long)lo);
}
#define AP(idx) ((const float*)tabp(F, idx))
#define WSP() tabp(F, I_WS)
#define OUTP() ((float*)tabp(F, I_OUT))
__device__ __forceinline__ Frame relaunder(const Frame& F0) { Frame F = F0; asm volatile("" : "+v"(F.tid)); asm volatile("" : "+s"(F.bid)); F.lane = F.tid & 63; F.wave = __builtin_amdgcn_readfirstlane(F.tid >> 6); return F; }
__device__ __forceinline__ float wave_sum(float v) {
#pragma unroll
    for (int o = 1; o < 64; o <<= 1) v += __shfl_xor(v, o);
    return v;
}
__device__ __forceinline__ float bf2f(bf16 h) { return __builtin_bit_cast(float, (unsigned)h << 16); }
__device__ __forceinline__ float bflo(unsigned w) { return __builtin_bit_cast(float, w << 16); }
__device__ __forceinline__ float bfhi(unsigned w) { return __builtin_bit_cast(float, w & 0xffff0000u); }
__device__ __forceinline__ bf16 f2bf_rne(float f) { return (bf16)f2bf(f); }

__device__ __forceinline__ void tr_item(const float* W, int K, int N, int Npad, const float* gain, bf16* WT, int gu, LAS float* scr, int item, int lane) {
    const int nblk = Npad / 32, kb = item / nblk, nb = item % nblk, k0 = 64 * kb, n0 = 32 * nb;
    const int nn = n0 + (lane & 31); const bool ok = nn < N;
#pragma unroll 8
    for (int i = 0; i < 32; ++i) { const int kk = 2 * i + (lane >> 5); float w = ok ? W[(size_t)(k0 + kk) * N + nn] : 0.f; if (gain) w *= gain[k0 + kk]; scr[kk * 33 + (lane & 31)] = w; }
    LDS_WAIT(); asm volatile("" ::: "memory");
    const int c = lane & 7;
#pragma unroll
    for (int j = 0; j < 4; ++j) { const int n = (lane >> 3) + 8 * j; const LAS float* s = scr + (8 * c) * 33 + n;
        v4u o; o.x = pk2(s[0 * 33], s[1 * 33]); o.y = pk2(s[2 * 33], s[3 * 33]); o.z = pk2(s[4 * 33], s[5 * 33]); o.w = pk2(s[6 * 33], s[7 * 33]);
        int drow = n0 + n; if (gu) drow = (drow >> 7) * 256 + (drow & 127) + (gu == 2 ? 128 : 0);
        *(GAS v4u*)(WT + (size_t)drow * K + k0 + 8 * c) = o; }
    LDS_WAIT(); asm volatile("" ::: "memory");
}
__device__ __forceinline__ void convert_weights(const Frame& F0, int l) {
    const Frame F = relaunder(F0);
    LAS float* scr = (LAS float*)(F.lds + RING_OFF + F.wave * 16384);
    const int gw = F.bid * NWAVES + F.wave, NGW = F.G * NWAVES;
    unsigned char* ws = WSP();
    constexpr int I_G = (D / 64) * (FF / 32), I_DN = (FF / 64) * (D / 32), I_O = (D / 64) * (D / 32);
    const bool odd = (l & 1) != 0; const int li = l >> 1;
    const int nin = odd ? GLA_IN : EVEN_IN, ninp = odd ? GLA_INP : EVEN_IN; const int I_IN = (D / 64) * (ninp / 32);
    const float* win = odd ? AP(I_GLA_IN) + (size_t)li * D * GLA_IN : AP(I_AB_IN) + (size_t)li * D * EVEN_IN;
    const float* wout = odd ? AP(I_GLA_OUT) + (size_t)li * D * D : AP(I_AB_OUT) + (size_t)li * D * D;
    const size_t fo = (size_t)l * D * FF;
    const int NITEMS = 6 * I_G + I_IN + I_O;
    static_assert(I_G == I_DN, "item counts");
    for (int it = gw; it < NITEMS; it += NGW) {
        int r = it;
        if (r < I_G) { tr_item(AP(I_PRE_WG) + fo, D, FF, FF, AP(I_PRE_NORM) + l * D, (bf16*)(ws + W_GU0), 1, scr, r, F.lane); continue; } r -= I_G;
        if (r < I_G) { tr_item(AP(I_PRE_WU) + fo, D, FF, FF, AP(I_PRE_NORM) + l * D, (bf16*)(ws + W_GU0), 2, scr, r, F.lane); continue; } r -= I_G;
        if (r < I_G) { tr_item(AP(I_PRE_WD) + fo, FF, D, D, nullptr, (bf16*)(ws + W_D0), 0, scr, r, F.lane); continue; } r -= I_G;
        if (r < I_G) { tr_item(AP(I_POST_WG) + fo, D, FF, FF, AP(I_POST_NORM) + l * D, (bf16*)(ws + W_GU1), 1, scr, r, F.lane); continue; } r -= I_G;
        if (r < I_G) { tr_item(AP(I_POST_WU) + fo, D, FF, FF, AP(I_POST_NORM) + l * D, (bf16*)(ws + W_GU1), 2, scr, r, F.lane); continue; } r -= I_G;
        if (r < I_G) { tr_item(AP(I_POST_WD) + fo, FF, D, D, nullptr, (bf16*)(ws + W_D1), 0, scr, r, F.lane); continue; } r -= I_G;
        if (r < I_IN) { tr_item(win, D, nin, ninp, AP(I_MIX_NORM) + l * D, (bf16*)(ws + W_IN), 0, scr, r, F.lane); continue; } r -= I_IN;
        tr_item(wout, D, D, D, nullptr, (bf16*)(ws + W_OUT), 0, scr, r, F.lane);
    }
}
__device__ __forceinline__ void prologue_rows(const Frame& F0) {
    const Frame F = relaunder(F0);
    unsigned char* ws = WSP();
    const int gw = F.bid * NWAVES + F.wave, NGW = F.G * NWAVES;
    bf16* XB = (bf16*)(ws + WS_XB); float* ssp = (float*)(ws + WS_SSP);
    for (int m = gw; m < M; m += NGW) {
        const GAS f32x4* xr = (const GAS f32x4*)(AP(I_X) + (size_t)m * D) + F.lane;
        GAS unsigned long long* o8 = (GAS unsigned long long*)(XB + (size_t)m * D) + F.lane;
        float s = 0.f;
#pragma unroll
        for (int j = 0; j < 4; ++j) { const f32x4 v = xr[64 * j]; s += (v.x * v.x + v.y * v.y) + (v.z * v.z + v.w * v.w);
            o8[64 * j] = (unsigned long long)pk2(v.x, v.y) | ((unsigned long long)pk2(v.z, v.w) << 32); }
        s = wave_sum(s);
        if (F.lane < 16) ssp[(size_t)m * 16 + F.lane] = (F.lane == 0) ? s : 0.f;
    }
    const int gt = F.bid * NTHREADS + F.tid, NGT = F.G * NTHREADS;
    float* rc = (float*)(ws + TAB_RC); float* rsn = (float*)(ws + TAB_RS); float* dc = (float*)(ws + TAB_DC); float* ds = (float*)(ws + TAB_DS);
    for (int e = gt; e < SEQ * 64; e += NGT) { const int t = e >> 6, i = e & 63; const float ang = (float)t * RET_FREQ[i];
        double rev = (double)ang * 0.15915494309189535; rev -= __builtin_rint(rev); const float r = (float)rev;
        rc[e] = __builtin_amdgcn_cosf(r); rsn[e] = __builtin_amdgcn_sinf(r); }
    for (int e = gt; e < SEQ * 8; e += NGT) { const int t = e >> 3, i = e & 7; const float ang = (float)t * ROPE_FREQ[i];
        double rev = (double)ang * 0.15915494309189535; rev -= __builtin_rint(rev); const float r = (float)rev;
        dc[e] = __builtin_amdgcn_cosf(r); ds[e] = __builtin_amdgcn_sinf(r); }
}

__device__ __forceinline__ void even_prep(const Frame& F0) {
    const Frame F = relaunder(F0);
    unsigned char* ws = WSP();
    const int gw = F.bid * NWAVES + F.wave, NGW = F.G * NWAVES;
    bf16* P = (bf16*)(ws + WS_ACT);
    const float* rc = (const float*)(ws + TAB_RC); const float* rsn = (const float*)(ws + TAB_RS); const float* dc = (const float*)(ws + TAB_DC); const float* ds = (const float*)(ws + TAB_DS);
    for (int m = gw; m < M; m += NGW) {
        const int pos = m & (SEQ - 1); bf16* row = P + (size_t)m * EVEN_IN;
        const float c = rc[pos * 64 + F.lane], s = rsn[pos * 64 + F.lane];
#pragma unroll
        for (int h = 0; h < 4; ++h) {
            { bf16* p1 = row + E_RQ + h * 128 + F.lane; bf16* p2 = p1 + 64; const float x1 = bf2f(*p1), x2 = bf2f(*p2); *p1 = f2bf_rne(x1 * c - x2 * s); *p2 = f2bf_rne(x2 * c + x1 * s); }
            { bf16* p1 = row + E_RK + h * 128 + F.lane; bf16* p2 = p1 + 64; const float x1 = bf2f(*p1), x2 = bf2f(*p2);
              *p1 = f2bf_rne((x1 * c - x2 * s) * 0.08838834764831845f); *p2 = f2bf_rne((x2 * c + x1 * s) * 0.08838834764831845f); }
        }
        { const int h = F.lane >> 3, i = F.lane & 7; const float c2 = dc[pos * 8 + i], s2 = ds[pos * 8 + i];
          { bf16* p1 = row + E_DQ + h * 64 + i; bf16* p2 = p1 + 8; const float x1 = bf2f(*p1), x2 = bf2f(*p2); *p1 = f2bf_rne(x1 * c2 - x2 * s2); *p2 = f2bf_rne(x2 * c2 + x1 * s2); }
          { bf16* p1 = row + E_DK + h * 64 + i; bf16* p2 = p1 + 8; const float x1 = bf2f(*p1), x2 = bf2f(*p2); *p1 = f2bf_rne(x1 * c2 - x2 * s2); *p2 = f2bf_rne(x2 * c2 + x1 * s2); } }
    }
}
__device__ __forceinline__ void even_core(const Frame& F0) {
    const Frame F = relaunder(F0);
    unsigned char* ws = WSP();
    const bf16* P = (const bf16*)(ws + WS_ACT);
    if (F.bid < 128) {
        const int b = F.bid >> 4, h = (F.bid >> 2) & 3, eg = F.bid & 3, e = eg * 32 + (F.tid >> 4), dq = F.tid & 15;
        const float g = 1.0f - exp2f(-5.0f - (float)h);
        float* oraw = (float*)(ws + WS_XB);
        const bf16* base = P + (size_t)b * SEQ * EVEN_IN;
        float S[8];
#pragma unroll
        for (int i = 0; i < 8; ++i) S[i] = 0.f;
        v4u qn = *(const GAS v4u*)(base + E_RQ + h * 128 + dq * 8), kn = *(const GAS v4u*)(base + E_RK + h * 128 + dq * 8); bf16 vn = base[E_RV + h * 128 + e];
        for (int t = 0; t < SEQ; ++t) {
            const v4u q = qn, k = kn; const float v = bf2f(vn);
            if (t + 1 < SEQ) { const bf16* nb = base + (size_t)(t + 1) * EVEN_IN; qn = *(const GAS v4u*)(nb + E_RQ + h * 128 + dq * 8); kn = *(const GAS v4u*)(nb + E_RK + h * 128 + dq * 8); vn = nb[E_RV + h * 128 + e]; }
            float o = 0.f;
#pragma unroll
            for (int i = 0; i < 4; ++i) { const unsigned qw = q[i], kw = k[i];
                S[2 * i] = g * S[2 * i] + bflo(kw) * v; S[2 * i + 1] = g * S[2 * i + 1] + bfhi(kw) * v;
                o += bflo(qw) * S[2 * i]; o += bfhi(qw) * S[2 * i + 1]; }
            o += __shfl_xor(o, 1); o += __shfl_xor(o, 2); o += __shfl_xor(o, 4); o += __shfl_xor(o, 8);
            if (dq == 0) oraw[((size_t)b * SEQ + t) * 512 + h * 128 + e] = o;
        }
    } else {
        bf16* CAT = (bf16*)(ws + WS_CAT);
        for (int it = F.bid - 128; it < BATCH * (SEQ / 64); it += F.G - 128) {
            const int b = it >> 6, t = (it & 63) * 64 + F.lane, h = F.wave;
            const bf16* base = P + (size_t)b * SEQ * EVEN_IN;
            float q[64];
            { const GAS v4u* qp = (const GAS v4u*)(base + (size_t)t * EVEN_IN + E_DQ + h * 64);
#pragma unroll
              for (int j = 0; j < 8; ++j) { const v4u w = qp[j];
#pragma unroll
                  for (int i = 0; i < 4; ++i) { q[8 * j + 2 * i] = bflo(w[i]) * (0.125f * 1.4426950408889634f); q[8 * j + 2 * i + 1] = bfhi(w[i]) * (0.125f * 1.4426950408889634f); } } }
            float o[64];
#pragma unroll
            for (int i = 0; i < 64; ++i) o[i] = 0.f;
            float mx = -INFINITY, l = 0.f;
            for (int p = 0; p < 3; ++p) {
                const int dil = (p == 0) ? 1 : (p == 1) ? 4 : 16;
                for (int j = 0; j <= 128; ++j) {
                    const int tk = t - j * dil;
                    if (tk >= 0) {
                        const GAS v4u* kp = (const GAS v4u*)(base + (size_t)tk * EVEN_IN + E_DK + h * 64);
                        const GAS v4u* vp = (const GAS v4u*)(base + (size_t)tk * EVEN_IN + E_DV + h * 64);
                        float s = 0.f;
#pragma unroll
                        for (int jj = 0; jj < 8; ++jj) { const v4u w = kp[jj];
#pragma unroll
                            for (int i = 0; i < 4; ++i) { s += q[8 * jj + 2 * i] * bflo(w[i]); s += q[8 * jj + 2 * i + 1] * bfhi(w[i]); } }
                        const float mn = fmaxf(mx, s), corr = __builtin_amdgcn_exp2f(mx - mn), pe = __builtin_amdgcn_exp2f(s - mn);
                        l = l * corr + pe; mx = mn;
#pragma unroll
                        for (int jj = 0; jj < 8; ++jj) { const v4u w = vp[jj];
#pragma unroll
                            for (int i = 0; i < 4; ++i) { o[8 * jj + 2 * i] = o[8 * jj + 2 * i] * corr + pe * bflo(w[i]); o[8 * jj + 2 * i + 1] = o[8 * jj + 2 * i + 1] * corr + pe * bfhi(w[i]); } }
                    }
                }
            }
            const float rl = 1.0f / l;
            GAS v4u* op = (GAS v4u*)(CAT + ((size_t)b * SEQ + t) * D + 512 + h * 64);
#pragma unroll
            for (int j = 0; j < 8; ++j) { v4u w; w.x = pk2(o[8 * j] * rl, o[8 * j + 1] * rl); w.y = pk2(o[8 * j + 2] * rl, o[8 * j + 3] * rl); w.z = pk2(o[8 * j + 4] * rl, o[8 * j + 5] * rl); w.w = pk2(o[8 * j + 6] * rl, o[8 * j + 7] * rl); op[j] = w; }
        }
    }
}
__device__ __forceinline__ void even_post(const Frame& F0) {
    const Frame F = relaunder(F0);
    unsigned char* ws = WSP();
    const int gw = F.bid * NWAVES + F.wave, NGW = F.G * NWAVES;
    const bf16* P = (const bf16*)(ws + WS_ACT); const float* oraw = (const float*)(ws + WS_XB); bf16* CAT = (bf16*)(ws + WS_CAT);
    for (int it = gw; it < M * 4; it += NGW) {
        const int m = it >> 2, h = it & 3;
        const float* op = oraw + (size_t)m * 512 + h * 128 + 2 * F.lane; const float o0 = op[0], o1 = op[1];
        const float mu = wave_sum(o0 + o1) * (1.0f / 128.0f); const float d0 = o0 - mu, d1 = o1 - mu;
        const float var = wave_sum(d0 * d0 + d1 * d1) * (1.0f / 128.0f); const float rstd = 1.0f / sqrtf(var + EPS);
        const unsigned gw2 = *(const unsigned*)(P + (size_t)m * EVEN_IN + E_RG + h * 128 + 2 * F.lane); const float g0 = bflo(gw2), g1 = bfhi(gw2);
        const float y0 = d0 * rstd * (g0 / (1.0f + expf(-g0))), y1 = d1 * rstd * (g1 / (1.0f + expf(-g1)));
        *(unsigned*)(CAT + (size_t)m * D + h * 128 + 2 * F.lane) = pk2(y0, y1);
    }
}
__device__ __forceinline__ void gla_prep(const Frame& F0, int li) {
    const Frame F = relaunder(F0);
    unsigned char* ws = WSP();
    const int gt = F.bid * NTHREADS + F.tid, NGT = F.G * NTHREADS;
    const bf16* P = (const bf16*)(ws + WS_ACT); float* A = (float*)(ws + WS_CAT);
    const float* w2 = AP(I_GLA_A2) + (size_t)li * 16 * 512; const float* ba = AP(I_GLA_BA) + (size_t)li * 512;
    for (int e = gt; e < M * 512; e += NGT) {
        const int m = e >> 9, c = e & 511; const bf16* al = P + (size_t)m * GLA_INP + G_A;
        float z = ba[c];
#pragma unroll
        for (int j = 0; j < 16; ++j) z += bf2f(al[j]) * w2[j * 512 + c];
        const float ls = fminf(z, 0.f) - log1pf(expf(-fabsf(z)));
        A[e] = expf(ls * (1.0f / 16.0f));
    }
}
__device__ __forceinline__ void gla_core(const Frame& F0) {
    const Frame F = relaunder(F0);
    unsigned char* ws = WSP();
    const bf16* P = (const bf16*)(ws + WS_ACT); const float* A = (const float*)(ws + WS_CAT); bf16* oraw = (bf16*)(ws + WS_XB);
    const int b = F.bid >> 5, h = (F.bid >> 3) & 3, eg = F.bid & 7, e = eg * 32 + (F.tid >> 4), dq = F.tid & 15;
    const bf16* base = P + (size_t)b * SEQ * GLA_INP; const float* abase = A + (size_t)b * SEQ * 512 + h * 128 + dq * 8;
    float S[8];
#pragma unroll
    for (int i = 0; i < 8; ++i) S[i] = 0.f;
    v4u qn = *(const GAS v4u*)(base + G_Q + h * 128 + dq * 8), kn = *(const GAS v4u*)(base + G_K + h * 128 + dq * 8); bf16 vn = base[G_V + h * 256 + e];
    f32x4 a0n = *(const GAS f32x4*)(abase), a1n = *(const GAS f32x4*)(abase + 4);
    for (int t = 0; t < SEQ; ++t) {
        const v4u q = qn, k = kn; const float v = bf2f(vn); const f32x4 a0 = a0n, a1 = a1n;
        if (t + 1 < SEQ) { const bf16* nb = base + (size_t)(t + 1) * GLA_INP; qn = *(const GAS v4u*)(nb + G_Q + h * 128 + dq * 8); kn = *(const GAS v4u*)(nb + G_K + h * 128 + dq * 8); vn = nb[G_V + h * 256 + e];
            a0n = *(const GAS f32x4*)(abase + (size_t)(t + 1) * 512); a1n = *(const GAS f32x4*)(abase + (size_t)(t + 1) * 512 + 4); }
        float o = 0.f;
#pragma unroll
        for (int i = 0; i < 4; ++i) { const unsigned qw = q[i], kw = k[i]; const float al = (i < 2) ? a0[2 * i] : a1[2 * i - 4], ah = (i < 2) ? a0[2 * i + 1] : a1[2 * i - 3];
            S[2 * i] = al * S[2 * i] + bflo(kw) * v; S[2 * i + 1] = ah * S[2 * i + 1] + bfhi(kw) * v;
            o += bflo(qw) * S[2 * i]; o += bfhi(qw) * S[2 * i + 1]; }
        o += __shfl_xor(o, 1); o += __shfl_xor(o, 2); o += __shfl_xor(o, 4); o += __shfl_xor(o, 8);
        if (dq == 0) oraw[((size_t)b * SEQ + t) * 1024 + h * 256 + e] = f2bf_rne(o * 0.08838834764831845f);
    }
}
__device__ __forceinline__ void gla_post(const Frame& F0) {
    const Frame F = relaunder(F0);
    unsigned char* ws = WSP();
    const int gw = F.bid * NWAVES + F.wave, NGW = F.G * NWAVES;
    const bf16* P = (const bf16*)(ws + WS_ACT); const bf16* oraw = (const bf16*)(ws + WS_XB); bf16* CAT = (bf16*)(ws + WS_CAT);
    for (int it = gw; it < M * 4; it += NGW) {
        const int m = it >> 2, h = it & 3;
        const unsigned long long ow = *(const unsigned long long*)(oraw + (size_t)m * 1024 + h * 256 + 4 * F.lane);
        const float o0 = bflo((unsigned)ow), o1 = bfhi((unsigned)ow), o2 = bflo((unsigned)(ow >> 32)), o3 = bfhi((unsigned)(ow >> 32));
        const float mu = wave_sum((o0 + o1) + (o2 + o3)) * (1.0f / 256.0f); const float d0 = o0 - mu, d1 = o1 - mu, d2 = o2 - mu, d3 = o3 - mu;
        const float var = wave_sum((d0 * d0 + d1 * d1) + (d2 * d2 + d3 * d3)) * (1.0f / 256.0f); const float rstd = 1.0f / sqrtf(var + EPS);
        const unsigned long long gw2 = *(const unsigned long long*)(P + (size_t)m * GLA_INP + G_R + h * 256 + 4 * F.lane);
        const float g0 = bflo((unsigned)gw2), g1 = bfhi((unsigned)gw2), g2 = bflo((unsigned)(gw2 >> 32)), g3 = bfhi((unsigned)(gw2 >> 32));
        const float y0 = d0 * rstd * (g0 / (1.0f + expf(-g0))), y1 = d1 * rstd * (g1 / (1.0f + expf(-g1))), y2 = d2 * rstd * (g2 / (1.0f + expf(-g2))), y3 = d3 * rstd * (g3 / (1.0f + expf(-g3)));
        *(unsigned long long*)(CAT + (size_t)m * D + h * 256 + 4 * F.lane) = (unsigned long long)pk2(y0, y1) | ((unsigned long long)pk2(y2, y3) << 32);
    }
}
__device__ __forceinline__ void final_norm(const Frame& F0) {
    const Frame F = relaunder(F0);
    const int gw = F.bid * NWAVES + F.wave, NGW = F.G * NWAVES;
    for (int m = gw; m < M; m += NGW) {
        GAS f32x4* xr = (GAS f32x4*)(OUTP() + (size_t)m * D) + F.lane; const GAS f32x4* gr = (const GAS f32x4*)AP(I_FINAL) + F.lane;
        f32x4 v[4]; float s = 0.f;
#pragma unroll
        for (int j = 0; j < 4; ++j) { v[j] = xr[64 * j]; s += (v[j].x * v[j].x + v[j].y * v[j].y) + (v[j].z * v[j].z + v[j].w * v[j].w); }
        const float rstd = 1.0f / sqrtf(wave_sum(s) * (1.0f / D) + EPS);
#pragma unroll
        for (int j = 0; j < 4; ++j) xr[64 * j] = v[j] * rstd * gr[64 * j];
    }
}


__device__ __forceinline__ float silu_f(float g) { return g * __builtin_amdgcn_rcpf(1.0f + __builtin_amdgcn_exp2f(-1.4426950408889634f * g)); }
typedef float f32x16 __attribute__((ext_vector_type(16)));
typedef short s16x4 __attribute__((ext_vector_type(4)));
typedef float f32x2_t __attribute__((ext_vector_type(2)));
typedef __bf16 bf16x2_t __attribute__((ext_vector_type(2)));
#define MFMA32(a, b, c) __builtin_amdgcn_mfma_f32_32x32x16_bf16((a), (b), (c), 0, 0, 0)
__device__ __forceinline__ int crow(int reg, int h) { return (reg & 3) + 8 * (reg >> 2) + 4 * h; }
__device__ __forceinline__ unsigned cvtpk(float lo, float hi) { f32x2_t v = {lo, hi}; bf16x2_t b = __builtin_convertvector(v, bf16x2_t); return __builtin_bit_cast(unsigned, b); }
__device__ __forceinline__ bf16 cvt1(float v) { return (bf16)(cvtpk(v, 0.f) & 0xffffu); }
#define PACK_STEP(x, s) __builtin_bit_cast(bf16x8, (v4u){cvtpk((x)[8 * (s)], (x)[8 * (s) + 1]), cvtpk((x)[8 * (s) + 2], (x)[8 * (s) + 3]), cvtpk((x)[8 * (s) + 4], (x)[8 * (s) + 5]), cvtpk((x)[8 * (s) + 6], (x)[8 * (s) + 7])})
typedef const LAS unsigned char* lcp;
__device__ __forceinline__ bf16x8 ld_row(lcp img, int P, int row0, int k0, int r, int h) { return *(const LAS bf16x8*)(img + (row0 + r) * P + (k0 + 8 * h) * 2); }
__device__ __forceinline__ bf16x8 ld_row_perm(lcp img, int P, int row0, int k0, int r, int h) {
    const s16x4 lo = *(const LAS s16x4*)(img + (row0 + r) * P + (k0 + 4 * h) * 2), hi = *(const LAS s16x4*)(img + (row0 + r) * P + (k0 + 8 + 4 * h) * 2);
    return __builtin_shufflevector(lo, hi, 0, 1, 2, 3, 4, 5, 6, 7); }
__device__ __forceinline__ s16x4 trd(lcp p) { return __builtin_bit_cast(s16x4, __builtin_amdgcn_ds_read_tr16_b64_v4i16((LAS s16x4*)p)); }
__device__ __forceinline__ bf16x8 ld_tr(lcp img, int P, int k0, int c0, int lane) {
    const int i16 = lane & 15, q = i16 >> 2, p = i16 & 3, blk = (lane >> 4) & 1, h = lane >> 5;
    lcp a = img + (k0 + 8 * h + q) * P + (c0 + 16 * blk + 4 * p) * 2;
    const s16x4 lo = trd(a), hi = trd(a + 4 * P);
    return __builtin_shufflevector(lo, hi, 0, 1, 2, 3, 4, 5, 6, 7); }
__device__ __forceinline__ bf16x8 ld_tr_perm(lcp img, int P, int k0, int c0, int lane) {
    const int i16 = lane & 15, q = i16 >> 2, p = i16 & 3, blk = (lane >> 4) & 1, h = lane >> 5;
    lcp a = img + (k0 + 4 * h + q) * P + (c0 + 16 * blk + 4 * p) * 2;
    const s16x4 lo = trd(a), hi = trd(a + 8 * P);
    return __builtin_shufflevector(lo, hi, 0, 1, 2, 3, 4, 5, 6, 7); }
template <int R, int C> __device__ __forceinline__ void stage_tile(LAS unsigned char* img, int P, const bf16* g, size_t gp, int tid) {
    constexpr int CPR = C / 8, N = R * CPR;
#pragma unroll
    for (int i = 0; i < (N + NTHREADS - 1) / NTHREADS; ++i) { const int c = tid + i * NTHREADS;
        if (c < N) { const int row = c / CPR, cc = c % CPR; const v4u v = *(const GAS v4u*)(g + (size_t)row * gp + cc * 8); *(LAS v4u*)(img + row * P + cc * 16) = v; } }
}
#define WG_BAR() do { asm volatile("s_waitcnt vmcnt(0) lgkmcnt(0)" ::: "memory"); __builtin_amdgcn_s_barrier(); asm volatile("" ::: "memory"); } while (0)

constexpr int GP128 = 272, GP256 = 528;
constexpr size_t WS_DEC = 6 * MiB;
constexpr float LOG2E = 1.4426950408889634f, LN2 = 0.6931471805599453f;
__device__ __forceinline__ void gla_cumsum(float (&Bc)[2][16], float& Blast, lcp AL, lcp W2, const LAS float* BA, LAS float* EX, int wave, int lane) {
    const int r = lane & 31, h = lane >> 5, db = wave & 3, jh = wave >> 2;
    const bf16x8 wf = *(const LAS bf16x8*)(W2 + (db * 32 + r) * 32 + h * 16);
    const float bias = BA[db * 32 + r];
    float run = 0.f;
#pragma unroll
    for (int t = 0; t < 2; ++t) {
        const bf16x8 af = *(const LAS bf16x8*)(AL + ((jh * 2 + t) * 32 + r) * 32 + h * 16);
        f32x16 z = {0.f, 0.f, 0.f, 0.f, 0.f, 0.f, 0.f, 0.f, 0.f, 0.f, 0.f, 0.f, 0.f, 0.f, 0.f, 0.f};
        z = MFMA32(af, wf, z);
        float own[4], oth[4];
#pragma unroll
        for (int g = 0; g < 4; ++g) {
            float acc = 0.f;
#pragma unroll
            for (int i = 0; i < 4; ++i) { const float zz = z[4 * g + i] + bias;
                const float la = (fminf(zz, 0.f) - LN2 * __builtin_amdgcn_logf(1.0f + __builtin_amdgcn_exp2f(-fabsf(zz) * LOG2E))) * (1.0f / 16.0f);
                acc += la; Bc[t][4 * g + i] = acc; }
            own[g] = acc; oth[g] = __shfl_xor(acc, 32);
        }
#pragma unroll
        for (int g = 0; g < 4; ++g) { const float off = run + (h ? oth[g] : 0.f);
#pragma unroll
            for (int i = 0; i < 4; ++i) Bc[t][4 * g + i] += off;
            run += own[g] + oth[g]; }
    }
    if (h == 0) EX[jh * 128 + db * 32 + r] = run;
    WG_BAR();
    const float t0 = EX[db * 32 + r], t1 = EX[128 + db * 32 + r];
    Blast = t0 + t1;
    if (jh == 1) {
#pragma unroll
        for (int t = 0; t < 2; ++t)
#pragma unroll
            for (int i = 0; i < 16; ++i) Bc[t][i] += t0; }
}
constexpr int GA_KI = 0, GA_VI = GA_KI + 128 * GP128, GA_KD = GA_VI + 128 * GP256, GA_AL = GA_KD + 128 * GP128, GA_W2 = GA_AL + 4096, GA_BA = GA_W2 + 4096, GA_EX = GA_BA + 512, GA_END = GA_EX + 1024;
constexpr int GC_QT = 0, GC_KT = GC_QT + 128 * GP128, GC_SI = GC_KT + 128 * GP128, GC_VI = GC_SI + 128 * GP128, GC_AL = GC_VI + 128 * GP128, GC_W2 = GC_AL + 4096, GC_BA = GC_W2 + 4096, GC_EX = GC_BA + 512, GC_END = GC_EX + 1024;
constexpr int GC_OI = 0;
static_assert(GA_END <= LDSCTL_OFF && GC_END <= LDSCTL_OFF && 128 * GP256 <= GC_SI, "GLA LDS maps");
__device__ __forceinline__ void gla_stage_small(const Frame& F, LAS unsigned char* AL, LAS unsigned char* W2, LAS float* BA, const bf16* Prow0, int li, int h) {
    if (F.tid < 256) { const int row = F.tid >> 1, cc = F.tid & 1; *(LAS v4u*)(AL + row * 32 + cc * 16) = *(const GAS v4u*)(Prow0 + (size_t)row * GLA_INP + G_A + cc * 8); }
    else if (F.tid < 384) { const int d = F.tid - 256; const float* w2 = AP(I_GLA_A2) + (size_t)li * 16 * 512 + h * 128 + d;
        v4u lo, hi; lo.x = cvtpk(w2[0], w2[512]); lo.y = cvtpk(w2[2 * 512], w2[3 * 512]); lo.z = cvtpk(w2[4 * 512], w2[5 * 512]); lo.w = cvtpk(w2[6 * 512], w2[7 * 512]);
        hi.x = cvtpk(w2[8 * 512], w2[9 * 512]); hi.y = cvtpk(w2[10 * 512], w2[11 * 512]); hi.z = cvtpk(w2[12 * 512], w2[13 * 512]); hi.w = cvtpk(w2[14 * 512], w2[15 * 512]);
        *(LAS v4u*)(W2 + d * 32) = lo; *(LAS v4u*)(W2 + d * 32 + 16) = hi; }
    else { const int d = F.tid - 384; BA[d] = AP(I_GLA_BA)[(size_t)li * 512 + h * 128 + d]; }
}
__device__ __forceinline__ void gla_phase_a(const Frame& F0, int li) {
    const Frame F = relaunder(F0);
    unsigned char* ws = WSP();
    const bf16* P = (const bf16*)(ws + WS_ACT); bf16* SKV = (bf16*)(ws + WS_XB); float* DEC = (float*)(ws + WS_DEC);
    LAS unsigned char* L = F.lds;
    const int lane = F.lane, r = lane & 31, h2 = lane >> 5, wave = F.wave, db = wave & 3, jh = wave >> 2;
    for (int it = F.bid; it < 1024; it += F.G) {
        const int bh = it >> 5, g = it & 31, b = bh >> 2, h = bh & 3;
        const bf16* Prow0 = P + ((size_t)b * SEQ + g * 128) * GLA_INP;
        stage_tile<128, 128>(L + GA_KI, GP128, Prow0 + G_K + h * 128, GLA_INP, F.tid);
        stage_tile<128, 256>(L + GA_VI, GP256, Prow0 + G_V + h * 256, GLA_INP, F.tid);
        gla_stage_small(F, L + GA_AL, L + GA_W2, (LAS float*)(L + GA_BA), Prow0, li, h);
        WG_BAR();
        float Bc[2][16], Blast;
        gla_cumsum(Bc, Blast, L + GA_AL, L + GA_W2, (const LAS float*)(L + GA_BA), (LAS float*)(L + GA_EX), wave, lane);
#pragma unroll
        for (int t = 0; t < 2; ++t)
#pragma unroll
            for (int i = 0; i < 16; ++i) { const int off = ((jh * 2 + t) * 32 + crow(i, h2)) * GP128 + (db * 32 + r) * 2;
                const float kv = bf2f(*(const LAS bf16*)(L + GA_KI + off)) * __builtin_amdgcn_exp2f((Blast - Bc[t][i]) * LOG2E);
                *(LAS bf16*)(L + GA_KD + off) = cvt1(kv); }
        if (jh == 0 && h2 == 0) DEC[(size_t)it * 128 + db * 32 + r] = __builtin_amdgcn_exp2f(Blast * LOG2E);
        WG_BAR();
        f32x16 acc[4];
#pragma unroll
        for (int t = 0; t < 4; ++t) acc[t] = (f32x16){0.f, 0.f, 0.f, 0.f, 0.f, 0.f, 0.f, 0.f, 0.f, 0.f, 0.f, 0.f, 0.f, 0.f, 0.f, 0.f};
#pragma unroll
        for (int ks = 0; ks < 8; ++ks) { const bf16x8 a = ld_tr(L + GA_KD, GP128, 16 * ks, db * 32, lane);
#pragma unroll
            for (int t = 0; t < 4; ++t) acc[t] = MFMA32(a, ld_tr(L + GA_VI, GP256, 16 * ks, (4 * jh + t) * 32, lane), acc[t]); }
        bf16* out = SKV + (size_t)it * 128 * 256;
#pragma unroll
        for (int t = 0; t < 4; ++t)
#pragma unroll
            for (int i = 0; i < 16; ++i) out[(size_t)(db * 32 + crow(i, h2)) * 256 + (4 * jh + t) * 32 + r] = cvt1(acc[t][i]);
        WG_BAR();
    }
}
__device__ __forceinline__ void gla_phase_b(const Frame& F0) {
    const Frame F = relaunder(F0);
    unsigned char* ws = WSP();
    bf16* SKV = (bf16*)(ws + WS_XB); const float* DEC = (const float*)(ws + WS_DEC);
    for (int gt = F.bid * NTHREADS + F.tid; gt < 32 * 128 * 32; gt += F.G * NTHREADS) {
        const int bh = gt >> 12, d = (gt >> 5) & 127, e8 = gt & 31;
        float s[8];
#pragma unroll
        for (int i = 0; i < 8; ++i) s[i] = 0.f;
        for (int g0 = 0; g0 < 32; g0 += 4) {
            v4u kv[4]; float dc[4];
#pragma unroll
            for (int u = 0; u < 4; ++u) { const size_t item = (size_t)bh * 32 + g0 + u; kv[u] = *(const GAS v4u*)(SKV + (item * 128 + d) * 256 + e8 * 8); dc[u] = DEC[item * 128 + d]; }
#pragma unroll
            for (int u = 0; u < 4; ++u) { const size_t item = (size_t)bh * 32 + g0 + u;
                v4u o; o.x = cvtpk(s[0], s[1]); o.y = cvtpk(s[2], s[3]); o.z = cvtpk(s[4], s[5]); o.w = cvtpk(s[6], s[7]);
                *(GAS v4u*)(SKV + (item * 128 + d) * 256 + e8 * 8) = o;
#pragma unroll
                for (int i = 0; i < 4; ++i) { s[2 * i] = dc[u] * s[2 * i] + bflo(kv[u][i]); s[2 * i + 1] = dc[u] * s[2 * i + 1] + bfhi(kv[u][i]); } }
        }
    }
}
__device__ __forceinline__ void gla_phase_c(const Frame& F0, int li) {
    const Frame F = relaunder(F0);
    unsigned char* ws = WSP();
    const bf16* P = (const bf16*)(ws + WS_ACT); const bf16* SKV = (const bf16*)(ws + WS_XB); bf16* CAT = (bf16*)(ws + WS_CAT);
    LAS unsigned char* L = F.lds;
    const int lane = F.lane, r = lane & 31, h2 = lane >> 5, wave = F.wave, db = wave & 3, jh = wave >> 2;
    const int ib = wave & 3, eq = wave >> 2;
    for (int it = F.bid; it < 1024; it += F.G) {
        const int bh = it >> 5, g = it & 31, b = bh >> 2, h = bh & 3;
        const bf16* Prow0 = P + ((size_t)b * SEQ + g * 128) * GLA_INP;
        const bf16* Sg = SKV + (size_t)it * 128 * 256;
        stage_tile<128, 128>(L + GC_QT, GP128, Prow0 + G_Q + h * 128, GLA_INP, F.tid);
        stage_tile<128, 128>(L + GC_KT, GP128, Prow0 + G_K + h * 128, GLA_INP, F.tid);
        stage_tile<128, 128>(L + GC_SI, GP128, Sg, 256, F.tid);
        stage_tile<128, 128>(L + GC_VI, GP128, Prow0 + G_V + h * 256, GLA_INP, F.tid);
        gla_stage_small(F, L + GC_AL, L + GC_W2, (LAS float*)(L + GC_BA), Prow0, li, h);
        WG_BAR();
        {
            float Bc[2][16], Blast;
            gla_cumsum(Bc, Blast, L + GC_AL, L + GC_W2, (const LAS float*)(L + GC_BA), (LAS float*)(L + GC_EX), wave, lane);
#pragma unroll
            for (int t = 0; t < 2; ++t)
#pragma unroll
                for (int i = 0; i < 16; ++i) { const int off = ((jh * 2 + t) * 32 + crow(i, h2)) * GP128 + (db * 32 + r) * 2;
                    const float eb = __builtin_amdgcn_exp2f(Bc[t][i] * LOG2E);
                    const float qv = bf2f(*(const LAS bf16*)(L + GC_QT + off)) * eb * 0.08838834764831845f;
                    const float kv = bf2f(*(const LAS bf16*)(L + GC_KT + off)) * __builtin_amdgcn_rcpf(eb);
                    *(LAS bf16*)(L + GC_QT + off) = cvt1(qv); *(LAS bf16*)(L + GC_KT + off) = cvt1(kv); }
        }
        WG_BAR();
        bf16x8 PA[4][2];
#pragma unroll
        for (int jb = 0; jb < 4; ++jb) {
            if (jb <= ib) {
                f32x16 x = {0.f, 0.f, 0.f, 0.f, 0.f, 0.f, 0.f, 0.f, 0.f, 0.f, 0.f, 0.f, 0.f, 0.f, 0.f, 0.f};
#pragma unroll
                for (int ks = 0; ks < 8; ++ks) x = MFMA32(ld_row(L + GC_KT, GP128, jb * 32, 16 * ks, r, h2), ld_row(L + GC_QT, GP128, ib * 32, 16 * ks, r, h2), x);
                if (jb == ib) {
#pragma unroll
                    for (int i = 0; i < 16; ++i) if (crow(i, h2) > r) x[i] = 0.f; }
                PA[jb][0] = PACK_STEP(x, 0); PA[jb][1] = PACK_STEP(x, 1);
            } else { PA[jb][0] = (bf16x8){0, 0, 0, 0, 0, 0, 0, 0}; PA[jb][1] = (bf16x8){0, 0, 0, 0, 0, 0, 0, 0}; }
        }
        f32x16 o[2][2];
#pragma unroll
        for (int half = 0; half < 2; ++half) {
            if (half == 1) {
                WG_BAR();
                stage_tile<128, 128>(L + GC_SI, GP128, Sg + 128, 256, F.tid);
                stage_tile<128, 128>(L + GC_VI, GP128, Prow0 + G_V + h * 256 + 128, GLA_INP, F.tid);
                WG_BAR();
            }
#pragma unroll
            for (int t = 0; t < 2; ++t) {
                const int eb = 2 * eq + t;
                f32x16 acc = {0.f, 0.f, 0.f, 0.f, 0.f, 0.f, 0.f, 0.f, 0.f, 0.f, 0.f, 0.f, 0.f, 0.f, 0.f, 0.f};
#pragma unroll
                for (int jb = 0; jb < 4; ++jb) if (jb <= ib) {
#pragma unroll
                    for (int s = 0; s < 2; ++s) acc = MFMA32(PA[jb][s], ld_tr_perm(L + GC_VI, GP128, jb * 32 + 16 * s, eb * 32, lane), acc); }
#pragma unroll
                for (int ks = 0; ks < 8; ++ks) acc = MFMA32(ld_row(L + GC_QT, GP128, ib * 32, 16 * ks, r, h2), ld_tr(L + GC_SI, GP128, 16 * ks, eb * 32, lane), acc);
                o[half][t] = acc;
            }
        }
        WG_BAR();
#pragma unroll
        for (int half = 0; half < 2; ++half)
#pragma unroll
            for (int t = 0; t < 2; ++t)
#pragma unroll
                for (int i = 0; i < 16; ++i) *(LAS bf16*)(L + GC_OI + (ib * 32 + crow(i, h2)) * GP256 + (half * 128 + (2 * eq + t) * 32 + r) * 2) = cvt1(o[half][t][i]);
        WG_BAR();
        {
            const int row = F.tid >> 2, qtr = F.tid & 3;
            lcp orow = L + GC_OI + row * GP256 + qtr * 128;
            float sum = 0.f;
#pragma unroll
            for (int c = 0; c < 8; ++c) { const v4u w = *(const LAS v4u*)(orow + c * 16);
#pragma unroll
                for (int i = 0; i < 4; ++i) sum += bflo(w[i]) + bfhi(w[i]); }
            sum += __shfl_xor(sum, 1); sum += __shfl_xor(sum, 2);
            const float mu = sum * (1.0f / 256.0f); float sq = 0.f;
#pragma unroll
            for (int c = 0; c < 8; ++c) { const v4u w = *(const LAS v4u*)(orow + c * 16);
#pragma unroll
                for (int i = 0; i < 4; ++i) { const float d0 = bflo(w[i]) - mu, d1 = bfhi(w[i]) - mu; sq += d0 * d0 + d1 * d1; } }
            sq += __shfl_xor(sq, 1); sq += __shfl_xor(sq, 2);
            const float rstd = 1.0f / sqrtf(sq * (1.0f / 256.0f) + EPS);
            const bf16* gp = Prow0 + (size_t)row * GLA_INP + G_R + h * 256 + qtr * 64;
            bf16* op = CAT + ((size_t)b * SEQ + g * 128 + row) * D + h * 256 + qtr * 64;
#pragma unroll
            for (int c = 0; c < 8; ++c) { const v4u gw = *(const GAS v4u*)(gp + c * 8); const v4u w = *(const LAS v4u*)(orow + c * 16); v4u ow;
#pragma unroll
                for (int i = 0; i < 4; ++i) { const float g0 = bflo(gw[i]), g1 = bfhi(gw[i]);
                    ow[i] = cvtpk((bflo(w[i]) - mu) * rstd * silu_f(g0), (bfhi(w[i]) - mu) * rstd * silu_f(g1)); }
                *(GAS v4u*)(op + c * 8) = ow; asm volatile("" ::: "memory"); }
        }
        WG_BAR();
    }
}

__global__ void __launch_bounds__(NTHREADS, 2) fwd_kernel(Args args) {
    extern __shared__ __attribute__((aligned(16))) unsigned char lds[];
    Frame F;
    F.lds = (LAS unsigned char*)lds;
    F.tid = threadIdx.x; F.lane = F.tid & 63; F.wave = __builtin_amdgcn_readfirstlane(F.tid >> 6); F.G = gridDim.x; F.bid = blockIdx.x;
    for (int u = F.tid; u < (LDS_BYTES - LDSCTL_OFF) / 4; u += NTHREADS) ((LAS unsigned*)(F.lds + LDSCTL_OFF))[u] = 0u;
    __syncthreads();
    if (F.tid < N_PTRS) { const unsigned long long v = (F.tid < 17) ? (unsigned long long)args.in[F.tid] : (F.tid == 17 ? (unsigned long long)args.out : (unsigned long long)args.ws);
        ((LAS unsigned*)(F.lds + PTR_OFF))[2 * F.tid] = (unsigned)v; ((LAS unsigned*)(F.lds + PTR_OFF))[2 * F.tid + 1] = (unsigned)(v >> 32); }
    __syncthreads();
    XcdBarrier bar = xcd_barrier_post((unsigned*)(WSP() + WS_CTL) + CW_BAR, (volatile LAS unsigned*)(F.lds + MISC_OFF) + 8);
#define GRID_BAR() xcd_barrier(bar)
#define XB ((bf16*)(WSP() + WS_XB))
#define ACT ((bf16*)(WSP() + WS_ACT))
#define CAT ((bf16*)(WSP() + WS_CAT))
#define SSP ((float*)(WSP() + WS_SSP))
#define WPTR(off) ((const bf16*)(WSP() + (off)))

#ifdef TEST_MIN
    {
        pg8::Gemm g{XB, WPTR(W_GU0), M, 2 * FF, D}; pg8::StaticOrder S; S.init(M, 2 * FF, F.G, F.bid);
        pg8::EpiSwiGLU E{ACT, FF, SSP};
        pg8::gemm_phase<pg8::EpiSwiGLU, pg8::StaticOrder, true, true>(F.lds + RING_OFF, g, S, E);
        GRID_BAR();
        return;
    }
#endif
    prologue_rows(F);
    convert_weights(F, 0);
    GRID_BAR();
    for (int s = 0; s < 8; ++s) {
        const int l = s >> 1; const bool post = (s & 1) != 0;
        {
            pg8::Gemm g{XB, WPTR(post ? W_GU1 : W_GU0), M, 2 * FF, D}; pg8::StaticOrder S; S.init(M, 2 * FF, F.G, F.bid);
            pg8::EpiSwiGLU E{ACT, FF, SSP};
#ifndef NO_F1
            pg8::gemm_phase<pg8::EpiSwiGLU, pg8::StaticOrder, true, true>(F.lds + RING_OFF, g, S, E);
#endif
        }
        GRID_BAR();
        {
            pg8::Gemm g{ACT, WPTR(post ? W_D1 : W_D0), M, D, FF}; pg8::StaticOrder S; S.init(M, D, F.G, F.bid);
            pg8::EpiResid E{s == 0 ? AP(I_X) : (const float*)OUTP(), OUTP(), XB, SSP, 0.5f};
#ifndef NO_F2
            pg8::gemm_phase<pg8::EpiResid, pg8::StaticOrder, true, true>(F.lds + RING_OFF, g, S, E);
#endif
        }
        GRID_BAR();
        if (!post) {
            const bool odd = (l & 1) != 0; const int nin = odd ? GLA_INP : EVEN_IN;
            {
                pg8::Gemm g{XB, WPTR(W_IN), M, nin, D}; pg8::StaticOrder S; S.init(M, nin, F.G, F.bid);
                pg8::EpiScaleBf16 E{ACT, nin, SSP};
#ifndef NO_M1
                pg8::gemm_phase<pg8::EpiScaleBf16, pg8::StaticOrder, true, true>(F.lds + RING_OFF, g, S, E);
#endif
            }
            GRID_BAR();
#ifndef NO_EVEN
            if (!odd) { even_prep(F); GRID_BAR(); even_core(F); GRID_BAR(); even_post(F); }
#endif
#ifndef NO_GLA
            if (odd) {
#ifndef NO_GA
                gla_phase_a(F, l >> 1);
#endif
                GRID_BAR();
#ifndef NO_GB
                gla_phase_b(F);
#endif
                GRID_BAR();
#ifndef NO_GC
                gla_phase_c(F, l >> 1);
#endif
            }
#endif
            GRID_BAR();
            {
                pg8::Gemm g{CAT, WPTR(W_OUT), M, D, D}; pg8::StaticOrder S; S.init(M, D, F.G, F.bid);
                pg8::EpiResid E{(const float*)OUTP(), OUTP(), XB, SSP, 1.0f};
#ifndef NO_M5
                pg8::gemm_phase<pg8::EpiResid, pg8::StaticOrder, true, true>(F.lds + RING_OFF, g, S, E);
#endif
            }
            GRID_BAR();
        } else if (l + 1 < DEPTH) {
            convert_weights(F, l + 1);
            GRID_BAR();
        }
    }
    final_norm(F);
}

extern "C" void kernel_launch(void* const* d_in, const int* in_sizes, int n_in, void* d_out, int out_size, void* d_ws, size_t ws_size, hipStream_t stream) {
    static int grid = 0;
    if (grid == 0) {
        if (n_in != 17 || in_sizes[0] != M * D || out_size != M * D || ws_size < WS_END) { fprintf(stderr, "kernel_launch: unexpected shapes (n_in %d, in0 %d, out %d, ws %zu)\n", n_in, n_in > 0 ? in_sizes[0] : -1, out_size, ws_size); grid = -1; return; }
        int dev = 0, cus = 0, per_cu = 0;
        if (hipGetDevice(&dev) != hipSuccess || hipDeviceGetAttribute(&cus, hipDeviceAttributeMultiprocessorCount, dev) != hipSuccess) { grid = -1; return; }
        if (hipFuncSetAttribute((const void*)fwd_kernel, hipFuncAttributeMaxDynamicSharedMemorySize, LDS_BYTES) != hipSuccess) { fprintf(stderr, "kernel_launch: hipFuncSetAttribute failed\n"); grid = -1; return; }
        if (hipOccupancyMaxActiveBlocksPerMultiprocessor(&per_cu, (const void*)fwd_kernel, NTHREADS, LDS_BYTES) != hipSuccess || per_cu < 1) { fprintf(stderr, "kernel_launch: occupancy query reports %d\n", per_cu); }
        (void)hipGetLastError();
        grid = cus;
        if (grid != 256) fprintf(stderr, "kernel_launch: %d CUs (expected 256)\n", grid);
    }
    if (grid < 0) return;
    if (hipMemsetAsync((char*)d_ws + WS_CTL, 0, CTL_ZERO_BYTES, stream) != hipSuccess) return;
    Args a{};
    for (int i = 0; i < 17; ++i) a.in[i] = (const float*)d_in[i];
    a.out = (float*)d_out; a.ws = (unsigned char*)d_ws;
    hipLaunchKernelGGL(fwd_kernel, dim3(grid), dim3(NTHREADS), LDS_BYTES, stream, a);
}
```

```cpp
#include <hip/hip_runtime.h>
#include <cstdio>
#include <cstdint>
#include <cmath>
template <int K> __device__ __forceinline__ float xsw(float v) { static_assert(K == 1 || K == 2 || K == 4 || K == 8 || K == 16, "xor mask inside a 32-lane half");
    return __builtin_bit_cast(float, __builtin_amdgcn_ds_swizzle(__builtin_bit_cast(int, v), 0x1F | (K << 10))); }
__device__ __forceinline__ float sum32(float v) { const unsigned u = __builtin_bit_cast(unsigned, v); auto rr = __builtin_amdgcn_permlane32_swap(u, u, false, false); return __builtin_bit_cast(float, (unsigned)rr[0]) + __builtin_bit_cast(float, (unsigned)rr[1]); }
__device__ __forceinline__ float max32(float v) { const unsigned u = __builtin_bit_cast(unsigned, v); auto rr = __builtin_amdgcn_permlane32_swap(u, u, false, false); return fmaxf(__builtin_bit_cast(float, (unsigned)rr[0]), __builtin_bit_cast(float, (unsigned)rr[1])); }
__device__ __forceinline__ float oth32(float v, int h) { const unsigned u = __builtin_bit_cast(unsigned, v); auto rr = __builtin_amdgcn_permlane32_swap(u, u, false, false); return __builtin_bit_cast(float, (unsigned)(h ? rr[0] : rr[1])); }
namespace pg8 {
#define PG8_LAS __attribute__((address_space(3)))
typedef unsigned short bf16_t;
typedef short bf16x8 __attribute__((ext_vector_type(8)));
typedef float f32x4 __attribute__((ext_vector_type(4)));
typedef unsigned u32x4 __attribute__((ext_vector_type(4)));
constexpr int BM = 256, BK = 64, HALF = 128, HTB = HALF * BK * 2  , STAGE_BYTES = 8 * HTB, NXCD = 8, WGM = 8;

__host__ __device__ __forceinline__ int lds_byte(int r, int c) { const int st = (r >> 4) * 2 + (c >> 5), rr = r & 15, cc = c & 31, ob = rr * 64 + cc * 2; return st * 1024 + (ob ^ (((ob >> 9) & 1) << 5)); }
__host__ __device__ __forceinline__ void stage_rc(int b, int& R, int& C) { const int st = b / 1024, sb = b % 1024, swz = sb ^ (((sb >> 9) & 1) << 5); R = (st >> 1) * 16 + swz / 64; C = (st & 1) * 32 + (swz % 64) / 2; }
__host__ __device__ __forceinline__ int perm32(int rho) { const int n = rho >> 4, i = rho & 15; return 8 * (i >> 2) + 4 * n + (i & 3); }

struct Unit { int pm, pn; };
struct Gemm { const bf16_t* A; const bf16_t* Bt; int M, N, K; };

struct StaticOrder {
    int nM, nN, nwg, G, c;
    __host__ __device__ void init(int M, int N, int G_, int c_) { nM = M / BM; nN = N / BM; nwg = nM * nN; G = G_; c = c_; }
    __host__ __device__ bool next(int i, Unit& u) const {
        const long L = (long)i * G + c; if (L >= nwg) return false;
        int wgid = (int)L; { const int q = nwg / NXCD, r = nwg % NXCD, xcd = wgid % NXCD, off = wgid / NXCD; wgid = (xcd < r ? xcd * (q + 1) : r * (q + 1) + (xcd - r) * q) + off; }
        const int nig = WGM * nN, gid = wgid / nig, fm = gid * WGM, gsz = (nM - fm) < WGM ? (nM - fm) : WGM;
        u.pm = fm + ((wgid % nig) % gsz); u.pn = (wgid % nig) / gsz; return true;
    }
    __device__ __forceinline__ void a_ready(const Unit&) const {}
    __device__ __forceinline__ void done(const Unit&) const {}
};

__device__ __forceinline__ unsigned cvt_pk_bf16(float lo, float hi) { unsigned r; asm volatile("v_cvt_pk_bf16_f32 %0, %1, %2" : "=v"(r) : "v"(lo), "v"(hi)); return r; }
constexpr int MROWS = 32768;
constexpr float RMS_EPS = 1e-6f;
__device__ __forceinline__ void row_rstd(float (&rs)[2][4], const float* ssp, const Unit& u, int wr, int fr, int fq) {
#pragma unroll
    for (int ai = 0; ai < 2; ++ai)
#pragma unroll
        for (int m = 0; m < 4; ++m) {
            const int row = u.pm * BM + ai * HALF + wr * 64 + m * 16 + fr;
            const f32x4 p = *(const f32x4*)(ssp + (size_t)row * 16 + 4 * fq);
            float s = (p[0] + p[1]) + (p[2] + p[3]);
            s += xsw<16>(s); s = sum32(s);
            rs[ai][m] = 1.0f / sqrtf(s * (1.0f / 1024.0f) + RMS_EPS);
        }
}
__device__ __forceinline__ float silu_f(float g) { return g * __builtin_amdgcn_rcpf(1.0f + __builtin_amdgcn_exp2f(-1.4426950408889634f * g)); }

struct EpiSwiGLU {
    static constexpr bool PERM = true, AFTER_DRAIN = false;
    bf16_t* H; int ldh; const float* ssp;
    __device__ __forceinline__ void operator()(const f32x4 (&acc)[2][2][4][2], const Unit& u, int wr, int wc, int fr, int fq) const {
        float rs[2][4]; row_rstd(rs, ssp, u, wr, fr, fq);
        const int col0 = u.pn * HALF + wc * 32 + 8 * fq;
#pragma unroll
        for (int ai = 0; ai < 2; ++ai)
#pragma unroll
            for (int m = 0; m < 4; ++m) {
                const int row = u.pm * BM + ai * HALF + wr * 64 + m * 16 + fr; const float r = rs[ai][m];
                float h[8];
#pragma unroll
                for (int n = 0; n < 2; ++n)
#pragma unroll
                    for (int i = 0; i < 4; ++i) { const float g = acc[ai][0][m][n][i] * r, up = acc[ai][1][m][n][i] * r; h[4 * n + i] = silu_f(g) * up; }
                u32x4 w; w.x = cvt_pk_bf16(h[0], h[1]); w.y = cvt_pk_bf16(h[2], h[3]); w.z = cvt_pk_bf16(h[4], h[5]); w.w = cvt_pk_bf16(h[6], h[7]);
                *(u32x4*)(H + (size_t)row * ldh + col0) = w;
                asm volatile("" ::: "memory");
            }
    }
};
struct EpiScaleBf16 {
    static constexpr bool PERM = true, AFTER_DRAIN = false;
    bf16_t* O; int ldc; const float* ssp;
    __device__ __forceinline__ void operator()(const f32x4 (&acc)[2][2][4][2], const Unit& u, int wr, int wc, int fr, int fq) const {
        float rs[2][4]; row_rstd(rs, ssp, u, wr, fr, fq);
        const int col0 = u.pn * BM + wc * 32 + 8 * fq;
#pragma unroll
        for (int ai = 0; ai < 2; ++ai)
#pragma unroll
            for (int m = 0; m < 4; ++m) {
                const int row = u.pm * BM + ai * HALF + wr * 64 + m * 16 + fr; const float r = rs[ai][m];
#pragma unroll
                for (int bj = 0; bj < 2; ++bj) { const f32x4 v0 = acc[ai][bj][m][0] * r, v1 = acc[ai][bj][m][1] * r;
                    u32x4 w; w.x = cvt_pk_bf16(v0[0], v0[1]); w.y = cvt_pk_bf16(v0[2], v0[3]); w.z = cvt_pk_bf16(v1[0], v1[1]); w.w = cvt_pk_bf16(v1[2], v1[3]);
                    *(u32x4*)(O + (size_t)row * ldc + col0 + bj * HALF) = w; }
                asm volatile("" ::: "memory");
            }
    }
};
struct EpiResid {
    static constexpr bool PERM = true, AFTER_DRAIN = false;
    const float* xold; float* xnew; bf16_t* xb; float* ssp; float scale;
    __device__ __forceinline__ void operator()(const f32x4 (&acc)[2][2][4][2], const Unit& u, int wr, int wc, int fr, int fq) const {
        const int col0 = u.pn * BM + wc * 32 + 8 * fq;
#pragma unroll
        for (int ai = 0; ai < 2; ++ai)
#pragma unroll
            for (int m = 0; m < 4; ++m) {
                const int row = u.pm * BM + ai * HALF + wr * 64 + m * 16 + fr; float ss = 0.f;
#pragma unroll
                for (int bj = 0; bj < 2; ++bj) { const size_t off = (size_t)row * 1024 + col0 + bj * HALF;
                    const f32x4 o0 = *(const f32x4*)(xold + off), o1 = *(const f32x4*)(xold + off + 4);
                    const f32x4 v0 = o0 + acc[ai][bj][m][0] * scale, v1 = o1 + acc[ai][bj][m][1] * scale;
                    *(f32x4*)(xnew + off) = v0; *(f32x4*)(xnew + off + 4) = v1;
                    u32x4 w; w.x = cvt_pk_bf16(v0[0], v0[1]); w.y = cvt_pk_bf16(v0[2], v0[3]); w.z = cvt_pk_bf16(v1[0], v1[1]); w.w = cvt_pk_bf16(v1[2], v1[3]);
                    *(u32x4*)(xb + off) = w;
                    ss += (v0[0] * v0[0] + v0[1] * v0[1]) + (v0[2] * v0[2] + v0[3] * v0[3]) + (v1[0] * v1[0] + v1[1] * v1[1]) + (v1[2] * v1[2] + v1[3] * v1[3]); }
                ss += xsw<16>(ss); ss = sum32(ss);
                if (fq == 0) ssp[(size_t)row * 16 + u.pn * 4 + wc] = ss;
                asm volatile("" ::: "memory");
            }
    }
};

template <class Epi, class Sched, bool ALIGN_EPI = false, bool SP2 = false>
__device__ __forceinline__ void gemm_phase(PG8_LAS unsigned char* lds, const Gemm g, const Sched& S, const Epi& E, int wave_in) {
    int tid_ = threadIdx.x; asm volatile("" : "+v"(tid_));
    const int tid = tid_, wid = __builtin_amdgcn_readfirstlane(tid >> 6), lane = tid & 63, wr = wid >> 2, wc = wid & 3, fr = lane & 15, fq = lane >> 4;
    const int K = g.K, nt = K / BK;
    unsigned voffA[2], voffB[2];
#pragma unroll
    for (int i = 0; i < 2; ++i) { int R, C; stage_rc(tid * 16 + i * 8192, R, C); const int Rb = Epi::PERM ? ((R & ~31) + perm32(R & 31)) : R;
        voffA[i] = (unsigned)(R * K + C) * 2u; voffB[i] = (unsigned)(Rb * K + C) * 2u; }
    const size_t kstep = (size_t)(BK * 2);
    const size_t hstep = (size_t)HALF * K * 2;
    const size_t tstep = 2 * hstep;
    const unsigned ldsw = (unsigned)wid * 1024u;
    const int aoff = lds_byte(wr * 64 + fr, fq * 8), boff = lds_byte(wc * 32 + fr, fq * 8);
#define PG8_SA(b, h) (((b) * 2 + (h)) * HTB)
#define PG8_SB(b, h) ((4 + (b) * 2 + (h)) * HTB)
#define PG8_STAGE(bufoff, gbase, voff) do { _Pragma("unroll") for (int _i = 0; _i < 2; ++_i) \
        __builtin_amdgcn_global_load_lds((const unsigned*)((const char*)(gbase) + (voff)[_i]), (PG8_LAS unsigned*)(lds + (bufoff) + ldsw + _i * 8192), 16, 0, 0); } while (0)
#define PG8_LDA(dst, b, h) do { _Pragma("unroll") for (int m = 0; m < 4; ++m) _Pragma("unroll") for (int k = 0; k < 2; ++k) dst[m][k] = *(const PG8_LAS bf16x8*)(lds + PG8_SA(b, h) + aoff + m * 2048 + k * 1024); } while (0)
#define PG8_LDB(dst, b, h) do { _Pragma("unroll") for (int n = 0; n < 2; ++n) _Pragma("unroll") for (int k = 0; k < 2; ++k) dst[n][k] = *(const PG8_LAS bf16x8*)(lds + PG8_SB(b, h) + boff + n * 2048 + k * 1024); } while (0)
#define PG8_MMA(ai, bj, At, Bt) do { __builtin_amdgcn_s_setprio(1); _Pragma("unroll") for (int m = 0; m < 4; ++m) _Pragma("unroll") for (int n = 0; n < 2; ++n) _Pragma("unroll") for (int k = 0; k < 2; ++k) \
        acc[ai][bj][m][n] = __builtin_amdgcn_mfma_f32_16x16x32_bf16(Bt[n][k], At[m][k], acc[ai][bj][m][n], 0, 0, 0); __builtin_amdgcn_s_setprio(0); } while (0)
#define PG8_WAIT_V(n) asm volatile("s_waitcnt vmcnt(" #n ")" ::: "memory")
#define PG8_WAIT_L(n) asm volatile("s_waitcnt lgkmcnt(" #n ")" ::: "memory")
#define PG8_BAR __builtin_amdgcn_s_barrier()
#define PG8_SCHED __builtin_amdgcn_sched_barrier(0)
    Unit cur, nxt; int ui = 0;
    if (!S.next(0, cur)) return;
    f32x4 acc[2][2][4][2];
#pragma unroll
    for (int a = 0; a < 2; ++a)
#pragma unroll
        for (int b = 0; b < 2; ++b)
#pragma unroll
            for (int m = 0; m < 4; ++m)
#pragma unroll
                for (int n = 0; n < 2; ++n) acc[a][b][m][n] = (f32x4){0.f, 0.f, 0.f, 0.f};
    bf16x8 At[4][2], B0[2][2], B1[2][2];
    const char* cA = (const char*)g.A + (size_t)cur.pm * tstep; const char* cB = (const char*)g.Bt + (size_t)cur.pn * tstep;
    S.a_ready(cur);
    if constexpr (SP2) {
        PG8_STAGE(PG8_SB(0, 0), cB, voffB); PG8_STAGE(PG8_SB(0, 1), cB + hstep, voffB); PG8_STAGE(PG8_SA(0, 0), cA, voffA); PG8_STAGE(PG8_SA(0, 1), cA + hstep, voffA);
        if (wr == 1) PG8_BAR;
        PG8_WAIT_V(2); PG8_BAR;
        PG8_STAGE(PG8_SB(1, 0), cB + kstep, voffB); PG8_STAGE(PG8_SA(1, 0), cA + kstep, voffA); PG8_STAGE(PG8_SB(1, 1), cB + hstep + kstep, voffB);
        PG8_WAIT_V(6); PG8_BAR;
    } else {
        PG8_STAGE(PG8_SB(0, 0), cB, voffB); PG8_STAGE(PG8_SA(0, 0), cA, voffA); PG8_STAGE(PG8_SB(0, 1), cB + hstep, voffB); PG8_STAGE(PG8_SA(0, 1), cA + hstep, voffA);
        if (wr == 1) PG8_BAR;
        PG8_WAIT_V(4); PG8_BAR;
        PG8_STAGE(PG8_SB(1, 0), cB + kstep, voffB); PG8_STAGE(PG8_SA(1, 0), cA + kstep, voffA); PG8_STAGE(PG8_SB(1, 1), cB + hstep + kstep, voffB);
        PG8_WAIT_V(6); PG8_BAR;
    }
    for (;;) {
        const bool has_next = S.next(ui + 1, nxt);
        const char* nA = has_next ? (const char*)g.A + (size_t)nxt.pm * tstep : cA; const char* nB = has_next ? (const char*)g.Bt + (size_t)nxt.pn * tstep : cB;
        for (int t = 0; t < nt; t += 2) {
            const bool last = (t == nt - 2);
            const char* a1 = cA + (size_t)(t + 1) * kstep;
            const char* a2 = last ? nA : cA + (size_t)(t + 2) * kstep; const char* b2 = last ? nB : cB + (size_t)(t + 2) * kstep;
            const char* a3 = a2 + kstep; const char* b3 = b2 + kstep;
            if (last && has_next) S.a_ready(nxt);
            if constexpr (SP2) {
            PG8_LDB(B0, 0, 0); PG8_LDB(B1, 0, 1); PG8_SCHED; PG8_LDA(At, 0, 0); PG8_STAGE(PG8_SA(1, 1), a1 + hstep, voffA);
            PG8_WAIT_V(8); PG8_WAIT_L(0); PG8_BAR; PG8_MMA(0, 0, At, B0); PG8_MMA(0, 1, At, B1); PG8_BAR; PG8_SCHED;
            PG8_LDA(At, 0, 1); PG8_STAGE(PG8_SB(0, 0), b2, voffB); PG8_STAGE(PG8_SB(0, 1), b2 + hstep, voffB); PG8_STAGE(PG8_SA(0, 0), a2, voffA);
            PG8_WAIT_V(8); PG8_WAIT_L(0); PG8_BAR; PG8_MMA(1, 0, At, B0); PG8_MMA(1, 1, At, B1); PG8_BAR; PG8_SCHED;
            PG8_LDB(B0, 1, 0); PG8_LDB(B1, 1, 1); PG8_SCHED; PG8_LDA(At, 1, 0); PG8_STAGE(PG8_SA(0, 1), a2 + hstep, voffA);
            PG8_WAIT_V(8); PG8_WAIT_L(0); PG8_BAR; PG8_MMA(0, 0, At, B0); PG8_MMA(0, 1, At, B1); PG8_BAR; PG8_SCHED;
            PG8_LDA(At, 1, 1); PG8_STAGE(PG8_SB(1, 0), b3, voffB); PG8_STAGE(PG8_SB(1, 1), b3 + hstep, voffB); PG8_STAGE(PG8_SA(1, 0), a3, voffA);
            PG8_WAIT_V(8); PG8_WAIT_L(0); PG8_BAR; PG8_MMA(1, 0, At, B0); PG8_MMA(1, 1, At, B1); PG8_BAR; PG8_SCHED;
            } else {
            PG8_LDB(B0, 0, 0); PG8_SCHED; PG8_LDA(At, 0, 0); PG8_STAGE(PG8_SA(1, 1), a1 + hstep, voffA);
            PG8_WAIT_L(8); PG8_BAR; PG8_WAIT_L(0); PG8_MMA(0, 0, At, B0); PG8_BAR; PG8_SCHED;
            PG8_LDB(B1, 0, 1); PG8_STAGE(PG8_SB(0, 0), b2, voffB);
            PG8_BAR; PG8_WAIT_L(0); PG8_MMA(0, 1, At, B1); PG8_BAR;
            PG8_LDA(At, 0, 1); PG8_STAGE(PG8_SA(0, 0), a2, voffA);
            PG8_BAR; PG8_WAIT_L(0); PG8_MMA(1, 0, At, B0); PG8_BAR; PG8_SCHED;
            PG8_STAGE(PG8_SB(0, 1), b2 + hstep, voffB);
            PG8_WAIT_V(6); PG8_BAR; PG8_MMA(1, 1, At, B1); PG8_BAR;
            PG8_LDB(B0, 1, 0); PG8_SCHED; PG8_LDA(At, 1, 0); PG8_STAGE(PG8_SA(0, 1), a2 + hstep, voffA);
            PG8_WAIT_L(8); PG8_BAR; PG8_WAIT_L(0); PG8_MMA(0, 0, At, B0); PG8_BAR; PG8_SCHED;
            PG8_LDB(B1, 1, 1); PG8_STAGE(PG8_SB(1, 0), b3, voffB);
            PG8_BAR; PG8_WAIT_L(0); PG8_MMA(0, 1, At, B1); PG8_BAR;
            PG8_LDA(At, 1, 1); PG8_STAGE(PG8_SA(1, 0), a3, voffA);
            PG8_BAR; PG8_WAIT_L(0); PG8_MMA(1, 0, At, B0); PG8_BAR; PG8_SCHED;
            PG8_STAGE(PG8_SB(1, 1), b3 + hstep, voffB);
            PG8_WAIT_V(6); PG8_BAR; PG8_MMA(1, 1, At, B1); PG8_BAR;
            }
        }
        if constexpr (ALIGN_EPI) { if (wr == 0) PG8_BAR; }
        if constexpr (!Epi::AFTER_DRAIN) { E(acc, cur, wr, wc, fr, fq); S.done(cur); }
        if (!has_next) break;
#pragma unroll
        for (int a = 0; a < 2; ++a)
#pragma unroll
            for (int b = 0; b < 2; ++b)
#pragma unroll
                for (int m = 0; m < 4; ++m)
#pragma unroll
                    for (int n = 0; n < 2; ++n) acc[a][b][m][n] = (f32x4){0.f, 0.f, 0.f, 0.f};
        cur = nxt; cA = nA; cB = nB; ++ui;
        if constexpr (ALIGN_EPI) { if (wr == 1) PG8_BAR; }
    }
    PG8_WAIT_V(0);
    if constexpr (!ALIGN_EPI) { if (wr == 0) PG8_BAR; }
    PG8_BAR;
    if constexpr (Epi::AFTER_DRAIN) { E.fused(acc, cur, wr, wc, fr, fq, lds, wid, lane); S.done(cur); }
#undef PG8_SA
#undef PG8_SB
#undef PG8_STAGE
#undef PG8_LDA
#undef PG8_LDB
#undef PG8_MMA
#undef PG8_WAIT_V
#undef PG8_WAIT_L
#undef PG8_BAR
#undef PG8_SCHED
}
}

constexpr int NWAVES = 8, NTHREADS = NWAVES * 64;
constexpr int BATCH = 8, SEQ = 4096, D = 1024, M = BATCH * SEQ, FF = 2816, DEPTH = 4;
constexpr int EVEN_IN = 3584, GLA_IN = 3088, GLA_INP = 3328;
static_assert(M == pg8::MROWS, "row count");
constexpr int E_RQ = 0, E_RK = 512, E_RV = 1024, E_RG = 1536, E_DQ = 2048, E_DK = 2560, E_DV = 3072;
constexpr int G_Q = 0, G_K = 512, G_V = 1024, G_R = 2048, G_A = 3072;
constexpr float EPS = 1e-6f;

constexpr size_t MiB = 1u << 20;
constexpr size_t WS_CTL = 0, CTL_ZERO_BYTES = 1 * MiB;
constexpr size_t WS_SSP = 1 * MiB;
constexpr size_t WS_TAB = 3 * MiB;
constexpr size_t TAB_RC = WS_TAB, TAB_RS = WS_TAB + 1 * MiB, TAB_DC = WS_TAB + 2 * MiB, TAB_DS = WS_TAB + 2 * MiB + 128 * 1024;
constexpr size_t WS_W = 8 * MiB;
constexpr size_t W_GU0 = WS_W, W_D0 = W_GU0 + (size_t)2 * FF * D * 2, W_GU1 = W_D0 + (size_t)D * FF * 2, W_D1 = W_GU1 + (size_t)2 * FF * D * 2,
                 W_IN = W_D1 + (size_t)D * FF * 2, W_OUT = W_IN + (size_t)EVEN_IN * D * 2, W_END = W_OUT + (size_t)D * D * 2;
constexpr size_t WS_XB = 56 * MiB;
constexpr size_t WS_ACT = 120 * MiB;
constexpr size_t WS_CAT = 344 * MiB;
constexpr size_t WS_END = 408 * MiB;
static_assert(W_END <= WS_XB && WS_XB + (size_t)M * D * 2 <= WS_ACT && WS_ACT + (size_t)M * EVEN_IN * 2 <= WS_CAT && WS_CAT + (size_t)M * D * 2 <= WS_END, "d_ws map");
constexpr int CW_BAR = 4096;

constexpr int RING_OFF = 0, RING_BYTES = 131072;
constexpr int LDSCTL_OFF = 161792, MISC_OFF = LDSCTL_OFF + 320, PTR_OFF = LDSCTL_OFF + 1024;
constexpr int LDS_BYTES = 163840;
static_assert(PTR_OFF + 19 * 8 <= LDS_BYTES && RING_BYTES <= LDSCTL_OFF, "LDS map");

#define GAS __attribute__((address_space(1)))
#define LAS __attribute__((address_space(3)))
typedef unsigned short bf16;
typedef unsigned v4u __attribute__((ext_vector_type(4)));
typedef float f32x4 __attribute__((ext_vector_type(4)));
typedef short bf16x8 __attribute__((ext_vector_type(8)));
typedef GAS unsigned gu32;
typedef GAS unsigned long long gu64;
#define RLX_AGENT __ATOMIC_RELAXED, __HIP_MEMORY_SCOPE_AGENT
#define LDS_WAIT() asm volatile("s_waitcnt lgkmcnt(0)" ::: "memory")
#define VM_WAIT() asm volatile("s_waitcnt vmcnt(0)" ::: "memory")
__device__ __forceinline__ unsigned long long rt() { return __builtin_amdgcn_s_memrealtime(); }
__device__ __forceinline__ unsigned f2bf(float f) { unsigned u = __builtin_bit_cast(unsigned, f); return (u + 0x7fffu + ((u >> 16) & 1u)) >> 16; }
__device__ __forceinline__ unsigned pk2(float lo, float hi) { return f2bf(lo) | (f2bf(hi) << 16); }

#define XB_TMO      128
#define XB_XCNT(j)  (256  + 64 * (j))
#define XB_XSUB(j)  (1280 + 64 * (j))
#define XB_XGEN(j)  (2304 + 64 * (j))
#define XB_TOP      3328
#define XB_TOPGEN   3392
#define XCD_BAR_WORDS 3456
#define XB_SPIN_CAP (1u << 18)

__device__ __forceinline__ unsigned xb_ld(unsigned* p)              { return __hip_atomic_load(p, __ATOMIC_RELAXED, __HIP_MEMORY_SCOPE_AGENT); }
__device__ __forceinline__ unsigned xb_add(unsigned* p, unsigned v) { return __hip_atomic_fetch_add(p, v, __ATOMIC_RELAXED, __HIP_MEMORY_SCOPE_AGENT); }
__device__ __forceinline__ unsigned xb_xcc_id() { return (unsigned)__builtin_amdgcn_s_getreg((3 << 11) | 20) & 0xFu; }
#define XB_SPIN(cond, bar) do { unsigned _sp = 0; while (cond) { __builtin_amdgcn_s_sleep(1); \
    if ((++_sp & 255u) == 0u) { if (xb_ld(&(bar)[XB_TMO])) break; if (_sp > XB_SPIN_CAP) { atomicAdd(&(bar)[XB_TMO], 1u); break; } } } } while (0)

struct XcdBarrier {
    unsigned* bar; unsigned x;
    volatile LAS unsigned* st;
};

__device__ __forceinline__ XcdBarrier xcd_barrier_post(unsigned* bar, volatile LAS unsigned* st, int tid) {
    XcdBarrier b; b.bar = bar; b.x = xb_xcc_id(); b.st = st;
    if (tid == 0) (void)xb_add(&bar[XB_XCNT(b.x)], 1u);
    return b;
}
__device__ __forceinline__ void xcd_barrier_complete(unsigned* bar, unsigned x, unsigned& nloc, unsigned& nx) {
    const unsigned G = gridDim.x * gridDim.y * gridDim.z;
    unsigned sum, cnt, mine, sp = 0u;
    for (;;) {
        sum = 0u; cnt = 0u; mine = 0u;
#pragma unroll
        for (unsigned j = 0; j < 16; ++j) { const unsigned c = xb_ld(&bar[XB_XCNT(j)]); sum += c; cnt += (c > 0u) ? 1u : 0u; mine = (j == x) ? c : mine; }
        if (sum == G) break;
        __builtin_amdgcn_s_sleep(1);
        if ((++sp & 255u) == 0u) { if (xb_ld(&bar[XB_TMO])) break; if (sp > XB_SPIN_CAP) { atomicAdd(&bar[XB_TMO], 1u); break; } }
    }
    nloc = mine > 0u ? mine : 1u; nx = cnt > 0u ? cnt : 1u;
}

__device__ __forceinline__ void xcd_barrier(const XcdBarrier& b, int tid) {
    asm volatile("s_waitcnt vmcnt(0)" ::: "memory");
    __syncthreads();
    if (tid == 0) {
        unsigned* bar = b.bar;
        __builtin_amdgcn_s_waitcnt(0);
        unsigned nloc = b.st[0], nx = b.st[1];
        if (nloc == 0u) { xcd_barrier_complete(bar, b.x, nloc, nx); b.st[0] = nloc; b.st[1] = nx; }
        const unsigned old = xb_add(&bar[XB_XSUB(b.x)], 1u);
        const unsigned gen = old / nloc;
        if (old + 1u == (gen + 1u) * nloc) {
            __builtin_amdgcn_fence(__ATOMIC_RELEASE, "agent");
            asm volatile("s_waitcnt vmcnt(0)" ::: "memory");
            const unsigned og = xb_add(&bar[XB_TOP], 1u);
            const unsigned tg = og / nx;
            if (og + 1u == (tg + 1u) * nx) xb_add(&bar[XB_TOPGEN], 1u);
            else XB_SPIN(xb_ld(&bar[XB_TOPGEN]) == tg, bar);
            __builtin_amdgcn_fence(__ATOMIC_ACQUIRE, "agent");
            xb_add(&bar[XB_XGEN(b.x)], 1u);
            asm volatile("s_waitcnt vmcnt(0)" ::: "memory");
        } else {
            XB_SPIN(xb_ld(&bar[XB_XGEN(b.x)]) == gen, bar);
            __builtin_amdgcn_fence(__ATOMIC_ACQUIRE, "agent");
            asm volatile("s_waitcnt vmcnt(0)" ::: "memory");
        }
    }
    __syncthreads();
}

__constant__ float RET_FREQ[64] = {1.000000000e+00f, 8.639884591e-01f, 7.464760542e-01f, 6.449466944e-01f, 5.572264791e-01f, 4.814372361e-01f, 4.159561992e-01f, 3.593813777e-01f, 3.105013371e-01f, 2.682695687e-01f, 2.317818105e-01f, 2.002568096e-01f, 1.730195731e-01f, 1.494869143e-01f, 1.291549653e-01f, 1.115883961e-01f, 9.641107172e-02f, 8.329805732e-02f, 7.196855545e-02f, 6.218000501e-02f, 5.372280627e-02f, 4.641588405e-02f, 4.010278732e-02f, 3.464834765e-02f, 2.993577160e-02f, 2.586415969e-02f, 2.234633639e-02f, 1.930697635e-02f, 1.668100432e-02f, 1.441219542e-02f, 1.245197095e-02f, 1.075835899e-02f, 9.295095690e-03f, 8.030855097e-03f, 6.938565988e-03f, 5.994840991e-03f, 5.179473665e-03f, 4.475005437e-03f, 3.866352839e-03f, 3.340484342e-03f, 2.886139788e-03f, 2.493591513e-03f, 2.154434333e-03f, 1.861406374e-03f, 1.608233666e-03f, 1.389495330e-03f, 1.200507861e-03f, 1.037224894e-03f, 8.961503627e-04f, 7.742635789e-04f, 6.689548027e-04f, 5.779692437e-04f, 4.993587499e-04f, 4.314401885e-04f, 3.727593285e-04f, 3.220597573e-04f, 2.782559313e-04f, 2.404099068e-04f, 2.077113895e-04f, 1.794602431e-04f, 1.550515735e-04f, 1.339627634e-04f, 1.157422885e-04f, 9.999999747e-05f};
__constant__ float ROPE_FREQ[8] = {1.000000000e+00f, 1.939227432e-01f, 3.760603070e-02f, 7.292664610e-03f, 1.414213562e-03f, 2.742481884e-04f, 5.318295734e-05f, 1.031338525e-05f};
struct Args { const float* in[17]; float* out; unsigned char* ws; };
enum { I_X = 0, I_PRE_NORM = 1, I_PRE_WG = 2, I_PRE_WU = 3, I_PRE_WD = 4, I_MIX_NORM = 5, I_AB_IN = 6, I_AB_OUT = 7, I_GLA_IN = 8, I_GLA_A2 = 9, I_GLA_BA = 10, I_GLA_OUT = 11,
       I_POST_NORM = 12, I_POST_WG = 13, I_POST_WU = 14, I_POST_WD = 15, I_FINAL = 16, I_OUT = 17, I_WS = 18, N_PTRS = 19 };
struct Frame {
    LAS unsigned char* lds;
    int tid, lane, wave, G, bid;
};
__device__ __forceinline__ unsigned char* tabp(const Frame& F, int idx) {
    int off_ = PTR_OFF + 8 * idx; asm volatile("" : "+s"(off_));
    const volatile LAS unsigned* T = (const volatile LAS unsigned*)(F.lds + off_);
    const unsigned lo = __builtin_amdgcn_readfirstlane(T[0]), hi = __builtin_amdgcn_readfirstlane(T[1]);
    return (unsigned char*)(((unsigned long long)hi << 32) | (unsigned long long)lo);
}
#define AP(idx) ((const float*)tabp(F, idx))
#define WSP() tabp(F, I_WS)
#define OUTP() ((float*)tabp(F, I_OUT))
__device__ __forceinline__ int hw_lane() { return (int)__builtin_amdgcn_mbcnt_hi(~0u, __builtin_amdgcn_mbcnt_lo(~0u, 0u)); }
__device__ __forceinline__ Frame relaunder(const Frame& F0) { Frame F = F0; int t_ = threadIdx.x; asm volatile("" : "+v"(t_)); asm volatile("" : "+s"(F.bid)); F.tid = t_; F.lane = F.tid & 63; F.wave = __builtin_amdgcn_readfirstlane(F.tid >> 6);
    unsigned lb_ = 0u; asm volatile("" : "+s"(lb_)); F.lds = F0.lds + lb_; return F; }
__device__ __forceinline__ float wave_sum(float v) {
    v += xsw<1>(v); v += xsw<2>(v); v += xsw<4>(v); v += xsw<8>(v); v += xsw<16>(v);
    return sum32(v);
}
__device__ __forceinline__ float bf2f(bf16 h) { return __builtin_bit_cast(float, (unsigned)h << 16); }
__device__ __forceinline__ float bflo(unsigned w) { return __builtin_bit_cast(float, w << 16); }
__device__ __forceinline__ float bfhi(unsigned w) { return __builtin_bit_cast(float, w & 0xffff0000u); }
__device__ __forceinline__ bf16 f2bf_rne(float f) { return (bf16)f2bf(f); }

__device__ __forceinline__ void tr_item(const float* W, int K, int N, int Npad, const float* gain, bf16* WT, int gu, LAS float* scr, int item, int lane) {
    const int nblk = Npad / 32, kb = item / nblk, nb = item % nblk, k0 = 64 * kb, n0 = 32 * nb;
    const int nn = n0 + (lane & 31); const bool ok = nn < N;
#pragma unroll 8
    for (int i = 0; i < 32; ++i) { const int kk = 2 * i + (lane >> 5); float w = ok ? W[(size_t)(k0 + kk) * N + nn] : 0.f; if (gain) w *= gain[k0 + kk]; scr[kk * 33 + (lane & 31)] = w; }
    LDS_WAIT(); asm volatile("" ::: "memory");
    const int c = lane & 7;
#pragma unroll
    for (int j = 0; j < 4; ++j) { const int n = (lane >> 3) + 8 * j; const LAS float* s = scr + (8 * c) * 33 + n;
        v4u o; o.x = pk2(s[0 * 33], s[1 * 33]); o.y = pk2(s[2 * 33], s[3 * 33]); o.z = pk2(s[4 * 33], s[5 * 33]); o.w = pk2(s[6 * 33], s[7 * 33]);
        int drow = n0 + n; if (gu) drow = (drow >> 7) * 256 + (drow & 127) + (gu == 2 ? 128 : 0);
        *(GAS v4u*)(WT + (size_t)drow * K + k0 + 8 * c) = o; }
    LDS_WAIT(); asm volatile("" ::: "memory");
}
__device__ __forceinline__ void convert_weights(const Frame& F0, int l) {
    const Frame F = relaunder(F0);
    LAS float* scr = (LAS float*)(F.lds + RING_OFF + F.wave * 16384);
    const int gw = F.bid * NWAVES + F.wave, NGW = F.G * NWAVES;
    unsigned char* ws = WSP();
    constexpr int I_G = (D / 64) * (FF / 32), I_DN = (FF / 64) * (D / 32), I_O = (D / 64) * (D / 32);
    const bool odd = (l & 1) != 0; const int li = l >> 1;
    const int nin = odd ? GLA_IN : EVEN_IN, ninp = odd ? GLA_INP : EVEN_IN; const int I_IN = (D / 64) * (ninp / 32);
    const float* win = odd ? AP(I_GLA_IN) + (size_t)li * D * GLA_IN : AP(I_AB_IN) + (size_t)li * D * EVEN_IN;
    const float* wout = odd ? AP(I_GLA_OUT) + (size_t)li * D * D : AP(I_AB_OUT) + (size_t)li * D * D;
    const size_t fo = (size_t)l * D * FF;
    const int NITEMS = 6 * I_G + I_IN + I_O;
    static_assert(I_G == I_DN, "item counts");
    for (int it = gw; it < NITEMS; it += NGW) {
        int r = it;
        if (r < I_G) { tr_item(AP(I_PRE_WG) + fo, D, FF, FF, AP(I_PRE_NORM) + l * D, (bf16*)(ws + W_GU0), 1, scr, r, F.lane); continue; } r -= I_G;
        if (r < I_G) { tr_item(AP(I_PRE_WU) + fo, D, FF, FF, AP(I_PRE_NORM) + l * D, (bf16*)(ws + W_GU0), 2, scr, r, F.lane); continue; } r -= I_G;
        if (r < I_G) { tr_item(AP(I_PRE_WD) + fo, FF, D, D, nullptr, (bf16*)(ws + W_D0), 0, scr, r, F.lane); continue; } r -= I_G;
        if (r < I_G) { tr_item(AP(I_POST_WG) + fo, D, FF, FF, AP(I_POST_NORM) + l * D, (bf16*)(ws + W_GU1), 1, scr, r, F.lane); continue; } r -= I_G;
        if (r < I_G) { tr_item(AP(I_POST_WU) + fo, D, FF, FF, AP(I_POST_NORM) + l * D, (bf16*)(ws + W_GU1), 2, scr, r, F.lane); continue; } r -= I_G;
        if (r < I_G) { tr_item(AP(I_POST_WD) + fo, FF, D, D, nullptr, (bf16*)(ws + W_D1), 0, scr, r, F.lane); continue; } r -= I_G;
        if (r < I_IN) { tr_item(win, D, nin, ninp, AP(I_MIX_NORM) + l * D, (bf16*)(ws + W_IN), 0, scr, r, F.lane); continue; } r -= I_IN;
        tr_item(wout, D, D, D, nullptr, (bf16*)(ws + W_OUT), 0, scr, r, F.lane);
    }
}
__device__ __forceinline__ void prologue_rows(const Frame& F0) {
    const Frame F = relaunder(F0);
    unsigned char* ws = WSP();
    const int gw = F.bid * NWAVES + F.wave, NGW = F.G * NWAVES;
    bf16* XB = (bf16*)(ws + WS_XB); float* ssp = (float*)(ws + WS_SSP);
    for (int m = gw; m < M; m += NGW) {
        const GAS f32x4* xr = (const GAS f32x4*)(AP(I_X) + (size_t)m * D) + F.lane;
        GAS unsigned long long* o8 = (GAS unsigned long long*)(XB + (size_t)m * D) + F.lane;
        float s = 0.f;
#pragma unroll
        for (int j = 0; j < 4; ++j) { const f32x4 v = xr[64 * j]; s += (v.x * v.x + v.y * v.y) + (v.z * v.z + v.w * v.w);
            o8[64 * j] = (unsigned long long)pk2(v.x, v.y) | ((unsigned long long)pk2(v.z, v.w) << 32); }
        s = wave_sum(s);
        if (F.lane < 16) ssp[(size_t)m * 16 + F.lane] = (F.lane == 0) ? s : 0.f;
    }
    const int gt = F.bid * NTHREADS + F.tid, NGT = F.G * NTHREADS;
    float* rc = (float*)(ws + TAB_RC); float* rsn = (float*)(ws + TAB_RS); float* dc = (float*)(ws + TAB_DC); float* ds = (float*)(ws + TAB_DS);
    for (int e = gt; e < SEQ * 64; e += NGT) { const int t = e >> 6, i = e & 63; const float ang = (float)t * RET_FREQ[i];
        double rev = (double)ang * 0.15915494309189535; rev -= __builtin_rint(rev); const float r = (float)rev;
        rc[e] = __builtin_amdgcn_cosf(r); rsn[e] = __builtin_amdgcn_sinf(r); }
    for (int e = gt; e < SEQ * 8; e += NGT) { const int t = e >> 3, i = e & 7; const float ang = (float)t * ROPE_FREQ[i];
        double rev = (double)ang * 0.15915494309189535; rev -= __builtin_rint(rev); const float r = (float)rev;
        dc[e] = __builtin_amdgcn_cosf(r); ds[e] = __builtin_amdgcn_sinf(r); }
}

__device__ __forceinline__ void even_prep(const Frame& F0) {
    const Frame F = relaunder(F0);
    unsigned char* ws = WSP();
    const int gw = F.bid * NWAVES + F.wave, NGW = F.G * NWAVES;
    bf16* P = (bf16*)(ws + WS_ACT);
    const float* rc = (const float*)(ws + TAB_RC); const float* rsn = (const float*)(ws + TAB_RS); const float* dc = (const float*)(ws + TAB_DC); const float* ds = (const float*)(ws + TAB_DS);
    for (int m = gw; m < M; m += NGW) {
        const int pos = m & (SEQ - 1); bf16* row = P + (size_t)m * EVEN_IN;
        const float c = rc[pos * 64 + F.lane], s = rsn[pos * 64 + F.lane];
#pragma unroll
        for (int h = 0; h < 4; ++h) {
            { bf16* p1 = row + E_RQ + h * 128 + F.lane; bf16* p2 = p1 + 64; const float x1 = bf2f(*p1), x2 = bf2f(*p2); *p1 = f2bf_rne(x1 * c - x2 * s); *p2 = f2bf_rne(x2 * c + x1 * s); }
            { bf16* p1 = row + E_RK + h * 128 + F.lane; bf16* p2 = p1 + 64; const float x1 = bf2f(*p1), x2 = bf2f(*p2);
              *p1 = f2bf_rne((x1 * c - x2 * s) * 0.08838834764831845f); *p2 = f2bf_rne((x2 * c + x1 * s) * 0.08838834764831845f); }
        }
        { const int h = F.lane >> 3, i = F.lane & 7; const float c2 = dc[pos * 8 + i], s2 = ds[pos * 8 + i];
          { bf16* p1 = row + E_DQ + h * 64 + i; bf16* p2 = p1 + 8; const float x1 = bf2f(*p1), x2 = bf2f(*p2); *p1 = f2bf_rne(x1 * c2 - x2 * s2); *p2 = f2bf_rne(x2 * c2 + x1 * s2); }
          { bf16* p1 = row + E_DK + h * 64 + i; bf16* p2 = p1 + 8; const float x1 = bf2f(*p1), x2 = bf2f(*p2); *p1 = f2bf_rne(x1 * c2 - x2 * s2); *p2 = f2bf_rne(x2 * c2 + x1 * s2); } }
    }
}
__device__ __forceinline__ void even_core(const Frame& F0) {
    const Frame F = relaunder(F0);
    unsigned char* ws = WSP();
    const bf16* P = (const bf16*)(ws + WS_ACT);
    if (F.bid < 128) {
        const int b = F.bid >> 4, h = (F.bid >> 2) & 3, eg = F.bid & 3, e = eg * 32 + (F.tid >> 4), dq = F.tid & 15;
        const float g = 1.0f - exp2f(-5.0f - (float)h);
        float* oraw = (float*)(ws + WS_XB);
        const bf16* base = P + (size_t)b * SEQ * EVEN_IN;
        float S[8];
#pragma unroll
        for (int i = 0; i < 8; ++i) S[i] = 0.f;
        v4u qn = *(const GAS v4u*)(base + E_RQ + h * 128 + dq * 8), kn = *(const GAS v4u*)(base + E_RK + h * 128 + dq * 8); bf16 vn = base[E_RV + h * 128 + e];
        for (int t = 0; t < SEQ; ++t) {
            const v4u q = qn, k = kn; const float v = bf2f(vn);
            if (t + 1 < SEQ) { const bf16* nb = base + (size_t)(t + 1) * EVEN_IN; qn = *(const GAS v4u*)(nb + E_RQ + h * 128 + dq * 8); kn = *(const GAS v4u*)(nb + E_RK + h * 128 + dq * 8); vn = nb[E_RV + h * 128 + e]; }
            float o = 0.f;
#pragma unroll
            for (int i = 0; i < 4; ++i) { const unsigned qw = q[i], kw = k[i];
                S[2 * i] = g * S[2 * i] + bflo(kw) * v; S[2 * i + 1] = g * S[2 * i + 1] + bfhi(kw) * v;
                o += bflo(qw) * S[2 * i]; o += bfhi(qw) * S[2 * i + 1]; }
            o += xsw<1>(o); o += xsw<2>(o); o += xsw<4>(o); o += xsw<8>(o);
            if (dq == 0) oraw[((size_t)b * SEQ + t) * 512 + h * 128 + e] = o;
        }
    } else {
        bf16* CAT = (bf16*)(ws + WS_CAT);
        for (int it = F.bid - 128; it < BATCH * (SEQ / 64); it += F.G - 128) {
            const int b = it >> 6, t = (it & 63) * 64 + F.lane, h = F.wave;
            const bf16* base = P + (size_t)b * SEQ * EVEN_IN;
            float q[64];
            { const GAS v4u* qp = (const GAS v4u*)(base + (size_t)t * EVEN_IN + E_DQ + h * 64);
#pragma unroll
              for (int j = 0; j < 8; ++j) { const v4u w = qp[j];
#pragma unroll
                  for (int i = 0; i < 4; ++i) { q[8 * j + 2 * i] = bflo(w[i]) * (0.125f * 1.4426950408889634f); q[8 * j + 2 * i + 1] = bfhi(w[i]) * (0.125f * 1.4426950408889634f); } } }
            float o[64];
#pragma unroll
            for (int i = 0; i < 64; ++i) o[i] = 0.f;
            float mx = -INFINITY, l = 0.f;
            for (int p = 0; p < 3; ++p) {
                const int dil = (p == 0) ? 1 : (p == 1) ? 4 : 16;
                for (int j = 0; j <= 128; ++j) {
                    const int tk = t - j * dil;
                    if (tk >= 0) {
                        const GAS v4u* kp = (const GAS v4u*)(base + (size_t)tk * EVEN_IN + E_DK + h * 64);
                        const GAS v4u* vp = (const GAS v4u*)(base + (size_t)tk * EVEN_IN + E_DV + h * 64);
                        float s = 0.f;
#pragma unroll
                        for (int jj = 0; jj < 8; ++jj) { const v4u w = kp[jj];
#pragma unroll
                            for (int i = 0; i < 4; ++i) { s += q[8 * jj + 2 * i] * bflo(w[i]); s += q[8 * jj + 2 * i + 1] * bfhi(w[i]); } }
                        const float mn = fmaxf(mx, s), corr = __builtin_amdgcn_exp2f(mx - mn), pe = __builtin_amdgcn_exp2f(s - mn);
                        l = l * corr + pe; mx = mn;
#pragma unroll
                        for (int jj = 0; jj < 8; ++jj) { const v4u w = vp[jj];
#pragma unroll
                            for (int i = 0; i < 4; ++i) { o[8 * jj + 2 * i] = o[8 * jj + 2 * i] * corr + pe * bflo(w[i]); o[8 * jj + 2 * i + 1] = o[8 * jj + 2 * i + 1] * corr + pe * bfhi(w[i]); } }
                    }
                }
            }
            const float rl = 1.0f / l;
            GAS v4u* op = (GAS v4u*)(CAT + ((size_t)b * SEQ + t) * D + 512 + h * 64);
#pragma unroll
            for (int j = 0; j < 8; ++j) { v4u w; w.x = pk2(o[8 * j] * rl, o[8 * j + 1] * rl); w.y = pk2(o[8 * j + 2] * rl, o[8 * j + 3] * rl); w.z = pk2(o[8 * j + 4] * rl, o[8 * j + 5] * rl); w.w = pk2(o[8 * j + 6] * rl, o[8 * j + 7] * rl); op[j] = w; }
        }
    }
}
__device__ __forceinline__ void even_post(const Frame& F0) {
    const Frame F = relaunder(F0);
    unsigned char* ws = WSP();
    const int gw = F.bid * NWAVES + F.wave, NGW = F.G * NWAVES;
    const bf16* P = (const bf16*)(ws + WS_ACT); const float* oraw = (const float*)(ws + WS_XB); bf16* CAT = (bf16*)(ws + WS_CAT);
    for (int it = gw; it < M * 4; it += NGW) {
        const int m = it >> 2, h = it & 3;
        const float* op = oraw + (size_t)m * 512 + h * 128 + 2 * F.lane; const float o0 = op[0], o1 = op[1];
        const float mu = wave_sum(o0 + o1) * (1.0f / 128.0f); const float d0 = o0 - mu, d1 = o1 - mu;
        const float var = wave_sum(d0 * d0 + d1 * d1) * (1.0f / 128.0f); const float rstd = 1.0f / sqrtf(var + EPS);
        const unsigned gw2 = *(const unsigned*)(P + (size_t)m * EVEN_IN + E_RG + h * 128 + 2 * F.lane); const float g0 = bflo(gw2), g1 = bfhi(gw2);
        const float y0 = d0 * rstd * (g0 / (1.0f + expf(-g0))), y1 = d1 * rstd * (g1 / (1.0f + expf(-g1)));
        *(unsigned*)(CAT + (size_t)m * D + h * 128 + 2 * F.lane) = pk2(y0, y1);
    }
}
__device__ __forceinline__ void gla_prep(const Frame& F0, int li) {
    const Frame F = relaunder(F0);
    unsigned char* ws = WSP();
    const int gt = F.bid * NTHREADS + F.tid, NGT = F.G * NTHREADS;
    const bf16* P = (const bf16*)(ws + WS_ACT); float* A = (float*)(ws + WS_CAT);
    const float* w2 = AP(I_GLA_A2) + (size_t)li * 16 * 512; const float* ba = AP(I_GLA_BA) + (size_t)li * 512;
    for (int e = gt; e < M * 512; e += NGT) {
        const int m = e >> 9, c = e & 511; const bf16* al = P + (size_t)m * GLA_INP + G_A;
        float z = ba[c];
#pragma unroll
        for (int j = 0; j < 16; ++j) z += bf2f(al[j]) * w2[j * 512 + c];
        const float ls = fminf(z, 0.f) - log1pf(expf(-fabsf(z)));
        A[e] = expf(ls * (1.0f / 16.0f));
    }
}
__device__ __forceinline__ void gla_core(const Frame& F0) {
    const Frame F = relaunder(F0);
    unsigned char* ws = WSP();
    const bf16* P = (const bf16*)(ws + WS_ACT); const float* A = (const float*)(ws + WS_CAT); bf16* oraw = (bf16*)(ws + WS_XB);
    const int b = F.bid >> 5, h = (F.bid >> 3) & 3, eg = F.bid & 7, e = eg * 32 + (F.tid >> 4), dq = F.tid & 15;
    const bf16* base = P + (size_t)b * SEQ * GLA_INP; const float* abase = A + (size_t)b * SEQ * 512 + h * 128 + dq * 8;
    float S[8];
#pragma unroll
    for (int i = 0; i < 8; ++i) S[i] = 0.f;
    v4u qn = *(const GAS v4u*)(base + G_Q + h * 128 + dq * 8), kn = *(const GAS v4u*)(base + G_K + h * 128 + dq * 8); bf16 vn = base[G_V + h * 256 + e];
    f32x4 a0n = *(const GAS f32x4*)(abase), a1n = *(const GAS f32x4*)(abase + 4);
    for (int t = 0; t < SEQ; ++t) {
        const v4u q = qn, k = kn; const float v = bf2f(vn); const f32x4 a0 = a0n, a1 = a1n;
        if (t + 1 < SEQ) { const bf16* nb = base + (size_t)(t + 1) * GLA_INP; qn = *(const GAS v4u*)(nb + G_Q + h * 128 + dq * 8); kn = *(const GAS v4u*)(nb + G_K + h * 128 + dq * 8); vn = nb[G_V + h * 256 + e];
            a0n = *(const GAS f32x4*)(abase + (size_t)(t + 1) * 512); a1n = *(const GAS f32x4*)(abase + (size_t)(t + 1) * 512 + 4); }
        float o = 0.f;
#pragma unroll
        for (int i = 0; i < 4; ++i) { const unsigned qw = q[i], kw = k[i]; const float al = (i < 2) ? a0[2 * i] : a1[2 * i - 4], ah = (i < 2) ? a0[2 * i + 1] : a1[2 * i - 3];
            S[2 * i] = al * S[2 * i] + bflo(kw) * v; S[2 * i + 1] = ah * S[2 * i + 1] + bfhi(kw) * v;
            o += bflo(qw) * S[2 * i]; o += bfhi(qw) * S[2 * i + 1]; }
        o += xsw<1>(o); o += xsw<2>(o); o += xsw<4>(o); o += xsw<8>(o);
        if (dq == 0) oraw[((size_t)b * SEQ + t) * 1024 + h * 256 + e] = f2bf_rne(o * 0.08838834764831845f);
    }
}
__device__ __forceinline__ void gla_post(const Frame& F0) {
    const Frame F = relaunder(F0);
    unsigned char* ws = WSP();
    const int gw = F.bid * NWAVES + F.wave, NGW = F.G * NWAVES;
    const bf16* P = (const bf16*)(ws + WS_ACT); const bf16* oraw = (const bf16*)(ws + WS_XB); bf16* CAT = (bf16*)(ws + WS_CAT);
    for (int it = gw; it < M * 4; it += NGW) {
        const int m = it >> 2, h = it & 3;
        const unsigned long long ow = *(const unsigned long long*)(oraw + (size_t)m * 1024 + h * 256 + 4 * F.lane);
        const float o0 = bflo((unsigned)ow), o1 = bfhi((unsigned)ow), o2 = bflo((unsigned)(ow >> 32)), o3 = bfhi((unsigned)(ow >> 32));
        const float mu = wave_sum((o0 + o1) + (o2 + o3)) * (1.0f / 256.0f); const float d0 = o0 - mu, d1 = o1 - mu, d2 = o2 - mu, d3 = o3 - mu;
        const float var = wave_sum((d0 * d0 + d1 * d1) + (d2 * d2 + d3 * d3)) * (1.0f / 256.0f); const float rstd = 1.0f / sqrtf(var + EPS);
        const unsigned long long gw2 = *(const unsigned long long*)(P + (size_t)m * GLA_INP + G_R + h * 256 + 4 * F.lane);
        const float g0 = bflo((unsigned)gw2), g1 = bfhi((unsigned)gw2), g2 = bflo((unsigned)(gw2 >> 32)), g3 = bfhi((unsigned)(gw2 >> 32));
        const float y0 = d0 * rstd * (g0 / (1.0f + expf(-g0))), y1 = d1 * rstd * (g1 / (1.0f + expf(-g1))), y2 = d2 * rstd * (g2 / (1.0f + expf(-g2))), y3 = d3 * rstd * (g3 / (1.0f + expf(-g3)));
        *(unsigned long long*)(CAT + (size_t)m * D + h * 256 + 4 * F.lane) = (unsigned long long)pk2(y0, y1) | ((unsigned long long)pk2(y2, y3) << 32);
    }
}
__device__ __forceinline__ void final_norm(const Frame& F0) {
    const Frame F = relaunder(F0);
    const int gw = F.bid * NWAVES + F.wave, NGW = F.G * NWAVES;
    for (int m = gw; m < M; m += NGW) {
        GAS f32x4* xr = (GAS f32x4*)(OUTP() + (size_t)m * D) + F.lane; const GAS f32x4* gr = (const GAS f32x4*)AP(I_FINAL) + F.lane;
        f32x4 v[4]; float s = 0.f;
#pragma unroll
        for (int j = 0; j < 4; ++j) { v[j] = xr[64 * j]; s += (v[j].x * v[j].x + v[j].y * v[j].y) + (v[j].z * v[j].z + v[j].w * v[j].w); }
        const float rstd = 1.0f / sqrtf(wave_sum(s) * (1.0f / D) + EPS);
#pragma unroll
        for (int j = 0; j < 4; ++j) xr[64 * j] = v[j] * rstd * gr[64 * j];
    }
}


__device__ __forceinline__ float silu_f(float g) { return g * __builtin_amdgcn_rcpf(1.0f + __builtin_amdgcn_exp2f(-1.4426950408889634f * g)); }
typedef float f32x16 __attribute__((ext_vector_type(16)));
typedef short s16x4 __attribute__((ext_vector_type(4)));
typedef float f32x2_t __attribute__((ext_vector_type(2)));
typedef __bf16 bf16x2_t __attribute__((ext_vector_type(2)));
#define MFMA32(a, b, c) __builtin_amdgcn_mfma_f32_32x32x16_bf16((a), (b), (c), 0, 0, 0)
__device__ __forceinline__ int crow(int reg, int h) { return (reg & 3) + 8 * (reg >> 2) + 4 * h; }
__device__ __forceinline__ unsigned cvtpk(float lo, float hi) { f32x2_t v = {lo, hi}; bf16x2_t b = __builtin_convertvector(v, bf16x2_t); return __builtin_bit_cast(unsigned, b); }
__device__ __forceinline__ bf16 cvt1(float v) { return (bf16)(cvtpk(v, 0.f) & 0xffffu); }
#define PACK_STEP(x, s) __builtin_bit_cast(bf16x8, (v4u){cvtpk((x)[8 * (s)], (x)[8 * (s) + 1]), cvtpk((x)[8 * (s) + 2], (x)[8 * (s) + 3]), cvtpk((x)[8 * (s) + 4], (x)[8 * (s) + 5]), cvtpk((x)[8 * (s) + 6], (x)[8 * (s) + 7])})
typedef const LAS unsigned char* lcp;
__device__ __forceinline__ bf16x8 ld_row(lcp img, int P, int row0, int k0, int r, int h) { return *(const LAS bf16x8*)(img + (row0 + r) * P + (k0 + 8 * h) * 2); }
__device__ __forceinline__ bf16x8 ld_row_perm(lcp img, int P, int row0, int k0, int r, int h) {
    const s16x4 lo = *(const LAS s16x4*)(img + (row0 + r) * P + (k0 + 4 * h) * 2), hi = *(const LAS s16x4*)(img + (row0 + r) * P + (k0 + 8 + 4 * h) * 2);
    return __builtin_shufflevector(lo, hi, 0, 1, 2, 3, 4, 5, 6, 7); }
__device__ __forceinline__ s16x4 trd(lcp p) { return __builtin_bit_cast(s16x4, __builtin_amdgcn_ds_read_tr16_b64_v4i16((LAS s16x4*)p)); }
__device__ __forceinline__ bf16x8 ld_tr(lcp img, int P, int k0, int c0, int lane) {
    const int i16 = lane & 15, q = i16 >> 2, p = i16 & 3, blk = (lane >> 4) & 1, h = lane >> 5;
    lcp a = img + (k0 + 8 * h + q) * P + (c0 + 16 * blk + 4 * p) * 2;
    const s16x4 lo = trd(a), hi = trd(a + 4 * P);
    return __builtin_shufflevector(lo, hi, 0, 1, 2, 3, 4, 5, 6, 7); }
__device__ __forceinline__ bf16x8 ld_tr_perm(lcp img, int P, int k0, int c0, int lane) {
    const int i16 = lane & 15, q = i16 >> 2, p = i16 & 3, blk = (lane >> 4) & 1, h = lane >> 5;
    lcp a = img + (k0 + 4 * h + q) * P + (c0 + 16 * blk + 4 * p) * 2;
    const s16x4 lo = trd(a), hi = trd(a + 8 * P);
    return __builtin_shufflevector(lo, hi, 0, 1, 2, 3, 4, 5, 6, 7); }
template <int R, int C> __device__ __forceinline__ void stage_tile(LAS unsigned char* img, int P, const bf16* g, size_t gp, int tid) {
    constexpr int CPR = C / 8, N = R * CPR;
#pragma unroll
    for (int i = 0; i < (N + NTHREADS - 1) / NTHREADS; ++i) { const int c = tid + i * NTHREADS;
        if (c < N) { const int row = c / CPR, cc = c % CPR; const v4u v = *(const GAS v4u*)(g + (size_t)row * gp + cc * 8); *(LAS v4u*)(img + row * P + cc * 16) = v; } }
}
#define WG_BAR() do { asm volatile("s_waitcnt vmcnt(0) lgkmcnt(0)" ::: "memory"); __builtin_amdgcn_s_barrier(); asm volatile("" ::: "memory"); } while (0)

constexpr int GP128 = 272, GP256 = 528;
constexpr size_t WS_DEC = 6 * MiB;
constexpr float LOG2E = 1.4426950408889634f, LN2 = 0.6931471805599453f;
__device__ __forceinline__ void gla_cumsum(float (&Bc)[2][16], float& Blast, lcp AL, lcp W2, const LAS float* BA, LAS float* EX, int wave, int lane) {
    const int r = lane & 31, h = lane >> 5, db = wave & 3, jh = wave >> 2;
    const bf16x8 wf = *(const LAS bf16x8*)(W2 + (db * 32 + r) * 32 + h * 16);
    const float bias = BA[db * 32 + r];
    float run = 0.f;
#pragma unroll
    for (int t = 0; t < 2; ++t) {
        const bf16x8 af = *(const LAS bf16x8*)(AL + ((jh * 2 + t) * 32 + r) * 32 + h * 16);
        f32x16 z = {0.f, 0.f, 0.f, 0.f, 0.f, 0.f, 0.f, 0.f, 0.f, 0.f, 0.f, 0.f, 0.f, 0.f, 0.f, 0.f};
        z = MFMA32(af, wf, z);
        float own[4], oth[4];
#pragma unroll
        for (int g = 0; g < 4; ++g) {
            float acc = 0.f;
#pragma unroll
            for (int i = 0; i < 4; ++i) { const float zz = z[4 * g + i] + bias;
                const float la = (fminf(zz, 0.f) - LN2 * __builtin_amdgcn_logf(1.0f + __builtin_amdgcn_exp2f(-fabsf(zz) * LOG2E))) * (1.0f / 16.0f);
                acc += la; Bc[t][4 * g + i] = acc; }
            own[g] = acc; oth[g] = oth32(acc, h);
        }
#pragma unroll
        for (int g = 0; g < 4; ++g) { const float off = run + (h ? oth[g] : 0.f);
#pragma unroll
            for (int i = 0; i < 4; ++i) Bc[t][4 * g + i] += off;
            run += own[g] + oth[g]; }
    }
    if (h == 0) EX[jh * 128 + db * 32 + r] = run;
    WG_BAR();
    const float t0 = EX[db * 32 + r], t1 = EX[128 + db * 32 + r];
    Blast = t0 + t1;
    if (jh == 1) {
#pragma unroll
        for (int t = 0; t < 2; ++t)
#pragma unroll
            for (int i = 0; i < 16; ++i) Bc[t][i] += t0; }
}
constexpr int GA_KI = 0, GA_VI = GA_KI + 128 * GP128, GA_KD = GA_VI + 128 * GP256, GA_AL = GA_KD + 128 * GP128, GA_W2 = GA_AL + 4096, GA_BA = GA_W2 + 4096, GA_EX = GA_BA + 512, GA_END = GA_EX + 1024;
constexpr int GC_QT = 0, GC_KT = GC_QT + 128 * GP128, GC_SI = GC_KT + 128 * GP128, GC_VI = GC_SI + 128 * GP128, GC_AL = GC_VI + 128 * GP128, GC_W2 = GC_AL + 4096, GC_BA = GC_W2 + 4096, GC_EX = GC_BA + 512, GC_END = GC_EX + 1024;
constexpr int GC_OI = 0;
static_assert(GA_END <= LDSCTL_OFF && GC_END <= LDSCTL_OFF && 128 * GP256 <= GC_SI, "GLA LDS maps");
__device__ __forceinline__ void gla_stage_small(const Frame& F, LAS unsigned char* AL, LAS unsigned char* W2, LAS float* BA, const bf16* Prow0, int li, int h) {
    if (F.tid < 256) { const int row = F.tid >> 1, cc = F.tid & 1; *(LAS v4u*)(AL + row * 32 + cc * 16) = *(const GAS v4u*)(Prow0 + (size_t)row * GLA_INP + G_A + cc * 8); }
    else if (F.tid < 384) { const int d = F.tid - 256; const float* w2 = AP(I_GLA_A2) + (size_t)li * 16 * 512 + h * 128 + d;
        v4u lo, hi; lo.x = cvtpk(w2[0], w2[512]); lo.y = cvtpk(w2[2 * 512], w2[3 * 512]); lo.z = cvtpk(w2[4 * 512], w2[5 * 512]); lo.w = cvtpk(w2[6 * 512], w2[7 * 512]);
        hi.x = cvtpk(w2[8 * 512], w2[9 * 512]); hi.y = cvtpk(w2[10 * 512], w2[11 * 512]); hi.z = cvtpk(w2[12 * 512], w2[13 * 512]); hi.w = cvtpk(w2[14 * 512], w2[15 * 512]);
        *(LAS v4u*)(W2 + d * 32) = lo; *(LAS v4u*)(W2 + d * 32 + 16) = hi; }
    else { const int d = F.tid - 384; BA[d] = AP(I_GLA_BA)[(size_t)li * 512 + h * 128 + d]; }
}
__device__ __forceinline__ void gla_phase_a(const Frame& F0, int li) {
    const Frame F = relaunder(F0);
    unsigned char* ws = WSP();
    const bf16* P = (const bf16*)(ws + WS_ACT); bf16* SKV = (bf16*)(ws + WS_XB); float* DEC = (float*)(ws + WS_DEC);
    LAS unsigned char* L = F.lds;
    const int lane = F.lane, r = lane & 31, h2 = lane >> 5, wave = F.wave, db = wave & 3, jh = wave >> 2;
    for (int it = F.bid; it < 1024; it += F.G) {
        const int bh = it >> 5, g = it & 31, b = bh >> 2, h = bh & 3;
        const bf16* Prow0 = P + ((size_t)b * SEQ + g * 128) * GLA_INP;
        stage_tile<128, 128>(L + GA_KI, GP128, Prow0 + G_K + h * 128, GLA_INP, F.tid);
        stage_tile<128, 256>(L + GA_VI, GP256, Prow0 + G_V + h * 256, GLA_INP, F.tid);
        gla_stage_small(F, L + GA_AL, L + GA_W2, (LAS float*)(L + GA_BA), Prow0, li, h);
        WG_BAR();
        float Bc[2][16], Blast;
        gla_cumsum(Bc, Blast, L + GA_AL, L + GA_W2, (const LAS float*)(L + GA_BA), (LAS float*)(L + GA_EX), wave, lane);
#pragma unroll
        for (int t = 0; t < 2; ++t)
#pragma unroll
            for (int i = 0; i < 16; ++i) { const int off = ((jh * 2 + t) * 32 + crow(i, h2)) * GP128 + (db * 32 + r) * 2;
                const float kv = bf2f(*(const LAS bf16*)(L + GA_KI + off)) * __builtin_amdgcn_exp2f((Blast - Bc[t][i]) * LOG2E);
                *(LAS bf16*)(L + GA_KD + off) = cvt1(kv); }
        if (jh == 0 && h2 == 0) DEC[(size_t)it * 128 + db * 32 + r] = __builtin_amdgcn_exp2f(Blast * LOG2E);
        WG_BAR();
        f32x16 acc[4];
#pragma unroll
        for (int t = 0; t < 4; ++t) acc[t] = (f32x16){0.f, 0.f, 0.f, 0.f, 0.f, 0.f, 0.f, 0.f, 0.f, 0.f, 0.f, 0.f, 0.f, 0.f, 0.f, 0.f};
#pragma unroll
        for (int ks = 0; ks < 8; ++ks) { const bf16x8 a = ld_tr(L + GA_KD, GP128, 16 * ks, db * 32, lane);
#pragma unroll
            for (int t = 0; t < 4; ++t) acc[t] = MFMA32(a, ld_tr(L + GA_VI, GP256, 16 * ks, (4 * jh + t) * 32, lane), acc[t]); }
        bf16* out = SKV + (size_t)it * 128 * 256;
#pragma unroll
        for (int t = 0; t < 4; ++t)
#pragma unroll
            for (int i = 0; i < 16; ++i) out[(size_t)(db * 32 + crow(i, h2)) * 256 + (4 * jh + t) * 32 + r] = cvt1(acc[t][i]);
        WG_BAR();
    }
}
__device__ __forceinline__ void gla_phase_b(const Frame& F0) {
    const Frame F = relaunder(F0);
    unsigned char* ws = WSP();
    bf16* SKV = (bf16*)(ws + WS_XB); const float* DEC = (const float*)(ws + WS_DEC);
    for (int gt = F.bid * NTHREADS + F.tid; gt < 32 * 128 * 32; gt += F.G * NTHREADS) {
        const int bh = gt >> 12, d = (gt >> 5) & 127, e8 = gt & 31;
        float s[8];
#pragma unroll
        for (int i = 0; i < 8; ++i) s[i] = 0.f;
        for (int g0 = 0; g0 < 32; g0 += 4) {
            v4u kv[4]; float dc[4];
#pragma unroll
            for (int u = 0; u < 4; ++u) { const size_t item = (size_t)bh * 32 + g0 + u; kv[u] = *(const GAS v4u*)(SKV + (item * 128 + d) * 256 + e8 * 8); dc[u] = DEC[item * 128 + d]; }
#pragma unroll
            for (int u = 0; u < 4; ++u) { const size_t item = (size_t)bh * 32 + g0 + u;
                v4u o; o.x = cvtpk(s[0], s[1]); o.y = cvtpk(s[2], s[3]); o.z = cvtpk(s[4], s[5]); o.w = cvtpk(s[6], s[7]);
                *(GAS v4u*)(SKV + (item * 128 + d) * 256 + e8 * 8) = o;
#pragma unroll
                for (int i = 0; i < 4; ++i) { s[2 * i] = dc[u] * s[2 * i] + bflo(kv[u][i]); s[2 * i + 1] = dc[u] * s[2 * i + 1] + bfhi(kv[u][i]); } }
        }
    }
}
__device__ __forceinline__ void gla_phase_c(const Frame& F0, int li) {
    const Frame F = relaunder(F0);
    unsigned char* ws = WSP();
    const bf16* P = (const bf16*)(ws + WS_ACT); const bf16* SKV = (const bf16*)(ws + WS_XB); bf16* CAT = (bf16*)(ws + WS_CAT);
    LAS unsigned char* L = F.lds;
    const int lane = F.lane, r = lane & 31, h2 = lane >> 5, wave = F.wave, db = wave & 3, jh = wave >> 2;
    const int ib = wave & 3, eq = wave >> 2;
    for (int it = F.bid; it < 1024; it += F.G) {
        const int bh = it >> 5, g = it & 31, b = bh >> 2, h = bh & 3;
        const bf16* Prow0 = P + ((size_t)b * SEQ + g * 128) * GLA_INP;
        const bf16* Sg = SKV + (size_t)it * 128 * 256;
        stage_tile<128, 128>(L + GC_QT, GP128, Prow0 + G_Q + h * 128, GLA_INP, F.tid);
        stage_tile<128, 128>(L + GC_KT, GP128, Prow0 + G_K + h * 128, GLA_INP, F.tid);
        stage_tile<128, 128>(L + GC_SI, GP128, Sg, 256, F.tid);
        stage_tile<128, 128>(L + GC_VI, GP128, Prow0 + G_V + h * 256, GLA_INP, F.tid);
        gla_stage_small(F, L + GC_AL, L + GC_W2, (LAS float*)(L + GC_BA), Prow0, li, h);
        WG_BAR();
        {
            float Bc[2][16], Blast;
            gla_cumsum(Bc, Blast, L + GC_AL, L + GC_W2, (const LAS float*)(L + GC_BA), (LAS float*)(L + GC_EX), wave, lane);
#pragma unroll
            for (int t = 0; t < 2; ++t)
#pragma unroll
                for (int i = 0; i < 16; ++i) { const int off = ((jh * 2 + t) * 32 + crow(i, h2)) * GP128 + (db * 32 + r) * 2;
                    const float eb = __builtin_amdgcn_exp2f(Bc[t][i] * LOG2E);
                    const float qv = bf2f(*(const LAS bf16*)(L + GC_QT + off)) * eb * 0.08838834764831845f;
                    const float kv = bf2f(*(const LAS bf16*)(L + GC_KT + off)) * __builtin_amdgcn_rcpf(eb);
                    *(LAS bf16*)(L + GC_QT + off) = cvt1(qv); *(LAS bf16*)(L + GC_KT + off) = cvt1(kv); }
        }
        WG_BAR();
        bf16x8 PA[4][2];
#pragma unroll
        for (int jb = 0; jb < 4; ++jb) {
            if (jb <= ib) {
                f32x16 x = {0.f, 0.f, 0.f, 0.f, 0.f, 0.f, 0.f, 0.f, 0.f, 0.f, 0.f, 0.f, 0.f, 0.f, 0.f, 0.f};
#pragma unroll
                for (int ks = 0; ks < 8; ++ks) x = MFMA32(ld_row(L + GC_KT, GP128, jb * 32, 16 * ks, r, h2), ld_row(L + GC_QT, GP128, ib * 32, 16 * ks, r, h2), x);
                if (jb == ib) {
#pragma unroll
                    for (int i = 0; i < 16; ++i) if (crow(i, h2) > r) x[i] = 0.f; }
                PA[jb][0] = PACK_STEP(x, 0); PA[jb][1] = PACK_STEP(x, 1);
            } else { PA[jb][0] = (bf16x8){0, 0, 0, 0, 0, 0, 0, 0}; PA[jb][1] = (bf16x8){0, 0, 0, 0, 0, 0, 0, 0}; }
        }
        f32x16 o[2][2];
#pragma unroll
        for (int half = 0; half < 2; ++half) {
            if (half == 1) {
                WG_BAR();
                stage_tile<128, 128>(L + GC_SI, GP128, Sg + 128, 256, F.tid);
                stage_tile<128, 128>(L + GC_VI, GP128, Prow0 + G_V + h * 256 + 128, GLA_INP, F.tid);
                WG_BAR();
            }
#pragma unroll
            for (int t = 0; t < 2; ++t) {
                const int eb = 2 * eq + t;
                f32x16 acc = {0.f, 0.f, 0.f, 0.f, 0.f, 0.f, 0.f, 0.f, 0.f, 0.f, 0.f, 0.f, 0.f, 0.f, 0.f, 0.f};
#pragma unroll
                for (int jb = 0; jb < 4; ++jb) if (jb <= ib) {
#pragma unroll
                    for (int s = 0; s < 2; ++s) acc = MFMA32(PA[jb][s], ld_tr_perm(L + GC_VI, GP128, jb * 32 + 16 * s, eb * 32, lane), acc); }
#pragma unroll
                for (int ks = 0; ks < 8; ++ks) acc = MFMA32(ld_row(L + GC_QT, GP128, ib * 32, 16 * ks, r, h2), ld_tr(L + GC_SI, GP128, 16 * ks, eb * 32, lane), acc);
                o[half][t] = acc;
            }
        }
        WG_BAR();
#pragma unroll
        for (int half = 0; half < 2; ++half)
#pragma unroll
            for (int t = 0; t < 2; ++t)
#pragma unroll
                for (int i = 0; i < 16; ++i) *(LAS bf16*)(L + GC_OI + (ib * 32 + crow(i, h2)) * GP256 + (half * 128 + (2 * eq + t) * 32 + r) * 2) = cvt1(o[half][t][i]);
        WG_BAR();
        {
            const int row = F.tid >> 2, qtr = F.tid & 3;
            lcp orow = L + GC_OI + row * GP256 + qtr * 128;
            float sum = 0.f;
#pragma unroll
            for (int c = 0; c < 8; ++c) { const v4u w = *(const LAS v4u*)(orow + c * 16);
#pragma unroll
                for (int i = 0; i < 4; ++i) sum += bflo(w[i]) + bfhi(w[i]); }
            sum += xsw<1>(sum); sum += xsw<2>(sum);
            const float mu = sum * (1.0f / 256.0f); float sq = 0.f;
#pragma unroll
            for (int c = 0; c < 8; ++c) { const v4u w = *(const LAS v4u*)(orow + c * 16);
#pragma unroll
                for (int i = 0; i < 4; ++i) { const float d0 = bflo(w[i]) - mu, d1 = bfhi(w[i]) - mu; sq += d0 * d0 + d1 * d1; } }
            sq += xsw<1>(sq); sq += xsw<2>(sq);
            const float rstd = 1.0f / sqrtf(sq * (1.0f / 256.0f) + EPS);
            const bf16* gp = Prow0 + (size_t)row * GLA_INP + G_R + h * 256 + qtr * 64;
            bf16* op = CAT + ((size_t)b * SEQ + g * 128 + row) * D + h * 256 + qtr * 64;
#pragma unroll
            for (int c = 0; c < 8; ++c) { const v4u gw = *(const GAS v4u*)(gp + c * 8); const v4u w = *(const LAS v4u*)(orow + c * 16); v4u ow;
#pragma unroll
                for (int i = 0; i < 4; ++i) { const float g0 = bflo(gw[i]), g1 = bfhi(gw[i]);
                    ow[i] = cvtpk((bflo(w[i]) - mu) * rstd * silu_f(g0), (bfhi(w[i]) - mu) * rstd * silu_f(g1)); }
                *(GAS v4u*)(op + c * 8) = ow; asm volatile("" ::: "memory"); }
        }
        WG_BAR();
    }
}


constexpr size_t WS_OD = 408 * MiB;
constexpr size_t WS_LSE = WS_XB + 32 * MiB;
constexpr size_t WS_END2 = 504 * MiB;
constexpr int RP = 272;
constexpr int RA_KI = 0, RA_VD = RA_KI + 128 * RP, RA_END = RA_VD + 128 * RP;
constexpr int RC_QI = 0, RC_KI = RC_QI + 128 * RP, RC_VI = RC_KI + 128 * RP, RC_SI = RC_VI + 128 * RP, RC_END = RC_SI + 128 * RP;
constexpr int DP = 144;
constexpr int DL_KI = 0, DL_VI = DL_KI + 384 * DP, DL_ST = DL_VI + 384 * DP, DL_LW = DL_ST + 8 * 32 * DP, DL_END = DL_LW + 8 * 256;
static_assert(RC_END <= LDSCTL_OFF && DL_END <= LDSCTL_OFF, "even mixer LDS maps");
__device__ __forceinline__ float ret_log2g(int h) { return log2f(1.0f - exp2f(-5.0f - (float)h)); }

__device__ __forceinline__ void ret_phase_a_item(const Frame& F, int it, const bf16* P, bf16* RKV) {
    LAS unsigned char* L = F.lds;
    const int lane = F.lane, r = lane & 31, h2 = lane >> 5, wave = F.wave, db = wave & 3, eh = wave >> 2;
    const int bh = it >> 5, n = it & 31, b = bh >> 2, h = bh & 3;
    const float lg = ret_log2g(h);
    const bf16* Prow0 = P + ((size_t)b * SEQ + n * 128) * EVEN_IN;
    stage_tile<128, 128>(L + RA_KI, RP, Prow0 + E_RK + h * 128, EVEN_IN, F.tid);
    {
        const bf16* gsrc = Prow0 + E_RV + h * 128;
#pragma unroll
        for (int i = 0; i < 4; ++i) { const int c = F.tid + i * NTHREADS, row = c >> 4, cc = c & 15; const float f = __builtin_amdgcn_exp2f(lg * (float)(127 - row));
            const v4u v = *(const GAS v4u*)(gsrc + (size_t)row * EVEN_IN + cc * 8); v4u o;
#pragma unroll
            for (int k = 0; k < 4; ++k) o[k] = cvtpk(bflo(v[k]) * f, bfhi(v[k]) * f);
            *(LAS v4u*)(L + RA_VD + row * RP + cc * 16) = o; }
    }
    WG_BAR();
    f32x16 acc[2];
#pragma unroll
    for (int t = 0; t < 2; ++t) acc[t] = (f32x16){0.f, 0.f, 0.f, 0.f, 0.f, 0.f, 0.f, 0.f, 0.f, 0.f, 0.f, 0.f, 0.f, 0.f, 0.f, 0.f};
#pragma unroll
    for (int ks = 0; ks < 8; ++ks) { const bf16x8 a = ld_tr(L + RA_KI, RP, 16 * ks, db * 32, lane);
#pragma unroll
        for (int t = 0; t < 2; ++t) acc[t] = MFMA32(a, ld_tr(L + RA_VD, RP, 16 * ks, (2 * eh + t) * 32, lane), acc[t]); }
    WG_BAR();
#pragma unroll
    for (int t = 0; t < 2; ++t)
#pragma unroll
        for (int i = 0; i < 16; ++i) *(LAS bf16*)(L + RA_KI + (db * 32 + crow(i, h2)) * RP + ((2 * eh + t) * 32 + r) * 2) = cvt1(acc[t][i]);
    WG_BAR();
    bf16* out = RKV + (size_t)it * 128 * 128;
#pragma unroll
    for (int i = 0; i < 4; ++i) { const int c = F.tid + i * NTHREADS, row = c >> 4, cc = c & 15; *(GAS v4u*)(out + row * 128 + cc * 8) = *(const LAS v4u*)(L + RA_KI + row * RP + cc * 16); }
    WG_BAR();
}
__device__ __forceinline__ void ret_scan(const Frame& F, bf16* RKV) {
    for (int gt = F.bid * NTHREADS + F.tid; gt < 32 * 128 * 16; gt += F.G * NTHREADS) {
        const int bh = gt >> 11, d = (gt >> 4) & 127, e8 = gt & 15, h = bh & 3;
        const float g128 = __builtin_amdgcn_exp2f(ret_log2g(h) * 128.0f);
        float s[8];
#pragma unroll
        for (int i = 0; i < 8; ++i) s[i] = 0.f;
        for (int n0 = 0; n0 < 32; n0 += 4) {
            v4u kv[4];
#pragma unroll
            for (int u = 0; u < 4; ++u) kv[u] = *(const GAS v4u*)(RKV + (((size_t)bh * 32 + n0 + u) * 128 + d) * 128 + e8 * 8);
#pragma unroll
            for (int u = 0; u < 4; ++u) {
                v4u o; o.x = cvtpk(s[0], s[1]); o.y = cvtpk(s[2], s[3]); o.z = cvtpk(s[4], s[5]); o.w = cvtpk(s[6], s[7]);
                *(GAS v4u*)(RKV + (((size_t)bh * 32 + n0 + u) * 128 + d) * 128 + e8 * 8) = o;
#pragma unroll
                for (int i = 0; i < 4; ++i) { s[2 * i] = g128 * s[2 * i] + bflo(kv[u][i]); s[2 * i + 1] = g128 * s[2 * i + 1] + bfhi(kv[u][i]); } }
        }
    }
}
__device__ __forceinline__ void ret_phase_c_item(const Frame& F, int it, const bf16* P, const bf16* RKV, bf16* CAT) {
    LAS unsigned char* L = F.lds;
    const int lane = F.lane, r = lane & 31, h2 = lane >> 5, wave = F.wave, ib = wave & 3, eq = wave >> 2;
    const int bh = it >> 5, n = it & 31, b = bh >> 2, h = bh & 3;
    const float lg = ret_log2g(h);
    const bf16* Prow0 = P + ((size_t)b * SEQ + n * 128) * EVEN_IN;
    stage_tile<128, 128>(L + RC_QI, RP, Prow0 + E_RQ + h * 128, EVEN_IN, F.tid);
    stage_tile<128, 128>(L + RC_KI, RP, Prow0 + E_RK + h * 128, EVEN_IN, F.tid);
    stage_tile<128, 128>(L + RC_VI, RP, Prow0 + E_RV + h * 128, EVEN_IN, F.tid);
    stage_tile<128, 128>(L + RC_SI, RP, RKV + (size_t)it * 128 * 128, 128, F.tid);
    WG_BAR();
    bf16x8 PA[4][2];
#pragma unroll
    for (int jb = 0; jb < 4; ++jb) {
        if (jb <= ib) {
            f32x16 x = {0.f, 0.f, 0.f, 0.f, 0.f, 0.f, 0.f, 0.f, 0.f, 0.f, 0.f, 0.f, 0.f, 0.f, 0.f, 0.f};
#pragma unroll
            for (int ks = 0; ks < 8; ++ks) x = MFMA32(ld_row(L + RC_KI, RP, jb * 32, 16 * ks, r, h2), ld_row(L + RC_QI, RP, ib * 32, 16 * ks, r, h2), x);
#pragma unroll
            for (int i = 0; i < 16; ++i) { const int dlt = (ib - jb) * 32 + r - crow(i, h2); x[i] = dlt >= 0 ? x[i] * __builtin_amdgcn_exp2f(lg * (float)dlt) : 0.f; }
            PA[jb][0] = PACK_STEP(x, 0); PA[jb][1] = PACK_STEP(x, 1);
        } else { PA[jb][0] = (bf16x8){0, 0, 0, 0, 0, 0, 0, 0}; PA[jb][1] = (bf16x8){0, 0, 0, 0, 0, 0, 0, 0}; }
    }
    f32x16 o[2];
#pragma unroll
    for (int t = 0; t < 2; ++t) {
        const int eb = 2 * eq + t;
        f32x16 z = {0.f, 0.f, 0.f, 0.f, 0.f, 0.f, 0.f, 0.f, 0.f, 0.f, 0.f, 0.f, 0.f, 0.f, 0.f, 0.f}, y = z;
#pragma unroll
        for (int jb = 0; jb < 4; ++jb) if (jb <= ib) {
#pragma unroll
            for (int s = 0; s < 2; ++s) z = MFMA32(PA[jb][s], ld_tr_perm(L + RC_VI, RP, jb * 32 + 16 * s, eb * 32, lane), z); }
#pragma unroll
        for (int ks = 0; ks < 8; ++ks) y = MFMA32(ld_row(L + RC_QI, RP, ib * 32, 16 * ks, r, h2), ld_tr(L + RC_SI, RP, 16 * ks, eb * 32, lane), y);
#pragma unroll
        for (int i = 0; i < 16; ++i) z[i] += y[i] * __builtin_amdgcn_exp2f(lg * (float)(ib * 32 + crow(i, h2) + 1));
        o[t] = z;
    }
    WG_BAR();
#pragma unroll
    for (int t = 0; t < 2; ++t)
#pragma unroll
        for (int i = 0; i < 16; ++i) *(LAS bf16*)(L + RC_QI + (ib * 32 + crow(i, h2)) * RP + ((2 * eq + t) * 32 + r) * 2) = cvt1(o[t][i]);
    WG_BAR();
    {
        const int row = F.tid >> 2, qtr = F.tid & 3;
        lcp orow = L + RC_QI + row * RP + qtr * 64;
        v4u w[4]; float sum = 0.f;
#pragma unroll
        for (int c = 0; c < 4; ++c) { w[c] = *(const LAS v4u*)(orow + c * 16);
#pragma unroll
            for (int i = 0; i < 4; ++i) sum += bflo(w[c][i]) + bfhi(w[c][i]); }
        sum += xsw<1>(sum); sum += xsw<2>(sum);
        const float mu = sum * (1.0f / 128.0f); float sq = 0.f;
#pragma unroll
        for (int c = 0; c < 4; ++c)
#pragma unroll
            for (int i = 0; i < 4; ++i) { const float d0 = bflo(w[c][i]) - mu, d1 = bfhi(w[c][i]) - mu; sq += d0 * d0 + d1 * d1; }
        sq += xsw<1>(sq); sq += xsw<2>(sq);
        const float rstd = 1.0f / sqrtf(sq * (1.0f / 128.0f) + EPS);
        const bf16* gp = Prow0 + (size_t)row * EVEN_IN + E_RG + h * 128 + qtr * 32;
        bf16* op = CAT + ((size_t)b * SEQ + n * 128 + row) * D + h * 128 + qtr * 32;
#pragma unroll
        for (int c = 0; c < 4; ++c) { const v4u gw = *(const GAS v4u*)(gp + c * 8); v4u ow;
#pragma unroll
            for (int i = 0; i < 4; ++i) { const float g0 = bflo(gw[i]), g1 = bfhi(gw[i]);
                ow[i] = cvtpk((bflo(w[c][i]) - mu) * rstd * silu_f(g0), (bfhi(w[c][i]) - mu) * rstd * silu_f(g1)); }
            *(GAS v4u*)(op + c * 8) = ow; }
    }
    WG_BAR();
}
__device__ __forceinline__ void dil_tile(const Frame& F, int T, const bf16* P, bf16* OD, float* LSE) {
    LAS unsigned char* L = F.lds;
    const int lane = F.lane, r = lane & 31, h2 = lane >> 5, wave = F.wave;
    const int b = T / 384, rem = T - b * 384, head = rem / 48, t48 = rem - head * 48, p = t48 >> 4, idx = t48 & 15;
    const int sh = 2 * p, dil = 1 << sh, res = idx & (dil - 1), blk = idx >> sh, q0 = blk * 256;
    const bf16* Pb = P + (size_t)b * SEQ * EVEN_IN + head * 64;
#pragma unroll
    for (int i = 0; i < 6; ++i) { const int c = F.tid + i * NTHREADS, row = c >> 3, cc = c & 7; int kidx = q0 - 128 + row; kidx = kidx < 0 ? 0 : kidx;
        const bf16* src = Pb + (size_t)(kidx * dil + res) * EVEN_IN + cc * 8;
        const v4u kv = *(const GAS v4u*)(src + E_DK), vv = *(const GAS v4u*)(src + E_DV);
        *(LAS v4u*)(L + DL_KI + row * DP + cc * 16) = kv; *(LAS v4u*)(L + DL_VI + row * DP + cc * 16) = vv; }
    bf16x8 qf[4];
    { const bf16* qsrc = Pb + (size_t)((q0 + 32 * wave + r) * dil + res) * EVEN_IN + E_DQ + 8 * h2;
#pragma unroll
      for (int ks = 0; ks < 4; ++ks) qf[ks] = *(const GAS bf16x8*)(qsrc + 16 * ks); }
    WG_BAR();
    f32x16 x[5];
    float mx = -INFINITY;
#pragma unroll
    for (int kb = 0; kb < 5; ++kb) {
        f32x16 a = {0.f, 0.f, 0.f, 0.f, 0.f, 0.f, 0.f, 0.f, 0.f, 0.f, 0.f, 0.f, 0.f, 0.f, 0.f, 0.f};
#pragma unroll
        for (int ks = 0; ks < 4; ++ks) a = MFMA32(ld_row(L + DL_KI, DP, 32 * wave + 32 * kb, 16 * ks, r, h2), qf[ks], a);
#pragma unroll
        for (int i = 0; i < 16; ++i) { const int cr = crow(i, h2), dist = 128 + r - 32 * kb - cr, kidx = q0 - 128 + 32 * wave + 32 * kb + cr;
            const bool valid = dist >= 0 && dist <= 128 && kidx >= 0;
            a[i] = valid ? a[i] : -INFINITY; mx = fmaxf(mx, a[i]); }
        x[kb] = a;
    }
    mx = max32(mx);
    constexpr float C2 = 0.125f * LOG2E;
    const float mc = mx * C2; float l = 0.f;
#pragma unroll
    for (int kb = 0; kb < 5; ++kb)
#pragma unroll
        for (int i = 0; i < 16; ++i) { const float pe = __builtin_amdgcn_exp2f(x[kb][i] * C2 - mc); x[kb][i] = pe; l += pe; }
    l = sum32(l);
    f32x16 o[2];
#pragma unroll
    for (int dbk = 0; dbk < 2; ++dbk) o[dbk] = (f32x16){0.f, 0.f, 0.f, 0.f, 0.f, 0.f, 0.f, 0.f, 0.f, 0.f, 0.f, 0.f, 0.f, 0.f, 0.f, 0.f};
#pragma unroll
    for (int kb = 0; kb < 5; ++kb)
#pragma unroll
        for (int s = 0; s < 2; ++s) { const bf16x8 pa = PACK_STEP(x[kb], s);
#pragma unroll
            for (int dbk = 0; dbk < 2; ++dbk) o[dbk] = MFMA32(pa, ld_tr_perm(L + DL_VI, DP, 32 * wave + 32 * kb + 16 * s, dbk * 32, lane), o[dbk]); }
    LAS float* lw = (LAS float*)(L + DL_LW + wave * 256);
    if (h2 == 0) lw[r] = l;
    LAS unsigned char* st = L + DL_ST + wave * 32 * DP;
#pragma unroll
    for (int i = 0; i < 16; ++i) { const float rl = __builtin_amdgcn_rcpf(lw[crow(i, h2)]);
#pragma unroll
        for (int dbk = 0; dbk < 2; ++dbk) *(LAS bf16*)(st + crow(i, h2) * DP + (dbk * 32 + r) * 2) = cvt1(o[dbk][i] * rl); }
    const size_t tokbase = (size_t)b * SEQ;
    bf16* odp = OD + (size_t)p * M * 512;
#pragma unroll
    for (int j = 0; j < 4; ++j) { const int c = lane + 64 * j, row = c >> 3, cc = c & 7; const size_t tok = tokbase + (size_t)(q0 + 32 * wave + row) * dil + res;
        *(GAS v4u*)(odp + tok * 512 + head * 64 + cc * 8) = *(const LAS v4u*)(st + row * DP + cc * 16); }
    if (h2 == 0) { const size_t tok = tokbase + (size_t)(q0 + 32 * wave + r) * dil + res; LSE[((size_t)p * M + tok) * 8 + head] = mx * 0.125f + LN2 * __builtin_amdgcn_logf(l); }
    WG_BAR();
}
__device__ __forceinline__ void dil_combine(const Frame& F, const bf16* OD, const float* LSE, bf16* CAT) {
    for (int gt = F.bid * NTHREADS + F.tid; gt < M * 64; gt += F.G * NTHREADS) {
        const int tok = gt >> 6, c8 = gt & 63, head = c8 >> 3;
        const float l0 = LSE[(size_t)tok * 8 + head], l1 = LSE[((size_t)M + tok) * 8 + head], l2 = LSE[((size_t)2 * M + tok) * 8 + head];
        const float mxl = fmaxf(l0, fmaxf(l1, l2));
        float w0 = __builtin_amdgcn_exp2f((l0 - mxl) * LOG2E), w1 = __builtin_amdgcn_exp2f((l1 - mxl) * LOG2E), w2 = __builtin_amdgcn_exp2f((l2 - mxl) * LOG2E);
        const float rs = 1.0f / (w0 + w1 + w2); w0 *= rs; w1 *= rs; w2 *= rs;
        const v4u a = *(const GAS v4u*)(OD + (size_t)tok * 512 + c8 * 8), bq = *(const GAS v4u*)(OD + ((size_t)M + tok) * 512 + c8 * 8), cq = *(const GAS v4u*)(OD + ((size_t)2 * M + tok) * 512 + c8 * 8);
        v4u o;
#pragma unroll
        for (int i = 0; i < 4; ++i) o[i] = cvtpk(w0 * bflo(a[i]) + w1 * bflo(bq[i]) + w2 * bflo(cq[i]), w0 * bfhi(a[i]) + w1 * bfhi(bq[i]) + w2 * bfhi(cq[i]));
        *(GAS v4u*)(CAT + (size_t)tok * D + 512 + c8 * 8) = o;
    }
}
constexpr int DIL_TILES = 3072, DIL_SPLIT = 1024;
__device__ __forceinline__ void even_phase_a(const Frame& F0) {
    const Frame F = relaunder(F0);
    unsigned char* ws = WSP();
    const bf16* P = (const bf16*)(ws + WS_ACT); bf16* RKV = (bf16*)(ws + WS_XB); bf16* OD = (bf16*)(ws + WS_OD); float* LSE = (float*)(ws + WS_LSE);
    for (int it = F.bid; it < 1024; it += F.G) ret_phase_a_item(F, it, P, RKV);
    for (int T = F.bid; T < DIL_SPLIT; T += F.G) dil_tile(F, T, P, OD, LSE);
}
__device__ __forceinline__ void even_phase_b(const Frame& F0) {
    const Frame F = relaunder(F0);
    unsigned char* ws = WSP();
    const bf16* P = (const bf16*)(ws + WS_ACT); bf16* RKV = (bf16*)(ws + WS_XB); bf16* OD = (bf16*)(ws + WS_OD); float* LSE = (float*)(ws + WS_LSE);
    ret_scan(F, RKV);
    for (int T = DIL_SPLIT + F.bid; T < DIL_TILES; T += F.G) dil_tile(F, T, P, OD, LSE);
}
__device__ __forceinline__ void even_phase_c(const Frame& F0) {
    const Frame F = relaunder(F0);
    unsigned char* ws = WSP();
    const bf16* P = (const bf16*)(ws + WS_ACT); const bf16* RKV = (const bf16*)(ws + WS_XB); const bf16* OD = (const bf16*)(ws + WS_OD); const float* LSE = (const float*)(ws + WS_LSE); bf16* CAT = (bf16*)(ws + WS_CAT);
    for (int it = F.bid; it < 1024; it += F.G) ret_phase_c_item(F, it, P, RKV, CAT);
    dil_combine(F, OD, LSE, CAT);
}

__global__ void __launch_bounds__(NTHREADS, 2) fwd_kernel(Args args) {
    extern __shared__ __attribute__((aligned(16))) unsigned char lds[];
    Frame F;
    F.lds = (LAS unsigned char*)lds;
    F.wave = __builtin_amdgcn_readfirstlane((int)(threadIdx.x >> 6)); F.lane = hw_lane(); F.tid = F.wave * 64 + F.lane; F.G = gridDim.x; F.bid = blockIdx.x;
    for (int u = F.tid; u < (LDS_BYTES - LDSCTL_OFF) / 4; u += NTHREADS) ((LAS unsigned*)(F.lds + LDSCTL_OFF))[u] = 0u;
    __syncthreads();
    if (F.tid < N_PTRS) { const unsigned long long v = (F.tid < 17) ? (unsigned long long)args.in[F.tid] : (F.tid == 17 ? (unsigned long long)args.out : (unsigned long long)args.ws);
        ((LAS unsigned*)(F.lds + PTR_OFF))[2 * F.tid] = (unsigned)v; ((LAS unsigned*)(F.lds + PTR_OFF))[2 * F.tid + 1] = (unsigned)(v >> 32); }
    __syncthreads();
    (void)xcd_barrier_post((unsigned*)(WSP() + WS_CTL) + CW_BAR, (volatile LAS unsigned*)(F.lds + MISC_OFF) + 8, F.tid);
#define GRID_BAR() do { XcdBarrier bar_; bar_.bar = (unsigned*)(WSP() + WS_CTL) + CW_BAR; bar_.x = (unsigned)__builtin_amdgcn_readfirstlane((int)xb_xcc_id()); \
        int mo_ = MISC_OFF + 32; asm volatile("" : "+s"(mo_)); bar_.st = (volatile LAS unsigned*)(F.lds + mo_); int t_ = threadIdx.x; asm volatile("" : "+v"(t_)); xcd_barrier(bar_, t_); } while (0)
#define XB ((bf16*)(WSP() + WS_XB))
#define ACT ((bf16*)(WSP() + WS_ACT))
#define CAT ((bf16*)(WSP() + WS_CAT))
#define SSP ((float*)(WSP() + WS_SSP))
#define WPTR(off) ((const bf16*)(WSP() + (off)))

#ifdef TEST_MIN
    {
        pg8::Gemm g{XB, WPTR(W_GU0), M, 2 * FF, D}; pg8::StaticOrder S; S.init(M, 2 * FF, F.G, F.bid);
        pg8::EpiSwiGLU E{ACT, FF, SSP};
        pg8::gemm_phase<pg8::EpiSwiGLU, pg8::StaticOrder, true, true>(F.lds + RING_OFF, g, S, E, F.wave);
        GRID_BAR();
        return;
    }
#endif
    prologue_rows(F);
    convert_weights(F, 0);
    GRID_BAR();
    for (int s = 0; s < 8; ++s) {
        const int l = s >> 1; const bool post = (s & 1) != 0;
        {
            pg8::Gemm g{XB, WPTR(post ? W_GU1 : W_GU0), M, 2 * FF, D}; pg8::StaticOrder S; S.init(M, 2 * FF, F.G, F.bid);
            pg8::EpiSwiGLU E{ACT, FF, SSP};
#ifndef NO_F1
            pg8::gemm_phase<pg8::EpiSwiGLU, pg8::StaticOrder, true, true>(F.lds + RING_OFF, g, S, E, F.wave);
#endif
        }
        GRID_BAR();
        {
            pg8::Gemm g{ACT, WPTR(post ? W_D1 : W_D0), M, D, FF}; pg8::StaticOrder S; S.init(M, D, F.G, F.bid);
            pg8::EpiResid E{s == 0 ? AP(I_X) : (const float*)OUTP(), OUTP(), XB, SSP, 0.5f};
#ifndef NO_F2
            pg8::gemm_phase<pg8::EpiResid, pg8::StaticOrder, true, true>(F.lds + RING_OFF, g, S, E, F.wave);
#endif
        }
        GRID_BAR();
        if (!post) {
            const bool odd = (l & 1) != 0; const int nin = odd ? GLA_INP : EVEN_IN;
            {
                pg8::Gemm g{XB, WPTR(W_IN), M, nin, D}; pg8::StaticOrder S; S.init(M, nin, F.G, F.bid);
                pg8::EpiScaleBf16 E{ACT, nin, SSP};
#ifndef NO_M1
                pg8::gemm_phase<pg8::EpiScaleBf16, pg8::StaticOrder, true, true>(F.lds + RING_OFF, g, S, E, F.wave);
#endif
            }
            GRID_BAR();
#ifndef NO_EVEN
            if (!odd) { even_prep(F); GRID_BAR(); even_phase_a(F); GRID_BAR(); even_phase_b(F); GRID_BAR(); even_phase_c(F); }
#endif
#ifndef NO_GLA
            if (odd) {
#ifndef NO_GA
                gla_phase_a(F, l >> 1);
#endif
                GRID_BAR();
#ifndef NO_GB
                gla_phase_b(F);
#endif
                GRID_BAR();
#ifndef NO_GC
                gla_phase_c(F, l >> 1);
#endif
            }
#endif
            GRID_BAR();
            {
                pg8::Gemm g{CAT, WPTR(W_OUT), M, D, D}; pg8::StaticOrder S; S.init(M, D, F.G, F.bid);
                pg8::EpiResid E{(const float*)OUTP(), OUTP(), XB, SSP, 1.0f};
#ifndef NO_M5
                pg8::gemm_phase<pg8::EpiResid, pg8::StaticOrder, true, true>(F.lds + RING_OFF, g, S, E, F.wave);
#endif
            }
            GRID_BAR();
        } else if (l + 1 < DEPTH) {
            convert_weights(F, l + 1);
            GRID_BAR();
        }
    }
    final_norm(F);
}

extern "C" void kernel_launch(void* const* d_in, const int* in_sizes, int n_in, void* d_out, int out_size, void* d_ws, size_t ws_size, hipStream_t stream) {
    static int grid = 0;
    if (grid == 0) {
        if (n_in != 17 || in_sizes[0] != M * D || out_size != M * D || ws_size < WS_END2) { fprintf(stderr, "kernel_launch: unexpected shapes (n_in %d, in0 %d, out %d, ws %zu)\n", n_in, n_in > 0 ? in_sizes[0] : -1, out_size, ws_size); grid = -1; return; }
        int dev = 0, cus = 0, per_cu = 0;
        if (hipGetDevice(&dev) != hipSuccess || hipDeviceGetAttribute(&cus, hipDeviceAttributeMultiprocessorCount, dev) != hipSuccess) { grid = -1; return; }
        if (hipFuncSetAttribute((const void*)fwd_kernel, hipFuncAttributeMaxDynamicSharedMemorySize, LDS_BYTES) != hipSuccess) { fprintf(stderr, "kernel_launch: hipFuncSetAttribute failed\n"); grid = -1; return; }
        if (hipOccupancyMaxActiveBlocksPerMultiprocessor(&per_cu, (const void*)fwd_kernel, NTHREADS, LDS_BYTES) != hipSuccess || per_cu < 1) { fprintf(stderr, "kernel_launch: occupancy query reports %d\n", per_cu); }
        (void)hipGetLastError();
        grid = cus;
        if (grid != 256) fprintf(stderr, "kernel_launch: %d CUs (expected 256)\n", grid);
    }
    if (grid < 0) return;
    if (hipMemsetAsync((char*)d_ws + WS_CTL, 0, CTL_ZERO_BYTES, stream) != hipSuccess) return;
    Args a{};
    for (int i = 0; i < 17; ++i) a.in[i] = (const float*)d_in[i];
    a.out = (float*)d_out; a.ws = (unsigned char*)d_ws;
    hipLaunchKernelGGL(fwd_kernel, dim3(grid), dim3(NTHREADS), LDS_BYTES, stream, a);
}
```

```cpp
#include <hip/hip_runtime.h>
#include <cstdio>
#include <cstdint>
#include <cmath>
template <int K> __device__ __forceinline__ float xsw(float v) { static_assert(K == 1 || K == 2 || K == 4 || K == 8 || K == 16, "xor mask inside a 32-lane half");
    return __builtin_bit_cast(float, __builtin_amdgcn_ds_swizzle(__builtin_bit_cast(int, v), 0x1F | (K << 10))); }
__device__ __forceinline__ float sum32(float v) { const unsigned u = __builtin_bit_cast(unsigned, v); auto rr = __builtin_amdgcn_permlane32_swap(u, u, false, false); return __builtin_bit_cast(float, (unsigned)rr[0]) + __builtin_bit_cast(float, (unsigned)rr[1]); }
__device__ __forceinline__ float max32(float v) { const unsigned u = __builtin_bit_cast(unsigned, v); auto rr = __builtin_amdgcn_permlane32_swap(u, u, false, false); return fmaxf(__builtin_bit_cast(float, (unsigned)rr[0]), __builtin_bit_cast(float, (unsigned)rr[1])); }
__device__ __forceinline__ float oth32(float v, int h) { const unsigned u = __builtin_bit_cast(unsigned, v); auto rr = __builtin_amdgcn_permlane32_swap(u, u, false, false); return __builtin_bit_cast(float, (unsigned)(h ? rr[0] : rr[1])); }
namespace pg8 {
#define PG8_LAS __attribute__((address_space(3)))
typedef unsigned short bf16_t;
typedef short bf16x8 __attribute__((ext_vector_type(8)));
typedef float f32x4 __attribute__((ext_vector_type(4)));
typedef unsigned u32x4 __attribute__((ext_vector_type(4)));
constexpr int BM = 256, BK = 64, HALF = 128, HTB = HALF * BK * 2  , STAGE_BYTES = 8 * HTB, NXCD = 8, WGM = 8;

__host__ __device__ __forceinline__ int lds_byte(int r, int c) { const int st = (r >> 4) * 2 + (c >> 5), rr = r & 15, cc = c & 31, ob = rr * 64 + cc * 2; return st * 1024 + (ob ^ (((ob >> 9) & 1) << 5)); }
__host__ __device__ __forceinline__ void stage_rc(int b, int& R, int& C) { const int st = b / 1024, sb = b % 1024, swz = sb ^ (((sb >> 9) & 1) << 5); R = (st >> 1) * 16 + swz / 64; C = (st & 1) * 32 + (swz % 64) / 2; }
__host__ __device__ __forceinline__ int perm32(int rho) { const int n = rho >> 4, i = rho & 15; return 8 * (i >> 2) + 4 * n + (i & 3); }

struct Unit { int pm, pn; };
struct Gemm { const bf16_t* A; const bf16_t* Bt; int M, N, K; };

struct StaticOrder {
    int nM, nN, nwg, G, c;
    __host__ __device__ void init(int M, int N, int G_, int c_) { nM = M / BM; nN = N / BM; nwg = nM * nN; G = G_; c = c_; }
    __host__ __device__ bool next(int i, Unit& u) const {
        const long L = (long)i * G + c; if (L >= nwg) return false;
        int wgid = (int)L; { const int q = nwg / NXCD, r = nwg % NXCD, xcd = wgid % NXCD, off = wgid / NXCD; wgid = (xcd < r ? xcd * (q + 1) : r * (q + 1) + (xcd - r) * q) + off; }
        const int nig = WGM * nN, gid = wgid / nig, fm = gid * WGM, gsz = (nM - fm) < WGM ? (nM - fm) : WGM;
        u.pm = fm + ((wgid % nig) % gsz); u.pn = (wgid % nig) / gsz; return true;
    }
    __device__ __forceinline__ void a_ready(const Unit&) const {}
    __device__ __forceinline__ void done(const Unit&) const {}
};

__device__ __forceinline__ unsigned cvt_pk_bf16(float lo, float hi) { unsigned r; asm volatile("v_cvt_pk_bf16_f32 %0, %1, %2" : "=v"(r) : "v"(lo), "v"(hi)); return r; }
constexpr int MROWS = 32768;
constexpr float RMS_EPS = 1e-6f;
__device__ __forceinline__ void row_rstd(float (&rs)[2][4], const float* ssp, const Unit& u, int wr, int fr, int fq) {
#pragma unroll
    for (int ai = 0; ai < 2; ++ai)
#pragma unroll
        for (int m = 0; m < 4; ++m) {
            const int row = u.pm * BM + ai * HALF + wr * 64 + m * 16 + fr;
            const f32x4 p = *(const f32x4*)(ssp + (size_t)row * 16 + 4 * fq);
            float s = (p[0] + p[1]) + (p[2] + p[3]);
            s += xsw<16>(s); s = sum32(s);
            rs[ai][m] = 1.0f / sqrtf(s * (1.0f / 1024.0f) + RMS_EPS);
        }
}
__device__ __forceinline__ float silu_f(float g) { return g * __builtin_amdgcn_rcpf(1.0f + __builtin_amdgcn_exp2f(-1.4426950408889634f * g)); }

struct EpiSwiGLU {
    static constexpr bool PERM = true, AFTER_DRAIN = false;
    bf16_t* H; int ldh; const float* ssp;
    __device__ __forceinline__ void operator()(const f32x4 (&acc)[2][2][4][2], const Unit& u, int wr, int wc, int fr, int fq) const {
        float rs[2][4]; row_rstd(rs, ssp, u, wr, fr, fq);
        const int col0 = u.pn * HALF + wc * 32 + 8 * fq;
#pragma unroll
        for (int ai = 0; ai < 2; ++ai)
#pragma unroll
            for (int m = 0; m < 4; ++m) {
                const int row = u.pm * BM + ai * HALF + wr * 64 + m * 16 + fr; const float r = rs[ai][m];
                float h[8];
#pragma unroll
                for (int n = 0; n < 2; ++n)
#pragma unroll
                    for (int i = 0; i < 4; ++i) { const float g = acc[ai][0][m][n][i] * r, up = acc[ai][1][m][n][i] * r; h[4 * n + i] = silu_f(g) * up; }
                u32x4 w; w.x = cvt_pk_bf16(h[0], h[1]); w.y = cvt_pk_bf16(h[2], h[3]); w.z = cvt_pk_bf16(h[4], h[5]); w.w = cvt_pk_bf16(h[6], h[7]);
                *(u32x4*)(H + (size_t)row * ldh + col0) = w;
                asm volatile("" ::: "memory");
            }
    }
};
struct EpiScaleBf16 {
    static constexpr bool PERM = true, AFTER_DRAIN = false;
    bf16_t* O; int ldc; const float* ssp;
    __device__ __forceinline__ void operator()(const f32x4 (&acc)[2][2][4][2], const Unit& u, int wr, int wc, int fr, int fq) const {
        float rs[2][4]; row_rstd(rs, ssp, u, wr, fr, fq);
        const int col0 = u.pn * BM + wc * 32 + 8 * fq;
#pragma unroll
        for (int ai = 0; ai < 2; ++ai)
#pragma unroll
            for (int m = 0; m < 4; ++m) {
                const int row = u.pm * BM + ai * HALF + wr * 64 + m * 16 + fr; const float r = rs[ai][m];
#pragma unroll
                for (int bj = 0; bj < 2; ++bj) { const f32x4 v0 = acc[ai][bj][m][0] * r, v1 = acc[ai][bj][m][1] * r;
                    u32x4 w; w.x = cvt_pk_bf16(v0[0], v0[1]); w.y = cvt_pk_bf16(v0[2], v0[3]); w.z = cvt_pk_bf16(v1[0], v1[1]); w.w = cvt_pk_bf16(v1[2], v1[3]);
                    *(u32x4*)(O + (size_t)row * ldc + col0 + bj * HALF) = w; }
                asm volatile("" ::: "memory");
            }
    }
};
struct EpiResid {
    static constexpr bool PERM = true, AFTER_DRAIN = false;
    const float* xold; float* xnew; bf16_t* xb; float* ssp; float scale;
    __device__ __forceinline__ void operator()(const f32x4 (&acc)[2][2][4][2], const Unit& u, int wr, int wc, int fr, int fq) const {
        const int col0 = u.pn * BM + wc * 32 + 8 * fq;
#pragma unroll
        for (int ai = 0; ai < 2; ++ai)
#pragma unroll
            for (int m = 0; m < 4; ++m) {
                const int row = u.pm * BM + ai * HALF + wr * 64 + m * 16 + fr; float ss = 0.f;
#pragma unroll
                for (int bj = 0; bj < 2; ++bj) { const size_t off = (size_t)row * 1024 + col0 + bj * HALF;
                    const f32x4 o0 = *(const f32x4*)(xold + off), o1 = *(const f32x4*)(xold + off + 4);
                    const f32x4 v0 = o0 + acc[ai][bj][m][0] * scale, v1 = o1 + acc[ai][bj][m][1] * scale;
                    *(f32x4*)(xnew + off) = v0; *(f32x4*)(xnew + off + 4) = v1;
                    u32x4 w; w.x = cvt_pk_bf16(v0[0], v0[1]); w.y = cvt_pk_bf16(v0[2], v0[3]); w.z = cvt_pk_bf16(v1[0], v1[1]); w.w = cvt_pk_bf16(v1[2], v1[3]);
                    *(u32x4*)(xb + off) = w;
                    ss += (v0[0] * v0[0] + v0[1] * v0[1]) + (v0[2] * v0[2] + v0[3] * v0[3]) + (v1[0] * v1[0] + v1[1] * v1[1]) + (v1[2] * v1[2] + v1[3] * v1[3]); }
                ss += xsw<16>(ss); ss = sum32(ss);
                if (fq == 0) ssp[(size_t)row * 16 + u.pn * 4 + wc] = ss;
                asm volatile("" ::: "memory");
            }
    }
};

template <class Epi, class Sched, bool ALIGN_EPI = false, bool SP2 = false>
__device__ __forceinline__ void gemm_phase(PG8_LAS unsigned char* lds, const Gemm g, const Sched& S, const Epi& E, int wave_in) {
    int tid_ = threadIdx.x; asm volatile("" : "+v"(tid_));
    const int tid = tid_, wid = __builtin_amdgcn_readfirstlane(tid >> 6), lane = tid & 63, wr = wid >> 2, wc = wid & 3, fr = lane & 15, fq = lane >> 4;
    const int K = g.K, nt = K / BK;
    unsigned voffA[2], voffB[2];
#pragma unroll
    for (int i = 0; i < 2; ++i) { int R, C; stage_rc(tid * 16 + i * 8192, R, C); const int Rb = Epi::PERM ? ((R & ~31) + perm32(R & 31)) : R;
        voffA[i] = (unsigned)(R * K + C) * 2u; voffB[i] = (unsigned)(Rb * K + C) * 2u; }
    const size_t kstep = (size_t)(BK * 2);
    const size_t hstep = (size_t)HALF * K * 2;
    const size_t tstep = 2 * hstep;
    const unsigned ldsw = (unsigned)wid * 1024u;
    const int aoff = lds_byte(wr * 64 + fr, fq * 8), boff = lds_byte(wc * 32 + fr, fq * 8);
#define PG8_SA(b, h) (((b) * 2 + (h)) * HTB)
#define PG8_SB(b, h) ((4 + (b) * 2 + (h)) * HTB)
#define PG8_STAGE(bufoff, gbase, voff) do { _Pragma("unroll") for (int _i = 0; _i < 2; ++_i) \
        __builtin_amdgcn_global_load_lds((const unsigned*)((const char*)(gbase) + (voff)[_i]), (PG8_LAS unsigned*)(lds + (bufoff) + ldsw + _i * 8192), 16, 0, 0); } while (0)
#define PG8_LDA(dst, b, h) do { _Pragma("unroll") for (int m = 0; m < 4; ++m) _Pragma("unroll") for (int k = 0; k < 2; ++k) dst[m][k] = *(const PG8_LAS bf16x8*)(lds + PG8_SA(b, h) + aoff + m * 2048 + k * 1024); } while (0)
#define PG8_LDB(dst, b, h) do { _Pragma("unroll") for (int n = 0; n < 2; ++n) _Pragma("unroll") for (int k = 0; k < 2; ++k) dst[n][k] = *(const PG8_LAS bf16x8*)(lds + PG8_SB(b, h) + boff + n * 2048 + k * 1024); } while (0)
#define PG8_MMA(ai, bj, At, Bt) do { __builtin_amdgcn_s_setprio(1); _Pragma("unroll") for (int m = 0; m < 4; ++m) _Pragma("unroll") for (int n = 0; n < 2; ++n) _Pragma("unroll") for (int k = 0; k < 2; ++k) \
        acc[ai][bj][m][n] = __builtin_amdgcn_mfma_f32_16x16x32_bf16(Bt[n][k], At[m][k], acc[ai][bj][m][n], 0, 0, 0); __builtin_amdgcn_s_setprio(0); } while (0)
#define PG8_WAIT_V(n) asm volatile("s_waitcnt vmcnt(" #n ")" ::: "memory")
#define PG8_WAIT_L(n) asm volatile("s_waitcnt lgkmcnt(" #n ")" ::: "memory")
#define PG8_BAR __builtin_amdgcn_s_barrier()
#define PG8_SCHED __builtin_amdgcn_sched_barrier(0)
    Unit cur, nxt; int ui = 0;
    if (!S.next(0, cur)) return;
    f32x4 acc[2][2][4][2];
#pragma unroll
    for (int a = 0; a < 2; ++a)
#pragma unroll
        for (int b = 0; b < 2; ++b)
#pragma unroll
            for (int m = 0; m < 4; ++m)
#pragma unroll
                for (int n = 0; n < 2; ++n) acc[a][b][m][n] = (f32x4){0.f, 0.f, 0.f, 0.f};
    bf16x8 At[4][2], B0[2][2], B1[2][2];
    const char* cA = (const char*)g.A + (size_t)cur.pm * tstep; const char* cB = (const char*)g.Bt + (size_t)cur.pn * tstep;
    S.a_ready(cur);
    if constexpr (SP2) {
        PG8_STAGE(PG8_SB(0, 0), cB, voffB); PG8_STAGE(PG8_SB(0, 1), cB + hstep, voffB); PG8_STAGE(PG8_SA(0, 0), cA, voffA); PG8_STAGE(PG8_SA(0, 1), cA + hstep, voffA);
        if (wr == 1) PG8_BAR;
        PG8_WAIT_V(2); PG8_BAR;
        PG8_STAGE(PG8_SB(1, 0), cB + kstep, voffB); PG8_STAGE(PG8_SA(1, 0), cA + kstep, voffA); PG8_STAGE(PG8_SB(1, 1), cB + hstep + kstep, voffB);
        PG8_WAIT_V(6); PG8_BAR;
    } else {
        PG8_STAGE(PG8_SB(0, 0), cB, voffB); PG8_STAGE(PG8_SA(0, 0), cA, voffA); PG8_STAGE(PG8_SB(0, 1), cB + hstep, voffB); PG8_STAGE(PG8_SA(0, 1), cA + hstep, voffA);
        if (wr == 1) PG8_BAR;
        PG8_WAIT_V(4); PG8_BAR;
        PG8_STAGE(PG8_SB(1, 0), cB + kstep, voffB); PG8_STAGE(PG8_SA(1, 0), cA + kstep, voffA); PG8_STAGE(PG8_SB(1, 1), cB + hstep + kstep, voffB);
        PG8_WAIT_V(6); PG8_BAR;
    }
    for (;;) {
        const bool has_next = S.next(ui + 1, nxt);
        const char* nA = has_next ? (const char*)g.A + (size_t)nxt.pm * tstep : cA; const char* nB = has_next ? (const char*)g.Bt + (size_t)nxt.pn * tstep : cB;
        for (int t = 0; t < nt; t += 2) {
            const bool last = (t == nt - 2);
            const char* a1 = cA + (size_t)(t + 1) * kstep;
            const char* a2 = last ? nA : cA + (size_t)(t + 2) * kstep; const char* b2 = last ? nB : cB + (size_t)(t + 2) * kstep;
            const char* a3 = a2 + kstep; const char* b3 = b2 + kstep;
            if (last && has_next) S.a_ready(nxt);
            if constexpr (SP2) {
            PG8_LDB(B0, 0, 0); PG8_LDB(B1, 0, 1); PG8_SCHED; PG8_LDA(At, 0, 0); PG8_STAGE(PG8_SA(1, 1), a1 + hstep, voffA);
            PG8_WAIT_V(8); PG8_WAIT_L(0); PG8_BAR; PG8_MMA(0, 0, At, B0); PG8_MMA(0, 1, At, B1); PG8_BAR; PG8_SCHED;
            PG8_LDA(At, 0, 1); PG8_STAGE(PG8_SB(0, 0), b2, voffB); PG8_STAGE(PG8_SB(0, 1), b2 + hstep, voffB); PG8_STAGE(PG8_SA(0, 0), a2, voffA);
            PG8_WAIT_V(8); PG8_WAIT_L(0); PG8_BAR; PG8_MMA(1, 0, At, B0); PG8_MMA(1, 1, At, B1); PG8_BAR; PG8_SCHED;
            PG8_LDB(B0, 1, 0); PG8_LDB(B1, 1, 1); PG8_SCHED; PG8_LDA(At, 1, 0); PG8_STAGE(PG8_SA(0, 1), a2 + hstep, voffA);
            PG8_WAIT_V(8); PG8_WAIT_L(0); PG8_BAR; PG8_MMA(0, 0, At, B0); PG8_MMA(0, 1, At, B1); PG8_BAR; PG8_SCHED;
            PG8_LDA(At, 1, 1); PG8_STAGE(PG8_SB(1, 0), b3, voffB); PG8_STAGE(PG8_SB(1, 1), b3 + hstep, voffB); PG8_STAGE(PG8_SA(1, 0), a3, voffA);
            PG8_WAIT_V(8); PG8_WAIT_L(0); PG8_BAR; PG8_MMA(1, 0, At, B0); PG8_MMA(1, 1, At, B1); PG8_BAR; PG8_SCHED;
            } else {
            PG8_LDB(B0, 0, 0); PG8_SCHED; PG8_LDA(At, 0, 0); PG8_STAGE(PG8_SA(1, 1), a1 + hstep, voffA);
            PG8_WAIT_L(8); PG8_BAR; PG8_WAIT_L(0); PG8_MMA(0, 0, At, B0); PG8_BAR; PG8_SCHED;
            PG8_LDB(B1, 0, 1); PG8_STAGE(PG8_SB(0, 0), b2, voffB);
            PG8_BAR; PG8_WAIT_L(0); PG8_MMA(0, 1, At, B1); PG8_BAR;
            PG8_LDA(At, 0, 1); PG8_STAGE(PG8_SA(0, 0), a2, voffA);
            PG8_BAR; PG8_WAIT_L(0); PG8_MMA(1, 0, At, B0); PG8_BAR; PG8_SCHED;
            PG8_STAGE(PG8_SB(0, 1), b2 + hstep, voffB);
            PG8_WAIT_V(6); PG8_BAR; PG8_MMA(1, 1, At, B1); PG8_BAR;
            PG8_LDB(B0, 1, 0); PG8_SCHED; PG8_LDA(At, 1, 0); PG8_STAGE(PG8_SA(0, 1), a2 + hstep, voffA);
            PG8_WAIT_L(8); PG8_BAR; PG8_WAIT_L(0); PG8_MMA(0, 0, At, B0); PG8_BAR; PG8_SCHED;
            PG8_LDB(B1, 1, 1); PG8_STAGE(PG8_SB(1, 0), b3, voffB);
            PG8_BAR; PG8_WAIT_L(0); PG8_MMA(0, 1, At, B1); PG8_BAR;
            PG8_LDA(At, 1, 1); PG8_STAGE(PG8_SA(1, 0), a3, voffA);
            PG8_BAR; PG8_WAIT_L(0); PG8_MMA(1, 0, At, B0); PG8_BAR; PG8_SCHED;
            PG8_STAGE(PG8_SB(1, 1), b3 + hstep, voffB);
            PG8_WAIT_V(6); PG8_BAR; PG8_MMA(1, 1, At, B1); PG8_BAR;
            }
        }
        if constexpr (ALIGN_EPI) { if (wr == 0) PG8_BAR; }
        if constexpr (!Epi::AFTER_DRAIN) { E(acc, cur, wr, wc, fr, fq); S.done(cur); }
        if (!has_next) break;
#pragma unroll
        for (int a = 0; a < 2; ++a)
#pragma unroll
            for (int b = 0; b < 2; ++b)
#pragma unroll
                for (int m = 0; m < 4; ++m)
#pragma unroll
                    for (int n = 0; n < 2; ++n) acc[a][b][m][n] = (f32x4){0.f, 0.f, 0.f, 0.f};
        cur = nxt; cA = nA; cB = nB; ++ui;
        if constexpr (ALIGN_EPI) { if (wr == 1) PG8_BAR; }
    }
    PG8_WAIT_V(0);
    if constexpr (!ALIGN_EPI) { if (wr == 0) PG8_BAR; }
    PG8_BAR;
    if constexpr (Epi::AFTER_DRAIN) { E.fused(acc, cur, wr, wc, fr, fq, lds, wid, lane); S.done(cur); }
#undef PG8_SA
#undef PG8_SB
#undef PG8_STAGE
#undef PG8_LDA
#undef PG8_LDB
#undef PG8_MMA
#undef PG8_WAIT_V
#undef PG8_WAIT_L
#undef PG8_BAR
#undef PG8_SCHED
}
}

constexpr int NWAVES = 8, NTHREADS = NWAVES * 64;
constexpr int BATCH = 8, SEQ = 4096, D = 1024, M = BATCH * SEQ, FF = 2816, DEPTH = 4;
constexpr int EVEN_IN = 3584, GLA_IN = 3088, GLA_INP = 3328;
static_assert(M == pg8::MROWS, "row count");
constexpr int E_RQ = 0, E_RK = 512, E_RV = 1024, E_RG = 1536, E_DQ = 2048, E_DK = 2560, E_DV = 3072;
constexpr int G_Q = 0, G_K = 512, G_V = 1024, G_R = 2048, G_A = 3072;
constexpr float EPS = 1e-6f;

constexpr size_t MiB = 1u << 20;
constexpr size_t WS_CTL = 0, CTL_ZERO_BYTES = 1 * MiB;
constexpr size_t WS_SSP = 1 * MiB;
constexpr size_t WS_TAB = 3 * MiB;
constexpr size_t TAB_RC = WS_TAB, TAB_RS = WS_TAB + 1 * MiB, TAB_DC = WS_TAB + 2 * MiB, TAB_DS = WS_TAB + 2 * MiB + 128 * 1024;
constexpr size_t WS_W = 8 * MiB;
constexpr size_t W_GU0 = WS_W, W_D0 = W_GU0 + (size_t)2 * FF * D * 2, W_GU1 = W_D0 + (size_t)D * FF * 2, W_D1 = W_GU1 + (size_t)2 * FF * D * 2,
                 W_IN = W_D1 + (size_t)D * FF * 2, W_OUT = W_IN + (size_t)EVEN_IN * D * 2, W_END = W_OUT + (size_t)D * D * 2;
constexpr size_t WS_XB = 56 * MiB;
constexpr size_t WS_ACT = 120 * MiB;
constexpr size_t WS_CAT = 344 * MiB;
constexpr size_t WS_END = 408 * MiB;
static_assert(W_END <= WS_XB && WS_XB + (size_t)M * D * 2 <= WS_ACT && WS_ACT + (size_t)M * EVEN_IN * 2 <= WS_CAT && WS_CAT + (size_t)M * D * 2 <= WS_END, "d_ws map");
constexpr int CW_BAR = 4096;

constexpr int RING_OFF = 0, RING_BYTES = 131072;
constexpr int LDSCTL_OFF = 161792, MISC_OFF = LDSCTL_OFF + 320, PTR_OFF = LDSCTL_OFF + 1024;
constexpr int LDS_BYTES = 163840;
static_assert(PTR_OFF + 19 * 8 <= LDS_BYTES && RING_BYTES <= LDSCTL_OFF, "LDS map");

#define GAS __attribute__((address_space(1)))
#define LAS __attribute__((address_space(3)))
typedef unsigned short bf16;
typedef unsigned v4u __attribute__((ext_vector_type(4)));
typedef float f32x4 __attribute__((ext_vector_type(4)));
typedef short bf16x8 __attribute__((ext_vector_type(8)));
typedef GAS unsigned gu32;
typedef GAS unsigned long long gu64;
#define RLX_AGENT __ATOMIC_RELAXED, __HIP_MEMORY_SCOPE_AGENT
#define LDS_WAIT() asm volatile("s_waitcnt lgkmcnt(0)" ::: "memory")
#define VM_WAIT() asm volatile("s_waitcnt vmcnt(0)" ::: "memory")
__device__ __forceinline__ unsigned long long rt() { return __builtin_amdgcn_s_memrealtime(); }
__device__ __forceinline__ unsigned f2bf(float f) { unsigned u = __builtin_bit_cast(unsigned, f); return (u + 0x7fffu + ((u >> 16) & 1u)) >> 16; }
__device__ __forceinline__ unsigned pk2(float lo, float hi) { return f2bf(lo) | (f2bf(hi) << 16); }

#define XB_TMO      128
#define XB_XCNT(j)  (256  + 64 * (j))
#define XB_XSUB(j)  (1280 + 64 * (j))
#define XB_XGEN(j)  (2304 + 64 * (j))
#define XB_TOP      3328
#define XB_TOPGEN   3392
#define XCD_BAR_WORDS 3456
#define XB_SPIN_CAP (1u << 18)

__device__ __forceinline__ unsigned xb_ld(unsigned* p)              { return __hip_atomic_load(p, __ATOMIC_RELAXED, __HIP_MEMORY_SCOPE_AGENT); }
__device__ __forceinline__ unsigned xb_add(unsigned* p, unsigned v) { return __hip_atomic_fetch_add(p, v, __ATOMIC_RELAXED, __HIP_MEMORY_SCOPE_AGENT); }
__device__ __forceinline__ unsigned xb_xcc_id() { return (unsigned)__builtin_amdgcn_s_getreg((3 << 11) | 20) & 0xFu; }
#define XB_SPIN(cond, bar) do { unsigned _sp = 0; while (cond) { __builtin_amdgcn_s_sleep(1); \
    if ((++_sp & 255u) == 0u) { if (xb_ld(&(bar)[XB_TMO])) break; if (_sp > XB_SPIN_CAP) { atomicAdd(&(bar)[XB_TMO], 1u); break; } } } } while (0)

struct XcdBarrier {
    unsigned* bar; unsigned x;
    volatile LAS unsigned* st;
};

__device__ __forceinline__ XcdBarrier xcd_barrier_post(unsigned* bar, volatile LAS unsigned* st, int tid) {
    XcdBarrier b; b.bar = bar; b.x = xb_xcc_id(); b.st = st;
    if (tid == 0) (void)xb_add(&bar[XB_XCNT(b.x)], 1u);
    return b;
}
__device__ __forceinline__ void xcd_barrier_complete(unsigned* bar, unsigned x, unsigned& nloc, unsigned& nx) {
    const unsigned G = gridDim.x * gridDim.y * gridDim.z;
    unsigned sum, cnt, mine, sp = 0u;
    for (;;) {
        sum = 0u; cnt = 0u; mine = 0u;
#pragma unroll
        for (unsigned j = 0; j < 16; ++j) { const unsigned c = xb_ld(&bar[XB_XCNT(j)]); sum += c; cnt += (c > 0u) ? 1u : 0u; mine = (j == x) ? c : mine; }
        if (sum == G) break;
        __builtin_amdgcn_s_sleep(1);
        if ((++sp & 255u) == 0u) { if (xb_ld(&bar[XB_TMO])) break; if (sp > XB_SPIN_CAP) { atomicAdd(&bar[XB_TMO], 1u); break; } }
    }
    nloc = mine > 0u ? mine : 1u; nx = cnt > 0u ? cnt : 1u;
}

__device__ __forceinline__ void xcd_barrier(const XcdBarrier& b, int tid) {
    asm volatile("s_waitcnt vmcnt(0)" ::: "memory");
    __syncthreads();
    if (tid == 0) {
        unsigned* bar = b.bar;
        __builtin_amdgcn_s_waitcnt(0);
        unsigned nloc = b.st[0], nx = b.st[1];
        if (nloc == 0u) { xcd_barrier_complete(bar, b.x, nloc, nx); b.st[0] = nloc; b.st[1] = nx; }
        const unsigned old = xb_add(&bar[XB_XSUB(b.x)], 1u);
        const unsigned gen = old / nloc;
        if (old + 1u == (gen + 1u) * nloc) {
            __builtin_amdgcn_fence(__ATOMIC_RELEASE, "agent");
            asm volatile("s_waitcnt vmcnt(0)" ::: "memory");
            const unsigned og = xb_add(&bar[XB_TOP], 1u);
            const unsigned tg = og / nx;
            if (og + 1u == (tg + 1u) * nx) xb_add(&bar[XB_TOPGEN], 1u);
            else XB_SPIN(xb_ld(&bar[XB_TOPGEN]) == tg, bar);
            __builtin_amdgcn_fence(__ATOMIC_ACQUIRE, "agent");
            xb_add(&bar[XB_XGEN(b.x)], 1u);
            asm volatile("s_waitcnt vmcnt(0)" ::: "memory");
        } else {
            XB_SPIN(xb_ld(&bar[XB_XGEN(b.x)]) == gen, bar);
            __builtin_amdgcn_fence(__ATOMIC_ACQUIRE, "agent");
            asm volatile("s_waitcnt vmcnt(0)" ::: "memory");
        }
    }
    __syncthreads();
}

__constant__ float RET_FREQ[64] = {1.000000000e+00f, 8.639884591e-01f, 7.464760542e-01f, 6.449466944e-01f, 5.572264791e-01f, 4.814372361e-01f, 4.159561992e-01f, 3.593813777e-01f, 3.105013371e-01f, 2.682695687e-01f, 2.317818105e-01f, 2.002568096e-01f, 1.730195731e-01f, 1.494869143e-01f, 1.291549653e-01f, 1.115883961e-01f, 9.641107172e-02f, 8.329805732e-02f, 7.196855545e-02f, 6.218000501e-02f, 5.372280627e-02f, 4.641588405e-02f, 4.010278732e-02f, 3.464834765e-02f, 2.993577160e-02f, 2.586415969e-02f, 2.234633639e-02f, 1.930697635e-02f, 1.668100432e-02f, 1.441219542e-02f, 1.245197095e-02f, 1.075835899e-02f, 9.295095690e-03f, 8.030855097e-03f, 6.938565988e-03f, 5.994840991e-03f, 5.179473665e-03f, 4.475005437e-03f, 3.866352839e-03f, 3.340484342e-03f, 2.886139788e-03f, 2.493591513e-03f, 2.154434333e-03f, 1.861406374e-03f, 1.608233666e-03f, 1.389495330e-03f, 1.200507861e-03f, 1.037224894e-03f, 8.961503627e-04f, 7.742635789e-04f, 6.689548027e-04f, 5.779692437e-04f, 4.993587499e-04f, 4.314401885e-04f, 3.727593285e-04f, 3.220597573e-04f, 2.782559313e-04f, 2.404099068e-04f, 2.077113895e-04f, 1.794602431e-04f, 1.550515735e-04f, 1.339627634e-04f, 1.157422885e-04f, 9.999999747e-05f};
__constant__ float ROPE_FREQ[8] = {1.000000000e+00f, 1.939227432e-01f, 3.760603070e-02f, 7.292664610e-03f, 1.414213562e-03f, 2.742481884e-04f, 5.318295734e-05f, 1.031338525e-05f};
struct Args { const float* in[17]; float* out; unsigned char* ws; };
enum { I_X = 0, I_PRE_NORM = 1, I_PRE_WG = 2, I_PRE_WU = 3, I_PRE_WD = 4, I_MIX_NORM = 5, I_AB_IN = 6, I_AB_OUT = 7, I_GLA_IN = 8, I_GLA_A2 = 9, I_GLA_BA = 10, I_GLA_OUT = 11,
       I_POST_NORM = 12, I_POST_WG = 13, I_POST_WU = 14, I_POST_WD = 15, I_FINAL = 16, I_OUT = 17, I_WS = 18, N_PTRS = 19 };
struct Frame {
    LAS unsigned char* lds;
    int tid, lane, wave, G, bid;
};
__device__ __forceinline__ unsigned char* tabp(const Frame& F, int idx) {
    int off_ = PTR_OFF + 8 * idx; asm volatile("" : "+s"(off_));
    const volatile LAS unsigned* T = (const volatile LAS unsigned*)(F.lds + off_);
    const unsigned lo = __builtin_amdgcn_readfirstlane(T[0]), hi = __builtin_amdgcn_readfirstlane(T[1]);
    return (unsigned char*)(((unsigned long long)hi << 32) | (unsigned long long)lo);
}
#define AP(idx) ((const float*)tabp(F, idx))
#define WSP() tabp(F, I_WS)
#define OUTP() ((float*)tabp(F, I_OUT))
__device__ __forceinline__ int lnd(int v) { asm volatile("" : "+s"(v)); return v; }
__device__ __forceinline__ int hw_lane() { return (int)__builtin_amdgcn_mbcnt_hi(~0u, __builtin_amdgcn_mbcnt_lo(~0u, 0u)); }
__device__ __forceinline__ Frame relaunder(const Frame& F0) { Frame F = F0; int t_ = threadIdx.x; asm volatile("" : "+v"(t_)); asm volatile("" : "+s"(F.bid)); F.tid = t_; F.lane = F.tid & 63; F.wave = __builtin_amdgcn_readfirstlane(F.tid >> 6);
    unsigned lb_ = 0u; asm volatile("" : "+s"(lb_)); F.lds = F0.lds + lb_; return F; }
__device__ __forceinline__ float wave_sum(float v) {
    v += xsw<1>(v); v += xsw<2>(v); v += xsw<4>(v); v += xsw<8>(v); v += xsw<16>(v);
    return sum32(v);
}
__device__ __forceinline__ float bf2f(bf16 h) { return __builtin_bit_cast(float, (unsigned)h << 16); }
__device__ __forceinline__ float bflo(unsigned w) { return __builtin_bit_cast(float, w << 16); }
__device__ __forceinline__ float bfhi(unsigned w) { return __builtin_bit_cast(float, w & 0xffff0000u); }
__device__ __forceinline__ bf16 f2bf_rne(float f) { return (bf16)f2bf(f); }

__device__ __forceinline__ void tr_item(const float* W, int K, int N, int Npad, const float* gain, bf16* WT, int gu, LAS float* scr, int item, int lane) {
    const int nblk = Npad / 32, kb = item / nblk, nb = item % nblk, k0 = 64 * kb, n0 = 32 * nb;
    const int nn = n0 + (lane & 31); const bool ok = nn < N;
#pragma unroll 8
    for (int i = 0; i < 32; ++i) { const int kk = 2 * i + (lane >> 5); float w = ok ? W[(size_t)(k0 + kk) * N + nn] : 0.f; if (gain) w *= gain[k0 + kk]; scr[kk * 33 + (lane & 31)] = w; }
    LDS_WAIT(); asm volatile("" ::: "memory");
    const int c = lane & 7;
#pragma unroll
    for (int j = 0; j < 4; ++j) { const int n = (lane >> 3) + 8 * j; const LAS float* s = scr + (8 * c) * 33 + n;
        v4u o; o.x = pk2(s[0 * 33], s[1 * 33]); o.y = pk2(s[2 * 33], s[3 * 33]); o.z = pk2(s[4 * 33], s[5 * 33]); o.w = pk2(s[6 * 33], s[7 * 33]);
        int drow = n0 + n; if (gu) drow = (drow >> 7) * 256 + (drow & 127) + (gu == 2 ? 128 : 0);
        *(GAS v4u*)(WT + (size_t)drow * K + k0 + 8 * c) = o; }
    LDS_WAIT(); asm volatile("" ::: "memory");
}
__device__ __forceinline__ void convert_weights(const Frame& F0, int l) {
    const Frame F = relaunder(F0);
    LAS float* scr = (LAS float*)(F.lds + RING_OFF + F.wave * 16384);
    const int gw = F.bid * NWAVES + F.wave, NGW = F.G * NWAVES;
    unsigned char* ws = WSP();
    constexpr int I_G = (D / 64) * (FF / 32), I_DN = (FF / 64) * (D / 32), I_O = (D / 64) * (D / 32);
    const bool odd = (l & 1) != 0; const int li = l >> 1;
    const int nin = odd ? GLA_IN : EVEN_IN, ninp = odd ? GLA_INP : EVEN_IN; const int I_IN = (D / 64) * (ninp / 32);
    const float* win = odd ? AP(I_GLA_IN) + (size_t)li * D * GLA_IN : AP(I_AB_IN) + (size_t)li * D * EVEN_IN;
    const float* wout = odd ? AP(I_GLA_OUT) + (size_t)li * D * D : AP(I_AB_OUT) + (size_t)li * D * D;
    const size_t fo = (size_t)l * D * FF;
    const int NITEMS = 6 * I_G + I_IN + I_O;
    static_assert(I_G == I_DN, "item counts");
    for (int it = gw; it < NITEMS; it += NGW) {
        int r = it;
        if (r < I_G) { tr_item(AP(I_PRE_WG) + fo, D, FF, FF, AP(I_PRE_NORM) + l * D, (bf16*)(ws + W_GU0), 1, scr, r, F.lane); continue; } r -= I_G;
        if (r < I_G) { tr_item(AP(I_PRE_WU) + fo, D, FF, FF, AP(I_PRE_NORM) + l * D, (bf16*)(ws + W_GU0), 2, scr, r, F.lane); continue; } r -= I_G;
        if (r < I_G) { tr_item(AP(I_PRE_WD) + fo, FF, D, D, nullptr, (bf16*)(ws + W_D0), 0, scr, r, F.lane); continue; } r -= I_G;
        if (r < I_G) { tr_item(AP(I_POST_WG) + fo, D, FF, FF, AP(I_POST_NORM) + l * D, (bf16*)(ws + W_GU1), 1, scr, r, F.lane); continue; } r -= I_G;
        if (r < I_G) { tr_item(AP(I_POST_WU) + fo, D, FF, FF, AP(I_POST_NORM) + l * D, (bf16*)(ws + W_GU1), 2, scr, r, F.lane); continue; } r -= I_G;
        if (r < I_G) { tr_item(AP(I_POST_WD) + fo, FF, D, D, nullptr, (bf16*)(ws + W_D1), 0, scr, r, F.lane); continue; } r -= I_G;
        if (r < I_IN) { tr_item(win, D, nin, ninp, AP(I_MIX_NORM) + l * D, (bf16*)(ws + W_IN), 0, scr, r, F.lane); continue; } r -= I_IN;
        tr_item(wout, D, D, D, nullptr, (bf16*)(ws + W_OUT), 0, scr, r, F.lane);
    }
}
__device__ __forceinline__ void prologue_rows(const Frame& F0) {
    const Frame F = relaunder(F0);
    unsigned char* ws = WSP();
    const int gw = F.bid * NWAVES + F.wave, NGW = F.G * NWAVES;
    bf16* XB = (bf16*)(ws + WS_XB); float* ssp = (float*)(ws + WS_SSP);
    for (int m = gw; m < M; m += NGW) {
        const GAS f32x4* xr = (const GAS f32x4*)(AP(I_X) + (size_t)m * D) + F.lane;
        GAS unsigned long long* o8 = (GAS unsigned long long*)(XB + (size_t)m * D) + F.lane;
        float s = 0.f;
#pragma unroll
        for (int j = 0; j < 4; ++j) { const f32x4 v = xr[64 * j]; s += (v.x * v.x + v.y * v.y) + (v.z * v.z + v.w * v.w);
            o8[64 * j] = (unsigned long long)pk2(v.x, v.y) | ((unsigned long long)pk2(v.z, v.w) << 32); }
        s = wave_sum(s);
        if (F.lane < 16) ssp[(size_t)m * 16 + F.lane] = (F.lane == 0) ? s : 0.f;
    }
    const int gt = F.bid * NTHREADS + F.tid, NGT = F.G * NTHREADS;
    float* rc = (float*)(ws + TAB_RC); float* rsn = (float*)(ws + TAB_RS); float* dc = (float*)(ws + TAB_DC); float* ds = (float*)(ws + TAB_DS);
    for (int e = gt; e < SEQ * 64; e += NGT) { const int t = e >> 6, i = e & 63; const float ang = (float)t * RET_FREQ[i];
        double rev = (double)ang * 0.15915494309189535; rev -= __builtin_rint(rev); const float r = (float)rev;
        rc[e] = __builtin_amdgcn_cosf(r); rsn[e] = __builtin_amdgcn_sinf(r); }
    for (int e = gt; e < SEQ * 8; e += NGT) { const int t = e >> 3, i = e & 7; const float ang = (float)t * ROPE_FREQ[i];
        double rev = (double)ang * 0.15915494309189535; rev -= __builtin_rint(rev); const float r = (float)rev;
        dc[e] = __builtin_amdgcn_cosf(r); ds[e] = __builtin_amdgcn_sinf(r); }
}

__device__ __forceinline__ void even_prep(const Frame& F0) {
    const Frame F = relaunder(F0);
    unsigned char* ws = WSP();
    const int gw = F.bid * NWAVES + F.wave, NGW = F.G * NWAVES;
    bf16* P = (bf16*)(ws + WS_ACT);
    const float* rc = (const float*)(ws + TAB_RC); const float* rsn = (const float*)(ws + TAB_RS); const float* dc = (const float*)(ws + TAB_DC); const float* ds = (const float*)(ws + TAB_DS);
    for (int m = gw; m < M; m += NGW) {
        const int pos = m & (SEQ - 1); bf16* row = P + (size_t)m * EVEN_IN;
        const float c = rc[pos * 64 + F.lane], s = rsn[pos * 64 + F.lane];
#pragma unroll
        for (int h = 0; h < 4; ++h) {
            { bf16* p1 = row + E_RQ + h * 128 + F.lane; bf16* p2 = p1 + 64; const float x1 = bf2f(*p1), x2 = bf2f(*p2); *p1 = f2bf_rne(x1 * c - x2 * s); *p2 = f2bf_rne(x2 * c + x1 * s); }
            { bf16* p1 = row + E_RK + h * 128 + F.lane; bf16* p2 = p1 + 64; const float x1 = bf2f(*p1), x2 = bf2f(*p2);
              *p1 = f2bf_rne((x1 * c - x2 * s) * 0.08838834764831845f); *p2 = f2bf_rne((x2 * c + x1 * s) * 0.08838834764831845f); }
        }
        { const int h = F.lane >> 3, i = F.lane & 7; const float c2 = dc[pos * 8 + i], s2 = ds[pos * 8 + i];
          { bf16* p1 = row + E_DQ + h * 64 + i; bf16* p2 = p1 + 8; const float x1 = bf2f(*p1), x2 = bf2f(*p2); *p1 = f2bf_rne(x1 * c2 - x2 * s2); *p2 = f2bf_rne(x2 * c2 + x1 * s2); }
          { bf16* p1 = row + E_DK + h * 64 + i; bf16* p2 = p1 + 8; const float x1 = bf2f(*p1), x2 = bf2f(*p2); *p1 = f2bf_rne(x1 * c2 - x2 * s2); *p2 = f2bf_rne(x2 * c2 + x1 * s2); } }
    }
}
__device__ __forceinline__ void even_core(const Frame& F0) {
    const Frame F = relaunder(F0);
    unsigned char* ws = WSP();
    const bf16* P = (const bf16*)(ws + WS_ACT);
    if (F.bid < 128) {
        const int b = F.bid >> 4, h = (F.bid >> 2) & 3, eg = F.bid & 3, e = eg * 32 + (F.tid >> 4), dq = F.tid & 15;
        const float g = 1.0f - exp2f(-5.0f - (float)h);
        float* oraw = (float*)(ws + WS_XB);
        const bf16* base = P + (size_t)b * SEQ * EVEN_IN;
        float S[8];
#pragma unroll
        for (int i = 0; i < 8; ++i) S[i] = 0.f;
        v4u qn = *(const GAS v4u*)(base + E_RQ + h * 128 + dq * 8), kn = *(const GAS v4u*)(base + E_RK + h * 128 + dq * 8); bf16 vn = base[E_RV + h * 128 + e];
        for (int t = 0; t < SEQ; ++t) {
            const v4u q = qn, k = kn; const float v = bf2f(vn);
            if (t + 1 < SEQ) { const bf16* nb = base + (size_t)(t + 1) * EVEN_IN; qn = *(const GAS v4u*)(nb + E_RQ + h * 128 + dq * 8); kn = *(const GAS v4u*)(nb + E_RK + h * 128 + dq * 8); vn = nb[E_RV + h * 128 + e]; }
            float o = 0.f;
#pragma unroll
            for (int i = 0; i < 4; ++i) { const unsigned qw = q[i], kw = k[i];
                S[2 * i] = g * S[2 * i] + bflo(kw) * v; S[2 * i + 1] = g * S[2 * i + 1] + bfhi(kw) * v;
                o += bflo(qw) * S[2 * i]; o += bfhi(qw) * S[2 * i + 1]; }
            o += xsw<1>(o); o += xsw<2>(o); o += xsw<4>(o); o += xsw<8>(o);
            if (dq == 0) oraw[((size_t)b * SEQ + t) * 512 + h * 128 + e] = o;
        }
    } else {
        bf16* CAT = (bf16*)(ws + WS_CAT);
        for (int it = F.bid - 128; it < BATCH * (SEQ / 64); it += F.G - 128) {
            const int b = it >> 6, t = (it & 63) * 64 + F.lane, h = F.wave;
            const bf16* base = P + (size_t)b * SEQ * EVEN_IN;
            float q[64];
            { const GAS v4u* qp = (const GAS v4u*)(base + (size_t)t * EVEN_IN + E_DQ + h * 64);
#pragma unroll
              for (int j = 0; j < 8; ++j) { const v4u w = qp[j];
#pragma unroll
                  for (int i = 0; i < 4; ++i) { q[8 * j + 2 * i] = bflo(w[i]) * (0.125f * 1.4426950408889634f); q[8 * j + 2 * i + 1] = bfhi(w[i]) * (0.125f * 1.4426950408889634f); } } }
            float o[64];
#pragma unroll
            for (int i = 0; i < 64; ++i) o[i] = 0.f;
            float mx = -INFINITY, l = 0.f;
            for (int p = 0; p < 3; ++p) {
                const int dil = (p == 0) ? 1 : (p == 1) ? 4 : 16;
                for (int j = 0; j <= 128; ++j) {
                    const int tk = t - j * dil;
                    if (tk >= 0) {
                        const GAS v4u* kp = (const GAS v4u*)(base + (size_t)tk * EVEN_IN + E_DK + h * 64);
                        const GAS v4u* vp = (const GAS v4u*)(base + (size_t)tk * EVEN_IN + E_DV + h * 64);
                        float s = 0.f;
#pragma unroll
                        for (int jj = 0; jj < 8; ++jj) { const v4u w = kp[jj];
#pragma unroll
                            for (int i = 0; i < 4; ++i) { s += q[8 * jj + 2 * i] * bflo(w[i]); s += q[8 * jj + 2 * i + 1] * bfhi(w[i]); } }
                        const float mn = fmaxf(mx, s), corr = __builtin_amdgcn_exp2f(mx - mn), pe = __builtin_amdgcn_exp2f(s - mn);
                        l = l * corr + pe; mx = mn;
#pragma unroll
                        for (int jj = 0; jj < 8; ++jj) { const v4u w = vp[jj];
#pragma unroll
                            for (int i = 0; i < 4; ++i) { o[8 * jj + 2 * i] = o[8 * jj + 2 * i] * corr + pe * bflo(w[i]); o[8 * jj + 2 * i + 1] = o[8 * jj + 2 * i + 1] * corr + pe * bfhi(w[i]); } }
                    }
                }
            }
            const float rl = 1.0f / l;
            GAS v4u* op = (GAS v4u*)(CAT + ((size_t)b * SEQ + t) * D + 512 + h * 64);
#pragma unroll
            for (int j = 0; j < 8; ++j) { v4u w; w.x = pk2(o[8 * j] * rl, o[8 * j + 1] * rl); w.y = pk2(o[8 * j + 2] * rl, o[8 * j + 3] * rl); w.z = pk2(o[8 * j + 4] * rl, o[8 * j + 5] * rl); w.w = pk2(o[8 * j + 6] * rl, o[8 * j + 7] * rl); op[j] = w; }
        }
    }
}
__device__ __forceinline__ void even_post(const Frame& F0) {
    const Frame F = relaunder(F0);
    unsigned char* ws = WSP();
    const int gw = F.bid * NWAVES + F.wave, NGW = F.G * NWAVES;
    const bf16* P = (const bf16*)(ws + WS_ACT); const float* oraw = (const float*)(ws + WS_XB); bf16* CAT = (bf16*)(ws + WS_CAT);
    for (int it = gw; it < M * 4; it += NGW) {
        const int m = it >> 2, h = it & 3;
        const float* op = oraw + (size_t)m * 512 + h * 128 + 2 * F.lane; const float o0 = op[0], o1 = op[1];
        const float mu = wave_sum(o0 + o1) * (1.0f / 128.0f); const float d0 = o0 - mu, d1 = o1 - mu;
        const float var = wave_sum(d0 * d0 + d1 * d1) * (1.0f / 128.0f); const float rstd = 1.0f / sqrtf(var + EPS);
        const unsigned gw2 = *(const unsigned*)(P + (size_t)m * EVEN_IN + E_RG + h * 128 + 2 * F.lane); const float g0 = bflo(gw2), g1 = bfhi(gw2);
        const float y0 = d0 * rstd * (g0 / (1.0f + expf(-g0))), y1 = d1 * rstd * (g1 / (1.0f + expf(-g1)));
        *(unsigned*)(CAT + (size_t)m * D + h * 128 + 2 * F.lane) = pk2(y0, y1);
    }
}
__device__ __forceinline__ void gla_prep(const Frame& F0, int li) {
    const Frame F = relaunder(F0);
    unsigned char* ws = WSP();
    const int gt = F.bid * NTHREADS + F.tid, NGT = F.G * NTHREADS;
    const bf16* P = (const bf16*)(ws + WS_ACT); float* A = (float*)(ws + WS_CAT);
    const float* w2 = AP(I_GLA_A2) + (size_t)li * 16 * 512; const float* ba = AP(I_GLA_BA) + (size_t)li * 512;
    for (int e = gt; e < M * 512; e += NGT) {
        const int m = e >> 9, c = e & 511; const bf16* al = P + (size_t)m * GLA_INP + G_A;
        float z = ba[c];
#pragma unroll
        for (int j = 0; j < 16; ++j) z += bf2f(al[j]) * w2[j * 512 + c];
        const float ls = fminf(z, 0.f) - log1pf(expf(-fabsf(z)));
        A[e] = expf(ls * (1.0f / 16.0f));
    }
}
__device__ __forceinline__ void gla_core(const Frame& F0) {
    const Frame F = relaunder(F0);
    unsigned char* ws = WSP();
    const bf16* P = (const bf16*)(ws + WS_ACT); const float* A = (const float*)(ws + WS_CAT); bf16* oraw = (bf16*)(ws + WS_XB);
    const int b = F.bid >> 5, h = (F.bid >> 3) & 3, eg = F.bid & 7, e = eg * 32 + (F.tid >> 4), dq = F.tid & 15;
    const bf16* base = P + (size_t)b * SEQ * GLA_INP; const float* abase = A + (size_t)b * SEQ * 512 + h * 128 + dq * 8;
    float S[8];
#pragma unroll
    for (int i = 0; i < 8; ++i) S[i] = 0.f;
    v4u qn = *(const GAS v4u*)(base + G_Q + h * 128 + dq * 8), kn = *(const GAS v4u*)(base + G_K + h * 128 + dq * 8); bf16 vn = base[G_V + h * 256 + e];
    f32x4 a0n = *(const GAS f32x4*)(abase), a1n = *(const GAS f32x4*)(abase + 4);
    for (int t = 0; t < SEQ; ++t) {
        const v4u q = qn, k = kn; const float v = bf2f(vn); const f32x4 a0 = a0n, a1 = a1n;
        if (t + 1 < SEQ) { const bf16* nb = base + (size_t)(t + 1) * GLA_INP; qn = *(const GAS v4u*)(nb + G_Q + h * 128 + dq * 8); kn = *(const GAS v4u*)(nb + G_K + h * 128 + dq * 8); vn = nb[G_V + h * 256 + e];
            a0n = *(const GAS f32x4*)(abase + (size_t)(t + 1) * 512); a1n = *(const GAS f32x4*)(abase + (size_t)(t + 1) * 512 + 4); }
        float o = 0.f;
#pragma unroll
        for (int i = 0; i < 4; ++i) { const unsigned qw = q[i], kw = k[i]; const float al = (i < 2) ? a0[2 * i] : a1[2 * i - 4], ah = (i < 2) ? a0[2 * i + 1] : a1[2 * i - 3];
            S[2 * i] = al * S[2 * i] + bflo(kw) * v; S[2 * i + 1] = ah * S[2 * i + 1] + bfhi(kw) * v;
            o += bflo(qw) * S[2 * i]; o += bfhi(qw) * S[2 * i + 1]; }
        o += xsw<1>(o); o += xsw<2>(o); o += xsw<4>(o); o += xsw<8>(o);
        if (dq == 0) oraw[((size_t)b * SEQ + t) * 1024 + h * 256 + e] = f2bf_rne(o * 0.08838834764831845f);
    }
}
__device__ __forceinline__ void gla_post(const Frame& F0) {
    const Frame F = relaunder(F0);
    unsigned char* ws = WSP();
    const int gw = F.bid * NWAVES + F.wave, NGW = F.G * NWAVES;
    const bf16* P = (const bf16*)(ws + WS_ACT); const bf16* oraw = (const bf16*)(ws + WS_XB); bf16* CAT = (bf16*)(ws + WS_CAT);
    for (int it = gw; it < M * 4; it += NGW) {
        const int m = it >> 2, h = it & 3;
        const unsigned long long ow = *(const unsigned long long*)(oraw + (size_t)m * 1024 + h * 256 + 4 * F.lane);
        const float o0 = bflo((unsigned)ow), o1 = bfhi((unsigned)ow), o2 = bflo((unsigned)(ow >> 32)), o3 = bfhi((unsigned)(ow >> 32));
        const float mu = wave_sum((o0 + o1) + (o2 + o3)) * (1.0f / 256.0f); const float d0 = o0 - mu, d1 = o1 - mu, d2 = o2 - mu, d3 = o3 - mu;
        const float var = wave_sum((d0 * d0 + d1 * d1) + (d2 * d2 + d3 * d3)) * (1.0f / 256.0f); const float rstd = 1.0f / sqrtf(var + EPS);
        const unsigned long long gw2 = *(const unsigned long long*)(P + (size_t)m * GLA_INP + G_R + h * 256 + 4 * F.lane);
        const float g0 = bflo((unsigned)gw2), g1 = bfhi((unsigned)gw2), g2 = bflo((unsigned)(gw2 >> 32)), g3 = bfhi((unsigned)(gw2 >> 32));
        const float y0 = d0 * rstd * (g0 / (1.0f + expf(-g0))), y1 = d1 * rstd * (g1 / (1.0f + expf(-g1))), y2 = d2 * rstd * (g2 / (1.0f + expf(-g2))), y3 = d3 * rstd * (g3 / (1.0f + expf(-g3)));
        *(unsigned long long*)(CAT + (size_t)m * D + h * 256 + 4 * F.lane) = (unsigned long long)pk2(y0, y1) | ((unsigned long long)pk2(y2, y3) << 32);
    }
}
__device__ __forceinline__ void final_norm(const Frame& F0) {
    const Frame F = relaunder(F0);
    const int gw = F.bid * NWAVES + F.wave, NGW = F.G * NWAVES;
    for (int m = gw; m < M; m += NGW) {
        GAS f32x4* xr = (GAS f32x4*)(OUTP() + (size_t)m * D) + F.lane; const GAS f32x4* gr = (const GAS f32x4*)AP(I_FINAL) + F.lane;
        f32x4 v[4]; float s = 0.f;
#pragma unroll
        for (int j = 0; j < 4; ++j) { v[j] = xr[64 * j]; s += (v[j].x * v[j].x + v[j].y * v[j].y) + (v[j].z * v[j].z + v[j].w * v[j].w); }
        const float rstd = 1.0f / sqrtf(wave_sum(s) * (1.0f / D) + EPS);
#pragma unroll
        for (int j = 0; j < 4; ++j) xr[64 * j] = v[j] * rstd * gr[64 * j];
    }
}


__device__ __forceinline__ float silu_f(float g) { return g * __builtin_amdgcn_rcpf(1.0f + __builtin_amdgcn_exp2f(-1.4426950408889634f * g)); }
typedef float f32x16 __attribute__((ext_vector_type(16)));
typedef short s16x4 __attribute__((ext_vector_type(4)));
typedef float f32x2_t __attribute__((ext_vector_type(2)));
typedef __bf16 bf16x2_t __attribute__((ext_vector_type(2)));
#define MFMA32(a, b, c) __builtin_amdgcn_mfma_f32_32x32x16_bf16((a), (b), (c), 0, 0, 0)
__device__ __forceinline__ int crow(int reg, int h) { return (reg & 3) + 8 * (reg >> 2) + 4 * h; }
__device__ __forceinline__ unsigned cvtpk(float lo, float hi) { f32x2_t v = {lo, hi}; bf16x2_t b = __builtin_convertvector(v, bf16x2_t); return __builtin_bit_cast(unsigned, b); }
__device__ __forceinline__ bf16 cvt1(float v) { return (bf16)(cvtpk(v, 0.f) & 0xffffu); }
#define PACK_STEP(x, s) __builtin_bit_cast(bf16x8, (v4u){cvtpk((x)[8 * (s)], (x)[8 * (s) + 1]), cvtpk((x)[8 * (s) + 2], (x)[8 * (s) + 3]), cvtpk((x)[8 * (s) + 4], (x)[8 * (s) + 5]), cvtpk((x)[8 * (s) + 6], (x)[8 * (s) + 7])})
typedef const LAS unsigned char* lcp;
__device__ __forceinline__ bf16x8 ld_row(lcp img, int P, int row0, int k0, int r, int h) { return *(const LAS bf16x8*)(img + (row0 + r) * P + (k0 + 8 * h) * 2); }
__device__ __forceinline__ bf16x8 ld_row_perm(lcp img, int P, int row0, int k0, int r, int h) {
    const s16x4 lo = *(const LAS s16x4*)(img + (row0 + r) * P + (k0 + 4 * h) * 2), hi = *(const LAS s16x4*)(img + (row0 + r) * P + (k0 + 8 + 4 * h) * 2);
    return __builtin_shufflevector(lo, hi, 0, 1, 2, 3, 4, 5, 6, 7); }
__device__ __forceinline__ s16x4 trd(lcp p) { return __builtin_bit_cast(s16x4, __builtin_amdgcn_ds_read_tr16_b64_v4i16((LAS s16x4*)p)); }
__device__ __forceinline__ bf16x8 ld_tr(lcp img, int P, int k0, int c0, int lane) {
    const int i16 = lane & 15, q = i16 >> 2, p = i16 & 3, blk = (lane >> 4) & 1, h = lane >> 5;
    lcp a = img + (k0 + 8 * h + q) * P + (c0 + 16 * blk + 4 * p) * 2;
    const s16x4 lo = trd(a), hi = trd(a + 4 * P);
    return __builtin_shufflevector(lo, hi, 0, 1, 2, 3, 4, 5, 6, 7); }
__device__ __forceinline__ bf16x8 ld_tr_perm(lcp img, int P, int k0, int c0, int lane) {
    const int i16 = lane & 15, q = i16 >> 2, p = i16 & 3, blk = (lane >> 4) & 1, h = lane >> 5;
    lcp a = img + (k0 + 4 * h + q) * P + (c0 + 16 * blk + 4 * p) * 2;
    const s16x4 lo = trd(a), hi = trd(a + 8 * P);
    return __builtin_shufflevector(lo, hi, 0, 1, 2, 3, 4, 5, 6, 7); }
template <int R, int C> __device__ __forceinline__ void stage_tile(LAS unsigned char* img, int P, const bf16* g, size_t gp, int tid) {
    constexpr int CPR = C / 8, N = R * CPR;
#pragma unroll
    for (int i = 0; i < (N + NTHREADS - 1) / NTHREADS; ++i) { const int c = tid + i * NTHREADS;
        if (c < N) { const int row = c / CPR, cc = c % CPR; const v4u v = *(const GAS v4u*)(g + (size_t)row * gp + cc * 8); *(LAS v4u*)(img + row * P + cc * 16) = v; } }
}
#define WG_BAR() do { asm volatile("s_waitcnt vmcnt(0) lgkmcnt(0)" ::: "memory"); __builtin_amdgcn_s_barrier(); asm volatile("" ::: "memory"); } while (0)

constexpr int GP128 = 272, GP256 = 528;
constexpr size_t WS_DEC = 6 * MiB;
constexpr float LOG2E = 1.4426950408889634f, LN2 = 0.6931471805599453f;
__device__ __forceinline__ void gla_cumsum(float (&Bc)[2][16], float& Blast, lcp AL, lcp W2, const LAS float* BA, LAS float* EX, int wave, int lane) {
    const int r = lane & 31, h = lane >> 5, db = wave & 3, jh = wave >> 2;
    const bf16x8 wf = *(const LAS bf16x8*)(W2 + (db * 32 + r) * 32 + h * 16);
    const float bias = BA[db * 32 + r];
    float run = 0.f;
#pragma unroll
    for (int t = 0; t < 2; ++t) {
        const bf16x8 af = *(const LAS bf16x8*)(AL + ((jh * 2 + t) * 32 + r) * 32 + h * 16);
        f32x16 z = {0.f, 0.f, 0.f, 0.f, 0.f, 0.f, 0.f, 0.f, 0.f, 0.f, 0.f, 0.f, 0.f, 0.f, 0.f, 0.f};
        z = MFMA32(af, wf, z);
        float own[4], oth[4];
#pragma unroll
        for (int g = 0; g < 4; ++g) {
            float acc = 0.f;
#pragma unroll
            for (int i = 0; i < 4; ++i) { const float zz = z[4 * g + i] + bias;
                const float la = (fminf(zz, 0.f) - LN2 * __builtin_amdgcn_logf(1.0f + __builtin_amdgcn_exp2f(-fabsf(zz) * LOG2E))) * (1.0f / 16.0f);
                acc += la; Bc[t][4 * g + i] = acc; }
            own[g] = acc; oth[g] = oth32(acc, h);
        }
#pragma unroll
        for (int g = 0; g < 4; ++g) { const float off = run + (h ? oth[g] : 0.f);
#pragma unroll
            for (int i = 0; i < 4; ++i) Bc[t][4 * g + i] += off;
            run += own[g] + oth[g]; }
    }
    if (h == 0) EX[jh * 128 + db * 32 + r] = run;
    WG_BAR();
    const float t0 = EX[db * 32 + r], t1 = EX[128 + db * 32 + r];
    Blast = t0 + t1;
    if (jh == 1) {
#pragma unroll
        for (int t = 0; t < 2; ++t)
#pragma unroll
            for (int i = 0; i < 16; ++i) Bc[t][i] += t0; }
}
constexpr int GA_KI = 0, GA_VI = GA_KI + 128 * GP128, GA_KD = GA_VI + 128 * GP256, GA_AL = GA_KD + 128 * GP128, GA_W2 = GA_AL + 4096, GA_BA = GA_W2 + 4096, GA_EX = GA_BA + 512, GA_END = GA_EX + 1024;
constexpr int GC_QT = 0, GC_KT = GC_QT + 128 * GP128, GC_SI = GC_KT + 128 * GP128, GC_VI = GC_SI + 128 * GP128, GC_AL = GC_VI + 128 * GP128, GC_W2 = GC_AL + 4096, GC_BA = GC_W2 + 4096, GC_EX = GC_BA + 512, GC_END = GC_EX + 1024;
constexpr int GC_OI = 0;
static_assert(GA_END <= LDSCTL_OFF && GC_END <= LDSCTL_OFF && 128 * GP256 <= GC_SI, "GLA LDS maps");
__device__ __forceinline__ void gla_stage_small(const Frame& F, LAS unsigned char* AL, LAS unsigned char* W2, LAS float* BA, const bf16* Prow0, int li, int h) {
    if (F.tid < 256) { const int row = F.tid >> 1, cc = F.tid & 1; *(LAS v4u*)(AL + row * 32 + cc * 16) = *(const GAS v4u*)(Prow0 + (size_t)row * GLA_INP + G_A + cc * 8); }
    else if (F.tid < 384) { const int d = F.tid - 256; const float* w2 = AP(I_GLA_A2) + (size_t)li * 16 * 512 + h * 128 + d;
        v4u lo, hi; lo.x = cvtpk(w2[0], w2[512]); lo.y = cvtpk(w2[2 * 512], w2[3 * 512]); lo.z = cvtpk(w2[4 * 512], w2[5 * 512]); lo.w = cvtpk(w2[6 * 512], w2[7 * 512]);
        hi.x = cvtpk(w2[8 * 512], w2[9 * 512]); hi.y = cvtpk(w2[10 * 512], w2[11 * 512]); hi.z = cvtpk(w2[12 * 512], w2[13 * 512]); hi.w = cvtpk(w2[14 * 512], w2[15 * 512]);
        *(LAS v4u*)(W2 + d * 32) = lo; *(LAS v4u*)(W2 + d * 32 + 16) = hi; }
    else { const int d = F.tid - 384; BA[d] = AP(I_GLA_BA)[(size_t)li * 512 + h * 128 + d]; }
}
__device__ __forceinline__ void gla_phase_a(const Frame& F0, int li) {
    const Frame F = relaunder(F0);
    unsigned char* ws = WSP();
    const bf16* P = (const bf16*)(ws + WS_ACT); bf16* SKV = (bf16*)(ws + WS_XB); float* DEC = (float*)(ws + WS_DEC);
    LAS unsigned char* L = F.lds;
    const int lane = F.lane, r = lane & 31, h2 = lane >> 5, wave = F.wave, db = wave & 3, jh = wave >> 2;
    for (int it = F.bid; it < 1024; it += F.G) {
        const int bh = it >> 5, g = it & 31, b = bh >> 2, h = bh & 3;
        const bf16* Prow0 = P + ((size_t)b * SEQ + g * 128) * GLA_INP;
        stage_tile<128, 128>(L + GA_KI, GP128, Prow0 + G_K + h * 128, GLA_INP, F.tid);
        stage_tile<128, 256>(L + GA_VI, GP256, Prow0 + G_V + h * 256, GLA_INP, F.tid);
        gla_stage_small(F, L + GA_AL, L + GA_W2, (LAS float*)(L + GA_BA), Prow0, li, h);
        WG_BAR();
        float Bc[2][16], Blast;
        gla_cumsum(Bc, Blast, L + GA_AL, L + GA_W2, (const LAS float*)(L + GA_BA), (LAS float*)(L + GA_EX), wave, lane);
#pragma unroll
        for (int t = 0; t < 2; ++t)
#pragma unroll
            for (int i = 0; i < 16; ++i) { const int off = ((jh * 2 + t) * 32 + crow(i, h2)) * GP128 + (db * 32 + r) * 2;
                const float kv = bf2f(*(const LAS bf16*)(L + GA_KI + off)) * __builtin_amdgcn_exp2f((Blast - Bc[t][i]) * LOG2E);
                *(LAS bf16*)(L + GA_KD + off) = cvt1(kv); }
        if (jh == 0 && h2 == 0) DEC[(size_t)it * 128 + db * 32 + r] = __builtin_amdgcn_exp2f(Blast * LOG2E);
        WG_BAR();
        f32x16 acc[4];
#pragma unroll
        for (int t = 0; t < 4; ++t) acc[t] = (f32x16){0.f, 0.f, 0.f, 0.f, 0.f, 0.f, 0.f, 0.f, 0.f, 0.f, 0.f, 0.f, 0.f, 0.f, 0.f, 0.f};
#pragma unroll
        for (int ks = 0; ks < 8; ++ks) { const bf16x8 a = ld_tr(L + GA_KD, GP128, 16 * ks, db * 32, lane);
#pragma unroll
            for (int t = 0; t < 4; ++t) acc[t] = MFMA32(a, ld_tr(L + GA_VI, GP256, 16 * ks, (4 * jh + t) * 32, lane), acc[t]); }
        bf16* out = SKV + (size_t)it * 128 * 256;
#pragma unroll
        for (int t = 0; t < 4; ++t)
#pragma unroll
            for (int i = 0; i < 16; ++i) out[(size_t)(db * 32 + crow(i, h2)) * 256 + (4 * jh + t) * 32 + r] = cvt1(acc[t][i]);
        WG_BAR();
    }
}
__device__ __forceinline__ void gla_phase_b(const Frame& F0) {
    const Frame F = relaunder(F0);
    unsigned char* ws = WSP();
    bf16* SKV = (bf16*)(ws + WS_XB); const float* DEC = (const float*)(ws + WS_DEC);
    for (int gt = F.bid * NTHREADS + F.tid; gt < 32 * 128 * 32; gt += F.G * NTHREADS) {
        const int bh = gt >> 12, d = (gt >> 5) & 127, e8 = gt & 31;
        float s[8];
#pragma unroll
        for (int i = 0; i < 8; ++i) s[i] = 0.f;
        for (int g0 = 0; g0 < 32; g0 += 4) {
            v4u kv[4]; float dc[4];
#pragma unroll
            for (int u = 0; u < 4; ++u) { const size_t item = (size_t)bh * 32 + g0 + u; kv[u] = *(const GAS v4u*)(SKV + (item * 128 + d) * 256 + e8 * 8); dc[u] = DEC[item * 128 + d]; }
#pragma unroll
            for (int u = 0; u < 4; ++u) { const size_t item = (size_t)bh * 32 + g0 + u;
                v4u o; o.x = cvtpk(s[0], s[1]); o.y = cvtpk(s[2], s[3]); o.z = cvtpk(s[4], s[5]); o.w = cvtpk(s[6], s[7]);
                *(GAS v4u*)(SKV + (item * 128 + d) * 256 + e8 * 8) = o;
#pragma unroll
                for (int i = 0; i < 4; ++i) { s[2 * i] = dc[u] * s[2 * i] + bflo(kv[u][i]); s[2 * i + 1] = dc[u] * s[2 * i + 1] + bfhi(kv[u][i]); } }
        }
    }
}
__device__ __forceinline__ void gla_phase_c(const Frame& F0, int li) {
    const Frame F = relaunder(F0);
    unsigned char* ws = WSP();
    const bf16* P = (const bf16*)(ws + WS_ACT); const bf16* SKV = (const bf16*)(ws + WS_XB); bf16* CAT = (bf16*)(ws + WS_CAT);
    LAS unsigned char* L = F.lds;
    const int lane = F.lane, r = lane & 31, h2 = lane >> 5, wave = F.wave, db = wave & 3, jh = wave >> 2;
    const int ib = wave & 3, eq = wave >> 2;
    for (int it = F.bid; it < 1024; it += F.G) {
        const int bh = it >> 5, g = it & 31, b = bh >> 2, h = bh & 3;
        const bf16* Prow0 = P + ((size_t)b * SEQ + g * 128) * GLA_INP;
        const bf16* Sg = SKV + (size_t)it * 128 * 256;
        stage_tile<128, 128>(L + GC_QT, GP128, Prow0 + G_Q + h * 128, GLA_INP, F.tid);
        stage_tile<128, 128>(L + GC_KT, GP128, Prow0 + G_K + h * 128, GLA_INP, F.tid);
        stage_tile<128, 128>(L + GC_SI, GP128, Sg, 256, F.tid);
        stage_tile<128, 128>(L + GC_VI, GP128, Prow0 + G_V + h * 256, GLA_INP, F.tid);
        gla_stage_small(F, L + GC_AL, L + GC_W2, (LAS float*)(L + GC_BA), Prow0, li, h);
        WG_BAR();
        {
            float Bc[2][16], Blast;
            gla_cumsum(Bc, Blast, L + GC_AL, L + GC_W2, (const LAS float*)(L + GC_BA), (LAS float*)(L + GC_EX), wave, lane);
#pragma unroll
            for (int t = 0; t < 2; ++t)
#pragma unroll
                for (int i = 0; i < 16; ++i) { const int off = ((jh * 2 + t) * 32 + crow(i, h2)) * GP128 + (db * 32 + r) * 2;
                    const float eb = __builtin_amdgcn_exp2f(Bc[t][i] * LOG2E);
                    const float qv = bf2f(*(const LAS bf16*)(L + GC_QT + off)) * eb * 0.08838834764831845f;
                    const float kv = bf2f(*(const LAS bf16*)(L + GC_KT + off)) * __builtin_amdgcn_rcpf(eb);
                    *(LAS bf16*)(L + GC_QT + off) = cvt1(qv); *(LAS bf16*)(L + GC_KT + off) = cvt1(kv); }
        }
        WG_BAR();
        bf16x8 PA[4][2];
#pragma unroll
        for (int jb = 0; jb < 4; ++jb) {
            if (jb <= ib) {
                f32x16 x = {0.f, 0.f, 0.f, 0.f, 0.f, 0.f, 0.f, 0.f, 0.f, 0.f, 0.f, 0.f, 0.f, 0.f, 0.f, 0.f};
#pragma unroll
                for (int ks = 0; ks < 8; ++ks) x = MFMA32(ld_row(L + GC_KT, GP128, jb * 32, 16 * ks, r, h2), ld_row(L + GC_QT, GP128, ib * 32, 16 * ks, r, h2), x);
                if (jb == ib) {
#pragma unroll
                    for (int i = 0; i < 16; ++i) if (crow(i, h2) > r) x[i] = 0.f; }
                PA[jb][0] = PACK_STEP(x, 0); PA[jb][1] = PACK_STEP(x, 1);
            } else { PA[jb][0] = (bf16x8){0, 0, 0, 0, 0, 0, 0, 0}; PA[jb][1] = (bf16x8){0, 0, 0, 0, 0, 0, 0, 0}; }
        }
        f32x16 o[2][2];
#pragma unroll
        for (int half = 0; half < 2; ++half) {
            if (half == 1) {
                WG_BAR();
                stage_tile<128, 128>(L + GC_SI, GP128, Sg + 128, 256, F.tid);
                stage_tile<128, 128>(L + GC_VI, GP128, Prow0 + G_V + h * 256 + 128, GLA_INP, F.tid);
                WG_BAR();
            }
#pragma unroll
            for (int t = 0; t < 2; ++t) {
                const int eb = 2 * eq + t;
                f32x16 acc = {0.f, 0.f, 0.f, 0.f, 0.f, 0.f, 0.f, 0.f, 0.f, 0.f, 0.f, 0.f, 0.f, 0.f, 0.f, 0.f};
#pragma unroll
                for (int jb = 0; jb < 4; ++jb) if (jb <= ib) {
#pragma unroll
                    for (int s = 0; s < 2; ++s) acc = MFMA32(PA[jb][s], ld_tr_perm(L + GC_VI, GP128, jb * 32 + 16 * s, eb * 32, lane), acc); }
#pragma unroll
                for (int ks = 0; ks < 8; ++ks) acc = MFMA32(ld_row(L + GC_QT, GP128, ib * 32, 16 * ks, r, h2), ld_tr(L + GC_SI, GP128, 16 * ks, eb * 32, lane), acc);
                o[half][t] = acc;
            }
        }
        WG_BAR();
#pragma unroll
        for (int half = 0; half < 2; ++half)
#pragma unroll
            for (int t = 0; t < 2; ++t)
#pragma unroll
                for (int i = 0; i < 16; ++i) *(LAS bf16*)(L + GC_OI + (ib * 32 + crow(i, h2)) * GP256 + (half * 128 + (2 * eq + t) * 32 + r) * 2) = cvt1(o[half][t][i]);
        WG_BAR();
        {
            const int row = F.tid >> 2, qtr = F.tid & 3;
            lcp orow = L + GC_OI + row * GP256 + qtr * 128;
            float sum = 0.f;
#pragma unroll
            for (int c = 0; c < 8; ++c) { const v4u w = *(const LAS v4u*)(orow + c * 16);
#pragma unroll
                for (int i = 0; i < 4; ++i) sum += bflo(w[i]) + bfhi(w[i]); }
            sum += xsw<1>(sum); sum += xsw<2>(sum);
            const float mu = sum * (1.0f / 256.0f); float sq = 0.f;
#pragma unroll
            for (int c = 0; c < 8; ++c) { const v4u w = *(const LAS v4u*)(orow + c * 16);
#pragma unroll
                for (int i = 0; i < 4; ++i) { const float d0 = bflo(w[i]) - mu, d1 = bfhi(w[i]) - mu; sq += d0 * d0 + d1 * d1; } }
            sq += xsw<1>(sq); sq += xsw<2>(sq);
            const float rstd = 1.0f / sqrtf(sq * (1.0f / 256.0f) + EPS);
            const bf16* gp = Prow0 + (size_t)row * GLA_INP + G_R + h * 256 + qtr * 64;
            bf16* op = CAT + ((size_t)b * SEQ + g * 128 + row) * D + h * 256 + qtr * 64;
#pragma unroll
            for (int c = 0; c < 8; ++c) { const v4u gw = *(const GAS v4u*)(gp + c * 8); const v4u w = *(const LAS v4u*)(orow + c * 16); v4u ow;
#pragma unroll
                for (int i = 0; i < 4; ++i) { const float g0 = bflo(gw[i]), g1 = bfhi(gw[i]);
                    ow[i] = cvtpk((bflo(w[i]) - mu) * rstd * silu_f(g0), (bfhi(w[i]) - mu) * rstd * silu_f(g1)); }
                *(GAS v4u*)(op + c * 8) = ow; asm volatile("" ::: "memory"); }
        }
        WG_BAR();
    }
}


constexpr size_t WS_OD = 408 * MiB;
constexpr size_t WS_LSE = WS_XB + 32 * MiB;
constexpr size_t WS_END2 = 504 * MiB;
constexpr int RP = 272;
constexpr int RA_KI = 0, RA_VD = RA_KI + 128 * RP, RA_END = RA_VD + 128 * RP;
constexpr int RC_QI = 0, RC_KI = RC_QI + 128 * RP, RC_VI = RC_KI + 128 * RP, RC_SI = RC_VI + 128 * RP, RC_END = RC_SI + 128 * RP;
constexpr int DP = 144;
constexpr int DL_KI = 0, DL_VI = DL_KI + 384 * DP, DL_ST = DL_VI + 384 * DP, DL_LW = DL_ST + 8 * 32 * DP, DL_END = DL_LW + 8 * 256;
static_assert(RC_END <= LDSCTL_OFF && DL_END <= LDSCTL_OFF, "even mixer LDS maps");
__device__ __forceinline__ float ret_log2g(int h) { return log2f(1.0f - exp2f(-5.0f - (float)h)); }

__device__ __forceinline__ void ret_phase_a_item(const Frame& F, int it, const bf16* P, bf16* RKV) {
    LAS unsigned char* L = F.lds;
    const int lane = F.lane, r = lane & 31, h2 = lane >> 5, wave = F.wave, db = wave & 3, eh = wave >> 2;
    const int bh = it >> 5, n = it & 31, b = bh >> 2, h = bh & 3;
    const float lg = ret_log2g(h);
    const bf16* Prow0 = P + ((size_t)b * SEQ + n * 128) * EVEN_IN;
    stage_tile<128, 128>(L + RA_KI, RP, Prow0 + E_RK + h * 128, EVEN_IN, F.tid);
    {
        const bf16* gsrc = Prow0 + E_RV + h * 128;
#pragma unroll
        for (int i = 0; i < 4; ++i) { const int c = F.tid + i * NTHREADS, row = c >> 4, cc = c & 15; const float f = __builtin_amdgcn_exp2f(lg * (float)(127 - row));
            const v4u v = *(const GAS v4u*)(gsrc + (size_t)row * EVEN_IN + cc * 8); v4u o;
#pragma unroll
            for (int k = 0; k < 4; ++k) o[k] = cvtpk(bflo(v[k]) * f, bfhi(v[k]) * f);
            *(LAS v4u*)(L + RA_VD + row * RP + cc * 16) = o; }
    }
    WG_BAR();
    f32x16 acc[2];
#pragma unroll
    for (int t = 0; t < 2; ++t) acc[t] = (f32x16){0.f, 0.f, 0.f, 0.f, 0.f, 0.f, 0.f, 0.f, 0.f, 0.f, 0.f, 0.f, 0.f, 0.f, 0.f, 0.f};
#pragma unroll
    for (int ks = 0; ks < 8; ++ks) { const bf16x8 a = ld_tr(L + RA_KI, RP, 16 * ks, db * 32, lane);
#pragma unroll
        for (int t = 0; t < 2; ++t) acc[t] = MFMA32(a, ld_tr(L + RA_VD, RP, 16 * ks, (2 * eh + t) * 32, lane), acc[t]); }
    WG_BAR();
#pragma unroll
    for (int t = 0; t < 2; ++t)
#pragma unroll
        for (int i = 0; i < 16; ++i) *(LAS bf16*)(L + RA_KI + (db * 32 + crow(i, h2)) * RP + ((2 * eh + t) * 32 + r) * 2) = cvt1(acc[t][i]);
    WG_BAR();
    bf16* out = RKV + (size_t)it * 128 * 128;
#pragma unroll
    for (int i = 0; i < 4; ++i) { const int c = F.tid + i * NTHREADS, row = c >> 4, cc = c & 15; *(GAS v4u*)(out + row * 128 + cc * 8) = *(const LAS v4u*)(L + RA_KI + row * RP + cc * 16); }
    WG_BAR();
}
__device__ __forceinline__ void ret_scan(const Frame& F, bf16* RKV) {
    for (int gt = F.bid * NTHREADS + F.tid; gt < 32 * 128 * 16; gt += F.G * NTHREADS) {
        const int bh = gt >> 11, d = (gt >> 4) & 127, e8 = gt & 15, h = bh & 3;
        const float g128 = __builtin_amdgcn_exp2f(ret_log2g(h) * 128.0f);
        float s[8];
#pragma unroll
        for (int i = 0; i < 8; ++i) s[i] = 0.f;
        for (int n0 = 0; n0 < 32; n0 += 4) {
            v4u kv[4];
#pragma unroll
            for (int u = 0; u < 4; ++u) kv[u] = *(const GAS v4u*)(RKV + (((size_t)bh * 32 + n0 + u) * 128 + d) * 128 + e8 * 8);
#pragma unroll
            for (int u = 0; u < 4; ++u) {
                v4u o; o.x = cvtpk(s[0], s[1]); o.y = cvtpk(s[2], s[3]); o.z = cvtpk(s[4], s[5]); o.w = cvtpk(s[6], s[7]);
                *(GAS v4u*)(RKV + (((size_t)bh * 32 + n0 + u) * 128 + d) * 128 + e8 * 8) = o;
#pragma unroll
                for (int i = 0; i < 4; ++i) { s[2 * i] = g128 * s[2 * i] + bflo(kv[u][i]); s[2 * i + 1] = g128 * s[2 * i + 1] + bfhi(kv[u][i]); } }
        }
    }
}
__device__ __forceinline__ void ret_phase_c_item(const Frame& F, int it, const bf16* P, const bf16* RKV, bf16* CAT) {
    LAS unsigned char* L = F.lds;
    const int lane = F.lane, r = lane & 31, h2 = lane >> 5, wave = F.wave, ib = wave & 3, eq = wave >> 2;
    const int bh = it >> 5, n = it & 31, b = bh >> 2, h = bh & 3;
    const float lg = ret_log2g(h);
    const bf16* Prow0 = P + ((size_t)b * SEQ + n * 128) * EVEN_IN;
    {
#pragma unroll
        for (int i = 0; i < 4; ++i) { const int c = F.tid + i * NTHREADS, row = c >> 4, cc = c & 15; const float fq = __builtin_amdgcn_exp2f(lg * (float)row), fk = __builtin_amdgcn_rcpf(fq);
            const v4u vq = *(const GAS v4u*)(Prow0 + (size_t)row * EVEN_IN + E_RQ + h * 128 + cc * 8), vk = *(const GAS v4u*)(Prow0 + (size_t)row * EVEN_IN + E_RK + h * 128 + cc * 8); v4u oq, ok;
#pragma unroll
            for (int k = 0; k < 4; ++k) { oq[k] = cvtpk(bflo(vq[k]) * fq, bfhi(vq[k]) * fq); ok[k] = cvtpk(bflo(vk[k]) * fk, bfhi(vk[k]) * fk); }
            *(LAS v4u*)(L + RC_QI + row * RP + cc * 16) = oq; *(LAS v4u*)(L + RC_KI + row * RP + cc * 16) = ok; }
    }
    stage_tile<128, 128>(L + RC_VI, RP, Prow0 + E_RV + h * 128, EVEN_IN, F.tid);
    stage_tile<128, 128>(L + RC_SI, RP, RKV + (size_t)it * 128 * 128, 128, F.tid);
    WG_BAR();
    bf16x8 PA[4][2];
#pragma unroll
    for (int jb = 0; jb < 4; ++jb) {
        if (jb <= ib) {
            f32x16 x = {0.f, 0.f, 0.f, 0.f, 0.f, 0.f, 0.f, 0.f, 0.f, 0.f, 0.f, 0.f, 0.f, 0.f, 0.f, 0.f};
#pragma unroll
            for (int ks = 0; ks < 8; ++ks) x = MFMA32(ld_row(L + RC_KI, RP, jb * 32, 16 * ks, r, h2), ld_row(L + RC_QI, RP, ib * 32, 16 * ks, r, h2), x);
            if (jb == ib) {
#pragma unroll
                for (int i = 0; i < 16; ++i) if (crow(i, h2) > r) x[i] = 0.f; }
            PA[jb][0] = PACK_STEP(x, 0); PA[jb][1] = PACK_STEP(x, 1);
        } else { PA[jb][0] = (bf16x8){0, 0, 0, 0, 0, 0, 0, 0}; PA[jb][1] = (bf16x8){0, 0, 0, 0, 0, 0, 0, 0}; }
    }
    f32x16 o[2];
#pragma unroll
    for (int t = 0; t < 2; ++t) {
        const int eb = 2 * eq + t;
        f32x16 z = {0.f, 0.f, 0.f, 0.f, 0.f, 0.f, 0.f, 0.f, 0.f, 0.f, 0.f, 0.f, 0.f, 0.f, 0.f, 0.f}, y = z;
#pragma unroll
        for (int jb = 0; jb < 4; ++jb) if (jb <= ib) {
#pragma unroll
            for (int s = 0; s < 2; ++s) z = MFMA32(PA[jb][s], ld_tr_perm(L + RC_VI, RP, jb * 32 + 16 * s, eb * 32, lane), z); }
#pragma unroll
        for (int ks = 0; ks < 8; ++ks) y = MFMA32(ld_row(L + RC_QI, RP, ib * 32, 16 * ks, r, h2), ld_tr(L + RC_SI, RP, 16 * ks, eb * 32, lane), y);
        const float g1 = __builtin_amdgcn_exp2f(lg);
#pragma unroll
        for (int i = 0; i < 16; ++i) z[i] += y[i] * g1;
        o[t] = z;
    }
    WG_BAR();
#pragma unroll
    for (int t = 0; t < 2; ++t)
#pragma unroll
        for (int i = 0; i < 16; ++i) *(LAS bf16*)(L + RC_QI + (ib * 32 + crow(i, h2)) * RP + ((2 * eq + t) * 32 + r) * 2) = cvt1(o[t][i]);
    WG_BAR();
    {
        const int row = F.tid >> 2, qtr = F.tid & 3;
        lcp orow = L + RC_QI + row * RP + qtr * 64;
        v4u w[4]; float sum = 0.f;
#pragma unroll
        for (int c = 0; c < 4; ++c) { w[c] = *(const LAS v4u*)(orow + c * 16);
#pragma unroll
            for (int i = 0; i < 4; ++i) sum += bflo(w[c][i]) + bfhi(w[c][i]); }
        sum += xsw<1>(sum); sum += xsw<2>(sum);
        const float mu = sum * (1.0f / 128.0f); float sq = 0.f;
#pragma unroll
        for (int c = 0; c < 4; ++c)
#pragma unroll
            for (int i = 0; i < 4; ++i) { const float d0 = bflo(w[c][i]) - mu, d1 = bfhi(w[c][i]) - mu; sq += d0 * d0 + d1 * d1; }
        sq += xsw<1>(sq); sq += xsw<2>(sq);
        const float rstd = 1.0f / sqrtf(sq * (1.0f / 128.0f) + EPS);
        const bf16* gp = Prow0 + (size_t)row * EVEN_IN + E_RG + h * 128 + qtr * 32;
        bf16* op = CAT + ((size_t)b * SEQ + n * 128 + row) * D + h * 128 + qtr * 32;
#pragma unroll
        for (int c = 0; c < 4; ++c) { const v4u gw = *(const GAS v4u*)(gp + c * 8); v4u ow;
#pragma unroll
            for (int i = 0; i < 4; ++i) { const float g0 = bflo(gw[i]), g1 = bfhi(gw[i]);
                ow[i] = cvtpk((bflo(w[c][i]) - mu) * rstd * silu_f(g0), (bfhi(w[c][i]) - mu) * rstd * silu_f(g1)); }
            *(GAS v4u*)(op + c * 8) = ow; }
    }
    WG_BAR();
}
__device__ __forceinline__ void dil_tile(const Frame& F, int T, const bf16* P, bf16* OD, float* LSE) {
    LAS unsigned char* L = F.lds;
    const int lane = F.lane, r = lane & 31, h2 = lane >> 5, wave = F.wave;
    const int b = T / 384, rem = T - b * 384, head = rem / 48, t48 = rem - head * 48, p = t48 >> 4, idx = t48 & 15;
    const int sh = 2 * p, dil = 1 << sh, res = idx & (dil - 1), blk = idx >> sh, q0 = blk * 256;
    const bf16* Pb = P + (size_t)b * SEQ * EVEN_IN + head * 64;
#pragma unroll
    for (int i = 0; i < 6; ++i) { const int c = F.tid + i * NTHREADS, row = c >> 3, cc = c & 7; int kidx = q0 - 128 + row; kidx = kidx < 0 ? 0 : kidx;
        const bf16* src = Pb + (size_t)(kidx * dil + res) * EVEN_IN + cc * 8;
        const v4u kv = *(const GAS v4u*)(src + E_DK), vv = *(const GAS v4u*)(src + E_DV);
        *(LAS v4u*)(L + DL_KI + row * DP + cc * 16) = kv; *(LAS v4u*)(L + DL_VI + row * DP + cc * 16) = vv; }
    bf16x8 qf[4];
    { const bf16* qsrc = Pb + (size_t)((q0 + 32 * wave + r) * dil + res) * EVEN_IN + E_DQ + 8 * h2;
#pragma unroll
      for (int ks = 0; ks < 4; ++ks) qf[ks] = *(const GAS bf16x8*)(qsrc + 16 * ks); }
    WG_BAR();
    f32x16 x[5];
    float mx = -INFINITY;
#pragma unroll
    for (int kb = 0; kb < 5; ++kb) {
        f32x16 a = {0.f, 0.f, 0.f, 0.f, 0.f, 0.f, 0.f, 0.f, 0.f, 0.f, 0.f, 0.f, 0.f, 0.f, 0.f, 0.f};
#pragma unroll
        for (int ks = 0; ks < 4; ++ks) a = MFMA32(ld_row(L + DL_KI, DP, 32 * wave + 32 * kb, 16 * ks, r, h2), qf[ks], a);
        if (kb == 0) {
#pragma unroll
            for (int i = 0; i < 16; ++i) if (crow(i, h2) < r) a[i] = -INFINITY; }
        if (kb == 4) {
#pragma unroll
            for (int i = 0; i < 16; ++i) if (crow(i, h2) > r) a[i] = -INFINITY; }
        if (q0 == 0 && 32 * wave + 32 * kb < 128) {
#pragma unroll
            for (int i = 0; i < 16; ++i) a[i] = -INFINITY; }
#pragma unroll
        for (int i = 0; i < 16; ++i) mx = fmaxf(mx, a[i]);
        x[kb] = a;
    }
    mx = max32(mx);
    constexpr float C2 = 0.125f * LOG2E;
    const float mc = mx * C2; float l = 0.f;
#pragma unroll
    for (int kb = 0; kb < 5; ++kb)
#pragma unroll
        for (int i = 0; i < 16; ++i) { const float pe = __builtin_amdgcn_exp2f(x[kb][i] * C2 - mc); x[kb][i] = pe; l += pe; }
    l = sum32(l);
    f32x16 o[2];
#pragma unroll
    for (int dbk = 0; dbk < 2; ++dbk) o[dbk] = (f32x16){0.f, 0.f, 0.f, 0.f, 0.f, 0.f, 0.f, 0.f, 0.f, 0.f, 0.f, 0.f, 0.f, 0.f, 0.f, 0.f};
#pragma unroll
    for (int kb = 0; kb < 5; ++kb)
#pragma unroll
        for (int s = 0; s < 2; ++s) { const bf16x8 pa = PACK_STEP(x[kb], s);
#pragma unroll
            for (int dbk = 0; dbk < 2; ++dbk) o[dbk] = MFMA32(pa, ld_tr_perm(L + DL_VI, DP, 32 * wave + 32 * kb + 16 * s, dbk * 32, lane), o[dbk]); }
    LAS float* lw = (LAS float*)(L + DL_LW + wave * 256);
    if (h2 == 0) lw[r] = l;
    LAS unsigned char* st = L + DL_ST + wave * 32 * DP;
#pragma unroll
    for (int i = 0; i < 16; ++i) { const float rl = __builtin_amdgcn_rcpf(lw[crow(i, h2)]);
#pragma unroll
        for (int dbk = 0; dbk < 2; ++dbk) *(LAS bf16*)(st + crow(i, h2) * DP + (dbk * 32 + r) * 2) = cvt1(o[dbk][i] * rl); }
    const size_t tokbase = (size_t)b * SEQ;
    bf16* odp = OD + (size_t)p * M * 512;
#pragma unroll
    for (int j = 0; j < 4; ++j) { const int c = lane + 64 * j, row = c >> 3, cc = c & 7; const size_t tok = tokbase + (size_t)(q0 + 32 * wave + row) * dil + res;
        *(GAS v4u*)(odp + tok * 512 + head * 64 + cc * 8) = *(const LAS v4u*)(st + row * DP + cc * 16); }
    if (h2 == 0) { const size_t tok = tokbase + (size_t)(q0 + 32 * wave + r) * dil + res; LSE[((size_t)p * M + tok) * 8 + head] = mx * 0.125f + LN2 * __builtin_amdgcn_logf(l); }
    WG_BAR();
}
__device__ __forceinline__ void dil_combine(const Frame& F, const bf16* OD, const float* LSE, bf16* CAT) {
    for (int gt = F.bid * NTHREADS + F.tid; gt < M * 64; gt += F.G * NTHREADS) {
        const int tok = gt >> 6, c8 = gt & 63, head = c8 >> 3;
        const float l0 = LSE[(size_t)tok * 8 + head], l1 = LSE[((size_t)M + tok) * 8 + head], l2 = LSE[((size_t)2 * M + tok) * 8 + head];
        const float mxl = fmaxf(l0, fmaxf(l1, l2));
        float w0 = __builtin_amdgcn_exp2f((l0 - mxl) * LOG2E), w1 = __builtin_amdgcn_exp2f((l1 - mxl) * LOG2E), w2 = __builtin_amdgcn_exp2f((l2 - mxl) * LOG2E);
        const float rs = 1.0f / (w0 + w1 + w2); w0 *= rs; w1 *= rs; w2 *= rs;
        const v4u a = *(const GAS v4u*)(OD + (size_t)tok * 512 + c8 * 8), bq = *(const GAS v4u*)(OD + ((size_t)M + tok) * 512 + c8 * 8), cq = *(const GAS v4u*)(OD + ((size_t)2 * M + tok) * 512 + c8 * 8);
        v4u o;
#pragma unroll
        for (int i = 0; i < 4; ++i) o[i] = cvtpk(w0 * bflo(a[i]) + w1 * bflo(bq[i]) + w2 * bflo(cq[i]), w0 * bfhi(a[i]) + w1 * bfhi(bq[i]) + w2 * bfhi(cq[i]));
        *(GAS v4u*)(CAT + (size_t)tok * D + 512 + c8 * 8) = o;
    }
}
constexpr int DIL_TILES = 3072, DIL_SPLIT = 1024;
__device__ __forceinline__ void even_phase_a(const Frame& F0) {
    const Frame F = relaunder(F0);
    unsigned char* ws = WSP();
    const bf16* P = (const bf16*)(ws + WS_ACT); bf16* RKV = (bf16*)(ws + WS_XB); bf16* OD = (bf16*)(ws + WS_OD); float* LSE = (float*)(ws + WS_LSE);
    for (int it = F.bid; it < 1024; it += F.G) ret_phase_a_item(F, it, P, RKV);
    for (int T = F.bid; T < DIL_SPLIT; T += F.G) dil_tile(F, T, P, OD, LSE);
}
__device__ __forceinline__ void even_phase_b(const Frame& F0) {
    const Frame F = relaunder(F0);
    unsigned char* ws = WSP();
    const bf16* P = (const bf16*)(ws + WS_ACT); bf16* RKV = (bf16*)(ws + WS_XB); bf16* OD = (bf16*)(ws + WS_OD); float* LSE = (float*)(ws + WS_LSE);
    ret_scan(F, RKV);
    for (int T = DIL_SPLIT + F.bid; T < DIL_TILES; T += F.G) dil_tile(F, T, P, OD, LSE);
}
__device__ __forceinline__ void even_phase_c(const Frame& F0) {
    const Frame F = relaunder(F0);
    unsigned char* ws = WSP();
    const bf16* P = (const bf16*)(ws + WS_ACT); const bf16* RKV = (const bf16*)(ws + WS_XB); const bf16* OD = (const bf16*)(ws + WS_OD); const float* LSE = (const float*)(ws + WS_LSE); bf16* CAT = (bf16*)(ws + WS_CAT);
    for (int it = F.bid; it < 1024; it += F.G) ret_phase_c_item(F, it, P, RKV, CAT);
    dil_combine(F, OD, LSE, CAT);
}

__global__ void __launch_bounds__(NTHREADS, 2) fwd_kernel(Args args) {
    extern __shared__ __attribute__((aligned(16))) unsigned char lds[];
    Frame F;
    F.lds = (LAS unsigned char*)lds;
    F.wave = __builtin_amdgcn_readfirstlane((int)(threadIdx.x >> 6)); F.lane = hw_lane(); F.tid = F.wave * 64 + F.lane; F.G = gridDim.x; F.bid = blockIdx.x;
    for (int u = F.tid; u < (LDS_BYTES - LDSCTL_OFF) / 4; u += NTHREADS) ((LAS unsigned*)(F.lds + LDSCTL_OFF))[u] = 0u;
    __syncthreads();
    if (F.tid < N_PTRS) { const unsigned long long v = (F.tid < 17) ? (unsigned long long)args.in[F.tid] : (F.tid == 17 ? (unsigned long long)args.out : (unsigned long long)args.ws);
        ((LAS unsigned*)(F.lds + PTR_OFF))[2 * F.tid] = (unsigned)v; ((LAS unsigned*)(F.lds + PTR_OFF))[2 * F.tid + 1] = (unsigned)(v >> 32); }
    __syncthreads();
    (void)xcd_barrier_post((unsigned*)(WSP() + WS_CTL) + CW_BAR, (volatile LAS unsigned*)(F.lds + MISC_OFF) + 8, F.tid);
#define GRID_BAR() do { XcdBarrier bar_; bar_.bar = (unsigned*)(WSP() + WS_CTL) + CW_BAR; bar_.x = (unsigned)__builtin_amdgcn_readfirstlane((int)xb_xcc_id()); \
        int mo_ = MISC_OFF + 32; asm volatile("" : "+s"(mo_)); bar_.st = (volatile LAS unsigned*)(F.lds + mo_); int t_ = threadIdx.x; asm volatile("" : "+v"(t_)); xcd_barrier(bar_, t_); } while (0)
#define XB ((bf16*)(WSP() + WS_XB))
#define ACT ((bf16*)(WSP() + WS_ACT))
#define CAT ((bf16*)(WSP() + WS_CAT))
#define SSP ((float*)(WSP() + WS_SSP))
#define WPTR(off) ((const bf16*)(WSP() + (off)))

#ifdef TEST_MIN
    {
        pg8::Gemm g{XB, WPTR(W_GU0), M, 2 * FF, D}; pg8::StaticOrder S; S.init(M, 2 * FF, lnd(F.G), lnd(F.bid));
        pg8::EpiSwiGLU E{ACT, FF, SSP};
        pg8::gemm_phase<pg8::EpiSwiGLU, pg8::StaticOrder, true, true>(F.lds + RING_OFF, g, S, E, lnd(F.wave));
        GRID_BAR();
        return;
    }
#endif
    prologue_rows(F);
    convert_weights(F, 0);
    GRID_BAR();
    for (int s = 0; s < 8; ++s) {
        const int l = s >> 1; const bool post = (s & 1) != 0;
#ifdef PROBE_F1X2
        for (int rep = 0; rep < 2; ++rep)
#endif
        {
            pg8::Gemm g{XB, WPTR(post ? W_GU1 : W_GU0), M, 2 * FF, D}; pg8::StaticOrder S; S.init(M, 2 * FF, lnd(F.G), lnd(F.bid));
            pg8::EpiSwiGLU E{ACT, FF, SSP};
#ifndef NO_F1
            pg8::gemm_phase<pg8::EpiSwiGLU, pg8::StaticOrder, true, true>(F.lds + RING_OFF, g, S, E, lnd(F.wave));
#endif
            GRID_BAR();
        }
#ifdef PROBE_F2X2
        for (int rep = 0; rep < 2; ++rep)
#else
        constexpr int rep = 1;
#endif
        {
            pg8::Gemm g{ACT, WPTR(post ? W_D1 : W_D0), M, D, FF}; pg8::StaticOrder S; S.init(M, D, lnd(F.G), lnd(F.bid));
            pg8::EpiResid E{s == 0 ? AP(I_X) : (const float*)OUTP(), OUTP(), XB, SSP, rep ? 0.5f : 0.0f};
#ifndef NO_F2
            pg8::gemm_phase<pg8::EpiResid, pg8::StaticOrder, true, true>(F.lds + RING_OFF, g, S, E, lnd(F.wave));
#endif
            GRID_BAR();
        }
        if (!post) {
            const bool odd = (l & 1) != 0; const int nin = odd ? GLA_INP : EVEN_IN;
            {
                pg8::Gemm g{XB, WPTR(W_IN), M, nin, D}; pg8::StaticOrder S; S.init(M, nin, lnd(F.G), lnd(F.bid));
                pg8::EpiScaleBf16 E{ACT, nin, SSP};
#ifndef NO_M1
                pg8::gemm_phase<pg8::EpiScaleBf16, pg8::StaticOrder, true, true>(F.lds + RING_OFF, g, S, E, lnd(F.wave));
#endif
            }
            GRID_BAR();
#ifndef NO_EVEN
#ifdef PROBE_MIXX2
            if (!odd) { even_prep(F); GRID_BAR(); even_phase_a(F); GRID_BAR(); even_phase_a(F); GRID_BAR(); even_phase_b(F); GRID_BAR(); even_phase_c(F); GRID_BAR(); even_phase_c(F); }
#else
            if (!odd) { even_prep(F); GRID_BAR(); even_phase_a(F); GRID_BAR(); even_phase_b(F); GRID_BAR(); even_phase_c(F); }
#endif
#endif
#ifndef NO_GLA
            if (odd) {
#ifndef NO_GA
                gla_phase_a(F, l >> 1);
#endif
#ifdef PROBE_MIXX2
                GRID_BAR(); gla_phase_a(F, l >> 1);
#endif
                GRID_BAR();
#ifndef NO_GB
                gla_phase_b(F);
#endif
                GRID_BAR();
#ifndef NO_GC
                gla_phase_c(F, l >> 1);
#endif
#ifdef PROBE_MIXX2
                GRID_BAR(); gla_phase_c(F, l >> 1);
#endif
            }
#endif
            GRID_BAR();
#ifdef PROBE_M5X2
            for (int rep2 = 0; rep2 < 2; ++rep2)
#else
            constexpr int rep2 = 1;
#endif
            {
                pg8::Gemm g{CAT, WPTR(W_OUT), M, D, D}; pg8::StaticOrder S; S.init(M, D, lnd(F.G), lnd(F.bid));
                pg8::EpiResid E{(const float*)OUTP(), OUTP(), XB, SSP, rep2 ? 1.0f : 0.0f};
#ifndef NO_M5
                pg8::gemm_phase<pg8::EpiResid, pg8::StaticOrder, true, true>(F.lds + RING_OFF, g, S, E, lnd(F.wave));
#endif
                GRID_BAR();
            }
        } else if (l + 1 < DEPTH) {
            convert_weights(F, l + 1);
            GRID_BAR();
        }
    }
    final_norm(F);
}

extern "C" void kernel_launch(void* const* d_in, const int* in_sizes, int n_in, void* d_out, int out_size, void* d_ws, size_t ws_size, hipStream_t stream) {
    static int grid = 0;
    if (grid == 0) {
        if (n_in != 17 || in_sizes[0] != M * D || out_size != M * D || ws_size < WS_END2) { fprintf(stderr, "kernel_launch: unexpected shapes (n_in %d, in0 %d, out %d, ws %zu)\n", n_in, n_in > 0 ? in_sizes[0] : -1, out_size, ws_size); grid = -1; return; }
        int dev = 0, cus = 0, per_cu = 0;
        if (hipGetDevice(&dev) != hipSuccess || hipDeviceGetAttribute(&cus, hipDeviceAttributeMultiprocessorCount, dev) != hipSuccess) { grid = -1; return; }
        if (hipFuncSetAttribute((const void*)fwd_kernel, hipFuncAttributeMaxDynamicSharedMemorySize, LDS_BYTES) != hipSuccess) { fprintf(stderr, "kernel_launch: hipFuncSetAttribute failed\n"); grid = -1; return; }
        if (hipOccupancyMaxActiveBlocksPerMultiprocessor(&per_cu, (const void*)fwd_kernel, NTHREADS, LDS_BYTES) != hipSuccess || per_cu < 1) { fprintf(stderr, "kernel_launch: occupancy query reports %d\n", per_cu); }
        (void)hipGetLastError();
        grid = cus;
        if (grid != 256) fprintf(stderr, "kernel_launch: %d CUs (expected 256)\n", grid);
    }
    if (grid < 0) return;
    if (hipMemsetAsync((char*)d_ws + WS_CTL, 0, CTL_ZERO_BYTES, stream) != hipSuccess) return;
    Args a{};
    for (int i = 0; i < 17; ++i) a.in[i] = (const float*)d_in[i];
    a.out = (float*)d_out; a.ws = (unsigned char*)d_ws;
    hipLaunchKernelGGL(fwd_kernel, dim3(grid), dim3(NTHREADS), LDS_BYTES, stream, a);
}
```

```cpp
#include <hip/hip_runtime.h>
#include <cstdio>
#include <cstdint>
#include <cmath>
template <int K> __device__ __forceinline__ float xsw(float v) { static_assert(K == 1 || K == 2 || K == 4 || K == 8 || K == 16, "xor mask inside a 32-lane half");
    return __builtin_bit_cast(float, __builtin_amdgcn_ds_swizzle(__builtin_bit_cast(int, v), 0x1F | (K << 10))); }
__device__ __forceinline__ float sum32(float v) { const unsigned u = __builtin_bit_cast(unsigned, v); auto rr = __builtin_amdgcn_permlane32_swap(u, u, false, false); return __builtin_bit_cast(float, (unsigned)rr[0]) + __builtin_bit_cast(float, (unsigned)rr[1]); }
__device__ __forceinline__ float max32(float v) { const unsigned u = __builtin_bit_cast(unsigned, v); auto rr = __builtin_amdgcn_permlane32_swap(u, u, false, false); return fmaxf(__builtin_bit_cast(float, (unsigned)rr[0]), __builtin_bit_cast(float, (unsigned)rr[1])); }
__device__ __forceinline__ float oth32(float v, int h) { const unsigned u = __builtin_bit_cast(unsigned, v); auto rr = __builtin_amdgcn_permlane32_swap(u, u, false, false); return __builtin_bit_cast(float, (unsigned)(h ? rr[0] : rr[1])); }
namespace pg8 {
#define PG8_LAS __attribute__((address_space(3)))
typedef unsigned short bf16_t;
typedef short bf16x8 __attribute__((ext_vector_type(8)));
typedef float f32x4 __attribute__((ext_vector_type(4)));
typedef unsigned u32x4 __attribute__((ext_vector_type(4)));
constexpr int BM = 256, BK = 64, HALF = 128, HTB = HALF * BK * 2  , STAGE_BYTES = 8 * HTB, NXCD = 8, WGM = 8;

__host__ __device__ __forceinline__ int lds_byte(int r, int c) { const int st = (r >> 4) * 2 + (c >> 5), rr = r & 15, cc = c & 31, ob = rr * 64 + cc * 2; return st * 1024 + (ob ^ (((ob >> 9) & 1) << 5)); }
__host__ __device__ __forceinline__ void stage_rc(int b, int& R, int& C) { const int st = b / 1024, sb = b % 1024, swz = sb ^ (((sb >> 9) & 1) << 5); R = (st >> 1) * 16 + swz / 64; C = (st & 1) * 32 + (swz % 64) / 2; }
__host__ __device__ __forceinline__ int perm32(int rho) { const int n = rho >> 4, i = rho & 15; return 8 * (i >> 2) + 4 * n + (i & 3); }

struct Unit { int pm, pn; };
struct Gemm { const bf16_t* A; const bf16_t* Bt; int M, N, K; };

struct StaticOrder {
    int nM, nN, nwg, G, c;
    __host__ __device__ void init(int M, int N, int G_, int c_) { nM = M / BM; nN = N / BM; nwg = nM * nN; G = G_; c = c_; }
    __host__ __device__ bool next(int i, Unit& u) const {
        const long L = (long)i * G + c; if (L >= nwg) return false;
        int wgid = (int)L; { const int q = nwg / NXCD, r = nwg % NXCD, xcd = wgid % NXCD, off = wgid / NXCD; wgid = (xcd < r ? xcd * (q + 1) : r * (q + 1) + (xcd - r) * q) + off; }
        const int nig = WGM * nN, gid = wgid / nig, fm = gid * WGM, gsz = (nM - fm) < WGM ? (nM - fm) : WGM;
        u.pm = fm + ((wgid % nig) % gsz); u.pn = (wgid % nig) / gsz; return true;
    }
    __device__ __forceinline__ void a_ready(const Unit&) const {}
    __device__ __forceinline__ void done(const Unit&) const {}
    static constexpr bool TWICE = false;
};
struct TwiceOrder : StaticOrder {
    static constexpr bool TWICE = true;
    __host__ __device__ bool next(int i, Unit& u) const { return StaticOrder::next(i >> 1, u); }
};

__device__ __forceinline__ unsigned cvt_pk_bf16(float lo, float hi) { unsigned r; asm volatile("v_cvt_pk_bf16_f32 %0, %1, %2" : "=v"(r) : "v"(lo), "v"(hi)); return r; }
constexpr int MROWS = 32768;
constexpr float RMS_EPS = 1e-6f;
__device__ __forceinline__ void row_rstd(float (&rs)[2][4], const float* ssp, const Unit& u, int wr, int fr, int fq) {
#pragma unroll
    for (int ai = 0; ai < 2; ++ai)
#pragma unroll
        for (int m = 0; m < 4; ++m) {
            const int row = u.pm * BM + ai * HALF + wr * 64 + m * 16 + fr;
            const f32x4 p = *(const f32x4*)(ssp + (size_t)row * 16 + 4 * fq);
            float s = (p[0] + p[1]) + (p[2] + p[3]);
            s += xsw<16>(s); s = sum32(s);
            rs[ai][m] = 1.0f / sqrtf(s * (1.0f / 1024.0f) + RMS_EPS);
        }
}
__device__ __forceinline__ float silu_f(float g) { return g * __builtin_amdgcn_rcpf(1.0f + __builtin_amdgcn_exp2f(-1.4426950408889634f * g)); }

struct EpiSwiGLU {
    static constexpr bool PERM = true, AFTER_DRAIN = false;
    bf16_t* H; int ldh; const float* ssp;
    __device__ __forceinline__ void operator()(const f32x4 (&acc)[2][2][4][2], const Unit& u, int wr, int wc, int fr, int fq) const {
        float rs[2][4]; row_rstd(rs, ssp, u, wr, fr, fq);
        const int col0 = u.pn * HALF + wc * 32 + 8 * fq;
#pragma unroll
        for (int ai = 0; ai < 2; ++ai)
#pragma unroll
            for (int m = 0; m < 4; ++m) {
                const int row = u.pm * BM + ai * HALF + wr * 64 + m * 16 + fr; const float r = rs[ai][m];
                float h[8];
#pragma unroll
                for (int n = 0; n < 2; ++n)
#pragma unroll
                    for (int i = 0; i < 4; ++i) { const float g = acc[ai][0][m][n][i] * r, up = acc[ai][1][m][n][i] * r; h[4 * n + i] = silu_f(g) * up; }
                u32x4 w; w.x = cvt_pk_bf16(h[0], h[1]); w.y = cvt_pk_bf16(h[2], h[3]); w.z = cvt_pk_bf16(h[4], h[5]); w.w = cvt_pk_bf16(h[6], h[7]);
                *(u32x4*)(H + (size_t)row * ldh + col0) = w;
                asm volatile("" ::: "memory");
            }
    }
};
struct EpiScaleBf16 {
    static constexpr bool PERM = true, AFTER_DRAIN = false;
    bf16_t* O; int ldc; const float* ssp;
    __device__ __forceinline__ void operator()(const f32x4 (&acc)[2][2][4][2], const Unit& u, int wr, int wc, int fr, int fq) const {
        float rs[2][4]; row_rstd(rs, ssp, u, wr, fr, fq);
        const int col0 = u.pn * BM + wc * 32 + 8 * fq;
#pragma unroll
        for (int ai = 0; ai < 2; ++ai)
#pragma unroll
            for (int m = 0; m < 4; ++m) {
                const int row = u.pm * BM + ai * HALF + wr * 64 + m * 16 + fr; const float r = rs[ai][m];
#pragma unroll
                for (int bj = 0; bj < 2; ++bj) { const f32x4 v0 = acc[ai][bj][m][0] * r, v1 = acc[ai][bj][m][1] * r;
                    u32x4 w; w.x = cvt_pk_bf16(v0[0], v0[1]); w.y = cvt_pk_bf16(v0[2], v0[3]); w.z = cvt_pk_bf16(v1[0], v1[1]); w.w = cvt_pk_bf16(v1[2], v1[3]);
                    *(u32x4*)(O + (size_t)row * ldc + col0 + bj * HALF) = w; }
                asm volatile("" ::: "memory");
            }
    }
};
struct EpiResid {
    static constexpr bool PERM = true, AFTER_DRAIN = false;
    const float* xold; float* xnew; bf16_t* xb; float* ssp; float scale;
    __device__ __forceinline__ void operator()(const f32x4 (&acc)[2][2][4][2], const Unit& u, int wr, int wc, int fr, int fq) const {
        const int col0 = u.pn * BM + wc * 32 + 8 * fq;
#pragma unroll
        for (int ai = 0; ai < 2; ++ai)
#pragma unroll
            for (int m = 0; m < 4; ++m) {
                const int row = u.pm * BM + ai * HALF + wr * 64 + m * 16 + fr; float ss = 0.f;
#pragma unroll
                for (int bj = 0; bj < 2; ++bj) { const size_t off = (size_t)row * 1024 + col0 + bj * HALF;
                    const f32x4 o0 = *(const f32x4*)(xold + off), o1 = *(const f32x4*)(xold + off + 4);
                    const f32x4 v0 = o0 + acc[ai][bj][m][0] * scale, v1 = o1 + acc[ai][bj][m][1] * scale;
                    *(f32x4*)(xnew + off) = v0; *(f32x4*)(xnew + off + 4) = v1;
                    u32x4 w; w.x = cvt_pk_bf16(v0[0], v0[1]); w.y = cvt_pk_bf16(v0[2], v0[3]); w.z = cvt_pk_bf16(v1[0], v1[1]); w.w = cvt_pk_bf16(v1[2], v1[3]);
                    *(u32x4*)(xb + off) = w;
                    ss += (v0[0] * v0[0] + v0[1] * v0[1]) + (v0[2] * v0[2] + v0[3] * v0[3]) + (v1[0] * v1[0] + v1[1] * v1[1]) + (v1[2] * v1[2] + v1[3] * v1[3]); }
                ss += xsw<16>(ss); ss = sum32(ss);
                if (fq == 0) ssp[(size_t)row * 16 + u.pn * 4 + wc] = ss;
                asm volatile("" ::: "memory");
            }
    }
};

template <class Epi, class Sched, bool ALIGN_EPI = false, bool SP2 = false>
__device__ __forceinline__ void gemm_phase(PG8_LAS unsigned char* lds, const Gemm g, const Sched& S, const Epi& E, int wave_in) {
    int tid_ = threadIdx.x; asm volatile("" : "+v"(tid_));
    const int tid = tid_, wid = __builtin_amdgcn_readfirstlane(tid >> 6), lane = tid & 63, wr = wid >> 2, wc = wid & 3, fr = lane & 15, fq = lane >> 4;
    const int K = g.K, nt = K / BK;
    unsigned voffA[2], voffB[2];
#pragma unroll
    for (int i = 0; i < 2; ++i) { int R, C; stage_rc(tid * 16 + i * 8192, R, C); const int Rb = Epi::PERM ? ((R & ~31) + perm32(R & 31)) : R;
        voffA[i] = (unsigned)(R * K + C) * 2u; voffB[i] = (unsigned)(Rb * K + C) * 2u; }
    const size_t kstep = (size_t)(BK * 2);
    const size_t hstep = (size_t)HALF * K * 2;
    const size_t tstep = 2 * hstep;
    const unsigned ldsw = (unsigned)wid * 1024u;
    const int aoff = lds_byte(wr * 64 + fr, fq * 8), boff = lds_byte(wc * 32 + fr, fq * 8);
#define PG8_SA(b, h) (((b) * 2 + (h)) * HTB)
#define PG8_SB(b, h) ((4 + (b) * 2 + (h)) * HTB)
#define PG8_STAGE(bufoff, gbase, voff) do { _Pragma("unroll") for (int _i = 0; _i < 2; ++_i) \
        __builtin_amdgcn_global_load_lds((const unsigned*)((const char*)(gbase) + (voff)[_i]), (PG8_LAS unsigned*)(lds + (bufoff) + ldsw + _i * 8192), 16, 0, 0); } while (0)
#define PG8_LDA(dst, b, h) do { _Pragma("unroll") for (int m = 0; m < 4; ++m) _Pragma("unroll") for (int k = 0; k < 2; ++k) dst[m][k] = *(const PG8_LAS bf16x8*)(lds + PG8_SA(b, h) + aoff + m * 2048 + k * 1024); } while (0)
#define PG8_LDB(dst, b, h) do { _Pragma("unroll") for (int n = 0; n < 2; ++n) _Pragma("unroll") for (int k = 0; k < 2; ++k) dst[n][k] = *(const PG8_LAS bf16x8*)(lds + PG8_SB(b, h) + boff + n * 2048 + k * 1024); } while (0)
#define PG8_MMA(ai, bj, At, Bt) do { __builtin_amdgcn_s_setprio(1); _Pragma("unroll") for (int m = 0; m < 4; ++m) _Pragma("unroll") for (int n = 0; n < 2; ++n) _Pragma("unroll") for (int k = 0; k < 2; ++k) \
        acc[ai][bj][m][n] = __builtin_amdgcn_mfma_f32_16x16x32_bf16(Bt[n][k], At[m][k], acc[ai][bj][m][n], 0, 0, 0); __builtin_amdgcn_s_setprio(0); } while (0)
#define PG8_WAIT_V(n) asm volatile("s_waitcnt vmcnt(" #n ")" ::: "memory")
#define PG8_WAIT_L(n) asm volatile("s_waitcnt lgkmcnt(" #n ")" ::: "memory")
#define PG8_BAR __builtin_amdgcn_s_barrier()
#define PG8_SCHED __builtin_amdgcn_sched_barrier(0)
    Unit cur, nxt; int ui = 0;
    if (!S.next(0, cur)) return;
    f32x4 acc[2][2][4][2];
#pragma unroll
    for (int a = 0; a < 2; ++a)
#pragma unroll
        for (int b = 0; b < 2; ++b)
#pragma unroll
            for (int m = 0; m < 4; ++m)
#pragma unroll
                for (int n = 0; n < 2; ++n) acc[a][b][m][n] = (f32x4){0.f, 0.f, 0.f, 0.f};
    bf16x8 At[4][2], B0[2][2], B1[2][2];
    const char* cA = (const char*)g.A + (size_t)cur.pm * tstep; const char* cB = (const char*)g.Bt + (size_t)cur.pn * tstep;
    S.a_ready(cur);
    if constexpr (SP2) {
        PG8_STAGE(PG8_SB(0, 0), cB, voffB); PG8_STAGE(PG8_SB(0, 1), cB + hstep, voffB); PG8_STAGE(PG8_SA(0, 0), cA, voffA); PG8_STAGE(PG8_SA(0, 1), cA + hstep, voffA);
        if (wr == 1) PG8_BAR;
        PG8_WAIT_V(2); PG8_BAR;
        PG8_STAGE(PG8_SB(1, 0), cB + kstep, voffB); PG8_STAGE(PG8_SA(1, 0), cA + kstep, voffA); PG8_STAGE(PG8_SB(1, 1), cB + hstep + kstep, voffB);
        PG8_WAIT_V(6); PG8_BAR;
    } else {
        PG8_STAGE(PG8_SB(0, 0), cB, voffB); PG8_STAGE(PG8_SA(0, 0), cA, voffA); PG8_STAGE(PG8_SB(0, 1), cB + hstep, voffB); PG8_STAGE(PG8_SA(0, 1), cA + hstep, voffA);
        if (wr == 1) PG8_BAR;
        PG8_WAIT_V(4); PG8_BAR;
        PG8_STAGE(PG8_SB(1, 0), cB + kstep, voffB); PG8_STAGE(PG8_SA(1, 0), cA + kstep, voffA); PG8_STAGE(PG8_SB(1, 1), cB + hstep + kstep, voffB);
        PG8_WAIT_V(6); PG8_BAR;
    }
    for (;;) {
        const bool has_next = S.next(ui + 1, nxt);
        const char* nA = has_next ? (const char*)g.A + (size_t)nxt.pm * tstep : cA; const char* nB = has_next ? (const char*)g.Bt + (size_t)nxt.pn * tstep : cB;
        for (int t = 0; t < nt; t += 2) {
            const bool last = (t == nt - 2);
            const char* a1 = cA + (size_t)(t + 1) * kstep;
            const char* a2 = last ? nA : cA + (size_t)(t + 2) * kstep; const char* b2 = last ? nB : cB + (size_t)(t + 2) * kstep;
            const char* a3 = a2 + kstep; const char* b3 = b2 + kstep;
            if (last && has_next) S.a_ready(nxt);
            if constexpr (SP2) {
            PG8_LDB(B0, 0, 0); PG8_LDB(B1, 0, 1); PG8_SCHED; PG8_LDA(At, 0, 0); PG8_STAGE(PG8_SA(1, 1), a1 + hstep, voffA);
            PG8_WAIT_V(8); PG8_WAIT_L(0); PG8_BAR; PG8_MMA(0, 0, At, B0); PG8_MMA(0, 1, At, B1); PG8_BAR; PG8_SCHED;
            PG8_LDA(At, 0, 1); PG8_STAGE(PG8_SB(0, 0), b2, voffB); PG8_STAGE(PG8_SB(0, 1), b2 + hstep, voffB); PG8_STAGE(PG8_SA(0, 0), a2, voffA);
            PG8_WAIT_V(8); PG8_WAIT_L(0); PG8_BAR; PG8_MMA(1, 0, At, B0); PG8_MMA(1, 1, At, B1); PG8_BAR; PG8_SCHED;
            PG8_LDB(B0, 1, 0); PG8_LDB(B1, 1, 1); PG8_SCHED; PG8_LDA(At, 1, 0); PG8_STAGE(PG8_SA(0, 1), a2 + hstep, voffA);
            PG8_WAIT_V(8); PG8_WAIT_L(0); PG8_BAR; PG8_MMA(0, 0, At, B0); PG8_MMA(0, 1, At, B1); PG8_BAR; PG8_SCHED;
            PG8_LDA(At, 1, 1); PG8_STAGE(PG8_SB(1, 0), b3, voffB); PG8_STAGE(PG8_SB(1, 1), b3 + hstep, voffB); PG8_STAGE(PG8_SA(1, 0), a3, voffA);
            PG8_WAIT_V(8); PG8_WAIT_L(0); PG8_BAR; PG8_MMA(1, 0, At, B0); PG8_MMA(1, 1, At, B1); PG8_BAR; PG8_SCHED;
            } else {
            PG8_LDB(B0, 0, 0); PG8_SCHED; PG8_LDA(At, 0, 0); PG8_STAGE(PG8_SA(1, 1), a1 + hstep, voffA);
            PG8_WAIT_L(8); PG8_BAR; PG8_WAIT_L(0); PG8_MMA(0, 0, At, B0); PG8_BAR; PG8_SCHED;
            PG8_LDB(B1, 0, 1); PG8_STAGE(PG8_SB(0, 0), b2, voffB);
            PG8_BAR; PG8_WAIT_L(0); PG8_MMA(0, 1, At, B1); PG8_BAR;
            PG8_LDA(At, 0, 1); PG8_STAGE(PG8_SA(0, 0), a2, voffA);
            PG8_BAR; PG8_WAIT_L(0); PG8_MMA(1, 0, At, B0); PG8_BAR; PG8_SCHED;
            PG8_STAGE(PG8_SB(0, 1), b2 + hstep, voffB);
            PG8_WAIT_V(6); PG8_BAR; PG8_MMA(1, 1, At, B1); PG8_BAR;
            PG8_LDB(B0, 1, 0); PG8_SCHED; PG8_LDA(At, 1, 0); PG8_STAGE(PG8_SA(0, 1), a2 + hstep, voffA);
            PG8_WAIT_L(8); PG8_BAR; PG8_WAIT_L(0); PG8_MMA(0, 0, At, B0); PG8_BAR; PG8_SCHED;
            PG8_LDB(B1, 1, 1); PG8_STAGE(PG8_SB(1, 0), b3, voffB);
            PG8_BAR; PG8_WAIT_L(0); PG8_MMA(0, 1, At, B1); PG8_BAR;
            PG8_LDA(At, 1, 1); PG8_STAGE(PG8_SA(1, 0), a3, voffA);
            PG8_BAR; PG8_WAIT_L(0); PG8_MMA(1, 0, At, B0); PG8_BAR; PG8_SCHED;
            PG8_STAGE(PG8_SB(1, 1), b3 + hstep, voffB);
            PG8_WAIT_V(6); PG8_BAR; PG8_MMA(1, 1, At, B1); PG8_BAR;
            }
        }
        if constexpr (ALIGN_EPI) { if (wr == 0) PG8_BAR; }
        if constexpr (!Epi::AFTER_DRAIN) { if (!Sched::TWICE || (ui & 1)) { E(acc, cur, wr, wc, fr, fq); S.done(cur); } }
        if (!has_next) break;
#pragma unroll
        for (int a = 0; a < 2; ++a)
#pragma unroll
            for (int b = 0; b < 2; ++b)
#pragma unroll
                for (int m = 0; m < 4; ++m)
#pragma unroll
                    for (int n = 0; n < 2; ++n) acc[a][b][m][n] = (f32x4){0.f, 0.f, 0.f, 0.f};
        cur = nxt; cA = nA; cB = nB; ++ui;
        if constexpr (ALIGN_EPI) { if (wr == 1) PG8_BAR; }
    }
    PG8_WAIT_V(0);
    if constexpr (!ALIGN_EPI) { if (wr == 0) PG8_BAR; }
    PG8_BAR;
    if constexpr (Epi::AFTER_DRAIN) { E.fused(acc, cur, wr, wc, fr, fq, lds, wid, lane); S.done(cur); }
#undef PG8_SA
#undef PG8_SB
#undef PG8_STAGE
#undef PG8_LDA
#undef PG8_LDB
#undef PG8_MMA
#undef PG8_WAIT_V
#undef PG8_WAIT_L
#undef PG8_BAR
#undef PG8_SCHED
}
}

constexpr int NWAVES = 8, NTHREADS = NWAVES * 64;
constexpr int BATCH = 8, SEQ = 4096, D = 1024, M = BATCH * SEQ, FF = 2816, DEPTH = 4;
constexpr int EVEN_IN = 3584, GLA_IN = 3088, GLA_INP = 3328;
static_assert(M == pg8::MROWS, "row count");
constexpr int E_RQ = 0, E_RK = 512, E_RV = 1024, E_RG = 1536, E_DQ = 2048, E_DK = 2560, E_DV = 3072;
constexpr int G_Q = 0, G_K = 512, G_V = 1024, G_R = 2048, G_A = 3072;
constexpr float EPS = 1e-6f;

constexpr size_t MiB = 1u << 20;
constexpr size_t WS_CTL = 0, CTL_ZERO_BYTES = 1 * MiB;
constexpr size_t WS_SSP = 1 * MiB;
constexpr size_t WS_TAB = 3 * MiB;
constexpr size_t TAB_RC = WS_TAB, TAB_RS = WS_TAB + 1 * MiB, TAB_DC = WS_TAB + 2 * MiB, TAB_DS = WS_TAB + 2 * MiB + 128 * 1024;
constexpr size_t WS_W = 8 * MiB;
constexpr size_t W_GU0 = WS_W, W_D0 = W_GU0 + (size_t)2 * FF * D * 2, W_GU1 = W_D0 + (size_t)D * FF * 2, W_D1 = W_GU1 + (size_t)2 * FF * D * 2,
                 W_IN = W_D1 + (size_t)D * FF * 2, W_OUT = W_IN + (size_t)EVEN_IN * D * 2, W_END = W_OUT + (size_t)D * D * 2;
constexpr size_t WS_XB = 56 * MiB;
constexpr size_t WS_ACT = 120 * MiB;
constexpr size_t WS_CAT = 344 * MiB;
constexpr size_t WS_END = 408 * MiB;
static_assert(W_END <= WS_XB && WS_XB + (size_t)M * D * 2 <= WS_ACT && WS_ACT + (size_t)M * EVEN_IN * 2 <= WS_CAT && WS_CAT + (size_t)M * D * 2 <= WS_END, "d_ws map");
constexpr int CW_BAR = 4096;

constexpr int RING_OFF = 0, RING_BYTES = 131072;
constexpr int LDSCTL_OFF = 161792, MISC_OFF = LDSCTL_OFF + 320, PTR_OFF = LDSCTL_OFF + 1024;
constexpr int LDS_BYTES = 163840;
static_assert(PTR_OFF + 19 * 8 <= LDS_BYTES && RING_BYTES <= LDSCTL_OFF, "LDS map");

#define GAS __attribute__((address_space(1)))
#define LAS __attribute__((address_space(3)))
typedef unsigned short bf16;
typedef unsigned v4u __attribute__((ext_vector_type(4)));
typedef float f32x4 __attribute__((ext_vector_type(4)));
typedef short bf16x8 __attribute__((ext_vector_type(8)));
typedef GAS unsigned gu32;
typedef GAS unsigned long long gu64;
#define RLX_AGENT __ATOMIC_RELAXED, __HIP_MEMORY_SCOPE_AGENT
#define LDS_WAIT() asm volatile("s_waitcnt lgkmcnt(0)" ::: "memory")
#define VM_WAIT() asm volatile("s_waitcnt vmcnt(0)" ::: "memory")
__device__ __forceinline__ unsigned long long rt() { return __builtin_amdgcn_s_memrealtime(); }
__device__ __forceinline__ unsigned f2bf(float f) { unsigned u = __builtin_bit_cast(unsigned, f); return (u + 0x7fffu + ((u >> 16) & 1u)) >> 16; }
__device__ __forceinline__ unsigned pk2(float lo, float hi) { return f2bf(lo) | (f2bf(hi) << 16); }

#define XB_TMO      128
#define XB_XCNT(j)  (256  + 64 * (j))
#define XB_XSUB(j)  (1280 + 64 * (j))
#define XB_XGEN(j)  (2304 + 64 * (j))
#define XB_TOP      3328
#define XB_TOPGEN   3392
#define XCD_BAR_WORDS 3456
#define XB_SPIN_CAP (1u << 18)

__device__ __forceinline__ unsigned xb_ld(unsigned* p)              { return __hip_atomic_load(p, __ATOMIC_RELAXED, __HIP_MEMORY_SCOPE_AGENT); }
__device__ __forceinline__ unsigned xb_add(unsigned* p, unsigned v) { return __hip_atomic_fetch_add(p, v, __ATOMIC_RELAXED, __HIP_MEMORY_SCOPE_AGENT); }
__device__ __forceinline__ unsigned xb_xcc_id() { return (unsigned)__builtin_amdgcn_s_getreg((3 << 11) | 20) & 0xFu; }
#define XB_SPIN(cond, bar) do { unsigned _sp = 0; while (cond) { __builtin_amdgcn_s_sleep(1); \
    if ((++_sp & 255u) == 0u) { if (xb_ld(&(bar)[XB_TMO])) break; if (_sp > XB_SPIN_CAP) { atomicAdd(&(bar)[XB_TMO], 1u); break; } } } } while (0)

struct XcdBarrier {
    unsigned* bar; unsigned x;
    volatile LAS unsigned* st;
};

__device__ __forceinline__ XcdBarrier xcd_barrier_post(unsigned* bar, volatile LAS unsigned* st, int tid) {
    XcdBarrier b; b.bar = bar; b.x = xb_xcc_id(); b.st = st;
    if (tid == 0) (void)xb_add(&bar[XB_XCNT(b.x)], 1u);
    return b;
}
__device__ __forceinline__ void xcd_barrier_complete(unsigned* bar, unsigned x, unsigned& nloc, unsigned& nx) {
    const unsigned G = gridDim.x * gridDim.y * gridDim.z;
    unsigned sum, cnt, mine, sp = 0u;
    for (;;) {
        sum = 0u; cnt = 0u; mine = 0u;
#pragma unroll
        for (unsigned j = 0; j < 16; ++j) { const unsigned c = xb_ld(&bar[XB_XCNT(j)]); sum += c; cnt += (c > 0u) ? 1u : 0u; mine = (j == x) ? c : mine; }
        if (sum == G) break;
        __builtin_amdgcn_s_sleep(1);
        if ((++sp & 255u) == 0u) { if (xb_ld(&bar[XB_TMO])) break; if (sp > XB_SPIN_CAP) { atomicAdd(&bar[XB_TMO], 1u); break; } }
    }
    nloc = mine > 0u ? mine : 1u; nx = cnt > 0u ? cnt : 1u;
}

__device__ __forceinline__ void xcd_barrier(const XcdBarrier& b, int tid) {
    asm volatile("s_waitcnt vmcnt(0)" ::: "memory");
    __syncthreads();
    if (tid == 0) {
        unsigned* bar = b.bar;
        __builtin_amdgcn_s_waitcnt(0);
        unsigned nloc = b.st[0], nx = b.st[1];
        if (nloc == 0u) { xcd_barrier_complete(bar, b.x, nloc, nx); b.st[0] = nloc; b.st[1] = nx; }
        const unsigned old = xb_add(&bar[XB_XSUB(b.x)], 1u);
        const unsigned gen = old / nloc;
        if (old + 1u == (gen + 1u) * nloc) {
            __builtin_amdgcn_fence(__ATOMIC_RELEASE, "agent");
            asm volatile("s_waitcnt vmcnt(0)" ::: "memory");
            const unsigned og = xb_add(&bar[XB_TOP], 1u);
            const unsigned tg = og / nx;
            if (og + 1u == (tg + 1u) * nx) xb_add(&bar[XB_TOPGEN], 1u);
            else XB_SPIN(xb_ld(&bar[XB_TOPGEN]) == tg, bar);
            __builtin_amdgcn_fence(__ATOMIC_ACQUIRE, "agent");
            xb_add(&bar[XB_XGEN(b.x)], 1u);
            asm volatile("s_waitcnt vmcnt(0)" ::: "memory");
        } else {
            XB_SPIN(xb_ld(&bar[XB_XGEN(b.x)]) == gen, bar);
            __builtin_amdgcn_fence(__ATOMIC_ACQUIRE, "agent");
            asm volatile("s_waitcnt vmcnt(0)" ::: "memory");
        }
    }
    __syncthreads();
}

__constant__ float RET_FREQ[64] = {1.000000000e+00f, 8.639884591e-01f, 7.464760542e-01f, 6.449466944e-01f, 5.572264791e-01f, 4.814372361e-01f, 4.159561992e-01f, 3.593813777e-01f, 3.105013371e-01f, 2.682695687e-01f, 2.317818105e-01f, 2.002568096e-01f, 1.730195731e-01f, 1.494869143e-01f, 1.291549653e-01f, 1.115883961e-01f, 9.641107172e-02f, 8.329805732e-02f, 7.196855545e-02f, 6.218000501e-02f, 5.372280627e-02f, 4.641588405e-02f, 4.010278732e-02f, 3.464834765e-02f, 2.993577160e-02f, 2.586415969e-02f, 2.234633639e-02f, 1.930697635e-02f, 1.668100432e-02f, 1.441219542e-02f, 1.245197095e-02f, 1.075835899e-02f, 9.295095690e-03f, 8.030855097e-03f, 6.938565988e-03f, 5.994840991e-03f, 5.179473665e-03f, 4.475005437e-03f, 3.866352839e-03f, 3.340484342e-03f, 2.886139788e-03f, 2.493591513e-03f, 2.154434333e-03f, 1.861406374e-03f, 1.608233666e-03f, 1.389495330e-03f, 1.200507861e-03f, 1.037224894e-03f, 8.961503627e-04f, 7.742635789e-04f, 6.689548027e-04f, 5.779692437e-04f, 4.993587499e-04f, 4.314401885e-04f, 3.727593285e-04f, 3.220597573e-04f, 2.782559313e-04f, 2.404099068e-04f, 2.077113895e-04f, 1.794602431e-04f, 1.550515735e-04f, 1.339627634e-04f, 1.157422885e-04f, 9.999999747e-05f};
__constant__ float ROPE_FREQ[8] = {1.000000000e+00f, 1.939227432e-01f, 3.760603070e-02f, 7.292664610e-03f, 1.414213562e-03f, 2.742481884e-04f, 5.318295734e-05f, 1.031338525e-05f};
struct Args { const float* in[17]; float* out; unsigned char* ws; };
enum { I_X = 0, I_PRE_NORM = 1, I_PRE_WG = 2, I_PRE_WU = 3, I_PRE_WD = 4, I_MIX_NORM = 5, I_AB_IN = 6, I_AB_OUT = 7, I_GLA_IN = 8, I_GLA_A2 = 9, I_GLA_BA = 10, I_GLA_OUT = 11,
       I_POST_NORM = 12, I_POST_WG = 13, I_POST_WU = 14, I_POST_WD = 15, I_FINAL = 16, I_OUT = 17, I_WS = 18, N_PTRS = 19 };
struct Frame {
    LAS unsigned char* lds;
    int tid, lane, wave, G, bid;
};
__device__ __forceinline__ unsigned char* tabp(const Frame& F, int idx) {
    int off_ = PTR_OFF + 8 * idx; asm volatile("" : "+s"(off_));
    const volatile LAS unsigned* T = (const volatile LAS unsigned*)(F.lds + off_);
    const unsigned lo = __builtin_amdgcn_readfirstlane(T[0]), hi = __builtin_amdgcn_readfirstlane(T[1]);
    GAS unsigned char* gp_ = (GAS unsigned char*)(((unsigned long long)hi << 32) | (unsigned long long)lo);
    return (unsigned char*)gp_;
}
#define AP(idx) ((const float*)tabp(F, idx))
#define WSP() tabp(F, I_WS)
#define OUTP() ((float*)tabp(F, I_OUT))
__device__ __forceinline__ int lnd(int v) { asm volatile("" : "+s"(v)); return v; }
__device__ __forceinline__ int hw_lane() { return (int)__builtin_amdgcn_mbcnt_hi(~0u, __builtin_amdgcn_mbcnt_lo(~0u, 0u)); }
__device__ __forceinline__ Frame relaunder(const Frame& F0) { Frame F = F0; int t_ = threadIdx.x; asm volatile("" : "+v"(t_)); asm volatile("" : "+s"(F.bid)); F.tid = t_; F.lane = F.tid & 63; F.wave = __builtin_amdgcn_readfirstlane(F.tid >> 6);
    unsigned lb_ = 0u; asm volatile("" : "+s"(lb_)); F.lds = F0.lds + lb_; return F; }
__device__ __forceinline__ float wave_sum(float v) {
    v += xsw<1>(v); v += xsw<2>(v); v += xsw<4>(v); v += xsw<8>(v); v += xsw<16>(v);
    return sum32(v);
}
__device__ __forceinline__ float bf2f(bf16 h) { return __builtin_bit_cast(float, (unsigned)h << 16); }
__device__ __forceinline__ float bflo(unsigned w) { return __builtin_bit_cast(float, w << 16); }
__device__ __forceinline__ float bfhi(unsigned w) { return __builtin_bit_cast(float, w & 0xffff0000u); }
__device__ __forceinline__ bf16 f2bf_rne(float f) { return (bf16)f2bf(f); }

__device__ __forceinline__ void tr_item(const float* W, int K, int N, int Npad, const float* gain, bf16* WT, int gu, LAS float* scr, int item, int lane) {
    const int nblk = Npad / 32, kb = item / nblk, nb = item % nblk, k0 = 64 * kb, n0 = 32 * nb;
    {
        const int c4 = lane & 7; const bool ok = n0 + 4 * c4 < N;
        const GAS float* src = (const GAS float*)W + (size_t)(k0 + (lane >> 3)) * N + n0 + 4 * c4;
        f32x4 v[8];
#pragma unroll
        for (int i = 0; i < 8; ++i) v[i] = ok ? *(const GAS f32x4*)(src + (size_t)(8 * i) * N) : (f32x4){0.f, 0.f, 0.f, 0.f};
#pragma unroll
        for (int i = 0; i < 8; ++i) { const int kk = 8 * i + (lane >> 3); const float gn = gain ? ((const GAS float*)gain)[k0 + kk] : 1.0f; LAS float* s = scr + kk * 33 + 4 * c4;
            s[0] = v[i][0] * gn; s[1] = v[i][1] * gn; s[2] = v[i][2] * gn; s[3] = v[i][3] * gn; }
    }
    LDS_WAIT(); asm volatile("" ::: "memory");
    const int c = lane & 7;
#pragma unroll
    for (int j = 0; j < 4; ++j) { const int n = (lane >> 3) + 8 * j; const LAS float* s = scr + (8 * c) * 33 + n;
        v4u o; o.x = pk2(s[0 * 33], s[1 * 33]); o.y = pk2(s[2 * 33], s[3 * 33]); o.z = pk2(s[4 * 33], s[5 * 33]); o.w = pk2(s[6 * 33], s[7 * 33]);
        int drow = n0 + n; if (gu) drow = (drow >> 7) * 256 + (drow & 127) + (gu == 2 ? 128 : 0);
        *(GAS v4u*)(WT + (size_t)drow * K + k0 + 8 * c) = o; }
    LDS_WAIT(); asm volatile("" ::: "memory");
}
__device__ __forceinline__ void convert_weights(const Frame& F0, int l) {
    const Frame F = relaunder(F0);
    LAS float* scr = (LAS float*)(F.lds + RING_OFF + F.wave * 16384);
    const int gw = F.bid * NWAVES + F.wave, NGW = F.G * NWAVES;
    unsigned char* ws = WSP();
    constexpr int I_G = (D / 64) * (FF / 32), I_DN = (FF / 64) * (D / 32), I_O = (D / 64) * (D / 32);
    const bool odd = (l & 1) != 0; const int li = l >> 1;
    const int nin = odd ? GLA_IN : EVEN_IN, ninp = odd ? GLA_INP : EVEN_IN; const int I_IN = (D / 64) * (ninp / 32);
    const float* win = odd ? AP(I_GLA_IN) + (size_t)li * D * GLA_IN : AP(I_AB_IN) + (size_t)li * D * EVEN_IN;
    const float* wout = odd ? AP(I_GLA_OUT) + (size_t)li * D * D : AP(I_AB_OUT) + (size_t)li * D * D;
    const size_t fo = (size_t)l * D * FF;
    const int NITEMS = 6 * I_G + I_IN + I_O;
    static_assert(I_G == I_DN, "item counts");
    for (int it = gw; it < NITEMS; it += NGW) {
        int r = it;
        if (r < I_G) { tr_item(AP(I_PRE_WG) + fo, D, FF, FF, AP(I_PRE_NORM) + l * D, (bf16*)(ws + W_GU0), 1, scr, r, F.lane); continue; } r -= I_G;
        if (r < I_G) { tr_item(AP(I_PRE_WU) + fo, D, FF, FF, AP(I_PRE_NORM) + l * D, (bf16*)(ws + W_GU0), 2, scr, r, F.lane); continue; } r -= I_G;
        if (r < I_G) { tr_item(AP(I_PRE_WD) + fo, FF, D, D, nullptr, (bf16*)(ws + W_D0), 0, scr, r, F.lane); continue; } r -= I_G;
        if (r < I_G) { tr_item(AP(I_POST_WG) + fo, D, FF, FF, AP(I_POST_NORM) + l * D, (bf16*)(ws + W_GU1), 1, scr, r, F.lane); continue; } r -= I_G;
        if (r < I_G) { tr_item(AP(I_POST_WU) + fo, D, FF, FF, AP(I_POST_NORM) + l * D, (bf16*)(ws + W_GU1), 2, scr, r, F.lane); continue; } r -= I_G;
        if (r < I_G) { tr_item(AP(I_POST_WD) + fo, FF, D, D, nullptr, (bf16*)(ws + W_D1), 0, scr, r, F.lane); continue; } r -= I_G;
        if (r < I_IN) { tr_item(win, D, nin, ninp, AP(I_MIX_NORM) + l * D, (bf16*)(ws + W_IN), 0, scr, r, F.lane); continue; } r -= I_IN;
        tr_item(wout, D, D, D, nullptr, (bf16*)(ws + W_OUT), 0, scr, r, F.lane);
    }
}
__device__ __forceinline__ void prologue_rows(const Frame& F0) {
    const Frame F = relaunder(F0);
    unsigned char* ws = WSP();
    const int gw = F.bid * NWAVES + F.wave, NGW = F.G * NWAVES;
    bf16* XB = (bf16*)(ws + WS_XB); float* ssp = (float*)(ws + WS_SSP);
    for (int m = gw; m < M; m += NGW) {
        const GAS f32x4* xr = (const GAS f32x4*)(AP(I_X) + (size_t)m * D) + F.lane;
        GAS unsigned long long* o8 = (GAS unsigned long long*)(XB + (size_t)m * D) + F.lane;
        float s = 0.f;
#pragma unroll
        for (int j = 0; j < 4; ++j) { const f32x4 v = xr[64 * j]; s += (v.x * v.x + v.y * v.y) + (v.z * v.z + v.w * v.w);
            o8[64 * j] = (unsigned long long)pk2(v.x, v.y) | ((unsigned long long)pk2(v.z, v.w) << 32); }
        s = wave_sum(s);
        if (F.lane < 16) ssp[(size_t)m * 16 + F.lane] = (F.lane == 0) ? s : 0.f;
    }
    const int gt = F.bid * NTHREADS + F.tid, NGT = F.G * NTHREADS;
    float* rc = (float*)(ws + TAB_RC); float* rsn = (float*)(ws + TAB_RS); float* dc = (float*)(ws + TAB_DC); float* ds = (float*)(ws + TAB_DS);
    for (int e = gt; e < SEQ * 64; e += NGT) { const int t = e >> 6, i = e & 63; const float ang = (float)t * RET_FREQ[i];
        double rev = (double)ang * 0.15915494309189535; rev -= __builtin_rint(rev); const float r = (float)rev;
        rc[e] = __builtin_amdgcn_cosf(r); rsn[e] = __builtin_amdgcn_sinf(r); }
    for (int e = gt; e < SEQ * 8; e += NGT) { const int t = e >> 3, i = e & 7; const float ang = (float)t * ROPE_FREQ[i];
        double rev = (double)ang * 0.15915494309189535; rev -= __builtin_rint(rev); const float r = (float)rev;
        dc[e] = __builtin_amdgcn_cosf(r); ds[e] = __builtin_amdgcn_sinf(r); }
}

__device__ __forceinline__ void even_prep(const Frame& F0) {
    const Frame F = relaunder(F0);
    unsigned char* ws = WSP();
    const int gw = F.bid * NWAVES + F.wave, NGW = F.G * NWAVES;
    bf16* P = (bf16*)(ws + WS_ACT);
    const float* rc = (const float*)(ws + TAB_RC); const float* rsn = (const float*)(ws + TAB_RS); const float* dc = (const float*)(ws + TAB_DC); const float* ds = (const float*)(ws + TAB_DS);
    for (int m = gw; m < M; m += NGW) {
        const int pos = m & (SEQ - 1); bf16* row = P + (size_t)m * EVEN_IN;
        const float c = rc[pos * 64 + F.lane], s = rsn[pos * 64 + F.lane];
#pragma unroll
        for (int h = 0; h < 4; ++h) {
            { bf16* p1 = row + E_RQ + h * 128 + F.lane; bf16* p2 = p1 + 64; const float x1 = bf2f(*p1), x2 = bf2f(*p2); *p1 = f2bf_rne(x1 * c - x2 * s); *p2 = f2bf_rne(x2 * c + x1 * s); }
            { bf16* p1 = row + E_RK + h * 128 + F.lane; bf16* p2 = p1 + 64; const float x1 = bf2f(*p1), x2 = bf2f(*p2);
              *p1 = f2bf_rne((x1 * c - x2 * s) * 0.08838834764831845f); *p2 = f2bf_rne((x2 * c + x1 * s) * 0.08838834764831845f); }
        }
        { const int h = F.lane >> 3, i = F.lane & 7; const float c2 = dc[pos * 8 + i], s2 = ds[pos * 8 + i];
          { bf16* p1 = row + E_DQ + h * 64 + i; bf16* p2 = p1 + 8; const float x1 = bf2f(*p1), x2 = bf2f(*p2); *p1 = f2bf_rne(x1 * c2 - x2 * s2); *p2 = f2bf_rne(x2 * c2 + x1 * s2); }
          { bf16* p1 = row + E_DK + h * 64 + i; bf16* p2 = p1 + 8; const float x1 = bf2f(*p1), x2 = bf2f(*p2); *p1 = f2bf_rne(x1 * c2 - x2 * s2); *p2 = f2bf_rne(x2 * c2 + x1 * s2); } }
    }
}
__device__ __forceinline__ void even_core(const Frame& F0) {
    const Frame F = relaunder(F0);
    unsigned char* ws = WSP();
    const bf16* P = (const bf16*)(ws + WS_ACT);
    if (F.bid < 128) {
        const int b = F.bid >> 4, h = (F.bid >> 2) & 3, eg = F.bid & 3, e = eg * 32 + (F.tid >> 4), dq = F.tid & 15;
        const float g = 1.0f - exp2f(-5.0f - (float)h);
        float* oraw = (float*)(ws + WS_XB);
        const bf16* base = P + (size_t)b * SEQ * EVEN_IN;
        float S[8];
#pragma unroll
        for (int i = 0; i < 8; ++i) S[i] = 0.f;
        v4u qn = *(const GAS v4u*)(base + E_RQ + h * 128 + dq * 8), kn = *(const GAS v4u*)(base + E_RK + h * 128 + dq * 8); bf16 vn = base[E_RV + h * 128 + e];
        for (int t = 0; t < SEQ; ++t) {
            const v4u q = qn, k = kn; const float v = bf2f(vn);
            if (t + 1 < SEQ) { const bf16* nb = base + (size_t)(t + 1) * EVEN_IN; qn = *(const GAS v4u*)(nb + E_RQ + h * 128 + dq * 8); kn = *(const GAS v4u*)(nb + E_RK + h * 128 + dq * 8); vn = nb[E_RV + h * 128 + e]; }
            float o = 0.f;
#pragma unroll
            for (int i = 0; i < 4; ++i) { const unsigned qw = q[i], kw = k[i];
                S[2 * i] = g * S[2 * i] + bflo(kw) * v; S[2 * i + 1] = g * S[2 * i + 1] + bfhi(kw) * v;
                o += bflo(qw) * S[2 * i]; o += bfhi(qw) * S[2 * i + 1]; }
            o += xsw<1>(o); o += xsw<2>(o); o += xsw<4>(o); o += xsw<8>(o);
            if (dq == 0) oraw[((size_t)b * SEQ + t) * 512 + h * 128 + e] = o;
        }
    } else {
        bf16* CAT = (bf16*)(ws + WS_CAT);
        for (int it = F.bid - 128; it < BATCH * (SEQ / 64); it += F.G - 128) {
            const int b = it >> 6, t = (it & 63) * 64 + F.lane, h = F.wave;
            const bf16* base = P + (size_t)b * SEQ * EVEN_IN;
            float q[64];
            { const GAS v4u* qp = (const GAS v4u*)(base + (size_t)t * EVEN_IN + E_DQ + h * 64);
#pragma unroll
              for (int j = 0; j < 8; ++j) { const v4u w = qp[j];
#pragma unroll
                  for (int i = 0; i < 4; ++i) { q[8 * j + 2 * i] = bflo(w[i]) * (0.125f * 1.4426950408889634f); q[8 * j + 2 * i + 1] = bfhi(w[i]) * (0.125f * 1.4426950408889634f); } } }
            float o[64];
#pragma unroll
            for (int i = 0; i < 64; ++i) o[i] = 0.f;
            float mx = -INFINITY, l = 0.f;
            for (int p = 0; p < 3; ++p) {
                const int dil = (p == 0) ? 1 : (p == 1) ? 4 : 16;
                for (int j = 0; j <= 128; ++j) {
                    const int tk = t - j * dil;
                    if (tk >= 0) {
                        const GAS v4u* kp = (const GAS v4u*)(base + (size_t)tk * EVEN_IN + E_DK + h * 64);
                        const GAS v4u* vp = (const GAS v4u*)(base + (size_t)tk * EVEN_IN + E_DV + h * 64);
                        float s = 0.f;
#pragma unroll
                        for (int jj = 0; jj < 8; ++jj) { const v4u w = kp[jj];
#pragma unroll
                            for (int i = 0; i < 4; ++i) { s += q[8 * jj + 2 * i] * bflo(w[i]); s += q[8 * jj + 2 * i + 1] * bfhi(w[i]); } }
                        const float mn = fmaxf(mx, s), corr = __builtin_amdgcn_exp2f(mx - mn), pe = __builtin_amdgcn_exp2f(s - mn);
                        l = l * corr + pe; mx = mn;
#pragma unroll
                        for (int jj = 0; jj < 8; ++jj) { const v4u w = vp[jj];
#pragma unroll
                            for (int i = 0; i < 4; ++i) { o[8 * jj + 2 * i] = o[8 * jj + 2 * i] * corr + pe * bflo(w[i]); o[8 * jj + 2 * i + 1] = o[8 * jj + 2 * i + 1] * corr + pe * bfhi(w[i]); } }
                    }
                }
            }
            const float rl = 1.0f / l;
            GAS v4u* op = (GAS v4u*)(CAT + ((size_t)b * SEQ + t) * D + 512 + h * 64);
#pragma unroll
            for (int j = 0; j < 8; ++j) { v4u w; w.x = pk2(o[8 * j] * rl, o[8 * j + 1] * rl); w.y = pk2(o[8 * j + 2] * rl, o[8 * j + 3] * rl); w.z = pk2(o[8 * j + 4] * rl, o[8 * j + 5] * rl); w.w = pk2(o[8 * j + 6] * rl, o[8 * j + 7] * rl); op[j] = w; }
        }
    }
}
__device__ __forceinline__ void even_post(const Frame& F0) {
    const Frame F = relaunder(F0);
    unsigned char* ws = WSP();
    const int gw = F.bid * NWAVES + F.wave, NGW = F.G * NWAVES;
    const bf16* P = (const bf16*)(ws + WS_ACT); const float* oraw = (const float*)(ws + WS_XB); bf16* CAT = (bf16*)(ws + WS_CAT);
    for (int it = gw; it < M * 4; it += NGW) {
        const int m = it >> 2, h = it & 3;
        const float* op = oraw + (size_t)m * 512 + h * 128 + 2 * F.lane; const float o0 = op[0], o1 = op[1];
        const float mu = wave_sum(o0 + o1) * (1.0f / 128.0f); const float d0 = o0 - mu, d1 = o1 - mu;
        const float var = wave_sum(d0 * d0 + d1 * d1) * (1.0f / 128.0f); const float rstd = 1.0f / sqrtf(var + EPS);
        const unsigned gw2 = *(const unsigned*)(P + (size_t)m * EVEN_IN + E_RG + h * 128 + 2 * F.lane); const float g0 = bflo(gw2), g1 = bfhi(gw2);
        const float y0 = d0 * rstd * (g0 / (1.0f + expf(-g0))), y1 = d1 * rstd * (g1 / (1.0f + expf(-g1)));
        *(unsigned*)(CAT + (size_t)m * D + h * 128 + 2 * F.lane) = pk2(y0, y1);
    }
}
__device__ __forceinline__ void gla_prep(const Frame& F0, int li) {
    const Frame F = relaunder(F0);
    unsigned char* ws = WSP();
    const int gt = F.bid * NTHREADS + F.tid, NGT = F.G * NTHREADS;
    const bf16* P = (const bf16*)(ws + WS_ACT); float* A = (float*)(ws + WS_CAT);
    const float* w2 = AP(I_GLA_A2) + (size_t)li * 16 * 512; const float* ba = AP(I_GLA_BA) + (size_t)li * 512;
    for (int e = gt; e < M * 512; e += NGT) {
        const int m = e >> 9, c = e & 511; const bf16* al = P + (size_t)m * GLA_INP + G_A;
        float z = ba[c];
#pragma unroll
        for (int j = 0; j < 16; ++j) z += bf2f(al[j]) * w2[j * 512 + c];
        const float ls = fminf(z, 0.f) - log1pf(expf(-fabsf(z)));
        A[e] = expf(ls * (1.0f / 16.0f));
    }
}
__device__ __forceinline__ void gla_core(const Frame& F0) {
    const Frame F = relaunder(F0);
    unsigned char* ws = WSP();
    const bf16* P = (const bf16*)(ws + WS_ACT); const float* A = (const float*)(ws + WS_CAT); bf16* oraw = (bf16*)(ws + WS_XB);
    const int b = F.bid >> 5, h = (F.bid >> 3) & 3, eg = F.bid & 7, e = eg * 32 + (F.tid >> 4), dq = F.tid & 15;
    const bf16* base = P + (size_t)b * SEQ * GLA_INP; const float* abase = A + (size_t)b * SEQ * 512 + h * 128 + dq * 8;
    float S[8];
#pragma unroll
    for (int i = 0; i < 8; ++i) S[i] = 0.f;
    v4u qn = *(const GAS v4u*)(base + G_Q + h * 128 + dq * 8), kn = *(const GAS v4u*)(base + G_K + h * 128 + dq * 8); bf16 vn = base[G_V + h * 256 + e];
    f32x4 a0n = *(const GAS f32x4*)(abase), a1n = *(const GAS f32x4*)(abase + 4);
    for (int t = 0; t < SEQ; ++t) {
        const v4u q = qn, k = kn; const float v = bf2f(vn); const f32x4 a0 = a0n, a1 = a1n;
        if (t + 1 < SEQ) { const bf16* nb = base + (size_t)(t + 1) * GLA_INP; qn = *(const GAS v4u*)(nb + G_Q + h * 128 + dq * 8); kn = *(const GAS v4u*)(nb + G_K + h * 128 + dq * 8); vn = nb[G_V + h * 256 + e];
            a0n = *(const GAS f32x4*)(abase + (size_t)(t + 1) * 512); a1n = *(const GAS f32x4*)(abase + (size_t)(t + 1) * 512 + 4); }
        float o = 0.f;
#pragma unroll
        for (int i = 0; i < 4; ++i) { const unsigned qw = q[i], kw = k[i]; const float al = (i < 2) ? a0[2 * i] : a1[2 * i - 4], ah = (i < 2) ? a0[2 * i + 1] : a1[2 * i - 3];
            S[2 * i] = al * S[2 * i] + bflo(kw) * v; S[2 * i + 1] = ah * S[2 * i + 1] + bfhi(kw) * v;
            o += bflo(qw) * S[2 * i]; o += bfhi(qw) * S[2 * i + 1]; }
        o += xsw<1>(o); o += xsw<2>(o); o += xsw<4>(o); o += xsw<8>(o);
        if (dq == 0) oraw[((size_t)b * SEQ + t) * 1024 + h * 256 + e] = f2bf_rne(o * 0.08838834764831845f);
    }
}
__device__ __forceinline__ void gla_post(const Frame& F0) {
    const Frame F = relaunder(F0);
    unsigned char* ws = WSP();
    const int gw = F.bid * NWAVES + F.wave, NGW = F.G * NWAVES;
    const bf16* P = (const bf16*)(ws + WS_ACT); const bf16* oraw = (const bf16*)(ws + WS_XB); bf16* CAT = (bf16*)(ws + WS_CAT);
    for (int it = gw; it < M * 4; it += NGW) {
        const int m = it >> 2, h = it & 3;
        const unsigned long long ow = *(const unsigned long long*)(oraw + (size_t)m * 1024 + h * 256 + 4 * F.lane);
        const float o0 = bflo((unsigned)ow), o1 = bfhi((unsigned)ow), o2 = bflo((unsigned)(ow >> 32)), o3 = bfhi((unsigned)(ow >> 32));
        const float mu = wave_sum((o0 + o1) + (o2 + o3)) * (1.0f / 256.0f); const float d0 = o0 - mu, d1 = o1 - mu, d2 = o2 - mu, d3 = o3 - mu;
        const float var = wave_sum((d0 * d0 + d1 * d1) + (d2 * d2 + d3 * d3)) * (1.0f / 256.0f); const float rstd = 1.0f / sqrtf(var + EPS);
        const unsigned long long gw2 = *(const unsigned long long*)(P + (size_t)m * GLA_INP + G_R + h * 256 + 4 * F.lane);
        const float g0 = bflo((unsigned)gw2), g1 = bfhi((unsigned)gw2), g2 = bflo((unsigned)(gw2 >> 32)), g3 = bfhi((unsigned)(gw2 >> 32));
        const float y0 = d0 * rstd * (g0 / (1.0f + expf(-g0))), y1 = d1 * rstd * (g1 / (1.0f + expf(-g1))), y2 = d2 * rstd * (g2 / (1.0f + expf(-g2))), y3 = d3 * rstd * (g3 / (1.0f + expf(-g3)));
        *(unsigned long long*)(CAT + (size_t)m * D + h * 256 + 4 * F.lane) = (unsigned long long)pk2(y0, y1) | ((unsigned long long)pk2(y2, y3) << 32);
    }
}
__device__ __forceinline__ void final_norm(const Frame& F0) {
    const Frame F = relaunder(F0);
    const int gw = F.bid * NWAVES + F.wave, NGW = F.G * NWAVES;
    for (int m = gw; m < M; m += NGW) {
        GAS f32x4* xr = (GAS f32x4*)(OUTP() + (size_t)m * D) + F.lane; const GAS f32x4* gr = (const GAS f32x4*)AP(I_FINAL) + F.lane;
        f32x4 v[4]; float s = 0.f;
#pragma unroll
        for (int j = 0; j < 4; ++j) { v[j] = xr[64 * j]; s += (v[j].x * v[j].x + v[j].y * v[j].y) + (v[j].z * v[j].z + v[j].w * v[j].w); }
        const float rstd = 1.0f / sqrtf(wave_sum(s) * (1.0f / D) + EPS);
#pragma unroll
        for (int j = 0; j < 4; ++j) xr[64 * j] = v[j] * rstd * gr[64 * j];
    }
}


__device__ __forceinline__ float silu_f(float g) { return g * __builtin_amdgcn_rcpf(1.0f + __builtin_amdgcn_exp2f(-1.4426950408889634f * g)); }
typedef float f32x16 __attribute__((ext_vector_type(16)));
typedef short s16x4 __attribute__((ext_vector_type(4)));
typedef float f32x2_t __attribute__((ext_vector_type(2)));
typedef __bf16 bf16x2_t __attribute__((ext_vector_type(2)));
#define MFMA32(a, b, c) __builtin_amdgcn_mfma_f32_32x32x16_bf16((a), (b), (c), 0, 0, 0)
__device__ __forceinline__ int crow(int reg, int h) { return (reg & 3) + 8 * (reg >> 2) + 4 * h; }
__device__ __forceinline__ unsigned cvtpk(float lo, float hi) { f32x2_t v = {lo, hi}; bf16x2_t b = __builtin_convertvector(v, bf16x2_t); return __builtin_bit_cast(unsigned, b); }
__device__ __forceinline__ bf16 cvt1(float v) { return (bf16)(cvtpk(v, 0.f) & 0xffffu); }
#define PACK_STEP(x, s) __builtin_bit_cast(bf16x8, (v4u){cvtpk((x)[8 * (s)], (x)[8 * (s) + 1]), cvtpk((x)[8 * (s) + 2], (x)[8 * (s) + 3]), cvtpk((x)[8 * (s) + 4], (x)[8 * (s) + 5]), cvtpk((x)[8 * (s) + 6], (x)[8 * (s) + 7])})
typedef const LAS unsigned char* lcp;
__device__ __forceinline__ bf16x8 ld_row(lcp img, int P, int row0, int k0, int r, int h) { return *(const LAS bf16x8*)(img + (row0 + r) * P + (k0 + 8 * h) * 2); }
__device__ __forceinline__ bf16x8 ld_row_perm(lcp img, int P, int row0, int k0, int r, int h) {
    const s16x4 lo = *(const LAS s16x4*)(img + (row0 + r) * P + (k0 + 4 * h) * 2), hi = *(const LAS s16x4*)(img + (row0 + r) * P + (k0 + 8 + 4 * h) * 2);
    return __builtin_shufflevector(lo, hi, 0, 1, 2, 3, 4, 5, 6, 7); }
__device__ __forceinline__ s16x4 trd(lcp p) { return __builtin_bit_cast(s16x4, __builtin_amdgcn_ds_read_tr16_b64_v4i16((LAS s16x4*)p)); }
__device__ __forceinline__ bf16x8 ld_tr(lcp img, int P, int k0, int c0, int lane) {
    const int i16 = lane & 15, q = i16 >> 2, p = i16 & 3, blk = (lane >> 4) & 1, h = lane >> 5;
    lcp a = img + (k0 + 8 * h + q) * P + (c0 + 16 * blk + 4 * p) * 2;
    const s16x4 lo = trd(a), hi = trd(a + 4 * P);
    return __builtin_shufflevector(lo, hi, 0, 1, 2, 3, 4, 5, 6, 7); }
__device__ __forceinline__ bf16x8 ld_tr_perm(lcp img, int P, int k0, int c0, int lane) {
    const int i16 = lane & 15, q = i16 >> 2, p = i16 & 3, blk = (lane >> 4) & 1, h = lane >> 5;
    lcp a = img + (k0 + 4 * h + q) * P + (c0 + 16 * blk + 4 * p) * 2;
    const s16x4 lo = trd(a), hi = trd(a + 8 * P);
    return __builtin_shufflevector(lo, hi, 0, 1, 2, 3, 4, 5, 6, 7); }
template <int R, int C> __device__ __forceinline__ void stage_tile(LAS unsigned char* img, int P, const bf16* g, size_t gp, int tid) {
    constexpr int CPR = C / 8, N = R * CPR;
#pragma unroll
    for (int i = 0; i < (N + NTHREADS - 1) / NTHREADS; ++i) { const int c = tid + i * NTHREADS;
        if (c < N) { const int row = c / CPR, cc = c % CPR; const v4u v = *(const GAS v4u*)(g + (size_t)row * gp + cc * 8); *(LAS v4u*)(img + row * P + cc * 16) = v; } }
}
#define WG_BAR() do { asm volatile("s_waitcnt vmcnt(0) lgkmcnt(0)" ::: "memory"); __builtin_amdgcn_s_barrier(); asm volatile("" ::: "memory"); } while (0)

constexpr int GP128 = 272, GP256 = 528;
constexpr size_t WS_DEC = 6 * MiB;
constexpr float LOG2E = 1.4426950408889634f, LN2 = 0.6931471805599453f;
__device__ __forceinline__ void gla_cumsum(float (&Bc)[2][16], float& Blast, lcp AL, lcp W2, const LAS float* BA, LAS float* EX, int wave, int lane) {
    const int r = lane & 31, h = lane >> 5, db = wave & 3, jh = wave >> 2;
    const bf16x8 wf = *(const LAS bf16x8*)(W2 + (db * 32 + r) * 32 + h * 16);
    const float bias = BA[db * 32 + r];
    float run = 0.f;
#pragma unroll
    for (int t = 0; t < 2; ++t) {
        const bf16x8 af = *(const LAS bf16x8*)(AL + ((jh * 2 + t) * 32 + r) * 32 + h * 16);
        f32x16 z = {0.f, 0.f, 0.f, 0.f, 0.f, 0.f, 0.f, 0.f, 0.f, 0.f, 0.f, 0.f, 0.f, 0.f, 0.f, 0.f};
        z = MFMA32(af, wf, z);
        float own[4], oth[4];
#pragma unroll
        for (int g = 0; g < 4; ++g) {
            float acc = 0.f;
#pragma unroll
            for (int i = 0; i < 4; ++i) { const float zz = z[4 * g + i] + bias;
                const float la = (fminf(zz, 0.f) - LN2 * __builtin_amdgcn_logf(1.0f + __builtin_amdgcn_exp2f(-fabsf(zz) * LOG2E))) * (1.0f / 16.0f);
                acc += la; Bc[t][4 * g + i] = acc; }
            own[g] = acc; oth[g] = oth32(acc, h);
        }
#pragma unroll
        for (int g = 0; g < 4; ++g) { const float off = run + (h ? oth[g] : 0.f);
#pragma unroll
            for (int i = 0; i < 4; ++i) Bc[t][4 * g + i] += off;
            run += own[g] + oth[g]; }
    }
    if (h == 0) EX[jh * 128 + db * 32 + r] = run;
    WG_BAR();
    const float t0 = EX[db * 32 + r], t1 = EX[128 + db * 32 + r];
    Blast = t0 + t1;
    if (jh == 1) {
#pragma unroll
        for (int t = 0; t < 2; ++t)
#pragma unroll
            for (int i = 0; i < 16; ++i) Bc[t][i] += t0; }
}
constexpr int GA_KI = 0, GA_VI = GA_KI + 128 * GP128, GA_KD = GA_VI + 128 * GP256, GA_AL = GA_KD + 128 * GP128, GA_W2 = GA_AL + 4096, GA_BA = GA_W2 + 4096, GA_EX = GA_BA + 512, GA_END = GA_EX + 1024;
constexpr int GC_QT = 0, GC_KT = GC_QT + 128 * GP128, GC_SI = GC_KT + 128 * GP128, GC_VI = GC_SI + 128 * GP128, GC_AL = GC_VI + 128 * GP128, GC_W2 = GC_AL + 4096, GC_BA = GC_W2 + 4096, GC_EX = GC_BA + 512, GC_END = GC_EX + 1024;
constexpr int GC_OI = 0;
static_assert(GA_END <= LDSCTL_OFF && GC_END <= LDSCTL_OFF && 128 * GP256 <= GC_SI, "GLA LDS maps");
__device__ __forceinline__ void gla_stage_small(const Frame& F, LAS unsigned char* AL, LAS unsigned char* W2, LAS float* BA, const bf16* Prow0, int li, int h) {
    if (F.tid < 256) { const int row = F.tid >> 1, cc = F.tid & 1; *(LAS v4u*)(AL + row * 32 + cc * 16) = *(const GAS v4u*)(Prow0 + (size_t)row * GLA_INP + G_A + cc * 8); }
    else if (F.tid < 384) { const int d = F.tid - 256; const float* w2 = AP(I_GLA_A2) + (size_t)li * 16 * 512 + h * 128 + d;
        v4u lo, hi; lo.x = cvtpk(w2[0], w2[512]); lo.y = cvtpk(w2[2 * 512], w2[3 * 512]); lo.z = cvtpk(w2[4 * 512], w2[5 * 512]); lo.w = cvtpk(w2[6 * 512], w2[7 * 512]);
        hi.x = cvtpk(w2[8 * 512], w2[9 * 512]); hi.y = cvtpk(w2[10 * 512], w2[11 * 512]); hi.z = cvtpk(w2[12 * 512], w2[13 * 512]); hi.w = cvtpk(w2[14 * 512], w2[15 * 512]);
        *(LAS v4u*)(W2 + d * 32) = lo; *(LAS v4u*)(W2 + d * 32 + 16) = hi; }
    else { const int d = F.tid - 384; BA[d] = AP(I_GLA_BA)[(size_t)li * 512 + h * 128 + d]; }
}
__device__ __forceinline__ void gla_phase_a(const Frame& F0, int li) {
    const Frame F = relaunder(F0);
    unsigned char* ws = WSP();
    const bf16* P = (const bf16*)(ws + WS_ACT); bf16* SKV = (bf16*)(ws + WS_XB); float* DEC = (float*)(ws + WS_DEC);
    LAS unsigned char* L = F.lds;
    const int lane = F.lane, r = lane & 31, h2 = lane >> 5, wave = F.wave, db = wave & 3, jh = wave >> 2;
    for (int it = F.bid; it < 1024; it += F.G) {
        const int bh = it >> 5, g = it & 31, b = bh >> 2, h = bh & 3;
        const bf16* Prow0 = P + ((size_t)b * SEQ + g * 128) * GLA_INP;
        stage_tile<128, 128>(L + GA_KI, GP128, Prow0 + G_K + h * 128, GLA_INP, F.tid);
        stage_tile<128, 256>(L + GA_VI, GP256, Prow0 + G_V + h * 256, GLA_INP, F.tid);
        gla_stage_small(F, L + GA_AL, L + GA_W2, (LAS float*)(L + GA_BA), Prow0, li, h);
        WG_BAR();
        float Bc[2][16], Blast;
        gla_cumsum(Bc, Blast, L + GA_AL, L + GA_W2, (const LAS float*)(L + GA_BA), (LAS float*)(L + GA_EX), wave, lane);
#pragma unroll
        for (int t = 0; t < 2; ++t)
#pragma unroll
            for (int i = 0; i < 16; ++i) { const int off = ((jh * 2 + t) * 32 + crow(i, h2)) * GP128 + (db * 32 + r) * 2;
                const float kv = bf2f(*(const LAS bf16*)(L + GA_KI + off)) * __builtin_amdgcn_exp2f((Blast - Bc[t][i]) * LOG2E);
                *(LAS bf16*)(L + GA_KD + off) = cvt1(kv); }
        if (jh == 0 && h2 == 0) DEC[(size_t)it * 128 + db * 32 + r] = __builtin_amdgcn_exp2f(Blast * LOG2E);
        WG_BAR();
        f32x16 acc[4];
#pragma unroll
        for (int t = 0; t < 4; ++t) acc[t] = (f32x16){0.f, 0.f, 0.f, 0.f, 0.f, 0.f, 0.f, 0.f, 0.f, 0.f, 0.f, 0.f, 0.f, 0.f, 0.f, 0.f};
#pragma unroll
        for (int ks = 0; ks < 8; ++ks) { const bf16x8 a = ld_tr(L + GA_KD, GP128, 16 * ks, db * 32, lane);
#pragma unroll
            for (int t = 0; t < 4; ++t) acc[t] = MFMA32(a, ld_tr(L + GA_VI, GP256, 16 * ks, (4 * jh + t) * 32, lane), acc[t]); }
        bf16* out = SKV + (size_t)it * 128 * 256;
#pragma unroll
        for (int t = 0; t < 4; ++t)
#pragma unroll
            for (int i = 0; i < 16; ++i) out[(size_t)(db * 32 + crow(i, h2)) * 256 + (4 * jh + t) * 32 + r] = cvt1(acc[t][i]);
        WG_BAR();
    }
}
__device__ __forceinline__ void gla_phase_b(const Frame& F0) {
    const Frame F = relaunder(F0);
    unsigned char* ws = WSP();
    bf16* SKV = (bf16*)(ws + WS_XB); const float* DEC = (const float*)(ws + WS_DEC);
    for (int gt = F.bid * NTHREADS + F.tid; gt < 32 * 128 * 32; gt += F.G * NTHREADS) {
        const int bh = gt >> 12, d = (gt >> 5) & 127, e8 = gt & 31;
        float s[8];
#pragma unroll
        for (int i = 0; i < 8; ++i) s[i] = 0.f;
        for (int g0 = 0; g0 < 32; g0 += 4) {
            v4u kv[4]; float dc[4];
#pragma unroll
            for (int u = 0; u < 4; ++u) { const size_t item = (size_t)bh * 32 + g0 + u; kv[u] = *(const GAS v4u*)(SKV + (item * 128 + d) * 256 + e8 * 8); dc[u] = DEC[item * 128 + d]; }
#pragma unroll
            for (int u = 0; u < 4; ++u) { const size_t item = (size_t)bh * 32 + g0 + u;
                v4u o; o.x = cvtpk(s[0], s[1]); o.y = cvtpk(s[2], s[3]); o.z = cvtpk(s[4], s[5]); o.w = cvtpk(s[6], s[7]);
                *(GAS v4u*)(SKV + (item * 128 + d) * 256 + e8 * 8) = o;
#pragma unroll
                for (int i = 0; i < 4; ++i) { s[2 * i] = dc[u] * s[2 * i] + bflo(kv[u][i]); s[2 * i + 1] = dc[u] * s[2 * i + 1] + bfhi(kv[u][i]); } }
        }
    }
}
__device__ __forceinline__ void gla_phase_c(const Frame& F0, int li) {
    const Frame F = relaunder(F0);
    unsigned char* ws = WSP();
    const bf16* P = (const bf16*)(ws + WS_ACT); const bf16* SKV = (const bf16*)(ws + WS_XB); bf16* CAT = (bf16*)(ws + WS_CAT);
    LAS unsigned char* L = F.lds;
    const int lane = F.lane, r = lane & 31, h2 = lane >> 5, wave = F.wave, db = wave & 3, jh = wave >> 2;
    const int ib = wave & 3, eq = wave >> 2;
    for (int it = F.bid; it < 1024; it += F.G) {
        const int bh = it >> 5, g = it & 31, b = bh >> 2, h = bh & 3;
        const bf16* Prow0 = P + ((size_t)b * SEQ + g * 128) * GLA_INP;
        const bf16* Sg = SKV + (size_t)it * 128 * 256;
        stage_tile<128, 128>(L + GC_QT, GP128, Prow0 + G_Q + h * 128, GLA_INP, F.tid);
        stage_tile<128, 128>(L + GC_KT, GP128, Prow0 + G_K + h * 128, GLA_INP, F.tid);
        stage_tile<128, 128>(L + GC_SI, GP128, Sg, 256, F.tid);
        stage_tile<128, 128>(L + GC_VI, GP128, Prow0 + G_V + h * 256, GLA_INP, F.tid);
        gla_stage_small(F, L + GC_AL, L + GC_W2, (LAS float*)(L + GC_BA), Prow0, li, h);
        WG_BAR();
        {
            float Bc[2][16], Blast;
            gla_cumsum(Bc, Blast, L + GC_AL, L + GC_W2, (const LAS float*)(L + GC_BA), (LAS float*)(L + GC_EX), wave, lane);
#pragma unroll
            for (int t = 0; t < 2; ++t)
#pragma unroll
                for (int i = 0; i < 16; ++i) { const int off = ((jh * 2 + t) * 32 + crow(i, h2)) * GP128 + (db * 32 + r) * 2;
                    const float eb = __builtin_amdgcn_exp2f(Bc[t][i] * LOG2E);
                    const float qv = bf2f(*(const LAS bf16*)(L + GC_QT + off)) * eb * 0.08838834764831845f;
                    const float kv = bf2f(*(const LAS bf16*)(L + GC_KT + off)) * __builtin_amdgcn_rcpf(eb);
                    *(LAS bf16*)(L + GC_QT + off) = cvt1(qv); *(LAS bf16*)(L + GC_KT + off) = cvt1(kv); }
        }
        WG_BAR();
        bf16x8 PA[4][2];
#pragma unroll
        for (int jb = 0; jb < 4; ++jb) {
            if (jb <= ib) {
                f32x16 x = {0.f, 0.f, 0.f, 0.f, 0.f, 0.f, 0.f, 0.f, 0.f, 0.f, 0.f, 0.f, 0.f, 0.f, 0.f, 0.f};
#pragma unroll
                for (int ks = 0; ks < 8; ++ks) x = MFMA32(ld_row(L + GC_KT, GP128, jb * 32, 16 * ks, r, h2), ld_row(L + GC_QT, GP128, ib * 32, 16 * ks, r, h2), x);
                if (jb == ib) {
#pragma unroll
                    for (int i = 0; i < 16; ++i) if (crow(i, h2) > r) x[i] = 0.f; }
                PA[jb][0] = PACK_STEP(x, 0); PA[jb][1] = PACK_STEP(x, 1);
            } else { PA[jb][0] = (bf16x8){0, 0, 0, 0, 0, 0, 0, 0}; PA[jb][1] = (bf16x8){0, 0, 0, 0, 0, 0, 0, 0}; }
        }
        f32x16 o[2][2];
#pragma unroll
        for (int half = 0; half < 2; ++half) {
            if (half == 1) {
                WG_BAR();
                stage_tile<128, 128>(L + GC_SI, GP128, Sg + 128, 256, F.tid);
                stage_tile<128, 128>(L + GC_VI, GP128, Prow0 + G_V + h * 256 + 128, GLA_INP, F.tid);
                WG_BAR();
            }
#pragma unroll
            for (int t = 0; t < 2; ++t) {
                const int eb = 2 * eq + t;
                f32x16 acc = {0.f, 0.f, 0.f, 0.f, 0.f, 0.f, 0.f, 0.f, 0.f, 0.f, 0.f, 0.f, 0.f, 0.f, 0.f, 0.f};
#pragma unroll
                for (int jb = 0; jb < 4; ++jb) if (jb <= ib) {
#pragma unroll
                    for (int s = 0; s < 2; ++s) acc = MFMA32(PA[jb][s], ld_tr_perm(L + GC_VI, GP128, jb * 32 + 16 * s, eb * 32, lane), acc); }
#pragma unroll
                for (int ks = 0; ks < 8; ++ks) acc = MFMA32(ld_row(L + GC_QT, GP128, ib * 32, 16 * ks, r, h2), ld_tr(L + GC_SI, GP128, 16 * ks, eb * 32, lane), acc);
                o[half][t] = acc;
            }
        }
        WG_BAR();
#pragma unroll
        for (int half = 0; half < 2; ++half)
#pragma unroll
            for (int t = 0; t < 2; ++t)
#pragma unroll
                for (int i = 0; i < 16; ++i) *(LAS bf16*)(L + GC_OI + (ib * 32 + crow(i, h2)) * GP256 + (half * 128 + (2 * eq + t) * 32 + r) * 2) = cvt1(o[half][t][i]);
        WG_BAR();
        {
            const int row = F.tid >> 2, qtr = F.tid & 3;
            lcp orow = L + GC_OI + row * GP256 + qtr * 128;
            float sum = 0.f;
#pragma unroll
            for (int c = 0; c < 8; ++c) { const v4u w = *(const LAS v4u*)(orow + c * 16);
#pragma unroll
                for (int i = 0; i < 4; ++i) sum += bflo(w[i]) + bfhi(w[i]); }
            sum += xsw<1>(sum); sum += xsw<2>(sum);
            const float mu = sum * (1.0f / 256.0f); float sq = 0.f;
#pragma unroll
            for (int c = 0; c < 8; ++c) { const v4u w = *(const LAS v4u*)(orow + c * 16);
#pragma unroll
                for (int i = 0; i < 4; ++i) { const float d0 = bflo(w[i]) - mu, d1 = bfhi(w[i]) - mu; sq += d0 * d0 + d1 * d1; } }
            sq += xsw<1>(sq); sq += xsw<2>(sq);
            const float rstd = 1.0f / sqrtf(sq * (1.0f / 256.0f) + EPS);
            const bf16* gp = Prow0 + (size_t)row * GLA_INP + G_R + h * 256 + qtr * 64;
            bf16* op = CAT + ((size_t)b * SEQ + g * 128 + row) * D + h * 256 + qtr * 64;
#pragma unroll
            for (int c = 0; c < 8; ++c) { const v4u gw = *(const GAS v4u*)(gp + c * 8); const v4u w = *(const LAS v4u*)(orow + c * 16); v4u ow;
#pragma unroll
                for (int i = 0; i < 4; ++i) { const float g0 = bflo(gw[i]), g1 = bfhi(gw[i]);
                    ow[i] = cvtpk((bflo(w[i]) - mu) * rstd * silu_f(g0), (bfhi(w[i]) - mu) * rstd * silu_f(g1)); }
                *(GAS v4u*)(op + c * 8) = ow; asm volatile("" ::: "memory"); }
        }
        WG_BAR();
    }
}


constexpr size_t WS_OD = 408 * MiB;
constexpr size_t WS_LSE = WS_XB + 32 * MiB;
constexpr size_t WS_END2 = 504 * MiB;
constexpr int RP = 272;
constexpr int RA_KI = 0, RA_VD = RA_KI + 128 * RP, RA_END = RA_VD + 128 * RP;
constexpr int RC_QI = 0, RC_KI = RC_QI + 128 * RP, RC_VI = RC_KI + 128 * RP, RC_SI = RC_VI + 128 * RP, RC_END = RC_SI + 128 * RP;
constexpr int DP = 144;
constexpr int DL_KI = 0, DL_VI = DL_KI + 384 * DP, DL_ST = DL_VI + 384 * DP, DL_LW = DL_ST + 8 * 32 * DP, DL_END = DL_LW + 8 * 256;
static_assert(RC_END <= LDSCTL_OFF && DL_END <= LDSCTL_OFF, "even mixer LDS maps");
__device__ __forceinline__ float ret_log2g(int h) { return log2f(1.0f - exp2f(-5.0f - (float)h)); }

__device__ __forceinline__ void ret_phase_a_item(const Frame& F, int it, const bf16* P, bf16* RKV) {
    LAS unsigned char* L = F.lds;
    const int lane = F.lane, r = lane & 31, h2 = lane >> 5, wave = F.wave, db = wave & 3, eh = wave >> 2;
    const int bh = it >> 5, n = it & 31, b = bh >> 2, h = bh & 3;
    const float lg = ret_log2g(h);
    const bf16* Prow0 = P + ((size_t)b * SEQ + n * 128) * EVEN_IN;
    stage_tile<128, 128>(L + RA_KI, RP, Prow0 + E_RK + h * 128, EVEN_IN, F.tid);
    {
        const bf16* gsrc = Prow0 + E_RV + h * 128;
#pragma unroll
        for (int i = 0; i < 4; ++i) { const int c = F.tid + i * NTHREADS, row = c >> 4, cc = c & 15; const float f = __builtin_amdgcn_exp2f(lg * (float)(127 - row));
            const v4u v = *(const GAS v4u*)(gsrc + (size_t)row * EVEN_IN + cc * 8); v4u o;
#pragma unroll
            for (int k = 0; k < 4; ++k) o[k] = cvtpk(bflo(v[k]) * f, bfhi(v[k]) * f);
            *(LAS v4u*)(L + RA_VD + row * RP + cc * 16) = o; }
    }
    WG_BAR();
    f32x16 acc[2];
#pragma unroll
    for (int t = 0; t < 2; ++t) acc[t] = (f32x16){0.f, 0.f, 0.f, 0.f, 0.f, 0.f, 0.f, 0.f, 0.f, 0.f, 0.f, 0.f, 0.f, 0.f, 0.f, 0.f};
#pragma unroll
    for (int ks = 0; ks < 8; ++ks) { const bf16x8 a = ld_tr(L + RA_KI, RP, 16 * ks, db * 32, lane);
#pragma unroll
        for (int t = 0; t < 2; ++t) acc[t] = MFMA32(a, ld_tr(L + RA_VD, RP, 16 * ks, (2 * eh + t) * 32, lane), acc[t]); }
    WG_BAR();
#pragma unroll
    for (int t = 0; t < 2; ++t)
#pragma unroll
        for (int i = 0; i < 16; ++i) *(LAS bf16*)(L + RA_KI + (db * 32 + crow(i, h2)) * RP + ((2 * eh + t) * 32 + r) * 2) = cvt1(acc[t][i]);
    WG_BAR();
    bf16* out = RKV + (size_t)it * 128 * 128;
#pragma unroll
    for (int i = 0; i < 4; ++i) { const int c = F.tid + i * NTHREADS, row = c >> 4, cc = c & 15; *(GAS v4u*)(out + row * 128 + cc * 8) = *(const LAS v4u*)(L + RA_KI + row * RP + cc * 16); }
    WG_BAR();
}
__device__ __forceinline__ void ret_scan(const Frame& F, bf16* RKV) {
    for (int gt = F.bid * NTHREADS + F.tid; gt < 32 * 128 * 16; gt += F.G * NTHREADS) {
        const int bh = gt >> 11, d = (gt >> 4) & 127, e8 = gt & 15, h = bh & 3;
        const float g128 = __builtin_amdgcn_exp2f(ret_log2g(h) * 128.0f);
        float s[8];
#pragma unroll
        for (int i = 0; i < 8; ++i) s[i] = 0.f;
        for (int n0 = 0; n0 < 32; n0 += 4) {
            v4u kv[4];
#pragma unroll
            for (int u = 0; u < 4; ++u) kv[u] = *(const GAS v4u*)(RKV + (((size_t)bh * 32 + n0 + u) * 128 + d) * 128 + e8 * 8);
#pragma unroll
            for (int u = 0; u < 4; ++u) {
                v4u o; o.x = cvtpk(s[0], s[1]); o.y = cvtpk(s[2], s[3]); o.z = cvtpk(s[4], s[5]); o.w = cvtpk(s[6], s[7]);
                *(GAS v4u*)(RKV + (((size_t)bh * 32 + n0 + u) * 128 + d) * 128 + e8 * 8) = o;
#pragma unroll
                for (int i = 0; i < 4; ++i) { s[2 * i] = g128 * s[2 * i] + bflo(kv[u][i]); s[2 * i + 1] = g128 * s[2 * i + 1] + bfhi(kv[u][i]); } }
        }
    }
}
__device__ __forceinline__ void ret_phase_c_item(const Frame& F, int it, const bf16* P, const bf16* RKV, bf16* CAT) {
    LAS unsigned char* L = F.lds;
    const int lane = F.lane, r = lane & 31, h2 = lane >> 5, wave = F.wave, ib = wave & 3, eq = wave >> 2;
    const int bh = it >> 5, n = it & 31, b = bh >> 2, h = bh & 3;
    const float lg = ret_log2g(h);
    const bf16* Prow0 = P + ((size_t)b * SEQ + n * 128) * EVEN_IN;
    {
#pragma unroll
        for (int i = 0; i < 4; ++i) { const int c = F.tid + i * NTHREADS, row = c >> 4, cc = c & 15; const float fq = __builtin_amdgcn_exp2f(lg * (float)row), fk = __builtin_amdgcn_rcpf(fq);
            const v4u vq = *(const GAS v4u*)(Prow0 + (size_t)row * EVEN_IN + E_RQ + h * 128 + cc * 8), vk = *(const GAS v4u*)(Prow0 + (size_t)row * EVEN_IN + E_RK + h * 128 + cc * 8); v4u oq, ok;
#pragma unroll
            for (int k = 0; k < 4; ++k) { oq[k] = cvtpk(bflo(vq[k]) * fq, bfhi(vq[k]) * fq); ok[k] = cvtpk(bflo(vk[k]) * fk, bfhi(vk[k]) * fk); }
            *(LAS v4u*)(L + RC_QI + row * RP + cc * 16) = oq; *(LAS v4u*)(L + RC_KI + row * RP + cc * 16) = ok; }
    }
    stage_tile<128, 128>(L + RC_VI, RP, Prow0 + E_RV + h * 128, EVEN_IN, F.tid);
    stage_tile<128, 128>(L + RC_SI, RP, RKV + (size_t)it * 128 * 128, 128, F.tid);
    WG_BAR();
    bf16x8 PA[4][2];
#pragma unroll
    for (int jb = 0; jb < 4; ++jb) {
        if (jb <= ib) {
            f32x16 x = {0.f, 0.f, 0.f, 0.f, 0.f, 0.f, 0.f, 0.f, 0.f, 0.f, 0.f, 0.f, 0.f, 0.f, 0.f, 0.f};
#pragma unroll
            for (int ks = 0; ks < 8; ++ks) x = MFMA32(ld_row(L + RC_KI, RP, jb * 32, 16 * ks, r, h2), ld_row(L + RC_QI, RP, ib * 32, 16 * ks, r, h2), x);
            if (jb == ib) {
#pragma unroll
                for (int i = 0; i < 16; ++i) if (crow(i, h2) > r) x[i] = 0.f; }
            PA[jb][0] = PACK_STEP(x, 0); PA[jb][1] = PACK_STEP(x, 1);
        } else { PA[jb][0] = (bf16x8){0, 0, 0, 0, 0, 0, 0, 0}; PA[jb][1] = (bf16x8){0, 0, 0, 0, 0, 0, 0, 0}; }
    }
    f32x16 o[2];
#pragma unroll
    for (int t = 0; t < 2; ++t) {
        const int eb = 2 * eq + t;
        f32x16 z = {0.f, 0.f, 0.f, 0.f, 0.f, 0.f, 0.f, 0.f, 0.f, 0.f, 0.f, 0.f, 0.f, 0.f, 0.f, 0.f}, y = z;
#pragma unroll
        for (int jb = 0; jb < 4; ++jb) if (jb <= ib) {
#pragma unroll
            for (int s = 0; s < 2; ++s) z = MFMA32(PA[jb][s], ld_tr_perm(L + RC_VI, RP, jb * 32 + 16 * s, eb * 32, lane), z); }
#pragma unroll
        for (int ks = 0; ks < 8; ++ks) y = MFMA32(ld_row(L + RC_QI, RP, ib * 32, 16 * ks, r, h2), ld_tr(L + RC_SI, RP, 16 * ks, eb * 32, lane), y);
        const float g1 = __builtin_amdgcn_exp2f(lg);
#pragma unroll
        for (int i = 0; i < 16; ++i) z[i] += y[i] * g1;
        o[t] = z;
    }
    WG_BAR();
#pragma unroll
    for (int t = 0; t < 2; ++t)
#pragma unroll
        for (int i = 0; i < 16; ++i) *(LAS bf16*)(L + RC_QI + (ib * 32 + crow(i, h2)) * RP + ((2 * eq + t) * 32 + r) * 2) = cvt1(o[t][i]);
    WG_BAR();
    {
        const int row = F.tid >> 2, qtr = F.tid & 3;
        lcp orow = L + RC_QI + row * RP + qtr * 64;
        v4u w[4]; float sum = 0.f;
#pragma unroll
        for (int c = 0; c < 4; ++c) { w[c] = *(const LAS v4u*)(orow + c * 16);
#pragma unroll
            for (int i = 0; i < 4; ++i) sum += bflo(w[c][i]) + bfhi(w[c][i]); }
        sum += xsw<1>(sum); sum += xsw<2>(sum);
        const float mu = sum * (1.0f / 128.0f); float sq = 0.f;
#pragma unroll
        for (int c = 0; c < 4; ++c)
#pragma unroll
            for (int i = 0; i < 4; ++i) { const float d0 = bflo(w[c][i]) - mu, d1 = bfhi(w[c][i]) - mu; sq += d0 * d0 + d1 * d1; }
        sq += xsw<1>(sq); sq += xsw<2>(sq);
        const float rstd = 1.0f / sqrtf(sq * (1.0f / 128.0f) + EPS);
        const bf16* gp = Prow0 + (size_t)row * EVEN_IN + E_RG + h * 128 + qtr * 32;
        bf16* op = CAT + ((size_t)b * SEQ + n * 128 + row) * D + h * 128 + qtr * 32;
#pragma unroll
        for (int c = 0; c < 4; ++c) { const v4u gw = *(const GAS v4u*)(gp + c * 8); v4u ow;
#pragma unroll
            for (int i = 0; i < 4; ++i) { const float g0 = bflo(gw[i]), g1 = bfhi(gw[i]);
                ow[i] = cvtpk((bflo(w[c][i]) - mu) * rstd * silu_f(g0), (bfhi(w[c][i]) - mu) * rstd * silu_f(g1)); }
            *(GAS v4u*)(op + c * 8) = ow; }
    }
    WG_BAR();
}
__device__ __forceinline__ void dil_tile(const Frame& F, int T, const bf16* P, bf16* OD, float* LSE) {
    LAS unsigned char* L = F.lds;
    const int lane = F.lane, r = lane & 31, h2 = lane >> 5, wave = F.wave;
    const int b = T / 384, rem = T - b * 384, head = rem / 48, t48 = rem - head * 48, p = t48 >> 4, idx = t48 & 15;
    const int sh = 2 * p, dil = 1 << sh, res = idx & (dil - 1), blk = idx >> sh, q0 = blk * 256;
    const bf16* Pb = P + (size_t)b * SEQ * EVEN_IN + head * 64;
#pragma unroll
    for (int i = 0; i < 6; ++i) { const int c = F.tid + i * NTHREADS, row = c >> 3, cc = c & 7; int kidx = q0 - 128 + row; kidx = kidx < 0 ? 0 : kidx;
        const bf16* src = Pb + (size_t)(kidx * dil + res) * EVEN_IN + cc * 8;
        const v4u kv = *(const GAS v4u*)(src + E_DK), vv = *(const GAS v4u*)(src + E_DV);
        *(LAS v4u*)(L + DL_KI + row * DP + cc * 16) = kv; *(LAS v4u*)(L + DL_VI + row * DP + cc * 16) = vv; }
    bf16x8 qf[4];
    { const bf16* qsrc = Pb + (size_t)((q0 + 32 * wave + r) * dil + res) * EVEN_IN + E_DQ + 8 * h2;
#pragma unroll
      for (int ks = 0; ks < 4; ++ks) qf[ks] = *(const GAS bf16x8*)(qsrc + 16 * ks); }
    WG_BAR();
    f32x16 x[5];
    float mx = -INFINITY;
#pragma unroll
    for (int kb = 0; kb < 5; ++kb) {
        f32x16 a = {0.f, 0.f, 0.f, 0.f, 0.f, 0.f, 0.f, 0.f, 0.f, 0.f, 0.f, 0.f, 0.f, 0.f, 0.f, 0.f};
#pragma unroll
        for (int ks = 0; ks < 4; ++ks) a = MFMA32(ld_row(L + DL_KI, DP, 32 * wave + 32 * kb, 16 * ks, r, h2), qf[ks], a);
        if (kb == 0) {
#pragma unroll
            for (int i = 0; i < 16; ++i) if (crow(i, h2) < r) a[i] = -INFINITY; }
        if (kb == 4) {
#pragma unroll
            for (int i = 0; i < 16; ++i) if (crow(i, h2) > r) a[i] = -INFINITY; }
        if (q0 == 0 && 32 * wave + 32 * kb < 128) {
#pragma unroll
            for (int i = 0; i < 16; ++i) a[i] = -INFINITY; }
#pragma unroll
        for (int i = 0; i < 16; ++i) mx = fmaxf(mx, a[i]);
        x[kb] = a;
    }
    mx = max32(mx);
    constexpr float C2 = 0.125f * LOG2E;
    const float mc = mx * C2; float l = 0.f;
#pragma unroll
    for (int kb = 0; kb < 5; ++kb)
#pragma unroll
        for (int i = 0; i < 16; ++i) { const float pe = __builtin_amdgcn_exp2f(x[kb][i] * C2 - mc); x[kb][i] = pe; l += pe; }
    l = sum32(l);
    f32x16 o[2];
#pragma unroll
    for (int dbk = 0; dbk < 2; ++dbk) o[dbk] = (f32x16){0.f, 0.f, 0.f, 0.f, 0.f, 0.f, 0.f, 0.f, 0.f, 0.f, 0.f, 0.f, 0.f, 0.f, 0.f, 0.f};
#pragma unroll
    for (int kb = 0; kb < 5; ++kb)
#pragma unroll
        for (int s = 0; s < 2; ++s) { const bf16x8 pa = PACK_STEP(x[kb], s);
#pragma unroll
            for (int dbk = 0; dbk < 2; ++dbk) o[dbk] = MFMA32(pa, ld_tr_perm(L + DL_VI, DP, 32 * wave + 32 * kb + 16 * s, dbk * 32, lane), o[dbk]); }
    LAS float* lw = (LAS float*)(L + DL_LW + wave * 256);
    if (h2 == 0) lw[r] = l;
    LAS unsigned char* st = L + DL_ST + wave * 32 * DP;
#pragma unroll
    for (int i = 0; i < 16; ++i) { const float rl = __builtin_amdgcn_rcpf(lw[crow(i, h2)]);
#pragma unroll
        for (int dbk = 0; dbk < 2; ++dbk) *(LAS bf16*)(st + crow(i, h2) * DP + (dbk * 32 + r) * 2) = cvt1(o[dbk][i] * rl); }
    const size_t tokbase = (size_t)b * SEQ;
    bf16* odp = OD + (size_t)p * M * 512;
#pragma unroll
    for (int j = 0; j < 4; ++j) { const int c = lane + 64 * j, row = c >> 3, cc = c & 7; const size_t tok = tokbase + (size_t)(q0 + 32 * wave + row) * dil + res;
        *(GAS v4u*)(odp + tok * 512 + head * 64 + cc * 8) = *(const LAS v4u*)(st + row * DP + cc * 16); }
    if (h2 == 0) { const size_t tok = tokbase + (size_t)(q0 + 32 * wave + r) * dil + res; LSE[((size_t)p * M + tok) * 8 + head] = mx * 0.125f + LN2 * __builtin_amdgcn_logf(l); }
    WG_BAR();
}
__device__ __forceinline__ void dil_combine(const Frame& F, const bf16* OD, const float* LSE, bf16* CAT) {
    for (int gt = F.bid * NTHREADS + F.tid; gt < M * 64; gt += F.G * NTHREADS) {
        const int tok = gt >> 6, c8 = gt & 63, head = c8 >> 3;
        const float l0 = LSE[(size_t)tok * 8 + head], l1 = LSE[((size_t)M + tok) * 8 + head], l2 = LSE[((size_t)2 * M + tok) * 8 + head];
        const float mxl = fmaxf(l0, fmaxf(l1, l2));
        float w0 = __builtin_amdgcn_exp2f((l0 - mxl) * LOG2E), w1 = __builtin_amdgcn_exp2f((l1 - mxl) * LOG2E), w2 = __builtin_amdgcn_exp2f((l2 - mxl) * LOG2E);
        const float rs = 1.0f / (w0 + w1 + w2); w0 *= rs; w1 *= rs; w2 *= rs;
        const v4u a = *(const GAS v4u*)(OD + (size_t)tok * 512 + c8 * 8), bq = *(const GAS v4u*)(OD + ((size_t)M + tok) * 512 + c8 * 8), cq = *(const GAS v4u*)(OD + ((size_t)2 * M + tok) * 512 + c8 * 8);
        v4u o;
#pragma unroll
        for (int i = 0; i < 4; ++i) o[i] = cvtpk(w0 * bflo(a[i]) + w1 * bflo(bq[i]) + w2 * bflo(cq[i]), w0 * bfhi(a[i]) + w1 * bfhi(bq[i]) + w2 * bfhi(cq[i]));
        *(GAS v4u*)(CAT + (size_t)tok * D + 512 + c8 * 8) = o;
    }
}
constexpr int DIL_TILES = 3072, DIL_SPLIT = 1024;
__device__ __forceinline__ void even_phase_a(const Frame& F0) {
    const Frame F = relaunder(F0);
    unsigned char* ws = WSP();
    const bf16* P = (const bf16*)(ws + WS_ACT); bf16* RKV = (bf16*)(ws + WS_XB); bf16* OD = (bf16*)(ws + WS_OD); float* LSE = (float*)(ws + WS_LSE);
    for (int it = F.bid; it < 1024; it += F.G) ret_phase_a_item(F, it, P, RKV);
    for (int T = F.bid; T < DIL_SPLIT; T += F.G) dil_tile(F, T, P, OD, LSE);
}
__device__ __forceinline__ void even_phase_b(const Frame& F0) {
    const Frame F = relaunder(F0);
    unsigned char* ws = WSP();
    const bf16* P = (const bf16*)(ws + WS_ACT); bf16* RKV = (bf16*)(ws + WS_XB); bf16* OD = (bf16*)(ws + WS_OD); float* LSE = (float*)(ws + WS_LSE);
    ret_scan(F, RKV);
    for (int T = DIL_SPLIT + F.bid; T < DIL_TILES; T += F.G) dil_tile(F, T, P, OD, LSE);
}
__device__ __forceinline__ void even_phase_c(const Frame& F0) {
    const Frame F = relaunder(F0);
    unsigned char* ws = WSP();
    const bf16* P = (const bf16*)(ws + WS_ACT); const bf16* RKV = (const bf16*)(ws + WS_XB); const bf16* OD = (const bf16*)(ws + WS_OD); const float* LSE = (const float*)(ws + WS_LSE); bf16* CAT = (bf16*)(ws + WS_CAT);
    for (int it = F.bid; it < 1024; it += F.G) ret_phase_c_item(F, it, P, RKV, CAT);
    dil_combine(F, OD, LSE, CAT);
}

__global__ void __launch_bounds__(NTHREADS, 2) fwd_kernel(Args args) {
    extern __shared__ __attribute__((aligned(16))) unsigned char lds[];
    Frame F;
    F.lds = (LAS unsigned char*)lds;
    F.wave = __builtin_amdgcn_readfirstlane((int)(threadIdx.x >> 6)); F.lane = hw_lane(); F.tid = F.wave * 64 + F.lane; F.G = gridDim.x; F.bid = blockIdx.x;
    for (int u = F.tid; u < (LDS_BYTES - LDSCTL_OFF) / 4; u += NTHREADS) ((LAS unsigned*)(F.lds + LDSCTL_OFF))[u] = 0u;
    __syncthreads();
    if (F.tid < N_PTRS) { const unsigned long long v = (F.tid < 17) ? (unsigned long long)args.in[F.tid] : (F.tid == 17 ? (unsigned long long)args.out : (unsigned long long)args.ws);
        ((LAS unsigned*)(F.lds + PTR_OFF))[2 * F.tid] = (unsigned)v; ((LAS unsigned*)(F.lds + PTR_OFF))[2 * F.tid + 1] = (unsigned)(v >> 32); }
    __syncthreads();
    (void)xcd_barrier_post((unsigned*)(WSP() + WS_CTL) + CW_BAR, (volatile LAS unsigned*)(F.lds + MISC_OFF) + 8, F.tid);
#ifdef PROBE_BARX2
#define PROBE_BAR2(b, t) xcd_barrier(b, t)
#else
#define PROBE_BAR2(b, t) do {} while (0)
#endif
#define GRID_BAR() do { XcdBarrier bar_; bar_.bar = (unsigned*)(WSP() + WS_CTL) + CW_BAR; bar_.x = (unsigned)__builtin_amdgcn_readfirstlane((int)xb_xcc_id()); \
        int mo_ = MISC_OFF + 32; asm volatile("" : "+s"(mo_)); bar_.st = (volatile LAS unsigned*)(F.lds + mo_); int t_ = threadIdx.x; asm volatile("" : "+v"(t_)); xcd_barrier(bar_, t_); PROBE_BAR2(bar_, t_); } while (0)
#define XB ((bf16*)(WSP() + WS_XB))
#define ACT ((bf16*)(WSP() + WS_ACT))
#define CAT ((bf16*)(WSP() + WS_CAT))
#define SSP ((float*)(WSP() + WS_SSP))
#define WPTR(off) ((const bf16*)(WSP() + (off)))

#ifdef TEST_MIN
    {
        pg8::Gemm g{XB, WPTR(W_GU0), M, 2 * FF, D}; pg8::StaticOrder S; S.init(M, 2 * FF, lnd(F.G), lnd(F.bid));
        pg8::EpiSwiGLU E{ACT, FF, SSP};
        pg8::gemm_phase<pg8::EpiSwiGLU, pg8::StaticOrder, true, true>(F.lds + RING_OFF, g, S, E, lnd(F.wave));
        GRID_BAR();
        return;
    }
#endif
    prologue_rows(F);
    convert_weights(F, 0);
    GRID_BAR();
    for (int s = 0; s < 8; ++s) {
        const int l = s >> 1; const bool post = (s & 1) != 0;
#ifdef PROBE_F1X2
        for (int rep = 0; rep < 2; ++rep)
#endif
        {
#ifdef PROBE_KX2
            typedef pg8::TwiceOrder F1Order;
#else
            typedef pg8::StaticOrder F1Order;
#endif
            pg8::Gemm g{XB, WPTR(post ? W_GU1 : W_GU0), M, 2 * FF, D}; F1Order S; S.init(M, 2 * FF, lnd(F.G), lnd(F.bid));
            pg8::EpiSwiGLU E{ACT, FF, SSP};
#ifndef NO_F1
            pg8::gemm_phase<pg8::EpiSwiGLU, F1Order, true, true>(F.lds + RING_OFF, g, S, E, lnd(F.wave));
#endif
            GRID_BAR();
        }
#ifdef PROBE_F2X2
        for (int rep = 0; rep < 2; ++rep)
#else
        constexpr int rep = 1;
#endif
        {
            pg8::Gemm g{ACT, WPTR(post ? W_D1 : W_D0), M, D, FF}; pg8::StaticOrder S; S.init(M, D, lnd(F.G), lnd(F.bid));
            pg8::EpiResid E{s == 0 ? AP(I_X) : (const float*)OUTP(), OUTP(), XB, SSP, rep ? 0.5f : 0.0f};
#ifndef NO_F2
            pg8::gemm_phase<pg8::EpiResid, pg8::StaticOrder, true, true>(F.lds + RING_OFF, g, S, E, lnd(F.wave));
#endif
            GRID_BAR();
        }
        if (!post) {
            const bool odd = (l & 1) != 0; const int nin = odd ? GLA_INP : EVEN_IN;
            {
                pg8::Gemm g{XB, WPTR(W_IN), M, nin, D}; pg8::StaticOrder S; S.init(M, nin, lnd(F.G), lnd(F.bid));
                pg8::EpiScaleBf16 E{ACT, nin, SSP};
#ifndef NO_M1
                pg8::gemm_phase<pg8::EpiScaleBf16, pg8::StaticOrder, true, true>(F.lds + RING_OFF, g, S, E, lnd(F.wave));
#endif
            }
            GRID_BAR();
#ifndef NO_EVEN
#ifdef PROBE_MIXX2
            if (!odd) { even_prep(F); GRID_BAR(); even_phase_a(F); GRID_BAR(); even_phase_a(F); GRID_BAR(); even_phase_b(F); GRID_BAR(); even_phase_c(F); GRID_BAR(); even_phase_c(F); }
#else
            if (!odd) { even_prep(F); GRID_BAR(); even_phase_a(F); GRID_BAR(); even_phase_b(F); GRID_BAR(); even_phase_c(F); }
#endif
#endif
#ifndef NO_GLA
            if (odd) {
#ifndef NO_GA
                gla_phase_a(F, l >> 1);
#endif
#ifdef PROBE_MIXX2
                GRID_BAR(); gla_phase_a(F, l >> 1);
#endif
                GRID_BAR();
#ifndef NO_GB
                gla_phase_b(F);
#endif
                GRID_BAR();
#ifndef NO_GC
                gla_phase_c(F, l >> 1);
#endif
#ifdef PROBE_MIXX2
                GRID_BAR(); gla_phase_c(F, l >> 1);
#endif
            }
#endif
            GRID_BAR();
#ifdef PROBE_M5X2
            for (int rep2 = 0; rep2 < 2; ++rep2)
#else
            constexpr int rep2 = 1;
#endif
            {
                pg8::Gemm g{CAT, WPTR(W_OUT), M, D, D}; pg8::StaticOrder S; S.init(M, D, lnd(F.G), lnd(F.bid));
                pg8::EpiResid E{(const float*)OUTP(), OUTP(), XB, SSP, rep2 ? 1.0f : 0.0f};
#ifndef NO_M5
                pg8::gemm_phase<pg8::EpiResid, pg8::StaticOrder, true, true>(F.lds + RING_OFF, g, S, E, lnd(F.wave));
#endif
                GRID_BAR();
            }
        } else if (l + 1 < DEPTH) {
            convert_weights(F, l + 1);
            GRID_BAR();
#ifdef PROBE_CONVX2
            convert_weights(F, l + 1);
            GRID_BAR();
#endif
        }
    }
    final_norm(F);
}

extern "C" void kernel_launch(void* const* d_in, const int* in_sizes, int n_in, void* d_out, int out_size, void* d_ws, size_t ws_size, hipStream_t stream) {
    static int grid = 0;
    if (grid == 0) {
        if (n_in != 17 || in_sizes[0] != M * D || out_size != M * D || ws_size < WS_END2) { fprintf(stderr, "kernel_launch: unexpected shapes (n_in %d, in0 %d, out %d, ws %zu)\n", n_in, n_in > 0 ? in_sizes[0] : -1, out_size, ws_size); grid = -1; return; }
        int dev = 0, cus = 0, per_cu = 0;
        if (hipGetDevice(&dev) != hipSuccess || hipDeviceGetAttribute(&cus, hipDeviceAttributeMultiprocessorCount, dev) != hipSuccess) { grid = -1; return; }
        if (hipFuncSetAttribute((const void*)fwd_kernel, hipFuncAttributeMaxDynamicSharedMemorySize, LDS_BYTES) != hipSuccess) { fprintf(stderr, "kernel_launch: hipFuncSetAttribute failed\n"); grid = -1; return; }
        if (hipOccupancyMaxActiveBlocksPerMultiprocessor(&per_cu, (const void*)fwd_kernel, NTHREADS, LDS_BYTES) != hipSuccess || per_cu < 1) { fprintf(stderr, "kernel_launch: occupancy query reports %d\n", per_cu); }
        (void)hipGetLastError();
        grid = cus;
        if (grid != 256) fprintf(stderr, "kernel_launch: %d CUs (expected 256)\n", grid);
    }
    if (grid < 0) return;
    if (hipMemsetAsync((char*)d_ws + WS_CTL, 0, CTL_ZERO_BYTES, stream) != hipSuccess) return;
    Args a{};
    for (int i = 0; i < 17; ++i) a.in[i] = (const float*)d_in[i];
    a.out = (float*)d_out; a.ws = (unsigned char*)d_ws;
    hipLaunchKernelGGL(fwd_kernel, dim3(grid), dim3(NTHREADS), LDS_BYTES, stream, a);
}
```

```cpp
#include <hip/hip_runtime.h>
#include <cstdio>
#include <cstdint>
#include <cmath>
template <int K> __device__ __forceinline__ float xsw(float v) { static_assert(K == 1 || K == 2 || K == 4 || K == 8 || K == 16, "xor mask inside a 32-lane half");
    return __builtin_bit_cast(float, __builtin_amdgcn_ds_swizzle(__builtin_bit_cast(int, v), 0x1F | (K << 10))); }
__device__ __forceinline__ float sum32(float v) { const unsigned u = __builtin_bit_cast(unsigned, v); auto rr = __builtin_amdgcn_permlane32_swap(u, u, false, false); return __builtin_bit_cast(float, (unsigned)rr[0]) + __builtin_bit_cast(float, (unsigned)rr[1]); }
__device__ __forceinline__ float max32(float v) { const unsigned u = __builtin_bit_cast(unsigned, v); auto rr = __builtin_amdgcn_permlane32_swap(u, u, false, false); return fmaxf(__builtin_bit_cast(float, (unsigned)rr[0]), __builtin_bit_cast(float, (unsigned)rr[1])); }
__device__ __forceinline__ float oth32(float v, int h) { const unsigned u = __builtin_bit_cast(unsigned, v); auto rr = __builtin_amdgcn_permlane32_swap(u, u, false, false); return __builtin_bit_cast(float, (unsigned)(h ? rr[0] : rr[1])); }
namespace pg8 {
#define PG8_LAS __attribute__((address_space(3)))
typedef unsigned short bf16_t;
typedef short bf16x8 __attribute__((ext_vector_type(8)));
typedef float f32x4 __attribute__((ext_vector_type(4)));
typedef unsigned u32x4 __attribute__((ext_vector_type(4)));
constexpr int BM = 256, BK = 64, HALF = 128, HTB = HALF * BK * 2  , STAGE_BYTES = 8 * HTB, NXCD = 8, WGM = 8;

__host__ __device__ __forceinline__ int lds_byte(int r, int c) { const int st = (r >> 4) * 2 + (c >> 5), rr = r & 15, cc = c & 31, ob = rr * 64 + cc * 2; return st * 1024 + (ob ^ (((ob >> 9) & 1) << 5)); }
__host__ __device__ __forceinline__ void stage_rc(int b, int& R, int& C) { const int st = b / 1024, sb = b % 1024, swz = sb ^ (((sb >> 9) & 1) << 5); R = (st >> 1) * 16 + swz / 64; C = (st & 1) * 32 + (swz % 64) / 2; }
__host__ __device__ __forceinline__ int perm32(int rho) { const int n = rho >> 4, i = rho & 15; return 8 * (i >> 2) + 4 * n + (i & 3); }

struct Unit { int pm, pn; };
struct Gemm { const bf16_t* A; const bf16_t* Bt; int M, N, K; };

struct StaticOrder {
    int nM, nN, nwg, G, c;
    __host__ __device__ void init(int M, int N, int G_, int c_) { nM = M / BM; nN = N / BM; nwg = nM * nN; G = G_; c = c_; }
    __host__ __device__ bool next(int i, Unit& u) const {
        const long L = (long)i * G + c; if (L >= nwg) return false;
        int wgid = (int)L; { const int q = nwg / NXCD, r = nwg % NXCD, xcd = wgid % NXCD, off = wgid / NXCD; wgid = (xcd < r ? xcd * (q + 1) : r * (q + 1) + (xcd - r) * q) + off; }
        const int nig = WGM * nN, gid = wgid / nig, fm = gid * WGM, gsz = (nM - fm) < WGM ? (nM - fm) : WGM;
        u.pm = fm + ((wgid % nig) % gsz); u.pn = (wgid % nig) / gsz; return true;
    }
    __device__ __forceinline__ void a_ready(const Unit&) const {}
    __device__ __forceinline__ void done(const Unit&) const {}
    static constexpr bool TWICE = false;
};
struct TwiceOrder : StaticOrder {
    static constexpr bool TWICE = true;
    __host__ __device__ bool next(int i, Unit& u) const { return StaticOrder::next(i >> 1, u); }
};

__device__ __forceinline__ unsigned cvt_pk_bf16(float lo, float hi) { unsigned r; asm volatile("v_cvt_pk_bf16_f32 %0, %1, %2" : "=v"(r) : "v"(lo), "v"(hi)); return r; }
constexpr int MROWS = 32768;
constexpr float RMS_EPS = 1e-6f;
__device__ __forceinline__ void row_rstd(float (&rs)[2][4], const float* ssp, const Unit& u, int wr, int fr, int fq) {
#pragma unroll
    for (int ai = 0; ai < 2; ++ai)
#pragma unroll
        for (int m = 0; m < 4; ++m) {
            const int row = u.pm * BM + ai * HALF + wr * 64 + m * 16 + fr;
            const f32x4 p = *(const f32x4*)(ssp + (size_t)row * 16 + 4 * fq);
            float s = (p[0] + p[1]) + (p[2] + p[3]);
            s += xsw<16>(s); s = sum32(s);
            rs[ai][m] = 1.0f / sqrtf(s * (1.0f / 1024.0f) + RMS_EPS);
        }
}
__device__ __forceinline__ float silu_f(float g) { return g * __builtin_amdgcn_rcpf(1.0f + __builtin_amdgcn_exp2f(-1.4426950408889634f * g)); }

struct EpiSwiGLU {
    static constexpr bool PERM = true, AFTER_DRAIN = false;
    bf16_t* H; int ldh; const float* ssp;
    __device__ __forceinline__ void operator()(const f32x4 (&acc)[2][2][4][2], const Unit& u, int wr, int wc, int fr, int fq) const {
        float rs[2][4]; row_rstd(rs, ssp, u, wr, fr, fq);
        const int col0 = u.pn * HALF + wc * 32 + 8 * fq;
#pragma unroll
        for (int ai = 0; ai < 2; ++ai)
#pragma unroll
            for (int m = 0; m < 4; ++m) {
                const int row = u.pm * BM + ai * HALF + wr * 64 + m * 16 + fr; const float r = rs[ai][m];
                float h[8];
#pragma unroll
                for (int n = 0; n < 2; ++n)
#pragma unroll
                    for (int i = 0; i < 4; ++i) { const float g = acc[ai][0][m][n][i] * r, up = acc[ai][1][m][n][i] * r; h[4 * n + i] = silu_f(g) * up; }
                u32x4 w; w.x = cvt_pk_bf16(h[0], h[1]); w.y = cvt_pk_bf16(h[2], h[3]); w.z = cvt_pk_bf16(h[4], h[5]); w.w = cvt_pk_bf16(h[6], h[7]);
                *(u32x4*)(H + (size_t)row * ldh + col0) = w;
                asm volatile("" ::: "memory");
            }
    }
};
struct EpiScaleBf16 {
    static constexpr bool PERM = true, AFTER_DRAIN = false;
    bf16_t* O; int ldc; const float* ssp;
    __device__ __forceinline__ void operator()(const f32x4 (&acc)[2][2][4][2], const Unit& u, int wr, int wc, int fr, int fq) const {
        float rs[2][4]; row_rstd(rs, ssp, u, wr, fr, fq);
        const int col0 = u.pn * BM + wc * 32 + 8 * fq;
#pragma unroll
        for (int ai = 0; ai < 2; ++ai)
#pragma unroll
            for (int m = 0; m < 4; ++m) {
                const int row = u.pm * BM + ai * HALF + wr * 64 + m * 16 + fr; const float r = rs[ai][m];
#pragma unroll
                for (int bj = 0; bj < 2; ++bj) { const f32x4 v0 = acc[ai][bj][m][0] * r, v1 = acc[ai][bj][m][1] * r;
                    u32x4 w; w.x = cvt_pk_bf16(v0[0], v0[1]); w.y = cvt_pk_bf16(v0[2], v0[3]); w.z = cvt_pk_bf16(v1[0], v1[1]); w.w = cvt_pk_bf16(v1[2], v1[3]);
                    *(u32x4*)(O + (size_t)row * ldc + col0 + bj * HALF) = w; }
                asm volatile("" ::: "memory");
            }
    }
};
struct EpiResid {
    static constexpr bool PERM = true, AFTER_DRAIN = false;
    const float* xold; float* xnew; bf16_t* xb; float* ssp; float scale;
    __device__ __forceinline__ void operator()(const f32x4 (&acc)[2][2][4][2], const Unit& u, int wr, int wc, int fr, int fq) const {
        const int col0 = u.pn * BM + wc * 32 + 8 * fq, rowb = u.pm * BM + wr * 64 + fr;
        f32x4 buf[2][4];
#define EPR_LOAD(g, slot) do { const size_t off_ = (size_t)(rowb + ((g) >> 2) * HALF + ((g) & 3) * 16) * 1024 + col0; \
        buf[slot][0] = *(const f32x4*)(xold + off_); buf[slot][1] = *(const f32x4*)(xold + off_ + 4); buf[slot][2] = *(const f32x4*)(xold + off_ + HALF); buf[slot][3] = *(const f32x4*)(xold + off_ + HALF + 4); } while (0)
        EPR_LOAD(0, 0); EPR_LOAD(1, 1);
        asm volatile("" ::: "memory");
#pragma unroll
        for (int g = 0; g < 8; ++g) {
            const int ai = g >> 2, m = g & 3, row = rowb + ai * HALF + m * 16; float ss = 0.f;
#pragma unroll
            for (int bj = 0; bj < 2; ++bj) { const size_t off = (size_t)row * 1024 + col0 + bj * HALF;
                const f32x4 v0 = buf[g & 1][2 * bj] + acc[ai][bj][m][0] * scale, v1 = buf[g & 1][2 * bj + 1] + acc[ai][bj][m][1] * scale;
                *(f32x4*)(xnew + off) = v0; *(f32x4*)(xnew + off + 4) = v1;
                u32x4 w; w.x = cvt_pk_bf16(v0[0], v0[1]); w.y = cvt_pk_bf16(v0[2], v0[3]); w.z = cvt_pk_bf16(v1[0], v1[1]); w.w = cvt_pk_bf16(v1[2], v1[3]);
                *(u32x4*)(xb + off) = w;
                ss += (v0[0] * v0[0] + v0[1] * v0[1]) + (v0[2] * v0[2] + v0[3] * v0[3]) + (v1[0] * v1[0] + v1[1] * v1[1]) + (v1[2] * v1[2] + v1[3] * v1[3]); }
            ss += xsw<16>(ss); ss = sum32(ss);
            if (fq == 0) ssp[(size_t)row * 16 + u.pn * 4 + wc] = ss;
            asm volatile("" ::: "memory");
            if (g + 2 < 8) { EPR_LOAD(g + 2, g & 1); asm volatile("" ::: "memory"); }
        }
#undef EPR_LOAD
    }
};

template <class Epi, class Sched, bool ALIGN_EPI = false, bool SP2 = false>
__device__ __forceinline__ void gemm_phase(PG8_LAS unsigned char* lds, const Gemm g, const Sched& S, const Epi& E, int wave_in) {
    int tid_ = threadIdx.x; asm volatile("" : "+v"(tid_));
    const int tid = tid_, wid = __builtin_amdgcn_readfirstlane(tid >> 6), lane = tid & 63, wr = wid >> 2, wc = wid & 3, fr = lane & 15, fq = lane >> 4;
    const int K = g.K, nt = K / BK;
    unsigned voffA[2], voffB[2];
#pragma unroll
    for (int i = 0; i < 2; ++i) { int R, C; stage_rc(tid * 16 + i * 8192, R, C); const int Rb = Epi::PERM ? ((R & ~31) + perm32(R & 31)) : R;
        voffA[i] = (unsigned)(R * K + C) * 2u; voffB[i] = (unsigned)(Rb * K + C) * 2u; }
    const size_t kstep = (size_t)(BK * 2);
    const size_t hstep = (size_t)HALF * K * 2;
    const size_t tstep = 2 * hstep;
    const unsigned ldsw = (unsigned)wid * 1024u;
    const int aoff = lds_byte(wr * 64 + fr, fq * 8), boff = lds_byte(wc * 32 + fr, fq * 8);
#define PG8_SA(b, h) (((b) * 2 + (h)) * HTB)
#define PG8_SB(b, h) ((4 + (b) * 2 + (h)) * HTB)
#define PG8_STAGE(bufoff, gbase, voff) do { _Pragma("unroll") for (int _i = 0; _i < 2; ++_i) \
        __builtin_amdgcn_global_load_lds((const unsigned*)((const char*)(gbase) + (voff)[_i]), (PG8_LAS unsigned*)(lds + (bufoff) + ldsw + _i * 8192), 16, 0, 0); } while (0)
#define PG8_LDA(dst, b, h) do { _Pragma("unroll") for (int m = 0; m < 4; ++m) _Pragma("unroll") for (int k = 0; k < 2; ++k) dst[m][k] = *(const PG8_LAS bf16x8*)(lds + PG8_SA(b, h) + aoff + m * 2048 + k * 1024); } while (0)
#define PG8_LDB(dst, b, h) do { _Pragma("unroll") for (int n = 0; n < 2; ++n) _Pragma("unroll") for (int k = 0; k < 2; ++k) dst[n][k] = *(const PG8_LAS bf16x8*)(lds + PG8_SB(b, h) + boff + n * 2048 + k * 1024); } while (0)
#define PG8_MMA(ai, bj, At, Bt) do { __builtin_amdgcn_s_setprio(1); _Pragma("unroll") for (int m = 0; m < 4; ++m) _Pragma("unroll") for (int n = 0; n < 2; ++n) _Pragma("unroll") for (int k = 0; k < 2; ++k) \
        acc[ai][bj][m][n] = __builtin_amdgcn_mfma_f32_16x16x32_bf16(Bt[n][k], At[m][k], acc[ai][bj][m][n], 0, 0, 0); __builtin_amdgcn_s_setprio(0); } while (0)
#define PG8_WAIT_V(n) asm volatile("s_waitcnt vmcnt(" #n ")" ::: "memory")
#define PG8_WAIT_L(n) asm volatile("s_waitcnt lgkmcnt(" #n ")" ::: "memory")
#define PG8_BAR __builtin_amdgcn_s_barrier()
#define PG8_SCHED __builtin_amdgcn_sched_barrier(0)
    Unit cur, nxt; int ui = 0;
    if (!S.next(0, cur)) return;
    f32x4 acc[2][2][4][2];
#pragma unroll
    for (int a = 0; a < 2; ++a)
#pragma unroll
        for (int b = 0; b < 2; ++b)
#pragma unroll
            for (int m = 0; m < 4; ++m)
#pragma unroll
                for (int n = 0; n < 2; ++n) acc[a][b][m][n] = (f32x4){0.f, 0.f, 0.f, 0.f};
    bf16x8 At[4][2], B0[2][2], B1[2][2];
    const char* cA = (const char*)g.A + (size_t)cur.pm * tstep; const char* cB = (const char*)g.Bt + (size_t)cur.pn * tstep;
    S.a_ready(cur);
    if constexpr (SP2) {
        PG8_STAGE(PG8_SB(0, 0), cB, voffB); PG8_STAGE(PG8_SB(0, 1), cB + hstep, voffB); PG8_STAGE(PG8_SA(0, 0), cA, voffA); PG8_STAGE(PG8_SA(0, 1), cA + hstep, voffA);
        if (wr == 1) PG8_BAR;
        PG8_WAIT_V(2); PG8_BAR;
        PG8_STAGE(PG8_SB(1, 0), cB + kstep, voffB); PG8_STAGE(PG8_SA(1, 0), cA + kstep, voffA); PG8_STAGE(PG8_SB(1, 1), cB + hstep + kstep, voffB);
        PG8_WAIT_V(6); PG8_BAR;
    } else {
        PG8_STAGE(PG8_SB(0, 0), cB, voffB); PG8_STAGE(PG8_SA(0, 0), cA, voffA); PG8_STAGE(PG8_SB(0, 1), cB + hstep, voffB); PG8_STAGE(PG8_SA(0, 1), cA + hstep, voffA);
        if (wr == 1) PG8_BAR;
        PG8_WAIT_V(4); PG8_BAR;
        PG8_STAGE(PG8_SB(1, 0), cB + kstep, voffB); PG8_STAGE(PG8_SA(1, 0), cA + kstep, voffA); PG8_STAGE(PG8_SB(1, 1), cB + hstep + kstep, voffB);
        PG8_WAIT_V(6); PG8_BAR;
    }
    for (;;) {
        const bool has_next = S.next(ui + 1, nxt);
        const char* nA = has_next ? (const char*)g.A + (size_t)nxt.pm * tstep : cA; const char* nB = has_next ? (const char*)g.Bt + (size_t)nxt.pn * tstep : cB;
        for (int t = 0; t < nt; t += 2) {
            const bool last = (t == nt - 2);
            const char* a1 = cA + (size_t)(t + 1) * kstep;
            const char* a2 = last ? nA : cA + (size_t)(t + 2) * kstep; const char* b2 = last ? nB : cB + (size_t)(t + 2) * kstep;
            const char* a3 = a2 + kstep; const char* b3 = b2 + kstep;
            if (last && has_next) S.a_ready(nxt);
            if constexpr (SP2) {
            PG8_LDB(B0, 0, 0); PG8_LDB(B1, 0, 1); PG8_SCHED; PG8_LDA(At, 0, 0); PG8_STAGE(PG8_SA(1, 1), a1 + hstep, voffA);
            PG8_WAIT_V(8); PG8_WAIT_L(0); PG8_BAR; PG8_MMA(0, 0, At, B0); PG8_MMA(0, 1, At, B1); PG8_BAR; PG8_SCHED;
            PG8_LDA(At, 0, 1); PG8_STAGE(PG8_SB(0, 0), b2, voffB); PG8_STAGE(PG8_SB(0, 1), b2 + hstep, voffB); PG8_STAGE(PG8_SA(0, 0), a2, voffA);
            PG8_WAIT_V(8); PG8_WAIT_L(0); PG8_BAR; PG8_MMA(1, 0, At, B0); PG8_MMA(1, 1, At, B1); PG8_BAR; PG8_SCHED;
            PG8_LDB(B0, 1, 0); PG8_LDB(B1, 1, 1); PG8_SCHED; PG8_LDA(At, 1, 0); PG8_STAGE(PG8_SA(0, 1), a2 + hstep, voffA);
            PG8_WAIT_V(8); PG8_WAIT_L(0); PG8_BAR; PG8_MMA(0, 0, At, B0); PG8_MMA(0, 1, At, B1); PG8_BAR; PG8_SCHED;
            PG8_LDA(At, 1, 1); PG8_STAGE(PG8_SB(1, 0), b3, voffB); PG8_STAGE(PG8_SB(1, 1), b3 + hstep, voffB); PG8_STAGE(PG8_SA(1, 0), a3, voffA);
            PG8_WAIT_V(8); PG8_WAIT_L(0); PG8_BAR; PG8_MMA(1, 0, At, B0); PG8_MMA(1, 1, At, B1); PG8_BAR; PG8_SCHED;
            } else {
            PG8_LDB(B0, 0, 0); PG8_SCHED; PG8_LDA(At, 0, 0); PG8_STAGE(PG8_SA(1, 1), a1 + hstep, voffA);
            PG8_WAIT_L(8); PG8_BAR; PG8_WAIT_L(0); PG8_MMA(0, 0, At, B0); PG8_BAR; PG8_SCHED;
            PG8_LDB(B1, 0, 1); PG8_STAGE(PG8_SB(0, 0), b2, voffB);
            PG8_BAR; PG8_WAIT_L(0); PG8_MMA(0, 1, At, B1); PG8_BAR;
            PG8_LDA(At, 0, 1); PG8_STAGE(PG8_SA(0, 0), a2, voffA);
            PG8_BAR; PG8_WAIT_L(0); PG8_MMA(1, 0, At, B0); PG8_BAR; PG8_SCHED;
            PG8_STAGE(PG8_SB(0, 1), b2 + hstep, voffB);
            PG8_WAIT_V(6); PG8_BAR; PG8_MMA(1, 1, At, B1); PG8_BAR;
            PG8_LDB(B0, 1, 0); PG8_SCHED; PG8_LDA(At, 1, 0); PG8_STAGE(PG8_SA(0, 1), a2 + hstep, voffA);
            PG8_WAIT_L(8); PG8_BAR; PG8_WAIT_L(0); PG8_MMA(0, 0, At, B0); PG8_BAR; PG8_SCHED;
            PG8_LDB(B1, 1, 1); PG8_STAGE(PG8_SB(1, 0), b3, voffB);
            PG8_BAR; PG8_WAIT_L(0); PG8_MMA(0, 1, At, B1); PG8_BAR;
            PG8_LDA(At, 1, 1); PG8_STAGE(PG8_SA(1, 0), a3, voffA);
            PG8_BAR; PG8_WAIT_L(0); PG8_MMA(1, 0, At, B0); PG8_BAR; PG8_SCHED;
            PG8_STAGE(PG8_SB(1, 1), b3 + hstep, voffB);
            PG8_WAIT_V(6); PG8_BAR; PG8_MMA(1, 1, At, B1); PG8_BAR;
            }
        }
        if constexpr (ALIGN_EPI) { if (wr == 0) PG8_BAR; }
        if constexpr (!Epi::AFTER_DRAIN) { if (!Sched::TWICE || (ui & 1)) { E(acc, cur, wr, wc, fr, fq); S.done(cur); } }
        if (!has_next) break;
#pragma unroll
        for (int a = 0; a < 2; ++a)
#pragma unroll
            for (int b = 0; b < 2; ++b)
#pragma unroll
                for (int m = 0; m < 4; ++m)
#pragma unroll
                    for (int n = 0; n < 2; ++n) acc[a][b][m][n] = (f32x4){0.f, 0.f, 0.f, 0.f};
        cur = nxt; cA = nA; cB = nB; ++ui;
        if constexpr (ALIGN_EPI) { if (wr == 1) PG8_BAR; }
    }
    PG8_WAIT_V(0);
    if constexpr (!ALIGN_EPI) { if (wr == 0) PG8_BAR; }
    PG8_BAR;
    if constexpr (Epi::AFTER_DRAIN) { E.fused(acc, cur, wr, wc, fr, fq, lds, wid, lane); S.done(cur); }
#undef PG8_SA
#undef PG8_SB
#undef PG8_STAGE
#undef PG8_LDA
#undef PG8_LDB
#undef PG8_MMA
#undef PG8_WAIT_V
#undef PG8_WAIT_L
#undef PG8_BAR
#undef PG8_SCHED
}
}

constexpr int NWAVES = 8, NTHREADS = NWAVES * 64;
constexpr int BATCH = 8, SEQ = 4096, D = 1024, M = BATCH * SEQ, FF = 2816, DEPTH = 4;
constexpr int EVEN_IN = 3584, GLA_IN = 3088, GLA_INP = 3328;
static_assert(M == pg8::MROWS, "row count");
constexpr int E_RQ = 0, E_RK = 512, E_RV = 1024, E_RG = 1536, E_DQ = 2048, E_DK = 2560, E_DV = 3072;
constexpr int G_Q = 0, G_K = 512, G_V = 1024, G_R = 2048, G_A = 3072;
constexpr float EPS = 1e-6f;

constexpr size_t MiB = 1u << 20;
constexpr size_t WS_CTL = 0, CTL_ZERO_BYTES = 1 * MiB;
constexpr size_t WS_SSP = 1 * MiB;
constexpr size_t WS_TAB = 3 * MiB;
constexpr size_t TAB_RC = WS_TAB, TAB_RS = WS_TAB + 1 * MiB, TAB_DC = WS_TAB + 2 * MiB, TAB_DS = WS_TAB + 2 * MiB + 128 * 1024;
constexpr size_t WS_W = 8 * MiB;
constexpr size_t W_GU0 = WS_W, W_D0 = W_GU0 + (size_t)2 * FF * D * 2, W_GU1 = W_D0 + (size_t)D * FF * 2, W_D1 = W_GU1 + (size_t)2 * FF * D * 2,
                 W_IN = W_D1 + (size_t)D * FF * 2, W_OUT = W_IN + (size_t)EVEN_IN * D * 2, W_END = W_OUT + (size_t)D * D * 2;
constexpr size_t WS_XB = 56 * MiB;
constexpr size_t WS_ACT = 120 * MiB;
constexpr size_t WS_CAT = 344 * MiB;
constexpr size_t WS_END = 408 * MiB;
static_assert(W_END <= WS_XB && WS_XB + (size_t)M * D * 2 <= WS_ACT && WS_ACT + (size_t)M * EVEN_IN * 2 <= WS_CAT && WS_CAT + (size_t)M * D * 2 <= WS_END, "d_ws map");
constexpr int CW_BAR = 4096;

constexpr int RING_OFF = 0, RING_BYTES = 131072;
constexpr int LDSCTL_OFF = 161792, MISC_OFF = LDSCTL_OFF + 320, PTR_OFF = LDSCTL_OFF + 1024;
constexpr int LDS_BYTES = 163840;
static_assert(PTR_OFF + 19 * 8 <= LDS_BYTES && RING_BYTES <= LDSCTL_OFF, "LDS map");

#define GAS __attribute__((address_space(1)))
#define LAS __attribute__((address_space(3)))
typedef unsigned short bf16;
typedef unsigned v4u __attribute__((ext_vector_type(4)));
typedef float f32x4 __attribute__((ext_vector_type(4)));
typedef short bf16x8 __attribute__((ext_vector_type(8)));
typedef GAS unsigned gu32;
typedef GAS unsigned long long gu64;
#define RLX_AGENT __ATOMIC_RELAXED, __HIP_MEMORY_SCOPE_AGENT
#define LDS_WAIT() asm volatile("s_waitcnt lgkmcnt(0)" ::: "memory")
#define VM_WAIT() asm volatile("s_waitcnt vmcnt(0)" ::: "memory")
__device__ __forceinline__ unsigned long long rt() { return __builtin_amdgcn_s_memrealtime(); }
__device__ __forceinline__ unsigned f2bf(float f) { unsigned u = __builtin_bit_cast(unsigned, f); return (u + 0x7fffu + ((u >> 16) & 1u)) >> 16; }
__device__ __forceinline__ unsigned pk2(float lo, float hi) { return f2bf(lo) | (f2bf(hi) << 16); }

#define XB_TMO      128
#define XB_XCNT(j)  (256  + 64 * (j))
#define XB_XSUB(j)  (1280 + 64 * (j))
#define XB_XGEN(j)  (2304 + 64 * (j))
#define XB_TOP      3328
#define XB_TOPGEN   3392
#define XCD_BAR_WORDS 3456
#define XB_SPIN_CAP (1u << 18)

__device__ __forceinline__ unsigned xb_ld(unsigned* p)              { return __hip_atomic_load(p, __ATOMIC_RELAXED, __HIP_MEMORY_SCOPE_AGENT); }
__device__ __forceinline__ unsigned xb_add(unsigned* p, unsigned v) { return __hip_atomic_fetch_add(p, v, __ATOMIC_RELAXED, __HIP_MEMORY_SCOPE_AGENT); }
__device__ __forceinline__ unsigned xb_xcc_id() { return (unsigned)__builtin_amdgcn_s_getreg((3 << 11) | 20) & 0xFu; }
#define XB_SPIN(cond, bar) do { unsigned _sp = 0; while (cond) { __builtin_amdgcn_s_sleep(1); \
    if ((++_sp & 255u) == 0u) { if (xb_ld(&(bar)[XB_TMO])) break; if (_sp > XB_SPIN_CAP) { atomicAdd(&(bar)[XB_TMO], 1u); break; } } } } while (0)

struct XcdBarrier {
    unsigned* bar; unsigned x;
    volatile LAS unsigned* st;
};

__device__ __forceinline__ XcdBarrier xcd_barrier_post(unsigned* bar, volatile LAS unsigned* st, int tid) {
    XcdBarrier b; b.bar = bar; b.x = xb_xcc_id(); b.st = st;
    if (tid == 0) (void)xb_add(&bar[XB_XCNT(b.x)], 1u);
    return b;
}
__device__ __forceinline__ void xcd_barrier_complete(unsigned* bar, unsigned x, unsigned& nloc, unsigned& nx) {
    const unsigned G = gridDim.x * gridDim.y * gridDim.z;
    unsigned sum, cnt, mine, sp = 0u;
    for (;;) {
        sum = 0u; cnt = 0u; mine = 0u;
#pragma unroll
        for (unsigned j = 0; j < 16; ++j) { const unsigned c = xb_ld(&bar[XB_XCNT(j)]); sum += c; cnt += (c > 0u) ? 1u : 0u; mine = (j == x) ? c : mine; }
        if (sum == G) break;
        __builtin_amdgcn_s_sleep(1);
        if ((++sp & 255u) == 0u) { if (xb_ld(&bar[XB_TMO])) break; if (sp > XB_SPIN_CAP) { atomicAdd(&bar[XB_TMO], 1u); break; } }
    }
    nloc = mine > 0u ? mine : 1u; nx = cnt > 0u ? cnt : 1u;
}

__device__ __forceinline__ void xcd_barrier(const XcdBarrier& b, int tid) {
    asm volatile("s_waitcnt vmcnt(0)" ::: "memory");
    __syncthreads();
    if (tid == 0) {
        unsigned* bar = b.bar;
        __builtin_amdgcn_s_waitcnt(0);
        unsigned nloc = b.st[0], nx = b.st[1];
        if (nloc == 0u) { xcd_barrier_complete(bar, b.x, nloc, nx); b.st[0] = nloc; b.st[1] = nx; }
        const unsigned old = xb_add(&bar[XB_XSUB(b.x)], 1u);
        const unsigned gen = old / nloc;
        if (old + 1u == (gen + 1u) * nloc) {
            __builtin_amdgcn_fence(__ATOMIC_RELEASE, "agent");
            asm volatile("s_waitcnt vmcnt(0)" ::: "memory");
            const unsigned og = xb_add(&bar[XB_TOP], 1u);
            const unsigned tg = og / nx;
            if (og + 1u == (tg + 1u) * nx) xb_add(&bar[XB_TOPGEN], 1u);
            else XB_SPIN(xb_ld(&bar[XB_TOPGEN]) == tg, bar);
            __builtin_amdgcn_fence(__ATOMIC_ACQUIRE, "agent");
            xb_add(&bar[XB_XGEN(b.x)], 1u);
            asm volatile("s_waitcnt vmcnt(0)" ::: "memory");
        } else {
            XB_SPIN(xb_ld(&bar[XB_XGEN(b.x)]) == gen, bar);
            __builtin_amdgcn_fence(__ATOMIC_ACQUIRE, "agent");
            asm volatile("s_waitcnt vmcnt(0)" ::: "memory");
        }
    }
    __syncthreads();
}

__constant__ float RET_FREQ[64] = {1.000000000e+00f, 8.639884591e-01f, 7.464760542e-01f, 6.449466944e-01f, 5.572264791e-01f, 4.814372361e-01f, 4.159561992e-01f, 3.593813777e-01f, 3.105013371e-01f, 2.682695687e-01f, 2.317818105e-01f, 2.002568096e-01f, 1.730195731e-01f, 1.494869143e-01f, 1.291549653e-01f, 1.115883961e-01f, 9.641107172e-02f, 8.329805732e-02f, 7.196855545e-02f, 6.218000501e-02f, 5.372280627e-02f, 4.641588405e-02f, 4.010278732e-02f, 3.464834765e-02f, 2.993577160e-02f, 2.586415969e-02f, 2.234633639e-02f, 1.930697635e-02f, 1.668100432e-02f, 1.441219542e-02f, 1.245197095e-02f, 1.075835899e-02f, 9.295095690e-03f, 8.030855097e-03f, 6.938565988e-03f, 5.994840991e-03f, 5.179473665e-03f, 4.475005437e-03f, 3.866352839e-03f, 3.340484342e-03f, 2.886139788e-03f, 2.493591513e-03f, 2.154434333e-03f, 1.861406374e-03f, 1.608233666e-03f, 1.389495330e-03f, 1.200507861e-03f, 1.037224894e-03f, 8.961503627e-04f, 7.742635789e-04f, 6.689548027e-04f, 5.779692437e-04f, 4.993587499e-04f, 4.314401885e-04f, 3.727593285e-04f, 3.220597573e-04f, 2.782559313e-04f, 2.404099068e-04f, 2.077113895e-04f, 1.794602431e-04f, 1.550515735e-04f, 1.339627634e-04f, 1.157422885e-04f, 9.999999747e-05f};
__constant__ float ROPE_FREQ[8] = {1.000000000e+00f, 1.939227432e-01f, 3.760603070e-02f, 7.292664610e-03f, 1.414213562e-03f, 2.742481884e-04f, 5.318295734e-05f, 1.031338525e-05f};
struct Args { const float* in[17]; float* out; unsigned char* ws; };
enum { I_X = 0, I_PRE_NORM = 1, I_PRE_WG = 2, I_PRE_WU = 3, I_PRE_WD = 4, I_MIX_NORM = 5, I_AB_IN = 6, I_AB_OUT = 7, I_GLA_IN = 8, I_GLA_A2 = 9, I_GLA_BA = 10, I_GLA_OUT = 11,
       I_POST_NORM = 12, I_POST_WG = 13, I_POST_WU = 14, I_POST_WD = 15, I_FINAL = 16, I_OUT = 17, I_WS = 18, N_PTRS = 19 };
struct Frame {
    LAS unsigned char* lds;
    int tid, lane, wave, G, bid;
};
__device__ __forceinline__ unsigned char* tabp(const Frame& F, int idx) {
    int off_ = PTR_OFF + 8 * idx; asm volatile("" : "+s"(off_));
    const volatile LAS unsigned* T = (const volatile LAS unsigned*)(F.lds + off_);
    const unsigned lo = __builtin_amdgcn_readfirstlane(T[0]), hi = __builtin_amdgcn_readfirstlane(T[1]);
    GAS unsigned char* gp_ = (GAS unsigned char*)(((unsigned long long)hi << 32) | (unsigned long long)lo);
    return (unsigned char*)gp_;
}
#define AP(idx) ((const float*)tabp(F, idx))
#define WSP() tabp(F, I_WS)
#define OUTP() ((float*)tabp(F, I_OUT))
__device__ __forceinline__ int lnd(int v) { asm volatile("" : "+s"(v)); return v; }
__device__ __forceinline__ int hw_lane() { return (int)__builtin_amdgcn_mbcnt_hi(~0u, __builtin_amdgcn_mbcnt_lo(~0u, 0u)); }
__device__ __forceinline__ Frame relaunder(const Frame& F0) { Frame F = F0; int t_ = threadIdx.x; asm volatile("" : "+v"(t_)); asm volatile("" : "+s"(F.bid)); F.tid = t_; F.lane = F.tid & 63; F.wave = __builtin_amdgcn_readfirstlane(F.tid >> 6);
    unsigned lb_ = 0u; asm volatile("" : "+s"(lb_)); F.lds = F0.lds + lb_; return F; }
__device__ __forceinline__ float wave_sum(float v) {
    v += xsw<1>(v); v += xsw<2>(v); v += xsw<4>(v); v += xsw<8>(v); v += xsw<16>(v);
    return sum32(v);
}
__device__ __forceinline__ float bf2f(bf16 h) { return __builtin_bit_cast(float, (unsigned)h << 16); }
__device__ __forceinline__ float bflo(unsigned w) { return __builtin_bit_cast(float, w << 16); }
__device__ __forceinline__ float bfhi(unsigned w) { return __builtin_bit_cast(float, w & 0xffff0000u); }
__device__ __forceinline__ bf16 f2bf_rne(float f) { return (bf16)f2bf(f); }

__device__ __forceinline__ void tr_item(const float* W, int K, int N, int Npad, const float* gain, bf16* WT, int gu, LAS float* scr, int item, int lane) {
    const int nblk = Npad / 32, kb = item / nblk, nb = item % nblk, k0 = 64 * kb, n0 = 32 * nb;
    {
        const int c4 = lane & 7; const bool ok = n0 + 4 * c4 < N;
        const GAS float* src = (const GAS float*)W + (size_t)(k0 + (lane >> 3)) * N + n0 + 4 * c4;
        f32x4 v[8];
#pragma unroll
        for (int i = 0; i < 8; ++i) v[i] = ok ? *(const GAS f32x4*)(src + (size_t)(8 * i) * N) : (f32x4){0.f, 0.f, 0.f, 0.f};
#pragma unroll
        for (int i = 0; i < 8; ++i) { const int kk = 8 * i + (lane >> 3); const float gn = gain ? ((const GAS float*)gain)[k0 + kk] : 1.0f; LAS float* s = scr + kk * 33 + 4 * c4;
            s[0] = v[i][0] * gn; s[1] = v[i][1] * gn; s[2] = v[i][2] * gn; s[3] = v[i][3] * gn; }
    }
    LDS_WAIT(); asm volatile("" ::: "memory");
    const int c = lane & 7;
#pragma unroll
    for (int j = 0; j < 4; ++j) { const int n = (lane >> 3) + 8 * j; const LAS float* s = scr + (8 * c) * 33 + n;
        v4u o; o.x = pk2(s[0 * 33], s[1 * 33]); o.y = pk2(s[2 * 33], s[3 * 33]); o.z = pk2(s[4 * 33], s[5 * 33]); o.w = pk2(s[6 * 33], s[7 * 33]);
        int drow = n0 + n; if (gu) drow = (drow >> 7) * 256 + (drow & 127) + (gu == 2 ? 128 : 0);
        *(GAS v4u*)(WT + (size_t)drow * K + k0 + 8 * c) = o; }
    LDS_WAIT(); asm volatile("" ::: "memory");
}
__device__ __forceinline__ void convert_weights(const Frame& F0, int l) {
    const Frame F = relaunder(F0);
    LAS float* scr = (LAS float*)(F.lds + RING_OFF + F.wave * 16384);
    const int gw = F.bid * NWAVES + F.wave, NGW = F.G * NWAVES;
    unsigned char* ws = WSP();
    constexpr int I_G = (D / 64) * (FF / 32), I_DN = (FF / 64) * (D / 32), I_O = (D / 64) * (D / 32);
    const bool odd = (l & 1) != 0; const int li = l >> 1;
    const int nin = odd ? GLA_IN : EVEN_IN, ninp = odd ? GLA_INP : EVEN_IN; const int I_IN = (D / 64) * (ninp / 32);
    const float* win = odd ? AP(I_GLA_IN) + (size_t)li * D * GLA_IN : AP(I_AB_IN) + (size_t)li * D * EVEN_IN;
    const float* wout = odd ? AP(I_GLA_OUT) + (size_t)li * D * D : AP(I_AB_OUT) + (size_t)li * D * D;
    const size_t fo = (size_t)l * D * FF;
    const int NITEMS = 6 * I_G + I_IN + I_O;
    static_assert(I_G == I_DN, "item counts");
    for (int it = gw; it < NITEMS; it += NGW) {
        int r = it;
        if (r < I_G) { tr_item(AP(I_PRE_WG) + fo, D, FF, FF, AP(I_PRE_NORM) + l * D, (bf16*)(ws + W_GU0), 1, scr, r, F.lane); continue; } r -= I_G;
        if (r < I_G) { tr_item(AP(I_PRE_WU) + fo, D, FF, FF, AP(I_PRE_NORM) + l * D, (bf16*)(ws + W_GU0), 2, scr, r, F.lane); continue; } r -= I_G;
        if (r < I_G) { tr_item(AP(I_PRE_WD) + fo, FF, D, D, nullptr, (bf16*)(ws + W_D0), 0, scr, r, F.lane); continue; } r -= I_G;
        if (r < I_G) { tr_item(AP(I_POST_WG) + fo, D, FF, FF, AP(I_POST_NORM) + l * D, (bf16*)(ws + W_GU1), 1, scr, r, F.lane); continue; } r -= I_G;
        if (r < I_G) { tr_item(AP(I_POST_WU) + fo, D, FF, FF, AP(I_POST_NORM) + l * D, (bf16*)(ws + W_GU1), 2, scr, r, F.lane); continue; } r -= I_G;
        if (r < I_G) { tr_item(AP(I_POST_WD) + fo, FF, D, D, nullptr, (bf16*)(ws + W_D1), 0, scr, r, F.lane); continue; } r -= I_G;
        if (r < I_IN) { tr_item(win, D, nin, ninp, AP(I_MIX_NORM) + l * D, (bf16*)(ws + W_IN), 0, scr, r, F.lane); continue; } r -= I_IN;
        tr_item(wout, D, D, D, nullptr, (bf16*)(ws + W_OUT), 0, scr, r, F.lane);
    }
}
__device__ __forceinline__ void prologue_rows(const Frame& F0) {
    const Frame F = relaunder(F0);
    unsigned char* ws = WSP();
    const int gw = F.bid * NWAVES + F.wave, NGW = F.G * NWAVES;
    bf16* XB = (bf16*)(ws + WS_XB); float* ssp = (float*)(ws + WS_SSP);
    for (int m = gw; m < M; m += NGW) {
        const GAS f32x4* xr = (const GAS f32x4*)(AP(I_X) + (size_t)m * D) + F.lane;
        GAS unsigned long long* o8 = (GAS unsigned long long*)(XB + (size_t)m * D) + F.lane;
        float s = 0.f;
#pragma unroll
        for (int j = 0; j < 4; ++j) { const f32x4 v = xr[64 * j]; s += (v.x * v.x + v.y * v.y) + (v.z * v.z + v.w * v.w);
            o8[64 * j] = (unsigned long long)pk2(v.x, v.y) | ((unsigned long long)pk2(v.z, v.w) << 32); }
        s = wave_sum(s);
        if (F.lane < 16) ssp[(size_t)m * 16 + F.lane] = (F.lane == 0) ? s : 0.f;
    }
    const int gt = F.bid * NTHREADS + F.tid, NGT = F.G * NTHREADS;
    float* rc = (float*)(ws + TAB_RC); float* rsn = (float*)(ws + TAB_RS); float* dc = (float*)(ws + TAB_DC); float* ds = (float*)(ws + TAB_DS);
    for (int e = gt; e < SEQ * 64; e += NGT) { const int t = e >> 6, i = e & 63; const float ang = (float)t * RET_FREQ[i];
        double rev = (double)ang * 0.15915494309189535; rev -= __builtin_rint(rev); const float r = (float)rev;
        rc[e] = __builtin_amdgcn_cosf(r); rsn[e] = __builtin_amdgcn_sinf(r); }
    for (int e = gt; e < SEQ * 8; e += NGT) { const int t = e >> 3, i = e & 7; const float ang = (float)t * ROPE_FREQ[i];
        double rev = (double)ang * 0.15915494309189535; rev -= __builtin_rint(rev); const float r = (float)rev;
        dc[e] = __builtin_amdgcn_cosf(r); ds[e] = __builtin_amdgcn_sinf(r); }
}

__device__ __forceinline__ void even_prep(const Frame& F0) {
    const Frame F = relaunder(F0);
    unsigned char* ws = WSP();
    const int gw = F.bid * NWAVES + F.wave, NGW = F.G * NWAVES;
    bf16* P = (bf16*)(ws + WS_ACT);
    const float* rc = (const float*)(ws + TAB_RC); const float* rsn = (const float*)(ws + TAB_RS); const float* dc = (const float*)(ws + TAB_DC); const float* ds = (const float*)(ws + TAB_DS);
    for (int m = gw; m < M; m += NGW) {
        const int pos = m & (SEQ - 1); bf16* row = P + (size_t)m * EVEN_IN;
        const float c = rc[pos * 64 + F.lane], s = rsn[pos * 64 + F.lane];
#pragma unroll
        for (int h = 0; h < 4; ++h) {
            { bf16* p1 = row + E_RQ + h * 128 + F.lane; bf16* p2 = p1 + 64; const float x1 = bf2f(*p1), x2 = bf2f(*p2); *p1 = f2bf_rne(x1 * c - x2 * s); *p2 = f2bf_rne(x2 * c + x1 * s); }
            { bf16* p1 = row + E_RK + h * 128 + F.lane; bf16* p2 = p1 + 64; const float x1 = bf2f(*p1), x2 = bf2f(*p2);
              *p1 = f2bf_rne((x1 * c - x2 * s) * 0.08838834764831845f); *p2 = f2bf_rne((x2 * c + x1 * s) * 0.08838834764831845f); }
        }
        { const int h = F.lane >> 3, i = F.lane & 7; const float c2 = dc[pos * 8 + i], s2 = ds[pos * 8 + i];
          { bf16* p1 = row + E_DQ + h * 64 + i; bf16* p2 = p1 + 8; const float x1 = bf2f(*p1), x2 = bf2f(*p2); *p1 = f2bf_rne(x1 * c2 - x2 * s2); *p2 = f2bf_rne(x2 * c2 + x1 * s2); }
          { bf16* p1 = row + E_DK + h * 64 + i; bf16* p2 = p1 + 8; const float x1 = bf2f(*p1), x2 = bf2f(*p2); *p1 = f2bf_rne(x1 * c2 - x2 * s2); *p2 = f2bf_rne(x2 * c2 + x1 * s2); } }
    }
}
__device__ __forceinline__ void even_core(const Frame& F0) {
    const Frame F = relaunder(F0);
    unsigned char* ws = WSP();
    const bf16* P = (const bf16*)(ws + WS_ACT);
    if (F.bid < 128) {
        const int b = F.bid >> 4, h = (F.bid >> 2) & 3, eg = F.bid & 3, e = eg * 32 + (F.tid >> 4), dq = F.tid & 15;
        const float g = 1.0f - exp2f(-5.0f - (float)h);
        float* oraw = (float*)(ws + WS_XB);
        const bf16* base = P + (size_t)b * SEQ * EVEN_IN;
        float S[8];
#pragma unroll
        for (int i = 0; i < 8; ++i) S[i] = 0.f;
        v4u qn = *(const GAS v4u*)(base + E_RQ + h * 128 + dq * 8), kn = *(const GAS v4u*)(base + E_RK + h * 128 + dq * 8); bf16 vn = base[E_RV + h * 128 + e];
        for (int t = 0; t < SEQ; ++t) {
            const v4u q = qn, k = kn; const float v = bf2f(vn);
            if (t + 1 < SEQ) { const bf16* nb = base + (size_t)(t + 1) * EVEN_IN; qn = *(const GAS v4u*)(nb + E_RQ + h * 128 + dq * 8); kn = *(const GAS v4u*)(nb + E_RK + h * 128 + dq * 8); vn = nb[E_RV + h * 128 + e]; }
            float o = 0.f;
#pragma unroll
            for (int i = 0; i < 4; ++i) { const unsigned qw = q[i], kw = k[i];
                S[2 * i] = g * S[2 * i] + bflo(kw) * v; S[2 * i + 1] = g * S[2 * i + 1] + bfhi(kw) * v;
                o += bflo(qw) * S[2 * i]; o += bfhi(qw) * S[2 * i + 1]; }
            o += xsw<1>(o); o += xsw<2>(o); o += xsw<4>(o); o += xsw<8>(o);
            if (dq == 0) oraw[((size_t)b * SEQ + t) * 512 + h * 128 + e] = o;
        }
    } else {
        bf16* CAT = (bf16*)(ws + WS_CAT);
        for (int it = F.bid - 128; it < BATCH * (SEQ / 64); it += F.G - 128) {
            const int b = it >> 6, t = (it & 63) * 64 + F.lane, h = F.wave;
            const bf16* base = P + (size_t)b * SEQ * EVEN_IN;
            float q[64];
            { const GAS v4u* qp = (const GAS v4u*)(base + (size_t)t * EVEN_IN + E_DQ + h * 64);
#pragma unroll
              for (int j = 0; j < 8; ++j) { const v4u w = qp[j];
#pragma unroll
                  for (int i = 0; i < 4; ++i) { q[8 * j + 2 * i] = bflo(w[i]) * (0.125f * 1.4426950408889634f); q[8 * j + 2 * i + 1] = bfhi(w[i]) * (0.125f * 1.4426950408889634f); } } }
            float o[64];
#pragma unroll
            for (int i = 0; i < 64; ++i) o[i] = 0.f;
            float mx = -INFINITY, l = 0.f;
            for (int p = 0; p < 3; ++p) {
                const int dil = (p == 0) ? 1 : (p == 1) ? 4 : 16;
                for (int j = 0; j <= 128; ++j) {
                    const int tk = t - j * dil;
                    if (tk >= 0) {
                        const GAS v4u* kp = (const GAS v4u*)(base + (size_t)tk * EVEN_IN + E_DK + h * 64);
                        const GAS v4u* vp = (const GAS v4u*)(base + (size_t)tk * EVEN_IN + E_DV + h * 64);
                        float s = 0.f;
#pragma unroll
                        for (int jj = 0; jj < 8; ++jj) { const v4u w = kp[jj];
#pragma unroll
                            for (int i = 0; i < 4; ++i) { s += q[8 * jj + 2 * i] * bflo(w[i]); s += q[8 * jj + 2 * i + 1] * bfhi(w[i]); } }
                        const float mn = fmaxf(mx, s), corr = __builtin_amdgcn_exp2f(mx - mn), pe = __builtin_amdgcn_exp2f(s - mn);
                        l = l * corr + pe; mx = mn;
#pragma unroll
                        for (int jj = 0; jj < 8; ++jj) { const v4u w = vp[jj];
#pragma unroll
                            for (int i = 0; i < 4; ++i) { o[8 * jj + 2 * i] = o[8 * jj + 2 * i] * corr + pe * bflo(w[i]); o[8 * jj + 2 * i + 1] = o[8 * jj + 2 * i + 1] * corr + pe * bfhi(w[i]); } }
                    }
                }
            }
            const float rl = 1.0f / l;
            GAS v4u* op = (GAS v4u*)(CAT + ((size_t)b * SEQ + t) * D + 512 + h * 64);
#pragma unroll
            for (int j = 0; j < 8; ++j) { v4u w; w.x = pk2(o[8 * j] * rl, o[8 * j + 1] * rl); w.y = pk2(o[8 * j + 2] * rl, o[8 * j + 3] * rl); w.z = pk2(o[8 * j + 4] * rl, o[8 * j + 5] * rl); w.w = pk2(o[8 * j + 6] * rl, o[8 * j + 7] * rl); op[j] = w; }
        }
    }
}
__device__ __forceinline__ void even_post(const Frame& F0) {
    const Frame F = relaunder(F0);
    unsigned char* ws = WSP();
    const int gw = F.bid * NWAVES + F.wave, NGW = F.G * NWAVES;
    const bf16* P = (const bf16*)(ws + WS_ACT); const float* oraw = (const float*)(ws + WS_XB); bf16* CAT = (bf16*)(ws + WS_CAT);
    for (int it = gw; it < M * 4; it += NGW) {
        const int m = it >> 2, h = it & 3;
        const float* op = oraw + (size_t)m * 512 + h * 128 + 2 * F.lane; const float o0 = op[0], o1 = op[1];
        const float mu = wave_sum(o0 + o1) * (1.0f / 128.0f); const float d0 = o0 - mu, d1 = o1 - mu;
        const float var = wave_sum(d0 * d0 + d1 * d1) * (1.0f / 128.0f); const float rstd = 1.0f / sqrtf(var + EPS);
        const unsigned gw2 = *(const unsigned*)(P + (size_t)m * EVEN_IN + E_RG + h * 128 + 2 * F.lane); const float g0 = bflo(gw2), g1 = bfhi(gw2);
        const float y0 = d0 * rstd * (g0 / (1.0f + expf(-g0))), y1 = d1 * rstd * (g1 / (1.0f + expf(-g1)));
        *(unsigned*)(CAT + (size_t)m * D + h * 128 + 2 * F.lane) = pk2(y0, y1);
    }
}
__device__ __forceinline__ void gla_prep(const Frame& F0, int li) {
    const Frame F = relaunder(F0);
    unsigned char* ws = WSP();
    const int gt = F.bid * NTHREADS + F.tid, NGT = F.G * NTHREADS;
    const bf16* P = (const bf16*)(ws + WS_ACT); float* A = (float*)(ws + WS_CAT);
    const float* w2 = AP(I_GLA_A2) + (size_t)li * 16 * 512; const float* ba = AP(I_GLA_BA) + (size_t)li * 512;
    for (int e = gt; e < M * 512; e += NGT) {
        const int m = e >> 9, c = e & 511; const bf16* al = P + (size_t)m * GLA_INP + G_A;
        float z = ba[c];
#pragma unroll
        for (int j = 0; j < 16; ++j) z += bf2f(al[j]) * w2[j * 512 + c];
        const float ls = fminf(z, 0.f) - log1pf(expf(-fabsf(z)));
        A[e] = expf(ls * (1.0f / 16.0f));
    }
}
__device__ __forceinline__ void gla_core(const Frame& F0) {
    const Frame F = relaunder(F0);
    unsigned char* ws = WSP();
    const bf16* P = (const bf16*)(ws + WS_ACT); const float* A = (const float*)(ws + WS_CAT); bf16* oraw = (bf16*)(ws + WS_XB);
    const int b = F.bid >> 5, h = (F.bid >> 3) & 3, eg = F.bid & 7, e = eg * 32 + (F.tid >> 4), dq = F.tid & 15;
    const bf16* base = P + (size_t)b * SEQ * GLA_INP; const float* abase = A + (size_t)b * SEQ * 512 + h * 128 + dq * 8;
    float S[8];
#pragma unroll
    for (int i = 0; i < 8; ++i) S[i] = 0.f;
    v4u qn = *(const GAS v4u*)(base + G_Q + h * 128 + dq * 8), kn = *(const GAS v4u*)(base + G_K + h * 128 + dq * 8); bf16 vn = base[G_V + h * 256 + e];
    f32x4 a0n = *(const GAS f32x4*)(abase), a1n = *(const GAS f32x4*)(abase + 4);
    for (int t = 0; t < SEQ; ++t) {
        const v4u q = qn, k = kn; const float v = bf2f(vn); const f32x4 a0 = a0n, a1 = a1n;
        if (t + 1 < SEQ) { const bf16* nb = base + (size_t)(t + 1) * GLA_INP; qn = *(const GAS v4u*)(nb + G_Q + h * 128 + dq * 8); kn = *(const GAS v4u*)(nb + G_K + h * 128 + dq * 8); vn = nb[G_V + h * 256 + e];
            a0n = *(const GAS f32x4*)(abase + (size_t)(t + 1) * 512); a1n = *(const GAS f32x4*)(abase + (size_t)(t + 1) * 512 + 4); }
        float o = 0.f;
#pragma unroll
        for (int i = 0; i < 4; ++i) { const unsigned qw = q[i], kw = k[i]; const float al = (i < 2) ? a0[2 * i] : a1[2 * i - 4], ah = (i < 2) ? a0[2 * i + 1] : a1[2 * i - 3];
            S[2 * i] = al * S[2 * i] + bflo(kw) * v; S[2 * i + 1] = ah * S[2 * i + 1] + bfhi(kw) * v;
            o += bflo(qw) * S[2 * i]; o += bfhi(qw) * S[2 * i + 1]; }
        o += xsw<1>(o); o += xsw<2>(o); o += xsw<4>(o); o += xsw<8>(o);
        if (dq == 0) oraw[((size_t)b * SEQ + t) * 1024 + h * 256 + e] = f2bf_rne(o * 0.08838834764831845f);
    }
}
__device__ __forceinline__ void gla_post(const Frame& F0) {
    const Frame F = relaunder(F0);
    unsigned char* ws = WSP();
    const int gw = F.bid * NWAVES + F.wave, NGW = F.G * NWAVES;
    const bf16* P = (const bf16*)(ws + WS_ACT); const bf16* oraw = (const bf16*)(ws + WS_XB); bf16* CAT = (bf16*)(ws + WS_CAT);
    for (int it = gw; it < M * 4; it += NGW) {
        const int m = it >> 2, h = it & 3;
        const unsigned long long ow = *(const unsigned long long*)(oraw + (size_t)m * 1024 + h * 256 + 4 * F.lane);
        const float o0 = bflo((unsigned)ow), o1 = bfhi((unsigned)ow), o2 = bflo((unsigned)(ow >> 32)), o3 = bfhi((unsigned)(ow >> 32));
        const float mu = wave_sum((o0 + o1) + (o2 + o3)) * (1.0f / 256.0f); const float d0 = o0 - mu, d1 = o1 - mu, d2 = o2 - mu, d3 = o3 - mu;
        const float var = wave_sum((d0 * d0 + d1 * d1) + (d2 * d2 + d3 * d3)) * (1.0f / 256.0f); const float rstd = 1.0f / sqrtf(var + EPS);
        const unsigned long long gw2 = *(const unsigned long long*)(P + (size_t)m * GLA_INP + G_R + h * 256 + 4 * F.lane);
        const float g0 = bflo((unsigned)gw2), g1 = bfhi((unsigned)gw2), g2 = bflo((unsigned)(gw2 >> 32)), g3 = bfhi((unsigned)(gw2 >> 32));
        const float y0 = d0 * rstd * (g0 / (1.0f + expf(-g0))), y1 = d1 * rstd * (g1 / (1.0f + expf(-g1))), y2 = d2 * rstd * (g2 / (1.0f + expf(-g2))), y3 = d3 * rstd * (g3 / (1.0f + expf(-g3)));
        *(unsigned long long*)(CAT + (size_t)m * D + h * 256 + 4 * F.lane) = (unsigned long long)pk2(y0, y1) | ((unsigned long long)pk2(y2, y3) << 32);
    }
}
__device__ __forceinline__ void final_norm(const Frame& F0) {
    const Frame F = relaunder(F0);
    const int gw = F.bid * NWAVES + F.wave, NGW = F.G * NWAVES;
    for (int m = gw; m < M; m += NGW) {
        GAS f32x4* xr = (GAS f32x4*)(OUTP() + (size_t)m * D) + F.lane; const GAS f32x4* gr = (const GAS f32x4*)AP(I_FINAL) + F.lane;
        f32x4 v[4]; float s = 0.f;
#pragma unroll
        for (int j = 0; j < 4; ++j) { v[j] = xr[64 * j]; s += (v[j].x * v[j].x + v[j].y * v[j].y) + (v[j].z * v[j].z + v[j].w * v[j].w); }
        const float rstd = 1.0f / sqrtf(wave_sum(s) * (1.0f / D) + EPS);
#pragma unroll
        for (int j = 0; j < 4; ++j) xr[64 * j] = v[j] * rstd * gr[64 * j];
    }
}


__device__ __forceinline__ float silu_f(float g) { return g * __builtin_amdgcn_rcpf(1.0f + __builtin_amdgcn_exp2f(-1.4426950408889634f * g)); }
typedef float f32x16 __attribute__((ext_vector_type(16)));
typedef short s16x4 __attribute__((ext_vector_type(4)));
typedef float f32x2_t __attribute__((ext_vector_type(2)));
typedef __bf16 bf16x2_t __attribute__((ext_vector_type(2)));
#define MFMA32(a, b, c) __builtin_amdgcn_mfma_f32_32x32x16_bf16((a), (b), (c), 0, 0, 0)
__device__ __forceinline__ int crow(int reg, int h) { return (reg & 3) + 8 * (reg >> 2) + 4 * h; }
__device__ __forceinline__ unsigned cvtpk(float lo, float hi) { f32x2_t v = {lo, hi}; bf16x2_t b = __builtin_convertvector(v, bf16x2_t); return __builtin_bit_cast(unsigned, b); }
__device__ __forceinline__ bf16 cvt1(float v) { return (bf16)(cvtpk(v, 0.f) & 0xffffu); }
#define PACK_STEP(x, s) __builtin_bit_cast(bf16x8, (v4u){cvtpk((x)[8 * (s)], (x)[8 * (s) + 1]), cvtpk((x)[8 * (s) + 2], (x)[8 * (s) + 3]), cvtpk((x)[8 * (s) + 4], (x)[8 * (s) + 5]), cvtpk((x)[8 * (s) + 6], (x)[8 * (s) + 7])})
typedef const LAS unsigned char* lcp;
__device__ __forceinline__ bf16x8 ld_row(lcp img, int P, int row0, int k0, int r, int h) { return *(const LAS bf16x8*)(img + (row0 + r) * P + (k0 + 8 * h) * 2); }
__device__ __forceinline__ bf16x8 ld_row_perm(lcp img, int P, int row0, int k0, int r, int h) {
    const s16x4 lo = *(const LAS s16x4*)(img + (row0 + r) * P + (k0 + 4 * h) * 2), hi = *(const LAS s16x4*)(img + (row0 + r) * P + (k0 + 8 + 4 * h) * 2);
    return __builtin_shufflevector(lo, hi, 0, 1, 2, 3, 4, 5, 6, 7); }
__device__ __forceinline__ s16x4 trd(lcp p) { return __builtin_bit_cast(s16x4, __builtin_amdgcn_ds_read_tr16_b64_v4i16((LAS s16x4*)p)); }
__device__ __forceinline__ bf16x8 ld_tr(lcp img, int P, int k0, int c0, int lane) {
    const int i16 = lane & 15, q = i16 >> 2, p = i16 & 3, blk = (lane >> 4) & 1, h = lane >> 5;
    lcp a = img + (k0 + 8 * h + q) * P + (c0 + 16 * blk + 4 * p) * 2;
    const s16x4 lo = trd(a), hi = trd(a + 4 * P);
    return __builtin_shufflevector(lo, hi, 0, 1, 2, 3, 4, 5, 6, 7); }
__device__ __forceinline__ bf16x8 ld_tr_perm(lcp img, int P, int k0, int c0, int lane) {
    const int i16 = lane & 15, q = i16 >> 2, p = i16 & 3, blk = (lane >> 4) & 1, h = lane >> 5;
    lcp a = img + (k0 + 4 * h + q) * P + (c0 + 16 * blk + 4 * p) * 2;
    const s16x4 lo = trd(a), hi = trd(a + 8 * P);
    return __builtin_shufflevector(lo, hi, 0, 1, 2, 3, 4, 5, 6, 7); }
template <int R, int C> __device__ __forceinline__ void stage_tile(LAS unsigned char* img, int P, const bf16* g, size_t gp, int tid) {
    constexpr int CPR = C / 8, N = R * CPR;
#pragma unroll
    for (int i = 0; i < (N + NTHREADS - 1) / NTHREADS; ++i) { const int c = tid + i * NTHREADS;
        if (c < N) { const int row = c / CPR, cc = c % CPR; const v4u v = *(const GAS v4u*)(g + (size_t)row * gp + cc * 8); *(LAS v4u*)(img + row * P + cc * 16) = v; } }
}
#define WG_BAR() do { asm volatile("s_waitcnt vmcnt(0) lgkmcnt(0)" ::: "memory"); __builtin_amdgcn_s_barrier(); asm volatile("" ::: "memory"); } while (0)

constexpr int GP128 = 272, GP256 = 528;
constexpr size_t WS_DEC = 6 * MiB;
constexpr float LOG2E = 1.4426950408889634f, LN2 = 0.6931471805599453f;
__device__ __forceinline__ void gla_cumsum(float (&Bc)[2][16], float& Blast, lcp AL, lcp W2, const LAS float* BA, LAS float* EX, int wave, int lane) {
    const int r = lane & 31, h = lane >> 5, db = wave & 3, jh = wave >> 2;
    const bf16x8 wf = *(const LAS bf16x8*)(W2 + (db * 32 + r) * 32 + h * 16);
    const float bias = BA[db * 32 + r];
    float run = 0.f;
#pragma unroll
    for (int t = 0; t < 2; ++t) {
        const bf16x8 af = *(const LAS bf16x8*)(AL + ((jh * 2 + t) * 32 + r) * 32 + h * 16);
        f32x16 z = {0.f, 0.f, 0.f, 0.f, 0.f, 0.f, 0.f, 0.f, 0.f, 0.f, 0.f, 0.f, 0.f, 0.f, 0.f, 0.f};
        z = MFMA32(af, wf, z);
        float own[4], oth[4];
#pragma unroll
        for (int g = 0; g < 4; ++g) {
            float acc = 0.f;
#pragma unroll
            for (int i = 0; i < 4; ++i) { const float zz = z[4 * g + i] + bias;
                const float la = (fminf(zz, 0.f) - LN2 * __builtin_amdgcn_logf(1.0f + __builtin_amdgcn_exp2f(-fabsf(zz) * LOG2E))) * (1.0f / 16.0f);
                acc += la; Bc[t][4 * g + i] = acc; }
            own[g] = acc; oth[g] = oth32(acc, h);
        }
#pragma unroll
        for (int g = 0; g < 4; ++g) { const float off = run + (h ? oth[g] : 0.f);
#pragma unroll
            for (int i = 0; i < 4; ++i) Bc[t][4 * g + i] += off;
            run += own[g] + oth[g]; }
    }
    if (h == 0) EX[jh * 128 + db * 32 + r] = run;
    WG_BAR();
    const float t0 = EX[db * 32 + r], t1 = EX[128 + db * 32 + r];
    Blast = t0 + t1;
    if (jh == 1) {
#pragma unroll
        for (int t = 0; t < 2; ++t)
#pragma unroll
            for (int i = 0; i < 16; ++i) Bc[t][i] += t0; }
}
constexpr int GA_KI = 0, GA_VI = GA_KI + 128 * GP128, GA_KD = GA_VI + 128 * GP256, GA_AL = GA_KD + 128 * GP128, GA_W2 = GA_AL + 4096, GA_BA = GA_W2 + 4096, GA_EX = GA_BA + 512, GA_END = GA_EX + 1024;
constexpr int GC_QT = 0, GC_KT = GC_QT + 128 * GP128, GC_SI = GC_KT + 128 * GP128, GC_VI = GC_SI + 128 * GP128, GC_AL = GC_VI + 128 * GP128, GC_W2 = GC_AL + 4096, GC_BA = GC_W2 + 4096, GC_EX = GC_BA + 512, GC_END = GC_EX + 1024;
constexpr int GC_OI = 0;
static_assert(GA_END <= LDSCTL_OFF && GC_END <= LDSCTL_OFF && 128 * GP256 <= GC_SI, "GLA LDS maps");
__device__ __forceinline__ void gla_stage_small(const Frame& F, LAS unsigned char* AL, LAS unsigned char* W2, LAS float* BA, const bf16* Prow0, int li, int h) {
    if (F.tid < 256) { const int row = F.tid >> 1, cc = F.tid & 1; *(LAS v4u*)(AL + row * 32 + cc * 16) = *(const GAS v4u*)(Prow0 + (size_t)row * GLA_INP + G_A + cc * 8); }
    else if (F.tid < 384) { const int d = F.tid - 256; const float* w2 = AP(I_GLA_A2) + (size_t)li * 16 * 512 + h * 128 + d;
        v4u lo, hi; lo.x = cvtpk(w2[0], w2[512]); lo.y = cvtpk(w2[2 * 512], w2[3 * 512]); lo.z = cvtpk(w2[4 * 512], w2[5 * 512]); lo.w = cvtpk(w2[6 * 512], w2[7 * 512]);
        hi.x = cvtpk(w2[8 * 512], w2[9 * 512]); hi.y = cvtpk(w2[10 * 512], w2[11 * 512]); hi.z = cvtpk(w2[12 * 512], w2[13 * 512]); hi.w = cvtpk(w2[14 * 512], w2[15 * 512]);
        *(LAS v4u*)(W2 + d * 32) = lo; *(LAS v4u*)(W2 + d * 32 + 16) = hi; }
    else { const int d = F.tid - 384; BA[d] = AP(I_GLA_BA)[(size_t)li * 512 + h * 128 + d]; }
}
__device__ __forceinline__ void gla_phase_a(const Frame& F0, int li) {
    const Frame F = relaunder(F0);
    unsigned char* ws = WSP();
    const bf16* P = (const bf16*)(ws + WS_ACT); bf16* SKV = (bf16*)(ws + WS_XB); float* DEC = (float*)(ws + WS_DEC);
    LAS unsigned char* L = F.lds;
    const int lane = F.lane, r = lane & 31, h2 = lane >> 5, wave = F.wave, db = wave & 3, jh = wave >> 2;
    for (int it = F.bid; it < 1024; it += F.G) {
        const int bh = it >> 5, g = it & 31, b = bh >> 2, h = bh & 3;
        const bf16* Prow0 = P + ((size_t)b * SEQ + g * 128) * GLA_INP;
        stage_tile<128, 128>(L + GA_KI, GP128, Prow0 + G_K + h * 128, GLA_INP, F.tid);
        stage_tile<128, 256>(L + GA_VI, GP256, Prow0 + G_V + h * 256, GLA_INP, F.tid);
        gla_stage_small(F, L + GA_AL, L + GA_W2, (LAS float*)(L + GA_BA), Prow0, li, h);
        WG_BAR();
        float Bc[2][16], Blast;
        gla_cumsum(Bc, Blast, L + GA_AL, L + GA_W2, (const LAS float*)(L + GA_BA), (LAS float*)(L + GA_EX), wave, lane);
#pragma unroll
        for (int t = 0; t < 2; ++t)
#pragma unroll
            for (int i = 0; i < 16; ++i) { const int off = ((jh * 2 + t) * 32 + crow(i, h2)) * GP128 + (db * 32 + r) * 2;
                const float kv = bf2f(*(const LAS bf16*)(L + GA_KI + off)) * __builtin_amdgcn_exp2f((Blast - Bc[t][i]) * LOG2E);
                *(LAS bf16*)(L + GA_KD + off) = cvt1(kv); }
        if (jh == 0 && h2 == 0) DEC[(size_t)it * 128 + db * 32 + r] = __builtin_amdgcn_exp2f(Blast * LOG2E);
        WG_BAR();
        f32x16 acc[4];
#pragma unroll
        for (int t = 0; t < 4; ++t) acc[t] = (f32x16){0.f, 0.f, 0.f, 0.f, 0.f, 0.f, 0.f, 0.f, 0.f, 0.f, 0.f, 0.f, 0.f, 0.f, 0.f, 0.f};
#pragma unroll
        for (int ks = 0; ks < 8; ++ks) { const bf16x8 a = ld_tr(L + GA_KD, GP128, 16 * ks, db * 32, lane);
#pragma unroll
            for (int t = 0; t < 4; ++t) acc[t] = MFMA32(a, ld_tr(L + GA_VI, GP256, 16 * ks, (4 * jh + t) * 32, lane), acc[t]); }
        bf16* out = SKV + (size_t)it * 128 * 256;
#pragma unroll
        for (int t = 0; t < 4; ++t)
#pragma unroll
            for (int i = 0; i < 16; ++i) out[(size_t)(db * 32 + crow(i, h2)) * 256 + (4 * jh + t) * 32 + r] = cvt1(acc[t][i]);
        WG_BAR();
    }
}
__device__ __forceinline__ void gla_phase_b(const Frame& F0) {
    const Frame F = relaunder(F0);
    unsigned char* ws = WSP();
    bf16* SKV = (bf16*)(ws + WS_XB); const float* DEC = (const float*)(ws + WS_DEC);
    for (int gt = F.bid * NTHREADS + F.tid; gt < 32 * 128 * 32; gt += F.G * NTHREADS) {
        const int bh = gt >> 12, d = (gt >> 5) & 127, e8 = gt & 31;
        float s[8];
#pragma unroll
        for (int i = 0; i < 8; ++i) s[i] = 0.f;
        for (int g0 = 0; g0 < 32; g0 += 4) {
            v4u kv[4]; float dc[4];
#pragma unroll
            for (int u = 0; u < 4; ++u) { const size_t item = (size_t)bh * 32 + g0 + u; kv[u] = *(const GAS v4u*)(SKV + (item * 128 + d) * 256 + e8 * 8); dc[u] = DEC[item * 128 + d]; }
#pragma unroll
            for (int u = 0; u < 4; ++u) { const size_t item = (size_t)bh * 32 + g0 + u;
                v4u o; o.x = cvtpk(s[0], s[1]); o.y = cvtpk(s[2], s[3]); o.z = cvtpk(s[4], s[5]); o.w = cvtpk(s[6], s[7]);
                *(GAS v4u*)(SKV + (item * 128 + d) * 256 + e8 * 8) = o;
#pragma unroll
                for (int i = 0; i < 4; ++i) { s[2 * i] = dc[u] * s[2 * i] + bflo(kv[u][i]); s[2 * i + 1] = dc[u] * s[2 * i + 1] + bfhi(kv[u][i]); } }
        }
    }
}
__device__ __forceinline__ void gla_phase_c(const Frame& F0, int li) {
    const Frame F = relaunder(F0);
    unsigned char* ws = WSP();
    const bf16* P = (const bf16*)(ws + WS_ACT); const bf16* SKV = (const bf16*)(ws + WS_XB); bf16* CAT = (bf16*)(ws + WS_CAT);
    LAS unsigned char* L = F.lds;
    const int lane = F.lane, r = lane & 31, h2 = lane >> 5, wave = F.wave, db = wave & 3, jh = wave >> 2;
    const int ib = wave & 3, eq = wave >> 2;
    for (int it = F.bid; it < 1024; it += F.G) {
        const int bh = it >> 5, g = it & 31, b = bh >> 2, h = bh & 3;
        const bf16* Prow0 = P + ((size_t)b * SEQ + g * 128) * GLA_INP;
        const bf16* Sg = SKV + (size_t)it * 128 * 256;
        stage_tile<128, 128>(L + GC_QT, GP128, Prow0 + G_Q + h * 128, GLA_INP, F.tid);
        stage_tile<128, 128>(L + GC_KT, GP128, Prow0 + G_K + h * 128, GLA_INP, F.tid);
        stage_tile<128, 128>(L + GC_SI, GP128, Sg, 256, F.tid);
        stage_tile<128, 128>(L + GC_VI, GP128, Prow0 + G_V + h * 256, GLA_INP, F.tid);
        gla_stage_small(F, L + GC_AL, L + GC_W2, (LAS float*)(L + GC_BA), Prow0, li, h);
        WG_BAR();
        {
            float Bc[2][16], Blast;
            gla_cumsum(Bc, Blast, L + GC_AL, L + GC_W2, (const LAS float*)(L + GC_BA), (LAS float*)(L + GC_EX), wave, lane);
#pragma unroll
            for (int t = 0; t < 2; ++t)
#pragma unroll
                for (int i = 0; i < 16; ++i) { const int off = ((jh * 2 + t) * 32 + crow(i, h2)) * GP128 + (db * 32 + r) * 2;
                    const float eb = __builtin_amdgcn_exp2f(Bc[t][i] * LOG2E);
                    const float qv = bf2f(*(const LAS bf16*)(L + GC_QT + off)) * eb * 0.08838834764831845f;
                    const float kv = bf2f(*(const LAS bf16*)(L + GC_KT + off)) * __builtin_amdgcn_rcpf(eb);
                    *(LAS bf16*)(L + GC_QT + off) = cvt1(qv); *(LAS bf16*)(L + GC_KT + off) = cvt1(kv); }
        }
        WG_BAR();
        bf16x8 PA[4][2];
#pragma unroll
        for (int jb = 0; jb < 4; ++jb) {
            if (jb <= ib) {
                f32x16 x = {0.f, 0.f, 0.f, 0.f, 0.f, 0.f, 0.f, 0.f, 0.f, 0.f, 0.f, 0.f, 0.f, 0.f, 0.f, 0.f};
#pragma unroll
                for (int ks = 0; ks < 8; ++ks) x = MFMA32(ld_row(L + GC_KT, GP128, jb * 32, 16 * ks, r, h2), ld_row(L + GC_QT, GP128, ib * 32, 16 * ks, r, h2), x);
                if (jb == ib) {
#pragma unroll
                    for (int i = 0; i < 16; ++i) if (crow(i, h2) > r) x[i] = 0.f; }
                PA[jb][0] = PACK_STEP(x, 0); PA[jb][1] = PACK_STEP(x, 1);
            } else { PA[jb][0] = (bf16x8){0, 0, 0, 0, 0, 0, 0, 0}; PA[jb][1] = (bf16x8){0, 0, 0, 0, 0, 0, 0, 0}; }
        }
        f32x16 o[2][2];
#pragma unroll
        for (int half = 0; half < 2; ++half) {
            if (half == 1) {
                WG_BAR();
                stage_tile<128, 128>(L + GC_SI, GP128, Sg + 128, 256, F.tid);
                stage_tile<128, 128>(L + GC_VI, GP128, Prow0 + G_V + h * 256 + 128, GLA_INP, F.tid);
                WG_BAR();
            }
#pragma unroll
            for (int t = 0; t < 2; ++t) {
                const int eb = 2 * eq + t;
                f32x16 acc = {0.f, 0.f, 0.f, 0.f, 0.f, 0.f, 0.f, 0.f, 0.f, 0.f, 0.f, 0.f, 0.f, 0.f, 0.f, 0.f};
#pragma unroll
                for (int jb = 0; jb < 4; ++jb) if (jb <= ib) {
#pragma unroll
                    for (int s = 0; s < 2; ++s) acc = MFMA32(PA[jb][s], ld_tr_perm(L + GC_VI, GP128, jb * 32 + 16 * s, eb * 32, lane), acc); }
#pragma unroll
                for (int ks = 0; ks < 8; ++ks) acc = MFMA32(ld_row(L + GC_QT, GP128, ib * 32, 16 * ks, r, h2), ld_tr(L + GC_SI, GP128, 16 * ks, eb * 32, lane), acc);
                o[half][t] = acc;
            }
        }
        WG_BAR();
#pragma unroll
        for (int half = 0; half < 2; ++half)
#pragma unroll
            for (int t = 0; t < 2; ++t)
#pragma unroll
                for (int i = 0; i < 16; ++i) *(LAS bf16*)(L + GC_OI + (ib * 32 + crow(i, h2)) * GP256 + (half * 128 + (2 * eq + t) * 32 + r) * 2) = cvt1(o[half][t][i]);
        WG_BAR();
        {
            const int row = F.tid >> 2, qtr = F.tid & 3;
            lcp orow = L + GC_OI + row * GP256 + qtr * 128;
            float sum = 0.f;
#pragma unroll
            for (int c = 0; c < 8; ++c) { const v4u w = *(const LAS v4u*)(orow + c * 16);
#pragma unroll
                for (int i = 0; i < 4; ++i) sum += bflo(w[i]) + bfhi(w[i]); }
            sum += xsw<1>(sum); sum += xsw<2>(sum);
            const float mu = sum * (1.0f / 256.0f); float sq = 0.f;
#pragma unroll
            for (int c = 0; c < 8; ++c) { const v4u w = *(const LAS v4u*)(orow + c * 16);
#pragma unroll
                for (int i = 0; i < 4; ++i) { const float d0 = bflo(w[i]) - mu, d1 = bfhi(w[i]) - mu; sq += d0 * d0 + d1 * d1; } }
            sq += xsw<1>(sq); sq += xsw<2>(sq);
            const float rstd = 1.0f / sqrtf(sq * (1.0f / 256.0f) + EPS);
            const bf16* gp = Prow0 + (size_t)row * GLA_INP + G_R + h * 256 + qtr * 64;
            bf16* op = CAT + ((size_t)b * SEQ + g * 128 + row) * D + h * 256 + qtr * 64;
#pragma unroll
            for (int c = 0; c < 8; ++c) { const v4u gw = *(const GAS v4u*)(gp + c * 8); const v4u w = *(const LAS v4u*)(orow + c * 16); v4u ow;
#pragma unroll
                for (int i = 0; i < 4; ++i) { const float g0 = bflo(gw[i]), g1 = bfhi(gw[i]);
                    ow[i] = cvtpk((bflo(w[i]) - mu) * rstd * silu_f(g0), (bfhi(w[i]) - mu) * rstd * silu_f(g1)); }
                *(GAS v4u*)(op + c * 8) = ow; asm volatile("" ::: "memory"); }
        }
        WG_BAR();
    }
}


constexpr size_t WS_OD = 408 * MiB;
constexpr size_t WS_LSE = WS_XB + 32 * MiB;
constexpr size_t WS_END2 = 504 * MiB;
constexpr int RP = 272;
constexpr int RA_KI = 0, RA_VD = RA_KI + 128 * RP, RA_END = RA_VD + 128 * RP;
constexpr int RC_QI = 0, RC_KI = RC_QI + 128 * RP, RC_VI = RC_KI + 128 * RP, RC_SI = RC_VI + 128 * RP, RC_END = RC_SI + 128 * RP;
constexpr int DP = 144;
constexpr int DL_KI = 0, DL_VI = DL_KI + 384 * DP, DL_ST = DL_VI + 384 * DP, DL_LW = DL_ST + 8 * 32 * DP, DL_END = DL_LW + 8 * 256;
static_assert(RC_END <= LDSCTL_OFF && DL_END <= LDSCTL_OFF, "even mixer LDS maps");
__device__ __forceinline__ float ret_log2g(int h) { return log2f(1.0f - exp2f(-5.0f - (float)h)); }

__device__ __forceinline__ void ret_phase_a_item(const Frame& F, int it, const bf16* P, bf16* RKV) {
    LAS unsigned char* L = F.lds;
    const int lane = F.lane, r = lane & 31, h2 = lane >> 5, wave = F.wave, db = wave & 3, eh = wave >> 2;
    const int bh = it >> 5, n = it & 31, b = bh >> 2, h = bh & 3;
    const float lg = ret_log2g(h);
    const bf16* Prow0 = P + ((size_t)b * SEQ + n * 128) * EVEN_IN;
    stage_tile<128, 128>(L + RA_KI, RP, Prow0 + E_RK + h * 128, EVEN_IN, F.tid);
    {
        const bf16* gsrc = Prow0 + E_RV + h * 128;
#pragma unroll
        for (int i = 0; i < 4; ++i) { const int c = F.tid + i * NTHREADS, row = c >> 4, cc = c & 15; const float f = __builtin_amdgcn_exp2f(lg * (float)(127 - row));
            const v4u v = *(const GAS v4u*)(gsrc + (size_t)row * EVEN_IN + cc * 8); v4u o;
#pragma unroll
            for (int k = 0; k < 4; ++k) o[k] = cvtpk(bflo(v[k]) * f, bfhi(v[k]) * f);
            *(LAS v4u*)(L + RA_VD + row * RP + cc * 16) = o; }
    }
    WG_BAR();
    f32x16 acc[2];
#pragma unroll
    for (int t = 0; t < 2; ++t) acc[t] = (f32x16){0.f, 0.f, 0.f, 0.f, 0.f, 0.f, 0.f, 0.f, 0.f, 0.f, 0.f, 0.f, 0.f, 0.f, 0.f, 0.f};
#pragma unroll
    for (int ks = 0; ks < 8; ++ks) { const bf16x8 a = ld_tr(L + RA_KI, RP, 16 * ks, db * 32, lane);
#pragma unroll
        for (int t = 0; t < 2; ++t) acc[t] = MFMA32(a, ld_tr(L + RA_VD, RP, 16 * ks, (2 * eh + t) * 32, lane), acc[t]); }
    WG_BAR();
#pragma unroll
    for (int t = 0; t < 2; ++t)
#pragma unroll
        for (int i = 0; i < 16; ++i) *(LAS bf16*)(L + RA_KI + (db * 32 + crow(i, h2)) * RP + ((2 * eh + t) * 32 + r) * 2) = cvt1(acc[t][i]);
    WG_BAR();
    bf16* out = RKV + (size_t)it * 128 * 128;
#pragma unroll
    for (int i = 0; i < 4; ++i) { const int c = F.tid + i * NTHREADS, row = c >> 4, cc = c & 15; *(GAS v4u*)(out + row * 128 + cc * 8) = *(const LAS v4u*)(L + RA_KI + row * RP + cc * 16); }
    WG_BAR();
}
__device__ __forceinline__ void ret_scan(const Frame& F, bf16* RKV) {
    for (int gt = F.bid * NTHREADS + F.tid; gt < 32 * 128 * 16; gt += F.G * NTHREADS) {
        const int bh = gt >> 11, d = (gt >> 4) & 127, e8 = gt & 15, h = bh & 3;
        const float g128 = __builtin_amdgcn_exp2f(ret_log2g(h) * 128.0f);
        float s[8];
#pragma unroll
        for (int i = 0; i < 8; ++i) s[i] = 0.f;
        for (int n0 = 0; n0 < 32; n0 += 4) {
            v4u kv[4];
#pragma unroll
            for (int u = 0; u < 4; ++u) kv[u] = *(const GAS v4u*)(RKV + (((size_t)bh * 32 + n0 + u) * 128 + d) * 128 + e8 * 8);
#pragma unroll
            for (int u = 0; u < 4; ++u) {
                v4u o; o.x = cvtpk(s[0], s[1]); o.y = cvtpk(s[2], s[3]); o.z = cvtpk(s[4], s[5]); o.w = cvtpk(s[6], s[7]);
                *(GAS v4u*)(RKV + (((size_t)bh * 32 + n0 + u) * 128 + d) * 128 + e8 * 8) = o;
#pragma unroll
                for (int i = 0; i < 4; ++i) { s[2 * i] = g128 * s[2 * i] + bflo(kv[u][i]); s[2 * i + 1] = g128 * s[2 * i + 1] + bfhi(kv[u][i]); } }
        }
    }
}
__device__ __forceinline__ void ret_phase_c_item(const Frame& F, int it, const bf16* P, const bf16* RKV, bf16* CAT) {
    LAS unsigned char* L = F.lds;
    const int lane = F.lane, r = lane & 31, h2 = lane >> 5, wave = F.wave, ib = wave & 3, eq = wave >> 2;
    const int bh = it >> 5, n = it & 31, b = bh >> 2, h = bh & 3;
    const float lg = ret_log2g(h);
    const bf16* Prow0 = P + ((size_t)b * SEQ + n * 128) * EVEN_IN;
    {
#pragma unroll
        for (int i = 0; i < 4; ++i) { const int c = F.tid + i * NTHREADS, row = c >> 4, cc = c & 15; const float fq = __builtin_amdgcn_exp2f(lg * (float)row), fk = __builtin_amdgcn_rcpf(fq);
            const v4u vq = *(const GAS v4u*)(Prow0 + (size_t)row * EVEN_IN + E_RQ + h * 128 + cc * 8), vk = *(const GAS v4u*)(Prow0 + (size_t)row * EVEN_IN + E_RK + h * 128 + cc * 8); v4u oq, ok;
#pragma unroll
            for (int k = 0; k < 4; ++k) { oq[k] = cvtpk(bflo(vq[k]) * fq, bfhi(vq[k]) * fq); ok[k] = cvtpk(bflo(vk[k]) * fk, bfhi(vk[k]) * fk); }
            *(LAS v4u*)(L + RC_QI + row * RP + cc * 16) = oq; *(LAS v4u*)(L + RC_KI + row * RP + cc * 16) = ok; }
    }
    stage_tile<128, 128>(L + RC_VI, RP, Prow0 + E_RV + h * 128, EVEN_IN, F.tid);
    stage_tile<128, 128>(L + RC_SI, RP, RKV + (size_t)it * 128 * 128, 128, F.tid);
    WG_BAR();
    bf16x8 PA[4][2];
#pragma unroll
    for (int jb = 0; jb < 4; ++jb) {
        if (jb <= ib) {
            f32x16 x = {0.f, 0.f, 0.f, 0.f, 0.f, 0.f, 0.f, 0.f, 0.f, 0.f, 0.f, 0.f, 0.f, 0.f, 0.f, 0.f};
#pragma unroll
            for (int ks = 0; ks < 8; ++ks) x = MFMA32(ld_row(L + RC_KI, RP, jb * 32, 16 * ks, r, h2), ld_row(L + RC_QI, RP, ib * 32, 16 * ks, r, h2), x);
            if (jb == ib) {
#pragma unroll
                for (int i = 0; i < 16; ++i) if (crow(i, h2) > r) x[i] = 0.f; }
            PA[jb][0] = PACK_STEP(x, 0); PA[jb][1] = PACK_STEP(x, 1);
        } else { PA[jb][0] = (bf16x8){0, 0, 0, 0, 0, 0, 0, 0}; PA[jb][1] = (bf16x8){0, 0, 0, 0, 0, 0, 0, 0}; }
    }
    f32x16 o[2];
#pragma unroll
    for (int t = 0; t < 2; ++t) {
        const int eb = 2 * eq + t;
        f32x16 z = {0.f, 0.f, 0.f, 0.f, 0.f, 0.f, 0.f, 0.f, 0.f, 0.f, 0.f, 0.f, 0.f, 0.f, 0.f, 0.f}, y = z;
#pragma unroll
        for (int jb = 0; jb < 4; ++jb) if (jb <= ib) {
#pragma unroll
            for (int s = 0; s < 2; ++s) z = MFMA32(PA[jb][s], ld_tr_perm(L + RC_VI, RP, jb * 32 + 16 * s, eb * 32, lane), z); }
#pragma unroll
        for (int ks = 0; ks < 8; ++ks) y = MFMA32(ld_row(L + RC_QI, RP, ib * 32, 16 * ks, r, h2), ld_tr(L + RC_SI, RP, 16 * ks, eb * 32, lane), y);
        const float g1 = __builtin_amdgcn_exp2f(lg);
#pragma unroll
        for (int i = 0; i < 16; ++i) z[i] += y[i] * g1;
        o[t] = z;
    }
    WG_BAR();
#pragma unroll
    for (int t = 0; t < 2; ++t)
#pragma unroll
        for (int i = 0; i < 16; ++i) *(LAS bf16*)(L + RC_QI + (ib * 32 + crow(i, h2)) * RP + ((2 * eq + t) * 32 + r) * 2) = cvt1(o[t][i]);
    WG_BAR();
    {
        const int row = F.tid >> 2, qtr = F.tid & 3;
        lcp orow = L + RC_QI + row * RP + qtr * 64;
        v4u w[4]; float sum = 0.f;
#pragma unroll
        for (int c = 0; c < 4; ++c) { w[c] = *(const LAS v4u*)(orow + c * 16);
#pragma unroll
            for (int i = 0; i < 4; ++i) sum += bflo(w[c][i]) + bfhi(w[c][i]); }
        sum += xsw<1>(sum); sum += xsw<2>(sum);
        const float mu = sum * (1.0f / 128.0f); float sq = 0.f;
#pragma unroll
        for (int c = 0; c < 4; ++c)
#pragma unroll
            for (int i = 0; i < 4; ++i) { const float d0 = bflo(w[c][i]) - mu, d1 = bfhi(w[c][i]) - mu; sq += d0 * d0 + d1 * d1; }
        sq += xsw<1>(sq); sq += xsw<2>(sq);
        const float rstd = 1.0f / sqrtf(sq * (1.0f / 128.0f) + EPS);
        const bf16* gp = Prow0 + (size_t)row * EVEN_IN + E_RG + h * 128 + qtr * 32;
        bf16* op = CAT + ((size_t)b * SEQ + n * 128 + row) * D + h * 128 + qtr * 32;
#pragma unroll
        for (int c = 0; c < 4; ++c) { const v4u gw = *(const GAS v4u*)(gp + c * 8); v4u ow;
#pragma unroll
            for (int i = 0; i < 4; ++i) { const float g0 = bflo(gw[i]), g1 = bfhi(gw[i]);
                ow[i] = cvtpk((bflo(w[c][i]) - mu) * rstd * silu_f(g0), (bfhi(w[c][i]) - mu) * rstd * silu_f(g1)); }
            *(GAS v4u*)(op + c * 8) = ow; }
    }
    WG_BAR();
}
__device__ __forceinline__ void dil_tile(const Frame& F, int T, const bf16* P, bf16* OD, float* LSE) {
    LAS unsigned char* L = F.lds;
    const int lane = F.lane, r = lane & 31, h2 = lane >> 5, wave = F.wave;
    const int b = T / 384, rem = T - b * 384, head = rem / 48, t48 = rem - head * 48, p = t48 >> 4, idx = t48 & 15;
    const int sh = 2 * p, dil = 1 << sh, res = idx & (dil - 1), blk = idx >> sh, q0 = blk * 256;
    const bf16* Pb = P + (size_t)b * SEQ * EVEN_IN + head * 64;
#pragma unroll
    for (int i = 0; i < 6; ++i) { const int c = F.tid + i * NTHREADS, row = c >> 3, cc = c & 7; int kidx = q0 - 128 + row; kidx = kidx < 0 ? 0 : kidx;
        const bf16* src = Pb + (size_t)(kidx * dil + res) * EVEN_IN + cc * 8;
        const v4u kv = *(const GAS v4u*)(src + E_DK), vv = *(const GAS v4u*)(src + E_DV);
        *(LAS v4u*)(L + DL_KI + row * DP + cc * 16) = kv; *(LAS v4u*)(L + DL_VI + row * DP + cc * 16) = vv; }
    bf16x8 qf[4];
    { const bf16* qsrc = Pb + (size_t)((q0 + 32 * wave + r) * dil + res) * EVEN_IN + E_DQ + 8 * h2;
#pragma unroll
      for (int ks = 0; ks < 4; ++ks) qf[ks] = *(const GAS bf16x8*)(qsrc + 16 * ks); }
    WG_BAR();
    f32x16 x[5];
    float mx = -INFINITY;
#pragma unroll
    for (int kb = 0; kb < 5; ++kb) {
        f32x16 a = {0.f, 0.f, 0.f, 0.f, 0.f, 0.f, 0.f, 0.f, 0.f, 0.f, 0.f, 0.f, 0.f, 0.f, 0.f, 0.f};
#pragma unroll
        for (int ks = 0; ks < 4; ++ks) a = MFMA32(ld_row(L + DL_KI, DP, 32 * wave + 32 * kb, 16 * ks, r, h2), qf[ks], a);
        if (kb == 0) {
#pragma unroll
            for (int i = 0; i < 16; ++i) if (crow(i, h2) < r) a[i] = -INFINITY; }
        if (kb == 4) {
#pragma unroll
            for (int i = 0; i < 16; ++i) if (crow(i, h2) > r) a[i] = -INFINITY; }
        if (q0 == 0 && 32 * wave + 32 * kb < 128) {
#pragma unroll
            for (int i = 0; i < 16; ++i) a[i] = -INFINITY; }
#pragma unroll
        for (int i = 0; i < 16; ++i) mx = fmaxf(mx, a[i]);
        x[kb] = a;
    }
    mx = max32(mx);
    constexpr float C2 = 0.125f * LOG2E;
    const float mc = mx * C2; float l = 0.f;
#pragma unroll
    for (int kb = 0; kb < 5; ++kb)
#pragma unroll
        for (int i = 0; i < 16; ++i) { const float pe = __builtin_amdgcn_exp2f(x[kb][i] * C2 - mc); x[kb][i] = pe; l += pe; }
    l = sum32(l);
    f32x16 o[2];
#pragma unroll
    for (int dbk = 0; dbk < 2; ++dbk) o[dbk] = (f32x16){0.f, 0.f, 0.f, 0.f, 0.f, 0.f, 0.f, 0.f, 0.f, 0.f, 0.f, 0.f, 0.f, 0.f, 0.f, 0.f};
#pragma unroll
    for (int kb = 0; kb < 5; ++kb)
#pragma unroll
        for (int s = 0; s < 2; ++s) { const bf16x8 pa = PACK_STEP(x[kb], s);
#pragma unroll
            for (int dbk = 0; dbk < 2; ++dbk) o[dbk] = MFMA32(pa, ld_tr_perm(L + DL_VI, DP, 32 * wave + 32 * kb + 16 * s, dbk * 32, lane), o[dbk]); }
    LAS float* lw = (LAS float*)(L + DL_LW + wave * 256);
    if (h2 == 0) lw[r] = l;
    LAS unsigned char* st = L + DL_ST + wave * 32 * DP;
#pragma unroll
    for (int i = 0; i < 16; ++i) { const float rl = __builtin_amdgcn_rcpf(lw[crow(i, h2)]);
#pragma unroll
        for (int dbk = 0; dbk < 2; ++dbk) *(LAS bf16*)(st + crow(i, h2) * DP + (dbk * 32 + r) * 2) = cvt1(o[dbk][i] * rl); }
    const size_t tokbase = (size_t)b * SEQ;
    bf16* odp = OD + (size_t)p * M * 512;
#pragma unroll
    for (int j = 0; j < 4; ++j) { const int c = lane + 64 * j, row = c >> 3, cc = c & 7; const size_t tok = tokbase + (size_t)(q0 + 32 * wave + row) * dil + res;
        *(GAS v4u*)(odp + tok * 512 + head * 64 + cc * 8) = *(const LAS v4u*)(st + row * DP + cc * 16); }
    if (h2 == 0) { const size_t tok = tokbase + (size_t)(q0 + 32 * wave + r) * dil + res; LSE[((size_t)p * M + tok) * 8 + head] = mx * 0.125f + LN2 * __builtin_amdgcn_logf(l); }
    WG_BAR();
}
__device__ __forceinline__ void dil_combine(const Frame& F, const bf16* OD, const float* LSE, bf16* CAT) {
    for (int gt = F.bid * NTHREADS + F.tid; gt < M * 64; gt += F.G * NTHREADS) {
        const int tok = gt >> 6, c8 = gt & 63, head = c8 >> 3;
        const float l0 = LSE[(size_t)tok * 8 + head], l1 = LSE[((size_t)M + tok) * 8 + head], l2 = LSE[((size_t)2 * M + tok) * 8 + head];
        const float mxl = fmaxf(l0, fmaxf(l1, l2));
        float w0 = __builtin_amdgcn_exp2f((l0 - mxl) * LOG2E), w1 = __builtin_amdgcn_exp2f((l1 - mxl) * LOG2E), w2 = __builtin_amdgcn_exp2f((l2 - mxl) * LOG2E);
        const float rs = 1.0f / (w0 + w1 + w2); w0 *= rs; w1 *= rs; w2 *= rs;
        const v4u a = *(const GAS v4u*)(OD + (size_t)tok * 512 + c8 * 8), bq = *(const GAS v4u*)(OD + ((size_t)M + tok) * 512 + c8 * 8), cq = *(const GAS v4u*)(OD + ((size_t)2 * M + tok) * 512 + c8 * 8);
        v4u o;
#pragma unroll
        for (int i = 0; i < 4; ++i) o[i] = cvtpk(w0 * bflo(a[i]) + w1 * bflo(bq[i]) + w2 * bflo(cq[i]), w0 * bfhi(a[i]) + w1 * bfhi(bq[i]) + w2 * bfhi(cq[i]));
        *(GAS v4u*)(CAT + (size_t)tok * D + 512 + c8 * 8) = o;
    }
}
constexpr int DIL_TILES = 3072, DIL_SPLIT = 1024;
__device__ __forceinline__ void even_phase_a(const Frame& F0) {
    const Frame F = relaunder(F0);
    unsigned char* ws = WSP();
    const bf16* P = (const bf16*)(ws + WS_ACT); bf16* RKV = (bf16*)(ws + WS_XB); bf16* OD = (bf16*)(ws + WS_OD); float* LSE = (float*)(ws + WS_LSE);
    for (int it = F.bid; it < 1024; it += F.G) ret_phase_a_item(F, it, P, RKV);
    for (int T = F.bid; T < DIL_SPLIT; T += F.G) dil_tile(F, T, P, OD, LSE);
}
__device__ __forceinline__ void even_phase_b(const Frame& F0) {
    const Frame F = relaunder(F0);
    unsigned char* ws = WSP();
    const bf16* P = (const bf16*)(ws + WS_ACT); bf16* RKV = (bf16*)(ws + WS_XB); bf16* OD = (bf16*)(ws + WS_OD); float* LSE = (float*)(ws + WS_LSE);
    ret_scan(F, RKV);
    for (int T = DIL_SPLIT + F.bid; T < DIL_TILES; T += F.G) dil_tile(F, T, P, OD, LSE);
}
__device__ __forceinline__ void even_phase_c(const Frame& F0) {
    const Frame F = relaunder(F0);
    unsigned char* ws = WSP();
    const bf16* P = (const bf16*)(ws + WS_ACT); const bf16* RKV = (const bf16*)(ws + WS_XB); const bf16* OD = (const bf16*)(ws + WS_OD); const float* LSE = (const float*)(ws + WS_LSE); bf16* CAT = (bf16*)(ws + WS_CAT);
    for (int it = F.bid; it < 1024; it += F.G) ret_phase_c_item(F, it, P, RKV, CAT);
    dil_combine(F, OD, LSE, CAT);
}

__global__ void __launch_bounds__(NTHREADS, 2) fwd_kernel(Args args) {
    extern __shared__ __attribute__((aligned(16))) unsigned char lds[];
    Frame F;
    F.lds = (LAS unsigned char*)lds;
    F.wave = __builtin_amdgcn_readfirstlane((int)(threadIdx.x >> 6)); F.lane = hw_lane(); F.tid = F.wave * 64 + F.lane; F.G = gridDim.x; F.bid = blockIdx.x;
    for (int u = F.tid; u < (LDS_BYTES - LDSCTL_OFF) / 4; u += NTHREADS) ((LAS unsigned*)(F.lds + LDSCTL_OFF))[u] = 0u;
    __syncthreads();
    if (F.tid < N_PTRS) { const unsigned long long v = (F.tid < 17) ? (unsigned long long)args.in[F.tid] : (F.tid == 17 ? (unsigned long long)args.out : (unsigned long long)args.ws);
        ((LAS unsigned*)(F.lds + PTR_OFF))[2 * F.tid] = (unsigned)v; ((LAS unsigned*)(F.lds + PTR_OFF))[2 * F.tid + 1] = (unsigned)(v >> 32); }
    __syncthreads();
    (void)xcd_barrier_post((unsigned*)(WSP() + WS_CTL) + CW_BAR, (volatile LAS unsigned*)(F.lds + MISC_OFF) + 8, F.tid);
#ifdef PROBE_BARX2
#define PROBE_BAR2(b, t) xcd_barrier(b, t)
#else
#define PROBE_BAR2(b, t) do {} while (0)
#endif
#define GRID_BAR() do { XcdBarrier bar_; bar_.bar = (unsigned*)(WSP() + WS_CTL) + CW_BAR; bar_.x = (unsigned)__builtin_amdgcn_readfirstlane((int)xb_xcc_id()); \
        int mo_ = MISC_OFF + 32; asm volatile("" : "+s"(mo_)); bar_.st = (volatile LAS unsigned*)(F.lds + mo_); int t_ = threadIdx.x; asm volatile("" : "+v"(t_)); xcd_barrier(bar_, t_); PROBE_BAR2(bar_, t_); } while (0)
#define XB ((bf16*)(WSP() + WS_XB))
#define ACT ((bf16*)(WSP() + WS_ACT))
#define CAT ((bf16*)(WSP() + WS_CAT))
#define SSP ((float*)(WSP() + WS_SSP))
#define WPTR(off) ((const bf16*)(WSP() + (off)))

#ifdef TEST_MIN
    {
        pg8::Gemm g{XB, WPTR(W_GU0), M, 2 * FF, D}; pg8::StaticOrder S; S.init(M, 2 * FF, lnd(F.G), lnd(F.bid));
        pg8::EpiSwiGLU E{ACT, FF, SSP};
        pg8::gemm_phase<pg8::EpiSwiGLU, pg8::StaticOrder, true, true>(F.lds + RING_OFF, g, S, E, lnd(F.wave));
        GRID_BAR();
        return;
    }
#endif
    prologue_rows(F);
    convert_weights(F, 0);
    GRID_BAR();
    for (int s = 0; s < 8; ++s) {
        const int l = s >> 1; const bool post = (s & 1) != 0;
#ifdef PROBE_F1X2
        for (int rep = 0; rep < 2; ++rep)
#endif
        {
#ifdef PROBE_KX2
            typedef pg8::TwiceOrder F1Order;
#else
            typedef pg8::StaticOrder F1Order;
#endif
            pg8::Gemm g{XB, WPTR(post ? W_GU1 : W_GU0), M, 2 * FF, D}; F1Order S; S.init(M, 2 * FF, lnd(F.G), lnd(F.bid));
            pg8::EpiSwiGLU E{ACT, FF, SSP};
#ifndef NO_F1
            pg8::gemm_phase<pg8::EpiSwiGLU, F1Order, true, true>(F.lds + RING_OFF, g, S, E, lnd(F.wave));
#endif
            GRID_BAR();
        }
#ifdef PROBE_F2X2
        for (int rep = 0; rep < 2; ++rep)
#else
        constexpr int rep = 1;
#endif
        {
            pg8::Gemm g{ACT, WPTR(post ? W_D1 : W_D0), M, D, FF}; pg8::StaticOrder S; S.init(M, D, lnd(F.G), lnd(F.bid));
            pg8::EpiResid E{s == 0 ? AP(I_X) : (const float*)OUTP(), OUTP(), XB, SSP, rep ? 0.5f : 0.0f};
#ifndef NO_F2
            pg8::gemm_phase<pg8::EpiResid, pg8::StaticOrder, true, true>(F.lds + RING_OFF, g, S, E, lnd(F.wave));
#endif
            GRID_BAR();
        }
        if (!post) {
            const bool odd = (l & 1) != 0; const int nin = odd ? GLA_INP : EVEN_IN;
            {
                pg8::Gemm g{XB, WPTR(W_IN), M, nin, D}; pg8::StaticOrder S; S.init(M, nin, lnd(F.G), lnd(F.bid));
                pg8::EpiScaleBf16 E{ACT, nin, SSP};
#ifndef NO_M1
                pg8::gemm_phase<pg8::EpiScaleBf16, pg8::StaticOrder, true, true>(F.lds + RING_OFF, g, S, E, lnd(F.wave));
#endif
            }
            GRID_BAR();
#ifndef NO_EVEN
#if defined(PROBE_MIXX2) || defined(PROBE_EVENX2)
            if (!odd) { even_prep(F); GRID_BAR(); even_phase_a(F); GRID_BAR(); even_phase_a(F); GRID_BAR(); even_phase_b(F); GRID_BAR(); even_phase_c(F); GRID_BAR(); even_phase_c(F); }
#else
            if (!odd) { even_prep(F); GRID_BAR(); even_phase_a(F); GRID_BAR(); even_phase_b(F); GRID_BAR(); even_phase_c(F); }
#endif
#endif
#ifndef NO_GLA
            if (odd) {
#ifndef NO_GA
                gla_phase_a(F, l >> 1);
#endif
#ifdef PROBE_MIXX2
                GRID_BAR(); gla_phase_a(F, l >> 1);
#endif
                GRID_BAR();
#ifndef NO_GB
                gla_phase_b(F);
#endif
                GRID_BAR();
#ifndef NO_GC
                gla_phase_c(F, l >> 1);
#endif
#ifdef PROBE_MIXX2
                GRID_BAR(); gla_phase_c(F, l >> 1);
#endif
            }
#endif
            GRID_BAR();
#ifdef PROBE_M5X2
            for (int rep2 = 0; rep2 < 2; ++rep2)
#else
            constexpr int rep2 = 1;
#endif
            {
                pg8::Gemm g{CAT, WPTR(W_OUT), M, D, D}; pg8::StaticOrder S; S.init(M, D, lnd(F.G), lnd(F.bid));
                pg8::EpiResid E{(const float*)OUTP(), OUTP(), XB, SSP, rep2 ? 1.0f : 0.0f};
#ifndef NO_M5
                pg8::gemm_phase<pg8::EpiResid, pg8::StaticOrder, true, true>(F.lds + RING_OFF, g, S, E, lnd(F.wave));
#endif
                GRID_BAR();
            }
        } else if (l + 1 < DEPTH) {
            convert_weights(F, l + 1);
            GRID_BAR();
#ifdef PROBE_CONVX2
            convert_weights(F, l + 1);
            GRID_BAR();
#endif
        }
    }
    final_norm(F);
}

extern "C" void kernel_launch(void* const* d_in, const int* in_sizes, int n_in, void* d_out, int out_size, void* d_ws, size_t ws_size, hipStream_t stream) {
    static int grid = 0;
    if (grid == 0) {
        if (n_in != 17 || in_sizes[0] != M * D || out_size != M * D || ws_size < WS_END2) { fprintf(stderr, "kernel_launch: unexpected shapes (n_in %d, in0 %d, out %d, ws %zu)\n", n_in, n_in > 0 ? in_sizes[0] : -1, out_size, ws_size); grid = -1; return; }
        int dev = 0, cus = 0, per_cu = 0;
        if (hipGetDevice(&dev) != hipSuccess || hipDeviceGetAttribute(&cus, hipDeviceAttributeMultiprocessorCount, dev) != hipSuccess) { grid = -1; return; }
        if (hipFuncSetAttribute((const void*)fwd_kernel, hipFuncAttributeMaxDynamicSharedMemorySize, LDS_BYTES) != hipSuccess) { fprintf(stderr, "kernel_launch: hipFuncSetAttribute failed\n"); grid = -1; return; }
        if (hipOccupancyMaxActiveBlocksPerMultiprocessor(&per_cu, (const void*)fwd_kernel, NTHREADS, LDS_BYTES) != hipSuccess || per_cu < 1) { fprintf(stderr, "kernel_launch: occupancy query reports %d\n", per_cu); }
        (void)hipGetLastError();
        grid = cus;
        if (grid != 256) fprintf(stderr, "kernel_launch: %d CUs (expected 256)\n", grid);
    }
    if (grid < 0) return;
    if (hipMemsetAsync((char*)d_ws + WS_CTL, 0, CTL_ZERO_BYTES, stream) != hipSuccess) return;
    Args a{};
    for (int i = 0; i < 17; ++i) a.in[i] = (const float*)d_in[i];
    a.out = (float*)d_out; a.ws = (unsigned char*)d_ws;
    hipLaunchKernelGGL(fwd_kernel, dim3(grid), dim3(NTHREADS), LDS_BYTES, stream, a);
}
```

```cpp
#include <hip/hip_runtime.h>
#include <cstdio>
#include <cstdint>
#include <cmath>
template <int K> __device__ __forceinline__ float xsw(float v) { static_assert(K == 1 || K == 2 || K == 4 || K == 8 || K == 16, "xor mask inside a 32-lane half");
    return __builtin_bit_cast(float, __builtin_amdgcn_ds_swizzle(__builtin_bit_cast(int, v), 0x1F | (K << 10))); }
__device__ __forceinline__ float sum32(float v) { const unsigned u = __builtin_bit_cast(unsigned, v); auto rr = __builtin_amdgcn_permlane32_swap(u, u, false, false); return __builtin_bit_cast(float, (unsigned)rr[0]) + __builtin_bit_cast(float, (unsigned)rr[1]); }
__device__ __forceinline__ float max32(float v) { const unsigned u = __builtin_bit_cast(unsigned, v); auto rr = __builtin_amdgcn_permlane32_swap(u, u, false, false); return fmaxf(__builtin_bit_cast(float, (unsigned)rr[0]), __builtin_bit_cast(float, (unsigned)rr[1])); }
__device__ __forceinline__ float oth32(float v, int h) { const unsigned u = __builtin_bit_cast(unsigned, v); auto rr = __builtin_amdgcn_permlane32_swap(u, u, false, false); return __builtin_bit_cast(float, (unsigned)(h ? rr[0] : rr[1])); }
namespace pg8 {
#define PG8_LAS __attribute__((address_space(3)))
typedef unsigned short bf16_t;
typedef short bf16x8 __attribute__((ext_vector_type(8)));
typedef float f32x4 __attribute__((ext_vector_type(4)));
typedef unsigned u32x4 __attribute__((ext_vector_type(4)));
constexpr int BM = 256, BK = 64, HALF = 128, HTB = HALF * BK * 2  , STAGE_BYTES = 8 * HTB, NXCD = 8, WGM = 8;

__host__ __device__ __forceinline__ int lds_byte(int r, int c) { const int st = (r >> 4) * 2 + (c >> 5), rr = r & 15, cc = c & 31, ob = rr * 64 + cc * 2; return st * 1024 + (ob ^ (((ob >> 9) & 1) << 5)); }
__host__ __device__ __forceinline__ void stage_rc(int b, int& R, int& C) { const int st = b / 1024, sb = b % 1024, swz = sb ^ (((sb >> 9) & 1) << 5); R = (st >> 1) * 16 + swz / 64; C = (st & 1) * 32 + (swz % 64) / 2; }
__host__ __device__ __forceinline__ int perm32(int rho) { const int n = rho >> 4, i = rho & 15; return 8 * (i >> 2) + 4 * n + (i & 3); }

struct Unit { int pm, pn; };
struct Gemm { const bf16_t* A; const bf16_t* Bt; int M, N, K; };

struct StaticOrder {
    int nM, nN, nwg, G, c;
    __host__ __device__ void init(int M, int N, int G_, int c_) { nM = M / BM; nN = N / BM; nwg = nM * nN; G = G_; c = c_; }
    __host__ __device__ bool next(int i, Unit& u) const {
        const long L = (long)i * G + c; if (L >= nwg) return false;
        int wgid = (int)L; { const int q = nwg / NXCD, r = nwg % NXCD, xcd = wgid % NXCD, off = wgid / NXCD; wgid = (xcd < r ? xcd * (q + 1) : r * (q + 1) + (xcd - r) * q) + off; }
        const int nig = WGM * nN, gid = wgid / nig, fm = gid * WGM, gsz = (nM - fm) < WGM ? (nM - fm) : WGM;
        u.pm = fm + ((wgid % nig) % gsz); u.pn = (wgid % nig) / gsz; return true;
    }
    __device__ __forceinline__ void a_ready(const Unit&) const {}
    __device__ __forceinline__ void done(const Unit&) const {}
    static constexpr bool TWICE = false;
};
struct TwiceOrder : StaticOrder {
    static constexpr bool TWICE = true;
    __host__ __device__ bool next(int i, Unit& u) const { return StaticOrder::next(i >> 1, u); }
};

__device__ __forceinline__ unsigned cvt_pk_bf16(float lo, float hi) { unsigned r; asm volatile("v_cvt_pk_bf16_f32 %0, %1, %2" : "=v"(r) : "v"(lo), "v"(hi)); return r; }
constexpr int MROWS = 32768;
constexpr float RMS_EPS = 1e-6f;
__device__ __forceinline__ void row_rstd(float (&rs)[2][4], const float* ssp, const Unit& u, int wr, int fr, int fq) {
#pragma unroll
    for (int ai = 0; ai < 2; ++ai)
#pragma unroll
        for (int m = 0; m < 4; ++m) {
            const int row = u.pm * BM + ai * HALF + wr * 64 + m * 16 + fr;
            const f32x4 p = *(const f32x4*)(ssp + (size_t)row * 16 + 4 * fq);
            float s = (p[0] + p[1]) + (p[2] + p[3]);
            s += xsw<16>(s); s = sum32(s);
            rs[ai][m] = 1.0f / sqrtf(s * (1.0f / 1024.0f) + RMS_EPS);
        }
}
__device__ __forceinline__ float silu_f(float g) { return g * __builtin_amdgcn_rcpf(1.0f + __builtin_amdgcn_exp2f(-1.4426950408889634f * g)); }

struct EpiSwiGLU {
    static constexpr bool PERM = true, AFTER_DRAIN = false;
    bf16_t* H; int ldh; const float* ssp;
    __device__ __forceinline__ void operator()(const f32x4 (&acc)[2][2][4][2], const Unit& u, int wr, int wc, int fr, int fq) const {
        float rs[2][4]; row_rstd(rs, ssp, u, wr, fr, fq);
        const int col0 = u.pn * HALF + wc * 32 + 8 * fq;
#pragma unroll
        for (int ai = 0; ai < 2; ++ai)
#pragma unroll
            for (int m = 0; m < 4; ++m) {
                const int row = u.pm * BM + ai * HALF + wr * 64 + m * 16 + fr; const float r = rs[ai][m];
                float h[8];
#pragma unroll
                for (int n = 0; n < 2; ++n)
#pragma unroll
                    for (int i = 0; i < 4; ++i) { const float g = acc[ai][0][m][n][i] * r, up = acc[ai][1][m][n][i] * r; h[4 * n + i] = silu_f(g) * up; }
                u32x4 w; w.x = cvt_pk_bf16(h[0], h[1]); w.y = cvt_pk_bf16(h[2], h[3]); w.z = cvt_pk_bf16(h[4], h[5]); w.w = cvt_pk_bf16(h[6], h[7]);
                *(u32x4*)(H + (size_t)row * ldh + col0) = w;
                asm volatile("" ::: "memory");
            }
    }
};
struct EpiScaleBf16 {
    static constexpr bool PERM = true, AFTER_DRAIN = false;
    bf16_t* O; int ldc; const float* ssp;
    __device__ __forceinline__ void operator()(const f32x4 (&acc)[2][2][4][2], const Unit& u, int wr, int wc, int fr, int fq) const {
        float rs[2][4]; row_rstd(rs, ssp, u, wr, fr, fq);
        const int col0 = u.pn * BM + wc * 32 + 8 * fq;
#pragma unroll
        for (int ai = 0; ai < 2; ++ai)
#pragma unroll
            for (int m = 0; m < 4; ++m) {
                const int row = u.pm * BM + ai * HALF + wr * 64 + m * 16 + fr; const float r = rs[ai][m];
#pragma unroll
                for (int bj = 0; bj < 2; ++bj) { const f32x4 v0 = acc[ai][bj][m][0] * r, v1 = acc[ai][bj][m][1] * r;
                    u32x4 w; w.x = cvt_pk_bf16(v0[0], v0[1]); w.y = cvt_pk_bf16(v0[2], v0[3]); w.z = cvt_pk_bf16(v1[0], v1[1]); w.w = cvt_pk_bf16(v1[2], v1[3]);
                    *(u32x4*)(O + (size_t)row * ldc + col0 + bj * HALF) = w; }
                asm volatile("" ::: "memory");
            }
    }
};
struct EpiResid {
    static constexpr bool PERM = true, AFTER_DRAIN = false;
    const float* xold; float* xnew; bf16_t* xb; float* ssp; float scale;
    __device__ __forceinline__ void operator()(const f32x4 (&acc)[2][2][4][2], const Unit& u, int wr, int wc, int fr, int fq) const {
        const int col0 = u.pn * BM + wc * 32 + 8 * fq, rowb = u.pm * BM + wr * 64 + fr;
        f32x4 buf[2][4];
#define EPR_LOAD(g, slot) do { const size_t off_ = (size_t)(rowb + ((g) >> 2) * HALF + ((g) & 3) * 16) * 1024 + col0; \
        buf[slot][0] = *(const f32x4*)(xold + off_); buf[slot][1] = *(const f32x4*)(xold + off_ + 4); buf[slot][2] = *(const f32x4*)(xold + off_ + HALF); buf[slot][3] = *(const f32x4*)(xold + off_ + HALF + 4); } while (0)
        EPR_LOAD(0, 0); EPR_LOAD(1, 1);
        asm volatile("" ::: "memory");
#pragma unroll
        for (int g = 0; g < 8; ++g) {
            const int ai = g >> 2, m = g & 3, row = rowb + ai * HALF + m * 16; float ss = 0.f;
#pragma unroll
            for (int bj = 0; bj < 2; ++bj) { const size_t off = (size_t)row * 1024 + col0 + bj * HALF;
                const f32x4 v0 = buf[g & 1][2 * bj] + acc[ai][bj][m][0] * scale, v1 = buf[g & 1][2 * bj + 1] + acc[ai][bj][m][1] * scale;
                *(f32x4*)(xnew + off) = v0; *(f32x4*)(xnew + off + 4) = v1;
                u32x4 w; w.x = cvt_pk_bf16(v0[0], v0[1]); w.y = cvt_pk_bf16(v0[2], v0[3]); w.z = cvt_pk_bf16(v1[0], v1[1]); w.w = cvt_pk_bf16(v1[2], v1[3]);
                *(u32x4*)(xb + off) = w;
                ss += (v0[0] * v0[0] + v0[1] * v0[1]) + (v0[2] * v0[2] + v0[3] * v0[3]) + (v1[0] * v1[0] + v1[1] * v1[1]) + (v1[2] * v1[2] + v1[3] * v1[3]); }
            ss += xsw<16>(ss); ss = sum32(ss);
            if (fq == 0) ssp[(size_t)row * 16 + u.pn * 4 + wc] = ss;
            asm volatile("" ::: "memory");
            if (g + 2 < 8) { EPR_LOAD(g + 2, g & 1); asm volatile("" ::: "memory"); }
        }
#undef EPR_LOAD
    }
};

template <class Epi, class Sched, bool ALIGN_EPI = false, bool SP2 = false>
__device__ __forceinline__ void gemm_phase(PG8_LAS unsigned char* lds, const Gemm g, const Sched& S, const Epi& E, int wave_in) {
    int tid_ = threadIdx.x; asm volatile("" : "+v"(tid_));
    const int tid = tid_, wid = __builtin_amdgcn_readfirstlane(tid >> 6), lane = tid & 63, wr = wid >> 2, wc = wid & 3, fr = lane & 15, fq = lane >> 4;
    const int K = g.K, nt = K / BK;
    unsigned voffA[2], voffB[2];
#pragma unroll
    for (int i = 0; i < 2; ++i) { int R, C; stage_rc(tid * 16 + i * 8192, R, C); const int Rb = Epi::PERM ? ((R & ~31) + perm32(R & 31)) : R;
        voffA[i] = (unsigned)(R * K + C) * 2u; voffB[i] = (unsigned)(Rb * K + C) * 2u; }
    const size_t kstep = (size_t)(BK * 2);
    const size_t hstep = (size_t)HALF * K * 2;
    const size_t tstep = 2 * hstep;
    const unsigned ldsw = (unsigned)wid * 1024u;
    const int aoff = lds_byte(wr * 64 + fr, fq * 8), boff = lds_byte(wc * 32 + fr, fq * 8);
#define PG8_SA(b, h) (((b) * 2 + (h)) * HTB)
#define PG8_SB(b, h) ((4 + (b) * 2 + (h)) * HTB)
#define PG8_STAGE(bufoff, gbase, voff) do { _Pragma("unroll") for (int _i = 0; _i < 2; ++_i) \
        __builtin_amdgcn_global_load_lds((const unsigned*)((const char*)(gbase) + (voff)[_i]), (PG8_LAS unsigned*)(lds + (bufoff) + ldsw + _i * 8192), 16, 0, 0); } while (0)
#define PG8_LDA(dst, b, h) do { _Pragma("unroll") for (int m = 0; m < 4; ++m) _Pragma("unroll") for (int k = 0; k < 2; ++k) dst[m][k] = *(const PG8_LAS bf16x8*)(lds + PG8_SA(b, h) + aoff + m * 2048 + k * 1024); } while (0)
#define PG8_LDB(dst, b, h) do { _Pragma("unroll") for (int n = 0; n < 2; ++n) _Pragma("unroll") for (int k = 0; k < 2; ++k) dst[n][k] = *(const PG8_LAS bf16x8*)(lds + PG8_SB(b, h) + boff + n * 2048 + k * 1024); } while (0)
#define PG8_MMA(ai, bj, At, Bt) do { __builtin_amdgcn_s_setprio(1); _Pragma("unroll") for (int m = 0; m < 4; ++m) _Pragma("unroll") for (int n = 0; n < 2; ++n) _Pragma("unroll") for (int k = 0; k < 2; ++k) \
        acc[ai][bj][m][n] = __builtin_amdgcn_mfma_f32_16x16x32_bf16(Bt[n][k], At[m][k], acc[ai][bj][m][n], 0, 0, 0); __builtin_amdgcn_s_setprio(0); } while (0)
#define PG8_WAIT_V(n) asm volatile("s_waitcnt vmcnt(" #n ")" ::: "memory")
#define PG8_WAIT_L(n) asm volatile("s_waitcnt lgkmcnt(" #n ")" ::: "memory")
#define PG8_BAR __builtin_amdgcn_s_barrier()
#define PG8_SCHED __builtin_amdgcn_sched_barrier(0)
    Unit cur, nxt; int ui = 0;
    if (!S.next(0, cur)) return;
    f32x4 acc[2][2][4][2];
#pragma unroll
    for (int a = 0; a < 2; ++a)
#pragma unroll
        for (int b = 0; b < 2; ++b)
#pragma unroll
            for (int m = 0; m < 4; ++m)
#pragma unroll
                for (int n = 0; n < 2; ++n) acc[a][b][m][n] = (f32x4){0.f, 0.f, 0.f, 0.f};
    bf16x8 At[4][2], B0[2][2], B1[2][2];
    const char* cA = (const char*)g.A + (size_t)cur.pm * tstep; const char* cB = (const char*)g.Bt + (size_t)cur.pn * tstep;
    S.a_ready(cur);
    if constexpr (SP2) {
        PG8_STAGE(PG8_SB(0, 0), cB, voffB); PG8_STAGE(PG8_SB(0, 1), cB + hstep, voffB); PG8_STAGE(PG8_SA(0, 0), cA, voffA); PG8_STAGE(PG8_SA(0, 1), cA + hstep, voffA);
        if (wr == 1) PG8_BAR;
        PG8_WAIT_V(2); PG8_BAR;
        PG8_STAGE(PG8_SB(1, 0), cB + kstep, voffB); PG8_STAGE(PG8_SA(1, 0), cA + kstep, voffA); PG8_STAGE(PG8_SB(1, 1), cB + hstep + kstep, voffB);
        PG8_WAIT_V(6); PG8_BAR;
    } else {
        PG8_STAGE(PG8_SB(0, 0), cB, voffB); PG8_STAGE(PG8_SA(0, 0), cA, voffA); PG8_STAGE(PG8_SB(0, 1), cB + hstep, voffB); PG8_STAGE(PG8_SA(0, 1), cA + hstep, voffA);
        if (wr == 1) PG8_BAR;
        PG8_WAIT_V(4); PG8_BAR;
        PG8_STAGE(PG8_SB(1, 0), cB + kstep, voffB); PG8_STAGE(PG8_SA(1, 0), cA + kstep, voffA); PG8_STAGE(PG8_SB(1, 1), cB + hstep + kstep, voffB);
        PG8_WAIT_V(6); PG8_BAR;
    }
    for (;;) {
        const bool has_next = S.next(ui + 1, nxt);
        const char* nA = has_next ? (const char*)g.A + (size_t)nxt.pm * tstep : cA; const char* nB = has_next ? (const char*)g.Bt + (size_t)nxt.pn * tstep : cB;
        for (int t = 0; t < nt; t += 2) {
            const bool last = (t == nt - 2);
            const char* a1 = cA + (size_t)(t + 1) * kstep;
            const char* a2 = last ? nA : cA + (size_t)(t + 2) * kstep; const char* b2 = last ? nB : cB + (size_t)(t + 2) * kstep;
            const char* a3 = a2 + kstep; const char* b3 = b2 + kstep;
            if (last && has_next) S.a_ready(nxt);
            if constexpr (SP2) {
            PG8_LDB(B0, 0, 0); PG8_LDB(B1, 0, 1); PG8_SCHED; PG8_LDA(At, 0, 0); PG8_STAGE(PG8_SA(1, 1), a1 + hstep, voffA);
            PG8_WAIT_V(8); PG8_WAIT_L(0); PG8_BAR; PG8_MMA(0, 0, At, B0); PG8_MMA(0, 1, At, B1); PG8_BAR; PG8_SCHED;
            PG8_LDA(At, 0, 1); PG8_STAGE(PG8_SB(0, 0), b2, voffB); PG8_STAGE(PG8_SB(0, 1), b2 + hstep, voffB); PG8_STAGE(PG8_SA(0, 0), a2, voffA);
            PG8_WAIT_V(8); PG8_WAIT_L(0); PG8_BAR; PG8_MMA(1, 0, At, B0); PG8_MMA(1, 1, At, B1); PG8_BAR; PG8_SCHED;
            PG8_LDB(B0, 1, 0); PG8_LDB(B1, 1, 1); PG8_SCHED; PG8_LDA(At, 1, 0); PG8_STAGE(PG8_SA(0, 1), a2 + hstep, voffA);
            PG8_WAIT_V(8); PG8_WAIT_L(0); PG8_BAR; PG8_MMA(0, 0, At, B0); PG8_MMA(0, 1, At, B1); PG8_BAR; PG8_SCHED;
            PG8_LDA(At, 1, 1); PG8_STAGE(PG8_SB(1, 0), b3, voffB); PG8_STAGE(PG8_SB(1, 1), b3 + hstep, voffB); PG8_STAGE(PG8_SA(1, 0), a3, voffA);
            PG8_WAIT_V(8); PG8_WAIT_L(0); PG8_BAR; PG8_MMA(1, 0, At, B0); PG8_MMA(1, 1, At, B1); PG8_BAR; PG8_SCHED;
            } else {
            PG8_LDB(B0, 0, 0); PG8_SCHED; PG8_LDA(At, 0, 0); PG8_STAGE(PG8_SA(1, 1), a1 + hstep, voffA);
            PG8_WAIT_L(8); PG8_BAR; PG8_WAIT_L(0); PG8_MMA(0, 0, At, B0); PG8_BAR; PG8_SCHED;
            PG8_LDB(B1, 0, 1); PG8_STAGE(PG8_SB(0, 0), b2, voffB);
            PG8_BAR; PG8_WAIT_L(0); PG8_MMA(0, 1, At, B1); PG8_BAR;
            PG8_LDA(At, 0, 1); PG8_STAGE(PG8_SA(0, 0), a2, voffA);
            PG8_BAR; PG8_WAIT_L(0); PG8_MMA(1, 0, At, B0); PG8_BAR; PG8_SCHED;
            PG8_STAGE(PG8_SB(0, 1), b2 + hstep, voffB);
            PG8_WAIT_V(6); PG8_BAR; PG8_MMA(1, 1, At, B1); PG8_BAR;
            PG8_LDB(B0, 1, 0); PG8_SCHED; PG8_LDA(At, 1, 0); PG8_STAGE(PG8_SA(0, 1), a2 + hstep, voffA);
            PG8_WAIT_L(8); PG8_BAR; PG8_WAIT_L(0); PG8_MMA(0, 0, At, B0); PG8_BAR; PG8_SCHED;
            PG8_LDB(B1, 1, 1); PG8_STAGE(PG8_SB(1, 0), b3, voffB);
            PG8_BAR; PG8_WAIT_L(0); PG8_MMA(0, 1, At, B1); PG8_BAR;
            PG8_LDA(At, 1, 1); PG8_STAGE(PG8_SA(1, 0), a3, voffA);
            PG8_BAR; PG8_WAIT_L(0); PG8_MMA(1, 0, At, B0); PG8_BAR; PG8_SCHED;
            PG8_STAGE(PG8_SB(1, 1), b3 + hstep, voffB);
            PG8_WAIT_V(6); PG8_BAR; PG8_MMA(1, 1, At, B1); PG8_BAR;
            }
        }
        if constexpr (ALIGN_EPI) { if (wr == 0) PG8_BAR; }
        if constexpr (!Epi::AFTER_DRAIN) { if (!Sched::TWICE || (ui & 1)) { E(acc, cur, wr, wc, fr, fq); S.done(cur); } }
        if (!has_next) break;
#pragma unroll
        for (int a = 0; a < 2; ++a)
#pragma unroll
            for (int b = 0; b < 2; ++b)
#pragma unroll
                for (int m = 0; m < 4; ++m)
#pragma unroll
                    for (int n = 0; n < 2; ++n) acc[a][b][m][n] = (f32x4){0.f, 0.f, 0.f, 0.f};
        cur = nxt; cA = nA; cB = nB; ++ui;
        if constexpr (ALIGN_EPI) { if (wr == 1) PG8_BAR; }
    }
    PG8_WAIT_V(0);
    if constexpr (!ALIGN_EPI) { if (wr == 0) PG8_BAR; }
    PG8_BAR;
    if constexpr (Epi::AFTER_DRAIN) { E.fused(acc, cur, wr, wc, fr, fq, lds, wid, lane); S.done(cur); }
#undef PG8_SA
#undef PG8_SB
#undef PG8_STAGE
#undef PG8_LDA
#undef PG8_LDB
#undef PG8_MMA
#undef PG8_WAIT_V
#undef PG8_WAIT_L
#undef PG8_BAR
#undef PG8_SCHED
}
}

constexpr int NWAVES = 8, NTHREADS = NWAVES * 64;
constexpr int BATCH = 8, SEQ = 4096, D = 1024, M = BATCH * SEQ, FF = 2816, DEPTH = 4;
constexpr int EVEN_IN = 3584, GLA_IN = 3088, GLA_INP = 3328;
static_assert(M == pg8::MROWS, "row count");
constexpr int E_RQ = 0, E_RK = 512, E_RV = 1024, E_RG = 1536, E_DQ = 2048, E_DK = 2560, E_DV = 3072;
constexpr int G_Q = 0, G_K = 512, G_V = 1024, G_R = 2048, G_A = 3072;
constexpr float EPS = 1e-6f;

constexpr size_t MiB = 1u << 20;
constexpr size_t WS_CTL = 0, CTL_ZERO_BYTES = 1 * MiB;
constexpr size_t WS_SSP = 1 * MiB;
constexpr size_t WS_TAB = 3 * MiB;
constexpr size_t TAB_RC = WS_TAB, TAB_RS = WS_TAB + 1 * MiB, TAB_DC = WS_TAB + 2 * MiB, TAB_DS = WS_TAB + 2 * MiB + 128 * 1024;
constexpr size_t WS_W = 8 * MiB;
constexpr size_t W_GU0 = WS_W, W_D0 = W_GU0 + (size_t)2 * FF * D * 2, W_GU1 = W_D0 + (size_t)D * FF * 2, W_D1 = W_GU1 + (size_t)2 * FF * D * 2,
                 W_IN = W_D1 + (size_t)D * FF * 2, W_OUT = W_IN + (size_t)EVEN_IN * D * 2, W_END = W_OUT + (size_t)D * D * 2;
constexpr size_t WS_XB = 56 * MiB;
constexpr size_t WS_ACT = 120 * MiB;
constexpr size_t WS_CAT = 344 * MiB;
constexpr size_t WS_END = 408 * MiB;
static_assert(W_END <= WS_XB && WS_XB + (size_t)M * D * 2 <= WS_ACT && WS_ACT + (size_t)M * EVEN_IN * 2 <= WS_CAT && WS_CAT + (size_t)M * D * 2 <= WS_END, "d_ws map");
constexpr int CW_BAR = 4096;

constexpr int RING_OFF = 0, RING_BYTES = 131072;
constexpr int LDSCTL_OFF = 161792, MISC_OFF = LDSCTL_OFF + 320, PTR_OFF = LDSCTL_OFF + 1024;
constexpr int LDS_BYTES = 163840;
static_assert(PTR_OFF + 19 * 8 <= LDS_BYTES && RING_BYTES <= LDSCTL_OFF, "LDS map");

#define GAS __attribute__((address_space(1)))
#define LAS __attribute__((address_space(3)))
typedef unsigned short bf16;
typedef unsigned v4u __attribute__((ext_vector_type(4)));
typedef float f32x4 __attribute__((ext_vector_type(4)));
typedef short bf16x8 __attribute__((ext_vector_type(8)));
typedef GAS unsigned gu32;
typedef GAS unsigned long long gu64;
#define RLX_AGENT __ATOMIC_RELAXED, __HIP_MEMORY_SCOPE_AGENT
#define LDS_WAIT() asm volatile("s_waitcnt lgkmcnt(0)" ::: "memory")
#define VM_WAIT() asm volatile("s_waitcnt vmcnt(0)" ::: "memory")
__device__ __forceinline__ unsigned long long rt() { return __builtin_amdgcn_s_memrealtime(); }
__device__ __forceinline__ unsigned f2bf(float f) { unsigned u = __builtin_bit_cast(unsigned, f); return (u + 0x7fffu + ((u >> 16) & 1u)) >> 16; }
__device__ __forceinline__ unsigned pk2(float lo, float hi) { return f2bf(lo) | (f2bf(hi) << 16); }

#define XB_TMO      128
#define XB_XCNT(j)  (256  + 64 * (j))
#define XB_XSUB(j)  (1280 + 64 * (j))
#define XB_XGEN(j)  (2304 + 64 * (j))
#define XB_TOP      3328
#define XB_TOPGEN   3392
#define XCD_BAR_WORDS 3456
#define XB_SPIN_CAP (1u << 18)

__device__ __forceinline__ unsigned xb_ld(unsigned* p)              { return __hip_atomic_load(p, __ATOMIC_RELAXED, __HIP_MEMORY_SCOPE_AGENT); }
__device__ __forceinline__ unsigned xb_add(unsigned* p, unsigned v) { return __hip_atomic_fetch_add(p, v, __ATOMIC_RELAXED, __HIP_MEMORY_SCOPE_AGENT); }
__device__ __forceinline__ unsigned xb_xcc_id() { return (unsigned)__builtin_amdgcn_s_getreg((3 << 11) | 20) & 0xFu; }
#define XB_SPIN(cond, bar) do { unsigned _sp = 0; while (cond) { __builtin_amdgcn_s_sleep(1); \
    if ((++_sp & 255u) == 0u) { if (xb_ld(&(bar)[XB_TMO])) break; if (_sp > XB_SPIN_CAP) { atomicAdd(&(bar)[XB_TMO], 1u); break; } } } } while (0)

struct XcdBarrier {
    unsigned* bar; unsigned x;
    volatile LAS unsigned* st;
};

__device__ __forceinline__ XcdBarrier xcd_barrier_post(unsigned* bar, volatile LAS unsigned* st, int tid) {
    XcdBarrier b; b.bar = bar; b.x = xb_xcc_id(); b.st = st;
    if (tid == 0) (void)xb_add(&bar[XB_XCNT(b.x)], 1u);
    return b;
}
__device__ __forceinline__ void xcd_barrier_complete(unsigned* bar, unsigned x, unsigned& nloc, unsigned& nx) {
    const unsigned G = gridDim.x * gridDim.y * gridDim.z;
    unsigned sum, cnt, mine, sp = 0u;
    for (;;) {
        sum = 0u; cnt = 0u; mine = 0u;
#pragma unroll
        for (unsigned j = 0; j < 16; ++j) { const unsigned c = xb_ld(&bar[XB_XCNT(j)]); sum += c; cnt += (c > 0u) ? 1u : 0u; mine = (j == x) ? c : mine; }
        if (sum == G) break;
        __builtin_amdgcn_s_sleep(1);
        if ((++sp & 255u) == 0u) { if (xb_ld(&bar[XB_TMO])) break; if (sp > XB_SPIN_CAP) { atomicAdd(&bar[XB_TMO], 1u); break; } }
    }
    nloc = mine > 0u ? mine : 1u; nx = cnt > 0u ? cnt : 1u;
}

__device__ __forceinline__ void xcd_barrier(const XcdBarrier& b, int tid) {
    asm volatile("s_waitcnt vmcnt(0)" ::: "memory");
    __syncthreads();
    if (tid == 0) {
        unsigned* bar = b.bar;
        __builtin_amdgcn_s_waitcnt(0);
        unsigned nloc = b.st[0], nx = b.st[1];
        if (nloc == 0u) { xcd_barrier_complete(bar, b.x, nloc, nx); b.st[0] = nloc; b.st[1] = nx; }
        const unsigned old = xb_add(&bar[XB_XSUB(b.x)], 1u);
        const unsigned gen = old / nloc;
        if (old + 1u == (gen + 1u) * nloc) {
            __builtin_amdgcn_fence(__ATOMIC_RELEASE, "agent");
            asm volatile("s_waitcnt vmcnt(0)" ::: "memory");
            const unsigned og = xb_add(&bar[XB_TOP], 1u);
            const unsigned tg = og / nx;
            if (og + 1u == (tg + 1u) * nx) xb_add(&bar[XB_TOPGEN], 1u);
            else XB_SPIN(xb_ld(&bar[XB_TOPGEN]) == tg, bar);
            __builtin_amdgcn_fence(__ATOMIC_ACQUIRE, "agent");
            xb_add(&bar[XB_XGEN(b.x)], 1u);
            asm volatile("s_waitcnt vmcnt(0)" ::: "memory");
        } else {
            XB_SPIN(xb_ld(&bar[XB_XGEN(b.x)]) == gen, bar);
            __builtin_amdgcn_fence(__ATOMIC_ACQUIRE, "agent");
            asm volatile("s_waitcnt vmcnt(0)" ::: "memory");
        }
    }
    __syncthreads();
}

__constant__ float RET_FREQ[64] = {1.000000000e+00f, 8.639884591e-01f, 7.464760542e-01f, 6.449466944e-01f, 5.572264791e-01f, 4.814372361e-01f, 4.159561992e-01f, 3.593813777e-01f, 3.105013371e-01f, 2.682695687e-01f, 2.317818105e-01f, 2.002568096e-01f, 1.730195731e-01f, 1.494869143e-01f, 1.291549653e-01f, 1.115883961e-01f, 9.641107172e-02f, 8.329805732e-02f, 7.196855545e-02f, 6.218000501e-02f, 5.372280627e-02f, 4.641588405e-02f, 4.010278732e-02f, 3.464834765e-02f, 2.993577160e-02f, 2.586415969e-02f, 2.234633639e-02f, 1.930697635e-02f, 1.668100432e-02f, 1.441219542e-02f, 1.245197095e-02f, 1.075835899e-02f, 9.295095690e-03f, 8.030855097e-03f, 6.938565988e-03f, 5.994840991e-03f, 5.179473665e-03f, 4.475005437e-03f, 3.866352839e-03f, 3.340484342e-03f, 2.886139788e-03f, 2.493591513e-03f, 2.154434333e-03f, 1.861406374e-03f, 1.608233666e-03f, 1.389495330e-03f, 1.200507861e-03f, 1.037224894e-03f, 8.961503627e-04f, 7.742635789e-04f, 6.689548027e-04f, 5.779692437e-04f, 4.993587499e-04f, 4.314401885e-04f, 3.727593285e-04f, 3.220597573e-04f, 2.782559313e-04f, 2.404099068e-04f, 2.077113895e-04f, 1.794602431e-04f, 1.550515735e-04f, 1.339627634e-04f, 1.157422885e-04f, 9.999999747e-05f};
__constant__ float ROPE_FREQ[8] = {1.000000000e+00f, 1.939227432e-01f, 3.760603070e-02f, 7.292664610e-03f, 1.414213562e-03f, 2.742481884e-04f, 5.318295734e-05f, 1.031338525e-05f};
struct Args { const float* in[17]; float* out; unsigned char* ws; };
enum { I_X = 0, I_PRE_NORM = 1, I_PRE_WG = 2, I_PRE_WU = 3, I_PRE_WD = 4, I_MIX_NORM = 5, I_AB_IN = 6, I_AB_OUT = 7, I_GLA_IN = 8, I_GLA_A2 = 9, I_GLA_BA = 10, I_GLA_OUT = 11,
       I_POST_NORM = 12, I_POST_WG = 13, I_POST_WU = 14, I_POST_WD = 15, I_FINAL = 16, I_OUT = 17, I_WS = 18, N_PTRS = 19 };
struct Frame {
    LAS unsigned char* lds;
    int tid, lane, wave, G, bid;
};
__device__ __forceinline__ unsigned char* tabp(const Frame& F, int idx) {
    int off_ = PTR_OFF + 8 * idx; asm volatile("" : "+s"(off_));
    const volatile LAS unsigned* T = (const volatile LAS unsigned*)(F.lds + off_);
    const unsigned lo = __builtin_amdgcn_readfirstlane(T[0]), hi = __builtin_amdgcn_readfirstlane(T[1]);
    GAS unsigned char* gp_ = (GAS unsigned char*)(((unsigned long long)hi << 32) | (unsigned long long)lo);
    return (unsigned char*)gp_;
}
#define AP(idx) ((const float*)tabp(F, idx))
#define WSP() tabp(F, I_WS)
#define OUTP() ((float*)tabp(F, I_OUT))
__device__ __forceinline__ int lnd(int v) { asm volatile("" : "+s"(v)); return v; }
__device__ __forceinline__ int hw_lane() { return (int)__builtin_amdgcn_mbcnt_hi(~0u, __builtin_amdgcn_mbcnt_lo(~0u, 0u)); }
__device__ __forceinline__ Frame relaunder(const Frame& F0) { Frame F = F0; int t_ = threadIdx.x; asm volatile("" : "+v"(t_)); asm volatile("" : "+s"(F.bid)); F.tid = t_; F.lane = F.tid & 63; F.wave = __builtin_amdgcn_readfirstlane(F.tid >> 6);
    unsigned lb_ = 0u; asm volatile("" : "+s"(lb_)); F.lds = F0.lds + lb_; return F; }
__device__ __forceinline__ float wave_sum(float v) {
    v += xsw<1>(v); v += xsw<2>(v); v += xsw<4>(v); v += xsw<8>(v); v += xsw<16>(v);
    return sum32(v);
}
__device__ __forceinline__ float bf2f(bf16 h) { return __builtin_bit_cast(float, (unsigned)h << 16); }
__device__ __forceinline__ float bflo(unsigned w) { return __builtin_bit_cast(float, w << 16); }
__device__ __forceinline__ float bfhi(unsigned w) { return __builtin_bit_cast(float, w & 0xffff0000u); }
__device__ __forceinline__ bf16 f2bf_rne(float f) { return (bf16)f2bf(f); }

__device__ __forceinline__ void tr_item(const float* W, int K, int N, int Npad, const float* gain, bf16* WT, int gu, LAS float* scr, int item, int lane) {
    const int nblk = Npad / 32, kb = item / nblk, nb = item % nblk, k0 = 64 * kb, n0 = 32 * nb;
    {
        const int c4 = lane & 7; const bool ok = n0 + 4 * c4 < N;
        const GAS float* src = (const GAS float*)W + (size_t)(k0 + (lane >> 3)) * N + n0 + 4 * c4;
        f32x4 v[8];
#pragma unroll
        for (int i = 0; i < 8; ++i) v[i] = ok ? *(const GAS f32x4*)(src + (size_t)(8 * i) * N) : (f32x4){0.f, 0.f, 0.f, 0.f};
#pragma unroll
        for (int i = 0; i < 8; ++i) { const int kk = 8 * i + (lane >> 3); const float gn = gain ? ((const GAS float*)gain)[k0 + kk] : 1.0f; LAS float* s = scr + kk * 33 + 4 * c4;
            s[0] = v[i][0] * gn; s[1] = v[i][1] * gn; s[2] = v[i][2] * gn; s[3] = v[i][3] * gn; }
    }
    LDS_WAIT(); asm volatile("" ::: "memory");
    const int c = lane & 7;
#pragma unroll
    for (int j = 0; j < 4; ++j) { const int n = (lane >> 3) + 8 * j; const LAS float* s = scr + (8 * c) * 33 + n;
        v4u o; o.x = pk2(s[0 * 33], s[1 * 33]); o.y = pk2(s[2 * 33], s[3 * 33]); o.z = pk2(s[4 * 33], s[5 * 33]); o.w = pk2(s[6 * 33], s[7 * 33]);
        int drow = n0 + n; if (gu) drow = (drow >> 7) * 256 + (drow & 127) + (gu == 2 ? 128 : 0);
        *(GAS v4u*)(WT + (size_t)drow * K + k0 + 8 * c) = o; }
    LDS_WAIT(); asm volatile("" ::: "memory");
}
__device__ __forceinline__ void convert_weights(const Frame& F0, int l) {
    const Frame F = relaunder(F0);
    LAS float* scr = (LAS float*)(F.lds + RING_OFF + F.wave * 16384);
    const int gw = F.bid * NWAVES + F.wave, NGW = F.G * NWAVES;
    unsigned char* ws = WSP();
    constexpr int I_G = (D / 64) * (FF / 32), I_DN = (FF / 64) * (D / 32), I_O = (D / 64) * (D / 32);
    const bool odd = (l & 1) != 0; const int li = l >> 1;
    const int nin = odd ? GLA_IN : EVEN_IN, ninp = odd ? GLA_INP : EVEN_IN; const int I_IN = (D / 64) * (ninp / 32);
    const float* win = odd ? AP(I_GLA_IN) + (size_t)li * D * GLA_IN : AP(I_AB_IN) + (size_t)li * D * EVEN_IN;
    const float* wout = odd ? AP(I_GLA_OUT) + (size_t)li * D * D : AP(I_AB_OUT) + (size_t)li * D * D;
    const size_t fo = (size_t)l * D * FF;
    const int NITEMS = 6 * I_G + I_IN + I_O;
    static_assert(I_G == I_DN, "item counts");
    for (int it = gw; it < NITEMS; it += NGW) {
        int r = it;
        if (r < I_G) { tr_item(AP(I_PRE_WG) + fo, D, FF, FF, AP(I_PRE_NORM) + l * D, (bf16*)(ws + W_GU0), 1, scr, r, F.lane); continue; } r -= I_G;
        if (r < I_G) { tr_item(AP(I_PRE_WU) + fo, D, FF, FF, AP(I_PRE_NORM) + l * D, (bf16*)(ws + W_GU0), 2, scr, r, F.lane); continue; } r -= I_G;
        if (r < I_G) { tr_item(AP(I_PRE_WD) + fo, FF, D, D, nullptr, (bf16*)(ws + W_D0), 0, scr, r, F.lane); continue; } r -= I_G;
        if (r < I_G) { tr_item(AP(I_POST_WG) + fo, D, FF, FF, AP(I_POST_NORM) + l * D, (bf16*)(ws + W_GU1), 1, scr, r, F.lane); continue; } r -= I_G;
        if (r < I_G) { tr_item(AP(I_POST_WU) + fo, D, FF, FF, AP(I_POST_NORM) + l * D, (bf16*)(ws + W_GU1), 2, scr, r, F.lane); continue; } r -= I_G;
        if (r < I_G) { tr_item(AP(I_POST_WD) + fo, FF, D, D, nullptr, (bf16*)(ws + W_D1), 0, scr, r, F.lane); continue; } r -= I_G;
        if (r < I_IN) { tr_item(win, D, nin, ninp, AP(I_MIX_NORM) + l * D, (bf16*)(ws + W_IN), 0, scr, r, F.lane); continue; } r -= I_IN;
        tr_item(wout, D, D, D, nullptr, (bf16*)(ws + W_OUT), 0, scr, r, F.lane);
    }
}
__device__ __forceinline__ void prologue_rows(const Frame& F0) {
    const Frame F = relaunder(F0);
    unsigned char* ws = WSP();
    const int gw = F.bid * NWAVES + F.wave, NGW = F.G * NWAVES;
    bf16* XB = (bf16*)(ws + WS_XB); float* ssp = (float*)(ws + WS_SSP);
    for (int m = gw; m < M; m += NGW) {
        const GAS f32x4* xr = (const GAS f32x4*)(AP(I_X) + (size_t)m * D) + F.lane;
        GAS unsigned long long* o8 = (GAS unsigned long long*)(XB + (size_t)m * D) + F.lane;
        float s = 0.f;
#pragma unroll
        for (int j = 0; j < 4; ++j) { const f32x4 v = xr[64 * j]; s += (v.x * v.x + v.y * v.y) + (v.z * v.z + v.w * v.w);
            o8[64 * j] = (unsigned long long)pk2(v.x, v.y) | ((unsigned long long)pk2(v.z, v.w) << 32); }
        s = wave_sum(s);
        if (F.lane < 16) ssp[(size_t)m * 16 + F.lane] = (F.lane == 0) ? s : 0.f;
    }
    const int gt = F.bid * NTHREADS + F.tid, NGT = F.G * NTHREADS;
    float* rc = (float*)(ws + TAB_RC); float* rsn = (float*)(ws + TAB_RS); float* dc = (float*)(ws + TAB_DC); float* ds = (float*)(ws + TAB_DS);
    for (int e = gt; e < SEQ * 64; e += NGT) { const int t = e >> 6, i = e & 63; const float ang = (float)t * RET_FREQ[i];
        double rev = (double)ang * 0.15915494309189535; rev -= __builtin_rint(rev); const float r = (float)rev;
        rc[e] = __builtin_amdgcn_cosf(r); rsn[e] = __builtin_amdgcn_sinf(r); }
    for (int e = gt; e < SEQ * 8; e += NGT) { const int t = e >> 3, i = e & 7; const float ang = (float)t * ROPE_FREQ[i];
        double rev = (double)ang * 0.15915494309189535; rev -= __builtin_rint(rev); const float r = (float)rev;
        dc[e] = __builtin_amdgcn_cosf(r); ds[e] = __builtin_amdgcn_sinf(r); }
}

__device__ __forceinline__ void even_prep(const Frame& F0) {
    const Frame F = relaunder(F0);
    unsigned char* ws = WSP();
    const int gw = F.bid * NWAVES + F.wave, NGW = F.G * NWAVES;
    bf16* P = (bf16*)(ws + WS_ACT);
    const float* rc = (const float*)(ws + TAB_RC); const float* rsn = (const float*)(ws + TAB_RS); const float* dc = (const float*)(ws + TAB_DC); const float* ds = (const float*)(ws + TAB_DS);
    for (int m = gw; m < M; m += NGW) {
        const int pos = m & (SEQ - 1); bf16* row = P + (size_t)m * EVEN_IN;
        const float c = rc[pos * 64 + F.lane], s = rsn[pos * 64 + F.lane];
#pragma unroll
        for (int h = 0; h < 4; ++h) {
            { bf16* p1 = row + E_RQ + h * 128 + F.lane; bf16* p2 = p1 + 64; const float x1 = bf2f(*p1), x2 = bf2f(*p2); *p1 = f2bf_rne(x1 * c - x2 * s); *p2 = f2bf_rne(x2 * c + x1 * s); }
            { bf16* p1 = row + E_RK + h * 128 + F.lane; bf16* p2 = p1 + 64; const float x1 = bf2f(*p1), x2 = bf2f(*p2);
              *p1 = f2bf_rne((x1 * c - x2 * s) * 0.08838834764831845f); *p2 = f2bf_rne((x2 * c + x1 * s) * 0.08838834764831845f); }
        }
        { const int h = F.lane >> 3, i = F.lane & 7; const float c2 = dc[pos * 8 + i], s2 = ds[pos * 8 + i];
          { bf16* p1 = row + E_DQ + h * 64 + i; bf16* p2 = p1 + 8; const float x1 = bf2f(*p1), x2 = bf2f(*p2); *p1 = f2bf_rne(x1 * c2 - x2 * s2); *p2 = f2bf_rne(x2 * c2 + x1 * s2); }
          { bf16* p1 = row + E_DK + h * 64 + i; bf16* p2 = p1 + 8; const float x1 = bf2f(*p1), x2 = bf2f(*p2); *p1 = f2bf_rne(x1 * c2 - x2 * s2); *p2 = f2bf_rne(x2 * c2 + x1 * s2); } }
    }
}
__device__ __forceinline__ void even_core(const Frame& F0) {
    const Frame F = relaunder(F0);
    unsigned char* ws = WSP();
    const bf16* P = (const bf16*)(ws + WS_ACT);
    if (F.bid < 128) {
        const int b = F.bid >> 4, h = (F.bid >> 2) & 3, eg = F.bid & 3, e = eg * 32 + (F.tid >> 4), dq = F.tid & 15;
        const float g = 1.0f - exp2f(-5.0f - (float)h);
        float* oraw = (float*)(ws + WS_XB);
        const bf16* base = P + (size_t)b * SEQ * EVEN_IN;
        float S[8];
#pragma unroll
        for (int i = 0; i < 8; ++i) S[i] = 0.f;
        v4u qn = *(const GAS v4u*)(base + E_RQ + h * 128 + dq * 8), kn = *(const GAS v4u*)(base + E_RK + h * 128 + dq * 8); bf16 vn = base[E_RV + h * 128 + e];
        for (int t = 0; t < SEQ; ++t) {
            const v4u q = qn, k = kn; const float v = bf2f(vn);
            if (t + 1 < SEQ) { const bf16* nb = base + (size_t)(t + 1) * EVEN_IN; qn = *(const GAS v4u*)(nb + E_RQ + h * 128 + dq * 8); kn = *(const GAS v4u*)(nb + E_RK + h * 128 + dq * 8); vn = nb[E_RV + h * 128 + e]; }
            float o = 0.f;
#pragma unroll
            for (int i = 0; i < 4; ++i) { const unsigned qw = q[i], kw = k[i];
                S[2 * i] = g * S[2 * i] + bflo(kw) * v; S[2 * i + 1] = g * S[2 * i + 1] + bfhi(kw) * v;
                o += bflo(qw) * S[2 * i]; o += bfhi(qw) * S[2 * i + 1]; }
            o += xsw<1>(o); o += xsw<2>(o); o += xsw<4>(o); o += xsw<8>(o);
            if (dq == 0) oraw[((size_t)b * SEQ + t) * 512 + h * 128 + e] = o;
        }
    } else {
        bf16* CAT = (bf16*)(ws + WS_CAT);
        for (int it = F.bid - 128; it < BATCH * (SEQ / 64); it += F.G - 128) {
            const int b = it >> 6, t = (it & 63) * 64 + F.lane, h = F.wave;
            const bf16* base = P + (size_t)b * SEQ * EVEN_IN;
            float q[64];
            { const GAS v4u* qp = (const GAS v4u*)(base + (size_t)t * EVEN_IN + E_DQ + h * 64);
#pragma unroll
              for (int j = 0; j < 8; ++j) { const v4u w = qp[j];
#pragma unroll
                  for (int i = 0; i < 4; ++i) { q[8 * j + 2 * i] = bflo(w[i]) * (0.125f * 1.4426950408889634f); q[8 * j + 2 * i + 1] = bfhi(w[i]) * (0.125f * 1.4426950408889634f); } } }
            float o[64];
#pragma unroll
            for (int i = 0; i < 64; ++i) o[i] = 0.f;
            float mx = -INFINITY, l = 0.f;
            for (int p = 0; p < 3; ++p) {
                const int dil = (p == 0) ? 1 : (p == 1) ? 4 : 16;
                for (int j = 0; j <= 128; ++j) {
                    const int tk = t - j * dil;
                    if (tk >= 0) {
                        const GAS v4u* kp = (const GAS v4u*)(base + (size_t)tk * EVEN_IN + E_DK + h * 64);
                        const GAS v4u* vp = (const GAS v4u*)(base + (size_t)tk * EVEN_IN + E_DV + h * 64);
                        float s = 0.f;
#pragma unroll
                        for (int jj = 0; jj < 8; ++jj) { const v4u w = kp[jj];
#pragma unroll
                            for (int i = 0; i < 4; ++i) { s += q[8 * jj + 2 * i] * bflo(w[i]); s += q[8 * jj + 2 * i + 1] * bfhi(w[i]); } }
                        const float mn = fmaxf(mx, s), corr = __builtin_amdgcn_exp2f(mx - mn), pe = __builtin_amdgcn_exp2f(s - mn);
                        l = l * corr + pe; mx = mn;
#pragma unroll
                        for (int jj = 0; jj < 8; ++jj) { const v4u w = vp[jj];
#pragma unroll
                            for (int i = 0; i < 4; ++i) { o[8 * jj + 2 * i] = o[8 * jj + 2 * i] * corr + pe * bflo(w[i]); o[8 * jj + 2 * i + 1] = o[8 * jj + 2 * i + 1] * corr + pe * bfhi(w[i]); } }
                    }
                }
            }
            const float rl = 1.0f / l;
            GAS v4u* op = (GAS v4u*)(CAT + ((size_t)b * SEQ + t) * D + 512 + h * 64);
#pragma unroll
            for (int j = 0; j < 8; ++j) { v4u w; w.x = pk2(o[8 * j] * rl, o[8 * j + 1] * rl); w.y = pk2(o[8 * j + 2] * rl, o[8 * j + 3] * rl); w.z = pk2(o[8 * j + 4] * rl, o[8 * j + 5] * rl); w.w = pk2(o[8 * j + 6] * rl, o[8 * j + 7] * rl); op[j] = w; }
        }
    }
}
__device__ __forceinline__ void even_post(const Frame& F0) {
    const Frame F = relaunder(F0);
    unsigned char* ws = WSP();
    const int gw = F.bid * NWAVES + F.wave, NGW = F.G * NWAVES;
    const bf16* P = (const bf16*)(ws + WS_ACT); const float* oraw = (const float*)(ws + WS_XB); bf16* CAT = (bf16*)(ws + WS_CAT);
    for (int it = gw; it < M * 4; it += NGW) {
        const int m = it >> 2, h = it & 3;
        const float* op = oraw + (size_t)m * 512 + h * 128 + 2 * F.lane; const float o0 = op[0], o1 = op[1];
        const float mu = wave_sum(o0 + o1) * (1.0f / 128.0f); const float d0 = o0 - mu, d1 = o1 - mu;
        const float var = wave_sum(d0 * d0 + d1 * d1) * (1.0f / 128.0f); const float rstd = 1.0f / sqrtf(var + EPS);
        const unsigned gw2 = *(const unsigned*)(P + (size_t)m * EVEN_IN + E_RG + h * 128 + 2 * F.lane); const float g0 = bflo(gw2), g1 = bfhi(gw2);
        const float y0 = d0 * rstd * (g0 / (1.0f + expf(-g0))), y1 = d1 * rstd * (g1 / (1.0f + expf(-g1)));
        *(unsigned*)(CAT + (size_t)m * D + h * 128 + 2 * F.lane) = pk2(y0, y1);
    }
}
__device__ __forceinline__ void gla_prep(const Frame& F0, int li) {
    const Frame F = relaunder(F0);
    unsigned char* ws = WSP();
    const int gt = F.bid * NTHREADS + F.tid, NGT = F.G * NTHREADS;
    const bf16* P = (const bf16*)(ws + WS_ACT); float* A = (float*)(ws + WS_CAT);
    const float* w2 = AP(I_GLA_A2) + (size_t)li * 16 * 512; const float* ba = AP(I_GLA_BA) + (size_t)li * 512;
    for (int e = gt; e < M * 512; e += NGT) {
        const int m = e >> 9, c = e & 511; const bf16* al = P + (size_t)m * GLA_INP + G_A;
        float z = ba[c];
#pragma unroll
        for (int j = 0; j < 16; ++j) z += bf2f(al[j]) * w2[j * 512 + c];
        const float ls = fminf(z, 0.f) - log1pf(expf(-fabsf(z)));
        A[e] = expf(ls * (1.0f / 16.0f));
    }
}
__device__ __forceinline__ void gla_core(const Frame& F0) {
    const Frame F = relaunder(F0);
    unsigned char* ws = WSP();
    const bf16* P = (const bf16*)(ws + WS_ACT); const float* A = (const float*)(ws + WS_CAT); bf16* oraw = (bf16*)(ws + WS_XB);
    const int b = F.bid >> 5, h = (F.bid >> 3) & 3, eg = F.bid & 7, e = eg * 32 + (F.tid >> 4), dq = F.tid & 15;
    const bf16* base = P + (size_t)b * SEQ * GLA_INP; const float* abase = A + (size_t)b * SEQ * 512 + h * 128 + dq * 8;
    float S[8];
#pragma unroll
    for (int i = 0; i < 8; ++i) S[i] = 0.f;
    v4u qn = *(const GAS v4u*)(base + G_Q + h * 128 + dq * 8), kn = *(const GAS v4u*)(base + G_K + h * 128 + dq * 8); bf16 vn = base[G_V + h * 256 + e];
    f32x4 a0n = *(const GAS f32x4*)(abase), a1n = *(const GAS f32x4*)(abase + 4);
    for (int t = 0; t < SEQ; ++t) {
        const v4u q = qn, k = kn; const float v = bf2f(vn); const f32x4 a0 = a0n, a1 = a1n;
        if (t + 1 < SEQ) { const bf16* nb = base + (size_t)(t + 1) * GLA_INP; qn = *(const GAS v4u*)(nb + G_Q + h * 128 + dq * 8); kn = *(const GAS v4u*)(nb + G_K + h * 128 + dq * 8); vn = nb[G_V + h * 256 + e];
            a0n = *(const GAS f32x4*)(abase + (size_t)(t + 1) * 512); a1n = *(const GAS f32x4*)(abase + (size_t)(t + 1) * 512 + 4); }
        float o = 0.f;
#pragma unroll
        for (int i = 0; i < 4; ++i) { const unsigned qw = q[i], kw = k[i]; const float al = (i < 2) ? a0[2 * i] : a1[2 * i - 4], ah = (i < 2) ? a0[2 * i + 1] : a1[2 * i - 3];
            S[2 * i] = al * S[2 * i] + bflo(kw) * v; S[2 * i + 1] = ah * S[2 * i + 1] + bfhi(kw) * v;
            o += bflo(qw) * S[2 * i]; o += bfhi(qw) * S[2 * i + 1]; }
        o += xsw<1>(o); o += xsw<2>(o); o += xsw<4>(o); o += xsw<8>(o);
        if (dq == 0) oraw[((size_t)b * SEQ + t) * 1024 + h * 256 + e] = f2bf_rne(o * 0.08838834764831845f);
    }
}
__device__ __forceinline__ void gla_post(const Frame& F0) {
    const Frame F = relaunder(F0);
    unsigned char* ws = WSP();
    const int gw = F.bid * NWAVES + F.wave, NGW = F.G * NWAVES;
    const bf16* P = (const bf16*)(ws + WS_ACT); const bf16* oraw = (const bf16*)(ws + WS_XB); bf16* CAT = (bf16*)(ws + WS_CAT);
    for (int it = gw; it < M * 4; it += NGW) {
        const int m = it >> 2, h = it & 3;
        const unsigned long long ow = *(const unsigned long long*)(oraw + (size_t)m * 1024 + h * 256 + 4 * F.lane);
        const float o0 = bflo((unsigned)ow), o1 = bfhi((unsigned)ow), o2 = bflo((unsigned)(ow >> 32)), o3 = bfhi((unsigned)(ow >> 32));
        const float mu = wave_sum((o0 + o1) + (o2 + o3)) * (1.0f / 256.0f); const float d0 = o0 - mu, d1 = o1 - mu, d2 = o2 - mu, d3 = o3 - mu;
        const float var = wave_sum((d0 * d0 + d1 * d1) + (d2 * d2 + d3 * d3)) * (1.0f / 256.0f); const float rstd = 1.0f / sqrtf(var + EPS);
        const unsigned long long gw2 = *(const unsigned long long*)(P + (size_t)m * GLA_INP + G_R + h * 256 + 4 * F.lane);
        const float g0 = bflo((unsigned)gw2), g1 = bfhi((unsigned)gw2), g2 = bflo((unsigned)(gw2 >> 32)), g3 = bfhi((unsigned)(gw2 >> 32));
        const float y0 = d0 * rstd * (g0 / (1.0f + expf(-g0))), y1 = d1 * rstd * (g1 / (1.0f + expf(-g1))), y2 = d2 * rstd * (g2 / (1.0f + expf(-g2))), y3 = d3 * rstd * (g3 / (1.0f + expf(-g3)));
        *(unsigned long long*)(CAT + (size_t)m * D + h * 256 + 4 * F.lane) = (unsigned long long)pk2(y0, y1) | ((unsigned long long)pk2(y2, y3) << 32);
    }
}
__device__ __forceinline__ void final_norm(const Frame& F0) {
    const Frame F = relaunder(F0);
    const int gw = F.bid * NWAVES + F.wave, NGW = F.G * NWAVES;
    for (int m = gw; m < M; m += NGW) {
        GAS f32x4* xr = (GAS f32x4*)(OUTP() + (size_t)m * D) + F.lane; const GAS f32x4* gr = (const GAS f32x4*)AP(I_FINAL) + F.lane;
        f32x4 v[4]; float s = 0.f;
#pragma unroll
        for (int j = 0; j < 4; ++j) { v[j] = xr[64 * j]; s += (v[j].x * v[j].x + v[j].y * v[j].y) + (v[j].z * v[j].z + v[j].w * v[j].w); }
        const float rstd = 1.0f / sqrtf(wave_sum(s) * (1.0f / D) + EPS);
#pragma unroll
        for (int j = 0; j < 4; ++j) xr[64 * j] = v[j] * rstd * gr[64 * j];
    }
}


__device__ __forceinline__ float silu_f(float g) { return g * __builtin_amdgcn_rcpf(1.0f + __builtin_amdgcn_exp2f(-1.4426950408889634f * g)); }
typedef float f32x16 __attribute__((ext_vector_type(16)));
typedef short s16x4 __attribute__((ext_vector_type(4)));
typedef float f32x2_t __attribute__((ext_vector_type(2)));
typedef __bf16 bf16x2_t __attribute__((ext_vector_type(2)));
#define MFMA32(a, b, c) __builtin_amdgcn_mfma_f32_32x32x16_bf16((a), (b), (c), 0, 0, 0)
__device__ __forceinline__ int crow(int reg, int h) { return (reg & 3) + 8 * (reg >> 2) + 4 * h; }
__device__ __forceinline__ unsigned cvtpk(float lo, float hi) { f32x2_t v = {lo, hi}; bf16x2_t b = __builtin_convertvector(v, bf16x2_t); return __builtin_bit_cast(unsigned, b); }
__device__ __forceinline__ bf16 cvt1(float v) { return (bf16)(cvtpk(v, 0.f) & 0xffffu); }
#define PACK_STEP(x, s) __builtin_bit_cast(bf16x8, (v4u){cvtpk((x)[8 * (s)], (x)[8 * (s) + 1]), cvtpk((x)[8 * (s) + 2], (x)[8 * (s) + 3]), cvtpk((x)[8 * (s) + 4], (x)[8 * (s) + 5]), cvtpk((x)[8 * (s) + 6], (x)[8 * (s) + 7])})
typedef const LAS unsigned char* lcp;
__device__ __forceinline__ int lndv(int v) { asm volatile("" : "+v"(v)); return v; }
__device__ __forceinline__ bf16x8 ld_row(lcp img, int P, int row0, int k0, int r, int h) { return *(const LAS bf16x8*)(img + (row0 + r) * P + (k0 + 8 * h) * 2); }
__device__ __forceinline__ bf16x8 ld_row_perm(lcp img, int P, int row0, int k0, int r, int h) {
    const s16x4 lo = *(const LAS s16x4*)(img + (row0 + r) * P + (k0 + 4 * h) * 2), hi = *(const LAS s16x4*)(img + (row0 + r) * P + (k0 + 8 + 4 * h) * 2);
    return __builtin_shufflevector(lo, hi, 0, 1, 2, 3, 4, 5, 6, 7); }
__device__ __forceinline__ s16x4 trd(lcp p) { return __builtin_bit_cast(s16x4, __builtin_amdgcn_ds_read_tr16_b64_v4i16((LAS s16x4*)p)); }
__device__ __forceinline__ bf16x8 ld_tr(lcp img, int P, int k0, int c0, int lane) {
    const int i16 = lane & 15, q = i16 >> 2, p = i16 & 3, blk = (lane >> 4) & 1, h = lane >> 5;
    lcp a = img + (k0 + 8 * h + q) * P + (c0 + 16 * blk + 4 * p) * 2;
    const s16x4 lo = trd(a), hi = trd(a + 4 * P);
    return __builtin_shufflevector(lo, hi, 0, 1, 2, 3, 4, 5, 6, 7); }
__device__ __forceinline__ bf16x8 ld_tr_perm(lcp img, int P, int k0, int c0, int lane) {
    const int i16 = lane & 15, q = i16 >> 2, p = i16 & 3, blk = (lane >> 4) & 1, h = lane >> 5;
    lcp a = img + (k0 + 4 * h + q) * P + (c0 + 16 * blk + 4 * p) * 2;
    const s16x4 lo = trd(a), hi = trd(a + 8 * P);
    return __builtin_shufflevector(lo, hi, 0, 1, 2, 3, 4, 5, 6, 7); }
template <int R, int C> __device__ __forceinline__ void tile_ld(v4u (&v)[R * C / 8 / NTHREADS], const bf16* g, size_t gp, int tid) {
    constexpr int CPR = C / 8, RS = NTHREADS / CPR;
    static_assert(NTHREADS % CPR == 0, "tile shape");
    const unsigned voff = (unsigned)((tid / CPR) * (int)gp + (tid % CPR) * 8) * 2u;
    const GAS unsigned char* gb = (const GAS unsigned char*)g;
#pragma unroll
    for (int i = 0; i < R * C / 8 / NTHREADS; ++i) v[i] = *(const GAS v4u*)(gb + (size_t)i * RS * gp * 2 + voff);
}
template <int R, int C> __device__ __forceinline__ void tile_st(const v4u (&v)[R * C / 8 / NTHREADS], LAS unsigned char* img, int P, int tid) {
    constexpr int CPR = C / 8, RS = NTHREADS / CPR;
    LAS unsigned char* lb = img + (tid / CPR) * P + (tid % CPR) * 16;
#pragma unroll
    for (int i = 0; i < R * C / 8 / NTHREADS; ++i) *(LAS v4u*)(lb + i * RS * P) = v[i];
}
template <int R, int C> __device__ __forceinline__ void stage_tile(LAS unsigned char* img, int P, const bf16* g, size_t gp, int tid) { v4u t_[R * C / 8 / NTHREADS]; tile_ld<R, C>(t_, g, gp, tid); tile_st<R, C>(t_, img, P, tid); }
#define WG_BAR() do { asm volatile("s_waitcnt lgkmcnt(0)" ::: "memory"); __builtin_amdgcn_s_barrier(); asm volatile("" ::: "memory"); } while (0)

constexpr int PR = 272, PT = 320, PT256 = 576, PO256 = 528;
constexpr size_t WS_DEC = 6 * MiB;
constexpr float LOG2E = 1.4426950408889634f, LN2 = 0.6931471805599453f;
__device__ __forceinline__ void gla_cumsum(float (&Bc)[2][16], float& Blast, lcp AL, lcp W2, const LAS float* BA, LAS float* EX, int wave, int lane) {
    const int r = lane & 31, h = lane >> 5, db = wave & 3, jh = wave >> 2;
    const bf16x8 wf = *(const LAS bf16x8*)(W2 + (db * 32 + r) * 32 + h * 16);
    const float bias = BA[db * 32 + r];
    float run = 0.f;
#pragma unroll
    for (int t = 0; t < 2; ++t) {
        const bf16x8 af = *(const LAS bf16x8*)(AL + ((jh * 2 + t) * 32 + r) * 32 + h * 16);
        f32x16 z = {0.f, 0.f, 0.f, 0.f, 0.f, 0.f, 0.f, 0.f, 0.f, 0.f, 0.f, 0.f, 0.f, 0.f, 0.f, 0.f};
        z = MFMA32(af, wf, z);
        float own[4], oth[4];
#pragma unroll
        for (int g = 0; g < 4; ++g) {
            float acc = 0.f;
#pragma unroll
            for (int i = 0; i < 4; ++i) { const float zz = z[4 * g + i] + bias;
                const float la = (fminf(zz, 0.f) - LN2 * __builtin_amdgcn_logf(1.0f + __builtin_amdgcn_exp2f(-fabsf(zz) * LOG2E))) * (1.0f / 16.0f);
                acc += la; Bc[t][4 * g + i] = acc; }
            own[g] = acc; oth[g] = oth32(acc, h);
        }
#pragma unroll
        for (int g = 0; g < 4; ++g) { const float off = run + (h ? oth[g] : 0.f);
#pragma unroll
            for (int i = 0; i < 4; ++i) Bc[t][4 * g + i] += off;
            run += own[g] + oth[g]; }
    }
    if (h == 0) EX[jh * 128 + db * 32 + r] = run;
    WG_BAR();
    const float t0 = EX[db * 32 + r], t1 = EX[128 + db * 32 + r];
    Blast = t0 + t1;
    if (jh == 1) {
#pragma unroll
        for (int t = 0; t < 2; ++t)
#pragma unroll
            for (int i = 0; i < 16; ++i) Bc[t][i] += t0; }
}
constexpr int GA_KI = 0, GA_VI = GA_KI + 128 * PR, GA_KD = GA_VI + 128 * PT256, GA_AL = GA_KD + 128 * PT, GA_W2 = GA_AL + 4096, GA_BA = GA_W2 + 4096, GA_EX = GA_BA + 512, GA_END = GA_EX + 1024;
constexpr int GA_OI = GA_VI;
constexpr int GC_QT = 0, GC_KT = GC_QT + 128 * PR, GC_SI = GC_KT + 128 * PR, GC_VI = GC_SI + 128 * PT, GC_AL = GC_VI + 128 * PT, GC_W2 = GC_AL + 4096, GC_BA = GC_W2 + 4096, GC_EX = GC_BA + 512, GC_END = GC_EX + 1024;
constexpr int GC_OI = 0;
static_assert(GA_END <= LDSCTL_OFF && GC_END <= LDSCTL_OFF && 128 * PO256 <= GC_SI && 128 * PO256 <= 128 * PT256, "GLA LDS maps");
__device__ __forceinline__ void gla_stage_w(const Frame& F, LAS unsigned char* W2, LAS float* BA, int li, int h) {
    if (F.tid < 128) { const int d = F.tid; const GAS float* w2 = (const GAS float*)AP(I_GLA_A2) + (size_t)li * 16 * 512 + h * 128 + d;
        v4u lo, hi; lo.x = cvtpk(w2[0], w2[512]); lo.y = cvtpk(w2[2 * 512], w2[3 * 512]); lo.z = cvtpk(w2[4 * 512], w2[5 * 512]); lo.w = cvtpk(w2[6 * 512], w2[7 * 512]);
        hi.x = cvtpk(w2[8 * 512], w2[9 * 512]); hi.y = cvtpk(w2[10 * 512], w2[11 * 512]); hi.z = cvtpk(w2[12 * 512], w2[13 * 512]); hi.w = cvtpk(w2[14 * 512], w2[15 * 512]);
        *(LAS v4u*)(W2 + d * 32) = lo; *(LAS v4u*)(W2 + d * 32 + 16) = hi; }
    else if (F.tid < 256) { const int d = F.tid - 128; BA[d] = ((const GAS float*)AP(I_GLA_BA))[(size_t)li * 512 + h * 128 + d]; }
}
__device__ __forceinline__ v4u gla_ld_alow(int tid, const bf16* Prow0) { const int t = tid & 255; return *(const GAS v4u*)(Prow0 + (size_t)(t >> 1) * GLA_INP + G_A + (t & 1) * 8); }
__device__ __forceinline__ void gla_st_alow(int tid, v4u v, LAS unsigned char* AL) { if (tid < 256) *(LAS v4u*)(AL + (tid >> 1) * 32 + (tid & 1) * 16) = v; }

__device__ __forceinline__ void gla_phase_a(const Frame& F0, int li) {
    const Frame F = relaunder(F0);
    unsigned char* ws = WSP();
    const bf16* P = (const bf16*)(ws + WS_ACT); bf16* SKV = (bf16*)(ws + WS_XB); float* DEC = (float*)(ws + WS_DEC);
    LAS unsigned char* L = F.lds;
    const int wave = F.wave, db = wave & 3, jh = wave >> 2;
    v4u kR[4], vR[8], aR; int hcur = -1;
    {   const int it = F.bid; if (it < 1024) { const int bh = it >> 5, g = it & 31; const bf16* Prow0 = P + ((size_t)(bh >> 2) * SEQ + g * 128) * GLA_INP;
            tile_ld<128, 128>(kR, Prow0 + G_K + (bh & 3) * 128, GLA_INP, F.tid); tile_ld<128, 256>(vR, Prow0 + G_V + (bh & 3) * 256, GLA_INP, F.tid); aR = gla_ld_alow(F.tid, Prow0); } }
    for (int it = F.bid; it < 1024; it += F.G) {
        const int bh = it >> 5, h = bh & 3;
        const int lane = lndv(F.lane), r = lane & 31, h2 = lane >> 5;
        tile_st<128, 128>(kR, L + GA_KI, PR, F.tid); tile_st<128, 256>(vR, L + GA_VI, PT256, F.tid); gla_st_alow(F.tid, aR, L + GA_AL);
        if (h != hcur) { gla_stage_w(F, L + GA_W2, (LAS float*)(L + GA_BA), li, h); hcur = h; }
        WG_BAR();
        {   const int nx = it + F.G; if (nx < 1024) { const int bh2 = nx >> 5, g2 = nx & 31; const bf16* Pn = P + ((size_t)(bh2 >> 2) * SEQ + g2 * 128) * GLA_INP;
                tile_ld<128, 128>(kR, Pn + G_K + (bh2 & 3) * 128, GLA_INP, F.tid); tile_ld<128, 256>(vR, Pn + G_V + (bh2 & 3) * 256, GLA_INP, F.tid); aR = gla_ld_alow(F.tid, Pn); } }
        float Bc[2][16], Blast;
        gla_cumsum(Bc, Blast, L + GA_AL, L + GA_W2, (const LAS float*)(L + GA_BA), (LAS float*)(L + GA_EX), wave, lane);
#pragma unroll
        for (int t = 0; t < 2; ++t)
#pragma unroll
            for (int i = 0; i < 16; ++i) { const int row = (jh * 2 + t) * 32 + crow(i, h2), col = db * 32 + r;
                const float kv = bf2f(*(const LAS bf16*)(L + GA_KI + row * PR + col * 2)) * __builtin_amdgcn_exp2f((Blast - Bc[t][i]) * LOG2E);
                *(LAS bf16*)(L + GA_KD + row * PT + col * 2) = cvt1(kv); }
        if (jh == 0 && h2 == 0) DEC[(size_t)it * 128 + db * 32 + r] = __builtin_amdgcn_exp2f(Blast * LOG2E);
        WG_BAR();
        f32x16 acc[4];
#pragma unroll
        for (int t = 0; t < 4; ++t) acc[t] = (f32x16){0.f, 0.f, 0.f, 0.f, 0.f, 0.f, 0.f, 0.f, 0.f, 0.f, 0.f, 0.f, 0.f, 0.f, 0.f, 0.f};
#pragma unroll
        for (int ks = 0; ks < 8; ++ks) { const bf16x8 a = ld_tr(L + GA_KD, PT, 16 * ks, db * 32, lane);
#pragma unroll
            for (int t = 0; t < 4; ++t) acc[t] = MFMA32(a, ld_tr(L + GA_VI, PT256, 16 * ks, (4 * jh + t) * 32, lane), acc[t]); }
        WG_BAR();
#pragma unroll
        for (int t = 0; t < 4; ++t)
#pragma unroll
            for (int i = 0; i < 16; ++i) *(LAS bf16*)(L + GA_OI + (db * 32 + crow(i, h2)) * PO256 + ((4 * jh + t) * 32 + r) * 2) = cvt1(acc[t][i]);
        WG_BAR();
        {   bf16* out = SKV + (size_t)it * 128 * 256;
#pragma unroll
            for (int i = 0; i < 8; ++i) { const int c = F.tid + i * NTHREADS, row = c >> 5, cc = c & 31; *(GAS v4u*)(out + row * 256 + cc * 8) = *(const LAS v4u*)(L + GA_OI + row * PO256 + cc * 16); } }
        WG_BAR();
    }
}
__device__ __forceinline__ void gla_phase_b(const Frame& F0) {
    const Frame F = relaunder(F0);
    unsigned char* ws = WSP();
    bf16* SKV = (bf16*)(ws + WS_XB); const float* DEC = (const float*)(ws + WS_DEC);
    for (int gt = F.bid * NTHREADS + F.tid; gt < 32 * 128 * 32; gt += F.G * NTHREADS) {
        const int bh = gt >> 12, d = (gt >> 5) & 127, e8 = gt & 31;
        float s[8];
#pragma unroll
        for (int i = 0; i < 8; ++i) s[i] = 0.f;
        for (int g0 = 0; g0 < 32; g0 += 8) {
            v4u kv[8]; float dc[8];
#pragma unroll
            for (int u = 0; u < 8; ++u) { const size_t item = (size_t)bh * 32 + g0 + u; kv[u] = *(const GAS v4u*)(SKV + (item * 128 + d) * 256 + e8 * 8); dc[u] = ((const GAS float*)DEC)[item * 128 + d]; }
#pragma unroll
            for (int u = 0; u < 8; ++u) { const size_t item = (size_t)bh * 32 + g0 + u;
                v4u o; o.x = cvtpk(s[0], s[1]); o.y = cvtpk(s[2], s[3]); o.z = cvtpk(s[4], s[5]); o.w = cvtpk(s[6], s[7]);
                *(GAS v4u*)(SKV + (item * 128 + d) * 256 + e8 * 8) = o;
#pragma unroll
                for (int i = 0; i < 4; ++i) { s[2 * i] = dc[u] * s[2 * i] + bflo(kv[u][i]); s[2 * i + 1] = dc[u] * s[2 * i + 1] + bfhi(kv[u][i]); } }
        }
    }
}
__device__ __forceinline__ void gla_phase_c(const Frame& F0, int li) {
    const Frame F = relaunder(F0);
    unsigned char* ws = WSP();
    const bf16* P = (const bf16*)(ws + WS_ACT); const bf16* SKV = (const bf16*)(ws + WS_XB); bf16* CAT = (bf16*)(ws + WS_CAT);
    LAS unsigned char* L = F.lds;
    const int wave = F.wave, db = wave & 3, jh = wave >> 2;
    const int ib = wave & 3, eq = wave >> 2;
    v4u qR[4], kR[4], aR; int hcur = -1;
    {   const int it = F.bid; if (it < 1024) { const int bh = it >> 5, g = it & 31, h = bh & 3; const bf16* Prow0 = P + ((size_t)(bh >> 2) * SEQ + g * 128) * GLA_INP;
            tile_ld<128, 128>(qR, Prow0 + G_Q + h * 128, GLA_INP, F.tid); tile_ld<128, 128>(kR, Prow0 + G_K + h * 128, GLA_INP, F.tid); aR = gla_ld_alow(F.tid, Prow0); } }
    for (int it = F.bid; it < 1024; it += F.G) {
        const int bh = it >> 5, g = it & 31, b = bh >> 2, h = bh & 3;
        const int tidl = lndv(F.tid), lane = tidl & 63, r = lane & 31, h2 = lane >> 5;
        const bf16* Prow0 = P + ((size_t)b * SEQ + g * 128) * GLA_INP;
        const bf16* Sg = SKV + (size_t)it * 128 * 256;
        {   v4u sR[4], vR[4]; tile_ld<128, 128>(sR, Sg, 256, tidl); tile_ld<128, 128>(vR, Prow0 + G_V + h * 256, GLA_INP, tidl);
            tile_st<128, 128>(qR, L + GC_QT, PR, tidl); tile_st<128, 128>(kR, L + GC_KT, PR, tidl); tile_st<128, 128>(sR, L + GC_SI, PT, tidl); tile_st<128, 128>(vR, L + GC_VI, PT, tidl); }
        gla_st_alow(tidl, aR, L + GC_AL);
        if (h != hcur) { gla_stage_w(F, L + GC_W2, (LAS float*)(L + GC_BA), li, h); hcur = h; }
        WG_BAR();
        {
            float Bc[2][16], Blast;
            gla_cumsum(Bc, Blast, L + GC_AL, L + GC_W2, (const LAS float*)(L + GC_BA), (LAS float*)(L + GC_EX), wave, lane);
#pragma unroll
            for (int t = 0; t < 2; ++t)
#pragma unroll
                for (int i = 0; i < 16; ++i) { const int off = ((jh * 2 + t) * 32 + crow(i, h2)) * PR + (db * 32 + r) * 2;
                    const float eb = __builtin_amdgcn_exp2f(Bc[t][i] * LOG2E);
                    const float qv = bf2f(*(const LAS bf16*)(L + GC_QT + off)) * eb * 0.08838834764831845f;
                    const float kv = bf2f(*(const LAS bf16*)(L + GC_KT + off)) * __builtin_amdgcn_rcpf(eb);
                    *(LAS bf16*)(L + GC_QT + off) = cvt1(qv); *(LAS bf16*)(L + GC_KT + off) = cvt1(kv); }
        }
        WG_BAR();
        bf16x8 PA[4][2];
#pragma unroll
        for (int jb = 0; jb < 4; ++jb) {
            if (jb <= ib) {
                f32x16 x = {0.f, 0.f, 0.f, 0.f, 0.f, 0.f, 0.f, 0.f, 0.f, 0.f, 0.f, 0.f, 0.f, 0.f, 0.f, 0.f};
#pragma unroll
                for (int ks = 0; ks < 8; ++ks) x = MFMA32(ld_row(L + GC_KT, PR, jb * 32, 16 * ks, r, h2), ld_row(L + GC_QT, PR, ib * 32, 16 * ks, r, h2), x);
                if (jb == ib) {
#pragma unroll
                    for (int i = 0; i < 16; ++i) if (crow(i, h2) > r) x[i] = 0.f; }
                PA[jb][0] = PACK_STEP(x, 0); PA[jb][1] = PACK_STEP(x, 1);
            } else { PA[jb][0] = (bf16x8){0, 0, 0, 0, 0, 0, 0, 0}; PA[jb][1] = (bf16x8){0, 0, 0, 0, 0, 0, 0, 0}; }
        }
        f32x16 o[2][2];
#pragma unroll
        for (int half = 0; half < 2; ++half) {
            if (half == 1) {
                WG_BAR();
                stage_tile<128, 128>(L + GC_SI, PT, Sg + 128, 256, tidl); stage_tile<128, 128>(L + GC_VI, PT, Prow0 + G_V + h * 256 + 128, GLA_INP, tidl);
                WG_BAR();
            }
#pragma unroll
            for (int t = 0; t < 2; ++t) {
                const int eb = 2 * eq + t;
                f32x16 acc = {0.f, 0.f, 0.f, 0.f, 0.f, 0.f, 0.f, 0.f, 0.f, 0.f, 0.f, 0.f, 0.f, 0.f, 0.f, 0.f};
#pragma unroll
                for (int jb = 0; jb < 4; ++jb) if (jb <= ib) {
#pragma unroll
                    for (int s = 0; s < 2; ++s) acc = MFMA32(PA[jb][s], ld_tr_perm(L + GC_VI, PT, jb * 32 + 16 * s, eb * 32, lane), acc); }
#pragma unroll
                for (int ks = 0; ks < 8; ++ks) acc = MFMA32(ld_row(L + GC_QT, PR, ib * 32, 16 * ks, r, h2), ld_tr(L + GC_SI, PT, 16 * ks, eb * 32, lane), acc);
                o[half][t] = acc;
            }
        }
        WG_BAR();
#pragma unroll
        for (int half = 0; half < 2; ++half)
#pragma unroll
            for (int t = 0; t < 2; ++t)
#pragma unroll
                for (int i = 0; i < 16; ++i) *(LAS bf16*)(L + GC_OI + (ib * 32 + crow(i, h2)) * PO256 + (half * 128 + (2 * eq + t) * 32 + r) * 2) = cvt1(o[half][t][i]);
        WG_BAR();
        {   const int nx = (it + F.G < 1024) ? it + F.G : it;
            const int bh2 = nx >> 5, g2 = nx & 31, hn = bh2 & 3; const bf16* Pn = P + ((size_t)(bh2 >> 2) * SEQ + g2 * 128) * GLA_INP;
            tile_ld<128, 128>(qR, Pn + G_Q + hn * 128, GLA_INP, tidl); tile_ld<128, 128>(kR, Pn + G_K + hn * 128, GLA_INP, tidl); aR = gla_ld_alow(tidl, Pn); }
        {
            const int tid2 = lndv(tidl), row = tid2 >> 2, qtr = tid2 & 3;
            lcp orow = L + GC_OI + row * PO256 + qtr * 128;
            const bf16* gp = Prow0 + (size_t)row * GLA_INP + G_R + h * 256 + qtr * 64;
            float sum = 0.f;
#pragma unroll
            for (int c = 0; c < 8; ++c) { const v4u w = *(const LAS v4u*)(orow + c * 16);
#pragma unroll
                for (int i = 0; i < 4; ++i) sum += bflo(w[i]) + bfhi(w[i]); }
            sum += xsw<1>(sum); sum += xsw<2>(sum);
            const float mu = sum * (1.0f / 256.0f); float sq = 0.f;
#pragma unroll
            for (int c = 0; c < 8; ++c) { const v4u w = *(const LAS v4u*)(orow + c * 16);
#pragma unroll
                for (int i = 0; i < 4; ++i) { const float d0 = bflo(w[i]) - mu, d1 = bfhi(w[i]) - mu; sq += d0 * d0 + d1 * d1; } }
            sq += xsw<1>(sq); sq += xsw<2>(sq);
            const float rstd = 1.0f / sqrtf(sq * (1.0f / 256.0f) + EPS);
            bf16* op = CAT + ((size_t)b * SEQ + g * 128 + row) * D + h * 256 + qtr * 64;
#pragma unroll
            for (int c = 0; c < 8; ++c) { const v4u gw = *(const GAS v4u*)(gp + c * 8); const v4u w = *(const LAS v4u*)(orow + c * 16); v4u ow;
#pragma unroll
                for (int i = 0; i < 4; ++i) { const float g0 = bflo(gw[i]), g1 = bfhi(gw[i]);
                    ow[i] = cvtpk((bflo(w[i]) - mu) * rstd * silu_f(g0), (bfhi(w[i]) - mu) * rstd * silu_f(g1)); }
                *(GAS v4u*)(op + c * 8) = ow; }
        }
        WG_BAR();
    }
}


constexpr size_t WS_OD = 408 * MiB;
constexpr size_t WS_LSE = WS_XB + 32 * MiB;
constexpr size_t WS_END2 = 504 * MiB;
constexpr int RP = 272;
constexpr int RA_KI = 0, RA_VD = RA_KI + 128 * RP, RA_END = RA_VD + 128 * RP;
constexpr int RC_QI = 0, RC_KI = RC_QI + 128 * RP, RC_VI = RC_KI + 128 * RP, RC_SI = RC_VI + 128 * RP, RC_END = RC_SI + 128 * RP;
constexpr int DP = 144;
constexpr int DL_KI = 0, DL_VI = DL_KI + 384 * DP, DL_ST = DL_VI + 384 * DP, DL_LW = DL_ST + 8 * 32 * DP, DL_END = DL_LW + 8 * 256;
static_assert(RC_END <= LDSCTL_OFF && DL_END <= LDSCTL_OFF, "even mixer LDS maps");
__device__ __forceinline__ float ret_log2g(int h) { return log2f(1.0f - exp2f(-5.0f - (float)h)); }

__device__ __forceinline__ void ret_phase_a_item(const Frame& F, int it, const bf16* P, bf16* RKV) {
    LAS unsigned char* L = F.lds;
    const int lane = F.lane, r = lane & 31, h2 = lane >> 5, wave = F.wave, db = wave & 3, eh = wave >> 2;
    const int bh = it >> 5, n = it & 31, b = bh >> 2, h = bh & 3;
    const float lg = ret_log2g(h);
    const bf16* Prow0 = P + ((size_t)b * SEQ + n * 128) * EVEN_IN;
    stage_tile<128, 128>(L + RA_KI, RP, Prow0 + E_RK + h * 128, EVEN_IN, F.tid);
    {
        const bf16* gsrc = Prow0 + E_RV + h * 128;
#pragma unroll
        for (int i = 0; i < 4; ++i) { const int c = F.tid + i * NTHREADS, row = c >> 4, cc = c & 15; const float f = __builtin_amdgcn_exp2f(lg * (float)(127 - row));
            const v4u v = *(const GAS v4u*)(gsrc + (size_t)row * EVEN_IN + cc * 8); v4u o;
#pragma unroll
            for (int k = 0; k < 4; ++k) o[k] = cvtpk(bflo(v[k]) * f, bfhi(v[k]) * f);
            *(LAS v4u*)(L + RA_VD + row * RP + cc * 16) = o; }
    }
    WG_BAR();
    f32x16 acc[2];
#pragma unroll
    for (int t = 0; t < 2; ++t) acc[t] = (f32x16){0.f, 0.f, 0.f, 0.f, 0.f, 0.f, 0.f, 0.f, 0.f, 0.f, 0.f, 0.f, 0.f, 0.f, 0.f, 0.f};
#pragma unroll
    for (int ks = 0; ks < 8; ++ks) { const bf16x8 a = ld_tr(L + RA_KI, RP, 16 * ks, db * 32, lane);
#pragma unroll
        for (int t = 0; t < 2; ++t) acc[t] = MFMA32(a, ld_tr(L + RA_VD, RP, 16 * ks, (2 * eh + t) * 32, lane), acc[t]); }
    WG_BAR();
#pragma unroll
    for (int t = 0; t < 2; ++t)
#pragma unroll
        for (int i = 0; i < 16; ++i) *(LAS bf16*)(L + RA_KI + (db * 32 + crow(i, h2)) * RP + ((2 * eh + t) * 32 + r) * 2) = cvt1(acc[t][i]);
    WG_BAR();
    bf16* out = RKV + (size_t)it * 128 * 128;
#pragma unroll
    for (int i = 0; i < 4; ++i) { const int c = F.tid + i * NTHREADS, row = c >> 4, cc = c & 15; *(GAS v4u*)(out + row * 128 + cc * 8) = *(const LAS v4u*)(L + RA_KI + row * RP + cc * 16); }
    WG_BAR();
}
__device__ __forceinline__ void ret_scan(const Frame& F, bf16* RKV) {
    for (int gt = F.bid * NTHREADS + F.tid; gt < 32 * 128 * 16; gt += F.G * NTHREADS) {
        const int bh = gt >> 11, d = (gt >> 4) & 127, e8 = gt & 15, h = bh & 3;
        const float g128 = __builtin_amdgcn_exp2f(ret_log2g(h) * 128.0f);
        float s[8];
#pragma unroll
        for (int i = 0; i < 8; ++i) s[i] = 0.f;
        for (int n0 = 0; n0 < 32; n0 += 4) {
            v4u kv[4];
#pragma unroll
            for (int u = 0; u < 4; ++u) kv[u] = *(const GAS v4u*)(RKV + (((size_t)bh * 32 + n0 + u) * 128 + d) * 128 + e8 * 8);
#pragma unroll
            for (int u = 0; u < 4; ++u) {
                v4u o; o.x = cvtpk(s[0], s[1]); o.y = cvtpk(s[2], s[3]); o.z = cvtpk(s[4], s[5]); o.w = cvtpk(s[6], s[7]);
                *(GAS v4u*)(RKV + (((size_t)bh * 32 + n0 + u) * 128 + d) * 128 + e8 * 8) = o;
#pragma unroll
                for (int i = 0; i < 4; ++i) { s[2 * i] = g128 * s[2 * i] + bflo(kv[u][i]); s[2 * i + 1] = g128 * s[2 * i + 1] + bfhi(kv[u][i]); } }
        }
    }
}
__device__ __forceinline__ void ret_phase_c_item(const Frame& F, int it, const bf16* P, const bf16* RKV, bf16* CAT) {
    LAS unsigned char* L = F.lds;
    const int lane = F.lane, r = lane & 31, h2 = lane >> 5, wave = F.wave, ib = wave & 3, eq = wave >> 2;
    const int bh = it >> 5, n = it & 31, b = bh >> 2, h = bh & 3;
    const float lg = ret_log2g(h);
    const bf16* Prow0 = P + ((size_t)b * SEQ + n * 128) * EVEN_IN;
    {
#pragma unroll
        for (int i = 0; i < 4; ++i) { const int c = F.tid + i * NTHREADS, row = c >> 4, cc = c & 15; const float fq = __builtin_amdgcn_exp2f(lg * (float)row), fk = __builtin_amdgcn_rcpf(fq);
            const v4u vq = *(const GAS v4u*)(Prow0 + (size_t)row * EVEN_IN + E_RQ + h * 128 + cc * 8), vk = *(const GAS v4u*)(Prow0 + (size_t)row * EVEN_IN + E_RK + h * 128 + cc * 8); v4u oq, ok;
#pragma unroll
            for (int k = 0; k < 4; ++k) { oq[k] = cvtpk(bflo(vq[k]) * fq, bfhi(vq[k]) * fq); ok[k] = cvtpk(bflo(vk[k]) * fk, bfhi(vk[k]) * fk); }
            *(LAS v4u*)(L + RC_QI + row * RP + cc * 16) = oq; *(LAS v4u*)(L + RC_KI + row * RP + cc * 16) = ok; }
    }
    stage_tile<128, 128>(L + RC_VI, RP, Prow0 + E_RV + h * 128, EVEN_IN, F.tid);
    stage_tile<128, 128>(L + RC_SI, RP, RKV + (size_t)it * 128 * 128, 128, F.tid);
    WG_BAR();
    bf16x8 PA[4][2];
#pragma unroll
    for (int jb = 0; jb < 4; ++jb) {
        if (jb <= ib) {
            f32x16 x = {0.f, 0.f, 0.f, 0.f, 0.f, 0.f, 0.f, 0.f, 0.f, 0.f, 0.f, 0.f, 0.f, 0.f, 0.f, 0.f};
#pragma unroll
            for (int ks = 0; ks < 8; ++ks) x = MFMA32(ld_row(L + RC_KI, RP, jb * 32, 16 * ks, r, h2), ld_row(L + RC_QI, RP, ib * 32, 16 * ks, r, h2), x);
            if (jb == ib) {
#pragma unroll
                for (int i = 0; i < 16; ++i) if (crow(i, h2) > r) x[i] = 0.f; }
            PA[jb][0] = PACK_STEP(x, 0); PA[jb][1] = PACK_STEP(x, 1);
        } else { PA[jb][0] = (bf16x8){0, 0, 0, 0, 0, 0, 0, 0}; PA[jb][1] = (bf16x8){0, 0, 0, 0, 0, 0, 0, 0}; }
    }
    f32x16 o[2];
#pragma unroll
    for (int t = 0; t < 2; ++t) {
        const int eb = 2 * eq + t;
        f32x16 z = {0.f, 0.f, 0.f, 0.f, 0.f, 0.f, 0.f, 0.f, 0.f, 0.f, 0.f, 0.f, 0.f, 0.f, 0.f, 0.f}, y = z;
#pragma unroll
        for (int jb = 0; jb < 4; ++jb) if (jb <= ib) {
#pragma unroll
            for (int s = 0; s < 2; ++s) z = MFMA32(PA[jb][s], ld_tr_perm(L + RC_VI, RP, jb * 32 + 16 * s, eb * 32, lane), z); }
#pragma unroll
        for (int ks = 0; ks < 8; ++ks) y = MFMA32(ld_row(L + RC_QI, RP, ib * 32, 16 * ks, r, h2), ld_tr(L + RC_SI, RP, 16 * ks, eb * 32, lane), y);
        const float g1 = __builtin_amdgcn_exp2f(lg);
#pragma unroll
        for (int i = 0; i < 16; ++i) z[i] += y[i] * g1;
        o[t] = z;
    }
    WG_BAR();
#pragma unroll
    for (int t = 0; t < 2; ++t)
#pragma unroll
        for (int i = 0; i < 16; ++i) *(LAS bf16*)(L + RC_QI + (ib * 32 + crow(i, h2)) * RP + ((2 * eq + t) * 32 + r) * 2) = cvt1(o[t][i]);
    WG_BAR();
    {
        const int row = F.tid >> 2, qtr = F.tid & 3;
        lcp orow = L + RC_QI + row * RP + qtr * 64;
        v4u w[4]; float sum = 0.f;
#pragma unroll
        for (int c = 0; c < 4; ++c) { w[c] = *(const LAS v4u*)(orow + c * 16);
#pragma unroll
            for (int i = 0; i < 4; ++i) sum += bflo(w[c][i]) + bfhi(w[c][i]); }
        sum += xsw<1>(sum); sum += xsw<2>(sum);
        const float mu = sum * (1.0f / 128.0f); float sq = 0.f;
#pragma unroll
        for (int c = 0; c < 4; ++c)
#pragma unroll
            for (int i = 0; i < 4; ++i) { const float d0 = bflo(w[c][i]) - mu, d1 = bfhi(w[c][i]) - mu; sq += d0 * d0 + d1 * d1; }
        sq += xsw<1>(sq); sq += xsw<2>(sq);
        const float rstd = 1.0f / sqrtf(sq * (1.0f / 128.0f) + EPS);
        const bf16* gp = Prow0 + (size_t)row * EVEN_IN + E_RG + h * 128 + qtr * 32;
        bf16* op = CAT + ((size_t)b * SEQ + n * 128 + row) * D + h * 128 + qtr * 32;
#pragma unroll
        for (int c = 0; c < 4; ++c) { const v4u gw = *(const GAS v4u*)(gp + c * 8); v4u ow;
#pragma unroll
            for (int i = 0; i < 4; ++i) { const float g0 = bflo(gw[i]), g1 = bfhi(gw[i]);
                ow[i] = cvtpk((bflo(w[c][i]) - mu) * rstd * silu_f(g0), (bfhi(w[c][i]) - mu) * rstd * silu_f(g1)); }
            *(GAS v4u*)(op + c * 8) = ow; }
    }
    WG_BAR();
}
__device__ __forceinline__ void dil_tile(const Frame& F, int T, const bf16* P, bf16* OD, float* LSE) {
    LAS unsigned char* L = F.lds;
    const int lane = F.lane, r = lane & 31, h2 = lane >> 5, wave = F.wave;
    const int b = T / 384, rem = T - b * 384, head = rem / 48, t48 = rem - head * 48, p = t48 >> 4, idx = t48 & 15;
    const int sh = 2 * p, dil = 1 << sh, res = idx & (dil - 1), blk = idx >> sh, q0 = blk * 256;
    const bf16* Pb = P + (size_t)b * SEQ * EVEN_IN + head * 64;
#pragma unroll
    for (int i = 0; i < 6; ++i) { const int c = F.tid + i * NTHREADS, row = c >> 3, cc = c & 7; int kidx = q0 - 128 + row; kidx = kidx < 0 ? 0 : kidx;
        const bf16* src = Pb + (size_t)(kidx * dil + res) * EVEN_IN + cc * 8;
        const v4u kv = *(const GAS v4u*)(src + E_DK), vv = *(const GAS v4u*)(src + E_DV);
        *(LAS v4u*)(L + DL_KI + row * DP + cc * 16) = kv; *(LAS v4u*)(L + DL_VI + row * DP + cc * 16) = vv; }
    bf16x8 qf[4];
    { const bf16* qsrc = Pb + (size_t)((q0 + 32 * wave + r) * dil + res) * EVEN_IN + E_DQ + 8 * h2;
#pragma unroll
      for (int ks = 0; ks < 4; ++ks) qf[ks] = *(const GAS bf16x8*)(qsrc + 16 * ks); }
    WG_BAR();
    f32x16 x[5];
    float mx = -INFINITY;
#pragma unroll
    for (int kb = 0; kb < 5; ++kb) {
        f32x16 a = {0.f, 0.f, 0.f, 0.f, 0.f, 0.f, 0.f, 0.f, 0.f, 0.f, 0.f, 0.f, 0.f, 0.f, 0.f, 0.f};
#pragma unroll
        for (int ks = 0; ks < 4; ++ks) a = MFMA32(ld_row(L + DL_KI, DP, 32 * wave + 32 * kb, 16 * ks, r, h2), qf[ks], a);
        if (kb == 0) {
#pragma unroll
            for (int i = 0; i < 16; ++i) if (crow(i, h2) < r) a[i] = -INFINITY; }
        if (kb == 4) {
#pragma unroll
            for (int i = 0; i < 16; ++i) if (crow(i, h2) > r) a[i] = -INFINITY; }
        if (q0 == 0 && 32 * wave + 32 * kb < 128) {
#pragma unroll
            for (int i = 0; i < 16; ++i) a[i] = -INFINITY; }
#pragma unroll
        for (int i = 0; i < 16; ++i) mx = fmaxf(mx, a[i]);
        x[kb] = a;
    }
    mx = max32(mx);
    constexpr float C2 = 0.125f * LOG2E;
    const float mc = mx * C2; float l = 0.f;
#pragma unroll
    for (int kb = 0; kb < 5; ++kb)
#pragma unroll
        for (int i = 0; i < 16; ++i) { const float pe = __builtin_amdgcn_exp2f(x[kb][i] * C2 - mc); x[kb][i] = pe; l += pe; }
    l = sum32(l);
    f32x16 o[2];
#pragma unroll
    for (int dbk = 0; dbk < 2; ++dbk) o[dbk] = (f32x16){0.f, 0.f, 0.f, 0.f, 0.f, 0.f, 0.f, 0.f, 0.f, 0.f, 0.f, 0.f, 0.f, 0.f, 0.f, 0.f};
#pragma unroll
    for (int kb = 0; kb < 5; ++kb)
#pragma unroll
        for (int s = 0; s < 2; ++s) { const bf16x8 pa = PACK_STEP(x[kb], s);
#pragma unroll
            for (int dbk = 0; dbk < 2; ++dbk) o[dbk] = MFMA32(pa, ld_tr_perm(L + DL_VI, DP, 32 * wave + 32 * kb + 16 * s, dbk * 32, lane), o[dbk]); }
    LAS float* lw = (LAS float*)(L + DL_LW + wave * 256);
    if (h2 == 0) lw[r] = l;
    LAS unsigned char* st = L + DL_ST + wave * 32 * DP;
#pragma unroll
    for (int i = 0; i < 16; ++i) { const float rl = __builtin_amdgcn_rcpf(lw[crow(i, h2)]);
#pragma unroll
        for (int dbk = 0; dbk < 2; ++dbk) *(LAS bf16*)(st + crow(i, h2) * DP + (dbk * 32 + r) * 2) = cvt1(o[dbk][i] * rl); }
    const size_t tokbase = (size_t)b * SEQ;
    bf16* odp = OD + (size_t)p * M * 512;
#pragma unroll
    for (int j = 0; j < 4; ++j) { const int c = lane + 64 * j, row = c >> 3, cc = c & 7; const size_t tok = tokbase + (size_t)(q0 + 32 * wave + row) * dil + res;
        *(GAS v4u*)(odp + tok * 512 + head * 64 + cc * 8) = *(const LAS v4u*)(st + row * DP + cc * 16); }
    if (h2 == 0) { const size_t tok = tokbase + (size_t)(q0 + 32 * wave + r) * dil + res; LSE[((size_t)p * M + tok) * 8 + head] = mx * 0.125f + LN2 * __builtin_amdgcn_logf(l); }
    WG_BAR();
}
__device__ __forceinline__ void dil_combine(const Frame& F, const bf16* OD, const float* LSE, bf16* CAT) {
    for (int gt = F.bid * NTHREADS + F.tid; gt < M * 64; gt += F.G * NTHREADS) {
        const int tok = gt >> 6, c8 = gt & 63, head = c8 >> 3;
        const float l0 = LSE[(size_t)tok * 8 + head], l1 = LSE[((size_t)M + tok) * 8 + head], l2 = LSE[((size_t)2 * M + tok) * 8 + head];
        const float mxl = fmaxf(l0, fmaxf(l1, l2));
        float w0 = __builtin_amdgcn_exp2f((l0 - mxl) * LOG2E), w1 = __builtin_amdgcn_exp2f((l1 - mxl) * LOG2E), w2 = __builtin_amdgcn_exp2f((l2 - mxl) * LOG2E);
        const float rs = 1.0f / (w0 + w1 + w2); w0 *= rs; w1 *= rs; w2 *= rs;
        const v4u a = *(const GAS v4u*)(OD + (size_t)tok * 512 + c8 * 8), bq = *(const GAS v4u*)(OD + ((size_t)M + tok) * 512 + c8 * 8), cq = *(const GAS v4u*)(OD + ((size_t)2 * M + tok) * 512 + c8 * 8);
        v4u o;
#pragma unroll
        for (int i = 0; i < 4; ++i) o[i] = cvtpk(w0 * bflo(a[i]) + w1 * bflo(bq[i]) + w2 * bflo(cq[i]), w0 * bfhi(a[i]) + w1 * bfhi(bq[i]) + w2 * bfhi(cq[i]));
        *(GAS v4u*)(CAT + (size_t)tok * D + 512 + c8 * 8) = o;
    }
}
constexpr int DIL_TILES = 3072, DIL_SPLIT = 1024;
__device__ __forceinline__ void even_phase_a(const Frame& F0) {
    const Frame F = relaunder(F0);
    unsigned char* ws = WSP();
    const bf16* P = (const bf16*)(ws + WS_ACT); bf16* RKV = (bf16*)(ws + WS_XB); bf16* OD = (bf16*)(ws + WS_OD); float* LSE = (float*)(ws + WS_LSE);
    for (int it = F.bid; it < 1024; it += F.G) ret_phase_a_item(F, it, P, RKV);
    for (int T = F.bid; T < DIL_SPLIT; T += F.G) dil_tile(F, T, P, OD, LSE);
}
__device__ __forceinline__ void even_phase_b(const Frame& F0) {
    const Frame F = relaunder(F0);
    unsigned char* ws = WSP();
    const bf16* P = (const bf16*)(ws + WS_ACT); bf16* RKV = (bf16*)(ws + WS_XB); bf16* OD = (bf16*)(ws + WS_OD); float* LSE = (float*)(ws + WS_LSE);
    ret_scan(F, RKV);
    for (int T = DIL_SPLIT + F.bid; T < DIL_TILES; T += F.G) dil_tile(F, T, P, OD, LSE);
}
__device__ __forceinline__ void even_phase_c(const Frame& F0) {
    const Frame F = relaunder(F0);
    unsigned char* ws = WSP();
    const bf16* P = (const bf16*)(ws + WS_ACT); const bf16* RKV = (const bf16*)(ws + WS_XB); const bf16* OD = (const bf16*)(ws + WS_OD); const float* LSE = (const float*)(ws + WS_LSE); bf16* CAT = (bf16*)(ws + WS_CAT);
    for (int it = F.bid; it < 1024; it += F.G) ret_phase_c_item(F, it, P, RKV, CAT);
    dil_combine(F, OD, LSE, CAT);
}

__global__ void __launch_bounds__(NTHREADS, 2) fwd_kernel(Args args) {
    extern __shared__ __attribute__((aligned(16))) unsigned char lds[];
    Frame F;
    F.lds = (LAS unsigned char*)lds;
    F.wave = __builtin_amdgcn_readfirstlane((int)(threadIdx.x >> 6)); F.lane = hw_lane(); F.tid = F.wave * 64 + F.lane; F.G = gridDim.x; F.bid = blockIdx.x;
    for (int u = F.tid; u < (LDS_BYTES - LDSCTL_OFF) / 4; u += NTHREADS) ((LAS unsigned*)(F.lds + LDSCTL_OFF))[u] = 0u;
    __syncthreads();
    if (F.tid < N_PTRS) { const unsigned long long v = (F.tid < 17) ? (unsigned long long)args.in[F.tid] : (F.tid == 17 ? (unsigned long long)args.out : (unsigned long long)args.ws);
        ((LAS unsigned*)(F.lds + PTR_OFF))[2 * F.tid] = (unsigned)v; ((LAS unsigned*)(F.lds + PTR_OFF))[2 * F.tid + 1] = (unsigned)(v >> 32); }
    __syncthreads();
    (void)xcd_barrier_post((unsigned*)(WSP() + WS_CTL) + CW_BAR, (volatile LAS unsigned*)(F.lds + MISC_OFF) + 8, F.tid);
#ifdef PROBE_BARX2
#define PROBE_BAR2(b, t) xcd_barrier(b, t)
#else
#define PROBE_BAR2(b, t) do {} while (0)
#endif
#define GRID_BAR() do { XcdBarrier bar_; bar_.bar = (unsigned*)(WSP() + WS_CTL) + CW_BAR; bar_.x = (unsigned)__builtin_amdgcn_readfirstlane((int)xb_xcc_id()); \
        int mo_ = MISC_OFF + 32; asm volatile("" : "+s"(mo_)); bar_.st = (volatile LAS unsigned*)(F.lds + mo_); int t_ = threadIdx.x; asm volatile("" : "+v"(t_)); xcd_barrier(bar_, t_); PROBE_BAR2(bar_, t_); } while (0)
#define XB ((bf16*)(WSP() + WS_XB))
#define ACT ((bf16*)(WSP() + WS_ACT))
#define CAT ((bf16*)(WSP() + WS_CAT))
#define SSP ((float*)(WSP() + WS_SSP))
#define WPTR(off) ((const bf16*)(WSP() + (off)))

#ifdef TEST_MIN
    {
        pg8::Gemm g{XB, WPTR(W_GU0), M, 2 * FF, D}; pg8::StaticOrder S; S.init(M, 2 * FF, lnd(F.G), lnd(F.bid));
        pg8::EpiSwiGLU E{ACT, FF, SSP};
        pg8::gemm_phase<pg8::EpiSwiGLU, pg8::StaticOrder, true, true>(F.lds + RING_OFF, g, S, E, lnd(F.wave));
        GRID_BAR();
        return;
    }
#endif
    prologue_rows(F);
    convert_weights(F, 0);
    GRID_BAR();
    for (int s = 0; s < 8; ++s) {
        const int l = s >> 1; const bool post = (s & 1) != 0;
#ifdef PROBE_F1X2
        for (int rep = 0; rep < 2; ++rep)
#endif
        {
#ifdef PROBE_KX2
            typedef pg8::TwiceOrder F1Order;
#else
            typedef pg8::StaticOrder F1Order;
#endif
            pg8::Gemm g{XB, WPTR(post ? W_GU1 : W_GU0), M, 2 * FF, D}; F1Order S; S.init(M, 2 * FF, lnd(F.G), lnd(F.bid));
            pg8::EpiSwiGLU E{ACT, FF, SSP};
#ifndef NO_F1
            pg8::gemm_phase<pg8::EpiSwiGLU, F1Order, true, true>(F.lds + RING_OFF, g, S, E, lnd(F.wave));
#endif
            GRID_BAR();
        }
#ifdef PROBE_F2X2
        for (int rep = 0; rep < 2; ++rep)
#else
        constexpr int rep = 1;
#endif
        {
            pg8::Gemm g{ACT, WPTR(post ? W_D1 : W_D0), M, D, FF}; pg8::StaticOrder S; S.init(M, D, lnd(F.G), lnd(F.bid));
            pg8::EpiResid E{s == 0 ? AP(I_X) : (const float*)OUTP(), OUTP(), XB, SSP, rep ? 0.5f : 0.0f};
#ifndef NO_F2
            pg8::gemm_phase<pg8::EpiResid, pg8::StaticOrder, true, true>(F.lds + RING_OFF, g, S, E, lnd(F.wave));
#endif
            GRID_BAR();
        }
        if (!post) {
            const bool odd = (l & 1) != 0; const int nin = odd ? GLA_INP : EVEN_IN;
            {
                pg8::Gemm g{XB, WPTR(W_IN), M, nin, D}; pg8::StaticOrder S; S.init(M, nin, lnd(F.G), lnd(F.bid));
                pg8::EpiScaleBf16 E{ACT, nin, SSP};
#ifndef NO_M1
                pg8::gemm_phase<pg8::EpiScaleBf16, pg8::StaticOrder, true, true>(F.lds + RING_OFF, g, S, E, lnd(F.wave));
#endif
            }
            GRID_BAR();
#ifndef NO_EVEN
#if defined(PROBE_MIXX2) || defined(PROBE_EVENX2)
            if (!odd) { even_prep(F); GRID_BAR(); even_phase_a(F); GRID_BAR(); even_phase_a(F); GRID_BAR(); even_phase_b(F); GRID_BAR(); even_phase_c(F); GRID_BAR(); even_phase_c(F); }
#else
            if (!odd) { even_prep(F); GRID_BAR(); even_phase_a(F); GRID_BAR(); even_phase_b(F); GRID_BAR(); even_phase_c(F); }
#endif
#endif
#ifndef NO_GLA
            if (odd) {
#ifndef NO_GA
                gla_phase_a(F, l >> 1);
#endif
#ifdef PROBE_MIXX2
                GRID_BAR(); gla_phase_a(F, l >> 1);
#endif
                GRID_BAR();
#ifndef NO_GB
                gla_phase_b(F);
#endif
                GRID_BAR();
#ifndef NO_GC
                gla_phase_c(F, l >> 1);
#endif
#ifdef PROBE_MIXX2
                GRID_BAR(); gla_phase_c(F, l >> 1);
#endif
            }
#endif
            GRID_BAR();
#ifdef PROBE_M5X2
            for (int rep2 = 0; rep2 < 2; ++rep2)
#else
            constexpr int rep2 = 1;
#endif
            {
                pg8::Gemm g{CAT, WPTR(W_OUT), M, D, D}; pg8::StaticOrder S; S.init(M, D, lnd(F.G), lnd(F.bid));
                pg8::EpiResid E{(const float*)OUTP(), OUTP(), XB, SSP, rep2 ? 1.0f : 0.0f};
#ifndef NO_M5
                pg8::gemm_phase<pg8::EpiResid, pg8::StaticOrder, true, true>(F.lds + RING_OFF, g, S, E, lnd(F.wave));
#endif
                GRID_BAR();
            }
        } else if (l + 1 < DEPTH) {
            convert_weights(F, l + 1);
            GRID_BAR();
#ifdef PROBE_CONVX2
            convert_weights(F, l + 1);
            GRID_BAR();
#endif
        }
    }
    final_norm(F);
}

extern "C" void kernel_launch(void* const* d_in, const int* in_sizes, int n_in, void* d_out, int out_size, void* d_ws, size_t ws_size, hipStream_t stream) {
    static int grid = 0;
    if (grid == 0) {
        if (n_in != 17 || in_sizes[0] != M * D || out_size != M * D || ws_size < WS_END2) { fprintf(stderr, "kernel_launch: unexpected shapes (n_in %d, in0 %d, out %d, ws %zu)\n", n_in, n_in > 0 ? in_sizes[0] : -1, out_size, ws_size); grid = -1; return; }
        int dev = 0, cus = 0, per_cu = 0;
        if (hipGetDevice(&dev) != hipSuccess || hipDeviceGetAttribute(&cus, hipDeviceAttributeMultiprocessorCount, dev) != hipSuccess) { grid = -1; return; }
        if (hipFuncSetAttribute((const void*)fwd_kernel, hipFuncAttributeMaxDynamicSharedMemorySize, LDS_BYTES) != hipSuccess) { fprintf(stderr, "kernel_launch: hipFuncSetAttribute failed\n"); grid = -1; return; }
        if (hipOccupancyMaxActiveBlocksPerMultiprocessor(&per_cu, (const void*)fwd_kernel, NTHREADS, LDS_BYTES) != hipSuccess || per_cu < 1) { fprintf(stderr, "kernel_launch: occupancy query reports %d\n", per_cu); }
        (void)hipGetLastError();
        grid = cus;
        if (grid != 256) fprintf(stderr, "kernel_launch: %d CUs (expected 256)\n", grid);
    }
    if (grid < 0) return;
    if (hipMemsetAsync((char*)d_ws + WS_CTL, 0, CTL_ZERO_BYTES, stream) != hipSuccess) return;
    Args a{};
    for (int i = 0; i < 17; ++i) a.in[i] = (const float*)d_in[i];
    a.out = (float*)d_out; a.ws = (unsigned char*)d_ws;
    hipLaunchKernelGGL(fwd_kernel, dim3(grid), dim3(NTHREADS), LDS_BYTES, stream, a);
}
```

```cpp
#include <hip/hip_runtime.h>
#include <cstdio>
#include <cstdint>
#include <cmath>
template <int K> __device__ __forceinline__ float xsw(float v) { static_assert(K == 1 || K == 2 || K == 4 || K == 8 || K == 16, "xor mask inside a 32-lane half");
    return __builtin_bit_cast(float, __builtin_amdgcn_ds_swizzle(__builtin_bit_cast(int, v), 0x1F | (K << 10))); }
__device__ __forceinline__ float sum32(float v) { const unsigned u = __builtin_bit_cast(unsigned, v); auto rr = __builtin_amdgcn_permlane32_swap(u, u, false, false); return __builtin_bit_cast(float, (unsigned)rr[0]) + __builtin_bit_cast(float, (unsigned)rr[1]); }
__device__ __forceinline__ float max32(float v) { const unsigned u = __builtin_bit_cast(unsigned, v); auto rr = __builtin_amdgcn_permlane32_swap(u, u, false, false); return fmaxf(__builtin_bit_cast(float, (unsigned)rr[0]), __builtin_bit_cast(float, (unsigned)rr[1])); }
__device__ __forceinline__ float oth32(float v, int h) { const unsigned u = __builtin_bit_cast(unsigned, v); auto rr = __builtin_amdgcn_permlane32_swap(u, u, false, false); return __builtin_bit_cast(float, (unsigned)(h ? rr[0] : rr[1])); }
namespace pg8 {
#define PG8_LAS __attribute__((address_space(3)))
typedef unsigned short bf16_t;
typedef short bf16x8 __attribute__((ext_vector_type(8)));
typedef float f32x4 __attribute__((ext_vector_type(4)));
typedef unsigned u32x4 __attribute__((ext_vector_type(4)));
constexpr int BM = 256, BK = 64, HALF = 128, HTB = HALF * BK * 2  , STAGE_BYTES = 8 * HTB, NXCD = 8, WGM = 8;

__host__ __device__ __forceinline__ int lds_byte(int r, int c) { const int st = (r >> 4) * 2 + (c >> 5), rr = r & 15, cc = c & 31, ob = rr * 64 + cc * 2; return st * 1024 + (ob ^ (((ob >> 9) & 1) << 5)); }
__host__ __device__ __forceinline__ void stage_rc(int b, int& R, int& C) { const int st = b / 1024, sb = b % 1024, swz = sb ^ (((sb >> 9) & 1) << 5); R = (st >> 1) * 16 + swz / 64; C = (st & 1) * 32 + (swz % 64) / 2; }
__host__ __device__ __forceinline__ int perm32(int rho) { const int n = rho >> 4, i = rho & 15; return 8 * (i >> 2) + 4 * n + (i & 3); }

struct Unit { int pm, pn; };
struct Gemm { const bf16_t* A; const bf16_t* Bt; int M, N, K; };

struct StaticOrder {
    int nM, nN, nwg, G, c;
    __host__ __device__ void init(int M, int N, int G_, int c_) { nM = M / BM; nN = N / BM; nwg = nM * nN; G = G_; c = c_; }
    __host__ __device__ bool next(int i, Unit& u) const {
        const long L = (long)i * G + c; if (L >= nwg) return false;
        int wgid = (int)L; { const int q = nwg / NXCD, r = nwg % NXCD, xcd = wgid % NXCD, off = wgid / NXCD; wgid = (xcd < r ? xcd * (q + 1) : r * (q + 1) + (xcd - r) * q) + off; }
        const int nig = WGM * nN, gid = wgid / nig, fm = gid * WGM, gsz = (nM - fm) < WGM ? (nM - fm) : WGM;
        u.pm = fm + ((wgid % nig) % gsz); u.pn = (wgid % nig) / gsz; return true;
    }
    __device__ __forceinline__ void a_ready(const Unit&) const {}
    __device__ __forceinline__ void done(const Unit&) const {}
    static constexpr bool TWICE = false;
};
struct TwiceOrder : StaticOrder {
    static constexpr bool TWICE = true;
    __host__ __device__ bool next(int i, Unit& u) const { return StaticOrder::next(i >> 1, u); }
};

__device__ __forceinline__ unsigned cvt_pk_bf16(float lo, float hi) { unsigned r; asm volatile("v_cvt_pk_bf16_f32 %0, %1, %2" : "=v"(r) : "v"(lo), "v"(hi)); return r; }
constexpr int MROWS = 32768;
constexpr float RMS_EPS = 1e-6f;
__device__ __forceinline__ void row_rstd(float (&rs)[2][4], const float* ssp, const Unit& u, int wr, int fr, int fq) {
#pragma unroll
    for (int ai = 0; ai < 2; ++ai)
#pragma unroll
        for (int m = 0; m < 4; ++m) {
            const int row = u.pm * BM + ai * HALF + wr * 64 + m * 16 + fr;
            const f32x4 p = *(const f32x4*)(ssp + (size_t)row * 16 + 4 * fq);
            float s = (p[0] + p[1]) + (p[2] + p[3]);
            s += xsw<16>(s); s = sum32(s);
            rs[ai][m] = 1.0f / sqrtf(s * (1.0f / 1024.0f) + RMS_EPS);
        }
}
__device__ __forceinline__ float silu_f(float g) { return g * __builtin_amdgcn_rcpf(1.0f + __builtin_amdgcn_exp2f(-1.4426950408889634f * g)); }

struct EpiSwiGLU {
    static constexpr bool PERM = true, AFTER_DRAIN = false;
    bf16_t* H; int ldh; const float* ssp;
    __device__ __forceinline__ void operator()(const f32x4 (&acc)[2][2][4][2], const Unit& u, int wr, int wc, int fr, int fq) const {
        float rs[2][4]; row_rstd(rs, ssp, u, wr, fr, fq);
        const int col0 = u.pn * HALF + wc * 32 + 8 * fq;
#pragma unroll
        for (int ai = 0; ai < 2; ++ai)
#pragma unroll
            for (int m = 0; m < 4; ++m) {
                const int row = u.pm * BM + ai * HALF + wr * 64 + m * 16 + fr; const float r = rs[ai][m];
                float h[8];
#pragma unroll
                for (int n = 0; n < 2; ++n)
#pragma unroll
                    for (int i = 0; i < 4; ++i) { const float g = acc[ai][0][m][n][i] * r, up = acc[ai][1][m][n][i] * r; h[4 * n + i] = silu_f(g) * up; }
                u32x4 w; w.x = cvt_pk_bf16(h[0], h[1]); w.y = cvt_pk_bf16(h[2], h[3]); w.z = cvt_pk_bf16(h[4], h[5]); w.w = cvt_pk_bf16(h[6], h[7]);
                *(u32x4*)(H + (size_t)row * ldh + col0) = w;
                asm volatile("" ::: "memory");
            }
    }
};
struct EpiScaleBf16 {
    static constexpr bool PERM = true, AFTER_DRAIN = false;
    bf16_t* O; int ldc; const float* ssp;
    __device__ __forceinline__ void operator()(const f32x4 (&acc)[2][2][4][2], const Unit& u, int wr, int wc, int fr, int fq) const {
        float rs[2][4]; row_rstd(rs, ssp, u, wr, fr, fq);
        const int col0 = u.pn * BM + wc * 32 + 8 * fq;
#pragma unroll
        for (int ai = 0; ai < 2; ++ai)
#pragma unroll
            for (int m = 0; m < 4; ++m) {
                const int row = u.pm * BM + ai * HALF + wr * 64 + m * 16 + fr; const float r = rs[ai][m];
#pragma unroll
                for (int bj = 0; bj < 2; ++bj) { const f32x4 v0 = acc[ai][bj][m][0] * r, v1 = acc[ai][bj][m][1] * r;
                    u32x4 w; w.x = cvt_pk_bf16(v0[0], v0[1]); w.y = cvt_pk_bf16(v0[2], v0[3]); w.z = cvt_pk_bf16(v1[0], v1[1]); w.w = cvt_pk_bf16(v1[2], v1[3]);
                    *(u32x4*)(O + (size_t)row * ldc + col0 + bj * HALF) = w; }
                asm volatile("" ::: "memory");
            }
    }
};
struct EpiResid {
    static constexpr bool PERM = true, AFTER_DRAIN = false;
    const float* xold; float* xnew; bf16_t* xb; float* ssp; float scale;
    __device__ __forceinline__ void operator()(const f32x4 (&acc)[2][2][4][2], const Unit& u, int wr, int wc, int fr, int fq) const {
        const int col0 = u.pn * BM + wc * 32 + 8 * fq, rowb = u.pm * BM + wr * 64 + fr;
        f32x4 buf[2][4];
#define EPR_LOAD(g, slot) do { const size_t off_ = (size_t)(rowb + ((g) >> 2) * HALF + ((g) & 3) * 16) * 1024 + col0; \
        buf[slot][0] = *(const f32x4*)(xold + off_); buf[slot][1] = *(const f32x4*)(xold + off_ + 4); buf[slot][2] = *(const f32x4*)(xold + off_ + HALF); buf[slot][3] = *(const f32x4*)(xold + off_ + HALF + 4); } while (0)
        EPR_LOAD(0, 0); EPR_LOAD(1, 1);
        asm volatile("" ::: "memory");
#pragma unroll
        for (int g = 0; g < 8; ++g) {
            const int ai = g >> 2, m = g & 3, row = rowb + ai * HALF + m * 16; float ss = 0.f;
#pragma unroll
            for (int bj = 0; bj < 2; ++bj) { const size_t off = (size_t)row * 1024 + col0 + bj * HALF;
                const f32x4 v0 = buf[g & 1][2 * bj] + acc[ai][bj][m][0] * scale, v1 = buf[g & 1][2 * bj + 1] + acc[ai][bj][m][1] * scale;
                *(f32x4*)(xnew + off) = v0; *(f32x4*)(xnew + off + 4) = v1;
                u32x4 w; w.x = cvt_pk_bf16(v0[0], v0[1]); w.y = cvt_pk_bf16(v0[2], v0[3]); w.z = cvt_pk_bf16(v1[0], v1[1]); w.w = cvt_pk_bf16(v1[2], v1[3]);
                *(u32x4*)(xb + off) = w;
                ss += (v0[0] * v0[0] + v0[1] * v0[1]) + (v0[2] * v0[2] + v0[3] * v0[3]) + (v1[0] * v1[0] + v1[1] * v1[1]) + (v1[2] * v1[2] + v1[3] * v1[3]); }
            ss += xsw<16>(ss); ss = sum32(ss);
            if (fq == 0) ssp[(size_t)row * 16 + u.pn * 4 + wc] = ss;
            asm volatile("" ::: "memory");
            if (g + 2 < 8) { EPR_LOAD(g + 2, g & 1); asm volatile("" ::: "memory"); }
        }
#undef EPR_LOAD
    }
};

template <class Epi, class Sched, bool ALIGN_EPI = false, bool SP2 = false>
__device__ __forceinline__ void gemm_phase(PG8_LAS unsigned char* lds, const Gemm g, const Sched& S, const Epi& E, int wave_in) {
    int tid_ = threadIdx.x; asm volatile("" : "+v"(tid_));
    const int tid = tid_, wid = __builtin_amdgcn_readfirstlane(tid >> 6), lane = tid & 63, wr = wid >> 2, wc = wid & 3, fr = lane & 15, fq = lane >> 4;
    const int K = g.K, nt = K / BK;
    unsigned voffA[2], voffB[2];
#pragma unroll
    for (int i = 0; i < 2; ++i) { int R, C; stage_rc(tid * 16 + i * 8192, R, C); const int Rb = Epi::PERM ? ((R & ~31) + perm32(R & 31)) : R;
        voffA[i] = (unsigned)(R * K + C) * 2u; voffB[i] = (unsigned)(Rb * K + C) * 2u; }
    const size_t kstep = (size_t)(BK * 2);
    const size_t hstep = (size_t)HALF * K * 2;
    const size_t tstep = 2 * hstep;
    const unsigned ldsw = (unsigned)wid * 1024u;
    const int aoff = lds_byte(wr * 64 + fr, fq * 8), boff = lds_byte(wc * 32 + fr, fq * 8);
#define PG8_SA(b, h) (((b) * 2 + (h)) * HTB)
#define PG8_SB(b, h) ((4 + (b) * 2 + (h)) * HTB)
#define PG8_STAGE(bufoff, gbase, voff) do { _Pragma("unroll") for (int _i = 0; _i < 2; ++_i) \
        __builtin_amdgcn_global_load_lds((const unsigned*)((const char*)(gbase) + (voff)[_i]), (PG8_LAS unsigned*)(lds + (bufoff) + ldsw + _i * 8192), 16, 0, 0); } while (0)
#define PG8_LDA(dst, b, h) do { _Pragma("unroll") for (int m = 0; m < 4; ++m) _Pragma("unroll") for (int k = 0; k < 2; ++k) dst[m][k] = *(const PG8_LAS bf16x8*)(lds + PG8_SA(b, h) + aoff + m * 2048 + k * 1024); } while (0)
#define PG8_LDB(dst, b, h) do { _Pragma("unroll") for (int n = 0; n < 2; ++n) _Pragma("unroll") for (int k = 0; k < 2; ++k) dst[n][k] = *(const PG8_LAS bf16x8*)(lds + PG8_SB(b, h) + boff + n * 2048 + k * 1024); } while (0)
#define PG8_MMA(ai, bj, At, Bt) do { __builtin_amdgcn_s_setprio(1); _Pragma("unroll") for (int m = 0; m < 4; ++m) _Pragma("unroll") for (int n = 0; n < 2; ++n) _Pragma("unroll") for (int k = 0; k < 2; ++k) \
        acc[ai][bj][m][n] = __builtin_amdgcn_mfma_f32_16x16x32_bf16(Bt[n][k], At[m][k], acc[ai][bj][m][n], 0, 0, 0); __builtin_amdgcn_s_setprio(0); } while (0)
#define PG8_WAIT_V(n) asm volatile("s_waitcnt vmcnt(" #n ")" ::: "memory")
#define PG8_WAIT_L(n) asm volatile("s_waitcnt lgkmcnt(" #n ")" ::: "memory")
#define PG8_BAR __builtin_amdgcn_s_barrier()
#define PG8_SCHED __builtin_amdgcn_sched_barrier(0)
    Unit cur, nxt; int ui = 0;
    if (!S.next(0, cur)) return;
    f32x4 acc[2][2][4][2];
#pragma unroll
    for (int a = 0; a < 2; ++a)
#pragma unroll
        for (int b = 0; b < 2; ++b)
#pragma unroll
            for (int m = 0; m < 4; ++m)
#pragma unroll
                for (int n = 0; n < 2; ++n) acc[a][b][m][n] = (f32x4){0.f, 0.f, 0.f, 0.f};
    bf16x8 At[4][2], B0[2][2], B1[2][2];
    const char* cA = (const char*)g.A + (size_t)cur.pm * tstep; const char* cB = (const char*)g.Bt + (size_t)cur.pn * tstep;
    S.a_ready(cur);
    if constexpr (SP2) {
        PG8_STAGE(PG8_SB(0, 0), cB, voffB); PG8_STAGE(PG8_SB(0, 1), cB + hstep, voffB); PG8_STAGE(PG8_SA(0, 0), cA, voffA); PG8_STAGE(PG8_SA(0, 1), cA + hstep, voffA);
        if (wr == 1) PG8_BAR;
        PG8_WAIT_V(2); PG8_BAR;
        PG8_STAGE(PG8_SB(1, 0), cB + kstep, voffB); PG8_STAGE(PG8_SA(1, 0), cA + kstep, voffA); PG8_STAGE(PG8_SB(1, 1), cB + hstep + kstep, voffB);
        PG8_WAIT_V(6); PG8_BAR;
    } else {
        PG8_STAGE(PG8_SB(0, 0), cB, voffB); PG8_STAGE(PG8_SA(0, 0), cA, voffA); PG8_STAGE(PG8_SB(0, 1), cB + hstep, voffB); PG8_STAGE(PG8_SA(0, 1), cA + hstep, voffA);
        if (wr == 1) PG8_BAR;
        PG8_WAIT_V(4); PG8_BAR;
        PG8_STAGE(PG8_SB(1, 0), cB + kstep, voffB); PG8_STAGE(PG8_SA(1, 0), cA + kstep, voffA); PG8_STAGE(PG8_SB(1, 1), cB + hstep + kstep, voffB);
        PG8_WAIT_V(6); PG8_BAR;
    }
    for (;;) {
        const bool has_next = S.next(ui + 1, nxt);
        const char* nA = has_next ? (const char*)g.A + (size_t)nxt.pm * tstep : cA; const char* nB = has_next ? (const char*)g.Bt + (size_t)nxt.pn * tstep : cB;
        for (int t = 0; t < nt; t += 2) {
            const bool last = (t == nt - 2);
            const char* a1 = cA + (size_t)(t + 1) * kstep;
            const char* a2 = last ? nA : cA + (size_t)(t + 2) * kstep; const char* b2 = last ? nB : cB + (size_t)(t + 2) * kstep;
            const char* a3 = a2 + kstep; const char* b3 = b2 + kstep;
            if (last && has_next) S.a_ready(nxt);
            if constexpr (SP2) {
            PG8_LDB(B0, 0, 0); PG8_LDB(B1, 0, 1); PG8_SCHED; PG8_LDA(At, 0, 0); PG8_STAGE(PG8_SA(1, 1), a1 + hstep, voffA);
            PG8_WAIT_V(8); PG8_WAIT_L(0); PG8_BAR; PG8_MMA(0, 0, At, B0); PG8_MMA(0, 1, At, B1); PG8_BAR; PG8_SCHED;
            PG8_LDA(At, 0, 1); PG8_STAGE(PG8_SB(0, 0), b2, voffB); PG8_STAGE(PG8_SB(0, 1), b2 + hstep, voffB); PG8_STAGE(PG8_SA(0, 0), a2, voffA);
            PG8_WAIT_V(8); PG8_WAIT_L(0); PG8_BAR; PG8_MMA(1, 0, At, B0); PG8_MMA(1, 1, At, B1); PG8_BAR; PG8_SCHED;
            PG8_LDB(B0, 1, 0); PG8_LDB(B1, 1, 1); PG8_SCHED; PG8_LDA(At, 1, 0); PG8_STAGE(PG8_SA(0, 1), a2 + hstep, voffA);
            PG8_WAIT_V(8); PG8_WAIT_L(0); PG8_BAR; PG8_MMA(0, 0, At, B0); PG8_MMA(0, 1, At, B1); PG8_BAR; PG8_SCHED;
            PG8_LDA(At, 1, 1); PG8_STAGE(PG8_SB(1, 0), b3, voffB); PG8_STAGE(PG8_SB(1, 1), b3 + hstep, voffB); PG8_STAGE(PG8_SA(1, 0), a3, voffA);
            PG8_WAIT_V(8); PG8_WAIT_L(0); PG8_BAR; PG8_MMA(1, 0, At, B0); PG8_MMA(1, 1, At, B1); PG8_BAR; PG8_SCHED;
            } else {
            PG8_LDB(B0, 0, 0); PG8_SCHED; PG8_LDA(At, 0, 0); PG8_STAGE(PG8_SA(1, 1), a1 + hstep, voffA);
            PG8_WAIT_L(8); PG8_BAR; PG8_WAIT_L(0); PG8_MMA(0, 0, At, B0); PG8_BAR; PG8_SCHED;
            PG8_LDB(B1, 0, 1); PG8_STAGE(PG8_SB(0, 0), b2, voffB);
            PG8_BAR; PG8_WAIT_L(0); PG8_MMA(0, 1, At, B1); PG8_BAR;
            PG8_LDA(At, 0, 1); PG8_STAGE(PG8_SA(0, 0), a2, voffA);
            PG8_BAR; PG8_WAIT_L(0); PG8_MMA(1, 0, At, B0); PG8_BAR; PG8_SCHED;
            PG8_STAGE(PG8_SB(0, 1), b2 + hstep, voffB);
            PG8_WAIT_V(6); PG8_BAR; PG8_MMA(1, 1, At, B1); PG8_BAR;
            PG8_LDB(B0, 1, 0); PG8_SCHED; PG8_LDA(At, 1, 0); PG8_STAGE(PG8_SA(0, 1), a2 + hstep, voffA);
            PG8_WAIT_L(8); PG8_BAR; PG8_WAIT_L(0); PG8_MMA(0, 0, At, B0); PG8_BAR; PG8_SCHED;
            PG8_LDB(B1, 1, 1); PG8_STAGE(PG8_SB(1, 0), b3, voffB);
            PG8_BAR; PG8_WAIT_L(0); PG8_MMA(0, 1, At, B1); PG8_BAR;
            PG8_LDA(At, 1, 1); PG8_STAGE(PG8_SA(1, 0), a3, voffA);
            PG8_BAR; PG8_WAIT_L(0); PG8_MMA(1, 0, At, B0); PG8_BAR; PG8_SCHED;
            PG8_STAGE(PG8_SB(1, 1), b3 + hstep, voffB);
            PG8_WAIT_V(6); PG8_BAR; PG8_MMA(1, 1, At, B1); PG8_BAR;
            }
        }
        if constexpr (ALIGN_EPI) { if (wr == 0) PG8_BAR; }
        if constexpr (!Epi::AFTER_DRAIN) { if (!Sched::TWICE || (ui & 1)) { E(acc, cur, wr, wc, fr, fq); S.done(cur); } }
        if (!has_next) break;
#pragma unroll
        for (int a = 0; a < 2; ++a)
#pragma unroll
            for (int b = 0; b < 2; ++b)
#pragma unroll
                for (int m = 0; m < 4; ++m)
#pragma unroll
                    for (int n = 0; n < 2; ++n) acc[a][b][m][n] = (f32x4){0.f, 0.f, 0.f, 0.f};
        cur = nxt; cA = nA; cB = nB; ++ui;
        if constexpr (ALIGN_EPI) { if (wr == 1) PG8_BAR; }
    }
    PG8_WAIT_V(0);
    if constexpr (!ALIGN_EPI) { if (wr == 0) PG8_BAR; }
    PG8_BAR;
    if constexpr (Epi::AFTER_DRAIN) { E.fused(acc, cur, wr, wc, fr, fq, lds, wid, lane); S.done(cur); }
#undef PG8_SA
#undef PG8_SB
#undef PG8_STAGE
#undef PG8_LDA
#undef PG8_LDB
#undef PG8_MMA
#undef PG8_WAIT_V
#undef PG8_WAIT_L
#undef PG8_BAR
#undef PG8_SCHED
}
}

constexpr int NWAVES = 8, NTHREADS = NWAVES * 64;
constexpr int BATCH = 8, SEQ = 4096, D = 1024, M = BATCH * SEQ, FF = 2816, DEPTH = 4;
constexpr int EVEN_IN = 3584, GLA_IN = 3088, GLA_INP = 3328;
static_assert(M == pg8::MROWS, "row count");
constexpr int E_RQ = 0, E_RK = 512, E_RV = 1024, E_RG = 1536, E_DQ = 2048, E_DK = 2560, E_DV = 3072;
constexpr int G_Q = 0, G_K = 512, G_V = 1024, G_R = 2048, G_A = 3072;
constexpr float EPS = 1e-6f;

constexpr size_t MiB = 1u << 20;
constexpr size_t WS_CTL = 0, CTL_ZERO_BYTES = 1 * MiB;
constexpr size_t WS_SSP = 1 * MiB;
constexpr size_t WS_TAB = 3 * MiB;
constexpr size_t TAB_RC = WS_TAB, TAB_RS = WS_TAB + 1 * MiB, TAB_DC = WS_TAB + 2 * MiB, TAB_DS = WS_TAB + 2 * MiB + 128 * 1024;
constexpr size_t WS_W = 8 * MiB;
constexpr size_t W_GU0 = WS_W, W_D0 = W_GU0 + (size_t)2 * FF * D * 2, W_GU1 = W_D0 + (size_t)D * FF * 2, W_D1 = W_GU1 + (size_t)2 * FF * D * 2,
                 W_IN = W_D1 + (size_t)D * FF * 2, W_OUT = W_IN + (size_t)EVEN_IN * D * 2, W_END = W_OUT + (size_t)D * D * 2;
constexpr size_t WS_XB = 56 * MiB;
constexpr size_t WS_ACT = 120 * MiB;
constexpr size_t WS_CAT = 344 * MiB;
constexpr size_t WS_END = 408 * MiB;
static_assert(W_END <= WS_XB && WS_XB + (size_t)M * D * 2 <= WS_ACT && WS_ACT + (size_t)M * EVEN_IN * 2 <= WS_CAT && WS_CAT + (size_t)M * D * 2 <= WS_END, "d_ws map");
constexpr int CW_BAR = 4096;

constexpr int RING_OFF = 0, RING_BYTES = 131072;
constexpr int LDSCTL_OFF = 161792, MISC_OFF = LDSCTL_OFF + 320, PTR_OFF = LDSCTL_OFF + 1024;
constexpr int LDS_BYTES = 163840;
static_assert(PTR_OFF + 19 * 8 <= LDS_BYTES && RING_BYTES <= LDSCTL_OFF, "LDS map");

#define GAS __attribute__((address_space(1)))
#define LAS __attribute__((address_space(3)))
typedef unsigned short bf16;
typedef unsigned v4u __attribute__((ext_vector_type(4)));
typedef float f32x4 __attribute__((ext_vector_type(4)));
typedef short bf16x8 __attribute__((ext_vector_type(8)));
typedef GAS unsigned gu32;
typedef GAS unsigned long long gu64;
#define RLX_AGENT __ATOMIC_RELAXED, __HIP_MEMORY_SCOPE_AGENT
#define LDS_WAIT() asm volatile("s_waitcnt lgkmcnt(0)" ::: "memory")
#define VM_WAIT() asm volatile("s_waitcnt vmcnt(0)" ::: "memory")
__device__ __forceinline__ unsigned long long rt() { return __builtin_amdgcn_s_memrealtime(); }
__device__ __forceinline__ unsigned f2bf(float f) { unsigned u = __builtin_bit_cast(unsigned, f); return (u + 0x7fffu + ((u >> 16) & 1u)) >> 16; }
__device__ __forceinline__ unsigned pk2(float lo, float hi) { return f2bf(lo) | (f2bf(hi) << 16); }

#define XB_TMO      128
#define XB_XCNT(j)  (256  + 64 * (j))
#define XB_XSUB(j)  (1280 + 64 * (j))
#define XB_XGEN(j)  (2304 + 64 * (j))
#define XB_TOP      3328
#define XB_TOPGEN   3392
#define XCD_BAR_WORDS 3456
#define XB_SPIN_CAP (1u << 18)

__device__ __forceinline__ unsigned xb_ld(unsigned* p)              { return __hip_atomic_load(p, __ATOMIC_RELAXED, __HIP_MEMORY_SCOPE_AGENT); }
__device__ __forceinline__ unsigned xb_add(unsigned* p, unsigned v) { return __hip_atomic_fetch_add(p, v, __ATOMIC_RELAXED, __HIP_MEMORY_SCOPE_AGENT); }
__device__ __forceinline__ unsigned xb_xcc_id() { return (unsigned)__builtin_amdgcn_s_getreg((3 << 11) | 20) & 0xFu; }
#define XB_SPIN(cond, bar) do { unsigned _sp = 0; while (cond) { __builtin_amdgcn_s_sleep(1); \
    if ((++_sp & 255u) == 0u) { if (xb_ld(&(bar)[XB_TMO])) break; if (_sp > XB_SPIN_CAP) { atomicAdd(&(bar)[XB_TMO], 1u); break; } } } } while (0)

struct XcdBarrier {
    unsigned* bar; unsigned x;
    volatile LAS unsigned* st;
};

__device__ __forceinline__ XcdBarrier xcd_barrier_post(unsigned* bar, volatile LAS unsigned* st, int tid) {
    XcdBarrier b; b.bar = bar; b.x = xb_xcc_id(); b.st = st;
    if (tid == 0) (void)xb_add(&bar[XB_XCNT(b.x)], 1u);
    return b;
}
__device__ __forceinline__ void xcd_barrier_complete(unsigned* bar, unsigned x, unsigned& nloc, unsigned& nx) {
    const unsigned G = gridDim.x * gridDim.y * gridDim.z;
    unsigned sum, cnt, mine, sp = 0u;
    for (;;) {
        sum = 0u; cnt = 0u; mine = 0u;
#pragma unroll
        for (unsigned j = 0; j < 16; ++j) { const unsigned c = xb_ld(&bar[XB_XCNT(j)]); sum += c; cnt += (c > 0u) ? 1u : 0u; mine = (j == x) ? c : mine; }
        if (sum == G) break;
        __builtin_amdgcn_s_sleep(1);
        if ((++sp & 255u) == 0u) { if (xb_ld(&bar[XB_TMO])) break; if (sp > XB_SPIN_CAP) { atomicAdd(&bar[XB_TMO], 1u); break; } }
    }
    nloc = mine > 0u ? mine : 1u; nx = cnt > 0u ? cnt : 1u;
}

__device__ __forceinline__ void xcd_barrier(const XcdBarrier& b, int tid) {
    asm volatile("s_waitcnt vmcnt(0)" ::: "memory");
    __syncthreads();
    if (tid == 0) {
        unsigned* bar = b.bar;
        __builtin_amdgcn_s_waitcnt(0);
        unsigned nloc = b.st[0], nx = b.st[1];
        if (nloc == 0u) { xcd_barrier_complete(bar, b.x, nloc, nx); b.st[0] = nloc; b.st[1] = nx; }
        const unsigned old = xb_add(&bar[XB_XSUB(b.x)], 1u);
        const unsigned gen = old / nloc;
        if (old + 1u == (gen + 1u) * nloc) {
            __builtin_amdgcn_fence(__ATOMIC_RELEASE, "agent");
            asm volatile("s_waitcnt vmcnt(0)" ::: "memory");
            const unsigned og = xb_add(&bar[XB_TOP], 1u);
            const unsigned tg = og / nx;
            if (og + 1u == (tg + 1u) * nx) xb_add(&bar[XB_TOPGEN], 1u);
            else XB_SPIN(xb_ld(&bar[XB_TOPGEN]) == tg, bar);
            __builtin_amdgcn_fence(__ATOMIC_ACQUIRE, "agent");
            xb_add(&bar[XB_XGEN(b.x)], 1u);
            asm volatile("s_waitcnt vmcnt(0)" ::: "memory");
        } else {
            XB_SPIN(xb_ld(&bar[XB_XGEN(b.x)]) == gen, bar);
            __builtin_amdgcn_fence(__ATOMIC_ACQUIRE, "agent");
            asm volatile("s_waitcnt vmcnt(0)" ::: "memory");
        }
    }
    __syncthreads();
}

__constant__ float RET_FREQ[64] = {1.000000000e+00f, 8.639884591e-01f, 7.464760542e-01f, 6.449466944e-01f, 5.572264791e-01f, 4.814372361e-01f, 4.159561992e-01f, 3.593813777e-01f, 3.105013371e-01f, 2.682695687e-01f, 2.317818105e-01f, 2.002568096e-01f, 1.730195731e-01f, 1.494869143e-01f, 1.291549653e-01f, 1.115883961e-01f, 9.641107172e-02f, 8.329805732e-02f, 7.196855545e-02f, 6.218000501e-02f, 5.372280627e-02f, 4.641588405e-02f, 4.010278732e-02f, 3.464834765e-02f, 2.993577160e-02f, 2.586415969e-02f, 2.234633639e-02f, 1.930697635e-02f, 1.668100432e-02f, 1.441219542e-02f, 1.245197095e-02f, 1.075835899e-02f, 9.295095690e-03f, 8.030855097e-03f, 6.938565988e-03f, 5.994840991e-03f, 5.179473665e-03f, 4.475005437e-03f, 3.866352839e-03f, 3.340484342e-03f, 2.886139788e-03f, 2.493591513e-03f, 2.154434333e-03f, 1.861406374e-03f, 1.608233666e-03f, 1.389495330e-03f, 1.200507861e-03f, 1.037224894e-03f, 8.961503627e-04f, 7.742635789e-04f, 6.689548027e-04f, 5.779692437e-04f, 4.993587499e-04f, 4.314401885e-04f, 3.727593285e-04f, 3.220597573e-04f, 2.782559313e-04f, 2.404099068e-04f, 2.077113895e-04f, 1.794602431e-04f, 1.550515735e-04f, 1.339627634e-04f, 1.157422885e-04f, 9.999999747e-05f};
__constant__ float ROPE_FREQ[8] = {1.000000000e+00f, 1.939227432e-01f, 3.760603070e-02f, 7.292664610e-03f, 1.414213562e-03f, 2.742481884e-04f, 5.318295734e-05f, 1.031338525e-05f};
struct Args { const float* in[17]; float* out; unsigned char* ws; };
enum { I_X = 0, I_PRE_NORM = 1, I_PRE_WG = 2, I_PRE_WU = 3, I_PRE_WD = 4, I_MIX_NORM = 5, I_AB_IN = 6, I_AB_OUT = 7, I_GLA_IN = 8, I_GLA_A2 = 9, I_GLA_BA = 10, I_GLA_OUT = 11,
       I_POST_NORM = 12, I_POST_WG = 13, I_POST_WU = 14, I_POST_WD = 15, I_FINAL = 16, I_OUT = 17, I_WS = 18, N_PTRS = 19 };
struct Frame {
    LAS unsigned char* lds;
    int tid, lane, wave, G, bid;
};
__device__ __forceinline__ unsigned char* tabp(const Frame& F, int idx) {
    int off_ = PTR_OFF + 8 * idx; asm volatile("" : "+s"(off_));
    const volatile LAS unsigned* T = (const volatile LAS unsigned*)(F.lds + off_);
    const unsigned lo = __builtin_amdgcn_readfirstlane(T[0]), hi = __builtin_amdgcn_readfirstlane(T[1]);
    GAS unsigned char* gp_ = (GAS unsigned char*)(((unsigned long long)hi << 32) | (unsigned long long)lo);
    return (unsigned char*)gp_;
}
#define AP(idx) ((const float*)tabp(F, idx))
#define WSP() tabp(F, I_WS)
#define OUTP() ((float*)tabp(F, I_OUT))
__device__ __forceinline__ int lnd(int v) { asm volatile("" : "+s"(v)); return v; }
__device__ __forceinline__ int hw_lane() { return (int)__builtin_amdgcn_mbcnt_hi(~0u, __builtin_amdgcn_mbcnt_lo(~0u, 0u)); }
__device__ __forceinline__ Frame relaunder(const Frame& F0) { Frame F = F0; int t_ = threadIdx.x; asm volatile("" : "+v"(t_)); asm volatile("" : "+s"(F.bid)); F.tid = t_; F.lane = F.tid & 63; F.wave = __builtin_amdgcn_readfirstlane(F.tid >> 6);
    unsigned lb_ = 0u; asm volatile("" : "+s"(lb_)); F.lds = F0.lds + lb_; return F; }
__device__ __forceinline__ float wave_sum(float v) {
    v += xsw<1>(v); v += xsw<2>(v); v += xsw<4>(v); v += xsw<8>(v); v += xsw<16>(v);
    return sum32(v);
}
__device__ __forceinline__ float bf2f(bf16 h) { return __builtin_bit_cast(float, (unsigned)h << 16); }
__device__ __forceinline__ float bflo(unsigned w) { return __builtin_bit_cast(float, w << 16); }
__device__ __forceinline__ float bfhi(unsigned w) { return __builtin_bit_cast(float, w & 0xffff0000u); }
__device__ __forceinline__ bf16 f2bf_rne(float f) { return (bf16)f2bf(f); }

__device__ __forceinline__ void tr_item(const float* W, int K, int N, int Npad, const float* gain, bf16* WT, int gu, LAS float* scr, int item, int lane) {
    const int nblk = Npad / 32, kb = item / nblk, nb = item % nblk, k0 = 64 * kb, n0 = 32 * nb;
    {
        const int c4 = lane & 7; const bool ok = n0 + 4 * c4 < N;
        const GAS float* src = (const GAS float*)W + (size_t)(k0 + (lane >> 3)) * N + n0 + 4 * c4;
        f32x4 v[8];
#pragma unroll
        for (int i = 0; i < 8; ++i) v[i] = ok ? *(const GAS f32x4*)(src + (size_t)(8 * i) * N) : (f32x4){0.f, 0.f, 0.f, 0.f};
#pragma unroll
        for (int i = 0; i < 8; ++i) { const int kk = 8 * i + (lane >> 3); const float gn = gain ? ((const GAS float*)gain)[k0 + kk] : 1.0f; LAS float* s = scr + kk * 33 + 4 * c4;
            s[0] = v[i][0] * gn; s[1] = v[i][1] * gn; s[2] = v[i][2] * gn; s[3] = v[i][3] * gn; }
    }
    LDS_WAIT(); asm volatile("" ::: "memory");
    const int c = lane & 7;
#pragma unroll
    for (int j = 0; j < 4; ++j) { const int n = (lane >> 3) + 8 * j; const LAS float* s = scr + (8 * c) * 33 + n;
        v4u o; o.x = pk2(s[0 * 33], s[1 * 33]); o.y = pk2(s[2 * 33], s[3 * 33]); o.z = pk2(s[4 * 33], s[5 * 33]); o.w = pk2(s[6 * 33], s[7 * 33]);
        int drow = n0 + n; if (gu) drow = (drow >> 7) * 256 + (drow & 127) + (gu == 2 ? 128 : 0);
        *(GAS v4u*)(WT + (size_t)drow * K + k0 + 8 * c) = o; }
    LDS_WAIT(); asm volatile("" ::: "memory");
}
__device__ __forceinline__ void convert_weights(const Frame& F0, int l) {
    const Frame F = relaunder(F0);
    LAS float* scr = (LAS float*)(F.lds + RING_OFF + F.wave * 16384);
    const int gw = F.bid * NWAVES + F.wave, NGW = F.G * NWAVES;
    unsigned char* ws = WSP();
    constexpr int I_G = (D / 64) * (FF / 32), I_DN = (FF / 64) * (D / 32), I_O = (D / 64) * (D / 32);
    const bool odd = (l & 1) != 0; const int li = l >> 1;
    const int nin = odd ? GLA_IN : EVEN_IN, ninp = odd ? GLA_INP : EVEN_IN; const int I_IN = (D / 64) * (ninp / 32);
    const float* win = odd ? AP(I_GLA_IN) + (size_t)li * D * GLA_IN : AP(I_AB_IN) + (size_t)li * D * EVEN_IN;
    const float* wout = odd ? AP(I_GLA_OUT) + (size_t)li * D * D : AP(I_AB_OUT) + (size_t)li * D * D;
    const size_t fo = (size_t)l * D * FF;
    const int NITEMS = 6 * I_G + I_IN + I_O;
    static_assert(I_G == I_DN, "item counts");
    for (int it = gw; it < NITEMS; it += NGW) {
        int r = it;
        if (r < I_G) { tr_item(AP(I_PRE_WG) + fo, D, FF, FF, AP(I_PRE_NORM) + l * D, (bf16*)(ws + W_GU0), 1, scr, r, F.lane); continue; } r -= I_G;
        if (r < I_G) { tr_item(AP(I_PRE_WU) + fo, D, FF, FF, AP(I_PRE_NORM) + l * D, (bf16*)(ws + W_GU0), 2, scr, r, F.lane); continue; } r -= I_G;
        if (r < I_G) { tr_item(AP(I_PRE_WD) + fo, FF, D, D, nullptr, (bf16*)(ws + W_D0), 0, scr, r, F.lane); continue; } r -= I_G;
        if (r < I_G) { tr_item(AP(I_POST_WG) + fo, D, FF, FF, AP(I_POST_NORM) + l * D, (bf16*)(ws + W_GU1), 1, scr, r, F.lane); continue; } r -= I_G;
        if (r < I_G) { tr_item(AP(I_POST_WU) + fo, D, FF, FF, AP(I_POST_NORM) + l * D, (bf16*)(ws + W_GU1), 2, scr, r, F.lane); continue; } r -= I_G;
        if (r < I_G) { tr_item(AP(I_POST_WD) + fo, FF, D, D, nullptr, (bf16*)(ws + W_D1), 0, scr, r, F.lane); continue; } r -= I_G;
        if (r < I_IN) { tr_item(win, D, nin, ninp, AP(I_MIX_NORM) + l * D, (bf16*)(ws + W_IN), 0, scr, r, F.lane); continue; } r -= I_IN;
        tr_item(wout, D, D, D, nullptr, (bf16*)(ws + W_OUT), 0, scr, r, F.lane);
    }
}
__device__ __forceinline__ void prologue_rows(const Frame& F0) {
    const Frame F = relaunder(F0);
    unsigned char* ws = WSP();
    const int gw = F.bid * NWAVES + F.wave, NGW = F.G * NWAVES;
    bf16* XB = (bf16*)(ws + WS_XB); float* ssp = (float*)(ws + WS_SSP);
    for (int m = gw; m < M; m += NGW) {
        const GAS f32x4* xr = (const GAS f32x4*)(AP(I_X) + (size_t)m * D) + F.lane;
        GAS unsigned long long* o8 = (GAS unsigned long long*)(XB + (size_t)m * D) + F.lane;
        float s = 0.f;
#pragma unroll
        for (int j = 0; j < 4; ++j) { const f32x4 v = xr[64 * j]; s += (v.x * v.x + v.y * v.y) + (v.z * v.z + v.w * v.w);
            o8[64 * j] = (unsigned long long)pk2(v.x, v.y) | ((unsigned long long)pk2(v.z, v.w) << 32); }
        s = wave_sum(s);
        if (F.lane < 16) ssp[(size_t)m * 16 + F.lane] = (F.lane == 0) ? s : 0.f;
    }
    const int gt = F.bid * NTHREADS + F.tid, NGT = F.G * NTHREADS;
    float* rc = (float*)(ws + TAB_RC); float* rsn = (float*)(ws + TAB_RS); float* dc = (float*)(ws + TAB_DC); float* ds = (float*)(ws + TAB_DS);
    for (int e = gt; e < SEQ * 64; e += NGT) { const int t = e >> 6, i = e & 63; const float ang = (float)t * RET_FREQ[i];
        double rev = (double)ang * 0.15915494309189535; rev -= __builtin_rint(rev); const float r = (float)rev;
        rc[e] = __builtin_amdgcn_cosf(r); rsn[e] = __builtin_amdgcn_sinf(r); }
    for (int e = gt; e < SEQ * 8; e += NGT) { const int t = e >> 3, i = e & 7; const float ang = (float)t * ROPE_FREQ[i];
        double rev = (double)ang * 0.15915494309189535; rev -= __builtin_rint(rev); const float r = (float)rev;
        dc[e] = __builtin_amdgcn_cosf(r); ds[e] = __builtin_amdgcn_sinf(r); }
}

__device__ __forceinline__ void even_prep(const Frame& F0) {
    const Frame F = relaunder(F0);
    unsigned char* ws = WSP();
    const int gw = F.bid * NWAVES + F.wave, NGW = F.G * NWAVES;
    bf16* P = (bf16*)(ws + WS_ACT);
    const float* rc = (const float*)(ws + TAB_RC); const float* rsn = (const float*)(ws + TAB_RS); const float* dc = (const float*)(ws + TAB_DC); const float* ds = (const float*)(ws + TAB_DS);
    for (int m = gw; m < M; m += NGW) {
        const int pos = m & (SEQ - 1); bf16* row = P + (size_t)m * EVEN_IN;
        const float c = rc[pos * 64 + F.lane], s = rsn[pos * 64 + F.lane];
#pragma unroll
        for (int h = 0; h < 4; ++h) {
            { bf16* p1 = row + E_RQ + h * 128 + F.lane; bf16* p2 = p1 + 64; const float x1 = bf2f(*p1), x2 = bf2f(*p2); *p1 = f2bf_rne(x1 * c - x2 * s); *p2 = f2bf_rne(x2 * c + x1 * s); }
            { bf16* p1 = row + E_RK + h * 128 + F.lane; bf16* p2 = p1 + 64; const float x1 = bf2f(*p1), x2 = bf2f(*p2);
              *p1 = f2bf_rne((x1 * c - x2 * s) * 0.08838834764831845f); *p2 = f2bf_rne((x2 * c + x1 * s) * 0.08838834764831845f); }
        }
        { const int h = F.lane >> 3, i = F.lane & 7; const float c2 = dc[pos * 8 + i], s2 = ds[pos * 8 + i];
          { bf16* p1 = row + E_DQ + h * 64 + i; bf16* p2 = p1 + 8; const float x1 = bf2f(*p1), x2 = bf2f(*p2); *p1 = f2bf_rne(x1 * c2 - x2 * s2); *p2 = f2bf_rne(x2 * c2 + x1 * s2); }
          { bf16* p1 = row + E_DK + h * 64 + i; bf16* p2 = p1 + 8; const float x1 = bf2f(*p1), x2 = bf2f(*p2); *p1 = f2bf_rne(x1 * c2 - x2 * s2); *p2 = f2bf_rne(x2 * c2 + x1 * s2); } }
    }
}
__device__ __forceinline__ void even_core(const Frame& F0) {
    const Frame F = relaunder(F0);
    unsigned char* ws = WSP();
    const bf16* P = (const bf16*)(ws + WS_ACT);
    if (F.bid < 128) {
        const int b = F.bid >> 4, h = (F.bid >> 2) & 3, eg = F.bid & 3, e = eg * 32 + (F.tid >> 4), dq = F.tid & 15;
        const float g = 1.0f - exp2f(-5.0f - (float)h);
        float* oraw = (float*)(ws + WS_XB);
        const bf16* base = P + (size_t)b * SEQ * EVEN_IN;
        float S[8];
#pragma unroll
        for (int i = 0; i < 8; ++i) S[i] = 0.f;
        v4u qn = *(const GAS v4u*)(base + E_RQ + h * 128 + dq * 8), kn = *(const GAS v4u*)(base + E_RK + h * 128 + dq * 8); bf16 vn = base[E_RV + h * 128 + e];
        for (int t = 0; t < SEQ; ++t) {
            const v4u q = qn, k = kn; const float v = bf2f(vn);
            if (t + 1 < SEQ) { const bf16* nb = base + (size_t)(t + 1) * EVEN_IN; qn = *(const GAS v4u*)(nb + E_RQ + h * 128 + dq * 8); kn = *(const GAS v4u*)(nb + E_RK + h * 128 + dq * 8); vn = nb[E_RV + h * 128 + e]; }
            float o = 0.f;
#pragma unroll
            for (int i = 0; i < 4; ++i) { const unsigned qw = q[i], kw = k[i];
                S[2 * i] = g * S[2 * i] + bflo(kw) * v; S[2 * i + 1] = g * S[2 * i + 1] + bfhi(kw) * v;
                o += bflo(qw) * S[2 * i]; o += bfhi(qw) * S[2 * i + 1]; }
            o += xsw<1>(o); o += xsw<2>(o); o += xsw<4>(o); o += xsw<8>(o);
            if (dq == 0) oraw[((size_t)b * SEQ + t) * 512 + h * 128 + e] = o;
        }
    } else {
        bf16* CAT = (bf16*)(ws + WS_CAT);
        for (int it = F.bid - 128; it < BATCH * (SEQ / 64); it += F.G - 128) {
            const int b = it >> 6, t = (it & 63) * 64 + F.lane, h = F.wave;
            const bf16* base = P + (size_t)b * SEQ * EVEN_IN;
            float q[64];
            { const GAS v4u* qp = (const GAS v4u*)(base + (size_t)t * EVEN_IN + E_DQ + h * 64);
#pragma unroll
              for (int j = 0; j < 8; ++j) { const v4u w = qp[j];
#pragma unroll
                  for (int i = 0; i < 4; ++i) { q[8 * j + 2 * i] = bflo(w[i]) * (0.125f * 1.4426950408889634f); q[8 * j + 2 * i + 1] = bfhi(w[i]) * (0.125f * 1.4426950408889634f); } } }
            float o[64];
#pragma unroll
            for (int i = 0; i < 64; ++i) o[i] = 0.f;
            float mx = -INFINITY, l = 0.f;
            for (int p = 0; p < 3; ++p) {
                const int dil = (p == 0) ? 1 : (p == 1) ? 4 : 16;
                for (int j = 0; j <= 128; ++j) {
                    const int tk = t - j * dil;
                    if (tk >= 0) {
                        const GAS v4u* kp = (const GAS v4u*)(base + (size_t)tk * EVEN_IN + E_DK + h * 64);
                        const GAS v4u* vp = (const GAS v4u*)(base + (size_t)tk * EVEN_IN + E_DV + h * 64);
                        float s = 0.f;
#pragma unroll
                        for (int jj = 0; jj < 8; ++jj) { const v4u w = kp[jj];
#pragma unroll
                            for (int i = 0; i < 4; ++i) { s += q[8 * jj + 2 * i] * bflo(w[i]); s += q[8 * jj + 2 * i + 1] * bfhi(w[i]); } }
                        const float mn = fmaxf(mx, s), corr = __builtin_amdgcn_exp2f(mx - mn), pe = __builtin_amdgcn_exp2f(s - mn);
                        l = l * corr + pe; mx = mn;
#pragma unroll
                        for (int jj = 0; jj < 8; ++jj) { const v4u w = vp[jj];
#pragma unroll
                            for (int i = 0; i < 4; ++i) { o[8 * jj + 2 * i] = o[8 * jj + 2 * i] * corr + pe * bflo(w[i]); o[8 * jj + 2 * i + 1] = o[8 * jj + 2 * i + 1] * corr + pe * bfhi(w[i]); } }
                    }
                }
            }
            const float rl = 1.0f / l;
            GAS v4u* op = (GAS v4u*)(CAT + ((size_t)b * SEQ + t) * D + 512 + h * 64);
#pragma unroll
            for (int j = 0; j < 8; ++j) { v4u w; w.x = pk2(o[8 * j] * rl, o[8 * j + 1] * rl); w.y = pk2(o[8 * j + 2] * rl, o[8 * j + 3] * rl); w.z = pk2(o[8 * j + 4] * rl, o[8 * j + 5] * rl); w.w = pk2(o[8 * j + 6] * rl, o[8 * j + 7] * rl); op[j] = w; }
        }
    }
}
__device__ __forceinline__ void even_post(const Frame& F0) {
    const Frame F = relaunder(F0);
    unsigned char* ws = WSP();
    const int gw = F.bid * NWAVES + F.wave, NGW = F.G * NWAVES;
    const bf16* P = (const bf16*)(ws + WS_ACT); const float* oraw = (const float*)(ws + WS_XB); bf16* CAT = (bf16*)(ws + WS_CAT);
    for (int it = gw; it < M * 4; it += NGW) {
        const int m = it >> 2, h = it & 3;
        const float* op = oraw + (size_t)m * 512 + h * 128 + 2 * F.lane; const float o0 = op[0], o1 = op[1];
        const float mu = wave_sum(o0 + o1) * (1.0f / 128.0f); const float d0 = o0 - mu, d1 = o1 - mu;
        const float var = wave_sum(d0 * d0 + d1 * d1) * (1.0f / 128.0f); const float rstd = 1.0f / sqrtf(var + EPS);
        const unsigned gw2 = *(const unsigned*)(P + (size_t)m * EVEN_IN + E_RG + h * 128 + 2 * F.lane); const float g0 = bflo(gw2), g1 = bfhi(gw2);
        const float y0 = d0 * rstd * (g0 / (1.0f + expf(-g0))), y1 = d1 * rstd * (g1 / (1.0f + expf(-g1)));
        *(unsigned*)(CAT + (size_t)m * D + h * 128 + 2 * F.lane) = pk2(y0, y1);
    }
}
__device__ __forceinline__ void gla_prep(const Frame& F0, int li) {
    const Frame F = relaunder(F0);
    unsigned char* ws = WSP();
    const int gt = F.bid * NTHREADS + F.tid, NGT = F.G * NTHREADS;
    const bf16* P = (const bf16*)(ws + WS_ACT); float* A = (float*)(ws + WS_CAT);
    const float* w2 = AP(I_GLA_A2) + (size_t)li * 16 * 512; const float* ba = AP(I_GLA_BA) + (size_t)li * 512;
    for (int e = gt; e < M * 512; e += NGT) {
        const int m = e >> 9, c = e & 511; const bf16* al = P + (size_t)m * GLA_INP + G_A;
        float z = ba[c];
#pragma unroll
        for (int j = 0; j < 16; ++j) z += bf2f(al[j]) * w2[j * 512 + c];
        const float ls = fminf(z, 0.f) - log1pf(expf(-fabsf(z)));
        A[e] = expf(ls * (1.0f / 16.0f));
    }
}
__device__ __forceinline__ void gla_core(const Frame& F0) {
    const Frame F = relaunder(F0);
    unsigned char* ws = WSP();
    const bf16* P = (const bf16*)(ws + WS_ACT); const float* A = (const float*)(ws + WS_CAT); bf16* oraw = (bf16*)(ws + WS_XB);
    const int b = F.bid >> 5, h = (F.bid >> 3) & 3, eg = F.bid & 7, e = eg * 32 + (F.tid >> 4), dq = F.tid & 15;
    const bf16* base = P + (size_t)b * SEQ * GLA_INP; const float* abase = A + (size_t)b * SEQ * 512 + h * 128 + dq * 8;
    float S[8];
#pragma unroll
    for (int i = 0; i < 8; ++i) S[i] = 0.f;
    v4u qn = *(const GAS v4u*)(base + G_Q + h * 128 + dq * 8), kn = *(const GAS v4u*)(base + G_K + h * 128 + dq * 8); bf16 vn = base[G_V + h * 256 + e];
    f32x4 a0n = *(const GAS f32x4*)(abase), a1n = *(const GAS f32x4*)(abase + 4);
    for (int t = 0; t < SEQ; ++t) {
        const v4u q = qn, k = kn; const float v = bf2f(vn); const f32x4 a0 = a0n, a1 = a1n;
        if (t + 1 < SEQ) { const bf16* nb = base + (size_t)(t + 1) * GLA_INP; qn = *(const GAS v4u*)(nb + G_Q + h * 128 + dq * 8); kn = *(const GAS v4u*)(nb + G_K + h * 128 + dq * 8); vn = nb[G_V + h * 256 + e];
            a0n = *(const GAS f32x4*)(abase + (size_t)(t + 1) * 512); a1n = *(const GAS f32x4*)(abase + (size_t)(t + 1) * 512 + 4); }
        float o = 0.f;
#pragma unroll
        for (int i = 0; i < 4; ++i) { const unsigned qw = q[i], kw = k[i]; const float al = (i < 2) ? a0[2 * i] : a1[2 * i - 4], ah = (i < 2) ? a0[2 * i + 1] : a1[2 * i - 3];
            S[2 * i] = al * S[2 * i] + bflo(kw) * v; S[2 * i + 1] = ah * S[2 * i + 1] + bfhi(kw) * v;
            o += bflo(qw) * S[2 * i]; o += bfhi(qw) * S[2 * i + 1]; }
        o += xsw<1>(o); o += xsw<2>(o); o += xsw<4>(o); o += xsw<8>(o);
        if (dq == 0) oraw[((size_t)b * SEQ + t) * 1024 + h * 256 + e] = f2bf_rne(o * 0.08838834764831845f);
    }
}
__device__ __forceinline__ void gla_post(const Frame& F0) {
    const Frame F = relaunder(F0);
    unsigned char* ws = WSP();
    const int gw = F.bid * NWAVES + F.wave, NGW = F.G * NWAVES;
    const bf16* P = (const bf16*)(ws + WS_ACT); const bf16* oraw = (const bf16*)(ws + WS_XB); bf16* CAT = (bf16*)(ws + WS_CAT);
    for (int it = gw; it < M * 4; it += NGW) {
        const int m = it >> 2, h = it & 3;
        const unsigned long long ow = *(const unsigned long long*)(oraw + (size_t)m * 1024 + h * 256 + 4 * F.lane);
        const float o0 = bflo((unsigned)ow), o1 = bfhi((unsigned)ow), o2 = bflo((unsigned)(ow >> 32)), o3 = bfhi((unsigned)(ow >> 32));
        const float mu = wave_sum((o0 + o1) + (o2 + o3)) * (1.0f / 256.0f); const float d0 = o0 - mu, d1 = o1 - mu, d2 = o2 - mu, d3 = o3 - mu;
        const float var = wave_sum((d0 * d0 + d1 * d1) + (d2 * d2 + d3 * d3)) * (1.0f / 256.0f); const float rstd = 1.0f / sqrtf(var + EPS);
        const unsigned long long gw2 = *(const unsigned long long*)(P + (size_t)m * GLA_INP + G_R + h * 256 + 4 * F.lane);
        const float g0 = bflo((unsigned)gw2), g1 = bfhi((unsigned)gw2), g2 = bflo((unsigned)(gw2 >> 32)), g3 = bfhi((unsigned)(gw2 >> 32));
        const float y0 = d0 * rstd * (g0 / (1.0f + expf(-g0))), y1 = d1 * rstd * (g1 / (1.0f + expf(-g1))), y2 = d2 * rstd * (g2 / (1.0f + expf(-g2))), y3 = d3 * rstd * (g3 / (1.0f + expf(-g3)));
        *(unsigned long long*)(CAT + (size_t)m * D + h * 256 + 4 * F.lane) = (unsigned long long)pk2(y0, y1) | ((unsigned long long)pk2(y2, y3) << 32);
    }
}
__device__ __forceinline__ void final_norm(const Frame& F0) {
    const Frame F = relaunder(F0);
    const int gw = F.bid * NWAVES + F.wave, NGW = F.G * NWAVES;
    for (int m = gw; m < M; m += NGW) {
        GAS f32x4* xr = (GAS f32x4*)(OUTP() + (size_t)m * D) + F.lane; const GAS f32x4* gr = (const GAS f32x4*)AP(I_FINAL) + F.lane;
        f32x4 v[4]; float s = 0.f;
#pragma unroll
        for (int j = 0; j < 4; ++j) { v[j] = xr[64 * j]; s += (v[j].x * v[j].x + v[j].y * v[j].y) + (v[j].z * v[j].z + v[j].w * v[j].w); }
        const float rstd = 1.0f / sqrtf(wave_sum(s) * (1.0f / D) + EPS);
#pragma unroll
        for (int j = 0; j < 4; ++j) xr[64 * j] = v[j] * rstd * gr[64 * j];
    }
}


__device__ __forceinline__ float silu_f(float g) { return g * __builtin_amdgcn_rcpf(1.0f + __builtin_amdgcn_exp2f(-1.4426950408889634f * g)); }
typedef float f32x16 __attribute__((ext_vector_type(16)));
typedef short s16x4 __attribute__((ext_vector_type(4)));
typedef float f32x2_t __attribute__((ext_vector_type(2)));
typedef __bf16 bf16x2_t __attribute__((ext_vector_type(2)));
#define MFMA32(a, b, c) __builtin_amdgcn_mfma_f32_32x32x16_bf16((a), (b), (c), 0, 0, 0)
__device__ __forceinline__ int crow(int reg, int h) { return (reg & 3) + 8 * (reg >> 2) + 4 * h; }
__device__ __forceinline__ unsigned cvtpk(float lo, float hi) { f32x2_t v = {lo, hi}; bf16x2_t b = __builtin_convertvector(v, bf16x2_t); return __builtin_bit_cast(unsigned, b); }
__device__ __forceinline__ bf16 cvt1(float v) { return (bf16)(cvtpk(v, 0.f) & 0xffffu); }
#define PACK_STEP(x, s) __builtin_bit_cast(bf16x8, (v4u){cvtpk((x)[8 * (s)], (x)[8 * (s) + 1]), cvtpk((x)[8 * (s) + 2], (x)[8 * (s) + 3]), cvtpk((x)[8 * (s) + 4], (x)[8 * (s) + 5]), cvtpk((x)[8 * (s) + 6], (x)[8 * (s) + 7])})
typedef const LAS unsigned char* lcp;
__device__ __forceinline__ int lndv(int v) { asm volatile("" : "+v"(v)); return v; }
__device__ __forceinline__ bf16x8 ld_row(lcp img, int P, int row0, int k0, int r, int h) { return *(const LAS bf16x8*)(img + (row0 + r) * P + (k0 + 8 * h) * 2); }
__device__ __forceinline__ bf16x8 ld_row_perm(lcp img, int P, int row0, int k0, int r, int h) {
    const s16x4 lo = *(const LAS s16x4*)(img + (row0 + r) * P + (k0 + 4 * h) * 2), hi = *(const LAS s16x4*)(img + (row0 + r) * P + (k0 + 8 + 4 * h) * 2);
    return __builtin_shufflevector(lo, hi, 0, 1, 2, 3, 4, 5, 6, 7); }
__device__ __forceinline__ s16x4 trd(lcp p) { return __builtin_bit_cast(s16x4, __builtin_amdgcn_ds_read_tr16_b64_v4i16((LAS s16x4*)p)); }
__device__ __forceinline__ bf16x8 ld_tr(lcp img, int P, int k0, int c0, int lane) {
    const int i16 = lane & 15, q = i16 >> 2, p = i16 & 3, blk = (lane >> 4) & 1, h = lane >> 5;
    lcp a = img + (k0 + 8 * h + q) * P + (c0 + 16 * blk + 4 * p) * 2;
    const s16x4 lo = trd(a), hi = trd(a + 4 * P);
    return __builtin_shufflevector(lo, hi, 0, 1, 2, 3, 4, 5, 6, 7); }
__device__ __forceinline__ bf16x8 ld_tr_perm(lcp img, int P, int k0, int c0, int lane) {
    const int i16 = lane & 15, q = i16 >> 2, p = i16 & 3, blk = (lane >> 4) & 1, h = lane >> 5;
    lcp a = img + (k0 + 4 * h + q) * P + (c0 + 16 * blk + 4 * p) * 2;
    const s16x4 lo = trd(a), hi = trd(a + 8 * P);
    return __builtin_shufflevector(lo, hi, 0, 1, 2, 3, 4, 5, 6, 7); }
template <int R, int C> __device__ __forceinline__ void tile_ld(v4u (&v)[R * C / 8 / NTHREADS], const bf16* g, size_t gp, int tid) {
    constexpr int CPR = C / 8, RS = NTHREADS / CPR;
    static_assert(NTHREADS % CPR == 0, "tile shape");
    const unsigned voff = (unsigned)((tid / CPR) * (int)gp + (tid % CPR) * 8) * 2u;
    const GAS unsigned char* gb = (const GAS unsigned char*)g;
#pragma unroll
    for (int i = 0; i < R * C / 8 / NTHREADS; ++i) v[i] = *(const GAS v4u*)(gb + (size_t)i * RS * gp * 2 + voff);
}
template <int R, int C> __device__ __forceinline__ void tile_st(const v4u (&v)[R * C / 8 / NTHREADS], LAS unsigned char* img, int P, int tid) {
    constexpr int CPR = C / 8, RS = NTHREADS / CPR;
    LAS unsigned char* lb = img + (tid / CPR) * P + (tid % CPR) * 16;
#pragma unroll
    for (int i = 0; i < R * C / 8 / NTHREADS; ++i) *(LAS v4u*)(lb + i * RS * P) = v[i];
}
template <int R, int C> __device__ __forceinline__ void stage_tile(LAS unsigned char* img, int P, const bf16* g, size_t gp, int tid) { v4u t_[R * C / 8 / NTHREADS]; tile_ld<R, C>(t_, g, gp, tid); tile_st<R, C>(t_, img, P, tid); }
#define WG_BAR() do { asm volatile("s_waitcnt lgkmcnt(0)" ::: "memory"); __builtin_amdgcn_s_barrier(); asm volatile("" ::: "memory"); } while (0)

constexpr int PR = 272, PT = 320, PT256 = 576, PO256 = 528;
constexpr size_t WS_DEC = 6 * MiB;
constexpr float LOG2E = 1.4426950408889634f, LN2 = 0.6931471805599453f;
__device__ __forceinline__ void gla_cumsum(float (&Bc)[2][16], float& Blast, lcp AL, lcp W2, const LAS float* BA, LAS float* EX, int wave, int lane) {
    const int r = lane & 31, h = lane >> 5, db = wave & 3, jh = wave >> 2;
    const bf16x8 wf = *(const LAS bf16x8*)(W2 + (db * 32 + r) * 32 + h * 16);
    const float bias = BA[db * 32 + r];
    float run = 0.f;
#pragma unroll
    for (int t = 0; t < 2; ++t) {
        const bf16x8 af = *(const LAS bf16x8*)(AL + ((jh * 2 + t) * 32 + r) * 32 + h * 16);
        f32x16 z = {0.f, 0.f, 0.f, 0.f, 0.f, 0.f, 0.f, 0.f, 0.f, 0.f, 0.f, 0.f, 0.f, 0.f, 0.f, 0.f};
        z = MFMA32(af, wf, z);
        float own[4], oth[4];
#pragma unroll
        for (int g = 0; g < 4; ++g) {
            float acc = 0.f;
#pragma unroll
            for (int i = 0; i < 4; ++i) { const float zz = z[4 * g + i] + bias;
                const float la = (fminf(zz, 0.f) - LN2 * __builtin_amdgcn_logf(1.0f + __builtin_amdgcn_exp2f(-fabsf(zz) * LOG2E))) * (1.0f / 16.0f);
                acc += la; Bc[t][4 * g + i] = acc; }
            own[g] = acc; oth[g] = oth32(acc, h);
        }
#pragma unroll
        for (int g = 0; g < 4; ++g) { const float off = run + (h ? oth[g] : 0.f);
#pragma unroll
            for (int i = 0; i < 4; ++i) Bc[t][4 * g + i] += off;
            run += own[g] + oth[g]; }
    }
    if (h == 0) EX[jh * 128 + db * 32 + r] = run;
    WG_BAR();
    const float t0 = EX[db * 32 + r], t1 = EX[128 + db * 32 + r];
    Blast = t0 + t1;
    if (jh == 1) {
#pragma unroll
        for (int t = 0; t < 2; ++t)
#pragma unroll
            for (int i = 0; i < 16; ++i) Bc[t][i] += t0; }
}
constexpr int GA_KI = 0, GA_VI = GA_KI + 128 * PR, GA_KD = GA_VI + 128 * PT256, GA_AL = GA_KD + 128 * PT, GA_W2 = GA_AL + 4096, GA_BA = GA_W2 + 4096, GA_EX = GA_BA + 512, GA_END = GA_EX + 1024;
constexpr int GA_OI = GA_VI;
constexpr int GC_QT = 0, GC_KT = GC_QT + 128 * PR, GC_SI = GC_KT + 128 * PR, GC_VI = GC_SI + 128 * PT, GC_AL = GC_VI + 128 * PT, GC_W2 = GC_AL + 4096, GC_BA = GC_W2 + 4096, GC_EX = GC_BA + 512, GC_END = GC_EX + 1024;
constexpr int GC_OI = 0;
static_assert(GA_END <= LDSCTL_OFF && GC_END <= LDSCTL_OFF && 128 * PO256 <= GC_SI && 128 * PO256 <= 128 * PT256, "GLA LDS maps");
__device__ __forceinline__ void gla_stage_w(const Frame& F, LAS unsigned char* W2, LAS float* BA, int li, int h) {
    if (F.tid < 128) { const int d = F.tid; const GAS float* w2 = (const GAS float*)AP(I_GLA_A2) + (size_t)li * 16 * 512 + h * 128 + d;
        v4u lo, hi; lo.x = cvtpk(w2[0], w2[512]); lo.y = cvtpk(w2[2 * 512], w2[3 * 512]); lo.z = cvtpk(w2[4 * 512], w2[5 * 512]); lo.w = cvtpk(w2[6 * 512], w2[7 * 512]);
        hi.x = cvtpk(w2[8 * 512], w2[9 * 512]); hi.y = cvtpk(w2[10 * 512], w2[11 * 512]); hi.z = cvtpk(w2[12 * 512], w2[13 * 512]); hi.w = cvtpk(w2[14 * 512], w2[15 * 512]);
        *(LAS v4u*)(W2 + d * 32) = lo; *(LAS v4u*)(W2 + d * 32 + 16) = hi; }
    else if (F.tid < 256) { const int d = F.tid - 128; BA[d] = ((const GAS float*)AP(I_GLA_BA))[(size_t)li * 512 + h * 128 + d]; }
}
__device__ __forceinline__ v4u gla_ld_alow(int tid, const bf16* Prow0) { const int t = tid & 255; return *(const GAS v4u*)(Prow0 + (size_t)(t >> 1) * GLA_INP + G_A + (t & 1) * 8); }
__device__ __forceinline__ void gla_st_alow(int tid, v4u v, LAS unsigned char* AL) { if (tid < 256) *(LAS v4u*)(AL + (tid >> 1) * 32 + (tid & 1) * 16) = v; }

__device__ __forceinline__ void gla_phase_a(const Frame& F0, int li) {
    const Frame F = relaunder(F0);
    unsigned char* ws = WSP();
    const bf16* P = (const bf16*)(ws + WS_ACT); bf16* SKV = (bf16*)(ws + WS_XB); float* DEC = (float*)(ws + WS_DEC);
    LAS unsigned char* L = F.lds;
    const int wave = F.wave, db = wave & 3, jh = wave >> 2;
    v4u kR[4], vR[8], aR; int hcur = -1;
    {   const int it = F.bid; if (it < 1024) { const int bh = it >> 5, g = it & 31; const bf16* Prow0 = P + ((size_t)(bh >> 2) * SEQ + g * 128) * GLA_INP;
            tile_ld<128, 128>(kR, Prow0 + G_K + (bh & 3) * 128, GLA_INP, F.tid); tile_ld<128, 256>(vR, Prow0 + G_V + (bh & 3) * 256, GLA_INP, F.tid); aR = gla_ld_alow(F.tid, Prow0); } }
    for (int it = F.bid; it < 1024; it += F.G) {
        const int bh = it >> 5, h = bh & 3;
        const int lane = lndv(F.lane), r = lane & 31, h2 = lane >> 5;
        tile_st<128, 128>(kR, L + GA_KI, PR, F.tid); tile_st<128, 256>(vR, L + GA_VI, PT256, F.tid); gla_st_alow(F.tid, aR, L + GA_AL);
        if (h != hcur) { gla_stage_w(F, L + GA_W2, (LAS float*)(L + GA_BA), li, h); hcur = h; }
        WG_BAR();
        {   const int nx = it + F.G; if (nx < 1024) { const int bh2 = nx >> 5, g2 = nx & 31; const bf16* Pn = P + ((size_t)(bh2 >> 2) * SEQ + g2 * 128) * GLA_INP;
                tile_ld<128, 128>(kR, Pn + G_K + (bh2 & 3) * 128, GLA_INP, F.tid); tile_ld<128, 256>(vR, Pn + G_V + (bh2 & 3) * 256, GLA_INP, F.tid); aR = gla_ld_alow(F.tid, Pn); } }
        float Bc[2][16], Blast;
        gla_cumsum(Bc, Blast, L + GA_AL, L + GA_W2, (const LAS float*)(L + GA_BA), (LAS float*)(L + GA_EX), wave, lane);
#pragma unroll
        for (int t = 0; t < 2; ++t)
#pragma unroll
            for (int i = 0; i < 16; ++i) { const int row = (jh * 2 + t) * 32 + crow(i, h2), col = db * 32 + r;
                const float kv = bf2f(*(const LAS bf16*)(L + GA_KI + row * PR + col * 2)) * __builtin_amdgcn_exp2f((Blast - Bc[t][i]) * LOG2E);
                *(LAS bf16*)(L + GA_KD + row * PT + col * 2) = cvt1(kv); }
        if (jh == 0 && h2 == 0) DEC[(size_t)it * 128 + db * 32 + r] = __builtin_amdgcn_exp2f(Blast * LOG2E);
        WG_BAR();
        f32x16 acc[4];
#pragma unroll
        for (int t = 0; t < 4; ++t) acc[t] = (f32x16){0.f, 0.f, 0.f, 0.f, 0.f, 0.f, 0.f, 0.f, 0.f, 0.f, 0.f, 0.f, 0.f, 0.f, 0.f, 0.f};
#pragma unroll
        for (int ks = 0; ks < 8; ++ks) { const bf16x8 a = ld_tr(L + GA_KD, PT, 16 * ks, db * 32, lane);
#pragma unroll
            for (int t = 0; t < 4; ++t) acc[t] = MFMA32(a, ld_tr(L + GA_VI, PT256, 16 * ks, (4 * jh + t) * 32, lane), acc[t]); }
        WG_BAR();
#pragma unroll
        for (int t = 0; t < 4; ++t)
#pragma unroll
            for (int i = 0; i < 16; ++i) *(LAS bf16*)(L + GA_OI + (db * 32 + crow(i, h2)) * PO256 + ((4 * jh + t) * 32 + r) * 2) = cvt1(acc[t][i]);
        WG_BAR();
        {   bf16* out = SKV + (size_t)it * 128 * 256;
#pragma unroll
            for (int i = 0; i < 8; ++i) { const int c = F.tid + i * NTHREADS, row = c >> 5, cc = c & 31; *(GAS v4u*)(out + row * 256 + cc * 8) = *(const LAS v4u*)(L + GA_OI + row * PO256 + cc * 16); } }
        WG_BAR();
    }
}
__device__ __forceinline__ void gla_phase_b(const Frame& F0) {
    const Frame F = relaunder(F0);
    unsigned char* ws = WSP();
    bf16* SKV = (bf16*)(ws + WS_XB); const float* DEC = (const float*)(ws + WS_DEC);
    for (int gt = F.bid * NTHREADS + F.tid; gt < 32 * 128 * 32; gt += F.G * NTHREADS) {
        const int bh = gt >> 12, d = (gt >> 5) & 127, e8 = gt & 31;
        float s[8];
#pragma unroll
        for (int i = 0; i < 8; ++i) s[i] = 0.f;
        for (int g0 = 0; g0 < 32; g0 += 8) {
            v4u kv[8]; float dc[8];
#pragma unroll
            for (int u = 0; u < 8; ++u) { const size_t item = (size_t)bh * 32 + g0 + u; kv[u] = *(const GAS v4u*)(SKV + (item * 128 + d) * 256 + e8 * 8); dc[u] = ((const GAS float*)DEC)[item * 128 + d]; }
#pragma unroll
            for (int u = 0; u < 8; ++u) { const size_t item = (size_t)bh * 32 + g0 + u;
                v4u o; o.x = cvtpk(s[0], s[1]); o.y = cvtpk(s[2], s[3]); o.z = cvtpk(s[4], s[5]); o.w = cvtpk(s[6], s[7]);
                *(GAS v4u*)(SKV + (item * 128 + d) * 256 + e8 * 8) = o;
#pragma unroll
                for (int i = 0; i < 4; ++i) { s[2 * i] = dc[u] * s[2 * i] + bflo(kv[u][i]); s[2 * i + 1] = dc[u] * s[2 * i + 1] + bfhi(kv[u][i]); } }
        }
    }
}
__device__ __forceinline__ void gla_phase_c(const Frame& F0, int li) {
    const Frame F = relaunder(F0);
    unsigned char* ws = WSP();
    const bf16* P = (const bf16*)(ws + WS_ACT); const bf16* SKV = (const bf16*)(ws + WS_XB); bf16* CAT = (bf16*)(ws + WS_CAT);
    LAS unsigned char* L = F.lds;
    const int wave = F.wave, db = wave & 3, jh = wave >> 2;
    const int ib = wave & 3, eq = wave >> 2;
    v4u qR[4], kR[4], aR; int hcur = -1;
    {   const int it = F.bid; if (it < 1024) { const int bh = it >> 5, g = it & 31, h = bh & 3; const bf16* Prow0 = P + ((size_t)(bh >> 2) * SEQ + g * 128) * GLA_INP;
            tile_ld<128, 128>(qR, Prow0 + G_Q + h * 128, GLA_INP, F.tid); tile_ld<128, 128>(kR, Prow0 + G_K + h * 128, GLA_INP, F.tid); aR = gla_ld_alow(F.tid, Prow0); } }
    for (int it = F.bid; it < 1024; it += F.G) {
        const int bh = it >> 5, g = it & 31, b = bh >> 2, h = bh & 3;
        const int tidl = lndv(F.tid), lane = tidl & 63, r = lane & 31, h2 = lane >> 5;
        const bf16* Prow0 = P + ((size_t)b * SEQ + g * 128) * GLA_INP;
        const bf16* Sg = SKV + (size_t)it * 128 * 256;
        {   v4u sR[4], vR[4]; tile_ld<128, 128>(sR, Sg, 256, tidl); tile_ld<128, 128>(vR, Prow0 + G_V + h * 256, GLA_INP, tidl);
            tile_st<128, 128>(qR, L + GC_QT, PR, tidl); tile_st<128, 128>(kR, L + GC_KT, PR, tidl); tile_st<128, 128>(sR, L + GC_SI, PT, tidl); tile_st<128, 128>(vR, L + GC_VI, PT, tidl); }
        gla_st_alow(tidl, aR, L + GC_AL);
        if (h != hcur) { gla_stage_w(F, L + GC_W2, (LAS float*)(L + GC_BA), li, h); hcur = h; }
        WG_BAR();
        {
            float Bc[2][16], Blast;
            gla_cumsum(Bc, Blast, L + GC_AL, L + GC_W2, (const LAS float*)(L + GC_BA), (LAS float*)(L + GC_EX), wave, lane);
#pragma unroll
            for (int t = 0; t < 2; ++t)
#pragma unroll
                for (int i = 0; i < 16; ++i) { const int off = ((jh * 2 + t) * 32 + crow(i, h2)) * PR + (db * 32 + r) * 2;
                    const float eb = __builtin_amdgcn_exp2f(Bc[t][i] * LOG2E);
                    const float qv = bf2f(*(const LAS bf16*)(L + GC_QT + off)) * eb * 0.08838834764831845f;
                    const float kv = bf2f(*(const LAS bf16*)(L + GC_KT + off)) * __builtin_amdgcn_rcpf(eb);
                    *(LAS bf16*)(L + GC_QT + off) = cvt1(qv); *(LAS bf16*)(L + GC_KT + off) = cvt1(kv); }
        }
        WG_BAR();
        bf16x8 PA[4][2];
#pragma unroll
        for (int jb = 0; jb < 4; ++jb) {
            if (jb <= ib) {
                f32x16 x = {0.f, 0.f, 0.f, 0.f, 0.f, 0.f, 0.f, 0.f, 0.f, 0.f, 0.f, 0.f, 0.f, 0.f, 0.f, 0.f};
#pragma unroll
                for (int ks = 0; ks < 8; ++ks) x = MFMA32(ld_row(L + GC_KT, PR, jb * 32, 16 * ks, r, h2), ld_row(L + GC_QT, PR, ib * 32, 16 * ks, r, h2), x);
                if (jb == ib) {
#pragma unroll
                    for (int i = 0; i < 16; ++i) if (crow(i, h2) > r) x[i] = 0.f; }
                PA[jb][0] = PACK_STEP(x, 0); PA[jb][1] = PACK_STEP(x, 1);
            } else { PA[jb][0] = (bf16x8){0, 0, 0, 0, 0, 0, 0, 0}; PA[jb][1] = (bf16x8){0, 0, 0, 0, 0, 0, 0, 0}; }
        }
        f32x16 o[2][2];
#pragma unroll
        for (int half = 0; half < 2; ++half) {
            if (half == 1) {
                WG_BAR();
                stage_tile<128, 128>(L + GC_SI, PT, Sg + 128, 256, tidl); stage_tile<128, 128>(L + GC_VI, PT, Prow0 + G_V + h * 256 + 128, GLA_INP, tidl);
                WG_BAR();
            }
#pragma unroll
            for (int t = 0; t < 2; ++t) {
                const int eb = 2 * eq + t;
                f32x16 acc = {0.f, 0.f, 0.f, 0.f, 0.f, 0.f, 0.f, 0.f, 0.f, 0.f, 0.f, 0.f, 0.f, 0.f, 0.f, 0.f};
#pragma unroll
                for (int jb = 0; jb < 4; ++jb) if (jb <= ib) {
#pragma unroll
                    for (int s = 0; s < 2; ++s) acc = MFMA32(PA[jb][s], ld_tr_perm(L + GC_VI, PT, jb * 32 + 16 * s, eb * 32, lane), acc); }
#pragma unroll
                for (int ks = 0; ks < 8; ++ks) acc = MFMA32(ld_row(L + GC_QT, PR, ib * 32, 16 * ks, r, h2), ld_tr(L + GC_SI, PT, 16 * ks, eb * 32, lane), acc);
                o[half][t] = acc;
            }
        }
        WG_BAR();
#pragma unroll
        for (int half = 0; half < 2; ++half)
#pragma unroll
            for (int t = 0; t < 2; ++t)
#pragma unroll
                for (int i = 0; i < 16; ++i) *(LAS bf16*)(L + GC_OI + (ib * 32 + crow(i, h2)) * PO256 + (half * 128 + (2 * eq + t) * 32 + r) * 2) = cvt1(o[half][t][i]);
        WG_BAR();
        {   const int nx = (it + F.G < 1024) ? it + F.G : it;
            const int bh2 = nx >> 5, g2 = nx & 31, hn = bh2 & 3; const bf16* Pn = P + ((size_t)(bh2 >> 2) * SEQ + g2 * 128) * GLA_INP;
            tile_ld<128, 128>(qR, Pn + G_Q + hn * 128, GLA_INP, tidl); tile_ld<128, 128>(kR, Pn + G_K + hn * 128, GLA_INP, tidl); aR = gla_ld_alow(tidl, Pn); }
        {
            const int tid2 = lndv(tidl), row = tid2 >> 2, qtr = tid2 & 3;
            lcp orow = L + GC_OI + row * PO256 + qtr * 128;
            const bf16* gp = Prow0 + (size_t)row * GLA_INP + G_R + h * 256 + qtr * 64;
            float sum = 0.f;
#pragma unroll
            for (int c = 0; c < 8; ++c) { const v4u w = *(const LAS v4u*)(orow + c * 16);
#pragma unroll
                for (int i = 0; i < 4; ++i) sum += bflo(w[i]) + bfhi(w[i]); }
            sum += xsw<1>(sum); sum += xsw<2>(sum);
            const float mu = sum * (1.0f / 256.0f); float sq = 0.f;
#pragma unroll
            for (int c = 0; c < 8; ++c) { const v4u w = *(const LAS v4u*)(orow + c * 16);
#pragma unroll
                for (int i = 0; i < 4; ++i) { const float d0 = bflo(w[i]) - mu, d1 = bfhi(w[i]) - mu; sq += d0 * d0 + d1 * d1; } }
            sq += xsw<1>(sq); sq += xsw<2>(sq);
            const float rstd = 1.0f / sqrtf(sq * (1.0f / 256.0f) + EPS);
            bf16* op = CAT + ((size_t)b * SEQ + g * 128 + row) * D + h * 256 + qtr * 64;
#pragma unroll
            for (int c = 0; c < 8; ++c) { const v4u gw = *(const GAS v4u*)(gp + c * 8); const v4u w = *(const LAS v4u*)(orow + c * 16); v4u ow;
#pragma unroll
                for (int i = 0; i < 4; ++i) { const float g0 = bflo(gw[i]), g1 = bfhi(gw[i]);
                    ow[i] = cvtpk((bflo(w[i]) - mu) * rstd * silu_f(g0), (bfhi(w[i]) - mu) * rstd * silu_f(g1)); }
                *(GAS v4u*)(op + c * 8) = ow; }
        }
        WG_BAR();
    }
}


constexpr size_t WS_OD = 408 * MiB;
constexpr size_t WS_LSE = WS_XB + 32 * MiB;
constexpr size_t WS_END2 = 504 * MiB;
constexpr int RA_KI = 0, RA_VD = RA_KI + 128 * PT, RA_END = RA_VD + 128 * PT;
constexpr int RC_QI = 0, RC_KI = RC_QI + 128 * PR, RC_VI = RC_KI + 128 * PR, RC_SI = RC_VI + 128 * PT, RC_END = RC_SI + 128 * PT;
constexpr int DPK = 144, DPV = 192;
constexpr int DL_KI = 0, DL_VI = DL_KI + 384 * DPK, DL_LW = DL_VI + 384 * DPV, DL_END = DL_LW + 8 * 256;
constexpr int DL_ST = DL_KI;
static_assert(RC_END <= LDSCTL_OFF && DL_END <= LDSCTL_OFF && 8 * 32 * DPK <= 384 * DPK, "even mixer LDS maps");
__device__ __forceinline__ float ret_log2g(int h) { return log2f(1.0f - exp2f(-5.0f - (float)h)); }

__device__ __forceinline__ void ret_phase_a_items(const Frame& F, const bf16* P, bf16* RKV) {
    LAS unsigned char* L = F.lds;
    const int wave = F.wave, db = wave & 3, eh = wave >> 2;
    v4u kR[4], vR[4];
    {   const int it = F.bid < 1024 ? F.bid : 0; const int bh = it >> 5, n = it & 31; const bf16* Prow0 = P + ((size_t)(bh >> 2) * SEQ + n * 128) * EVEN_IN;
        tile_ld<128, 128>(kR, Prow0 + E_RK + (bh & 3) * 128, EVEN_IN, F.tid); tile_ld<128, 128>(vR, Prow0 + E_RV + (bh & 3) * 128, EVEN_IN, F.tid); }
    for (int it = F.bid; it < 1024; it += F.G) {
        const int tidl = lndv(F.tid), lane = tidl & 63, r = lane & 31, h2 = lane >> 5;
        const int bh = it >> 5, h = bh & 3;
        const float lg = ret_log2g(h);
        tile_st<128, 128>(kR, L + RA_KI, PT, tidl);
        {
#pragma unroll
            for (int i = 0; i < 4; ++i) { const int row = (tidl >> 4) + 32 * i, cc = tidl & 15; const float f = __builtin_amdgcn_exp2f(lg * (float)(127 - row)); v4u o;
#pragma unroll
                for (int k = 0; k < 4; ++k) o[k] = cvtpk(bflo(vR[i][k]) * f, bfhi(vR[i][k]) * f);
                *(LAS v4u*)(L + RA_VD + row * PT + cc * 16) = o; }
        }
        WG_BAR();
        {   const int nx = (it + F.G < 1024) ? it + F.G : it; const int bh2 = nx >> 5, n2 = nx & 31; const bf16* Pn = P + ((size_t)(bh2 >> 2) * SEQ + n2 * 128) * EVEN_IN;
            tile_ld<128, 128>(kR, Pn + E_RK + (bh2 & 3) * 128, EVEN_IN, tidl); tile_ld<128, 128>(vR, Pn + E_RV + (bh2 & 3) * 128, EVEN_IN, tidl); }
        f32x16 acc[2];
#pragma unroll
        for (int t = 0; t < 2; ++t) acc[t] = (f32x16){0.f, 0.f, 0.f, 0.f, 0.f, 0.f, 0.f, 0.f, 0.f, 0.f, 0.f, 0.f, 0.f, 0.f, 0.f, 0.f};
#pragma unroll
        for (int ks = 0; ks < 8; ++ks) { const bf16x8 a = ld_tr(L + RA_KI, PT, 16 * ks, db * 32, lane);
#pragma unroll
            for (int t = 0; t < 2; ++t) acc[t] = MFMA32(a, ld_tr(L + RA_VD, PT, 16 * ks, (2 * eh + t) * 32, lane), acc[t]); }
        WG_BAR();
#pragma unroll
        for (int t = 0; t < 2; ++t)
#pragma unroll
            for (int i = 0; i < 16; ++i) *(LAS bf16*)(L + RA_KI + (db * 32 + crow(i, h2)) * PR + ((2 * eh + t) * 32 + r) * 2) = cvt1(acc[t][i]);
        WG_BAR();
        bf16* out = RKV + (size_t)it * 128 * 128;
#pragma unroll
        for (int i = 0; i < 4; ++i) { const int row = (tidl >> 4) + 32 * i, cc = tidl & 15; *(GAS v4u*)(out + row * 128 + cc * 8) = *(const LAS v4u*)(L + RA_KI + row * PR + cc * 16); }
        WG_BAR();
    }
}
__device__ __forceinline__ void ret_scan(const Frame& F, bf16* RKV) {
    for (int gt = F.bid * NTHREADS + F.tid; gt < 32 * 128 * 16; gt += F.G * NTHREADS) {
        const int bh = gt >> 11, d = (gt >> 4) & 127, e8 = gt & 15, h = bh & 3;
        const float g128 = __builtin_amdgcn_exp2f(ret_log2g(h) * 128.0f);
        float s[8];
#pragma unroll
        for (int i = 0; i < 8; ++i) s[i] = 0.f;
        for (int n0 = 0; n0 < 32; n0 += 4) {
            v4u kv[4];
#pragma unroll
            for (int u = 0; u < 4; ++u) kv[u] = *(const GAS v4u*)(RKV + (((size_t)bh * 32 + n0 + u) * 128 + d) * 128 + e8 * 8);
#pragma unroll
            for (int u = 0; u < 4; ++u) {
                v4u o; o.x = cvtpk(s[0], s[1]); o.y = cvtpk(s[2], s[3]); o.z = cvtpk(s[4], s[5]); o.w = cvtpk(s[6], s[7]);
                *(GAS v4u*)(RKV + (((size_t)bh * 32 + n0 + u) * 128 + d) * 128 + e8 * 8) = o;
#pragma unroll
                for (int i = 0; i < 4; ++i) { s[2 * i] = g128 * s[2 * i] + bflo(kv[u][i]); s[2 * i + 1] = g128 * s[2 * i + 1] + bfhi(kv[u][i]); } }
        }
    }
}
__device__ __forceinline__ void ret_phase_c_items(const Frame& F, const bf16* P, const bf16* RKV, bf16* CAT) {
    LAS unsigned char* L = F.lds;
    const int wave = F.wave, ib = wave & 3, eq = wave >> 2;
    v4u qR[4], kR[4];
    {   const int it = F.bid < 1024 ? F.bid : 0; const int bh = it >> 5, n = it & 31; const bf16* Prow0 = P + ((size_t)(bh >> 2) * SEQ + n * 128) * EVEN_IN;
        tile_ld<128, 128>(qR, Prow0 + E_RQ + (bh & 3) * 128, EVEN_IN, F.tid); tile_ld<128, 128>(kR, Prow0 + E_RK + (bh & 3) * 128, EVEN_IN, F.tid); }
    for (int it = F.bid; it < 1024; it += F.G) {
        const int tidl = lndv(F.tid), lane = tidl & 63, r = lane & 31, h2 = lane >> 5;
        const int bh = it >> 5, n = it & 31, b = bh >> 2, h = bh & 3;
        const float lg = ret_log2g(h);
        const bf16* Prow0 = P + ((size_t)b * SEQ + n * 128) * EVEN_IN;
        {   v4u vR[4], sR[4]; tile_ld<128, 128>(vR, Prow0 + E_RV + h * 128, EVEN_IN, tidl); tile_ld<128, 128>(sR, RKV + (size_t)it * 128 * 128, 128, tidl);
#pragma unroll
            for (int i = 0; i < 4; ++i) { const int row = (tidl >> 4) + 32 * i, cc = tidl & 15; const float fq = __builtin_amdgcn_exp2f(lg * (float)row), fk = __builtin_amdgcn_rcpf(fq); v4u oq, ok;
#pragma unroll
                for (int k = 0; k < 4; ++k) { oq[k] = cvtpk(bflo(qR[i][k]) * fq, bfhi(qR[i][k]) * fq); ok[k] = cvtpk(bflo(kR[i][k]) * fk, bfhi(kR[i][k]) * fk); }
                *(LAS v4u*)(L + RC_QI + row * PR + cc * 16) = oq; *(LAS v4u*)(L + RC_KI + row * PR + cc * 16) = ok; }
            tile_st<128, 128>(vR, L + RC_VI, PT, tidl); tile_st<128, 128>(sR, L + RC_SI, PT, tidl); }
        WG_BAR();
        bf16x8 PA[4][2];
#pragma unroll
        for (int jb = 0; jb < 4; ++jb) {
            if (jb <= ib) {
                f32x16 x = {0.f, 0.f, 0.f, 0.f, 0.f, 0.f, 0.f, 0.f, 0.f, 0.f, 0.f, 0.f, 0.f, 0.f, 0.f, 0.f};
#pragma unroll
                for (int ks = 0; ks < 8; ++ks) x = MFMA32(ld_row(L + RC_KI, PR, jb * 32, 16 * ks, r, h2), ld_row(L + RC_QI, PR, ib * 32, 16 * ks, r, h2), x);
                if (jb == ib) {
#pragma unroll
                    for (int i = 0; i < 16; ++i) if (crow(i, h2) > r) x[i] = 0.f; }
                PA[jb][0] = PACK_STEP(x, 0); PA[jb][1] = PACK_STEP(x, 1);
            } else { PA[jb][0] = (bf16x8){0, 0, 0, 0, 0, 0, 0, 0}; PA[jb][1] = (bf16x8){0, 0, 0, 0, 0, 0, 0, 0}; }
        }
        f32x16 o[2];
#pragma unroll
        for (int t = 0; t < 2; ++t) {
            const int eb = 2 * eq + t;
            f32x16 z = {0.f, 0.f, 0.f, 0.f, 0.f, 0.f, 0.f, 0.f, 0.f, 0.f, 0.f, 0.f, 0.f, 0.f, 0.f, 0.f}, y = z;
#pragma unroll
            for (int jb = 0; jb < 4; ++jb) if (jb <= ib) {
#pragma unroll
                for (int s = 0; s < 2; ++s) z = MFMA32(PA[jb][s], ld_tr_perm(L + RC_VI, PT, jb * 32 + 16 * s, eb * 32, lane), z); }
#pragma unroll
            for (int ks = 0; ks < 8; ++ks) y = MFMA32(ld_row(L + RC_QI, PR, ib * 32, 16 * ks, r, h2), ld_tr(L + RC_SI, PT, 16 * ks, eb * 32, lane), y);
            const float g1 = __builtin_amdgcn_exp2f(lg);
#pragma unroll
            for (int i = 0; i < 16; ++i) z[i] += y[i] * g1;
            o[t] = z;
        }
        WG_BAR();
#pragma unroll
        for (int t = 0; t < 2; ++t)
#pragma unroll
            for (int i = 0; i < 16; ++i) *(LAS bf16*)(L + RC_QI + (ib * 32 + crow(i, h2)) * PR + ((2 * eq + t) * 32 + r) * 2) = cvt1(o[t][i]);
        WG_BAR();
        {   const int nx = (it + F.G < 1024) ? it + F.G : it; const int bh2 = nx >> 5, n2 = nx & 31; const bf16* Pn = P + ((size_t)(bh2 >> 2) * SEQ + n2 * 128) * EVEN_IN;
            tile_ld<128, 128>(qR, Pn + E_RQ + (bh2 & 3) * 128, EVEN_IN, tidl); tile_ld<128, 128>(kR, Pn + E_RK + (bh2 & 3) * 128, EVEN_IN, tidl); }
        {
            const int tid2 = lndv(tidl), row = tid2 >> 2, qtr = tid2 & 3;
            lcp orow = L + RC_QI + row * PR + qtr * 64;
            v4u w[4]; float sum = 0.f;
#pragma unroll
            for (int c = 0; c < 4; ++c) { w[c] = *(const LAS v4u*)(orow + c * 16);
#pragma unroll
                for (int i = 0; i < 4; ++i) sum += bflo(w[c][i]) + bfhi(w[c][i]); }
            sum += xsw<1>(sum); sum += xsw<2>(sum);
            const float mu = sum * (1.0f / 128.0f); float sq = 0.f;
#pragma unroll
            for (int c = 0; c < 4; ++c)
#pragma unroll
                for (int i = 0; i < 4; ++i) { const float d0 = bflo(w[c][i]) - mu, d1 = bfhi(w[c][i]) - mu; sq += d0 * d0 + d1 * d1; }
            sq += xsw<1>(sq); sq += xsw<2>(sq);
            const float rstd = 1.0f / sqrtf(sq * (1.0f / 128.0f) + EPS);
            const bf16* gp = Prow0 + (size_t)row * EVEN_IN + E_RG + h * 128 + qtr * 32;
            bf16* op = CAT + ((size_t)b * SEQ + n * 128 + row) * D + h * 128 + qtr * 32;
#pragma unroll
            for (int c = 0; c < 4; ++c) { const v4u gw = *(const GAS v4u*)(gp + c * 8); v4u ow;
#pragma unroll
                for (int i = 0; i < 4; ++i) { const float g0 = bflo(gw[i]), g1 = bfhi(gw[i]);
                    ow[i] = cvtpk((bflo(w[c][i]) - mu) * rstd * silu_f(g0), (bfhi(w[c][i]) - mu) * rstd * silu_f(g1)); }
                *(GAS v4u*)(op + c * 8) = ow; }
        }
        WG_BAR();
    }
}
struct DilTile { int b, head, p, dil, res, q0; };
__device__ __forceinline__ DilTile dil_decode(int T) { DilTile t; t.b = T / 384; const int rem = T - t.b * 384; t.head = rem / 48; const int t48 = rem - t.head * 48; t.p = t48 >> 4; const int idx = t48 & 15, sh = 2 * t.p;
    t.dil = 1 << sh; t.res = idx & (t.dil - 1); t.q0 = (idx >> sh) * 256; return t; }
__device__ __forceinline__ void dil_ld(v4u (&kR)[6], v4u (&vR)[6], const DilTile& t, const bf16* P, int tid) {
    const bf16* Pb = P + (size_t)t.b * SEQ * EVEN_IN + t.head * 64 + (tid & 7) * 8;
#pragma unroll
    for (int i = 0; i < 6; ++i) { int kidx = t.q0 - 128 + (tid >> 3) + 64 * i; kidx = kidx < 0 ? 0 : kidx;
        const bf16* src = Pb + (size_t)(kidx * t.dil + t.res) * EVEN_IN; kR[i] = *(const GAS v4u*)(src + E_DK); vR[i] = *(const GAS v4u*)(src + E_DV); }
}
__device__ __forceinline__ void dil_tiles(const Frame& F, int T0, int T1, int step, const bf16* P, bf16* OD, float* LSE) {
    LAS unsigned char* L = F.lds;
    const int wave = F.wave;
    if (T0 >= T1) return;
    v4u kR[6], vR[6];
    { const DilTile t0 = dil_decode(T0); dil_ld(kR, vR, t0, P, F.tid); }
    for (int T = T0; T < T1; T += step) {
        const int tidl = lndv(F.tid), lane = tidl & 63, r = lane & 31, h2 = lane >> 5;
        const DilTile t = dil_decode(T);
        const bf16* Pb = P + (size_t)t.b * SEQ * EVEN_IN + t.head * 64;
#pragma unroll
        for (int i = 0; i < 6; ++i) { const int row = (tidl >> 3) + 64 * i, cc = tidl & 7; *(LAS v4u*)(L + DL_KI + row * DPK + cc * 16) = kR[i]; *(LAS v4u*)(L + DL_VI + row * DPV + cc * 16) = vR[i]; }
        bf16x8 qf[4];
        { const bf16* qsrc = Pb + (size_t)((t.q0 + 32 * wave + r) * t.dil + t.res) * EVEN_IN + E_DQ + 8 * h2;
#pragma unroll
          for (int ks = 0; ks < 4; ++ks) qf[ks] = *(const GAS bf16x8*)(qsrc + 16 * ks); }
        WG_BAR();
        { const DilTile tn = dil_decode(T + step < T1 ? T + step : T); dil_ld(kR, vR, tn, P, tidl); }
        f32x16 x[5];
        float mx = -INFINITY;
#pragma unroll
        for (int kb = 0; kb < 5; ++kb) {
            f32x16 a = {0.f, 0.f, 0.f, 0.f, 0.f, 0.f, 0.f, 0.f, 0.f, 0.f, 0.f, 0.f, 0.f, 0.f, 0.f, 0.f};
#pragma unroll
            for (int ks = 0; ks < 4; ++ks) a = MFMA32(ld_row(L + DL_KI, DPK, 32 * wave + 32 * kb, 16 * ks, r, h2), qf[ks], a);
            if (kb == 0) {
#pragma unroll
                for (int i = 0; i < 16; ++i) if (crow(i, h2) < r) a[i] = -INFINITY; }
            if (kb == 4) {
#pragma unroll
                for (int i = 0; i < 16; ++i) if (crow(i, h2) > r) a[i] = -INFINITY; }
            if (t.q0 == 0 && 32 * wave + 32 * kb < 128) {
#pragma unroll
                for (int i = 0; i < 16; ++i) a[i] = -INFINITY; }
#pragma unroll
            for (int i = 0; i < 16; ++i) mx = fmaxf(mx, a[i]);
            x[kb] = a;
        }
        mx = max32(mx);
        constexpr float C2 = 0.125f * LOG2E;
        const float mc = mx * C2; float l = 0.f;
#pragma unroll
        for (int kb = 0; kb < 5; ++kb)
#pragma unroll
            for (int i = 0; i < 16; ++i) { const float pe = __builtin_amdgcn_exp2f(x[kb][i] * C2 - mc); x[kb][i] = pe; l += pe; }
        l = sum32(l);
        f32x16 o[2];
#pragma unroll
        for (int dbk = 0; dbk < 2; ++dbk) o[dbk] = (f32x16){0.f, 0.f, 0.f, 0.f, 0.f, 0.f, 0.f, 0.f, 0.f, 0.f, 0.f, 0.f, 0.f, 0.f, 0.f, 0.f};
#pragma unroll
        for (int kb = 0; kb < 5; ++kb)
#pragma unroll
            for (int s = 0; s < 2; ++s) { const bf16x8 pa = PACK_STEP(x[kb], s);
#pragma unroll
                for (int dbk = 0; dbk < 2; ++dbk) o[dbk] = MFMA32(pa, ld_tr_perm(L + DL_VI, DPV, 32 * wave + 32 * kb + 16 * s, dbk * 32, lane), o[dbk]); }
        LAS float* lw = (LAS float*)(L + DL_LW + wave * 256);
        if (h2 == 0) lw[r] = l;
        WG_BAR();
        LAS unsigned char* st = L + DL_ST + wave * 32 * DPK;
#pragma unroll
        for (int i = 0; i < 16; ++i) { const float rl = __builtin_amdgcn_rcpf(lw[crow(i, h2)]);
#pragma unroll
            for (int dbk = 0; dbk < 2; ++dbk) *(LAS bf16*)(st + crow(i, h2) * DPK + (dbk * 32 + r) * 2) = cvt1(o[dbk][i] * rl); }
        const size_t tokbase = (size_t)t.b * SEQ;
        bf16* odp = OD + (size_t)t.p * M * 512;
#pragma unroll
        for (int j = 0; j < 4; ++j) { const int c = lane + 64 * j, row = c >> 3, cc = c & 7; const size_t tok = tokbase + (size_t)(t.q0 + 32 * wave + row) * t.dil + t.res;
            *(GAS v4u*)(odp + tok * 512 + t.head * 64 + cc * 8) = *(const LAS v4u*)(st + row * DPK + cc * 16); }
        if (h2 == 0) { const size_t tok = tokbase + (size_t)(t.q0 + 32 * wave + r) * t.dil + t.res; LSE[((size_t)t.p * M + tok) * 8 + t.head] = mx * 0.125f + LN2 * __builtin_amdgcn_logf(l); }
        WG_BAR();
    }
}
__device__ __forceinline__ void dil_combine(const Frame& F, const bf16* OD, const float* LSE, bf16* CAT) {
    for (int gt = F.bid * NTHREADS + F.tid; gt < M * 64; gt += F.G * NTHREADS) {
        const int tok = gt >> 6, c8 = gt & 63, head = c8 >> 3;
        const float l0 = LSE[(size_t)tok * 8 + head], l1 = LSE[((size_t)M + tok) * 8 + head], l2 = LSE[((size_t)2 * M + tok) * 8 + head];
        const float mxl = fmaxf(l0, fmaxf(l1, l2));
        float w0 = __builtin_amdgcn_exp2f((l0 - mxl) * LOG2E), w1 = __builtin_amdgcn_exp2f((l1 - mxl) * LOG2E), w2 = __builtin_amdgcn_exp2f((l2 - mxl) * LOG2E);
        const float rs = 1.0f / (w0 + w1 + w2); w0 *= rs; w1 *= rs; w2 *= rs;
        const v4u a = *(const GAS v4u*)(OD + (size_t)tok * 512 + c8 * 8), bq = *(const GAS v4u*)(OD + ((size_t)M + tok) * 512 + c8 * 8), cq = *(const GAS v4u*)(OD + ((size_t)2 * M + tok) * 512 + c8 * 8);
        v4u o;
#pragma unroll
        for (int i = 0; i < 4; ++i) o[i] = cvtpk(w0 * bflo(a[i]) + w1 * bflo(bq[i]) + w2 * bflo(cq[i]), w0 * bfhi(a[i]) + w1 * bfhi(bq[i]) + w2 * bfhi(cq[i]));
        *(GAS v4u*)(CAT + (size_t)tok * D + 512 + c8 * 8) = o;
    }
}
constexpr int DIL_TILES = 3072, DIL_SPLIT = 1024;
__device__ __forceinline__ void even_phase_a(const Frame& F0) {
    const Frame F = relaunder(F0);
    unsigned char* ws = WSP();
    const bf16* P = (const bf16*)(ws + WS_ACT); bf16* RKV = (bf16*)(ws + WS_XB); bf16* OD = (bf16*)(ws + WS_OD); float* LSE = (float*)(ws + WS_LSE);
    ret_phase_a_items(F, P, RKV);
    dil_tiles(F, F.bid, DIL_SPLIT, F.G, P, OD, LSE);
}
__device__ __forceinline__ void even_phase_b(const Frame& F0) {
    const Frame F = relaunder(F0);
    unsigned char* ws = WSP();
    const bf16* P = (const bf16*)(ws + WS_ACT); bf16* RKV = (bf16*)(ws + WS_XB); bf16* OD = (bf16*)(ws + WS_OD); float* LSE = (float*)(ws + WS_LSE);
    ret_scan(F, RKV);
    dil_tiles(F, DIL_SPLIT + F.bid, DIL_TILES, F.G, P, OD, LSE);
}
__device__ __forceinline__ void even_phase_c(const Frame& F0) {
    const Frame F = relaunder(F0);
    unsigned char* ws = WSP();
    const bf16* P = (const bf16*)(ws + WS_ACT); const bf16* RKV = (const bf16*)(ws + WS_XB); const bf16* OD = (const bf16*)(ws + WS_OD); const float* LSE = (const float*)(ws + WS_LSE); bf16* CAT = (bf16*)(ws + WS_CAT);
    ret_phase_c_items(F, P, RKV, CAT);
    dil_combine(F, OD, LSE, CAT);
}

__global__ void __launch_bounds__(NTHREADS, 2) fwd_kernel(Args args) {
    extern __shared__ __attribute__((aligned(16))) unsigned char lds[];
    Frame F;
    F.lds = (LAS unsigned char*)lds;
    F.wave = __builtin_amdgcn_readfirstlane((int)(threadIdx.x >> 6)); F.lane = hw_lane(); F.tid = F.wave * 64 + F.lane; F.G = gridDim.x; F.bid = blockIdx.x;
    for (int u = F.tid; u < (LDS_BYTES - LDSCTL_OFF) / 4; u += NTHREADS) ((LAS unsigned*)(F.lds + LDSCTL_OFF))[u] = 0u;
    __syncthreads();
    if (F.tid < N_PTRS) { const unsigned long long v = (F.tid < 17) ? (unsigned long long)args.in[F.tid] : (F.tid == 17 ? (unsigned long long)args.out : (unsigned long long)args.ws);
        ((LAS unsigned*)(F.lds + PTR_OFF))[2 * F.tid] = (unsigned)v; ((LAS unsigned*)(F.lds + PTR_OFF))[2 * F.tid + 1] = (unsigned)(v >> 32); }
    __syncthreads();
    (void)xcd_barrier_post((unsigned*)(WSP() + WS_CTL) + CW_BAR, (volatile LAS unsigned*)(F.lds + MISC_OFF) + 8, F.tid);
#ifdef PROBE_BARX2
#define PROBE_BAR2(b, t) xcd_barrier(b, t)
#else
#define PROBE_BAR2(b, t) do {} while (0)
#endif
#define GRID_BAR() do { XcdBarrier bar_; bar_.bar = (unsigned*)(WSP() + WS_CTL) + CW_BAR; bar_.x = (unsigned)__builtin_amdgcn_readfirstlane((int)xb_xcc_id()); \
        int mo_ = MISC_OFF + 32; asm volatile("" : "+s"(mo_)); bar_.st = (volatile LAS unsigned*)(F.lds + mo_); int t_ = threadIdx.x; asm volatile("" : "+v"(t_)); xcd_barrier(bar_, t_); PROBE_BAR2(bar_, t_); } while (0)
#define XB ((bf16*)(WSP() + WS_XB))
#define ACT ((bf16*)(WSP() + WS_ACT))
#define CAT ((bf16*)(WSP() + WS_CAT))
#define SSP ((float*)(WSP() + WS_SSP))
#define WPTR(off) ((const bf16*)(WSP() + (off)))

#ifdef TEST_MIN
    {
        pg8::Gemm g{XB, WPTR(W_GU0), M, 2 * FF, D}; pg8::StaticOrder S; S.init(M, 2 * FF, lnd(F.G), lnd(F.bid));
        pg8::EpiSwiGLU E{ACT, FF, SSP};
        pg8::gemm_phase<pg8::EpiSwiGLU, pg8::StaticOrder, true, true>(F.lds + RING_OFF, g, S, E, lnd(F.wave));
        GRID_BAR();
        return;
    }
#endif
    prologue_rows(F);
    convert_weights(F, 0);
    GRID_BAR();
    for (int s = 0; s < 8; ++s) {
        const int l = s >> 1; const bool post = (s & 1) != 0;
#ifdef PROBE_F1X2
        for (int rep = 0; rep < 2; ++rep)
#endif
        {
#ifdef PROBE_KX2
            typedef pg8::TwiceOrder F1Order;
#else
            typedef pg8::StaticOrder F1Order;
#endif
            pg8::Gemm g{XB, WPTR(post ? W_GU1 : W_GU0), M, 2 * FF, D}; F1Order S; S.init(M, 2 * FF, lnd(F.G), lnd(F.bid));
            pg8::EpiSwiGLU E{ACT, FF, SSP};
#ifndef NO_F1
            pg8::gemm_phase<pg8::EpiSwiGLU, F1Order, true, true>(F.lds + RING_OFF, g, S, E, lnd(F.wave));
#endif
            GRID_BAR();
        }
#ifdef PROBE_F2X2
        for (int rep = 0; rep < 2; ++rep)
#else
        constexpr int rep = 1;
#endif
        {
            pg8::Gemm g{ACT, WPTR(post ? W_D1 : W_D0), M, D, FF}; pg8::StaticOrder S; S.init(M, D, lnd(F.G), lnd(F.bid));
            pg8::EpiResid E{s == 0 ? AP(I_X) : (const float*)OUTP(), OUTP(), XB, SSP, rep ? 0.5f : 0.0f};
#ifndef NO_F2
            pg8::gemm_phase<pg8::EpiResid, pg8::StaticOrder, true, true>(F.lds + RING_OFF, g, S, E, lnd(F.wave));
#endif
            GRID_BAR();
        }
        if (!post) {
            const bool odd = (l & 1) != 0; const int nin = odd ? GLA_INP : EVEN_IN;
            {
                pg8::Gemm g{XB, WPTR(W_IN), M, nin, D}; pg8::StaticOrder S; S.init(M, nin, lnd(F.G), lnd(F.bid));
                pg8::EpiScaleBf16 E{ACT, nin, SSP};
#ifndef NO_M1
                pg8::gemm_phase<pg8::EpiScaleBf16, pg8::StaticOrder, true, true>(F.lds + RING_OFF, g, S, E, lnd(F.wave));
#endif
            }
            GRID_BAR();
#ifndef NO_EVEN
#if defined(PROBE_MIXX2) || defined(PROBE_EVENX2)
            if (!odd) { even_prep(F); GRID_BAR(); even_phase_a(F); GRID_BAR(); even_phase_a(F); GRID_BAR(); even_phase_b(F); GRID_BAR(); even_phase_c(F); GRID_BAR(); even_phase_c(F); }
#else
            if (!odd) { even_prep(F); GRID_BAR(); even_phase_a(F); GRID_BAR(); even_phase_b(F); GRID_BAR(); even_phase_c(F); }
#endif
#endif
#ifndef NO_GLA
            if (odd) {
#ifndef NO_GA
                gla_phase_a(F, l >> 1);
#endif
#ifdef PROBE_MIXX2
                GRID_BAR(); gla_phase_a(F, l >> 1);
#endif
                GRID_BAR();
#ifndef NO_GB
                gla_phase_b(F);
#endif
                GRID_BAR();
#ifndef NO_GC
                gla_phase_c(F, l >> 1);
#endif
#ifdef PROBE_MIXX2
                GRID_BAR(); gla_phase_c(F, l >> 1);
#endif
            }
#endif
            GRID_BAR();
#ifdef PROBE_M5X2
            for (int rep2 = 0; rep2 < 2; ++rep2)
#else
            constexpr int rep2 = 1;
#endif
            {
                pg8::Gemm g{CAT, WPTR(W_OUT), M, D, D}; pg8::StaticOrder S; S.init(M, D, lnd(F.G), lnd(F.bid));
                pg8::EpiResid E{(const float*)OUTP(), OUTP(), XB, SSP, rep2 ? 1.0f : 0.0f};
#ifndef NO_M5
                pg8::gemm_phase<pg8::EpiResid, pg8::StaticOrder, true, true>(F.lds + RING_OFF, g, S, E, lnd(F.wave));
#endif
                GRID_BAR();
            }
        } else if (l + 1 < DEPTH) {
            convert_weights(F, l + 1);
            GRID_BAR();
#ifdef PROBE_CONVX2
            convert_weights(F, l + 1);
            GRID_BAR();
#endif
        }
    }
    final_norm(F);
}

extern "C" void kernel_launch(void* const* d_in, const int* in_sizes, int n_in, void* d_out, int out_size, void* d_ws, size_t ws_size, hipStream_t stream) {
    static int grid = 0;
    if (grid == 0) {
        if (n_in != 17 || in_sizes[0] != M * D || out_size != M * D || ws_size < WS_END2) { fprintf(stderr, "kernel_launch: unexpected shapes (n_in %d, in0 %d, out %d, ws %zu)\n", n_in, n_in > 0 ? in_sizes[0] : -1, out_size, ws_size); grid = -1; return; }
        int dev = 0, cus = 0, per_cu = 0;
        if (hipGetDevice(&dev) != hipSuccess || hipDeviceGetAttribute(&cus, hipDeviceAttributeMultiprocessorCount, dev) != hipSuccess) { grid = -1; return; }
        if (hipFuncSetAttribute((const void*)fwd_kernel, hipFuncAttributeMaxDynamicSharedMemorySize, LDS_BYTES) != hipSuccess) { fprintf(stderr, "kernel_launch: hipFuncSetAttribute failed\n"); grid = -1; return; }
        if (hipOccupancyMaxActiveBlocksPerMultiprocessor(&per_cu, (const void*)fwd_kernel, NTHREADS, LDS_BYTES) != hipSuccess || per_cu < 1) { fprintf(stderr, "kernel_launch: occupancy query reports %d\n", per_cu); }
        (void)hipGetLastError();
        grid = cus;
        if (grid != 256) fprintf(stderr, "kernel_launch: %d CUs (expected 256)\n", grid);
    }
    if (grid < 0) return;
    if (hipMemsetAsync((char*)d_ws + WS_CTL, 0, CTL_ZERO_BYTES, stream) != hipSuccess) return;
    Args a{};
    for (int i = 0; i < 17; ++i) a.in[i] = (const float*)d_in[i];
    a.out = (float*)d_out; a.ws = (unsigned char*)d_ws;
    hipLaunchKernelGGL(fwd_kernel, dim3(grid), dim3(NTHREADS), LDS_BYTES, stream, a);
}
```

```cpp
#include <hip/hip_runtime.h>
#include <cstdio>
#include <cstdint>
#include <cmath>
template <int K> __device__ __forceinline__ float xsw(float v) { static_assert(K == 1 || K == 2 || K == 4 || K == 8 || K == 16, "xor mask inside a 32-lane half");
    return __builtin_bit_cast(float, __builtin_amdgcn_ds_swizzle(__builtin_bit_cast(int, v), 0x1F | (K << 10))); }
__device__ __forceinline__ float sum32(float v) { const unsigned u = __builtin_bit_cast(unsigned, v); auto rr = __builtin_amdgcn_permlane32_swap(u, u, false, false); return __builtin_bit_cast(float, (unsigned)rr[0]) + __builtin_bit_cast(float, (unsigned)rr[1]); }
__device__ __forceinline__ float max32(float v) { const unsigned u = __builtin_bit_cast(unsigned, v); auto rr = __builtin_amdgcn_permlane32_swap(u, u, false, false); return fmaxf(__builtin_bit_cast(float, (unsigned)rr[0]), __builtin_bit_cast(float, (unsigned)rr[1])); }
__device__ __forceinline__ float oth32(float v, int h) { const unsigned u = __builtin_bit_cast(unsigned, v); auto rr = __builtin_amdgcn_permlane32_swap(u, u, false, false); return __builtin_bit_cast(float, (unsigned)(h ? rr[0] : rr[1])); }
namespace pg8 {
#define PG8_LAS __attribute__((address_space(3)))
typedef unsigned short bf16_t;
typedef short bf16x8 __attribute__((ext_vector_type(8)));
typedef float f32x4 __attribute__((ext_vector_type(4)));
typedef unsigned u32x4 __attribute__((ext_vector_type(4)));
constexpr int BM = 256, BK = 64, HALF = 128, HTB = HALF * BK * 2  , STAGE_BYTES = 8 * HTB, NXCD = 8, WGM = 8;

__host__ __device__ __forceinline__ int lds_byte(int r, int c) { const int st = (r >> 4) * 2 + (c >> 5), rr = r & 15, cc = c & 31, ob = rr * 64 + cc * 2; return st * 1024 + (ob ^ (((ob >> 9) & 1) << 5)); }
__host__ __device__ __forceinline__ void stage_rc(int b, int& R, int& C) { const int st = b / 1024, sb = b % 1024, swz = sb ^ (((sb >> 9) & 1) << 5); R = (st >> 1) * 16 + swz / 64; C = (st & 1) * 32 + (swz % 64) / 2; }
__host__ __device__ __forceinline__ int perm32(int rho) { const int n = rho >> 4, i = rho & 15; return 8 * (i >> 2) + 4 * n + (i & 3); }

struct Unit { int pm, pn; };
struct Gemm { const bf16_t* A; const bf16_t* Bt; int M, N, K; };

struct StaticOrder {
    int nM, nN, nwg, G, c;
    __host__ __device__ void init(int M, int N, int G_, int c_) { nM = M / BM; nN = N / BM; nwg = nM * nN; G = G_; c = c_; }
    __host__ __device__ bool next(int i, Unit& u) const {
        const long L = (long)i * G + c; if (L >= nwg) return false;
        int wgid = (int)L; { const int q = nwg / NXCD, r = nwg % NXCD, xcd = wgid % NXCD, off = wgid / NXCD; wgid = (xcd < r ? xcd * (q + 1) : r * (q + 1) + (xcd - r) * q) + off; }
        const int nig = WGM * nN, gid = wgid / nig, fm = gid * WGM, gsz = (nM - fm) < WGM ? (nM - fm) : WGM;
        u.pm = fm + ((wgid % nig) % gsz); u.pn = (wgid % nig) / gsz; return true;
    }
    __device__ __forceinline__ void a_ready(const Unit&) const {}
    __device__ __forceinline__ void done(const Unit&) const {}
    static constexpr bool TWICE = false;
};
struct TwiceOrder : StaticOrder {
    static constexpr bool TWICE = true;
    __host__ __device__ bool next(int i, Unit& u) const { return StaticOrder::next(i >> 1, u); }
};

__device__ __forceinline__ unsigned cvt_pk_bf16(float lo, float hi) { unsigned r; asm volatile("v_cvt_pk_bf16_f32 %0, %1, %2" : "=v"(r) : "v"(lo), "v"(hi)); return r; }
constexpr int MROWS = 32768;
constexpr float RMS_EPS = 1e-6f;
__device__ __forceinline__ void row_rstd(float (&rs)[2][4], const float* ssp, const Unit& u, int wr, int fr, int fq) {
#pragma unroll
    for (int ai = 0; ai < 2; ++ai)
#pragma unroll
        for (int m = 0; m < 4; ++m) {
            const int row = u.pm * BM + ai * HALF + wr * 64 + m * 16 + fr;
            const f32x4 p = *(const f32x4*)(ssp + (size_t)row * 16 + 4 * fq);
            float s = (p[0] + p[1]) + (p[2] + p[3]);
            s += xsw<16>(s); s = sum32(s);
            rs[ai][m] = 1.0f / sqrtf(s * (1.0f / 1024.0f) + RMS_EPS);
        }
}
__device__ __forceinline__ float silu_f(float g) { return g * __builtin_amdgcn_rcpf(1.0f + __builtin_amdgcn_exp2f(-1.4426950408889634f * g)); }

struct EpiSwiGLU {
    static constexpr bool PERM = true, AFTER_DRAIN = false;
    bf16_t* H; int ldh; const float* ssp;
    __device__ __forceinline__ void operator()(const f32x4 (&acc)[2][2][4][2], const Unit& u, int wr, int wc, int fr, int fq) const {
        float rs[2][4]; row_rstd(rs, ssp, u, wr, fr, fq);
        const int col0 = u.pn * HALF + wc * 32 + 8 * fq;
#pragma unroll
        for (int ai = 0; ai < 2; ++ai)
#pragma unroll
            for (int m = 0; m < 4; ++m) {
                const int row = u.pm * BM + ai * HALF + wr * 64 + m * 16 + fr; const float r = rs[ai][m];
                float h[8];
#pragma unroll
                for (int n = 0; n < 2; ++n)
#pragma unroll
                    for (int i = 0; i < 4; ++i) { const float g = acc[ai][0][m][n][i] * r, up = acc[ai][1][m][n][i] * r; h[4 * n + i] = silu_f(g) * up; }
                u32x4 w; w.x = cvt_pk_bf16(h[0], h[1]); w.y = cvt_pk_bf16(h[2], h[3]); w.z = cvt_pk_bf16(h[4], h[5]); w.w = cvt_pk_bf16(h[6], h[7]);
                *(u32x4*)(H + (size_t)row * ldh + col0) = w;
                asm volatile("" ::: "memory");
            }
    }
};
struct EpiInProj {
    static constexpr bool PERM = true, AFTER_DRAIN = false;
    bf16_t* O; int ldc; const float* ssp; const float* rc; const float* rs; const float* dc; const float* ds; int even;
    __device__ __forceinline__ void operator()(const f32x4 (&acc)[2][2][4][2], const Unit& u, int wr, int wc, int fr, int fq) const {
        float rsd[2][4]; row_rstd(rsd, ssp, u, wr, fr, fq);
        const int col0 = u.pn * BM + wc * 32 + 8 * fq;
        const int kind = even ? (u.pn < 4 ? 1 : ((u.pn >= 8 && u.pn < 12) ? 2 : 0)) : 0;
        const float ksc = (kind == 1 && u.pn >= 2) ? 0.08838834764831845f : 1.0f;
        const bool rot2 = (kind == 2) && ((wc & 1) == 0) && (fq < 2);
        const float* tc = (kind == 1) ? rc + wc * 16 + 4 * fq : dc + 4 * (fq & 1);
        const float* ts = (kind == 1) ? rs + wc * 16 + 4 * fq : ds + 4 * (fq & 1);
        const int tstride = (kind == 1) ? 64 : 8;
#pragma unroll
        for (int ai = 0; ai < 2; ++ai)
#pragma unroll
            for (int m = 0; m < 4; ++m) {
                const int row = u.pm * BM + ai * HALF + wr * 64 + m * 16 + fr; const float r = rsd[ai][m] * ksc;
                f32x4 c4 = {1.f, 1.f, 1.f, 1.f}, s4 = {0.f, 0.f, 0.f, 0.f};
                if (kind == 1 || rot2) { const int pos = row & 4095; c4 = *(const f32x4*)(tc + (size_t)pos * tstride); s4 = *(const f32x4*)(ts + (size_t)pos * tstride); }
#pragma unroll
                for (int bj = 0; bj < 2; ++bj) { const f32x4 v0 = acc[ai][bj][m][0] * r, v1 = acc[ai][bj][m][1] * r;
                    const float o0 = v0[0] * c4[0] - v0[1] * s4[0], o1 = v0[1] * c4[0] + v0[0] * s4[0], o2 = v0[2] * c4[1] - v0[3] * s4[1], o3 = v0[3] * c4[1] + v0[2] * s4[1];
                    const float o4 = v1[0] * c4[2] - v1[1] * s4[2], o5 = v1[1] * c4[2] + v1[0] * s4[2], o6 = v1[2] * c4[3] - v1[3] * s4[3], o7 = v1[3] * c4[3] + v1[2] * s4[3];
                    u32x4 w; w.x = cvt_pk_bf16(o0, o1); w.y = cvt_pk_bf16(o2, o3); w.z = cvt_pk_bf16(o4, o5); w.w = cvt_pk_bf16(o6, o7);
                    *(u32x4*)(O + (size_t)row * ldc + col0 + bj * HALF) = w; }
                asm volatile("" ::: "memory");
            }
    }
};
struct EpiResid {
    static constexpr bool PERM = true, AFTER_DRAIN = false;
    const float* xold; float* xnew; bf16_t* xb; float* ssp; float scale;
    __device__ __forceinline__ void operator()(const f32x4 (&acc)[2][2][4][2], const Unit& u, int wr, int wc, int fr, int fq) const {
        const int col0 = u.pn * BM + wc * 32 + 8 * fq, rowb = u.pm * BM + wr * 64 + fr;
        f32x4 buf[2][4];
#define EPR_LOAD(g, slot) do { const size_t off_ = (size_t)(rowb + ((g) >> 2) * HALF + ((g) & 3) * 16) * 1024 + col0; \
        buf[slot][0] = *(const f32x4*)(xold + off_); buf[slot][1] = *(const f32x4*)(xold + off_ + 4); buf[slot][2] = *(const f32x4*)(xold + off_ + HALF); buf[slot][3] = *(const f32x4*)(xold + off_ + HALF + 4); } while (0)
        EPR_LOAD(0, 0); EPR_LOAD(1, 1);
        asm volatile("" ::: "memory");
#pragma unroll
        for (int g = 0; g < 8; ++g) {
            const int ai = g >> 2, m = g & 3, row = rowb + ai * HALF + m * 16; float ss = 0.f;
#pragma unroll
            for (int bj = 0; bj < 2; ++bj) { const size_t off = (size_t)row * 1024 + col0 + bj * HALF;
                const f32x4 v0 = buf[g & 1][2 * bj] + acc[ai][bj][m][0] * scale, v1 = buf[g & 1][2 * bj + 1] + acc[ai][bj][m][1] * scale;
                *(f32x4*)(xnew + off) = v0; *(f32x4*)(xnew + off + 4) = v1;
                u32x4 w; w.x = cvt_pk_bf16(v0[0], v0[1]); w.y = cvt_pk_bf16(v0[2], v0[3]); w.z = cvt_pk_bf16(v1[0], v1[1]); w.w = cvt_pk_bf16(v1[2], v1[3]);
                *(u32x4*)(xb + off) = w;
                ss += (v0[0] * v0[0] + v0[1] * v0[1]) + (v0[2] * v0[2] + v0[3] * v0[3]) + (v1[0] * v1[0] + v1[1] * v1[1]) + (v1[2] * v1[2] + v1[3] * v1[3]); }
            ss += xsw<16>(ss); ss = sum32(ss);
            if (fq == 0) ssp[(size_t)row * 16 + u.pn * 4 + wc] = ss;
            asm volatile("" ::: "memory");
            if (g + 2 < 8) { EPR_LOAD(g + 2, g & 1); asm volatile("" ::: "memory"); }
        }
#undef EPR_LOAD
    }
};

template <class Epi, class Sched, bool ALIGN_EPI = false, bool SP2 = false>
__device__ __forceinline__ void gemm_phase(PG8_LAS unsigned char* lds, const Gemm g, const Sched& S, const Epi& E, int wave_in) {
    int tid_ = threadIdx.x; asm volatile("" : "+v"(tid_));
    const int tid = tid_, wid = __builtin_amdgcn_readfirstlane(tid >> 6), lane = tid & 63, wr = wid >> 2, wc = wid & 3, fr = lane & 15, fq = lane >> 4;
    const int K = g.K, nt = K / BK;
    unsigned voffA[2], voffB[2];
#pragma unroll
    for (int i = 0; i < 2; ++i) { int R, C; stage_rc(tid * 16 + i * 8192, R, C); const int Rb = Epi::PERM ? ((R & ~31) + perm32(R & 31)) : R;
        voffA[i] = (unsigned)(R * K + C) * 2u; voffB[i] = (unsigned)(Rb * K + C) * 2u; }
    const size_t kstep = (size_t)(BK * 2);
    const size_t hstep = (size_t)HALF * K * 2;
    const size_t tstep = 2 * hstep;
    const unsigned ldsw = (unsigned)wid * 1024u;
    const int aoff = lds_byte(wr * 64 + fr, fq * 8), boff = lds_byte(wc * 32 + fr, fq * 8);
#define PG8_SA(b, h) (((b) * 2 + (h)) * HTB)
#define PG8_SB(b, h) ((4 + (b) * 2 + (h)) * HTB)
#define PG8_STAGE(bufoff, gbase, voff) do { _Pragma("unroll") for (int _i = 0; _i < 2; ++_i) \
        __builtin_amdgcn_global_load_lds((const unsigned*)((const char*)(gbase) + (voff)[_i]), (PG8_LAS unsigned*)(lds + (bufoff) + ldsw + _i * 8192), 16, 0, 0); } while (0)
#define PG8_LDA(dst, b, h) do { _Pragma("unroll") for (int m = 0; m < 4; ++m) _Pragma("unroll") for (int k = 0; k < 2; ++k) dst[m][k] = *(const PG8_LAS bf16x8*)(lds + PG8_SA(b, h) + aoff + m * 2048 + k * 1024); } while (0)
#define PG8_LDB(dst, b, h) do { _Pragma("unroll") for (int n = 0; n < 2; ++n) _Pragma("unroll") for (int k = 0; k < 2; ++k) dst[n][k] = *(const PG8_LAS bf16x8*)(lds + PG8_SB(b, h) + boff + n * 2048 + k * 1024); } while (0)
#define PG8_MMA(ai, bj, At, Bt) do { __builtin_amdgcn_s_setprio(1); _Pragma("unroll") for (int m = 0; m < 4; ++m) _Pragma("unroll") for (int n = 0; n < 2; ++n) _Pragma("unroll") for (int k = 0; k < 2; ++k) \
        acc[ai][bj][m][n] = __builtin_amdgcn_mfma_f32_16x16x32_bf16(Bt[n][k], At[m][k], acc[ai][bj][m][n], 0, 0, 0); __builtin_amdgcn_s_setprio(0); } while (0)
#define PG8_WAIT_V(n) asm volatile("s_waitcnt vmcnt(" #n ")" ::: "memory")
#define PG8_WAIT_L(n) asm volatile("s_waitcnt lgkmcnt(" #n ")" ::: "memory")
#define PG8_BAR __builtin_amdgcn_s_barrier()
#define PG8_SCHED __builtin_amdgcn_sched_barrier(0)
    Unit cur, nxt; int ui = 0;
    if (!S.next(0, cur)) return;
    f32x4 acc[2][2][4][2];
#pragma unroll
    for (int a = 0; a < 2; ++a)
#pragma unroll
        for (int b = 0; b < 2; ++b)
#pragma unroll
            for (int m = 0; m < 4; ++m)
#pragma unroll
                for (int n = 0; n < 2; ++n) acc[a][b][m][n] = (f32x4){0.f, 0.f, 0.f, 0.f};
    bf16x8 At[4][2], B0[2][2], B1[2][2];
    const char* cA = (const char*)g.A + (size_t)cur.pm * tstep; const char* cB = (const char*)g.Bt + (size_t)cur.pn * tstep;
    S.a_ready(cur);
    if constexpr (SP2) {
        PG8_STAGE(PG8_SB(0, 0), cB, voffB); PG8_STAGE(PG8_SB(0, 1), cB + hstep, voffB); PG8_STAGE(PG8_SA(0, 0), cA, voffA); PG8_STAGE(PG8_SA(0, 1), cA + hstep, voffA);
        if (wr == 1) PG8_BAR;
        PG8_WAIT_V(2); PG8_BAR;
        PG8_STAGE(PG8_SB(1, 0), cB + kstep, voffB); PG8_STAGE(PG8_SA(1, 0), cA + kstep, voffA); PG8_STAGE(PG8_SB(1, 1), cB + hstep + kstep, voffB);
        PG8_WAIT_V(6); PG8_BAR;
    } else {
        PG8_STAGE(PG8_SB(0, 0), cB, voffB); PG8_STAGE(PG8_SA(0, 0), cA, voffA); PG8_STAGE(PG8_SB(0, 1), cB + hstep, voffB); PG8_STAGE(PG8_SA(0, 1), cA + hstep, voffA);
        if (wr == 1) PG8_BAR;
        PG8_WAIT_V(4); PG8_BAR;
        PG8_STAGE(PG8_SB(1, 0), cB + kstep, voffB); PG8_STAGE(PG8_SA(1, 0), cA + kstep, voffA); PG8_STAGE(PG8_SB(1, 1), cB + hstep + kstep, voffB);
        PG8_WAIT_V(6); PG8_BAR;
    }
    for (;;) {
        const bool has_next = S.next(ui + 1, nxt);
        const char* nA = has_next ? (const char*)g.A + (size_t)nxt.pm * tstep : cA; const char* nB = has_next ? (const char*)g.Bt + (size_t)nxt.pn * tstep : cB;
        for (int t = 0; t < nt; t += 2) {
            const bool last = (t == nt - 2);
            const char* a1 = cA + (size_t)(t + 1) * kstep;
            const char* a2 = last ? nA : cA + (size_t)(t + 2) * kstep; const char* b2 = last ? nB : cB + (size_t)(t + 2) * kstep;
            const char* a3 = a2 + kstep; const char* b3 = b2 + kstep;
            if (last && has_next) S.a_ready(nxt);
            if constexpr (SP2) {
            PG8_LDB(B0, 0, 0); PG8_LDB(B1, 0, 1); PG8_SCHED; PG8_LDA(At, 0, 0); PG8_STAGE(PG8_SA(1, 1), a1 + hstep, voffA);
            PG8_WAIT_V(8); PG8_WAIT_L(0); PG8_BAR; PG8_MMA(0, 0, At, B0); PG8_MMA(0, 1, At, B1); PG8_BAR; PG8_SCHED;
            PG8_LDA(At, 0, 1); PG8_STAGE(PG8_SB(0, 0), b2, voffB); PG8_STAGE(PG8_SB(0, 1), b2 + hstep, voffB); PG8_STAGE(PG8_SA(0, 0), a2, voffA);
            PG8_WAIT_V(8); PG8_WAIT_L(0); PG8_BAR; PG8_MMA(1, 0, At, B0); PG8_MMA(1, 1, At, B1); PG8_BAR; PG8_SCHED;
            PG8_LDB(B0, 1, 0); PG8_LDB(B1, 1, 1); PG8_SCHED; PG8_LDA(At, 1, 0); PG8_STAGE(PG8_SA(0, 1), a2 + hstep, voffA);
            PG8_WAIT_V(8); PG8_WAIT_L(0); PG8_BAR; PG8_MMA(0, 0, At, B0); PG8_MMA(0, 1, At, B1); PG8_BAR; PG8_SCHED;
            PG8_LDA(At, 1, 1); PG8_STAGE(PG8_SB(1, 0), b3, voffB); PG8_STAGE(PG8_SB(1, 1), b3 + hstep, voffB); PG8_STAGE(PG8_SA(1, 0), a3, voffA);
            PG8_WAIT_V(8); PG8_WAIT_L(0); PG8_BAR; PG8_MMA(1, 0, At, B0); PG8_MMA(1, 1, At, B1); PG8_BAR; PG8_SCHED;
            } else {
            PG8_LDB(B0, 0, 0); PG8_SCHED; PG8_LDA(At, 0, 0); PG8_STAGE(PG8_SA(1, 1), a1 + hstep, voffA);
            PG8_WAIT_L(8); PG8_BAR; PG8_WAIT_L(0); PG8_MMA(0, 0, At, B0); PG8_BAR; PG8_SCHED;
            PG8_LDB(B1, 0, 1); PG8_STAGE(PG8_SB(0, 0), b2, voffB);
            PG8_BAR; PG8_WAIT_L(0); PG8_MMA(0, 1, At, B1); PG8_BAR;
            PG8_LDA(At, 0, 1); PG8_STAGE(PG8_SA(0, 0), a2, voffA);
            PG8_BAR; PG8_WAIT_L(0); PG8_MMA(1, 0, At, B0); PG8_BAR; PG8_SCHED;
            PG8_STAGE(PG8_SB(0, 1), b2 + hstep, voffB);
            PG8_WAIT_V(6); PG8_BAR; PG8_MMA(1, 1, At, B1); PG8_BAR;
            PG8_LDB(B0, 1, 0); PG8_SCHED; PG8_LDA(At, 1, 0); PG8_STAGE(PG8_SA(0, 1), a2 + hstep, voffA);
            PG8_WAIT_L(8); PG8_BAR; PG8_WAIT_L(0); PG8_MMA(0, 0, At, B0); PG8_BAR; PG8_SCHED;
            PG8_LDB(B1, 1, 1); PG8_STAGE(PG8_SB(1, 0), b3, voffB);
            PG8_BAR; PG8_WAIT_L(0); PG8_MMA(0, 1, At, B1); PG8_BAR;
            PG8_LDA(At, 1, 1); PG8_STAGE(PG8_SA(1, 0), a3, voffA);
            PG8_BAR; PG8_WAIT_L(0); PG8_MMA(1, 0, At, B0); PG8_BAR; PG8_SCHED;
            PG8_STAGE(PG8_SB(1, 1), b3 + hstep, voffB);
            PG8_WAIT_V(6); PG8_BAR; PG8_MMA(1, 1, At, B1); PG8_BAR;
            }
        }
        if constexpr (ALIGN_EPI) { if (wr == 0) PG8_BAR; }
        if constexpr (!Epi::AFTER_DRAIN) { if (!Sched::TWICE || (ui & 1)) { E(acc, cur, wr, wc, fr, fq); S.done(cur); } }
        if (!has_next) break;
#pragma unroll
        for (int a = 0; a < 2; ++a)
#pragma unroll
            for (int b = 0; b < 2; ++b)
#pragma unroll
                for (int m = 0; m < 4; ++m)
#pragma unroll
                    for (int n = 0; n < 2; ++n) acc[a][b][m][n] = (f32x4){0.f, 0.f, 0.f, 0.f};
        cur = nxt; cA = nA; cB = nB; ++ui;
        if constexpr (ALIGN_EPI) { if (wr == 1) PG8_BAR; }
    }
    PG8_WAIT_V(0);
    if constexpr (!ALIGN_EPI) { if (wr == 0) PG8_BAR; }
    PG8_BAR;
    if constexpr (Epi::AFTER_DRAIN) { E.fused(acc, cur, wr, wc, fr, fq, lds, wid, lane); S.done(cur); }
#undef PG8_SA
#undef PG8_SB
#undef PG8_STAGE
#undef PG8_LDA
#undef PG8_LDB
#undef PG8_MMA
#undef PG8_WAIT_V
#undef PG8_WAIT_L
#undef PG8_BAR
#undef PG8_SCHED
}
}

constexpr int NWAVES = 8, NTHREADS = NWAVES * 64;
constexpr int BATCH = 8, SEQ = 4096, D = 1024, M = BATCH * SEQ, FF = 2816, DEPTH = 4;
constexpr int EVEN_IN = 3584, GLA_IN = 3088, GLA_INP = 3328;
static_assert(M == pg8::MROWS, "row count");
constexpr int E_RQ = 0, E_RK = 512, E_RV = 1024, E_RG = 1536, E_DQ = 2048, E_DK = 2560, E_DV = 3072;
constexpr int G_Q = 0, G_K = 512, G_V = 1024, G_R = 2048, G_A = 3072;
constexpr float EPS = 1e-6f;

constexpr size_t MiB = 1u << 20;
constexpr size_t WS_CTL = 0, CTL_ZERO_BYTES = 1 * MiB;
constexpr size_t WS_SSP = 1 * MiB;
constexpr size_t WS_TAB = 3 * MiB;
constexpr size_t TAB_RC = WS_TAB, TAB_RS = WS_TAB + 1 * MiB, TAB_DC = WS_TAB + 2 * MiB, TAB_DS = WS_TAB + 2 * MiB + 128 * 1024;
constexpr size_t WS_W = 8 * MiB;
constexpr size_t W_GU0 = WS_W, W_D0 = W_GU0 + (size_t)2 * FF * D * 2, W_GU1 = W_D0 + (size_t)D * FF * 2, W_D1 = W_GU1 + (size_t)2 * FF * D * 2,
                 W_IN = W_D1 + (size_t)D * FF * 2, W_OUT = W_IN + (size_t)EVEN_IN * D * 2, W_END = W_OUT + (size_t)D * D * 2;
constexpr size_t WS_XB = 56 * MiB;
constexpr size_t WS_ACT = 120 * MiB;
constexpr size_t WS_CAT = 344 * MiB;
constexpr size_t WS_END = 408 * MiB;
static_assert(W_END <= WS_XB && WS_XB + (size_t)M * D * 2 <= WS_ACT && WS_ACT + (size_t)M * EVEN_IN * 2 <= WS_CAT && WS_CAT + (size_t)M * D * 2 <= WS_END, "d_ws map");
constexpr int CW_BAR = 4096;

constexpr int RING_OFF = 0, RING_BYTES = 131072;
constexpr int LDSCTL_OFF = 161792, MISC_OFF = LDSCTL_OFF + 320, PTR_OFF = LDSCTL_OFF + 1024;
constexpr int LDS_BYTES = 163840;
static_assert(PTR_OFF + 19 * 8 <= LDS_BYTES && RING_BYTES <= LDSCTL_OFF, "LDS map");

#define GAS __attribute__((address_space(1)))
#define LAS __attribute__((address_space(3)))
typedef unsigned short bf16;
typedef unsigned v4u __attribute__((ext_vector_type(4)));
typedef float f32x4 __attribute__((ext_vector_type(4)));
typedef short bf16x8 __attribute__((ext_vector_type(8)));
typedef GAS unsigned gu32;
typedef GAS unsigned long long gu64;
#define RLX_AGENT __ATOMIC_RELAXED, __HIP_MEMORY_SCOPE_AGENT
#define LDS_WAIT() asm volatile("s_waitcnt lgkmcnt(0)" ::: "memory")
#define VM_WAIT() asm volatile("s_waitcnt vmcnt(0)" ::: "memory")
__device__ __forceinline__ unsigned long long rt() { return __builtin_amdgcn_s_memrealtime(); }
__device__ __forceinline__ unsigned f2bf(float f) { unsigned u = __builtin_bit_cast(unsigned, f); return (u + 0x7fffu + ((u >> 16) & 1u)) >> 16; }
__device__ __forceinline__ unsigned pk2(float lo, float hi) { return f2bf(lo) | (f2bf(hi) << 16); }

#define XB_TMO      128
#define XB_XCNT(j)  (256  + 64 * (j))
#define XB_XSUB(j)  (1280 + 64 * (j))
#define XB_XGEN(j)  (2304 + 64 * (j))
#define XB_TOP      3328
#define XB_TOPGEN   3392
#define XCD_BAR_WORDS 3456
#define XB_SPIN_CAP (1u << 18)

__device__ __forceinline__ unsigned xb_ld(unsigned* p)              { return __hip_atomic_load(p, __ATOMIC_RELAXED, __HIP_MEMORY_SCOPE_AGENT); }
__device__ __forceinline__ unsigned xb_add(unsigned* p, unsigned v) { return __hip_atomic_fetch_add(p, v, __ATOMIC_RELAXED, __HIP_MEMORY_SCOPE_AGENT); }
__device__ __forceinline__ unsigned xb_xcc_id() { return (unsigned)__builtin_amdgcn_s_getreg((3 << 11) | 20) & 0xFu; }
#define XB_SPIN(cond, bar) do { unsigned _sp = 0; while (cond) { __builtin_amdgcn_s_sleep(1); \
    if ((++_sp & 255u) == 0u) { if (xb_ld(&(bar)[XB_TMO])) break; if (_sp > XB_SPIN_CAP) { atomicAdd(&(bar)[XB_TMO], 1u); break; } } } } while (0)

struct XcdBarrier {
    unsigned* bar; unsigned x;
    volatile LAS unsigned* st;
};

__device__ __forceinline__ XcdBarrier xcd_barrier_post(unsigned* bar, volatile LAS unsigned* st, int tid) {
    XcdBarrier b; b.bar = bar; b.x = xb_xcc_id(); b.st = st;
    if (tid == 0) (void)xb_add(&bar[XB_XCNT(b.x)], 1u);
    return b;
}
__device__ __forceinline__ void xcd_barrier_complete(unsigned* bar, unsigned x, unsigned& nloc, unsigned& nx) {
    const unsigned G = gridDim.x * gridDim.y * gridDim.z;
    unsigned sum, cnt, mine, sp = 0u;
    for (;;) {
        sum = 0u; cnt = 0u; mine = 0u;
#pragma unroll
        for (unsigned j = 0; j < 16; ++j) { const unsigned c = xb_ld(&bar[XB_XCNT(j)]); sum += c; cnt += (c > 0u) ? 1u : 0u; mine = (j == x) ? c : mine; }
        if (sum == G) break;
        __builtin_amdgcn_s_sleep(1);
        if ((++sp & 255u) == 0u) { if (xb_ld(&bar[XB_TMO])) break; if (sp > XB_SPIN_CAP) { atomicAdd(&bar[XB_TMO], 1u); break; } }
    }
    nloc = mine > 0u ? mine : 1u; nx = cnt > 0u ? cnt : 1u;
}

__device__ __forceinline__ void xcd_barrier(const XcdBarrier& b, int tid) {
    asm volatile("s_waitcnt vmcnt(0)" ::: "memory");
    __syncthreads();
    if (tid == 0) {
        unsigned* bar = b.bar;
        __builtin_amdgcn_s_waitcnt(0);
        unsigned nloc = b.st[0], nx = b.st[1];
        if (nloc == 0u) { xcd_barrier_complete(bar, b.x, nloc, nx); b.st[0] = nloc; b.st[1] = nx; }
        const unsigned old = xb_add(&bar[XB_XSUB(b.x)], 1u);
        const unsigned gen = old / nloc;
        if (old + 1u == (gen + 1u) * nloc) {
            __builtin_amdgcn_fence(__ATOMIC_RELEASE, "agent");
            asm volatile("s_waitcnt vmcnt(0)" ::: "memory");
            const unsigned og = xb_add(&bar[XB_TOP], 1u);
            const unsigned tg = og / nx;
            if (og + 1u == (tg + 1u) * nx) xb_add(&bar[XB_TOPGEN], 1u);
            else XB_SPIN(xb_ld(&bar[XB_TOPGEN]) == tg, bar);
            __builtin_amdgcn_fence(__ATOMIC_ACQUIRE, "agent");
            xb_add(&bar[XB_XGEN(b.x)], 1u);
            asm volatile("s_waitcnt vmcnt(0)" ::: "memory");
        } else {
            XB_SPIN(xb_ld(&bar[XB_XGEN(b.x)]) == gen, bar);
            __builtin_amdgcn_fence(__ATOMIC_ACQUIRE, "agent");
            asm volatile("s_waitcnt vmcnt(0)" ::: "memory");
        }
    }
    __syncthreads();
}

__constant__ float RET_FREQ[64] = {1.000000000e+00f, 8.639884591e-01f, 7.464760542e-01f, 6.449466944e-01f, 5.572264791e-01f, 4.814372361e-01f, 4.159561992e-01f, 3.593813777e-01f, 3.105013371e-01f, 2.682695687e-01f, 2.317818105e-01f, 2.002568096e-01f, 1.730195731e-01f, 1.494869143e-01f, 1.291549653e-01f, 1.115883961e-01f, 9.641107172e-02f, 8.329805732e-02f, 7.196855545e-02f, 6.218000501e-02f, 5.372280627e-02f, 4.641588405e-02f, 4.010278732e-02f, 3.464834765e-02f, 2.993577160e-02f, 2.586415969e-02f, 2.234633639e-02f, 1.930697635e-02f, 1.668100432e-02f, 1.441219542e-02f, 1.245197095e-02f, 1.075835899e-02f, 9.295095690e-03f, 8.030855097e-03f, 6.938565988e-03f, 5.994840991e-03f, 5.179473665e-03f, 4.475005437e-03f, 3.866352839e-03f, 3.340484342e-03f, 2.886139788e-03f, 2.493591513e-03f, 2.154434333e-03f, 1.861406374e-03f, 1.608233666e-03f, 1.389495330e-03f, 1.200507861e-03f, 1.037224894e-03f, 8.961503627e-04f, 7.742635789e-04f, 6.689548027e-04f, 5.779692437e-04f, 4.993587499e-04f, 4.314401885e-04f, 3.727593285e-04f, 3.220597573e-04f, 2.782559313e-04f, 2.404099068e-04f, 2.077113895e-04f, 1.794602431e-04f, 1.550515735e-04f, 1.339627634e-04f, 1.157422885e-04f, 9.999999747e-05f};
__constant__ float ROPE_FREQ[8] = {1.000000000e+00f, 1.939227432e-01f, 3.760603070e-02f, 7.292664610e-03f, 1.414213562e-03f, 2.742481884e-04f, 5.318295734e-05f, 1.031338525e-05f};
struct Args { const float* in[17]; float* out; unsigned char* ws; };
enum { I_X = 0, I_PRE_NORM = 1, I_PRE_WG = 2, I_PRE_WU = 3, I_PRE_WD = 4, I_MIX_NORM = 5, I_AB_IN = 6, I_AB_OUT = 7, I_GLA_IN = 8, I_GLA_A2 = 9, I_GLA_BA = 10, I_GLA_OUT = 11,
       I_POST_NORM = 12, I_POST_WG = 13, I_POST_WU = 14, I_POST_WD = 15, I_FINAL = 16, I_OUT = 17, I_WS = 18, N_PTRS = 19 };
struct Frame {
    LAS unsigned char* lds;
    int tid, lane, wave, G, bid;
};
__device__ __forceinline__ unsigned char* tabp(const Frame& F, int idx) {
    int off_ = PTR_OFF + 8 * idx; asm volatile("" : "+s"(off_));
    const volatile LAS unsigned* T = (const volatile LAS unsigned*)(F.lds + off_);
    const unsigned lo = __builtin_amdgcn_readfirstlane(T[0]), hi = __builtin_amdgcn_readfirstlane(T[1]);
    GAS unsigned char* gp_ = (GAS unsigned char*)(((unsigned long long)hi << 32) | (unsigned long long)lo);
    return (unsigned char*)gp_;
}
#define AP(idx) ((const float*)tabp(F, idx))
#define WSP() tabp(F, I_WS)
#define OUTP() ((float*)tabp(F, I_OUT))
__device__ __forceinline__ int lnd(int v) { asm volatile("" : "+s"(v)); return v; }
__device__ __forceinline__ int hw_lane() { return (int)__builtin_amdgcn_mbcnt_hi(~0u, __builtin_amdgcn_mbcnt_lo(~0u, 0u)); }
__device__ __forceinline__ Frame relaunder(const Frame& F0) { Frame F = F0; int t_ = threadIdx.x; asm volatile("" : "+v"(t_)); asm volatile("" : "+s"(F.bid)); F.tid = t_; F.lane = F.tid & 63; F.wave = __builtin_amdgcn_readfirstlane(F.tid >> 6);
    unsigned lb_ = 0u; asm volatile("" : "+s"(lb_)); F.lds = F0.lds + lb_; return F; }
__device__ __forceinline__ float wave_sum(float v) {
    v += xsw<1>(v); v += xsw<2>(v); v += xsw<4>(v); v += xsw<8>(v); v += xsw<16>(v);
    return sum32(v);
}
__device__ __forceinline__ float bf2f(bf16 h) { return __builtin_bit_cast(float, (unsigned)h << 16); }
__device__ __forceinline__ float bflo(unsigned w) { return __builtin_bit_cast(float, w << 16); }
__device__ __forceinline__ float bfhi(unsigned w) { return __builtin_bit_cast(float, w & 0xffff0000u); }
__device__ __forceinline__ bf16 f2bf_rne(float f) { return (bf16)f2bf(f); }

__device__ __forceinline__ void tr_item(const float* W, int K, int N, int Npad, const float* gain, bf16* WT, int gu, LAS float* scr, int item, int lane) {
    const int nblk = Npad / 32, kb = item / nblk, nb = item % nblk, k0 = 64 * kb, n0 = 32 * nb;
    {
        const int c4 = lane & 7; const bool ok = n0 + 4 * c4 < N;
        const GAS float* src = (const GAS float*)W + (size_t)(k0 + (lane >> 3)) * N + n0 + 4 * c4;
        f32x4 v[8];
#pragma unroll
        for (int i = 0; i < 8; ++i) v[i] = ok ? *(const GAS f32x4*)(src + (size_t)(8 * i) * N) : (f32x4){0.f, 0.f, 0.f, 0.f};
#pragma unroll
        for (int i = 0; i < 8; ++i) { const int kk = 8 * i + (lane >> 3); const float gn = gain ? ((const GAS float*)gain)[k0 + kk] : 1.0f; LAS float* s = scr + kk * 33 + 4 * c4;
            s[0] = v[i][0] * gn; s[1] = v[i][1] * gn; s[2] = v[i][2] * gn; s[3] = v[i][3] * gn; }
    }
    LDS_WAIT(); asm volatile("" ::: "memory");
    const int c = lane & 7;
#pragma unroll
    for (int j = 0; j < 4; ++j) { const int n = (lane >> 3) + 8 * j; const LAS float* s = scr + (8 * c) * 33 + n;
        v4u o; o.x = pk2(s[0 * 33], s[1 * 33]); o.y = pk2(s[2 * 33], s[3 * 33]); o.z = pk2(s[4 * 33], s[5 * 33]); o.w = pk2(s[6 * 33], s[7 * 33]);
        int drow = n0 + n;
        if (gu == 3) {
            if (drow < 1024) { const int j = drow & 127; drow = (drow & ~127) + (j < 64 ? 2 * j : 2 * (j - 64) + 1); }
            else if (drow >= 2048 && drow < 3072) { const int j = drow & 63; drow = (drow & ~63) + (j < 8 ? 2 * j : (j < 16 ? 2 * (j - 8) + 1 : j)); }
        } else if (gu) drow = (drow >> 7) * 256 + (drow & 127) + (gu == 2 ? 128 : 0);
        *(GAS v4u*)(WT + (size_t)drow * K + k0 + 8 * c) = o; }
    LDS_WAIT(); asm volatile("" ::: "memory");
}
__device__ __forceinline__ void convert_weights(const Frame& F0, int l) {
    const Frame F = relaunder(F0);
    LAS float* scr = (LAS float*)(F.lds + RING_OFF + F.wave * 16384);
    const int gw = F.bid * NWAVES + F.wave, NGW = F.G * NWAVES;
    unsigned char* ws = WSP();
    constexpr int I_G = (D / 64) * (FF / 32), I_DN = (FF / 64) * (D / 32), I_O = (D / 64) * (D / 32);
    const bool odd = (l & 1) != 0; const int li = l >> 1;
    const int nin = odd ? GLA_IN : EVEN_IN, ninp = odd ? GLA_INP : EVEN_IN; const int I_IN = (D / 64) * (ninp / 32);
    const float* win = odd ? AP(I_GLA_IN) + (size_t)li * D * GLA_IN : AP(I_AB_IN) + (size_t)li * D * EVEN_IN;
    const float* wout = odd ? AP(I_GLA_OUT) + (size_t)li * D * D : AP(I_AB_OUT) + (size_t)li * D * D;
    const size_t fo = (size_t)l * D * FF;
    const int NITEMS = 6 * I_G + I_IN + I_O;
    static_assert(I_G == I_DN, "item counts");
    for (int it = gw; it < NITEMS; it += NGW) {
        int r = it;
        if (r < I_G) { tr_item(AP(I_PRE_WG) + fo, D, FF, FF, AP(I_PRE_NORM) + l * D, (bf16*)(ws + W_GU0), 1, scr, r, F.lane); continue; } r -= I_G;
        if (r < I_G) { tr_item(AP(I_PRE_WU) + fo, D, FF, FF, AP(I_PRE_NORM) + l * D, (bf16*)(ws + W_GU0), 2, scr, r, F.lane); continue; } r -= I_G;
        if (r < I_G) { tr_item(AP(I_PRE_WD) + fo, FF, D, D, nullptr, (bf16*)(ws + W_D0), 0, scr, r, F.lane); continue; } r -= I_G;
        if (r < I_G) { tr_item(AP(I_POST_WG) + fo, D, FF, FF, AP(I_POST_NORM) + l * D, (bf16*)(ws + W_GU1), 1, scr, r, F.lane); continue; } r -= I_G;
        if (r < I_G) { tr_item(AP(I_POST_WU) + fo, D, FF, FF, AP(I_POST_NORM) + l * D, (bf16*)(ws + W_GU1), 2, scr, r, F.lane); continue; } r -= I_G;
        if (r < I_G) { tr_item(AP(I_POST_WD) + fo, FF, D, D, nullptr, (bf16*)(ws + W_D1), 0, scr, r, F.lane); continue; } r -= I_G;
        if (r < I_IN) { tr_item(win, D, nin, ninp, AP(I_MIX_NORM) + l * D, (bf16*)(ws + W_IN), odd ? 0 : 3, scr, r, F.lane); continue; } r -= I_IN;
        tr_item(wout, D, D, D, nullptr, (bf16*)(ws + W_OUT), 0, scr, r, F.lane);
    }
}
__device__ __forceinline__ void prologue_rows(const Frame& F0) {
    const Frame F = relaunder(F0);
    unsigned char* ws = WSP();
    const int gw = F.bid * NWAVES + F.wave, NGW = F.G * NWAVES;
    bf16* XB = (bf16*)(ws + WS_XB); float* ssp = (float*)(ws + WS_SSP);
    for (int m = gw; m < M; m += NGW) {
        const GAS f32x4* xr = (const GAS f32x4*)(AP(I_X) + (size_t)m * D) + F.lane;
        GAS unsigned long long* o8 = (GAS unsigned long long*)(XB + (size_t)m * D) + F.lane;
        float s = 0.f;
#pragma unroll
        for (int j = 0; j < 4; ++j) { const f32x4 v = xr[64 * j]; s += (v.x * v.x + v.y * v.y) + (v.z * v.z + v.w * v.w);
            o8[64 * j] = (unsigned long long)pk2(v.x, v.y) | ((unsigned long long)pk2(v.z, v.w) << 32); }
        s = wave_sum(s);
        if (F.lane < 16) ssp[(size_t)m * 16 + F.lane] = (F.lane == 0) ? s : 0.f;
    }
    const int gt = F.bid * NTHREADS + F.tid, NGT = F.G * NTHREADS;
    float* rc = (float*)(ws + TAB_RC); float* rsn = (float*)(ws + TAB_RS); float* dc = (float*)(ws + TAB_DC); float* ds = (float*)(ws + TAB_DS);
    for (int e = gt; e < SEQ * 64; e += NGT) { const int t = e >> 6, i = e & 63; const float ang = (float)t * RET_FREQ[i];
        double rev = (double)ang * 0.15915494309189535; rev -= __builtin_rint(rev); const float r = (float)rev;
        rc[e] = __builtin_amdgcn_cosf(r); rsn[e] = __builtin_amdgcn_sinf(r); }
    for (int e = gt; e < SEQ * 8; e += NGT) { const int t = e >> 3, i = e & 7; const float ang = (float)t * ROPE_FREQ[i];
        double rev = (double)ang * 0.15915494309189535; rev -= __builtin_rint(rev); const float r = (float)rev;
        dc[e] = __builtin_amdgcn_cosf(r); ds[e] = __builtin_amdgcn_sinf(r); }
}

__device__ __forceinline__ void even_prep(const Frame& F0) {
    const Frame F = relaunder(F0);
    unsigned char* ws = WSP();
    const int gw = F.bid * NWAVES + F.wave, NGW = F.G * NWAVES;
    bf16* P = (bf16*)(ws + WS_ACT);
    const float* rc = (const float*)(ws + TAB_RC); const float* rsn = (const float*)(ws + TAB_RS); const float* dc = (const float*)(ws + TAB_DC); const float* ds = (const float*)(ws + TAB_DS);
    for (int m = gw; m < M; m += NGW) {
        const int pos = m & (SEQ - 1); bf16* row = P + (size_t)m * EVEN_IN;
        const float c = rc[pos * 64 + F.lane], s = rsn[pos * 64 + F.lane];
#pragma unroll
        for (int h = 0; h < 4; ++h) {
            { bf16* p1 = row + E_RQ + h * 128 + F.lane; bf16* p2 = p1 + 64; const float x1 = bf2f(*p1), x2 = bf2f(*p2); *p1 = f2bf_rne(x1 * c - x2 * s); *p2 = f2bf_rne(x2 * c + x1 * s); }
            { bf16* p1 = row + E_RK + h * 128 + F.lane; bf16* p2 = p1 + 64; const float x1 = bf2f(*p1), x2 = bf2f(*p2);
              *p1 = f2bf_rne((x1 * c - x2 * s) * 0.08838834764831845f); *p2 = f2bf_rne((x2 * c + x1 * s) * 0.08838834764831845f); }
        }
        { const int h = F.lane >> 3, i = F.lane & 7; const float c2 = dc[pos * 8 + i], s2 = ds[pos * 8 + i];
          { bf16* p1 = row + E_DQ + h * 64 + i; bf16* p2 = p1 + 8; const float x1 = bf2f(*p1), x2 = bf2f(*p2); *p1 = f2bf_rne(x1 * c2 - x2 * s2); *p2 = f2bf_rne(x2 * c2 + x1 * s2); }
          { bf16* p1 = row + E_DK + h * 64 + i; bf16* p2 = p1 + 8; const float x1 = bf2f(*p1), x2 = bf2f(*p2); *p1 = f2bf_rne(x1 * c2 - x2 * s2); *p2 = f2bf_rne(x2 * c2 + x1 * s2); } }
    }
}
__device__ __forceinline__ void even_core(const Frame& F0) {
    const Frame F = relaunder(F0);
    unsigned char* ws = WSP();
    const bf16* P = (const bf16*)(ws + WS_ACT);
    if (F.bid < 128) {
        const int b = F.bid >> 4, h = (F.bid >> 2) & 3, eg = F.bid & 3, e = eg * 32 + (F.tid >> 4), dq = F.tid & 15;
        const float g = 1.0f - exp2f(-5.0f - (float)h);
        float* oraw = (float*)(ws + WS_XB);
        const bf16* base = P + (size_t)b * SEQ * EVEN_IN;
        float S[8];
#pragma unroll
        for (int i = 0; i < 8; ++i) S[i] = 0.f;
        v4u qn = *(const GAS v4u*)(base + E_RQ + h * 128 + dq * 8), kn = *(const GAS v4u*)(base + E_RK + h * 128 + dq * 8); bf16 vn = base[E_RV + h * 128 + e];
        for (int t = 0; t < SEQ; ++t) {
            const v4u q = qn, k = kn; const float v = bf2f(vn);
            if (t + 1 < SEQ) { const bf16* nb = base + (size_t)(t + 1) * EVEN_IN; qn = *(const GAS v4u*)(nb + E_RQ + h * 128 + dq * 8); kn = *(const GAS v4u*)(nb + E_RK + h * 128 + dq * 8); vn = nb[E_RV + h * 128 + e]; }
            float o = 0.f;
#pragma unroll
            for (int i = 0; i < 4; ++i) { const unsigned qw = q[i], kw = k[i];
                S[2 * i] = g * S[2 * i] + bflo(kw) * v; S[2 * i + 1] = g * S[2 * i + 1] + bfhi(kw) * v;
                o += bflo(qw) * S[2 * i]; o += bfhi(qw) * S[2 * i + 1]; }
            o += xsw<1>(o); o += xsw<2>(o); o += xsw<4>(o); o += xsw<8>(o);
            if (dq == 0) oraw[((size_t)b * SEQ + t) * 512 + h * 128 + e] = o;
        }
    } else {
        bf16* CAT = (bf16*)(ws + WS_CAT);
        for (int it = F.bid - 128; it < BATCH * (SEQ / 64); it += F.G - 128) {
            const int b = it >> 6, t = (it & 63) * 64 + F.lane, h = F.wave;
            const bf16* base = P + (size_t)b * SEQ * EVEN_IN;
            float q[64];
            { const GAS v4u* qp = (const GAS v4u*)(base + (size_t)t * EVEN_IN + E_DQ + h * 64);
#pragma unroll
              for (int j = 0; j < 8; ++j) { const v4u w = qp[j];
#pragma unroll
                  for (int i = 0; i < 4; ++i) { q[8 * j + 2 * i] = bflo(w[i]) * (0.125f * 1.4426950408889634f); q[8 * j + 2 * i + 1] = bfhi(w[i]) * (0.125f * 1.4426950408889634f); } } }
            float o[64];
#pragma unroll
            for (int i = 0; i < 64; ++i) o[i] = 0.f;
            float mx = -INFINITY, l = 0.f;
            for (int p = 0; p < 3; ++p) {
                const int dil = (p == 0) ? 1 : (p == 1) ? 4 : 16;
                for (int j = 0; j <= 128; ++j) {
                    const int tk = t - j * dil;
                    if (tk >= 0) {
                        const GAS v4u* kp = (const GAS v4u*)(base + (size_t)tk * EVEN_IN + E_DK + h * 64);
                        const GAS v4u* vp = (const GAS v4u*)(base + (size_t)tk * EVEN_IN + E_DV + h * 64);
                        float s = 0.f;
#pragma unroll
                        for (int jj = 0; jj < 8; ++jj) { const v4u w = kp[jj];
#pragma unroll
                            for (int i = 0; i < 4; ++i) { s += q[8 * jj + 2 * i] * bflo(w[i]); s += q[8 * jj + 2 * i + 1] * bfhi(w[i]); } }
                        const float mn = fmaxf(mx, s), corr = __builtin_amdgcn_exp2f(mx - mn), pe = __builtin_amdgcn_exp2f(s - mn);
                        l = l * corr + pe; mx = mn;
#pragma unroll
                        for (int jj = 0; jj < 8; ++jj) { const v4u w = vp[jj];
#pragma unroll
                            for (int i = 0; i < 4; ++i) { o[8 * jj + 2 * i] = o[8 * jj + 2 * i] * corr + pe * bflo(w[i]); o[8 * jj + 2 * i + 1] = o[8 * jj + 2 * i + 1] * corr + pe * bfhi(w[i]); } }
                    }
                }
            }
            const float rl = 1.0f / l;
            GAS v4u* op = (GAS v4u*)(CAT + ((size_t)b * SEQ + t) * D + 512 + h * 64);
#pragma unroll
            for (int j = 0; j < 8; ++j) { v4u w; w.x = pk2(o[8 * j] * rl, o[8 * j + 1] * rl); w.y = pk2(o[8 * j + 2] * rl, o[8 * j + 3] * rl); w.z = pk2(o[8 * j + 4] * rl, o[8 * j + 5] * rl); w.w = pk2(o[8 * j + 6] * rl, o[8 * j + 7] * rl); op[j] = w; }
        }
    }
}
__device__ __forceinline__ void even_post(const Frame& F0) {
    const Frame F = relaunder(F0);
    unsigned char* ws = WSP();
    const int gw = F.bid * NWAVES + F.wave, NGW = F.G * NWAVES;
    const bf16* P = (const bf16*)(ws + WS_ACT); const float* oraw = (const float*)(ws + WS_XB); bf16* CAT = (bf16*)(ws + WS_CAT);
    for (int it = gw; it < M * 4; it += NGW) {
        const int m = it >> 2, h = it & 3;
        const float* op = oraw + (size_t)m * 512 + h * 128 + 2 * F.lane; const float o0 = op[0], o1 = op[1];
        const float mu = wave_sum(o0 + o1) * (1.0f / 128.0f); const float d0 = o0 - mu, d1 = o1 - mu;
        const float var = wave_sum(d0 * d0 + d1 * d1) * (1.0f / 128.0f); const float rstd = 1.0f / sqrtf(var + EPS);
        const unsigned gw2 = *(const unsigned*)(P + (size_t)m * EVEN_IN + E_RG + h * 128 + 2 * F.lane); const float g0 = bflo(gw2), g1 = bfhi(gw2);
        const float y0 = d0 * rstd * (g0 / (1.0f + expf(-g0))), y1 = d1 * rstd * (g1 / (1.0f + expf(-g1)));
        *(unsigned*)(CAT + (size_t)m * D + h * 128 + 2 * F.lane) = pk2(y0, y1);
    }
}
__device__ __forceinline__ void gla_prep(const Frame& F0, int li) {
    const Frame F = relaunder(F0);
    unsigned char* ws = WSP();
    const int gt = F.bid * NTHREADS + F.tid, NGT = F.G * NTHREADS;
    const bf16* P = (const bf16*)(ws + WS_ACT); float* A = (float*)(ws + WS_CAT);
    const float* w2 = AP(I_GLA_A2) + (size_t)li * 16 * 512; const float* ba = AP(I_GLA_BA) + (size_t)li * 512;
    for (int e = gt; e < M * 512; e += NGT) {
        const int m = e >> 9, c = e & 511; const bf16* al = P + (size_t)m * GLA_INP + G_A;
        float z = ba[c];
#pragma unroll
        for (int j = 0; j < 16; ++j) z += bf2f(al[j]) * w2[j * 512 + c];
        const float ls = fminf(z, 0.f) - log1pf(expf(-fabsf(z)));
        A[e] = expf(ls * (1.0f / 16.0f));
    }
}
__device__ __forceinline__ void gla_core(const Frame& F0) {
    const Frame F = relaunder(F0);
    unsigned char* ws = WSP();
    const bf16* P = (const bf16*)(ws + WS_ACT); const float* A = (const float*)(ws + WS_CAT); bf16* oraw = (bf16*)(ws + WS_XB);
    const int b = F.bid >> 5, h = (F.bid >> 3) & 3, eg = F.bid & 7, e = eg * 32 + (F.tid >> 4), dq = F.tid & 15;
    const bf16* base = P + (size_t)b * SEQ * GLA_INP; const float* abase = A + (size_t)b * SEQ * 512 + h * 128 + dq * 8;
    float S[8];
#pragma unroll
    for (int i = 0; i < 8; ++i) S[i] = 0.f;
    v4u qn = *(const GAS v4u*)(base + G_Q + h * 128 + dq * 8), kn = *(const GAS v4u*)(base + G_K + h * 128 + dq * 8); bf16 vn = base[G_V + h * 256 + e];
    f32x4 a0n = *(const GAS f32x4*)(abase), a1n = *(const GAS f32x4*)(abase + 4);
    for (int t = 0; t < SEQ; ++t) {
        const v4u q = qn, k = kn; const float v = bf2f(vn); const f32x4 a0 = a0n, a1 = a1n;
        if (t + 1 < SEQ) { const bf16* nb = base + (size_t)(t + 1) * GLA_INP; qn = *(const GAS v4u*)(nb + G_Q + h * 128 + dq * 8); kn = *(const GAS v4u*)(nb + G_K + h * 128 + dq * 8); vn = nb[G_V + h * 256 + e];
            a0n = *(const GAS f32x4*)(abase + (size_t)(t + 1) * 512); a1n = *(const GAS f32x4*)(abase + (size_t)(t + 1) * 512 + 4); }
        float o = 0.f;
#pragma unroll
        for (int i = 0; i < 4; ++i) { const unsigned qw = q[i], kw = k[i]; const float al = (i < 2) ? a0[2 * i] : a1[2 * i - 4], ah = (i < 2) ? a0[2 * i + 1] : a1[2 * i - 3];
            S[2 * i] = al * S[2 * i] + bflo(kw) * v; S[2 * i + 1] = ah * S[2 * i + 1] + bfhi(kw) * v;
            o += bflo(qw) * S[2 * i]; o += bfhi(qw) * S[2 * i + 1]; }
        o += xsw<1>(o); o += xsw<2>(o); o += xsw<4>(o); o += xsw<8>(o);
        if (dq == 0) oraw[((size_t)b * SEQ + t) * 1024 + h * 256 + e] = f2bf_rne(o * 0.08838834764831845f);
    }
}
__device__ __forceinline__ void gla_post(const Frame& F0) {
    const Frame F = relaunder(F0);
    unsigned char* ws = WSP();
    const int gw = F.bid * NWAVES + F.wave, NGW = F.G * NWAVES;
    const bf16* P = (const bf16*)(ws + WS_ACT); const bf16* oraw = (const bf16*)(ws + WS_XB); bf16* CAT = (bf16*)(ws + WS_CAT);
    for (int it = gw; it < M * 4; it += NGW) {
        const int m = it >> 2, h = it & 3;
        const unsigned long long ow = *(const unsigned long long*)(oraw + (size_t)m * 1024 + h * 256 + 4 * F.lane);
        const float o0 = bflo((unsigned)ow), o1 = bfhi((unsigned)ow), o2 = bflo((unsigned)(ow >> 32)), o3 = bfhi((unsigned)(ow >> 32));
        const float mu = wave_sum((o0 + o1) + (o2 + o3)) * (1.0f / 256.0f); const float d0 = o0 - mu, d1 = o1 - mu, d2 = o2 - mu, d3 = o3 - mu;
        const float var = wave_sum((d0 * d0 + d1 * d1) + (d2 * d2 + d3 * d3)) * (1.0f / 256.0f); const float rstd = 1.0f / sqrtf(var + EPS);
        const unsigned long long gw2 = *(const unsigned long long*)(P + (size_t)m * GLA_INP + G_R + h * 256 + 4 * F.lane);
        const float g0 = bflo((unsigned)gw2), g1 = bfhi((unsigned)gw2), g2 = bflo((unsigned)(gw2 >> 32)), g3 = bfhi((unsigned)(gw2 >> 32));
        const float y0 = d0 * rstd * (g0 / (1.0f + expf(-g0))), y1 = d1 * rstd * (g1 / (1.0f + expf(-g1))), y2 = d2 * rstd * (g2 / (1.0f + expf(-g2))), y3 = d3 * rstd * (g3 / (1.0f + expf(-g3)));
        *(unsigned long long*)(CAT + (size_t)m * D + h * 256 + 4 * F.lane) = (unsigned long long)pk2(y0, y1) | ((unsigned long long)pk2(y2, y3) << 32);
    }
}
__device__ __forceinline__ void final_norm(const Frame& F0) {
    const Frame F = relaunder(F0);
    const int gw = F.bid * NWAVES + F.wave, NGW = F.G * NWAVES;
    for (int m = gw; m < M; m += NGW) {
        GAS f32x4* xr = (GAS f32x4*)(OUTP() + (size_t)m * D) + F.lane; const GAS f32x4* gr = (const GAS f32x4*)AP(I_FINAL) + F.lane;
        f32x4 v[4]; float s = 0.f;
#pragma unroll
        for (int j = 0; j < 4; ++j) { v[j] = xr[64 * j]; s += (v[j].x * v[j].x + v[j].y * v[j].y) + (v[j].z * v[j].z + v[j].w * v[j].w); }
        const float rstd = 1.0f / sqrtf(wave_sum(s) * (1.0f / D) + EPS);
#pragma unroll
        for (int j = 0; j < 4; ++j) xr[64 * j] = v[j] * rstd * gr[64 * j];
    }
}


__device__ __forceinline__ float silu_f(float g) { return g * __builtin_amdgcn_rcpf(1.0f + __builtin_amdgcn_exp2f(-1.4426950408889634f * g)); }
typedef float f32x16 __attribute__((ext_vector_type(16)));
typedef short s16x4 __attribute__((ext_vector_type(4)));
typedef float f32x2_t __attribute__((ext_vector_type(2)));
typedef __bf16 bf16x2_t __attribute__((ext_vector_type(2)));
#define MFMA32(a, b, c) __builtin_amdgcn_mfma_f32_32x32x16_bf16((a), (b), (c), 0, 0, 0)
__device__ __forceinline__ int crow(int reg, int h) { return (reg & 3) + 8 * (reg >> 2) + 4 * h; }
__device__ __forceinline__ unsigned cvtpk(float lo, float hi) { f32x2_t v = {lo, hi}; bf16x2_t b = __builtin_convertvector(v, bf16x2_t); return __builtin_bit_cast(unsigned, b); }
__device__ __forceinline__ bf16 cvt1(float v) { return (bf16)(cvtpk(v, 0.f) & 0xffffu); }
#define PACK_STEP(x, s) __builtin_bit_cast(bf16x8, (v4u){cvtpk((x)[8 * (s)], (x)[8 * (s) + 1]), cvtpk((x)[8 * (s) + 2], (x)[8 * (s) + 3]), cvtpk((x)[8 * (s) + 4], (x)[8 * (s) + 5]), cvtpk((x)[8 * (s) + 6], (x)[8 * (s) + 7])})
typedef const LAS unsigned char* lcp;
__device__ __forceinline__ int lndv(int v) { asm volatile("" : "+v"(v)); return v; }
__device__ __forceinline__ bf16x8 ld_row(lcp img, int P, int row0, int k0, int r, int h) { return *(const LAS bf16x8*)(img + (row0 + r) * P + (k0 + 8 * h) * 2); }
__device__ __forceinline__ bf16x8 ld_row_perm(lcp img, int P, int row0, int k0, int r, int h) {
    const s16x4 lo = *(const LAS s16x4*)(img + (row0 + r) * P + (k0 + 4 * h) * 2), hi = *(const LAS s16x4*)(img + (row0 + r) * P + (k0 + 8 + 4 * h) * 2);
    return __builtin_shufflevector(lo, hi, 0, 1, 2, 3, 4, 5, 6, 7); }
__device__ __forceinline__ s16x4 trd(lcp p) { return __builtin_bit_cast(s16x4, __builtin_amdgcn_ds_read_tr16_b64_v4i16((LAS s16x4*)p)); }
__device__ __forceinline__ bf16x8 ld_tr(lcp img, int P, int k0, int c0, int lane) {
    const int i16 = lane & 15, q = i16 >> 2, p = i16 & 3, blk = (lane >> 4) & 1, h = lane >> 5;
    lcp a = img + (k0 + 8 * h + q) * P + (c0 + 16 * blk + 4 * p) * 2;
    const s16x4 lo = trd(a), hi = trd(a + 4 * P);
    return __builtin_shufflevector(lo, hi, 0, 1, 2, 3, 4, 5, 6, 7); }
__device__ __forceinline__ bf16x8 ld_tr_perm(lcp img, int P, int k0, int c0, int lane) {
    const int i16 = lane & 15, q = i16 >> 2, p = i16 & 3, blk = (lane >> 4) & 1, h = lane >> 5;
    lcp a = img + (k0 + 4 * h + q) * P + (c0 + 16 * blk + 4 * p) * 2;
    const s16x4 lo = trd(a), hi = trd(a + 8 * P);
    return __builtin_shufflevector(lo, hi, 0, 1, 2, 3, 4, 5, 6, 7); }
template <int R, int C> __device__ __forceinline__ void tile_ld(v4u (&v)[R * C / 8 / NTHREADS], const bf16* g, size_t gp, int tid) {
    constexpr int CPR = C / 8, RS = NTHREADS / CPR;
    static_assert(NTHREADS % CPR == 0, "tile shape");
    const unsigned voff = (unsigned)((tid / CPR) * (int)gp + (tid % CPR) * 8) * 2u;
    const GAS unsigned char* gb = (const GAS unsigned char*)g;
#pragma unroll
    for (int i = 0; i < R * C / 8 / NTHREADS; ++i) v[i] = *(const GAS v4u*)(gb + (size_t)i * RS * gp * 2 + voff);
}
template <int R, int C> __device__ __forceinline__ void tile_st(const v4u (&v)[R * C / 8 / NTHREADS], LAS unsigned char* img, int P, int tid) {
    constexpr int CPR = C / 8, RS = NTHREADS / CPR;
    LAS unsigned char* lb = img + (tid / CPR) * P + (tid % CPR) * 16;
#pragma unroll
    for (int i = 0; i < R * C / 8 / NTHREADS; ++i) *(LAS v4u*)(lb + i * RS * P) = v[i];
}
template <int R, int C> __device__ __forceinline__ void stage_tile(LAS unsigned char* img, int P, const bf16* g, size_t gp, int tid) { v4u t_[R * C / 8 / NTHREADS]; tile_ld<R, C>(t_, g, gp, tid); tile_st<R, C>(t_, img, P, tid); }
#define WG_BAR() do { asm volatile("s_waitcnt lgkmcnt(0)" ::: "memory"); __builtin_amdgcn_s_barrier(); asm volatile("" ::: "memory"); } while (0)

constexpr int PR = 272, PT = 320, PT256 = 576, PO256 = 528;
constexpr size_t WS_DEC = 6 * MiB;
constexpr float LOG2E = 1.4426950408889634f, LN2 = 0.6931471805599453f;
__device__ __forceinline__ void gla_cumsum(float (&Bc)[2][16], float& Blast, lcp AL, lcp W2, const LAS float* BA, LAS float* EX, int wave, int lane) {
    const int r = lane & 31, h = lane >> 5, db = wave & 3, jh = wave >> 2;
    const bf16x8 wf = *(const LAS bf16x8*)(W2 + (db * 32 + r) * 32 + h * 16);
    const float bias = BA[db * 32 + r];
    float run = 0.f;
#pragma unroll
    for (int t = 0; t < 2; ++t) {
        const bf16x8 af = *(const LAS bf16x8*)(AL + ((jh * 2 + t) * 32 + r) * 32 + h * 16);
        f32x16 z = {0.f, 0.f, 0.f, 0.f, 0.f, 0.f, 0.f, 0.f, 0.f, 0.f, 0.f, 0.f, 0.f, 0.f, 0.f, 0.f};
        z = MFMA32(af, wf, z);
        float own[4], oth[4];
#pragma unroll
        for (int g = 0; g < 4; ++g) {
            float acc = 0.f;
#pragma unroll
            for (int i = 0; i < 4; ++i) { const float zz = z[4 * g + i] + bias;
                const float la = (fminf(zz, 0.f) - LN2 * __builtin_amdgcn_logf(1.0f + __builtin_amdgcn_exp2f(-fabsf(zz) * LOG2E))) * (1.0f / 16.0f);
                acc += la; Bc[t][4 * g + i] = acc; }
            own[g] = acc; oth[g] = oth32(acc, h);
        }
#pragma unroll
        for (int g = 0; g < 4; ++g) { const float off = run + (h ? oth[g] : 0.f);
#pragma unroll
            for (int i = 0; i < 4; ++i) Bc[t][4 * g + i] += off;
            run += own[g] + oth[g]; }
    }
    if (h == 0) EX[jh * 128 + db * 32 + r] = run;
    WG_BAR();
    const float t0 = EX[db * 32 + r], t1 = EX[128 + db * 32 + r];
    Blast = t0 + t1;
    if (jh == 1) {
#pragma unroll
        for (int t = 0; t < 2; ++t)
#pragma unroll
            for (int i = 0; i < 16; ++i) Bc[t][i] += t0; }
}
constexpr int GA_KI = 0, GA_VI = GA_KI + 128 * PR, GA_KD = GA_VI + 128 * PT256, GA_AL = GA_KD + 128 * PT, GA_W2 = GA_AL + 4096, GA_BA = GA_W2 + 4096, GA_EX = GA_BA + 512, GA_END = GA_EX + 1024;
constexpr int GA_OI = GA_VI;
constexpr int GC_QT = 0, GC_KT = GC_QT + 128 * PR, GC_SI = GC_KT + 128 * PR, GC_VI = GC_SI + 128 * PT, GC_AL = GC_VI + 128 * PT, GC_W2 = GC_AL + 4096, GC_BA = GC_W2 + 4096, GC_EX = GC_BA + 512, GC_END = GC_EX + 1024;
constexpr int GC_OI = 0;
static_assert(GA_END <= LDSCTL_OFF && GC_END <= LDSCTL_OFF && 128 * PO256 <= GC_SI && 128 * PO256 <= 128 * PT256, "GLA LDS maps");
__device__ __forceinline__ void gla_stage_w(const Frame& F, LAS unsigned char* W2, LAS float* BA, int li, int h) {
    if (F.tid < 128) { const int d = F.tid; const GAS float* w2 = (const GAS float*)AP(I_GLA_A2) + (size_t)li * 16 * 512 + h * 128 + d;
        v4u lo, hi; lo.x = cvtpk(w2[0], w2[512]); lo.y = cvtpk(w2[2 * 512], w2[3 * 512]); lo.z = cvtpk(w2[4 * 512], w2[5 * 512]); lo.w = cvtpk(w2[6 * 512], w2[7 * 512]);
        hi.x = cvtpk(w2[8 * 512], w2[9 * 512]); hi.y = cvtpk(w2[10 * 512], w2[11 * 512]); hi.z = cvtpk(w2[12 * 512], w2[13 * 512]); hi.w = cvtpk(w2[14 * 512], w2[15 * 512]);
        *(LAS v4u*)(W2 + d * 32) = lo; *(LAS v4u*)(W2 + d * 32 + 16) = hi; }
    else if (F.tid < 256) { const int d = F.tid - 128; BA[d] = ((const GAS float*)AP(I_GLA_BA))[(size_t)li * 512 + h * 128 + d]; }
}
__device__ __forceinline__ v4u gla_ld_alow(int tid, const bf16* Prow0) { const int t = tid & 255; return *(const GAS v4u*)(Prow0 + (size_t)(t >> 1) * GLA_INP + G_A + (t & 1) * 8); }
__device__ __forceinline__ void gla_st_alow(int tid, v4u v, LAS unsigned char* AL) { if (tid < 256) *(LAS v4u*)(AL + (tid >> 1) * 32 + (tid & 1) * 16) = v; }

__device__ __forceinline__ void gla_phase_a(const Frame& F0, int li) {
    const Frame F = relaunder(F0);
    unsigned char* ws = WSP();
    const bf16* P = (const bf16*)(ws + WS_ACT); bf16* SKV = (bf16*)(ws + WS_XB); float* DEC = (float*)(ws + WS_DEC);
    LAS unsigned char* L = F.lds;
    const int wave = F.wave, db = wave & 3, jh = wave >> 2;
    v4u kR[4], vR[8], aR; int hcur = -1;
    {   const int it = F.bid; if (it < 1024) { const int bh = it >> 5, g = it & 31; const bf16* Prow0 = P + ((size_t)(bh >> 2) * SEQ + g * 128) * GLA_INP;
            tile_ld<128, 128>(kR, Prow0 + G_K + (bh & 3) * 128, GLA_INP, F.tid); tile_ld<128, 256>(vR, Prow0 + G_V + (bh & 3) * 256, GLA_INP, F.tid); aR = gla_ld_alow(F.tid, Prow0); } }
    for (int it = F.bid; it < 1024; it += F.G) {
        const int bh = it >> 5, h = bh & 3;
        const int lane = lndv(F.lane), r = lane & 31, h2 = lane >> 5;
        tile_st<128, 128>(kR, L + GA_KI, PR, F.tid); tile_st<128, 256>(vR, L + GA_VI, PT256, F.tid); gla_st_alow(F.tid, aR, L + GA_AL);
        if (h != hcur) { gla_stage_w(F, L + GA_W2, (LAS float*)(L + GA_BA), li, h); hcur = h; }
        WG_BAR();
        {   const int nx = it + F.G; if (nx < 1024) { const int bh2 = nx >> 5, g2 = nx & 31; const bf16* Pn = P + ((size_t)(bh2 >> 2) * SEQ + g2 * 128) * GLA_INP;
                tile_ld<128, 128>(kR, Pn + G_K + (bh2 & 3) * 128, GLA_INP, F.tid); tile_ld<128, 256>(vR, Pn + G_V + (bh2 & 3) * 256, GLA_INP, F.tid); aR = gla_ld_alow(F.tid, Pn); } }
        float Bc[2][16], Blast;
        gla_cumsum(Bc, Blast, L + GA_AL, L + GA_W2, (const LAS float*)(L + GA_BA), (LAS float*)(L + GA_EX), wave, lane);
#pragma unroll
        for (int t = 0; t < 2; ++t)
#pragma unroll
            for (int i = 0; i < 16; ++i) { const int row = (jh * 2 + t) * 32 + crow(i, h2), col = db * 32 + r;
                const float kv = bf2f(*(const LAS bf16*)(L + GA_KI + row * PR + col * 2)) * __builtin_amdgcn_exp2f((Blast - Bc[t][i]) * LOG2E);
                *(LAS bf16*)(L + GA_KD + row * PT + col * 2) = cvt1(kv); }
        if (jh == 0 && h2 == 0) DEC[(size_t)it * 128 + db * 32 + r] = __builtin_amdgcn_exp2f(Blast * LOG2E);
        WG_BAR();
        f32x16 acc[4];
#pragma unroll
        for (int t = 0; t < 4; ++t) acc[t] = (f32x16){0.f, 0.f, 0.f, 0.f, 0.f, 0.f, 0.f, 0.f, 0.f, 0.f, 0.f, 0.f, 0.f, 0.f, 0.f, 0.f};
#pragma unroll
        for (int ks = 0; ks < 8; ++ks) { const bf16x8 a = ld_tr(L + GA_KD, PT, 16 * ks, db * 32, lane);
#pragma unroll
            for (int t = 0; t < 4; ++t) acc[t] = MFMA32(a, ld_tr(L + GA_VI, PT256, 16 * ks, (4 * jh + t) * 32, lane), acc[t]); }
        WG_BAR();
#pragma unroll
        for (int t = 0; t < 4; ++t)
#pragma unroll
            for (int i = 0; i < 16; ++i) *(LAS bf16*)(L + GA_OI + (db * 32 + crow(i, h2)) * PO256 + ((4 * jh + t) * 32 + r) * 2) = cvt1(acc[t][i]);
        WG_BAR();
        {   bf16* out = SKV + (size_t)it * 128 * 256;
#pragma unroll
            for (int i = 0; i < 8; ++i) { const int c = F.tid + i * NTHREADS, row = c >> 5, cc = c & 31; *(GAS v4u*)(out + row * 256 + cc * 8) = *(const LAS v4u*)(L + GA_OI + row * PO256 + cc * 16); } }
        WG_BAR();
    }
}
__device__ __forceinline__ void gla_phase_b(const Frame& F0) {
    const Frame F = relaunder(F0);
    unsigned char* ws = WSP();
    bf16* SKV = (bf16*)(ws + WS_XB); const float* DEC = (const float*)(ws + WS_DEC);
    for (int gt = F.bid * NTHREADS + F.tid; gt < 32 * 128 * 32; gt += F.G * NTHREADS) {
        const int bh = gt >> 12, d = (gt >> 5) & 127, e8 = gt & 31;
        float s[8];
#pragma unroll
        for (int i = 0; i < 8; ++i) s[i] = 0.f;
        for (int g0 = 0; g0 < 32; g0 += 8) {
            v4u kv[8]; float dc[8];
#pragma unroll
            for (int u = 0; u < 8; ++u) { const size_t item = (size_t)bh * 32 + g0 + u; kv[u] = *(const GAS v4u*)(SKV + (item * 128 + d) * 256 + e8 * 8); dc[u] = ((const GAS float*)DEC)[item * 128 + d]; }
#pragma unroll
            for (int u = 0; u < 8; ++u) { const size_t item = (size_t)bh * 32 + g0 + u;
                v4u o; o.x = cvtpk(s[0], s[1]); o.y = cvtpk(s[2], s[3]); o.z = cvtpk(s[4], s[5]); o.w = cvtpk(s[6], s[7]);
                *(GAS v4u*)(SKV + (item * 128 + d) * 256 + e8 * 8) = o;
#pragma unroll
                for (int i = 0; i < 4; ++i) { s[2 * i] = dc[u] * s[2 * i] + bflo(kv[u][i]); s[2 * i + 1] = dc[u] * s[2 * i + 1] + bfhi(kv[u][i]); } }
        }
    }
}
__device__ __forceinline__ void gla_phase_c(const Frame& F0, int li) {
    const Frame F = relaunder(F0);
    unsigned char* ws = WSP();
    const bf16* P = (const bf16*)(ws + WS_ACT); const bf16* SKV = (const bf16*)(ws + WS_XB); bf16* CAT = (bf16*)(ws + WS_CAT);
    LAS unsigned char* L = F.lds;
    const int wave = F.wave, db = wave & 3, jh = wave >> 2;
    const int ib = wave & 3, eq = wave >> 2;
    v4u qR[4], kR[4], aR; int hcur = -1;
    {   const int it = F.bid; if (it < 1024) { const int bh = it >> 5, g = it & 31, h = bh & 3; const bf16* Prow0 = P + ((size_t)(bh >> 2) * SEQ + g * 128) * GLA_INP;
            tile_ld<128, 128>(qR, Prow0 + G_Q + h * 128, GLA_INP, F.tid); tile_ld<128, 128>(kR, Prow0 + G_K + h * 128, GLA_INP, F.tid); aR = gla_ld_alow(F.tid, Prow0); } }
    for (int it = F.bid; it < 1024; it += F.G) {
        const int bh = it >> 5, g = it & 31, b = bh >> 2, h = bh & 3;
        const int tidl = lndv(F.tid), lane = tidl & 63, r = lane & 31, h2 = lane >> 5;
        const bf16* Prow0 = P + ((size_t)b * SEQ + g * 128) * GLA_INP;
        const bf16* Sg = SKV + (size_t)it * 128 * 256;
        {   v4u sR[4], vR[4]; tile_ld<128, 128>(sR, Sg, 256, tidl); tile_ld<128, 128>(vR, Prow0 + G_V + h * 256, GLA_INP, tidl);
            tile_st<128, 128>(qR, L + GC_QT, PR, tidl); tile_st<128, 128>(kR, L + GC_KT, PR, tidl); tile_st<128, 128>(sR, L + GC_SI, PT, tidl); tile_st<128, 128>(vR, L + GC_VI, PT, tidl); }
        gla_st_alow(tidl, aR, L + GC_AL);
        if (h != hcur) { gla_stage_w(F, L + GC_W2, (LAS float*)(L + GC_BA), li, h); hcur = h; }
        WG_BAR();
        {
            float Bc[2][16], Blast;
            gla_cumsum(Bc, Blast, L + GC_AL, L + GC_W2, (const LAS float*)(L + GC_BA), (LAS float*)(L + GC_EX), wave, lane);
#pragma unroll
            for (int t = 0; t < 2; ++t)
#pragma unroll
                for (int i = 0; i < 16; ++i) { const int off = ((jh * 2 + t) * 32 + crow(i, h2)) * PR + (db * 32 + r) * 2;
                    const float eb = __builtin_amdgcn_exp2f(Bc[t][i] * LOG2E);
                    const float qv = bf2f(*(const LAS bf16*)(L + GC_QT + off)) * eb * 0.08838834764831845f;
                    const float kv = bf2f(*(const LAS bf16*)(L + GC_KT + off)) * __builtin_amdgcn_rcpf(eb);
                    *(LAS bf16*)(L + GC_QT + off) = cvt1(qv); *(LAS bf16*)(L + GC_KT + off) = cvt1(kv); }
        }
        WG_BAR();
        bf16x8 PA[4][2];
#pragma unroll
        for (int jb = 0; jb < 4; ++jb) {
            if (jb <= ib) {
                f32x16 x = {0.f, 0.f, 0.f, 0.f, 0.f, 0.f, 0.f, 0.f, 0.f, 0.f, 0.f, 0.f, 0.f, 0.f, 0.f, 0.f};
#pragma unroll
                for (int ks = 0; ks < 8; ++ks) x = MFMA32(ld_row(L + GC_KT, PR, jb * 32, 16 * ks, r, h2), ld_row(L + GC_QT, PR, ib * 32, 16 * ks, r, h2), x);
                if (jb == ib) {
#pragma unroll
                    for (int i = 0; i < 16; ++i) if (crow(i, h2) > r) x[i] = 0.f; }
                PA[jb][0] = PACK_STEP(x, 0); PA[jb][1] = PACK_STEP(x, 1);
            } else { PA[jb][0] = (bf16x8){0, 0, 0, 0, 0, 0, 0, 0}; PA[jb][1] = (bf16x8){0, 0, 0, 0, 0, 0, 0, 0}; }
        }
        f32x16 o[2][2];
#pragma unroll
        for (int half = 0; half < 2; ++half) {
            if (half == 1) {
                WG_BAR();
                stage_tile<128, 128>(L + GC_SI, PT, Sg + 128, 256, tidl); stage_tile<128, 128>(L + GC_VI, PT, Prow0 + G_V + h * 256 + 128, GLA_INP, tidl);
                WG_BAR();
            }
#pragma unroll
            for (int t = 0; t < 2; ++t) {
                const int eb = 2 * eq + t;
                f32x16 acc = {0.f, 0.f, 0.f, 0.f, 0.f, 0.f, 0.f, 0.f, 0.f, 0.f, 0.f, 0.f, 0.f, 0.f, 0.f, 0.f};
#pragma unroll
                for (int jb = 0; jb < 4; ++jb) if (jb <= ib) {
#pragma unroll
                    for (int s = 0; s < 2; ++s) acc = MFMA32(PA[jb][s], ld_tr_perm(L + GC_VI, PT, jb * 32 + 16 * s, eb * 32, lane), acc); }
#pragma unroll
                for (int ks = 0; ks < 8; ++ks) acc = MFMA32(ld_row(L + GC_QT, PR, ib * 32, 16 * ks, r, h2), ld_tr(L + GC_SI, PT, 16 * ks, eb * 32, lane), acc);
                o[half][t] = acc;
            }
        }
        WG_BAR();
#pragma unroll
        for (int half = 0; half < 2; ++half)
#pragma unroll
            for (int t = 0; t < 2; ++t)
#pragma unroll
                for (int i = 0; i < 16; ++i) *(LAS bf16*)(L + GC_OI + (ib * 32 + crow(i, h2)) * PO256 + (half * 128 + (2 * eq + t) * 32 + r) * 2) = cvt1(o[half][t][i]);
        WG_BAR();
        {   const int nx = (it + F.G < 1024) ? it + F.G : it;
            const int bh2 = nx >> 5, g2 = nx & 31, hn = bh2 & 3; const bf16* Pn = P + ((size_t)(bh2 >> 2) * SEQ + g2 * 128) * GLA_INP;
            tile_ld<128, 128>(qR, Pn + G_Q + hn * 128, GLA_INP, tidl); tile_ld<128, 128>(kR, Pn + G_K + hn * 128, GLA_INP, tidl); aR = gla_ld_alow(tidl, Pn); }
        {
            const int tid2 = lndv(tidl), row = tid2 >> 2, qtr = tid2 & 3;
            lcp orow = L + GC_OI + row * PO256 + qtr * 128;
            const bf16* gp = Prow0 + (size_t)row * GLA_INP + G_R + h * 256 + qtr * 64;
            float sum = 0.f;
#pragma unroll
            for (int c = 0; c < 8; ++c) { const v4u w = *(const LAS v4u*)(orow + c * 16);
#pragma unroll
                for (int i = 0; i < 4; ++i) sum += bflo(w[i]) + bfhi(w[i]); }
            sum += xsw<1>(sum); sum += xsw<2>(sum);
            const float mu = sum * (1.0f / 256.0f); float sq = 0.f;
#pragma unroll
            for (int c = 0; c < 8; ++c) { const v4u w = *(const LAS v4u*)(orow + c * 16);
#pragma unroll
                for (int i = 0; i < 4; ++i) { const float d0 = bflo(w[i]) - mu, d1 = bfhi(w[i]) - mu; sq += d0 * d0 + d1 * d1; } }
            sq += xsw<1>(sq); sq += xsw<2>(sq);
            const float rstd = 1.0f / sqrtf(sq * (1.0f / 256.0f) + EPS);
            bf16* op = CAT + ((size_t)b * SEQ + g * 128 + row) * D + h * 256 + qtr * 64;
#pragma unroll
            for (int c = 0; c < 8; ++c) { const v4u gw = *(const GAS v4u*)(gp + c * 8); const v4u w = *(const LAS v4u*)(orow + c * 16); v4u ow;
#pragma unroll
                for (int i = 0; i < 4; ++i) { const float g0 = bflo(gw[i]), g1 = bfhi(gw[i]);
                    ow[i] = cvtpk((bflo(w[i]) - mu) * rstd * silu_f(g0), (bfhi(w[i]) - mu) * rstd * silu_f(g1)); }
                *(GAS v4u*)(op + c * 8) = ow; }
        }
        WG_BAR();
    }
}


constexpr size_t WS_OD = 408 * MiB;
constexpr size_t WS_LSE = WS_XB + 32 * MiB;
constexpr size_t WS_END2 = 504 * MiB;
constexpr int RA_KI = 0, RA_VD = RA_KI + 128 * PT, RA_END = RA_VD + 128 * PT;
constexpr int RC_QI = 0, RC_KI = RC_QI + 128 * PR, RC_VI = RC_KI + 128 * PR, RC_SI = RC_VI + 128 * PT, RC_END = RC_SI + 128 * PT;
constexpr int DPK = 144, DPV = 192;
constexpr int DL_KI = 0, DL_VI = DL_KI + 384 * DPK, DL_LW = DL_VI + 384 * DPV, DL_END = DL_LW + 8 * 256;
constexpr int DL_ST = DL_KI;
static_assert(RC_END <= LDSCTL_OFF && DL_END <= LDSCTL_OFF && 8 * 32 * DPK <= 384 * DPK, "even mixer LDS maps");
__device__ __forceinline__ float ret_log2g(int h) { return log2f(1.0f - exp2f(-5.0f - (float)h)); }

__device__ __forceinline__ void ret_phase_a_items(const Frame& F, const bf16* P, bf16* RKV) {
    LAS unsigned char* L = F.lds;
    const int wave = F.wave, db = wave & 3, eh = wave >> 2;
    v4u kR[4], vR[4];
    {   const int it = F.bid < 1024 ? F.bid : 0; const int bh = it >> 5, n = it & 31; const bf16* Prow0 = P + ((size_t)(bh >> 2) * SEQ + n * 128) * EVEN_IN;
        tile_ld<128, 128>(kR, Prow0 + E_RK + (bh & 3) * 128, EVEN_IN, F.tid); tile_ld<128, 128>(vR, Prow0 + E_RV + (bh & 3) * 128, EVEN_IN, F.tid); }
    for (int it = F.bid; it < 1024; it += F.G) {
        const int tidl = lndv(F.tid), lane = tidl & 63, r = lane & 31, h2 = lane >> 5;
        const int bh = it >> 5, h = bh & 3;
        const float lg = ret_log2g(h);
        tile_st<128, 128>(kR, L + RA_KI, PT, tidl);
        {
#pragma unroll
            for (int i = 0; i < 4; ++i) { const int row = (tidl >> 4) + 32 * i, cc = tidl & 15; const float f = __builtin_amdgcn_exp2f(lg * (float)(127 - row)); v4u o;
#pragma unroll
                for (int k = 0; k < 4; ++k) o[k] = cvtpk(bflo(vR[i][k]) * f, bfhi(vR[i][k]) * f);
                *(LAS v4u*)(L + RA_VD + row * PT + cc * 16) = o; }
        }
        WG_BAR();
        {   const int nx = (it + F.G < 1024) ? it + F.G : it; const int bh2 = nx >> 5, n2 = nx & 31; const bf16* Pn = P + ((size_t)(bh2 >> 2) * SEQ + n2 * 128) * EVEN_IN;
            tile_ld<128, 128>(kR, Pn + E_RK + (bh2 & 3) * 128, EVEN_IN, tidl); tile_ld<128, 128>(vR, Pn + E_RV + (bh2 & 3) * 128, EVEN_IN, tidl); }
        f32x16 acc[2];
#pragma unroll
        for (int t = 0; t < 2; ++t) acc[t] = (f32x16){0.f, 0.f, 0.f, 0.f, 0.f, 0.f, 0.f, 0.f, 0.f, 0.f, 0.f, 0.f, 0.f, 0.f, 0.f, 0.f};
#pragma unroll
        for (int ks = 0; ks < 8; ++ks) { const bf16x8 a = ld_tr(L + RA_KI, PT, 16 * ks, db * 32, lane);
#pragma unroll
            for (int t = 0; t < 2; ++t) acc[t] = MFMA32(a, ld_tr(L + RA_VD, PT, 16 * ks, (2 * eh + t) * 32, lane), acc[t]); }
        WG_BAR();
#pragma unroll
        for (int t = 0; t < 2; ++t)
#pragma unroll
            for (int i = 0; i < 16; ++i) *(LAS bf16*)(L + RA_KI + (db * 32 + crow(i, h2)) * PR + ((2 * eh + t) * 32 + r) * 2) = cvt1(acc[t][i]);
        WG_BAR();
        bf16* out = RKV + (size_t)it * 128 * 128;
#pragma unroll
        for (int i = 0; i < 4; ++i) { const int row = (tidl >> 4) + 32 * i, cc = tidl & 15; *(GAS v4u*)(out + row * 128 + cc * 8) = *(const LAS v4u*)(L + RA_KI + row * PR + cc * 16); }
        WG_BAR();
    }
}
__device__ __forceinline__ void ret_scan(const Frame& F, bf16* RKV) {
    for (int gt = F.bid * NTHREADS + F.tid; gt < 32 * 128 * 16; gt += F.G * NTHREADS) {
        const int bh = gt >> 11, d = (gt >> 4) & 127, e8 = gt & 15, h = bh & 3;
        const float g128 = __builtin_amdgcn_exp2f(ret_log2g(h) * 128.0f);
        float s[8];
#pragma unroll
        for (int i = 0; i < 8; ++i) s[i] = 0.f;
        for (int n0 = 0; n0 < 32; n0 += 4) {
            v4u kv[4];
#pragma unroll
            for (int u = 0; u < 4; ++u) kv[u] = *(const GAS v4u*)(RKV + (((size_t)bh * 32 + n0 + u) * 128 + d) * 128 + e8 * 8);
#pragma unroll
            for (int u = 0; u < 4; ++u) {
                v4u o; o.x = cvtpk(s[0], s[1]); o.y = cvtpk(s[2], s[3]); o.z = cvtpk(s[4], s[5]); o.w = cvtpk(s[6], s[7]);
                *(GAS v4u*)(RKV + (((size_t)bh * 32 + n0 + u) * 128 + d) * 128 + e8 * 8) = o;
#pragma unroll
                for (int i = 0; i < 4; ++i) { s[2 * i] = g128 * s[2 * i] + bflo(kv[u][i]); s[2 * i + 1] = g128 * s[2 * i + 1] + bfhi(kv[u][i]); } }
        }
    }
}
__device__ __forceinline__ void ret_phase_c_items(const Frame& F, const bf16* P, const bf16* RKV, bf16* CAT) {
    LAS unsigned char* L = F.lds;
    const int wave = F.wave, ib = wave & 3, eq = wave >> 2;
    v4u qR[4], kR[4];
    {   const int it = F.bid < 1024 ? F.bid : 0; const int bh = it >> 5, n = it & 31; const bf16* Prow0 = P + ((size_t)(bh >> 2) * SEQ + n * 128) * EVEN_IN;
        tile_ld<128, 128>(qR, Prow0 + E_RQ + (bh & 3) * 128, EVEN_IN, F.tid); tile_ld<128, 128>(kR, Prow0 + E_RK + (bh & 3) * 128, EVEN_IN, F.tid); }
    for (int it = F.bid; it < 1024; it += F.G) {
        const int tidl = lndv(F.tid), lane = tidl & 63, r = lane & 31, h2 = lane >> 5;
        const int bh = it >> 5, n = it & 31, b = bh >> 2, h = bh & 3;
        const float lg = ret_log2g(h);
        const bf16* Prow0 = P + ((size_t)b * SEQ + n * 128) * EVEN_IN;
        {   v4u vR[4], sR[4]; tile_ld<128, 128>(vR, Prow0 + E_RV + h * 128, EVEN_IN, tidl); tile_ld<128, 128>(sR, RKV + (size_t)it * 128 * 128, 128, tidl);
#pragma unroll
            for (int i = 0; i < 4; ++i) { const int row = (tidl >> 4) + 32 * i, cc = tidl & 15; const float fq = __builtin_amdgcn_exp2f(lg * (float)row), fk = __builtin_amdgcn_rcpf(fq); v4u oq, ok;
#pragma unroll
                for (int k = 0; k < 4; ++k) { oq[k] = cvtpk(bflo(qR[i][k]) * fq, bfhi(qR[i][k]) * fq); ok[k] = cvtpk(bflo(kR[i][k]) * fk, bfhi(kR[i][k]) * fk); }
                *(LAS v4u*)(L + RC_QI + row * PR + cc * 16) = oq; *(LAS v4u*)(L + RC_KI + row * PR + cc * 16) = ok; }
            tile_st<128, 128>(vR, L + RC_VI, PT, tidl); tile_st<128, 128>(sR, L + RC_SI, PT, tidl); }
        WG_BAR();
        bf16x8 PA[4][2];
#pragma unroll
        for (int jb = 0; jb < 4; ++jb) {
            if (jb <= ib) {
                f32x16 x = {0.f, 0.f, 0.f, 0.f, 0.f, 0.f, 0.f, 0.f, 0.f, 0.f, 0.f, 0.f, 0.f, 0.f, 0.f, 0.f};
#pragma unroll
                for (int ks = 0; ks < 8; ++ks) x = MFMA32(ld_row(L + RC_KI, PR, jb * 32, 16 * ks, r, h2), ld_row(L + RC_QI, PR, ib * 32, 16 * ks, r, h2), x);
                if (jb == ib) {
#pragma unroll
                    for (int i = 0; i < 16; ++i) if (crow(i, h2) > r) x[i] = 0.f; }
                PA[jb][0] = PACK_STEP(x, 0); PA[jb][1] = PACK_STEP(x, 1);
            } else { PA[jb][0] = (bf16x8){0, 0, 0, 0, 0, 0, 0, 0}; PA[jb][1] = (bf16x8){0, 0, 0, 0, 0, 0, 0, 0}; }
        }
        f32x16 o[2];
#pragma unroll
        for (int t = 0; t < 2; ++t) {
            const int eb = 2 * eq + t;
            f32x16 z = {0.f, 0.f, 0.f, 0.f, 0.f, 0.f, 0.f, 0.f, 0.f, 0.f, 0.f, 0.f, 0.f, 0.f, 0.f, 0.f}, y = z;
#pragma unroll
            for (int jb = 0; jb < 4; ++jb) if (jb <= ib) {
#pragma unroll
                for (int s = 0; s < 2; ++s) z = MFMA32(PA[jb][s], ld_tr_perm(L + RC_VI, PT, jb * 32 + 16 * s, eb * 32, lane), z); }
#pragma unroll
            for (int ks = 0; ks < 8; ++ks) y = MFMA32(ld_row(L + RC_QI, PR, ib * 32, 16 * ks, r, h2), ld_tr(L + RC_SI, PT, 16 * ks, eb * 32, lane), y);
            const float g1 = __builtin_amdgcn_exp2f(lg);
#pragma unroll
            for (int i = 0; i < 16; ++i) z[i] += y[i] * g1;
            o[t] = z;
        }
        WG_BAR();
#pragma unroll
        for (int t = 0; t < 2; ++t)
#pragma unroll
            for (int i = 0; i < 16; ++i) *(LAS bf16*)(L + RC_QI + (ib * 32 + crow(i, h2)) * PR + ((2 * eq + t) * 32 + r) * 2) = cvt1(o[t][i]);
        WG_BAR();
        {   const int nx = (it + F.G < 1024) ? it + F.G : it; const int bh2 = nx >> 5, n2 = nx & 31; const bf16* Pn = P + ((size_t)(bh2 >> 2) * SEQ + n2 * 128) * EVEN_IN;
            tile_ld<128, 128>(qR, Pn + E_RQ + (bh2 & 3) * 128, EVEN_IN, tidl); tile_ld<128, 128>(kR, Pn + E_RK + (bh2 & 3) * 128, EVEN_IN, tidl); }
        {
            const int tid2 = lndv(tidl), row = tid2 >> 2, qtr = tid2 & 3;
            lcp orow = L + RC_QI + row * PR + qtr * 64;
            v4u w[4]; float sum = 0.f;
#pragma unroll
            for (int c = 0; c < 4; ++c) { w[c] = *(const LAS v4u*)(orow + c * 16);
#pragma unroll
                for (int i = 0; i < 4; ++i) sum += bflo(w[c][i]) + bfhi(w[c][i]); }
            sum += xsw<1>(sum); sum += xsw<2>(sum);
            const float mu = sum * (1.0f / 128.0f); float sq = 0.f;
#pragma unroll
            for (int c = 0; c < 4; ++c)
#pragma unroll
                for (int i = 0; i < 4; ++i) { const float d0 = bflo(w[c][i]) - mu, d1 = bfhi(w[c][i]) - mu; sq += d0 * d0 + d1 * d1; }
            sq += xsw<1>(sq); sq += xsw<2>(sq);
            const float rstd = 1.0f / sqrtf(sq * (1.0f / 128.0f) + EPS);
            const bf16* gp = Prow0 + (size_t)row * EVEN_IN + E_RG + h * 128 + qtr * 32;
            bf16* op = CAT + ((size_t)b * SEQ + n * 128 + row) * D + h * 128 + qtr * 32;
#pragma unroll
            for (int c = 0; c < 4; ++c) { const v4u gw = *(const GAS v4u*)(gp + c * 8); v4u ow;
#pragma unroll
                for (int i = 0; i < 4; ++i) { const float g0 = bflo(gw[i]), g1 = bfhi(gw[i]);
                    ow[i] = cvtpk((bflo(w[c][i]) - mu) * rstd * silu_f(g0), (bfhi(w[c][i]) - mu) * rstd * silu_f(g1)); }
                *(GAS v4u*)(op + c * 8) = ow; }
        }
        WG_BAR();
    }
}
struct DilTile { int b, head, p, dil, res, q0; };
__device__ __forceinline__ DilTile dil_decode(int T) { DilTile t; t.b = T / 384; const int rem = T - t.b * 384; t.head = rem / 48; const int t48 = rem - t.head * 48; t.p = t48 >> 4; const int idx = t48 & 15, sh = 2 * t.p;
    t.dil = 1 << sh; t.res = idx & (t.dil - 1); t.q0 = (idx >> sh) * 256; return t; }
__device__ __forceinline__ void dil_ld(v4u (&kR)[6], v4u (&vR)[6], const DilTile& t, const bf16* P, int tid) {
    const bf16* Pb = P + (size_t)t.b * SEQ * EVEN_IN + t.head * 64 + (tid & 7) * 8;
#pragma unroll
    for (int i = 0; i < 6; ++i) { int kidx = t.q0 - 128 + (tid >> 3) + 64 * i; kidx = kidx < 0 ? 0 : kidx;
        const bf16* src = Pb + (size_t)(kidx * t.dil + t.res) * EVEN_IN; kR[i] = *(const GAS v4u*)(src + E_DK); vR[i] = *(const GAS v4u*)(src + E_DV); }
}
__device__ __forceinline__ void dil_tiles(const Frame& F, int T0, int T1, int step, const bf16* P, bf16* OD, float* LSE) {
    LAS unsigned char* L = F.lds;
    const int wave = F.wave;
    if (T0 >= T1) return;
    v4u kR[6], vR[6];
    { const DilTile t0 = dil_decode(T0); dil_ld(kR, vR, t0, P, F.tid); }
    for (int T = T0; T < T1; T += step) {
        const int tidl = lndv(F.tid), lane = tidl & 63, r = lane & 31, h2 = lane >> 5;
        const DilTile t = dil_decode(T);
        const bf16* Pb = P + (size_t)t.b * SEQ * EVEN_IN + t.head * 64;
#pragma unroll
        for (int i = 0; i < 6; ++i) { const int row = (tidl >> 3) + 64 * i, cc = tidl & 7; *(LAS v4u*)(L + DL_KI + row * DPK + cc * 16) = kR[i]; *(LAS v4u*)(L + DL_VI + row * DPV + cc * 16) = vR[i]; }
        bf16x8 qf[4];
        { const bf16* qsrc = Pb + (size_t)((t.q0 + 32 * wave + r) * t.dil + t.res) * EVEN_IN + E_DQ + 8 * h2;
#pragma unroll
          for (int ks = 0; ks < 4; ++ks) qf[ks] = *(const GAS bf16x8*)(qsrc + 16 * ks); }
        WG_BAR();
        { const DilTile tn = dil_decode(T + step < T1 ? T + step : T); dil_ld(kR, vR, tn, P, tidl); }
        f32x16 x[5];
        float mx = -INFINITY;
#pragma unroll
        for (int kb = 0; kb < 5; ++kb) {
            f32x16 a = {0.f, 0.f, 0.f, 0.f, 0.f, 0.f, 0.f, 0.f, 0.f, 0.f, 0.f, 0.f, 0.f, 0.f, 0.f, 0.f};
#pragma unroll
            for (int ks = 0; ks < 4; ++ks) a = MFMA32(ld_row(L + DL_KI, DPK, 32 * wave + 32 * kb, 16 * ks, r, h2), qf[ks], a);
            if (kb == 0) {
#pragma unroll
                for (int i = 0; i < 16; ++i) if (crow(i, h2) < r) a[i] = -INFINITY; }
            if (kb == 4) {
#pragma unroll
                for (int i = 0; i < 16; ++i) if (crow(i, h2) > r) a[i] = -INFINITY; }
            if (t.q0 == 0 && 32 * wave + 32 * kb < 128) {
#pragma unroll
                for (int i = 0; i < 16; ++i) a[i] = -INFINITY; }
#pragma unroll
            for (int i = 0; i < 16; ++i) mx = fmaxf(mx, a[i]);
            x[kb] = a;
        }
        mx = max32(mx);
        constexpr float C2 = 0.125f * LOG2E;
        const float mc = mx * C2; float l = 0.f;
#pragma unroll
        for (int kb = 0; kb < 5; ++kb)
#pragma unroll
            for (int i = 0; i < 16; ++i) { const float pe = __builtin_amdgcn_exp2f(x[kb][i] * C2 - mc); x[kb][i] = pe; l += pe; }
        l = sum32(l);
        f32x16 o[2];
#pragma unroll
        for (int dbk = 0; dbk < 2; ++dbk) o[dbk] = (f32x16){0.f, 0.f, 0.f, 0.f, 0.f, 0.f, 0.f, 0.f, 0.f, 0.f, 0.f, 0.f, 0.f, 0.f, 0.f, 0.f};
#pragma unroll
        for (int kb = 0; kb < 5; ++kb)
#pragma unroll
            for (int s = 0; s < 2; ++s) { const bf16x8 pa = PACK_STEP(x[kb], s);
#pragma unroll
                for (int dbk = 0; dbk < 2; ++dbk) o[dbk] = MFMA32(pa, ld_tr_perm(L + DL_VI, DPV, 32 * wave + 32 * kb + 16 * s, dbk * 32, lane), o[dbk]); }
        LAS float* lw = (LAS float*)(L + DL_LW + wave * 256);
        if (h2 == 0) lw[r] = l;
        WG_BAR();
        LAS unsigned char* st = L + DL_ST + wave * 32 * DPK;
#pragma unroll
        for (int i = 0; i < 16; ++i) { const float rl = __builtin_amdgcn_rcpf(lw[crow(i, h2)]);
#pragma unroll
            for (int dbk = 0; dbk < 2; ++dbk) *(LAS bf16*)(st + crow(i, h2) * DPK + (dbk * 32 + r) * 2) = cvt1(o[dbk][i] * rl); }
        const size_t tokbase = (size_t)t.b * SEQ;
        bf16* odp = OD + (size_t)t.p * M * 512;
#pragma unroll
        for (int j = 0; j < 4; ++j) { const int c = lane + 64 * j, row = c >> 3, cc = c & 7; const size_t tok = tokbase + (size_t)(t.q0 + 32 * wave + row) * t.dil + t.res;
            *(GAS v4u*)(odp + tok * 512 + t.head * 64 + cc * 8) = *(const LAS v4u*)(st + row * DPK + cc * 16); }
        if (h2 == 0) { const size_t tok = tokbase + (size_t)(t.q0 + 32 * wave + r) * t.dil + t.res; LSE[((size_t)t.p * M + tok) * 8 + t.head] = mx * 0.125f + LN2 * __builtin_amdgcn_logf(l); }
        WG_BAR();
    }
}
__device__ __forceinline__ void dil_combine(const Frame& F, const bf16* OD, const float* LSE, bf16* CAT) {
    for (int gt = F.bid * NTHREADS + F.tid; gt < M * 64; gt += F.G * NTHREADS) {
        const int tok = gt >> 6, c8 = gt & 63, head = c8 >> 3;
        const float l0 = LSE[(size_t)tok * 8 + head], l1 = LSE[((size_t)M + tok) * 8 + head], l2 = LSE[((size_t)2 * M + tok) * 8 + head];
        const float mxl = fmaxf(l0, fmaxf(l1, l2));
        float w0 = __builtin_amdgcn_exp2f((l0 - mxl) * LOG2E), w1 = __builtin_amdgcn_exp2f((l1 - mxl) * LOG2E), w2 = __builtin_amdgcn_exp2f((l2 - mxl) * LOG2E);
        const float rs = 1.0f / (w0 + w1 + w2); w0 *= rs; w1 *= rs; w2 *= rs;
        const v4u a = *(const GAS v4u*)(OD + (size_t)tok * 512 + c8 * 8), bq = *(const GAS v4u*)(OD + ((size_t)M + tok) * 512 + c8 * 8), cq = *(const GAS v4u*)(OD + ((size_t)2 * M + tok) * 512 + c8 * 8);
        v4u o;
#pragma unroll
        for (int i = 0; i < 4; ++i) o[i] = cvtpk(w0 * bflo(a[i]) + w1 * bflo(bq[i]) + w2 * bflo(cq[i]), w0 * bfhi(a[i]) + w1 * bfhi(bq[i]) + w2 * bfhi(cq[i]));
        *(GAS v4u*)(CAT + (size_t)tok * D + 512 + c8 * 8) = o;
    }
}
constexpr int DIL_TILES = 3072, DIL_SPLIT = 1024;
__device__ __forceinline__ void even_phase_a(const Frame& F0) {
    const Frame F = relaunder(F0);
    unsigned char* ws = WSP();
    const bf16* P = (const bf16*)(ws + WS_ACT); bf16* RKV = (bf16*)(ws + WS_XB); bf16* OD = (bf16*)(ws + WS_OD); float* LSE = (float*)(ws + WS_LSE);
    ret_phase_a_items(F, P, RKV);
    dil_tiles(F, F.bid, DIL_SPLIT, F.G, P, OD, LSE);
}
__device__ __forceinline__ void even_phase_b(const Frame& F0) {
    const Frame F = relaunder(F0);
    unsigned char* ws = WSP();
    const bf16* P = (const bf16*)(ws + WS_ACT); bf16* RKV = (bf16*)(ws + WS_XB); bf16* OD = (bf16*)(ws + WS_OD); float* LSE = (float*)(ws + WS_LSE);
    ret_scan(F, RKV);
    dil_tiles(F, DIL_SPLIT + F.bid, DIL_TILES, F.G, P, OD, LSE);
}
__device__ __forceinline__ void even_phase_c(const Frame& F0) {
    const Frame F = relaunder(F0);
    unsigned char* ws = WSP();
    const bf16* P = (const bf16*)(ws + WS_ACT); const bf16* RKV = (const bf16*)(ws + WS_XB); const bf16* OD = (const bf16*)(ws + WS_OD); const float* LSE = (const float*)(ws + WS_LSE); bf16* CAT = (bf16*)(ws + WS_CAT);
    ret_phase_c_items(F, P, RKV, CAT);
    dil_combine(F, OD, LSE, CAT);
}

__global__ void __launch_bounds__(NTHREADS, 2) fwd_kernel(Args args) {
    extern __shared__ __attribute__((aligned(16))) unsigned char lds[];
    Frame F;
    F.lds = (LAS unsigned char*)lds;
    F.wave = __builtin_amdgcn_readfirstlane((int)(threadIdx.x >> 6)); F.lane = hw_lane(); F.tid = F.wave * 64 + F.lane; F.G = gridDim.x; F.bid = blockIdx.x;
    for (int u = F.tid; u < (LDS_BYTES - LDSCTL_OFF) / 4; u += NTHREADS) ((LAS unsigned*)(F.lds + LDSCTL_OFF))[u] = 0u;
    __syncthreads();
    if (F.tid < N_PTRS) { const unsigned long long v = (F.tid < 17) ? (unsigned long long)args.in[F.tid] : (F.tid == 17 ? (unsigned long long)args.out : (unsigned long long)args.ws);
        ((LAS unsigned*)(F.lds + PTR_OFF))[2 * F.tid] = (unsigned)v; ((LAS unsigned*)(F.lds + PTR_OFF))[2 * F.tid + 1] = (unsigned)(v >> 32); }
    __syncthreads();
    (void)xcd_barrier_post((unsigned*)(WSP() + WS_CTL) + CW_BAR, (volatile LAS unsigned*)(F.lds + MISC_OFF) + 8, F.tid);
#ifdef PROBE_BARX2
#define PROBE_BAR2(b, t) xcd_barrier(b, t)
#else
#define PROBE_BAR2(b, t) do {} while (0)
#endif
#define GRID_BAR() do { XcdBarrier bar_; bar_.bar = (unsigned*)(WSP() + WS_CTL) + CW_BAR; bar_.x = (unsigned)__builtin_amdgcn_readfirstlane((int)xb_xcc_id()); \
        int mo_ = MISC_OFF + 32; asm volatile("" : "+s"(mo_)); bar_.st = (volatile LAS unsigned*)(F.lds + mo_); int t_ = threadIdx.x; asm volatile("" : "+v"(t_)); xcd_barrier(bar_, t_); PROBE_BAR2(bar_, t_); } while (0)
#define XB ((bf16*)(WSP() + WS_XB))
#define ACT ((bf16*)(WSP() + WS_ACT))
#define CAT ((bf16*)(WSP() + WS_CAT))
#define SSP ((float*)(WSP() + WS_SSP))
#define WPTR(off) ((const bf16*)(WSP() + (off)))

#ifdef TEST_MIN
    {
        pg8::Gemm g{XB, WPTR(W_GU0), M, 2 * FF, D}; pg8::StaticOrder S; S.init(M, 2 * FF, lnd(F.G), lnd(F.bid));
        pg8::EpiSwiGLU E{ACT, FF, SSP};
        pg8::gemm_phase<pg8::EpiSwiGLU, pg8::StaticOrder, true, true>(F.lds + RING_OFF, g, S, E, lnd(F.wave));
        GRID_BAR();
        return;
    }
#endif
    prologue_rows(F);
    convert_weights(F, 0);
    GRID_BAR();
    for (int s = 0; s < 8; ++s) {
        const int l = s >> 1; const bool post = (s & 1) != 0;
#ifdef PROBE_F1X2
        for (int rep = 0; rep < 2; ++rep)
#endif
        {
#ifdef PROBE_KX2
            typedef pg8::TwiceOrder F1Order;
#else
            typedef pg8::StaticOrder F1Order;
#endif
            pg8::Gemm g{XB, WPTR(post ? W_GU1 : W_GU0), M, 2 * FF, D}; F1Order S; S.init(M, 2 * FF, lnd(F.G), lnd(F.bid));
            pg8::EpiSwiGLU E{ACT, FF, SSP};
#ifndef NO_F1
            pg8::gemm_phase<pg8::EpiSwiGLU, F1Order, true, true>(F.lds + RING_OFF, g, S, E, lnd(F.wave));
#endif
            GRID_BAR();
        }
#ifdef PROBE_F2X2
        for (int rep = 0; rep < 2; ++rep)
#else
        constexpr int rep = 1;
#endif
        {
            pg8::Gemm g{ACT, WPTR(post ? W_D1 : W_D0), M, D, FF}; pg8::StaticOrder S; S.init(M, D, lnd(F.G), lnd(F.bid));
            pg8::EpiResid E{s == 0 ? AP(I_X) : (const float*)OUTP(), OUTP(), XB, SSP, rep ? 0.5f : 0.0f};
#ifndef NO_F2
            pg8::gemm_phase<pg8::EpiResid, pg8::StaticOrder, true, true>(F.lds + RING_OFF, g, S, E, lnd(F.wave));
#endif
            GRID_BAR();
        }
        if (!post) {
            const bool odd = (l & 1) != 0; const int nin = odd ? GLA_INP : EVEN_IN;
            {
                pg8::Gemm g{XB, WPTR(W_IN), M, nin, D}; pg8::StaticOrder S; S.init(M, nin, lnd(F.G), lnd(F.bid));
                pg8::EpiInProj E{ACT, nin, SSP, (const float*)(WSP() + TAB_RC), (const float*)(WSP() + TAB_RS), (const float*)(WSP() + TAB_DC), (const float*)(WSP() + TAB_DS), odd ? 0 : 1};
#ifndef NO_M1
                pg8::gemm_phase<pg8::EpiInProj, pg8::StaticOrder, true, true>(F.lds + RING_OFF, g, S, E, lnd(F.wave));
#endif
            }
            GRID_BAR();
#ifndef NO_EVEN
#if defined(PROBE_MIXX2) || defined(PROBE_EVENX2)
            if (!odd) { even_phase_a(F); GRID_BAR(); even_phase_a(F); GRID_BAR(); even_phase_b(F); GRID_BAR(); even_phase_c(F); GRID_BAR(); even_phase_c(F); }
#else
            if (!odd) { even_phase_a(F); GRID_BAR(); even_phase_b(F); GRID_BAR(); even_phase_c(F); }
#endif
#endif
#ifndef NO_GLA
            if (odd) {
#ifndef NO_GA
                gla_phase_a(F, l >> 1);
#endif
#ifdef PROBE_MIXX2
                GRID_BAR(); gla_phase_a(F, l >> 1);
#endif
                GRID_BAR();
#ifndef NO_GB
                gla_phase_b(F);
#endif
                GRID_BAR();
#ifndef NO_GC
                gla_phase_c(F, l >> 1);
#endif
#ifdef PROBE_MIXX2
                GRID_BAR(); gla_phase_c(F, l >> 1);
#endif
            }
#endif
            GRID_BAR();
#ifdef PROBE_M5X2
            for (int rep2 = 0; rep2 < 2; ++rep2)
#else
            constexpr int rep2 = 1;
#endif
            {
                pg8::Gemm g{CAT, WPTR(W_OUT), M, D, D}; pg8::StaticOrder S; S.init(M, D, lnd(F.G), lnd(F.bid));
                pg8::EpiResid E{(const float*)OUTP(), OUTP(), XB, SSP, rep2 ? 1.0f : 0.0f};
#ifndef NO_M5
                pg8::gemm_phase<pg8::EpiResid, pg8::StaticOrder, true, true>(F.lds + RING_OFF, g, S, E, lnd(F.wave));
#endif
                GRID_BAR();
            }
        } else if (l + 1 < DEPTH) {
            convert_weights(F, l + 1);
            GRID_BAR();
#ifdef PROBE_CONVX2
            convert_weights(F, l + 1);
            GRID_BAR();
#endif
        }
    }
    final_norm(F);
}

extern "C" void kernel_launch(void* const* d_in, const int* in_sizes, int n_in, void* d_out, int out_size, void* d_ws, size_t ws_size, hipStream_t stream) {
    static int grid = 0;
    if (grid == 0) {
        if (n_in != 17 || in_sizes[0] != M * D || out_size != M * D || ws_size < WS_END2) { fprintf(stderr, "kernel_launch: unexpected shapes (n_in %d, in0 %d, out %d, ws %zu)\n", n_in, n_in > 0 ? in_sizes[0] : -1, out_size, ws_size); grid = -1; return; }
        int dev = 0, cus = 0, per_cu = 0;
        if (hipGetDevice(&dev) != hipSuccess || hipDeviceGetAttribute(&cus, hipDeviceAttributeMultiprocessorCount, dev) != hipSuccess) { grid = -1; return; }
        if (hipFuncSetAttribute((const void*)fwd_kernel, hipFuncAttributeMaxDynamicSharedMemorySize, LDS_BYTES) != hipSuccess) { fprintf(stderr, "kernel_launch: hipFuncSetAttribute failed\n"); grid = -1; return; }
        if (hipOccupancyMaxActiveBlocksPerMultiprocessor(&per_cu, (const void*)fwd_kernel, NTHREADS, LDS_BYTES) != hipSuccess || per_cu < 1) { fprintf(stderr, "kernel_launch: occupancy query reports %d\n", per_cu); }
        (void)hipGetLastError();
        grid = cus;
        if (grid != 256) fprintf(stderr, "kernel_launch: %d CUs (expected 256)\n", grid);
    }
    if (grid < 0) return;
    if (hipMemsetAsync((char*)d_ws + WS_CTL, 0, CTL_ZERO_BYTES, stream) != hipSuccess) return;
    Args a{};
    for (int i = 0; i < 17; ++i) a.in[i] = (const float*)d_in[i];
    a.out = (float*)d_out; a.ws = (unsigned char*)d_ws;
    hipLaunchKernelGGL(fwd_kernel, dim3(grid), dim3(NTHREADS), LDS_BYTES, stream, a);
}
```

```cpp
#include <hip/hip_runtime.h>
#include <cstdio>
#include <cstdint>
#include <cmath>
template <int K> __device__ __forceinline__ float xsw(float v) { static_assert(K == 1 || K == 2 || K == 4 || K == 8 || K == 16, "xor mask inside a 32-lane half");
    return __builtin_bit_cast(float, __builtin_amdgcn_ds_swizzle(__builtin_bit_cast(int, v), 0x1F | (K << 10))); }
__device__ __forceinline__ float sum32(float v) { const unsigned u = __builtin_bit_cast(unsigned, v); auto rr = __builtin_amdgcn_permlane32_swap(u, u, false, false); return __builtin_bit_cast(float, (unsigned)rr[0]) + __builtin_bit_cast(float, (unsigned)rr[1]); }
__device__ __forceinline__ float max32(float v) { const unsigned u = __builtin_bit_cast(unsigned, v); auto rr = __builtin_amdgcn_permlane32_swap(u, u, false, false); return fmaxf(__builtin_bit_cast(float, (unsigned)rr[0]), __builtin_bit_cast(float, (unsigned)rr[1])); }
__device__ __forceinline__ float oth32(float v, int h) { const unsigned u = __builtin_bit_cast(unsigned, v); auto rr = __builtin_amdgcn_permlane32_swap(u, u, false, false); return __builtin_bit_cast(float, (unsigned)(h ? rr[0] : rr[1])); }
namespace pg8 {
#define PG8_LAS __attribute__((address_space(3)))
typedef unsigned short bf16_t;
typedef short bf16x8 __attribute__((ext_vector_type(8)));
typedef float f32x4 __attribute__((ext_vector_type(4)));
typedef unsigned u32x4 __attribute__((ext_vector_type(4)));
constexpr int BM = 256, BK = 64, HALF = 128, HTB = HALF * BK * 2  , STAGE_BYTES = 8 * HTB, NXCD = 8, WGM = 8;

__host__ __device__ __forceinline__ int lds_byte(int r, int c) { const int st = (r >> 4) * 2 + (c >> 5), rr = r & 15, cc = c & 31, ob = rr * 64 + cc * 2; return st * 1024 + (ob ^ (((ob >> 9) & 1) << 5)); }
__host__ __device__ __forceinline__ void stage_rc(int b, int& R, int& C) { const int st = b / 1024, sb = b % 1024, swz = sb ^ (((sb >> 9) & 1) << 5); R = (st >> 1) * 16 + swz / 64; C = (st & 1) * 32 + (swz % 64) / 2; }
__host__ __device__ __forceinline__ int perm32(int rho) { const int n = rho >> 4, i = rho & 15; return 8 * (i >> 2) + 4 * n + (i & 3); }

struct Unit { int pm, pn; };
struct Gemm { const bf16_t* A; const bf16_t* Bt; int M, N, K; };

struct StaticOrder {
    int nM, nN, nwg, G, c;
    __host__ __device__ void init(int M, int N, int G_, int c_) { nM = M / BM; nN = N / BM; nwg = nM * nN; G = G_; c = c_; }
    __host__ __device__ bool next(int i, Unit& u) const {
        const long L = (long)i * G + c; if (L >= nwg) return false;
        int wgid = (int)L; { const int q = nwg / NXCD, r = nwg % NXCD, xcd = wgid % NXCD, off = wgid / NXCD; wgid = (xcd < r ? xcd * (q + 1) : r * (q + 1) + (xcd - r) * q) + off; }
        const int nig = WGM * nN, gid = wgid / nig, fm = gid * WGM, gsz = (nM - fm) < WGM ? (nM - fm) : WGM;
        u.pm = fm + ((wgid % nig) % gsz); u.pn = (wgid % nig) / gsz; return true;
    }
    __device__ __forceinline__ void a_ready(const Unit&) const {}
    __device__ __forceinline__ void done(const Unit&) const {}
    static constexpr bool TWICE = false;
};
struct RevOrder : StaticOrder {
    __host__ __device__ bool next(int i, Unit& u) const { const int rounds = nwg / G; if (i >= rounds) return false; return StaticOrder::next(rounds - 1 - i, u); }
};
struct TwiceOrder : StaticOrder {
    static constexpr bool TWICE = true;
    __host__ __device__ bool next(int i, Unit& u) const { return StaticOrder::next(i >> 1, u); }
};

__device__ __forceinline__ unsigned cvt_pk_bf16(float lo, float hi) { unsigned r; asm volatile("v_cvt_pk_bf16_f32 %0, %1, %2" : "=v"(r) : "v"(lo), "v"(hi)); return r; }
constexpr int MROWS = 32768;
constexpr float RMS_EPS = 1e-6f;
__device__ __forceinline__ void row_rstd(float (&rs)[2][4], const float* ssp, const Unit& u, int wr, int fr, int fq) {
#pragma unroll
    for (int ai = 0; ai < 2; ++ai)
#pragma unroll
        for (int m = 0; m < 4; ++m) {
            const int row = u.pm * BM + ai * HALF + wr * 64 + m * 16 + fr;
            const f32x4 p = *(const f32x4*)(ssp + (size_t)row * 16 + 4 * fq);
            float s = (p[0] + p[1]) + (p[2] + p[3]);
            s += xsw<16>(s); s = sum32(s);
            rs[ai][m] = 1.0f / sqrtf(s * (1.0f / 1024.0f) + RMS_EPS);
        }
}
__device__ __forceinline__ float silu_f(float g) { return g * __builtin_amdgcn_rcpf(1.0f + __builtin_amdgcn_exp2f(-1.4426950408889634f * g)); }

struct EpiSwiGLU {
    static constexpr bool PERM = true, AFTER_DRAIN = false;
    bf16_t* H; int ldh; const float* ssp;
    __device__ __forceinline__ void operator()(const f32x4 (&acc)[2][2][4][2], const Unit& u, int wr, int wc, int fr, int fq) const {
        float rs[2][4]; row_rstd(rs, ssp, u, wr, fr, fq);
        const int col0 = u.pn * HALF + wc * 32 + 8 * fq;
#pragma unroll
        for (int ai = 0; ai < 2; ++ai)
#pragma unroll
            for (int m = 0; m < 4; ++m) {
                const int row = u.pm * BM + ai * HALF + wr * 64 + m * 16 + fr; const float r = rs[ai][m];
                float h[8];
#pragma unroll
                for (int n = 0; n < 2; ++n)
#pragma unroll
                    for (int i = 0; i < 4; ++i) { const float g = acc[ai][0][m][n][i] * r, up = acc[ai][1][m][n][i] * r; h[4 * n + i] = silu_f(g) * up; }
                u32x4 w; w.x = cvt_pk_bf16(h[0], h[1]); w.y = cvt_pk_bf16(h[2], h[3]); w.z = cvt_pk_bf16(h[4], h[5]); w.w = cvt_pk_bf16(h[6], h[7]);
                *(u32x4*)(H + (size_t)row * ldh + col0) = w;
                asm volatile("" ::: "memory");
            }
    }
};
struct EpiInProj {
    static constexpr bool PERM = true, AFTER_DRAIN = false;
    bf16_t* O; int ldc; const float* ssp; const float* rc; const float* rs; const float* dc; const float* ds; int even;
    __device__ __forceinline__ void operator()(const f32x4 (&acc)[2][2][4][2], const Unit& u, int wr, int wc, int fr, int fq) const {
        float rsd[2][4]; row_rstd(rsd, ssp, u, wr, fr, fq);
        const int col0 = u.pn * BM + wc * 32 + 8 * fq;
        const int kind = even ? (u.pn < 4 ? 1 : ((u.pn >= 8 && u.pn < 12) ? 2 : 0)) : 0;
        const float ksc = (kind == 1 && u.pn >= 2) ? 0.08838834764831845f : 1.0f;
        const bool rot2 = (kind == 2) && ((wc & 1) == 0) && (fq < 2);
        const float* tc = (kind == 1) ? rc + wc * 16 + 4 * fq : dc + 4 * (fq & 1);
        const float* ts = (kind == 1) ? rs + wc * 16 + 4 * fq : ds + 4 * (fq & 1);
        const int tstride = (kind == 1) ? 64 : 8;
#pragma unroll
        for (int ai = 0; ai < 2; ++ai)
#pragma unroll
            for (int m = 0; m < 4; ++m) {
                const int row = u.pm * BM + ai * HALF + wr * 64 + m * 16 + fr; const float r = rsd[ai][m] * ksc;
                f32x4 c4 = {1.f, 1.f, 1.f, 1.f}, s4 = {0.f, 0.f, 0.f, 0.f};
                if (kind == 1 || rot2) { const int pos = row & 4095; c4 = *(const f32x4*)(tc + (size_t)pos * tstride); s4 = *(const f32x4*)(ts + (size_t)pos * tstride); }
#pragma unroll
                for (int bj = 0; bj < 2; ++bj) { const f32x4 v0 = acc[ai][bj][m][0] * r, v1 = acc[ai][bj][m][1] * r;
                    const float o0 = v0[0] * c4[0] - v0[1] * s4[0], o1 = v0[1] * c4[0] + v0[0] * s4[0], o2 = v0[2] * c4[1] - v0[3] * s4[1], o3 = v0[3] * c4[1] + v0[2] * s4[1];
                    const float o4 = v1[0] * c4[2] - v1[1] * s4[2], o5 = v1[1] * c4[2] + v1[0] * s4[2], o6 = v1[2] * c4[3] - v1[3] * s4[3], o7 = v1[3] * c4[3] + v1[2] * s4[3];
                    u32x4 w; w.x = cvt_pk_bf16(o0, o1); w.y = cvt_pk_bf16(o2, o3); w.z = cvt_pk_bf16(o4, o5); w.w = cvt_pk_bf16(o6, o7);
                    *(u32x4*)(O + (size_t)row * ldc + col0 + bj * HALF) = w; }
                asm volatile("" ::: "memory");
            }
    }
};
struct EpiResid {
    static constexpr bool PERM = true, AFTER_DRAIN = false;
    const float* xold; float* xnew; bf16_t* xb; float* ssp; float scale;
    __device__ __forceinline__ void operator()(const f32x4 (&acc)[2][2][4][2], const Unit& u, int wr, int wc, int fr, int fq) const {
        const int col0 = u.pn * BM + wc * 32 + 8 * fq, rowb = u.pm * BM + wr * 64 + fr;
        f32x4 buf[2][4];
#define EPR_LOAD(g, slot) do { const size_t off_ = (size_t)(rowb + ((g) >> 2) * HALF + ((g) & 3) * 16) * 1024 + col0; \
        buf[slot][0] = *(const f32x4*)(xold + off_); buf[slot][1] = *(const f32x4*)(xold + off_ + 4); buf[slot][2] = *(const f32x4*)(xold + off_ + HALF); buf[slot][3] = *(const f32x4*)(xold + off_ + HALF + 4); } while (0)
        EPR_LOAD(0, 0); EPR_LOAD(1, 1);
        asm volatile("" ::: "memory");
#pragma unroll
        for (int g = 0; g < 8; ++g) {
            const int ai = g >> 2, m = g & 3, row = rowb + ai * HALF + m * 16; float ss = 0.f;
#pragma unroll
            for (int bj = 0; bj < 2; ++bj) { const size_t off = (size_t)row * 1024 + col0 + bj * HALF;
                const f32x4 v0 = buf[g & 1][2 * bj] + acc[ai][bj][m][0] * scale, v1 = buf[g & 1][2 * bj + 1] + acc[ai][bj][m][1] * scale;
                *(f32x4*)(xnew + off) = v0; *(f32x4*)(xnew + off + 4) = v1;
                u32x4 w; w.x = cvt_pk_bf16(v0[0], v0[1]); w.y = cvt_pk_bf16(v0[2], v0[3]); w.z = cvt_pk_bf16(v1[0], v1[1]); w.w = cvt_pk_bf16(v1[2], v1[3]);
                *(u32x4*)(xb + off) = w;
                ss += (v0[0] * v0[0] + v0[1] * v0[1]) + (v0[2] * v0[2] + v0[3] * v0[3]) + (v1[0] * v1[0] + v1[1] * v1[1]) + (v1[2] * v1[2] + v1[3] * v1[3]); }
            ss += xsw<16>(ss); ss = sum32(ss);
            if (fq == 0) ssp[(size_t)row * 16 + u.pn * 4 + wc] = ss;
            asm volatile("" ::: "memory");
            if (g + 2 < 8) { EPR_LOAD(g + 2, g & 1); asm volatile("" ::: "memory"); }
        }
#undef EPR_LOAD
    }
};

template <class Epi, class Sched, bool ALIGN_EPI = false, bool SP2 = false>
__device__ __forceinline__ void gemm_phase(PG8_LAS unsigned char* lds, const Gemm g, const Sched& S, const Epi& E, int wave_in) {
    int tid_ = threadIdx.x; asm volatile("" : "+v"(tid_));
    const int tid = tid_, wid = __builtin_amdgcn_readfirstlane(tid >> 6), lane = tid & 63, wr = wid >> 2, wc = wid & 3, fr = lane & 15, fq = lane >> 4;
    const int K = g.K, nt = K / BK;
    unsigned voffA[2], voffB[2];
#pragma unroll
    for (int i = 0; i < 2; ++i) { int R, C; stage_rc(tid * 16 + i * 8192, R, C); const int Rb = Epi::PERM ? ((R & ~31) + perm32(R & 31)) : R;
        voffA[i] = (unsigned)(R * K + C) * 2u; voffB[i] = (unsigned)(Rb * K + C) * 2u; }
    const size_t kstep = (size_t)(BK * 2);
    const size_t hstep = (size_t)HALF * K * 2;
    const size_t tstep = 2 * hstep;
    const unsigned ldsw = (unsigned)wid * 1024u;
    const int aoff = lds_byte(wr * 64 + fr, fq * 8), boff = lds_byte(wc * 32 + fr, fq * 8);
#define PG8_SA(b, h) (((b) * 2 + (h)) * HTB)
#define PG8_SB(b, h) ((4 + (b) * 2 + (h)) * HTB)
#define PG8_STAGE(bufoff, gbase, voff) do { _Pragma("unroll") for (int _i = 0; _i < 2; ++_i) \
        __builtin_amdgcn_global_load_lds((const unsigned*)((const char*)(gbase) + (voff)[_i]), (PG8_LAS unsigned*)(lds + (bufoff) + ldsw + _i * 8192), 16, 0, 0); } while (0)
#define PG8_LDA(dst, b, h) do { _Pragma("unroll") for (int m = 0; m < 4; ++m) _Pragma("unroll") for (int k = 0; k < 2; ++k) dst[m][k] = *(const PG8_LAS bf16x8*)(lds + PG8_SA(b, h) + aoff + m * 2048 + k * 1024); } while (0)
#define PG8_LDB(dst, b, h) do { _Pragma("unroll") for (int n = 0; n < 2; ++n) _Pragma("unroll") for (int k = 0; k < 2; ++k) dst[n][k] = *(const PG8_LAS bf16x8*)(lds + PG8_SB(b, h) + boff + n * 2048 + k * 1024); } while (0)
#define PG8_MMA(ai, bj, At, Bt) do { __builtin_amdgcn_s_setprio(1); _Pragma("unroll") for (int m = 0; m < 4; ++m) _Pragma("unroll") for (int n = 0; n < 2; ++n) _Pragma("unroll") for (int k = 0; k < 2; ++k) \
        acc[ai][bj][m][n] = __builtin_amdgcn_mfma_f32_16x16x32_bf16(Bt[n][k], At[m][k], acc[ai][bj][m][n], 0, 0, 0); __builtin_amdgcn_s_setprio(0); } while (0)
#define PG8_WAIT_V(n) asm volatile("s_waitcnt vmcnt(" #n ")" ::: "memory")
#define PG8_WAIT_L(n) asm volatile("s_waitcnt lgkmcnt(" #n ")" ::: "memory")
#define PG8_BAR __builtin_amdgcn_s_barrier()
#define PG8_SCHED __builtin_amdgcn_sched_barrier(0)
    Unit cur, nxt; int ui = 0;
    if (!S.next(0, cur)) return;
    f32x4 acc[2][2][4][2];
#pragma unroll
    for (int a = 0; a < 2; ++a)
#pragma unroll
        for (int b = 0; b < 2; ++b)
#pragma unroll
            for (int m = 0; m < 4; ++m)
#pragma unroll
                for (int n = 0; n < 2; ++n) acc[a][b][m][n] = (f32x4){0.f, 0.f, 0.f, 0.f};
    bf16x8 At[4][2], B0[2][2], B1[2][2];
    const char* cA = (const char*)g.A + (size_t)cur.pm * tstep; const char* cB = (const char*)g.Bt + (size_t)cur.pn * tstep;
    S.a_ready(cur);
    if constexpr (SP2) {
        PG8_STAGE(PG8_SB(0, 0), cB, voffB); PG8_STAGE(PG8_SB(0, 1), cB + hstep, voffB); PG8_STAGE(PG8_SA(0, 0), cA, voffA); PG8_STAGE(PG8_SA(0, 1), cA + hstep, voffA);
        if (wr == 1) PG8_BAR;
        PG8_WAIT_V(2); PG8_BAR;
        PG8_STAGE(PG8_SB(1, 0), cB + kstep, voffB); PG8_STAGE(PG8_SA(1, 0), cA + kstep, voffA); PG8_STAGE(PG8_SB(1, 1), cB + hstep + kstep, voffB);
        PG8_WAIT_V(6); PG8_BAR;
    } else {
        PG8_STAGE(PG8_SB(0, 0), cB, voffB); PG8_STAGE(PG8_SA(0, 0), cA, voffA); PG8_STAGE(PG8_SB(0, 1), cB + hstep, voffB); PG8_STAGE(PG8_SA(0, 1), cA + hstep, voffA);
        if (wr == 1) PG8_BAR;
        PG8_WAIT_V(4); PG8_BAR;
        PG8_STAGE(PG8_SB(1, 0), cB + kstep, voffB); PG8_STAGE(PG8_SA(1, 0), cA + kstep, voffA); PG8_STAGE(PG8_SB(1, 1), cB + hstep + kstep, voffB);
        PG8_WAIT_V(6); PG8_BAR;
    }
    for (;;) {
        const bool has_next = S.next(ui + 1, nxt);
        const char* nA = has_next ? (const char*)g.A + (size_t)nxt.pm * tstep : cA; const char* nB = has_next ? (const char*)g.Bt + (size_t)nxt.pn * tstep : cB;
        for (int t = 0; t < nt; t += 2) {
            const bool last = (t == nt - 2);
            const char* a1 = cA + (size_t)(t + 1) * kstep;
            const char* a2 = last ? nA : cA + (size_t)(t + 2) * kstep; const char* b2 = last ? nB : cB + (size_t)(t + 2) * kstep;
            const char* a3 = a2 + kstep; const char* b3 = b2 + kstep;
            if (last && has_next) S.a_ready(nxt);
            if constexpr (SP2) {
            PG8_LDB(B0, 0, 0); PG8_LDB(B1, 0, 1); PG8_SCHED; PG8_LDA(At, 0, 0); PG8_STAGE(PG8_SA(1, 1), a1 + hstep, voffA);
            PG8_WAIT_V(8); PG8_WAIT_L(0); PG8_BAR; PG8_MMA(0, 0, At, B0); PG8_MMA(0, 1, At, B1); PG8_BAR; PG8_SCHED;
            PG8_LDA(At, 0, 1); PG8_STAGE(PG8_SB(0, 0), b2, voffB); PG8_STAGE(PG8_SB(0, 1), b2 + hstep, voffB); PG8_STAGE(PG8_SA(0, 0), a2, voffA);
            PG8_WAIT_V(8); PG8_WAIT_L(0); PG8_BAR; PG8_MMA(1, 0, At, B0); PG8_MMA(1, 1, At, B1); PG8_BAR; PG8_SCHED;
            PG8_LDB(B0, 1, 0); PG8_LDB(B1, 1, 1); PG8_SCHED; PG8_LDA(At, 1, 0); PG8_STAGE(PG8_SA(0, 1), a2 + hstep, voffA);
            PG8_WAIT_V(8); PG8_WAIT_L(0); PG8_BAR; PG8_MMA(0, 0, At, B0); PG8_MMA(0, 1, At, B1); PG8_BAR; PG8_SCHED;
            PG8_LDA(At, 1, 1); PG8_STAGE(PG8_SB(1, 0), b3, voffB); PG8_STAGE(PG8_SB(1, 1), b3 + hstep, voffB); PG8_STAGE(PG8_SA(1, 0), a3, voffA);
            PG8_WAIT_V(8); PG8_WAIT_L(0); PG8_BAR; PG8_MMA(1, 0, At, B0); PG8_MMA(1, 1, At, B1); PG8_BAR; PG8_SCHED;
            } else {
            PG8_LDB(B0, 0, 0); PG8_SCHED; PG8_LDA(At, 0, 0); PG8_STAGE(PG8_SA(1, 1), a1 + hstep, voffA);
            PG8_WAIT_L(8); PG8_BAR; PG8_WAIT_L(0); PG8_MMA(0, 0, At, B0); PG8_BAR; PG8_SCHED;
            PG8_LDB(B1, 0, 1); PG8_STAGE(PG8_SB(0, 0), b2, voffB);
            PG8_BAR; PG8_WAIT_L(0); PG8_MMA(0, 1, At, B1); PG8_BAR;
            PG8_LDA(At, 0, 1); PG8_STAGE(PG8_SA(0, 0), a2, voffA);
            PG8_BAR; PG8_WAIT_L(0); PG8_MMA(1, 0, At, B0); PG8_BAR; PG8_SCHED;
            PG8_STAGE(PG8_SB(0, 1), b2 + hstep, voffB);
            PG8_WAIT_V(6); PG8_BAR; PG8_MMA(1, 1, At, B1); PG8_BAR;
            PG8_LDB(B0, 1, 0); PG8_SCHED; PG8_LDA(At, 1, 0); PG8_STAGE(PG8_SA(0, 1), a2 + hstep, voffA);
            PG8_WAIT_L(8); PG8_BAR; PG8_WAIT_L(0); PG8_MMA(0, 0, At, B0); PG8_BAR; PG8_SCHED;
            PG8_LDB(B1, 1, 1); PG8_STAGE(PG8_SB(1, 0), b3, voffB);
            PG8_BAR; PG8_WAIT_L(0); PG8_MMA(0, 1, At, B1); PG8_BAR;
            PG8_LDA(At, 1, 1); PG8_STAGE(PG8_SA(1, 0), a3, voffA);
            PG8_BAR; PG8_WAIT_L(0); PG8_MMA(1, 0, At, B0); PG8_BAR; PG8_SCHED;
            PG8_STAGE(PG8_SB(1, 1), b3 + hstep, voffB);
            PG8_WAIT_V(6); PG8_BAR; PG8_MMA(1, 1, At, B1); PG8_BAR;
            }
        }
        if constexpr (ALIGN_EPI) { if (wr == 0) PG8_BAR; }
        if constexpr (!Epi::AFTER_DRAIN) { if (!Sched::TWICE || (ui & 1)) { E(acc, cur, wr, wc, fr, fq); S.done(cur); } }
        if (!has_next) break;
#pragma unroll
        for (int a = 0; a < 2; ++a)
#pragma unroll
            for (int b = 0; b < 2; ++b)
#pragma unroll
                for (int m = 0; m < 4; ++m)
#pragma unroll
                    for (int n = 0; n < 2; ++n) acc[a][b][m][n] = (f32x4){0.f, 0.f, 0.f, 0.f};
        cur = nxt; cA = nA; cB = nB; ++ui;
        if constexpr (ALIGN_EPI) { if (wr == 1) PG8_BAR; }
    }
    PG8_WAIT_V(0);
    if constexpr (!ALIGN_EPI) { if (wr == 0) PG8_BAR; }
    PG8_BAR;
    if constexpr (Epi::AFTER_DRAIN) { E.fused(acc, cur, wr, wc, fr, fq, lds, wid, lane); S.done(cur); }
#undef PG8_SA
#undef PG8_SB
#undef PG8_STAGE
#undef PG8_LDA
#undef PG8_LDB
#undef PG8_MMA
#undef PG8_WAIT_V
#undef PG8_WAIT_L
#undef PG8_BAR
#undef PG8_SCHED
}
}

constexpr int NWAVES = 8, NTHREADS = NWAVES * 64;
constexpr int BATCH = 8, SEQ = 4096, D = 1024, M = BATCH * SEQ, FF = 2816, DEPTH = 4;
constexpr int EVEN_IN = 3584, GLA_IN = 3088, GLA_INP = 3328;
static_assert(M == pg8::MROWS, "row count");
constexpr int E_RQ = 0, E_RK = 512, E_RV = 1024, E_RG = 1536, E_DQ = 2048, E_DK = 2560, E_DV = 3072;
constexpr int G_Q = 0, G_K = 512, G_V = 1024, G_R = 2048, G_A = 3072;
constexpr float EPS = 1e-6f;

constexpr size_t MiB = 1u << 20;
constexpr size_t WS_CTL = 0, CTL_ZERO_BYTES = 1 * MiB;
constexpr size_t WS_SSP = 1 * MiB;
constexpr size_t WS_TAB = 3 * MiB;
constexpr size_t TAB_RC = WS_TAB, TAB_RS = WS_TAB + 1 * MiB, TAB_DC = WS_TAB + 2 * MiB, TAB_DS = WS_TAB + 2 * MiB + 128 * 1024;
constexpr size_t WS_W = 8 * MiB;
constexpr size_t W_GU0 = WS_W, W_D0 = W_GU0 + (size_t)2 * FF * D * 2, W_GU1 = W_D0 + (size_t)D * FF * 2, W_D1 = W_GU1 + (size_t)2 * FF * D * 2,
                 W_IN = W_D1 + (size_t)D * FF * 2, W_OUT = W_IN + (size_t)EVEN_IN * D * 2, W_END = W_OUT + (size_t)D * D * 2;
constexpr size_t WS_XB = 56 * MiB;
constexpr size_t WS_ACT = 120 * MiB;
constexpr size_t WS_CAT = 344 * MiB;
constexpr size_t WS_END = 408 * MiB;
static_assert(W_END <= WS_XB && WS_XB + (size_t)M * D * 2 <= WS_ACT && WS_ACT + (size_t)M * EVEN_IN * 2 <= WS_CAT && WS_CAT + (size_t)M * D * 2 <= WS_END, "d_ws map");
constexpr int CW_BAR = 4096;

constexpr int RING_OFF = 0, RING_BYTES = 131072;
constexpr int LDSCTL_OFF = 161792, MISC_OFF = LDSCTL_OFF + 320, PTR_OFF = LDSCTL_OFF + 1024;
constexpr int LDS_BYTES = 163840;
static_assert(PTR_OFF + 19 * 8 <= LDS_BYTES && RING_BYTES <= LDSCTL_OFF, "LDS map");

#define GAS __attribute__((address_space(1)))
#define LAS __attribute__((address_space(3)))
typedef unsigned short bf16;
typedef unsigned v4u __attribute__((ext_vector_type(4)));
typedef float f32x4 __attribute__((ext_vector_type(4)));
typedef short bf16x8 __attribute__((ext_vector_type(8)));
typedef GAS unsigned gu32;
typedef GAS unsigned long long gu64;
#define RLX_AGENT __ATOMIC_RELAXED, __HIP_MEMORY_SCOPE_AGENT
#define LDS_WAIT() asm volatile("s_waitcnt lgkmcnt(0)" ::: "memory")
#define VM_WAIT() asm volatile("s_waitcnt vmcnt(0)" ::: "memory")
__device__ __forceinline__ unsigned long long rt() { return __builtin_amdgcn_s_memrealtime(); }
__device__ __forceinline__ unsigned f2bf(float f) { unsigned u = __builtin_bit_cast(unsigned, f); return (u + 0x7fffu + ((u >> 16) & 1u)) >> 16; }
__device__ __forceinline__ unsigned pk2(float lo, float hi) { return f2bf(lo) | (f2bf(hi) << 16); }

#define XB_TMO      128
#define XB_XCNT(j)  (256  + 64 * (j))
#define XB_XSUB(j)  (1280 + 64 * (j))
#define XB_XGEN(j)  (2304 + 64 * (j))
#define XB_TOP      3328
#define XB_TOPGEN   3392
#define XCD_BAR_WORDS 3456
#define XB_SPIN_CAP (1u << 18)

__device__ __forceinline__ unsigned xb_ld(unsigned* p)              { return __hip_atomic_load(p, __ATOMIC_RELAXED, __HIP_MEMORY_SCOPE_AGENT); }
__device__ __forceinline__ unsigned xb_add(unsigned* p, unsigned v) { return __hip_atomic_fetch_add(p, v, __ATOMIC_RELAXED, __HIP_MEMORY_SCOPE_AGENT); }
__device__ __forceinline__ unsigned xb_xcc_id() { return (unsigned)__builtin_amdgcn_s_getreg((3 << 11) | 20) & 0xFu; }
#define XB_SPIN(cond, bar) do { unsigned _sp = 0; while (cond) { __builtin_amdgcn_s_sleep(1); \
    if ((++_sp & 255u) == 0u) { if (xb_ld(&(bar)[XB_TMO])) break; if (_sp > XB_SPIN_CAP) { atomicAdd(&(bar)[XB_TMO], 1u); break; } } } } while (0)

struct XcdBarrier {
    unsigned* bar; unsigned x;
    volatile LAS unsigned* st;
};

__device__ __forceinline__ XcdBarrier xcd_barrier_post(unsigned* bar, volatile LAS unsigned* st, int tid) {
    XcdBarrier b; b.bar = bar; b.x = xb_xcc_id(); b.st = st;
    if (tid == 0) (void)xb_add(&bar[XB_XCNT(b.x)], 1u);
    return b;
}
__device__ __forceinline__ void xcd_barrier_complete(unsigned* bar, unsigned x, unsigned& nloc, unsigned& nx) {
    const unsigned G = gridDim.x * gridDim.y * gridDim.z;
    unsigned sum, cnt, mine, sp = 0u;
    for (;;) {
        sum = 0u; cnt = 0u; mine = 0u;
#pragma unroll
        for (unsigned j = 0; j < 16; ++j) { const unsigned c = xb_ld(&bar[XB_XCNT(j)]); sum += c; cnt += (c > 0u) ? 1u : 0u; mine = (j == x) ? c : mine; }
        if (sum == G) break;
        __builtin_amdgcn_s_sleep(1);
        if ((++sp & 255u) == 0u) { if (xb_ld(&bar[XB_TMO])) break; if (sp > XB_SPIN_CAP) { atomicAdd(&bar[XB_TMO], 1u); break; } }
    }
    nloc = mine > 0u ? mine : 1u; nx = cnt > 0u ? cnt : 1u;
}

__device__ __forceinline__ void xcd_barrier(const XcdBarrier& b, int tid) {
    asm volatile("s_waitcnt vmcnt(0)" ::: "memory");
    __syncthreads();
    if (tid == 0) {
        unsigned* bar = b.bar;
        __builtin_amdgcn_s_waitcnt(0);
        unsigned nloc = b.st[0], nx = b.st[1];
        if (nloc == 0u) { xcd_barrier_complete(bar, b.x, nloc, nx); b.st[0] = nloc; b.st[1] = nx; }
        const unsigned old = xb_add(&bar[XB_XSUB(b.x)], 1u);
        const unsigned gen = old / nloc;
        if (old + 1u == (gen + 1u) * nloc) {
            __builtin_amdgcn_fence(__ATOMIC_RELEASE, "agent");
            asm volatile("s_waitcnt vmcnt(0)" ::: "memory");
            const unsigned og = xb_add(&bar[XB_TOP], 1u);
            const unsigned tg = og / nx;
            if (og + 1u == (tg + 1u) * nx) xb_add(&bar[XB_TOPGEN], 1u);
            else XB_SPIN(xb_ld(&bar[XB_TOPGEN]) == tg, bar);
            __builtin_amdgcn_fence(__ATOMIC_ACQUIRE, "agent");
            xb_add(&bar[XB_XGEN(b.x)], 1u);
            asm volatile("s_waitcnt vmcnt(0)" ::: "memory");
        } else {
            XB_SPIN(xb_ld(&bar[XB_XGEN(b.x)]) == gen, bar);
            __builtin_amdgcn_fence(__ATOMIC_ACQUIRE, "agent");
            asm volatile("s_waitcnt vmcnt(0)" ::: "memory");
        }
    }
    __syncthreads();
}

__constant__ float RET_FREQ[64] = {1.000000000e+00f, 8.639884591e-01f, 7.464760542e-01f, 6.449466944e-01f, 5.572264791e-01f, 4.814372361e-01f, 4.159561992e-01f, 3.593813777e-01f, 3.105013371e-01f, 2.682695687e-01f, 2.317818105e-01f, 2.002568096e-01f, 1.730195731e-01f, 1.494869143e-01f, 1.291549653e-01f, 1.115883961e-01f, 9.641107172e-02f, 8.329805732e-02f, 7.196855545e-02f, 6.218000501e-02f, 5.372280627e-02f, 4.641588405e-02f, 4.010278732e-02f, 3.464834765e-02f, 2.993577160e-02f, 2.586415969e-02f, 2.234633639e-02f, 1.930697635e-02f, 1.668100432e-02f, 1.441219542e-02f, 1.245197095e-02f, 1.075835899e-02f, 9.295095690e-03f, 8.030855097e-03f, 6.938565988e-03f, 5.994840991e-03f, 5.179473665e-03f, 4.475005437e-03f, 3.866352839e-03f, 3.340484342e-03f, 2.886139788e-03f, 2.493591513e-03f, 2.154434333e-03f, 1.861406374e-03f, 1.608233666e-03f, 1.389495330e-03f, 1.200507861e-03f, 1.037224894e-03f, 8.961503627e-04f, 7.742635789e-04f, 6.689548027e-04f, 5.779692437e-04f, 4.993587499e-04f, 4.314401885e-04f, 3.727593285e-04f, 3.220597573e-04f, 2.782559313e-04f, 2.404099068e-04f, 2.077113895e-04f, 1.794602431e-04f, 1.550515735e-04f, 1.339627634e-04f, 1.157422885e-04f, 9.999999747e-05f};
__constant__ float ROPE_FREQ[8] = {1.000000000e+00f, 1.939227432e-01f, 3.760603070e-02f, 7.292664610e-03f, 1.414213562e-03f, 2.742481884e-04f, 5.318295734e-05f, 1.031338525e-05f};
struct Args { const float* in[17]; float* out; unsigned char* ws; };
enum { I_X = 0, I_PRE_NORM = 1, I_PRE_WG = 2, I_PRE_WU = 3, I_PRE_WD = 4, I_MIX_NORM = 5, I_AB_IN = 6, I_AB_OUT = 7, I_GLA_IN = 8, I_GLA_A2 = 9, I_GLA_BA = 10, I_GLA_OUT = 11,
       I_POST_NORM = 12, I_POST_WG = 13, I_POST_WU = 14, I_POST_WD = 15, I_FINAL = 16, I_OUT = 17, I_WS = 18, N_PTRS = 19 };
struct Frame {
    LAS unsigned char* lds;
    int tid, lane, wave, G, bid;
};
__device__ __forceinline__ unsigned char* tabp(const Frame& F, int idx) {
    int off_ = PTR_OFF + 8 * idx; asm volatile("" : "+s"(off_));
    const volatile LAS unsigned* T = (const volatile LAS unsigned*)(F.lds + off_);
    const unsigned lo = __builtin_amdgcn_readfirstlane(T[0]), hi = __builtin_amdgcn_readfirstlane(T[1]);
    GAS unsigned char* gp_ = (GAS unsigned char*)(((unsigned long long)hi << 32) | (unsigned long long)lo);
    return (unsigned char*)gp_;
}
#define AP(idx) ((const float*)tabp(F, idx))
#define WSP() tabp(F, I_WS)
#define OUTP() ((float*)tabp(F, I_OUT))
__device__ __forceinline__ int lnd(int v) { asm volatile("" : "+s"(v)); return v; }
__device__ __forceinline__ int hw_lane() { return (int)__builtin_amdgcn_mbcnt_hi(~0u, __builtin_amdgcn_mbcnt_lo(~0u, 0u)); }
__device__ __forceinline__ Frame relaunder(const Frame& F0) { Frame F = F0; int t_ = threadIdx.x; asm volatile("" : "+v"(t_)); asm volatile("" : "+s"(F.bid)); F.tid = t_; F.lane = F.tid & 63; F.wave = __builtin_amdgcn_readfirstlane(F.tid >> 6);
    unsigned lb_ = 0u; asm volatile("" : "+s"(lb_)); F.lds = F0.lds + lb_; return F; }
__device__ __forceinline__ float wave_sum(float v) {
    v += xsw<1>(v); v += xsw<2>(v); v += xsw<4>(v); v += xsw<8>(v); v += xsw<16>(v);
    return sum32(v);
}
__device__ __forceinline__ float bf2f(bf16 h) { return __builtin_bit_cast(float, (unsigned)h << 16); }
__device__ __forceinline__ float bflo(unsigned w) { return __builtin_bit_cast(float, w << 16); }
__device__ __forceinline__ float bfhi(unsigned w) { return __builtin_bit_cast(float, w & 0xffff0000u); }
__device__ __forceinline__ bf16 f2bf_rne(float f) { return (bf16)f2bf(f); }

__device__ __forceinline__ void tr_item(const float* W, int K, int N, int Npad, const float* gain, bf16* WT, int gu, LAS float* scr, int item, int lane) {
    const int nblk = Npad / 32, kb = item / nblk, nb = item % nblk, k0 = 64 * kb, n0 = 32 * nb;
    {
        const int c4 = lane & 7; const bool ok = n0 + 4 * c4 < N;
        const GAS float* src = (const GAS float*)W + (size_t)(k0 + (lane >> 3)) * N + n0 + 4 * c4;
        f32x4 v[8];
#pragma unroll
        for (int i = 0; i < 8; ++i) v[i] = ok ? *(const GAS f32x4*)(src + (size_t)(8 * i) * N) : (f32x4){0.f, 0.f, 0.f, 0.f};
#pragma unroll
        for (int i = 0; i < 8; ++i) { const int kk = 8 * i + (lane >> 3); const float gn = gain ? ((const GAS float*)gain)[k0 + kk] : 1.0f; LAS float* s = scr + kk * 33 + 4 * c4;
            s[0] = v[i][0] * gn; s[1] = v[i][1] * gn; s[2] = v[i][2] * gn; s[3] = v[i][3] * gn; }
    }
    LDS_WAIT(); asm volatile("" ::: "memory");
    const int c = lane & 7;
#pragma unroll
    for (int j = 0; j < 4; ++j) { const int n = (lane >> 3) + 8 * j; const LAS float* s = scr + (8 * c) * 33 + n;
        v4u o; o.x = pk2(s[0 * 33], s[1 * 33]); o.y = pk2(s[2 * 33], s[3 * 33]); o.z = pk2(s[4 * 33], s[5 * 33]); o.w = pk2(s[6 * 33], s[7 * 33]);
        int drow = n0 + n;
        if (gu == 3) {
            if (drow < 1024) { const int j = drow & 127; drow = (drow & ~127) + (j < 64 ? 2 * j : 2 * (j - 64) + 1); }
            else if (drow >= 2048 && drow < 3072) { const int j = drow & 63; drow = (drow & ~63) + (j < 8 ? 2 * j : (j < 16 ? 2 * (j - 8) + 1 : j)); }
        } else if (gu) drow = (drow >> 7) * 256 + (drow & 127) + (gu == 2 ? 128 : 0);
        *(GAS v4u*)(WT + (size_t)drow * K + k0 + 8 * c) = o; }
    LDS_WAIT(); asm volatile("" ::: "memory");
}
__device__ __forceinline__ void convert_weights(const Frame& F0, int l) {
    const Frame F = relaunder(F0);
    LAS float* scr = (LAS float*)(F.lds + RING_OFF + F.wave * 16384);
    const int gw = F.bid * NWAVES + F.wave, NGW = F.G * NWAVES;
    unsigned char* ws = WSP();
    constexpr int I_G = (D / 64) * (FF / 32), I_DN = (FF / 64) * (D / 32), I_O = (D / 64) * (D / 32);
    const bool odd = (l & 1) != 0; const int li = l >> 1;
    const int nin = odd ? GLA_IN : EVEN_IN, ninp = odd ? GLA_INP : EVEN_IN; const int I_IN = (D / 64) * (ninp / 32);
    const float* win = odd ? AP(I_GLA_IN) + (size_t)li * D * GLA_IN : AP(I_AB_IN) + (size_t)li * D * EVEN_IN;
    const float* wout = odd ? AP(I_GLA_OUT) + (size_t)li * D * D : AP(I_AB_OUT) + (size_t)li * D * D;
    const size_t fo = (size_t)l * D * FF;
    const int NITEMS = 6 * I_G + I_IN + I_O;
    static_assert(I_G == I_DN, "item counts");
    for (int it = gw; it < NITEMS; it += NGW) {
        int r = it;
        if (r < I_G) { tr_item(AP(I_PRE_WG) + fo, D, FF, FF, AP(I_PRE_NORM) + l * D, (bf16*)(ws + W_GU0), 1, scr, r, F.lane); continue; } r -= I_G;
        if (r < I_G) { tr_item(AP(I_PRE_WU) + fo, D, FF, FF, AP(I_PRE_NORM) + l * D, (bf16*)(ws + W_GU0), 2, scr, r, F.lane); continue; } r -= I_G;
        if (r < I_G) { tr_item(AP(I_PRE_WD) + fo, FF, D, D, nullptr, (bf16*)(ws + W_D0), 0, scr, r, F.lane); continue; } r -= I_G;
        if (r < I_G) { tr_item(AP(I_POST_WG) + fo, D, FF, FF, AP(I_POST_NORM) + l * D, (bf16*)(ws + W_GU1), 1, scr, r, F.lane); continue; } r -= I_G;
        if (r < I_G) { tr_item(AP(I_POST_WU) + fo, D, FF, FF, AP(I_POST_NORM) + l * D, (bf16*)(ws + W_GU1), 2, scr, r, F.lane); continue; } r -= I_G;
        if (r < I_G) { tr_item(AP(I_POST_WD) + fo, FF, D, D, nullptr, (bf16*)(ws + W_D1), 0, scr, r, F.lane); continue; } r -= I_G;
        if (r < I_IN) { tr_item(win, D, nin, ninp, AP(I_MIX_NORM) + l * D, (bf16*)(ws + W_IN), odd ? 0 : 3, scr, r, F.lane); continue; } r -= I_IN;
        tr_item(wout, D, D, D, nullptr, (bf16*)(ws + W_OUT), 0, scr, r, F.lane);
    }
}
__device__ __forceinline__ void prologue_rows(const Frame& F0) {
    const Frame F = relaunder(F0);
    unsigned char* ws = WSP();
    const int gw = F.bid * NWAVES + F.wave, NGW = F.G * NWAVES;
    bf16* XB = (bf16*)(ws + WS_XB); float* ssp = (float*)(ws + WS_SSP);
    for (int m = gw; m < M; m += NGW) {
        const GAS f32x4* xr = (const GAS f32x4*)(AP(I_X) + (size_t)m * D) + F.lane;
        GAS unsigned long long* o8 = (GAS unsigned long long*)(XB + (size_t)m * D) + F.lane;
        float s = 0.f;
#pragma unroll
        for (int j = 0; j < 4; ++j) { const f32x4 v = xr[64 * j]; s += (v.x * v.x + v.y * v.y) + (v.z * v.z + v.w * v.w);
            o8[64 * j] = (unsigned long long)pk2(v.x, v.y) | ((unsigned long long)pk2(v.z, v.w) << 32); }
        s = wave_sum(s);
        if (F.lane < 16) ssp[(size_t)m * 16 + F.lane] = (F.lane == 0) ? s : 0.f;
    }
    const int gt = F.bid * NTHREADS + F.tid, NGT = F.G * NTHREADS;
    float* rc = (float*)(ws + TAB_RC); float* rsn = (float*)(ws + TAB_RS); float* dc = (float*)(ws + TAB_DC); float* ds = (float*)(ws + TAB_DS);
    for (int e = gt; e < SEQ * 64; e += NGT) { const int t = e >> 6, i = e & 63; const float ang = (float)t * RET_FREQ[i];
        double rev = (double)ang * 0.15915494309189535; rev -= __builtin_rint(rev); const float r = (float)rev;
        rc[e] = __builtin_amdgcn_cosf(r); rsn[e] = __builtin_amdgcn_sinf(r); }
    for (int e = gt; e < SEQ * 8; e += NGT) { const int t = e >> 3, i = e & 7; const float ang = (float)t * ROPE_FREQ[i];
        double rev = (double)ang * 0.15915494309189535; rev -= __builtin_rint(rev); const float r = (float)rev;
        dc[e] = __builtin_amdgcn_cosf(r); ds[e] = __builtin_amdgcn_sinf(r); }
}

__device__ __forceinline__ void even_prep(const Frame& F0) {
    const Frame F = relaunder(F0);
    unsigned char* ws = WSP();
    const int gw = F.bid * NWAVES + F.wave, NGW = F.G * NWAVES;
    bf16* P = (bf16*)(ws + WS_ACT);
    const float* rc = (const float*)(ws + TAB_RC); const float* rsn = (const float*)(ws + TAB_RS); const float* dc = (const float*)(ws + TAB_DC); const float* ds = (const float*)(ws + TAB_DS);
    for (int m = gw; m < M; m += NGW) {
        const int pos = m & (SEQ - 1); bf16* row = P + (size_t)m * EVEN_IN;
        const float c = rc[pos * 64 + F.lane], s = rsn[pos * 64 + F.lane];
#pragma unroll
        for (int h = 0; h < 4; ++h) {
            { bf16* p1 = row + E_RQ + h * 128 + F.lane; bf16* p2 = p1 + 64; const float x1 = bf2f(*p1), x2 = bf2f(*p2); *p1 = f2bf_rne(x1 * c - x2 * s); *p2 = f2bf_rne(x2 * c + x1 * s); }
            { bf16* p1 = row + E_RK + h * 128 + F.lane; bf16* p2 = p1 + 64; const float x1 = bf2f(*p1), x2 = bf2f(*p2);
              *p1 = f2bf_rne((x1 * c - x2 * s) * 0.08838834764831845f); *p2 = f2bf_rne((x2 * c + x1 * s) * 0.08838834764831845f); }
        }
        { const int h = F.lane >> 3, i = F.lane & 7; const float c2 = dc[pos * 8 + i], s2 = ds[pos * 8 + i];
          { bf16* p1 = row + E_DQ + h * 64 + i; bf16* p2 = p1 + 8; const float x1 = bf2f(*p1), x2 = bf2f(*p2); *p1 = f2bf_rne(x1 * c2 - x2 * s2); *p2 = f2bf_rne(x2 * c2 + x1 * s2); }
          { bf16* p1 = row + E_DK + h * 64 + i; bf16* p2 = p1 + 8; const float x1 = bf2f(*p1), x2 = bf2f(*p2); *p1 = f2bf_rne(x1 * c2 - x2 * s2); *p2 = f2bf_rne(x2 * c2 + x1 * s2); } }
    }
}
__device__ __forceinline__ void even_core(const Frame& F0) {
    const Frame F = relaunder(F0);
    unsigned char* ws = WSP();
    const bf16* P = (const bf16*)(ws + WS_ACT);
    if (F.bid < 128) {
        const int b = F.bid >> 4, h = (F.bid >> 2) & 3, eg = F.bid & 3, e = eg * 32 + (F.tid >> 4), dq = F.tid & 15;
        const float g = 1.0f - exp2f(-5.0f - (float)h);
        float* oraw = (float*)(ws + WS_XB);
        const bf16* base = P + (size_t)b * SEQ * EVEN_IN;
        float S[8];
#pragma unroll
        for (int i = 0; i < 8; ++i) S[i] = 0.f;
        v4u qn = *(const GAS v4u*)(base + E_RQ + h * 128 + dq * 8), kn = *(const GAS v4u*)(base + E_RK + h * 128 + dq * 8); bf16 vn = base[E_RV + h * 128 + e];
        for (int t = 0; t < SEQ; ++t) {
            const v4u q = qn, k = kn; const float v = bf2f(vn);
            if (t + 1 < SEQ) { const bf16* nb = base + (size_t)(t + 1) * EVEN_IN; qn = *(const GAS v4u*)(nb + E_RQ + h * 128 + dq * 8); kn = *(const GAS v4u*)(nb + E_RK + h * 128 + dq * 8); vn = nb[E_RV + h * 128 + e]; }
            float o = 0.f;
#pragma unroll
            for (int i = 0; i < 4; ++i) { const unsigned qw = q[i], kw = k[i];
                S[2 * i] = g * S[2 * i] + bflo(kw) * v; S[2 * i + 1] = g * S[2 * i + 1] + bfhi(kw) * v;
                o += bflo(qw) * S[2 * i]; o += bfhi(qw) * S[2 * i + 1]; }
            o += xsw<1>(o); o += xsw<2>(o); o += xsw<4>(o); o += xsw<8>(o);
            if (dq == 0) oraw[((size_t)b * SEQ + t) * 512 + h * 128 + e] = o;
        }
    } else {
        bf16* CAT = (bf16*)(ws + WS_CAT);
        for (int it = F.bid - 128; it < BATCH * (SEQ / 64); it += F.G - 128) {
            const int b = it >> 6, t = (it & 63) * 64 + F.lane, h = F.wave;
            const bf16* base = P + (size_t)b * SEQ * EVEN_IN;
            float q[64];
            { const GAS v4u* qp = (const GAS v4u*)(base + (size_t)t * EVEN_IN + E_DQ + h * 64);
#pragma unroll
              for (int j = 0; j < 8; ++j) { const v4u w = qp[j];
#pragma unroll
                  for (int i = 0; i < 4; ++i) { q[8 * j + 2 * i] = bflo(w[i]) * (0.125f * 1.4426950408889634f); q[8 * j + 2 * i + 1] = bfhi(w[i]) * (0.125f * 1.4426950408889634f); } } }
            float o[64];
#pragma unroll
            for (int i = 0; i < 64; ++i) o[i] = 0.f;
            float mx = -INFINITY, l = 0.f;
            for (int p = 0; p < 3; ++p) {
                const int dil = (p == 0) ? 1 : (p == 1) ? 4 : 16;
                for (int j = 0; j <= 128; ++j) {
                    const int tk = t - j * dil;
                    if (tk >= 0) {
                        const GAS v4u* kp = (const GAS v4u*)(base + (size_t)tk * EVEN_IN + E_DK + h * 64);
                        const GAS v4u* vp = (const GAS v4u*)(base + (size_t)tk * EVEN_IN + E_DV + h * 64);
                        float s = 0.f;
#pragma unroll
                        for (int jj = 0; jj < 8; ++jj) { const v4u w = kp[jj];
#pragma unroll
                            for (int i = 0; i < 4; ++i) { s += q[8 * jj + 2 * i] * bflo(w[i]); s += q[8 * jj + 2 * i + 1] * bfhi(w[i]); } }
                        const float mn = fmaxf(mx, s), corr = __builtin_amdgcn_exp2f(mx - mn), pe = __builtin_amdgcn_exp2f(s - mn);
                        l = l * corr + pe; mx = mn;
#pragma unroll
                        for (int jj = 0; jj < 8; ++jj) { const v4u w = vp[jj];
#pragma unroll
                            for (int i = 0; i < 4; ++i) { o[8 * jj + 2 * i] = o[8 * jj + 2 * i] * corr + pe * bflo(w[i]); o[8 * jj + 2 * i + 1] = o[8 * jj + 2 * i + 1] * corr + pe * bfhi(w[i]); } }
                    }
                }
            }
            const float rl = 1.0f / l;
            GAS v4u* op = (GAS v4u*)(CAT + ((size_t)b * SEQ + t) * D + 512 + h * 64);
#pragma unroll
            for (int j = 0; j < 8; ++j) { v4u w; w.x = pk2(o[8 * j] * rl, o[8 * j + 1] * rl); w.y = pk2(o[8 * j + 2] * rl, o[8 * j + 3] * rl); w.z = pk2(o[8 * j + 4] * rl, o[8 * j + 5] * rl); w.w = pk2(o[8 * j + 6] * rl, o[8 * j + 7] * rl); op[j] = w; }
        }
    }
}
__device__ __forceinline__ void even_post(const Frame& F0) {
    const Frame F = relaunder(F0);
    unsigned char* ws = WSP();
    const int gw = F.bid * NWAVES + F.wave, NGW = F.G * NWAVES;
    const bf16* P = (const bf16*)(ws + WS_ACT); const float* oraw = (const float*)(ws + WS_XB); bf16* CAT = (bf16*)(ws + WS_CAT);
    for (int it = gw; it < M * 4; it += NGW) {
        const int m = it >> 2, h = it & 3;
        const float* op = oraw + (size_t)m * 512 + h * 128 + 2 * F.lane; const float o0 = op[0], o1 = op[1];
        const float mu = wave_sum(o0 + o1) * (1.0f / 128.0f); const float d0 = o0 - mu, d1 = o1 - mu;
        const float var = wave_sum(d0 * d0 + d1 * d1) * (1.0f / 128.0f); const float rstd = 1.0f / sqrtf(var + EPS);
        const unsigned gw2 = *(const unsigned*)(P + (size_t)m * EVEN_IN + E_RG + h * 128 + 2 * F.lane); const float g0 = bflo(gw2), g1 = bfhi(gw2);
        const float y0 = d0 * rstd * (g0 / (1.0f + expf(-g0))), y1 = d1 * rstd * (g1 / (1.0f + expf(-g1)));
        *(unsigned*)(CAT + (size_t)m * D + h * 128 + 2 * F.lane) = pk2(y0, y1);
    }
}
__device__ __forceinline__ void gla_prep(const Frame& F0, int li) {
    const Frame F = relaunder(F0);
    unsigned char* ws = WSP();
    const int gt = F.bid * NTHREADS + F.tid, NGT = F.G * NTHREADS;
    const bf16* P = (const bf16*)(ws + WS_ACT); float* A = (float*)(ws + WS_CAT);
    const float* w2 = AP(I_GLA_A2) + (size_t)li * 16 * 512; const float* ba = AP(I_GLA_BA) + (size_t)li * 512;
    for (int e = gt; e < M * 512; e += NGT) {
        const int m = e >> 9, c = e & 511; const bf16* al = P + (size_t)m * GLA_INP + G_A;
        float z = ba[c];
#pragma unroll
        for (int j = 0; j < 16; ++j) z += bf2f(al[j]) * w2[j * 512 + c];
        const float ls = fminf(z, 0.f) - log1pf(expf(-fabsf(z)));
        A[e] = expf(ls * (1.0f / 16.0f));
    }
}
__device__ __forceinline__ void gla_core(const Frame& F0) {
    const Frame F = relaunder(F0);
    unsigned char* ws = WSP();
    const bf16* P = (const bf16*)(ws + WS_ACT); const float* A = (const float*)(ws + WS_CAT); bf16* oraw = (bf16*)(ws + WS_XB);
    const int b = F.bid >> 5, h = (F.bid >> 3) & 3, eg = F.bid & 7, e = eg * 32 + (F.tid >> 4), dq = F.tid & 15;
    const bf16* base = P + (size_t)b * SEQ * GLA_INP; const float* abase = A + (size_t)b * SEQ * 512 + h * 128 + dq * 8;
    float S[8];
#pragma unroll
    for (int i = 0; i < 8; ++i) S[i] = 0.f;
    v4u qn = *(const GAS v4u*)(base + G_Q + h * 128 + dq * 8), kn = *(const GAS v4u*)(base + G_K + h * 128 + dq * 8); bf16 vn = base[G_V + h * 256 + e];
    f32x4 a0n = *(const GAS f32x4*)(abase), a1n = *(const GAS f32x4*)(abase + 4);
    for (int t = 0; t < SEQ; ++t) {
        const v4u q = qn, k = kn; const float v = bf2f(vn); const f32x4 a0 = a0n, a1 = a1n;
        if (t + 1 < SEQ) { const bf16* nb = base + (size_t)(t + 1) * GLA_INP; qn = *(const GAS v4u*)(nb + G_Q + h * 128 + dq * 8); kn = *(const GAS v4u*)(nb + G_K + h * 128 + dq * 8); vn = nb[G_V + h * 256 + e];
            a0n = *(const GAS f32x4*)(abase + (size_t)(t + 1) * 512); a1n = *(const GAS f32x4*)(abase + (size_t)(t + 1) * 512 + 4); }
        float o = 0.f;
#pragma unroll
        for (int i = 0; i < 4; ++i) { const unsigned qw = q[i], kw = k[i]; const float al = (i < 2) ? a0[2 * i] : a1[2 * i - 4], ah = (i < 2) ? a0[2 * i + 1] : a1[2 * i - 3];
            S[2 * i] = al * S[2 * i] + bflo(kw) * v; S[2 * i + 1] = ah * S[2 * i + 1] + bfhi(kw) * v;
            o += bflo(qw) * S[2 * i]; o += bfhi(qw) * S[2 * i + 1]; }
        o += xsw<1>(o); o += xsw<2>(o); o += xsw<4>(o); o += xsw<8>(o);
        if (dq == 0) oraw[((size_t)b * SEQ + t) * 1024 + h * 256 + e] = f2bf_rne(o * 0.08838834764831845f);
    }
}
__device__ __forceinline__ void gla_post(const Frame& F0) {
    const Frame F = relaunder(F0);
    unsigned char* ws = WSP();
    const int gw = F.bid * NWAVES + F.wave, NGW = F.G * NWAVES;
    const bf16* P = (const bf16*)(ws + WS_ACT); const bf16* oraw = (const bf16*)(ws + WS_XB); bf16* CAT = (bf16*)(ws + WS_CAT);
    for (int it = gw; it < M * 4; it += NGW) {
        const int m = it >> 2, h = it & 3;
        const unsigned long long ow = *(const unsigned long long*)(oraw + (size_t)m * 1024 + h * 256 + 4 * F.lane);
        const float o0 = bflo((unsigned)ow), o1 = bfhi((unsigned)ow), o2 = bflo((unsigned)(ow >> 32)), o3 = bfhi((unsigned)(ow >> 32));
        const float mu = wave_sum((o0 + o1) + (o2 + o3)) * (1.0f / 256.0f); const float d0 = o0 - mu, d1 = o1 - mu, d2 = o2 - mu, d3 = o3 - mu;
        const float var = wave_sum((d0 * d0 + d1 * d1) + (d2 * d2 + d3 * d3)) * (1.0f / 256.0f); const float rstd = 1.0f / sqrtf(var + EPS);
        const unsigned long long gw2 = *(const unsigned long long*)(P + (size_t)m * GLA_INP + G_R + h * 256 + 4 * F.lane);
        const float g0 = bflo((unsigned)gw2), g1 = bfhi((unsigned)gw2), g2 = bflo((unsigned)(gw2 >> 32)), g3 = bfhi((unsigned)(gw2 >> 32));
        const float y0 = d0 * rstd * (g0 / (1.0f + expf(-g0))), y1 = d1 * rstd * (g1 / (1.0f + expf(-g1))), y2 = d2 * rstd * (g2 / (1.0f + expf(-g2))), y3 = d3 * rstd * (g3 / (1.0f + expf(-g3)));
        *(unsigned long long*)(CAT + (size_t)m * D + h * 256 + 4 * F.lane) = (unsigned long long)pk2(y0, y1) | ((unsigned long long)pk2(y2, y3) << 32);
    }
}
__device__ __forceinline__ void final_norm(const Frame& F0) {
    const Frame F = relaunder(F0);
    const int gw = F.bid * NWAVES + F.wave, NGW = F.G * NWAVES;
    for (int m = gw; m < M; m += NGW) {
        GAS f32x4* xr = (GAS f32x4*)(OUTP() + (size_t)m * D) + F.lane; const GAS f32x4* gr = (const GAS f32x4*)AP(I_FINAL) + F.lane;
        f32x4 v[4]; float s = 0.f;
#pragma unroll
        for (int j = 0; j < 4; ++j) { v[j] = xr[64 * j]; s += (v[j].x * v[j].x + v[j].y * v[j].y) + (v[j].z * v[j].z + v[j].w * v[j].w); }
        const float rstd = 1.0f / sqrtf(wave_sum(s) * (1.0f / D) + EPS);
#pragma unroll
        for (int j = 0; j < 4; ++j) xr[64 * j] = v[j] * rstd * gr[64 * j];
    }
}


__device__ __forceinline__ float silu_f(float g) { return g * __builtin_amdgcn_rcpf(1.0f + __builtin_amdgcn_exp2f(-1.4426950408889634f * g)); }
typedef float f32x16 __attribute__((ext_vector_type(16)));
typedef short s16x4 __attribute__((ext_vector_type(4)));
typedef float f32x2_t __attribute__((ext_vector_type(2)));
typedef __bf16 bf16x2_t __attribute__((ext_vector_type(2)));
#define MFMA32(a, b, c) __builtin_amdgcn_mfma_f32_32x32x16_bf16((a), (b), (c), 0, 0, 0)
__device__ __forceinline__ int crow(int reg, int h) { return (reg & 3) + 8 * (reg >> 2) + 4 * h; }
__device__ __forceinline__ unsigned cvtpk(float lo, float hi) { f32x2_t v = {lo, hi}; bf16x2_t b = __builtin_convertvector(v, bf16x2_t); return __builtin_bit_cast(unsigned, b); }
__device__ __forceinline__ bf16 cvt1(float v) { return (bf16)(cvtpk(v, 0.f) & 0xffffu); }
#define PACK_STEP(x, s) __builtin_bit_cast(bf16x8, (v4u){cvtpk((x)[8 * (s)], (x)[8 * (s) + 1]), cvtpk((x)[8 * (s) + 2], (x)[8 * (s) + 3]), cvtpk((x)[8 * (s) + 4], (x)[8 * (s) + 5]), cvtpk((x)[8 * (s) + 6], (x)[8 * (s) + 7])})
typedef const LAS unsigned char* lcp;
__device__ __forceinline__ int lndv(int v) { asm volatile("" : "+v"(v)); return v; }
__device__ __forceinline__ bf16x8 ld_row(lcp img, int P, int row0, int k0, int r, int h) { return *(const LAS bf16x8*)(img + (row0 + r) * P + (k0 + 8 * h) * 2); }
__device__ __forceinline__ bf16x8 ld_row_perm(lcp img, int P, int row0, int k0, int r, int h) {
    const s16x4 lo = *(const LAS s16x4*)(img + (row0 + r) * P + (k0 + 4 * h) * 2), hi = *(const LAS s16x4*)(img + (row0 + r) * P + (k0 + 8 + 4 * h) * 2);
    return __builtin_shufflevector(lo, hi, 0, 1, 2, 3, 4, 5, 6, 7); }
__device__ __forceinline__ s16x4 trd(lcp p) { return __builtin_bit_cast(s16x4, __builtin_amdgcn_ds_read_tr16_b64_v4i16((LAS s16x4*)p)); }
__device__ __forceinline__ bf16x8 ld_tr(lcp img, int P, int k0, int c0, int lane) {
    const int i16 = lane & 15, q = i16 >> 2, p = i16 & 3, blk = (lane >> 4) & 1, h = lane >> 5;
    lcp a = img + (k0 + 8 * h + q) * P + (c0 + 16 * blk + 4 * p) * 2;
    const s16x4 lo = trd(a), hi = trd(a + 4 * P);
    return __builtin_shufflevector(lo, hi, 0, 1, 2, 3, 4, 5, 6, 7); }
__device__ __forceinline__ bf16x8 ld_tr_perm(lcp img, int P, int k0, int c0, int lane) {
    const int i16 = lane & 15, q = i16 >> 2, p = i16 & 3, blk = (lane >> 4) & 1, h = lane >> 5;
    lcp a = img + (k0 + 4 * h + q) * P + (c0 + 16 * blk + 4 * p) * 2;
    const s16x4 lo = trd(a), hi = trd(a + 8 * P);
    return __builtin_shufflevector(lo, hi, 0, 1, 2, 3, 4, 5, 6, 7); }
template <int R, int C> __device__ __forceinline__ void tile_ld(v4u (&v)[R * C / 8 / NTHREADS], const bf16* g, size_t gp, int tid) {
    constexpr int CPR = C / 8, RS = NTHREADS / CPR;
    static_assert(NTHREADS % CPR == 0, "tile shape");
    const unsigned voff = (unsigned)((tid / CPR) * (int)gp + (tid % CPR) * 8) * 2u;
    const GAS unsigned char* gb = (const GAS unsigned char*)g;
#pragma unroll
    for (int i = 0; i < R * C / 8 / NTHREADS; ++i) v[i] = *(const GAS v4u*)(gb + (size_t)i * RS * gp * 2 + voff);
}
template <int R, int C> __device__ __forceinline__ void tile_st(const v4u (&v)[R * C / 8 / NTHREADS], LAS unsigned char* img, int P, int tid) {
    constexpr int CPR = C / 8, RS = NTHREADS / CPR;
    LAS unsigned char* lb = img + (tid / CPR) * P + (tid % CPR) * 16;
#pragma unroll
    for (int i = 0; i < R * C / 8 / NTHREADS; ++i) *(LAS v4u*)(lb + i * RS * P) = v[i];
}
template <int R, int C> __device__ __forceinline__ void stage_tile(LAS unsigned char* img, int P, const bf16* g, size_t gp, int tid) { v4u t_[R * C / 8 / NTHREADS]; tile_ld<R, C>(t_, g, gp, tid); tile_st<R, C>(t_, img, P, tid); }
#define WG_BAR() do { asm volatile("s_waitcnt lgkmcnt(0)" ::: "memory"); __builtin_amdgcn_s_barrier(); asm volatile("" ::: "memory"); } while (0)

constexpr int PR = 272, PT = 320, PT256 = 576, PO256 = 528;
constexpr size_t WS_DEC = 6 * MiB;
constexpr float LOG2E = 1.4426950408889634f, LN2 = 0.6931471805599453f;
__device__ __forceinline__ void gla_cumsum(float (&Bc)[2][16], float& Blast, lcp AL, lcp W2, const LAS float* BA, LAS float* EX, int wave, int lane) {
    const int r = lane & 31, h = lane >> 5, db = wave & 3, jh = wave >> 2;
    const bf16x8 wf = *(const LAS bf16x8*)(W2 + (db * 32 + r) * 32 + h * 16);
    const float bias = BA[db * 32 + r];
    float run = 0.f;
#pragma unroll
    for (int t = 0; t < 2; ++t) {
        const bf16x8 af = *(const LAS bf16x8*)(AL + ((jh * 2 + t) * 32 + r) * 32 + h * 16);
        f32x16 z = {0.f, 0.f, 0.f, 0.f, 0.f, 0.f, 0.f, 0.f, 0.f, 0.f, 0.f, 0.f, 0.f, 0.f, 0.f, 0.f};
        z = MFMA32(af, wf, z);
        float own[4], oth[4];
#pragma unroll
        for (int g = 0; g < 4; ++g) {
            float acc = 0.f;
#pragma unroll
            for (int i = 0; i < 4; ++i) { const float zz = z[4 * g + i] + bias;
                const float la = (fminf(zz, 0.f) - LN2 * __builtin_amdgcn_logf(1.0f + __builtin_amdgcn_exp2f(-fabsf(zz) * LOG2E))) * (1.0f / 16.0f);
                acc += la; Bc[t][4 * g + i] = acc; }
            own[g] = acc; oth[g] = oth32(acc, h);
        }
#pragma unroll
        for (int g = 0; g < 4; ++g) { const float off = run + (h ? oth[g] : 0.f);
#pragma unroll
            for (int i = 0; i < 4; ++i) Bc[t][4 * g + i] += off;
            run += own[g] + oth[g]; }
    }
    if (h == 0) EX[jh * 128 + db * 32 + r] = run;
    WG_BAR();
    const float t0 = EX[db * 32 + r], t1 = EX[128 + db * 32 + r];
    Blast = t0 + t1;
    if (jh == 1) {
#pragma unroll
        for (int t = 0; t < 2; ++t)
#pragma unroll
            for (int i = 0; i < 16; ++i) Bc[t][i] += t0; }
}
constexpr int GA_KI = 0, GA_VI = GA_KI + 128 * PR, GA_KD = GA_VI + 128 * PT256, GA_AL = GA_KD + 128 * PT, GA_W2 = GA_AL + 4096, GA_BA = GA_W2 + 4096, GA_EX = GA_BA + 512, GA_END = GA_EX + 1024;
constexpr int GA_OI = GA_VI;
constexpr int GC_QT = 0, GC_KT = GC_QT + 128 * PR, GC_SI = GC_KT + 128 * PR, GC_VI = GC_SI + 128 * PT, GC_AL = GC_VI + 128 * PT, GC_W2 = GC_AL + 4096, GC_BA = GC_W2 + 4096, GC_EX = GC_BA + 512, GC_END = GC_EX + 1024;
constexpr int GC_OI = 0;
static_assert(GA_END <= LDSCTL_OFF && GC_END <= LDSCTL_OFF && 128 * PO256 <= GC_SI && 128 * PO256 <= 128 * PT256, "GLA LDS maps");
__device__ __forceinline__ void gla_stage_w(const Frame& F, LAS unsigned char* W2, LAS float* BA, int li, int h) {
    if (F.tid < 128) { const int d = F.tid; const GAS float* w2 = (const GAS float*)AP(I_GLA_A2) + (size_t)li * 16 * 512 + h * 128 + d;
        v4u lo, hi; lo.x = cvtpk(w2[0], w2[512]); lo.y = cvtpk(w2[2 * 512], w2[3 * 512]); lo.z = cvtpk(w2[4 * 512], w2[5 * 512]); lo.w = cvtpk(w2[6 * 512], w2[7 * 512]);
        hi.x = cvtpk(w2[8 * 512], w2[9 * 512]); hi.y = cvtpk(w2[10 * 512], w2[11 * 512]); hi.z = cvtpk(w2[12 * 512], w2[13 * 512]); hi.w = cvtpk(w2[14 * 512], w2[15 * 512]);
        *(LAS v4u*)(W2 + d * 32) = lo; *(LAS v4u*)(W2 + d * 32 + 16) = hi; }
    else if (F.tid < 256) { const int d = F.tid - 128; BA[d] = ((const GAS float*)AP(I_GLA_BA))[(size_t)li * 512 + h * 128 + d]; }
}
__device__ __forceinline__ v4u gla_ld_alow(int tid, const bf16* Prow0) { const int t = tid & 255; return *(const GAS v4u*)(Prow0 + (size_t)(t >> 1) * GLA_INP + G_A + (t & 1) * 8); }
__device__ __forceinline__ void gla_st_alow(int tid, v4u v, LAS unsigned char* AL) { if (tid < 256) *(LAS v4u*)(AL + (tid >> 1) * 32 + (tid & 1) * 16) = v; }

__device__ __forceinline__ void gla_phase_a(const Frame& F0, int li) {
    const Frame F = relaunder(F0);
    unsigned char* ws = WSP();
    const bf16* P = (const bf16*)(ws + WS_ACT); bf16* SKV = (bf16*)(ws + WS_XB); float* DEC = (float*)(ws + WS_DEC);
    LAS unsigned char* L = F.lds;
    const int wave = F.wave, db = wave & 3, jh = wave >> 2;
    v4u kR[4], vR[8], aR; int hcur = -1;
    {   const int it = F.bid; if (it < 1024) { const int bh = it >> 5, g = it & 31; const bf16* Prow0 = P + ((size_t)(bh >> 2) * SEQ + g * 128) * GLA_INP;
            tile_ld<128, 128>(kR, Prow0 + G_K + (bh & 3) * 128, GLA_INP, F.tid); tile_ld<128, 256>(vR, Prow0 + G_V + (bh & 3) * 256, GLA_INP, F.tid); aR = gla_ld_alow(F.tid, Prow0); } }
    for (int it = F.bid; it < 1024; it += F.G) {
        const int bh = it >> 5, h = bh & 3;
        const int lane = lndv(F.lane), r = lane & 31, h2 = lane >> 5;
        tile_st<128, 128>(kR, L + GA_KI, PR, F.tid); tile_st<128, 256>(vR, L + GA_VI, PT256, F.tid); gla_st_alow(F.tid, aR, L + GA_AL);
        if (h != hcur) { gla_stage_w(F, L + GA_W2, (LAS float*)(L + GA_BA), li, h); hcur = h; }
        WG_BAR();
        {   const int nx = it + F.G; if (nx < 1024) { const int bh2 = nx >> 5, g2 = nx & 31; const bf16* Pn = P + ((size_t)(bh2 >> 2) * SEQ + g2 * 128) * GLA_INP;
                tile_ld<128, 128>(kR, Pn + G_K + (bh2 & 3) * 128, GLA_INP, F.tid); tile_ld<128, 256>(vR, Pn + G_V + (bh2 & 3) * 256, GLA_INP, F.tid); aR = gla_ld_alow(F.tid, Pn); } }
        float Bc[2][16], Blast;
        gla_cumsum(Bc, Blast, L + GA_AL, L + GA_W2, (const LAS float*)(L + GA_BA), (LAS float*)(L + GA_EX), wave, lane);
#pragma unroll
        for (int t = 0; t < 2; ++t)
#pragma unroll
            for (int i = 0; i < 16; ++i) { const int row = (jh * 2 + t) * 32 + crow(i, h2), col = db * 32 + r;
                const float kv = bf2f(*(const LAS bf16*)(L + GA_KI + row * PR + col * 2)) * __builtin_amdgcn_exp2f((Blast - Bc[t][i]) * LOG2E);
                *(LAS bf16*)(L + GA_KD + row * PT + col * 2) = cvt1(kv); }
        if (jh == 0 && h2 == 0) DEC[(size_t)it * 128 + db * 32 + r] = __builtin_amdgcn_exp2f(Blast * LOG2E);
        WG_BAR();
        f32x16 acc[4];
#pragma unroll
        for (int t = 0; t < 4; ++t) acc[t] = (f32x16){0.f, 0.f, 0.f, 0.f, 0.f, 0.f, 0.f, 0.f, 0.f, 0.f, 0.f, 0.f, 0.f, 0.f, 0.f, 0.f};
#pragma unroll
        for (int ks = 0; ks < 8; ++ks) { const bf16x8 a = ld_tr(L + GA_KD, PT, 16 * ks, db * 32, lane);
#pragma unroll
            for (int t = 0; t < 4; ++t) acc[t] = MFMA32(a, ld_tr(L + GA_VI, PT256, 16 * ks, (4 * jh + t) * 32, lane), acc[t]); }
        WG_BAR();
#pragma unroll
        for (int t = 0; t < 4; ++t)
#pragma unroll
            for (int i = 0; i < 16; ++i) *(LAS bf16*)(L + GA_OI + (db * 32 + crow(i, h2)) * PO256 + ((4 * jh + t) * 32 + r) * 2) = cvt1(acc[t][i]);
        WG_BAR();
        {   bf16* out = SKV + (size_t)it * 128 * 256;
#pragma unroll
            for (int i = 0; i < 8; ++i) { const int c = F.tid + i * NTHREADS, row = c >> 5, cc = c & 31; *(GAS v4u*)(out + row * 256 + cc * 8) = *(const LAS v4u*)(L + GA_OI + row * PO256 + cc * 16); } }
        WG_BAR();
    }
}
__device__ __forceinline__ void gla_phase_b(const Frame& F0) {
    const Frame F = relaunder(F0);
    unsigned char* ws = WSP();
    bf16* SKV = (bf16*)(ws + WS_XB); const float* DEC = (const float*)(ws + WS_DEC);
    for (int gt = F.bid * NTHREADS + F.tid; gt < 32 * 128 * 32; gt += F.G * NTHREADS) {
        const int bh = gt >> 12, d = (gt >> 5) & 127, e8 = gt & 31;
        float s[8];
#pragma unroll
        for (int i = 0; i < 8; ++i) s[i] = 0.f;
        for (int g0 = 0; g0 < 32; g0 += 8) {
            v4u kv[8]; float dc[8];
#pragma unroll
            for (int u = 0; u < 8; ++u) { const size_t item = (size_t)bh * 32 + g0 + u; kv[u] = *(const GAS v4u*)(SKV + (item * 128 + d) * 256 + e8 * 8); dc[u] = ((const GAS float*)DEC)[item * 128 + d]; }
#pragma unroll
            for (int u = 0; u < 8; ++u) { const size_t item = (size_t)bh * 32 + g0 + u;
                v4u o; o.x = cvtpk(s[0], s[1]); o.y = cvtpk(s[2], s[3]); o.z = cvtpk(s[4], s[5]); o.w = cvtpk(s[6], s[7]);
                *(GAS v4u*)(SKV + (item * 128 + d) * 256 + e8 * 8) = o;
#pragma unroll
                for (int i = 0; i < 4; ++i) { s[2 * i] = dc[u] * s[2 * i] + bflo(kv[u][i]); s[2 * i + 1] = dc[u] * s[2 * i + 1] + bfhi(kv[u][i]); } }
        }
    }
}
__device__ __forceinline__ void gla_phase_c(const Frame& F0, int li) {
    const Frame F = relaunder(F0);
    unsigned char* ws = WSP();
    const bf16* P = (const bf16*)(ws + WS_ACT); const bf16* SKV = (const bf16*)(ws + WS_XB); bf16* CAT = (bf16*)(ws + WS_CAT);
    LAS unsigned char* L = F.lds;
    const int wave = F.wave, db = wave & 3, jh = wave >> 2;
    const int ib = wave & 3, eq = wave >> 2;
    v4u qR[4], kR[4], aR; int hcur = -1;
    {   const int it = F.bid; if (it < 1024) { const int bh = it >> 5, g = it & 31, h = bh & 3; const bf16* Prow0 = P + ((size_t)(bh >> 2) * SEQ + g * 128) * GLA_INP;
            tile_ld<128, 128>(qR, Prow0 + G_Q + h * 128, GLA_INP, F.tid); tile_ld<128, 128>(kR, Prow0 + G_K + h * 128, GLA_INP, F.tid); aR = gla_ld_alow(F.tid, Prow0); } }
    for (int it = F.bid; it < 1024; it += F.G) {
        const int bh = it >> 5, g = it & 31, b = bh >> 2, h = bh & 3;
        const int tidl = lndv(F.tid), lane = tidl & 63, r = lane & 31, h2 = lane >> 5;
        const bf16* Prow0 = P + ((size_t)b * SEQ + g * 128) * GLA_INP;
        const bf16* Sg = SKV + (size_t)it * 128 * 256;
        {   v4u sR[4], vR[4]; tile_ld<128, 128>(sR, Sg, 256, tidl); tile_ld<128, 128>(vR, Prow0 + G_V + h * 256, GLA_INP, tidl);
            tile_st<128, 128>(qR, L + GC_QT, PR, tidl); tile_st<128, 128>(kR, L + GC_KT, PR, tidl); tile_st<128, 128>(sR, L + GC_SI, PT, tidl); tile_st<128, 128>(vR, L + GC_VI, PT, tidl); }
        gla_st_alow(tidl, aR, L + GC_AL);
        if (h != hcur) { gla_stage_w(F, L + GC_W2, (LAS float*)(L + GC_BA), li, h); hcur = h; }
        WG_BAR();
        {
            float Bc[2][16], Blast;
            gla_cumsum(Bc, Blast, L + GC_AL, L + GC_W2, (const LAS float*)(L + GC_BA), (LAS float*)(L + GC_EX), wave, lane);
#pragma unroll
            for (int t = 0; t < 2; ++t)
#pragma unroll
                for (int i = 0; i < 16; ++i) { const int off = ((jh * 2 + t) * 32 + crow(i, h2)) * PR + (db * 32 + r) * 2;
                    const float eb = __builtin_amdgcn_exp2f(Bc[t][i] * LOG2E);
                    const float qv = bf2f(*(const LAS bf16*)(L + GC_QT + off)) * eb * 0.08838834764831845f;
                    const float kv = bf2f(*(const LAS bf16*)(L + GC_KT + off)) * __builtin_amdgcn_rcpf(eb);
                    *(LAS bf16*)(L + GC_QT + off) = cvt1(qv); *(LAS bf16*)(L + GC_KT + off) = cvt1(kv); }
        }
        WG_BAR();
        bf16x8 PA[4][2];
#pragma unroll
        for (int jb = 0; jb < 4; ++jb) {
            if (jb <= ib) {
                f32x16 x = {0.f, 0.f, 0.f, 0.f, 0.f, 0.f, 0.f, 0.f, 0.f, 0.f, 0.f, 0.f, 0.f, 0.f, 0.f, 0.f};
#pragma unroll
                for (int ks = 0; ks < 8; ++ks) x = MFMA32(ld_row(L + GC_KT, PR, jb * 32, 16 * ks, r, h2), ld_row(L + GC_QT, PR, ib * 32, 16 * ks, r, h2), x);
                if (jb == ib) {
#pragma unroll
                    for (int i = 0; i < 16; ++i) if (crow(i, h2) > r) x[i] = 0.f; }
                PA[jb][0] = PACK_STEP(x, 0); PA[jb][1] = PACK_STEP(x, 1);
            } else { PA[jb][0] = (bf16x8){0, 0, 0, 0, 0, 0, 0, 0}; PA[jb][1] = (bf16x8){0, 0, 0, 0, 0, 0, 0, 0}; }
        }
        f32x16 o[2][2];
#pragma unroll
        for (int half = 0; half < 2; ++half) {
            if (half == 1) {
                WG_BAR();
                stage_tile<128, 128>(L + GC_SI, PT, Sg + 128, 256, tidl); stage_tile<128, 128>(L + GC_VI, PT, Prow0 + G_V + h * 256 + 128, GLA_INP, tidl);
                WG_BAR();
            }
#pragma unroll
            for (int t = 0; t < 2; ++t) {
                const int eb = 2 * eq + t;
                f32x16 acc = {0.f, 0.f, 0.f, 0.f, 0.f, 0.f, 0.f, 0.f, 0.f, 0.f, 0.f, 0.f, 0.f, 0.f, 0.f, 0.f};
#pragma unroll
                for (int jb = 0; jb < 4; ++jb) if (jb <= ib) {
#pragma unroll
                    for (int s = 0; s < 2; ++s) acc = MFMA32(PA[jb][s], ld_tr_perm(L + GC_VI, PT, jb * 32 + 16 * s, eb * 32, lane), acc); }
#pragma unroll
                for (int ks = 0; ks < 8; ++ks) acc = MFMA32(ld_row(L + GC_QT, PR, ib * 32, 16 * ks, r, h2), ld_tr(L + GC_SI, PT, 16 * ks, eb * 32, lane), acc);
                o[half][t] = acc;
            }
        }
        WG_BAR();
#pragma unroll
        for (int half = 0; half < 2; ++half)
#pragma unroll
            for (int t = 0; t < 2; ++t)
#pragma unroll
                for (int i = 0; i < 16; ++i) *(LAS bf16*)(L + GC_OI + (ib * 32 + crow(i, h2)) * PO256 + (half * 128 + (2 * eq + t) * 32 + r) * 2) = cvt1(o[half][t][i]);
        WG_BAR();
        {   const int nx = (it + F.G < 1024) ? it + F.G : it;
            const int bh2 = nx >> 5, g2 = nx & 31, hn = bh2 & 3; const bf16* Pn = P + ((size_t)(bh2 >> 2) * SEQ + g2 * 128) * GLA_INP;
            tile_ld<128, 128>(qR, Pn + G_Q + hn * 128, GLA_INP, tidl); tile_ld<128, 128>(kR, Pn + G_K + hn * 128, GLA_INP, tidl); aR = gla_ld_alow(tidl, Pn); }
        {
            const int tid2 = lndv(tidl), row = tid2 >> 2, qtr = tid2 & 3;
            lcp orow = L + GC_OI + row * PO256 + qtr * 128;
            const bf16* gp = Prow0 + (size_t)row * GLA_INP + G_R + h * 256 + qtr * 64;
            float sum = 0.f;
#pragma unroll
            for (int c = 0; c < 8; ++c) { const v4u w = *(const LAS v4u*)(orow + c * 16);
#pragma unroll
                for (int i = 0; i < 4; ++i) sum += bflo(w[i]) + bfhi(w[i]); }
            sum += xsw<1>(sum); sum += xsw<2>(sum);
            const float mu = sum * (1.0f / 256.0f); float sq = 0.f;
#pragma unroll
            for (int c = 0; c < 8; ++c) { const v4u w = *(const LAS v4u*)(orow + c * 16);
#pragma unroll
                for (int i = 0; i < 4; ++i) { const float d0 = bflo(w[i]) - mu, d1 = bfhi(w[i]) - mu; sq += d0 * d0 + d1 * d1; } }
            sq += xsw<1>(sq); sq += xsw<2>(sq);
            const float rstd = 1.0f / sqrtf(sq * (1.0f / 256.0f) + EPS);
            bf16* op = CAT + ((size_t)b * SEQ + g * 128 + row) * D + h * 256 + qtr * 64;
#pragma unroll
            for (int c = 0; c < 8; ++c) { const v4u gw = *(const GAS v4u*)(gp + c * 8); const v4u w = *(const LAS v4u*)(orow + c * 16); v4u ow;
#pragma unroll
                for (int i = 0; i < 4; ++i) { const float g0 = bflo(gw[i]), g1 = bfhi(gw[i]);
                    ow[i] = cvtpk((bflo(w[i]) - mu) * rstd * silu_f(g0), (bfhi(w[i]) - mu) * rstd * silu_f(g1)); }
                *(GAS v4u*)(op + c * 8) = ow; }
        }
        WG_BAR();
    }
}


constexpr size_t WS_OD = 408 * MiB;
constexpr size_t WS_LSE = WS_XB + 32 * MiB;
constexpr size_t WS_END2 = 504 * MiB;
constexpr int RA_KI = 0, RA_VD = RA_KI + 128 * PT, RA_END = RA_VD + 128 * PT;
constexpr int RC_QI = 0, RC_KI = RC_QI + 128 * PR, RC_VI = RC_KI + 128 * PR, RC_SI = RC_VI + 128 * PT, RC_END = RC_SI + 128 * PT;
constexpr int DPK = 144, DPV = 192;
constexpr int DL_KI = 0, DL_VI = DL_KI + 384 * DPK, DL_LW = DL_VI + 384 * DPV, DL_END = DL_LW + 8 * 256;
constexpr int DL_ST = DL_KI;
static_assert(RC_END <= LDSCTL_OFF && DL_END <= LDSCTL_OFF && 8 * 32 * DPK <= 384 * DPK, "even mixer LDS maps");
__device__ __forceinline__ float ret_log2g(int h) { return log2f(1.0f - exp2f(-5.0f - (float)h)); }

__device__ __forceinline__ void ret_phase_a_items(const Frame& F, const bf16* P, bf16* RKV) {
    LAS unsigned char* L = F.lds;
    const int wave = F.wave, db = wave & 3, eh = wave >> 2;
    v4u kR[4], vR[4];
    {   const int it = F.bid < 1024 ? F.bid : 0; const int bh = it >> 5, n = it & 31; const bf16* Prow0 = P + ((size_t)(bh >> 2) * SEQ + n * 128) * EVEN_IN;
        tile_ld<128, 128>(kR, Prow0 + E_RK + (bh & 3) * 128, EVEN_IN, F.tid); tile_ld<128, 128>(vR, Prow0 + E_RV + (bh & 3) * 128, EVEN_IN, F.tid); }
    for (int it = F.bid; it < 1024; it += F.G) {
        const int tidl = lndv(F.tid), lane = tidl & 63, r = lane & 31, h2 = lane >> 5;
        const int bh = it >> 5, h = bh & 3;
        const float lg = ret_log2g(h);
        tile_st<128, 128>(kR, L + RA_KI, PT, tidl);
        {
#pragma unroll
            for (int i = 0; i < 4; ++i) { const int row = (tidl >> 4) + 32 * i, cc = tidl & 15; const float f = __builtin_amdgcn_exp2f(lg * (float)(127 - row)); v4u o;
#pragma unroll
                for (int k = 0; k < 4; ++k) o[k] = cvtpk(bflo(vR[i][k]) * f, bfhi(vR[i][k]) * f);
                *(LAS v4u*)(L + RA_VD + row * PT + cc * 16) = o; }
        }
        WG_BAR();
        {   const int nx = (it + F.G < 1024) ? it + F.G : it; const int bh2 = nx >> 5, n2 = nx & 31; const bf16* Pn = P + ((size_t)(bh2 >> 2) * SEQ + n2 * 128) * EVEN_IN;
            tile_ld<128, 128>(kR, Pn + E_RK + (bh2 & 3) * 128, EVEN_IN, tidl); tile_ld<128, 128>(vR, Pn + E_RV + (bh2 & 3) * 128, EVEN_IN, tidl); }
        f32x16 acc[2];
#pragma unroll
        for (int t = 0; t < 2; ++t) acc[t] = (f32x16){0.f, 0.f, 0.f, 0.f, 0.f, 0.f, 0.f, 0.f, 0.f, 0.f, 0.f, 0.f, 0.f, 0.f, 0.f, 0.f};
#pragma unroll
        for (int ks = 0; ks < 8; ++ks) { const bf16x8 a = ld_tr(L + RA_KI, PT, 16 * ks, db * 32, lane);
#pragma unroll
            for (int t = 0; t < 2; ++t) acc[t] = MFMA32(a, ld_tr(L + RA_VD, PT, 16 * ks, (2 * eh + t) * 32, lane), acc[t]); }
        WG_BAR();
#pragma unroll
        for (int t = 0; t < 2; ++t)
#pragma unroll
            for (int i = 0; i < 16; ++i) *(LAS bf16*)(L + RA_KI + (db * 32 + crow(i, h2)) * PR + ((2 * eh + t) * 32 + r) * 2) = cvt1(acc[t][i]);
        WG_BAR();
        bf16* out = RKV + (size_t)it * 128 * 128;
#pragma unroll
        for (int i = 0; i < 4; ++i) { const int row = (tidl >> 4) + 32 * i, cc = tidl & 15; *(GAS v4u*)(out + row * 128 + cc * 8) = *(const LAS v4u*)(L + RA_KI + row * PR + cc * 16); }
        WG_BAR();
    }
}
__device__ __forceinline__ void ret_scan(const Frame& F, bf16* RKV) {
    for (int gt = F.bid * NTHREADS + F.tid; gt < 32 * 128 * 16; gt += F.G * NTHREADS) {
        const int bh = gt >> 11, d = (gt >> 4) & 127, e8 = gt & 15, h = bh & 3;
        const float g128 = __builtin_amdgcn_exp2f(ret_log2g(h) * 128.0f);
        float s[8];
#pragma unroll
        for (int i = 0; i < 8; ++i) s[i] = 0.f;
        for (int n0 = 0; n0 < 32; n0 += 4) {
            v4u kv[4];
#pragma unroll
            for (int u = 0; u < 4; ++u) kv[u] = *(const GAS v4u*)(RKV + (((size_t)bh * 32 + n0 + u) * 128 + d) * 128 + e8 * 8);
#pragma unroll
            for (int u = 0; u < 4; ++u) {
                v4u o; o.x = cvtpk(s[0], s[1]); o.y = cvtpk(s[2], s[3]); o.z = cvtpk(s[4], s[5]); o.w = cvtpk(s[6], s[7]);
                *(GAS v4u*)(RKV + (((size_t)bh * 32 + n0 + u) * 128 + d) * 128 + e8 * 8) = o;
#pragma unroll
                for (int i = 0; i < 4; ++i) { s[2 * i] = g128 * s[2 * i] + bflo(kv[u][i]); s[2 * i + 1] = g128 * s[2 * i + 1] + bfhi(kv[u][i]); } }
        }
    }
}
__device__ __forceinline__ void ret_phase_c_items(const Frame& F, const bf16* P, const bf16* RKV, bf16* CAT) {
    LAS unsigned char* L = F.lds;
    const int wave = F.wave, ib = wave & 3, eq = wave >> 2;
    v4u qR[4], kR[4];
    {   const int it = F.bid < 1024 ? F.bid : 0; const int bh = it >> 5, n = it & 31; const bf16* Prow0 = P + ((size_t)(bh >> 2) * SEQ + n * 128) * EVEN_IN;
        tile_ld<128, 128>(qR, Prow0 + E_RQ + (bh & 3) * 128, EVEN_IN, F.tid); tile_ld<128, 128>(kR, Prow0 + E_RK + (bh & 3) * 128, EVEN_IN, F.tid); }
    for (int it = F.bid; it < 1024; it += F.G) {
        const int tidl = lndv(F.tid), lane = tidl & 63, r = lane & 31, h2 = lane >> 5;
        const int bh = it >> 5, n = it & 31, b = bh >> 2, h = bh & 3;
        const float lg = ret_log2g(h);
        const bf16* Prow0 = P + ((size_t)b * SEQ + n * 128) * EVEN_IN;
        {   v4u vR[4], sR[4]; tile_ld<128, 128>(vR, Prow0 + E_RV + h * 128, EVEN_IN, tidl); tile_ld<128, 128>(sR, RKV + (size_t)it * 128 * 128, 128, tidl);
#pragma unroll
            for (int i = 0; i < 4; ++i) { const int row = (tidl >> 4) + 32 * i, cc = tidl & 15; const float fq = __builtin_amdgcn_exp2f(lg * (float)row), fk = __builtin_amdgcn_rcpf(fq); v4u oq, ok;
#pragma unroll
                for (int k = 0; k < 4; ++k) { oq[k] = cvtpk(bflo(qR[i][k]) * fq, bfhi(qR[i][k]) * fq); ok[k] = cvtpk(bflo(kR[i][k]) * fk, bfhi(kR[i][k]) * fk); }
                *(LAS v4u*)(L + RC_QI + row * PR + cc * 16) = oq; *(LAS v4u*)(L + RC_KI + row * PR + cc * 16) = ok; }
            tile_st<128, 128>(vR, L + RC_VI, PT, tidl); tile_st<128, 128>(sR, L + RC_SI, PT, tidl); }
        WG_BAR();
        bf16x8 PA[4][2];
#pragma unroll
        for (int jb = 0; jb < 4; ++jb) {
            if (jb <= ib) {
                f32x16 x = {0.f, 0.f, 0.f, 0.f, 0.f, 0.f, 0.f, 0.f, 0.f, 0.f, 0.f, 0.f, 0.f, 0.f, 0.f, 0.f};
#pragma unroll
                for (int ks = 0; ks < 8; ++ks) x = MFMA32(ld_row(L + RC_KI, PR, jb * 32, 16 * ks, r, h2), ld_row(L + RC_QI, PR, ib * 32, 16 * ks, r, h2), x);
                if (jb == ib) {
#pragma unroll
                    for (int i = 0; i < 16; ++i) if (crow(i, h2) > r) x[i] = 0.f; }
                PA[jb][0] = PACK_STEP(x, 0); PA[jb][1] = PACK_STEP(x, 1);
            } else { PA[jb][0] = (bf16x8){0, 0, 0, 0, 0, 0, 0, 0}; PA[jb][1] = (bf16x8){0, 0, 0, 0, 0, 0, 0, 0}; }
        }
        f32x16 o[2];
#pragma unroll
        for (int t = 0; t < 2; ++t) {
            const int eb = 2 * eq + t;
            f32x16 z = {0.f, 0.f, 0.f, 0.f, 0.f, 0.f, 0.f, 0.f, 0.f, 0.f, 0.f, 0.f, 0.f, 0.f, 0.f, 0.f}, y = z;
#pragma unroll
            for (int jb = 0; jb < 4; ++jb) if (jb <= ib) {
#pragma unroll
                for (int s = 0; s < 2; ++s) z = MFMA32(PA[jb][s], ld_tr_perm(L + RC_VI, PT, jb * 32 + 16 * s, eb * 32, lane), z); }
#pragma unroll
            for (int ks = 0; ks < 8; ++ks) y = MFMA32(ld_row(L + RC_QI, PR, ib * 32, 16 * ks, r, h2), ld_tr(L + RC_SI, PT, 16 * ks, eb * 32, lane), y);
            const float g1 = __builtin_amdgcn_exp2f(lg);
#pragma unroll
            for (int i = 0; i < 16; ++i) z[i] += y[i] * g1;
            o[t] = z;
        }
        WG_BAR();
#pragma unroll
        for (int t = 0; t < 2; ++t)
#pragma unroll
            for (int i = 0; i < 16; ++i) *(LAS bf16*)(L + RC_QI + (ib * 32 + crow(i, h2)) * PR + ((2 * eq + t) * 32 + r) * 2) = cvt1(o[t][i]);
        WG_BAR();
        {   const int nx = (it + F.G < 1024) ? it + F.G : it; const int bh2 = nx >> 5, n2 = nx & 31; const bf16* Pn = P + ((size_t)(bh2 >> 2) * SEQ + n2 * 128) * EVEN_IN;
            tile_ld<128, 128>(qR, Pn + E_RQ + (bh2 & 3) * 128, EVEN_IN, tidl); tile_ld<128, 128>(kR, Pn + E_RK + (bh2 & 3) * 128, EVEN_IN, tidl); }
        {
            const int tid2 = lndv(tidl), row = tid2 >> 2, qtr = tid2 & 3;
            lcp orow = L + RC_QI + row * PR + qtr * 64;
            v4u w[4]; float sum = 0.f;
#pragma unroll
            for (int c = 0; c < 4; ++c) { w[c] = *(const LAS v4u*)(orow + c * 16);
#pragma unroll
                for (int i = 0; i < 4; ++i) sum += bflo(w[c][i]) + bfhi(w[c][i]); }
            sum += xsw<1>(sum); sum += xsw<2>(sum);
            const float mu = sum * (1.0f / 128.0f); float sq = 0.f;
#pragma unroll
            for (int c = 0; c < 4; ++c)
#pragma unroll
                for (int i = 0; i < 4; ++i) { const float d0 = bflo(w[c][i]) - mu, d1 = bfhi(w[c][i]) - mu; sq += d0 * d0 + d1 * d1; }
            sq += xsw<1>(sq); sq += xsw<2>(sq);
            const float rstd = 1.0f / sqrtf(sq * (1.0f / 128.0f) + EPS);
            const bf16* gp = Prow0 + (size_t)row * EVEN_IN + E_RG + h * 128 + qtr * 32;
            bf16* op = CAT + ((size_t)b * SEQ + n * 128 + row) * D + h * 128 + qtr * 32;
#pragma unroll
            for (int c = 0; c < 4; ++c) { const v4u gw = *(const GAS v4u*)(gp + c * 8); v4u ow;
#pragma unroll
                for (int i = 0; i < 4; ++i) { const float g0 = bflo(gw[i]), g1 = bfhi(gw[i]);
                    ow[i] = cvtpk((bflo(w[c][i]) - mu) * rstd * silu_f(g0), (bfhi(w[c][i]) - mu) * rstd * silu_f(g1)); }
                *(GAS v4u*)(op + c * 8) = ow; }
        }
        WG_BAR();
    }
}
struct DilTile { int b, head, p, dil, res, q0; };
__device__ __forceinline__ DilTile dil_decode(int T) { DilTile t; t.b = T / 384; const int rem = T - t.b * 384; t.head = rem / 48; const int t48 = rem - t.head * 48; t.p = t48 >> 4; const int idx = t48 & 15, sh = 2 * t.p;
    t.dil = 1 << sh; t.res = idx & (t.dil - 1); t.q0 = (idx >> sh) * 256; return t; }
__device__ __forceinline__ void dil_ld(v4u (&kR)[6], v4u (&vR)[6], const DilTile& t, const bf16* P, int tid) {
    const bf16* Pb = P + (size_t)t.b * SEQ * EVEN_IN + t.head * 64 + (tid & 7) * 8;
#pragma unroll
    for (int i = 0; i < 6; ++i) { int kidx = t.q0 - 128 + (tid >> 3) + 64 * i; kidx = kidx < 0 ? 0 : kidx;
        const bf16* src = Pb + (size_t)(kidx * t.dil + t.res) * EVEN_IN; kR[i] = *(const GAS v4u*)(src + E_DK); vR[i] = *(const GAS v4u*)(src + E_DV); }
}
__device__ __forceinline__ void dil_tiles(const Frame& F, int T0, int T1, int step, const bf16* P, bf16* OD, float* LSE) {
    LAS unsigned char* L = F.lds;
    const int wave = F.wave;
    if (T0 >= T1) return;
    v4u kR[6], vR[6];
    { const DilTile t0 = dil_decode(T0); dil_ld(kR, vR, t0, P, F.tid); }
    for (int T = T0; T < T1; T += step) {
        const int tidl = lndv(F.tid), lane = tidl & 63, r = lane & 31, h2 = lane >> 5;
        const DilTile t = dil_decode(T);
        const bf16* Pb = P + (size_t)t.b * SEQ * EVEN_IN + t.head * 64;
#pragma unroll
        for (int i = 0; i < 6; ++i) { const int row = (tidl >> 3) + 64 * i, cc = tidl & 7; *(LAS v4u*)(L + DL_KI + row * DPK + cc * 16) = kR[i]; *(LAS v4u*)(L + DL_VI + row * DPV + cc * 16) = vR[i]; }
        bf16x8 qf[4];
        { const bf16* qsrc = Pb + (size_t)((t.q0 + 32 * wave + r) * t.dil + t.res) * EVEN_IN + E_DQ + 8 * h2;
#pragma unroll
          for (int ks = 0; ks < 4; ++ks) qf[ks] = *(const GAS bf16x8*)(qsrc + 16 * ks); }
        WG_BAR();
        { const DilTile tn = dil_decode(T + step < T1 ? T + step : T); dil_ld(kR, vR, tn, P, tidl); }
        f32x16 x[5];
        float mx = -INFINITY;
#pragma unroll
        for (int kb = 0; kb < 5; ++kb) {
            f32x16 a = {0.f, 0.f, 0.f, 0.f, 0.f, 0.f, 0.f, 0.f, 0.f, 0.f, 0.f, 0.f, 0.f, 0.f, 0.f, 0.f};
#pragma unroll
            for (int ks = 0; ks < 4; ++ks) a = MFMA32(ld_row(L + DL_KI, DPK, 32 * wave + 32 * kb, 16 * ks, r, h2), qf[ks], a);
            if (kb == 0) {
#pragma unroll
                for (int i = 0; i < 16; ++i) if (crow(i, h2) < r) a[i] = -INFINITY; }
            if (kb == 4) {
#pragma unroll
                for (int i = 0; i < 16; ++i) if (crow(i, h2) > r) a[i] = -INFINITY; }
            if (t.q0 == 0 && 32 * wave + 32 * kb < 128) {
#pragma unroll
                for (int i = 0; i < 16; ++i) a[i] = -INFINITY; }
#pragma unroll
            for (int i = 0; i < 16; ++i) mx = fmaxf(mx, a[i]);
            x[kb] = a;
        }
        mx = max32(mx);
        constexpr float C2 = 0.125f * LOG2E;
        const float mc = mx * C2; float l = 0.f;
#pragma unroll
        for (int kb = 0; kb < 5; ++kb)
#pragma unroll
            for (int i = 0; i < 16; ++i) { const float pe = __builtin_amdgcn_exp2f(x[kb][i] * C2 - mc); x[kb][i] = pe; l += pe; }
        l = sum32(l);
        f32x16 o[2];
#pragma unroll
        for (int dbk = 0; dbk < 2; ++dbk) o[dbk] = (f32x16){0.f, 0.f, 0.f, 0.f, 0.f, 0.f, 0.f, 0.f, 0.f, 0.f, 0.f, 0.f, 0.f, 0.f, 0.f, 0.f};
#pragma unroll
        for (int kb = 0; kb < 5; ++kb)
#pragma unroll
            for (int s = 0; s < 2; ++s) { const bf16x8 pa = PACK_STEP(x[kb], s);
#pragma unroll
                for (int dbk = 0; dbk < 2; ++dbk) o[dbk] = MFMA32(pa, ld_tr_perm(L + DL_VI, DPV, 32 * wave + 32 * kb + 16 * s, dbk * 32, lane), o[dbk]); }
        LAS float* lw = (LAS float*)(L + DL_LW + wave * 256);
        if (h2 == 0) lw[r] = l;
        WG_BAR();
        LAS unsigned char* st = L + DL_ST + wave * 32 * DPK;
#pragma unroll
        for (int i = 0; i < 16; ++i) { const float rl = __builtin_amdgcn_rcpf(lw[crow(i, h2)]);
#pragma unroll
            for (int dbk = 0; dbk < 2; ++dbk) *(LAS bf16*)(st + crow(i, h2) * DPK + (dbk * 32 + r) * 2) = cvt1(o[dbk][i] * rl); }
        const size_t tokbase = (size_t)t.b * SEQ;
        bf16* odp = OD + (size_t)t.p * M * 512;
#pragma unroll
        for (int j = 0; j < 4; ++j) { const int c = lane + 64 * j, row = c >> 3, cc = c & 7; const size_t tok = tokbase + (size_t)(t.q0 + 32 * wave + row) * t.dil + t.res;
            *(GAS v4u*)(odp + tok * 512 + t.head * 64 + cc * 8) = *(const LAS v4u*)(st + row * DPK + cc * 16); }
        if (h2 == 0) { const size_t tok = tokbase + (size_t)(t.q0 + 32 * wave + r) * t.dil + t.res; LSE[((size_t)t.p * M + tok) * 8 + t.head] = mx * 0.125f + LN2 * __builtin_amdgcn_logf(l); }
        WG_BAR();
    }
}
__device__ __forceinline__ void dil_combine(const Frame& F, const bf16* OD, const float* LSE, bf16* CAT) {
    for (int gt = F.bid * NTHREADS + F.tid; gt < M * 64; gt += F.G * NTHREADS) {
        const int tok = gt >> 6, c8 = gt & 63, head = c8 >> 3;
        const float l0 = LSE[(size_t)tok * 8 + head], l1 = LSE[((size_t)M + tok) * 8 + head], l2 = LSE[((size_t)2 * M + tok) * 8 + head];
        const float mxl = fmaxf(l0, fmaxf(l1, l2));
        float w0 = __builtin_amdgcn_exp2f((l0 - mxl) * LOG2E), w1 = __builtin_amdgcn_exp2f((l1 - mxl) * LOG2E), w2 = __builtin_amdgcn_exp2f((l2 - mxl) * LOG2E);
        const float rs = 1.0f / (w0 + w1 + w2); w0 *= rs; w1 *= rs; w2 *= rs;
        const v4u a = *(const GAS v4u*)(OD + (size_t)tok * 512 + c8 * 8), bq = *(const GAS v4u*)(OD + ((size_t)M + tok) * 512 + c8 * 8), cq = *(const GAS v4u*)(OD + ((size_t)2 * M + tok) * 512 + c8 * 8);
        v4u o;
#pragma unroll
        for (int i = 0; i < 4; ++i) o[i] = cvtpk(w0 * bflo(a[i]) + w1 * bflo(bq[i]) + w2 * bflo(cq[i]), w0 * bfhi(a[i]) + w1 * bfhi(bq[i]) + w2 * bfhi(cq[i]));
        *(GAS v4u*)(CAT + (size_t)tok * D + 512 + c8 * 8) = o;
    }
}
constexpr int DIL_TILES = 3072, DIL_SPLIT = 1024;
__device__ __forceinline__ void even_phase_a(const Frame& F0) {
    const Frame F = relaunder(F0);
    unsigned char* ws = WSP();
    const bf16* P = (const bf16*)(ws + WS_ACT); bf16* RKV = (bf16*)(ws + WS_XB); bf16* OD = (bf16*)(ws + WS_OD); float* LSE = (float*)(ws + WS_LSE);
    ret_phase_a_items(F, P, RKV);
    dil_tiles(F, F.bid, DIL_SPLIT, F.G, P, OD, LSE);
}
__device__ __forceinline__ void even_phase_b(const Frame& F0) {
    const Frame F = relaunder(F0);
    unsigned char* ws = WSP();
    const bf16* P = (const bf16*)(ws + WS_ACT); bf16* RKV = (bf16*)(ws + WS_XB); bf16* OD = (bf16*)(ws + WS_OD); float* LSE = (float*)(ws + WS_LSE);
    ret_scan(F, RKV);
    dil_tiles(F, DIL_SPLIT + F.bid, DIL_TILES, F.G, P, OD, LSE);
}
__device__ __forceinline__ void even_phase_c(const Frame& F0) {
    const Frame F = relaunder(F0);
    unsigned char* ws = WSP();
    const bf16* P = (const bf16*)(ws + WS_ACT); const bf16* RKV = (const bf16*)(ws + WS_XB); const bf16* OD = (const bf16*)(ws + WS_OD); const float* LSE = (const float*)(ws + WS_LSE); bf16* CAT = (bf16*)(ws + WS_CAT);
    ret_phase_c_items(F, P, RKV, CAT);
    dil_combine(F, OD, LSE, CAT);
}

__global__ void __launch_bounds__(NTHREADS, 2) fwd_kernel(Args args) {
    extern __shared__ __attribute__((aligned(16))) unsigned char lds[];
    Frame F;
    F.lds = (LAS unsigned char*)lds;
    F.wave = __builtin_amdgcn_readfirstlane((int)(threadIdx.x >> 6)); F.lane = hw_lane(); F.tid = F.wave * 64 + F.lane; F.G = gridDim.x; F.bid = blockIdx.x;
    for (int u = F.tid; u < (LDS_BYTES - LDSCTL_OFF) / 4; u += NTHREADS) ((LAS unsigned*)(F.lds + LDSCTL_OFF))[u] = 0u;
    __syncthreads();
    if (F.tid < N_PTRS) { const unsigned long long v = (F.tid < 17) ? (unsigned long long)args.in[F.tid] : (F.tid == 17 ? (unsigned long long)args.out : (unsigned long long)args.ws);
        ((LAS unsigned*)(F.lds + PTR_OFF))[2 * F.tid] = (unsigned)v; ((LAS unsigned*)(F.lds + PTR_OFF))[2 * F.tid + 1] = (unsigned)(v >> 32); }
    __syncthreads();
    (void)xcd_barrier_post((unsigned*)(WSP() + WS_CTL) + CW_BAR, (volatile LAS unsigned*)(F.lds + MISC_OFF) + 8, F.tid);
#ifdef PROBE_BARX2
#define PROBE_BAR2(b, t) xcd_barrier(b, t)
#else
#define PROBE_BAR2(b, t) do {} while (0)
#endif
#define GRID_BAR() do { XcdBarrier bar_; bar_.bar = (unsigned*)(WSP() + WS_CTL) + CW_BAR; bar_.x = (unsigned)__builtin_amdgcn_readfirstlane((int)xb_xcc_id()); \
        int mo_ = MISC_OFF + 32; asm volatile("" : "+s"(mo_)); bar_.st = (volatile LAS unsigned*)(F.lds + mo_); int t_ = threadIdx.x; asm volatile("" : "+v"(t_)); xcd_barrier(bar_, t_); PROBE_BAR2(bar_, t_); } while (0)
#define XB ((bf16*)(WSP() + WS_XB))
#define ACT ((bf16*)(WSP() + WS_ACT))
#define CAT ((bf16*)(WSP() + WS_CAT))
#define SSP ((float*)(WSP() + WS_SSP))
#define WPTR(off) ((const bf16*)(WSP() + (off)))

#ifdef TEST_MIN
    {
        pg8::Gemm g{XB, WPTR(W_GU0), M, 2 * FF, D}; pg8::StaticOrder S; S.init(M, 2 * FF, lnd(F.G), lnd(F.bid));
        pg8::EpiSwiGLU E{ACT, FF, SSP};
        pg8::gemm_phase<pg8::EpiSwiGLU, pg8::StaticOrder, true, true>(F.lds + RING_OFF, g, S, E, lnd(F.wave));
        GRID_BAR();
        return;
    }
#endif
    prologue_rows(F);
    convert_weights(F, 0);
    GRID_BAR();
    for (int s = 0; s < 8; ++s) {
        const int l = s >> 1; const bool post = (s & 1) != 0;
#ifdef PROBE_F1X2
        for (int rep = 0; rep < 2; ++rep)
#endif
        {
#ifdef PROBE_KX2
            typedef pg8::TwiceOrder F1Order;
#else
            typedef pg8::StaticOrder F1Order;
#endif
            pg8::Gemm g{XB, WPTR(post ? W_GU1 : W_GU0), M, 2 * FF, D}; F1Order S; S.init(M, 2 * FF, lnd(F.G), lnd(F.bid));
            pg8::EpiSwiGLU E{ACT, FF, SSP};
#ifndef NO_F1
            pg8::gemm_phase<pg8::EpiSwiGLU, F1Order, true, true>(F.lds + RING_OFF, g, S, E, lnd(F.wave));
#endif
            GRID_BAR();
        }
#ifdef PROBE_F2X2
        for (int rep = 0; rep < 2; ++rep)
#else
        constexpr int rep = 1;
#endif
        {
            pg8::Gemm g{ACT, WPTR(post ? W_D1 : W_D0), M, D, FF}; pg8::RevOrder S; S.init(M, D, lnd(F.G), lnd(F.bid));
            pg8::EpiResid E{s == 0 ? AP(I_X) : (const float*)OUTP(), OUTP(), XB, SSP, rep ? 0.5f : 0.0f};
#ifndef NO_F2
            pg8::gemm_phase<pg8::EpiResid, pg8::RevOrder, true, true>(F.lds + RING_OFF, g, S, E, lnd(F.wave));
#endif
            GRID_BAR();
        }
        if (!post) {
            const bool odd = (l & 1) != 0; const int nin = odd ? GLA_INP : EVEN_IN;
            {
                pg8::Gemm g{XB, WPTR(W_IN), M, nin, D}; pg8::StaticOrder S; S.init(M, nin, lnd(F.G), lnd(F.bid));
                pg8::EpiInProj E{ACT, nin, SSP, (const float*)(WSP() + TAB_RC), (const float*)(WSP() + TAB_RS), (const float*)(WSP() + TAB_DC), (const float*)(WSP() + TAB_DS), odd ? 0 : 1};
#ifndef NO_M1
                pg8::gemm_phase<pg8::EpiInProj, pg8::StaticOrder, true, true>(F.lds + RING_OFF, g, S, E, lnd(F.wave));
#endif
            }
            GRID_BAR();
#ifndef NO_EVEN
#if defined(PROBE_MIXX2) || defined(PROBE_EVENX2)
            if (!odd) { even_phase_a(F); GRID_BAR(); even_phase_a(F); GRID_BAR(); even_phase_b(F); GRID_BAR(); even_phase_c(F); GRID_BAR(); even_phase_c(F); }
#else
            if (!odd) { even_phase_a(F); GRID_BAR(); even_phase_b(F); GRID_BAR(); even_phase_c(F); }
#endif
#endif
#ifndef NO_GLA
            if (odd) {
#ifndef NO_GA
                gla_phase_a(F, l >> 1);
#endif
#ifdef PROBE_MIXX2
                GRID_BAR(); gla_phase_a(F, l >> 1);
#endif
                GRID_BAR();
#ifndef NO_GB
                gla_phase_b(F);
#endif
                GRID_BAR();
#ifndef NO_GC
                gla_phase_c(F, l >> 1);
#endif
#ifdef PROBE_MIXX2
                GRID_BAR(); gla_phase_c(F, l >> 1);
#endif
            }
#endif
            GRID_BAR();
#ifdef PROBE_M5X2
            for (int rep2 = 0; rep2 < 2; ++rep2)
#else
            constexpr int rep2 = 1;
#endif
            {
                pg8::Gemm g{CAT, WPTR(W_OUT), M, D, D}; pg8::StaticOrder S; S.init(M, D, lnd(F.G), lnd(F.bid));
                pg8::EpiResid E{(const float*)OUTP(), OUTP(), XB, SSP, rep2 ? 1.0f : 0.0f};
#ifndef NO_M5
                pg8::gemm_phase<pg8::EpiResid, pg8::StaticOrder, true, true>(F.lds + RING_OFF, g, S, E, lnd(F.wave));
#endif
                GRID_BAR();
            }
        } else if (l + 1 < DEPTH) {
            convert_weights(F, l + 1);
            GRID_BAR();
#ifdef PROBE_CONVX2
            convert_weights(F, l + 1);
            GRID_BAR();
#endif
        }
    }
    final_norm(F);
}

extern "C" void kernel_launch(void* const* d_in, const int* in_sizes, int n_in, void* d_out, int out_size, void* d_ws, size_t ws_size, hipStream_t stream) {
    static int grid = 0;
    if (grid == 0) {
        if (n_in != 17 || in_sizes[0] != M * D || out_size != M * D || ws_size < WS_END2) { fprintf(stderr, "kernel_launch: unexpected shapes (n_in %d, in0 %d, out %d, ws %zu)\n", n_in, n_in > 0 ? in_sizes[0] : -1, out_size, ws_size); grid = -1; return; }
        int dev = 0, cus = 0, per_cu = 0;
        if (hipGetDevice(&dev) != hipSuccess || hipDeviceGetAttribute(&cus, hipDeviceAttributeMultiprocessorCount, dev) != hipSuccess) { grid = -1; return; }
        if (hipFuncSetAttribute((const void*)fwd_kernel, hipFuncAttributeMaxDynamicSharedMemorySize, LDS_BYTES) != hipSuccess) { fprintf(stderr, "kernel_launch: hipFuncSetAttribute failed\n"); grid = -1; return; }
        if (hipOccupancyMaxActiveBlocksPerMultiprocessor(&per_cu, (const void*)fwd_kernel, NTHREADS, LDS_BYTES) != hipSuccess || per_cu < 1) { fprintf(stderr, "kernel_launch: occupancy query reports %d\n", per_cu); }
        (void)hipGetLastError();
        grid = cus;
        if (grid != 256) fprintf(stderr, "kernel_launch: %d CUs (expected 256)\n", grid);
    }
    if (grid < 0) return;
    if (hipMemsetAsync((char*)d_ws + WS_CTL, 0, CTL_ZERO_BYTES, stream) != hipSuccess) return;
    Args a{};
    for (int i = 0; i < 17; ++i) a.in[i] = (const float*)d_in[i];
    a.out = (float*)d_out; a.ws = (unsigned char*)d_ws;
    hipLaunchKernelGGL(fwd_kernel, dim3(grid), dim3(NTHREADS), LDS_BYTES, stream, a);
}
```

```cpp
#include <hip/hip_runtime.h>
#include <cstdio>
#include <cstdint>
#include <cmath>
template <int K> __device__ __forceinline__ float xsw(float v) { static_assert(K == 1 || K == 2 || K == 4 || K == 8 || K == 16, "xor mask inside a 32-lane half");
    return __builtin_bit_cast(float, __builtin_amdgcn_ds_swizzle(__builtin_bit_cast(int, v), 0x1F | (K << 10))); }
__device__ __forceinline__ float sum32(float v) { const unsigned u = __builtin_bit_cast(unsigned, v); auto rr = __builtin_amdgcn_permlane32_swap(u, u, false, false); return __builtin_bit_cast(float, (unsigned)rr[0]) + __builtin_bit_cast(float, (unsigned)rr[1]); }
__device__ __forceinline__ float max32(float v) { const unsigned u = __builtin_bit_cast(unsigned, v); auto rr = __builtin_amdgcn_permlane32_swap(u, u, false, false); return fmaxf(__builtin_bit_cast(float, (unsigned)rr[0]), __builtin_bit_cast(float, (unsigned)rr[1])); }
__device__ __forceinline__ float oth32(float v, int h) { const unsigned u = __builtin_bit_cast(unsigned, v); auto rr = __builtin_amdgcn_permlane32_swap(u, u, false, false); return __builtin_bit_cast(float, (unsigned)(h ? rr[0] : rr[1])); }
namespace pg8 {
#define PG8_LAS __attribute__((address_space(3)))
typedef unsigned short bf16_t;
typedef short bf16x8 __attribute__((ext_vector_type(8)));
typedef float f32x4 __attribute__((ext_vector_type(4)));
typedef unsigned u32x4 __attribute__((ext_vector_type(4)));
constexpr int BM = 256, BK = 64, HALF = 128, HTB = HALF * BK * 2  , STAGE_BYTES = 8 * HTB, NXCD = 8, WGM = 8;

__host__ __device__ __forceinline__ int lds_byte(int r, int c) { const int st = (r >> 4) * 2 + (c >> 5), rr = r & 15, cc = c & 31, ob = rr * 64 + cc * 2; return st * 1024 + (ob ^ (((ob >> 9) & 1) << 5)); }
__host__ __device__ __forceinline__ void stage_rc(int b, int& R, int& C) { const int st = b / 1024, sb = b % 1024, swz = sb ^ (((sb >> 9) & 1) << 5); R = (st >> 1) * 16 + swz / 64; C = (st & 1) * 32 + (swz % 64) / 2; }
__host__ __device__ __forceinline__ int perm32(int rho) { const int n = rho >> 4, i = rho & 15; return 8 * (i >> 2) + 4 * n + (i & 3); }

struct Unit { int pm, pn; };
struct Gemm { const bf16_t* A; const bf16_t* Bt; int M, N, K; };

struct StaticOrder {
    int nM, nN, nwg, G, c;
    __host__ __device__ void init(int M, int N, int G_, int c_) { nM = M / BM; nN = N / BM; nwg = nM * nN; G = G_; c = c_; }
    __host__ __device__ bool next(int i, Unit& u) const {
        const long L = (long)i * G + c; if (L >= nwg) return false;
        int wgid = (int)L; { const int q = nwg / NXCD, r = nwg % NXCD, xcd = wgid % NXCD, off = wgid / NXCD; wgid = (xcd < r ? xcd * (q + 1) : r * (q + 1) + (xcd - r) * q) + off; }
        const int nig = WGM * nN, gid = wgid / nig, fm = gid * WGM, gsz = (nM - fm) < WGM ? (nM - fm) : WGM;
        u.pm = fm + ((wgid % nig) % gsz); u.pn = (wgid % nig) / gsz; return true;
    }
    __device__ __forceinline__ void a_ready(const Unit&) const {}
    __device__ __forceinline__ void done(const Unit&) const {}
    static constexpr bool TWICE = false;
};
struct RevOrder : StaticOrder {
    __host__ __device__ bool next(int i, Unit& u) const { const int rounds = nwg / G; if (i >= rounds) return false; return StaticOrder::next(rounds - 1 - i, u); }
};
struct TwiceOrder : StaticOrder {
    static constexpr bool TWICE = true;
    __host__ __device__ bool next(int i, Unit& u) const { return StaticOrder::next(i >> 1, u); }
};

__device__ __forceinline__ unsigned cvt_pk_bf16(float lo, float hi) { unsigned r; asm volatile("v_cvt_pk_bf16_f32 %0, %1, %2" : "=v"(r) : "v"(lo), "v"(hi)); return r; }
constexpr int MROWS = 32768;
constexpr float RMS_EPS = 1e-6f;
__device__ __forceinline__ void row_rstd(float (&rs)[2][4], const float* ssp, const Unit& u, int wr, int fr, int fq) {
#pragma unroll
    for (int ai = 0; ai < 2; ++ai)
#pragma unroll
        for (int m = 0; m < 4; ++m) {
            const int row = u.pm * BM + ai * HALF + wr * 64 + m * 16 + fr;
            const f32x4 p = *(const f32x4*)(ssp + (size_t)row * 16 + 4 * fq);
            float s = (p[0] + p[1]) + (p[2] + p[3]);
            s += xsw<16>(s); s = sum32(s);
            rs[ai][m] = 1.0f / sqrtf(s * (1.0f / 1024.0f) + RMS_EPS);
        }
}
__device__ __forceinline__ float silu_f(float g) { return g * __builtin_amdgcn_rcpf(1.0f + __builtin_amdgcn_exp2f(-1.4426950408889634f * g)); }

struct EpiSwiGLU {
    static constexpr bool PERM = true, AFTER_DRAIN = false;
    bf16_t* H; int ldh; const float* ssp;
    __device__ __forceinline__ void operator()(const f32x4 (&acc)[2][2][4][2], const Unit& u, int wr, int wc, int fr, int fq) const {
        float rs[2][4]; row_rstd(rs, ssp, u, wr, fr, fq);
        const int col0 = u.pn * HALF + wc * 32 + 8 * fq;
#pragma unroll
        for (int ai = 0; ai < 2; ++ai)
#pragma unroll
            for (int m = 0; m < 4; ++m) {
                const int row = u.pm * BM + ai * HALF + wr * 64 + m * 16 + fr; const float r = rs[ai][m];
                float h[8];
#pragma unroll
                for (int n = 0; n < 2; ++n)
#pragma unroll
                    for (int i = 0; i < 4; ++i) { const float g = acc[ai][0][m][n][i] * r, up = acc[ai][1][m][n][i] * r; h[4 * n + i] = silu_f(g) * up; }
                u32x4 w; w.x = cvt_pk_bf16(h[0], h[1]); w.y = cvt_pk_bf16(h[2], h[3]); w.z = cvt_pk_bf16(h[4], h[5]); w.w = cvt_pk_bf16(h[6], h[7]);
                *(u32x4*)(H + (size_t)row * ldh + col0) = w;
                asm volatile("" ::: "memory");
            }
    }
};
struct EpiInProj {
    static constexpr bool PERM = true, AFTER_DRAIN = false;
    bf16_t* O; int ldc; const float* ssp; const float* rc; const float* rs; const float* dc; const float* ds; int even;
    __device__ __forceinline__ void operator()(const f32x4 (&acc)[2][2][4][2], const Unit& u, int wr, int wc, int fr, int fq) const {
        float rsd[2][4]; row_rstd(rsd, ssp, u, wr, fr, fq);
        const int col0 = u.pn * BM + wc * 32 + 8 * fq;
        const int kind = even ? (u.pn < 4 ? 1 : ((u.pn >= 8 && u.pn < 12) ? 2 : 0)) : 0;
        const float ksc = (kind == 1 && u.pn >= 2) ? 0.08838834764831845f : 1.0f;
        const bool rot2 = (kind == 2) && ((wc & 1) == 0) && (fq < 2);
        const float* tc = (kind == 1) ? rc + wc * 16 + 4 * fq : dc + 4 * (fq & 1);
        const float* ts = (kind == 1) ? rs + wc * 16 + 4 * fq : ds + 4 * (fq & 1);
        const int tstride = (kind == 1) ? 64 : 8;
#pragma unroll
        for (int ai = 0; ai < 2; ++ai)
#pragma unroll
            for (int m = 0; m < 4; ++m) {
                const int row = u.pm * BM + ai * HALF + wr * 64 + m * 16 + fr; const float r = rsd[ai][m] * ksc;
                f32x4 c4 = {1.f, 1.f, 1.f, 1.f}, s4 = {0.f, 0.f, 0.f, 0.f};
                if (kind == 1 || rot2) { const int pos = row & 4095; c4 = *(const f32x4*)(tc + (size_t)pos * tstride); s4 = *(const f32x4*)(ts + (size_t)pos * tstride); }
#pragma unroll
                for (int bj = 0; bj < 2; ++bj) { const f32x4 v0 = acc[ai][bj][m][0] * r, v1 = acc[ai][bj][m][1] * r;
                    const float o0 = v0[0] * c4[0] - v0[1] * s4[0], o1 = v0[1] * c4[0] + v0[0] * s4[0], o2 = v0[2] * c4[1] - v0[3] * s4[1], o3 = v0[3] * c4[1] + v0[2] * s4[1];
                    const float o4 = v1[0] * c4[2] - v1[1] * s4[2], o5 = v1[1] * c4[2] + v1[0] * s4[2], o6 = v1[2] * c4[3] - v1[3] * s4[3], o7 = v1[3] * c4[3] + v1[2] * s4[3];
                    u32x4 w; w.x = cvt_pk_bf16(o0, o1); w.y = cvt_pk_bf16(o2, o3); w.z = cvt_pk_bf16(o4, o5); w.w = cvt_pk_bf16(o6, o7);
                    *(u32x4*)(O + (size_t)row * ldc + col0 + bj * HALF) = w; }
                asm volatile("" ::: "memory");
            }
    }
};
struct EpiResid {
    static constexpr bool PERM = true, AFTER_DRAIN = false;
    bf16_t* xb; float* ssp; float scale;
    __device__ __forceinline__ void operator()(const f32x4 (&acc)[2][2][4][2], const Unit& u, int wr, int wc, int fr, int fq) const {
        const int col0 = u.pn * BM + wc * 32 + 8 * fq, rowb = u.pm * BM + wr * 64 + fr;
        u32x4 old[8][2];
#pragma unroll
        for (int g = 0; g < 8; ++g) { const size_t off = (size_t)(rowb + (g >> 2) * HALF + (g & 3) * 16) * 1024 + col0; old[g][0] = *(const u32x4*)(xb + off); old[g][1] = *(const u32x4*)(xb + off + HALF); }
#pragma unroll
        for (int g = 0; g < 8; ++g) {
            const int ai = g >> 2, m = g & 3, row = rowb + ai * HALF + m * 16; float ss = 0.f;
#pragma unroll
            for (int bj = 0; bj < 2; ++bj) { const size_t off = (size_t)row * 1024 + col0 + bj * HALF; const u32x4 o = old[g][bj];
                const f32x4 a0 = acc[ai][bj][m][0] * scale, a1 = acc[ai][bj][m][1] * scale;
                const float v0 = __builtin_bit_cast(float, o.x << 16) + a0[0], v1 = __builtin_bit_cast(float, o.x & 0xffff0000u) + a0[1], v2 = __builtin_bit_cast(float, o.y << 16) + a0[2], v3 = __builtin_bit_cast(float, o.y & 0xffff0000u) + a0[3];
                const float v4 = __builtin_bit_cast(float, o.z << 16) + a1[0], v5 = __builtin_bit_cast(float, o.z & 0xffff0000u) + a1[1], v6 = __builtin_bit_cast(float, o.w << 16) + a1[2], v7 = __builtin_bit_cast(float, o.w & 0xffff0000u) + a1[3];
                u32x4 w; w.x = cvt_pk_bf16(v0, v1); w.y = cvt_pk_bf16(v2, v3); w.z = cvt_pk_bf16(v4, v5); w.w = cvt_pk_bf16(v6, v7);
                *(u32x4*)(xb + off) = w;
                ss += (v0 * v0 + v1 * v1) + (v2 * v2 + v3 * v3) + (v4 * v4 + v5 * v5) + (v6 * v6 + v7 * v7); }
            ss += xsw<16>(ss); ss = sum32(ss);
            if (fq == 0) ssp[(size_t)row * 16 + u.pn * 4 + wc] = ss;
        }
    }
};

template <class Epi, class Sched, bool ALIGN_EPI = false, bool SP2 = false>
__device__ __forceinline__ void gemm_phase(PG8_LAS unsigned char* lds, const Gemm g, const Sched& S, const Epi& E, int wave_in) {
    int tid_ = threadIdx.x; asm volatile("" : "+v"(tid_));
    const int tid = tid_, wid = __builtin_amdgcn_readfirstlane(tid >> 6), lane = tid & 63, wr = wid >> 2, wc = wid & 3, fr = lane & 15, fq = lane >> 4;
    const int K = g.K, nt = K / BK;
    unsigned voffA[2], voffB[2];
#pragma unroll
    for (int i = 0; i < 2; ++i) { int R, C; stage_rc(tid * 16 + i * 8192, R, C); const int Rb = Epi::PERM ? ((R & ~31) + perm32(R & 31)) : R;
        voffA[i] = (unsigned)(R * K + C) * 2u; voffB[i] = (unsigned)(Rb * K + C) * 2u; }
    const size_t kstep = (size_t)(BK * 2);
    const size_t hstep = (size_t)HALF * K * 2;
    const size_t tstep = 2 * hstep;
    const unsigned ldsw = (unsigned)wid * 1024u;
    const int aoff = lds_byte(wr * 64 + fr, fq * 8), boff = lds_byte(wc * 32 + fr, fq * 8);
#define PG8_SA(b, h) (((b) * 2 + (h)) * HTB)
#define PG8_SB(b, h) ((4 + (b) * 2 + (h)) * HTB)
#define PG8_STAGE(bufoff, gbase, voff) do { _Pragma("unroll") for (int _i = 0; _i < 2; ++_i) \
        __builtin_amdgcn_global_load_lds((const unsigned*)((const char*)(gbase) + (voff)[_i]), (PG8_LAS unsigned*)(lds + (bufoff) + ldsw + _i * 8192), 16, 0, 0); } while (0)
#define PG8_LDA(dst, b, h) do { _Pragma("unroll") for (int m = 0; m < 4; ++m) _Pragma("unroll") for (int k = 0; k < 2; ++k) dst[m][k] = *(const PG8_LAS bf16x8*)(lds + PG8_SA(b, h) + aoff + m * 2048 + k * 1024); } while (0)
#define PG8_LDB(dst, b, h) do { _Pragma("unroll") for (int n = 0; n < 2; ++n) _Pragma("unroll") for (int k = 0; k < 2; ++k) dst[n][k] = *(const PG8_LAS bf16x8*)(lds + PG8_SB(b, h) + boff + n * 2048 + k * 1024); } while (0)
#define PG8_MMA(ai, bj, At, Bt) do { __builtin_amdgcn_s_setprio(1); _Pragma("unroll") for (int m = 0; m < 4; ++m) _Pragma("unroll") for (int n = 0; n < 2; ++n) _Pragma("unroll") for (int k = 0; k < 2; ++k) \
        acc[ai][bj][m][n] = __builtin_amdgcn_mfma_f32_16x16x32_bf16(Bt[n][k], At[m][k], acc[ai][bj][m][n], 0, 0, 0); __builtin_amdgcn_s_setprio(0); } while (0)
#define PG8_WAIT_V(n) asm volatile("s_waitcnt vmcnt(" #n ")" ::: "memory")
#define PG8_WAIT_L(n) asm volatile("s_waitcnt lgkmcnt(" #n ")" ::: "memory")
#define PG8_BAR __builtin_amdgcn_s_barrier()
#define PG8_SCHED __builtin_amdgcn_sched_barrier(0)
    Unit cur, nxt; int ui = 0;
    if (!S.next(0, cur)) return;
    f32x4 acc[2][2][4][2];
#pragma unroll
    for (int a = 0; a < 2; ++a)
#pragma unroll
        for (int b = 0; b < 2; ++b)
#pragma unroll
            for (int m = 0; m < 4; ++m)
#pragma unroll
                for (int n = 0; n < 2; ++n) acc[a][b][m][n] = (f32x4){0.f, 0.f, 0.f, 0.f};
    bf16x8 At[4][2], B0[2][2], B1[2][2];
    const char* cA = (const char*)g.A + (size_t)cur.pm * tstep; const char* cB = (const char*)g.Bt + (size_t)cur.pn * tstep;
    S.a_ready(cur);
    if constexpr (SP2) {
        PG8_STAGE(PG8_SB(0, 0), cB, voffB); PG8_STAGE(PG8_SB(0, 1), cB + hstep, voffB); PG8_STAGE(PG8_SA(0, 0), cA, voffA); PG8_STAGE(PG8_SA(0, 1), cA + hstep, voffA);
        if (wr == 1) PG8_BAR;
        PG8_WAIT_V(2); PG8_BAR;
        PG8_STAGE(PG8_SB(1, 0), cB + kstep, voffB); PG8_STAGE(PG8_SA(1, 0), cA + kstep, voffA); PG8_STAGE(PG8_SB(1, 1), cB + hstep + kstep, voffB);
        PG8_WAIT_V(6); PG8_BAR;
    } else {
        PG8_STAGE(PG8_SB(0, 0), cB, voffB); PG8_STAGE(PG8_SA(0, 0), cA, voffA); PG8_STAGE(PG8_SB(0, 1), cB + hstep, voffB); PG8_STAGE(PG8_SA(0, 1), cA + hstep, voffA);
        if (wr == 1) PG8_BAR;
        PG8_WAIT_V(4); PG8_BAR;
        PG8_STAGE(PG8_SB(1, 0), cB + kstep, voffB); PG8_STAGE(PG8_SA(1, 0), cA + kstep, voffA); PG8_STAGE(PG8_SB(1, 1), cB + hstep + kstep, voffB);
        PG8_WAIT_V(6); PG8_BAR;
    }
    for (;;) {
        const bool has_next = S.next(ui + 1, nxt);
        const char* nA = has_next ? (const char*)g.A + (size_t)nxt.pm * tstep : cA; const char* nB = has_next ? (const char*)g.Bt + (size_t)nxt.pn * tstep : cB;
        for (int t = 0; t < nt; t += 2) {
            const bool last = (t == nt - 2);
            const char* a1 = cA + (size_t)(t + 1) * kstep;
            const char* a2 = last ? nA : cA + (size_t)(t + 2) * kstep; const char* b2 = last ? nB : cB + (size_t)(t + 2) * kstep;
            const char* a3 = a2 + kstep; const char* b3 = b2 + kstep;
            if (last && has_next) S.a_ready(nxt);
            if constexpr (SP2) {
            PG8_LDB(B0, 0, 0); PG8_LDB(B1, 0, 1); PG8_SCHED; PG8_LDA(At, 0, 0); PG8_STAGE(PG8_SA(1, 1), a1 + hstep, voffA);
            PG8_WAIT_V(8); PG8_WAIT_L(0); PG8_BAR; PG8_MMA(0, 0, At, B0); PG8_MMA(0, 1, At, B1); PG8_BAR; PG8_SCHED;
            PG8_LDA(At, 0, 1); PG8_STAGE(PG8_SB(0, 0), b2, voffB); PG8_STAGE(PG8_SB(0, 1), b2 + hstep, voffB); PG8_STAGE(PG8_SA(0, 0), a2, voffA);
            PG8_WAIT_V(8); PG8_WAIT_L(0); PG8_BAR; PG8_MMA(1, 0, At, B0); PG8_MMA(1, 1, At, B1); PG8_BAR; PG8_SCHED;
            PG8_LDB(B0, 1, 0); PG8_LDB(B1, 1, 1); PG8_SCHED; PG8_LDA(At, 1, 0); PG8_STAGE(PG8_SA(0, 1), a2 + hstep, voffA);
            PG8_WAIT_V(8); PG8_WAIT_L(0); PG8_BAR; PG8_MMA(0, 0, At, B0); PG8_MMA(0, 1, At, B1); PG8_BAR; PG8_SCHED;
            PG8_LDA(At, 1, 1); PG8_STAGE(PG8_SB(1, 0), b3, voffB); PG8_STAGE(PG8_SB(1, 1), b3 + hstep, voffB); PG8_STAGE(PG8_SA(1, 0), a3, voffA);
            PG8_WAIT_V(8); PG8_WAIT_L(0); PG8_BAR; PG8_MMA(1, 0, At, B0); PG8_MMA(1, 1, At, B1); PG8_BAR; PG8_SCHED;
            } else {
            PG8_LDB(B0, 0, 0); PG8_SCHED; PG8_LDA(At, 0, 0); PG8_STAGE(PG8_SA(1, 1), a1 + hstep, voffA);
            PG8_WAIT_L(8); PG8_BAR; PG8_WAIT_L(0); PG8_MMA(0, 0, At, B0); PG8_BAR; PG8_SCHED;
            PG8_LDB(B1, 0, 1); PG8_STAGE(PG8_SB(0, 0), b2, voffB);
            PG8_BAR; PG8_WAIT_L(0); PG8_MMA(0, 1, At, B1); PG8_BAR;
            PG8_LDA(At, 0, 1); PG8_STAGE(PG8_SA(0, 0), a2, voffA);
            PG8_BAR; PG8_WAIT_L(0); PG8_MMA(1, 0, At, B0); PG8_BAR; PG8_SCHED;
            PG8_STAGE(PG8_SB(0, 1), b2 + hstep, voffB);
            PG8_WAIT_V(6); PG8_BAR; PG8_MMA(1, 1, At, B1); PG8_BAR;
            PG8_LDB(B0, 1, 0); PG8_SCHED; PG8_LDA(At, 1, 0); PG8_STAGE(PG8_SA(0, 1), a2 + hstep, voffA);
            PG8_WAIT_L(8); PG8_BAR; PG8_WAIT_L(0); PG8_MMA(0, 0, At, B0); PG8_BAR; PG8_SCHED;
            PG8_LDB(B1, 1, 1); PG8_STAGE(PG8_SB(1, 0), b3, voffB);
            PG8_BAR; PG8_WAIT_L(0); PG8_MMA(0, 1, At, B1); PG8_BAR;
            PG8_LDA(At, 1, 1); PG8_STAGE(PG8_SA(1, 0), a3, voffA);
            PG8_BAR; PG8_WAIT_L(0); PG8_MMA(1, 0, At, B0); PG8_BAR; PG8_SCHED;
            PG8_STAGE(PG8_SB(1, 1), b3 + hstep, voffB);
            PG8_WAIT_V(6); PG8_BAR; PG8_MMA(1, 1, At, B1); PG8_BAR;
            }
        }
        if constexpr (ALIGN_EPI) { if (wr == 0) PG8_BAR; }
        if constexpr (!Epi::AFTER_DRAIN) { if (!Sched::TWICE || (ui & 1)) { E(acc, cur, wr, wc, fr, fq); S.done(cur); } }
        if (!has_next) break;
#pragma unroll
        for (int a = 0; a < 2; ++a)
#pragma unroll
            for (int b = 0; b < 2; ++b)
#pragma unroll
                for (int m = 0; m < 4; ++m)
#pragma unroll
                    for (int n = 0; n < 2; ++n) acc[a][b][m][n] = (f32x4){0.f, 0.f, 0.f, 0.f};
        cur = nxt; cA = nA; cB = nB; ++ui;
        if constexpr (ALIGN_EPI) { if (wr == 1) PG8_BAR; }
    }
    PG8_WAIT_V(0);
    if constexpr (!ALIGN_EPI) { if (wr == 0) PG8_BAR; }
    PG8_BAR;
    if constexpr (Epi::AFTER_DRAIN) { E.fused(acc, cur, wr, wc, fr, fq, lds, wid, lane); S.done(cur); }
#undef PG8_SA
#undef PG8_SB
#undef PG8_STAGE
#undef PG8_LDA
#undef PG8_LDB
#undef PG8_MMA
#undef PG8_WAIT_V
#undef PG8_WAIT_L
#undef PG8_BAR
#undef PG8_SCHED
}
}

constexpr int NWAVES = 8, NTHREADS = NWAVES * 64;
constexpr int BATCH = 8, SEQ = 4096, D = 1024, M = BATCH * SEQ, FF = 2816, DEPTH = 4;
constexpr int EVEN_IN = 3584, GLA_IN = 3088, GLA_INP = 3328;
static_assert(M == pg8::MROWS, "row count");
constexpr int E_RQ = 0, E_RK = 512, E_RV = 1024, E_RG = 1536, E_DQ = 2048, E_DK = 2560, E_DV = 3072;
constexpr int G_Q = 0, G_K = 512, G_V = 1024, G_R = 2048, G_A = 3072;
constexpr float EPS = 1e-6f;

constexpr size_t MiB = 1u << 20;
constexpr size_t WS_CTL = 0, CTL_ZERO_BYTES = 1 * MiB;
constexpr size_t WS_SSP = 1 * MiB;
constexpr size_t WS_TAB = 3 * MiB;
constexpr size_t TAB_RC = WS_TAB, TAB_RS = WS_TAB + 1 * MiB, TAB_DC = WS_TAB + 2 * MiB, TAB_DS = WS_TAB + 2 * MiB + 128 * 1024;
constexpr size_t WS_W = 8 * MiB;
constexpr size_t W_GU0 = WS_W, W_D0 = W_GU0 + (size_t)2 * FF * D * 2, W_GU1 = W_D0 + (size_t)D * FF * 2, W_D1 = W_GU1 + (size_t)2 * FF * D * 2,
                 W_IN = W_D1 + (size_t)D * FF * 2, W_OUT = W_IN + (size_t)EVEN_IN * D * 2, W_END = W_OUT + (size_t)D * D * 2;
constexpr size_t WS_XB = 56 * MiB;
constexpr size_t WS_ACT = 120 * MiB;
constexpr size_t WS_CAT = 344 * MiB;
constexpr size_t WS_END = 408 * MiB;
static_assert(W_END <= WS_XB && WS_XB + (size_t)M * D * 2 <= WS_ACT && WS_ACT + (size_t)M * EVEN_IN * 2 <= WS_CAT && WS_CAT + (size_t)M * D * 2 <= WS_END, "d_ws map");
constexpr int CW_BAR = 4096;

constexpr int RING_OFF = 0, RING_BYTES = 131072;
constexpr int LDSCTL_OFF = 161792, MISC_OFF = LDSCTL_OFF + 320, PTR_OFF = LDSCTL_OFF + 1024;
constexpr int LDS_BYTES = 163840;
static_assert(PTR_OFF + 19 * 8 <= LDS_BYTES && RING_BYTES <= LDSCTL_OFF, "LDS map");

#define GAS __attribute__((address_space(1)))
#define LAS __attribute__((address_space(3)))
typedef unsigned short bf16;
typedef unsigned v4u __attribute__((ext_vector_type(4)));
typedef float f32x4 __attribute__((ext_vector_type(4)));
typedef short bf16x8 __attribute__((ext_vector_type(8)));
typedef GAS unsigned gu32;
typedef GAS unsigned long long gu64;
#define RLX_AGENT __ATOMIC_RELAXED, __HIP_MEMORY_SCOPE_AGENT
#define LDS_WAIT() asm volatile("s_waitcnt lgkmcnt(0)" ::: "memory")
#define VM_WAIT() asm volatile("s_waitcnt vmcnt(0)" ::: "memory")
__device__ __forceinline__ unsigned long long rt() { return __builtin_amdgcn_s_memrealtime(); }
__device__ __forceinline__ unsigned f2bf(float f) { unsigned u = __builtin_bit_cast(unsigned, f); return (u + 0x7fffu + ((u >> 16) & 1u)) >> 16; }
__device__ __forceinline__ unsigned pk2(float lo, float hi) { return f2bf(lo) | (f2bf(hi) << 16); }

#define XB_TMO      128
#define XB_XCNT(j)  (256  + 64 * (j))
#define XB_XSUB(j)  (1280 + 64 * (j))
#define XB_XGEN(j)  (2304 + 64 * (j))
#define XB_TOP      3328
#define XB_TOPGEN   3392
#define XCD_BAR_WORDS 3456
#define XB_SPIN_CAP (1u << 18)

__device__ __forceinline__ unsigned xb_ld(unsigned* p)              { return __hip_atomic_load(p, __ATOMIC_RELAXED, __HIP_MEMORY_SCOPE_AGENT); }
__device__ __forceinline__ unsigned xb_add(unsigned* p, unsigned v) { return __hip_atomic_fetch_add(p, v, __ATOMIC_RELAXED, __HIP_MEMORY_SCOPE_AGENT); }
__device__ __forceinline__ unsigned xb_xcc_id() { return (unsigned)__builtin_amdgcn_s_getreg((3 << 11) | 20) & 0xFu; }
#define XB_SPIN(cond, bar) do { unsigned _sp = 0; while (cond) { __builtin_amdgcn_s_sleep(1); \
    if ((++_sp & 255u) == 0u) { if (xb_ld(&(bar)[XB_TMO])) break; if (_sp > XB_SPIN_CAP) { atomicAdd(&(bar)[XB_TMO], 1u); break; } } } } while (0)

struct XcdBarrier {
    unsigned* bar; unsigned x;
    volatile LAS unsigned* st;
};

__device__ __forceinline__ XcdBarrier xcd_barrier_post(unsigned* bar, volatile LAS unsigned* st, int tid) {
    XcdBarrier b; b.bar = bar; b.x = xb_xcc_id(); b.st = st;
    if (tid == 0) (void)xb_add(&bar[XB_XCNT(b.x)], 1u);
    return b;
}
__device__ __forceinline__ void xcd_barrier_complete(unsigned* bar, unsigned x, unsigned& nloc, unsigned& nx) {
    const unsigned G = gridDim.x * gridDim.y * gridDim.z;
    unsigned sum, cnt, mine, sp = 0u;
    for (;;) {
        sum = 0u; cnt = 0u; mine = 0u;
#pragma unroll
        for (unsigned j = 0; j < 16; ++j) { const unsigned c = xb_ld(&bar[XB_XCNT(j)]); sum += c; cnt += (c > 0u) ? 1u : 0u; mine = (j == x) ? c : mine; }
        if (sum == G) break;
        __builtin_amdgcn_s_sleep(1);
        if ((++sp & 255u) == 0u) { if (xb_ld(&bar[XB_TMO])) break; if (sp > XB_SPIN_CAP) { atomicAdd(&bar[XB_TMO], 1u); break; } }
    }
    nloc = mine > 0u ? mine : 1u; nx = cnt > 0u ? cnt : 1u;
}

__device__ __forceinline__ void xcd_barrier(const XcdBarrier& b, int tid) {
    asm volatile("s_waitcnt vmcnt(0)" ::: "memory");
    __syncthreads();
    if (tid == 0) {
        unsigned* bar = b.bar;
        __builtin_amdgcn_s_waitcnt(0);
        unsigned nloc = b.st[0], nx = b.st[1];
        if (nloc == 0u) { xcd_barrier_complete(bar, b.x, nloc, nx); b.st[0] = nloc; b.st[1] = nx; }
        const unsigned old = xb_add(&bar[XB_XSUB(b.x)], 1u);
        const unsigned gen = old / nloc;
        if (old + 1u == (gen + 1u) * nloc) {
            __builtin_amdgcn_fence(__ATOMIC_RELEASE, "agent");
            asm volatile("s_waitcnt vmcnt(0)" ::: "memory");
            const unsigned og = xb_add(&bar[XB_TOP], 1u);
            const unsigned tg = og / nx;
            if (og + 1u == (tg + 1u) * nx) xb_add(&bar[XB_TOPGEN], 1u);
            else XB_SPIN(xb_ld(&bar[XB_TOPGEN]) == tg, bar);
            __builtin_amdgcn_fence(__ATOMIC_ACQUIRE, "agent");
            xb_add(&bar[XB_XGEN(b.x)], 1u);
            asm volatile("s_waitcnt vmcnt(0)" ::: "memory");
        } else {
            XB_SPIN(xb_ld(&bar[XB_XGEN(b.x)]) == gen, bar);
            __builtin_amdgcn_fence(__ATOMIC_ACQUIRE, "agent");
            asm volatile("s_waitcnt vmcnt(0)" ::: "memory");
        }
    }
    __syncthreads();
}

__constant__ float RET_FREQ[64] = {1.000000000e+00f, 8.639884591e-01f, 7.464760542e-01f, 6.449466944e-01f, 5.572264791e-01f, 4.814372361e-01f, 4.159561992e-01f, 3.593813777e-01f, 3.105013371e-01f, 2.682695687e-01f, 2.317818105e-01f, 2.002568096e-01f, 1.730195731e-01f, 1.494869143e-01f, 1.291549653e-01f, 1.115883961e-01f, 9.641107172e-02f, 8.329805732e-02f, 7.196855545e-02f, 6.218000501e-02f, 5.372280627e-02f, 4.641588405e-02f, 4.010278732e-02f, 3.464834765e-02f, 2.993577160e-02f, 2.586415969e-02f, 2.234633639e-02f, 1.930697635e-02f, 1.668100432e-02f, 1.441219542e-02f, 1.245197095e-02f, 1.075835899e-02f, 9.295095690e-03f, 8.030855097e-03f, 6.938565988e-03f, 5.994840991e-03f, 5.179473665e-03f, 4.475005437e-03f, 3.866352839e-03f, 3.340484342e-03f, 2.886139788e-03f, 2.493591513e-03f, 2.154434333e-03f, 1.861406374e-03f, 1.608233666e-03f, 1.389495330e-03f, 1.200507861e-03f, 1.037224894e-03f, 8.961503627e-04f, 7.742635789e-04f, 6.689548027e-04f, 5.779692437e-04f, 4.993587499e-04f, 4.314401885e-04f, 3.727593285e-04f, 3.220597573e-04f, 2.782559313e-04f, 2.404099068e-04f, 2.077113895e-04f, 1.794602431e-04f, 1.550515735e-04f, 1.339627634e-04f, 1.157422885e-04f, 9.999999747e-05f};
__constant__ float ROPE_FREQ[8] = {1.000000000e+00f, 1.939227432e-01f, 3.760603070e-02f, 7.292664610e-03f, 1.414213562e-03f, 2.742481884e-04f, 5.318295734e-05f, 1.031338525e-05f};
struct Args { const float* in[17]; float* out; unsigned char* ws; };
enum { I_X = 0, I_PRE_NORM = 1, I_PRE_WG = 2, I_PRE_WU = 3, I_PRE_WD = 4, I_MIX_NORM = 5, I_AB_IN = 6, I_AB_OUT = 7, I_GLA_IN = 8, I_GLA_A2 = 9, I_GLA_BA = 10, I_GLA_OUT = 11,
       I_POST_NORM = 12, I_POST_WG = 13, I_POST_WU = 14, I_POST_WD = 15, I_FINAL = 16, I_OUT = 17, I_WS = 18, N_PTRS = 19 };
struct Frame {
    LAS unsigned char* lds;
    int tid, lane, wave, G, bid;
};
__device__ __forceinline__ unsigned char* tabp(const Frame& F, int idx) {
    int off_ = PTR_OFF + 8 * idx; asm volatile("" : "+s"(off_));
    const volatile LAS unsigned* T = (const volatile LAS unsigned*)(F.lds + off_);
    const unsigned lo = __builtin_amdgcn_readfirstlane(T[0]), hi = __builtin_amdgcn_readfirstlane(T[1]);
    GAS unsigned char* gp_ = (GAS unsigned char*)(((unsigned long long)hi << 32) | (unsigned long long)lo);
    return (unsigned char*)gp_;
}
#define AP(idx) ((const float*)tabp(F, idx))
#define WSP() tabp(F, I_WS)
#define OUTP() ((float*)tabp(F, I_OUT))
__device__ __forceinline__ int lnd(int v) { asm volatile("" : "+s"(v)); return v; }
__device__ __forceinline__ int hw_lane() { return (int)__builtin_amdgcn_mbcnt_hi(~0u, __builtin_amdgcn_mbcnt_lo(~0u, 0u)); }
__device__ __forceinline__ Frame relaunder(const Frame& F0) { Frame F = F0; int t_ = threadIdx.x; asm volatile("" : "+v"(t_)); asm volatile("" : "+s"(F.bid)); F.tid = t_; F.lane = F.tid & 63; F.wave = __builtin_amdgcn_readfirstlane(F.tid >> 6);
    unsigned lb_ = 0u; asm volatile("" : "+s"(lb_)); F.lds = F0.lds + lb_; return F; }
__device__ __forceinline__ float wave_sum(float v) {
    v += xsw<1>(v); v += xsw<2>(v); v += xsw<4>(v); v += xsw<8>(v); v += xsw<16>(v);
    return sum32(v);
}
__device__ __forceinline__ float bf2f(bf16 h) { return __builtin_bit_cast(float, (unsigned)h << 16); }
__device__ __forceinline__ float bflo(unsigned w) { return __builtin_bit_cast(float, w << 16); }
__device__ __forceinline__ float bfhi(unsigned w) { return __builtin_bit_cast(float, w & 0xffff0000u); }
__device__ __forceinline__ bf16 f2bf_rne(float f) { return (bf16)f2bf(f); }

__device__ __forceinline__ void tr_item(const float* W, int K, int N, int Npad, const float* gain, bf16* WT, int gu, LAS float* scr, int item, int lane) {
    const int nblk = Npad / 32, kb = item / nblk, nb = item % nblk, k0 = 64 * kb, n0 = 32 * nb;
    {
        const int c4 = lane & 7; const bool ok = n0 + 4 * c4 < N;
        const GAS float* src = (const GAS float*)W + (size_t)(k0 + (lane >> 3)) * N + n0 + 4 * c4;
        f32x4 v[8];
#pragma unroll
        for (int i = 0; i < 8; ++i) v[i] = ok ? *(const GAS f32x4*)(src + (size_t)(8 * i) * N) : (f32x4){0.f, 0.f, 0.f, 0.f};
#pragma unroll
        for (int i = 0; i < 8; ++i) { const int kk = 8 * i + (lane >> 3); const float gn = gain ? ((const GAS float*)gain)[k0 + kk] : 1.0f; LAS float* s = scr + kk * 33 + 4 * c4;
            s[0] = v[i][0] * gn; s[1] = v[i][1] * gn; s[2] = v[i][2] * gn; s[3] = v[i][3] * gn; }
    }
    LDS_WAIT(); asm volatile("" ::: "memory");
    const int c = lane & 7;
#pragma unroll
    for (int j = 0; j < 4; ++j) { const int n = (lane >> 3) + 8 * j; const LAS float* s = scr + (8 * c) * 33 + n;
        v4u o; o.x = pk2(s[0 * 33], s[1 * 33]); o.y = pk2(s[2 * 33], s[3 * 33]); o.z = pk2(s[4 * 33], s[5 * 33]); o.w = pk2(s[6 * 33], s[7 * 33]);
        int drow = n0 + n;
        if (gu == 3) {
            if (drow < 1024) { const int j = drow & 127; drow = (drow & ~127) + (j < 64 ? 2 * j : 2 * (j - 64) + 1); }
            else if (drow >= 2048 && drow < 3072) { const int j = drow & 63; drow = (drow & ~63) + (j < 8 ? 2 * j : (j < 16 ? 2 * (j - 8) + 1 : j)); }
        } else if (gu) drow = (drow >> 7) * 256 + (drow & 127) + (gu == 2 ? 128 : 0);
        *(GAS v4u*)(WT + (size_t)drow * K + k0 + 8 * c) = o; }
    LDS_WAIT(); asm volatile("" ::: "memory");
}
__device__ __forceinline__ void convert_weights(const Frame& F0, int l) {
    const Frame F = relaunder(F0);
    LAS float* scr = (LAS float*)(F.lds + RING_OFF + F.wave * 16384);
    const int gw = F.bid * NWAVES + F.wave, NGW = F.G * NWAVES;
    unsigned char* ws = WSP();
    constexpr int I_G = (D / 64) * (FF / 32), I_DN = (FF / 64) * (D / 32), I_O = (D / 64) * (D / 32);
    const bool odd = (l & 1) != 0; const int li = l >> 1;
    const int nin = odd ? GLA_IN : EVEN_IN, ninp = odd ? GLA_INP : EVEN_IN; const int I_IN = (D / 64) * (ninp / 32);
    const float* win = odd ? AP(I_GLA_IN) + (size_t)li * D * GLA_IN : AP(I_AB_IN) + (size_t)li * D * EVEN_IN;
    const float* wout = odd ? AP(I_GLA_OUT) + (size_t)li * D * D : AP(I_AB_OUT) + (size_t)li * D * D;
    const size_t fo = (size_t)l * D * FF;
    const int NITEMS = 6 * I_G + I_IN + I_O;
    static_assert(I_G == I_DN, "item counts");
    for (int it = gw; it < NITEMS; it += NGW) {
        int r = it;
        if (r < I_G) { tr_item(AP(I_PRE_WG) + fo, D, FF, FF, AP(I_PRE_NORM) + l * D, (bf16*)(ws + W_GU0), 1, scr, r, F.lane); continue; } r -= I_G;
        if (r < I_G) { tr_item(AP(I_PRE_WU) + fo, D, FF, FF, AP(I_PRE_NORM) + l * D, (bf16*)(ws + W_GU0), 2, scr, r, F.lane); continue; } r -= I_G;
        if (r < I_G) { tr_item(AP(I_PRE_WD) + fo, FF, D, D, nullptr, (bf16*)(ws + W_D0), 0, scr, r, F.lane); continue; } r -= I_G;
        if (r < I_G) { tr_item(AP(I_POST_WG) + fo, D, FF, FF, AP(I_POST_NORM) + l * D, (bf16*)(ws + W_GU1), 1, scr, r, F.lane); continue; } r -= I_G;
        if (r < I_G) { tr_item(AP(I_POST_WU) + fo, D, FF, FF, AP(I_POST_NORM) + l * D, (bf16*)(ws + W_GU1), 2, scr, r, F.lane); continue; } r -= I_G;
        if (r < I_G) { tr_item(AP(I_POST_WD) + fo, FF, D, D, nullptr, (bf16*)(ws + W_D1), 0, scr, r, F.lane); continue; } r -= I_G;
        if (r < I_IN) { tr_item(win, D, nin, ninp, AP(I_MIX_NORM) + l * D, (bf16*)(ws + W_IN), odd ? 0 : 3, scr, r, F.lane); continue; } r -= I_IN;
        tr_item(wout, D, D, D, nullptr, (bf16*)(ws + W_OUT), 0, scr, r, F.lane);
    }
}
__device__ __forceinline__ void prologue_rows(const Frame& F0) {
    const Frame F = relaunder(F0);
    unsigned char* ws = WSP();
    const int gw = F.bid * NWAVES + F.wave, NGW = F.G * NWAVES;
    bf16* XB = (bf16*)(ws + WS_XB); float* ssp = (float*)(ws + WS_SSP);
    for (int m = gw; m < M; m += NGW) {
        const GAS f32x4* xr = (const GAS f32x4*)(AP(I_X) + (size_t)m * D) + F.lane;
        GAS unsigned long long* o8 = (GAS unsigned long long*)(XB + (size_t)m * D) + F.lane;
        float s = 0.f;
#pragma unroll
        for (int j = 0; j < 4; ++j) { const f32x4 v = xr[64 * j]; s += (v.x * v.x + v.y * v.y) + (v.z * v.z + v.w * v.w);
            o8[64 * j] = (unsigned long long)pk2(v.x, v.y) | ((unsigned long long)pk2(v.z, v.w) << 32); }
        s = wave_sum(s);
        if (F.lane < 16) ssp[(size_t)m * 16 + F.lane] = (F.lane == 0) ? s : 0.f;
    }
    const int gt = F.bid * NTHREADS + F.tid, NGT = F.G * NTHREADS;
    float* rc = (float*)(ws + TAB_RC); float* rsn = (float*)(ws + TAB_RS); float* dc = (float*)(ws + TAB_DC); float* ds = (float*)(ws + TAB_DS);
    for (int e = gt; e < SEQ * 64; e += NGT) { const int t = e >> 6, i = e & 63; const float ang = (float)t * RET_FREQ[i];
        double rev = (double)ang * 0.15915494309189535; rev -= __builtin_rint(rev); const float r = (float)rev;
        rc[e] = __builtin_amdgcn_cosf(r); rsn[e] = __builtin_amdgcn_sinf(r); }
    for (int e = gt; e < SEQ * 8; e += NGT) { const int t = e >> 3, i = e & 7; const float ang = (float)t * ROPE_FREQ[i];
        double rev = (double)ang * 0.15915494309189535; rev -= __builtin_rint(rev); const float r = (float)rev;
        dc[e] = __builtin_amdgcn_cosf(r); ds[e] = __builtin_amdgcn_sinf(r); }
}

__device__ __forceinline__ void even_prep(const Frame& F0) {
    const Frame F = relaunder(F0);
    unsigned char* ws = WSP();
    const int gw = F.bid * NWAVES + F.wave, NGW = F.G * NWAVES;
    bf16* P = (bf16*)(ws + WS_ACT);
    const float* rc = (const float*)(ws + TAB_RC); const float* rsn = (const float*)(ws + TAB_RS); const float* dc = (const float*)(ws + TAB_DC); const float* ds = (const float*)(ws + TAB_DS);
    for (int m = gw; m < M; m += NGW) {
        const int pos = m & (SEQ - 1); bf16* row = P + (size_t)m * EVEN_IN;
        const float c = rc[pos * 64 + F.lane], s = rsn[pos * 64 + F.lane];
#pragma unroll
        for (int h = 0; h < 4; ++h) {
            { bf16* p1 = row + E_RQ + h * 128 + F.lane; bf16* p2 = p1 + 64; const float x1 = bf2f(*p1), x2 = bf2f(*p2); *p1 = f2bf_rne(x1 * c - x2 * s); *p2 = f2bf_rne(x2 * c + x1 * s); }
            { bf16* p1 = row + E_RK + h * 128 + F.lane; bf16* p2 = p1 + 64; const float x1 = bf2f(*p1), x2 = bf2f(*p2);
              *p1 = f2bf_rne((x1 * c - x2 * s) * 0.08838834764831845f); *p2 = f2bf_rne((x2 * c + x1 * s) * 0.08838834764831845f); }
        }
        { const int h = F.lane >> 3, i = F.lane & 7; const float c2 = dc[pos * 8 + i], s2 = ds[pos * 8 + i];
          { bf16* p1 = row + E_DQ + h * 64 + i; bf16* p2 = p1 + 8; const float x1 = bf2f(*p1), x2 = bf2f(*p2); *p1 = f2bf_rne(x1 * c2 - x2 * s2); *p2 = f2bf_rne(x2 * c2 + x1 * s2); }
          { bf16* p1 = row + E_DK + h * 64 + i; bf16* p2 = p1 + 8; const float x1 = bf2f(*p1), x2 = bf2f(*p2); *p1 = f2bf_rne(x1 * c2 - x2 * s2); *p2 = f2bf_rne(x2 * c2 + x1 * s2); } }
    }
}
__device__ __forceinline__ void even_core(const Frame& F0) {
    const Frame F = relaunder(F0);
    unsigned char* ws = WSP();
    const bf16* P = (const bf16*)(ws + WS_ACT);
    if (F.bid < 128) {
        const int b = F.bid >> 4, h = (F.bid >> 2) & 3, eg = F.bid & 3, e = eg * 32 + (F.tid >> 4), dq = F.tid & 15;
        const float g = 1.0f - exp2f(-5.0f - (float)h);
        float* oraw = (float*)(ws + WS_XB);
        const bf16* base = P + (size_t)b * SEQ * EVEN_IN;
        float S[8];
#pragma unroll
        for (int i = 0; i < 8; ++i) S[i] = 0.f;
        v4u qn = *(const GAS v4u*)(base + E_RQ + h * 128 + dq * 8), kn = *(const GAS v4u*)(base + E_RK + h * 128 + dq * 8); bf16 vn = base[E_RV + h * 128 + e];
        for (int t = 0; t < SEQ; ++t) {
            const v4u q = qn, k = kn; const float v = bf2f(vn);
            if (t + 1 < SEQ) { const bf16* nb = base + (size_t)(t + 1) * EVEN_IN; qn = *(const GAS v4u*)(nb + E_RQ + h * 128 + dq * 8); kn = *(const GAS v4u*)(nb + E_RK + h * 128 + dq * 8); vn = nb[E_RV + h * 128 + e]; }
            float o = 0.f;
#pragma unroll
            for (int i = 0; i < 4; ++i) { const unsigned qw = q[i], kw = k[i];
                S[2 * i] = g * S[2 * i] + bflo(kw) * v; S[2 * i + 1] = g * S[2 * i + 1] + bfhi(kw) * v;
                o += bflo(qw) * S[2 * i]; o += bfhi(qw) * S[2 * i + 1]; }
            o += xsw<1>(o); o += xsw<2>(o); o += xsw<4>(o); o += xsw<8>(o);
            if (dq == 0) oraw[((size_t)b * SEQ + t) * 512 + h * 128 + e] = o;
        }
    } else {
        bf16* CAT = (bf16*)(ws + WS_CAT);
        for (int it = F.bid - 128; it < BATCH * (SEQ / 64); it += F.G - 128) {
            const int b = it >> 6, t = (it & 63) * 64 + F.lane, h = F.wave;
            const bf16* base = P + (size_t)b * SEQ * EVEN_IN;
            float q[64];
            { const GAS v4u* qp = (const GAS v4u*)(base + (size_t)t * EVEN_IN + E_DQ + h * 64);
#pragma unroll
              for (int j = 0; j < 8; ++j) { const v4u w = qp[j];
#pragma unroll
                  for (int i = 0; i < 4; ++i) { q[8 * j + 2 * i] = bflo(w[i]) * (0.125f * 1.4426950408889634f); q[8 * j + 2 * i + 1] = bfhi(w[i]) * (0.125f * 1.4426950408889634f); } } }
            float o[64];
#pragma unroll
            for (int i = 0; i < 64; ++i) o[i] = 0.f;
            float mx = -INFINITY, l = 0.f;
            for (int p = 0; p < 3; ++p) {
                const int dil = (p == 0) ? 1 : (p == 1) ? 4 : 16;
                for (int j = 0; j <= 128; ++j) {
                    const int tk = t - j * dil;
                    if (tk >= 0) {
                        const GAS v4u* kp = (const GAS v4u*)(base + (size_t)tk * EVEN_IN + E_DK + h * 64);
                        const GAS v4u* vp = (const GAS v4u*)(base + (size_t)tk * EVEN_IN + E_DV + h * 64);
                        float s = 0.f;
#pragma unroll
                        for (int jj = 0; jj < 8; ++jj) { const v4u w = kp[jj];
#pragma unroll
                            for (int i = 0; i < 4; ++i) { s += q[8 * jj + 2 * i] * bflo(w[i]); s += q[8 * jj + 2 * i + 1] * bfhi(w[i]); } }
                        const float mn = fmaxf(mx, s), corr = __builtin_amdgcn_exp2f(mx - mn), pe = __builtin_amdgcn_exp2f(s - mn);
                        l = l * corr + pe; mx = mn;
#pragma unroll
                        for (int jj = 0; jj < 8; ++jj) { const v4u w = vp[jj];
#pragma unroll
                            for (int i = 0; i < 4; ++i) { o[8 * jj + 2 * i] = o[8 * jj + 2 * i] * corr + pe * bflo(w[i]); o[8 * jj + 2 * i + 1] = o[8 * jj + 2 * i + 1] * corr + pe * bfhi(w[i]); } }
                    }
                }
            }
            const float rl = 1.0f / l;
            GAS v4u* op = (GAS v4u*)(CAT + ((size_t)b * SEQ + t) * D + 512 + h * 64);
#pragma unroll
            for (int j = 0; j < 8; ++j) { v4u w; w.x = pk2(o[8 * j] * rl, o[8 * j + 1] * rl); w.y = pk2(o[8 * j + 2] * rl, o[8 * j + 3] * rl); w.z = pk2(o[8 * j + 4] * rl, o[8 * j + 5] * rl); w.w = pk2(o[8 * j + 6] * rl, o[8 * j + 7] * rl); op[j] = w; }
        }
    }
}
__device__ __forceinline__ void even_post(const Frame& F0) {
    const Frame F = relaunder(F0);
    unsigned char* ws = WSP();
    const int gw = F.bid * NWAVES + F.wave, NGW = F.G * NWAVES;
    const bf16* P = (const bf16*)(ws + WS_ACT); const float* oraw = (const float*)(ws + WS_XB); bf16* CAT = (bf16*)(ws + WS_CAT);
    for (int it = gw; it < M * 4; it += NGW) {
        const int m = it >> 2, h = it & 3;
        const float* op = oraw + (size_t)m * 512 + h * 128 + 2 * F.lane; const float o0 = op[0], o1 = op[1];
        const float mu = wave_sum(o0 + o1) * (1.0f / 128.0f); const float d0 = o0 - mu, d1 = o1 - mu;
        const float var = wave_sum(d0 * d0 + d1 * d1) * (1.0f / 128.0f); const float rstd = 1.0f / sqrtf(var + EPS);
        const unsigned gw2 = *(const unsigned*)(P + (size_t)m * EVEN_IN + E_RG + h * 128 + 2 * F.lane); const float g0 = bflo(gw2), g1 = bfhi(gw2);
        const float y0 = d0 * rstd * (g0 / (1.0f + expf(-g0))), y1 = d1 * rstd * (g1 / (1.0f + expf(-g1)));
        *(unsigned*)(CAT + (size_t)m * D + h * 128 + 2 * F.lane) = pk2(y0, y1);
    }
}
__device__ __forceinline__ void gla_prep(const Frame& F0, int li) {
    const Frame F = relaunder(F0);
    unsigned char* ws = WSP();
    const int gt = F.bid * NTHREADS + F.tid, NGT = F.G * NTHREADS;
    const bf16* P = (const bf16*)(ws + WS_ACT); float* A = (float*)(ws + WS_CAT);
    const float* w2 = AP(I_GLA_A2) + (size_t)li * 16 * 512; const float* ba = AP(I_GLA_BA) + (size_t)li * 512;
    for (int e = gt; e < M * 512; e += NGT) {
        const int m = e >> 9, c = e & 511; const bf16* al = P + (size_t)m * GLA_INP + G_A;
        float z = ba[c];
#pragma unroll
        for (int j = 0; j < 16; ++j) z += bf2f(al[j]) * w2[j * 512 + c];
        const float ls = fminf(z, 0.f) - log1pf(expf(-fabsf(z)));
        A[e] = expf(ls * (1.0f / 16.0f));
    }
}
__device__ __forceinline__ void gla_core(const Frame& F0) {
    const Frame F = relaunder(F0);
    unsigned char* ws = WSP();
    const bf16* P = (const bf16*)(ws + WS_ACT); const float* A = (const float*)(ws + WS_CAT); bf16* oraw = (bf16*)(ws + WS_XB);
    const int b = F.bid >> 5, h = (F.bid >> 3) & 3, eg = F.bid & 7, e = eg * 32 + (F.tid >> 4), dq = F.tid & 15;
    const bf16* base = P + (size_t)b * SEQ * GLA_INP; const float* abase = A + (size_t)b * SEQ * 512 + h * 128 + dq * 8;
    float S[8];
#pragma unroll
    for (int i = 0; i < 8; ++i) S[i] = 0.f;
    v4u qn = *(const GAS v4u*)(base + G_Q + h * 128 + dq * 8), kn = *(const GAS v4u*)(base + G_K + h * 128 + dq * 8); bf16 vn = base[G_V + h * 256 + e];
    f32x4 a0n = *(const GAS f32x4*)(abase), a1n = *(const GAS f32x4*)(abase + 4);
    for (int t = 0; t < SEQ; ++t) {
        const v4u q = qn, k = kn; const float v = bf2f(vn); const f32x4 a0 = a0n, a1 = a1n;
        if (t + 1 < SEQ) { const bf16* nb = base + (size_t)(t + 1) * GLA_INP; qn = *(const GAS v4u*)(nb + G_Q + h * 128 + dq * 8); kn = *(const GAS v4u*)(nb + G_K + h * 128 + dq * 8); vn = nb[G_V + h * 256 + e];
            a0n = *(const GAS f32x4*)(abase + (size_t)(t + 1) * 512); a1n = *(const GAS f32x4*)(abase + (size_t)(t + 1) * 512 + 4); }
        float o = 0.f;
#pragma unroll
        for (int i = 0; i < 4; ++i) { const unsigned qw = q[i], kw = k[i]; const float al = (i < 2) ? a0[2 * i] : a1[2 * i - 4], ah = (i < 2) ? a0[2 * i + 1] : a1[2 * i - 3];
            S[2 * i] = al * S[2 * i] + bflo(kw) * v; S[2 * i + 1] = ah * S[2 * i + 1] + bfhi(kw) * v;
            o += bflo(qw) * S[2 * i]; o += bfhi(qw) * S[2 * i + 1]; }
        o += xsw<1>(o); o += xsw<2>(o); o += xsw<4>(o); o += xsw<8>(o);
        if (dq == 0) oraw[((size_t)b * SEQ + t) * 1024 + h * 256 + e] = f2bf_rne(o * 0.08838834764831845f);
    }
}
__device__ __forceinline__ void gla_post(const Frame& F0) {
    const Frame F = relaunder(F0);
    unsigned char* ws = WSP();
    const int gw = F.bid * NWAVES + F.wave, NGW = F.G * NWAVES;
    const bf16* P = (const bf16*)(ws + WS_ACT); const bf16* oraw = (const bf16*)(ws + WS_XB); bf16* CAT = (bf16*)(ws + WS_CAT);
    for (int it = gw; it < M * 4; it += NGW) {
        const int m = it >> 2, h = it & 3;
        const unsigned long long ow = *(const unsigned long long*)(oraw + (size_t)m * 1024 + h * 256 + 4 * F.lane);
        const float o0 = bflo((unsigned)ow), o1 = bfhi((unsigned)ow), o2 = bflo((unsigned)(ow >> 32)), o3 = bfhi((unsigned)(ow >> 32));
        const float mu = wave_sum((o0 + o1) + (o2 + o3)) * (1.0f / 256.0f); const float d0 = o0 - mu, d1 = o1 - mu, d2 = o2 - mu, d3 = o3 - mu;
        const float var = wave_sum((d0 * d0 + d1 * d1) + (d2 * d2 + d3 * d3)) * (1.0f / 256.0f); const float rstd = 1.0f / sqrtf(var + EPS);
        const unsigned long long gw2 = *(const unsigned long long*)(P + (size_t)m * GLA_INP + G_R + h * 256 + 4 * F.lane);
        const float g0 = bflo((unsigned)gw2), g1 = bfhi((unsigned)gw2), g2 = bflo((unsigned)(gw2 >> 32)), g3 = bfhi((unsigned)(gw2 >> 32));
        const float y0 = d0 * rstd * (g0 / (1.0f + expf(-g0))), y1 = d1 * rstd * (g1 / (1.0f + expf(-g1))), y2 = d2 * rstd * (g2 / (1.0f + expf(-g2))), y3 = d3 * rstd * (g3 / (1.0f + expf(-g3)));
        *(unsigned long long*)(CAT + (size_t)m * D + h * 256 + 4 * F.lane) = (unsigned long long)pk2(y0, y1) | ((unsigned long long)pk2(y2, y3) << 32);
    }
}
__device__ __forceinline__ void final_norm(const Frame& F0) {
    const Frame F = relaunder(F0);
    const int gw = F.bid * NWAVES + F.wave, NGW = F.G * NWAVES;
    const bf16* XBp = (const bf16*)(WSP() + WS_XB); float* out = OUTP(); const GAS f32x4* gr = (const GAS f32x4*)AP(I_FINAL);
    for (int m = gw; m < M; m += NGW) {
        const v4u w0 = *(const GAS v4u*)(XBp + (size_t)m * D + F.lane * 8), w1 = *(const GAS v4u*)(XBp + (size_t)m * D + 512 + F.lane * 8);
        float v[16]; float s = 0.f;
#pragma unroll
        for (int i = 0; i < 4; ++i) { v[2 * i] = bflo(w0[i]); v[2 * i + 1] = bfhi(w0[i]); v[8 + 2 * i] = bflo(w1[i]); v[8 + 2 * i + 1] = bfhi(w1[i]); }
#pragma unroll
        for (int i = 0; i < 16; ++i) s += v[i] * v[i];
        const float rstd = 1.0f / sqrtf(wave_sum(s) * (1.0f / D) + EPS);
        GAS f32x4* o = (GAS f32x4*)(out + (size_t)m * D);
#pragma unroll
        for (int hh = 0; hh < 2; ++hh)
#pragma unroll
            for (int q = 0; q < 2; ++q) { const int c4 = hh * 128 + F.lane * 2 + q; const f32x4 g = gr[c4];
                o[c4] = (f32x4){v[hh * 8 + q * 4] * rstd * g[0], v[hh * 8 + q * 4 + 1] * rstd * g[1], v[hh * 8 + q * 4 + 2] * rstd * g[2], v[hh * 8 + q * 4 + 3] * rstd * g[3]}; }
    }
}


__device__ __forceinline__ float silu_f(float g) { return g * __builtin_amdgcn_rcpf(1.0f + __builtin_amdgcn_exp2f(-1.4426950408889634f * g)); }
typedef float f32x16 __attribute__((ext_vector_type(16)));
typedef short s16x4 __attribute__((ext_vector_type(4)));
typedef float f32x2_t __attribute__((ext_vector_type(2)));
typedef __bf16 bf16x2_t __attribute__((ext_vector_type(2)));
#define MFMA32(a, b, c) __builtin_amdgcn_mfma_f32_32x32x16_bf16((a), (b), (c), 0, 0, 0)
__device__ __forceinline__ int crow(int reg, int h) { return (reg & 3) + 8 * (reg >> 2) + 4 * h; }
__device__ __forceinline__ unsigned cvtpk(float lo, float hi) { f32x2_t v = {lo, hi}; bf16x2_t b = __builtin_convertvector(v, bf16x2_t); return __builtin_bit_cast(unsigned, b); }
__device__ __forceinline__ bf16 cvt1(float v) { return (bf16)(cvtpk(v, 0.f) & 0xffffu); }
#define PACK_STEP(x, s) __builtin_bit_cast(bf16x8, (v4u){cvtpk((x)[8 * (s)], (x)[8 * (s) + 1]), cvtpk((x)[8 * (s) + 2], (x)[8 * (s) + 3]), cvtpk((x)[8 * (s) + 4], (x)[8 * (s) + 5]), cvtpk((x)[8 * (s) + 6], (x)[8 * (s) + 7])})
typedef const LAS unsigned char* lcp;
__device__ __forceinline__ int lndv(int v) { asm volatile("" : "+v"(v)); return v; }
__device__ __forceinline__ bf16x8 ld_row(lcp img, int P, int row0, int k0, int r, int h) { return *(const LAS bf16x8*)(img + (row0 + r) * P + (k0 + 8 * h) * 2); }
__device__ __forceinline__ bf16x8 ld_row_perm(lcp img, int P, int row0, int k0, int r, int h) {
    const s16x4 lo = *(const LAS s16x4*)(img + (row0 + r) * P + (k0 + 4 * h) * 2), hi = *(const LAS s16x4*)(img + (row0 + r) * P + (k0 + 8 + 4 * h) * 2);
    return __builtin_shufflevector(lo, hi, 0, 1, 2, 3, 4, 5, 6, 7); }
__device__ __forceinline__ s16x4 trd(lcp p) { return __builtin_bit_cast(s16x4, __builtin_amdgcn_ds_read_tr16_b64_v4i16((LAS s16x4*)p)); }
__device__ __forceinline__ bf16x8 ld_tr(lcp img, int P, int k0, int c0, int lane) {
    const int i16 = lane & 15, q = i16 >> 2, p = i16 & 3, blk = (lane >> 4) & 1, h = lane >> 5;
    lcp a = img + (k0 + 8 * h + q) * P + (c0 + 16 * blk + 4 * p) * 2;
    const s16x4 lo = trd(a), hi = trd(a + 4 * P);
    return __builtin_shufflevector(lo, hi, 0, 1, 2, 3, 4, 5, 6, 7); }
__device__ __forceinline__ bf16x8 ld_tr_perm(lcp img, int P, int k0, int c0, int lane) {
    const int i16 = lane & 15, q = i16 >> 2, p = i16 & 3, blk = (lane >> 4) & 1, h = lane >> 5;
    lcp a = img + (k0 + 4 * h + q) * P + (c0 + 16 * blk + 4 * p) * 2;
    const s16x4 lo = trd(a), hi = trd(a + 8 * P);
    return __builtin_shufflevector(lo, hi, 0, 1, 2, 3, 4, 5, 6, 7); }
template <int R, int C> __device__ __forceinline__ void tile_ld(v4u (&v)[R * C / 8 / NTHREADS], const bf16* g, size_t gp, int tid) {
    constexpr int CPR = C / 8, RS = NTHREADS / CPR;
    static_assert(NTHREADS % CPR == 0, "tile shape");
    const unsigned voff = (unsigned)((tid / CPR) * (int)gp + (tid % CPR) * 8) * 2u;
    const GAS unsigned char* gb = (const GAS unsigned char*)g;
#pragma unroll
    for (int i = 0; i < R * C / 8 / NTHREADS; ++i) v[i] = *(const GAS v4u*)(gb + (size_t)i * RS * gp * 2 + voff);
}
template <int R, int C> __device__ __forceinline__ void tile_st(const v4u (&v)[R * C / 8 / NTHREADS], LAS unsigned char* img, int P, int tid) {
    constexpr int CPR = C / 8, RS = NTHREADS / CPR;
    LAS unsigned char* lb = img + (tid / CPR) * P + (tid % CPR) * 16;
#pragma unroll
    for (int i = 0; i < R * C / 8 / NTHREADS; ++i) *(LAS v4u*)(lb + i * RS * P) = v[i];
}
template <int R, int C> __device__ __forceinline__ void stage_tile(LAS unsigned char* img, int P, const bf16* g, size_t gp, int tid) { v4u t_[R * C / 8 / NTHREADS]; tile_ld<R, C>(t_, g, gp, tid); tile_st<R, C>(t_, img, P, tid); }
#define WG_BAR() do { asm volatile("s_waitcnt lgkmcnt(0)" ::: "memory"); __builtin_amdgcn_s_barrier(); asm volatile("" ::: "memory"); } while (0)

constexpr int PR = 272, PT = 320, PT256 = 576, PO256 = 528;
constexpr size_t WS_DEC = 6 * MiB;
constexpr float LOG2E = 1.4426950408889634f, LN2 = 0.6931471805599453f;
__device__ __forceinline__ void gla_cumsum(float (&Bc)[2][16], float& Blast, lcp AL, lcp W2, const LAS float* BA, LAS float* EX, int wave, int lane) {
    const int r = lane & 31, h = lane >> 5, db = wave & 3, jh = wave >> 2;
    const bf16x8 wf = *(const LAS bf16x8*)(W2 + (db * 32 + r) * 32 + h * 16);
    const float bias = BA[db * 32 + r];
    float run = 0.f;
#pragma unroll
    for (int t = 0; t < 2; ++t) {
        const bf16x8 af = *(const LAS bf16x8*)(AL + ((jh * 2 + t) * 32 + r) * 32 + h * 16);
        f32x16 z = {0.f, 0.f, 0.f, 0.f, 0.f, 0.f, 0.f, 0.f, 0.f, 0.f, 0.f, 0.f, 0.f, 0.f, 0.f, 0.f};
        z = MFMA32(af, wf, z);
        float own[4], oth[4];
#pragma unroll
        for (int g = 0; g < 4; ++g) {
            float acc = 0.f;
#pragma unroll
            for (int i = 0; i < 4; ++i) { const float zz = z[4 * g + i] + bias;
                const float la = (fminf(zz, 0.f) - LN2 * __builtin_amdgcn_logf(1.0f + __builtin_amdgcn_exp2f(-fabsf(zz) * LOG2E))) * (1.0f / 16.0f);
                acc += la; Bc[t][4 * g + i] = acc; }
            own[g] = acc; oth[g] = oth32(acc, h);
        }
#pragma unroll
        for (int g = 0; g < 4; ++g) { const float off = run + (h ? oth[g] : 0.f);
#pragma unroll
            for (int i = 0; i < 4; ++i) Bc[t][4 * g + i] += off;
            run += own[g] + oth[g]; }
    }
    if (h == 0) EX[jh * 128 + db * 32 + r] = run;
    WG_BAR();
    const float t0 = EX[db * 32 + r], t1 = EX[128 + db * 32 + r];
    Blast = t0 + t1;
    if (jh == 1) {
#pragma unroll
        for (int t = 0; t < 2; ++t)
#pragma unroll
            for (int i = 0; i < 16; ++i) Bc[t][i] += t0; }
}
constexpr int GA_KI = 0, GA_VI = GA_KI + 128 * PR, GA_KD = GA_VI + 128 * PT256, GA_AL = GA_KD + 128 * PT, GA_W2 = GA_AL + 4096, GA_BA = GA_W2 + 4096, GA_EX = GA_BA + 512, GA_END = GA_EX + 1024;
constexpr int GA_OI = GA_VI;
constexpr int GC_QT = 0, GC_KT = GC_QT + 128 * PR, GC_SI = GC_KT + 128 * PR, GC_VI = GC_SI + 128 * PT, GC_AL = GC_VI + 128 * PT, GC_W2 = GC_AL + 4096, GC_BA = GC_W2 + 4096, GC_EX = GC_BA + 512, GC_END = GC_EX + 1024;
constexpr int GC_OI = 0;
static_assert(GA_END <= LDSCTL_OFF && GC_END <= LDSCTL_OFF && 128 * PO256 <= GC_SI && 128 * PO256 <= 128 * PT256, "GLA LDS maps");
__device__ __forceinline__ void gla_stage_w(const Frame& F, LAS unsigned char* W2, LAS float* BA, int li, int h) {
    if (F.tid < 128) { const int d = F.tid; const GAS float* w2 = (const GAS float*)AP(I_GLA_A2) + (size_t)li * 16 * 512 + h * 128 + d;
        v4u lo, hi; lo.x = cvtpk(w2[0], w2[512]); lo.y = cvtpk(w2[2 * 512], w2[3 * 512]); lo.z = cvtpk(w2[4 * 512], w2[5 * 512]); lo.w = cvtpk(w2[6 * 512], w2[7 * 512]);
        hi.x = cvtpk(w2[8 * 512], w2[9 * 512]); hi.y = cvtpk(w2[10 * 512], w2[11 * 512]); hi.z = cvtpk(w2[12 * 512], w2[13 * 512]); hi.w = cvtpk(w2[14 * 512], w2[15 * 512]);
        *(LAS v4u*)(W2 + d * 32) = lo; *(LAS v4u*)(W2 + d * 32 + 16) = hi; }
    else if (F.tid < 256) { const int d = F.tid - 128; BA[d] = ((const GAS float*)AP(I_GLA_BA))[(size_t)li * 512 + h * 128 + d]; }
}
__device__ __forceinline__ v4u gla_ld_alow(int tid, const bf16* Prow0) { const int t = tid & 255; return *(const GAS v4u*)(Prow0 + (size_t)(t >> 1) * GLA_INP + G_A + (t & 1) * 8); }
__device__ __forceinline__ void gla_st_alow(int tid, v4u v, LAS unsigned char* AL) { if (tid < 256) *(LAS v4u*)(AL + (tid >> 1) * 32 + (tid & 1) * 16) = v; }

__device__ __forceinline__ void gla_phase_a(const Frame& F0, int li) {
    const Frame F = relaunder(F0);
    unsigned char* ws = WSP();
    const bf16* P = (const bf16*)(ws + WS_ACT); bf16* SKV = (bf16*)OUTP(); float* DEC = (float*)(ws + WS_DEC);
    LAS unsigned char* L = F.lds;
    const int wave = F.wave, db = wave & 3, jh = wave >> 2;
    v4u kR[4], vR[8], aR; int hcur = -1;
    {   const int it = F.bid; if (it < 1024) { const int bh = it >> 5, g = it & 31; const bf16* Prow0 = P + ((size_t)(bh >> 2) * SEQ + g * 128) * GLA_INP;
            tile_ld<128, 128>(kR, Prow0 + G_K + (bh & 3) * 128, GLA_INP, F.tid); tile_ld<128, 256>(vR, Prow0 + G_V + (bh & 3) * 256, GLA_INP, F.tid); aR = gla_ld_alow(F.tid, Prow0); } }
    for (int it = F.bid; it < 1024; it += F.G) {
        const int bh = it >> 5, h = bh & 3;
        const int lane = lndv(F.lane), r = lane & 31, h2 = lane >> 5;
        tile_st<128, 128>(kR, L + GA_KI, PR, F.tid); tile_st<128, 256>(vR, L + GA_VI, PT256, F.tid); gla_st_alow(F.tid, aR, L + GA_AL);
        if (h != hcur) { gla_stage_w(F, L + GA_W2, (LAS float*)(L + GA_BA), li, h); hcur = h; }
        WG_BAR();
        {   const int nx = it + F.G; if (nx < 1024) { const int bh2 = nx >> 5, g2 = nx & 31; const bf16* Pn = P + ((size_t)(bh2 >> 2) * SEQ + g2 * 128) * GLA_INP;
                tile_ld<128, 128>(kR, Pn + G_K + (bh2 & 3) * 128, GLA_INP, F.tid); tile_ld<128, 256>(vR, Pn + G_V + (bh2 & 3) * 256, GLA_INP, F.tid); aR = gla_ld_alow(F.tid, Pn); } }
        float Bc[2][16], Blast;
        gla_cumsum(Bc, Blast, L + GA_AL, L + GA_W2, (const LAS float*)(L + GA_BA), (LAS float*)(L + GA_EX), wave, lane);
#pragma unroll
        for (int t = 0; t < 2; ++t)
#pragma unroll
            for (int i = 0; i < 16; ++i) { const int row = (jh * 2 + t) * 32 + crow(i, h2), col = db * 32 + r;
                const float kv = bf2f(*(const LAS bf16*)(L + GA_KI + row * PR + col * 2)) * __builtin_amdgcn_exp2f((Blast - Bc[t][i]) * LOG2E);
                *(LAS bf16*)(L + GA_KD + row * PT + col * 2) = cvt1(kv); }
        if (jh == 0 && h2 == 0) DEC[(size_t)it * 128 + db * 32 + r] = __builtin_amdgcn_exp2f(Blast * LOG2E);
        WG_BAR();
        f32x16 acc[4];
#pragma unroll
        for (int t = 0; t < 4; ++t) acc[t] = (f32x16){0.f, 0.f, 0.f, 0.f, 0.f, 0.f, 0.f, 0.f, 0.f, 0.f, 0.f, 0.f, 0.f, 0.f, 0.f, 0.f};
#pragma unroll
        for (int ks = 0; ks < 8; ++ks) { const bf16x8 a = ld_tr(L + GA_KD, PT, 16 * ks, db * 32, lane);
#pragma unroll
            for (int t = 0; t < 4; ++t) acc[t] = MFMA32(a, ld_tr(L + GA_VI, PT256, 16 * ks, (4 * jh + t) * 32, lane), acc[t]); }
        WG_BAR();
#pragma unroll
        for (int t = 0; t < 4; ++t)
#pragma unroll
            for (int i = 0; i < 16; ++i) *(LAS bf16*)(L + GA_OI + (db * 32 + crow(i, h2)) * PO256 + ((4 * jh + t) * 32 + r) * 2) = cvt1(acc[t][i]);
        WG_BAR();
        {   bf16* out = SKV + (size_t)it * 128 * 256;
#pragma unroll
            for (int i = 0; i < 8; ++i) { const int c = F.tid + i * NTHREADS, row = c >> 5, cc = c & 31; *(GAS v4u*)(out + row * 256 + cc * 8) = *(const LAS v4u*)(L + GA_OI + row * PO256 + cc * 16); } }
        WG_BAR();
    }
}
__device__ __forceinline__ void gla_phase_b(const Frame& F0) {
    const Frame F = relaunder(F0);
    unsigned char* ws = WSP();
    bf16* SKV = (bf16*)OUTP(); const float* DEC = (const float*)(ws + WS_DEC);
    for (int gt = F.bid * NTHREADS + F.tid; gt < 32 * 128 * 32; gt += F.G * NTHREADS) {
        const int bh = gt >> 12, d = (gt >> 5) & 127, e8 = gt & 31;
        float s[8];
#pragma unroll
        for (int i = 0; i < 8; ++i) s[i] = 0.f;
        for (int g0 = 0; g0 < 32; g0 += 8) {
            v4u kv[8]; float dc[8];
#pragma unroll
            for (int u = 0; u < 8; ++u) { const size_t item = (size_t)bh * 32 + g0 + u; kv[u] = *(const GAS v4u*)(SKV + (item * 128 + d) * 256 + e8 * 8); dc[u] = ((const GAS float*)DEC)[item * 128 + d]; }
#pragma unroll
            for (int u = 0; u < 8; ++u) { const size_t item = (size_t)bh * 32 + g0 + u;
                v4u o; o.x = cvtpk(s[0], s[1]); o.y = cvtpk(s[2], s[3]); o.z = cvtpk(s[4], s[5]); o.w = cvtpk(s[6], s[7]);
                *(GAS v4u*)(SKV + (item * 128 + d) * 256 + e8 * 8) = o;
#pragma unroll
                for (int i = 0; i < 4; ++i) { s[2 * i] = dc[u] * s[2 * i] + bflo(kv[u][i]); s[2 * i + 1] = dc[u] * s[2 * i + 1] + bfhi(kv[u][i]); } }
        }
    }
}
__device__ __forceinline__ void gla_phase_c(const Frame& F0, int li) {
    const Frame F = relaunder(F0);
    unsigned char* ws = WSP();
    const bf16* P = (const bf16*)(ws + WS_ACT); const bf16* SKV = (const bf16*)OUTP(); bf16* CAT = (bf16*)(ws + WS_CAT);
    LAS unsigned char* L = F.lds;
    const int wave = F.wave, db = wave & 3, jh = wave >> 2;
    const int ib = wave & 3, eq = wave >> 2;
    v4u qR[4], kR[4], aR; int hcur = -1;
    {   const int it = F.bid; if (it < 1024) { const int bh = it >> 5, g = it & 31, h = bh & 3; const bf16* Prow0 = P + ((size_t)(bh >> 2) * SEQ + g * 128) * GLA_INP;
            tile_ld<128, 128>(qR, Prow0 + G_Q + h * 128, GLA_INP, F.tid); tile_ld<128, 128>(kR, Prow0 + G_K + h * 128, GLA_INP, F.tid); aR = gla_ld_alow(F.tid, Prow0); } }
    for (int it = F.bid; it < 1024; it += F.G) {
        const int bh = it >> 5, g = it & 31, b = bh >> 2, h = bh & 3;
        const int tidl = lndv(F.tid), lane = tidl & 63, r = lane & 31, h2 = lane >> 5;
        const bf16* Prow0 = P + ((size_t)b * SEQ + g * 128) * GLA_INP;
        const bf16* Sg = SKV + (size_t)it * 128 * 256;
        {   v4u sR[4], vR[4]; tile_ld<128, 128>(sR, Sg, 256, tidl); tile_ld<128, 128>(vR, Prow0 + G_V + h * 256, GLA_INP, tidl);
            tile_st<128, 128>(qR, L + GC_QT, PR, tidl); tile_st<128, 128>(kR, L + GC_KT, PR, tidl); tile_st<128, 128>(sR, L + GC_SI, PT, tidl); tile_st<128, 128>(vR, L + GC_VI, PT, tidl); }
        gla_st_alow(tidl, aR, L + GC_AL);
        if (h != hcur) { gla_stage_w(F, L + GC_W2, (LAS float*)(L + GC_BA), li, h); hcur = h; }
        WG_BAR();
        {
            float Bc[2][16], Blast;
            gla_cumsum(Bc, Blast, L + GC_AL, L + GC_W2, (const LAS float*)(L + GC_BA), (LAS float*)(L + GC_EX), wave, lane);
#pragma unroll
            for (int t = 0; t < 2; ++t)
#pragma unroll
                for (int i = 0; i < 16; ++i) { const int off = ((jh * 2 + t) * 32 + crow(i, h2)) * PR + (db * 32 + r) * 2;
                    const float eb = __builtin_amdgcn_exp2f(Bc[t][i] * LOG2E);
                    const float qv = bf2f(*(const LAS bf16*)(L + GC_QT + off)) * eb * 0.08838834764831845f;
                    const float kv = bf2f(*(const LAS bf16*)(L + GC_KT + off)) * __builtin_amdgcn_rcpf(eb);
                    *(LAS bf16*)(L + GC_QT + off) = cvt1(qv); *(LAS bf16*)(L + GC_KT + off) = cvt1(kv); }
        }
        WG_BAR();
        bf16x8 PA[4][2];
#pragma unroll
        for (int jb = 0; jb < 4; ++jb) {
            if (jb <= ib) {
                f32x16 x = {0.f, 0.f, 0.f, 0.f, 0.f, 0.f, 0.f, 0.f, 0.f, 0.f, 0.f, 0.f, 0.f, 0.f, 0.f, 0.f};
#pragma unroll
                for (int ks = 0; ks < 8; ++ks) x = MFMA32(ld_row(L + GC_KT, PR, jb * 32, 16 * ks, r, h2), ld_row(L + GC_QT, PR, ib * 32, 16 * ks, r, h2), x);
                if (jb == ib) {
#pragma unroll
                    for (int i = 0; i < 16; ++i) if (crow(i, h2) > r) x[i] = 0.f; }
                PA[jb][0] = PACK_STEP(x, 0); PA[jb][1] = PACK_STEP(x, 1);
            } else { PA[jb][0] = (bf16x8){0, 0, 0, 0, 0, 0, 0, 0}; PA[jb][1] = (bf16x8){0, 0, 0, 0, 0, 0, 0, 0}; }
        }
        f32x16 o[2][2];
#pragma unroll
        for (int half = 0; half < 2; ++half) {
            if (half == 1) {
                WG_BAR();
                stage_tile<128, 128>(L + GC_SI, PT, Sg + 128, 256, tidl); stage_tile<128, 128>(L + GC_VI, PT, Prow0 + G_V + h * 256 + 128, GLA_INP, tidl);
                WG_BAR();
            }
#pragma unroll
            for (int t = 0; t < 2; ++t) {
                const int eb = 2 * eq + t;
                f32x16 acc = {0.f, 0.f, 0.f, 0.f, 0.f, 0.f, 0.f, 0.f, 0.f, 0.f, 0.f, 0.f, 0.f, 0.f, 0.f, 0.f};
#pragma unroll
                for (int jb = 0; jb < 4; ++jb) if (jb <= ib) {
#pragma unroll
                    for (int s = 0; s < 2; ++s) acc = MFMA32(PA[jb][s], ld_tr_perm(L + GC_VI, PT, jb * 32 + 16 * s, eb * 32, lane), acc); }
#pragma unroll
                for (int ks = 0; ks < 8; ++ks) acc = MFMA32(ld_row(L + GC_QT, PR, ib * 32, 16 * ks, r, h2), ld_tr(L + GC_SI, PT, 16 * ks, eb * 32, lane), acc);
                o[half][t] = acc;
            }
        }
        WG_BAR();
#pragma unroll
        for (int half = 0; half < 2; ++half)
#pragma unroll
            for (int t = 0; t < 2; ++t)
#pragma unroll
                for (int i = 0; i < 16; ++i) *(LAS bf16*)(L + GC_OI + (ib * 32 + crow(i, h2)) * PO256 + (half * 128 + (2 * eq + t) * 32 + r) * 2) = cvt1(o[half][t][i]);
        WG_BAR();
        {   const int nx = (it + F.G < 1024) ? it + F.G : it;
            const int bh2 = nx >> 5, g2 = nx & 31, hn = bh2 & 3; const bf16* Pn = P + ((size_t)(bh2 >> 2) * SEQ + g2 * 128) * GLA_INP;
            tile_ld<128, 128>(qR, Pn + G_Q + hn * 128, GLA_INP, tidl); tile_ld<128, 128>(kR, Pn + G_K + hn * 128, GLA_INP, tidl); aR = gla_ld_alow(tidl, Pn); }
        {
            const int tid2 = lndv(tidl), row = tid2 >> 2, qtr = tid2 & 3;
            lcp orow = L + GC_OI + row * PO256 + qtr * 128;
            const bf16* gp = Prow0 + (size_t)row * GLA_INP + G_R + h * 256 + qtr * 64;
            float sum = 0.f;
#pragma unroll
            for (int c = 0; c < 8; ++c) { const v4u w = *(const LAS v4u*)(orow + c * 16);
#pragma unroll
                for (int i = 0; i < 4; ++i) sum += bflo(w[i]) + bfhi(w[i]); }
            sum += xsw<1>(sum); sum += xsw<2>(sum);
            const float mu = sum * (1.0f / 256.0f); float sq = 0.f;
#pragma unroll
            for (int c = 0; c < 8; ++c) { const v4u w = *(const LAS v4u*)(orow + c * 16);
#pragma unroll
                for (int i = 0; i < 4; ++i) { const float d0 = bflo(w[i]) - mu, d1 = bfhi(w[i]) - mu; sq += d0 * d0 + d1 * d1; } }
            sq += xsw<1>(sq); sq += xsw<2>(sq);
            const float rstd = 1.0f / sqrtf(sq * (1.0f / 256.0f) + EPS);
            bf16* op = CAT + ((size_t)b * SEQ + g * 128 + row) * D + h * 256 + qtr * 64;
#pragma unroll
            for (int c = 0; c < 8; ++c) { const v4u gw = *(const GAS v4u*)(gp + c * 8); const v4u w = *(const LAS v4u*)(orow + c * 16); v4u ow;
#pragma unroll
                for (int i = 0; i < 4; ++i) { const float g0 = bflo(gw[i]), g1 = bfhi(gw[i]);
                    ow[i] = cvtpk((bflo(w[i]) - mu) * rstd * silu_f(g0), (bfhi(w[i]) - mu) * rstd * silu_f(g1)); }
                *(GAS v4u*)(op + c * 8) = ow; }
        }
        WG_BAR();
    }
}


constexpr size_t WS_OD = 408 * MiB;
constexpr size_t OUT_LSE = 32 * MiB;
constexpr size_t WS_END2 = 504 * MiB;
constexpr int RA_KI = 0, RA_VD = RA_KI + 128 * PT, RA_END = RA_VD + 128 * PT;
constexpr int RC_QI = 0, RC_KI = RC_QI + 128 * PR, RC_VI = RC_KI + 128 * PR, RC_SI = RC_VI + 128 * PT, RC_END = RC_SI + 128 * PT;
constexpr int DPK = 144, DPV = 192;
constexpr int DL_KI = 0, DL_VI = DL_KI + 384 * DPK, DL_LW = DL_VI + 384 * DPV, DL_END = DL_LW + 8 * 256;
constexpr int DL_ST = DL_KI;
static_assert(RC_END <= LDSCTL_OFF && DL_END <= LDSCTL_OFF && 8 * 32 * DPK <= 384 * DPK, "even mixer LDS maps");
__device__ __forceinline__ float ret_log2g(int h) { return log2f(1.0f - exp2f(-5.0f - (float)h)); }

__device__ __forceinline__ void ret_phase_a_items(const Frame& F, const bf16* P, bf16* RKV) {
    LAS unsigned char* L = F.lds;
    const int wave = F.wave, db = wave & 3, eh = wave >> 2;
    v4u kR[4], vR[4];
    {   const int it = F.bid < 1024 ? F.bid : 0; const int bh = it >> 5, n = it & 31; const bf16* Prow0 = P + ((size_t)(bh >> 2) * SEQ + n * 128) * EVEN_IN;
        tile_ld<128, 128>(kR, Prow0 + E_RK + (bh & 3) * 128, EVEN_IN, F.tid); tile_ld<128, 128>(vR, Prow0 + E_RV + (bh & 3) * 128, EVEN_IN, F.tid); }
    for (int it = F.bid; it < 1024; it += F.G) {
        const int tidl = lndv(F.tid), lane = tidl & 63, r = lane & 31, h2 = lane >> 5;
        const int bh = it >> 5, h = bh & 3;
        const float lg = ret_log2g(h);
        tile_st<128, 128>(kR, L + RA_KI, PT, tidl);
        {
#pragma unroll
            for (int i = 0; i < 4; ++i) { const int row = (tidl >> 4) + 32 * i, cc = tidl & 15; const float f = __builtin_amdgcn_exp2f(lg * (float)(127 - row)); v4u o;
#pragma unroll
                for (int k = 0; k < 4; ++k) o[k] = cvtpk(bflo(vR[i][k]) * f, bfhi(vR[i][k]) * f);
                *(LAS v4u*)(L + RA_VD + row * PT + cc * 16) = o; }
        }
        WG_BAR();
        {   const int nx = (it + F.G < 1024) ? it + F.G : it; const int bh2 = nx >> 5, n2 = nx & 31; const bf16* Pn = P + ((size_t)(bh2 >> 2) * SEQ + n2 * 128) * EVEN_IN;
            tile_ld<128, 128>(kR, Pn + E_RK + (bh2 & 3) * 128, EVEN_IN, tidl); tile_ld<128, 128>(vR, Pn + E_RV + (bh2 & 3) * 128, EVEN_IN, tidl); }
        f32x16 acc[2];
#pragma unroll
        for (int t = 0; t < 2; ++t) acc[t] = (f32x16){0.f, 0.f, 0.f, 0.f, 0.f, 0.f, 0.f, 0.f, 0.f, 0.f, 0.f, 0.f, 0.f, 0.f, 0.f, 0.f};
#pragma unroll
        for (int ks = 0; ks < 8; ++ks) { const bf16x8 a = ld_tr(L + RA_KI, PT, 16 * ks, db * 32, lane);
#pragma unroll
            for (int t = 0; t < 2; ++t) acc[t] = MFMA32(a, ld_tr(L + RA_VD, PT, 16 * ks, (2 * eh + t) * 32, lane), acc[t]); }
        WG_BAR();
#pragma unroll
        for (int t = 0; t < 2; ++t)
#pragma unroll
            for (int i = 0; i < 16; ++i) *(LAS bf16*)(L + RA_KI + (db * 32 + crow(i, h2)) * PR + ((2 * eh + t) * 32 + r) * 2) = cvt1(acc[t][i]);
        WG_BAR();
        bf16* out = RKV + (size_t)it * 128 * 128;
#pragma unroll
        for (int i = 0; i < 4; ++i) { const int row = (tidl >> 4) + 32 * i, cc = tidl & 15; *(GAS v4u*)(out + row * 128 + cc * 8) = *(const LAS v4u*)(L + RA_KI + row * PR + cc * 16); }
        WG_BAR();
    }
}
__device__ __forceinline__ void ret_scan(const Frame& F, bf16* RKV) {
    for (int gt = F.bid * NTHREADS + F.tid; gt < 32 * 128 * 16; gt += F.G * NTHREADS) {
        const int bh = gt >> 11, d = (gt >> 4) & 127, e8 = gt & 15, h = bh & 3;
        const float g128 = __builtin_amdgcn_exp2f(ret_log2g(h) * 128.0f);
        float s[8];
#pragma unroll
        for (int i = 0; i < 8; ++i) s[i] = 0.f;
        for (int n0 = 0; n0 < 32; n0 += 4) {
            v4u kv[4];
#pragma unroll
            for (int u = 0; u < 4; ++u) kv[u] = *(const GAS v4u*)(RKV + (((size_t)bh * 32 + n0 + u) * 128 + d) * 128 + e8 * 8);
#pragma unroll
            for (int u = 0; u < 4; ++u) {
                v4u o; o.x = cvtpk(s[0], s[1]); o.y = cvtpk(s[2], s[3]); o.z = cvtpk(s[4], s[5]); o.w = cvtpk(s[6], s[7]);
                *(GAS v4u*)(RKV + (((size_t)bh * 32 + n0 + u) * 128 + d) * 128 + e8 * 8) = o;
#pragma unroll
                for (int i = 0; i < 4; ++i) { s[2 * i] = g128 * s[2 * i] + bflo(kv[u][i]); s[2 * i + 1] = g128 * s[2 * i + 1] + bfhi(kv[u][i]); } }
        }
    }
}
__device__ __forceinline__ void ret_phase_c_items(const Frame& F, const bf16* P, const bf16* RKV, bf16* CAT) {
    LAS unsigned char* L = F.lds;
    const int wave = F.wave, ib = wave & 3, eq = wave >> 2;
    v4u qR[4], kR[4];
    {   const int it = F.bid < 1024 ? F.bid : 0; const int bh = it >> 5, n = it & 31; const bf16* Prow0 = P + ((size_t)(bh >> 2) * SEQ + n * 128) * EVEN_IN;
        tile_ld<128, 128>(qR, Prow0 + E_RQ + (bh & 3) * 128, EVEN_IN, F.tid); tile_ld<128, 128>(kR, Prow0 + E_RK + (bh & 3) * 128, EVEN_IN, F.tid); }
    for (int it = F.bid; it < 1024; it += F.G) {
        const int tidl = lndv(F.tid), lane = tidl & 63, r = lane & 31, h2 = lane >> 5;
        const int bh = it >> 5, n = it & 31, b = bh >> 2, h = bh & 3;
        const float lg = ret_log2g(h);
        const bf16* Prow0 = P + ((size_t)b * SEQ + n * 128) * EVEN_IN;
        {   v4u vR[4], sR[4]; tile_ld<128, 128>(vR, Prow0 + E_RV + h * 128, EVEN_IN, tidl); tile_ld<128, 128>(sR, RKV + (size_t)it * 128 * 128, 128, tidl);
#pragma unroll
            for (int i = 0; i < 4; ++i) { const int row = (tidl >> 4) + 32 * i, cc = tidl & 15; const float fq = __builtin_amdgcn_exp2f(lg * (float)row), fk = __builtin_amdgcn_rcpf(fq); v4u oq, ok;
#pragma unroll
                for (int k = 0; k < 4; ++k) { oq[k] = cvtpk(bflo(qR[i][k]) * fq, bfhi(qR[i][k]) * fq); ok[k] = cvtpk(bflo(kR[i][k]) * fk, bfhi(kR[i][k]) * fk); }
                *(LAS v4u*)(L + RC_QI + row * PR + cc * 16) = oq; *(LAS v4u*)(L + RC_KI + row * PR + cc * 16) = ok; }
            tile_st<128, 128>(vR, L + RC_VI, PT, tidl); tile_st<128, 128>(sR, L + RC_SI, PT, tidl); }
        WG_BAR();
        bf16x8 PA[4][2];
#pragma unroll
        for (int jb = 0; jb < 4; ++jb) {
            if (jb <= ib) {
                f32x16 x = {0.f, 0.f, 0.f, 0.f, 0.f, 0.f, 0.f, 0.f, 0.f, 0.f, 0.f, 0.f, 0.f, 0.f, 0.f, 0.f};
#pragma unroll
                for (int ks = 0; ks < 8; ++ks) x = MFMA32(ld_row(L + RC_KI, PR, jb * 32, 16 * ks, r, h2), ld_row(L + RC_QI, PR, ib * 32, 16 * ks, r, h2), x);
                if (jb == ib) {
#pragma unroll
                    for (int i = 0; i < 16; ++i) if (crow(i, h2) > r) x[i] = 0.f; }
                PA[jb][0] = PACK_STEP(x, 0); PA[jb][1] = PACK_STEP(x, 1);
            } else { PA[jb][0] = (bf16x8){0, 0, 0, 0, 0, 0, 0, 0}; PA[jb][1] = (bf16x8){0, 0, 0, 0, 0, 0, 0, 0}; }
        }
        f32x16 o[2];
#pragma unroll
        for (int t = 0; t < 2; ++t) {
            const int eb = 2 * eq + t;
            f32x16 z = {0.f, 0.f, 0.f, 0.f, 0.f, 0.f, 0.f, 0.f, 0.f, 0.f, 0.f, 0.f, 0.f, 0.f, 0.f, 0.f}, y = z;
#pragma unroll
            for (int jb = 0; jb < 4; ++jb) if (jb <= ib) {
#pragma unroll
                for (int s = 0; s < 2; ++s) z = MFMA32(PA[jb][s], ld_tr_perm(L + RC_VI, PT, jb * 32 + 16 * s, eb * 32, lane), z); }
#pragma unroll
            for (int ks = 0; ks < 8; ++ks) y = MFMA32(ld_row(L + RC_QI, PR, ib * 32, 16 * ks, r, h2), ld_tr(L + RC_SI, PT, 16 * ks, eb * 32, lane), y);
            const float g1 = __builtin_amdgcn_exp2f(lg);
#pragma unroll
            for (int i = 0; i < 16; ++i) z[i] += y[i] * g1;
            o[t] = z;
        }
        WG_BAR();
#pragma unroll
        for (int t = 0; t < 2; ++t)
#pragma unroll
            for (int i = 0; i < 16; ++i) *(LAS bf16*)(L + RC_QI + (ib * 32 + crow(i, h2)) * PR + ((2 * eq + t) * 32 + r) * 2) = cvt1(o[t][i]);
        WG_BAR();
        {   const int nx = (it + F.G < 1024) ? it + F.G : it; const int bh2 = nx >> 5, n2 = nx & 31; const bf16* Pn = P + ((size_t)(bh2 >> 2) * SEQ + n2 * 128) * EVEN_IN;
            tile_ld<128, 128>(qR, Pn + E_RQ + (bh2 & 3) * 128, EVEN_IN, tidl); tile_ld<128, 128>(kR, Pn + E_RK + (bh2 & 3) * 128, EVEN_IN, tidl); }
        {
            const int tid2 = lndv(tidl), row = tid2 >> 2, qtr = tid2 & 3;
            lcp orow = L + RC_QI + row * PR + qtr * 64;
            v4u w[4]; float sum = 0.f;
#pragma unroll
            for (int c = 0; c < 4; ++c) { w[c] = *(const LAS v4u*)(orow + c * 16);
#pragma unroll
                for (int i = 0; i < 4; ++i) sum += bflo(w[c][i]) + bfhi(w[c][i]); }
            sum += xsw<1>(sum); sum += xsw<2>(sum);
            const float mu = sum * (1.0f / 128.0f); float sq = 0.f;
#pragma unroll
            for (int c = 0; c < 4; ++c)
#pragma unroll
                for (int i = 0; i < 4; ++i) { const float d0 = bflo(w[c][i]) - mu, d1 = bfhi(w[c][i]) - mu; sq += d0 * d0 + d1 * d1; }
            sq += xsw<1>(sq); sq += xsw<2>(sq);
            const float rstd = 1.0f / sqrtf(sq * (1.0f / 128.0f) + EPS);
            const bf16* gp = Prow0 + (size_t)row * EVEN_IN + E_RG + h * 128 + qtr * 32;
            bf16* op = CAT + ((size_t)b * SEQ + n * 128 + row) * D + h * 128 + qtr * 32;
#pragma unroll
            for (int c = 0; c < 4; ++c) { const v4u gw = *(const GAS v4u*)(gp + c * 8); v4u ow;
#pragma unroll
                for (int i = 0; i < 4; ++i) { const float g0 = bflo(gw[i]), g1 = bfhi(gw[i]);
                    ow[i] = cvtpk((bflo(w[c][i]) - mu) * rstd * silu_f(g0), (bfhi(w[c][i]) - mu) * rstd * silu_f(g1)); }
                *(GAS v4u*)(op + c * 8) = ow; }
        }
        WG_BAR();
    }
}
struct DilTile { int b, head, p, dil, res, q0; };
__device__ __forceinline__ DilTile dil_decode(int T) { DilTile t; t.b = T / 384; const int rem = T - t.b * 384; t.head = rem / 48; const int t48 = rem - t.head * 48; t.p = t48 >> 4; const int idx = t48 & 15, sh = 2 * t.p;
    t.dil = 1 << sh; t.res = idx & (t.dil - 1); t.q0 = (idx >> sh) * 256; return t; }
__device__ __forceinline__ void dil_ld(v4u (&kR)[6], v4u (&vR)[6], const DilTile& t, const bf16* P, int tid) {
    const bf16* Pb = P + (size_t)t.b * SEQ * EVEN_IN + t.head * 64 + (tid & 7) * 8;
#pragma unroll
    for (int i = 0; i < 6; ++i) { int kidx = t.q0 - 128 + (tid >> 3) + 64 * i; kidx = kidx < 0 ? 0 : kidx;
        const bf16* src = Pb + (size_t)(kidx * t.dil + t.res) * EVEN_IN; kR[i] = *(const GAS v4u*)(src + E_DK); vR[i] = *(const GAS v4u*)(src + E_DV); }
}
__device__ __forceinline__ void dil_tiles(const Frame& F, int T0, int T1, int step, const bf16* P, bf16* OD, float* LSE) {
    LAS unsigned char* L = F.lds;
    const int wave = F.wave;
    if (T0 >= T1) return;
    v4u kR[6], vR[6];
    { const DilTile t0 = dil_decode(T0); dil_ld(kR, vR, t0, P, F.tid); }
    for (int T = T0; T < T1; T += step) {
        const int tidl = lndv(F.tid), lane = tidl & 63, r = lane & 31, h2 = lane >> 5;
        const DilTile t = dil_decode(T);
        const bf16* Pb = P + (size_t)t.b * SEQ * EVEN_IN + t.head * 64;
#pragma unroll
        for (int i = 0; i < 6; ++i) { const int row = (tidl >> 3) + 64 * i, cc = tidl & 7; *(LAS v4u*)(L + DL_KI + row * DPK + cc * 16) = kR[i]; *(LAS v4u*)(L + DL_VI + row * DPV + cc * 16) = vR[i]; }
        bf16x8 qf[4];
        { const bf16* qsrc = Pb + (size_t)((t.q0 + 32 * wave + r) * t.dil + t.res) * EVEN_IN + E_DQ + 8 * h2;
#pragma unroll
          for (int ks = 0; ks < 4; ++ks) qf[ks] = *(const GAS bf16x8*)(qsrc + 16 * ks); }
        WG_BAR();
        { const DilTile tn = dil_decode(T + step < T1 ? T + step : T); dil_ld(kR, vR, tn, P, tidl); }
        f32x16 x[5];
        float mx = -INFINITY;
#pragma unroll
        for (int kb = 0; kb < 5; ++kb) {
            f32x16 a = {0.f, 0.f, 0.f, 0.f, 0.f, 0.f, 0.f, 0.f, 0.f, 0.f, 0.f, 0.f, 0.f, 0.f, 0.f, 0.f};
#pragma unroll
            for (int ks = 0; ks < 4; ++ks) a = MFMA32(ld_row(L + DL_KI, DPK, 32 * wave + 32 * kb, 16 * ks, r, h2), qf[ks], a);
            if (kb == 0) {
#pragma unroll
                for (int i = 0; i < 16; ++i) if (crow(i, h2) < r) a[i] = -INFINITY; }
            if (kb == 4) {
#pragma unroll
                for (int i = 0; i < 16; ++i) if (crow(i, h2) > r) a[i] = -INFINITY; }
            if (t.q0 == 0 && 32 * wave + 32 * kb < 128) {
#pragma unroll
                for (int i = 0; i < 16; ++i) a[i] = -INFINITY; }
#pragma unroll
            for (int i = 0; i < 16; ++i) mx = fmaxf(mx, a[i]);
            x[kb] = a;
        }
        mx = max32(mx);
        constexpr float C2 = 0.125f * LOG2E;
        const float mc = mx * C2; float l = 0.f;
#pragma unroll
        for (int kb = 0; kb < 5; ++kb)
#pragma unroll
            for (int i = 0; i < 16; ++i) { const float pe = __builtin_amdgcn_exp2f(x[kb][i] * C2 - mc); x[kb][i] = pe; l += pe; }
        l = sum32(l);
        f32x16 o[2];
#pragma unroll
        for (int dbk = 0; dbk < 2; ++dbk) o[dbk] = (f32x16){0.f, 0.f, 0.f, 0.f, 0.f, 0.f, 0.f, 0.f, 0.f, 0.f, 0.f, 0.f, 0.f, 0.f, 0.f, 0.f};
#pragma unroll
        for (int kb = 0; kb < 5; ++kb)
#pragma unroll
            for (int s = 0; s < 2; ++s) { const bf16x8 pa = PACK_STEP(x[kb], s);
#pragma unroll
                for (int dbk = 0; dbk < 2; ++dbk) o[dbk] = MFMA32(pa, ld_tr_perm(L + DL_VI, DPV, 32 * wave + 32 * kb + 16 * s, dbk * 32, lane), o[dbk]); }
        LAS float* lw = (LAS float*)(L + DL_LW + wave * 256);
        if (h2 == 0) lw[r] = l;
        WG_BAR();
        LAS unsigned char* st = L + DL_ST + wave * 32 * DPK;
#pragma unroll
        for (int i = 0; i < 16; ++i) { const float rl = __builtin_amdgcn_rcpf(lw[crow(i, h2)]);
#pragma unroll
            for (int dbk = 0; dbk < 2; ++dbk) *(LAS bf16*)(st + crow(i, h2) * DPK + (dbk * 32 + r) * 2) = cvt1(o[dbk][i] * rl); }
        const size_t tokbase = (size_t)t.b * SEQ;
        bf16* odp = OD + (size_t)t.p * M * 512;
#pragma unroll
        for (int j = 0; j < 4; ++j) { const int c = lane + 64 * j, row = c >> 3, cc = c & 7; const size_t tok = tokbase + (size_t)(t.q0 + 32 * wave + row) * t.dil + t.res;
            *(GAS v4u*)(odp + tok * 512 + t.head * 64 + cc * 8) = *(const LAS v4u*)(st + row * DPK + cc * 16); }
        if (h2 == 0) { const size_t tok = tokbase + (size_t)(t.q0 + 32 * wave + r) * t.dil + t.res; LSE[((size_t)t.p * M + tok) * 8 + t.head] = mx * 0.125f + LN2 * __builtin_amdgcn_logf(l); }
        WG_BAR();
    }
}
__device__ __forceinline__ void dil_combine(const Frame& F, const bf16* OD, const float* LSE, bf16* CAT) {
    for (int gt = F.bid * NTHREADS + F.tid; gt < M * 64; gt += F.G * NTHREADS) {
        const int tok = gt >> 6, c8 = gt & 63, head = c8 >> 3;
        const float l0 = LSE[(size_t)tok * 8 + head], l1 = LSE[((size_t)M + tok) * 8 + head], l2 = LSE[((size_t)2 * M + tok) * 8 + head];
        const float mxl = fmaxf(l0, fmaxf(l1, l2));
        float w0 = __builtin_amdgcn_exp2f((l0 - mxl) * LOG2E), w1 = __builtin_amdgcn_exp2f((l1 - mxl) * LOG2E), w2 = __builtin_amdgcn_exp2f((l2 - mxl) * LOG2E);
        const float rs = 1.0f / (w0 + w1 + w2); w0 *= rs; w1 *= rs; w2 *= rs;
        const v4u a = *(const GAS v4u*)(OD + (size_t)tok * 512 + c8 * 8), bq = *(const GAS v4u*)(OD + ((size_t)M + tok) * 512 + c8 * 8), cq = *(const GAS v4u*)(OD + ((size_t)2 * M + tok) * 512 + c8 * 8);
        v4u o;
#pragma unroll
        for (int i = 0; i < 4; ++i) o[i] = cvtpk(w0 * bflo(a[i]) + w1 * bflo(bq[i]) + w2 * bflo(cq[i]), w0 * bfhi(a[i]) + w1 * bfhi(bq[i]) + w2 * bfhi(cq[i]));
        *(GAS v4u*)(CAT + (size_t)tok * D + 512 + c8 * 8) = o;
    }
}
constexpr int DIL_TILES = 3072, DIL_SPLIT = 1024;
__device__ __forceinline__ void even_phase_a(const Frame& F0) {
    const Frame F = relaunder(F0);
    unsigned char* ws = WSP();
    const bf16* P = (const bf16*)(ws + WS_ACT); bf16* RKV = (bf16*)OUTP(); bf16* OD = (bf16*)(ws + WS_OD); float* LSE = (float*)((unsigned char*)OUTP() + OUT_LSE);
    ret_phase_a_items(F, P, RKV);
    dil_tiles(F, F.bid, DIL_SPLIT, F.G, P, OD, LSE);
}
__device__ __forceinline__ void even_phase_b(const Frame& F0) {
    const Frame F = relaunder(F0);
    unsigned char* ws = WSP();
    const bf16* P = (const bf16*)(ws + WS_ACT); bf16* RKV = (bf16*)OUTP(); bf16* OD = (bf16*)(ws + WS_OD); float* LSE = (float*)((unsigned char*)OUTP() + OUT_LSE);
    ret_scan(F, RKV);
    dil_tiles(F, DIL_SPLIT + F.bid, DIL_TILES, F.G, P, OD, LSE);
}
__device__ __forceinline__ void even_phase_c(const Frame& F0) {
    const Frame F = relaunder(F0);
    unsigned char* ws = WSP();
    const bf16* P = (const bf16*)(ws + WS_ACT); const bf16* RKV = (const bf16*)OUTP(); const bf16* OD = (const bf16*)(ws + WS_OD); const float* LSE = (const float*)((unsigned char*)OUTP() + OUT_LSE); bf16* CAT = (bf16*)(ws + WS_CAT);
    ret_phase_c_items(F, P, RKV, CAT);
    dil_combine(F, OD, LSE, CAT);
}

__global__ void __launch_bounds__(NTHREADS, 2) fwd_kernel(Args args) {
    extern __shared__ __attribute__((aligned(16))) unsigned char lds[];
    Frame F;
    F.lds = (LAS unsigned char*)lds;
    F.wave = __builtin_amdgcn_readfirstlane((int)(threadIdx.x >> 6)); F.lane = hw_lane(); F.tid = F.wave * 64 + F.lane; F.G = gridDim.x; F.bid = blockIdx.x;
    for (int u = F.tid; u < (LDS_BYTES - LDSCTL_OFF) / 4; u += NTHREADS) ((LAS unsigned*)(F.lds + LDSCTL_OFF))[u] = 0u;
    __syncthreads();
    if (F.tid < N_PTRS) { const unsigned long long v = (F.tid < 17) ? (unsigned long long)args.in[F.tid] : (F.tid == 17 ? (unsigned long long)args.out : (unsigned long long)args.ws);
        ((LAS unsigned*)(F.lds + PTR_OFF))[2 * F.tid] = (unsigned)v; ((LAS unsigned*)(F.lds + PTR_OFF))[2 * F.tid + 1] = (unsigned)(v >> 32); }
    __syncthreads();
    (void)xcd_barrier_post((unsigned*)(WSP() + WS_CTL) + CW_BAR, (volatile LAS unsigned*)(F.lds + MISC_OFF) + 8, F.tid);
#ifdef PROBE_BARX2
#define PROBE_BAR2(b, t) xcd_barrier(b, t)
#else
#define PROBE_BAR2(b, t) do {} while (0)
#endif
#define GRID_BAR() do { XcdBarrier bar_; bar_.bar = (unsigned*)(WSP() + WS_CTL) + CW_BAR; bar_.x = (unsigned)__builtin_amdgcn_readfirstlane((int)xb_xcc_id()); \
        int mo_ = MISC_OFF + 32; asm volatile("" : "+s"(mo_)); bar_.st = (volatile LAS unsigned*)(F.lds + mo_); int t_ = threadIdx.x; asm volatile("" : "+v"(t_)); xcd_barrier(bar_, t_); PROBE_BAR2(bar_, t_); } while (0)
#define XB ((bf16*)(WSP() + WS_XB))
#define ACT ((bf16*)(WSP() + WS_ACT))
#define CAT ((bf16*)(WSP() + WS_CAT))
#define SSP ((float*)(WSP() + WS_SSP))
#define WPTR(off) ((const bf16*)(WSP() + (off)))

#ifdef TEST_MIN
    {
        pg8::Gemm g{XB, WPTR(W_GU0), M, 2 * FF, D}; pg8::StaticOrder S; S.init(M, 2 * FF, lnd(F.G), lnd(F.bid));
        pg8::EpiSwiGLU E{ACT, FF, SSP};
        pg8::gemm_phase<pg8::EpiSwiGLU, pg8::StaticOrder, true, true>(F.lds + RING_OFF, g, S, E, lnd(F.wave));
        GRID_BAR();
        return;
    }
#endif
    prologue_rows(F);
    convert_weights(F, 0);
    GRID_BAR();
    for (int s = 0; s < 8; ++s) {
        const int l = s >> 1; const bool post = (s & 1) != 0;
#ifdef PROBE_F1X2
        for (int rep = 0; rep < 2; ++rep)
#endif
        {
#ifdef PROBE_KX2
            typedef pg8::TwiceOrder F1Order;
#else
            typedef pg8::StaticOrder F1Order;
#endif
            pg8::Gemm g{XB, WPTR(post ? W_GU1 : W_GU0), M, 2 * FF, D}; F1Order S; S.init(M, 2 * FF, lnd(F.G), lnd(F.bid));
            pg8::EpiSwiGLU E{ACT, FF, SSP};
#ifndef NO_F1
            pg8::gemm_phase<pg8::EpiSwiGLU, F1Order, true, true>(F.lds + RING_OFF, g, S, E, lnd(F.wave));
#endif
            GRID_BAR();
        }
#ifdef PROBE_F2X2
        for (int rep = 0; rep < 2; ++rep)
#else
        constexpr int rep = 1;
#endif
        {
            pg8::Gemm g{ACT, WPTR(post ? W_D1 : W_D0), M, D, FF}; pg8::RevOrder S; S.init(M, D, lnd(F.G), lnd(F.bid));
            pg8::EpiResid E{XB, SSP, rep ? 0.5f : 0.0f};
#ifndef NO_F2
            pg8::gemm_phase<pg8::EpiResid, pg8::RevOrder, true, true>(F.lds + RING_OFF, g, S, E, lnd(F.wave));
#endif
            GRID_BAR();
        }
        if (!post) {
            const bool odd = (l & 1) != 0; const int nin = odd ? GLA_INP : EVEN_IN;
            {
                pg8::Gemm g{XB, WPTR(W_IN), M, nin, D}; pg8::StaticOrder S; S.init(M, nin, lnd(F.G), lnd(F.bid));
                pg8::EpiInProj E{ACT, nin, SSP, (const float*)(WSP() + TAB_RC), (const float*)(WSP() + TAB_RS), (const float*)(WSP() + TAB_DC), (const float*)(WSP() + TAB_DS), odd ? 0 : 1};
#ifndef NO_M1
                pg8::gemm_phase<pg8::EpiInProj, pg8::StaticOrder, true, true>(F.lds + RING_OFF, g, S, E, lnd(F.wave));
#endif
            }
            GRID_BAR();
#ifndef NO_EVEN
#if defined(PROBE_MIXX2) || defined(PROBE_EVENX2)
            if (!odd) { even_phase_a(F); GRID_BAR(); even_phase_a(F); GRID_BAR(); even_phase_b(F); GRID_BAR(); even_phase_c(F); GRID_BAR(); even_phase_c(F); }
#else
            if (!odd) { even_phase_a(F); GRID_BAR(); even_phase_b(F); GRID_BAR(); even_phase_c(F); }
#endif
#endif
#ifndef NO_GLA
            if (odd) {
#ifndef NO_GA
                gla_phase_a(F, l >> 1);
#endif
#ifdef PROBE_MIXX2
                GRID_BAR(); gla_phase_a(F, l >> 1);
#endif
                GRID_BAR();
#ifndef NO_GB
                gla_phase_b(F);
#endif
                GRID_BAR();
#ifndef NO_GC
                gla_phase_c(F, l >> 1);
#endif
#ifdef PROBE_MIXX2
                GRID_BAR(); gla_phase_c(F, l >> 1);
#endif
            }
#endif
            GRID_BAR();
#ifdef PROBE_M5X2
            for (int rep2 = 0; rep2 < 2; ++rep2)
#else
            constexpr int rep2 = 1;
#endif
            {
                pg8::Gemm g{CAT, WPTR(W_OUT), M, D, D}; pg8::StaticOrder S; S.init(M, D, lnd(F.G), lnd(F.bid));
                pg8::EpiResid E{XB, SSP, rep2 ? 1.0f : 0.0f};
#ifndef NO_M5
                pg8::gemm_phase<pg8::EpiResid, pg8::StaticOrder, true, true>(F.lds + RING_OFF, g, S, E, lnd(F.wave));
#endif
                GRID_BAR();
            }
        } else if (l + 1 < DEPTH) {
            convert_weights(F, l + 1);
            GRID_BAR();
#ifdef PROBE_CONVX2
            convert_weights(F, l + 1);
            GRID_BAR();
#endif
        }
    }
    final_norm(F);
}

extern "C" void kernel_launch(void* const* d_in, const int* in_sizes, int n_in, void* d_out, int out_size, void* d_ws, size_t ws_size, hipStream_t stream) {
    static int grid = 0;
    if (grid == 0) {
        if (n_in != 17 || in_sizes[0] != M * D || out_size != M * D || ws_size < WS_END2) { fprintf(stderr, "kernel_launch: unexpected shapes (n_in %d, in0 %d, out %d, ws %zu)\n", n_in, n_in > 0 ? in_sizes[0] : -1, out_size, ws_size); grid = -1; return; }
        int dev = 0, cus = 0, per_cu = 0;
        if (hipGetDevice(&dev) != hipSuccess || hipDeviceGetAttribute(&cus, hipDeviceAttributeMultiprocessorCount, dev) != hipSuccess) { grid = -1; return; }
        if (hipFuncSetAttribute((const void*)fwd_kernel, hipFuncAttributeMaxDynamicSharedMemorySize, LDS_BYTES) != hipSuccess) { fprintf(stderr, "kernel_launch: hipFuncSetAttribute failed\n"); grid = -1; return; }
        if (hipOccupancyMaxActiveBlocksPerMultiprocessor(&per_cu, (const void*)fwd_kernel, NTHREADS, LDS_BYTES) != hipSuccess || per_cu < 1) { fprintf(stderr, "kernel_launch: occupancy query reports %d\n", per_cu); }
        (void)hipGetLastError();
        grid = cus;
        if (grid != 256) fprintf(stderr, "kernel_launch: %d CUs (expected 256)\n", grid);
    }
    if (grid < 0) return;
    if (hipMemsetAsync((char*)d_ws + WS_CTL, 0, CTL_ZERO_BYTES, stream) != hipSuccess) return;
    Args a{};
    for (int i = 0; i < 17; ++i) a.in[i] = (const float*)d_in[i];
    a.out = (float*)d_out; a.ws = (unsigned char*)d_ws;
    hipLaunchKernelGGL(fwd_kernel, dim3(grid), dim3(NTHREADS), LDS_BYTES, stream, a);
}
```

```cpp
#include <hip/hip_runtime.h>
#include <cstdio>
#include <cstdint>
#include <cmath>
template <int K> __device__ __forceinline__ float xsw(float v) { static_assert(K == 1 || K == 2 || K == 4 || K == 8 || K == 16, "xor mask inside a 32-lane half");
    return __builtin_bit_cast(float, __builtin_amdgcn_ds_swizzle(__builtin_bit_cast(int, v), 0x1F | (K << 10))); }
__device__ __forceinline__ float sum32(float v) { const unsigned u = __builtin_bit_cast(unsigned, v); auto rr = __builtin_amdgcn_permlane32_swap(u, u, false, false); return __builtin_bit_cast(float, (unsigned)rr[0]) + __builtin_bit_cast(float, (unsigned)rr[1]); }
__device__ __forceinline__ float max32(float v) { const unsigned u = __builtin_bit_cast(unsigned, v); auto rr = __builtin_amdgcn_permlane32_swap(u, u, false, false); return fmaxf(__builtin_bit_cast(float, (unsigned)rr[0]), __builtin_bit_cast(float, (unsigned)rr[1])); }
__device__ __forceinline__ float oth32(float v, int h) { const unsigned u = __builtin_bit_cast(unsigned, v); auto rr = __builtin_amdgcn_permlane32_swap(u, u, false, false); return __builtin_bit_cast(float, (unsigned)(h ? rr[0] : rr[1])); }
namespace pg8 {
#define PG8_LAS __attribute__((address_space(3)))
typedef unsigned short bf16_t;
typedef short bf16x8 __attribute__((ext_vector_type(8)));
typedef float f32x4 __attribute__((ext_vector_type(4)));
typedef unsigned u32x4 __attribute__((ext_vector_type(4)));
constexpr int BM = 256, BK = 64, HALF = 128, HTB = HALF * BK * 2  , STAGE_BYTES = 8 * HTB, NXCD = 8, WGM = 8;

__host__ __device__ __forceinline__ int lds_byte(int r, int c) { const int st = (r >> 4) * 2 + (c >> 5), rr = r & 15, cc = c & 31, ob = rr * 64 + cc * 2; return st * 1024 + (ob ^ (((ob >> 9) & 1) << 5)); }
__host__ __device__ __forceinline__ void stage_rc(int b, int& R, int& C) { const int st = b / 1024, sb = b % 1024, swz = sb ^ (((sb >> 9) & 1) << 5); R = (st >> 1) * 16 + swz / 64; C = (st & 1) * 32 + (swz % 64) / 2; }
__host__ __device__ __forceinline__ int perm32(int rho) { const int n = rho >> 4, i = rho & 15; return 8 * (i >> 2) + 4 * n + (i & 3); }

struct Unit { int pm, pn; };
struct Gemm { const bf16_t* A; const bf16_t* Bt; int M, N, K; };

struct StaticOrder {
    int nM, nN, nwg, G, c;
    __host__ __device__ void init(int M, int N, int G_, int c_) { nM = M / BM; nN = N / BM; nwg = nM * nN; G = G_; c = c_; }
    __host__ __device__ bool next(int i, Unit& u) const {
        const long L = (long)i * G + c; if (L >= nwg) return false;
        int wgid = (int)L; { const int q = nwg / NXCD, r = nwg % NXCD, xcd = wgid % NXCD, off = wgid / NXCD; wgid = (xcd < r ? xcd * (q + 1) : r * (q + 1) + (xcd - r) * q) + off; }
        const int nig = WGM * nN, gid = wgid / nig, fm = gid * WGM, gsz = (nM - fm) < WGM ? (nM - fm) : WGM;
        u.pm = fm + ((wgid % nig) % gsz); u.pn = (wgid % nig) / gsz; return true;
    }
    __device__ __forceinline__ void a_ready(const Unit&) const {}
    __device__ __forceinline__ void done(const Unit&) const {}
    static constexpr bool TWICE = false;
};
struct RevOrder : StaticOrder {
    __host__ __device__ bool next(int i, Unit& u) const { const int rounds = nwg / G; if (i >= rounds) return false; return StaticOrder::next(rounds - 1 - i, u); }
};
struct TwiceOrder : StaticOrder {
    static constexpr bool TWICE = true;
    __host__ __device__ bool next(int i, Unit& u) const { return StaticOrder::next(i >> 1, u); }
};

__device__ __forceinline__ unsigned cvt_pk_bf16(float lo, float hi) { unsigned r; asm volatile("v_cvt_pk_bf16_f32 %0, %1, %2" : "=v"(r) : "v"(lo), "v"(hi)); return r; }
constexpr int MROWS = 32768;
constexpr float RMS_EPS = 1e-6f;
__device__ __forceinline__ void row_rstd(float (&rs)[2][4], const float* ssp, const Unit& u, int wr, int fr, int fq) {
#pragma unroll
    for (int ai = 0; ai < 2; ++ai)
#pragma unroll
        for (int m = 0; m < 4; ++m) {
            const int row = u.pm * BM + ai * HALF + wr * 64 + m * 16 + fr;
            const f32x4 p = *(const f32x4*)(ssp + (size_t)row * 16 + 4 * fq);
            float s = (p[0] + p[1]) + (p[2] + p[3]);
            s += xsw<16>(s); s = sum32(s);
            rs[ai][m] = 1.0f / sqrtf(s * (1.0f / 1024.0f) + RMS_EPS);
        }
}
__device__ __forceinline__ float silu_f(float g) { return g * __builtin_amdgcn_rcpf(1.0f + __builtin_amdgcn_exp2f(-1.4426950408889634f * g)); }

struct EpiSwiGLU {
    static constexpr bool PERM = true, AFTER_DRAIN = false;
    bf16_t* H; int ldh; const float* ssp;
    __device__ __forceinline__ void operator()(const f32x4 (&acc)[2][2][4][2], const Unit& u, int wr, int wc, int fr, int fq) const {
        float rs[2][4]; row_rstd(rs, ssp, u, wr, fr, fq);
        const int col0 = u.pn * HALF + wc * 32 + 8 * fq;
#pragma unroll
        for (int ai = 0; ai < 2; ++ai)
#pragma unroll
            for (int m = 0; m < 4; ++m) {
                const int row = u.pm * BM + ai * HALF + wr * 64 + m * 16 + fr; const float r = rs[ai][m];
                float h[8];
#pragma unroll
                for (int n = 0; n < 2; ++n)
#pragma unroll
                    for (int i = 0; i < 4; ++i) { const float g = acc[ai][0][m][n][i] * r, up = acc[ai][1][m][n][i] * r; h[4 * n + i] = silu_f(g) * up; }
                u32x4 w; w.x = cvt_pk_bf16(h[0], h[1]); w.y = cvt_pk_bf16(h[2], h[3]); w.z = cvt_pk_bf16(h[4], h[5]); w.w = cvt_pk_bf16(h[6], h[7]);
                *(u32x4*)(H + (size_t)row * ldh + col0) = w;
                asm volatile("" ::: "memory");
            }
    }
};
struct EpiInProj {
    static constexpr bool PERM = true, AFTER_DRAIN = false;
    bf16_t* O; int ldc; const float* ssp; const float* rc; const float* rs; const float* dc; const float* ds; int even;
    __device__ __forceinline__ void operator()(const f32x4 (&acc)[2][2][4][2], const Unit& u, int wr, int wc, int fr, int fq) const {
        float rsd[2][4]; row_rstd(rsd, ssp, u, wr, fr, fq);
        const int col0 = u.pn * BM + wc * 32 + 8 * fq;
        const int kind = even ? (u.pn < 4 ? 1 : ((u.pn >= 8 && u.pn < 12) ? 2 : 0)) : 0;
        const float ksc = (kind == 1 && u.pn >= 2) ? 0.08838834764831845f : 1.0f;
        const bool rot2 = (kind == 2) && ((wc & 1) == 0) && (fq < 2);
        const float* tc = (kind == 1) ? rc + wc * 16 + 4 * fq : dc + 4 * (fq & 1);
        const float* ts = (kind == 1) ? rs + wc * 16 + 4 * fq : ds + 4 * (fq & 1);
        const int tstride = (kind == 1) ? 64 : 8;
#pragma unroll
        for (int ai = 0; ai < 2; ++ai)
#pragma unroll
            for (int m = 0; m < 4; ++m) {
                const int row = u.pm * BM + ai * HALF + wr * 64 + m * 16 + fr; const float r = rsd[ai][m] * ksc;
                f32x4 c4 = {1.f, 1.f, 1.f, 1.f}, s4 = {0.f, 0.f, 0.f, 0.f};
                if (kind == 1 || rot2) { const int pos = row & 4095; c4 = *(const f32x4*)(tc + (size_t)pos * tstride); s4 = *(const f32x4*)(ts + (size_t)pos * tstride); }
#pragma unroll
                for (int bj = 0; bj < 2; ++bj) { const f32x4 v0 = acc[ai][bj][m][0] * r, v1 = acc[ai][bj][m][1] * r;
                    const float o0 = v0[0] * c4[0] - v0[1] * s4[0], o1 = v0[1] * c4[0] + v0[0] * s4[0], o2 = v0[2] * c4[1] - v0[3] * s4[1], o3 = v0[3] * c4[1] + v0[2] * s4[1];
                    const float o4 = v1[0] * c4[2] - v1[1] * s4[2], o5 = v1[1] * c4[2] + v1[0] * s4[2], o6 = v1[2] * c4[3] - v1[3] * s4[3], o7 = v1[3] * c4[3] + v1[2] * s4[3];
                    u32x4 w; w.x = cvt_pk_bf16(o0, o1); w.y = cvt_pk_bf16(o2, o3); w.z = cvt_pk_bf16(o4, o5); w.w = cvt_pk_bf16(o6, o7);
                    *(u32x4*)(O + (size_t)row * ldc + col0 + bj * HALF) = w; }
                asm volatile("" ::: "memory");
            }
    }
};
struct EpiResid {
    static constexpr bool PERM = true, AFTER_DRAIN = false;
    bf16_t* xb; float* ssp; float scale;
    __device__ __forceinline__ void operator()(const f32x4 (&acc)[2][2][4][2], const Unit& u, int wr, int wc, int fr, int fq) const {
        const int col0 = u.pn * BM + wc * 32 + 8 * fq, rowb = u.pm * BM + wr * 64 + fr;
        u32x4 old[8][2];
#pragma unroll
        for (int g = 0; g < 8; ++g) { const size_t off = (size_t)(rowb + (g >> 2) * HALF + (g & 3) * 16) * 1024 + col0; old[g][0] = *(const u32x4*)(xb + off); old[g][1] = *(const u32x4*)(xb + off + HALF); }
#pragma unroll
        for (int g = 0; g < 8; ++g) {
            const int ai = g >> 2, m = g & 3, row = rowb + ai * HALF + m * 16; float ss = 0.f;
#pragma unroll
            for (int bj = 0; bj < 2; ++bj) { const size_t off = (size_t)row * 1024 + col0 + bj * HALF; const u32x4 o = old[g][bj];
                const f32x4 a0 = acc[ai][bj][m][0] * scale, a1 = acc[ai][bj][m][1] * scale;
                const float v0 = __builtin_bit_cast(float, o.x << 16) + a0[0], v1 = __builtin_bit_cast(float, o.x & 0xffff0000u) + a0[1], v2 = __builtin_bit_cast(float, o.y << 16) + a0[2], v3 = __builtin_bit_cast(float, o.y & 0xffff0000u) + a0[3];
                const float v4 = __builtin_bit_cast(float, o.z << 16) + a1[0], v5 = __builtin_bit_cast(float, o.z & 0xffff0000u) + a1[1], v6 = __builtin_bit_cast(float, o.w << 16) + a1[2], v7 = __builtin_bit_cast(float, o.w & 0xffff0000u) + a1[3];
                u32x4 w; w.x = cvt_pk_bf16(v0, v1); w.y = cvt_pk_bf16(v2, v3); w.z = cvt_pk_bf16(v4, v5); w.w = cvt_pk_bf16(v6, v7);
                *(u32x4*)(xb + off) = w;
                ss += (v0 * v0 + v1 * v1) + (v2 * v2 + v3 * v3) + (v4 * v4 + v5 * v5) + (v6 * v6 + v7 * v7); }
            ss += xsw<16>(ss); ss = sum32(ss);
            if (fq == 0) ssp[(size_t)row * 16 + u.pn * 4 + wc] = ss;
        }
    }
};

template <class Epi, class Sched, bool ALIGN_EPI = false, bool SP2 = false>
__device__ __forceinline__ void gemm_phase(PG8_LAS unsigned char* lds, const Gemm g, const Sched& S, const Epi& E, int wave_in) {
    int tid_ = threadIdx.x; asm volatile("" : "+v"(tid_));
    const int tid = tid_, wid = __builtin_amdgcn_readfirstlane(tid >> 6), lane = tid & 63, wr = wid >> 2, wc = wid & 3, fr = lane & 15, fq = lane >> 4;
    const int K = g.K, nt = K / BK;
    unsigned voffA[2], voffB[2];
#pragma unroll
    for (int i = 0; i < 2; ++i) { int R, C; stage_rc(tid * 16 + i * 8192, R, C); const int Rb = Epi::PERM ? ((R & ~31) + perm32(R & 31)) : R;
        voffA[i] = (unsigned)(R * K + C) * 2u; voffB[i] = (unsigned)(Rb * K + C) * 2u; }
    const size_t kstep = (size_t)(BK * 2);
    const size_t hstep = (size_t)HALF * K * 2;
    const size_t tstep = 2 * hstep;
    const unsigned ldsw = (unsigned)wid * 1024u;
    const int aoff = lds_byte(wr * 64 + fr, fq * 8), boff = lds_byte(wc * 32 + fr, fq * 8);
#define PG8_SA(b, h) (((b) * 2 + (h)) * HTB)
#define PG8_SB(b, h) ((4 + (b) * 2 + (h)) * HTB)
#define PG8_STAGE(bufoff, gbase, voff) do { _Pragma("unroll") for (int _i = 0; _i < 2; ++_i) \
        __builtin_amdgcn_global_load_lds((const unsigned*)((const char*)(gbase) + (voff)[_i]), (PG8_LAS unsigned*)(lds + (bufoff) + ldsw + _i * 8192), 16, 0, 0); } while (0)
#define PG8_LDA(dst, b, h) do { _Pragma("unroll") for (int m = 0; m < 4; ++m) _Pragma("unroll") for (int k = 0; k < 2; ++k) dst[m][k] = *(const PG8_LAS bf16x8*)(lds + PG8_SA(b, h) + aoff + m * 2048 + k * 1024); } while (0)
#define PG8_LDB(dst, b, h) do { _Pragma("unroll") for (int n = 0; n < 2; ++n) _Pragma("unroll") for (int k = 0; k < 2; ++k) dst[n][k] = *(const PG8_LAS bf16x8*)(lds + PG8_SB(b, h) + boff + n * 2048 + k * 1024); } while (0)
#define PG8_MMA(ai, bj, At, Bt) do { __builtin_amdgcn_s_setprio(1); _Pragma("unroll") for (int m = 0; m < 4; ++m) _Pragma("unroll") for (int n = 0; n < 2; ++n) _Pragma("unroll") for (int k = 0; k < 2; ++k) \
        acc[ai][bj][m][n] = __builtin_amdgcn_mfma_f32_16x16x32_bf16(Bt[n][k], At[m][k], acc[ai][bj][m][n], 0, 0, 0); __builtin_amdgcn_s_setprio(0); } while (0)
#define PG8_WAIT_V(n) asm volatile("s_waitcnt vmcnt(" #n ")" ::: "memory")
#define PG8_WAIT_L(n) asm volatile("s_waitcnt lgkmcnt(" #n ")" ::: "memory")
#define PG8_BAR __builtin_amdgcn_s_barrier()
#define PG8_SCHED __builtin_amdgcn_sched_barrier(0)
    Unit cur, nxt; int ui = 0;
    if (!S.next(0, cur)) return;
    f32x4 acc[2][2][4][2];
#pragma unroll
    for (int a = 0; a < 2; ++a)
#pragma unroll
        for (int b = 0; b < 2; ++b)
#pragma unroll
            for (int m = 0; m < 4; ++m)
#pragma unroll
                for (int n = 0; n < 2; ++n) acc[a][b][m][n] = (f32x4){0.f, 0.f, 0.f, 0.f};
    bf16x8 At[4][2], B0[2][2], B1[2][2];
    const char* cA = (const char*)g.A + (size_t)cur.pm * tstep; const char* cB = (const char*)g.Bt + (size_t)cur.pn * tstep;
    S.a_ready(cur);
    if constexpr (SP2) {
        PG8_STAGE(PG8_SB(0, 0), cB, voffB); PG8_STAGE(PG8_SB(0, 1), cB + hstep, voffB); PG8_STAGE(PG8_SA(0, 0), cA, voffA); PG8_STAGE(PG8_SA(0, 1), cA + hstep, voffA);
        if (wr == 1) PG8_BAR;
        PG8_WAIT_V(2); PG8_BAR;
        PG8_STAGE(PG8_SB(1, 0), cB + kstep, voffB); PG8_STAGE(PG8_SA(1, 0), cA + kstep, voffA); PG8_STAGE(PG8_SB(1, 1), cB + hstep + kstep, voffB);
        PG8_WAIT_V(6); PG8_BAR;
    } else {
        PG8_STAGE(PG8_SB(0, 0), cB, voffB); PG8_STAGE(PG8_SA(0, 0), cA, voffA); PG8_STAGE(PG8_SB(0, 1), cB + hstep, voffB); PG8_STAGE(PG8_SA(0, 1), cA + hstep, voffA);
        if (wr == 1) PG8_BAR;
        PG8_WAIT_V(4); PG8_BAR;
        PG8_STAGE(PG8_SB(1, 0), cB + kstep, voffB); PG8_STAGE(PG8_SA(1, 0), cA + kstep, voffA); PG8_STAGE(PG8_SB(1, 1), cB + hstep + kstep, voffB);
        PG8_WAIT_V(6); PG8_BAR;
    }
    for (;;) {
        const bool has_next = S.next(ui + 1, nxt);
        const char* nA = has_next ? (const char*)g.A + (size_t)nxt.pm * tstep : cA; const char* nB = has_next ? (const char*)g.Bt + (size_t)nxt.pn * tstep : cB;
        for (int t = 0; t < nt; t += 2) {
            const bool last = (t == nt - 2);
            const char* a1 = cA + (size_t)(t + 1) * kstep;
            const char* a2 = last ? nA : cA + (size_t)(t + 2) * kstep; const char* b2 = last ? nB : cB + (size_t)(t + 2) * kstep;
            const char* a3 = a2 + kstep; const char* b3 = b2 + kstep;
            if (last && has_next) S.a_ready(nxt);
            if constexpr (SP2) {
            PG8_LDB(B0, 0, 0); PG8_LDB(B1, 0, 1); PG8_SCHED; PG8_LDA(At, 0, 0); PG8_STAGE(PG8_SA(1, 1), a1 + hstep, voffA);
            PG8_WAIT_V(8); PG8_WAIT_L(0); PG8_BAR; PG8_MMA(0, 0, At, B0); PG8_MMA(0, 1, At, B1); PG8_BAR; PG8_SCHED;
            PG8_LDA(At, 0, 1); PG8_STAGE(PG8_SB(0, 0), b2, voffB); PG8_STAGE(PG8_SB(0, 1), b2 + hstep, voffB); PG8_STAGE(PG8_SA(0, 0), a2, voffA);
            PG8_WAIT_V(8); PG8_WAIT_L(0); PG8_BAR; PG8_MMA(1, 0, At, B0); PG8_MMA(1, 1, At, B1); PG8_BAR; PG8_SCHED;
            PG8_LDB(B0, 1, 0); PG8_LDB(B1, 1, 1); PG8_SCHED; PG8_LDA(At, 1, 0); PG8_STAGE(PG8_SA(0, 1), a2 + hstep, voffA);
            PG8_WAIT_V(8); PG8_WAIT_L(0); PG8_BAR; PG8_MMA(0, 0, At, B0); PG8_MMA(0, 1, At, B1); PG8_BAR; PG8_SCHED;
            PG8_LDA(At, 1, 1); PG8_STAGE(PG8_SB(1, 0), b3, voffB); PG8_STAGE(PG8_SB(1, 1), b3 + hstep, voffB); PG8_STAGE(PG8_SA(1, 0), a3, voffA);
            PG8_WAIT_V(8); PG8_WAIT_L(0); PG8_BAR; PG8_MMA(1, 0, At, B0); PG8_MMA(1, 1, At, B1); PG8_BAR; PG8_SCHED;
            } else {
            PG8_LDB(B0, 0, 0); PG8_SCHED; PG8_LDA(At, 0, 0); PG8_STAGE(PG8_SA(1, 1), a1 + hstep, voffA);
            PG8_WAIT_L(8); PG8_BAR; PG8_WAIT_L(0); PG8_MMA(0, 0, At, B0); PG8_BAR; PG8_SCHED;
            PG8_LDB(B1, 0, 1); PG8_STAGE(PG8_SB(0, 0), b2, voffB);
            PG8_BAR; PG8_WAIT_L(0); PG8_MMA(0, 1, At, B1); PG8_BAR;
            PG8_LDA(At, 0, 1); PG8_STAGE(PG8_SA(0, 0), a2, voffA);
            PG8_BAR; PG8_WAIT_L(0); PG8_MMA(1, 0, At, B0); PG8_BAR; PG8_SCHED;
            PG8_STAGE(PG8_SB(0, 1), b2 + hstep, voffB);
            PG8_WAIT_V(6); PG8_BAR; PG8_MMA(1, 1, At, B1); PG8_BAR;
            PG8_LDB(B0, 1, 0); PG8_SCHED; PG8_LDA(At, 1, 0); PG8_STAGE(PG8_SA(0, 1), a2 + hstep, voffA);
            PG8_WAIT_L(8); PG8_BAR; PG8_WAIT_L(0); PG8_MMA(0, 0, At, B0); PG8_BAR; PG8_SCHED;
            PG8_LDB(B1, 1, 1); PG8_STAGE(PG8_SB(1, 0), b3, voffB);
            PG8_BAR; PG8_WAIT_L(0); PG8_MMA(0, 1, At, B1); PG8_BAR;
            PG8_LDA(At, 1, 1); PG8_STAGE(PG8_SA(1, 0), a3, voffA);
            PG8_BAR; PG8_WAIT_L(0); PG8_MMA(1, 0, At, B0); PG8_BAR; PG8_SCHED;
            PG8_STAGE(PG8_SB(1, 1), b3 + hstep, voffB);
            PG8_WAIT_V(6); PG8_BAR; PG8_MMA(1, 1, At, B1); PG8_BAR;
            }
        }
        if constexpr (ALIGN_EPI) { if (wr == 0) PG8_BAR; }
        if constexpr (!Epi::AFTER_DRAIN) { if (!Sched::TWICE || (ui & 1)) { E(acc, cur, wr, wc, fr, fq); S.done(cur); } }
        if (!has_next) break;
#pragma unroll
        for (int a = 0; a < 2; ++a)
#pragma unroll
            for (int b = 0; b < 2; ++b)
#pragma unroll
                for (int m = 0; m < 4; ++m)
#pragma unroll
                    for (int n = 0; n < 2; ++n) acc[a][b][m][n] = (f32x4){0.f, 0.f, 0.f, 0.f};
        cur = nxt; cA = nA; cB = nB; ++ui;
        if constexpr (ALIGN_EPI) { if (wr == 1) PG8_BAR; }
    }
    PG8_WAIT_V(0);
    if constexpr (!ALIGN_EPI) { if (wr == 0) PG8_BAR; }
    PG8_BAR;
    if constexpr (Epi::AFTER_DRAIN) { E.fused(acc, cur, wr, wc, fr, fq, lds, wid, lane); S.done(cur); }
#undef PG8_SA
#undef PG8_SB
#undef PG8_STAGE
#undef PG8_LDA
#undef PG8_LDB
#undef PG8_MMA
#undef PG8_WAIT_V
#undef PG8_WAIT_L
#undef PG8_BAR
#undef PG8_SCHED
}
}

constexpr int NWAVES = 8, NTHREADS = NWAVES * 64;
constexpr int BATCH = 8, SEQ = 4096, D = 1024, M = BATCH * SEQ, FF = 2816, DEPTH = 4;
constexpr int EVEN_IN = 3584, GLA_IN = 3088, GLA_INP = 3328;
static_assert(M == pg8::MROWS, "row count");
constexpr int E_RQ = 0, E_RK = 512, E_RV = 1024, E_RG = 1536, E_DQ = 2048, E_DK = 2560, E_DV = 3072;
constexpr int G_Q = 0, G_K = 512, G_V = 1024, G_R = 2048, G_A = 3072;
constexpr float EPS = 1e-6f;

constexpr size_t MiB = 1u << 20;
constexpr size_t WS_CTL = 0, CTL_ZERO_BYTES = 1 * MiB;
constexpr size_t WS_SSP = 1 * MiB;
constexpr size_t WS_TAB = 3 * MiB;
constexpr size_t TAB_RC = WS_TAB, TAB_RS = WS_TAB + 1 * MiB, TAB_DC = WS_TAB + 2 * MiB, TAB_DS = WS_TAB + 2 * MiB + 128 * 1024;
constexpr size_t WS_W = 8 * MiB;
constexpr size_t W_GU0 = WS_W, W_D0 = W_GU0 + (size_t)2 * FF * D * 2, W_GU1 = W_D0 + (size_t)D * FF * 2, W_D1 = W_GU1 + (size_t)2 * FF * D * 2,
                 W_IN = W_D1 + (size_t)D * FF * 2, W_OUT = W_IN + (size_t)EVEN_IN * D * 2, W_END = W_OUT + (size_t)D * D * 2;
constexpr size_t WS_XB = 56 * MiB;
constexpr size_t WS_ACT = 120 * MiB;
constexpr size_t WS_CAT = 344 * MiB;
constexpr size_t WS_END = 408 * MiB;
static_assert(W_END <= WS_XB && WS_XB + (size_t)M * D * 2 <= WS_ACT && WS_ACT + (size_t)M * EVEN_IN * 2 <= WS_CAT && WS_CAT + (size_t)M * D * 2 <= WS_END, "d_ws map");
constexpr int CW_BAR = 4096;

constexpr int RING_OFF = 0, RING_BYTES = 131072;
constexpr int LDSCTL_OFF = 161792, MISC_OFF = LDSCTL_OFF + 320, PTR_OFF = LDSCTL_OFF + 1024;
constexpr int LDS_BYTES = 163840;
static_assert(PTR_OFF + 19 * 8 <= LDS_BYTES && RING_BYTES <= LDSCTL_OFF, "LDS map");

#define GAS __attribute__((address_space(1)))
#define LAS __attribute__((address_space(3)))
typedef unsigned short bf16;
typedef unsigned v4u __attribute__((ext_vector_type(4)));
typedef float f32x4 __attribute__((ext_vector_type(4)));
typedef short bf16x8 __attribute__((ext_vector_type(8)));
typedef GAS unsigned gu32;
typedef GAS unsigned long long gu64;
#define RLX_AGENT __ATOMIC_RELAXED, __HIP_MEMORY_SCOPE_AGENT
#define LDS_WAIT() asm volatile("s_waitcnt lgkmcnt(0)" ::: "memory")
#define VM_WAIT() asm volatile("s_waitcnt vmcnt(0)" ::: "memory")
__device__ __forceinline__ unsigned long long rt() { return __builtin_amdgcn_s_memrealtime(); }
__device__ __forceinline__ unsigned f2bf(float f) { unsigned u = __builtin_bit_cast(unsigned, f); return (u + 0x7fffu + ((u >> 16) & 1u)) >> 16; }
__device__ __forceinline__ unsigned pk2(float lo, float hi) { return f2bf(lo) | (f2bf(hi) << 16); }

#define XB_TMO      128
#define XB_XCNT(j)  (256  + 64 * (j))
#define XB_XSUB(j)  (1280 + 64 * (j))
#define XB_XGEN(j)  (2304 + 64 * (j))
#define XB_TOP      3328
#define XB_TOPGEN   3392
#define XCD_BAR_WORDS 3456
#define XB_SPIN_CAP (1u << 18)

__device__ __forceinline__ unsigned xb_ld(unsigned* p)              { return __hip_atomic_load(p, __ATOMIC_RELAXED, __HIP_MEMORY_SCOPE_AGENT); }
__device__ __forceinline__ unsigned xb_add(unsigned* p, unsigned v) { return __hip_atomic_fetch_add(p, v, __ATOMIC_RELAXED, __HIP_MEMORY_SCOPE_AGENT); }
__device__ __forceinline__ unsigned xb_xcc_id() { return (unsigned)__builtin_amdgcn_s_getreg((3 << 11) | 20) & 0xFu; }
#define XB_SPIN(cond, bar) do { unsigned _sp = 0; while (cond) { __builtin_amdgcn_s_sleep(1); \
    if ((++_sp & 255u) == 0u) { if (xb_ld(&(bar)[XB_TMO])) break; if (_sp > XB_SPIN_CAP) { atomicAdd(&(bar)[XB_TMO], 1u); break; } } } } while (0)

struct XcdBarrier {
    unsigned* bar; unsigned x;
    volatile LAS unsigned* st;
};

__device__ __forceinline__ XcdBarrier xcd_barrier_post(unsigned* bar, volatile LAS unsigned* st, int tid) {
    XcdBarrier b; b.bar = bar; b.x = xb_xcc_id(); b.st = st;
    if (tid == 0) (void)xb_add(&bar[XB_XCNT(b.x)], 1u);
    return b;
}
__device__ __forceinline__ void xcd_barrier_complete(unsigned* bar, unsigned x, unsigned& nloc, unsigned& nx) {
    const unsigned G = gridDim.x * gridDim.y * gridDim.z;
    unsigned sum, cnt, mine, sp = 0u;
    for (;;) {
        sum = 0u; cnt = 0u; mine = 0u;
#pragma unroll
        for (unsigned j = 0; j < 16; ++j) { const unsigned c = xb_ld(&bar[XB_XCNT(j)]); sum += c; cnt += (c > 0u) ? 1u : 0u; mine = (j == x) ? c : mine; }
        if (sum == G) break;
        __builtin_amdgcn_s_sleep(1);
        if ((++sp & 255u) == 0u) { if (xb_ld(&bar[XB_TMO])) break; if (sp > XB_SPIN_CAP) { atomicAdd(&bar[XB_TMO], 1u); break; } }
    }
    nloc = mine > 0u ? mine : 1u; nx = cnt > 0u ? cnt : 1u;
}

__device__ __forceinline__ void xcd_barrier(const XcdBarrier& b, int tid) {
    asm volatile("s_waitcnt vmcnt(0)" ::: "memory");
    __syncthreads();
    if (tid == 0) {
        unsigned* bar = b.bar;
        __builtin_amdgcn_s_waitcnt(0);
        unsigned nloc = b.st[0], nx = b.st[1];
        if (nloc == 0u) { xcd_barrier_complete(bar, b.x, nloc, nx); b.st[0] = nloc; b.st[1] = nx; }
        const unsigned old = xb_add(&bar[XB_XSUB(b.x)], 1u);
        const unsigned gen = old / nloc;
        if (old + 1u == (gen + 1u) * nloc) {
            __builtin_amdgcn_fence(__ATOMIC_RELEASE, "agent");
            asm volatile("s_waitcnt vmcnt(0)" ::: "memory");
            const unsigned og = xb_add(&bar[XB_TOP], 1u);
            const unsigned tg = og / nx;
            if (og + 1u == (tg + 1u) * nx) xb_add(&bar[XB_TOPGEN], 1u);
            else XB_SPIN(xb_ld(&bar[XB_TOPGEN]) == tg, bar);
            __builtin_amdgcn_fence(__ATOMIC_ACQUIRE, "agent");
            xb_add(&bar[XB_XGEN(b.x)], 1u);
            asm volatile("s_waitcnt vmcnt(0)" ::: "memory");
        } else {
            XB_SPIN(xb_ld(&bar[XB_XGEN(b.x)]) == gen, bar);
            __builtin_amdgcn_fence(__ATOMIC_ACQUIRE, "agent");
            asm volatile("s_waitcnt vmcnt(0)" ::: "memory");
        }
    }
    __syncthreads();
}

__constant__ float RET_FREQ[64] = {1.000000000e+00f, 8.639884591e-01f, 7.464760542e-01f, 6.449466944e-01f, 5.572264791e-01f, 4.814372361e-01f, 4.159561992e-01f, 3.593813777e-01f, 3.105013371e-01f, 2.682695687e-01f, 2.317818105e-01f, 2.002568096e-01f, 1.730195731e-01f, 1.494869143e-01f, 1.291549653e-01f, 1.115883961e-01f, 9.641107172e-02f, 8.329805732e-02f, 7.196855545e-02f, 6.218000501e-02f, 5.372280627e-02f, 4.641588405e-02f, 4.010278732e-02f, 3.464834765e-02f, 2.993577160e-02f, 2.586415969e-02f, 2.234633639e-02f, 1.930697635e-02f, 1.668100432e-02f, 1.441219542e-02f, 1.245197095e-02f, 1.075835899e-02f, 9.295095690e-03f, 8.030855097e-03f, 6.938565988e-03f, 5.994840991e-03f, 5.179473665e-03f, 4.475005437e-03f, 3.866352839e-03f, 3.340484342e-03f, 2.886139788e-03f, 2.493591513e-03f, 2.154434333e-03f, 1.861406374e-03f, 1.608233666e-03f, 1.389495330e-03f, 1.200507861e-03f, 1.037224894e-03f, 8.961503627e-04f, 7.742635789e-04f, 6.689548027e-04f, 5.779692437e-04f, 4.993587499e-04f, 4.314401885e-04f, 3.727593285e-04f, 3.220597573e-04f, 2.782559313e-04f, 2.404099068e-04f, 2.077113895e-04f, 1.794602431e-04f, 1.550515735e-04f, 1.339627634e-04f, 1.157422885e-04f, 9.999999747e-05f};
__constant__ float ROPE_FREQ[8] = {1.000000000e+00f, 1.939227432e-01f, 3.760603070e-02f, 7.292664610e-03f, 1.414213562e-03f, 2.742481884e-04f, 5.318295734e-05f, 1.031338525e-05f};
struct Args { const float* in[17]; float* out; unsigned char* ws; };
enum { I_X = 0, I_PRE_NORM = 1, I_PRE_WG = 2, I_PRE_WU = 3, I_PRE_WD = 4, I_MIX_NORM = 5, I_AB_IN = 6, I_AB_OUT = 7, I_GLA_IN = 8, I_GLA_A2 = 9, I_GLA_BA = 10, I_GLA_OUT = 11,
       I_POST_NORM = 12, I_POST_WG = 13, I_POST_WU = 14, I_POST_WD = 15, I_FINAL = 16, I_OUT = 17, I_WS = 18, N_PTRS = 19 };
struct Frame {
    LAS unsigned char* lds;
    int tid, lane, wave, G, bid;
};
__device__ __forceinline__ unsigned char* tabp(const Frame& F, int idx) {
    int off_ = PTR_OFF + 8 * idx; asm volatile("" : "+s"(off_));
    const volatile LAS unsigned* T = (const volatile LAS unsigned*)(F.lds + off_);
    const unsigned lo = __builtin_amdgcn_readfirstlane(T[0]), hi = __builtin_amdgcn_readfirstlane(T[1]);
    GAS unsigned char* gp_ = (GAS unsigned char*)(((unsigned long long)hi << 32) | (unsigned long long)lo);
    return (unsigned char*)gp_;
}
#define AP(idx) ((const float*)tabp(F, idx))
#define WSP() tabp(F, I_WS)
#define OUTP() ((float*)tabp(F, I_OUT))
__device__ __forceinline__ int lnd(int v) { asm volatile("" : "+s"(v)); return v; }
__device__ __forceinline__ int hw_lane() { return (int)__builtin_amdgcn_mbcnt_hi(~0u, __builtin_amdgcn_mbcnt_lo(~0u, 0u)); }
__device__ __forceinline__ Frame relaunder(const Frame& F0) { Frame F = F0; int t_ = threadIdx.x; asm volatile("" : "+v"(t_)); asm volatile("" : "+s"(F.bid)); F.tid = t_; F.lane = F.tid & 63; F.wave = __builtin_amdgcn_readfirstlane(F.tid >> 6);
    unsigned lb_ = 0u; asm volatile("" : "+s"(lb_)); F.lds = F0.lds + lb_; return F; }
__device__ __forceinline__ float wave_sum(float v) {
    v += xsw<1>(v); v += xsw<2>(v); v += xsw<4>(v); v += xsw<8>(v); v += xsw<16>(v);
    return sum32(v);
}
__device__ __forceinline__ float bf2f(bf16 h) { return __builtin_bit_cast(float, (unsigned)h << 16); }
__device__ __forceinline__ float bflo(unsigned w) { return __builtin_bit_cast(float, w << 16); }
__device__ __forceinline__ float bfhi(unsigned w) { return __builtin_bit_cast(float, w & 0xffff0000u); }
__device__ __forceinline__ bf16 f2bf_rne(float f) { return (bf16)f2bf(f); }

__device__ __forceinline__ void tr_item(const float* W, int K, int N, int Npad, const float* gain, bf16* WT, int gu, LAS float* scr, int item, int lane) {
    const int nblk = Npad / 32, kb = item / nblk, nb = item % nblk, k0 = 64 * kb, n0 = 32 * nb;
    {
        const int c4 = lane & 7; const bool ok = n0 + 4 * c4 < N;
        const GAS float* src = (const GAS float*)W + (size_t)(k0 + (lane >> 3)) * N + n0 + 4 * c4;
        f32x4 v[8];
#pragma unroll
        for (int i = 0; i < 8; ++i) v[i] = ok ? *(const GAS f32x4*)(src + (size_t)(8 * i) * N) : (f32x4){0.f, 0.f, 0.f, 0.f};
#pragma unroll
        for (int i = 0; i < 8; ++i) { const int kk = 8 * i + (lane >> 3); const float gn = gain ? ((const GAS float*)gain)[k0 + kk] : 1.0f; LAS float* s = scr + kk * 33 + 4 * c4;
            s[0] = v[i][0] * gn; s[1] = v[i][1] * gn; s[2] = v[i][2] * gn; s[3] = v[i][3] * gn; }
    }
    LDS_WAIT(); asm volatile("" ::: "memory");
    const int c = lane & 7;
#pragma unroll
    for (int j = 0; j < 4; ++j) { const int n = (lane >> 3) + 8 * j; const LAS float* s = scr + (8 * c) * 33 + n;
        v4u o; o.x = pk2(s[0 * 33], s[1 * 33]); o.y = pk2(s[2 * 33], s[3 * 33]); o.z = pk2(s[4 * 33], s[5 * 33]); o.w = pk2(s[6 * 33], s[7 * 33]);
        int drow = n0 + n;
        if (gu == 3) {
            if (drow < 1024) { const int j = drow & 127; drow = (drow & ~127) + (j < 64 ? 2 * j : 2 * (j - 64) + 1); }
            else if (drow >= 2048 && drow < 3072) { const int j = drow & 63; drow = (drow & ~63) + (j < 8 ? 2 * j : (j < 16 ? 2 * (j - 8) + 1 : j)); }
        } else if (gu) drow = (drow >> 7) * 256 + (drow & 127) + (gu == 2 ? 128 : 0);
        *(GAS v4u*)(WT + (size_t)drow * K + k0 + 8 * c) = o; }
    LDS_WAIT(); asm volatile("" ::: "memory");
}
__device__ __forceinline__ void convert_weights(const Frame& F0, int l) {
    const Frame F = relaunder(F0);
    LAS float* scr = (LAS float*)(F.lds + RING_OFF + F.wave * 16384);
    const int gw = F.bid * NWAVES + F.wave, NGW = F.G * NWAVES;
    unsigned char* ws = WSP();
    constexpr int I_G = (D / 64) * (FF / 32), I_DN = (FF / 64) * (D / 32), I_O = (D / 64) * (D / 32);
    const bool odd = (l & 1) != 0; const int li = l >> 1;
    const int nin = odd ? GLA_IN : EVEN_IN, ninp = odd ? GLA_INP : EVEN_IN; const int I_IN = (D / 64) * (ninp / 32);
    const float* win = odd ? AP(I_GLA_IN) + (size_t)li * D * GLA_IN : AP(I_AB_IN) + (size_t)li * D * EVEN_IN;
    const float* wout = odd ? AP(I_GLA_OUT) + (size_t)li * D * D : AP(I_AB_OUT) + (size_t)li * D * D;
    const size_t fo = (size_t)l * D * FF;
    const int NITEMS = 6 * I_G + I_IN + I_O;
    static_assert(I_G == I_DN, "item counts");
    for (int it = gw; it < NITEMS; it += NGW) {
        int r = it;
        if (r < I_G) { tr_item(AP(I_PRE_WG) + fo, D, FF, FF, AP(I_PRE_NORM) + l * D, (bf16*)(ws + W_GU0), 1, scr, r, F.lane); continue; } r -= I_G;
        if (r < I_G) { tr_item(AP(I_PRE_WU) + fo, D, FF, FF, AP(I_PRE_NORM) + l * D, (bf16*)(ws + W_GU0), 2, scr, r, F.lane); continue; } r -= I_G;
        if (r < I_G) { tr_item(AP(I_PRE_WD) + fo, FF, D, D, nullptr, (bf16*)(ws + W_D0), 0, scr, r, F.lane); continue; } r -= I_G;
        if (r < I_G) { tr_item(AP(I_POST_WG) + fo, D, FF, FF, AP(I_POST_NORM) + l * D, (bf16*)(ws + W_GU1), 1, scr, r, F.lane); continue; } r -= I_G;
        if (r < I_G) { tr_item(AP(I_POST_WU) + fo, D, FF, FF, AP(I_POST_NORM) + l * D, (bf16*)(ws + W_GU1), 2, scr, r, F.lane); continue; } r -= I_G;
        if (r < I_G) { tr_item(AP(I_POST_WD) + fo, FF, D, D, nullptr, (bf16*)(ws + W_D1), 0, scr, r, F.lane); continue; } r -= I_G;
        if (r < I_IN) { tr_item(win, D, nin, ninp, AP(I_MIX_NORM) + l * D, (bf16*)(ws + W_IN), odd ? 0 : 3, scr, r, F.lane); continue; } r -= I_IN;
        tr_item(wout, D, D, D, nullptr, (bf16*)(ws + W_OUT), 0, scr, r, F.lane);
    }
}
__device__ __forceinline__ void prologue_rows(const Frame& F0) {
    const Frame F = relaunder(F0);
    unsigned char* ws = WSP();
    const int gw = F.bid * NWAVES + F.wave, NGW = F.G * NWAVES;
    bf16* XB = (bf16*)(ws + WS_XB); float* ssp = (float*)(ws + WS_SSP);
    for (int m = gw; m < M; m += NGW) {
        const GAS f32x4* xr = (const GAS f32x4*)(AP(I_X) + (size_t)m * D) + F.lane;
        GAS unsigned long long* o8 = (GAS unsigned long long*)(XB + (size_t)m * D) + F.lane;
        float s = 0.f;
#pragma unroll
        for (int j = 0; j < 4; ++j) { const f32x4 v = xr[64 * j]; s += (v.x * v.x + v.y * v.y) + (v.z * v.z + v.w * v.w);
            o8[64 * j] = (unsigned long long)pk2(v.x, v.y) | ((unsigned long long)pk2(v.z, v.w) << 32); }
        s = wave_sum(s);
        if (F.lane < 16) ssp[(size_t)m * 16 + F.lane] = (F.lane == 0) ? s : 0.f;
    }
    const int gt = F.bid * NTHREADS + F.tid, NGT = F.G * NTHREADS;
    float* rc = (float*)(ws + TAB_RC); float* rsn = (float*)(ws + TAB_RS); float* dc = (float*)(ws + TAB_DC); float* ds = (float*)(ws + TAB_DS);
    for (int e = gt; e < SEQ * 64; e += NGT) { const int t = e >> 6, i = e & 63; const float ang = (float)t * RET_FREQ[i];
        double rev = (double)ang * 0.15915494309189535; rev -= __builtin_rint(rev); const float r = (float)rev;
        rc[e] = __builtin_amdgcn_cosf(r); rsn[e] = __builtin_amdgcn_sinf(r); }
    for (int e = gt; e < SEQ * 8; e += NGT) { const int t = e >> 3, i = e & 7; const float ang = (float)t * ROPE_FREQ[i];
        double rev = (double)ang * 0.15915494309189535; rev -= __builtin_rint(rev); const float r = (float)rev;
        dc[e] = __builtin_amdgcn_cosf(r); ds[e] = __builtin_amdgcn_sinf(r); }
}

__device__ __forceinline__ void final_norm(const Frame& F0) {
    const Frame F = relaunder(F0);
    const int gw = F.bid * NWAVES + F.wave, NGW = F.G * NWAVES;
    const bf16* XBp = (const bf16*)(WSP() + WS_XB); float* out = OUTP(); const GAS f32x4* gr = (const GAS f32x4*)AP(I_FINAL);
    for (int m = gw; m < M; m += NGW) {
        const v4u w0 = *(const GAS v4u*)(XBp + (size_t)m * D + F.lane * 8), w1 = *(const GAS v4u*)(XBp + (size_t)m * D + 512 + F.lane * 8);
        float v[16]; float s = 0.f;
#pragma unroll
        for (int i = 0; i < 4; ++i) { v[2 * i] = bflo(w0[i]); v[2 * i + 1] = bfhi(w0[i]); v[8 + 2 * i] = bflo(w1[i]); v[8 + 2 * i + 1] = bfhi(w1[i]); }
#pragma unroll
        for (int i = 0; i < 16; ++i) s += v[i] * v[i];
        const float rstd = 1.0f / sqrtf(wave_sum(s) * (1.0f / D) + EPS);
        GAS f32x4* o = (GAS f32x4*)(out + (size_t)m * D);
#pragma unroll
        for (int hh = 0; hh < 2; ++hh)
#pragma unroll
            for (int q = 0; q < 2; ++q) { const int c4 = hh * 128 + F.lane * 2 + q; const f32x4 g = gr[c4];
                o[c4] = (f32x4){v[hh * 8 + q * 4] * rstd * g[0], v[hh * 8 + q * 4 + 1] * rstd * g[1], v[hh * 8 + q * 4 + 2] * rstd * g[2], v[hh * 8 + q * 4 + 3] * rstd * g[3]}; }
    }
}


__device__ __forceinline__ float silu_f(float g) { return g * __builtin_amdgcn_rcpf(1.0f + __builtin_amdgcn_exp2f(-1.4426950408889634f * g)); }
typedef float f32x16 __attribute__((ext_vector_type(16)));
typedef short s16x4 __attribute__((ext_vector_type(4)));
typedef float f32x2_t __attribute__((ext_vector_type(2)));
typedef __bf16 bf16x2_t __attribute__((ext_vector_type(2)));
#define MFMA32(a, b, c) __builtin_amdgcn_mfma_f32_32x32x16_bf16((a), (b), (c), 0, 0, 0)
__device__ __forceinline__ int crow(int reg, int h) { return (reg & 3) + 8 * (reg >> 2) + 4 * h; }
__device__ __forceinline__ unsigned cvtpk(float lo, float hi) { f32x2_t v = {lo, hi}; bf16x2_t b = __builtin_convertvector(v, bf16x2_t); return __builtin_bit_cast(unsigned, b); }
__device__ __forceinline__ bf16 cvt1(float v) { return (bf16)(cvtpk(v, 0.f) & 0xffffu); }
#define PACK_STEP(x, s) __builtin_bit_cast(bf16x8, (v4u){cvtpk((x)[8 * (s)], (x)[8 * (s) + 1]), cvtpk((x)[8 * (s) + 2], (x)[8 * (s) + 3]), cvtpk((x)[8 * (s) + 4], (x)[8 * (s) + 5]), cvtpk((x)[8 * (s) + 6], (x)[8 * (s) + 7])})
typedef const LAS unsigned char* lcp;
__device__ __forceinline__ int lndv(int v) { asm volatile("" : "+v"(v)); return v; }
__device__ __forceinline__ bf16x8 ld_row(lcp img, int P, int row0, int k0, int r, int h) { return *(const LAS bf16x8*)(img + (row0 + r) * P + (k0 + 8 * h) * 2); }
__device__ __forceinline__ bf16x8 ld_row_perm(lcp img, int P, int row0, int k0, int r, int h) {
    const s16x4 lo = *(const LAS s16x4*)(img + (row0 + r) * P + (k0 + 4 * h) * 2), hi = *(const LAS s16x4*)(img + (row0 + r) * P + (k0 + 8 + 4 * h) * 2);
    return __builtin_shufflevector(lo, hi, 0, 1, 2, 3, 4, 5, 6, 7); }
__device__ __forceinline__ s16x4 trd(lcp p) { return __builtin_bit_cast(s16x4, __builtin_amdgcn_ds_read_tr16_b64_v4i16((LAS s16x4*)p)); }
__device__ __forceinline__ bf16x8 ld_tr(lcp img, int P, int k0, int c0, int lane) {
    const int i16 = lane & 15, q = i16 >> 2, p = i16 & 3, blk = (lane >> 4) & 1, h = lane >> 5;
    lcp a = img + (k0 + 8 * h + q) * P + (c0 + 16 * blk + 4 * p) * 2;
    const s16x4 lo = trd(a), hi = trd(a + 4 * P);
    return __builtin_shufflevector(lo, hi, 0, 1, 2, 3, 4, 5, 6, 7); }
__device__ __forceinline__ bf16x8 ld_tr_perm(lcp img, int P, int k0, int c0, int lane) {
    const int i16 = lane & 15, q = i16 >> 2, p = i16 & 3, blk = (lane >> 4) & 1, h = lane >> 5;
    lcp a = img + (k0 + 4 * h + q) * P + (c0 + 16 * blk + 4 * p) * 2;
    const s16x4 lo = trd(a), hi = trd(a + 8 * P);
    return __builtin_shufflevector(lo, hi, 0, 1, 2, 3, 4, 5, 6, 7); }
template <int R, int C> __device__ __forceinline__ void tile_ld(v4u (&v)[R * C / 8 / NTHREADS], const bf16* g, size_t gp, int tid) {
    constexpr int CPR = C / 8, RS = NTHREADS / CPR;
    static_assert(NTHREADS % CPR == 0, "tile shape");
    const unsigned voff = (unsigned)((tid / CPR) * (int)gp + (tid % CPR) * 8) * 2u;
    const GAS unsigned char* gb = (const GAS unsigned char*)g;
#pragma unroll
    for (int i = 0; i < R * C / 8 / NTHREADS; ++i) v[i] = *(const GAS v4u*)(gb + (size_t)i * RS * gp * 2 + voff);
}
template <int R, int C> __device__ __forceinline__ void tile_st(const v4u (&v)[R * C / 8 / NTHREADS], LAS unsigned char* img, int P, int tid) {
    constexpr int CPR = C / 8, RS = NTHREADS / CPR;
    LAS unsigned char* lb = img + (tid / CPR) * P + (tid % CPR) * 16;
#pragma unroll
    for (int i = 0; i < R * C / 8 / NTHREADS; ++i) *(LAS v4u*)(lb + i * RS * P) = v[i];
}
template <int R, int C> __device__ __forceinline__ void stage_tile(LAS unsigned char* img, int P, const bf16* g, size_t gp, int tid) { v4u t_[R * C / 8 / NTHREADS]; tile_ld<R, C>(t_, g, gp, tid); tile_st<R, C>(t_, img, P, tid); }
#define WG_BAR() do { asm volatile("s_waitcnt lgkmcnt(0)" ::: "memory"); __builtin_amdgcn_s_barrier(); asm volatile("" ::: "memory"); } while (0)

constexpr int PR = 272, PT = 320, PT256 = 576, PO256 = 528;
constexpr size_t WS_DEC = 6 * MiB;
constexpr float LOG2E = 1.4426950408889634f, LN2 = 0.6931471805599453f;
__device__ __forceinline__ void gla_cumsum(float (&Bc)[2][16], float& Blast, lcp AL, lcp W2, const LAS float* BA, LAS float* EX, int wave, int lane) {
    const int r = lane & 31, h = lane >> 5, db = wave & 3, jh = wave >> 2;
    const bf16x8 wf = *(const LAS bf16x8*)(W2 + (db * 32 + r) * 32 + h * 16);
    const float bias = BA[db * 32 + r];
    float run = 0.f;
#pragma unroll
    for (int t = 0; t < 2; ++t) {
        const bf16x8 af = *(const LAS bf16x8*)(AL + ((jh * 2 + t) * 32 + r) * 32 + h * 16);
        f32x16 z = {0.f, 0.f, 0.f, 0.f, 0.f, 0.f, 0.f, 0.f, 0.f, 0.f, 0.f, 0.f, 0.f, 0.f, 0.f, 0.f};
        z = MFMA32(af, wf, z);
        float own[4], oth[4];
#pragma unroll
        for (int g = 0; g < 4; ++g) {
            float acc = 0.f;
#pragma unroll
            for (int i = 0; i < 4; ++i) { const float zz = z[4 * g + i] + bias;
                const float la = (fminf(zz, 0.f) - LN2 * __builtin_amdgcn_logf(1.0f + __builtin_amdgcn_exp2f(-fabsf(zz) * LOG2E))) * (1.0f / 16.0f);
                acc += la; Bc[t][4 * g + i] = acc; }
            own[g] = acc; oth[g] = oth32(acc, h);
        }
#pragma unroll
        for (int g = 0; g < 4; ++g) { const float off = run + (h ? oth[g] : 0.f);
#pragma unroll
            for (int i = 0; i < 4; ++i) Bc[t][4 * g + i] += off;
            run += own[g] + oth[g]; }
    }
    if (h == 0) EX[jh * 128 + db * 32 + r] = run;
    WG_BAR();
    const float t0 = EX[db * 32 + r], t1 = EX[128 + db * 32 + r];
    Blast = t0 + t1;
    if (jh == 1) {
#pragma unroll
        for (int t = 0; t < 2; ++t)
#pragma unroll
            for (int i = 0; i < 16; ++i) Bc[t][i] += t0; }
}
constexpr int GA_KI = 0, GA_VI = GA_KI + 128 * PR, GA_KD = GA_VI + 128 * PT256, GA_AL = GA_KD + 128 * PT, GA_W2 = GA_AL + 4096, GA_BA = GA_W2 + 4096, GA_EX = GA_BA + 512, GA_END = GA_EX + 1024;
constexpr int GA_OI = GA_VI;
constexpr int GC_QT = 0, GC_KT = GC_QT + 128 * PR, GC_SI = GC_KT + 128 * PR, GC_VI = GC_SI + 128 * PT, GC_AL = GC_VI + 128 * PT, GC_W2 = GC_AL + 4096, GC_BA = GC_W2 + 4096, GC_EX = GC_BA + 512, GC_END = GC_EX + 1024;
constexpr int GC_OI = 0;
static_assert(GA_END <= LDSCTL_OFF && GC_END <= LDSCTL_OFF && 128 * PO256 <= GC_SI && 128 * PO256 <= 128 * PT256, "GLA LDS maps");
__device__ __forceinline__ void gla_stage_w(const Frame& F, LAS unsigned char* W2, LAS float* BA, int li, int h) {
    if (F.tid < 128) { const int d = F.tid; const GAS float* w2 = (const GAS float*)AP(I_GLA_A2) + (size_t)li * 16 * 512 + h * 128 + d;
        v4u lo, hi; lo.x = cvtpk(w2[0], w2[512]); lo.y = cvtpk(w2[2 * 512], w2[3 * 512]); lo.z = cvtpk(w2[4 * 512], w2[5 * 512]); lo.w = cvtpk(w2[6 * 512], w2[7 * 512]);
        hi.x = cvtpk(w2[8 * 512], w2[9 * 512]); hi.y = cvtpk(w2[10 * 512], w2[11 * 512]); hi.z = cvtpk(w2[12 * 512], w2[13 * 512]); hi.w = cvtpk(w2[14 * 512], w2[15 * 512]);
        *(LAS v4u*)(W2 + d * 32) = lo; *(LAS v4u*)(W2 + d * 32 + 16) = hi; }
    else if (F.tid < 256) { const int d = F.tid - 128; BA[d] = ((const GAS float*)AP(I_GLA_BA))[(size_t)li * 512 + h * 128 + d]; }
}
__device__ __forceinline__ v4u gla_ld_alow(int tid, const bf16* Prow0) { const int t = tid & 255; return *(const GAS v4u*)(Prow0 + (size_t)(t >> 1) * GLA_INP + G_A + (t & 1) * 8); }
__device__ __forceinline__ void gla_st_alow(int tid, v4u v, LAS unsigned char* AL) { if (tid < 256) *(LAS v4u*)(AL + (tid >> 1) * 32 + (tid & 1) * 16) = v; }

__device__ __forceinline__ void gla_phase_a(const Frame& F0, int li) {
    const Frame F = relaunder(F0);
    unsigned char* ws = WSP();
    const bf16* P = (const bf16*)(ws + WS_ACT); bf16* SKV = (bf16*)OUTP(); float* DEC = (float*)(ws + WS_DEC);
    LAS unsigned char* L = F.lds;
    const int wave = F.wave, db = wave & 3, jh = wave >> 2;
    v4u kR[4], vR[8], aR; int hcur = -1;
    {   const int it = F.bid; if (it < 1024) { const int bh = it >> 5, g = it & 31; const bf16* Prow0 = P + ((size_t)(bh >> 2) * SEQ + g * 128) * GLA_INP;
            tile_ld<128, 128>(kR, Prow0 + G_K + (bh & 3) * 128, GLA_INP, F.tid); tile_ld<128, 256>(vR, Prow0 + G_V + (bh & 3) * 256, GLA_INP, F.tid); aR = gla_ld_alow(F.tid, Prow0); } }
    for (int it = F.bid; it < 1024; it += F.G) {
        const int bh = it >> 5, h = bh & 3;
        const int lane = lndv(F.lane), r = lane & 31, h2 = lane >> 5;
        tile_st<128, 128>(kR, L + GA_KI, PR, F.tid); tile_st<128, 256>(vR, L + GA_VI, PT256, F.tid); gla_st_alow(F.tid, aR, L + GA_AL);
        if (h != hcur) { gla_stage_w(F, L + GA_W2, (LAS float*)(L + GA_BA), li, h); hcur = h; }
        WG_BAR();
        {   const int nx = it + F.G; if (nx < 1024) { const int bh2 = nx >> 5, g2 = nx & 31; const bf16* Pn = P + ((size_t)(bh2 >> 2) * SEQ + g2 * 128) * GLA_INP;
                tile_ld<128, 128>(kR, Pn + G_K + (bh2 & 3) * 128, GLA_INP, F.tid); tile_ld<128, 256>(vR, Pn + G_V + (bh2 & 3) * 256, GLA_INP, F.tid); aR = gla_ld_alow(F.tid, Pn); } }
        float Bc[2][16], Blast;
        gla_cumsum(Bc, Blast, L + GA_AL, L + GA_W2, (const LAS float*)(L + GA_BA), (LAS float*)(L + GA_EX), wave, lane);
#pragma unroll
        for (int t = 0; t < 2; ++t)
#pragma unroll
            for (int i = 0; i < 16; ++i) { const int row = (jh * 2 + t) * 32 + crow(i, h2), col = db * 32 + r;
                const float kv = bf2f(*(const LAS bf16*)(L + GA_KI + row * PR + col * 2)) * __builtin_amdgcn_exp2f((Blast - Bc[t][i]) * LOG2E);
                *(LAS bf16*)(L + GA_KD + row * PT + col * 2) = cvt1(kv); }
        if (jh == 0 && h2 == 0) DEC[(size_t)it * 128 + db * 32 + r] = __builtin_amdgcn_exp2f(Blast * LOG2E);
        WG_BAR();
        f32x16 acc[4];
#pragma unroll
        for (int t = 0; t < 4; ++t) acc[t] = (f32x16){0.f, 0.f, 0.f, 0.f, 0.f, 0.f, 0.f, 0.f, 0.f, 0.f, 0.f, 0.f, 0.f, 0.f, 0.f, 0.f};
#pragma unroll
        for (int ks = 0; ks < 8; ++ks) { const bf16x8 a = ld_tr(L + GA_KD, PT, 16 * ks, db * 32, lane);
#pragma unroll
            for (int t = 0; t < 4; ++t) acc[t] = MFMA32(a, ld_tr(L + GA_VI, PT256, 16 * ks, (4 * jh + t) * 32, lane), acc[t]); }
        WG_BAR();
#pragma unroll
        for (int t = 0; t < 4; ++t)
#pragma unroll
            for (int i = 0; i < 16; ++i) *(LAS bf16*)(L + GA_OI + (db * 32 + crow(i, h2)) * PO256 + ((4 * jh + t) * 32 + r) * 2) = cvt1(acc[t][i]);
        WG_BAR();
        {   bf16* out = SKV + (size_t)it * 128 * 256;
#pragma unroll
            for (int i = 0; i < 8; ++i) { const int c = F.tid + i * NTHREADS, row = c >> 5, cc = c & 31; *(GAS v4u*)(out + row * 256 + cc * 8) = *(const LAS v4u*)(L + GA_OI + row * PO256 + cc * 16); } }
        WG_BAR();
    }
}
__device__ __forceinline__ void gla_phase_b(const Frame& F0) {
    const Frame F = relaunder(F0);
    unsigned char* ws = WSP();
    bf16* SKV = (bf16*)OUTP(); const float* DEC = (const float*)(ws + WS_DEC);
    for (int gt = F.bid * NTHREADS + F.tid; gt < 32 * 128 * 32; gt += F.G * NTHREADS) {
        const int bh = gt >> 12, d = (gt >> 5) & 127, e8 = gt & 31;
        float s[8];
#pragma unroll
        for (int i = 0; i < 8; ++i) s[i] = 0.f;
        for (int g0 = 0; g0 < 32; g0 += 8) {
            v4u kv[8]; float dc[8];
#pragma unroll
            for (int u = 0; u < 8; ++u) { const size_t item = (size_t)bh * 32 + g0 + u; kv[u] = *(const GAS v4u*)(SKV + (item * 128 + d) * 256 + e8 * 8); dc[u] = ((const GAS float*)DEC)[item * 128 + d]; }
#pragma unroll
            for (int u = 0; u < 8; ++u) { const size_t item = (size_t)bh * 32 + g0 + u;
                v4u o; o.x = cvtpk(s[0], s[1]); o.y = cvtpk(s[2], s[3]); o.z = cvtpk(s[4], s[5]); o.w = cvtpk(s[6], s[7]);
                *(GAS v4u*)(SKV + (item * 128 + d) * 256 + e8 * 8) = o;
#pragma unroll
                for (int i = 0; i < 4; ++i) { s[2 * i] = dc[u] * s[2 * i] + bflo(kv[u][i]); s[2 * i + 1] = dc[u] * s[2 * i + 1] + bfhi(kv[u][i]); } }
        }
    }
}
__device__ __forceinline__ void gla_phase_c(const Frame& F0, int li) {
    const Frame F = relaunder(F0);
    unsigned char* ws = WSP();
    const bf16* P = (const bf16*)(ws + WS_ACT); const bf16* SKV = (const bf16*)OUTP(); bf16* CAT = (bf16*)(ws + WS_CAT);
    LAS unsigned char* L = F.lds;
    const int wave = F.wave, db = wave & 3, jh = wave >> 2;
    const int ib = wave & 3, eq = wave >> 2;
    v4u qR[4], kR[4], aR; int hcur = -1;
    {   const int it = F.bid; if (it < 1024) { const int bh = it >> 5, g = it & 31, h = bh & 3; const bf16* Prow0 = P + ((size_t)(bh >> 2) * SEQ + g * 128) * GLA_INP;
            tile_ld<128, 128>(qR, Prow0 + G_Q + h * 128, GLA_INP, F.tid); tile_ld<128, 128>(kR, Prow0 + G_K + h * 128, GLA_INP, F.tid); aR = gla_ld_alow(F.tid, Prow0); } }
    for (int it = F.bid; it < 1024; it += F.G) {
        const int bh = it >> 5, g = it & 31, b = bh >> 2, h = bh & 3;
        const int tidl = lndv(F.tid), lane = tidl & 63, r = lane & 31, h2 = lane >> 5;
        const bf16* Prow0 = P + ((size_t)b * SEQ + g * 128) * GLA_INP;
        const bf16* Sg = SKV + (size_t)it * 128 * 256;
        {   v4u sR[4], vR[4]; tile_ld<128, 128>(sR, Sg, 256, tidl); tile_ld<128, 128>(vR, Prow0 + G_V + h * 256, GLA_INP, tidl);
            tile_st<128, 128>(qR, L + GC_QT, PR, tidl); tile_st<128, 128>(kR, L + GC_KT, PR, tidl); tile_st<128, 128>(sR, L + GC_SI, PT, tidl); tile_st<128, 128>(vR, L + GC_VI, PT, tidl); }
        gla_st_alow(tidl, aR, L + GC_AL);
        if (h != hcur) { gla_stage_w(F, L + GC_W2, (LAS float*)(L + GC_BA), li, h); hcur = h; }
        WG_BAR();
        {
            float Bc[2][16], Blast;
            gla_cumsum(Bc, Blast, L + GC_AL, L + GC_W2, (const LAS float*)(L + GC_BA), (LAS float*)(L + GC_EX), wave, lane);
#pragma unroll
            for (int t = 0; t < 2; ++t)
#pragma unroll
                for (int i = 0; i < 16; ++i) { const int off = ((jh * 2 + t) * 32 + crow(i, h2)) * PR + (db * 32 + r) * 2;
                    const float eb = __builtin_amdgcn_exp2f(Bc[t][i] * LOG2E);
                    const float qv = bf2f(*(const LAS bf16*)(L + GC_QT + off)) * eb * 0.08838834764831845f;
                    const float kv = bf2f(*(const LAS bf16*)(L + GC_KT + off)) * __builtin_amdgcn_rcpf(eb);
                    *(LAS bf16*)(L + GC_QT + off) = cvt1(qv); *(LAS bf16*)(L + GC_KT + off) = cvt1(kv); }
        }
        WG_BAR();
        bf16x8 PA[4][2];
#pragma unroll
        for (int jb = 0; jb < 4; ++jb) {
            if (jb <= ib) {
                f32x16 x = {0.f, 0.f, 0.f, 0.f, 0.f, 0.f, 0.f, 0.f, 0.f, 0.f, 0.f, 0.f, 0.f, 0.f, 0.f, 0.f};
#pragma unroll
                for (int ks = 0; ks < 8; ++ks) x = MFMA32(ld_row(L + GC_KT, PR, jb * 32, 16 * ks, r, h2), ld_row(L + GC_QT, PR, ib * 32, 16 * ks, r, h2), x);
                if (jb == ib) {
#pragma unroll
                    for (int i = 0; i < 16; ++i) if (crow(i, h2) > r) x[i] = 0.f; }
                PA[jb][0] = PACK_STEP(x, 0); PA[jb][1] = PACK_STEP(x, 1);
            } else { PA[jb][0] = (bf16x8){0, 0, 0, 0, 0, 0, 0, 0}; PA[jb][1] = (bf16x8){0, 0, 0, 0, 0, 0, 0, 0}; }
        }
        f32x16 o[2][2];
#pragma unroll
        for (int half = 0; half < 2; ++half) {
            if (half == 1) {
                WG_BAR();
                stage_tile<128, 128>(L + GC_SI, PT, Sg + 128, 256, tidl); stage_tile<128, 128>(L + GC_VI, PT, Prow0 + G_V + h * 256 + 128, GLA_INP, tidl);
                WG_BAR();
            }
#pragma unroll
            for (int t = 0; t < 2; ++t) {
                const int eb = 2 * eq + t;
                f32x16 acc = {0.f, 0.f, 0.f, 0.f, 0.f, 0.f, 0.f, 0.f, 0.f, 0.f, 0.f, 0.f, 0.f, 0.f, 0.f, 0.f};
#pragma unroll
                for (int jb = 0; jb < 4; ++jb) if (jb <= ib) {
#pragma unroll
                    for (int s = 0; s < 2; ++s) acc = MFMA32(PA[jb][s], ld_tr_perm(L + GC_VI, PT, jb * 32 + 16 * s, eb * 32, lane), acc); }
#pragma unroll
                for (int ks = 0; ks < 8; ++ks) acc = MFMA32(ld_row(L + GC_QT, PR, ib * 32, 16 * ks, r, h2), ld_tr(L + GC_SI, PT, 16 * ks, eb * 32, lane), acc);
                o[half][t] = acc;
            }
        }
        WG_BAR();
#pragma unroll
        for (int half = 0; half < 2; ++half)
#pragma unroll
            for (int t = 0; t < 2; ++t)
#pragma unroll
                for (int i = 0; i < 16; ++i) *(LAS bf16*)(L + GC_OI + (ib * 32 + crow(i, h2)) * PO256 + (half * 128 + (2 * eq + t) * 32 + r) * 2) = cvt1(o[half][t][i]);
        WG_BAR();
        {   const int nx = (it + F.G < 1024) ? it + F.G : it;
            const int bh2 = nx >> 5, g2 = nx & 31, hn = bh2 & 3; const bf16* Pn = P + ((size_t)(bh2 >> 2) * SEQ + g2 * 128) * GLA_INP;
            tile_ld<128, 128>(qR, Pn + G_Q + hn * 128, GLA_INP, tidl); tile_ld<128, 128>(kR, Pn + G_K + hn * 128, GLA_INP, tidl); aR = gla_ld_alow(tidl, Pn); }
        {
            const int tid2 = lndv(tidl), row = tid2 >> 2, qtr = tid2 & 3;
            lcp orow = L + GC_OI + row * PO256 + qtr * 128;
            const bf16* gp = Prow0 + (size_t)row * GLA_INP + G_R + h * 256 + qtr * 64;
            float sum = 0.f;
#pragma unroll
            for (int c = 0; c < 8; ++c) { const v4u w = *(const LAS v4u*)(orow + c * 16);
#pragma unroll
                for (int i = 0; i < 4; ++i) sum += bflo(w[i]) + bfhi(w[i]); }
            sum += xsw<1>(sum); sum += xsw<2>(sum);
            const float mu = sum * (1.0f / 256.0f); float sq = 0.f;
#pragma unroll
            for (int c = 0; c < 8; ++c) { const v4u w = *(const LAS v4u*)(orow + c * 16);
#pragma unroll
                for (int i = 0; i < 4; ++i) { const float d0 = bflo(w[i]) - mu, d1 = bfhi(w[i]) - mu; sq += d0 * d0 + d1 * d1; } }
            sq += xsw<1>(sq); sq += xsw<2>(sq);
            const float rstd = 1.0f / sqrtf(sq * (1.0f / 256.0f) + EPS);
            bf16* op = CAT + ((size_t)b * SEQ + g * 128 + row) * D + h * 256 + qtr * 64;
#pragma unroll
            for (int c = 0; c < 8; ++c) { const v4u gw = *(const GAS v4u*)(gp + c * 8); const v4u w = *(const LAS v4u*)(orow + c * 16); v4u ow;
#pragma unroll
                for (int i = 0; i < 4; ++i) { const float g0 = bflo(gw[i]), g1 = bfhi(gw[i]);
                    ow[i] = cvtpk((bflo(w[i]) - mu) * rstd * silu_f(g0), (bfhi(w[i]) - mu) * rstd * silu_f(g1)); }
                *(GAS v4u*)(op + c * 8) = ow; }
        }
        WG_BAR();
    }
}


constexpr size_t WS_OD = 408 * MiB;
constexpr size_t OUT_LSE = 32 * MiB;
constexpr size_t WS_END2 = 504 * MiB;
constexpr int RA_KI = 0, RA_VD = RA_KI + 128 * PT, RA_END = RA_VD + 128 * PT;
constexpr int RC_QI = 0, RC_KI = RC_QI + 128 * PR, RC_VI = RC_KI + 128 * PR, RC_SI = RC_VI + 128 * PT, RC_END = RC_SI + 128 * PT;
constexpr int DPK = 144, DPV = 192;
constexpr int DL_KI = 0, DL_VI = DL_KI + 384 * DPK, DL_LW = DL_VI + 384 * DPV, DL_END = DL_LW + 8 * 256;
constexpr int DL_ST = DL_KI;
static_assert(RC_END <= LDSCTL_OFF && DL_END <= LDSCTL_OFF && 8 * 32 * DPK <= 384 * DPK, "even mixer LDS maps");
__device__ __forceinline__ float ret_log2g(int h) { return log2f(1.0f - exp2f(-5.0f - (float)h)); }

__device__ __forceinline__ void ret_phase_a_items(const Frame& F, const bf16* P, bf16* RKV) {
    LAS unsigned char* L = F.lds;
    const int wave = F.wave, db = wave & 3, eh = wave >> 2;
    v4u kR[4], vR[4];
    {   const int it = F.bid < 1024 ? F.bid : 0; const int bh = it >> 5, n = it & 31; const bf16* Prow0 = P + ((size_t)(bh >> 2) * SEQ + n * 128) * EVEN_IN;
        tile_ld<128, 128>(kR, Prow0 + E_RK + (bh & 3) * 128, EVEN_IN, F.tid); tile_ld<128, 128>(vR, Prow0 + E_RV + (bh & 3) * 128, EVEN_IN, F.tid); }
    for (int it = F.bid; it < 1024; it += F.G) {
        const int tidl = lndv(F.tid), lane = tidl & 63, r = lane & 31, h2 = lane >> 5;
        const int bh = it >> 5, h = bh & 3;
        const float lg = ret_log2g(h);
        tile_st<128, 128>(kR, L + RA_KI, PT, tidl);
        {
#pragma unroll
            for (int i = 0; i < 4; ++i) { const int row = (tidl >> 4) + 32 * i, cc = tidl & 15; const float f = __builtin_amdgcn_exp2f(lg * (float)(127 - row)); v4u o;
#pragma unroll
                for (int k = 0; k < 4; ++k) o[k] = cvtpk(bflo(vR[i][k]) * f, bfhi(vR[i][k]) * f);
                *(LAS v4u*)(L + RA_VD + row * PT + cc * 16) = o; }
        }
        WG_BAR();
        {   const int nx = (it + F.G < 1024) ? it + F.G : it; const int bh2 = nx >> 5, n2 = nx & 31; const bf16* Pn = P + ((size_t)(bh2 >> 2) * SEQ + n2 * 128) * EVEN_IN;
            tile_ld<128, 128>(kR, Pn + E_RK + (bh2 & 3) * 128, EVEN_IN, tidl); tile_ld<128, 128>(vR, Pn + E_RV + (bh2 & 3) * 128, EVEN_IN, tidl); }
        f32x16 acc[2];
#pragma unroll
        for (int t = 0; t < 2; ++t) acc[t] = (f32x16){0.f, 0.f, 0.f, 0.f, 0.f, 0.f, 0.f, 0.f, 0.f, 0.f, 0.f, 0.f, 0.f, 0.f, 0.f, 0.f};
#pragma unroll
        for (int ks = 0; ks < 8; ++ks) { const bf16x8 a = ld_tr(L + RA_KI, PT, 16 * ks, db * 32, lane);
#pragma unroll
            for (int t = 0; t < 2; ++t) acc[t] = MFMA32(a, ld_tr(L + RA_VD, PT, 16 * ks, (2 * eh + t) * 32, lane), acc[t]); }
        WG_BAR();
#pragma unroll
        for (int t = 0; t < 2; ++t)
#pragma unroll
            for (int i = 0; i < 16; ++i) *(LAS bf16*)(L + RA_KI + (db * 32 + crow(i, h2)) * PR + ((2 * eh + t) * 32 + r) * 2) = cvt1(acc[t][i]);
        WG_BAR();
        bf16* out = RKV + (size_t)it * 128 * 128;
#pragma unroll
        for (int i = 0; i < 4; ++i) { const int row = (tidl >> 4) + 32 * i, cc = tidl & 15; *(GAS v4u*)(out + row * 128 + cc * 8) = *(const LAS v4u*)(L + RA_KI + row * PR + cc * 16); }
        WG_BAR();
    }
}
__device__ __forceinline__ void ret_scan(const Frame& F, bf16* RKV) {
    for (int gt = F.bid * NTHREADS + F.tid; gt < 32 * 128 * 16; gt += F.G * NTHREADS) {
        const int bh = gt >> 11, d = (gt >> 4) & 127, e8 = gt & 15, h = bh & 3;
        const float g128 = __builtin_amdgcn_exp2f(ret_log2g(h) * 128.0f);
        float s[8];
#pragma unroll
        for (int i = 0; i < 8; ++i) s[i] = 0.f;
        for (int n0 = 0; n0 < 32; n0 += 4) {
            v4u kv[4];
#pragma unroll
            for (int u = 0; u < 4; ++u) kv[u] = *(const GAS v4u*)(RKV + (((size_t)bh * 32 + n0 + u) * 128 + d) * 128 + e8 * 8);
#pragma unroll
            for (int u = 0; u < 4; ++u) {
                v4u o; o.x = cvtpk(s[0], s[1]); o.y = cvtpk(s[2], s[3]); o.z = cvtpk(s[4], s[5]); o.w = cvtpk(s[6], s[7]);
                *(GAS v4u*)(RKV + (((size_t)bh * 32 + n0 + u) * 128 + d) * 128 + e8 * 8) = o;
#pragma unroll
                for (int i = 0; i < 4; ++i) { s[2 * i] = g128 * s[2 * i] + bflo(kv[u][i]); s[2 * i + 1] = g128 * s[2 * i + 1] + bfhi(kv[u][i]); } }
        }
    }
}
__device__ __forceinline__ void ret_phase_c_items(const Frame& F, const bf16* P, const bf16* RKV, bf16* CAT) {
    LAS unsigned char* L = F.lds;
    const int wave = F.wave, ib = wave & 3, eq = wave >> 2;
    v4u qR[4], kR[4];
    {   const int it = F.bid < 1024 ? F.bid : 0; const int bh = it >> 5, n = it & 31; const bf16* Prow0 = P + ((size_t)(bh >> 2) * SEQ + n * 128) * EVEN_IN;
        tile_ld<128, 128>(qR, Prow0 + E_RQ + (bh & 3) * 128, EVEN_IN, F.tid); tile_ld<128, 128>(kR, Prow0 + E_RK + (bh & 3) * 128, EVEN_IN, F.tid); }
    for (int it = F.bid; it < 1024; it += F.G) {
        const int tidl = lndv(F.tid), lane = tidl & 63, r = lane & 31, h2 = lane >> 5;
        const int bh = it >> 5, n = it & 31, b = bh >> 2, h = bh & 3;
        const float lg = ret_log2g(h);
        const bf16* Prow0 = P + ((size_t)b * SEQ + n * 128) * EVEN_IN;
        {   v4u vR[4], sR[4]; tile_ld<128, 128>(vR, Prow0 + E_RV + h * 128, EVEN_IN, tidl); tile_ld<128, 128>(sR, RKV + (size_t)it * 128 * 128, 128, tidl);
#pragma unroll
            for (int i = 0; i < 4; ++i) { const int row = (tidl >> 4) + 32 * i, cc = tidl & 15; const float fq = __builtin_amdgcn_exp2f(lg * (float)row), fk = __builtin_amdgcn_rcpf(fq); v4u oq, ok;
#pragma unroll
                for (int k = 0; k < 4; ++k) { oq[k] = cvtpk(bflo(qR[i][k]) * fq, bfhi(qR[i][k]) * fq); ok[k] = cvtpk(bflo(kR[i][k]) * fk, bfhi(kR[i][k]) * fk); }
                *(LAS v4u*)(L + RC_QI + row * PR + cc * 16) = oq; *(LAS v4u*)(L + RC_KI + row * PR + cc * 16) = ok; }
            tile_st<128, 128>(vR, L + RC_VI, PT, tidl); tile_st<128, 128>(sR, L + RC_SI, PT, tidl); }
        WG_BAR();
        bf16x8 PA[4][2];
#pragma unroll
        for (int jb = 0; jb < 4; ++jb) {
            if (jb <= ib) {
                f32x16 x = {0.f, 0.f, 0.f, 0.f, 0.f, 0.f, 0.f, 0.f, 0.f, 0.f, 0.f, 0.f, 0.f, 0.f, 0.f, 0.f};
#pragma unroll
                for (int ks = 0; ks < 8; ++ks) x = MFMA32(ld_row(L + RC_KI, PR, jb * 32, 16 * ks, r, h2), ld_row(L + RC_QI, PR, ib * 32, 16 * ks, r, h2), x);
                if (jb == ib) {
#pragma unroll
                    for (int i = 0; i < 16; ++i) if (crow(i, h2) > r) x[i] = 0.f; }
                PA[jb][0] = PACK_STEP(x, 0); PA[jb][1] = PACK_STEP(x, 1);
            } else { PA[jb][0] = (bf16x8){0, 0, 0, 0, 0, 0, 0, 0}; PA[jb][1] = (bf16x8){0, 0, 0, 0, 0, 0, 0, 0}; }
        }
        f32x16 o[2];
#pragma unroll
        for (int t = 0; t < 2; ++t) {
            const int eb = 2 * eq + t;
            f32x16 z = {0.f, 0.f, 0.f, 0.f, 0.f, 0.f, 0.f, 0.f, 0.f, 0.f, 0.f, 0.f, 0.f, 0.f, 0.f, 0.f}, y = z;
#pragma unroll
            for (int jb = 0; jb < 4; ++jb) if (jb <= ib) {
#pragma unroll
                for (int s = 0; s < 2; ++s) z = MFMA32(PA[jb][s], ld_tr_perm(L + RC_VI, PT, jb * 32 + 16 * s, eb * 32, lane), z); }
#pragma unroll
            for (int ks = 0; ks < 8; ++ks) y = MFMA32(ld_row(L + RC_QI, PR, ib * 32, 16 * ks, r, h2), ld_tr(L + RC_SI, PT, 16 * ks, eb * 32, lane), y);
            const float g1 = __builtin_amdgcn_exp2f(lg);
#pragma unroll
            for (int i = 0; i < 16; ++i) z[i] += y[i] * g1;
            o[t] = z;
        }
        WG_BAR();
#pragma unroll
        for (int t = 0; t < 2; ++t)
#pragma unroll
            for (int i = 0; i < 16; ++i) *(LAS bf16*)(L + RC_QI + (ib * 32 + crow(i, h2)) * PR + ((2 * eq + t) * 32 + r) * 2) = cvt1(o[t][i]);
        WG_BAR();
        {   const int nx = (it + F.G < 1024) ? it + F.G : it; const int bh2 = nx >> 5, n2 = nx & 31; const bf16* Pn = P + ((size_t)(bh2 >> 2) * SEQ + n2 * 128) * EVEN_IN;
            tile_ld<128, 128>(qR, Pn + E_RQ + (bh2 & 3) * 128, EVEN_IN, tidl); tile_ld<128, 128>(kR, Pn + E_RK + (bh2 & 3) * 128, EVEN_IN, tidl); }
        {
            const int tid2 = lndv(tidl), row = tid2 >> 2, qtr = tid2 & 3;
            lcp orow = L + RC_QI + row * PR + qtr * 64;
            v4u w[4]; float sum = 0.f;
#pragma unroll
            for (int c = 0; c < 4; ++c) { w[c] = *(const LAS v4u*)(orow + c * 16);
#pragma unroll
                for (int i = 0; i < 4; ++i) sum += bflo(w[c][i]) + bfhi(w[c][i]); }
            sum += xsw<1>(sum); sum += xsw<2>(sum);
            const float mu = sum * (1.0f / 128.0f); float sq = 0.f;
#pragma unroll
            for (int c = 0; c < 4; ++c)
#pragma unroll
                for (int i = 0; i < 4; ++i) { const float d0 = bflo(w[c][i]) - mu, d1 = bfhi(w[c][i]) - mu; sq += d0 * d0 + d1 * d1; }
            sq += xsw<1>(sq); sq += xsw<2>(sq);
            const float rstd = 1.0f / sqrtf(sq * (1.0f / 128.0f) + EPS);
            const bf16* gp = Prow0 + (size_t)row * EVEN_IN + E_RG + h * 128 + qtr * 32;
            bf16* op = CAT + ((size_t)b * SEQ + n * 128 + row) * D + h * 128 + qtr * 32;
#pragma unroll
            for (int c = 0; c < 4; ++c) { const v4u gw = *(const GAS v4u*)(gp + c * 8); v4u ow;
#pragma unroll
                for (int i = 0; i < 4; ++i) { const float g0 = bflo(gw[i]), g1 = bfhi(gw[i]);
                    ow[i] = cvtpk((bflo(w[c][i]) - mu) * rstd * silu_f(g0), (bfhi(w[c][i]) - mu) * rstd * silu_f(g1)); }
                *(GAS v4u*)(op + c * 8) = ow; }
        }
        WG_BAR();
    }
}
struct DilTile { int b, head, p, dil, res, q0; };
__device__ __forceinline__ DilTile dil_decode(int T) { DilTile t; t.b = T / 384; const int rem = T - t.b * 384; t.head = rem / 48; const int t48 = rem - t.head * 48; t.p = t48 >> 4; const int idx = t48 & 15, sh = 2 * t.p;
    t.dil = 1 << sh; t.res = idx & (t.dil - 1); t.q0 = (idx >> sh) * 256; return t; }
__device__ __forceinline__ void dil_ld(v4u (&kR)[6], v4u (&vR)[6], const DilTile& t, const bf16* P, int tid) {
    const bf16* Pb = P + (size_t)t.b * SEQ * EVEN_IN + t.head * 64 + (tid & 7) * 8;
#pragma unroll
    for (int i = 0; i < 6; ++i) { int kidx = t.q0 - 128 + (tid >> 3) + 64 * i; kidx = kidx < 0 ? 0 : kidx;
        const bf16* src = Pb + (size_t)(kidx * t.dil + t.res) * EVEN_IN; kR[i] = *(const GAS v4u*)(src + E_DK); vR[i] = *(const GAS v4u*)(src + E_DV); }
}
__device__ __forceinline__ void dil_tiles(const Frame& F, int T0, int T1, int step, const bf16* P, bf16* OD, float* LSE) {
    LAS unsigned char* L = F.lds;
    const int wave = F.wave;
    if (T0 >= T1) return;
    v4u kR[6], vR[6];
    { const DilTile t0 = dil_decode(T0); dil_ld(kR, vR, t0, P, F.tid); }
    for (int T = T0; T < T1; T += step) {
        const int tidl = lndv(F.tid), lane = tidl & 63, r = lane & 31, h2 = lane >> 5;
        const DilTile t = dil_decode(T);
        const bf16* Pb = P + (size_t)t.b * SEQ * EVEN_IN + t.head * 64;
#pragma unroll
        for (int i = 0; i < 6; ++i) { const int row = (tidl >> 3) + 64 * i, cc = tidl & 7; *(LAS v4u*)(L + DL_KI + row * DPK + cc * 16) = kR[i]; *(LAS v4u*)(L + DL_VI + row * DPV + cc * 16) = vR[i]; }
        bf16x8 qf[4];
        { const bf16* qsrc = Pb + (size_t)((t.q0 + 32 * wave + r) * t.dil + t.res) * EVEN_IN + E_DQ + 8 * h2;
#pragma unroll
          for (int ks = 0; ks < 4; ++ks) qf[ks] = *(const GAS bf16x8*)(qsrc + 16 * ks); }
        WG_BAR();
        { const DilTile tn = dil_decode(T + step < T1 ? T + step : T); dil_ld(kR, vR, tn, P, tidl); }
        f32x16 x[5];
        float mx = -INFINITY;
#pragma unroll
        for (int kb = 0; kb < 5; ++kb) {
            f32x16 a = {0.f, 0.f, 0.f, 0.f, 0.f, 0.f, 0.f, 0.f, 0.f, 0.f, 0.f, 0.f, 0.f, 0.f, 0.f, 0.f};
#pragma unroll
            for (int ks = 0; ks < 4; ++ks) a = MFMA32(ld_row(L + DL_KI, DPK, 32 * wave + 32 * kb, 16 * ks, r, h2), qf[ks], a);
            if (kb == 0) {
#pragma unroll
                for (int i = 0; i < 16; ++i) if (crow(i, h2) < r) a[i] = -INFINITY; }
            if (kb == 4) {
#pragma unroll
                for (int i = 0; i < 16; ++i) if (crow(i, h2) > r) a[i] = -INFINITY; }
            if (t.q0 == 0 && 32 * wave + 32 * kb < 128) {
#pragma unroll
                for (int i = 0; i < 16; ++i) a[i] = -INFINITY; }
#pragma unroll
            for (int i = 0; i < 16; ++i) mx = fmaxf(mx, a[i]);
            x[kb] = a;
        }
        mx = max32(mx);
        constexpr float C2 = 0.125f * LOG2E;
        const float mc = mx * C2; float l = 0.f;
#pragma unroll
        for (int kb = 0; kb < 5; ++kb)
#pragma unroll
            for (int i = 0; i < 16; ++i) { const float pe = __builtin_amdgcn_exp2f(x[kb][i] * C2 - mc); x[kb][i] = pe; l += pe; }
        l = sum32(l);
        f32x16 o[2];
#pragma unroll
        for (int dbk = 0; dbk < 2; ++dbk) o[dbk] = (f32x16){0.f, 0.f, 0.f, 0.f, 0.f, 0.f, 0.f, 0.f, 0.f, 0.f, 0.f, 0.f, 0.f, 0.f, 0.f, 0.f};
#pragma unroll
        for (int kb = 0; kb < 5; ++kb)
#pragma unroll
            for (int s = 0; s < 2; ++s) { const bf16x8 pa = PACK_STEP(x[kb], s);
#pragma unroll
                for (int dbk = 0; dbk < 2; ++dbk) o[dbk] = MFMA32(pa, ld_tr_perm(L + DL_VI, DPV, 32 * wave + 32 * kb + 16 * s, dbk * 32, lane), o[dbk]); }
        LAS float* lw = (LAS float*)(L + DL_LW + wave * 256);
        if (h2 == 0) lw[r] = l;
        WG_BAR();
        LAS unsigned char* st = L + DL_ST + wave * 32 * DPK;
#pragma unroll
        for (int i = 0; i < 16; ++i) { const float rl = __builtin_amdgcn_rcpf(lw[crow(i, h2)]);
#pragma unroll
            for (int dbk = 0; dbk < 2; ++dbk) *(LAS bf16*)(st + crow(i, h2) * DPK + (dbk * 32 + r) * 2) = cvt1(o[dbk][i] * rl); }
        const size_t tokbase = (size_t)t.b * SEQ;
        bf16* odp = OD + (size_t)t.p * M * 512;
#pragma unroll
        for (int j = 0; j < 4; ++j) { const int c = lane + 64 * j, row = c >> 3, cc = c & 7; const size_t tok = tokbase + (size_t)(t.q0 + 32 * wave + row) * t.dil + t.res;
            *(GAS v4u*)(odp + tok * 512 + t.head * 64 + cc * 8) = *(const LAS v4u*)(st + row * DPK + cc * 16); }
        if (h2 == 0) { const size_t tok = tokbase + (size_t)(t.q0 + 32 * wave + r) * t.dil + t.res; LSE[((size_t)t.p * M + tok) * 8 + t.head] = mx * 0.125f + LN2 * __builtin_amdgcn_logf(l); }
        WG_BAR();
    }
}
__device__ __forceinline__ void dil_combine(const Frame& F, const bf16* OD, const float* LSE, bf16* CAT) {
    for (int gt = F.bid * NTHREADS + F.tid; gt < M * 64; gt += F.G * NTHREADS) {
        const int tok = gt >> 6, c8 = gt & 63, head = c8 >> 3;
        const float l0 = LSE[(size_t)tok * 8 + head], l1 = LSE[((size_t)M + tok) * 8 + head], l2 = LSE[((size_t)2 * M + tok) * 8 + head];
        const float mxl = fmaxf(l0, fmaxf(l1, l2));
        float w0 = __builtin_amdgcn_exp2f((l0 - mxl) * LOG2E), w1 = __builtin_amdgcn_exp2f((l1 - mxl) * LOG2E), w2 = __builtin_amdgcn_exp2f((l2 - mxl) * LOG2E);
        const float rs = 1.0f / (w0 + w1 + w2); w0 *= rs; w1 *= rs; w2 *= rs;
        const v4u a = *(const GAS v4u*)(OD + (size_t)tok * 512 + c8 * 8), bq = *(const GAS v4u*)(OD + ((size_t)M + tok) * 512 + c8 * 8), cq = *(const GAS v4u*)(OD + ((size_t)2 * M + tok) * 512 + c8 * 8);
        v4u o;
#pragma unroll
        for (int i = 0; i < 4; ++i) o[i] = cvtpk(w0 * bflo(a[i]) + w1 * bflo(bq[i]) + w2 * bflo(cq[i]), w0 * bfhi(a[i]) + w1 * bfhi(bq[i]) + w2 * bfhi(cq[i]));
        *(GAS v4u*)(CAT + (size_t)tok * D + 512 + c8 * 8) = o;
    }
}
constexpr int DIL_TILES = 3072, DIL_SPLIT = 1024;
__device__ __forceinline__ void even_phase_a(const Frame& F0) {
    const Frame F = relaunder(F0);
    unsigned char* ws = WSP();
    const bf16* P = (const bf16*)(ws + WS_ACT); bf16* RKV = (bf16*)OUTP(); bf16* OD = (bf16*)(ws + WS_OD); float* LSE = (float*)((unsigned char*)OUTP() + OUT_LSE);
    ret_phase_a_items(F, P, RKV);
    dil_tiles(F, F.bid, DIL_SPLIT, F.G, P, OD, LSE);
}
__device__ __forceinline__ void even_phase_b(const Frame& F0) {
    const Frame F = relaunder(F0);
    unsigned char* ws = WSP();
    const bf16* P = (const bf16*)(ws + WS_ACT); bf16* RKV = (bf16*)OUTP(); bf16* OD = (bf16*)(ws + WS_OD); float* LSE = (float*)((unsigned char*)OUTP() + OUT_LSE);
    ret_scan(F, RKV);
    dil_tiles(F, DIL_SPLIT + F.bid, DIL_TILES, F.G, P, OD, LSE);
}
__device__ __forceinline__ void even_phase_c(const Frame& F0) {
    const Frame F = relaunder(F0);
    unsigned char* ws = WSP();
    const bf16* P = (const bf16*)(ws + WS_ACT); const bf16* RKV = (const bf16*)OUTP(); const bf16* OD = (const bf16*)(ws + WS_OD); const float* LSE = (const float*)((unsigned char*)OUTP() + OUT_LSE); bf16* CAT = (bf16*)(ws + WS_CAT);
    ret_phase_c_items(F, P, RKV, CAT);
    dil_combine(F, OD, LSE, CAT);
}

__global__ void __launch_bounds__(NTHREADS, 2) fwd_kernel(Args args) {
    extern __shared__ __attribute__((aligned(16))) unsigned char lds[];
    Frame F;
    F.lds = (LAS unsigned char*)lds;
    F.wave = __builtin_amdgcn_readfirstlane((int)(threadIdx.x >> 6)); F.lane = hw_lane(); F.tid = F.wave * 64 + F.lane; F.G = gridDim.x; F.bid = blockIdx.x;
    for (int u = F.tid; u < (LDS_BYTES - LDSCTL_OFF) / 4; u += NTHREADS) ((LAS unsigned*)(F.lds + LDSCTL_OFF))[u] = 0u;
    __syncthreads();
    if (F.tid < N_PTRS) { const unsigned long long v = (F.tid < 17) ? (unsigned long long)args.in[F.tid] : (F.tid == 17 ? (unsigned long long)args.out : (unsigned long long)args.ws);
        ((LAS unsigned*)(F.lds + PTR_OFF))[2 * F.tid] = (unsigned)v; ((LAS unsigned*)(F.lds + PTR_OFF))[2 * F.tid + 1] = (unsigned)(v >> 32); }
    __syncthreads();
    (void)xcd_barrier_post((unsigned*)(WSP() + WS_CTL) + CW_BAR, (volatile LAS unsigned*)(F.lds + MISC_OFF) + 8, F.tid);
#ifdef PROBE_BARX2
#define PROBE_BAR2(b, t) xcd_barrier(b, t)
#else
#define PROBE_BAR2(b, t) do {} while (0)
#endif
#define GRID_BAR() do { XcdBarrier bar_; bar_.bar = (unsigned*)(WSP() + WS_CTL) + CW_BAR; bar_.x = (unsigned)__builtin_amdgcn_readfirstlane((int)xb_xcc_id()); \
        int mo_ = MISC_OFF + 32; asm volatile("" : "+s"(mo_)); bar_.st = (volatile LAS unsigned*)(F.lds + mo_); int t_ = threadIdx.x; asm volatile("" : "+v"(t_)); xcd_barrier(bar_, t_); PROBE_BAR2(bar_, t_); } while (0)
#define XB ((bf16*)(WSP() + WS_XB))
#define ACT ((bf16*)(WSP() + WS_ACT))
#define CAT ((bf16*)(WSP() + WS_CAT))
#define SSP ((float*)(WSP() + WS_SSP))
#define WPTR(off) ((const bf16*)(WSP() + (off)))

#ifdef TEST_MIN
    {
        pg8::Gemm g{XB, WPTR(W_GU0), M, 2 * FF, D}; pg8::StaticOrder S; S.init(M, 2 * FF, lnd(F.G), lnd(F.bid));
        pg8::EpiSwiGLU E{ACT, FF, SSP};
        pg8::gemm_phase<pg8::EpiSwiGLU, pg8::StaticOrder, true, true>(F.lds + RING_OFF, g, S, E, lnd(F.wave));
        GRID_BAR();
        return;
    }
#endif
    prologue_rows(F);
    convert_weights(F, 0);
    GRID_BAR();
    for (int s = 0; s < 8; ++s) {
        const int l = s >> 1; const bool post = (s & 1) != 0;
#ifdef PROBE_F1X2
        for (int rep = 0; rep < 2; ++rep)
#endif
        {
#ifndef F1_ALIGN
#define F1_ALIGN true
#endif
#ifdef PROBE_KX2
            typedef pg8::TwiceOrder F1Order;
#else
            typedef pg8::StaticOrder F1Order;
#endif
            pg8::Gemm g{XB, WPTR(post ? W_GU1 : W_GU0), M, 2 * FF, D}; F1Order S; S.init(M, 2 * FF, lnd(F.G), lnd(F.bid));
            pg8::EpiSwiGLU E{ACT, FF, SSP};
#ifndef NO_F1
            pg8::gemm_phase<pg8::EpiSwiGLU, F1Order, F1_ALIGN, true>(F.lds + RING_OFF, g, S, E, lnd(F.wave));
#endif
            GRID_BAR();
        }
#ifdef PROBE_F2X2
        for (int rep = 0; rep < 2; ++rep)
#else
        constexpr int rep = 1;
#endif
        {
            pg8::Gemm g{ACT, WPTR(post ? W_D1 : W_D0), M, D, FF}; pg8::RevOrder S; S.init(M, D, lnd(F.G), lnd(F.bid));
            pg8::EpiResid E{XB, SSP, rep ? 0.5f : 0.0f};
#ifndef NO_F2
            pg8::gemm_phase<pg8::EpiResid, pg8::RevOrder, true, true>(F.lds + RING_OFF, g, S, E, lnd(F.wave));
#endif
            GRID_BAR();
        }
        if (!post) {
            const bool odd = (l & 1) != 0; const int nin = odd ? GLA_INP : EVEN_IN;
            {
                pg8::Gemm g{XB, WPTR(W_IN), M, nin, D}; pg8::StaticOrder S; S.init(M, nin, lnd(F.G), lnd(F.bid));
                pg8::EpiInProj E{ACT, nin, SSP, (const float*)(WSP() + TAB_RC), (const float*)(WSP() + TAB_RS), (const float*)(WSP() + TAB_DC), (const float*)(WSP() + TAB_DS), odd ? 0 : 1};
#ifndef NO_M1
                pg8::gemm_phase<pg8::EpiInProj, pg8::StaticOrder, true, true>(F.lds + RING_OFF, g, S, E, lnd(F.wave));
#endif
            }
            GRID_BAR();
#if defined(PROBE_MIXX2)
            constexpr int NREP = 2;
#else
            constexpr int NREP = 1;
#endif
            if (!odd) {
                for (int rp = 0; rp < NREP; ++rp) { even_phase_a(F); GRID_BAR(); }
                even_phase_b(F); GRID_BAR();
                for (int rp = 0; rp < NREP; ++rp) { if (rp) GRID_BAR(); even_phase_c(F); }
            } else {
                for (int rp = 0; rp < NREP; ++rp) { gla_phase_a(F, l >> 1); GRID_BAR(); }
                gla_phase_b(F); GRID_BAR();
                for (int rp = 0; rp < NREP; ++rp) { if (rp) GRID_BAR(); gla_phase_c(F, l >> 1); }
            }
            GRID_BAR();
#ifdef PROBE_M5X2
            for (int rep2 = 0; rep2 < 2; ++rep2)
#else
            constexpr int rep2 = 1;
#endif
            {
                pg8::Gemm g{CAT, WPTR(W_OUT), M, D, D}; pg8::StaticOrder S; S.init(M, D, lnd(F.G), lnd(F.bid));
                pg8::EpiResid E{XB, SSP, rep2 ? 1.0f : 0.0f};
#ifndef NO_M5
                pg8::gemm_phase<pg8::EpiResid, pg8::StaticOrder, true, true>(F.lds + RING_OFF, g, S, E, lnd(F.wave));
#endif
                GRID_BAR();
            }
        } else if (l + 1 < DEPTH) {
            convert_weights(F, l + 1);
            GRID_BAR();
#ifdef PROBE_CONVX2
            convert_weights(F, l + 1);
            GRID_BAR();
#endif
        }
    }
    final_norm(F);
}

extern "C" void kernel_launch(void* const* d_in, const int* in_sizes, int n_in, void* d_out, int out_size, void* d_ws, size_t ws_size, hipStream_t stream) {
    static int grid = 0;
    if (grid == 0) {
        if (n_in != 17 || in_sizes[0] != M * D || out_size != M * D || ws_size < WS_END2) { fprintf(stderr, "kernel_launch: unexpected shapes (n_in %d, in0 %d, out %d, ws %zu)\n", n_in, n_in > 0 ? in_sizes[0] : -1, out_size, ws_size); grid = -1; return; }
        int dev = 0, cus = 0, per_cu = 0;
        if (hipGetDevice(&dev) != hipSuccess || hipDeviceGetAttribute(&cus, hipDeviceAttributeMultiprocessorCount, dev) != hipSuccess) { grid = -1; return; }
        if (hipFuncSetAttribute((const void*)fwd_kernel, hipFuncAttributeMaxDynamicSharedMemorySize, LDS_BYTES) != hipSuccess) { fprintf(stderr, "kernel_launch: hipFuncSetAttribute failed\n"); grid = -1; return; }
        if (hipOccupancyMaxActiveBlocksPerMultiprocessor(&per_cu, (const void*)fwd_kernel, NTHREADS, LDS_BYTES) != hipSuccess || per_cu < 1) { fprintf(stderr, "kernel_launch: occupancy query reports %d\n", per_cu); }
        (void)hipGetLastError();
        grid = cus;
        if (grid != 256) fprintf(stderr, "kernel_launch: %d CUs (expected 256)\n", grid);
    }
    if (grid < 0) return;
    if (hipMemsetAsync((char*)d_ws + WS_CTL, 0, CTL_ZERO_BYTES, stream) != hipSuccess) return;
    Args a{};
    for (int i = 0; i < 17; ++i) a.in[i] = (const float*)d_in[i];
    a.out = (float*)d_out; a.ws = (unsigned char*)d_ws;
    hipLaunchKernelGGL(fwd_kernel, dim3(grid), dim3(NTHREADS), LDS_BYTES, stream, a);
}
```

```cpp
#include <hip/hip_runtime.h>
#include <cstdio>
#include <cstdint>
#include <cmath>
template <int K> __device__ __forceinline__ float xsw(float v) { static_assert(K == 1 || K == 2 || K == 4 || K == 8 || K == 16, "xor mask inside a 32-lane half");
    return __builtin_bit_cast(float, __builtin_amdgcn_ds_swizzle(__builtin_bit_cast(int, v), 0x1F | (K << 10))); }
__device__ __forceinline__ float sum32(float v) { const unsigned u = __builtin_bit_cast(unsigned, v); auto rr = __builtin_amdgcn_permlane32_swap(u, u, false, false); return __builtin_bit_cast(float, (unsigned)rr[0]) + __builtin_bit_cast(float, (unsigned)rr[1]); }
__device__ __forceinline__ float max32(float v) { const unsigned u = __builtin_bit_cast(unsigned, v); auto rr = __builtin_amdgcn_permlane32_swap(u, u, false, false); return fmaxf(__builtin_bit_cast(float, (unsigned)rr[0]), __builtin_bit_cast(float, (unsigned)rr[1])); }
__device__ __forceinline__ float oth32(float v, int h) { const unsigned u = __builtin_bit_cast(unsigned, v); auto rr = __builtin_amdgcn_permlane32_swap(u, u, false, false); return __builtin_bit_cast(float, (unsigned)(h ? rr[0] : rr[1])); }
namespace pg8 {
#define PG8_LAS __attribute__((address_space(3)))
typedef unsigned short bf16_t;
typedef short bf16x8 __attribute__((ext_vector_type(8)));
typedef float f32x4 __attribute__((ext_vector_type(4)));
typedef unsigned u32x4 __attribute__((ext_vector_type(4)));
constexpr int BM = 256, BK = 64, HALF = 128, HTB = HALF * BK * 2  , STAGE_BYTES = 8 * HTB, NXCD = 8, WGM = 8;

__host__ __device__ __forceinline__ int lds_byte(int r, int c) { const int st = (r >> 4) * 2 + (c >> 5), rr = r & 15, cc = c & 31, ob = rr * 64 + cc * 2; return st * 1024 + (ob ^ (((ob >> 9) & 1) << 5)); }
__host__ __device__ __forceinline__ void stage_rc(int b, int& R, int& C) { const int st = b / 1024, sb = b % 1024, swz = sb ^ (((sb >> 9) & 1) << 5); R = (st >> 1) * 16 + swz / 64; C = (st & 1) * 32 + (swz % 64) / 2; }
__host__ __device__ __forceinline__ int perm32(int rho) { const int n = rho >> 4, i = rho & 15; return 8 * (i >> 2) + 4 * n + (i & 3); }

struct Unit { int pm, pn; };
struct Gemm { const bf16_t* A; const bf16_t* Bt; int M, N, K; };

struct StaticOrder {
    int nM, nN, nwg, G, c;
    __host__ __device__ void init(int M, int N, int G_, int c_) { nM = M / BM; nN = N / BM; nwg = nM * nN; G = G_; c = c_; }
    __host__ __device__ bool next(int i, Unit& u) const {
        const long L = (long)i * G + c; if (L >= nwg) return false;
        int wgid = (int)L; { const int q = nwg / NXCD, r = nwg % NXCD, xcd = wgid % NXCD, off = wgid / NXCD; wgid = (xcd < r ? xcd * (q + 1) : r * (q + 1) + (xcd - r) * q) + off; }
        const int nig = WGM * nN, gid = wgid / nig, fm = gid * WGM, gsz = (nM - fm) < WGM ? (nM - fm) : WGM;
        u.pm = fm + ((wgid % nig) % gsz); u.pn = (wgid % nig) / gsz; return true;
    }
    __device__ __forceinline__ void a_ready(const Unit&) const {}
    __device__ __forceinline__ void done(const Unit&) const {}
    static constexpr bool TWICE = false;
};
struct RevOrder : StaticOrder {
    __host__ __device__ bool next(int i, Unit& u) const { const int rounds = nwg / G; if (i >= rounds) return false; return StaticOrder::next(rounds - 1 - i, u); }
};
struct TwiceOrder : StaticOrder {
    static constexpr bool TWICE = true;
    __host__ __device__ bool next(int i, Unit& u) const { return StaticOrder::next(i >> 1, u); }
};

__device__ __forceinline__ unsigned cvt_pk_bf16(float lo, float hi) { unsigned r; asm volatile("v_cvt_pk_bf16_f32 %0, %1, %2" : "=v"(r) : "v"(lo), "v"(hi)); return r; }
constexpr int MROWS = 32768;
constexpr float RMS_EPS = 1e-6f;
__device__ __forceinline__ void row_rstd(float (&rs)[2][4], const float* ssp, const Unit& u, int wr, int fr, int fq) {
#pragma unroll
    for (int ai = 0; ai < 2; ++ai)
#pragma unroll
        for (int m = 0; m < 4; ++m) {
            const int row = u.pm * BM + ai * HALF + wr * 64 + m * 16 + fr;
            const f32x4 p = *(const f32x4*)(ssp + (size_t)row * 16 + 4 * fq);
            float s = (p[0] + p[1]) + (p[2] + p[3]);
            s += xsw<16>(s); s = sum32(s);
            rs[ai][m] = 1.0f / sqrtf(s * (1.0f / 1024.0f) + RMS_EPS);
        }
}
struct RowPre { PG8_LAS unsigned char* tab; Unit nxt; bool has_next; int ui; };
__device__ __forceinline__ void rowpre_get(float (&rs)[2][4], const float* ssp, const Unit& u, const RowPre& rp, int wr, int fr, int fq) {
    if (rp.ui == 0) { row_rstd(rs, ssp, u, wr, fr, fq); return; }
    const PG8_LAS float* t = (const PG8_LAS float*)rp.tab + (rp.ui & 1) * 128 + fr;
#pragma unroll
    for (int ai = 0; ai < 2; ++ai)
#pragma unroll
        for (int m = 0; m < 4; ++m) rs[ai][m] = t[(ai * 4 + m) * 16];
}
__device__ __forceinline__ void rowpre_issue(f32x4 (&p)[2][4], const float* ssp, const RowPre& rp, int wr, int fr, int fq) {
#pragma unroll
    for (int ai = 0; ai < 2; ++ai)
#pragma unroll
        for (int m = 0; m < 4; ++m) p[ai][m] = *(const f32x4*)(ssp + (size_t)(rp.nxt.pm * BM + ai * HALF + wr * 64 + m * 16 + fr) * 16 + 4 * fq);
}
__device__ __forceinline__ void rowpre_park(const f32x4 (&p)[2][4], const RowPre& rp, int fr, int fq) {
    PG8_LAS float* t = (PG8_LAS float*)rp.tab + ((rp.ui + 1) & 1) * 128 + fr;
#pragma unroll
    for (int ai = 0; ai < 2; ++ai)
#pragma unroll
        for (int m = 0; m < 4; ++m) { float s = (p[ai][m][0] + p[ai][m][1]) + (p[ai][m][2] + p[ai][m][3]); s += xsw<16>(s); s = sum32(s);
            if (fq == 0) t[(ai * 4 + m) * 16] = 1.0f / sqrtf(s * (1.0f / 1024.0f) + RMS_EPS); }
}
__device__ __forceinline__ float silu_f(float g) { return g * __builtin_amdgcn_rcpf(1.0f + __builtin_amdgcn_exp2f(-1.4426950408889634f * g)); }

struct EpiSwiGLU {
    static constexpr bool PERM = true, AFTER_DRAIN = false;
    bf16_t* H; int ldh; const float* ssp;
    __device__ __forceinline__ void operator()(const f32x4 (&acc)[2][2][4][2], const Unit& u, int wr, int wc, int fr, int fq, const RowPre& rp) const {
        float rs[2][4]; rowpre_get(rs, ssp, u, rp, wr, fr, fq);
        f32x4 pre[2][4]; if (rp.has_next) rowpre_issue(pre, ssp, rp, wr, fr, fq);
        const int col0 = u.pn * HALF + wc * 32 + 8 * fq;
#pragma unroll
        for (int ai = 0; ai < 2; ++ai)
#pragma unroll
            for (int m = 0; m < 4; ++m) {
                const int row = u.pm * BM + ai * HALF + wr * 64 + m * 16 + fr; const float r = rs[ai][m];
                float h[8];
#pragma unroll
                for (int n = 0; n < 2; ++n)
#pragma unroll
                    for (int i = 0; i < 4; ++i) { const float g = acc[ai][0][m][n][i] * r, up = acc[ai][1][m][n][i] * r; h[4 * n + i] = silu_f(g) * up;
#ifdef PROBE_FP8EMU
                        { unsigned uu = __builtin_bit_cast(unsigned, h[4 * n + i]); uu += 0x7FFFFu + ((uu >> 20) & 1u); uu &= 0xFFF00000u; h[4 * n + i] = __builtin_bit_cast(float, uu); }
#endif
                    }
                u32x4 w; w.x = cvt_pk_bf16(h[0], h[1]); w.y = cvt_pk_bf16(h[2], h[3]); w.z = cvt_pk_bf16(h[4], h[5]); w.w = cvt_pk_bf16(h[6], h[7]);
                *(u32x4*)(H + (size_t)row * ldh + col0) = w;
                asm volatile("" ::: "memory");
            }
        if (rp.has_next) rowpre_park(pre, rp, fr, fq);
    }
};
struct EpiInProj {
    static constexpr bool PERM = true, AFTER_DRAIN = false;
    bf16_t* O; int ldc; const float* ssp; const float* rc; const float* rs; const float* dc; const float* ds; int even;
    __device__ __forceinline__ void operator()(const f32x4 (&acc)[2][2][4][2], const Unit& u, int wr, int wc, int fr, int fq, const RowPre& rp) const {
        float rsd[2][4]; rowpre_get(rsd, ssp, u, rp, wr, fr, fq);
        f32x4 pre[2][4]; if (rp.has_next) rowpre_issue(pre, ssp, rp, wr, fr, fq);
        const int col0 = u.pn * BM + wc * 32 + 8 * fq;
        const int kind = even ? (u.pn < 4 ? 1 : ((u.pn >= 8 && u.pn < 12) ? 2 : 0)) : 0;
        const float ksc = (kind == 1 && u.pn >= 2) ? 0.08838834764831845f : 1.0f;
        const bool rot2 = (kind == 2) && ((wc & 1) == 0) && (fq < 2);
        const float* tc = (kind == 1) ? rc + wc * 16 + 4 * fq : dc + 4 * (fq & 1);
        const float* ts = (kind == 1) ? rs + wc * 16 + 4 * fq : ds + 4 * (fq & 1);
        const int tstride = (kind == 1) ? 64 : 8;
#pragma unroll
        for (int ai = 0; ai < 2; ++ai)
#pragma unroll
            for (int m = 0; m < 4; ++m) {
                const int row = u.pm * BM + ai * HALF + wr * 64 + m * 16 + fr; const float r = rsd[ai][m] * ksc;
                f32x4 c4 = {1.f, 1.f, 1.f, 1.f}, s4 = {0.f, 0.f, 0.f, 0.f};
                if (kind == 1 || rot2) { const int pos = row & 4095; c4 = *(const f32x4*)(tc + (size_t)pos * tstride); s4 = *(const f32x4*)(ts + (size_t)pos * tstride); }
#pragma unroll
                for (int bj = 0; bj < 2; ++bj) { const f32x4 v0 = acc[ai][bj][m][0] * r, v1 = acc[ai][bj][m][1] * r;
                    const float o0 = v0[0] * c4[0] - v0[1] * s4[0], o1 = v0[1] * c4[0] + v0[0] * s4[0], o2 = v0[2] * c4[1] - v0[3] * s4[1], o3 = v0[3] * c4[1] + v0[2] * s4[1];
                    const float o4 = v1[0] * c4[2] - v1[1] * s4[2], o5 = v1[1] * c4[2] + v1[0] * s4[2], o6 = v1[2] * c4[3] - v1[3] * s4[3], o7 = v1[3] * c4[3] + v1[2] * s4[3];
                    u32x4 w; w.x = cvt_pk_bf16(o0, o1); w.y = cvt_pk_bf16(o2, o3); w.z = cvt_pk_bf16(o4, o5); w.w = cvt_pk_bf16(o6, o7);
                    *(u32x4*)(O + (size_t)row * ldc + col0 + bj * HALF) = w; }
                asm volatile("" ::: "memory");
            }
        if (rp.has_next) rowpre_park(pre, rp, fr, fq);
    }
};
struct EpiResid {
    static constexpr bool PERM = true, AFTER_DRAIN = false;
    bf16_t* xb; float* ssp; float scale;
    __device__ __forceinline__ void operator()(const f32x4 (&acc)[2][2][4][2], const Unit& u, int wr, int wc, int fr, int fq, const RowPre&) const {
        const int col0 = u.pn * BM + wc * 32 + 8 * fq, rowb = u.pm * BM + wr * 64 + fr;
        u32x4 old[8][2];
#pragma unroll
        for (int g = 0; g < 8; ++g) { const size_t off = (size_t)(rowb + (g >> 2) * HALF + (g & 3) * 16) * 1024 + col0; old[g][0] = *(const u32x4*)(xb + off); old[g][1] = *(const u32x4*)(xb + off + HALF); }
#pragma unroll
        for (int g = 0; g < 8; ++g) {
            const int ai = g >> 2, m = g & 3, row = rowb + ai * HALF + m * 16; float ss = 0.f;
#pragma unroll
            for (int bj = 0; bj < 2; ++bj) { const size_t off = (size_t)row * 1024 + col0 + bj * HALF; const u32x4 o = old[g][bj];
                const f32x4 a0 = acc[ai][bj][m][0] * scale, a1 = acc[ai][bj][m][1] * scale;
                const float v0 = __builtin_bit_cast(float, o.x << 16) + a0[0], v1 = __builtin_bit_cast(float, o.x & 0xffff0000u) + a0[1], v2 = __builtin_bit_cast(float, o.y << 16) + a0[2], v3 = __builtin_bit_cast(float, o.y & 0xffff0000u) + a0[3];
                const float v4 = __builtin_bit_cast(float, o.z << 16) + a1[0], v5 = __builtin_bit_cast(float, o.z & 0xffff0000u) + a1[1], v6 = __builtin_bit_cast(float, o.w << 16) + a1[2], v7 = __builtin_bit_cast(float, o.w & 0xffff0000u) + a1[3];
                u32x4 w; w.x = cvt_pk_bf16(v0, v1); w.y = cvt_pk_bf16(v2, v3); w.z = cvt_pk_bf16(v4, v5); w.w = cvt_pk_bf16(v6, v7);
                *(u32x4*)(xb + off) = w;
                ss += (v0 * v0 + v1 * v1) + (v2 * v2 + v3 * v3) + (v4 * v4 + v5 * v5) + (v6 * v6 + v7 * v7); }
            ss += xsw<16>(ss); ss = sum32(ss);
            if (fq == 0) ssp[(size_t)row * 16 + u.pn * 4 + wc] = ss;
        }
    }
};

template <class Epi, class Sched, bool ALIGN_EPI = false, bool SP2 = false>
__device__ __forceinline__ void gemm_phase(PG8_LAS unsigned char* lds, const Gemm g, const Sched& S, const Epi& E, int wave_in) {
    int tid_ = threadIdx.x; asm volatile("" : "+v"(tid_));
    const int tid = tid_, wid = __builtin_amdgcn_readfirstlane(tid >> 6), lane = tid & 63, wr = wid >> 2, wc = wid & 3, fr = lane & 15, fq = lane >> 4;
    const int K = g.K, nt = K / BK;
    unsigned voffA[2], voffB[2];
#pragma unroll
    for (int i = 0; i < 2; ++i) { int R, C; stage_rc(tid * 16 + i * 8192, R, C); const int Rb = Epi::PERM ? ((R & ~31) + perm32(R & 31)) : R;
        voffA[i] = (unsigned)(R * K + C) * 2u; voffB[i] = (unsigned)(Rb * K + C) * 2u; }
    const size_t kstep = (size_t)(BK * 2);
    const size_t hstep = (size_t)HALF * K * 2;
    const size_t tstep = 2 * hstep;
    const unsigned ldsw = (unsigned)wid * 1024u;
    const int aoff = lds_byte(wr * 64 + fr, fq * 8), boff = lds_byte(wc * 32 + fr, fq * 8);
#define PG8_SA(b, h) (((b) * 2 + (h)) * HTB)
#define PG8_SB(b, h) ((4 + (b) * 2 + (h)) * HTB)
#define PG8_STAGE(bufoff, gbase, voff) do { _Pragma("unroll") for (int _i = 0; _i < 2; ++_i) \
        __builtin_amdgcn_global_load_lds((const unsigned*)((const char*)(gbase) + (voff)[_i]), (PG8_LAS unsigned*)(lds + (bufoff) + ldsw + _i * 8192), 16, 0, 0); } while (0)
#define PG8_LDA(dst, b, h) do { _Pragma("unroll") for (int m = 0; m < 4; ++m) _Pragma("unroll") for (int k = 0; k < 2; ++k) dst[m][k] = *(const PG8_LAS bf16x8*)(lds + PG8_SA(b, h) + aoff + m * 2048 + k * 1024); } while (0)
#define PG8_LDB(dst, b, h) do { _Pragma("unroll") for (int n = 0; n < 2; ++n) _Pragma("unroll") for (int k = 0; k < 2; ++k) dst[n][k] = *(const PG8_LAS bf16x8*)(lds + PG8_SB(b, h) + boff + n * 2048 + k * 1024); } while (0)
#define PG8_MMA(ai, bj, At, Bt) do { __builtin_amdgcn_s_setprio(1); _Pragma("unroll") for (int m = 0; m < 4; ++m) _Pragma("unroll") for (int n = 0; n < 2; ++n) _Pragma("unroll") for (int k = 0; k < 2; ++k) \
        acc[ai][bj][m][n] = __builtin_amdgcn_mfma_f32_16x16x32_bf16(Bt[n][k], At[m][k], acc[ai][bj][m][n], 0, 0, 0); __builtin_amdgcn_s_setprio(0); } while (0)
#define PG8_WAIT_V(n) asm volatile("s_waitcnt vmcnt(" #n ")" ::: "memory")
#define PG8_WAIT_L(n) asm volatile("s_waitcnt lgkmcnt(" #n ")" ::: "memory")
#define PG8_BAR __builtin_amdgcn_s_barrier()
#define PG8_SCHED __builtin_amdgcn_sched_barrier(0)
    Unit cur, nxt; int ui = 0;
    if (!S.next(0, cur)) return;
    f32x4 acc[2][2][4][2];
#pragma unroll
    for (int a = 0; a < 2; ++a)
#pragma unroll
        for (int b = 0; b < 2; ++b)
#pragma unroll
            for (int m = 0; m < 4; ++m)
#pragma unroll
                for (int n = 0; n < 2; ++n) acc[a][b][m][n] = (f32x4){0.f, 0.f, 0.f, 0.f};
    bf16x8 At[4][2], B0[2][2], B1[2][2];
    const char* cA = (const char*)g.A + (size_t)cur.pm * tstep; const char* cB = (const char*)g.Bt + (size_t)cur.pn * tstep;
    S.a_ready(cur);
    if constexpr (SP2) {
        PG8_STAGE(PG8_SB(0, 0), cB, voffB); PG8_STAGE(PG8_SB(0, 1), cB + hstep, voffB); PG8_STAGE(PG8_SA(0, 0), cA, voffA); PG8_STAGE(PG8_SA(0, 1), cA + hstep, voffA);
        if (wr == 1) PG8_BAR;
        PG8_WAIT_V(2); PG8_BAR;
        PG8_STAGE(PG8_SB(1, 0), cB + kstep, voffB); PG8_STAGE(PG8_SA(1, 0), cA + kstep, voffA); PG8_STAGE(PG8_SB(1, 1), cB + hstep + kstep, voffB);
        PG8_WAIT_V(6); PG8_BAR;
    } else {
        PG8_STAGE(PG8_SB(0, 0), cB, voffB); PG8_STAGE(PG8_SA(0, 0), cA, voffA); PG8_STAGE(PG8_SB(0, 1), cB + hstep, voffB); PG8_STAGE(PG8_SA(0, 1), cA + hstep, voffA);
        if (wr == 1) PG8_BAR;
        PG8_WAIT_V(4); PG8_BAR;
        PG8_STAGE(PG8_SB(1, 0), cB + kstep, voffB); PG8_STAGE(PG8_SA(1, 0), cA + kstep, voffA); PG8_STAGE(PG8_SB(1, 1), cB + hstep + kstep, voffB);
        PG8_WAIT_V(6); PG8_BAR;
    }
    for (;;) {
        const bool has_next = S.next(ui + 1, nxt);
        const char* nA = has_next ? (const char*)g.A + (size_t)nxt.pm * tstep : cA; const char* nB = has_next ? (const char*)g.Bt + (size_t)nxt.pn * tstep : cB;
        for (int t = 0; t < nt; t += 2) {
            const bool last = (t == nt - 2);
            const char* a1 = cA + (size_t)(t + 1) * kstep;
            const char* a2 = last ? nA : cA + (size_t)(t + 2) * kstep; const char* b2 = last ? nB : cB + (size_t)(t + 2) * kstep;
            const char* a3 = a2 + kstep; const char* b3 = b2 + kstep;
            if (last && has_next) S.a_ready(nxt);
            if constexpr (SP2) {
            PG8_LDB(B0, 0, 0); PG8_LDB(B1, 0, 1); PG8_SCHED; PG8_LDA(At, 0, 0); PG8_STAGE(PG8_SA(1, 1), a1 + hstep, voffA);
            PG8_WAIT_V(8); PG8_WAIT_L(0); PG8_BAR; PG8_MMA(0, 0, At, B0); PG8_MMA(0, 1, At, B1); PG8_BAR; PG8_SCHED;
            PG8_LDA(At, 0, 1); PG8_STAGE(PG8_SB(0, 0), b2, voffB); PG8_STAGE(PG8_SB(0, 1), b2 + hstep, voffB); PG8_STAGE(PG8_SA(0, 0), a2, voffA);
            PG8_WAIT_V(8); PG8_WAIT_L(0); PG8_BAR; PG8_MMA(1, 0, At, B0); PG8_MMA(1, 1, At, B1); PG8_BAR; PG8_SCHED;
            PG8_LDB(B0, 1, 0); PG8_LDB(B1, 1, 1); PG8_SCHED; PG8_LDA(At, 1, 0); PG8_STAGE(PG8_SA(0, 1), a2 + hstep, voffA);
            PG8_WAIT_V(8); PG8_WAIT_L(0); PG8_BAR; PG8_MMA(0, 0, At, B0); PG8_MMA(0, 1, At, B1); PG8_BAR; PG8_SCHED;
            PG8_LDA(At, 1, 1); PG8_STAGE(PG8_SB(1, 0), b3, voffB); PG8_STAGE(PG8_SB(1, 1), b3 + hstep, voffB); PG8_STAGE(PG8_SA(1, 0), a3, voffA);
            PG8_WAIT_V(8); PG8_WAIT_L(0); PG8_BAR; PG8_MMA(1, 0, At, B0); PG8_MMA(1, 1, At, B1); PG8_BAR; PG8_SCHED;
            } else {
            PG8_LDB(B0, 0, 0); PG8_SCHED; PG8_LDA(At, 0, 0); PG8_STAGE(PG8_SA(1, 1), a1 + hstep, voffA);
            PG8_WAIT_L(8); PG8_BAR; PG8_WAIT_L(0); PG8_MMA(0, 0, At, B0); PG8_BAR; PG8_SCHED;
            PG8_LDB(B1, 0, 1); PG8_STAGE(PG8_SB(0, 0), b2, voffB);
            PG8_BAR; PG8_WAIT_L(0); PG8_MMA(0, 1, At, B1); PG8_BAR;
            PG8_LDA(At, 0, 1); PG8_STAGE(PG8_SA(0, 0), a2, voffA);
            PG8_BAR; PG8_WAIT_L(0); PG8_MMA(1, 0, At, B0); PG8_BAR; PG8_SCHED;
            PG8_STAGE(PG8_SB(0, 1), b2 + hstep, voffB);
            PG8_WAIT_V(6); PG8_BAR; PG8_MMA(1, 1, At, B1); PG8_BAR;
            PG8_LDB(B0, 1, 0); PG8_SCHED; PG8_LDA(At, 1, 0); PG8_STAGE(PG8_SA(0, 1), a2 + hstep, voffA);
            PG8_WAIT_L(8); PG8_BAR; PG8_WAIT_L(0); PG8_MMA(0, 0, At, B0); PG8_BAR; PG8_SCHED;
            PG8_LDB(B1, 1, 1); PG8_STAGE(PG8_SB(1, 0), b3, voffB);
            PG8_BAR; PG8_WAIT_L(0); PG8_MMA(0, 1, At, B1); PG8_BAR;
            PG8_LDA(At, 1, 1); PG8_STAGE(PG8_SA(1, 0), a3, voffA);
            PG8_BAR; PG8_WAIT_L(0); PG8_MMA(1, 0, At, B0); PG8_BAR; PG8_SCHED;
            PG8_STAGE(PG8_SB(1, 1), b3 + hstep, voffB);
            PG8_WAIT_V(6); PG8_BAR; PG8_MMA(1, 1, At, B1); PG8_BAR;
            }
        }
        if constexpr (ALIGN_EPI) { if (wr == 0) PG8_BAR; }
        if constexpr (!Epi::AFTER_DRAIN) { if (!Sched::TWICE || (ui & 1)) { E(acc, cur, wr, wc, fr, fq, RowPre{lds + STAGE_BYTES + wid * 1024, has_next ? nxt : cur, has_next && !Sched::TWICE, Sched::TWICE ? 0 : ui}); S.done(cur); } }
        if (!has_next) break;
#pragma unroll
        for (int a = 0; a < 2; ++a)
#pragma unroll
            for (int b = 0; b < 2; ++b)
#pragma unroll
                for (int m = 0; m < 4; ++m)
#pragma unroll
                    for (int n = 0; n < 2; ++n) acc[a][b][m][n] = (f32x4){0.f, 0.f, 0.f, 0.f};
        cur = nxt; cA = nA; cB = nB; ++ui;
        if constexpr (ALIGN_EPI) { if (wr == 1) PG8_BAR; }
    }
    PG8_WAIT_V(0);
    if constexpr (!ALIGN_EPI) { if (wr == 0) PG8_BAR; }
    PG8_BAR;
    if constexpr (Epi::AFTER_DRAIN) { E.fused(acc, cur, wr, wc, fr, fq, lds, wid, lane); S.done(cur); }
#undef PG8_SA
#undef PG8_SB
#undef PG8_STAGE
#undef PG8_LDA
#undef PG8_LDB
#undef PG8_MMA
#undef PG8_WAIT_V
#undef PG8_WAIT_L
#undef PG8_BAR
#undef PG8_SCHED
}
}

constexpr int NWAVES = 8, NTHREADS = NWAVES * 64;
constexpr int BATCH = 8, SEQ = 4096, D = 1024, M = BATCH * SEQ, FF = 2816, DEPTH = 4;
constexpr int EVEN_IN = 3584, GLA_IN = 3088, GLA_INP = 3328;
static_assert(M == pg8::MROWS, "row count");
constexpr int E_RQ = 0, E_RK = 512, E_RV = 1024, E_RG = 1536, E_DQ = 2048, E_DK = 2560, E_DV = 3072;
constexpr int G_Q = 0, G_K = 512, G_V = 1024, G_R = 2048, G_A = 3072;
constexpr float EPS = 1e-6f;

constexpr size_t MiB = 1u << 20;
constexpr size_t WS_CTL = 0, CTL_ZERO_BYTES = 1 * MiB;
constexpr size_t WS_SSP = 1 * MiB;
constexpr size_t WS_TAB = 3 * MiB;
constexpr size_t TAB_RC = WS_TAB, TAB_RS = WS_TAB + 1 * MiB, TAB_DC = WS_TAB + 2 * MiB, TAB_DS = WS_TAB + 2 * MiB + 128 * 1024;
constexpr size_t WS_W = 8 * MiB;
constexpr size_t W_GU0 = WS_W, W_D0 = W_GU0 + (size_t)2 * FF * D * 2, W_GU1 = W_D0 + (size_t)D * FF * 2, W_D1 = W_GU1 + (size_t)2 * FF * D * 2,
                 W_IN = W_D1 + (size_t)D * FF * 2, W_OUT = W_IN + (size_t)EVEN_IN * D * 2, W_END = W_OUT + (size_t)D * D * 2;
constexpr size_t WS_XB = 56 * MiB;
constexpr size_t WS_ACT = 120 * MiB;
constexpr size_t WS_CAT = 344 * MiB;
constexpr size_t WS_END = 408 * MiB;
static_assert(W_END <= WS_XB && WS_XB + (size_t)M * D * 2 <= WS_ACT && WS_ACT + (size_t)M * EVEN_IN * 2 <= WS_CAT && WS_CAT + (size_t)M * D * 2 <= WS_END, "d_ws map");
constexpr int CW_BAR = 4096;

constexpr int RING_OFF = 0, RING_BYTES = 131072;
constexpr int LDSCTL_OFF = 161792, MISC_OFF = LDSCTL_OFF + 320, PTR_OFF = LDSCTL_OFF + 1024;
constexpr int LDS_BYTES = 163840;
static_assert(PTR_OFF + 19 * 8 <= LDS_BYTES && RING_BYTES <= LDSCTL_OFF, "LDS map");

#define GAS __attribute__((address_space(1)))
#define LAS __attribute__((address_space(3)))
typedef unsigned short bf16;
typedef unsigned v4u __attribute__((ext_vector_type(4)));
typedef float f32x4 __attribute__((ext_vector_type(4)));
typedef short bf16x8 __attribute__((ext_vector_type(8)));
typedef GAS unsigned gu32;
typedef GAS unsigned long long gu64;
#define RLX_AGENT __ATOMIC_RELAXED, __HIP_MEMORY_SCOPE_AGENT
#define LDS_WAIT() asm volatile("s_waitcnt lgkmcnt(0)" ::: "memory")
#define VM_WAIT() asm volatile("s_waitcnt vmcnt(0)" ::: "memory")
__device__ __forceinline__ unsigned long long rt() { return __builtin_amdgcn_s_memrealtime(); }
__device__ __forceinline__ unsigned f2bf(float f) { unsigned u = __builtin_bit_cast(unsigned, f); return (u + 0x7fffu + ((u >> 16) & 1u)) >> 16; }
__device__ __forceinline__ unsigned pk2(float lo, float hi) { return f2bf(lo) | (f2bf(hi) << 16); }

#define XB_TMO      128
#define XB_XCNT(j)  (256  + 64 * (j))
#define XB_XSUB(j)  (1280 + 64 * (j))
#define XB_XGEN(j)  (2304 + 64 * (j))
#define XB_TOP      3328
#define XB_TOPGEN   3392
#define XCD_BAR_WORDS 3456
#define XB_SPIN_CAP (1u << 18)

__device__ __forceinline__ unsigned xb_ld(unsigned* p)              { return __hip_atomic_load(p, __ATOMIC_RELAXED, __HIP_MEMORY_SCOPE_AGENT); }
__device__ __forceinline__ unsigned xb_add(unsigned* p, unsigned v) { return __hip_atomic_fetch_add(p, v, __ATOMIC_RELAXED, __HIP_MEMORY_SCOPE_AGENT); }
__device__ __forceinline__ unsigned xb_xcc_id() { return (unsigned)__builtin_amdgcn_s_getreg((3 << 11) | 20) & 0xFu; }
#define XB_SPIN(cond, bar) do { unsigned _sp = 0; while (cond) { __builtin_amdgcn_s_sleep(1); \
    if ((++_sp & 255u) == 0u) { if (xb_ld(&(bar)[XB_TMO])) break; if (_sp > XB_SPIN_CAP) { atomicAdd(&(bar)[XB_TMO], 1u); break; } } } } while (0)

struct XcdBarrier {
    unsigned* bar; unsigned x;
    volatile LAS unsigned* st;
};

__device__ __forceinline__ XcdBarrier xcd_barrier_post(unsigned* bar, volatile LAS unsigned* st, int tid) {
    XcdBarrier b; b.bar = bar; b.x = xb_xcc_id(); b.st = st;
    if (tid == 0) (void)xb_add(&bar[XB_XCNT(b.x)], 1u);
    return b;
}
__device__ __forceinline__ void xcd_barrier_complete(unsigned* bar, unsigned x, unsigned& nloc, unsigned& nx) {
    const unsigned G = gridDim.x * gridDim.y * gridDim.z;
    unsigned sum, cnt, mine, sp = 0u;
    for (;;) {
        sum = 0u; cnt = 0u; mine = 0u;
#pragma unroll
        for (unsigned j = 0; j < 16; ++j) { const unsigned c = xb_ld(&bar[XB_XCNT(j)]); sum += c; cnt += (c > 0u) ? 1u : 0u; mine = (j == x) ? c : mine; }
        if (sum == G) break;
        __builtin_amdgcn_s_sleep(1);
        if ((++sp & 255u) == 0u) { if (xb_ld(&bar[XB_TMO])) break; if (sp > XB_SPIN_CAP) { atomicAdd(&bar[XB_TMO], 1u); break; } }
    }
    nloc = mine > 0u ? mine : 1u; nx = cnt > 0u ? cnt : 1u;
}

__device__ __forceinline__ void xcd_barrier(const XcdBarrier& b, int tid) {
    asm volatile("s_waitcnt vmcnt(0)" ::: "memory");
    __syncthreads();
    if (tid == 0) {
        unsigned* bar = b.bar;
        __builtin_amdgcn_s_waitcnt(0);
        unsigned nloc = b.st[0], nx = b.st[1];
        if (nloc == 0u) { xcd_barrier_complete(bar, b.x, nloc, nx); b.st[0] = nloc; b.st[1] = nx; }
        const unsigned old = xb_add(&bar[XB_XSUB(b.x)], 1u);
        const unsigned gen = old / nloc;
        if (old + 1u == (gen + 1u) * nloc) {
            __builtin_amdgcn_fence(__ATOMIC_RELEASE, "agent");
            asm volatile("s_waitcnt vmcnt(0)" ::: "memory");
            const unsigned og = xb_add(&bar[XB_TOP], 1u);
            const unsigned tg = og / nx;
            if (og + 1u == (tg + 1u) * nx) xb_add(&bar[XB_TOPGEN], 1u);
            else XB_SPIN(xb_ld(&bar[XB_TOPGEN]) == tg, bar);
            __builtin_amdgcn_fence(__ATOMIC_ACQUIRE, "agent");
            xb_add(&bar[XB_XGEN(b.x)], 1u);
            asm volatile("s_waitcnt vmcnt(0)" ::: "memory");
        } else {
            XB_SPIN(xb_ld(&bar[XB_XGEN(b.x)]) == gen, bar);
            __builtin_amdgcn_fence(__ATOMIC_ACQUIRE, "agent");
            asm volatile("s_waitcnt vmcnt(0)" ::: "memory");
        }
    }
    __syncthreads();
}

__constant__ float RET_FREQ[64] = {1.000000000e+00f, 8.639884591e-01f, 7.464760542e-01f, 6.449466944e-01f, 5.572264791e-01f, 4.814372361e-01f, 4.159561992e-01f, 3.593813777e-01f, 3.105013371e-01f, 2.682695687e-01f, 2.317818105e-01f, 2.002568096e-01f, 1.730195731e-01f, 1.494869143e-01f, 1.291549653e-01f, 1.115883961e-01f, 9.641107172e-02f, 8.329805732e-02f, 7.196855545e-02f, 6.218000501e-02f, 5.372280627e-02f, 4.641588405e-02f, 4.010278732e-02f, 3.464834765e-02f, 2.993577160e-02f, 2.586415969e-02f, 2.234633639e-02f, 1.930697635e-02f, 1.668100432e-02f, 1.441219542e-02f, 1.245197095e-02f, 1.075835899e-02f, 9.295095690e-03f, 8.030855097e-03f, 6.938565988e-03f, 5.994840991e-03f, 5.179473665e-03f, 4.475005437e-03f, 3.866352839e-03f, 3.340484342e-03f, 2.886139788e-03f, 2.493591513e-03f, 2.154434333e-03f, 1.861406374e-03f, 1.608233666e-03f, 1.389495330e-03f, 1.200507861e-03f, 1.037224894e-03f, 8.961503627e-04f, 7.742635789e-04f, 6.689548027e-04f, 5.779692437e-04f, 4.993587499e-04f, 4.314401885e-04f, 3.727593285e-04f, 3.220597573e-04f, 2.782559313e-04f, 2.404099068e-04f, 2.077113895e-04f, 1.794602431e-04f, 1.550515735e-04f, 1.339627634e-04f, 1.157422885e-04f, 9.999999747e-05f};
__constant__ float ROPE_FREQ[8] = {1.000000000e+00f, 1.939227432e-01f, 3.760603070e-02f, 7.292664610e-03f, 1.414213562e-03f, 2.742481884e-04f, 5.318295734e-05f, 1.031338525e-05f};
struct Args { const float* in[17]; float* out; unsigned char* ws; };
enum { I_X = 0, I_PRE_NORM = 1, I_PRE_WG = 2, I_PRE_WU = 3, I_PRE_WD = 4, I_MIX_NORM = 5, I_AB_IN = 6, I_AB_OUT = 7, I_GLA_IN = 8, I_GLA_A2 = 9, I_GLA_BA = 10, I_GLA_OUT = 11,
       I_POST_NORM = 12, I_POST_WG = 13, I_POST_WU = 14, I_POST_WD = 15, I_FINAL = 16, I_OUT = 17, I_WS = 18, N_PTRS = 19 };
struct Frame {
    LAS unsigned char* lds;
    int tid, lane, wave, G, bid;
};
__device__ __forceinline__ unsigned char* tabp(const Frame& F, int idx) {
    int off_ = PTR_OFF + 8 * idx; asm volatile("" : "+s"(off_));
    const volatile LAS unsigned* T = (const volatile LAS unsigned*)(F.lds + off_);
    const unsigned lo = __builtin_amdgcn_readfirstlane(T[0]), hi = __builtin_amdgcn_readfirstlane(T[1]);
    GAS unsigned char* gp_ = (GAS unsigned char*)(((unsigned long long)hi << 32) | (unsigned long long)lo);
    return (unsigned char*)gp_;
}
#define AP(idx) ((const float*)tabp(F, idx))
#define WSP() tabp(F, I_WS)
#define OUTP() ((float*)tabp(F, I_OUT))
__device__ __forceinline__ int lnd(int v) { asm volatile("" : "+s"(v)); return v; }
__device__ __forceinline__ int hw_lane() { return (int)__builtin_amdgcn_mbcnt_hi(~0u, __builtin_amdgcn_mbcnt_lo(~0u, 0u)); }
__device__ __forceinline__ Frame relaunder(const Frame& F0) { Frame F = F0; int t_ = threadIdx.x; asm volatile("" : "+v"(t_)); asm volatile("" : "+s"(F.bid)); F.tid = t_; F.lane = F.tid & 63; F.wave = __builtin_amdgcn_readfirstlane(F.tid >> 6);
    unsigned lb_ = 0u; asm volatile("" : "+s"(lb_)); F.lds = F0.lds + lb_; return F; }
__device__ __forceinline__ float wave_sum(float v) {
    v += xsw<1>(v); v += xsw<2>(v); v += xsw<4>(v); v += xsw<8>(v); v += xsw<16>(v);
    return sum32(v);
}
__device__ __forceinline__ float bf2f(bf16 h) { return __builtin_bit_cast(float, (unsigned)h << 16); }
__device__ __forceinline__ float bflo(unsigned w) { return __builtin_bit_cast(float, w << 16); }
__device__ __forceinline__ float bfhi(unsigned w) { return __builtin_bit_cast(float, w & 0xffff0000u); }
__device__ __forceinline__ bf16 f2bf_rne(float f) { return (bf16)f2bf(f); }

__device__ __forceinline__ void tr_item(const float* W, int K, int N, int Npad, const float* gain, bf16* WT, int gu, LAS float* scr, int item, int lane) {
    const int nblk = Npad / 32, kb = item / nblk, nb = item % nblk, k0 = 64 * kb, n0 = 32 * nb;
    {
        const int c4 = lane & 7; const bool ok = n0 + 4 * c4 < N;
        const GAS float* src = (const GAS float*)W + (size_t)(k0 + (lane >> 3)) * N + n0 + 4 * c4;
        f32x4 v[8];
#pragma unroll
        for (int i = 0; i < 8; ++i) v[i] = ok ? *(const GAS f32x4*)(src + (size_t)(8 * i) * N) : (f32x4){0.f, 0.f, 0.f, 0.f};
#pragma unroll
        for (int i = 0; i < 8; ++i) { const int kk = 8 * i + (lane >> 3); const float gn = gain ? ((const GAS float*)gain)[k0 + kk] : 1.0f; LAS float* s = scr + kk * 33 + 4 * c4;
            s[0] = v[i][0] * gn; s[1] = v[i][1] * gn; s[2] = v[i][2] * gn; s[3] = v[i][3] * gn;
#ifdef PROBE_FP8EMU
            if (K == FF) {
#pragma unroll
                for (int q = 0; q < 4; ++q) { unsigned uu = __builtin_bit_cast(unsigned, (float)s[q]); uu += 0x7FFFFu + ((uu >> 20) & 1u); uu &= 0xFFF00000u; s[q] = __builtin_bit_cast(float, uu); } }
#endif
            }
    }
    LDS_WAIT(); asm volatile("" ::: "memory");
    const int c = lane & 7;
#pragma unroll
    for (int j = 0; j < 4; ++j) { const int n = (lane >> 3) + 8 * j; const LAS float* s = scr + (8 * c) * 33 + n;
        v4u o; o.x = pk2(s[0 * 33], s[1 * 33]); o.y = pk2(s[2 * 33], s[3 * 33]); o.z = pk2(s[4 * 33], s[5 * 33]); o.w = pk2(s[6 * 33], s[7 * 33]);
        int drow = n0 + n;
        if (gu == 3) {
            if (drow < 1024) { const int j = drow & 127; drow = (drow & ~127) + (j < 64 ? 2 * j : 2 * (j - 64) + 1); }
            else if (drow >= 2048 && drow < 3072) { const int j = drow & 63; drow = (drow & ~63) + (j < 8 ? 2 * j : (j < 16 ? 2 * (j - 8) + 1 : j)); }
        } else if (gu) drow = (drow >> 7) * 256 + (drow & 127) + (gu == 2 ? 128 : 0);
        *(GAS v4u*)(WT + (size_t)drow * K + k0 + 8 * c) = o; }
    LDS_WAIT(); asm volatile("" ::: "memory");
}
__device__ __forceinline__ void convert_weights(const Frame& F0, int l) {
    const Frame F = relaunder(F0);
    LAS float* scr = (LAS float*)(F.lds + RING_OFF + F.wave * 16384);
    const int gw = F.bid * NWAVES + F.wave, NGW = F.G * NWAVES;
    unsigned char* ws = WSP();
    constexpr int I_G = (D / 64) * (FF / 32), I_DN = (FF / 64) * (D / 32), I_O = (D / 64) * (D / 32);
    const bool odd = (l & 1) != 0; const int li = l >> 1;
    const int nin = odd ? GLA_IN : EVEN_IN, ninp = odd ? GLA_INP : EVEN_IN; const int I_IN = (D / 64) * (ninp / 32);
    const float* win = odd ? AP(I_GLA_IN) + (size_t)li * D * GLA_IN : AP(I_AB_IN) + (size_t)li * D * EVEN_IN;
    const float* wout = odd ? AP(I_GLA_OUT) + (size_t)li * D * D : AP(I_AB_OUT) + (size_t)li * D * D;
    const size_t fo = (size_t)l * D * FF;
    const int NITEMS = 6 * I_G + I_IN + I_O;
    static_assert(I_G == I_DN, "item counts");
    for (int it = gw; it < NITEMS; it += NGW) {
        int r = it;
        if (r < I_G) { tr_item(AP(I_PRE_WG) + fo, D, FF, FF, AP(I_PRE_NORM) + l * D, (bf16*)(ws + W_GU0), 1, scr, r, F.lane); continue; } r -= I_G;
        if (r < I_G) { tr_item(AP(I_PRE_WU) + fo, D, FF, FF, AP(I_PRE_NORM) + l * D, (bf16*)(ws + W_GU0), 2, scr, r, F.lane); continue; } r -= I_G;
        if (r < I_G) { tr_item(AP(I_PRE_WD) + fo, FF, D, D, nullptr, (bf16*)(ws + W_D0), 0, scr, r, F.lane); continue; } r -= I_G;
        if (r < I_G) { tr_item(AP(I_POST_WG) + fo, D, FF, FF, AP(I_POST_NORM) + l * D, (bf16*)(ws + W_GU1), 1, scr, r, F.lane); continue; } r -= I_G;
        if (r < I_G) { tr_item(AP(I_POST_WU) + fo, D, FF, FF, AP(I_POST_NORM) + l * D, (bf16*)(ws + W_GU1), 2, scr, r, F.lane); continue; } r -= I_G;
        if (r < I_G) { tr_item(AP(I_POST_WD) + fo, FF, D, D, nullptr, (bf16*)(ws + W_D1), 0, scr, r, F.lane); continue; } r -= I_G;
        if (r < I_IN) { tr_item(win, D, nin, ninp, AP(I_MIX_NORM) + l * D, (bf16*)(ws + W_IN), odd ? 0 : 3, scr, r, F.lane); continue; } r -= I_IN;
        tr_item(wout, D, D, D, nullptr, (bf16*)(ws + W_OUT), 0, scr, r, F.lane);
    }
}
__device__ __forceinline__ void prologue_rows(const Frame& F0) {
    const Frame F = relaunder(F0);
    unsigned char* ws = WSP();
    const int gw = F.bid * NWAVES + F.wave, NGW = F.G * NWAVES;
    bf16* XB = (bf16*)(ws + WS_XB); float* ssp = (float*)(ws + WS_SSP);
    for (int m = gw; m < M; m += NGW) {
        const GAS f32x4* xr = (const GAS f32x4*)(AP(I_X) + (size_t)m * D) + F.lane;
        GAS unsigned long long* o8 = (GAS unsigned long long*)(XB + (size_t)m * D) + F.lane;
        float s = 0.f;
#pragma unroll
        for (int j = 0; j < 4; ++j) { const f32x4 v = xr[64 * j]; s += (v.x * v.x + v.y * v.y) + (v.z * v.z + v.w * v.w);
            o8[64 * j] = (unsigned long long)pk2(v.x, v.y) | ((unsigned long long)pk2(v.z, v.w) << 32); }
        s = wave_sum(s);
        if (F.lane < 16) ssp[(size_t)m * 16 + F.lane] = (F.lane == 0) ? s : 0.f;
    }
    const int gt = F.bid * NTHREADS + F.tid, NGT = F.G * NTHREADS;
    float* rc = (float*)(ws + TAB_RC); float* rsn = (float*)(ws + TAB_RS); float* dc = (float*)(ws + TAB_DC); float* ds = (float*)(ws + TAB_DS);
    for (int e = gt; e < SEQ * 64; e += NGT) { const int t = e >> 6, i = e & 63; const float ang = (float)t * RET_FREQ[i];
        double rev = (double)ang * 0.15915494309189535; rev -= __builtin_rint(rev); const float r = (float)rev;
        rc[e] = __builtin_amdgcn_cosf(r); rsn[e] = __builtin_amdgcn_sinf(r); }
    for (int e = gt; e < SEQ * 8; e += NGT) { const int t = e >> 3, i = e & 7; const float ang = (float)t * ROPE_FREQ[i];
        double rev = (double)ang * 0.15915494309189535; rev -= __builtin_rint(rev); const float r = (float)rev;
        dc[e] = __builtin_amdgcn_cosf(r); ds[e] = __builtin_amdgcn_sinf(r); }
}

__device__ __forceinline__ void final_norm(const Frame& F0) {
    const Frame F = relaunder(F0);
    const int gw = F.bid * NWAVES + F.wave, NGW = F.G * NWAVES;
    const bf16* XBp = (const bf16*)(WSP() + WS_XB); float* out = OUTP(); const GAS f32x4* gr = (const GAS f32x4*)AP(I_FINAL);
    for (int m = gw; m < M; m += NGW) {
        const v4u w0 = *(const GAS v4u*)(XBp + (size_t)m * D + F.lane * 8), w1 = *(const GAS v4u*)(XBp + (size_t)m * D + 512 + F.lane * 8);
        float v[16]; float s = 0.f;
#pragma unroll
        for (int i = 0; i < 4; ++i) { v[2 * i] = bflo(w0[i]); v[2 * i + 1] = bfhi(w0[i]); v[8 + 2 * i] = bflo(w1[i]); v[8 + 2 * i + 1] = bfhi(w1[i]); }
#pragma unroll
        for (int i = 0; i < 16; ++i) s += v[i] * v[i];
        const float rstd = 1.0f / sqrtf(wave_sum(s) * (1.0f / D) + EPS);
        GAS f32x4* o = (GAS f32x4*)(out + (size_t)m * D);
#pragma unroll
        for (int hh = 0; hh < 2; ++hh)
#pragma unroll
            for (int q = 0; q < 2; ++q) { const int c4 = hh * 128 + F.lane * 2 + q; const f32x4 g = gr[c4];
                o[c4] = (f32x4){v[hh * 8 + q * 4] * rstd * g[0], v[hh * 8 + q * 4 + 1] * rstd * g[1], v[hh * 8 + q * 4 + 2] * rstd * g[2], v[hh * 8 + q * 4 + 3] * rstd * g[3]}; }
    }
}


__device__ __forceinline__ float silu_f(float g) { return g * __builtin_amdgcn_rcpf(1.0f + __builtin_amdgcn_exp2f(-1.4426950408889634f * g)); }
typedef float f32x16 __attribute__((ext_vector_type(16)));
typedef short s16x4 __attribute__((ext_vector_type(4)));
typedef float f32x2_t __attribute__((ext_vector_type(2)));
typedef __bf16 bf16x2_t __attribute__((ext_vector_type(2)));
#define MFMA32(a, b, c) __builtin_amdgcn_mfma_f32_32x32x16_bf16((a), (b), (c), 0, 0, 0)
__device__ __forceinline__ int crow(int reg, int h) { return (reg & 3) + 8 * (reg >> 2) + 4 * h; }
__device__ __forceinline__ unsigned cvtpk(float lo, float hi) { f32x2_t v = {lo, hi}; bf16x2_t b = __builtin_convertvector(v, bf16x2_t); return __builtin_bit_cast(unsigned, b); }
__device__ __forceinline__ bf16 cvt1(float v) { return (bf16)(cvtpk(v, 0.f) & 0xffffu); }
#define PACK_STEP(x, s) __builtin_bit_cast(bf16x8, (v4u){cvtpk((x)[8 * (s)], (x)[8 * (s) + 1]), cvtpk((x)[8 * (s) + 2], (x)[8 * (s) + 3]), cvtpk((x)[8 * (s) + 4], (x)[8 * (s) + 5]), cvtpk((x)[8 * (s) + 6], (x)[8 * (s) + 7])})
typedef const LAS unsigned char* lcp;
__device__ __forceinline__ int lndv(int v) { asm volatile("" : "+v"(v)); return v; }
__device__ __forceinline__ bf16x8 ld_row(lcp img, int P, int row0, int k0, int r, int h) { return *(const LAS bf16x8*)(img + (row0 + r) * P + (k0 + 8 * h) * 2); }
__device__ __forceinline__ bf16x8 ld_row_perm(lcp img, int P, int row0, int k0, int r, int h) {
    const s16x4 lo = *(const LAS s16x4*)(img + (row0 + r) * P + (k0 + 4 * h) * 2), hi = *(const LAS s16x4*)(img + (row0 + r) * P + (k0 + 8 + 4 * h) * 2);
    return __builtin_shufflevector(lo, hi, 0, 1, 2, 3, 4, 5, 6, 7); }
__device__ __forceinline__ s16x4 trd(lcp p) { return __builtin_bit_cast(s16x4, __builtin_amdgcn_ds_read_tr16_b64_v4i16((LAS s16x4*)p)); }
__device__ __forceinline__ bf16x8 ld_tr(lcp img, int P, int k0, int c0, int lane) {
    const int i16 = lane & 15, q = i16 >> 2, p = i16 & 3, blk = (lane >> 4) & 1, h = lane >> 5;
    lcp a = img + (k0 + 8 * h + q) * P + (c0 + 16 * blk + 4 * p) * 2;
    const s16x4 lo = trd(a), hi = trd(a + 4 * P);
    return __builtin_shufflevector(lo, hi, 0, 1, 2, 3, 4, 5, 6, 7); }
__device__ __forceinline__ bf16x8 ld_tr_perm(lcp img, int P, int k0, int c0, int lane) {
    const int i16 = lane & 15, q = i16 >> 2, p = i16 & 3, blk = (lane >> 4) & 1, h = lane >> 5;
    lcp a = img + (k0 + 4 * h + q) * P + (c0 + 16 * blk + 4 * p) * 2;
    const s16x4 lo = trd(a), hi = trd(a + 8 * P);
    return __builtin_shufflevector(lo, hi, 0, 1, 2, 3, 4, 5, 6, 7); }
template <int R, int C> __device__ __forceinline__ void tile_ld(v4u (&v)[R * C / 8 / NTHREADS], const bf16* g, size_t gp, int tid) {
    constexpr int CPR = C / 8, RS = NTHREADS / CPR;
    static_assert(NTHREADS % CPR == 0, "tile shape");
    const unsigned voff = (unsigned)((tid / CPR) * (int)gp + (tid % CPR) * 8) * 2u;
    const GAS unsigned char* gb = (const GAS unsigned char*)g;
#pragma unroll
    for (int i = 0; i < R * C / 8 / NTHREADS; ++i) v[i] = *(const GAS v4u*)(gb + (size_t)i * RS * gp * 2 + voff);
}
template <int R, int C> __device__ __forceinline__ void tile_st(const v4u (&v)[R * C / 8 / NTHREADS], LAS unsigned char* img, int P, int tid) {
    constexpr int CPR = C / 8, RS = NTHREADS / CPR;
    LAS unsigned char* lb = img + (tid / CPR) * P + (tid % CPR) * 16;
#pragma unroll
    for (int i = 0; i < R * C / 8 / NTHREADS; ++i) *(LAS v4u*)(lb + i * RS * P) = v[i];
}
template <int R, int C> __device__ __forceinline__ void stage_tile(LAS unsigned char* img, int P, const bf16* g, size_t gp, int tid) { v4u t_[R * C / 8 / NTHREADS]; tile_ld<R, C>(t_, g, gp, tid); tile_st<R, C>(t_, img, P, tid); }
#define WG_BAR() do { asm volatile("s_waitcnt lgkmcnt(0)" ::: "memory"); __builtin_amdgcn_s_barrier(); asm volatile("" ::: "memory"); } while (0)

constexpr int PR = 272, PT = 320, PT256 = 576, PO256 = 528;
constexpr size_t WS_DEC = 6 * MiB;
constexpr float LOG2E = 1.4426950408889634f, LN2 = 0.6931471805599453f;
__device__ __forceinline__ void gla_cumsum(float (&Bc)[2][16], float& Blast, lcp AL, lcp W2, const LAS float* BA, LAS float* EX, int wave, int lane) {
    const int r = lane & 31, h = lane >> 5, db = wave & 3, jh = wave >> 2;
    const bf16x8 wf = *(const LAS bf16x8*)(W2 + (db * 32 + r) * 32 + h * 16);
    const float bias = BA[db * 32 + r];
    float run = 0.f;
#pragma unroll
    for (int t = 0; t < 2; ++t) {
        const bf16x8 af = *(const LAS bf16x8*)(AL + ((jh * 2 + t) * 32 + r) * 32 + h * 16);
        f32x16 z = {0.f, 0.f, 0.f, 0.f, 0.f, 0.f, 0.f, 0.f, 0.f, 0.f, 0.f, 0.f, 0.f, 0.f, 0.f, 0.f};
        z = MFMA32(af, wf, z);
        float own[4], oth[4];
#pragma unroll
        for (int g = 0; g < 4; ++g) {
            float acc = 0.f;
#pragma unroll
            for (int i = 0; i < 4; ++i) { const float zz = z[4 * g + i] + bias;
                const float la = (fminf(zz, 0.f) - LN2 * __builtin_amdgcn_logf(1.0f + __builtin_amdgcn_exp2f(-fabsf(zz) * LOG2E))) * (1.0f / 16.0f);
                acc += la; Bc[t][4 * g + i] = acc; }
            own[g] = acc; oth[g] = oth32(acc, h);
        }
#pragma unroll
        for (int g = 0; g < 4; ++g) { const float off = run + (h ? oth[g] : 0.f);
#pragma unroll
            for (int i = 0; i < 4; ++i) Bc[t][4 * g + i] += off;
            run += own[g] + oth[g]; }
    }
    if (h == 0) EX[jh * 128 + db * 32 + r] = run;
    WG_BAR();
    const float t0 = EX[db * 32 + r], t1 = EX[128 + db * 32 + r];
    Blast = t0 + t1;
    if (jh == 1) {
#pragma unroll
        for (int t = 0; t < 2; ++t)
#pragma unroll
            for (int i = 0; i < 16; ++i) Bc[t][i] += t0; }
}
constexpr int GA_KI = 0, GA_VI = GA_KI + 128 * PR, GA_KD = GA_VI + 128 * PT256, GA_AL = GA_KD + 128 * PT, GA_W2 = GA_AL + 4096, GA_BA = GA_W2 + 4096, GA_EX = GA_BA + 512, GA_END = GA_EX + 1024;
constexpr int GA_OI = GA_VI;
constexpr int GC_QT = 0, GC_KT = GC_QT + 128 * PR, GC_SI = GC_KT + 128 * PR, GC_VI = GC_SI + 128 * PT, GC_AL = GC_VI + 128 * PT, GC_W2 = GC_AL + 4096, GC_BA = GC_W2 + 4096, GC_EX = GC_BA + 512, GC_END = GC_EX + 1024;
constexpr int GC_OI = 0;
static_assert(GA_END <= LDSCTL_OFF && GC_END <= LDSCTL_OFF && 128 * PO256 <= GC_SI && 128 * PO256 <= 128 * PT256, "GLA LDS maps");
__device__ __forceinline__ void gla_stage_w(const Frame& F, LAS unsigned char* W2, LAS float* BA, int li, int h) {
    if (F.tid < 128) { const int d = F.tid; const GAS float* w2 = (const GAS float*)AP(I_GLA_A2) + (size_t)li * 16 * 512 + h * 128 + d;
        v4u lo, hi; lo.x = cvtpk(w2[0], w2[512]); lo.y = cvtpk(w2[2 * 512], w2[3 * 512]); lo.z = cvtpk(w2[4 * 512], w2[5 * 512]); lo.w = cvtpk(w2[6 * 512], w2[7 * 512]);
        hi.x = cvtpk(w2[8 * 512], w2[9 * 512]); hi.y = cvtpk(w2[10 * 512], w2[11 * 512]); hi.z = cvtpk(w2[12 * 512], w2[13 * 512]); hi.w = cvtpk(w2[14 * 512], w2[15 * 512]);
        *(LAS v4u*)(W2 + d * 32) = lo; *(LAS v4u*)(W2 + d * 32 + 16) = hi; }
    else if (F.tid < 256) { const int d = F.tid - 128; BA[d] = ((const GAS float*)AP(I_GLA_BA))[(size_t)li * 512 + h * 128 + d]; }
}
__device__ __forceinline__ v4u gla_ld_alow(int tid, const bf16* Prow0) { const int t = tid & 255; return *(const GAS v4u*)(Prow0 + (size_t)(t >> 1) * GLA_INP + G_A + (t & 1) * 8); }
__device__ __forceinline__ void gla_st_alow(int tid, v4u v, LAS unsigned char* AL) { if (tid < 256) *(LAS v4u*)(AL + (tid >> 1) * 32 + (tid & 1) * 16) = v; }

__device__ __forceinline__ void gla_phase_a(const Frame& F0, int li) {
    const Frame F = relaunder(F0);
    unsigned char* ws = WSP();
    const bf16* P = (const bf16*)(ws + WS_ACT); bf16* SKV = (bf16*)OUTP(); float* DEC = (float*)(ws + WS_DEC);
    LAS unsigned char* L = F.lds;
    const int wave = F.wave, db = wave & 3, jh = wave >> 2;
    v4u kR[4], vR[8], aR; int hcur = -1;
    {   const int it = F.bid; if (it < 1024) { const int bh = it >> 5, g = it & 31; const bf16* Prow0 = P + ((size_t)(bh >> 2) * SEQ + g * 128) * GLA_INP;
            tile_ld<128, 128>(kR, Prow0 + G_K + (bh & 3) * 128, GLA_INP, F.tid); tile_ld<128, 256>(vR, Prow0 + G_V + (bh & 3) * 256, GLA_INP, F.tid); aR = gla_ld_alow(F.tid, Prow0); } }
    for (int it = F.bid; it < 1024; it += F.G) {
        const int bh = it >> 5, h = bh & 3;
        const int lane = lndv(F.lane), r = lane & 31, h2 = lane >> 5;
        tile_st<128, 128>(kR, L + GA_KI, PR, F.tid); tile_st<128, 256>(vR, L + GA_VI, PT256, F.tid); gla_st_alow(F.tid, aR, L + GA_AL);
        if (h != hcur) { gla_stage_w(F, L + GA_W2, (LAS float*)(L + GA_BA), li, h); hcur = h; }
        WG_BAR();
        {   const int nx = it + F.G; if (nx < 1024) { const int bh2 = nx >> 5, g2 = nx & 31; const bf16* Pn = P + ((size_t)(bh2 >> 2) * SEQ + g2 * 128) * GLA_INP;
                tile_ld<128, 128>(kR, Pn + G_K + (bh2 & 3) * 128, GLA_INP, F.tid); tile_ld<128, 256>(vR, Pn + G_V + (bh2 & 3) * 256, GLA_INP, F.tid); aR = gla_ld_alow(F.tid, Pn); } }
        float Bc[2][16], Blast;
        gla_cumsum(Bc, Blast, L + GA_AL, L + GA_W2, (const LAS float*)(L + GA_BA), (LAS float*)(L + GA_EX), wave, lane);
#pragma unroll
        for (int t = 0; t < 2; ++t)
#pragma unroll
            for (int i = 0; i < 16; ++i) { const int row = (jh * 2 + t) * 32 + crow(i, h2), col = db * 32 + r;
                const float kv = bf2f(*(const LAS bf16*)(L + GA_KI + row * PR + col * 2)) * __builtin_amdgcn_exp2f((Blast - Bc[t][i]) * LOG2E);
                *(LAS bf16*)(L + GA_KD + row * PT + col * 2) = cvt1(kv); }
        if (jh == 0 && h2 == 0) DEC[(size_t)it * 128 + db * 32 + r] = __builtin_amdgcn_exp2f(Blast * LOG2E);
        WG_BAR();
        f32x16 acc[4];
#pragma unroll
        for (int t = 0; t < 4; ++t) acc[t] = (f32x16){0.f, 0.f, 0.f, 0.f, 0.f, 0.f, 0.f, 0.f, 0.f, 0.f, 0.f, 0.f, 0.f, 0.f, 0.f, 0.f};
#pragma unroll
        for (int ks = 0; ks < 8; ++ks) { const bf16x8 a = ld_tr(L + GA_KD, PT, 16 * ks, db * 32, lane);
#pragma unroll
            for (int t = 0; t < 4; ++t) acc[t] = MFMA32(a, ld_tr(L + GA_VI, PT256, 16 * ks, (4 * jh + t) * 32, lane), acc[t]); }
        WG_BAR();
#pragma unroll
        for (int t = 0; t < 4; ++t)
#pragma unroll
            for (int i = 0; i < 16; ++i) *(LAS bf16*)(L + GA_OI + (db * 32 + crow(i, h2)) * PO256 + ((4 * jh + t) * 32 + r) * 2) = cvt1(acc[t][i]);
        WG_BAR();
        {   bf16* out = SKV + (size_t)it * 128 * 256;
#pragma unroll
            for (int i = 0; i < 8; ++i) { const int c = F.tid + i * NTHREADS, row = c >> 5, cc = c & 31; *(GAS v4u*)(out + row * 256 + cc * 8) = *(const LAS v4u*)(L + GA_OI + row * PO256 + cc * 16); } }
        WG_BAR();
    }
}
__device__ __forceinline__ void gla_phase_b(const Frame& F0) {
    const Frame F = relaunder(F0);
    unsigned char* ws = WSP();
    bf16* SKV = (bf16*)OUTP(); const float* DEC = (const float*)(ws + WS_DEC);
    for (int gt = F.bid * NTHREADS + F.tid; gt < 32 * 128 * 32; gt += F.G * NTHREADS) {
        const int bh = gt >> 12, d = (gt >> 5) & 127, e8 = gt & 31;
        float s[8];
#pragma unroll
        for (int i = 0; i < 8; ++i) s[i] = 0.f;
        for (int g0 = 0; g0 < 32; g0 += 8) {
            v4u kv[8]; float dc[8];
#pragma unroll
            for (int u = 0; u < 8; ++u) { const size_t item = (size_t)bh * 32 + g0 + u; kv[u] = *(const GAS v4u*)(SKV + (item * 128 + d) * 256 + e8 * 8); dc[u] = ((const GAS float*)DEC)[item * 128 + d]; }
#pragma unroll
            for (int u = 0; u < 8; ++u) { const size_t item = (size_t)bh * 32 + g0 + u;
                v4u o; o.x = cvtpk(s[0], s[1]); o.y = cvtpk(s[2], s[3]); o.z = cvtpk(s[4], s[5]); o.w = cvtpk(s[6], s[7]);
                *(GAS v4u*)(SKV + (item * 128 + d) * 256 + e8 * 8) = o;
#pragma unroll
                for (int i = 0; i < 4; ++i) { s[2 * i] = dc[u] * s[2 * i] + bflo(kv[u][i]); s[2 * i + 1] = dc[u] * s[2 * i + 1] + bfhi(kv[u][i]); } }
        }
    }
}
__device__ __forceinline__ void gla_phase_c(const Frame& F0, int li) {
    const Frame F = relaunder(F0);
    unsigned char* ws = WSP();
    const bf16* P = (const bf16*)(ws + WS_ACT); const bf16* SKV = (const bf16*)OUTP(); bf16* CAT = (bf16*)(ws + WS_CAT);
    LAS unsigned char* L = F.lds;
    const int wave = F.wave, db = wave & 3, jh = wave >> 2;
    const int ib = wave & 3, eq = wave >> 2;
    v4u qR[4], kR[4], aR; int hcur = -1;
    {   const int it = F.bid; if (it < 1024) { const int bh = it >> 5, g = it & 31, h = bh & 3; const bf16* Prow0 = P + ((size_t)(bh >> 2) * SEQ + g * 128) * GLA_INP;
            tile_ld<128, 128>(qR, Prow0 + G_Q + h * 128, GLA_INP, F.tid); tile_ld<128, 128>(kR, Prow0 + G_K + h * 128, GLA_INP, F.tid); aR = gla_ld_alow(F.tid, Prow0); } }
    for (int it = F.bid; it < 1024; it += F.G) {
        const int bh = it >> 5, g = it & 31, b = bh >> 2, h = bh & 3;
        const int tidl = lndv(F.tid), lane = tidl & 63, r = lane & 31, h2 = lane >> 5;
        const bf16* Prow0 = P + ((size_t)b * SEQ + g * 128) * GLA_INP;
        const bf16* Sg = SKV + (size_t)it * 128 * 256;
        {   v4u sR[4], vR[4]; tile_ld<128, 128>(sR, Sg, 256, tidl); tile_ld<128, 128>(vR, Prow0 + G_V + h * 256, GLA_INP, tidl);
            tile_st<128, 128>(qR, L + GC_QT, PR, tidl); tile_st<128, 128>(kR, L + GC_KT, PR, tidl); tile_st<128, 128>(sR, L + GC_SI, PT, tidl); tile_st<128, 128>(vR, L + GC_VI, PT, tidl); }
        gla_st_alow(tidl, aR, L + GC_AL);
        if (h != hcur) { gla_stage_w(F, L + GC_W2, (LAS float*)(L + GC_BA), li, h); hcur = h; }
        WG_BAR();
        {
            float Bc[2][16], Blast;
            gla_cumsum(Bc, Blast, L + GC_AL, L + GC_W2, (const LAS float*)(L + GC_BA), (LAS float*)(L + GC_EX), wave, lane);
#pragma unroll
            for (int t = 0; t < 2; ++t)
#pragma unroll
                for (int i = 0; i < 16; ++i) { const int off = ((jh * 2 + t) * 32 + crow(i, h2)) * PR + (db * 32 + r) * 2;
                    const float eb = __builtin_amdgcn_exp2f(Bc[t][i] * LOG2E);
                    const float qv = bf2f(*(const LAS bf16*)(L + GC_QT + off)) * eb * 0.08838834764831845f;
                    const float kv = bf2f(*(const LAS bf16*)(L + GC_KT + off)) * __builtin_amdgcn_rcpf(eb);
                    *(LAS bf16*)(L + GC_QT + off) = cvt1(qv); *(LAS bf16*)(L + GC_KT + off) = cvt1(kv); }
        }
        WG_BAR();
        bf16x8 PA[4][2];
#pragma unroll
        for (int jb = 0; jb < 4; ++jb) {
            if (jb <= ib) {
                f32x16 x = {0.f, 0.f, 0.f, 0.f, 0.f, 0.f, 0.f, 0.f, 0.f, 0.f, 0.f, 0.f, 0.f, 0.f, 0.f, 0.f};
#pragma unroll
                for (int ks = 0; ks < 8; ++ks) x = MFMA32(ld_row(L + GC_KT, PR, jb * 32, 16 * ks, r, h2), ld_row(L + GC_QT, PR, ib * 32, 16 * ks, r, h2), x);
                if (jb == ib) {
#pragma unroll
                    for (int i = 0; i < 16; ++i) if (crow(i, h2) > r) x[i] = 0.f; }
                PA[jb][0] = PACK_STEP(x, 0); PA[jb][1] = PACK_STEP(x, 1);
            } else { PA[jb][0] = (bf16x8){0, 0, 0, 0, 0, 0, 0, 0}; PA[jb][1] = (bf16x8){0, 0, 0, 0, 0, 0, 0, 0}; }
        }
        f32x16 o[2][2];
#pragma unroll
        for (int half = 0; half < 2; ++half) {
            if (half == 1) {
                WG_BAR();
                stage_tile<128, 128>(L + GC_SI, PT, Sg + 128, 256, tidl); stage_tile<128, 128>(L + GC_VI, PT, Prow0 + G_V + h * 256 + 128, GLA_INP, tidl);
                WG_BAR();
            }
#pragma unroll
            for (int t = 0; t < 2; ++t) {
                const int eb = 2 * eq + t;
                f32x16 acc = {0.f, 0.f, 0.f, 0.f, 0.f, 0.f, 0.f, 0.f, 0.f, 0.f, 0.f, 0.f, 0.f, 0.f, 0.f, 0.f};
#pragma unroll
                for (int jb = 0; jb < 4; ++jb) if (jb <= ib) {
#pragma unroll
                    for (int s = 0; s < 2; ++s) acc = MFMA32(PA[jb][s], ld_tr_perm(L + GC_VI, PT, jb * 32 + 16 * s, eb * 32, lane), acc); }
#pragma unroll
                for (int ks = 0; ks < 8; ++ks) acc = MFMA32(ld_row(L + GC_QT, PR, ib * 32, 16 * ks, r, h2), ld_tr(L + GC_SI, PT, 16 * ks, eb * 32, lane), acc);
                o[half][t] = acc;
            }
        }
        WG_BAR();
#pragma unroll
        for (int half = 0; half < 2; ++half)
#pragma unroll
            for (int t = 0; t < 2; ++t)
#pragma unroll
                for (int i = 0; i < 16; ++i) *(LAS bf16*)(L + GC_OI + (ib * 32 + crow(i, h2)) * PO256 + (half * 128 + (2 * eq + t) * 32 + r) * 2) = cvt1(o[half][t][i]);
        WG_BAR();
        {   const int nx = (it + F.G < 1024) ? it + F.G : it;
            const int bh2 = nx >> 5, g2 = nx & 31, hn = bh2 & 3; const bf16* Pn = P + ((size_t)(bh2 >> 2) * SEQ + g2 * 128) * GLA_INP;
            tile_ld<128, 128>(qR, Pn + G_Q + hn * 128, GLA_INP, tidl); tile_ld<128, 128>(kR, Pn + G_K + hn * 128, GLA_INP, tidl); aR = gla_ld_alow(tidl, Pn); }
        {
            const int tid2 = lndv(tidl), row = tid2 >> 2, qtr = tid2 & 3;
            lcp orow = L + GC_OI + row * PO256 + qtr * 128;
            const bf16* gp = Prow0 + (size_t)row * GLA_INP + G_R + h * 256 + qtr * 64;
            float sum = 0.f;
#pragma unroll
            for (int c = 0; c < 8; ++c) { const v4u w = *(const LAS v4u*)(orow + c * 16);
#pragma unroll
                for (int i = 0; i < 4; ++i) sum += bflo(w[i]) + bfhi(w[i]); }
            sum += xsw<1>(sum); sum += xsw<2>(sum);
            const float mu = sum * (1.0f / 256.0f); float sq = 0.f;
#pragma unroll
            for (int c = 0; c < 8; ++c) { const v4u w = *(const LAS v4u*)(orow + c * 16);
#pragma unroll
                for (int i = 0; i < 4; ++i) { const float d0 = bflo(w[i]) - mu, d1 = bfhi(w[i]) - mu; sq += d0 * d0 + d1 * d1; } }
            sq += xsw<1>(sq); sq += xsw<2>(sq);
            const float rstd = 1.0f / sqrtf(sq * (1.0f / 256.0f) + EPS);
            bf16* op = CAT + ((size_t)b * SEQ + g * 128 + row) * D + h * 256 + qtr * 64;
#pragma unroll
            for (int c = 0; c < 8; ++c) { const v4u gw = *(const GAS v4u*)(gp + c * 8); const v4u w = *(const LAS v4u*)(orow + c * 16); v4u ow;
#pragma unroll
                for (int i = 0; i < 4; ++i) { const float g0 = bflo(gw[i]), g1 = bfhi(gw[i]);
                    ow[i] = cvtpk((bflo(w[i]) - mu) * rstd * silu_f(g0), (bfhi(w[i]) - mu) * rstd * silu_f(g1)); }
                *(GAS v4u*)(op + c * 8) = ow; }
        }
        WG_BAR();
    }
}


constexpr size_t WS_OD = 408 * MiB;
constexpr size_t OUT_LSE = 32 * MiB;
constexpr size_t WS_END2 = 504 * MiB;
constexpr int RA_KI = 0, RA_VD = RA_KI + 128 * PT, RA_END = RA_VD + 128 * PT;
constexpr int RC_QI = 0, RC_KI = RC_QI + 128 * PR, RC_VI = RC_KI + 128 * PR, RC_SI = RC_VI + 128 * PT, RC_END = RC_SI + 128 * PT;
constexpr int DPK = 144, DPV = 192;
constexpr int DL_KI = 0, DL_VI = DL_KI + 384 * DPK, DL_LW = DL_VI + 384 * DPV, DL_END = DL_LW + 8 * 256;
constexpr int DL_ST = DL_KI;
static_assert(RC_END <= LDSCTL_OFF && DL_END <= LDSCTL_OFF && 8 * 32 * DPK <= 384 * DPK, "even mixer LDS maps");
__device__ __forceinline__ float ret_log2g(int h) { return log2f(1.0f - exp2f(-5.0f - (float)h)); }

__device__ __forceinline__ void ret_phase_a_items(const Frame& F, const bf16* P, bf16* RKV) {
    LAS unsigned char* L = F.lds;
    const int wave = F.wave, db = wave & 3, eh = wave >> 2;
    v4u kR[4], vR[4];
    {   const int it = F.bid < 1024 ? F.bid : 0; const int bh = it >> 5, n = it & 31; const bf16* Prow0 = P + ((size_t)(bh >> 2) * SEQ + n * 128) * EVEN_IN;
        tile_ld<128, 128>(kR, Prow0 + E_RK + (bh & 3) * 128, EVEN_IN, F.tid); tile_ld<128, 128>(vR, Prow0 + E_RV + (bh & 3) * 128, EVEN_IN, F.tid); }
    for (int it = F.bid; it < 1024; it += F.G) {
        const int tidl = lndv(F.tid), lane = tidl & 63, r = lane & 31, h2 = lane >> 5;
        const int bh = it >> 5, h = bh & 3;
        const float lg = ret_log2g(h);
        tile_st<128, 128>(kR, L + RA_KI, PT, tidl);
        {
#pragma unroll
            for (int i = 0; i < 4; ++i) { const int row = (tidl >> 4) + 32 * i, cc = tidl & 15; const float f = __builtin_amdgcn_exp2f(lg * (float)(127 - row)); v4u o;
#pragma unroll
                for (int k = 0; k < 4; ++k) o[k] = cvtpk(bflo(vR[i][k]) * f, bfhi(vR[i][k]) * f);
                *(LAS v4u*)(L + RA_VD + row * PT + cc * 16) = o; }
        }
        WG_BAR();
        {   const int nx = (it + F.G < 1024) ? it + F.G : it; const int bh2 = nx >> 5, n2 = nx & 31; const bf16* Pn = P + ((size_t)(bh2 >> 2) * SEQ + n2 * 128) * EVEN_IN;
            tile_ld<128, 128>(kR, Pn + E_RK + (bh2 & 3) * 128, EVEN_IN, tidl); tile_ld<128, 128>(vR, Pn + E_RV + (bh2 & 3) * 128, EVEN_IN, tidl); }
        f32x16 acc[2];
#pragma unroll
        for (int t = 0; t < 2; ++t) acc[t] = (f32x16){0.f, 0.f, 0.f, 0.f, 0.f, 0.f, 0.f, 0.f, 0.f, 0.f, 0.f, 0.f, 0.f, 0.f, 0.f, 0.f};
#pragma unroll
        for (int ks = 0; ks < 8; ++ks) { const bf16x8 a = ld_tr(L + RA_KI, PT, 16 * ks, db * 32, lane);
#pragma unroll
            for (int t = 0; t < 2; ++t) acc[t] = MFMA32(a, ld_tr(L + RA_VD, PT, 16 * ks, (2 * eh + t) * 32, lane), acc[t]); }
        WG_BAR();
#pragma unroll
        for (int t = 0; t < 2; ++t)
#pragma unroll
            for (int i = 0; i < 16; ++i) *(LAS bf16*)(L + RA_KI + (db * 32 + crow(i, h2)) * PR + ((2 * eh + t) * 32 + r) * 2) = cvt1(acc[t][i]);
        WG_BAR();
        bf16* out = RKV + (size_t)it * 128 * 128;
#pragma unroll
        for (int i = 0; i < 4; ++i) { const int row = (tidl >> 4) + 32 * i, cc = tidl & 15; *(GAS v4u*)(out + row * 128 + cc * 8) = *(const LAS v4u*)(L + RA_KI + row * PR + cc * 16); }
        WG_BAR();
    }
}
__device__ __forceinline__ void ret_scan(const Frame& F, bf16* RKV) {
    for (int gt = F.bid * NTHREADS + F.tid; gt < 32 * 128 * 16; gt += F.G * NTHREADS) {
        const int bh = gt >> 11, d = (gt >> 4) & 127, e8 = gt & 15, h = bh & 3;
        const float g128 = __builtin_amdgcn_exp2f(ret_log2g(h) * 128.0f);
        float s[8];
#pragma unroll
        for (int i = 0; i < 8; ++i) s[i] = 0.f;
        for (int n0 = 0; n0 < 32; n0 += 4) {
            v4u kv[4];
#pragma unroll
            for (int u = 0; u < 4; ++u) kv[u] = *(const GAS v4u*)(RKV + (((size_t)bh * 32 + n0 + u) * 128 + d) * 128 + e8 * 8);
#pragma unroll
            for (int u = 0; u < 4; ++u) {
                v4u o; o.x = cvtpk(s[0], s[1]); o.y = cvtpk(s[2], s[3]); o.z = cvtpk(s[4], s[5]); o.w = cvtpk(s[6], s[7]);
                *(GAS v4u*)(RKV + (((size_t)bh * 32 + n0 + u) * 128 + d) * 128 + e8 * 8) = o;
#pragma unroll
                for (int i = 0; i < 4; ++i) { s[2 * i] = g128 * s[2 * i] + bflo(kv[u][i]); s[2 * i + 1] = g128 * s[2 * i + 1] + bfhi(kv[u][i]); } }
        }
    }
}
__device__ __forceinline__ void ret_phase_c_items(const Frame& F, const bf16* P, const bf16* RKV, bf16* CAT) {
    LAS unsigned char* L = F.lds;
    const int wave = F.wave, ib = wave & 3, eq = wave >> 2;
    v4u qR[4], kR[4];
    {   const int it = F.bid < 1024 ? F.bid : 0; const int bh = it >> 5, n = it & 31; const bf16* Prow0 = P + ((size_t)(bh >> 2) * SEQ + n * 128) * EVEN_IN;
        tile_ld<128, 128>(qR, Prow0 + E_RQ + (bh & 3) * 128, EVEN_IN, F.tid); tile_ld<128, 128>(kR, Prow0 + E_RK + (bh & 3) * 128, EVEN_IN, F.tid); }
    for (int it = F.bid; it < 1024; it += F.G) {
        const int tidl = lndv(F.tid), lane = tidl & 63, r = lane & 31, h2 = lane >> 5;
        const int bh = it >> 5, n = it & 31, b = bh >> 2, h = bh & 3;
        const float lg = ret_log2g(h);
        const bf16* Prow0 = P + ((size_t)b * SEQ + n * 128) * EVEN_IN;
        {   v4u vR[4], sR[4]; tile_ld<128, 128>(vR, Prow0 + E_RV + h * 128, EVEN_IN, tidl); tile_ld<128, 128>(sR, RKV + (size_t)it * 128 * 128, 128, tidl);
#pragma unroll
            for (int i = 0; i < 4; ++i) { const int row = (tidl >> 4) + 32 * i, cc = tidl & 15; const float fq = __builtin_amdgcn_exp2f(lg * (float)row), fk = __builtin_amdgcn_rcpf(fq); v4u oq, ok;
#pragma unroll
                for (int k = 0; k < 4; ++k) { oq[k] = cvtpk(bflo(qR[i][k]) * fq, bfhi(qR[i][k]) * fq); ok[k] = cvtpk(bflo(kR[i][k]) * fk, bfhi(kR[i][k]) * fk); }
                *(LAS v4u*)(L + RC_QI + row * PR + cc * 16) = oq; *(LAS v4u*)(L + RC_KI + row * PR + cc * 16) = ok; }
            tile_st<128, 128>(vR, L + RC_VI, PT, tidl); tile_st<128, 128>(sR, L + RC_SI, PT, tidl); }
        WG_BAR();
        bf16x8 PA[4][2];
#pragma unroll
        for (int jb = 0; jb < 4; ++jb) {
            if (jb <= ib) {
                f32x16 x = {0.f, 0.f, 0.f, 0.f, 0.f, 0.f, 0.f, 0.f, 0.f, 0.f, 0.f, 0.f, 0.f, 0.f, 0.f, 0.f};
#pragma unroll
                for (int ks = 0; ks < 8; ++ks) x = MFMA32(ld_row(L + RC_KI, PR, jb * 32, 16 * ks, r, h2), ld_row(L + RC_QI, PR, ib * 32, 16 * ks, r, h2), x);
                if (jb == ib) {
#pragma unroll
                    for (int i = 0; i < 16; ++i) if (crow(i, h2) > r) x[i] = 0.f; }
                PA[jb][0] = PACK_STEP(x, 0); PA[jb][1] = PACK_STEP(x, 1);
            } else { PA[jb][0] = (bf16x8){0, 0, 0, 0, 0, 0, 0, 0}; PA[jb][1] = (bf16x8){0, 0, 0, 0, 0, 0, 0, 0}; }
        }
        f32x16 o[2];
#pragma unroll
        for (int t = 0; t < 2; ++t) {
            const int eb = 2 * eq + t;
            f32x16 z = {0.f, 0.f, 0.f, 0.f, 0.f, 0.f, 0.f, 0.f, 0.f, 0.f, 0.f, 0.f, 0.f, 0.f, 0.f, 0.f}, y = z;
#pragma unroll
            for (int jb = 0; jb < 4; ++jb) if (jb <= ib) {
#pragma unroll
                for (int s = 0; s < 2; ++s) z = MFMA32(PA[jb][s], ld_tr_perm(L + RC_VI, PT, jb * 32 + 16 * s, eb * 32, lane), z); }
#pragma unroll
            for (int ks = 0; ks < 8; ++ks) y = MFMA32(ld_row(L + RC_QI, PR, ib * 32, 16 * ks, r, h2), ld_tr(L + RC_SI, PT, 16 * ks, eb * 32, lane), y);
            const float g1 = __builtin_amdgcn_exp2f(lg);
#pragma unroll
            for (int i = 0; i < 16; ++i) z[i] += y[i] * g1;
            o[t] = z;
        }
        WG_BAR();
#pragma unroll
        for (int t = 0; t < 2; ++t)
#pragma unroll
            for (int i = 0; i < 16; ++i) *(LAS bf16*)(L + RC_QI + (ib * 32 + crow(i, h2)) * PR + ((2 * eq + t) * 32 + r) * 2) = cvt1(o[t][i]);
        WG_BAR();
        {   const int nx = (it + F.G < 1024) ? it + F.G : it; const int bh2 = nx >> 5, n2 = nx & 31; const bf16* Pn = P + ((size_t)(bh2 >> 2) * SEQ + n2 * 128) * EVEN_IN;
            tile_ld<128, 128>(qR, Pn + E_RQ + (bh2 & 3) * 128, EVEN_IN, tidl); tile_ld<128, 128>(kR, Pn + E_RK + (bh2 & 3) * 128, EVEN_IN, tidl); }
        {
            const int tid2 = lndv(tidl), row = tid2 >> 2, qtr = tid2 & 3;
            lcp orow = L + RC_QI + row * PR + qtr * 64;
            v4u w[4]; float sum = 0.f;
#pragma unroll
            for (int c = 0; c < 4; ++c) { w[c] = *(const LAS v4u*)(orow + c * 16);
#pragma unroll
                for (int i = 0; i < 4; ++i) sum += bflo(w[c][i]) + bfhi(w[c][i]); }
            sum += xsw<1>(sum); sum += xsw<2>(sum);
            const float mu = sum * (1.0f / 128.0f); float sq = 0.f;
#pragma unroll
            for (int c = 0; c < 4; ++c)
#pragma unroll
                for (int i = 0; i < 4; ++i) { const float d0 = bflo(w[c][i]) - mu, d1 = bfhi(w[c][i]) - mu; sq += d0 * d0 + d1 * d1; }
            sq += xsw<1>(sq); sq += xsw<2>(sq);
            const float rstd = 1.0f / sqrtf(sq * (1.0f / 128.0f) + EPS);
            const bf16* gp = Prow0 + (size_t)row * EVEN_IN + E_RG + h * 128 + qtr * 32;
            bf16* op = CAT + ((size_t)b * SEQ + n * 128 + row) * D + h * 128 + qtr * 32;
#pragma unroll
            for (int c = 0; c < 4; ++c) { const v4u gw = *(const GAS v4u*)(gp + c * 8); v4u ow;
#pragma unroll
                for (int i = 0; i < 4; ++i) { const float g0 = bflo(gw[i]), g1 = bfhi(gw[i]);
                    ow[i] = cvtpk((bflo(w[c][i]) - mu) * rstd * silu_f(g0), (bfhi(w[c][i]) - mu) * rstd * silu_f(g1)); }
                *(GAS v4u*)(op + c * 8) = ow; }
        }
        WG_BAR();
    }
}
struct DilTile { int b, head, p, dil, res, q0; };
__device__ __forceinline__ DilTile dil_decode(int T) { DilTile t; t.b = T / 384; const int rem = T - t.b * 384; t.head = rem / 48; const int t48 = rem - t.head * 48; t.p = t48 >> 4; const int idx = t48 & 15, sh = 2 * t.p;
    t.dil = 1 << sh; t.res = idx & (t.dil - 1); t.q0 = (idx >> sh) * 256; return t; }
__device__ __forceinline__ void dil_ld(v4u (&kR)[6], v4u (&vR)[6], const DilTile& t, const bf16* P, int tid) {
    const bf16* Pb = P + (size_t)t.b * SEQ * EVEN_IN + t.head * 64 + (tid & 7) * 8;
#pragma unroll
    for (int i = 0; i < 6; ++i) { int kidx = t.q0 - 128 + (tid >> 3) + 64 * i; kidx = kidx < 0 ? 0 : kidx;
        const bf16* src = Pb + (size_t)(kidx * t.dil + t.res) * EVEN_IN; kR[i] = *(const GAS v4u*)(src + E_DK); vR[i] = *(const GAS v4u*)(src + E_DV); }
}
__device__ __forceinline__ void dil_tiles(const Frame& F, int T0, int T1, int step, const bf16* P, bf16* OD, float* LSE) {
    LAS unsigned char* L = F.lds;
    const int wave = F.wave;
    if (T0 >= T1) return;
    v4u kR[6], vR[6];
    { const DilTile t0 = dil_decode(T0); dil_ld(kR, vR, t0, P, F.tid); }
    for (int T = T0; T < T1; T += step) {
        const int tidl = lndv(F.tid), lane = tidl & 63, r = lane & 31, h2 = lane >> 5;
        const DilTile t = dil_decode(T);
        const bf16* Pb = P + (size_t)t.b * SEQ * EVEN_IN + t.head * 64;
#pragma unroll
        for (int i = 0; i < 6; ++i) { const int row = (tidl >> 3) + 64 * i, cc = tidl & 7; *(LAS v4u*)(L + DL_KI + row * DPK + cc * 16) = kR[i]; *(LAS v4u*)(L + DL_VI + row * DPV + cc * 16) = vR[i]; }
        bf16x8 qf[4];
        { const bf16* qsrc = Pb + (size_t)((t.q0 + 32 * wave + r) * t.dil + t.res) * EVEN_IN + E_DQ + 8 * h2;
#pragma unroll
          for (int ks = 0; ks < 4; ++ks) qf[ks] = *(const GAS bf16x8*)(qsrc + 16 * ks); }
        WG_BAR();
        { const DilTile tn = dil_decode(T + step < T1 ? T + step : T); dil_ld(kR, vR, tn, P, tidl); }
        f32x16 x[5];
        float mx = -INFINITY;
#pragma unroll
        for (int kb = 0; kb < 5; ++kb) {
            f32x16 a = {0.f, 0.f, 0.f, 0.f, 0.f, 0.f, 0.f, 0.f, 0.f, 0.f, 0.f, 0.f, 0.f, 0.f, 0.f, 0.f};
#pragma unroll
            for (int ks = 0; ks < 4; ++ks) a = MFMA32(ld_row(L + DL_KI, DPK, 32 * wave + 32 * kb, 16 * ks, r, h2), qf[ks], a);
            if (kb == 0) {
#pragma unroll
                for (int i = 0; i < 16; ++i) if (crow(i, h2) < r) a[i] = -INFINITY; }
            if (kb == 4) {
#pragma unroll
                for (int i = 0; i < 16; ++i) if (crow(i, h2) > r) a[i] = -INFINITY; }
            if (t.q0 == 0 && 32 * wave + 32 * kb < 128) {
#pragma unroll
                for (int i = 0; i < 16; ++i) a[i] = -INFINITY; }
#pragma unroll
            for (int i = 0; i < 16; ++i) mx = fmaxf(mx, a[i]);
            x[kb] = a;
        }
        mx = max32(mx);
        constexpr float C2 = 0.125f * LOG2E;
        const float mc = mx * C2; float l = 0.f;
#pragma unroll
        for (int kb = 0; kb < 5; ++kb)
#pragma unroll
            for (int i = 0; i < 16; ++i) { const float pe = __builtin_amdgcn_exp2f(x[kb][i] * C2 - mc); x[kb][i] = pe; l += pe; }
        l = sum32(l);
        f32x16 o[2];
#pragma unroll
        for (int dbk = 0; dbk < 2; ++dbk) o[dbk] = (f32x16){0.f, 0.f, 0.f, 0.f, 0.f, 0.f, 0.f, 0.f, 0.f, 0.f, 0.f, 0.f, 0.f, 0.f, 0.f, 0.f};
#pragma unroll
        for (int kb = 0; kb < 5; ++kb)
#pragma unroll
            for (int s = 0; s < 2; ++s) { const bf16x8 pa = PACK_STEP(x[kb], s);
#pragma unroll
                for (int dbk = 0; dbk < 2; ++dbk) o[dbk] = MFMA32(pa, ld_tr_perm(L + DL_VI, DPV, 32 * wave + 32 * kb + 16 * s, dbk * 32, lane), o[dbk]); }
        LAS float* lw = (LAS float*)(L + DL_LW + wave * 256);
        if (h2 == 0) lw[r] = l;
        WG_BAR();
        LAS unsigned char* st = L + DL_ST + wave * 32 * DPK;
#pragma unroll
        for (int i = 0; i < 16; ++i) { const float rl = __builtin_amdgcn_rcpf(lw[crow(i, h2)]);
#pragma unroll
            for (int dbk = 0; dbk < 2; ++dbk) *(LAS bf16*)(st + crow(i, h2) * DPK + (dbk * 32 + r) * 2) = cvt1(o[dbk][i] * rl); }
        const size_t tokbase = (size_t)t.b * SEQ;
        bf16* odp = OD + (size_t)t.p * M * 512;
#pragma unroll
        for (int j = 0; j < 4; ++j) { const int c = lane + 64 * j, row = c >> 3, cc = c & 7; const size_t tok = tokbase + (size_t)(t.q0 + 32 * wave + row) * t.dil + t.res;
            *(GAS v4u*)(odp + tok * 512 + t.head * 64 + cc * 8) = *(const LAS v4u*)(st + row * DPK + cc * 16); }
        if (h2 == 0) { const size_t tok = tokbase + (size_t)(t.q0 + 32 * wave + r) * t.dil + t.res; LSE[((size_t)t.p * M + tok) * 8 + t.head] = mx * 0.125f + LN2 * __builtin_amdgcn_logf(l); }
        WG_BAR();
    }
}
__device__ __forceinline__ void dil_combine(const Frame& F, const bf16* OD, const float* LSE, bf16* CAT) {
    for (int gt = F.bid * NTHREADS + F.tid; gt < M * 64; gt += F.G * NTHREADS) {
        const int tok = gt >> 6, c8 = gt & 63, head = c8 >> 3;
        const float l0 = LSE[(size_t)tok * 8 + head], l1 = LSE[((size_t)M + tok) * 8 + head], l2 = LSE[((size_t)2 * M + tok) * 8 + head];
        const float mxl = fmaxf(l0, fmaxf(l1, l2));
        float w0 = __builtin_amdgcn_exp2f((l0 - mxl) * LOG2E), w1 = __builtin_amdgcn_exp2f((l1 - mxl) * LOG2E), w2 = __builtin_amdgcn_exp2f((l2 - mxl) * LOG2E);
        const float rs = 1.0f / (w0 + w1 + w2); w0 *= rs; w1 *= rs; w2 *= rs;
        const v4u a = *(const GAS v4u*)(OD + (size_t)tok * 512 + c8 * 8), bq = *(const GAS v4u*)(OD + ((size_t)M + tok) * 512 + c8 * 8), cq = *(const GAS v4u*)(OD + ((size_t)2 * M + tok) * 512 + c8 * 8);
        v4u o;
#pragma unroll
        for (int i = 0; i < 4; ++i) o[i] = cvtpk(w0 * bflo(a[i]) + w1 * bflo(bq[i]) + w2 * bflo(cq[i]), w0 * bfhi(a[i]) + w1 * bfhi(bq[i]) + w2 * bfhi(cq[i]));
        *(GAS v4u*)(CAT + (size_t)tok * D + 512 + c8 * 8) = o;
    }
}
constexpr int DIL_TILES = 3072, DIL_SPLIT = 1024;
__device__ __forceinline__ void even_phase_a(const Frame& F0) {
    const Frame F = relaunder(F0);
    unsigned char* ws = WSP();
    const bf16* P = (const bf16*)(ws + WS_ACT); bf16* RKV = (bf16*)OUTP(); bf16* OD = (bf16*)(ws + WS_OD); float* LSE = (float*)((unsigned char*)OUTP() + OUT_LSE);
    ret_phase_a_items(F, P, RKV);
    dil_tiles(F, F.bid, DIL_SPLIT, F.G, P, OD, LSE);
}
__device__ __forceinline__ void even_phase_b(const Frame& F0) {
    const Frame F = relaunder(F0);
    unsigned char* ws = WSP();
    const bf16* P = (const bf16*)(ws + WS_ACT); bf16* RKV = (bf16*)OUTP(); bf16* OD = (bf16*)(ws + WS_OD); float* LSE = (float*)((unsigned char*)OUTP() + OUT_LSE);
    ret_scan(F, RKV);
    dil_tiles(F, DIL_SPLIT + F.bid, DIL_TILES, F.G, P, OD, LSE);
}
__device__ __forceinline__ void even_phase_c(const Frame& F0) {
    const Frame F = relaunder(F0);
    unsigned char* ws = WSP();
    const bf16* P = (const bf16*)(ws + WS_ACT); const bf16* RKV = (const bf16*)OUTP(); const bf16* OD = (const bf16*)(ws + WS_OD); const float* LSE = (const float*)((unsigned char*)OUTP() + OUT_LSE); bf16* CAT = (bf16*)(ws + WS_CAT);
    ret_phase_c_items(F, P, RKV, CAT);
    dil_combine(F, OD, LSE, CAT);
}

__global__ void __launch_bounds__(NTHREADS, 2) fwd_kernel(Args args) {
    extern __shared__ __attribute__((aligned(16))) unsigned char lds[];
    Frame F;
    F.lds = (LAS unsigned char*)lds;
    F.wave = __builtin_amdgcn_readfirstlane((int)(threadIdx.x >> 6)); F.lane = hw_lane(); F.tid = F.wave * 64 + F.lane; F.G = gridDim.x; F.bid = blockIdx.x;
    for (int u = F.tid; u < (LDS_BYTES - LDSCTL_OFF) / 4; u += NTHREADS) ((LAS unsigned*)(F.lds + LDSCTL_OFF))[u] = 0u;
    __syncthreads();
    if (F.tid < N_PTRS) { const unsigned long long v = (F.tid < 17) ? (unsigned long long)args.in[F.tid] : (F.tid == 17 ? (unsigned long long)args.out : (unsigned long long)args.ws);
        ((LAS unsigned*)(F.lds + PTR_OFF))[2 * F.tid] = (unsigned)v; ((LAS unsigned*)(F.lds + PTR_OFF))[2 * F.tid + 1] = (unsigned)(v >> 32); }
    __syncthreads();
    (void)xcd_barrier_post((unsigned*)(WSP() + WS_CTL) + CW_BAR, (volatile LAS unsigned*)(F.lds + MISC_OFF) + 8, F.tid);
#ifdef PROBE_BARX2
#define PROBE_BAR2(b, t) xcd_barrier(b, t)
#else
#define PROBE_BAR2(b, t) do {} while (0)
#endif
#define GRID_BAR() do { XcdBarrier bar_; bar_.bar = (unsigned*)(WSP() + WS_CTL) + CW_BAR; bar_.x = (unsigned)__builtin_amdgcn_readfirstlane((int)xb_xcc_id()); \
        int mo_ = MISC_OFF + 32; asm volatile("" : "+s"(mo_)); bar_.st = (volatile LAS unsigned*)(F.lds + mo_); int t_ = threadIdx.x; asm volatile("" : "+v"(t_)); xcd_barrier(bar_, t_); PROBE_BAR2(bar_, t_); } while (0)
#define XB ((bf16*)(WSP() + WS_XB))
#define ACT ((bf16*)(WSP() + WS_ACT))
#define CAT ((bf16*)(WSP() + WS_CAT))
#define SSP ((float*)(WSP() + WS_SSP))
#define WPTR(off) ((const bf16*)(WSP() + (off)))

#ifdef TEST_MIN
    {
        pg8::Gemm g{XB, WPTR(W_GU0), M, 2 * FF, D}; pg8::StaticOrder S; S.init(M, 2 * FF, lnd(F.G), lnd(F.bid));
        pg8::EpiSwiGLU E{ACT, FF, SSP};
        pg8::gemm_phase<pg8::EpiSwiGLU, pg8::StaticOrder, true, true>(F.lds + RING_OFF, g, S, E, lnd(F.wave));
        GRID_BAR();
        return;
    }
#endif
    prologue_rows(F);
    convert_weights(F, 0);
    GRID_BAR();
    for (int s = 0; s < 8; ++s) {
        const int l = s >> 1; const bool post = (s & 1) != 0;
#ifdef PROBE_F1X2
        for (int rep = 0; rep < 2; ++rep)
#endif
        {
#ifndef F1_ALIGN
#define F1_ALIGN true
#endif
#ifdef PROBE_KX2
            typedef pg8::TwiceOrder F1Order;
#else
            typedef pg8::StaticOrder F1Order;
#endif
            pg8::Gemm g{XB, WPTR(post ? W_GU1 : W_GU0), M, 2 * FF, D}; F1Order S; S.init(M, 2 * FF, lnd(F.G), lnd(F.bid));
            pg8::EpiSwiGLU E{ACT, FF, SSP};
#ifndef NO_F1
            pg8::gemm_phase<pg8::EpiSwiGLU, F1Order, F1_ALIGN, true>(F.lds + RING_OFF, g, S, E, lnd(F.wave));
#endif
            GRID_BAR();
        }
#ifdef PROBE_F2X2
        for (int rep = 0; rep < 2; ++rep)
#else
        constexpr int rep = 1;
#endif
        {
            pg8::Gemm g{ACT, WPTR(post ? W_D1 : W_D0), M, D, FF}; pg8::RevOrder S; S.init(M, D, lnd(F.G), lnd(F.bid));
            pg8::EpiResid E{XB, SSP, rep ? 0.5f : 0.0f};
#ifndef NO_F2
            pg8::gemm_phase<pg8::EpiResid, pg8::RevOrder, true, true>(F.lds + RING_OFF, g, S, E, lnd(F.wave));
#endif
            GRID_BAR();
        }
        if (!post) {
            const bool odd = (l & 1) != 0; const int nin = odd ? GLA_INP : EVEN_IN;
            {
                pg8::Gemm g{XB, WPTR(W_IN), M, nin, D}; pg8::StaticOrder S; S.init(M, nin, lnd(F.G), lnd(F.bid));
                pg8::EpiInProj E{ACT, nin, SSP, (const float*)(WSP() + TAB_RC), (const float*)(WSP() + TAB_RS), (const float*)(WSP() + TAB_DC), (const float*)(WSP() + TAB_DS), odd ? 0 : 1};
#ifndef NO_M1
                pg8::gemm_phase<pg8::EpiInProj, pg8::StaticOrder, true, true>(F.lds + RING_OFF, g, S, E, lnd(F.wave));
#endif
            }
            GRID_BAR();
#if defined(PROBE_MIXX2)
            constexpr int NREP = 2;
#else
            constexpr int NREP = 1;
#endif
            if (!odd) {
                for (int rp = 0; rp < NREP; ++rp) { even_phase_a(F); GRID_BAR(); }
                even_phase_b(F); GRID_BAR();
                for (int rp = 0; rp < NREP; ++rp) { if (rp) GRID_BAR(); even_phase_c(F); }
            } else {
                for (int rp = 0; rp < NREP; ++rp) { gla_phase_a(F, l >> 1); GRID_BAR(); }
                gla_phase_b(F); GRID_BAR();
                for (int rp = 0; rp < NREP; ++rp) { if (rp) GRID_BAR(); gla_phase_c(F, l >> 1); }
            }
            GRID_BAR();
#ifdef PROBE_M5X2
            for (int rep2 = 0; rep2 < 2; ++rep2)
#else
            constexpr int rep2 = 1;
#endif
            {
                pg8::Gemm g{CAT, WPTR(W_OUT), M, D, D}; pg8::StaticOrder S; S.init(M, D, lnd(F.G), lnd(F.bid));
                pg8::EpiResid E{XB, SSP, rep2 ? 1.0f : 0.0f};
#ifndef NO_M5
                pg8::gemm_phase<pg8::EpiResid, pg8::StaticOrder, true, true>(F.lds + RING_OFF, g, S, E, lnd(F.wave));
#endif
                GRID_BAR();
            }
        } else if (l + 1 < DEPTH) {
            convert_weights(F, l + 1);
            GRID_BAR();
#ifdef PROBE_CONVX2
            convert_weights(F, l + 1);
            GRID_BAR();
#endif
        }
    }
    final_norm(F);
}

extern "C" void kernel_launch(void* const* d_in, const int* in_sizes, int n_in, void* d_out, int out_size, void* d_ws, size_t ws_size, hipStream_t stream) {
    static int grid = 0;
    if (grid == 0) {
        if (n_in != 17 || in_sizes[0] != M * D || out_size != M * D || ws_size < WS_END2) { fprintf(stderr, "kernel_launch: unexpected shapes (n_in %d, in0 %d, out %d, ws %zu)\n", n_in, n_in > 0 ? in_sizes[0] : -1, out_size, ws_size); grid = -1; return; }
        int dev = 0, cus = 0, per_cu = 0;
        if (hipGetDevice(&dev) != hipSuccess || hipDeviceGetAttribute(&cus, hipDeviceAttributeMultiprocessorCount, dev) != hipSuccess) { grid = -1; return; }
        if (hipFuncSetAttribute((const void*)fwd_kernel, hipFuncAttributeMaxDynamicSharedMemorySize, LDS_BYTES) != hipSuccess) { fprintf(stderr, "kernel_launch: hipFuncSetAttribute failed\n"); grid = -1; return; }
        if (hipOccupancyMaxActiveBlocksPerMultiprocessor(&per_cu, (const void*)fwd_kernel, NTHREADS, LDS_BYTES) != hipSuccess || per_cu < 1) { fprintf(stderr, "kernel_launch: occupancy query reports %d\n", per_cu); }
        (void)hipGetLastError();
        grid = cus;
        if (grid != 256) fprintf(stderr, "kernel_launch: %d CUs (expected 256)\n", grid);
    }
    if (grid < 0) return;
    if (hipMemsetAsync((char*)d_ws + WS_CTL, 0, CTL_ZERO_BYTES, stream) != hipSuccess) return;
    Args a{};
    for (int i = 0; i < 17; ++i) a.in[i] = (const float*)d_in[i];
    a.out = (float*)d_out; a.ws = (unsigned char*)d_ws;
    hipLaunchKernelGGL(fwd_kernel, dim3(grid), dim3(NTHREADS), LDS_BYTES, stream, a);
}
```

```cpp
#include <hip/hip_runtime.h>
#include <cstdio>
#include <cstdint>
#include <cmath>
template <int K> __device__ __forceinline__ float xsw(float v) { static_assert(K == 1 || K == 2 || K == 4 || K == 8 || K == 16, "xor mask inside a 32-lane half");
    return __builtin_bit_cast(float, __builtin_amdgcn_ds_swizzle(__builtin_bit_cast(int, v), 0x1F | (K << 10))); }
__device__ __forceinline__ float sum32(float v) { const unsigned u = __builtin_bit_cast(unsigned, v); auto rr = __builtin_amdgcn_permlane32_swap(u, u, false, false); return __builtin_bit_cast(float, (unsigned)rr[0]) + __builtin_bit_cast(float, (unsigned)rr[1]); }
__device__ __forceinline__ float max32(float v) { const unsigned u = __builtin_bit_cast(unsigned, v); auto rr = __builtin_amdgcn_permlane32_swap(u, u, false, false); return fmaxf(__builtin_bit_cast(float, (unsigned)rr[0]), __builtin_bit_cast(float, (unsigned)rr[1])); }
__device__ __forceinline__ float oth32(float v, int h) { const unsigned u = __builtin_bit_cast(unsigned, v); auto rr = __builtin_amdgcn_permlane32_swap(u, u, false, false); return __builtin_bit_cast(float, (unsigned)(h ? rr[0] : rr[1])); }
#ifndef PG8_WGM
#define PG8_WGM 8
#endif
namespace pg8 {
#define PG8_LAS __attribute__((address_space(3)))
typedef unsigned short bf16_t;
typedef short bf16x8 __attribute__((ext_vector_type(8)));
typedef float f32x4 __attribute__((ext_vector_type(4)));
typedef unsigned u32x4 __attribute__((ext_vector_type(4)));
constexpr int BM = 256, BK = 64, HALF = 128, HTB = HALF * BK * 2  , STAGE_BYTES = 8 * HTB, NXCD = 8, WGM = PG8_WGM;

__host__ __device__ __forceinline__ int lds_byte(int r, int c) { const int st = (r >> 4) * 2 + (c >> 5), rr = r & 15, cc = c & 31, ob = rr * 64 + cc * 2; return st * 1024 + (ob ^ (((ob >> 9) & 1) << 5)); }
__host__ __device__ __forceinline__ void stage_rc(int b, int& R, int& C) { const int st = b / 1024, sb = b % 1024, swz = sb ^ (((sb >> 9) & 1) << 5); R = (st >> 1) * 16 + swz / 64; C = (st & 1) * 32 + (swz % 64) / 2; }
__host__ __device__ __forceinline__ int perm32(int rho) { const int n = rho >> 4, i = rho & 15; return 8 * (i >> 2) + 4 * n + (i & 3); }

struct Unit { int pm, pn; };
struct Gemm { const bf16_t* A; const bf16_t* Bt; int M, N, K; };

struct StaticOrder {
    int nM, nN, nwg, G, c;
    __host__ __device__ void init(int M, int N, int G_, int c_) { nM = M / BM; nN = N / BM; nwg = nM * nN; G = G_; c = c_; }
    __host__ __device__ bool next(int i, Unit& u) const {
        const long L = (long)i * G + c; if (L >= nwg) return false;
        int wgid = (int)L; { const int q = nwg / NXCD, r = nwg % NXCD, xcd = wgid % NXCD, off = wgid / NXCD; wgid = (xcd < r ? xcd * (q + 1) : r * (q + 1) + (xcd - r) * q) + off; }
        const int nig = WGM * nN, gid = wgid / nig, fm = gid * WGM, gsz = (nM - fm) < WGM ? (nM - fm) : WGM;
        u.pm = fm + ((wgid % nig) % gsz); u.pn = (wgid % nig) / gsz; return true;
    }
    __device__ __forceinline__ void a_ready(const Unit&) const {}
    __device__ __forceinline__ void done(const Unit&) const {}
};
struct RevOrder : StaticOrder {
    __host__ __device__ bool next(int i, Unit& u) const { const int rounds = nwg / G; if (i >= rounds) return false; return StaticOrder::next(rounds - 1 - i, u); }
};

__device__ __forceinline__ unsigned cvt_pk_bf16(float lo, float hi) { unsigned r; asm volatile("v_cvt_pk_bf16_f32 %0, %1, %2" : "=v"(r) : "v"(lo), "v"(hi)); return r; }
constexpr int MROWS = 32768;
constexpr float RMS_EPS = 1e-6f;
__device__ __forceinline__ float c1024_() { float c = 1.0f / 1024.0f; asm volatile("" : "+v"(c)); return c; }
__device__ __forceinline__ void row_rstd(float (&rs)[2][4], const float* ssp, const Unit& u, int wr, int fr, int fq) {
#pragma unroll
    for (int ai = 0; ai < 2; ++ai)
#pragma unroll
        for (int m = 0; m < 4; ++m) {
            const int row = u.pm * BM + ai * HALF + wr * 64 + m * 16 + fr;
            const f32x4 p = *(const f32x4*)(ssp + (size_t)row * 16 + 4 * fq);
            float s = (p[0] + p[1]) + (p[2] + p[3]);
            s += xsw<16>(s); s = sum32(s);
            rs[ai][m] = __builtin_amdgcn_rsqf(s * c1024_() + RMS_EPS);
        }
}
struct RowPre { PG8_LAS unsigned char* tab; Unit nxt; bool has_next; int ui; };
__device__ __forceinline__ void rowpre_get(float (&rs)[2][4], const float* ssp, const Unit& u, const RowPre& rp, int wr, int fr, int fq) {
    const PG8_LAS float* t = (const PG8_LAS float*)rp.tab + (rp.ui & 1) * 128 + fr;
#pragma unroll
    for (int ai = 0; ai < 2; ++ai)
#pragma unroll
        for (int m = 0; m < 4; ++m) rs[ai][m] = t[(ai * 4 + m) * 16];
}
__device__ __forceinline__ void rowpre_issue(f32x4 (&p)[2][4], const float* ssp, const RowPre& rp, int wr, int fr, int fq) {
#pragma unroll
    for (int ai = 0; ai < 2; ++ai)
#pragma unroll
        for (int m = 0; m < 4; ++m) p[ai][m] = *(const f32x4*)(ssp + (size_t)(rp.nxt.pm * BM + ai * HALF + wr * 64 + m * 16 + fr) * 16 + 4 * fq);
}
__device__ __forceinline__ void rowpre_park(const f32x4 (&p)[2][4], const RowPre& rp, int fr, int fq) {
    PG8_LAS float* t = (PG8_LAS float*)rp.tab + ((rp.ui + 1) & 1) * 128 + fr;
#pragma unroll
    for (int ai = 0; ai < 2; ++ai)
#pragma unroll
        for (int m = 0; m < 4; ++m) { float s = (p[ai][m][0] + p[ai][m][1]) + (p[ai][m][2] + p[ai][m][3]); s += xsw<16>(s); s = sum32(s);
            if (fq == 0) t[(ai * 4 + m) * 16] = __builtin_amdgcn_rsqf(s * c1024_() + RMS_EPS); }
}
__device__ __forceinline__ void rowpre_prime_issue(f32x4 (&p)[2][4], const float* ssp, const Unit& u, int wr, int fr, int fq) {
#pragma unroll
    for (int ai = 0; ai < 2; ++ai)
#pragma unroll
        for (int m = 0; m < 4; ++m) p[ai][m] = *(const f32x4*)(ssp + (size_t)(u.pm * BM + ai * HALF + wr * 64 + m * 16 + fr) * 16 + 4 * fq);
}
__device__ __forceinline__ void rowpre_prime_park(const f32x4 (&p)[2][4], PG8_LAS unsigned char* tab, int fr, int fq) {
    PG8_LAS float* t = (PG8_LAS float*)tab + fr;
#pragma unroll
    for (int ai = 0; ai < 2; ++ai)
#pragma unroll
        for (int m = 0; m < 4; ++m) { float s = (p[ai][m][0] + p[ai][m][1]) + (p[ai][m][2] + p[ai][m][3]); s += xsw<16>(s); s = sum32(s);
            if (fq == 0) t[(ai * 4 + m) * 16] = __builtin_amdgcn_rsqf(s * c1024_() + RMS_EPS); }
}
__device__ __forceinline__ float silu_f(float g) { return g * __builtin_amdgcn_rcpf(1.0f + __builtin_amdgcn_exp2f(-1.4426950408889634f * g)); }

constexpr float F8_XSCALE = 8.0f, F8_GUSCALE = 16.0f;
constexpr float F8_HSCALE = 4.0f, F8_WSCALE = 32.0f;
template <bool OUT8, bool ACCI = false> struct EpiSwiGLUT {
    static constexpr bool PERM = true, AFTER_DRAIN = false, NEEDS_RSTD = true;
    bf16_t* H; int ldh; const float* ssp; float ascale;
    __device__ __forceinline__ void operator()(const f32x4 (&acc)[2][2][4][2], const Unit& u, int wr, int wc, int fr, int fq, const RowPre& rp) const {
        float rs[2][4]; rowpre_get(rs, ssp, u, rp, wr, fr, fq);
        f32x4 pre[2][4]; rowpre_issue(pre, ssp, rp, wr, fr, fq);
        const int col0 = u.pn * HALF + wc * 32 + 8 * fq;
#pragma unroll
        for (int ai = 0; ai < 2; ++ai)
#pragma unroll
            for (int m = 0; m < 4; ++m) {
                const int row = u.pm * BM + ai * HALF + wr * 64 + m * 16 + fr; const float r = rs[ai][m] * ascale, rn = -1.4426950408889634f * r, rr = OUT8 ? r * r * F8_HSCALE : r * r;
                float h[8];
                typedef float f32x2 __attribute__((ext_vector_type(2)));
#pragma unroll
                for (int n = 0; n < 2; ++n)
#pragma unroll
                    for (int i = 0; i < 4; i += 2) {
                        float g0 = acc[ai][0][m][n][i], g1 = acc[ai][0][m][n][i + 1], u0 = acc[ai][1][m][n][i], u1 = acc[ai][1][m][n][i + 1];
                        if constexpr (ACCI) { g0 = (float)__builtin_bit_cast(int, g0); g1 = (float)__builtin_bit_cast(int, g1); u0 = (float)__builtin_bit_cast(int, u0); u1 = (float)__builtin_bit_cast(int, u1); }
                        const f32x2 G = {g0, g1}, U = {u0, u1};
                        const f32x2 t = G * rn; f32x2 e; e.x = __builtin_amdgcn_exp2f(t.x); e.y = __builtin_amdgcn_exp2f(t.y);
                        const f32x2 d = e + 1.0f; f32x2 sg; sg.x = __builtin_amdgcn_rcpf(d.x); sg.y = __builtin_amdgcn_rcpf(d.y);
                        const f32x2 hv = ((G * U) * rr) * sg; h[4 * n + i] = hv.x; h[4 * n + i + 1] = hv.y;
                    }
                if constexpr (OUT8) {
                    int w0 = __builtin_amdgcn_cvt_pk_fp8_f32(h[0], h[1], 0, false); w0 = __builtin_amdgcn_cvt_pk_fp8_f32(h[2], h[3], w0, true);
                    int w1 = __builtin_amdgcn_cvt_pk_fp8_f32(h[4], h[5], 0, false); w1 = __builtin_amdgcn_cvt_pk_fp8_f32(h[6], h[7], w1, true);
                    typedef int i32x2 __attribute__((ext_vector_type(2)));
                    *(i32x2*)((unsigned char*)H + (size_t)row * ldh + col0) = (i32x2){w0, w1};
                } else {
                u32x4 w; w.x = cvt_pk_bf16(h[0], h[1]); w.y = cvt_pk_bf16(h[2], h[3]); w.z = cvt_pk_bf16(h[4], h[5]); w.w = cvt_pk_bf16(h[6], h[7]);
                *(u32x4*)(H + (size_t)row * ldh + col0) = w;
                }
                asm volatile("" ::: "memory");
            }
        rowpre_park(pre, rp, fr, fq);
    }
};
typedef EpiSwiGLUT<false> EpiSwiGLU;
typedef EpiSwiGLUT<true> EpiSwiGLU8;
typedef EpiSwiGLUT<false, true> EpiSwiGLUI;
typedef EpiSwiGLUT<true, true> EpiSwiGLU8I;
struct EpiInProj {
    static constexpr bool PERM = true, AFTER_DRAIN = false, NEEDS_RSTD = true;
    bf16_t* O; int ldc; const float* ssp; const float* rc; const float* rs; const float* dc; const float* ds; int even;
    __device__ __forceinline__ void operator()(const f32x4 (&acc)[2][2][4][2], const Unit& u, int wr, int wc, int fr, int fq, const RowPre& rp) const {
        float rsd[2][4]; rowpre_get(rsd, ssp, u, rp, wr, fr, fq);
        f32x4 pre[2][4]; rowpre_issue(pre, ssp, rp, wr, fr, fq);
        const int col0 = u.pn * BM + wc * 32 + 8 * fq;
        const int kind = even ? (u.pn < 4 ? 1 : ((u.pn >= 8 && u.pn < 12) ? 2 : 0)) : 0;
        const float ksc = (kind == 1 && u.pn >= 2) ? 0.08838834764831845f : 1.0f;
        const bool rot2 = (kind == 2) && ((wc & 1) == 0) && (fq < 2);
        const int b_ = (u.pm * BM) >> 12, t0 = (u.pm * BM) & 4095;
        size_t hb[2]; int dh, d0[2];
#pragma unroll
        for (int bj = 0; bj < 2; ++bj) {
            int c0, nh, head;
            if (even) { c0 = (u.pn >> 1) * 512; if (u.pn < 8) { nh = 4; dh = 128; head = (u.pn & 1) * 2 + bj; d0[bj] = wc * 32; } else { nh = 8; dh = 64; head = (u.pn & 1) * 4 + bj * 2 + (wc >> 1); d0[bj] = (wc & 1) * 32; } }
            else if (u.pn < 4) { c0 = (u.pn >> 1) * 512; nh = 4; dh = 128; head = (u.pn & 1) * 2 + bj; d0[bj] = wc * 32; }
            else if (u.pn < 12) { c0 = u.pn < 8 ? 1024 : 2048; nh = 4; dh = 256; head = u.pn & 3; d0[bj] = bj * 128 + wc * 32; }
            else { c0 = 3072; nh = 1; dh = 256; head = 0; d0[bj] = bj * 128 + wc * 32; }
            hb[bj] = (size_t)c0 * MROWS + ((size_t)(b_ * nh + head) * 4096 + t0) * dh;
        }
        const float* tc = (kind == 1) ? rc + wc * 16 + 4 * fq : dc + 4 * (fq & 1);
        const float* ts = (kind == 1) ? rs + wc * 16 + 4 * fq : ds + 4 * (fq & 1);
        const int tstride = (kind == 1) ? 64 : 8;
        typedef float f32x2 __attribute__((ext_vector_type(2)));
        if (kind == 0) {
#pragma unroll
            for (int ai = 0; ai < 2; ++ai)
#pragma unroll
                for (int m = 0; m < 4; ++m) {
                    const int row = u.pm * BM + ai * HALF + wr * 64 + m * 16 + fr; const float r = rsd[ai][m];
#pragma unroll
                    for (int bj = 0; bj < 2; ++bj) { const f32x4 v0 = acc[ai][bj][m][0] * r, v1 = acc[ai][bj][m][1] * r;
                        u32x4 w; w.x = cvt_pk_bf16(v0[0], v0[1]); w.y = cvt_pk_bf16(v0[2], v0[3]); w.z = cvt_pk_bf16(v1[0], v1[1]); w.w = cvt_pk_bf16(v1[2], v1[3]);
                        *(u32x4*)(O + hb[bj] + (size_t)(row - u.pm * BM) * dh + d0[bj] + 8 * fq) = w; }
                    asm volatile("" ::: "memory");
                }
        } else {
#pragma unroll
            for (int ai = 0; ai < 2; ++ai)
#pragma unroll
                for (int m = 0; m < 4; ++m) {
                    const int row = u.pm * BM + ai * HALF + wr * 64 + m * 16 + fr; const float r = rsd[ai][m] * ksc;
                    f32x4 c4 = {r, r, r, r}, s4 = {0.f, 0.f, 0.f, 0.f};
                    if (kind == 1 || rot2) { const int pos = row & 4095; c4 = *(const f32x4*)(tc + (size_t)pos * tstride) * r; s4 = *(const f32x4*)(ts + (size_t)pos * tstride) * r; }
#pragma unroll
                    for (int bj = 0; bj < 2; ++bj) { const f32x4 v0 = acc[ai][bj][m][0], v1 = acc[ai][bj][m][1];
                        const f32x2 a0 = {v0[0], v0[1]}, a1 = {v0[2], v0[3]}, a2 = {v1[0], v1[1]}, a3 = {v1[2], v1[3]};
                        const f32x2 b0 = {-v0[1], v0[0]}, b1 = {-v0[3], v0[2]}, b2 = {-v1[1], v1[0]}, b3 = {-v1[3], v1[2]};
                        const f32x2 o0 = a0 * c4[0] + b0 * s4[0], o1 = a1 * c4[1] + b1 * s4[1], o2 = a2 * c4[2] + b2 * s4[2], o3 = a3 * c4[3] + b3 * s4[3];
                        u32x4 w; w.x = cvt_pk_bf16(o0.x, o0.y); w.y = cvt_pk_bf16(o1.x, o1.y); w.z = cvt_pk_bf16(o2.x, o2.y); w.w = cvt_pk_bf16(o3.x, o3.y);
                        *(u32x4*)(O + hb[bj] + (size_t)(row - u.pm * BM) * dh + d0[bj] + 8 * fq) = w; }
                    asm volatile("" ::: "memory");
                }
        }
        rowpre_park(pre, rp, fr, fq);
    }
};
struct EpiResid {
    static constexpr bool PERM = true, AFTER_DRAIN = false, NEEDS_RSTD = false;
    bf16_t* xb; float* ssp; float scale; int x8d;
    __device__ __forceinline__ void operator()(const f32x4 (&acc)[2][2][4][2], const Unit& u, int wr, int wc, int fr, int fq, const RowPre&) const {
        const int col0 = u.pn * BM + wc * 32 + 8 * fq, rowb = u.pm * BM + wr * 64 + fr;
        u32x4 old[8][2];
#pragma unroll
        for (int g = 0; g < 8; ++g) { const size_t off = (size_t)(rowb + (g >> 2) * HALF + (g & 3) * 16) * 1024 + col0; old[g][0] = *(const u32x4*)(xb + off); old[g][1] = *(const u32x4*)(xb + off + HALF); }
#pragma unroll
        for (int g = 0; g < 8; ++g) {
            const int ai = g >> 2, m = g & 3, row = rowb + ai * HALF + m * 16; float ss = 0.f;
#pragma unroll
            for (int bj = 0; bj < 2; ++bj) { const size_t off = (size_t)row * 1024 + col0 + bj * HALF; const u32x4 o = old[g][bj];
                const f32x4 a0 = acc[ai][bj][m][0] * scale, a1 = acc[ai][bj][m][1] * scale;
                const float v0 = __builtin_bit_cast(float, o.x << 16) + a0[0], v1 = __builtin_bit_cast(float, o.x & 0xffff0000u) + a0[1], v2 = __builtin_bit_cast(float, o.y << 16) + a0[2], v3 = __builtin_bit_cast(float, o.y & 0xffff0000u) + a0[3];
                const float v4 = __builtin_bit_cast(float, o.z << 16) + a1[0], v5 = __builtin_bit_cast(float, o.z & 0xffff0000u) + a1[1], v6 = __builtin_bit_cast(float, o.w << 16) + a1[2], v7 = __builtin_bit_cast(float, o.w & 0xffff0000u) + a1[3];
                u32x4 w; w.x = cvt_pk_bf16(v0, v1); w.y = cvt_pk_bf16(v2, v3); w.z = cvt_pk_bf16(v4, v5); w.w = cvt_pk_bf16(v6, v7);
                *(u32x4*)(xb + off) = w;
                if (x8d) { int y0 = __builtin_amdgcn_cvt_pk_fp8_f32(v0 * F8_XSCALE, v1 * F8_XSCALE, 0, false); y0 = __builtin_amdgcn_cvt_pk_fp8_f32(v2 * F8_XSCALE, v3 * F8_XSCALE, y0, true);
                    int y1 = __builtin_amdgcn_cvt_pk_fp8_f32(v4 * F8_XSCALE, v5 * F8_XSCALE, 0, false); y1 = __builtin_amdgcn_cvt_pk_fp8_f32(v6 * F8_XSCALE, v7 * F8_XSCALE, y1, true);
                    typedef int i32x2r __attribute__((ext_vector_type(2))); *(i32x2r*)((unsigned char*)xb + x8d + off) = (i32x2r){y0, y1}; }
                ss += (v0 * v0 + v1 * v1) + (v2 * v2 + v3 * v3) + (v4 * v4 + v5 * v5) + (v6 * v6 + v7 * v7); }
            ss += xsw<16>(ss); ss = sum32(ss);
            if (fq == 0) ssp[(size_t)row * 16 + u.pn * 4 + wc] = ss;
        }
    }
};

typedef int pg8_v8i __attribute__((ext_vector_type(8)));
typedef int pg8_v4i __attribute__((ext_vector_type(4)));
__device__ __forceinline__ pg8_v8i pg8_cat(bf16x8 lo, bf16x8 hi) { const pg8_v4i a = __builtin_bit_cast(pg8_v4i, lo), b = __builtin_bit_cast(pg8_v4i, hi); return __builtin_shufflevector(a, b, 0, 1, 2, 3, 4, 5, 6, 7); }
template <class Epi, class Sched, bool ALIGN_EPI = false, bool SP2 = false, bool F8 = false, bool I8 = false>
__device__ __forceinline__ void gemm_phase(PG8_LAS unsigned char* lds, const Gemm g, const Sched& S, const Epi& E, int wave_in) {
    int tid_; { int l_; asm volatile("v_mbcnt_lo_u32_b32 %0, -1, 0\n\tv_mbcnt_hi_u32_b32 %0, -1, %0" : "=v"(l_)); tid_ = wave_in * 64 + l_; }
    const int tid = tid_, wid = __builtin_amdgcn_readfirstlane(tid >> 6), lane = tid & 63, wr = wid >> 2, wc = wid & 3, fr = lane & 15, fq = lane >> 4;
    constexpr int ES = (F8 || I8) ? 1 : 2;
    const int K = g.K, nt = K * ES / (BK * 2);
    unsigned voffA[2], voffB[2];
#pragma unroll
    for (int i = 0; i < 2; ++i) { int R, C; stage_rc(tid * 16 + i * 8192, R, C); const int Rb = Epi::PERM ? ((R & ~31) + perm32(R & 31)) : R;
        voffA[i] = (unsigned)(R * K * ES + C * 2); voffB[i] = (unsigned)(Rb * K * ES + C * 2); }
    const size_t kstep = (size_t)(BK * 2);
    const size_t hstep = (size_t)HALF * K * ES;
    const size_t tstep = 2 * hstep;
    const unsigned ldsw = (unsigned)wid * 1024u;
    const int aoff = lds_byte(wr * 64 + fr, fq * 8), boff = lds_byte(wc * 32 + fr, fq * 8);
#define PG8_SA(b, h) (((b) * 2 + (h)) * HTB)
#define PG8_SB(b, h) ((4 + (b) * 2 + (h)) * HTB)
#define PG8_STAGE(bufoff, gbase, voff) do { _Pragma("unroll") for (int _i = 0; _i < 2; ++_i) { if constexpr (F8) { unsigned vo_ = (voff)[0]; asm volatile("" : "+v"(vo_));     \
        __builtin_amdgcn_global_load_lds((const unsigned*)((const char*)(gbase) + (size_t)_i * 64 * K * ES + vo_), (PG8_LAS unsigned*)(lds + (bufoff) + ldsw + _i * 8192), 16, 0, 0); } else \
        __builtin_amdgcn_global_load_lds((const unsigned*)((const char*)(gbase) + (voff)[_i]), (PG8_LAS unsigned*)(lds + (bufoff) + ldsw + _i * 8192), 16, 0, 0); } } while (0)
#define PG8_LDA(dst, b, h) do { _Pragma("unroll") for (int m = 0; m < 4; ++m) _Pragma("unroll") for (int k = 0; k < 2; ++k) dst[m][k] = *(const PG8_LAS bf16x8*)(lds + PG8_SA(b, h) + aoff + m * 2048 + k * 1024); } while (0)
#define PG8_LDB(dst, b, h) do { _Pragma("unroll") for (int n = 0; n < 2; ++n) _Pragma("unroll") for (int k = 0; k < 2; ++k) dst[n][k] = *(const PG8_LAS bf16x8*)(lds + PG8_SB(b, h) + boff + n * 2048 + k * 1024); } while (0)
#define PG8_MMA(ai, bj, At, Bt) do { __builtin_amdgcn_s_setprio(1); if constexpr (F8) { _Pragma("unroll") for (int m = 0; m < 4; ++m) _Pragma("unroll") for (int n = 0; n < 2; ++n) \
        acc[ai][bj][m][n] = __builtin_amdgcn_mfma_scale_f32_16x16x128_f8f6f4(pg8_cat(Bt[n][0], Bt[n][1]), pg8_cat(At[m][0], At[m][1]), acc[ai][bj][m][n], 0, 0, 0, 0, 0, 0); } \
        else if constexpr (I8) { _Pragma("unroll") for (int m = 0; m < 4; ++m) _Pragma("unroll") for (int n = 0; n < 2; ++n) _Pragma("unroll") for (int k = 0; k < 2; ++k) \
        acc[ai][bj][m][n] = __builtin_bit_cast(f32x4, __builtin_amdgcn_mfma_i32_16x16x64_i8(__builtin_bit_cast(pg8_v4i, Bt[n][k]), __builtin_bit_cast(pg8_v4i, At[m][k]), __builtin_bit_cast(pg8_v4i, acc[ai][bj][m][n]), 0, 0, 0)); } \
        else { _Pragma("unroll") for (int m = 0; m < 4; ++m) _Pragma("unroll") for (int n = 0; n < 2; ++n) _Pragma("unroll") for (int k = 0; k < 2; ++k) \
        acc[ai][bj][m][n] = __builtin_amdgcn_mfma_f32_16x16x32_bf16(Bt[n][k], At[m][k], acc[ai][bj][m][n], 0, 0, 0); } __builtin_amdgcn_s_setprio(0); } while (0)
#define PG8_WAIT_V(n) asm volatile("s_waitcnt vmcnt(" #n ")" ::: "memory")
#define PG8_WAIT_L(n) asm volatile("s_waitcnt lgkmcnt(" #n ")" ::: "memory")
#define PG8_BAR __builtin_amdgcn_s_barrier()
#define PG8_SCHED __builtin_amdgcn_sched_barrier(0)
    Unit cur, nxt; int ui = 0;
    if (!S.next(0, cur)) return;
    f32x4 acc[2][2][4][2];
#pragma unroll
    for (int a = 0; a < 2; ++a)
#pragma unroll
        for (int b = 0; b < 2; ++b)
#pragma unroll
            for (int m = 0; m < 4; ++m)
#pragma unroll
                for (int n = 0; n < 2; ++n) acc[a][b][m][n] = (f32x4){0.f, 0.f, 0.f, 0.f};
    bf16x8 At[4][2], B0[2][2], B1[2][2];
    const char* cA = (const char*)g.A + (size_t)cur.pm * tstep; const char* cB = (const char*)g.Bt + (size_t)cur.pn * tstep;
    S.a_ready(cur);
    f32x4 p0[2][4];
    if constexpr (Epi::NEEDS_RSTD) rowpre_prime_issue(p0, E.ssp, cur, wr, fr, fq);
    if constexpr (SP2) {
        PG8_STAGE(PG8_SB(0, 0), cB, voffB); PG8_STAGE(PG8_SB(0, 1), cB + hstep, voffB); PG8_STAGE(PG8_SA(0, 0), cA, voffA); PG8_STAGE(PG8_SA(0, 1), cA + hstep, voffA);
        if constexpr (Epi::NEEDS_RSTD) rowpre_prime_park(p0, lds + STAGE_BYTES + wid * 1024, fr, fq);
        if (wr == 1) PG8_BAR;
        PG8_WAIT_V(2); PG8_BAR;
        PG8_STAGE(PG8_SB(1, 0), cB + kstep, voffB); PG8_STAGE(PG8_SA(1, 0), cA + kstep, voffA); PG8_STAGE(PG8_SB(1, 1), cB + hstep + kstep, voffB);
        PG8_WAIT_V(6); PG8_BAR;
    } else {
        PG8_STAGE(PG8_SB(0, 0), cB, voffB); PG8_STAGE(PG8_SA(0, 0), cA, voffA); PG8_STAGE(PG8_SB(0, 1), cB + hstep, voffB); PG8_STAGE(PG8_SA(0, 1), cA + hstep, voffA);
        if constexpr (Epi::NEEDS_RSTD) rowpre_prime_park(p0, lds + STAGE_BYTES + wid * 1024, fr, fq);
        if (wr == 1) PG8_BAR;
        PG8_WAIT_V(4); PG8_BAR;
        PG8_STAGE(PG8_SB(1, 0), cB + kstep, voffB); PG8_STAGE(PG8_SA(1, 0), cA + kstep, voffA); PG8_STAGE(PG8_SB(1, 1), cB + hstep + kstep, voffB);
        PG8_WAIT_V(6); PG8_BAR;
    }
    for (;;) {
        const bool has_next = S.next(ui + 1, nxt);
        const char* nA = has_next ? (const char*)g.A + (size_t)nxt.pm * tstep : cA; const char* nB = has_next ? (const char*)g.Bt + (size_t)nxt.pn * tstep : cB;
        for (int t = 0; t < nt; t += 2) {
            const bool last = (t == nt - 2);
            const char* a1 = cA + (size_t)(t + 1) * kstep;
            const char* a2 = last ? nA : cA + (size_t)(t + 2) * kstep; const char* b2 = last ? nB : cB + (size_t)(t + 2) * kstep;
            const char* a3 = a2 + kstep; const char* b3 = b2 + kstep;
            if (last && has_next) S.a_ready(nxt);
            if constexpr (SP2) {
            PG8_LDB(B0, 0, 0); PG8_LDB(B1, 0, 1); PG8_SCHED; PG8_LDA(At, 0, 0); PG8_STAGE(PG8_SA(1, 1), a1 + hstep, voffA);
            PG8_WAIT_V(8); PG8_WAIT_L(0); PG8_BAR; PG8_MMA(0, 0, At, B0); PG8_MMA(0, 1, At, B1); PG8_BAR; PG8_SCHED;
            PG8_LDA(At, 0, 1); PG8_STAGE(PG8_SB(0, 0), b2, voffB); PG8_STAGE(PG8_SB(0, 1), b2 + hstep, voffB); PG8_STAGE(PG8_SA(0, 0), a2, voffA);
            PG8_WAIT_V(8); PG8_WAIT_L(0); PG8_BAR; PG8_MMA(1, 0, At, B0); PG8_MMA(1, 1, At, B1); PG8_BAR; PG8_SCHED;
            PG8_LDB(B0, 1, 0); PG8_LDB(B1, 1, 1); PG8_SCHED; PG8_LDA(At, 1, 0); PG8_STAGE(PG8_SA(0, 1), a2 + hstep, voffA);
            PG8_WAIT_V(8); PG8_WAIT_L(0); PG8_BAR; PG8_MMA(0, 0, At, B0); PG8_MMA(0, 1, At, B1); PG8_BAR; PG8_SCHED;
            PG8_LDA(At, 1, 1); PG8_STAGE(PG8_SB(1, 0), b3, voffB); PG8_STAGE(PG8_SB(1, 1), b3 + hstep, voffB); PG8_STAGE(PG8_SA(1, 0), a3, voffA);
            PG8_WAIT_V(8); PG8_WAIT_L(0); PG8_BAR; PG8_MMA(1, 0, At, B0); PG8_MMA(1, 1, At, B1); PG8_BAR; PG8_SCHED;
            } else {
            PG8_LDB(B0, 0, 0); PG8_SCHED; PG8_LDA(At, 0, 0); PG8_STAGE(PG8_SA(1, 1), a1 + hstep, voffA);
            PG8_WAIT_L(8); PG8_BAR; PG8_WAIT_L(0); PG8_MMA(0, 0, At, B0); PG8_BAR; PG8_SCHED;
            PG8_LDB(B1, 0, 1); PG8_STAGE(PG8_SB(0, 0), b2, voffB);
            PG8_BAR; PG8_WAIT_L(0); PG8_MMA(0, 1, At, B1); PG8_BAR;
            PG8_LDA(At, 0, 1); PG8_STAGE(PG8_SA(0, 0), a2, voffA);
            PG8_BAR; PG8_WAIT_L(0); PG8_MMA(1, 0, At, B0); PG8_BAR; PG8_SCHED;
            PG8_STAGE(PG8_SB(0, 1), b2 + hstep, voffB);
            PG8_WAIT_V(6); PG8_BAR; PG8_MMA(1, 1, At, B1); PG8_BAR;
            PG8_LDB(B0, 1, 0); PG8_SCHED; PG8_LDA(At, 1, 0); PG8_STAGE(PG8_SA(0, 1), a2 + hstep, voffA);
            PG8_WAIT_L(8); PG8_BAR; PG8_WAIT_L(0); PG8_MMA(0, 0, At, B0); PG8_BAR; PG8_SCHED;
            PG8_LDB(B1, 1, 1); PG8_STAGE(PG8_SB(1, 0), b3, voffB);
            PG8_BAR; PG8_WAIT_L(0); PG8_MMA(0, 1, At, B1); PG8_BAR;
            PG8_LDA(At, 1, 1); PG8_STAGE(PG8_SA(1, 0), a3, voffA);
            PG8_BAR; PG8_WAIT_L(0); PG8_MMA(1, 0, At, B0); PG8_BAR; PG8_SCHED;
            PG8_STAGE(PG8_SB(1, 1), b3 + hstep, voffB);
            PG8_WAIT_V(6); PG8_BAR; PG8_MMA(1, 1, At, B1); PG8_BAR;
            }
        }
        if constexpr (ALIGN_EPI) { if (wr == 0) PG8_BAR; }
        if constexpr (!Epi::AFTER_DRAIN) {
            if constexpr (F8) { int l2; asm volatile("v_mbcnt_lo_u32_b32 %0, -1, 0\n\tv_mbcnt_hi_u32_b32 %0, -1, %0" : "=v"(l2));
                E(acc, cur, wr, wc, l2 & 15, l2 >> 4, RowPre{lds + STAGE_BYTES + wid * 1024, has_next ? nxt : cur, has_next, ui}); }
            else E(acc, cur, wr, wc, fr, fq, RowPre{lds + STAGE_BYTES + wid * 1024, has_next ? nxt : cur, has_next, ui});
            S.done(cur); }
        if (!has_next) break;
#pragma unroll
        for (int a = 0; a < 2; ++a)
#pragma unroll
            for (int b = 0; b < 2; ++b)
#pragma unroll
                for (int m = 0; m < 4; ++m)
#pragma unroll
                    for (int n = 0; n < 2; ++n) acc[a][b][m][n] = (f32x4){0.f, 0.f, 0.f, 0.f};
        cur = nxt; cA = nA; cB = nB; ++ui;
        if constexpr (ALIGN_EPI) { if (wr == 1) PG8_BAR; }
    }
    PG8_WAIT_V(0);
    if constexpr (!ALIGN_EPI) { if (wr == 0) PG8_BAR; }
    PG8_BAR;
    if constexpr (Epi::AFTER_DRAIN) { E.fused(acc, cur, wr, wc, fr, fq, lds, wid, lane); S.done(cur); }
#undef PG8_SA
#undef PG8_SB
#undef PG8_STAGE
#undef PG8_LDA
#undef PG8_LDB
#undef PG8_MMA
#undef PG8_WAIT_V
#undef PG8_WAIT_L
#undef PG8_BAR
#undef PG8_SCHED
}
}

constexpr int NWAVES = 8, NTHREADS = NWAVES * 64;
constexpr int BATCH = 8, SEQ = 4096, D = 1024, M = BATCH * SEQ, FF = 2816, DEPTH = 4;
constexpr int EVEN_IN = 3584, GLA_IN = 3088, GLA_INP = 3328;
static_assert(M == pg8::MROWS, "row count");
constexpr int E_RQ = 0, E_RK = 512, E_RV = 1024, E_RG = 1536, E_DQ = 2048, E_DK = 2560, E_DV = 3072;
constexpr int G_Q = 0, G_K = 512, G_V = 1024, G_R = 2048, G_A = 3072;
constexpr float EPS = 1e-6f;
#define HM(c0, nh, dh, b, h) ((size_t)(c0) * M + ((size_t)((b) * (nh) + (h)) * SEQ) * (dh))

constexpr size_t MiB = 1u << 20;
constexpr size_t WS_CTL = 0, CTL_ZERO_BYTES = 32768;
constexpr size_t WS_SSP = 1 * MiB;
constexpr size_t WS_TAB = 3 * MiB;
constexpr size_t TAB_RC = WS_TAB, TAB_RS = WS_TAB + 1 * MiB, TAB_DC = WS_TAB + 2 * MiB, TAB_DS = WS_TAB + 2 * MiB + 128 * 1024;
constexpr size_t WS_W = 8 * MiB;
constexpr size_t W_GU0 = WS_W, W_D0 = W_GU0 + (size_t)2 * FF * D * 2, W_GU1 = W_D0 + (size_t)D * FF * 2, W_D1 = W_GU1 + (size_t)2 * FF * D * 2,
                 W_IN = W_D1 + (size_t)D * FF * 2, W_OUT = W_IN + (size_t)EVEN_IN * D * 2, W_END = W_OUT + (size_t)D * D * 2;
constexpr size_t WS_XB = 56 * MiB;
constexpr size_t WS_ACT = 120 * MiB;
constexpr size_t WS_CAT = 344 * MiB;
constexpr size_t WS_END = 408 * MiB;
static_assert(W_END <= WS_XB && WS_XB + (size_t)M * D * 2 <= WS_ACT && WS_ACT + (size_t)M * EVEN_IN * 2 <= WS_CAT && WS_CAT + (size_t)M * D * 2 <= WS_END, "d_ws map");
constexpr int CW_BAR = 4096;

constexpr int RING_OFF = 0, RING_BYTES = 131072;
constexpr int LDSCTL_OFF = 161792, MISC_OFF = LDSCTL_OFF + 320, PTR_OFF = LDSCTL_OFF + 1024;
constexpr int LDS_BYTES = 163840;
static_assert(PTR_OFF + 19 * 8 <= LDS_BYTES && RING_BYTES <= LDSCTL_OFF, "LDS map");

#define GAS __attribute__((address_space(1)))
#define LAS __attribute__((address_space(3)))
typedef unsigned short bf16;
typedef unsigned v4u __attribute__((ext_vector_type(4)));
typedef float f32x4 __attribute__((ext_vector_type(4)));
typedef short bf16x8 __attribute__((ext_vector_type(8)));
typedef GAS unsigned gu32;
typedef GAS unsigned long long gu64;
#define RLX_AGENT __ATOMIC_RELAXED, __HIP_MEMORY_SCOPE_AGENT
#define LDS_WAIT() asm volatile("s_waitcnt lgkmcnt(0)" ::: "memory")
#define VM_WAIT() asm volatile("s_waitcnt vmcnt(0)" ::: "memory")
__device__ __forceinline__ unsigned long long rt() { return __builtin_amdgcn_s_memrealtime(); }
__device__ __forceinline__ unsigned f2bf(float f) { unsigned u = __builtin_bit_cast(unsigned, f); return (u + 0x7fffu + ((u >> 16) & 1u)) >> 16; }
__device__ __forceinline__ unsigned pk2(float lo, float hi) { return f2bf(lo) | (f2bf(hi) << 16); }

#define XB_TMO      128
#ifndef XB_MIS_EXPECT
#define XB_MIS_EXPECT 0u
#endif
#define XB_MIS      192
#define XB_XCNT(j)  (256  + 64 * (j))
#define XB_XSUB(j)  (1280 + 64 * (j))
#define XB_XGEN(j)  (2304 + 64 * (j))
#define XB_TOP      3328
#define XB_TOPGEN   3392
#define XB_TEAM(t)  (3520 + 8 * (t))
#define XCD_BAR_WORDS 4096
#define XB_SPIN_CAP (1u << 18)

__device__ __forceinline__ unsigned xb_ld(unsigned* p)              { return __hip_atomic_load(p, __ATOMIC_RELAXED, __HIP_MEMORY_SCOPE_AGENT); }
__device__ __forceinline__ unsigned xb_add(unsigned* p, unsigned v) { return __hip_atomic_fetch_add(p, v, __ATOMIC_RELAXED, __HIP_MEMORY_SCOPE_AGENT); }
__device__ __forceinline__ unsigned xb_xcc_id() { return (unsigned)__builtin_amdgcn_s_getreg((3 << 11) | 20) & 0xFu; }
#define XB_SPIN(cond, bar) do { unsigned _sp = 0; while (cond) { __builtin_amdgcn_s_sleep(1); \
    if ((++_sp & 255u) == 0u) { if (xb_ld(&(bar)[XB_TMO])) break; if (_sp > XB_SPIN_CAP) { atomicAdd(&(bar)[XB_TMO], 1u); break; } } } } while (0)

struct XcdBarrier {
    unsigned* bar; unsigned x;
    volatile LAS unsigned* st;
};

__device__ __forceinline__ XcdBarrier xcd_barrier_post(unsigned* bar, volatile LAS unsigned* st, int tid) {
    XcdBarrier b; b.bar = bar; b.x = xb_xcc_id(); b.st = st;
    if (tid == 0) { if ((blockIdx.x & 7u) != b.x) (void)xb_add(&bar[XB_MIS], 1u); (void)xb_add(&bar[XB_XCNT(b.x)], 1u); }
    return b;
}
__device__ __forceinline__ void xcd_barrier_complete(unsigned* bar, unsigned x, unsigned& nloc, unsigned& nx) {
    const unsigned G = gridDim.x * gridDim.y * gridDim.z;
    unsigned sum, cnt, mine, sp = 0u;
    for (;;) {
        sum = 0u; cnt = 0u; mine = 0u;
#pragma unroll
        for (unsigned j = 0; j < 16; ++j) { const unsigned c = xb_ld(&bar[XB_XCNT(j)]); sum += c; cnt += (c > 0u) ? 1u : 0u; mine = (j == x) ? c : mine; }
        if (sum == G) break;
        __builtin_amdgcn_s_sleep(1);
        if ((++sp & 255u) == 0u) { if (xb_ld(&bar[XB_TMO])) break; if (sp > XB_SPIN_CAP) { atomicAdd(&bar[XB_TMO], 1u); break; } }
    }
    nloc = mine > 0u ? mine : 1u; nx = cnt > 0u ? cnt : 1u;
}

template <int LOCAL = 0>
__device__ __forceinline__ void xcd_barrier(const XcdBarrier& b, int tid) {
    asm volatile("s_waitcnt vmcnt(0)" ::: "memory");
    __syncthreads();
    if (tid == 0) {
        unsigned* bar = b.bar;
        __builtin_amdgcn_s_waitcnt(0);
        unsigned nloc = b.st[0], nx = b.st[1];
        if (nloc == 0u) { xcd_barrier_complete(bar, b.x, nloc, nx); b.st[0] = nloc; b.st[1] = nx; }
        bool skip_top = false;
        if (LOCAL) { unsigned lk = b.st[2];
            if (lk == 0u) { lk = (xb_ld(&bar[XB_MIS]) == XB_MIS_EXPECT && nx == 8u && nloc == 32u && gridDim.x == 256u) ? 1u : 2u; b.st[2] = lk; }
            skip_top = lk == 1u; }
        if (LOCAL == 2 && skip_top) {
            unsigned* c = &bar[XB_TEAM((blockIdx.x & 7u) * 8u + ((blockIdx.x >> 3) & 7u))];
            const unsigned tgt = (xb_add(c, 1u) / 4u + 1u) * 4u;
            XB_SPIN(xb_ld(c) < tgt, bar);
            __builtin_amdgcn_fence(__ATOMIC_ACQUIRE, "agent");
            asm volatile("s_waitcnt vmcnt(0)" ::: "memory");
        } else {
        const unsigned old = xb_add(&bar[XB_XSUB(b.x)], 1u);
        const unsigned gen = old / nloc;
        if (old + 1u == (gen + 1u) * nloc) {
          if (!skip_top) {
            __builtin_amdgcn_fence(__ATOMIC_RELEASE, "agent");
            asm volatile("s_waitcnt vmcnt(0)" ::: "memory");
            const unsigned og = xb_add(&bar[XB_TOP], 1u);
            const unsigned tg = og / nx;
            if (og + 1u == (tg + 1u) * nx) xb_add(&bar[XB_TOPGEN], 1u);
            else XB_SPIN(xb_ld(&bar[XB_TOPGEN]) == tg, bar);
          }
            __builtin_amdgcn_fence(__ATOMIC_ACQUIRE, "agent");
            xb_add(&bar[XB_XGEN(b.x)], 1u);
            asm volatile("s_waitcnt vmcnt(0)" ::: "memory");
        } else {
            XB_SPIN(xb_ld(&bar[XB_XGEN(b.x)]) == gen, bar);
            __builtin_amdgcn_fence(__ATOMIC_ACQUIRE, "agent");
            asm volatile("s_waitcnt vmcnt(0)" ::: "memory");
        }
        }
    }
    __syncthreads();
}

__constant__ float RET_FREQ[64] = {1.000000000e+00f, 8.639884591e-01f, 7.464760542e-01f, 6.449466944e-01f, 5.572264791e-01f, 4.814372361e-01f, 4.159561992e-01f, 3.593813777e-01f, 3.105013371e-01f, 2.682695687e-01f, 2.317818105e-01f, 2.002568096e-01f, 1.730195731e-01f, 1.494869143e-01f, 1.291549653e-01f, 1.115883961e-01f, 9.641107172e-02f, 8.329805732e-02f, 7.196855545e-02f, 6.218000501e-02f, 5.372280627e-02f, 4.641588405e-02f, 4.010278732e-02f, 3.464834765e-02f, 2.993577160e-02f, 2.586415969e-02f, 2.234633639e-02f, 1.930697635e-02f, 1.668100432e-02f, 1.441219542e-02f, 1.245197095e-02f, 1.075835899e-02f, 9.295095690e-03f, 8.030855097e-03f, 6.938565988e-03f, 5.994840991e-03f, 5.179473665e-03f, 4.475005437e-03f, 3.866352839e-03f, 3.340484342e-03f, 2.886139788e-03f, 2.493591513e-03f, 2.154434333e-03f, 1.861406374e-03f, 1.608233666e-03f, 1.389495330e-03f, 1.200507861e-03f, 1.037224894e-03f, 8.961503627e-04f, 7.742635789e-04f, 6.689548027e-04f, 5.779692437e-04f, 4.993587499e-04f, 4.314401885e-04f, 3.727593285e-04f, 3.220597573e-04f, 2.782559313e-04f, 2.404099068e-04f, 2.077113895e-04f, 1.794602431e-04f, 1.550515735e-04f, 1.339627634e-04f, 1.157422885e-04f, 9.999999747e-05f};
__constant__ float ROPE_FREQ[8] = {1.000000000e+00f, 1.939227432e-01f, 3.760603070e-02f, 7.292664610e-03f, 1.414213562e-03f, 2.742481884e-04f, 5.318295734e-05f, 1.031338525e-05f};
static_assert((CW_BAR + XCD_BAR_WORDS) * 4 <= (int)CTL_ZERO_BYTES, "the grid barrier's words are inside the per-call memset");
struct Args { const float* in[17]; float* out; unsigned char* ws; };
enum { I_X = 0, I_PRE_NORM = 1, I_PRE_WG = 2, I_PRE_WU = 3, I_PRE_WD = 4, I_MIX_NORM = 5, I_AB_IN = 6, I_AB_OUT = 7, I_GLA_IN = 8, I_GLA_A2 = 9, I_GLA_BA = 10, I_GLA_OUT = 11,
       I_POST_NORM = 12, I_POST_WG = 13, I_POST_WU = 14, I_POST_WD = 15, I_FINAL = 16, I_OUT = 17, I_WS = 18, N_PTRS = 19 };
struct Frame {
    LAS unsigned char* lds;
    int tid, lane, wave, G, bid;
};
__device__ __forceinline__ unsigned char* tabp(const Frame& F, int idx) {
    int off_ = PTR_OFF + 8 * idx; asm volatile("" : "+s"(off_));
    const volatile LAS unsigned* T = (const volatile LAS unsigned*)(F.lds + off_);
    const unsigned lo = __builtin_amdgcn_readfirstlane(T[0]), hi = __builtin_amdgcn_readfirstlane(T[1]);
    GAS unsigned char* gp_ = (GAS unsigned char*)(((unsigned long long)hi << 32) | (unsigned long long)lo);
    return (unsigned char*)gp_;
}
#define AP(idx) ((const float*)tabp(F, idx))
#define WSP() tabp(F, I_WS)
#define OUTP() ((float*)tabp(F, I_OUT))
__device__ __forceinline__ int lnd(int v) { asm volatile("" : "+s"(v)); return v; }
__device__ __forceinline__ int hw_lane() { return (int)__builtin_amdgcn_mbcnt_hi(~0u, __builtin_amdgcn_mbcnt_lo(~0u, 0u)); }
__device__ __forceinline__ int hw_lane_v() { int l; asm volatile("v_mbcnt_lo_u32_b32 %0, -1, 0\n\tv_mbcnt_hi_u32_b32 %0, -1, %0" : "=v"(l)); return l; }
__device__ __forceinline__ Frame relaunder(const Frame& F0) { Frame F = F0; int t_ = F0.wave * 64 + hw_lane_v(); asm volatile("" : "+s"(F.bid)); F.tid = t_; F.lane = F.tid & 63; F.wave = __builtin_amdgcn_readfirstlane(F.tid >> 6);
    unsigned lb_ = 0u; asm volatile("" : "+s"(lb_)); F.lds = F0.lds + lb_; return F; }
__device__ __forceinline__ float wave_sum(float v) {
    v += xsw<1>(v); v += xsw<2>(v); v += xsw<4>(v); v += xsw<8>(v); v += xsw<16>(v);
    return sum32(v);
}
__device__ __forceinline__ float bf2f(bf16 h) { return __builtin_bit_cast(float, (unsigned)h << 16); }
__device__ __forceinline__ float bflo(unsigned w) { return __builtin_bit_cast(float, w << 16); }
__device__ __forceinline__ float bfhi(unsigned w) { return __builtin_bit_cast(float, w & 0xffff0000u); }
__device__ __forceinline__ bf16 f2bf_rne(float f) { return (bf16)f2bf(f); }

#ifndef F8_MASK
#define F8_MASK 0xE0
#endif
#define F8SLOT(s_) (((F8_MASK) >> (s_)) & 1)
#ifndef F8A_MASK
#define F8A_MASK 0x00
#endif
#define F8ASLOT(s_) ((s_) < 8 && (((F8A_MASK) >> (s_)) & 1))
#ifndef I8A_MASK
#define I8A_MASK 0xFF
#endif
#define I8ASLOT(s_) ((s_) < 8 && (((I8A_MASK) >> (s_)) & 1))
#define I8CONV(s_) I8ASLOT(s_)
#ifndef I8_WCLIP
#define I8_WCLIP 3.4f
#endif
constexpr size_t WS_I8S = 2048;
#define I8SW(s_) (*(const GAS float*)(WSP() + WS_I8S + 4 * (s_)))
static_assert((I8A_MASK & F8A_MASK) == 0, "a gate|up GEMM is int8 or fp8, not both");
static_assert((F8A_MASK & ~F8_MASK) == 0, "an fp8 gate|up GEMM writes e4m3 hidden rows: its down projection must be fp8 as well");
constexpr size_t WS_X8 = 408 * MiB;
#define XB8 (WSP() + WS_X8)
constexpr int XB8_D = (int)(WS_X8 - WS_XB);
__device__ __forceinline__ void tr_item(const float* W, int K, int N, int Npad, const float* gain, bf16* WT, int gu, LAS float* scr, int item, int lane, float f8s = 0.f) {
    const int nblk = Npad / 32, kb = item / nblk, nb = item % nblk, k0 = 64 * kb, n0 = 32 * nb;
    {
        const int c4 = lane & 7; const bool ok = n0 + 4 * c4 < N;
        const GAS float* src = (const GAS float*)W + (size_t)(k0 + (lane >> 3)) * N + n0 + 4 * c4;
        f32x4 v[8];
#pragma unroll
        for (int i = 0; i < 8; ++i) v[i] = ok ? __builtin_nontemporal_load((const GAS f32x4*)(src + (size_t)(8 * i) * N)) : (f32x4){0.f, 0.f, 0.f, 0.f};
#pragma unroll
        for (int i = 0; i < 8; ++i) { const int kk = 8 * i + (lane >> 3); const float gn = gain ? ((const GAS float*)gain)[k0 + kk] : 1.0f; LAS float* s = scr + kk * 33 + 4 * c4;
            s[0] = v[i][0] * gn; s[1] = v[i][1] * gn; s[2] = v[i][2] * gn; s[3] = v[i][3] * gn;
            }
    }
    LDS_WAIT(); asm volatile("" ::: "memory");
    const int c = lane & 7;
#pragma unroll
    for (int j = 0; j < 4; ++j) { const int n = (lane >> 3) + 8 * j; const LAS float* s = scr + (8 * c) * 33 + n;
        v4u o; o.x = pk2(s[0 * 33], s[1 * 33]); o.y = pk2(s[2 * 33], s[3 * 33]); o.z = pk2(s[4 * 33], s[5 * 33]); o.w = pk2(s[6 * 33], s[7 * 33]);
        int drow = n0 + n;
        if (gu == 3) {
            if (drow < 1024) { const int j = drow & 127; drow = (drow & ~127) + (j < 64 ? 2 * j : 2 * (j - 64) + 1); }
            else if (drow >= 2048 && drow < 3072) { const int j = drow & 63; drow = (drow & ~63) + (j < 8 ? 2 * j : (j < 16 ? 2 * (j - 8) + 1 : j)); }
        } else if (gu == 1 || gu == 2) drow = (drow >> 7) * 256 + (drow & 127) + (gu == 2 ? 128 : 0);
        if (f8s < 0.f) {
            int q[8];
#pragma unroll
            for (int e = 0; e < 8; ++e) q[e] = (int)fminf(fmaxf(rintf(s[e * 33] * -f8s), -127.f), 127.f) & 0xff;
            typedef int i32x2q __attribute__((ext_vector_type(2)));
            *(GAS i32x2q*)((GAS unsigned char*)WT + (size_t)drow * K + k0 + 8 * c) = (i32x2q){q[0] | (q[1] << 8) | (q[2] << 16) | (q[3] << 24), q[4] | (q[5] << 8) | (q[6] << 16) | (q[7] << 24)};
        } else
        if (f8s != 0.f) {
            const int w0 = __builtin_amdgcn_cvt_pk_fp8_f32(s[0 * 33] * f8s, s[1 * 33] * f8s, 0, false), w0b = __builtin_amdgcn_cvt_pk_fp8_f32(s[2 * 33] * f8s, s[3 * 33] * f8s, w0, true);
            const int w1 = __builtin_amdgcn_cvt_pk_fp8_f32(s[4 * 33] * f8s, s[5 * 33] * f8s, 0, false), w1b = __builtin_amdgcn_cvt_pk_fp8_f32(s[6 * 33] * f8s, s[7 * 33] * f8s, w1, true);
            typedef int i32x2_ __attribute__((ext_vector_type(2)));
            *(GAS i32x2_*)((GAS unsigned char*)WT + (size_t)drow * K + k0 + 8 * c) = (i32x2_){w0b, w1b};
        } else
        *(GAS v4u*)(WT + (size_t)drow * K + k0 + 8 * c) = o; }
    LDS_WAIT(); asm volatile("" ::: "memory");
}
__device__ __forceinline__ void convert_weights(const Frame& F0, int l, int part, float pro_s0 = 0.f, float pro_s1 = 0.f) {
    const Frame F = relaunder(F0);
    LAS float* scr = (LAS float*)(F.lds + RING_OFF + F.wave * 16384);
    const int gw = F.bid * NWAVES + F.wave, NGW = F.G * NWAVES;
    unsigned char* ws = WSP();
    constexpr int I_G = (D / 64) * (FF / 32), I_DN = (FF / 64) * (D / 32), I_O = (D / 64) * (D / 32);
    const bool odd = (l & 1) != 0; const int li = l >> 1;
    const int nin = odd ? GLA_IN : EVEN_IN, ninp = odd ? GLA_INP : EVEN_IN; const int I_IN = (D / 64) * (ninp / 32);
    const float* win = odd ? AP(I_GLA_IN) + (size_t)li * D * GLA_IN : AP(I_AB_IN) + (size_t)li * D * EVEN_IN;
    const float* wout = odd ? AP(I_GLA_OUT) + (size_t)li * D * D : AP(I_AB_OUT) + (size_t)li * D * D;
    const size_t fo = (size_t)l * D * FF;
    const int NITEMS = 6 * I_G + I_IN + I_O;
    static_assert(I_G == I_DN, "item counts");
    const int nitems = part == 0 ? NITEMS : (part == 1 ? 3 * I_G + I_IN : 3 * I_G + I_O);
    const float i8s0 = I8CONV(2 * l) ? (part == 0 ? -pro_s0 : -I8SW(2 * l)) : 0.f, i8s1 = I8CONV(2 * l + 1) ? (part == 0 ? -pro_s1 : -I8SW(2 * l + 1)) : 0.f;
    for (int it = gw; it < nitems; it += NGW) {
        int r = part == 2 ? (it < 3 * I_G ? it + 3 * I_G : it + 3 * I_G + I_IN) : ((part == 1 && it >= 3 * I_G) ? it + 3 * I_G : it);
        if (r < I_G) { tr_item(AP(I_PRE_WG) + fo, D, FF, FF, AP(I_PRE_NORM) + l * D, (bf16*)(ws + W_GU0), 1, scr, r, F.lane, I8CONV(2 * l) ? i8s0 : (F8ASLOT(2 * l) ? pg8::F8_GUSCALE : 0.f)); continue; } r -= I_G;
        if (r < I_G) { tr_item(AP(I_PRE_WU) + fo, D, FF, FF, AP(I_PRE_NORM) + l * D, (bf16*)(ws + W_GU0), 2, scr, r, F.lane, I8CONV(2 * l) ? i8s0 : (F8ASLOT(2 * l) ? pg8::F8_GUSCALE : 0.f)); continue; } r -= I_G;
        if (r < I_G) { tr_item(AP(I_PRE_WD) + fo, FF, D, D, nullptr, (bf16*)(ws + W_D0), 0, scr, r, F.lane, F8SLOT(2 * l) ? pg8::F8_WSCALE : 0.f); continue; } r -= I_G;
        if (r < I_G) { tr_item(AP(I_POST_WG) + fo, D, FF, FF, AP(I_POST_NORM) + l * D, (bf16*)(ws + W_GU1), 1, scr, r, F.lane, I8CONV(2 * l + 1) ? i8s1 : (F8ASLOT(2 * l + 1) ? pg8::F8_GUSCALE : 0.f)); continue; } r -= I_G;
        if (r < I_G) { tr_item(AP(I_POST_WU) + fo, D, FF, FF, AP(I_POST_NORM) + l * D, (bf16*)(ws + W_GU1), 2, scr, r, F.lane, I8CONV(2 * l + 1) ? i8s1 : (F8ASLOT(2 * l + 1) ? pg8::F8_GUSCALE : 0.f)); continue; } r -= I_G;
        if (r < I_G) { tr_item(AP(I_POST_WD) + fo, FF, D, D, nullptr, (bf16*)(ws + W_D1), 0, scr, r, F.lane, F8SLOT(2 * l + 1) ? pg8::F8_WSCALE : 0.f); continue; } r -= I_G;
        if (r < I_IN) { tr_item(win, D, nin, ninp, AP(I_MIX_NORM) + l * D, (bf16*)(ws + W_IN), odd ? 0 : 3, scr, r, F.lane); continue; } r -= I_IN;
        tr_item(wout, D, D, D, nullptr, (bf16*)(ws + W_OUT), 0, scr, r, F.lane);
    }
}
__device__ __forceinline__ float i8_scale_block(const Frame& F, int s) {
    const int l = s >> 1; const bool post = (s & 1) != 0; const size_t fo = (size_t)l * D * FF;
    const GAS float* wg = (const GAS float*)(AP(post ? I_POST_WG : I_PRE_WG) + fo); const GAS float* wu = (const GAS float*)(AP(post ? I_POST_WU : I_PRE_WU) + fo);
    const GAS float* gn = (const GAS float*)(AP(post ? I_POST_NORM : I_PRE_NORM) + l * D);
    float ss = 0.f, gm = 0.f;
    {
        f32x4 a[8], b[8];
#pragma unroll
        for (int i = 0; i < 8; ++i) { a[i] = ((const GAS f32x4*)wg)[F.tid + i * NTHREADS]; b[i] = ((const GAS f32x4*)wu)[F.tid + i * NTHREADS]; }
        static_assert(8 * NTHREADS * 4 == 16384, "sample size");
        for (int i = F.tid; i < D; i += NTHREADS) gm = fmaxf(gm, fabsf(gn[i]));
#pragma unroll
        for (int i = 0; i < 8; ++i) ss += a[i][0] * a[i][0] + a[i][1] * a[i][1] + a[i][2] * a[i][2] + a[i][3] * a[i][3] + b[i][0] * b[i][0] + b[i][1] * b[i][1] + b[i][2] * b[i][2] + b[i][3] * b[i][3];
    }
    ss = wave_sum(ss);
    gm = fmaxf(gm, xsw<1>(gm)); gm = fmaxf(gm, xsw<2>(gm)); gm = fmaxf(gm, xsw<4>(gm)); gm = fmaxf(gm, xsw<8>(gm)); gm = fmaxf(gm, xsw<16>(gm)); gm = max32(gm);
    LAS float* red = (LAS float*)(F.lds + RING_OFF);
    if (F.lane == 0) { red[F.wave] = ss; red[8 + F.wave] = gm; }
    __syncthreads();
    float st = 0.f, gt = 0.f;
    for (int w = 0; w < NWAVES; ++w) { st += red[w]; gt = fmaxf(gt, red[8 + w]); }
    __syncthreads();
    const float sigma = sqrtf(st * (1.0f / (2.0f * 16384.0f)));
    return 127.0f / fmaxf(I8_WCLIP * sigma * gt, 1e-20f);
}
__device__ __forceinline__ float i8_scales(const Frame& F0, float& s0) {
    const Frame F = relaunder(F0);
    float s1 = 0.f; s0 = 0.f;
    if (I8ASLOT(0)) { s0 = i8_scale_block(F, 0); if (F.bid == 0 && F.tid == 0) *(GAS float*)(WSP() + WS_I8S) = s0; }
    if (I8ASLOT(1)) { s1 = i8_scale_block(F, 1); if (F.bid == 1 && F.tid == 0) *(GAS float*)(WSP() + WS_I8S + 4) = s1; }
    if (F.bid >= 2 && F.bid < 8 && I8ASLOT(F.bid)) { const float v = i8_scale_block(F, F.bid); if (F.tid == 0) *(GAS float*)(WSP() + WS_I8S + 4 * F.bid) = v; }
    return s1;
}
__device__ __forceinline__ void prologue_rows(const Frame& F0) {
    const Frame F = relaunder(F0);
    unsigned char* ws = WSP();
    const int gw = F.bid * NWAVES + F.wave, NGW = F.G * NWAVES;
    bf16* XB = (bf16*)(ws + WS_XB); float* ssp = (float*)(ws + WS_SSP);
    for (int m = gw; m < M; m += NGW) {
        const GAS f32x4* xr = (const GAS f32x4*)(AP(I_X) + (size_t)m * D) + F.lane;
        GAS unsigned long long* o8 = (GAS unsigned long long*)(XB + (size_t)m * D) + F.lane;
        float s = 0.f;
#pragma unroll
        for (int j = 0; j < 4; ++j) { const f32x4 v = xr[64 * j]; s += (v.x * v.x + v.y * v.y) + (v.z * v.z + v.w * v.w);
            o8[64 * j] = (unsigned long long)pk2(v.x, v.y) | ((unsigned long long)pk2(v.z, v.w) << 32); }
        s = wave_sum(s);
        if (F.lane < 16) ssp[(size_t)m * 16 + F.lane] = (F.lane == 0) ? s : 0.f;
    }
    const int gt = F.bid * NTHREADS + F.tid, NGT = F.G * NTHREADS;
    float* rc = (float*)(ws + TAB_RC); float* rsn = (float*)(ws + TAB_RS); float* dc = (float*)(ws + TAB_DC); float* ds = (float*)(ws + TAB_DS);
    for (int e = gt; e < SEQ * 64; e += NGT) { const int t = e >> 6, i = e & 63; const float ang = (float)t * RET_FREQ[i];
        double rev = (double)ang * 0.15915494309189535; rev -= __builtin_rint(rev); const float r = (float)rev;
        rc[e] = __builtin_amdgcn_cosf(r); rsn[e] = __builtin_amdgcn_sinf(r); }
    for (int e = gt; e < SEQ * 8; e += NGT) { const int t = e >> 3, i = e & 7; const float ang = (float)t * ROPE_FREQ[i];
        double rev = (double)ang * 0.15915494309189535; rev -= __builtin_rint(rev); const float r = (float)rev;
        dc[e] = __builtin_amdgcn_cosf(r); ds[e] = __builtin_amdgcn_sinf(r); }
}

__device__ __forceinline__ void quant_rows(const Frame& F0, int slot) {
    const Frame F = relaunder(F0);
    unsigned char* ws = WSP();
    const int pan0 = (F.bid & 7) * 16 + ((F.bid >> 3) & 7), widx = (F.bid >> 6) * NWAVES + F.wave;
    const bf16* XBp = (const bf16*)(ws + WS_XB); unsigned char* X8 = ws + WS_X8; float* ssp = (float*)(ws + WS_SSP);
    const float swi = 1.0f / I8SW(slot);
    for (int k = 0; k < 16; ++k) {
        const int m = (pan0 + (k & 8)) * 256 + widx + 32 * (k & 7);
        const GAS v4u* xr = (const GAS v4u*)(XBp + (size_t)m * D) + 2 * F.lane;
        const v4u a = xr[0], b = xr[1];
        float v[16];
#pragma unroll
        for (int i = 0; i < 4; ++i) { v[2 * i] = bflo(a[i]); v[2 * i + 1] = bfhi(a[i]); v[8 + 2 * i] = bflo(b[i]); v[8 + 2 * i + 1] = bfhi(b[i]); }
        float ss = 0.f, mx = 0.f;
#pragma unroll
        for (int i = 0; i < 16; ++i) { ss += v[i] * v[i]; mx = fmaxf(mx, fabsf(v[i])); }
        ss = wave_sum(ss);
        mx = fmaxf(mx, xsw<1>(mx)); mx = fmaxf(mx, xsw<2>(mx)); mx = fmaxf(mx, xsw<4>(mx)); mx = fmaxf(mx, xsw<8>(mx)); mx = fmaxf(mx, xsw<16>(mx)); mx = max32(mx);
        mx = fmaxf(mx, 1e-20f);
        const float sx = 127.0f / mx;
        int q[16];
#pragma unroll
        for (int i = 0; i < 16; ++i) q[i] = (int)rintf(v[i] * sx) & 0xff;
        v4u o;
#pragma unroll
        for (int i = 0; i < 4; ++i) o[i] = (unsigned)(q[4 * i] | (q[4 * i + 1] << 8) | (q[4 * i + 2] << 16) | (q[4 * i + 3] << 24));
        *((GAS v4u*)(X8 + (size_t)m * D) + F.lane) = o;
        const float rstd = 1.0f / sqrtf(ss * (1.0f / D) + EPS), reff = rstd * mx * (1.0f / 127.0f) * swi;
        if (F.lane < 16) ssp[(size_t)m * 16 + F.lane] = (F.lane == 0) ? 1024.0f * (1.0f / (reff * reff) - EPS) : 0.f;
    }
}

__device__ __forceinline__ void final_norm(const Frame& F0) {
    const Frame F = relaunder(F0);
    const int gw = F.bid * NWAVES + F.wave, NGW = F.G * NWAVES;
    const bf16* XBp = (const bf16*)(WSP() + WS_XB); float* out = OUTP(); const GAS f32x4* gr = (const GAS f32x4*)AP(I_FINAL);
    for (int m = gw; m < M; m += NGW) {
        const v4u w0 = *(const GAS v4u*)(XBp + (size_t)m * D + F.lane * 8), w1 = *(const GAS v4u*)(XBp + (size_t)m * D + 512 + F.lane * 8);
        float v[16]; float s = 0.f;
#pragma unroll
        for (int i = 0; i < 4; ++i) { v[2 * i] = bflo(w0[i]); v[2 * i + 1] = bfhi(w0[i]); v[8 + 2 * i] = bflo(w1[i]); v[8 + 2 * i + 1] = bfhi(w1[i]); }
#pragma unroll
        for (int i = 0; i < 16; ++i) s += v[i] * v[i];
        const float rstd = 1.0f / sqrtf(wave_sum(s) * (1.0f / D) + EPS);
        GAS f32x4* o = (GAS f32x4*)(out + (size_t)m * D);
#pragma unroll
        for (int hh = 0; hh < 2; ++hh)
#pragma unroll
            for (int q = 0; q < 2; ++q) { const int c4 = hh * 128 + F.lane * 2 + q; const f32x4 g = gr[c4];
                o[c4] = (f32x4){v[hh * 8 + q * 4] * rstd * g[0], v[hh * 8 + q * 4 + 1] * rstd * g[1], v[hh * 8 + q * 4 + 2] * rstd * g[2], v[hh * 8 + q * 4 + 3] * rstd * g[3]}; }
    }
}


__device__ __forceinline__ float silu_f(float g) { return g * __builtin_amdgcn_rcpf(1.0f + __builtin_amdgcn_exp2f(-1.4426950408889634f * g)); }
typedef float f32x16 __attribute__((ext_vector_type(16)));
typedef short s16x4 __attribute__((ext_vector_type(4)));
typedef float f32x2_t __attribute__((ext_vector_type(2)));
typedef __bf16 bf16x2_t __attribute__((ext_vector_type(2)));
#define MFMA32(a, b, c) __builtin_amdgcn_mfma_f32_32x32x16_bf16((a), (b), (c), 0, 0, 0)
__device__ __forceinline__ int crow(int reg, int h) { return (reg & 3) + 8 * (reg >> 2) + 4 * h; }
__device__ __forceinline__ unsigned cvtpk(float lo, float hi) { f32x2_t v = {lo, hi}; bf16x2_t b = __builtin_convertvector(v, bf16x2_t); return __builtin_bit_cast(unsigned, b); }
__device__ __forceinline__ bf16 cvt1(float v) { return (bf16)(cvtpk(v, 0.f) & 0xffffu); }
#define PACK_STEP(x, s) __builtin_bit_cast(bf16x8, (v4u){cvtpk((x)[8 * (s)], (x)[8 * (s) + 1]), cvtpk((x)[8 * (s) + 2], (x)[8 * (s) + 3]), cvtpk((x)[8 * (s) + 4], (x)[8 * (s) + 5]), cvtpk((x)[8 * (s) + 6], (x)[8 * (s) + 7])})
typedef const LAS unsigned char* lcp;
__device__ __forceinline__ int lndv(int v) { asm volatile("" : "+v"(v)); return v; }
__device__ __forceinline__ bf16x8 ld_row(lcp img, int P, int row0, int k0, int r, int h) { return *(const LAS bf16x8*)(img + (row0 + r) * P + (k0 + 8 * h) * 2); }
__device__ __forceinline__ bf16x8 ld_row_perm(lcp img, int P, int row0, int k0, int r, int h) {
    const s16x4 lo = *(const LAS s16x4*)(img + (row0 + r) * P + (k0 + 4 * h) * 2), hi = *(const LAS s16x4*)(img + (row0 + r) * P + (k0 + 8 + 4 * h) * 2);
    return __builtin_shufflevector(lo, hi, 0, 1, 2, 3, 4, 5, 6, 7); }
__device__ __forceinline__ s16x4 trd(lcp p) { return __builtin_bit_cast(s16x4, __builtin_amdgcn_ds_read_tr16_b64_v4i16((LAS s16x4*)p)); }
__device__ __forceinline__ bf16x8 ld_tr(lcp img, int P, int k0, int c0, int lane) {
    const int i16 = lane & 15, q = i16 >> 2, p = i16 & 3, blk = (lane >> 4) & 1, h = lane >> 5;
    lcp a = img + (k0 + 8 * h + q) * P + (c0 + 16 * blk + 4 * p) * 2;
    const s16x4 lo = trd(a), hi = trd(a + 4 * P);
    return __builtin_shufflevector(lo, hi, 0, 1, 2, 3, 4, 5, 6, 7); }
__device__ __forceinline__ bf16x8 ld_tr_perm(lcp img, int P, int k0, int c0, int lane) {
    const int i16 = lane & 15, q = i16 >> 2, p = i16 & 3, blk = (lane >> 4) & 1, h = lane >> 5;
    lcp a = img + (k0 + 4 * h + q) * P + (c0 + 16 * blk + 4 * p) * 2;
    const s16x4 lo = trd(a), hi = trd(a + 8 * P);
    return __builtin_shufflevector(lo, hi, 0, 1, 2, 3, 4, 5, 6, 7); }
template <int R, int C> __device__ __forceinline__ void tile_ld(v4u (&v)[R * C / 8 / NTHREADS], const bf16* g, size_t gp, int tid) {
    constexpr int CPR = C / 8, RS = NTHREADS / CPR;
    static_assert(NTHREADS % CPR == 0, "tile shape");
    const unsigned voff = (unsigned)((tid / CPR) * (int)gp + (tid % CPR) * 8) * 2u;
    const GAS unsigned char* gb = (const GAS unsigned char*)g;
#pragma unroll
    for (int i = 0; i < R * C / 8 / NTHREADS; ++i) v[i] = *(const GAS v4u*)(gb + (size_t)i * RS * gp * 2 + voff);
}
template <int R, int C> __device__ __forceinline__ void tile_st(const v4u (&v)[R * C / 8 / NTHREADS], LAS unsigned char* img, int P, int tid) {
    constexpr int CPR = C / 8, RS = NTHREADS / CPR;
    LAS unsigned char* lb = img + (tid / CPR) * P + (tid % CPR) * 16;
#pragma unroll
    for (int i = 0; i < R * C / 8 / NTHREADS; ++i) *(LAS v4u*)(lb + i * RS * P) = v[i];
}
template <int R, int C> __device__ __forceinline__ void stage_tile(LAS unsigned char* img, int P, const bf16* g, size_t gp, int tid) { v4u t_[R * C / 8 / NTHREADS]; tile_ld<R, C>(t_, g, gp, tid); tile_st<R, C>(t_, img, P, tid); }
#define WG_BAR() do { asm volatile("s_waitcnt lgkmcnt(0)" ::: "memory"); __builtin_amdgcn_s_barrier(); asm volatile("" ::: "memory"); } while (0)

constexpr int PR = 272, PT = 320, PT256 = 576, PO256 = 528;
constexpr size_t WS_ALOW = 7 * MiB;
constexpr size_t WS_DEC = 6 * MiB;
constexpr float LOG2E = 1.4426950408889634f, LN2 = 0.6931471805599453f;
__device__ __forceinline__ void gla_cumsum(float (&Bc)[2][16], float& Blast, lcp AL, lcp W2, const LAS float* BA, LAS float* EX, int wave, int lane) {
    const int r = lane & 31, h = lane >> 5, db = wave & 3, jh = wave >> 2;
    const bf16x8 wf = *(const LAS bf16x8*)(W2 + (db * 32 + r) * 32 + h * 16);
    const float bias = BA[db * 32 + r];
    float run = 0.f;
    float c16 = 1.0f / 16.0f; asm volatile("" : "+v"(c16)); float ln2_ = LN2; asm volatile("" : "+v"(ln2_));
#pragma unroll
    for (int t = 0; t < 2; ++t) {
        const bf16x8 af = *(const LAS bf16x8*)(AL + ((jh * 2 + t) * 32 + r) * 32 + h * 16);
        f32x16 z = {0.f, 0.f, 0.f, 0.f, 0.f, 0.f, 0.f, 0.f, 0.f, 0.f, 0.f, 0.f, 0.f, 0.f, 0.f, 0.f};
        z = MFMA32(af, wf, z);
        float own[4], oth[4];
#pragma unroll
        for (int g = 0; g < 4; ++g) {
            float acc = 0.f;
#pragma unroll
            for (int i = 0; i < 4; ++i) { const float zz = z[4 * g + i] + bias;
                const float la = (fminf(zz, 0.f) - ln2_ * __builtin_amdgcn_logf(1.0f + __builtin_amdgcn_exp2f(-fabsf(zz) * LOG2E))) * c16;
                acc += la; Bc[t][4 * g + i] = acc; }
            own[g] = acc; oth[g] = oth32(acc, h);
        }
#pragma unroll
        for (int g = 0; g < 4; ++g) { const float off = run + (h ? oth[g] : 0.f);
#pragma unroll
            for (int i = 0; i < 4; ++i) Bc[t][4 * g + i] += off;
            run += own[g] + oth[g]; }
    }
    if (h == 0) EX[jh * 128 + db * 32 + r] = run;
    WG_BAR();
    const float t0 = EX[db * 32 + r], t1 = EX[128 + db * 32 + r];
    Blast = t0 + t1;
    if (jh == 1) {
#pragma unroll
        for (int t = 0; t < 2; ++t)
#pragma unroll
            for (int i = 0; i < 16; ++i) Bc[t][i] += t0; }
}
constexpr int GA_KI = 0, GA_VI = GA_KI + 128 * PR, GA_KD = GA_VI + 128 * PT256, GA_AL = GA_KD + 128 * PT, GA_W2 = GA_AL + 4096, GA_BA = GA_W2 + 4096, GA_EX = GA_BA + 512, GA_END = GA_EX + 1024;
constexpr int GA_OI = GA_VI;
constexpr int GC_QT = 0, GC_KT = GC_QT + 128 * PR, GC_SI = GC_KT + 128 * PR, GC_VI = GC_SI + 128 * PT, GC_AL = GC_VI + 128 * PT, GC_W2 = GC_AL + 4096, GC_BA = GC_W2 + 4096, GC_EX = GC_BA + 512, GC_END = GC_EX + 1024;
constexpr int GC_OI = 0;
static_assert(GA_END <= LDSCTL_OFF && GC_END <= LDSCTL_OFF && 128 * PO256 <= GC_SI && 128 * PO256 <= 128 * PT256, "GLA LDS maps");
__device__ __forceinline__ void gla_stage_w(const Frame& F, LAS unsigned char* W2, LAS float* BA, int li, int h) {
    if (F.tid < 128) { const int d = F.tid; const GAS float* w2 = (const GAS float*)AP(I_GLA_A2) + (size_t)li * 16 * 512 + h * 128 + d;
        v4u lo, hi; lo.x = cvtpk(w2[0], w2[512]); lo.y = cvtpk(w2[2 * 512], w2[3 * 512]); lo.z = cvtpk(w2[4 * 512], w2[5 * 512]); lo.w = cvtpk(w2[6 * 512], w2[7 * 512]);
        hi.x = cvtpk(w2[8 * 512], w2[9 * 512]); hi.y = cvtpk(w2[10 * 512], w2[11 * 512]); hi.z = cvtpk(w2[12 * 512], w2[13 * 512]); hi.w = cvtpk(w2[14 * 512], w2[15 * 512]);
        *(LAS v4u*)(W2 + d * 32) = lo; *(LAS v4u*)(W2 + d * 32 + 16) = hi; }
    else if (F.tid < 256) { const int d = F.tid - 128; BA[d] = ((const GAS float*)AP(I_GLA_BA))[(size_t)li * 512 + h * 128 + d]; }
}
__device__ __forceinline__ v4u gla_ld_alow(int tid, const bf16* Arow0) { const int t = tid & 255; return *(const GAS v4u*)(Arow0 + (size_t)(t >> 1) * 16 + (t & 1) * 8); }
__device__ __forceinline__ void gla_st_alow(int tid, v4u v, LAS unsigned char* AL) { if (tid < 256) *(LAS v4u*)(AL + (tid >> 1) * 32 + (tid & 1) * 16) = v; }

__device__ __forceinline__ void gla_alow(const Frame& F0) {
    const Frame F = relaunder(F0);
    unsigned char* ws = WSP();
    const bf16* XBp = (const bf16*)(ws + WS_XB); const bf16* Wa = (const bf16*)(ws + W_IN) + (size_t)3072 * D; const float* ssp = (const float*)(ws + WS_SSP); bf16* ALOW = (bf16*)(ws + WS_ALOW);
    LAS unsigned char* L = F.lds;
    const int lane = F.lane, r = lane & 31, h2 = lane >> 5, tb = F.wave & 3, kh = F.wave >> 2;
    for (int blk = F.bid; blk < M / 128; blk += F.G) {
        const int tok = blk * 128 + tb * 32 + r;
        const bf16* xa = XBp + (size_t)tok * D + kh * 512 + 8 * h2; const bf16* wa = Wa + (size_t)(r & 15) * D + kh * 512 + 8 * h2;
        f32x16 acc = {0.f, 0.f, 0.f, 0.f, 0.f, 0.f, 0.f, 0.f, 0.f, 0.f, 0.f, 0.f, 0.f, 0.f, 0.f, 0.f};
#pragma unroll 1
        for (int k8 = 0; k8 < 4; ++k8) {
            bf16x8 af[8], bfr[8];
#pragma unroll
            for (int ks = 0; ks < 8; ++ks) { af[ks] = *(const GAS bf16x8*)(wa + (k8 * 8 + ks) * 16); bfr[ks] = *(const GAS bf16x8*)(xa + (k8 * 8 + ks) * 16); }
#pragma unroll
            for (int ks = 0; ks < 8; ++ks) acc = MFMA32(af[ks], bfr[ks], acc);
        }
        LAS float* red = (LAS float*)L + tb * 1024;
        if (kh == 1) {
#pragma unroll
            for (int i = 0; i < 8; ++i) red[i * 64 + lane] = acc[i]; }
        WG_BAR();
        if (kh == 0) {
            const f32x4 p0 = *(const GAS f32x4*)(ssp + (size_t)tok * 16), p1 = *(const GAS f32x4*)(ssp + (size_t)tok * 16 + 4), p2 = *(const GAS f32x4*)(ssp + (size_t)tok * 16 + 8), p3 = *(const GAS f32x4*)(ssp + (size_t)tok * 16 + 12);
            const float ss = ((p0[0] + p0[1]) + (p0[2] + p0[3])) + ((p1[0] + p1[1]) + (p1[2] + p1[3])) + ((p2[0] + p2[1]) + (p2[2] + p2[3])) + ((p3[0] + p3[1]) + (p3[2] + p3[3]));
            const float rstd = __builtin_amdgcn_rsqf(ss * (1.0f / 1024.0f) + EPS);
            float v[8];
#pragma unroll
            for (int i = 0; i < 8; ++i) v[i] = (acc[i] + red[i * 64 + lane]) * rstd;
            typedef unsigned u2v __attribute__((ext_vector_type(2)));
            u2v w0, w1; w0.x = cvtpk(v[0], v[1]); w0.y = cvtpk(v[2], v[3]); w1.x = cvtpk(v[4], v[5]); w1.y = cvtpk(v[6], v[7]);
            *(GAS u2v*)(ALOW + (size_t)tok * 16 + 4 * h2) = w0; *(GAS u2v*)(ALOW + (size_t)tok * 16 + 8 + 4 * h2) = w1;
        }
        WG_BAR();
    }
}
__device__ __forceinline__ void gla_phase_a(const Frame& F0, int li) {
    const Frame F = relaunder(F0);
    unsigned char* ws = WSP();
    const bf16* P = (const bf16*)(ws + WS_ACT); bf16* SKV = (bf16*)OUTP(); float* DEC = (float*)(ws + WS_DEC); const bf16* ALOWP = (const bf16*)(ws + WS_ALOW);
    LAS unsigned char* L = F.lds;
    const int wave = F.wave, db = wave & 3, jh = wave >> 2;
    v4u kR[4], vR[8], aR; int hcur = -1;
    {   const int it = F.bid; if (it < 1024) { const int bh = it >> 5, g = it & 31, b = bh >> 2, h = bh & 3;
            tile_ld<128, 128>(kR, P + HM(G_K, 4, 128, b, h) + g * 128 * 128, 128, F.tid); tile_ld<128, 256>(vR, P + HM(G_V, 4, 256, b, h) + g * 128 * 256, 256, F.tid); aR = gla_ld_alow(F.tid, ALOWP + ((size_t)b * SEQ + g * 128) * 16); } }
    for (int it = F.bid; it < 1024; it += F.G) {
        const int bh = it >> 5, h = bh & 3;
        const int lane = lndv(F.lane), r = lane & 31, h2 = lane >> 5;
        tile_st<128, 128>(kR, L + GA_KI, PR, F.tid); tile_st<128, 256>(vR, L + GA_VI, PT256, F.tid); gla_st_alow(F.tid, aR, L + GA_AL);
        if (h != hcur) { gla_stage_w(F, L + GA_W2, (LAS float*)(L + GA_BA), li, h); hcur = h; }
        WG_BAR();
        {   const int nx = it + F.G; if (nx < 1024) { const int bh2 = nx >> 5, g2 = nx & 31, b2 = bh2 >> 2, h2n = bh2 & 3;
                tile_ld<128, 128>(kR, P + HM(G_K, 4, 128, b2, h2n) + g2 * 128 * 128, 128, F.tid); tile_ld<128, 256>(vR, P + HM(G_V, 4, 256, b2, h2n) + g2 * 128 * 256, 256, F.tid); aR = gla_ld_alow(F.tid, ALOWP + ((size_t)b2 * SEQ + g2 * 128) * 16); } }
        float Bc[2][16], Blast;
        gla_cumsum(Bc, Blast, L + GA_AL, L + GA_W2, (const LAS float*)(L + GA_BA), (LAS float*)(L + GA_EX), wave, lane);
#pragma unroll
        for (int t = 0; t < 2; ++t)
#pragma unroll
            for (int i = 0; i < 16; ++i) { const int row = (jh * 2 + t) * 32 + crow(i, h2), col = db * 32 + r;
                const float kv = bf2f(*(const LAS bf16*)(L + GA_KI + row * PR + col * 2)) * __builtin_amdgcn_exp2f((Blast - Bc[t][i]) * LOG2E);
                *(LAS bf16*)(L + GA_KD + row * PT + col * 2) = cvt1(kv); }
        if (jh == 0 && h2 == 0) DEC[(size_t)it * 128 + db * 32 + r] = __builtin_amdgcn_exp2f(Blast * LOG2E);
        WG_BAR();
        f32x16 acc[4];
#pragma unroll
        for (int t = 0; t < 4; ++t) acc[t] = (f32x16){0.f, 0.f, 0.f, 0.f, 0.f, 0.f, 0.f, 0.f, 0.f, 0.f, 0.f, 0.f, 0.f, 0.f, 0.f, 0.f};
#pragma unroll
        for (int ks = 0; ks < 8; ++ks) { const bf16x8 a = ld_tr(L + GA_KD, PT, 16 * ks, db * 32, lane);
#pragma unroll
            for (int t = 0; t < 4; ++t) acc[t] = MFMA32(a, ld_tr(L + GA_VI, PT256, 16 * ks, (4 * jh + t) * 32, lane), acc[t]); }
        WG_BAR();
#pragma unroll
        for (int t = 0; t < 4; ++t)
#pragma unroll
            for (int i = 0; i < 16; ++i) *(LAS bf16*)(L + GA_OI + (db * 32 + crow(i, h2)) * PO256 + ((4 * jh + t) * 32 + r) * 2) = cvt1(acc[t][i]);
        WG_BAR();
        {   bf16* out = SKV + (size_t)it * 128 * 256;
#pragma unroll
            for (int i = 0; i < 8; ++i) { const int c = F.tid + i * NTHREADS, row = c >> 5, cc = c & 31; *(GAS v4u*)(out + row * 256 + cc * 8) = *(const LAS v4u*)(L + GA_OI + row * PO256 + cc * 16); } }
        WG_BAR();
    }
}
__device__ __forceinline__ void gla_phase_b(const Frame& F0) {
    const Frame F = relaunder(F0);
    unsigned char* ws = WSP();
    bf16* SKV = (bf16*)OUTP(); const float* DEC = (const float*)(ws + WS_DEC);
    for (int gt = F.bid * NTHREADS + F.tid; gt < 32 * 128 * 32; gt += F.G * NTHREADS) {
        const int bh = gt >> 12, d = (gt >> 5) & 127, e8 = gt & 31;
        float s[8];
#pragma unroll
        for (int i = 0; i < 8; ++i) s[i] = 0.f;
        for (int g0 = 0; g0 < 32; g0 += 8) {
            v4u kv[8]; float dc[8];
#pragma unroll
            for (int u = 0; u < 8; ++u) { const size_t item = (size_t)bh * 32 + g0 + u; kv[u] = *(const GAS v4u*)(SKV + (item * 128 + d) * 256 + e8 * 8); dc[u] = ((const GAS float*)DEC)[item * 128 + d]; }
#pragma unroll
            for (int u = 0; u < 8; ++u) { const size_t item = (size_t)bh * 32 + g0 + u;
                v4u o; o.x = cvtpk(s[0], s[1]); o.y = cvtpk(s[2], s[3]); o.z = cvtpk(s[4], s[5]); o.w = cvtpk(s[6], s[7]);
                *(GAS v4u*)(SKV + (item * 128 + d) * 256 + e8 * 8) = o;
#pragma unroll
                for (int i = 0; i < 4; ++i) { s[2 * i] = dc[u] * s[2 * i] + bflo(kv[u][i]); s[2 * i + 1] = dc[u] * s[2 * i + 1] + bfhi(kv[u][i]); } }
        }
    }
}
__device__ __forceinline__ void gla_phase_c(const Frame& F0, int li) {
    const Frame F = relaunder(F0);
    unsigned char* ws = WSP();
    const bf16* P = (const bf16*)(ws + WS_ACT); const bf16* SKV = (const bf16*)OUTP(); bf16* CAT = (bf16*)(ws + WS_CAT); const bf16* ALOWP = (const bf16*)(ws + WS_ALOW);
    LAS unsigned char* L = F.lds;
    const int wave = F.wave, db = wave & 3, jh = wave >> 2;
    const int ib = wave & 3, eq = wave >> 2;
    v4u qR[4], kR[4], aR; int hcur = -1;
    {   const int it = F.bid; if (it < 1024) { const int bh = it >> 5, g = it & 31, b = bh >> 2, h = bh & 3;
            tile_ld<128, 128>(qR, P + HM(G_Q, 4, 128, b, h) + g * 128 * 128, 128, F.tid); tile_ld<128, 128>(kR, P + HM(G_K, 4, 128, b, h) + g * 128 * 128, 128, F.tid); aR = gla_ld_alow(F.tid, ALOWP + ((size_t)b * SEQ + g * 128) * 16); } }
    for (int it = F.bid; it < 1024; it += F.G) {
        const int bh = it >> 5, g = it & 31, b = bh >> 2, h = bh & 3;
        const int tidl = lndv(F.tid), lane = tidl & 63, r = lane & 31, h2 = lane >> 5;
        const bf16* Vs = P + HM(G_V, 4, 256, b, h) + (size_t)g * 128 * 256; const bf16* Rs = P + HM(G_R, 4, 256, b, h) + (size_t)g * 128 * 256;
        const bf16* Sg = SKV + (size_t)it * 128 * 256;
        {   v4u sR[4], vR[4]; tile_ld<128, 128>(sR, Sg, 256, tidl); tile_ld<128, 128>(vR, Vs, 256, tidl);
            tile_st<128, 128>(qR, L + GC_QT, PR, tidl); tile_st<128, 128>(kR, L + GC_KT, PR, tidl); tile_st<128, 128>(sR, L + GC_SI, PT, tidl); tile_st<128, 128>(vR, L + GC_VI, PT, tidl); }
        gla_st_alow(tidl, aR, L + GC_AL);
        if (h != hcur) { gla_stage_w(F, L + GC_W2, (LAS float*)(L + GC_BA), li, h); hcur = h; }
        WG_BAR();
        {
            float Bc[2][16], Blast;
            gla_cumsum(Bc, Blast, L + GC_AL, L + GC_W2, (const LAS float*)(L + GC_BA), (LAS float*)(L + GC_EX), wave, lane);
#pragma unroll
            for (int t = 0; t < 2; ++t)
#pragma unroll
                for (int i = 0; i < 16; ++i) { const int off = ((jh * 2 + t) * 32 + crow(i, h2)) * PR + (db * 32 + r) * 2;
                    const float eb = __builtin_amdgcn_exp2f(Bc[t][i] * LOG2E);
                    const float qv = bf2f(*(const LAS bf16*)(L + GC_QT + off)) * eb * 0.08838834764831845f;
                    const float kv = bf2f(*(const LAS bf16*)(L + GC_KT + off)) * __builtin_amdgcn_rcpf(eb);
                    *(LAS bf16*)(L + GC_QT + off) = cvt1(qv); *(LAS bf16*)(L + GC_KT + off) = cvt1(kv); }
        }
        WG_BAR();
        bf16x8 PA[4][2];
#pragma unroll
        for (int jb = 0; jb < 4; ++jb) {
            if (jb <= ib) {
                f32x16 x = {0.f, 0.f, 0.f, 0.f, 0.f, 0.f, 0.f, 0.f, 0.f, 0.f, 0.f, 0.f, 0.f, 0.f, 0.f, 0.f};
#pragma unroll
                for (int ks = 0; ks < 8; ++ks) x = MFMA32(ld_row(L + GC_KT, PR, jb * 32, 16 * ks, r, h2), ld_row(L + GC_QT, PR, ib * 32, 16 * ks, r, h2), x);
                if (jb == ib) {
#pragma unroll
                    for (int i = 0; i < 16; ++i) if (crow(i, h2) > r) x[i] = 0.f; }
                PA[jb][0] = PACK_STEP(x, 0); PA[jb][1] = PACK_STEP(x, 1);
            } else { PA[jb][0] = (bf16x8){0, 0, 0, 0, 0, 0, 0, 0}; PA[jb][1] = (bf16x8){0, 0, 0, 0, 0, 0, 0, 0}; }
        }
        f32x16 o[2][2];
        v4u s1R[4], v1R[4];
        tile_ld<128, 128>(s1R, Sg + 128, 256, tidl); tile_ld<128, 128>(v1R, Vs + 128, 256, tidl);
#pragma unroll
        for (int half = 0; half < 2; ++half) {
            if (half == 1) {
                WG_BAR();
                tile_st<128, 128>(s1R, L + GC_SI, PT, tidl); tile_st<128, 128>(v1R, L + GC_VI, PT, tidl);
                WG_BAR();
            }
#pragma unroll
            for (int t = 0; t < 2; ++t) {
                const int eb = 2 * eq + t;
                f32x16 acc = {0.f, 0.f, 0.f, 0.f, 0.f, 0.f, 0.f, 0.f, 0.f, 0.f, 0.f, 0.f, 0.f, 0.f, 0.f, 0.f};
#pragma unroll
                for (int jb = 0; jb < 4; ++jb) if (jb <= ib) {
#pragma unroll
                    for (int s = 0; s < 2; ++s) acc = MFMA32(PA[jb][s], ld_tr_perm(L + GC_VI, PT, jb * 32 + 16 * s, eb * 32, lane), acc); }
#pragma unroll
                for (int ks = 0; ks < 8; ++ks) acc = MFMA32(ld_row(L + GC_QT, PR, ib * 32, 16 * ks, r, h2), ld_tr(L + GC_SI, PT, 16 * ks, eb * 32, lane), acc);
                o[half][t] = acc;
            }
        }
        WG_BAR();
#pragma unroll
        for (int half = 0; half < 2; ++half)
#pragma unroll
            for (int t = 0; t < 2; ++t)
#pragma unroll
                for (int i = 0; i < 16; ++i) *(LAS bf16*)(L + GC_OI + (ib * 32 + crow(i, h2)) * PO256 + (half * 128 + (2 * eq + t) * 32 + r) * 2) = cvt1(o[half][t][i]);
        WG_BAR();
        {   const int nx = (it + F.G < 1024) ? it + F.G : it;
            const int bh2 = nx >> 5, g2 = nx & 31, hn = bh2 & 3, bn = bh2 >> 2;
            tile_ld<128, 128>(qR, P + HM(G_Q, 4, 128, bn, hn) + g2 * 128 * 128, 128, tidl); tile_ld<128, 128>(kR, P + HM(G_K, 4, 128, bn, hn) + g2 * 128 * 128, 128, tidl); aR = gla_ld_alow(tidl, ALOWP + ((size_t)bn * SEQ + g2 * 128) * 16); }
        {
            const int tid2 = lndv(tidl), row = tid2 >> 2, qtr = tid2 & 3;
            lcp orow = L + GC_OI + row * PO256 + qtr * 128;
            const bf16* gp = Rs + (size_t)row * 256 + qtr * 64;
            float sum = 0.f;
#pragma unroll
            for (int c = 0; c < 8; ++c) { const v4u w = *(const LAS v4u*)(orow + c * 16);
#pragma unroll
                for (int i = 0; i < 4; ++i) sum += bflo(w[i]) + bfhi(w[i]); }
            sum += xsw<1>(sum); sum += xsw<2>(sum);
            const float mu = sum * (1.0f / 256.0f); float sq = 0.f;
#pragma unroll
            for (int c = 0; c < 8; ++c) { const v4u w = *(const LAS v4u*)(orow + c * 16);
#pragma unroll
                for (int i = 0; i < 4; ++i) { const float d0 = bflo(w[i]) - mu, d1 = bfhi(w[i]) - mu; sq += d0 * d0 + d1 * d1; } }
            sq += xsw<1>(sq); sq += xsw<2>(sq);
            float eps_ = EPS; asm volatile("" : "+v"(eps_)); const float rstd = 1.0f / sqrtf(sq * (1.0f / 256.0f) + eps_);
            bf16* op = CAT + ((size_t)b * SEQ + g * 128 + row) * D + h * 256 + qtr * 64;
#pragma unroll
            for (int c = 0; c < 8; ++c) { const v4u gw = *(const GAS v4u*)(gp + c * 8); const v4u w = *(const LAS v4u*)(orow + c * 16); v4u ow;
#pragma unroll
                for (int i = 0; i < 4; ++i) { const float g0 = bflo(gw[i]), g1 = bfhi(gw[i]);
                    ow[i] = cvtpk((bflo(w[i]) - mu) * rstd * silu_f(g0), (bfhi(w[i]) - mu) * rstd * silu_f(g1)); }
                *(GAS v4u*)(op + c * 8) = ow; }
        }
        WG_BAR();
    }
}


constexpr size_t WS_OD = 408 * MiB;
constexpr size_t OUT_LSE = 32 * MiB;
constexpr size_t WS_END2 = 504 * MiB;
constexpr int RA_KI = 0, RA_VD = RA_KI + 128 * PT, RA_END = RA_VD + 128 * PT;
constexpr int RC_QI = 0, RC_KI = RC_QI + 128 * PR, RC_VI = RC_KI + 128 * PR, RC_SI = RC_VI + 128 * PT, RC_END = RC_SI + 128 * PT;
constexpr int DPK = 144, DPV = 192;
constexpr int DL_KI = 0, DL_VI = DL_KI + 384 * DPK, DL_LW = DL_VI + 384 * DPV, DL_END = DL_LW + 8 * 256;
constexpr int DL_ST = DL_KI;
static_assert(RC_END <= LDSCTL_OFF && DL_END <= LDSCTL_OFF && 8 * 32 * DPK <= 384 * DPK, "even mixer LDS maps");
__device__ __forceinline__ float ret_log2g(int h) { return log2f(1.0f - exp2f(-5.0f - (float)h)); }

__device__ __forceinline__ void ret_phase_a_items(const Frame& F, const bf16* P, bf16* RKV) {
    LAS unsigned char* L = F.lds;
    const int wave = F.wave, db = wave & 3, eh = wave >> 2;
    v4u kR[4], vR[4];
    {   const int it = F.bid < 1024 ? F.bid : 0; const int bh = it >> 5, n = it & 31;
        tile_ld<128, 128>(kR, P + HM(E_RK, 4, 128, bh >> 2, bh & 3) + n * 128 * 128, 128, F.tid); tile_ld<128, 128>(vR, P + HM(E_RV, 4, 128, bh >> 2, bh & 3) + n * 128 * 128, 128, F.tid); }
    for (int it = F.bid; it < 1024; it += F.G) {
        const int tidl = lndv(F.tid), lane = tidl & 63, r = lane & 31, h2 = lane >> 5;
        const int bh = it >> 5, h = bh & 3;
        const float lg = ret_log2g(h);
        tile_st<128, 128>(kR, L + RA_KI, PT, tidl);
        {
#pragma unroll
            for (int i = 0; i < 4; ++i) { const int row = (tidl >> 4) + 32 * i, cc = tidl & 15; const float f = __builtin_amdgcn_exp2f(lg * (float)(127 - row)); v4u o;
#pragma unroll
                for (int k = 0; k < 4; ++k) o[k] = cvtpk(bflo(vR[i][k]) * f, bfhi(vR[i][k]) * f);
                *(LAS v4u*)(L + RA_VD + row * PT + cc * 16) = o; }
        }
        WG_BAR();
        {   const int nx = (it + F.G < 1024) ? it + F.G : it; const int bh2 = nx >> 5, n2 = nx & 31;
            tile_ld<128, 128>(kR, P + HM(E_RK, 4, 128, bh2 >> 2, bh2 & 3) + n2 * 128 * 128, 128, tidl); tile_ld<128, 128>(vR, P + HM(E_RV, 4, 128, bh2 >> 2, bh2 & 3) + n2 * 128 * 128, 128, tidl); }
        f32x16 acc[2];
#pragma unroll
        for (int t = 0; t < 2; ++t) acc[t] = (f32x16){0.f, 0.f, 0.f, 0.f, 0.f, 0.f, 0.f, 0.f, 0.f, 0.f, 0.f, 0.f, 0.f, 0.f, 0.f, 0.f};
#pragma unroll
        for (int ks = 0; ks < 8; ++ks) { const bf16x8 a = ld_tr(L + RA_KI, PT, 16 * ks, db * 32, lane);
#pragma unroll
            for (int t = 0; t < 2; ++t) acc[t] = MFMA32(a, ld_tr(L + RA_VD, PT, 16 * ks, (2 * eh + t) * 32, lane), acc[t]); }
        WG_BAR();
#pragma unroll
        for (int t = 0; t < 2; ++t)
#pragma unroll
            for (int i = 0; i < 16; ++i) *(LAS bf16*)(L + RA_KI + (db * 32 + crow(i, h2)) * PR + ((2 * eh + t) * 32 + r) * 2) = cvt1(acc[t][i]);
        WG_BAR();
        bf16* out = RKV + (size_t)it * 128 * 128;
#pragma unroll
        for (int i = 0; i < 4; ++i) { const int row = (tidl >> 4) + 32 * i, cc = tidl & 15; *(GAS v4u*)(out + row * 128 + cc * 8) = *(const LAS v4u*)(L + RA_KI + row * PR + cc * 16); }
        WG_BAR();
    }
}
__device__ __forceinline__ void ret_scan(const Frame& F, bf16* RKV) {
    for (int gt = F.bid * NTHREADS + F.tid; gt < 32 * 128 * 32; gt += F.G * NTHREADS) {
        const int bh = gt >> 12, d = (gt >> 5) & 127, e4 = gt & 31, h = bh & 3;
        const float g128 = __builtin_amdgcn_exp2f(ret_log2g(h) * 128.0f);
        float s[4];
#pragma unroll
        for (int i = 0; i < 4; ++i) s[i] = 0.f;
        typedef unsigned u2v __attribute__((ext_vector_type(2)));
        for (int n0 = 0; n0 < 32; n0 += 8) {
            u2v kv[8];
#pragma unroll
            for (int u = 0; u < 8; ++u) kv[u] = *(const GAS u2v*)(RKV + (((size_t)bh * 32 + n0 + u) * 128 + d) * 128 + e4 * 4);
#pragma unroll
            for (int u = 0; u < 8; ++u) {
                u2v o; o.x = cvtpk(s[0], s[1]); o.y = cvtpk(s[2], s[3]);
                *(GAS u2v*)(RKV + (((size_t)bh * 32 + n0 + u) * 128 + d) * 128 + e4 * 4) = o;
#pragma unroll
                for (int i = 0; i < 2; ++i) { s[2 * i] = g128 * s[2 * i] + bflo(kv[u][i]); s[2 * i + 1] = g128 * s[2 * i + 1] + bfhi(kv[u][i]); } }
        }
    }
}
__device__ __forceinline__ void ret_phase_c_items(const Frame& F, const bf16* P, const bf16* RKV, bf16* CAT) {
    LAS unsigned char* L = F.lds;
    const int wave = F.wave, ib = wave & 3, eq = wave >> 2;
    v4u qR[4], kR[4];
    {   const int it = F.bid < 1024 ? F.bid : 0; const int bh = it >> 5, n = it & 31;
        tile_ld<128, 128>(qR, P + HM(E_RQ, 4, 128, bh >> 2, bh & 3) + n * 128 * 128, 128, F.tid); tile_ld<128, 128>(kR, P + HM(E_RK, 4, 128, bh >> 2, bh & 3) + n * 128 * 128, 128, F.tid); }
    for (int it = F.bid; it < 1024; it += F.G) {
        const int tidl = lndv(F.tid), lane = tidl & 63, r = lane & 31, h2 = lane >> 5;
        const int bh = it >> 5, n = it & 31, b = bh >> 2, h = bh & 3;
        const float lg = ret_log2g(h);
        {   v4u vR[4], sR[4]; tile_ld<128, 128>(vR, P + HM(E_RV, 4, 128, b, h) + n * 128 * 128, 128, tidl); tile_ld<128, 128>(sR, RKV + (size_t)it * 128 * 128, 128, tidl);
#pragma unroll
            for (int i = 0; i < 4; ++i) { const int row = (tidl >> 4) + 32 * i, cc = tidl & 15; const float fq = __builtin_amdgcn_exp2f(lg * (float)row), fk = __builtin_amdgcn_rcpf(fq); v4u oq, ok;
#pragma unroll
                for (int k = 0; k < 4; ++k) { oq[k] = cvtpk(bflo(qR[i][k]) * fq, bfhi(qR[i][k]) * fq); ok[k] = cvtpk(bflo(kR[i][k]) * fk, bfhi(kR[i][k]) * fk); }
                *(LAS v4u*)(L + RC_QI + row * PR + cc * 16) = oq; *(LAS v4u*)(L + RC_KI + row * PR + cc * 16) = ok; }
            tile_st<128, 128>(vR, L + RC_VI, PT, tidl); tile_st<128, 128>(sR, L + RC_SI, PT, tidl); }
        WG_BAR();
        bf16x8 PA[4][2];
#pragma unroll
        for (int jb = 0; jb < 4; ++jb) {
            if (jb <= ib) {
                f32x16 x = {0.f, 0.f, 0.f, 0.f, 0.f, 0.f, 0.f, 0.f, 0.f, 0.f, 0.f, 0.f, 0.f, 0.f, 0.f, 0.f};
#pragma unroll
                for (int ks = 0; ks < 8; ++ks) x = MFMA32(ld_row(L + RC_KI, PR, jb * 32, 16 * ks, r, h2), ld_row(L + RC_QI, PR, ib * 32, 16 * ks, r, h2), x);
                if (jb == ib) {
#pragma unroll
                    for (int i = 0; i < 16; ++i) if (crow(i, h2) > r) x[i] = 0.f; }
                PA[jb][0] = PACK_STEP(x, 0); PA[jb][1] = PACK_STEP(x, 1);
            } else { PA[jb][0] = (bf16x8){0, 0, 0, 0, 0, 0, 0, 0}; PA[jb][1] = (bf16x8){0, 0, 0, 0, 0, 0, 0, 0}; }
        }
        f32x16 o[2];
#pragma unroll
        for (int t = 0; t < 2; ++t) {
            const int eb = 2 * eq + t;
            f32x16 z = {0.f, 0.f, 0.f, 0.f, 0.f, 0.f, 0.f, 0.f, 0.f, 0.f, 0.f, 0.f, 0.f, 0.f, 0.f, 0.f}, y = z;
#pragma unroll
            for (int jb = 0; jb < 4; ++jb) if (jb <= ib) {
#pragma unroll
                for (int s = 0; s < 2; ++s) z = MFMA32(PA[jb][s], ld_tr_perm(L + RC_VI, PT, jb * 32 + 16 * s, eb * 32, lane), z); }
#pragma unroll
            for (int ks = 0; ks < 8; ++ks) y = MFMA32(ld_row(L + RC_QI, PR, ib * 32, 16 * ks, r, h2), ld_tr(L + RC_SI, PT, 16 * ks, eb * 32, lane), y);
            const float g1 = __builtin_amdgcn_exp2f(lg);
#pragma unroll
            for (int i = 0; i < 16; ++i) z[i] += y[i] * g1;
            o[t] = z;
        }
        WG_BAR();
#pragma unroll
        for (int t = 0; t < 2; ++t)
#pragma unroll
            for (int i = 0; i < 16; ++i) *(LAS bf16*)(L + RC_QI + (ib * 32 + crow(i, h2)) * PR + ((2 * eq + t) * 32 + r) * 2) = cvt1(o[t][i]);
        WG_BAR();
        {   const int nx = (it + F.G < 1024) ? it + F.G : it; const int bh2 = nx >> 5, n2 = nx & 31;
            tile_ld<128, 128>(qR, P + HM(E_RQ, 4, 128, bh2 >> 2, bh2 & 3) + n2 * 128 * 128, 128, tidl); tile_ld<128, 128>(kR, P + HM(E_RK, 4, 128, bh2 >> 2, bh2 & 3) + n2 * 128 * 128, 128, tidl); }
        {
            const int tid2 = lndv(tidl), row = tid2 >> 2, qtr = tid2 & 3;
            lcp orow = L + RC_QI + row * PR + qtr * 64;
            v4u w[4]; float sum = 0.f;
#pragma unroll
            for (int c = 0; c < 4; ++c) { w[c] = *(const LAS v4u*)(orow + c * 16);
#pragma unroll
                for (int i = 0; i < 4; ++i) sum += bflo(w[c][i]) + bfhi(w[c][i]); }
            sum += xsw<1>(sum); sum += xsw<2>(sum);
            const float mu = sum * (1.0f / 128.0f); float sq = 0.f;
#pragma unroll
            for (int c = 0; c < 4; ++c)
#pragma unroll
                for (int i = 0; i < 4; ++i) { const float d0 = bflo(w[c][i]) - mu, d1 = bfhi(w[c][i]) - mu; sq += d0 * d0 + d1 * d1; }
            sq += xsw<1>(sq); sq += xsw<2>(sq);
            float eps_ = EPS; asm volatile("" : "+v"(eps_)); const float rstd = 1.0f / sqrtf(sq * (1.0f / 128.0f) + eps_);
            const bf16* gp = P + HM(E_RG, 4, 128, b, h) + (size_t)(n * 128 + row) * 128 + qtr * 32;
            bf16* op = CAT + ((size_t)b * SEQ + n * 128 + row) * D + h * 128 + qtr * 32;
#pragma unroll
            for (int c = 0; c < 4; ++c) { const v4u gw = *(const GAS v4u*)(gp + c * 8); v4u ow;
#pragma unroll
                for (int i = 0; i < 4; ++i) { const float g0 = bflo(gw[i]), g1 = bfhi(gw[i]);
                    ow[i] = cvtpk((bflo(w[c][i]) - mu) * rstd * silu_f(g0), (bfhi(w[c][i]) - mu) * rstd * silu_f(g1)); }
                *(GAS v4u*)(op + c * 8) = ow; }
        }
        WG_BAR();
    }
}
struct DilTile { int b, head, p, dil, res, q0; };
template <bool FUSE> __device__ __forceinline__ DilTile dil_decode(int T) { DilTile t;
    if (FUSE) { t.b = T >> 7; t.head = T & 7; t.p = 0; t.dil = 1; t.res = 0; t.q0 = ((T >> 3) & 15) * 256; }
    else { t.b = T >> 8; t.head = (T >> 5) & 7; const int t32 = T & 31, hi = t32 >> 3, lo = t32 & 3;
        t.p = 1 + (((t32 >> 2) ^ t.b) & 1);
        if (t.p == 1) { t.dil = 4; t.res = lo; t.q0 = ((hi + (t.b >> 1)) & 3) * 256; }
        else { t.dil = 16; t.res = hi * 4 + lo; t.q0 = 0; } }
    return t; }
__device__ __forceinline__ void dil_ld(v4u (&kR)[6], v4u (&vR)[6], const DilTile& t, const bf16* P, int tid) {
    const bf16* Kb = P + HM(E_DK, 8, 64, t.b, t.head) + (tid & 7) * 8; const bf16* Vb = P + HM(E_DV, 8, 64, t.b, t.head) + (tid & 7) * 8;
#pragma unroll
    for (int i = 0; i < 6; ++i) { int kidx = t.q0 - 128 + (tid >> 3) + 64 * i; kidx = kidx < 0 ? 0 : kidx;
        const size_t ro = (size_t)(kidx * t.dil + t.res) * 64; kR[i] = *(const GAS v4u*)(Kb + ro); vR[i] = *(const GAS v4u*)(Vb + ro); }
}
template <bool FUSE> __device__ __forceinline__ void dil_tiles(const Frame& F, int T0, int T1, int step, const bf16* P, bf16* OD, float* LSE, bf16* CAT) {
    LAS unsigned char* L = F.lds;
    const int wave = F.wave;
    if (T0 >= T1) return;
    v4u kR[6], vR[6];
    { const DilTile t0 = dil_decode<FUSE>(T0); dil_ld(kR, vR, t0, P, F.tid); }
    for (int T = T0; T < T1; T += step) {
        const int tidl = lndv(F.tid), lane = tidl & 63, r = lane & 31, h2 = lane >> 5;
        const DilTile t = dil_decode<FUSE>(T);
#pragma unroll
        for (int i = 0; i < 6; ++i) { const int row = (tidl >> 3) + 64 * i, cc = tidl & 7; *(LAS v4u*)(L + DL_KI + row * DPK + cc * 16) = kR[i]; *(LAS v4u*)(L + DL_VI + row * DPV + cc * 16) = vR[i]; }
        bf16x8 qf[4];
        { const bf16* qsrc = P + HM(E_DQ, 8, 64, t.b, t.head) + (size_t)((t.q0 + 32 * wave + r) * t.dil + t.res) * 64 + 8 * h2;
#pragma unroll
          for (int ks = 0; ks < 4; ++ks) qf[ks] = *(const GAS bf16x8*)(qsrc + 16 * ks); }
        WG_BAR();
        { const DilTile tn = dil_decode<FUSE>(T + step < T1 ? T + step : T); dil_ld(kR, vR, tn, P, tidl); }
        f32x16 x[5];
        float ninf = -INFINITY; asm volatile("" : "+v"(ninf));
        float mx = ninf;
        bf16x8 kf[2][4];
#pragma unroll
        for (int ks = 0; ks < 4; ++ks) kf[0][ks] = ld_row(L + DL_KI, DPK, 32 * wave, 16 * ks, r, h2);
#pragma unroll
        for (int kb = 0; kb < 5; ++kb) {
            if (kb < 4) {
#pragma unroll
                for (int ks = 0; ks < 4; ++ks) kf[(kb + 1) & 1][ks] = ld_row(L + DL_KI, DPK, 32 * wave + 32 * (kb + 1), 16 * ks, r, h2); }
            f32x16 a = {0.f, 0.f, 0.f, 0.f, 0.f, 0.f, 0.f, 0.f, 0.f, 0.f, 0.f, 0.f, 0.f, 0.f, 0.f, 0.f};
#pragma unroll
            for (int ks = 0; ks < 4; ++ks) a = MFMA32(kf[kb & 1][ks], qf[ks], a);
            if (kb == 0) {
#pragma unroll
                for (int i = 0; i < 16; ++i) if (crow(i, h2) < r) a[i] = ninf; }
            if (kb == 4) {
#pragma unroll
                for (int i = 0; i < 16; ++i) if (crow(i, h2) > r) a[i] = ninf; }
            if (t.q0 == 0 && 32 * wave + 32 * kb < 128) {
#pragma unroll
                for (int i = 0; i < 16; ++i) a[i] = ninf; }
#pragma unroll
            for (int i = 0; i < 16; ++i) mx = fmaxf(mx, a[i]);
            x[kb] = a;
        }
        mx = max32(mx);
        constexpr float C2 = 0.125f * LOG2E;
        const float mc = mx * C2; float l = 0.f;
#pragma unroll
        for (int kb = 0; kb < 5; ++kb)
#pragma unroll
            for (int i = 0; i < 16; ++i) { const float pe = __builtin_amdgcn_exp2f(x[kb][i] * C2 - mc); x[kb][i] = pe; l += pe; }
        l = sum32(l);
        f32x16 o[2];
#pragma unroll
        for (int dbk = 0; dbk < 2; ++dbk) o[dbk] = (f32x16){0.f, 0.f, 0.f, 0.f, 0.f, 0.f, 0.f, 0.f, 0.f, 0.f, 0.f, 0.f, 0.f, 0.f, 0.f, 0.f};
        bf16x8 vf[2][2];
#pragma unroll
        for (int dbk = 0; dbk < 2; ++dbk) vf[0][dbk] = ld_tr_perm(L + DL_VI, DPV, 32 * wave, dbk * 32, lane);
#pragma unroll
        for (int idx = 0; idx < 10; ++idx) { const int kb = idx >> 1, s = idx & 1;
            if (idx < 9) {
#pragma unroll
                for (int dbk = 0; dbk < 2; ++dbk) vf[(idx + 1) & 1][dbk] = ld_tr_perm(L + DL_VI, DPV, 32 * wave + 16 * (idx + 1), dbk * 32, lane); }
            const bf16x8 pa = PACK_STEP(x[kb], s);
#pragma unroll
            for (int dbk = 0; dbk < 2; ++dbk) o[dbk] = MFMA32(pa, vf[idx & 1][dbk], o[dbk]); }
        LAS float* lw = (LAS float*)(L + DL_LW + wave * 256);
        const float lse = mx * 0.125f + LN2 * __builtin_amdgcn_logf(l);
        if (h2 == 0) { lw[r] = l; lw[32 + r] = lse; }
        WG_BAR();
        LAS unsigned char* st = L + DL_ST + wave * 32 * DPK;
#pragma unroll
        for (int i = 0; i < 16; ++i) { const float rl = __builtin_amdgcn_rcpf(lw[crow(i, h2)]);
#pragma unroll
            for (int dbk = 0; dbk < 2; ++dbk) *(LAS bf16*)(st + crow(i, h2) * DPK + (dbk * 32 + r) * 2) = cvt1(o[dbk][i] * rl); }
        const size_t tokbase = (size_t)t.b * SEQ;
        if (!FUSE) {
            bf16* odp = OD + (size_t)t.p * M * 512;
#pragma unroll
            for (int j = 0; j < 4; ++j) { const int c = lane + 64 * j, row = c >> 3, cc = c & 7; const size_t tok = tokbase + (size_t)(t.q0 + 32 * wave + row) * t.dil + t.res;
                *(GAS v4u*)(odp + tok * 512 + t.head * 64 + cc * 8) = *(const LAS v4u*)(st + row * DPK + cc * 16); }
            if (h2 == 0) { const size_t tok = tokbase + (size_t)(t.q0 + 32 * wave + r) * t.dil + t.res; LSE[((size_t)t.p * M + tok) * 8 + t.head] = lse; }
        } else {
#pragma unroll
            for (int j = 0; j < 4; ++j) { const int c = lane + 64 * j, row = c >> 3, cc = c & 7; const size_t tok = tokbase + (size_t)(t.q0 + 32 * wave + row);
                const float l0 = lw[32 + row], l1 = ((const GAS float*)LSE)[((size_t)M + tok) * 8 + t.head], l2 = ((const GAS float*)LSE)[((size_t)2 * M + tok) * 8 + t.head];
                const v4u a = *(const LAS v4u*)(st + row * DPK + cc * 16), bq = *(const GAS v4u*)(OD + ((size_t)M + tok) * 512 + t.head * 64 + cc * 8), cq = *(const GAS v4u*)(OD + ((size_t)2 * M + tok) * 512 + t.head * 64 + cc * 8);
                const float mxl = fmaxf(l0, fmaxf(l1, l2));
                float w0 = __builtin_amdgcn_exp2f((l0 - mxl) * LOG2E), w1 = __builtin_amdgcn_exp2f((l1 - mxl) * LOG2E), w2 = __builtin_amdgcn_exp2f((l2 - mxl) * LOG2E);
                const float rs = __builtin_amdgcn_rcpf(w0 + w1 + w2); w0 *= rs; w1 *= rs; w2 *= rs;
                v4u ov;
#pragma unroll
                for (int i = 0; i < 4; ++i) ov[i] = cvtpk(w0 * bflo(a[i]) + w1 * bflo(bq[i]) + w2 * bflo(cq[i]), w0 * bfhi(a[i]) + w1 * bfhi(bq[i]) + w2 * bfhi(cq[i]));
                *(GAS v4u*)(CAT + tok * D + 512 + t.head * 64 + cc * 8) = ov; }
        }
        WG_BAR();
    }
}
constexpr int DIL_TILES12 = 2048, DIL_TILES0 = 1024;
__device__ __forceinline__ void even_phase_a(const Frame& F0) {
    const Frame F = relaunder(F0);
    unsigned char* ws = WSP();
    const bf16* P = (const bf16*)(ws + WS_ACT); bf16* RKV = (bf16*)OUTP(); bf16* OD = (bf16*)(ws + WS_OD); float* LSE = (float*)((unsigned char*)OUTP() + OUT_LSE);
    ret_phase_a_items(F, P, RKV);
    dil_tiles<false>(F, F.bid, DIL_TILES12, F.G, P, OD, LSE, nullptr);
}
__device__ __forceinline__ void even_phase_b(const Frame& F0) {
    const Frame F = relaunder(F0);
    unsigned char* ws = WSP();
    const bf16* P = (const bf16*)(ws + WS_ACT); bf16* RKV = (bf16*)OUTP(); bf16* OD = (bf16*)(ws + WS_OD); float* LSE = (float*)((unsigned char*)OUTP() + OUT_LSE);
    ret_scan(F, RKV);
    dil_tiles<true>(F, F.bid, DIL_TILES0, F.G, P, OD, LSE, (bf16*)(ws + WS_CAT));
}
__device__ __forceinline__ void even_phase_c(const Frame& F0) {
    const Frame F = relaunder(F0);
    unsigned char* ws = WSP();
    const bf16* P = (const bf16*)(ws + WS_ACT); const bf16* RKV = (const bf16*)OUTP(); const bf16* OD = (const bf16*)(ws + WS_OD); const float* LSE = (const float*)((unsigned char*)OUTP() + OUT_LSE); bf16* CAT = (bf16*)(ws + WS_CAT);
    ret_phase_c_items(F, P, RKV, CAT);
}

static_assert(WS_X8 == WS_OD, "the e4m3 residual copy overlays the dilated-output buffer");
__global__ void __launch_bounds__(NTHREADS, 2) fwd_kernel(Args args) {
    extern __shared__ __attribute__((aligned(16))) unsigned char lds[];
    Frame F;
    F.lds = (LAS unsigned char*)lds;
    F.wave = __builtin_amdgcn_readfirstlane((int)(threadIdx.x >> 6)); F.lane = hw_lane(); F.tid = F.wave * 64 + F.lane; F.G = gridDim.x; F.bid = blockIdx.x;
    for (int u = F.tid; u < (LDS_BYTES - LDSCTL_OFF) / 4; u += NTHREADS) ((LAS unsigned*)(F.lds + LDSCTL_OFF))[u] = 0u;
    __syncthreads();
    if (F.tid < N_PTRS) { const unsigned long long v = (F.tid < 17) ? (unsigned long long)args.in[F.tid] : (F.tid == 17 ? (unsigned long long)args.out : (unsigned long long)args.ws);
        ((LAS unsigned*)(F.lds + PTR_OFF))[2 * F.tid] = (unsigned)v; ((LAS unsigned*)(F.lds + PTR_OFF))[2 * F.tid + 1] = (unsigned)(v >> 32); }
    __syncthreads();
    (void)xcd_barrier_post((unsigned*)(WSP() + WS_CTL) + CW_BAR, (volatile LAS unsigned*)(F.lds + MISC_OFF) + 8, F.tid);
#define GRID_BAR() do { XcdBarrier bar_; bar_.bar = (unsigned*)(WSP() + WS_CTL) + CW_BAR; bar_.x = (unsigned)__builtin_amdgcn_readfirstlane((int)xb_xcc_id()); \
        int mo_ = MISC_OFF + 32; asm volatile("" : "+s"(mo_)); bar_.st = (volatile LAS unsigned*)(F.lds + mo_); int t_ = F.wave * 64 + hw_lane_v(); xcd_barrier<0>(bar_, t_); } while (0)
#ifndef XCD_BAR_MODE
#define XCD_BAR_MODE 2
#endif
#ifdef NO_XCD_LOCAL
#define XCD_BAR() GRID_BAR()
#else
#define XCD_BAR() do { XcdBarrier bar_; bar_.bar = (unsigned*)(WSP() + WS_CTL) + CW_BAR; bar_.x = (unsigned)__builtin_amdgcn_readfirstlane((int)xb_xcc_id()); \
        int mo_ = MISC_OFF + 32; asm volatile("" : "+s"(mo_)); bar_.st = (volatile LAS unsigned*)(F.lds + mo_); int t_ = F.wave * 64 + hw_lane_v(); xcd_barrier<XCD_BAR_MODE>(bar_, t_); } while (0)
#endif
#define XB ((bf16*)(WSP() + WS_XB))
#define ACT ((bf16*)(WSP() + WS_ACT))
#define CAT ((bf16*)(WSP() + WS_CAT))
#define SSP ((float*)(WSP() + WS_SSP))
#define WPTR(off) ((const bf16*)(WSP() + (off)))

    float pro_s0; const float pro_s1 = i8_scales(F, pro_s0);
    prologue_rows(F);
    convert_weights(F, 0, 0, pro_s0, pro_s1);
    GRID_BAR();
    for (int s = 0; s < 8; ++s) {
        const int l = s >> 1; const bool post = (s & 1) != 0;
        if (I8ASLOT(s)) { quant_rows(F, lnd(s)); XCD_BAR(); }
        {
            pg8::Gemm g{XB, WPTR(post ? W_GU1 : W_GU0), M, 2 * FF, D}; pg8::StaticOrder S; S.init(M, 2 * FF, lnd(F.G), lnd(F.bid));
            pg8::EpiSwiGLU E{ACT, FF, SSP, 1.0f};
            if (I8ASLOT(s)) {
                pg8::Gemm g8{(const bf16*)XB8, WPTR(post ? W_GU1 : W_GU0), M, 2 * FF, D};
                if (F8SLOT(s)) { pg8::EpiSwiGLU8I E8{ACT, FF, SSP, 1.0f}; pg8::gemm_phase<pg8::EpiSwiGLU8I, pg8::StaticOrder, true, true, false, true>(F.lds + RING_OFF, g8, S, E8, lnd(F.wave)); }
                else { pg8::EpiSwiGLUI EI{ACT, FF, SSP, 1.0f}; pg8::gemm_phase<pg8::EpiSwiGLUI, pg8::StaticOrder, true, true, false, true>(F.lds + RING_OFF, g8, S, EI, lnd(F.wave)); } }
            else if (F8ASLOT(s)) { pg8::Gemm g8{(const bf16*)XB8, WPTR(post ? W_GU1 : W_GU0), M, 2 * FF, D}; pg8::EpiSwiGLU8 E8{ACT, FF, SSP, 1.0f / (pg8::F8_XSCALE * pg8::F8_GUSCALE)};
                pg8::gemm_phase<pg8::EpiSwiGLU8, pg8::StaticOrder, true, true, true>(F.lds + RING_OFF, g8, S, E8, lnd(F.wave)); }
            else if (F8SLOT(s)) { pg8::EpiSwiGLU8 E8{ACT, FF, SSP, 1.0f}; pg8::gemm_phase<pg8::EpiSwiGLU8, pg8::StaticOrder, true, true>(F.lds + RING_OFF, g, S, E8, lnd(F.wave)); }
            else pg8::gemm_phase<pg8::EpiSwiGLU, pg8::StaticOrder, true, true>(F.lds + RING_OFF, g, S, E, lnd(F.wave));
            XCD_BAR();
        }
        {
            const bool do_conv = post ? (l + 1 < DEPTH) : (l >= 1); const int conv_l = post ? l + 1 : l, conv_part = post ? 1 : 2; const int grp = (lnd(F.bid) >> 3) & 1;
            for (int pass = 0; pass < 3; ++pass) {
                if (pass == 1) {
                    pg8::Gemm g{ACT, WPTR(post ? W_D1 : W_D0), M, D, FF}; pg8::RevOrder S; S.init(M, D, lnd(F.G), lnd(F.bid));
                    if (F8SLOT(s)) { pg8::EpiResid E{XB, SSP, 0.5f / (pg8::F8_HSCALE * pg8::F8_WSCALE), (post && F8ASLOT(s + 1)) ? XB8_D : 0}; pg8::gemm_phase<pg8::EpiResid, pg8::RevOrder, true, true, true>(F.lds + RING_OFF, g, S, E, lnd(F.wave)); }
                    else { pg8::EpiResid E{XB, SSP, 0.5f, (post && F8ASLOT(s + 1)) ? XB8_D : 0};
                    pg8::gemm_phase<pg8::EpiResid, pg8::RevOrder, true, true>(F.lds + RING_OFF, g, S, E, lnd(F.wave)); }
                } else if (do_conv && ((pass == 0) == (grp == 1))) {
                    convert_weights(F, conv_l, conv_part);
                    __syncthreads();
                }
            }
            GRID_BAR();
        }
        if (!post) {
            const bool odd = (l & 1) != 0; const int nin = odd ? 3072 : EVEN_IN;
            {
                pg8::Gemm g{XB, WPTR(W_IN), M, nin, D}; pg8::StaticOrder S; S.init(M, nin, lnd(F.G), lnd(F.bid));
                pg8::EpiInProj E{ACT, nin, SSP, (const float*)(WSP() + TAB_RC), (const float*)(WSP() + TAB_RS), (const float*)(WSP() + TAB_DC), (const float*)(WSP() + TAB_DS), odd ? 0 : 1};
                pg8::gemm_phase<pg8::EpiInProj, pg8::StaticOrder, true, true>(F.lds + RING_OFF, g, S, E, lnd(F.wave));
            }
            if (odd) gla_alow(F);
            GRID_BAR();
            if (!odd) { even_phase_a(F); GRID_BAR(); even_phase_b(F); GRID_BAR(); even_phase_c(F); }
            else { gla_phase_a(F, l >> 1); GRID_BAR(); gla_phase_b(F); GRID_BAR(); gla_phase_c(F, l >> 1); }
            GRID_BAR();
            {
                pg8::Gemm g{CAT, WPTR(W_OUT), M, D, D}; pg8::StaticOrder S; S.init(M, D, lnd(F.G), lnd(F.bid));
                pg8::EpiResid E{XB, SSP, 1.0f, F8ASLOT(s + 1) ? XB8_D : 0};
                pg8::gemm_phase<pg8::EpiResid, pg8::StaticOrder, true, true>(F.lds + RING_OFF, g, S, E, lnd(F.wave));
                XCD_BAR();
            }
        }
    }
    final_norm(F);
}

extern "C" void kernel_launch(void* const* d_in, const int* in_sizes, int n_in, void* d_out, int out_size, void* d_ws, size_t ws_size, hipStream_t stream) {
    static int grid = 0;
    if (grid == 0) {
        if (n_in != 17 || in_sizes[0] != M * D || out_size != M * D || ws_size < WS_END2) { fprintf(stderr, "kernel_launch: unexpected shapes (n_in %d, in0 %d, out %d, ws %zu)\n", n_in, n_in > 0 ? in_sizes[0] : -1, out_size, ws_size); grid = -1; return; }
        int dev = 0, cus = 0, per_cu = 0;
        if (hipGetDevice(&dev) != hipSuccess || hipDeviceGetAttribute(&cus, hipDeviceAttributeMultiprocessorCount, dev) != hipSuccess) { grid = -1; return; }
        if (hipFuncSetAttribute((const void*)fwd_kernel, hipFuncAttributeMaxDynamicSharedMemorySize, LDS_BYTES) != hipSuccess) { fprintf(stderr, "kernel_launch: hipFuncSetAttribute failed\n"); grid = -1; return; }
        if (hipOccupancyMaxActiveBlocksPerMultiprocessor(&per_cu, (const void*)fwd_kernel, NTHREADS, LDS_BYTES) != hipSuccess || per_cu < 1) { fprintf(stderr, "kernel_launch: occupancy query reports %d\n", per_cu); }
        (void)hipGetLastError();
        grid = cus;
        if (grid != 256) fprintf(stderr, "kernel_launch: %d CUs (expected 256)\n", grid);
    }
    if (grid < 0) return;
    if (hipMemsetAsync((char*)d_ws + WS_CTL, 0, CTL_ZERO_BYTES, stream) != hipSuccess) return;
    Args a{};
    for (int i = 0; i < 17; ++i) a.in[i] = (const float*)d_in[i];
    a.out = (float*)d_out; a.ws = (unsigned char*)d_ws;
    hipLaunchKernelGGL(fwd_kernel, dim3(grid), dim3(NTHREADS), LDS_BYTES, stream, a);
}
```

```cpp
#define F8_MASK 0xF0
#include <hip/hip_runtime.h>
#include <cstdio>
#include <cstdint>
#include <cmath>
template <int K> __device__ __forceinline__ float xsw(float v) { static_assert(K == 1 || K == 2 || K == 4 || K == 8 || K == 16, "xor mask inside a 32-lane half");
    return __builtin_bit_cast(float, __builtin_amdgcn_ds_swizzle(__builtin_bit_cast(int, v), 0x1F | (K << 10))); }
__device__ __forceinline__ float sum32(float v) { const unsigned u = __builtin_bit_cast(unsigned, v); auto rr = __builtin_amdgcn_permlane32_swap(u, u, false, false); return __builtin_bit_cast(float, (unsigned)rr[0]) + __builtin_bit_cast(float, (unsigned)rr[1]); }
__device__ __forceinline__ float max32(float v) { const unsigned u = __builtin_bit_cast(unsigned, v); auto rr = __builtin_amdgcn_permlane32_swap(u, u, false, false); return fmaxf(__builtin_bit_cast(float, (unsigned)rr[0]), __builtin_bit_cast(float, (unsigned)rr[1])); }
__device__ __forceinline__ float oth32(float v, int h) { const unsigned u = __builtin_bit_cast(unsigned, v); auto rr = __builtin_amdgcn_permlane32_swap(u, u, false, false); return __builtin_bit_cast(float, (unsigned)(h ? rr[0] : rr[1])); }
#ifndef PG8_WGM
#define PG8_WGM 8
#endif
namespace pg8 {
#define PG8_LAS __attribute__((address_space(3)))
typedef unsigned short bf16_t;
typedef short bf16x8 __attribute__((ext_vector_type(8)));
typedef float f32x4 __attribute__((ext_vector_type(4)));
typedef unsigned u32x4 __attribute__((ext_vector_type(4)));
constexpr int BM = 256, BK = 64, HALF = 128, HTB = HALF * BK * 2  , STAGE_BYTES = 8 * HTB, NXCD = 8, WGM = PG8_WGM;

__host__ __device__ __forceinline__ int lds_byte(int r, int c) { const int st = (r >> 4) * 2 + (c >> 5), rr = r & 15, cc = c & 31, ob = rr * 64 + cc * 2; return st * 1024 + (ob ^ (((ob >> 9) & 1) << 5)); }
__host__ __device__ __forceinline__ void stage_rc(int b, int& R, int& C) { const int st = b / 1024, sb = b % 1024, swz = sb ^ (((sb >> 9) & 1) << 5); R = (st >> 1) * 16 + swz / 64; C = (st & 1) * 32 + (swz % 64) / 2; }
__host__ __device__ __forceinline__ int perm32(int rho) { const int n = rho >> 4, i = rho & 15; return 8 * (i >> 2) + 4 * n + (i & 3); }

struct Unit { int pm, pn; };
struct Gemm { const bf16_t* A; const bf16_t* Bt; int M, N, K; };

struct StaticOrder {
    int nM, nN, nwg, G, c;
    __host__ __device__ void init(int M, int N, int G_, int c_) { nM = M / BM; nN = N / BM; nwg = nM * nN; G = G_; c = c_; }
    __host__ __device__ bool next(int i, Unit& u) const {
        const long L = (long)i * G + c; if (L >= nwg) return false;
        int wgid = (int)L; { const int q = nwg / NXCD, r = nwg % NXCD, xcd = wgid % NXCD, off = wgid / NXCD; wgid = (xcd < r ? xcd * (q + 1) : r * (q + 1) + (xcd - r) * q) + off; }
        const int nig = WGM * nN, gid = wgid / nig, fm = gid * WGM, gsz = (nM - fm) < WGM ? (nM - fm) : WGM;
        u.pm = fm + ((wgid % nig) % gsz); u.pn = (wgid % nig) / gsz; return true;
    }
    __device__ __forceinline__ void a_ready(const Unit&) const {}
    __device__ __forceinline__ void done(const Unit&) const {}
};
struct RevOrder : StaticOrder {
    __host__ __device__ bool next(int i, Unit& u) const { const int rounds = nwg / G; if (i >= rounds) return false; return StaticOrder::next(rounds - 1 - i, u); }
};

__device__ __forceinline__ unsigned cvt_pk_bf16(float lo, float hi) { unsigned r; asm volatile("v_cvt_pk_bf16_f32 %0, %1, %2" : "=v"(r) : "v"(lo), "v"(hi)); return r; }
constexpr int MROWS = 32768;
constexpr float RMS_EPS = 1e-6f;
__device__ __forceinline__ float c1024_() { float c = 1.0f / 1024.0f; asm volatile("" : "+v"(c)); return c; }
__device__ __forceinline__ void row_rstd(float (&rs)[2][4], const float* ssp, const Unit& u, int wr, int fr, int fq) {
#pragma unroll
    for (int ai = 0; ai < 2; ++ai)
#pragma unroll
        for (int m = 0; m < 4; ++m) {
            const int row = u.pm * BM + ai * HALF + wr * 64 + m * 16 + fr;
            const f32x4 p = *(const f32x4*)(ssp + (size_t)row * 16 + 4 * fq);
            float s = (p[0] + p[1]) + (p[2] + p[3]);
            s += xsw<16>(s); s = sum32(s);
            rs[ai][m] = __builtin_amdgcn_rsqf(s * c1024_() + RMS_EPS);
        }
}
struct RowPre { PG8_LAS unsigned char* tab; Unit nxt; bool has_next; int ui; };
__device__ __forceinline__ void rowpre_get(float (&rs)[2][4], const float* ssp, const Unit& u, const RowPre& rp, int wr, int fr, int fq) {
    const PG8_LAS float* t = (const PG8_LAS float*)rp.tab + (rp.ui & 1) * 128 + fr;
#pragma unroll
    for (int ai = 0; ai < 2; ++ai)
#pragma unroll
        for (int m = 0; m < 4; ++m) rs[ai][m] = t[(ai * 4 + m) * 16];
}
__device__ __forceinline__ void rowpre_issue(f32x4 (&p)[2][4], const float* ssp, const RowPre& rp, int wr, int fr, int fq) {
#pragma unroll
    for (int ai = 0; ai < 2; ++ai)
#pragma unroll
        for (int m = 0; m < 4; ++m) p[ai][m] = *(const f32x4*)(ssp + (size_t)(rp.nxt.pm * BM + ai * HALF + wr * 64 + m * 16 + fr) * 16 + 4 * fq);
}
__device__ __forceinline__ void rowpre_park(const f32x4 (&p)[2][4], const RowPre& rp, int fr, int fq) {
    PG8_LAS float* t = (PG8_LAS float*)rp.tab + ((rp.ui + 1) & 1) * 128 + fr;
#pragma unroll
    for (int ai = 0; ai < 2; ++ai)
#pragma unroll
        for (int m = 0; m < 4; ++m) { float s = (p[ai][m][0] + p[ai][m][1]) + (p[ai][m][2] + p[ai][m][3]); s += xsw<16>(s); s = sum32(s);
            if (fq == 0) t[(ai * 4 + m) * 16] = __builtin_amdgcn_rsqf(s * c1024_() + RMS_EPS); }
}
__device__ __forceinline__ void rowpre_prime_issue(f32x4 (&p)[2][4], const float* ssp, const Unit& u, int wr, int fr, int fq) {
#pragma unroll
    for (int ai = 0; ai < 2; ++ai)
#pragma unroll
        for (int m = 0; m < 4; ++m) p[ai][m] = *(const f32x4*)(ssp + (size_t)(u.pm * BM + ai * HALF + wr * 64 + m * 16 + fr) * 16 + 4 * fq);
}
__device__ __forceinline__ void rowpre_prime_park(const f32x4 (&p)[2][4], PG8_LAS unsigned char* tab, int fr, int fq) {
    PG8_LAS float* t = (PG8_LAS float*)tab + fr;
#pragma unroll
    for (int ai = 0; ai < 2; ++ai)
#pragma unroll
        for (int m = 0; m < 4; ++m) { float s = (p[ai][m][0] + p[ai][m][1]) + (p[ai][m][2] + p[ai][m][3]); s += xsw<16>(s); s = sum32(s);
            if (fq == 0) t[(ai * 4 + m) * 16] = __builtin_amdgcn_rsqf(s * c1024_() + RMS_EPS); }
}
__device__ __forceinline__ float silu_f(float g) { return g * __builtin_amdgcn_rcpf(1.0f + __builtin_amdgcn_exp2f(-1.4426950408889634f * g)); }

constexpr float F8_XSCALE = 8.0f, F8_GUSCALE = 16.0f;
constexpr float F8_HSCALE = 4.0f, F8_WSCALE = 32.0f;
template <bool OUT8, bool ACCI = false> struct EpiSwiGLUT {
    static constexpr bool PERM = true, AFTER_DRAIN = false, NEEDS_RSTD = true;
    bf16_t* H; int ldh; const float* ssp; float ascale;
    __device__ __forceinline__ void operator()(const f32x4 (&acc)[2][2][4][2], const Unit& u, int wr, int wc, int fr, int fq, const RowPre& rp) const {
        float rs[2][4]; rowpre_get(rs, ssp, u, rp, wr, fr, fq);
        f32x4 pre[2][4]; rowpre_issue(pre, ssp, rp, wr, fr, fq);
        const int col0 = u.pn * HALF + wc * 32 + 8 * fq;
#pragma unroll
        for (int ai = 0; ai < 2; ++ai)
#pragma unroll
            for (int m = 0; m < 4; ++m) {
                const int row = u.pm * BM + ai * HALF + wr * 64 + m * 16 + fr; const float r = rs[ai][m] * ascale, rn = -1.4426950408889634f * r, rr = OUT8 ? r * r * F8_HSCALE : r * r;
                float h[8];
                typedef float f32x2 __attribute__((ext_vector_type(2)));
#pragma unroll
                for (int n = 0; n < 2; ++n)
#pragma unroll
                    for (int i = 0; i < 4; i += 2) {
                        float g0 = acc[ai][0][m][n][i], g1 = acc[ai][0][m][n][i + 1], u0 = acc[ai][1][m][n][i], u1 = acc[ai][1][m][n][i + 1];
                        if constexpr (ACCI) { g0 = (float)__builtin_bit_cast(int, g0); g1 = (float)__builtin_bit_cast(int, g1); u0 = (float)__builtin_bit_cast(int, u0); u1 = (float)__builtin_bit_cast(int, u1); }
                        const f32x2 G = {g0, g1}, U = {u0, u1};
                        const f32x2 t = G * rn; f32x2 e; e.x = __builtin_amdgcn_exp2f(t.x); e.y = __builtin_amdgcn_exp2f(t.y);
                        const f32x2 d = e + 1.0f; f32x2 sg; sg.x = __builtin_amdgcn_rcpf(d.x); sg.y = __builtin_amdgcn_rcpf(d.y);
                        const f32x2 hv = ((G * U) * rr) * sg; h[4 * n + i] = hv.x; h[4 * n + i + 1] = hv.y;
                    }
                if constexpr (OUT8) {
                    int w0 = __builtin_amdgcn_cvt_pk_fp8_f32(h[0], h[1], 0, false); w0 = __builtin_amdgcn_cvt_pk_fp8_f32(h[2], h[3], w0, true);
                    int w1 = __builtin_amdgcn_cvt_pk_fp8_f32(h[4], h[5], 0, false); w1 = __builtin_amdgcn_cvt_pk_fp8_f32(h[6], h[7], w1, true);
                    typedef int i32x2 __attribute__((ext_vector_type(2)));
                    *(i32x2*)((unsigned char*)H + (size_t)row * ldh + col0) = (i32x2){w0, w1};
                } else {
                u32x4 w; w.x = cvt_pk_bf16(h[0], h[1]); w.y = cvt_pk_bf16(h[2], h[3]); w.z = cvt_pk_bf16(h[4], h[5]); w.w = cvt_pk_bf16(h[6], h[7]);
                *(u32x4*)(H + (size_t)row * ldh + col0) = w;
                }
                asm volatile("" ::: "memory");
            }
        rowpre_park(pre, rp, fr, fq);
    }
};
typedef EpiSwiGLUT<false> EpiSwiGLU;
typedef EpiSwiGLUT<true> EpiSwiGLU8;
typedef EpiSwiGLUT<false, true> EpiSwiGLUI;
typedef EpiSwiGLUT<true, true> EpiSwiGLU8I;
struct EpiInProj {
    static constexpr bool PERM = true, AFTER_DRAIN = false, NEEDS_RSTD = true;
    bf16_t* O; int ldc; const float* ssp; const float* rc; const float* rs; const float* dc; const float* ds; int even;
    __device__ __forceinline__ void operator()(const f32x4 (&acc)[2][2][4][2], const Unit& u, int wr, int wc, int fr, int fq, const RowPre& rp) const {
        float rsd[2][4]; rowpre_get(rsd, ssp, u, rp, wr, fr, fq);
        f32x4 pre[2][4]; rowpre_issue(pre, ssp, rp, wr, fr, fq);
        const int col0 = u.pn * BM + wc * 32 + 8 * fq;
        const int kind = even ? (u.pn < 4 ? 1 : ((u.pn >= 8 && u.pn < 12) ? 2 : 0)) : 0;
        const float ksc = (kind == 1 && u.pn >= 2) ? 0.08838834764831845f : 1.0f;
        const bool rot2 = (kind == 2) && ((wc & 1) == 0) && (fq < 2);
        const int b_ = (u.pm * BM) >> 12, t0 = (u.pm * BM) & 4095;
        size_t hb[2]; int dh, d0[2];
#pragma unroll
        for (int bj = 0; bj < 2; ++bj) {
            int c0, nh, head;
            if (even) { c0 = (u.pn >> 1) * 512; if (u.pn < 8) { nh = 4; dh = 128; head = (u.pn & 1) * 2 + bj; d0[bj] = wc * 32; } else { nh = 8; dh = 64; head = (u.pn & 1) * 4 + bj * 2 + (wc >> 1); d0[bj] = (wc & 1) * 32; } }
            else if (u.pn < 4) { c0 = (u.pn >> 1) * 512; nh = 4; dh = 128; head = (u.pn & 1) * 2 + bj; d0[bj] = wc * 32; }
            else if (u.pn < 12) { c0 = u.pn < 8 ? 1024 : 2048; nh = 4; dh = 256; head = u.pn & 3; d0[bj] = bj * 128 + wc * 32; }
            else { c0 = 3072; nh = 1; dh = 256; head = 0; d0[bj] = bj * 128 + wc * 32; }
            hb[bj] = (size_t)c0 * MROWS + ((size_t)(b_ * nh + head) * 4096 + t0) * dh;
        }
        const float* tc = (kind == 1) ? rc + wc * 16 + 4 * fq : dc + 4 * (fq & 1);
        const float* ts = (kind == 1) ? rs + wc * 16 + 4 * fq : ds + 4 * (fq & 1);
        const int tstride = (kind == 1) ? 64 : 8;
        typedef float f32x2 __attribute__((ext_vector_type(2)));
        if (kind == 0) {
#pragma unroll
            for (int ai = 0; ai < 2; ++ai)
#pragma unroll
                for (int m = 0; m < 4; ++m) {
                    const int row = u.pm * BM + ai * HALF + wr * 64 + m * 16 + fr; const float r = rsd[ai][m];
#pragma unroll
                    for (int bj = 0; bj < 2; ++bj) { const f32x4 v0 = acc[ai][bj][m][0] * r, v1 = acc[ai][bj][m][1] * r;
                        u32x4 w; w.x = cvt_pk_bf16(v0[0], v0[1]); w.y = cvt_pk_bf16(v0[2], v0[3]); w.z = cvt_pk_bf16(v1[0], v1[1]); w.w = cvt_pk_bf16(v1[2], v1[3]);
                        *(u32x4*)(O + hb[bj] + (size_t)(row - u.pm * BM) * dh + d0[bj] + 8 * fq) = w; }
                    asm volatile("" ::: "memory");
                }
        } else {
#pragma unroll
            for (int ai = 0; ai < 2; ++ai)
#pragma unroll
                for (int m = 0; m < 4; ++m) {
                    const int row = u.pm * BM + ai * HALF + wr * 64 + m * 16 + fr; const float r = rsd[ai][m] * ksc;
                    f32x4 c4 = {r, r, r, r}, s4 = {0.f, 0.f, 0.f, 0.f};
                    if (kind == 1 || rot2) { const int pos = row & 4095; c4 = *(const f32x4*)(tc + (size_t)pos * tstride) * r; s4 = *(const f32x4*)(ts + (size_t)pos * tstride) * r; }
#pragma unroll
                    for (int bj = 0; bj < 2; ++bj) { const f32x4 v0 = acc[ai][bj][m][0], v1 = acc[ai][bj][m][1];
                        const f32x2 a0 = {v0[0], v0[1]}, a1 = {v0[2], v0[3]}, a2 = {v1[0], v1[1]}, a3 = {v1[2], v1[3]};
                        const f32x2 b0 = {-v0[1], v0[0]}, b1 = {-v0[3], v0[2]}, b2 = {-v1[1], v1[0]}, b3 = {-v1[3], v1[2]};
                        const f32x2 o0 = a0 * c4[0] + b0 * s4[0], o1 = a1 * c4[1] + b1 * s4[1], o2 = a2 * c4[2] + b2 * s4[2], o3 = a3 * c4[3] + b3 * s4[3];
                        u32x4 w; w.x = cvt_pk_bf16(o0.x, o0.y); w.y = cvt_pk_bf16(o1.x, o1.y); w.z = cvt_pk_bf16(o2.x, o2.y); w.w = cvt_pk_bf16(o3.x, o3.y);
                        *(u32x4*)(O + hb[bj] + (size_t)(row - u.pm * BM) * dh + d0[bj] + 8 * fq) = w; }
                    asm volatile("" ::: "memory");
                }
        }
        rowpre_park(pre, rp, fr, fq);
    }
};
struct EpiResid {
    static constexpr bool PERM = true, AFTER_DRAIN = false, NEEDS_RSTD = false;
    bf16_t* xb; float* ssp; float scale; int x8d;
    __device__ __forceinline__ void operator()(const f32x4 (&acc)[2][2][4][2], const Unit& u, int wr, int wc, int fr, int fq, const RowPre&) const {
        const int col0 = u.pn * BM + wc * 32 + 8 * fq, rowb = u.pm * BM + wr * 64 + fr;
        u32x4 old[8][2];
#pragma unroll
        for (int g = 0; g < 8; ++g) { const size_t off = (size_t)(rowb + (g >> 2) * HALF + (g & 3) * 16) * 1024 + col0; old[g][0] = *(const u32x4*)(xb + off); old[g][1] = *(const u32x4*)(xb + off + HALF); }
#pragma unroll
        for (int g = 0; g < 8; ++g) {
            const int ai = g >> 2, m = g & 3, row = rowb + ai * HALF + m * 16; float ss = 0.f;
#pragma unroll
            for (int bj = 0; bj < 2; ++bj) { const size_t off = (size_t)row * 1024 + col0 + bj * HALF; const u32x4 o = old[g][bj];
                const f32x4 a0 = acc[ai][bj][m][0] * scale, a1 = acc[ai][bj][m][1] * scale;
                const float v0 = __builtin_bit_cast(float, o.x << 16) + a0[0], v1 = __builtin_bit_cast(float, o.x & 0xffff0000u) + a0[1], v2 = __builtin_bit_cast(float, o.y << 16) + a0[2], v3 = __builtin_bit_cast(float, o.y & 0xffff0000u) + a0[3];
                const float v4 = __builtin_bit_cast(float, o.z << 16) + a1[0], v5 = __builtin_bit_cast(float, o.z & 0xffff0000u) + a1[1], v6 = __builtin_bit_cast(float, o.w << 16) + a1[2], v7 = __builtin_bit_cast(float, o.w & 0xffff0000u) + a1[3];
                u32x4 w; w.x = cvt_pk_bf16(v0, v1); w.y = cvt_pk_bf16(v2, v3); w.z = cvt_pk_bf16(v4, v5); w.w = cvt_pk_bf16(v6, v7);
                *(u32x4*)(xb + off) = w;
                if (x8d) { int y0 = __builtin_amdgcn_cvt_pk_fp8_f32(v0 * F8_XSCALE, v1 * F8_XSCALE, 0, false); y0 = __builtin_amdgcn_cvt_pk_fp8_f32(v2 * F8_XSCALE, v3 * F8_XSCALE, y0, true);
                    int y1 = __builtin_amdgcn_cvt_pk_fp8_f32(v4 * F8_XSCALE, v5 * F8_XSCALE, 0, false); y1 = __builtin_amdgcn_cvt_pk_fp8_f32(v6 * F8_XSCALE, v7 * F8_XSCALE, y1, true);
                    typedef int i32x2r __attribute__((ext_vector_type(2))); *(i32x2r*)((unsigned char*)xb + x8d + off) = (i32x2r){y0, y1}; }
                ss += (v0 * v0 + v1 * v1) + (v2 * v2 + v3 * v3) + (v4 * v4 + v5 * v5) + (v6 * v6 + v7 * v7); }
            ss += xsw<16>(ss); ss = sum32(ss);
            if (fq == 0) ssp[(size_t)row * 16 + u.pn * 4 + wc] = ss;
        }
    }
};

typedef int pg8_v8i __attribute__((ext_vector_type(8)));
typedef int pg8_v4i __attribute__((ext_vector_type(4)));
__device__ __forceinline__ pg8_v8i pg8_cat(bf16x8 lo, bf16x8 hi) { const pg8_v4i a = __builtin_bit_cast(pg8_v4i, lo), b = __builtin_bit_cast(pg8_v4i, hi); return __builtin_shufflevector(a, b, 0, 1, 2, 3, 4, 5, 6, 7); }
template <class Epi, class Sched, bool ALIGN_EPI = false, bool SP2 = false, bool F8 = false, bool I8 = false>
__device__ __forceinline__ void gemm_phase(PG8_LAS unsigned char* lds, const Gemm g, const Sched& S, const Epi& E, int wave_in) {
    int tid_; { int l_; asm volatile("v_mbcnt_lo_u32_b32 %0, -1, 0\n\tv_mbcnt_hi_u32_b32 %0, -1, %0" : "=v"(l_)); tid_ = wave_in * 64 + l_; }
    const int tid = tid_, wid = __builtin_amdgcn_readfirstlane(tid >> 6), lane = tid & 63, wr = wid >> 2, wc = wid & 3, fr = lane & 15, fq = lane >> 4;
    constexpr int ES = (F8 || I8) ? 1 : 2;
    const int K = g.K, nt = K * ES / (BK * 2);
    unsigned voffA[2], voffB[2];
#pragma unroll
    for (int i = 0; i < 2; ++i) { int R, C; stage_rc(tid * 16 + i * 8192, R, C); const int Rb = Epi::PERM ? ((R & ~31) + perm32(R & 31)) : R;
        voffA[i] = (unsigned)(R * K * ES + C * 2); voffB[i] = (unsigned)(Rb * K * ES + C * 2); }
    const size_t kstep = (size_t)(BK * 2);
    const size_t hstep = (size_t)HALF * K * ES;
    const size_t tstep = 2 * hstep;
    const unsigned ldsw = (unsigned)wid * 1024u;
    const int aoff = lds_byte(wr * 64 + fr, fq * 8), boff = lds_byte(wc * 32 + fr, fq * 8);
#define PG8_SA(b, h) (((b) * 2 + (h)) * HTB)
#define PG8_SB(b, h) ((4 + (b) * 2 + (h)) * HTB)
#define PG8_STAGE(bufoff, gbase, voff) do { _Pragma("unroll") for (int _i = 0; _i < 2; ++_i) { if constexpr (F8) { unsigned vo_ = (voff)[0]; asm volatile("" : "+v"(vo_));     \
        __builtin_amdgcn_global_load_lds((const unsigned*)((const char*)(gbase) + (size_t)_i * 64 * K * ES + vo_), (PG8_LAS unsigned*)(lds + (bufoff) + ldsw + _i * 8192), 16, 0, 0); } else \
        __builtin_amdgcn_global_load_lds((const unsigned*)((const char*)(gbase) + (voff)[_i]), (PG8_LAS unsigned*)(lds + (bufoff) + ldsw + _i * 8192), 16, 0, 0); } } while (0)
#define PG8_LDA(dst, b, h) do { _Pragma("unroll") for (int m = 0; m < 4; ++m) _Pragma("unroll") for (int k = 0; k < 2; ++k) dst[m][k] = *(const PG8_LAS bf16x8*)(lds + PG8_SA(b, h) + aoff + m * 2048 + k * 1024); } while (0)
#define PG8_LDB(dst, b, h) do { _Pragma("unroll") for (int n = 0; n < 2; ++n) _Pragma("unroll") for (int k = 0; k < 2; ++k) dst[n][k] = *(const PG8_LAS bf16x8*)(lds + PG8_SB(b, h) + boff + n * 2048 + k * 1024); } while (0)
#define PG8_MMA(ai, bj, At, Bt) do { __builtin_amdgcn_s_setprio(1); if constexpr (F8) { _Pragma("unroll") for (int m = 0; m < 4; ++m) _Pragma("unroll") for (int n = 0; n < 2; ++n) \
        acc[ai][bj][m][n] = __builtin_amdgcn_mfma_scale_f32_16x16x128_f8f6f4(pg8_cat(Bt[n][0], Bt[n][1]), pg8_cat(At[m][0], At[m][1]), acc[ai][bj][m][n], 0, 0, 0, 0, 0, 0); } \
        else if constexpr (I8) { _Pragma("unroll") for (int m = 0; m < 4; ++m) _Pragma("unroll") for (int n = 0; n < 2; ++n) _Pragma("unroll") for (int k = 0; k < 2; ++k) \
        acc[ai][bj][m][n] = __builtin_bit_cast(f32x4, __builtin_amdgcn_mfma_i32_16x16x64_i8(__builtin_bit_cast(pg8_v4i, Bt[n][k]), __builtin_bit_cast(pg8_v4i, At[m][k]), __builtin_bit_cast(pg8_v4i, acc[ai][bj][m][n]), 0, 0, 0)); } \
        else { _Pragma("unroll") for (int m = 0; m < 4; ++m) _Pragma("unroll") for (int n = 0; n < 2; ++n) _Pragma("unroll") for (int k = 0; k < 2; ++k) \
        acc[ai][bj][m][n] = __builtin_amdgcn_mfma_f32_16x16x32_bf16(Bt[n][k], At[m][k], acc[ai][bj][m][n], 0, 0, 0); } __builtin_amdgcn_s_setprio(0); } while (0)
#define PG8_WAIT_V(n) asm volatile("s_waitcnt vmcnt(" #n ")" ::: "memory")
#define PG8_WAIT_L(n) asm volatile("s_waitcnt lgkmcnt(" #n ")" ::: "memory")
#define PG8_BAR __builtin_amdgcn_s_barrier()
#define PG8_SCHED __builtin_amdgcn_sched_barrier(0)
    Unit cur, nxt; int ui = 0;
    if (!S.next(0, cur)) return;
    f32x4 acc[2][2][4][2];
#pragma unroll
    for (int a = 0; a < 2; ++a)
#pragma unroll
        for (int b = 0; b < 2; ++b)
#pragma unroll
            for (int m = 0; m < 4; ++m)
#pragma unroll
                for (int n = 0; n < 2; ++n) acc[a][b][m][n] = (f32x4){0.f, 0.f, 0.f, 0.f};
    bf16x8 At[4][2], B0[2][2], B1[2][2];
    const char* cA = (const char*)g.A + (size_t)cur.pm * tstep; const char* cB = (const char*)g.Bt + (size_t)cur.pn * tstep;
    S.a_ready(cur);
    f32x4 p0[2][4];
    if constexpr (Epi::NEEDS_RSTD) rowpre_prime_issue(p0, E.ssp, cur, wr, fr, fq);
    if constexpr (SP2) {
        PG8_STAGE(PG8_SB(0, 0), cB, voffB); PG8_STAGE(PG8_SB(0, 1), cB + hstep, voffB); PG8_STAGE(PG8_SA(0, 0), cA, voffA); PG8_STAGE(PG8_SA(0, 1), cA + hstep, voffA);
        if constexpr (Epi::NEEDS_RSTD) rowpre_prime_park(p0, lds + STAGE_BYTES + wid * 1024, fr, fq);
        if (wr == 1) PG8_BAR;
        PG8_WAIT_V(2); PG8_BAR;
        PG8_STAGE(PG8_SB(1, 0), cB + kstep, voffB); PG8_STAGE(PG8_SA(1, 0), cA + kstep, voffA); PG8_STAGE(PG8_SB(1, 1), cB + hstep + kstep, voffB);
        PG8_WAIT_V(6); PG8_BAR;
    } else {
        PG8_STAGE(PG8_SB(0, 0), cB, voffB); PG8_STAGE(PG8_SA(0, 0), cA, voffA); PG8_STAGE(PG8_SB(0, 1), cB + hstep, voffB); PG8_STAGE(PG8_SA(0, 1), cA + hstep, voffA);
        if constexpr (Epi::NEEDS_RSTD) rowpre_prime_park(p0, lds + STAGE_BYTES + wid * 1024, fr, fq);
        if (wr == 1) PG8_BAR;
        PG8_WAIT_V(4); PG8_BAR;
        PG8_STAGE(PG8_SB(1, 0), cB + kstep, voffB); PG8_STAGE(PG8_SA(1, 0), cA + kstep, voffA); PG8_STAGE(PG8_SB(1, 1), cB + hstep + kstep, voffB);
        PG8_WAIT_V(6); PG8_BAR;
    }
    for (;;) {
        const bool has_next = S.next(ui + 1, nxt);
        const char* nA = has_next ? (const char*)g.A + (size_t)nxt.pm * tstep : cA; const char* nB = has_next ? (const char*)g.Bt + (size_t)nxt.pn * tstep : cB;
        for (int t = 0; t < nt; t += 2) {
            const bool last = (t == nt - 2);
            const char* a1 = cA + (size_t)(t + 1) * kstep;
            const char* a2 = last ? nA : cA + (size_t)(t + 2) * kstep; const char* b2 = last ? nB : cB + (size_t)(t + 2) * kstep;
            const char* a3 = a2 + kstep; const char* b3 = b2 + kstep;
            if (last && has_next) S.a_ready(nxt);
            if constexpr (SP2) {
            PG8_LDB(B0, 0, 0); PG8_LDB(B1, 0, 1); PG8_SCHED; PG8_LDA(At, 0, 0); PG8_STAGE(PG8_SA(1, 1), a1 + hstep, voffA);
            PG8_WAIT_V(8); PG8_WAIT_L(0); PG8_BAR; PG8_MMA(0, 0, At, B0); PG8_MMA(0, 1, At, B1); PG8_BAR; PG8_SCHED;
            PG8_LDA(At, 0, 1); PG8_STAGE(PG8_SB(0, 0), b2, voffB); PG8_STAGE(PG8_SB(0, 1), b2 + hstep, voffB); PG8_STAGE(PG8_SA(0, 0), a2, voffA);
            PG8_WAIT_V(8); PG8_WAIT_L(0); PG8_BAR; PG8_MMA(1, 0, At, B0); PG8_MMA(1, 1, At, B1); PG8_BAR; PG8_SCHED;
            PG8_LDB(B0, 1, 0); PG8_LDB(B1, 1, 1); PG8_SCHED; PG8_LDA(At, 1, 0); PG8_STAGE(PG8_SA(0, 1), a2 + hstep, voffA);
            PG8_WAIT_V(8); PG8_WAIT_L(0); PG8_BAR; PG8_MMA(0, 0, At, B0); PG8_MMA(0, 1, At, B1); PG8_BAR; PG8_SCHED;
            PG8_LDA(At, 1, 1); PG8_STAGE(PG8_SB(1, 0), b3, voffB); PG8_STAGE(PG8_SB(1, 1), b3 + hstep, voffB); PG8_STAGE(PG8_SA(1, 0), a3, voffA);
            PG8_WAIT_V(8); PG8_WAIT_L(0); PG8_BAR; PG8_MMA(1, 0, At, B0); PG8_MMA(1, 1, At, B1); PG8_BAR; PG8_SCHED;
            } else {
            PG8_LDB(B0, 0, 0); PG8_SCHED; PG8_LDA(At, 0, 0); PG8_STAGE(PG8_SA(1, 1), a1 + hstep, voffA);
            PG8_WAIT_L(8); PG8_BAR; PG8_WAIT_L(0); PG8_MMA(0, 0, At, B0); PG8_BAR; PG8_SCHED;
            PG8_LDB(B1, 0, 1); PG8_STAGE(PG8_SB(0, 0), b2, voffB);
            PG8_BAR; PG8_WAIT_L(0); PG8_MMA(0, 1, At, B1); PG8_BAR;
            PG8_LDA(At, 0, 1); PG8_STAGE(PG8_SA(0, 0), a2, voffA);
            PG8_BAR; PG8_WAIT_L(0); PG8_MMA(1, 0, At, B0); PG8_BAR; PG8_SCHED;
            PG8_STAGE(PG8_SB(0, 1), b2 + hstep, voffB);
            PG8_WAIT_V(6); PG8_BAR; PG8_MMA(1, 1, At, B1); PG8_BAR;
            PG8_LDB(B0, 1, 0); PG8_SCHED; PG8_LDA(At, 1, 0); PG8_STAGE(PG8_SA(0, 1), a2 + hstep, voffA);
            PG8_WAIT_L(8); PG8_BAR; PG8_WAIT_L(0); PG8_MMA(0, 0, At, B0); PG8_BAR; PG8_SCHED;
            PG8_LDB(B1, 1, 1); PG8_STAGE(PG8_SB(1, 0), b3, voffB);
            PG8_BAR; PG8_WAIT_L(0); PG8_MMA(0, 1, At, B1); PG8_BAR;
            PG8_LDA(At, 1, 1); PG8_STAGE(PG8_SA(1, 0), a3, voffA);
            PG8_BAR; PG8_WAIT_L(0); PG8_MMA(1, 0, At, B0); PG8_BAR; PG8_SCHED;
            PG8_STAGE(PG8_SB(1, 1), b3 + hstep, voffB);
            PG8_WAIT_V(6); PG8_BAR; PG8_MMA(1, 1, At, B1); PG8_BAR;
            }
        }
        if constexpr (ALIGN_EPI) { if (wr == 0) PG8_BAR; }
        if constexpr (!Epi::AFTER_DRAIN) {
            if constexpr (F8) { int l2; asm volatile("v_mbcnt_lo_u32_b32 %0, -1, 0\n\tv_mbcnt_hi_u32_b32 %0, -1, %0" : "=v"(l2));
                E(acc, cur, wr, wc, l2 & 15, l2 >> 4, RowPre{lds + STAGE_BYTES + wid * 1024, has_next ? nxt : cur, has_next, ui}); }
            else E(acc, cur, wr, wc, fr, fq, RowPre{lds + STAGE_BYTES + wid * 1024, has_next ? nxt : cur, has_next, ui});
            S.done(cur); }
        if (!has_next) break;
#pragma unroll
        for (int a = 0; a < 2; ++a)
#pragma unroll
            for (int b = 0; b < 2; ++b)
#pragma unroll
                for (int m = 0; m < 4; ++m)
#pragma unroll
                    for (int n = 0; n < 2; ++n) acc[a][b][m][n] = (f32x4){0.f, 0.f, 0.f, 0.f};
        cur = nxt; cA = nA; cB = nB; ++ui;
        if constexpr (ALIGN_EPI) { if (wr == 1) PG8_BAR; }
    }
    PG8_WAIT_V(0);
    if constexpr (!ALIGN_EPI) { if (wr == 0) PG8_BAR; }
    PG8_BAR;
    if constexpr (Epi::AFTER_DRAIN) { E.fused(acc, cur, wr, wc, fr, fq, lds, wid, lane); S.done(cur); }
#undef PG8_SA
#undef PG8_SB
#undef PG8_STAGE
#undef PG8_LDA
#undef PG8_LDB
#undef PG8_MMA
#undef PG8_WAIT_V
#undef PG8_WAIT_L
#undef PG8_BAR
#undef PG8_SCHED
}
}

constexpr int NWAVES = 8, NTHREADS = NWAVES * 64;
constexpr int BATCH = 8, SEQ = 4096, D = 1024, M = BATCH * SEQ, FF = 2816, DEPTH = 4;
constexpr int EVEN_IN = 3584, GLA_IN = 3088, GLA_INP = 3328;
static_assert(M == pg8::MROWS, "row count");
constexpr int E_RQ = 0, E_RK = 512, E_RV = 1024, E_RG = 1536, E_DQ = 2048, E_DK = 2560, E_DV = 3072;
constexpr int G_Q = 0, G_K = 512, G_V = 1024, G_R = 2048, G_A = 3072;
constexpr float EPS = 1e-6f;
#define HM(c0, nh, dh, b, h) ((size_t)(c0) * M + ((size_t)((b) * (nh) + (h)) * SEQ) * (dh))

constexpr size_t MiB = 1u << 20;
constexpr size_t WS_CTL = 0, CTL_ZERO_BYTES = 32768;
constexpr size_t WS_SSP = 1 * MiB;
constexpr size_t WS_TAB = 3 * MiB;
constexpr size_t TAB_RC = WS_TAB, TAB_RS = WS_TAB + 1 * MiB, TAB_DC = WS_TAB + 2 * MiB, TAB_DS = WS_TAB + 2 * MiB + 128 * 1024;
constexpr size_t WS_W = 8 * MiB;
constexpr size_t W_GU0 = WS_W, W_D0 = W_GU0 + (size_t)2 * FF * D * 2, W_GU1 = W_D0 + (size_t)D * FF * 2, W_D1 = W_GU1 + (size_t)2 * FF * D * 2,
                 W_IN = W_D1 + (size_t)D * FF * 2, W_OUT = W_IN + (size_t)EVEN_IN * D * 2, W_END = W_OUT + (size_t)D * D * 2;
constexpr size_t WS_XB = 56 * MiB;
constexpr size_t WS_ACT = 120 * MiB;
constexpr size_t WS_CAT = 344 * MiB;
constexpr size_t WS_END = 408 * MiB;
static_assert(W_END <= WS_XB && WS_XB + (size_t)M * D * 2 <= WS_ACT && WS_ACT + (size_t)M * EVEN_IN * 2 <= WS_CAT && WS_CAT + (size_t)M * D * 2 <= WS_END, "d_ws map");
constexpr int CW_BAR = 4096;

constexpr int RING_OFF = 0, RING_BYTES = 131072;
constexpr int LDSCTL_OFF = 161792, MISC_OFF = LDSCTL_OFF + 320, PTR_OFF = LDSCTL_OFF + 1024;
constexpr int LDS_BYTES = 163840;
static_assert(PTR_OFF + 19 * 8 <= LDS_BYTES && RING_BYTES <= LDSCTL_OFF, "LDS map");

#define GAS __attribute__((address_space(1)))
#define LAS __attribute__((address_space(3)))
typedef unsigned short bf16;
typedef unsigned v4u __attribute__((ext_vector_type(4)));
typedef float f32x4 __attribute__((ext_vector_type(4)));
typedef short bf16x8 __attribute__((ext_vector_type(8)));
typedef GAS unsigned gu32;
typedef GAS unsigned long long gu64;
#define RLX_AGENT __ATOMIC_RELAXED, __HIP_MEMORY_SCOPE_AGENT
#define LDS_WAIT() asm volatile("s_waitcnt lgkmcnt(0)" ::: "memory")
#define VM_WAIT() asm volatile("s_waitcnt vmcnt(0)" ::: "memory")
__device__ __forceinline__ unsigned long long rt() { return __builtin_amdgcn_s_memrealtime(); }
__device__ __forceinline__ unsigned f2bf(float f) { unsigned u = __builtin_bit_cast(unsigned, f); return (u + 0x7fffu + ((u >> 16) & 1u)) >> 16; }
__device__ __forceinline__ unsigned pk2(float lo, float hi) { return f2bf(lo) | (f2bf(hi) << 16); }

#define XB_TMO      128
#ifndef XB_MIS_EXPECT
#define XB_MIS_EXPECT 0u
#endif
#define XB_MIS      192
#define XB_XCNT(j)  (256  + 64 * (j))
#define XB_XSUB(j)  (1280 + 64 * (j))
#define XB_XGEN(j)  (2304 + 64 * (j))
#define XB_TOP      3328
#define XB_TOPGEN   3392
#define XB_TEAM(t)  (3520 + 8 * (t))
#define XCD_BAR_WORDS 4096
#define XB_SPIN_CAP (1u << 18)

__device__ __forceinline__ unsigned xb_ld(unsigned* p)              { return __hip_atomic_load(p, __ATOMIC_RELAXED, __HIP_MEMORY_SCOPE_AGENT); }
__device__ __forceinline__ unsigned xb_add(unsigned* p, unsigned v) { return __hip_atomic_fetch_add(p, v, __ATOMIC_RELAXED, __HIP_MEMORY_SCOPE_AGENT); }
__device__ __forceinline__ unsigned xb_xcc_id() { return (unsigned)__builtin_amdgcn_s_getreg((3 << 11) | 20) & 0xFu; }
#define XB_SPIN(cond, bar) do { unsigned _sp = 0; while (cond) { __builtin_amdgcn_s_sleep(1); \
    if ((++_sp & 255u) == 0u) { if (xb_ld(&(bar)[XB_TMO])) break; if (_sp > XB_SPIN_CAP) { atomicAdd(&(bar)[XB_TMO], 1u); break; } } } } while (0)

struct XcdBarrier {
    unsigned* bar; unsigned x;
    volatile LAS unsigned* st;
};

__device__ __forceinline__ XcdBarrier xcd_barrier_post(unsigned* bar, volatile LAS unsigned* st, int tid) {
    XcdBarrier b; b.bar = bar; b.x = xb_xcc_id(); b.st = st;
    if (tid == 0) { if ((blockIdx.x & 7u) != b.x) (void)xb_add(&bar[XB_MIS], 1u); (void)xb_add(&bar[XB_XCNT(b.x)], 1u); }
    return b;
}
__device__ __forceinline__ void xcd_barrier_complete(unsigned* bar, unsigned x, unsigned& nloc, unsigned& nx) {
    const unsigned G = gridDim.x * gridDim.y * gridDim.z;
    unsigned sum, cnt, mine, sp = 0u;
    for (;;) {
        sum = 0u; cnt = 0u; mine = 0u;
#pragma unroll
        for (unsigned j = 0; j < 16; ++j) { const unsigned c = xb_ld(&bar[XB_XCNT(j)]); sum += c; cnt += (c > 0u) ? 1u : 0u; mine = (j == x) ? c : mine; }
        if (sum == G) break;
        __builtin_amdgcn_s_sleep(1);
        if ((++sp & 255u) == 0u) { if (xb_ld(&bar[XB_TMO])) break; if (sp > XB_SPIN_CAP) { atomicAdd(&bar[XB_TMO], 1u); break; } }
    }
    nloc = mine > 0u ? mine : 1u; nx = cnt > 0u ? cnt : 1u;
}

template <int LOCAL = 0>
__device__ __forceinline__ void xcd_barrier(const XcdBarrier& b, int tid) {
    asm volatile("s_waitcnt vmcnt(0)" ::: "memory");
    __syncthreads();
    if (tid == 0) {
        unsigned* bar = b.bar;
        __builtin_amdgcn_s_waitcnt(0);
        unsigned nloc = b.st[0], nx = b.st[1];
        if (nloc == 0u) { xcd_barrier_complete(bar, b.x, nloc, nx); b.st[0] = nloc; b.st[1] = nx; }
        bool skip_top = false;
        if (LOCAL) { unsigned lk = b.st[2];
            if (lk == 0u) { lk = (xb_ld(&bar[XB_MIS]) == XB_MIS_EXPECT && nx == 8u && nloc == 32u && gridDim.x == 256u) ? 1u : 2u; b.st[2] = lk; }
            skip_top = lk == 1u; }
        if (LOCAL == 2 && skip_top) {
            unsigned* c = &bar[XB_TEAM((blockIdx.x & 7u) * 8u + ((blockIdx.x >> 3) & 7u))];
            const unsigned tgt = (xb_add(c, 1u) / 4u + 1u) * 4u;
            XB_SPIN(xb_ld(c) < tgt, bar);
            __builtin_amdgcn_fence(__ATOMIC_ACQUIRE, "agent");
            asm volatile("s_waitcnt vmcnt(0)" ::: "memory");
        } else {
        const unsigned old = xb_add(&bar[XB_XSUB(b.x)], 1u);
        const unsigned gen = old / nloc;
        if (old + 1u == (gen + 1u) * nloc) {
          if (!skip_top) {
            __builtin_amdgcn_fence(__ATOMIC_RELEASE, "agent");
            asm volatile("s_waitcnt vmcnt(0)" ::: "memory");
            const unsigned og = xb_add(&bar[XB_TOP], 1u);
            const unsigned tg = og / nx;
            if (og + 1u == (tg + 1u) * nx) xb_add(&bar[XB_TOPGEN], 1u);
            else XB_SPIN(xb_ld(&bar[XB_TOPGEN]) == tg, bar);
          }
            __builtin_amdgcn_fence(__ATOMIC_ACQUIRE, "agent");
            xb_add(&bar[XB_XGEN(b.x)], 1u);
            asm volatile("s_waitcnt vmcnt(0)" ::: "memory");
        } else {
            XB_SPIN(xb_ld(&bar[XB_XGEN(b.x)]) == gen, bar);
            __builtin_amdgcn_fence(__ATOMIC_ACQUIRE, "agent");
            asm volatile("s_waitcnt vmcnt(0)" ::: "memory");
        }
        }
    }
    __syncthreads();
}

__constant__ float RET_FREQ[64] = {1.000000000e+00f, 8.639884591e-01f, 7.464760542e-01f, 6.449466944e-01f, 5.572264791e-01f, 4.814372361e-01f, 4.159561992e-01f, 3.593813777e-01f, 3.105013371e-01f, 2.682695687e-01f, 2.317818105e-01f, 2.002568096e-01f, 1.730195731e-01f, 1.494869143e-01f, 1.291549653e-01f, 1.115883961e-01f, 9.641107172e-02f, 8.329805732e-02f, 7.196855545e-02f, 6.218000501e-02f, 5.372280627e-02f, 4.641588405e-02f, 4.010278732e-02f, 3.464834765e-02f, 2.993577160e-02f, 2.586415969e-02f, 2.234633639e-02f, 1.930697635e-02f, 1.668100432e-02f, 1.441219542e-02f, 1.245197095e-02f, 1.075835899e-02f, 9.295095690e-03f, 8.030855097e-03f, 6.938565988e-03f, 5.994840991e-03f, 5.179473665e-03f, 4.475005437e-03f, 3.866352839e-03f, 3.340484342e-03f, 2.886139788e-03f, 2.493591513e-03f, 2.154434333e-03f, 1.861406374e-03f, 1.608233666e-03f, 1.389495330e-03f, 1.200507861e-03f, 1.037224894e-03f, 8.961503627e-04f, 7.742635789e-04f, 6.689548027e-04f, 5.779692437e-04f, 4.993587499e-04f, 4.314401885e-04f, 3.727593285e-04f, 3.220597573e-04f, 2.782559313e-04f, 2.404099068e-04f, 2.077113895e-04f, 1.794602431e-04f, 1.550515735e-04f, 1.339627634e-04f, 1.157422885e-04f, 9.999999747e-05f};
__constant__ float ROPE_FREQ[8] = {1.000000000e+00f, 1.939227432e-01f, 3.760603070e-02f, 7.292664610e-03f, 1.414213562e-03f, 2.742481884e-04f, 5.318295734e-05f, 1.031338525e-05f};
static_assert((CW_BAR + XCD_BAR_WORDS) * 4 <= (int)CTL_ZERO_BYTES, "the grid barrier's words are inside the per-call memset");
struct Args { const float* in[17]; float* out; unsigned char* ws; };
enum { I_X = 0, I_PRE_NORM = 1, I_PRE_WG = 2, I_PRE_WU = 3, I_PRE_WD = 4, I_MIX_NORM = 5, I_AB_IN = 6, I_AB_OUT = 7, I_GLA_IN = 8, I_GLA_A2 = 9, I_GLA_BA = 10, I_GLA_OUT = 11,
       I_POST_NORM = 12, I_POST_WG = 13, I_POST_WU = 14, I_POST_WD = 15, I_FINAL = 16, I_OUT = 17, I_WS = 18, N_PTRS = 19 };
struct Frame {
    LAS unsigned char* lds;
    int tid, lane, wave, G, bid;
};
__device__ __forceinline__ unsigned char* tabp(const Frame& F, int idx) {
    int off_ = PTR_OFF + 8 * idx; asm volatile("" : "+s"(off_));
    const volatile LAS unsigned* T = (const volatile LAS unsigned*)(F.lds + off_);
    const unsigned lo = __builtin_amdgcn_readfirstlane(T[0]), hi = __builtin_amdgcn_readfirstlane(T[1]);
    GAS unsigned char* gp_ = (GAS unsigned char*)(((unsigned long long)hi << 32) | (unsigned long long)lo);
    return (unsigned char*)gp_;
}
#define AP(idx) ((const float*)tabp(F, idx))
#define WSP() tabp(F, I_WS)
#define OUTP() ((float*)tabp(F, I_OUT))
__device__ __forceinline__ int lnd(int v) { asm volatile("" : "+s"(v)); return v; }
__device__ __forceinline__ int hw_lane() { return (int)__builtin_amdgcn_mbcnt_hi(~0u, __builtin_amdgcn_mbcnt_lo(~0u, 0u)); }
__device__ __forceinline__ int hw_lane_v() { int l; asm volatile("v_mbcnt_lo_u32_b32 %0, -1, 0\n\tv_mbcnt_hi_u32_b32 %0, -1, %0" : "=v"(l)); return l; }
__device__ __forceinline__ Frame relaunder(const Frame& F0) { Frame F = F0; int t_ = F0.wave * 64 + hw_lane_v(); asm volatile("" : "+s"(F.bid)); F.tid = t_; F.lane = F.tid & 63; F.wave = __builtin_amdgcn_readfirstlane(F.tid >> 6);
    unsigned lb_ = 0u; asm volatile("" : "+s"(lb_)); F.lds = F0.lds + lb_; return F; }
__device__ __forceinline__ float wave_sum(float v) {
    v += xsw<1>(v); v += xsw<2>(v); v += xsw<4>(v); v += xsw<8>(v); v += xsw<16>(v);
    return sum32(v);
}
__device__ __forceinline__ float bf2f(bf16 h) { return __builtin_bit_cast(float, (unsigned)h << 16); }
__device__ __forceinline__ float bflo(unsigned w) { return __builtin_bit_cast(float, w << 16); }
__device__ __forceinline__ float bfhi(unsigned w) { return __builtin_bit_cast(float, w & 0xffff0000u); }
__device__ __forceinline__ bf16 f2bf_rne(float f) { return (bf16)f2bf(f); }

#ifndef F8_MASK
#define F8_MASK 0xE0
#endif
#define F8SLOT(s_) (((F8_MASK) >> (s_)) & 1)
#ifndef F8A_MASK
#define F8A_MASK 0x00
#endif
#define F8ASLOT(s_) ((s_) < 8 && (((F8A_MASK) >> (s_)) & 1))
#ifndef I8A_MASK
#define I8A_MASK 0xFF
#endif
#define I8ASLOT(s_) ((s_) < 8 && (((I8A_MASK) >> (s_)) & 1))
#define I8CONV(s_) I8ASLOT(s_)
#ifndef I8_WCLIP
#define I8_WCLIP 3.4f
#endif
constexpr size_t WS_I8S = 2048;
#define I8SW(s_) (*(const GAS float*)(WSP() + WS_I8S + 4 * (s_)))
static_assert((I8A_MASK & F8A_MASK) == 0, "a gate|up GEMM is int8 or fp8, not both");
static_assert((F8A_MASK & ~F8_MASK) == 0, "an fp8 gate|up GEMM writes e4m3 hidden rows: its down projection must be fp8 as well");
constexpr size_t WS_X8 = 408 * MiB;
#define XB8 (WSP() + WS_X8)
constexpr int XB8_D = (int)(WS_X8 - WS_XB);
__device__ __forceinline__ void tr_item(const float* W, int K, int N, int Npad, const float* gain, bf16* WT, int gu, LAS float* scr, int item, int lane, float f8s = 0.f) {
    const int nblk = Npad / 32, kb = item / nblk, nb = item % nblk, k0 = 64 * kb, n0 = 32 * nb;
    {
        const int c4 = lane & 7; const bool ok = n0 + 4 * c4 < N;
        const GAS float* src = (const GAS float*)W + (size_t)(k0 + (lane >> 3)) * N + n0 + 4 * c4;
        f32x4 v[8];
#pragma unroll
        for (int i = 0; i < 8; ++i) v[i] = ok ? __builtin_nontemporal_load((const GAS f32x4*)(src + (size_t)(8 * i) * N)) : (f32x4){0.f, 0.f, 0.f, 0.f};
#pragma unroll
        for (int i = 0; i < 8; ++i) { const int kk = 8 * i + (lane >> 3); const float gn = gain ? ((const GAS float*)gain)[k0 + kk] : 1.0f; LAS float* s = scr + kk * 33 + 4 * c4;
            s[0] = v[i][0] * gn; s[1] = v[i][1] * gn; s[2] = v[i][2] * gn; s[3] = v[i][3] * gn;
            }
    }
    LDS_WAIT(); asm volatile("" ::: "memory");
    const int c = lane & 7;
#pragma unroll
    for (int j = 0; j < 4; ++j) { const int n = (lane >> 3) + 8 * j; const LAS float* s = scr + (8 * c) * 33 + n;
        v4u o; o.x = pk2(s[0 * 33], s[1 * 33]); o.y = pk2(s[2 * 33], s[3 * 33]); o.z = pk2(s[4 * 33], s[5 * 33]); o.w = pk2(s[6 * 33], s[7 * 33]);
        int drow = n0 + n;
        if (gu == 3) {
            if (drow < 1024) { const int j = drow & 127; drow = (drow & ~127) + (j < 64 ? 2 * j : 2 * (j - 64) + 1); }
            else if (drow >= 2048 && drow < 3072) { const int j = drow & 63; drow = (drow & ~63) + (j < 8 ? 2 * j : (j < 16 ? 2 * (j - 8) + 1 : j)); }
        } else if (gu == 1 || gu == 2) drow = (drow >> 7) * 256 + (drow & 127) + (gu == 2 ? 128 : 0);
        if (f8s < 0.f) {
            int q[8];
#pragma unroll
            for (int e = 0; e < 8; ++e) q[e] = (int)fminf(fmaxf(rintf(s[e * 33] * -f8s), -127.f), 127.f) & 0xff;
            typedef int i32x2q __attribute__((ext_vector_type(2)));
            *(GAS i32x2q*)((GAS unsigned char*)WT + (size_t)drow * K + k0 + 8 * c) = (i32x2q){q[0] | (q[1] << 8) | (q[2] << 16) | (q[3] << 24), q[4] | (q[5] << 8) | (q[6] << 16) | (q[7] << 24)};
        } else
        if (f8s != 0.f) {
            const int w0 = __builtin_amdgcn_cvt_pk_fp8_f32(s[0 * 33] * f8s, s[1 * 33] * f8s, 0, false), w0b = __builtin_amdgcn_cvt_pk_fp8_f32(s[2 * 33] * f8s, s[3 * 33] * f8s, w0, true);
            const int w1 = __builtin_amdgcn_cvt_pk_fp8_f32(s[4 * 33] * f8s, s[5 * 33] * f8s, 0, false), w1b = __builtin_amdgcn_cvt_pk_fp8_f32(s[6 * 33] * f8s, s[7 * 33] * f8s, w1, true);
            typedef int i32x2_ __attribute__((ext_vector_type(2)));
            *(GAS i32x2_*)((GAS unsigned char*)WT + (size_t)drow * K + k0 + 8 * c) = (i32x2_){w0b, w1b};
        } else
        *(GAS v4u*)(WT + (size_t)drow * K + k0 + 8 * c) = o; }
    LDS_WAIT(); asm volatile("" ::: "memory");
}
__device__ __forceinline__ void convert_weights(const Frame& F0, int l, int part, float pro_s0 = 0.f, float pro_s1 = 0.f) {
    const Frame F = relaunder(F0);
    LAS float* scr = (LAS float*)(F.lds + RING_OFF + F.wave * 16384);
    const int gw = F.bid * NWAVES + F.wave, NGW = F.G * NWAVES;
    unsigned char* ws = WSP();
    constexpr int I_G = (D / 64) * (FF / 32), I_DN = (FF / 64) * (D / 32), I_O = (D / 64) * (D / 32);
    const bool odd = (l & 1) != 0; const int li = l >> 1;
    const int nin = odd ? GLA_IN : EVEN_IN, ninp = odd ? GLA_INP : EVEN_IN; const int I_IN = (D / 64) * (ninp / 32);
    const float* win = odd ? AP(I_GLA_IN) + (size_t)li * D * GLA_IN : AP(I_AB_IN) + (size_t)li * D * EVEN_IN;
    const float* wout = odd ? AP(I_GLA_OUT) + (size_t)li * D * D : AP(I_AB_OUT) + (size_t)li * D * D;
    const size_t fo = (size_t)l * D * FF;
    const int NITEMS = 6 * I_G + I_IN + I_O;
    static_assert(I_G == I_DN, "item counts");
    const int nitems = part == 0 ? NITEMS : (part == 1 ? 3 * I_G + I_IN : 3 * I_G + I_O);
    const float i8s0 = I8CONV(2 * l) ? (part == 0 ? -pro_s0 : -I8SW(2 * l)) : 0.f, i8s1 = I8CONV(2 * l + 1) ? (part == 0 ? -pro_s1 : -I8SW(2 * l + 1)) : 0.f;
    for (int it = gw; it < nitems; it += NGW) {
        int r = part == 2 ? (it < 3 * I_G ? it + 3 * I_G : it + 3 * I_G + I_IN) : ((part == 1 && it >= 3 * I_G) ? it + 3 * I_G : it);
        if (r < I_G) { tr_item(AP(I_PRE_WG) + fo, D, FF, FF, AP(I_PRE_NORM) + l * D, (bf16*)(ws + W_GU0), 1, scr, r, F.lane, I8CONV(2 * l) ? i8s0 : (F8ASLOT(2 * l) ? pg8::F8_GUSCALE : 0.f)); continue; } r -= I_G;
        if (r < I_G) { tr_item(AP(I_PRE_WU) + fo, D, FF, FF, AP(I_PRE_NORM) + l * D, (bf16*)(ws + W_GU0), 2, scr, r, F.lane, I8CONV(2 * l) ? i8s0 : (F8ASLOT(2 * l) ? pg8::F8_GUSCALE : 0.f)); continue; } r -= I_G;
        if (r < I_G) { tr_item(AP(I_PRE_WD) + fo, FF, D, D, nullptr, (bf16*)(ws + W_D0), 0, scr, r, F.lane, F8SLOT(2 * l) ? pg8::F8_WSCALE : 0.f); continue; } r -= I_G;
        if (r < I_G) { tr_item(AP(I_POST_WG) + fo, D, FF, FF, AP(I_POST_NORM) + l * D, (bf16*)(ws + W_GU1), 1, scr, r, F.lane, I8CONV(2 * l + 1) ? i8s1 : (F8ASLOT(2 * l + 1) ? pg8::F8_GUSCALE : 0.f)); continue; } r -= I_G;
        if (r < I_G) { tr_item(AP(I_POST_WU) + fo, D, FF, FF, AP(I_POST_NORM) + l * D, (bf16*)(ws + W_GU1), 2, scr, r, F.lane, I8CONV(2 * l + 1) ? i8s1 : (F8ASLOT(2 * l + 1) ? pg8::F8_GUSCALE : 0.f)); continue; } r -= I_G;
        if (r < I_G) { tr_item(AP(I_POST_WD) + fo, FF, D, D, nullptr, (bf16*)(ws + W_D1), 0, scr, r, F.lane, F8SLOT(2 * l + 1) ? pg8::F8_WSCALE : 0.f); continue; } r -= I_G;
        if (r < I_IN) { tr_item(win, D, nin, ninp, AP(I_MIX_NORM) + l * D, (bf16*)(ws + W_IN), odd ? 0 : 3, scr, r, F.lane); continue; } r -= I_IN;
        tr_item(wout, D, D, D, nullptr, (bf16*)(ws + W_OUT), 0, scr, r, F.lane);
    }
}
__device__ __forceinline__ float i8_scale_block(const Frame& F, int s) {
    const int l = s >> 1; const bool post = (s & 1) != 0; const size_t fo = (size_t)l * D * FF;
    const GAS float* wg = (const GAS float*)(AP(post ? I_POST_WG : I_PRE_WG) + fo); const GAS float* wu = (const GAS float*)(AP(post ? I_POST_WU : I_PRE_WU) + fo);
    const GAS float* gn = (const GAS float*)(AP(post ? I_POST_NORM : I_PRE_NORM) + l * D);
    float ss = 0.f, gm = 0.f;
    {
        f32x4 a[8], b[8];
#pragma unroll
        for (int i = 0; i < 8; ++i) { a[i] = ((const GAS f32x4*)wg)[F.tid + i * NTHREADS]; b[i] = ((const GAS f32x4*)wu)[F.tid + i * NTHREADS]; }
        static_assert(8 * NTHREADS * 4 == 16384, "sample size");
        for (int i = F.tid; i < D; i += NTHREADS) gm = fmaxf(gm, fabsf(gn[i]));
#pragma unroll
        for (int i = 0; i < 8; ++i) ss += a[i][0] * a[i][0] + a[i][1] * a[i][1] + a[i][2] * a[i][2] + a[i][3] * a[i][3] + b[i][0] * b[i][0] + b[i][1] * b[i][1] + b[i][2] * b[i][2] + b[i][3] * b[i][3];
    }
    ss = wave_sum(ss);
    gm = fmaxf(gm, xsw<1>(gm)); gm = fmaxf(gm, xsw<2>(gm)); gm = fmaxf(gm, xsw<4>(gm)); gm = fmaxf(gm, xsw<8>(gm)); gm = fmaxf(gm, xsw<16>(gm)); gm = max32(gm);
    LAS float* red = (LAS float*)(F.lds + RING_OFF);
    if (F.lane == 0) { red[F.wave] = ss; red[8 + F.wave] = gm; }
    __syncthreads();
    float st = 0.f, gt = 0.f;
    for (int w = 0; w < NWAVES; ++w) { st += red[w]; gt = fmaxf(gt, red[8 + w]); }
    __syncthreads();
    const float sigma = sqrtf(st * (1.0f / (2.0f * 16384.0f)));
    return 127.0f / fmaxf(I8_WCLIP * sigma * gt, 1e-20f);
}
__device__ __forceinline__ float i8_scales(const Frame& F0, float& s0) {
    const Frame F = relaunder(F0);
    float s1 = 0.f; s0 = 0.f;
    if (I8ASLOT(0)) { s0 = i8_scale_block(F, 0); if (F.bid == 0 && F.tid == 0) *(GAS float*)(WSP() + WS_I8S) = s0; }
    if (I8ASLOT(1)) { s1 = i8_scale_block(F, 1); if (F.bid == 1 && F.tid == 0) *(GAS float*)(WSP() + WS_I8S + 4) = s1; }
    if (F.bid >= 2 && F.bid < 8 && I8ASLOT(F.bid)) { const float v = i8_scale_block(F, F.bid); if (F.tid == 0) *(GAS float*)(WSP() + WS_I8S + 4 * F.bid) = v; }
    return s1;
}
__device__ __forceinline__ void prologue_rows(const Frame& F0) {
    const Frame F = relaunder(F0);
    unsigned char* ws = WSP();
    const int gw = F.bid * NWAVES + F.wave, NGW = F.G * NWAVES;
    bf16* XB = (bf16*)(ws + WS_XB); float* ssp = (float*)(ws + WS_SSP);
    for (int m = gw; m < M; m += NGW) {
        const GAS f32x4* xr = (const GAS f32x4*)(AP(I_X) + (size_t)m * D) + F.lane;
        GAS unsigned long long* o8 = (GAS unsigned long long*)(XB + (size_t)m * D) + F.lane;
        float s = 0.f;
#pragma unroll
        for (int j = 0; j < 4; ++j) { const f32x4 v = xr[64 * j]; s += (v.x * v.x + v.y * v.y) + (v.z * v.z + v.w * v.w);
            o8[64 * j] = (unsigned long long)pk2(v.x, v.y) | ((unsigned long long)pk2(v.z, v.w) << 32); }
        s = wave_sum(s);
        if (F.lane < 16) ssp[(size_t)m * 16 + F.lane] = (F.lane == 0) ? s : 0.f;
    }
    const int gt = F.bid * NTHREADS + F.tid, NGT = F.G * NTHREADS;
    float* rc = (float*)(ws + TAB_RC); float* rsn = (float*)(ws + TAB_RS); float* dc = (float*)(ws + TAB_DC); float* ds = (float*)(ws + TAB_DS);
    for (int e = gt; e < SEQ * 64; e += NGT) { const int t = e >> 6, i = e & 63; const float ang = (float)t * RET_FREQ[i];
        double rev = (double)ang * 0.15915494309189535; rev -= __builtin_rint(rev); const float r = (float)rev;
        rc[e] = __builtin_amdgcn_cosf(r); rsn[e] = __builtin_amdgcn_sinf(r); }
    for (int e = gt; e < SEQ * 8; e += NGT) { const int t = e >> 3, i = e & 7; const float ang = (float)t * ROPE_FREQ[i];
        double rev = (double)ang * 0.15915494309189535; rev -= __builtin_rint(rev); const float r = (float)rev;
        dc[e] = __builtin_amdgcn_cosf(r); ds[e] = __builtin_amdgcn_sinf(r); }
}

__device__ __forceinline__ void quant_rows(const Frame& F0, int slot) {
    const Frame F = relaunder(F0);
    unsigned char* ws = WSP();
    const int pan0 = (F.bid & 7) * 16 + ((F.bid >> 3) & 7), widx = (F.bid >> 6) * NWAVES + F.wave;
    const bf16* XBp = (const bf16*)(ws + WS_XB); unsigned char* X8 = ws + WS_X8; float* ssp = (float*)(ws + WS_SSP);
    const float swi = 1.0f / I8SW(slot);
    for (int k = 0; k < 16; ++k) {
        const int m = (pan0 + (k & 8)) * 256 + widx + 32 * (k & 7);
        const GAS v4u* xr = (const GAS v4u*)(XBp + (size_t)m * D) + 2 * F.lane;
        const v4u a = xr[0], b = xr[1];
        float v[16];
#pragma unroll
        for (int i = 0; i < 4; ++i) { v[2 * i] = bflo(a[i]); v[2 * i + 1] = bfhi(a[i]); v[8 + 2 * i] = bflo(b[i]); v[8 + 2 * i + 1] = bfhi(b[i]); }
        float ss = 0.f, mx = 0.f;
#pragma unroll
        for (int i = 0; i < 16; ++i) { ss += v[i] * v[i]; mx = fmaxf(mx, fabsf(v[i])); }
        ss = wave_sum(ss);
        mx = fmaxf(mx, xsw<1>(mx)); mx = fmaxf(mx, xsw<2>(mx)); mx = fmaxf(mx, xsw<4>(mx)); mx = fmaxf(mx, xsw<8>(mx)); mx = fmaxf(mx, xsw<16>(mx)); mx = max32(mx);
        mx = fmaxf(mx, 1e-20f);
        const float sx = 127.0f / mx;
        int q[16];
#pragma unroll
        for (int i = 0; i < 16; ++i) q[i] = (int)rintf(v[i] * sx) & 0xff;
        v4u o;
#pragma unroll
        for (int i = 0; i < 4; ++i) o[i] = (unsigned)(q[4 * i] | (q[4 * i + 1] << 8) | (q[4 * i + 2] << 16) | (q[4 * i + 3] << 24));
        *((GAS v4u*)(X8 + (size_t)m * D) + F.lane) = o;
        const float rstd = 1.0f / sqrtf(ss * (1.0f / D) + EPS), reff = rstd * mx * (1.0f / 127.0f) * swi;
        if (F.lane < 16) ssp[(size_t)m * 16 + F.lane] = (F.lane == 0) ? 1024.0f * (1.0f / (reff * reff) - EPS) : 0.f;
    }
}

__device__ __forceinline__ void final_norm(const Frame& F0) {
    const Frame F = relaunder(F0);
    const int gw = F.bid * NWAVES + F.wave, NGW = F.G * NWAVES;
    const bf16* XBp = (const bf16*)(WSP() + WS_XB); float* out = OUTP(); const GAS f32x4* gr = (const GAS f32x4*)AP(I_FINAL);
    for (int m = gw; m < M; m += NGW) {
        const v4u w0 = *(const GAS v4u*)(XBp + (size_t)m * D + F.lane * 8), w1 = *(const GAS v4u*)(XBp + (size_t)m * D + 512 + F.lane * 8);
        float v[16]; float s = 0.f;
#pragma unroll
        for (int i = 0; i < 4; ++i) { v[2 * i] = bflo(w0[i]); v[2 * i + 1] = bfhi(w0[i]); v[8 + 2 * i] = bflo(w1[i]); v[8 + 2 * i + 1] = bfhi(w1[i]); }
#pragma unroll
        for (int i = 0; i < 16; ++i) s += v[i] * v[i];
        const float rstd = 1.0f / sqrtf(wave_sum(s) * (1.0f / D) + EPS);
        GAS f32x4* o = (GAS f32x4*)(out + (size_t)m * D);
#pragma unroll
        for (int hh = 0; hh < 2; ++hh)
#pragma unroll
            for (int q = 0; q < 2; ++q) { const int c4 = hh * 128 + F.lane * 2 + q; const f32x4 g = gr[c4];
                o[c4] = (f32x4){v[hh * 8 + q * 4] * rstd * g[0], v[hh * 8 + q * 4 + 1] * rstd * g[1], v[hh * 8 + q * 4 + 2] * rstd * g[2], v[hh * 8 + q * 4 + 3] * rstd * g[3]}; }
    }
}


__device__ __forceinline__ float silu_f(float g) { return g * __builtin_amdgcn_rcpf(1.0f + __builtin_amdgcn_exp2f(-1.4426950408889634f * g)); }
typedef float f32x16 __attribute__((ext_vector_type(16)));
typedef short s16x4 __attribute__((ext_vector_type(4)));
typedef float f32x2_t __attribute__((ext_vector_type(2)));
typedef __bf16 bf16x2_t __attribute__((ext_vector_type(2)));
#define MFMA32(a, b, c) __builtin_amdgcn_mfma_f32_32x32x16_bf16((a), (b), (c), 0, 0, 0)
__device__ __forceinline__ int crow(int reg, int h) { return (reg & 3) + 8 * (reg >> 2) + 4 * h; }
__device__ __forceinline__ unsigned cvtpk(float lo, float hi) { f32x2_t v = {lo, hi}; bf16x2_t b = __builtin_convertvector(v, bf16x2_t); return __builtin_bit_cast(unsigned, b); }
__device__ __forceinline__ bf16 cvt1(float v) { return (bf16)(cvtpk(v, 0.f) & 0xffffu); }
#define PACK_STEP(x, s) __builtin_bit_cast(bf16x8, (v4u){cvtpk((x)[8 * (s)], (x)[8 * (s) + 1]), cvtpk((x)[8 * (s) + 2], (x)[8 * (s) + 3]), cvtpk((x)[8 * (s) + 4], (x)[8 * (s) + 5]), cvtpk((x)[8 * (s) + 6], (x)[8 * (s) + 7])})
typedef const LAS unsigned char* lcp;
__device__ __forceinline__ int lndv(int v) { asm volatile("" : "+v"(v)); return v; }
__device__ __forceinline__ bf16x8 ld_row(lcp img, int P, int row0, int k0, int r, int h) { return *(const LAS bf16x8*)(img + (row0 + r) * P + (k0 + 8 * h) * 2); }
__device__ __forceinline__ bf16x8 ld_row_perm(lcp img, int P, int row0, int k0, int r, int h) {
    const s16x4 lo = *(const LAS s16x4*)(img + (row0 + r) * P + (k0 + 4 * h) * 2), hi = *(const LAS s16x4*)(img + (row0 + r) * P + (k0 + 8 + 4 * h) * 2);
    return __builtin_shufflevector(lo, hi, 0, 1, 2, 3, 4, 5, 6, 7); }
__device__ __forceinline__ s16x4 trd(lcp p) { return __builtin_bit_cast(s16x4, __builtin_amdgcn_ds_read_tr16_b64_v4i16((LAS s16x4*)p)); }
__device__ __forceinline__ bf16x8 ld_tr(lcp img, int P, int k0, int c0, int lane) {
    const int i16 = lane & 15, q = i16 >> 2, p = i16 & 3, blk = (lane >> 4) & 1, h = lane >> 5;
    lcp a = img + (k0 + 8 * h + q) * P + (c0 + 16 * blk + 4 * p) * 2;
    const s16x4 lo = trd(a), hi = trd(a + 4 * P);
    return __builtin_shufflevector(lo, hi, 0, 1, 2, 3, 4, 5, 6, 7); }
__device__ __forceinline__ bf16x8 ld_tr_perm(lcp img, int P, int k0, int c0, int lane) {
    const int i16 = lane & 15, q = i16 >> 2, p = i16 & 3, blk = (lane >> 4) & 1, h = lane >> 5;
    lcp a = img + (k0 + 4 * h + q) * P + (c0 + 16 * blk + 4 * p) * 2;
    const s16x4 lo = trd(a), hi = trd(a + 8 * P);
    return __builtin_shufflevector(lo, hi, 0, 1, 2, 3, 4, 5, 6, 7); }
template <int R, int C> __device__ __forceinline__ void tile_ld(v4u (&v)[R * C / 8 / NTHREADS], const bf16* g, size_t gp, int tid) {
    constexpr int CPR = C / 8, RS = NTHREADS / CPR;
    static_assert(NTHREADS % CPR == 0, "tile shape");
    const unsigned voff = (unsigned)((tid / CPR) * (int)gp + (tid % CPR) * 8) * 2u;
    const GAS unsigned char* gb = (const GAS unsigned char*)g;
#pragma unroll
    for (int i = 0; i < R * C / 8 / NTHREADS; ++i) v[i] = *(const GAS v4u*)(gb + (size_t)i * RS * gp * 2 + voff);
}
template <int R, int C> __device__ __forceinline__ void tile_st(const v4u (&v)[R * C / 8 / NTHREADS], LAS unsigned char* img, int P, int tid) {
    constexpr int CPR = C / 8, RS = NTHREADS / CPR;
    LAS unsigned char* lb = img + (tid / CPR) * P + (tid % CPR) * 16;
#pragma unroll
    for (int i = 0; i < R * C / 8 / NTHREADS; ++i) *(LAS v4u*)(lb + i * RS * P) = v[i];
}
template <int R, int C> __device__ __forceinline__ void stage_tile(LAS unsigned char* img, int P, const bf16* g, size_t gp, int tid) { v4u t_[R * C / 8 / NTHREADS]; tile_ld<R, C>(t_, g, gp, tid); tile_st<R, C>(t_, img, P, tid); }
#define WG_BAR() do { asm volatile("s_waitcnt lgkmcnt(0)" ::: "memory"); __builtin_amdgcn_s_barrier(); asm volatile("" ::: "memory"); } while (0)

constexpr int PR = 272, PT = 320, PT256 = 576, PO256 = 528;
constexpr size_t WS_ALOW = 7 * MiB;
constexpr size_t WS_DEC = 6 * MiB;
constexpr float LOG2E = 1.4426950408889634f, LN2 = 0.6931471805599453f;
__device__ __forceinline__ void gla_cumsum(float (&Bc)[2][16], float& Blast, lcp AL, lcp W2, const LAS float* BA, LAS float* EX, int wave, int lane) {
    const int r = lane & 31, h = lane >> 5, db = wave & 3, jh = wave >> 2;
    const bf16x8 wf = *(const LAS bf16x8*)(W2 + (db * 32 + r) * 32 + h * 16);
    const float bias = BA[db * 32 + r];
    float run = 0.f;
    float c16 = 1.0f / 16.0f; asm volatile("" : "+v"(c16)); float ln2_ = LN2; asm volatile("" : "+v"(ln2_));
#pragma unroll
    for (int t = 0; t < 2; ++t) {
        const bf16x8 af = *(const LAS bf16x8*)(AL + ((jh * 2 + t) * 32 + r) * 32 + h * 16);
        f32x16 z = {0.f, 0.f, 0.f, 0.f, 0.f, 0.f, 0.f, 0.f, 0.f, 0.f, 0.f, 0.f, 0.f, 0.f, 0.f, 0.f};
        z = MFMA32(af, wf, z);
        float own[4], oth[4];
#pragma unroll
        for (int g = 0; g < 4; ++g) {
            float acc = 0.f;
#pragma unroll
            for (int i = 0; i < 4; ++i) { const float zz = z[4 * g + i] + bias;
                const float la = (fminf(zz, 0.f) - ln2_ * __builtin_amdgcn_logf(1.0f + __builtin_amdgcn_exp2f(-fabsf(zz) * LOG2E))) * c16;
                acc += la; Bc[t][4 * g + i] = acc; }
            own[g] = acc; oth[g] = oth32(acc, h);
        }
#pragma unroll
        for (int g = 0; g < 4; ++g) { const float off = run + (h ? oth[g] : 0.f);
#pragma unroll
            for (int i = 0; i < 4; ++i) Bc[t][4 * g + i] += off;
            run += own[g] + oth[g]; }
    }
    if (h == 0) EX[jh * 128 + db * 32 + r] = run;
    WG_BAR();
    const float t0 = EX[db * 32 + r], t1 = EX[128 + db * 32 + r];
    Blast = t0 + t1;
    if (jh == 1) {
#pragma unroll
        for (int t = 0; t < 2; ++t)
#pragma unroll
            for (int i = 0; i < 16; ++i) Bc[t][i] += t0; }
}
constexpr int GA_KI = 0, GA_VI = GA_KI + 128 * PR, GA_KD = GA_VI + 128 * PT256, GA_AL = GA_KD + 128 * PT, GA_W2 = GA_AL + 4096, GA_BA = GA_W2 + 4096, GA_EX = GA_BA + 512, GA_END = GA_EX + 1024;
constexpr int GA_OI = GA_VI;
constexpr int GC_QT = 0, GC_KT = GC_QT + 128 * PR, GC_SI = GC_KT + 128 * PR, GC_VI = GC_SI + 128 * PT, GC_AL = GC_VI + 128 * PT, GC_W2 = GC_AL + 4096, GC_BA = GC_W2 + 4096, GC_EX = GC_BA + 512, GC_END = GC_EX + 1024;
constexpr int GC_OI = 0;
static_assert(GA_END <= LDSCTL_OFF && GC_END <= LDSCTL_OFF && 128 * PO256 <= GC_SI && 128 * PO256 <= 128 * PT256, "GLA LDS maps");
__device__ __forceinline__ void gla_stage_w(const Frame& F, LAS unsigned char* W2, LAS float* BA, int li, int h) {
    if (F.tid < 128) { const int d = F.tid; const GAS float* w2 = (const GAS float*)AP(I_GLA_A2) + (size_t)li * 16 * 512 + h * 128 + d;
        v4u lo, hi; lo.x = cvtpk(w2[0], w2[512]); lo.y = cvtpk(w2[2 * 512], w2[3 * 512]); lo.z = cvtpk(w2[4 * 512], w2[5 * 512]); lo.w = cvtpk(w2[6 * 512], w2[7 * 512]);
        hi.x = cvtpk(w2[8 * 512], w2[9 * 512]); hi.y = cvtpk(w2[10 * 512], w2[11 * 512]); hi.z = cvtpk(w2[12 * 512], w2[13 * 512]); hi.w = cvtpk(w2[14 * 512], w2[15 * 512]);
        *(LAS v4u*)(W2 + d * 32) = lo; *(LAS v4u*)(W2 + d * 32 + 16) = hi; }
    else if (F.tid < 256) { const int d = F.tid - 128; BA[d] = ((const GAS float*)AP(I_GLA_BA))[(size_t)li * 512 + h * 128 + d]; }
}
__device__ __forceinline__ v4u gla_ld_alow(int tid, const bf16* Arow0) { const int t = tid & 255; return *(const GAS v4u*)(Arow0 + (size_t)(t >> 1) * 16 + (t & 1) * 8); }
__device__ __forceinline__ void gla_st_alow(int tid, v4u v, LAS unsigned char* AL) { if (tid < 256) *(LAS v4u*)(AL + (tid >> 1) * 32 + (tid & 1) * 16) = v; }

__device__ __forceinline__ void gla_alow(const Frame& F0) {
    const Frame F = relaunder(F0);
    unsigned char* ws = WSP();
    const bf16* XBp = (const bf16*)(ws + WS_XB); const bf16* Wa = (const bf16*)(ws + W_IN) + (size_t)3072 * D; const float* ssp = (const float*)(ws + WS_SSP); bf16* ALOW = (bf16*)(ws + WS_ALOW);
    LAS unsigned char* L = F.lds;
    const int lane = F.lane, r = lane & 31, h2 = lane >> 5, tb = F.wave & 3, kh = F.wave >> 2;
    for (int blk = F.bid; blk < M / 128; blk += F.G) {
        const int tok = blk * 128 + tb * 32 + r;
        const bf16* xa = XBp + (size_t)tok * D + kh * 512 + 8 * h2; const bf16* wa = Wa + (size_t)(r & 15) * D + kh * 512 + 8 * h2;
        f32x16 acc = {0.f, 0.f, 0.f, 0.f, 0.f, 0.f, 0.f, 0.f, 0.f, 0.f, 0.f, 0.f, 0.f, 0.f, 0.f, 0.f};
#pragma unroll 1
        for (int k8 = 0; k8 < 4; ++k8) {
            bf16x8 af[8], bfr[8];
#pragma unroll
            for (int ks = 0; ks < 8; ++ks) { af[ks] = *(const GAS bf16x8*)(wa + (k8 * 8 + ks) * 16); bfr[ks] = *(const GAS bf16x8*)(xa + (k8 * 8 + ks) * 16); }
#pragma unroll
            for (int ks = 0; ks < 8; ++ks) acc = MFMA32(af[ks], bfr[ks], acc);
        }
        LAS float* red = (LAS float*)L + tb * 1024;
        if (kh == 1) {
#pragma unroll
            for (int i = 0; i < 8; ++i) red[i * 64 + lane] = acc[i]; }
        WG_BAR();
        if (kh == 0) {
            const f32x4 p0 = *(const GAS f32x4*)(ssp + (size_t)tok * 16), p1 = *(const GAS f32x4*)(ssp + (size_t)tok * 16 + 4), p2 = *(const GAS f32x4*)(ssp + (size_t)tok * 16 + 8), p3 = *(const GAS f32x4*)(ssp + (size_t)tok * 16 + 12);
            const float ss = ((p0[0] + p0[1]) + (p0[2] + p0[3])) + ((p1[0] + p1[1]) + (p1[2] + p1[3])) + ((p2[0] + p2[1]) + (p2[2] + p2[3])) + ((p3[0] + p3[1]) + (p3[2] + p3[3]));
            const float rstd = __builtin_amdgcn_rsqf(ss * (1.0f / 1024.0f) + EPS);
            float v[8];
#pragma unroll
            for (int i = 0; i < 8; ++i) v[i] = (acc[i] + red[i * 64 + lane]) * rstd;
            typedef unsigned u2v __attribute__((ext_vector_type(2)));
            u2v w0, w1; w0.x = cvtpk(v[0], v[1]); w0.y = cvtpk(v[2], v[3]); w1.x = cvtpk(v[4], v[5]); w1.y = cvtpk(v[6], v[7]);
            *(GAS u2v*)(ALOW + (size_t)tok * 16 + 4 * h2) = w0; *(GAS u2v*)(ALOW + (size_t)tok * 16 + 8 + 4 * h2) = w1;
        }
        WG_BAR();
    }
}
__device__ __forceinline__ void gla_phase_a(const Frame& F0, int li) {
    const Frame F = relaunder(F0);
    unsigned char* ws = WSP();
    const bf16* P = (const bf16*)(ws + WS_ACT); bf16* SKV = (bf16*)OUTP(); float* DEC = (float*)(ws + WS_DEC); const bf16* ALOWP = (const bf16*)(ws + WS_ALOW);
    LAS unsigned char* L = F.lds;
    const int wave = F.wave, db = wave & 3, jh = wave >> 2;
    v4u kR[4], vR[8], aR; int hcur = -1;
    {   const int it = F.bid; if (it < 1024) { const int bh = it >> 5, g = it & 31, b = bh >> 2, h = bh & 3;
            tile_ld<128, 128>(kR, P + HM(G_K, 4, 128, b, h) + g * 128 * 128, 128, F.tid); tile_ld<128, 256>(vR, P + HM(G_V, 4, 256, b, h) + g * 128 * 256, 256, F.tid); aR = gla_ld_alow(F.tid, ALOWP + ((size_t)b * SEQ + g * 128) * 16); } }
    for (int it = F.bid; it < 1024; it += F.G) {
        const int bh = it >> 5, h = bh & 3;
        const int lane = lndv(F.lane), r = lane & 31, h2 = lane >> 5;
        tile_st<128, 128>(kR, L + GA_KI, PR, F.tid); tile_st<128, 256>(vR, L + GA_VI, PT256, F.tid); gla_st_alow(F.tid, aR, L + GA_AL);
        if (h != hcur) { gla_stage_w(F, L + GA_W2, (LAS float*)(L + GA_BA), li, h); hcur = h; }
        WG_BAR();
        {   const int nx = it + F.G; if (nx < 1024) { const int bh2 = nx >> 5, g2 = nx & 31, b2 = bh2 >> 2, h2n = bh2 & 3;
                tile_ld<128, 128>(kR, P + HM(G_K, 4, 128, b2, h2n) + g2 * 128 * 128, 128, F.tid); tile_ld<128, 256>(vR, P + HM(G_V, 4, 256, b2, h2n) + g2 * 128 * 256, 256, F.tid); aR = gla_ld_alow(F.tid, ALOWP + ((size_t)b2 * SEQ + g2 * 128) * 16); } }
        float Bc[2][16], Blast;
        gla_cumsum(Bc, Blast, L + GA_AL, L + GA_W2, (const LAS float*)(L + GA_BA), (LAS float*)(L + GA_EX), wave, lane);
#pragma unroll
        for (int t = 0; t < 2; ++t)
#pragma unroll
            for (int i = 0; i < 16; ++i) { const int row = (jh * 2 + t) * 32 + crow(i, h2), col = db * 32 + r;
                const float kv = bf2f(*(const LAS bf16*)(L + GA_KI + row * PR + col * 2)) * __builtin_amdgcn_exp2f((Blast - Bc[t][i]) * LOG2E);
                *(LAS bf16*)(L + GA_KD + row * PT + col * 2) = cvt1(kv); }
        if (jh == 0 && h2 == 0) DEC[(size_t)it * 128 + db * 32 + r] = __builtin_amdgcn_exp2f(Blast * LOG2E);
        WG_BAR();
        f32x16 acc[4];
#pragma unroll
        for (int t = 0; t < 4; ++t) acc[t] = (f32x16){0.f, 0.f, 0.f, 0.f, 0.f, 0.f, 0.f, 0.f, 0.f, 0.f, 0.f, 0.f, 0.f, 0.f, 0.f, 0.f};
#pragma unroll
        for (int ks = 0; ks < 8; ++ks) { const bf16x8 a = ld_tr(L + GA_KD, PT, 16 * ks, db * 32, lane);
#pragma unroll
            for (int t = 0; t < 4; ++t) acc[t] = MFMA32(a, ld_tr(L + GA_VI, PT256, 16 * ks, (4 * jh + t) * 32, lane), acc[t]); }
        WG_BAR();
#pragma unroll
        for (int t = 0; t < 4; ++t)
#pragma unroll
            for (int i = 0; i < 16; ++i) *(LAS bf16*)(L + GA_OI + (db * 32 + crow(i, h2)) * PO256 + ((4 * jh + t) * 32 + r) * 2) = cvt1(acc[t][i]);
        WG_BAR();
        {   bf16* out = SKV + (size_t)it * 128 * 256;
#pragma unroll
            for (int i = 0; i < 8; ++i) { const int c = F.tid + i * NTHREADS, row = c >> 5, cc = c & 31; *(GAS v4u*)(out + row * 256 + cc * 8) = *(const LAS v4u*)(L + GA_OI + row * PO256 + cc * 16); } }
        WG_BAR();
    }
}
__device__ __forceinline__ void gla_phase_b(const Frame& F0) {
    const Frame F = relaunder(F0);
    unsigned char* ws = WSP();
    bf16* SKV = (bf16*)OUTP(); const float* DEC = (const float*)(ws + WS_DEC);
    for (int gt = F.bid * NTHREADS + F.tid; gt < 32 * 128 * 32; gt += F.G * NTHREADS) {
        const int bh = gt >> 12, d = (gt >> 5) & 127, e8 = gt & 31;
        float s[8];
#pragma unroll
        for (int i = 0; i < 8; ++i) s[i] = 0.f;
        for (int g0 = 0; g0 < 32; g0 += 8) {
            v4u kv[8]; float dc[8];
#pragma unroll
            for (int u = 0; u < 8; ++u) { const size_t item = (size_t)bh * 32 + g0 + u; kv[u] = *(const GAS v4u*)(SKV + (item * 128 + d) * 256 + e8 * 8); dc[u] = ((const GAS float*)DEC)[item * 128 + d]; }
#pragma unroll
            for (int u = 0; u < 8; ++u) { const size_t item = (size_t)bh * 32 + g0 + u;
                v4u o; o.x = cvtpk(s[0], s[1]); o.y = cvtpk(s[2], s[3]); o.z = cvtpk(s[4], s[5]); o.w = cvtpk(s[6], s[7]);
                *(GAS v4u*)(SKV + (item * 128 + d) * 256 + e8 * 8) = o;
#pragma unroll
                for (int i = 0; i < 4; ++i) { s[2 * i] = dc[u] * s[2 * i] + bflo(kv[u][i]); s[2 * i + 1] = dc[u] * s[2 * i + 1] + bfhi(kv[u][i]); } }
        }
    }
}
__device__ __forceinline__ void gla_phase_c(const Frame& F0, int li) {
    const Frame F = relaunder(F0);
    unsigned char* ws = WSP();
    const bf16* P = (const bf16*)(ws + WS_ACT); const bf16* SKV = (const bf16*)OUTP(); bf16* CAT = (bf16*)(ws + WS_CAT); const bf16* ALOWP = (const bf16*)(ws + WS_ALOW);
    LAS unsigned char* L = F.lds;
    const int wave = F.wave, db = wave & 3, jh = wave >> 2;
    const int ib = wave & 3, eq = wave >> 2;
    v4u qR[4], kR[4], aR; int hcur = -1;
    {   const int it = F.bid; if (it < 1024) { const int bh = it >> 5, g = it & 31, b = bh >> 2, h = bh & 3;
            tile_ld<128, 128>(qR, P + HM(G_Q, 4, 128, b, h) + g * 128 * 128, 128, F.tid); tile_ld<128, 128>(kR, P + HM(G_K, 4, 128, b, h) + g * 128 * 128, 128, F.tid); aR = gla_ld_alow(F.tid, ALOWP + ((size_t)b * SEQ + g * 128) * 16); } }
    for (int it = F.bid; it < 1024; it += F.G) {
        const int bh = it >> 5, g = it & 31, b = bh >> 2, h = bh & 3;
        const int tidl = lndv(F.tid), lane = tidl & 63, r = lane & 31, h2 = lane >> 5;
        const bf16* Vs = P + HM(G_V, 4, 256, b, h) + (size_t)g * 128 * 256; const bf16* Rs = P + HM(G_R, 4, 256, b, h) + (size_t)g * 128 * 256;
        const bf16* Sg = SKV + (size_t)it * 128 * 256;
        {   v4u sR[4], vR[4]; tile_ld<128, 128>(sR, Sg, 256, tidl); tile_ld<128, 128>(vR, Vs, 256, tidl);
            tile_st<128, 128>(qR, L + GC_QT, PR, tidl); tile_st<128, 128>(kR, L + GC_KT, PR, tidl); tile_st<128, 128>(sR, L + GC_SI, PT, tidl); tile_st<128, 128>(vR, L + GC_VI, PT, tidl); }
        gla_st_alow(tidl, aR, L + GC_AL);
        if (h != hcur) { gla_stage_w(F, L + GC_W2, (LAS float*)(L + GC_BA), li, h); hcur = h; }
        WG_BAR();
        {
            float Bc[2][16], Blast;
            gla_cumsum(Bc, Blast, L + GC_AL, L + GC_W2, (const LAS float*)(L + GC_BA), (LAS float*)(L + GC_EX), wave, lane);
#pragma unroll
            for (int t = 0; t < 2; ++t)
#pragma unroll
                for (int i = 0; i < 16; ++i) { const int off = ((jh * 2 + t) * 32 + crow(i, h2)) * PR + (db * 32 + r) * 2;
                    const float eb = __builtin_amdgcn_exp2f(Bc[t][i] * LOG2E);
                    const float qv = bf2f(*(const LAS bf16*)(L + GC_QT + off)) * eb * 0.08838834764831845f;
                    const float kv = bf2f(*(const LAS bf16*)(L + GC_KT + off)) * __builtin_amdgcn_rcpf(eb);
                    *(LAS bf16*)(L + GC_QT + off) = cvt1(qv); *(LAS bf16*)(L + GC_KT + off) = cvt1(kv); }
        }
        WG_BAR();
        bf16x8 PA[4][2];
#pragma unroll
        for (int jb = 0; jb < 4; ++jb) {
            if (jb <= ib) {
                f32x16 x = {0.f, 0.f, 0.f, 0.f, 0.f, 0.f, 0.f, 0.f, 0.f, 0.f, 0.f, 0.f, 0.f, 0.f, 0.f, 0.f};
#pragma unroll
                for (int ks = 0; ks < 8; ++ks) x = MFMA32(ld_row(L + GC_KT, PR, jb * 32, 16 * ks, r, h2), ld_row(L + GC_QT, PR, ib * 32, 16 * ks, r, h2), x);
                if (jb == ib) {
#pragma unroll
                    for (int i = 0; i < 16; ++i) if (crow(i, h2) > r) x[i] = 0.f; }
                PA[jb][0] = PACK_STEP(x, 0); PA[jb][1] = PACK_STEP(x, 1);
            } else { PA[jb][0] = (bf16x8){0, 0, 0, 0, 0, 0, 0, 0}; PA[jb][1] = (bf16x8){0, 0, 0, 0, 0, 0, 0, 0}; }
        }
        f32x16 o[2][2];
        v4u s1R[4], v1R[4];
        tile_ld<128, 128>(s1R, Sg + 128, 256, tidl); tile_ld<128, 128>(v1R, Vs + 128, 256, tidl);
#pragma unroll
        for (int half = 0; half < 2; ++half) {
            if (half == 1) {
                WG_BAR();
                tile_st<128, 128>(s1R, L + GC_SI, PT, tidl); tile_st<128, 128>(v1R, L + GC_VI, PT, tidl);
                WG_BAR();
            }
#pragma unroll
            for (int t = 0; t < 2; ++t) {
                const int eb = 2 * eq + t;
                f32x16 acc = {0.f, 0.f, 0.f, 0.f, 0.f, 0.f, 0.f, 0.f, 0.f, 0.f, 0.f, 0.f, 0.f, 0.f, 0.f, 0.f};
#pragma unroll
                for (int jb = 0; jb < 4; ++jb) if (jb <= ib) {
#pragma unroll
                    for (int s = 0; s < 2; ++s) acc = MFMA32(PA[jb][s], ld_tr_perm(L + GC_VI, PT, jb * 32 + 16 * s, eb * 32, lane), acc); }
#pragma unroll
                for (int ks = 0; ks < 8; ++ks) acc = MFMA32(ld_row(L + GC_QT, PR, ib * 32, 16 * ks, r, h2), ld_tr(L + GC_SI, PT, 16 * ks, eb * 32, lane), acc);
                o[half][t] = acc;
            }
        }
        WG_BAR();
#pragma unroll
        for (int half = 0; half < 2; ++half)
#pragma unroll
            for (int t = 0; t < 2; ++t)
#pragma unroll
                for (int i = 0; i < 16; ++i) *(LAS bf16*)(L + GC_OI + (ib * 32 + crow(i, h2)) * PO256 + (half * 128 + (2 * eq + t) * 32 + r) * 2) = cvt1(o[half][t][i]);
        WG_BAR();
        {   const int nx = (it + F.G < 1024) ? it + F.G : it;
            const int bh2 = nx >> 5, g2 = nx & 31, hn = bh2 & 3, bn = bh2 >> 2;
            tile_ld<128, 128>(qR, P + HM(G_Q, 4, 128, bn, hn) + g2 * 128 * 128, 128, tidl); tile_ld<128, 128>(kR, P + HM(G_K, 4, 128, bn, hn) + g2 * 128 * 128, 128, tidl); aR = gla_ld_alow(tidl, ALOWP + ((size_t)bn * SEQ + g2 * 128) * 16); }
        {
            const int tid2 = lndv(tidl), row = tid2 >> 2, qtr = tid2 & 3;
            lcp orow = L + GC_OI + row * PO256 + qtr * 128;
            const bf16* gp = Rs + (size_t)row * 256 + qtr * 64;
            float sum = 0.f;
#pragma unroll
            for (int c = 0; c < 8; ++c) { const v4u w = *(const LAS v4u*)(orow + c * 16);
#pragma unroll
                for (int i = 0; i < 4; ++i) sum += bflo(w[i]) + bfhi(w[i]); }
            sum += xsw<1>(sum); sum += xsw<2>(sum);
            const float mu = sum * (1.0f / 256.0f); float sq = 0.f;
#pragma unroll
            for (int c = 0; c < 8; ++c) { const v4u w = *(const LAS v4u*)(orow + c * 16);
#pragma unroll
                for (int i = 0; i < 4; ++i) { const float d0 = bflo(w[i]) - mu, d1 = bfhi(w[i]) - mu; sq += d0 * d0 + d1 * d1; } }
            sq += xsw<1>(sq); sq += xsw<2>(sq);
            float eps_ = EPS; asm volatile("" : "+v"(eps_)); const float rstd = 1.0f / sqrtf(sq * (1.0f / 256.0f) + eps_);
            bf16* op = CAT + ((size_t)b * SEQ + g * 128 + row) * D + h * 256 + qtr * 64;
#pragma unroll
            for (int c = 0; c < 8; ++c) { const v4u gw = *(const GAS v4u*)(gp + c * 8); const v4u w = *(const LAS v4u*)(orow + c * 16); v4u ow;
#pragma unroll
                for (int i = 0; i < 4; ++i) { const float g0 = bflo(gw[i]), g1 = bfhi(gw[i]);
                    ow[i] = cvtpk((bflo(w[i]) - mu) * rstd * silu_f(g0), (bfhi(w[i]) - mu) * rstd * silu_f(g1)); }
                *(GAS v4u*)(op + c * 8) = ow; }
        }
        WG_BAR();
    }
}


constexpr size_t WS_OD = 408 * MiB;
constexpr size_t OUT_LSE = 32 * MiB;
constexpr size_t WS_END2 = 504 * MiB;
constexpr int RA_KI = 0, RA_VD = RA_KI + 128 * PT, RA_END = RA_VD + 128 * PT;
constexpr int RC_QI = 0, RC_KI = RC_QI + 128 * PR, RC_VI = RC_KI + 128 * PR, RC_SI = RC_VI + 128 * PT, RC_END = RC_SI + 128 * PT;
constexpr int DPK = 144, DPV = 192;
constexpr int DL_KI = 0, DL_VI = DL_KI + 384 * DPK, DL_LW = DL_VI + 384 * DPV, DL_END = DL_LW + 8 * 256;
constexpr int DL_ST = DL_KI;
static_assert(RC_END <= LDSCTL_OFF && DL_END <= LDSCTL_OFF && 8 * 32 * DPK <= 384 * DPK, "even mixer LDS maps");
__device__ __forceinline__ float ret_log2g(int h) { return log2f(1.0f - exp2f(-5.0f - (float)h)); }

__device__ __forceinline__ void ret_phase_a_items(const Frame& F, const bf16* P, bf16* RKV) {
    LAS unsigned char* L = F.lds;
    const int wave = F.wave, db = wave & 3, eh = wave >> 2;
    v4u kR[4], vR[4];
    {   const int it = F.bid < 1024 ? F.bid : 0; const int bh = it >> 5, n = it & 31;
        tile_ld<128, 128>(kR, P + HM(E_RK, 4, 128, bh >> 2, bh & 3) + n * 128 * 128, 128, F.tid); tile_ld<128, 128>(vR, P + HM(E_RV, 4, 128, bh >> 2, bh & 3) + n * 128 * 128, 128, F.tid); }
    for (int it = F.bid; it < 1024; it += F.G) {
        const int tidl = lndv(F.tid), lane = tidl & 63, r = lane & 31, h2 = lane >> 5;
        const int bh = it >> 5, h = bh & 3;
        const float lg = ret_log2g(h);
        tile_st<128, 128>(kR, L + RA_KI, PT, tidl);
        {
#pragma unroll
            for (int i = 0; i < 4; ++i) { const int row = (tidl >> 4) + 32 * i, cc = tidl & 15; const float f = __builtin_amdgcn_exp2f(lg * (float)(127 - row)); v4u o;
#pragma unroll
                for (int k = 0; k < 4; ++k) o[k] = cvtpk(bflo(vR[i][k]) * f, bfhi(vR[i][k]) * f);
                *(LAS v4u*)(L + RA_VD + row * PT + cc * 16) = o; }
        }
        WG_BAR();
        {   const int nx = (it + F.G < 1024) ? it + F.G : it; const int bh2 = nx >> 5, n2 = nx & 31;
            tile_ld<128, 128>(kR, P + HM(E_RK, 4, 128, bh2 >> 2, bh2 & 3) + n2 * 128 * 128, 128, tidl); tile_ld<128, 128>(vR, P + HM(E_RV, 4, 128, bh2 >> 2, bh2 & 3) + n2 * 128 * 128, 128, tidl); }
        f32x16 acc[2];
#pragma unroll
        for (int t = 0; t < 2; ++t) acc[t] = (f32x16){0.f, 0.f, 0.f, 0.f, 0.f, 0.f, 0.f, 0.f, 0.f, 0.f, 0.f, 0.f, 0.f, 0.f, 0.f, 0.f};
#pragma unroll
        for (int ks = 0; ks < 8; ++ks) { const bf16x8 a = ld_tr(L + RA_KI, PT, 16 * ks, db * 32, lane);
#pragma unroll
            for (int t = 0; t < 2; ++t) acc[t] = MFMA32(a, ld_tr(L + RA_VD, PT, 16 * ks, (2 * eh + t) * 32, lane), acc[t]); }
        WG_BAR();
#pragma unroll
        for (int t = 0; t < 2; ++t)
#pragma unroll
            for (int i = 0; i < 16; ++i) *(LAS bf16*)(L + RA_KI + (db * 32 + crow(i, h2)) * PR + ((2 * eh + t) * 32 + r) * 2) = cvt1(acc[t][i]);
        WG_BAR();
        bf16* out = RKV + (size_t)it * 128 * 128;
#pragma unroll
        for (int i = 0; i < 4; ++i) { const int row = (tidl >> 4) + 32 * i, cc = tidl & 15; *(GAS v4u*)(out + row * 128 + cc * 8) = *(const LAS v4u*)(L + RA_KI + row * PR + cc * 16); }
        WG_BAR();
    }
}
__device__ __forceinline__ void ret_scan(const Frame& F, bf16* RKV) {
    for (int gt = F.bid * NTHREADS + F.tid; gt < 32 * 128 * 32; gt += F.G * NTHREADS) {
        const int bh = gt >> 12, d = (gt >> 5) & 127, e4 = gt & 31, h = bh & 3;
        const float g128 = __builtin_amdgcn_exp2f(ret_log2g(h) * 128.0f);
        float s[4];
#pragma unroll
        for (int i = 0; i < 4; ++i) s[i] = 0.f;
        typedef unsigned u2v __attribute__((ext_vector_type(2)));
        for (int n0 = 0; n0 < 32; n0 += 8) {
            u2v kv[8];
#pragma unroll
            for (int u = 0; u < 8; ++u) kv[u] = *(const GAS u2v*)(RKV + (((size_t)bh * 32 + n0 + u) * 128 + d) * 128 + e4 * 4);
#pragma unroll
            for (int u = 0; u < 8; ++u) {
                u2v o; o.x = cvtpk(s[0], s[1]); o.y = cvtpk(s[2], s[3]);
                *(GAS u2v*)(RKV + (((size_t)bh * 32 + n0 + u) * 128 + d) * 128 + e4 * 4) = o;
#pragma unroll
                for (int i = 0; i < 2; ++i) { s[2 * i] = g128 * s[2 * i] + bflo(kv[u][i]); s[2 * i + 1] = g128 * s[2 * i + 1] + bfhi(kv[u][i]); } }
        }
    }
}
__device__ __forceinline__ void ret_phase_c_items(const Frame& F, const bf16* P, const bf16* RKV, bf16* CAT) {
    LAS unsigned char* L = F.lds;
    const int wave = F.wave, ib = wave & 3, eq = wave >> 2;
    v4u qR[4], kR[4];
    {   const int it = F.bid < 1024 ? F.bid : 0; const int bh = it >> 5, n = it & 31;
        tile_ld<128, 128>(qR, P + HM(E_RQ, 4, 128, bh >> 2, bh & 3) + n * 128 * 128, 128, F.tid); tile_ld<128, 128>(kR, P + HM(E_RK, 4, 128, bh >> 2, bh & 3) + n * 128 * 128, 128, F.tid); }
    for (int it = F.bid; it < 1024; it += F.G) {
        const int tidl = lndv(F.tid), lane = tidl & 63, r = lane & 31, h2 = lane >> 5;
        const int bh = it >> 5, n = it & 31, b = bh >> 2, h = bh & 3;
        const float lg = ret_log2g(h);
        {   v4u vR[4], sR[4]; tile_ld<128, 128>(vR, P + HM(E_RV, 4, 128, b, h) + n * 128 * 128, 128, tidl); tile_ld<128, 128>(sR, RKV + (size_t)it * 128 * 128, 128, tidl);
#pragma unroll
            for (int i = 0; i < 4; ++i) { const int row = (tidl >> 4) + 32 * i, cc = tidl & 15; const float fq = __builtin_amdgcn_exp2f(lg * (float)row), fk = __builtin_amdgcn_rcpf(fq); v4u oq, ok;
#pragma unroll
                for (int k = 0; k < 4; ++k) { oq[k] = cvtpk(bflo(qR[i][k]) * fq, bfhi(qR[i][k]) * fq); ok[k] = cvtpk(bflo(kR[i][k]) * fk, bfhi(kR[i][k]) * fk); }
                *(LAS v4u*)(L + RC_QI + row * PR + cc * 16) = oq; *(LAS v4u*)(L + RC_KI + row * PR + cc * 16) = ok; }
            tile_st<128, 128>(vR, L + RC_VI, PT, tidl); tile_st<128, 128>(sR, L + RC_SI, PT, tidl); }
        WG_BAR();
        bf16x8 PA[4][2];
#pragma unroll
        for (int jb = 0; jb < 4; ++jb) {
            if (jb <= ib) {
                f32x16 x = {0.f, 0.f, 0.f, 0.f, 0.f, 0.f, 0.f, 0.f, 0.f, 0.f, 0.f, 0.f, 0.f, 0.f, 0.f, 0.f};
#pragma unroll
                for (int ks = 0; ks < 8; ++ks) x = MFMA32(ld_row(L + RC_KI, PR, jb * 32, 16 * ks, r, h2), ld_row(L + RC_QI, PR, ib * 32, 16 * ks, r, h2), x);
                if (jb == ib) {
#pragma unroll
                    for (int i = 0; i < 16; ++i) if (crow(i, h2) > r) x[i] = 0.f; }
                PA[jb][0] = PACK_STEP(x, 0); PA[jb][1] = PACK_STEP(x, 1);
            } else { PA[jb][0] = (bf16x8){0, 0, 0, 0, 0, 0, 0, 0}; PA[jb][1] = (bf16x8){0, 0, 0, 0, 0, 0, 0, 0}; }
        }
        f32x16 o[2];
#pragma unroll
        for (int t = 0; t < 2; ++t) {
            const int eb = 2 * eq + t;
            f32x16 z = {0.f, 0.f, 0.f, 0.f, 0.f, 0.f, 0.f, 0.f, 0.f, 0.f, 0.f, 0.f, 0.f, 0.f, 0.f, 0.f}, y = z;
#pragma unroll
            for (int jb = 0; jb < 4; ++jb) if (jb <= ib) {
#pragma unroll
                for (int s = 0; s < 2; ++s) z = MFMA32(PA[jb][s], ld_tr_perm(L + RC_VI, PT, jb * 32 + 16 * s, eb * 32, lane), z); }
#pragma unroll
            for (int ks = 0; ks < 8; ++ks) y = MFMA32(ld_row(L + RC_QI, PR, ib * 32, 16 * ks, r, h2), ld_tr(L + RC_SI, PT, 16 * ks, eb * 32, lane), y);
            const float g1 = __builtin_amdgcn_exp2f(lg);
#pragma unroll
            for (int i = 0; i < 16; ++i) z[i] += y[i] * g1;
            o[t] = z;
        }
        WG_BAR();
#pragma unroll
        for (int t = 0; t < 2; ++t)
#pragma unroll
            for (int i = 0; i < 16; ++i) *(LAS bf16*)(L + RC_QI + (ib * 32 + crow(i, h2)) * PR + ((2 * eq + t) * 32 + r) * 2) = cvt1(o[t][i]);
        WG_BAR();
        {   const int nx = (it + F.G < 1024) ? it + F.G : it; const int bh2 = nx >> 5, n2 = nx & 31;
            tile_ld<128, 128>(qR, P + HM(E_RQ, 4, 128, bh2 >> 2, bh2 & 3) + n2 * 128 * 128, 128, tidl); tile_ld<128, 128>(kR, P + HM(E_RK, 4, 128, bh2 >> 2, bh2 & 3) + n2 * 128 * 128, 128, tidl); }
        {
            const int tid2 = lndv(tidl), row = tid2 >> 2, qtr = tid2 & 3;
            lcp orow = L + RC_QI + row * PR + qtr * 64;
            v4u w[4]; float sum = 0.f;
#pragma unroll
            for (int c = 0; c < 4; ++c) { w[c] = *(const LAS v4u*)(orow + c * 16);
#pragma unroll
                for (int i = 0; i < 4; ++i) sum += bflo(w[c][i]) + bfhi(w[c][i]); }
            sum += xsw<1>(sum); sum += xsw<2>(sum);
            const float mu = sum * (1.0f / 128.0f); float sq = 0.f;
#pragma unroll
            for (int c = 0; c < 4; ++c)
#pragma unroll
                for (int i = 0; i < 4; ++i) { const float d0 = bflo(w[c][i]) - mu, d1 = bfhi(w[c][i]) - mu; sq += d0 * d0 + d1 * d1; }
            sq += xsw<1>(sq); sq += xsw<2>(sq);
            float eps_ = EPS; asm volatile("" : "+v"(eps_)); const float rstd = 1.0f / sqrtf(sq * (1.0f / 128.0f) + eps_);
            const bf16* gp = P + HM(E_RG, 4, 128, b, h) + (size_t)(n * 128 + row) * 128 + qtr * 32;
            bf16* op = CAT + ((size_t)b * SEQ + n * 128 + row) * D + h * 128 + qtr * 32;
#pragma unroll
            for (int c = 0; c < 4; ++c) { const v4u gw = *(const GAS v4u*)(gp + c * 8); v4u ow;
#pragma unroll
                for (int i = 0; i < 4; ++i) { const float g0 = bflo(gw[i]), g1 = bfhi(gw[i]);
                    ow[i] = cvtpk((bflo(w[c][i]) - mu) * rstd * silu_f(g0), (bfhi(w[c][i]) - mu) * rstd * silu_f(g1)); }
                *(GAS v4u*)(op + c * 8) = ow; }
        }
        WG_BAR();
    }
}
struct DilTile { int b, head, p, dil, res, q0; };
template <bool FUSE> __device__ __forceinline__ DilTile dil_decode(int T) { DilTile t;
    if (FUSE) { t.b = T >> 7; t.head = T & 7; t.p = 0; t.dil = 1; t.res = 0; t.q0 = ((T >> 3) & 15) * 256; }
    else { t.b = T >> 8; t.head = (T >> 5) & 7; const int t32 = T & 31, hi = t32 >> 3, lo = t32 & 3;
        t.p = 1 + (((t32 >> 2) ^ t.b) & 1);
        if (t.p == 1) { t.dil = 4; t.res = lo; t.q0 = ((hi + (t.b >> 1)) & 3) * 256; }
        else { t.dil = 16; t.res = hi * 4 + lo; t.q0 = 0; } }
    return t; }
__device__ __forceinline__ void dil_ld(v4u (&kR)[6], v4u (&vR)[6], const DilTile& t, const bf16* P, int tid) {
    const bf16* Kb = P + HM(E_DK, 8, 64, t.b, t.head) + (tid & 7) * 8; const bf16* Vb = P + HM(E_DV, 8, 64, t.b, t.head) + (tid & 7) * 8;
#pragma unroll
    for (int i = 0; i < 6; ++i) { int kidx = t.q0 - 128 + (tid >> 3) + 64 * i; kidx = kidx < 0 ? 0 : kidx;
        const size_t ro = (size_t)(kidx * t.dil + t.res) * 64; kR[i] = *(const GAS v4u*)(Kb + ro); vR[i] = *(const GAS v4u*)(Vb + ro); }
}
template <bool FUSE> __device__ __forceinline__ void dil_tiles(const Frame& F, int T0, int T1, int step, const bf16* P, bf16* OD, float* LSE, bf16* CAT) {
    LAS unsigned char* L = F.lds;
    const int wave = F.wave;
    if (T0 >= T1) return;
    v4u kR[6], vR[6];
    { const DilTile t0 = dil_decode<FUSE>(T0); dil_ld(kR, vR, t0, P, F.tid); }
    for (int T = T0; T < T1; T += step) {
        const int tidl = lndv(F.tid), lane = tidl & 63, r = lane & 31, h2 = lane >> 5;
        const DilTile t = dil_decode<FUSE>(T);
#pragma unroll
        for (int i = 0; i < 6; ++i) { const int row = (tidl >> 3) + 64 * i, cc = tidl & 7; *(LAS v4u*)(L + DL_KI + row * DPK + cc * 16) = kR[i]; *(LAS v4u*)(L + DL_VI + row * DPV + cc * 16) = vR[i]; }
        bf16x8 qf[4];
        { const bf16* qsrc = P + HM(E_DQ, 8, 64, t.b, t.head) + (size_t)((t.q0 + 32 * wave + r) * t.dil + t.res) * 64 + 8 * h2;
#pragma unroll
          for (int ks = 0; ks < 4; ++ks) qf[ks] = *(const GAS bf16x8*)(qsrc + 16 * ks); }
        WG_BAR();
        { const DilTile tn = dil_decode<FUSE>(T + step < T1 ? T + step : T); dil_ld(kR, vR, tn, P, tidl); }
        f32x16 x[5];
        float ninf = -INFINITY; asm volatile("" : "+v"(ninf));
        float mx = ninf;
        bf16x8 kf[2][4];
#pragma unroll
        for (int ks = 0; ks < 4; ++ks) kf[0][ks] = ld_row(L + DL_KI, DPK, 32 * wave, 16 * ks, r, h2);
#pragma unroll
        for (int kb = 0; kb < 5; ++kb) {
            if (kb < 4) {
#pragma unroll
                for (int ks = 0; ks < 4; ++ks) kf[(kb + 1) & 1][ks] = ld_row(L + DL_KI, DPK, 32 * wave + 32 * (kb + 1), 16 * ks, r, h2); }
            f32x16 a = {0.f, 0.f, 0.f, 0.f, 0.f, 0.f, 0.f, 0.f, 0.f, 0.f, 0.f, 0.f, 0.f, 0.f, 0.f, 0.f};
#pragma unroll
            for (int ks = 0; ks < 4; ++ks) a = MFMA32(kf[kb & 1][ks], qf[ks], a);
            if (kb == 0) {
#pragma unroll
                for (int i = 0; i < 16; ++i) if (crow(i, h2) < r) a[i] = ninf; }
            if (kb == 4) {
#pragma unroll
                for (int i = 0; i < 16; ++i) if (crow(i, h2) > r) a[i] = ninf; }
            if (t.q0 == 0 && 32 * wave + 32 * kb < 128) {
#pragma unroll
                for (int i = 0; i < 16; ++i) a[i] = ninf; }
#pragma unroll
            for (int i = 0; i < 16; ++i) mx = fmaxf(mx, a[i]);
            x[kb] = a;
        }
        mx = max32(mx);
        constexpr float C2 = 0.125f * LOG2E;
        const float mc = mx * C2; float l = 0.f;
#pragma unroll
        for (int kb = 0; kb < 5; ++kb)
#pragma unroll
            for (int i = 0; i < 16; ++i) { const float pe = __builtin_amdgcn_exp2f(x[kb][i] * C2 - mc); x[kb][i] = pe; l += pe; }
        l = sum32(l);
        f32x16 o[2];
#pragma unroll
        for (int dbk = 0; dbk < 2; ++dbk) o[dbk] = (f32x16){0.f, 0.f, 0.f, 0.f, 0.f, 0.f, 0.f, 0.f, 0.f, 0.f, 0.f, 0.f, 0.f, 0.f, 0.f, 0.f};
        bf16x8 vf[2][2];
#pragma unroll
        for (int dbk = 0; dbk < 2; ++dbk) vf[0][dbk] = ld_tr_perm(L + DL_VI, DPV, 32 * wave, dbk * 32, lane);
#pragma unroll
        for (int idx = 0; idx < 10; ++idx) { const int kb = idx >> 1, s = idx & 1;
            if (idx < 9) {
#pragma unroll
                for (int dbk = 0; dbk < 2; ++dbk) vf[(idx + 1) & 1][dbk] = ld_tr_perm(L + DL_VI, DPV, 32 * wave + 16 * (idx + 1), dbk * 32, lane); }
            const bf16x8 pa = PACK_STEP(x[kb], s);
#pragma unroll
            for (int dbk = 0; dbk < 2; ++dbk) o[dbk] = MFMA32(pa, vf[idx & 1][dbk], o[dbk]); }
        LAS float* lw = (LAS float*)(L + DL_LW + wave * 256);
        const float lse = mx * 0.125f + LN2 * __builtin_amdgcn_logf(l);
        if (h2 == 0) { lw[r] = l; lw[32 + r] = lse; }
        WG_BAR();
        LAS unsigned char* st = L + DL_ST + wave * 32 * DPK;
#pragma unroll
        for (int i = 0; i < 16; ++i) { const float rl = __builtin_amdgcn_rcpf(lw[crow(i, h2)]);
#pragma unroll
            for (int dbk = 0; dbk < 2; ++dbk) *(LAS bf16*)(st + crow(i, h2) * DPK + (dbk * 32 + r) * 2) = cvt1(o[dbk][i] * rl); }
        const size_t tokbase = (size_t)t.b * SEQ;
        if (!FUSE) {
            bf16* odp = OD + (size_t)t.p * M * 512;
#pragma unroll
            for (int j = 0; j < 4; ++j) { const int c = lane + 64 * j, row = c >> 3, cc = c & 7; const size_t tok = tokbase + (size_t)(t.q0 + 32 * wave + row) * t.dil + t.res;
                *(GAS v4u*)(odp + tok * 512 + t.head * 64 + cc * 8) = *(const LAS v4u*)(st + row * DPK + cc * 16); }
            if (h2 == 0) { const size_t tok = tokbase + (size_t)(t.q0 + 32 * wave + r) * t.dil + t.res; LSE[((size_t)t.p * M + tok) * 8 + t.head] = lse; }
        } else {
#pragma unroll
            for (int j = 0; j < 4; ++j) { const int c = lane + 64 * j, row = c >> 3, cc = c & 7; const size_t tok = tokbase + (size_t)(t.q0 + 32 * wave + row);
                const float l0 = lw[32 + row], l1 = ((const GAS float*)LSE)[((size_t)M + tok) * 8 + t.head], l2 = ((const GAS float*)LSE)[((size_t)2 * M + tok) * 8 + t.head];
                const v4u a = *(const LAS v4u*)(st + row * DPK + cc * 16), bq = *(const GAS v4u*)(OD + ((size_t)M + tok) * 512 + t.head * 64 + cc * 8), cq = *(const GAS v4u*)(OD + ((size_t)2 * M + tok) * 512 + t.head * 64 + cc * 8);
                const float mxl = fmaxf(l0, fmaxf(l1, l2));
                float w0 = __builtin_amdgcn_exp2f((l0 - mxl) * LOG2E), w1 = __builtin_amdgcn_exp2f((l1 - mxl) * LOG2E), w2 = __builtin_amdgcn_exp2f((l2 - mxl) * LOG2E);
                const float rs = __builtin_amdgcn_rcpf(w0 + w1 + w2); w0 *= rs; w1 *= rs; w2 *= rs;
                v4u ov;
#pragma unroll
                for (int i = 0; i < 4; ++i) ov[i] = cvtpk(w0 * bflo(a[i]) + w1 * bflo(bq[i]) + w2 * bflo(cq[i]), w0 * bfhi(a[i]) + w1 * bfhi(bq[i]) + w2 * bfhi(cq[i]));
                *(GAS v4u*)(CAT + tok * D + 512 + t.head * 64 + cc * 8) = ov; }
        }
        WG_BAR();
    }
}
constexpr int DIL_TILES12 = 2048, DIL_TILES0 = 1024;
__device__ __forceinline__ void even_phase_a(const Frame& F0) {
    const Frame F = relaunder(F0);
    unsigned char* ws = WSP();
    const bf16* P = (const bf16*)(ws + WS_ACT); bf16* RKV = (bf16*)OUTP(); bf16* OD = (bf16*)(ws + WS_OD); float* LSE = (float*)((unsigned char*)OUTP() + OUT_LSE);
    ret_phase_a_items(F, P, RKV);
    dil_tiles<false>(F, F.bid, DIL_TILES12, F.G, P, OD, LSE, nullptr);
}
__device__ __forceinline__ void even_phase_b(const Frame& F0) {
    const Frame F = relaunder(F0);
    unsigned char* ws = WSP();
    const bf16* P = (const bf16*)(ws + WS_ACT); bf16* RKV = (bf16*)OUTP(); bf16* OD = (bf16*)(ws + WS_OD); float* LSE = (float*)((unsigned char*)OUTP() + OUT_LSE);
    ret_scan(F, RKV);
    dil_tiles<true>(F, F.bid, DIL_TILES0, F.G, P, OD, LSE, (bf16*)(ws + WS_CAT));
}
__device__ __forceinline__ void even_phase_c(const Frame& F0) {
    const Frame F = relaunder(F0);
    unsigned char* ws = WSP();
    const bf16* P = (const bf16*)(ws + WS_ACT); const bf16* RKV = (const bf16*)OUTP(); const bf16* OD = (const bf16*)(ws + WS_OD); const float* LSE = (const float*)((unsigned char*)OUTP() + OUT_LSE); bf16* CAT = (bf16*)(ws + WS_CAT);
    ret_phase_c_items(F, P, RKV, CAT);
}

static_assert(WS_X8 == WS_OD, "the e4m3 residual copy overlays the dilated-output buffer");
__global__ void __launch_bounds__(NTHREADS, 2) fwd_kernel(Args args) {
    extern __shared__ __attribute__((aligned(16))) unsigned char lds[];
    Frame F;
    F.lds = (LAS unsigned char*)lds;
    F.wave = __builtin_amdgcn_readfirstlane((int)(threadIdx.x >> 6)); F.lane = hw_lane(); F.tid = F.wave * 64 + F.lane; F.G = gridDim.x; F.bid = blockIdx.x;
    for (int u = F.tid; u < (LDS_BYTES - LDSCTL_OFF) / 4; u += NTHREADS) ((LAS unsigned*)(F.lds + LDSCTL_OFF))[u] = 0u;
    __syncthreads();
    if (F.tid < N_PTRS) { const unsigned long long v = (F.tid < 17) ? (unsigned long long)args.in[F.tid] : (F.tid == 17 ? (unsigned long long)args.out : (unsigned long long)args.ws);
        ((LAS unsigned*)(F.lds + PTR_OFF))[2 * F.tid] = (unsigned)v; ((LAS unsigned*)(F.lds + PTR_OFF))[2 * F.tid + 1] = (unsigned)(v >> 32); }
    __syncthreads();
    (void)xcd_barrier_post((unsigned*)(WSP() + WS_CTL) + CW_BAR, (volatile LAS unsigned*)(F.lds + MISC_OFF) + 8, F.tid);
#define GRID_BAR() do { XcdBarrier bar_; bar_.bar = (unsigned*)(WSP() + WS_CTL) + CW_BAR; bar_.x = (unsigned)__builtin_amdgcn_readfirstlane((int)xb_xcc_id()); \
        int mo_ = MISC_OFF + 32; asm volatile("" : "+s"(mo_)); bar_.st = (volatile LAS unsigned*)(F.lds + mo_); int t_ = F.wave * 64 + hw_lane_v(); xcd_barrier<0>(bar_, t_); } while (0)
#ifndef XCD_BAR_MODE
#define XCD_BAR_MODE 2
#endif
#ifdef NO_XCD_LOCAL
#define XCD_BAR() GRID_BAR()
#else
#define XCD_BAR() do { XcdBarrier bar_; bar_.bar = (unsigned*)(WSP() + WS_CTL) + CW_BAR; bar_.x = (unsigned)__builtin_amdgcn_readfirstlane((int)xb_xcc_id()); \
        int mo_ = MISC_OFF + 32; asm volatile("" : "+s"(mo_)); bar_.st = (volatile LAS unsigned*)(F.lds + mo_); int t_ = F.wave * 64 + hw_lane_v(); xcd_barrier<XCD_BAR_MODE>(bar_, t_); } while (0)
#endif
#define XB ((bf16*)(WSP() + WS_XB))
#define ACT ((bf16*)(WSP() + WS_ACT))
#define CAT ((bf16*)(WSP() + WS_CAT))
#define SSP ((float*)(WSP() + WS_SSP))
#define WPTR(off) ((const bf16*)(WSP() + (off)))

    float pro_s0; const float pro_s1 = i8_scales(F, pro_s0);
    prologue_rows(F);
    convert_weights(F, 0, 0, pro_s0, pro_s1);
    GRID_BAR();
    for (int s = 0; s < 8; ++s) {
        const int l = s >> 1; const bool post = (s & 1) != 0;
        if (I8ASLOT(s)) { quant_rows(F, lnd(s)); XCD_BAR(); }
        {
            pg8::Gemm g{XB, WPTR(post ? W_GU1 : W_GU0), M, 2 * FF, D}; pg8::StaticOrder S; S.init(M, 2 * FF, lnd(F.G), lnd(F.bid));
            pg8::EpiSwiGLU E{ACT, FF, SSP, 1.0f};
            if (I8ASLOT(s)) {
                pg8::Gemm g8{(const bf16*)XB8, WPTR(post ? W_GU1 : W_GU0), M, 2 * FF, D};
                if (F8SLOT(s)) { pg8::EpiSwiGLU8I E8{ACT, FF, SSP, 1.0f}; pg8::gemm_phase<pg8::EpiSwiGLU8I, pg8::StaticOrder, true, true, false, true>(F.lds + RING_OFF, g8, S, E8, lnd(F.wave)); }
                else { pg8::EpiSwiGLUI EI{ACT, FF, SSP, 1.0f}; pg8::gemm_phase<pg8::EpiSwiGLUI, pg8::StaticOrder, true, true, false, true>(F.lds + RING_OFF, g8, S, EI, lnd(F.wave)); } }
            else if (F8ASLOT(s)) { pg8::Gemm g8{(const bf16*)XB8, WPTR(post ? W_GU1 : W_GU0), M, 2 * FF, D}; pg8::EpiSwiGLU8 E8{ACT, FF, SSP, 1.0f / (pg8::F8_XSCALE * pg8::F8_GUSCALE)};
                pg8::gemm_phase<pg8::EpiSwiGLU8, pg8::StaticOrder, true, true, true>(F.lds + RING_OFF, g8, S, E8, lnd(F.wave)); }
            else if (F8SLOT(s)) { pg8::EpiSwiGLU8 E8{ACT, FF, SSP, 1.0f}; pg8::gemm_phase<pg8::EpiSwiGLU8, pg8::StaticOrder, true, true>(F.lds + RING_OFF, g, S, E8, lnd(F.wave)); }
            else pg8::gemm_phase<pg8::EpiSwiGLU, pg8::StaticOrder, true, true>(F.lds + RING_OFF, g, S, E, lnd(F.wave));
            XCD_BAR();
        }
        {
            const bool do_conv = post ? (l + 1 < DEPTH) : (l >= 1); const int conv_l = post ? l + 1 : l, conv_part = post ? 1 : 2; const int grp = (lnd(F.bid) >> 3) & 1;
            for (int pass = 0; pass < 3; ++pass) {
                if (pass == 1) {
                    pg8::Gemm g{ACT, WPTR(post ? W_D1 : W_D0), M, D, FF}; pg8::RevOrder S; S.init(M, D, lnd(F.G), lnd(F.bid));
                    if (F8SLOT(s)) { pg8::EpiResid E{XB, SSP, 0.5f / (pg8::F8_HSCALE * pg8::F8_WSCALE), (post && F8ASLOT(s + 1)) ? XB8_D : 0}; pg8::gemm_phase<pg8::EpiResid, pg8::RevOrder, true, true, true>(F.lds + RING_OFF, g, S, E, lnd(F.wave)); }
                    else { pg8::EpiResid E{XB, SSP, 0.5f, (post && F8ASLOT(s + 1)) ? XB8_D : 0};
                    pg8::gemm_phase<pg8::EpiResid, pg8::RevOrder, true, true>(F.lds + RING_OFF, g, S, E, lnd(F.wave)); }
                } else if (do_conv && ((pass == 0) == (grp == 1))) {
                    convert_weights(F, conv_l, conv_part);
                    __syncthreads();
                }
            }
            GRID_BAR();
        }
        if (!post) {
            const bool odd = (l & 1) != 0; const int nin = odd ? 3072 : EVEN_IN;
            {
                pg8::Gemm g{XB, WPTR(W_IN), M, nin, D}; pg8::StaticOrder S; S.init(M, nin, lnd(F.G), lnd(F.bid));
                pg8::EpiInProj E{ACT, nin, SSP, (const float*)(WSP() + TAB_RC), (const float*)(WSP() + TAB_RS), (const float*)(WSP() + TAB_DC), (const float*)(WSP() + TAB_DS), odd ? 0 : 1};
                pg8::gemm_phase<pg8::EpiInProj, pg8::StaticOrder, true, true>(F.lds + RING_OFF, g, S, E, lnd(F.wave));
            }
            if (odd) gla_alow(F);
            GRID_BAR();
            if (!odd) { even_phase_a(F); GRID_BAR(); even_phase_b(F); GRID_BAR(); even_phase_c(F); }
            else { gla_phase_a(F, l >> 1); GRID_BAR(); gla_phase_b(F); GRID_BAR(); gla_phase_c(F, l >> 1); }
            GRID_BAR();
            {
                pg8::Gemm g{CAT, WPTR(W_OUT), M, D, D}; pg8::StaticOrder S; S.init(M, D, lnd(F.G), lnd(F.bid));
                pg8::EpiResid E{XB, SSP, 1.0f, F8ASLOT(s + 1) ? XB8_D : 0};
                pg8::gemm_phase<pg8::EpiResid, pg8::StaticOrder, true, true>(F.lds + RING_OFF, g, S, E, lnd(F.wave));
                XCD_BAR();
            }
        }
    }
    final_norm(F);
}

extern "C" void kernel_launch(void* const* d_in, const int* in_sizes, int n_in, void* d_out, int out_size, void* d_ws, size_t ws_size, hipStream_t stream) {
    static int grid = 0;
    if (grid == 0) {
        if (n_in != 17 || in_sizes[0] != M * D || out_size != M * D || ws_size < WS_END2) { fprintf(stderr, "kernel_launch: unexpected shapes (n_in %d, in0 %d, out %d, ws %zu)\n", n_in, n_in > 0 ? in_sizes[0] : -1, out_size, ws_size); grid = -1; return; }
        int dev = 0, cus = 0, per_cu = 0;
        if (hipGetDevice(&dev) != hipSuccess || hipDeviceGetAttribute(&cus, hipDeviceAttributeMultiprocessorCount, dev) != hipSuccess) { grid = -1; return; }
        if (hipFuncSetAttribute((const void*)fwd_kernel, hipFuncAttributeMaxDynamicSharedMemorySize, LDS_BYTES) != hipSuccess) { fprintf(stderr, "kernel_launch: hipFuncSetAttribute failed\n"); grid = -1; return; }
        if (hipOccupancyMaxActiveBlocksPerMultiprocessor(&per_cu, (const void*)fwd_kernel, NTHREADS, LDS_BYTES) != hipSuccess || per_cu < 1) { fprintf(stderr, "kernel_launch: occupancy query reports %d\n", per_cu); }
        (void)hipGetLastError();
        grid = cus;
        if (grid != 256) fprintf(stderr, "kernel_launch: %d CUs (expected 256)\n", grid);
    }
    if (grid < 0) return;
    if (hipMemsetAsync((char*)d_ws + WS_CTL, 0, CTL_ZERO_BYTES, stream) != hipSuccess) return;
    Args a{};
    for (int i = 0; i < 17; ++i) a.in[i] = (const float*)d_in[i];
    a.out = (float*)d_out; a.ws = (unsigned char*)d_ws;
    hipLaunchKernelGGL(fwd_kernel, dim3(grid), dim3(NTHREADS), LDS_BYTES, stream, a);
}
```

```cpp
#include <hip/hip_runtime.h>
#include <cstdio>
#include <cstdint>
#include <cmath>
template <int K> __device__ __forceinline__ float xsw(float v) { static_assert(K == 1 || K == 2 || K == 4 || K == 8 || K == 16, "xor mask inside a 32-lane half");
    return __builtin_bit_cast(float, __builtin_amdgcn_ds_swizzle(__builtin_bit_cast(int, v), 0x1F | (K << 10))); }
__device__ __forceinline__ float sum32(float v) { const unsigned u = __builtin_bit_cast(unsigned, v); auto rr = __builtin_amdgcn_permlane32_swap(u, u, false, false); return __builtin_bit_cast(float, (unsigned)rr[0]) + __builtin_bit_cast(float, (unsigned)rr[1]); }
__device__ __forceinline__ float max32(float v) { const unsigned u = __builtin_bit_cast(unsigned, v); auto rr = __builtin_amdgcn_permlane32_swap(u, u, false, false); return fmaxf(__builtin_bit_cast(float, (unsigned)rr[0]), __builtin_bit_cast(float, (unsigned)rr[1])); }
__device__ __forceinline__ float oth32(float v, int h) { const unsigned u = __builtin_bit_cast(unsigned, v); auto rr = __builtin_amdgcn_permlane32_swap(u, u, false, false); return __builtin_bit_cast(float, (unsigned)(h ? rr[0] : rr[1])); }
#ifndef PG8_WGM
#define PG8_WGM 8
#endif
namespace pg8 {
#define PG8_LAS __attribute__((address_space(3)))
typedef unsigned short bf16_t;
typedef short bf16x8 __attribute__((ext_vector_type(8)));
typedef float f32x4 __attribute__((ext_vector_type(4)));
typedef unsigned u32x4 __attribute__((ext_vector_type(4)));
constexpr int BM = 256, BK = 64, HALF = 128, HTB = HALF * BK * 2  , STAGE_BYTES = 8 * HTB, NXCD = 8, WGM = PG8_WGM;

__host__ __device__ __forceinline__ int lds_byte(int r, int c) { const int st = (r >> 4) * 2 + (c >> 5), rr = r & 15, cc = c & 31, ob = rr * 64 + cc * 2; return st * 1024 + (ob ^ (((ob >> 9) & 1) << 5)); }
__host__ __device__ __forceinline__ void stage_rc(int b, int& R, int& C) { const int st = b / 1024, sb = b % 1024, swz = sb ^ (((sb >> 9) & 1) << 5); R = (st >> 1) * 16 + swz / 64; C = (st & 1) * 32 + (swz % 64) / 2; }
__host__ __device__ __forceinline__ int perm32(int rho) { const int n = rho >> 4, i = rho & 15; return 8 * (i >> 2) + 4 * n + (i & 3); }

struct Unit { int pm, pn; };
struct Gemm { const bf16_t* A; const bf16_t* Bt; int M, N, K; };

struct StaticOrder {
    int nM, nN, nwg, G, c;
    __host__ __device__ void init(int M, int N, int G_, int c_) { nM = M / BM; nN = N / BM; nwg = nM * nN; G = G_; c = c_; }
    __host__ __device__ bool next(int i, Unit& u) const {
        const long L = (long)i * G + c; if (L >= nwg) return false;
        int wgid = (int)L; { const int q = nwg / NXCD, r = nwg % NXCD, xcd = wgid % NXCD, off = wgid / NXCD; wgid = (xcd < r ? xcd * (q + 1) : r * (q + 1) + (xcd - r) * q) + off; }
        const int nig = WGM * nN, gid = wgid / nig, fm = gid * WGM, gsz = (nM - fm) < WGM ? (nM - fm) : WGM;
        u.pm = fm + ((wgid % nig) % gsz); u.pn = (wgid % nig) / gsz; return true;
    }
    __device__ __forceinline__ void a_ready(const Unit&) const {}
    __device__ __forceinline__ void done(const Unit&) const {}
};
struct RevOrder : StaticOrder {
    __host__ __device__ bool next(int i, Unit& u) const { const int rounds = nwg / G; if (i >= rounds) return false; return StaticOrder::next(rounds - 1 - i, u); }
};

__device__ __forceinline__ unsigned cvt_pk_bf16(float lo, float hi) { unsigned r; asm volatile("v_cvt_pk_bf16_f32 %0, %1, %2" : "=v"(r) : "v"(lo), "v"(hi)); return r; }
constexpr int MROWS = 32768;
constexpr float RMS_EPS = 1e-6f;
__device__ __forceinline__ float c1024_() { float c = 1.0f / 1024.0f; asm volatile("" : "+v"(c)); return c; }
__device__ __forceinline__ void row_rstd(float (&rs)[2][4], const float* ssp, const Unit& u, int wr, int fr, int fq) {
#pragma unroll
    for (int ai = 0; ai < 2; ++ai)
#pragma unroll
        for (int m = 0; m < 4; ++m) {
            const int row = u.pm * BM + ai * HALF + wr * 64 + m * 16 + fr;
            const f32x4 p = *(const f32x4*)(ssp + (size_t)row * 16 + 4 * fq);
            float s = (p[0] + p[1]) + (p[2] + p[3]);
            s += xsw<16>(s); s = sum32(s);
            rs[ai][m] = __builtin_amdgcn_rsqf(s * c1024_() + RMS_EPS);
        }
}
struct RowPre { PG8_LAS unsigned char* tab; Unit nxt; bool has_next; int ui; };
__device__ __forceinline__ void rowpre_get(float (&rs)[2][4], const float* ssp, const Unit& u, const RowPre& rp, int wr, int fr, int fq) {
    const PG8_LAS float* t = (const PG8_LAS float*)rp.tab + (rp.ui & 1) * 128 + fr;
#pragma unroll
    for (int ai = 0; ai < 2; ++ai)
#pragma unroll
        for (int m = 0; m < 4; ++m) rs[ai][m] = t[(ai * 4 + m) * 16];
}
__device__ __forceinline__ void rowpre_issue(f32x4 (&p)[2][4], const float* ssp, const RowPre& rp, int wr, int fr, int fq) {
#pragma unroll
    for (int ai = 0; ai < 2; ++ai)
#pragma unroll
        for (int m = 0; m < 4; ++m) p[ai][m] = *(const f32x4*)(ssp + (size_t)(rp.nxt.pm * BM + ai * HALF + wr * 64 + m * 16 + fr) * 16 + 4 * fq);
}
__device__ __forceinline__ void rowpre_park(const f32x4 (&p)[2][4], const RowPre& rp, int fr, int fq) {
    PG8_LAS float* t = (PG8_LAS float*)rp.tab + ((rp.ui + 1) & 1) * 128 + fr;
#pragma unroll
    for (int ai = 0; ai < 2; ++ai)
#pragma unroll
        for (int m = 0; m < 4; ++m) { float s = (p[ai][m][0] + p[ai][m][1]) + (p[ai][m][2] + p[ai][m][3]); s += xsw<16>(s); s = sum32(s);
            if (fq == 0) t[(ai * 4 + m) * 16] = __builtin_amdgcn_rsqf(s * c1024_() + RMS_EPS); }
}
__device__ __forceinline__ void rowpre_prime_issue(f32x4 (&p)[2][4], const float* ssp, const Unit& u, int wr, int fr, int fq) {
#pragma unroll
    for (int ai = 0; ai < 2; ++ai)
#pragma unroll
        for (int m = 0; m < 4; ++m) p[ai][m] = *(const f32x4*)(ssp + (size_t)(u.pm * BM + ai * HALF + wr * 64 + m * 16 + fr) * 16 + 4 * fq);
}
__device__ __forceinline__ void rowpre_prime_park(const f32x4 (&p)[2][4], PG8_LAS unsigned char* tab, int fr, int fq) {
    PG8_LAS float* t = (PG8_LAS float*)tab + fr;
#pragma unroll
    for (int ai = 0; ai < 2; ++ai)
#pragma unroll
        for (int m = 0; m < 4; ++m) { float s = (p[ai][m][0] + p[ai][m][1]) + (p[ai][m][2] + p[ai][m][3]); s += xsw<16>(s); s = sum32(s);
            if (fq == 0) t[(ai * 4 + m) * 16] = __builtin_amdgcn_rsqf(s * c1024_() + RMS_EPS); }
}
__device__ __forceinline__ float silu_f(float g) { return g * __builtin_amdgcn_rcpf(1.0f + __builtin_amdgcn_exp2f(-1.4426950408889634f * g)); }

constexpr float F8_XSCALE = 8.0f, F8_GUSCALE = 16.0f;
constexpr float F8_HSCALE = 4.0f, F8_WSCALE = 32.0f;
template <bool OUT8, bool ACCI = false> struct EpiSwiGLUT {
    static constexpr bool PERM = true, AFTER_DRAIN = false, NEEDS_RSTD = true;
    bf16_t* H; int ldh; const float* ssp; float ascale;
    __device__ __forceinline__ void operator()(const f32x4 (&acc)[2][2][4][2], const Unit& u, int wr, int wc, int fr, int fq, const RowPre& rp) const {
        float rs[2][4]; rowpre_get(rs, ssp, u, rp, wr, fr, fq);
        f32x4 pre[2][4]; rowpre_issue(pre, ssp, rp, wr, fr, fq);
        const int col0 = u.pn * HALF + wc * 32 + 8 * fq;
#pragma unroll
        for (int ai = 0; ai < 2; ++ai)
#pragma unroll
            for (int m = 0; m < 4; ++m) {
                const int row = u.pm * BM + ai * HALF + wr * 64 + m * 16 + fr; const float r = rs[ai][m] * ascale, rn = -1.4426950408889634f * r, rr = OUT8 ? r * r * F8_HSCALE : r * r;
                float h[8];
                typedef float f32x2 __attribute__((ext_vector_type(2)));
#pragma unroll
                for (int n = 0; n < 2; ++n)
#pragma unroll
                    for (int i = 0; i < 4; i += 2) {
                        float g0 = acc[ai][0][m][n][i], g1 = acc[ai][0][m][n][i + 1], u0 = acc[ai][1][m][n][i], u1 = acc[ai][1][m][n][i + 1];
                        if constexpr (ACCI) { g0 = (float)__builtin_bit_cast(int, g0); g1 = (float)__builtin_bit_cast(int, g1); u0 = (float)__builtin_bit_cast(int, u0); u1 = (float)__builtin_bit_cast(int, u1); }
                        const f32x2 G = {g0, g1}, U = {u0, u1};
                        const f32x2 t = G * rn; f32x2 e; e.x = __builtin_amdgcn_exp2f(t.x); e.y = __builtin_amdgcn_exp2f(t.y);
                        const f32x2 d = e + 1.0f; f32x2 sg; sg.x = __builtin_amdgcn_rcpf(d.x); sg.y = __builtin_amdgcn_rcpf(d.y);
                        const f32x2 hv = ((G * U) * rr) * sg; h[4 * n + i] = hv.x; h[4 * n + i + 1] = hv.y;
                    }
                if constexpr (OUT8) {
                    int w0 = __builtin_amdgcn_cvt_pk_fp8_f32(h[0], h[1], 0, false); w0 = __builtin_amdgcn_cvt_pk_fp8_f32(h[2], h[3], w0, true);
                    int w1 = __builtin_amdgcn_cvt_pk_fp8_f32(h[4], h[5], 0, false); w1 = __builtin_amdgcn_cvt_pk_fp8_f32(h[6], h[7], w1, true);
                    typedef int i32x2 __attribute__((ext_vector_type(2)));
                    *(i32x2*)((unsigned char*)H + (size_t)row * ldh + col0) = (i32x2){w0, w1};
                } else {
                u32x4 w; w.x = cvt_pk_bf16(h[0], h[1]); w.y = cvt_pk_bf16(h[2], h[3]); w.z = cvt_pk_bf16(h[4], h[5]); w.w = cvt_pk_bf16(h[6], h[7]);
                *(u32x4*)(H + (size_t)row * ldh + col0) = w;
                }
                asm volatile("" ::: "memory");
            }
        rowpre_park(pre, rp, fr, fq);
    }
};
typedef EpiSwiGLUT<false> EpiSwiGLU;
typedef EpiSwiGLUT<true> EpiSwiGLU8;
typedef EpiSwiGLUT<false, true> EpiSwiGLUI;
typedef EpiSwiGLUT<true, true> EpiSwiGLU8I;
struct EpiInProj {
    static constexpr bool PERM = true, AFTER_DRAIN = false, NEEDS_RSTD = true;
    bf16_t* O; int ldc; const float* ssp; const float* rc; const float* rs; const float* dc; const float* ds; int even;
    __device__ __forceinline__ void operator()(const f32x4 (&acc)[2][2][4][2], const Unit& u, int wr, int wc, int fr, int fq, const RowPre& rp) const {
        float rsd[2][4]; rowpre_get(rsd, ssp, u, rp, wr, fr, fq);
        f32x4 pre[2][4]; rowpre_issue(pre, ssp, rp, wr, fr, fq);
        const int col0 = u.pn * BM + wc * 32 + 8 * fq;
        const int kind = even ? (u.pn < 4 ? 1 : ((u.pn >= 8 && u.pn < 12) ? 2 : 0)) : 0;
        const float ksc = (kind == 1 && u.pn >= 2) ? 0.08838834764831845f : 1.0f;
        const bool rot2 = (kind == 2) && ((wc & 1) == 0) && (fq < 2);
        const int b_ = (u.pm * BM) >> 12, t0 = (u.pm * BM) & 4095;
        size_t hb[2]; int dh, d0[2];
#pragma unroll
        for (int bj = 0; bj < 2; ++bj) {
            int c0, nh, head;
            if (even) { c0 = (u.pn >> 1) * 512; if (u.pn < 8) { nh = 4; dh = 128; head = (u.pn & 1) * 2 + bj; d0[bj] = wc * 32; } else { nh = 8; dh = 64; head = (u.pn & 1) * 4 + bj * 2 + (wc >> 1); d0[bj] = (wc & 1) * 32; } }
            else if (u.pn < 4) { c0 = (u.pn >> 1) * 512; nh = 4; dh = 128; head = (u.pn & 1) * 2 + bj; d0[bj] = wc * 32; }
            else if (u.pn < 12) { c0 = u.pn < 8 ? 1024 : 2048; nh = 4; dh = 256; head = u.pn & 3; d0[bj] = bj * 128 + wc * 32; }
            else { c0 = 3072; nh = 1; dh = 256; head = 0; d0[bj] = bj * 128 + wc * 32; }
            hb[bj] = (size_t)c0 * MROWS + ((size_t)(b_ * nh + head) * 4096 + t0) * dh;
        }
        const float* tc = (kind == 1) ? rc + wc * 16 + 4 * fq : dc + 4 * (fq & 1);
        const float* ts = (kind == 1) ? rs + wc * 16 + 4 * fq : ds + 4 * (fq & 1);
        const int tstride = (kind == 1) ? 64 : 8;
        typedef float f32x2 __attribute__((ext_vector_type(2)));
        if (kind == 0) {
#pragma unroll
            for (int ai = 0; ai < 2; ++ai)
#pragma unroll
                for (int m = 0; m < 4; ++m) {
                    const int row = u.pm * BM + ai * HALF + wr * 64 + m * 16 + fr; const float r = rsd[ai][m];
#pragma unroll
                    for (int bj = 0; bj < 2; ++bj) { const f32x4 v0 = acc[ai][bj][m][0] * r, v1 = acc[ai][bj][m][1] * r;
                        u32x4 w; w.x = cvt_pk_bf16(v0[0], v0[1]); w.y = cvt_pk_bf16(v0[2], v0[3]); w.z = cvt_pk_bf16(v1[0], v1[1]); w.w = cvt_pk_bf16(v1[2], v1[3]);
                        *(u32x4*)(O + hb[bj] + (size_t)(row - u.pm * BM) * dh + d0[bj] + 8 * fq) = w; }
                    asm volatile("" ::: "memory");
                }
        } else {
#pragma unroll
            for (int ai = 0; ai < 2; ++ai)
#pragma unroll
                for (int m = 0; m < 4; ++m) {
                    const int row = u.pm * BM + ai * HALF + wr * 64 + m * 16 + fr; const float r = rsd[ai][m] * ksc;
                    f32x4 c4 = {r, r, r, r}, s4 = {0.f, 0.f, 0.f, 0.f};
                    if (kind == 1 || rot2) { const int pos = row & 4095; c4 = *(const f32x4*)(tc + (size_t)pos * tstride) * r; s4 = *(const f32x4*)(ts + (size_t)pos * tstride) * r; }
#pragma unroll
                    for (int bj = 0; bj < 2; ++bj) { const f32x4 v0 = acc[ai][bj][m][0], v1 = acc[ai][bj][m][1];
                        const f32x2 a0 = {v0[0], v0[1]}, a1 = {v0[2], v0[3]}, a2 = {v1[0], v1[1]}, a3 = {v1[2], v1[3]};
                        const f32x2 b0 = {-v0[1], v0[0]}, b1 = {-v0[3], v0[2]}, b2 = {-v1[1], v1[0]}, b3 = {-v1[3], v1[2]};
                        const f32x2 o0 = a0 * c4[0] + b0 * s4[0], o1 = a1 * c4[1] + b1 * s4[1], o2 = a2 * c4[2] + b2 * s4[2], o3 = a3 * c4[3] + b3 * s4[3];
                        u32x4 w; w.x = cvt_pk_bf16(o0.x, o0.y); w.y = cvt_pk_bf16(o1.x, o1.y); w.z = cvt_pk_bf16(o2.x, o2.y); w.w = cvt_pk_bf16(o3.x, o3.y);
                        *(u32x4*)(O + hb[bj] + (size_t)(row - u.pm * BM) * dh + d0[bj] + 8 * fq) = w; }
                    asm volatile("" ::: "memory");
                }
        }
        rowpre_park(pre, rp, fr, fq);
    }
};
struct EpiResid {
    static constexpr bool PERM = true, AFTER_DRAIN = false, NEEDS_RSTD = false;
    bf16_t* xb; float* ssp; float scale; int x8d;
    __device__ __forceinline__ void operator()(const f32x4 (&acc)[2][2][4][2], const Unit& u, int wr, int wc, int fr, int fq, const RowPre&) const {
        const int col0 = u.pn * BM + wc * 32 + 8 * fq, rowb = u.pm * BM + wr * 64 + fr;
        u32x4 old[8][2];
#pragma unroll
        for (int g = 0; g < 8; ++g) { const size_t off = (size_t)(rowb + (g >> 2) * HALF + (g & 3) * 16) * 1024 + col0; old[g][0] = *(const u32x4*)(xb + off); old[g][1] = *(const u32x4*)(xb + off + HALF); }
#pragma unroll
        for (int g = 0; g < 8; ++g) {
            const int ai = g >> 2, m = g & 3, row = rowb + ai * HALF + m * 16; float ss = 0.f;
#pragma unroll
            for (int bj = 0; bj < 2; ++bj) { const size_t off = (size_t)row * 1024 + col0 + bj * HALF; const u32x4 o = old[g][bj];
                const f32x4 a0 = acc[ai][bj][m][0] * scale, a1 = acc[ai][bj][m][1] * scale;
                const float v0 = __builtin_bit_cast(float, o.x << 16) + a0[0], v1 = __builtin_bit_cast(float, o.x & 0xffff0000u) + a0[1], v2 = __builtin_bit_cast(float, o.y << 16) + a0[2], v3 = __builtin_bit_cast(float, o.y & 0xffff0000u) + a0[3];
                const float v4 = __builtin_bit_cast(float, o.z << 16) + a1[0], v5 = __builtin_bit_cast(float, o.z & 0xffff0000u) + a1[1], v6 = __builtin_bit_cast(float, o.w << 16) + a1[2], v7 = __builtin_bit_cast(float, o.w & 0xffff0000u) + a1[3];
                u32x4 w; w.x = cvt_pk_bf16(v0, v1); w.y = cvt_pk_bf16(v2, v3); w.z = cvt_pk_bf16(v4, v5); w.w = cvt_pk_bf16(v6, v7);
                *(u32x4*)(xb + off) = w;
                if (x8d) { int y0 = __builtin_amdgcn_cvt_pk_fp8_f32(v0 * F8_XSCALE, v1 * F8_XSCALE, 0, false); y0 = __builtin_amdgcn_cvt_pk_fp8_f32(v2 * F8_XSCALE, v3 * F8_XSCALE, y0, true);
                    int y1 = __builtin_amdgcn_cvt_pk_fp8_f32(v4 * F8_XSCALE, v5 * F8_XSCALE, 0, false); y1 = __builtin_amdgcn_cvt_pk_fp8_f32(v6 * F8_XSCALE, v7 * F8_XSCALE, y1, true);
                    typedef int i32x2r __attribute__((ext_vector_type(2))); *(i32x2r*)((unsigned char*)xb + x8d + off) = (i32x2r){y0, y1}; }
                ss += (v0 * v0 + v1 * v1) + (v2 * v2 + v3 * v3) + (v4 * v4 + v5 * v5) + (v6 * v6 + v7 * v7); }
            ss += xsw<16>(ss); ss = sum32(ss);
            if (fq == 0) ssp[(size_t)row * 16 + u.pn * 4 + wc] = ss;
        }
    }
};

typedef int pg8_v8i __attribute__((ext_vector_type(8)));
typedef int pg8_v4i __attribute__((ext_vector_type(4)));
__device__ __forceinline__ pg8_v8i pg8_cat(bf16x8 lo, bf16x8 hi) { const pg8_v4i a = __builtin_bit_cast(pg8_v4i, lo), b = __builtin_bit_cast(pg8_v4i, hi); return __builtin_shufflevector(a, b, 0, 1, 2, 3, 4, 5, 6, 7); }
template <class Epi, class Sched, bool ALIGN_EPI = false, bool SP2 = false, bool F8 = false, bool I8 = false>
__device__ __forceinline__ void gemm_phase(PG8_LAS unsigned char* lds, const Gemm g, const Sched& S, const Epi& E, int wave_in) {
    int tid_; { int l_; asm volatile("v_mbcnt_lo_u32_b32 %0, -1, 0\n\tv_mbcnt_hi_u32_b32 %0, -1, %0" : "=v"(l_)); tid_ = wave_in * 64 + l_; }
    const int tid = tid_, wid = __builtin_amdgcn_readfirstlane(tid >> 6), lane = tid & 63, wr = wid >> 2, wc = wid & 3, fr = lane & 15, fq = lane >> 4;
    constexpr int ES = (F8 || I8) ? 1 : 2;
    const int K = g.K, nt = K * ES / (BK * 2);
    unsigned voffA[2], voffB[2];
#pragma unroll
    for (int i = 0; i < 2; ++i) { int R, C; stage_rc(tid * 16 + i * 8192, R, C); const int Rb = Epi::PERM ? ((R & ~31) + perm32(R & 31)) : R;
        voffA[i] = (unsigned)(R * K * ES + C * 2); voffB[i] = (unsigned)(Rb * K * ES + C * 2); }
    const size_t kstep = (size_t)(BK * 2);
    const size_t hstep = (size_t)HALF * K * ES;
    const size_t tstep = 2 * hstep;
    const unsigned ldsw = (unsigned)wid * 1024u;
    const int aoff = lds_byte(wr * 64 + fr, fq * 8), boff = lds_byte(wc * 32 + fr, fq * 8);
#define PG8_SA(b, h) (((b) * 2 + (h)) * HTB)
#define PG8_SB(b, h) ((4 + (b) * 2 + (h)) * HTB)
#define PG8_STAGE(bufoff, gbase, voff) do { _Pragma("unroll") for (int _i = 0; _i < 2; ++_i) { if constexpr (F8) { unsigned vo_ = (voff)[0]; asm volatile("" : "+v"(vo_));     \
        __builtin_amdgcn_global_load_lds((const unsigned*)((const char*)(gbase) + (size_t)_i * 64 * K * ES + vo_), (PG8_LAS unsigned*)(lds + (bufoff) + ldsw + _i * 8192), 16, 0, 0); } else \
        __builtin_amdgcn_global_load_lds((const unsigned*)((const char*)(gbase) + (voff)[_i]), (PG8_LAS unsigned*)(lds + (bufoff) + ldsw + _i * 8192), 16, 0, 0); } } while (0)
#define PG8_LDA(dst, b, h) do { _Pragma("unroll") for (int m = 0; m < 4; ++m) _Pragma("unroll") for (int k = 0; k < 2; ++k) dst[m][k] = *(const PG8_LAS bf16x8*)(lds + PG8_SA(b, h) + aoff + m * 2048 + k * 1024); } while (0)
#define PG8_LDB(dst, b, h) do { _Pragma("unroll") for (int n = 0; n < 2; ++n) _Pragma("unroll") for (int k = 0; k < 2; ++k) dst[n][k] = *(const PG8_LAS bf16x8*)(lds + PG8_SB(b, h) + boff + n * 2048 + k * 1024); } while (0)
#define PG8_MMA(ai, bj, At, Bt) do { __builtin_amdgcn_s_setprio(1); if constexpr (F8) { _Pragma("unroll") for (int m = 0; m < 4; ++m) _Pragma("unroll") for (int n = 0; n < 2; ++n) \
        acc[ai][bj][m][n] = __builtin_amdgcn_mfma_scale_f32_16x16x128_f8f6f4(pg8_cat(Bt[n][0], Bt[n][1]), pg8_cat(At[m][0], At[m][1]), acc[ai][bj][m][n], 0, 0, 0, 0, 0, 0); } \
        else if constexpr (I8) { _Pragma("unroll") for (int m = 0; m < 4; ++m) _Pragma("unroll") for (int n = 0; n < 2; ++n) _Pragma("unroll") for (int k = 0; k < 2; ++k) \
        acc[ai][bj][m][n] = __builtin_bit_cast(f32x4, __builtin_amdgcn_mfma_i32_16x16x64_i8(__builtin_bit_cast(pg8_v4i, Bt[n][k]), __builtin_bit_cast(pg8_v4i, At[m][k]), __builtin_bit_cast(pg8_v4i, acc[ai][bj][m][n]), 0, 0, 0)); } \
        else { _Pragma("unroll") for (int m = 0; m < 4; ++m) _Pragma("unroll") for (int n = 0; n < 2; ++n) _Pragma("unroll") for (int k = 0; k < 2; ++k) \
        acc[ai][bj][m][n] = __builtin_amdgcn_mfma_f32_16x16x32_bf16(Bt[n][k], At[m][k], acc[ai][bj][m][n], 0, 0, 0); } __builtin_amdgcn_s_setprio(0); } while (0)
#define PG8_WAIT_V(n) asm volatile("s_waitcnt vmcnt(" #n ")" ::: "memory")
#define PG8_WAIT_L(n) asm volatile("s_waitcnt lgkmcnt(" #n ")" ::: "memory")
#define PG8_BAR __builtin_amdgcn_s_barrier()
#define PG8_SCHED __builtin_amdgcn_sched_barrier(0)
    Unit cur, nxt; int ui = 0;
    if (!S.next(0, cur)) return;
    f32x4 acc[2][2][4][2];
#pragma unroll
    for (int a = 0; a < 2; ++a)
#pragma unroll
        for (int b = 0; b < 2; ++b)
#pragma unroll
            for (int m = 0; m < 4; ++m)
#pragma unroll
                for (int n = 0; n < 2; ++n) acc[a][b][m][n] = (f32x4){0.f, 0.f, 0.f, 0.f};
    bf16x8 At[4][2], B0[2][2], B1[2][2];
    const char* cA = (const char*)g.A + (size_t)cur.pm * tstep; const char* cB = (const char*)g.Bt + (size_t)cur.pn * tstep;
    S.a_ready(cur);
    f32x4 p0[2][4];
    if constexpr (Epi::NEEDS_RSTD) rowpre_prime_issue(p0, E.ssp, cur, wr, fr, fq);
    if constexpr (SP2) {
        PG8_STAGE(PG8_SB(0, 0), cB, voffB); PG8_STAGE(PG8_SB(0, 1), cB + hstep, voffB); PG8_STAGE(PG8_SA(0, 0), cA, voffA); PG8_STAGE(PG8_SA(0, 1), cA + hstep, voffA);
        if constexpr (Epi::NEEDS_RSTD) rowpre_prime_park(p0, lds + STAGE_BYTES + wid * 1024, fr, fq);
        if (wr == 1) PG8_BAR;
        PG8_WAIT_V(2); PG8_BAR;
        PG8_STAGE(PG8_SB(1, 0), cB + kstep, voffB); PG8_STAGE(PG8_SA(1, 0), cA + kstep, voffA); PG8_STAGE(PG8_SB(1, 1), cB + hstep + kstep, voffB);
        PG8_WAIT_V(6); PG8_BAR;
    } else {
        PG8_STAGE(PG8_SB(0, 0), cB, voffB); PG8_STAGE(PG8_SA(0, 0), cA, voffA); PG8_STAGE(PG8_SB(0, 1), cB + hstep, voffB); PG8_STAGE(PG8_SA(0, 1), cA + hstep, voffA);
        if constexpr (Epi::NEEDS_RSTD) rowpre_prime_park(p0, lds + STAGE_BYTES + wid * 1024, fr, fq);
        if (wr == 1) PG8_BAR;
        PG8_WAIT_V(4); PG8_BAR;
        PG8_STAGE(PG8_SB(1, 0), cB + kstep, voffB); PG8_STAGE(PG8_SA(1, 0), cA + kstep, voffA); PG8_STAGE(PG8_SB(1, 1), cB + hstep + kstep, voffB);
        PG8_WAIT_V(6); PG8_BAR;
    }
    for (;;) {
        const bool has_next = S.next(ui + 1, nxt);
        const char* nA = has_next ? (const char*)g.A + (size_t)nxt.pm * tstep : cA; const char* nB = has_next ? (const char*)g.Bt + (size_t)nxt.pn * tstep : cB;
        for (int t = 0; t < nt; t += 2) {
            const bool last = (t == nt - 2);
            const char* a1 = cA + (size_t)(t + 1) * kstep;
            const char* a2 = last ? nA : cA + (size_t)(t + 2) * kstep; const char* b2 = last ? nB : cB + (size_t)(t + 2) * kstep;
            const char* a3 = a2 + kstep; const char* b3 = b2 + kstep;
            if (last && has_next) S.a_ready(nxt);
            if constexpr (SP2) {
            PG8_LDB(B0, 0, 0); PG8_LDB(B1, 0, 1); PG8_SCHED; PG8_LDA(At, 0, 0); PG8_STAGE(PG8_SA(1, 1), a1 + hstep, voffA);
            PG8_WAIT_V(8); PG8_WAIT_L(0); PG8_BAR; PG8_MMA(0, 0, At, B0); PG8_MMA(0, 1, At, B1); PG8_BAR; PG8_SCHED;
            PG8_LDA(At, 0, 1); PG8_STAGE(PG8_SB(0, 0), b2, voffB); PG8_STAGE(PG8_SB(0, 1), b2 + hstep, voffB); PG8_STAGE(PG8_SA(0, 0), a2, voffA);
            PG8_WAIT_V(8); PG8_WAIT_L(0); PG8_BAR; PG8_MMA(1, 0, At, B0); PG8_MMA(1, 1, At, B1); PG8_BAR; PG8_SCHED;
            PG8_LDB(B0, 1, 0); PG8_LDB(B1, 1, 1); PG8_SCHED; PG8_LDA(At, 1, 0); PG8_STAGE(PG8_SA(0, 1), a2 + hstep, voffA);
            PG8_WAIT_V(8); PG8_WAIT_L(0); PG8_BAR; PG8_MMA(0, 0, At, B0); PG8_MMA(0, 1, At, B1); PG8_BAR; PG8_SCHED;
            PG8_LDA(At, 1, 1); PG8_STAGE(PG8_SB(1, 0), b3, voffB); PG8_STAGE(PG8_SB(1, 1), b3 + hstep, voffB); PG8_STAGE(PG8_SA(1, 0), a3, voffA);
            PG8_WAIT_V(8); PG8_WAIT_L(0); PG8_BAR; PG8_MMA(1, 0, At, B0); PG8_MMA(1, 1, At, B1); PG8_BAR; PG8_SCHED;
            } else {
            PG8_LDB(B0, 0, 0); PG8_SCHED; PG8_LDA(At, 0, 0); PG8_STAGE(PG8_SA(1, 1), a1 + hstep, voffA);
            PG8_WAIT_L(8); PG8_BAR; PG8_WAIT_L(0); PG8_MMA(0, 0, At, B0); PG8_BAR; PG8_SCHED;
            PG8_LDB(B1, 0, 1); PG8_STAGE(PG8_SB(0, 0), b2, voffB);
            PG8_BAR; PG8_WAIT_L(0); PG8_MMA(0, 1, At, B1); PG8_BAR;
            PG8_LDA(At, 0, 1); PG8_STAGE(PG8_SA(0, 0), a2, voffA);
            PG8_BAR; PG8_WAIT_L(0); PG8_MMA(1, 0, At, B0); PG8_BAR; PG8_SCHED;
            PG8_STAGE(PG8_SB(0, 1), b2 + hstep, voffB);
            PG8_WAIT_V(6); PG8_BAR; PG8_MMA(1, 1, At, B1); PG8_BAR;
            PG8_LDB(B0, 1, 0); PG8_SCHED; PG8_LDA(At, 1, 0); PG8_STAGE(PG8_SA(0, 1), a2 + hstep, voffA);
            PG8_WAIT_L(8); PG8_BAR; PG8_WAIT_L(0); PG8_MMA(0, 0, At, B0); PG8_BAR; PG8_SCHED;
            PG8_LDB(B1, 1, 1); PG8_STAGE(PG8_SB(1, 0), b3, voffB);
            PG8_BAR; PG8_WAIT_L(0); PG8_MMA(0, 1, At, B1); PG8_BAR;
            PG8_LDA(At, 1, 1); PG8_STAGE(PG8_SA(1, 0), a3, voffA);
            PG8_BAR; PG8_WAIT_L(0); PG8_MMA(1, 0, At, B0); PG8_BAR; PG8_SCHED;
            PG8_STAGE(PG8_SB(1, 1), b3 + hstep, voffB);
            PG8_WAIT_V(6); PG8_BAR; PG8_MMA(1, 1, At, B1); PG8_BAR;
            }
        }
        if constexpr (ALIGN_EPI) { if (wr == 0) PG8_BAR; }
        if constexpr (!Epi::AFTER_DRAIN) {
            if constexpr (F8) { int l2; asm volatile("v_mbcnt_lo_u32_b32 %0, -1, 0\n\tv_mbcnt_hi_u32_b32 %0, -1, %0" : "=v"(l2));
                E(acc, cur, wr, wc, l2 & 15, l2 >> 4, RowPre{lds + STAGE_BYTES + wid * 1024, has_next ? nxt : cur, has_next, ui}); }
            else E(acc, cur, wr, wc, fr, fq, RowPre{lds + STAGE_BYTES + wid * 1024, has_next ? nxt : cur, has_next, ui});
            S.done(cur); }
        if (!has_next) break;
#pragma unroll
        for (int a = 0; a < 2; ++a)
#pragma unroll
            for (int b = 0; b < 2; ++b)
#pragma unroll
                for (int m = 0; m < 4; ++m)
#pragma unroll
                    for (int n = 0; n < 2; ++n) acc[a][b][m][n] = (f32x4){0.f, 0.f, 0.f, 0.f};
        cur = nxt; cA = nA; cB = nB; ++ui;
        if constexpr (ALIGN_EPI) { if (wr == 1) PG8_BAR; }
    }
    PG8_WAIT_V(0);
    if constexpr (!ALIGN_EPI) { if (wr == 0) PG8_BAR; }
    PG8_BAR;
    if constexpr (Epi::AFTER_DRAIN) { E.fused(acc, cur, wr, wc, fr, fq, lds, wid, lane); S.done(cur); }
#undef PG8_SA
#undef PG8_SB
#undef PG8_STAGE
#undef PG8_LDA
#undef PG8_LDB
#undef PG8_MMA
#undef PG8_WAIT_V
#undef PG8_WAIT_L
#undef PG8_BAR
#undef PG8_SCHED
}
}

constexpr int NWAVES = 8, NTHREADS = NWAVES * 64;
constexpr int BATCH = 8, SEQ = 4096, D = 1024, M = BATCH * SEQ, FF = 2816, DEPTH = 4;
constexpr int EVEN_IN = 3584, GLA_IN = 3088, GLA_INP = 3328;
static_assert(M == pg8::MROWS, "row count");
constexpr int E_RQ = 0, E_RK = 512, E_RV = 1024, E_RG = 1536, E_DQ = 2048, E_DK = 2560, E_DV = 3072;
constexpr int G_Q = 0, G_K = 512, G_V = 1024, G_R = 2048, G_A = 3072;
constexpr float EPS = 1e-6f;
#define HM(c0, nh, dh, b, h) ((size_t)(c0) * M + ((size_t)((b) * (nh) + (h)) * SEQ) * (dh))

constexpr size_t MiB = 1u << 20;
constexpr size_t WS_CTL = 0, CTL_ZERO_BYTES = 32768;
constexpr size_t WS_SSP = 1 * MiB;
constexpr size_t WS_TAB = 3 * MiB;
constexpr size_t TAB_RC = WS_TAB, TAB_RS = WS_TAB + 1 * MiB, TAB_DC = WS_TAB + 2 * MiB, TAB_DS = WS_TAB + 2 * MiB + 128 * 1024;
constexpr size_t WS_W = 8 * MiB;
constexpr size_t W_GU0 = WS_W, W_D0 = W_GU0 + (size_t)2 * FF * D * 2, W_GU1 = W_D0 + (size_t)D * FF * 2, W_D1 = W_GU1 + (size_t)2 * FF * D * 2,
                 W_IN = W_D1 + (size_t)D * FF * 2, W_OUT = W_IN + (size_t)EVEN_IN * D * 2, W_END = W_OUT + (size_t)D * D * 2;
constexpr size_t WS_XB = 56 * MiB;
constexpr size_t WS_ACT = 120 * MiB;
constexpr size_t WS_CAT = 344 * MiB;
constexpr size_t WS_END = 408 * MiB;
static_assert(W_END <= WS_XB && WS_XB + (size_t)M * D * 2 <= WS_ACT && WS_ACT + (size_t)M * EVEN_IN * 2 <= WS_CAT && WS_CAT + (size_t)M * D * 2 <= WS_END, "d_ws map");
constexpr int CW_BAR = 4096;

constexpr int RING_OFF = 0, RING_BYTES = 131072;
constexpr int LDSCTL_OFF = 161792, MISC_OFF = LDSCTL_OFF + 320, PTR_OFF = LDSCTL_OFF + 1024;
constexpr int LDS_BYTES = 163840;
static_assert(PTR_OFF + 19 * 8 <= LDS_BYTES && RING_BYTES <= LDSCTL_OFF, "LDS map");

#define GAS __attribute__((address_space(1)))
#define LAS __attribute__((address_space(3)))
typedef unsigned short bf16;
typedef unsigned v4u __attribute__((ext_vector_type(4)));
typedef float f32x4 __attribute__((ext_vector_type(4)));
typedef short bf16x8 __attribute__((ext_vector_type(8)));
typedef GAS unsigned gu32;
typedef GAS unsigned long long gu64;
#define RLX_AGENT __ATOMIC_RELAXED, __HIP_MEMORY_SCOPE_AGENT
#define LDS_WAIT() asm volatile("s_waitcnt lgkmcnt(0)" ::: "memory")
#define VM_WAIT() asm volatile("s_waitcnt vmcnt(0)" ::: "memory")
__device__ __forceinline__ unsigned long long rt() { return __builtin_amdgcn_s_memrealtime(); }
__device__ __forceinline__ unsigned f2bf(float f) { unsigned u = __builtin_bit_cast(unsigned, f); return (u + 0x7fffu + ((u >> 16) & 1u)) >> 16; }
__device__ __forceinline__ unsigned pk2(float lo, float hi) { return f2bf(lo) | (f2bf(hi) << 16); }

#define XB_TMO      128
#ifndef XB_MIS_EXPECT
#define XB_MIS_EXPECT 0u
#endif
#define XB_MIS      192
#define XB_XCNT(j)  (256  + 64 * (j))
#define XB_XSUB(j)  (1280 + 64 * (j))
#define XB_XGEN(j)  (2304 + 64 * (j))
#define XB_TOP      3328
#define XB_TOPGEN   3392
#define XB_TEAM(t)  (3520 + 8 * (t))
#define XCD_BAR_WORDS 4096
#define XB_SPIN_CAP (1u << 18)

__device__ __forceinline__ unsigned xb_ld(unsigned* p)              { return __hip_atomic_load(p, __ATOMIC_RELAXED, __HIP_MEMORY_SCOPE_AGENT); }
__device__ __forceinline__ unsigned xb_add(unsigned* p, unsigned v) { return __hip_atomic_fetch_add(p, v, __ATOMIC_RELAXED, __HIP_MEMORY_SCOPE_AGENT); }
__device__ __forceinline__ unsigned xb_xcc_id() { return (unsigned)__builtin_amdgcn_s_getreg((3 << 11) | 20) & 0xFu; }
#define XB_SPIN(cond, bar) do { unsigned _sp = 0; while (cond) { __builtin_amdgcn_s_sleep(1); \
    if ((++_sp & 255u) == 0u) { if (xb_ld(&(bar)[XB_TMO])) break; if (_sp > XB_SPIN_CAP) { atomicAdd(&(bar)[XB_TMO], 1u); break; } } } } while (0)

struct XcdBarrier {
    unsigned* bar; unsigned x;
    volatile LAS unsigned* st;
};

__device__ __forceinline__ XcdBarrier xcd_barrier_post(unsigned* bar, volatile LAS unsigned* st, int tid) {
    XcdBarrier b; b.bar = bar; b.x = xb_xcc_id(); b.st = st;
    if (tid == 0) { if ((blockIdx.x & 7u) != b.x) (void)xb_add(&bar[XB_MIS], 1u); (void)xb_add(&bar[XB_XCNT(b.x)], 1u); }
    return b;
}
__device__ __forceinline__ void xcd_barrier_complete(unsigned* bar, unsigned x, unsigned& nloc, unsigned& nx) {
    const unsigned G = gridDim.x * gridDim.y * gridDim.z;
    unsigned sum, cnt, mine, sp = 0u;
    for (;;) {
        sum = 0u; cnt = 0u; mine = 0u;
#pragma unroll
        for (unsigned j = 0; j < 16; ++j) { const unsigned c = xb_ld(&bar[XB_XCNT(j)]); sum += c; cnt += (c > 0u) ? 1u : 0u; mine = (j == x) ? c : mine; }
        if (sum == G) break;
        __builtin_amdgcn_s_sleep(1);
        if ((++sp & 255u) == 0u) { if (xb_ld(&bar[XB_TMO])) break; if (sp > XB_SPIN_CAP) { atomicAdd(&bar[XB_TMO], 1u); break; } }
    }
    nloc = mine > 0u ? mine : 1u; nx = cnt > 0u ? cnt : 1u;
}

template <int LOCAL = 0>
__device__ __forceinline__ void xcd_barrier(const XcdBarrier& b, int tid) {
    asm volatile("s_waitcnt vmcnt(0)" ::: "memory");
    __syncthreads();
    if (tid == 0) {
        unsigned* bar = b.bar;
        __builtin_amdgcn_s_waitcnt(0);
        unsigned nloc = b.st[0], nx = b.st[1];
        if (nloc == 0u) { xcd_barrier_complete(bar, b.x, nloc, nx); b.st[0] = nloc; b.st[1] = nx; }
        bool skip_top = false;
        if (LOCAL) { unsigned lk = b.st[2];
            if (lk == 0u) { lk = (xb_ld(&bar[XB_MIS]) == XB_MIS_EXPECT && nx == 8u && nloc == 32u && gridDim.x == 256u) ? 1u : 2u; b.st[2] = lk; }
            skip_top = lk == 1u; }
        if (LOCAL == 2 && skip_top) {
            unsigned* c = &bar[XB_TEAM((blockIdx.x & 7u) * 8u + ((blockIdx.x >> 3) & 7u))];
            const unsigned tgt = (xb_add(c, 1u) / 4u + 1u) * 4u;
            XB_SPIN(xb_ld(c) < tgt, bar);
            __builtin_amdgcn_fence(__ATOMIC_ACQUIRE, "agent");
            asm volatile("s_waitcnt vmcnt(0)" ::: "memory");
        } else {
        const unsigned old = xb_add(&bar[XB_XSUB(b.x)], 1u);
        const unsigned gen = old / nloc;
        if (old + 1u == (gen + 1u) * nloc) {
          if (!skip_top) {
            __builtin_amdgcn_fence(__ATOMIC_RELEASE, "agent");
            asm volatile("s_waitcnt vmcnt(0)" ::: "memory");
            const unsigned og = xb_add(&bar[XB_TOP], 1u);
            const unsigned tg = og / nx;
            if (og + 1u == (tg + 1u) * nx) xb_add(&bar[XB_TOPGEN], 1u);
            else XB_SPIN(xb_ld(&bar[XB_TOPGEN]) == tg, bar);
          }
            __builtin_amdgcn_fence(__ATOMIC_ACQUIRE, "agent");
            xb_add(&bar[XB_XGEN(b.x)], 1u);
            asm volatile("s_waitcnt vmcnt(0)" ::: "memory");
        } else {
            XB_SPIN(xb_ld(&bar[XB_XGEN(b.x)]) == gen, bar);
            __builtin_amdgcn_fence(__ATOMIC_ACQUIRE, "agent");
            asm volatile("s_waitcnt vmcnt(0)" ::: "memory");
        }
        }
    }
    __syncthreads();
}

__constant__ float RET_FREQ[64] = {1.000000000e+00f, 8.639884591e-01f, 7.464760542e-01f, 6.449466944e-01f, 5.572264791e-01f, 4.814372361e-01f, 4.159561992e-01f, 3.593813777e-01f, 3.105013371e-01f, 2.682695687e-01f, 2.317818105e-01f, 2.002568096e-01f, 1.730195731e-01f, 1.494869143e-01f, 1.291549653e-01f, 1.115883961e-01f, 9.641107172e-02f, 8.329805732e-02f, 7.196855545e-02f, 6.218000501e-02f, 5.372280627e-02f, 4.641588405e-02f, 4.010278732e-02f, 3.464834765e-02f, 2.993577160e-02f, 2.586415969e-02f, 2.234633639e-02f, 1.930697635e-02f, 1.668100432e-02f, 1.441219542e-02f, 1.245197095e-02f, 1.075835899e-02f, 9.295095690e-03f, 8.030855097e-03f, 6.938565988e-03f, 5.994840991e-03f, 5.179473665e-03f, 4.475005437e-03f, 3.866352839e-03f, 3.340484342e-03f, 2.886139788e-03f, 2.493591513e-03f, 2.154434333e-03f, 1.861406374e-03f, 1.608233666e-03f, 1.389495330e-03f, 1.200507861e-03f, 1.037224894e-03f, 8.961503627e-04f, 7.742635789e-04f, 6.689548027e-04f, 5.779692437e-04f, 4.993587499e-04f, 4.314401885e-04f, 3.727593285e-04f, 3.220597573e-04f, 2.782559313e-04f, 2.404099068e-04f, 2.077113895e-04f, 1.794602431e-04f, 1.550515735e-04f, 1.339627634e-04f, 1.157422885e-04f, 9.999999747e-05f};
__constant__ float ROPE_FREQ[8] = {1.000000000e+00f, 1.939227432e-01f, 3.760603070e-02f, 7.292664610e-03f, 1.414213562e-03f, 2.742481884e-04f, 5.318295734e-05f, 1.031338525e-05f};
static_assert((CW_BAR + XCD_BAR_WORDS) * 4 <= (int)CTL_ZERO_BYTES, "the grid barrier's words are inside the per-call memset");
struct Args { const float* in[17]; float* out; unsigned char* ws; };
enum { I_X = 0, I_PRE_NORM = 1, I_PRE_WG = 2, I_PRE_WU = 3, I_PRE_WD = 4, I_MIX_NORM = 5, I_AB_IN = 6, I_AB_OUT = 7, I_GLA_IN = 8, I_GLA_A2 = 9, I_GLA_BA = 10, I_GLA_OUT = 11,
       I_POST_NORM = 12, I_POST_WG = 13, I_POST_WU = 14, I_POST_WD = 15, I_FINAL = 16, I_OUT = 17, I_WS = 18, N_PTRS = 19 };
struct Frame {
    LAS unsigned char* lds;
    int tid, lane, wave, G, bid;
};
__device__ __forceinline__ unsigned char* tabp(const Frame& F, int idx) {
    int off_ = PTR_OFF + 8 * idx; asm volatile("" : "+s"(off_));
    const volatile LAS unsigned* T = (const volatile LAS unsigned*)(F.lds + off_);
    const unsigned lo = __builtin_amdgcn_readfirstlane(T[0]), hi = __builtin_amdgcn_readfirstlane(T[1]);
    GAS unsigned char* gp_ = (GAS unsigned char*)(((unsigned long long)hi << 32) | (unsigned long long)lo);
    return (unsigned char*)gp_;
}
#define AP(idx) ((const float*)tabp(F, idx))
#define WSP() tabp(F, I_WS)
#define OUTP() ((float*)tabp(F, I_OUT))
__device__ __forceinline__ int lnd(int v) { asm volatile("" : "+s"(v)); return v; }
__device__ __forceinline__ int hw_lane() { return (int)__builtin_amdgcn_mbcnt_hi(~0u, __builtin_amdgcn_mbcnt_lo(~0u, 0u)); }
__device__ __forceinline__ int hw_lane_v() { int l; asm volatile("v_mbcnt_lo_u32_b32 %0, -1, 0\n\tv_mbcnt_hi_u32_b32 %0, -1, %0" : "=v"(l)); return l; }
__device__ __forceinline__ Frame relaunder(const Frame& F0) { Frame F = F0; int t_ = F0.wave * 64 + hw_lane_v(); asm volatile("" : "+s"(F.bid)); F.tid = t_; F.lane = F.tid & 63; F.wave = __builtin_amdgcn_readfirstlane(F.tid >> 6);
    unsigned lb_ = 0u; asm volatile("" : "+s"(lb_)); F.lds = F0.lds + lb_; return F; }
__device__ __forceinline__ float wave_sum(float v) {
    v += xsw<1>(v); v += xsw<2>(v); v += xsw<4>(v); v += xsw<8>(v); v += xsw<16>(v);
    return sum32(v);
}
__device__ __forceinline__ float bf2f(bf16 h) { return __builtin_bit_cast(float, (unsigned)h << 16); }
__device__ __forceinline__ float bflo(unsigned w) { return __builtin_bit_cast(float, w << 16); }
__device__ __forceinline__ float bfhi(unsigned w) { return __builtin_bit_cast(float, w & 0xffff0000u); }
__device__ __forceinline__ bf16 f2bf_rne(float f) { return (bf16)f2bf(f); }

#ifndef F8_MASK
#define F8_MASK 0xE0
#endif
#define F8SLOT(s_) (((F8_MASK) >> (s_)) & 1)
#ifndef F8A_MASK
#define F8A_MASK 0x00
#endif
#define F8ASLOT(s_) ((s_) < 8 && (((F8A_MASK) >> (s_)) & 1))
#ifndef I8A_MASK
#define I8A_MASK 0xFF
#endif
#define I8ASLOT(s_) ((s_) < 8 && (((I8A_MASK) >> (s_)) & 1))
#define I8CONV(s_) I8ASLOT(s_)
#ifndef I8_WCLIP
#define I8_WCLIP 3.4f
#endif
constexpr size_t WS_I8S = 2048;
#define I8SW(s_) (*(const GAS float*)(WSP() + WS_I8S + 4 * (s_)))
static_assert((I8A_MASK & F8A_MASK) == 0, "a gate|up GEMM is int8 or fp8, not both");
static_assert((F8A_MASK & ~F8_MASK) == 0, "an fp8 gate|up GEMM writes e4m3 hidden rows: its down projection must be fp8 as well");
constexpr size_t WS_X8 = 408 * MiB;
#define XB8 (WSP() + WS_X8)
constexpr int XB8_D = (int)(WS_X8 - WS_XB);
__device__ __forceinline__ void tr_item(const float* W, int K, int N, int Npad, const float* gain, bf16* WT, int gu, LAS float* scr, int item, int lane, float f8s = 0.f) {
    const int nblk = Npad / 32, kb = item / nblk, nb = item % nblk, k0 = 64 * kb, n0 = 32 * nb;
    {
        const int c4 = lane & 7; const bool ok = n0 + 4 * c4 < N;
        const GAS float* src = (const GAS float*)W + (size_t)(k0 + (lane >> 3)) * N + n0 + 4 * c4;
        f32x4 v[8];
#pragma unroll
        for (int i = 0; i < 8; ++i) v[i] = ok ? __builtin_nontemporal_load((const GAS f32x4*)(src + (size_t)(8 * i) * N)) : (f32x4){0.f, 0.f, 0.f, 0.f};
#pragma unroll
        for (int i = 0; i < 8; ++i) { const int kk = 8 * i + (lane >> 3); const float gn = gain ? ((const GAS float*)gain)[k0 + kk] : 1.0f; LAS float* s = scr + kk * 33 + 4 * c4;
            s[0] = v[i][0] * gn; s[1] = v[i][1] * gn; s[2] = v[i][2] * gn; s[3] = v[i][3] * gn;
            }
    }
    LDS_WAIT(); asm volatile("" ::: "memory");
    const int c = lane & 7;
#pragma unroll
    for (int j = 0; j < 4; ++j) { const int n = (lane >> 3) + 8 * j; const LAS float* s = scr + (8 * c) * 33 + n;
        v4u o; o.x = pk2(s[0 * 33], s[1 * 33]); o.y = pk2(s[2 * 33], s[3 * 33]); o.z = pk2(s[4 * 33], s[5 * 33]); o.w = pk2(s[6 * 33], s[7 * 33]);
        int drow = n0 + n;
        if (gu == 3) {
            if (drow < 1024) { const int j = drow & 127; drow = (drow & ~127) + (j < 64 ? 2 * j : 2 * (j - 64) + 1); }
            else if (drow >= 2048 && drow < 3072) { const int j = drow & 63; drow = (drow & ~63) + (j < 8 ? 2 * j : (j < 16 ? 2 * (j - 8) + 1 : j)); }
        } else if (gu == 1 || gu == 2) drow = (drow >> 7) * 256 + (drow & 127) + (gu == 2 ? 128 : 0);
        if (f8s < 0.f) {
            int q[8];
#pragma unroll
            for (int e = 0; e < 8; ++e) q[e] = (int)fminf(fmaxf(rintf(s[e * 33] * -f8s), -127.f), 127.f) & 0xff;
            typedef int i32x2q __attribute__((ext_vector_type(2)));
            *(GAS i32x2q*)((GAS unsigned char*)WT + (size_t)drow * K + k0 + 8 * c) = (i32x2q){q[0] | (q[1] << 8) | (q[2] << 16) | (q[3] << 24), q[4] | (q[5] << 8) | (q[6] << 16) | (q[7] << 24)};
        } else
        if (f8s != 0.f) {
            const int w0 = __builtin_amdgcn_cvt_pk_fp8_f32(s[0 * 33] * f8s, s[1 * 33] * f8s, 0, false), w0b = __builtin_amdgcn_cvt_pk_fp8_f32(s[2 * 33] * f8s, s[3 * 33] * f8s, w0, true);
            const int w1 = __builtin_amdgcn_cvt_pk_fp8_f32(s[4 * 33] * f8s, s[5 * 33] * f8s, 0, false), w1b = __builtin_amdgcn_cvt_pk_fp8_f32(s[6 * 33] * f8s, s[7 * 33] * f8s, w1, true);
            typedef int i32x2_ __attribute__((ext_vector_type(2)));
            *(GAS i32x2_*)((GAS unsigned char*)WT + (size_t)drow * K + k0 + 8 * c) = (i32x2_){w0b, w1b};
        } else
        *(GAS v4u*)(WT + (size_t)drow * K + k0 + 8 * c) = o; }
    LDS_WAIT(); asm volatile("" ::: "memory");
}
__device__ __forceinline__ void convert_weights(const Frame& F0, int l, int part, float pro_s0 = 0.f, float pro_s1 = 0.f) {
    const Frame F = relaunder(F0);
    LAS float* scr = (LAS float*)(F.lds + RING_OFF + F.wave * 16384);
    const int gw = F.bid * NWAVES + F.wave, NGW = F.G * NWAVES;
    unsigned char* ws = WSP();
    constexpr int I_G = (D / 64) * (FF / 32), I_DN = (FF / 64) * (D / 32), I_O = (D / 64) * (D / 32);
    const bool odd = (l & 1) != 0; const int li = l >> 1;
    const int nin = odd ? GLA_IN : EVEN_IN, ninp = odd ? GLA_INP : EVEN_IN; const int I_IN = (D / 64) * (ninp / 32);
    const float* win = odd ? AP(I_GLA_IN) + (size_t)li * D * GLA_IN : AP(I_AB_IN) + (size_t)li * D * EVEN_IN;
    const float* wout = odd ? AP(I_GLA_OUT) + (size_t)li * D * D : AP(I_AB_OUT) + (size_t)li * D * D;
    const size_t fo = (size_t)l * D * FF;
    const int NITEMS = 6 * I_G + I_IN + I_O;
    static_assert(I_G == I_DN, "item counts");
    const int nitems = part == 0 ? NITEMS : (part == 1 ? 3 * I_G + I_IN : 3 * I_G + I_O);
    const float i8s0 = I8CONV(2 * l) ? (part == 0 ? -pro_s0 : -I8SW(2 * l)) : 0.f, i8s1 = I8CONV(2 * l + 1) ? (part == 0 ? -pro_s1 : -I8SW(2 * l + 1)) : 0.f;
    for (int it = gw; it < nitems; it += NGW) {
        int r = part == 2 ? (it < 3 * I_G ? it + 3 * I_G : it + 3 * I_G + I_IN) : ((part == 1 && it >= 3 * I_G) ? it + 3 * I_G : it);
        if (r < I_G) { tr_item(AP(I_PRE_WG) + fo, D, FF, FF, AP(I_PRE_NORM) + l * D, (bf16*)(ws + W_GU0), 1, scr, r, F.lane, I8CONV(2 * l) ? i8s0 : (F8ASLOT(2 * l) ? pg8::F8_GUSCALE : 0.f)); continue; } r -= I_G;
        if (r < I_G) { tr_item(AP(I_PRE_WU) + fo, D, FF, FF, AP(I_PRE_NORM) + l * D, (bf16*)(ws + W_GU0), 2, scr, r, F.lane, I8CONV(2 * l) ? i8s0 : (F8ASLOT(2 * l) ? pg8::F8_GUSCALE : 0.f)); continue; } r -= I_G;
        if (r < I_G) { tr_item(AP(I_PRE_WD) + fo, FF, D, D, nullptr, (bf16*)(ws + W_D0), 0, scr, r, F.lane, F8SLOT(2 * l) ? pg8::F8_WSCALE : 0.f); continue; } r -= I_G;
        if (r < I_G) { tr_item(AP(I_POST_WG) + fo, D, FF, FF, AP(I_POST_NORM) + l * D, (bf16*)(ws + W_GU1), 1, scr, r, F.lane, I8CONV(2 * l + 1) ? i8s1 : (F8ASLOT(2 * l + 1) ? pg8::F8_GUSCALE : 0.f)); continue; } r -= I_G;
        if (r < I_G) { tr_item(AP(I_POST_WU) + fo, D, FF, FF, AP(I_POST_NORM) + l * D, (bf16*)(ws + W_GU1), 2, scr, r, F.lane, I8CONV(2 * l + 1) ? i8s1 : (F8ASLOT(2 * l + 1) ? pg8::F8_GUSCALE : 0.f)); continue; } r -= I_G;
        if (r < I_G) { tr_item(AP(I_POST_WD) + fo, FF, D, D, nullptr, (bf16*)(ws + W_D1), 0, scr, r, F.lane, F8SLOT(2 * l + 1) ? pg8::F8_WSCALE : 0.f); continue; } r -= I_G;
        if (r < I_IN) { tr_item(win, D, nin, ninp, AP(I_MIX_NORM) + l * D, (bf16*)(ws + W_IN), odd ? 0 : 3, scr, r, F.lane); continue; } r -= I_IN;
        tr_item(wout, D, D, D, nullptr, (bf16*)(ws + W_OUT), 0, scr, r, F.lane);
    }
}
__device__ __forceinline__ float i8_scale_block(const Frame& F, int s) {
    const int l = s >> 1; const bool post = (s & 1) != 0; const size_t fo = (size_t)l * D * FF;
    const GAS float* wg = (const GAS float*)(AP(post ? I_POST_WG : I_PRE_WG) + fo); const GAS float* wu = (const GAS float*)(AP(post ? I_POST_WU : I_PRE_WU) + fo);
    const GAS float* gn = (const GAS float*)(AP(post ? I_POST_NORM : I_PRE_NORM) + l * D);
    float ss = 0.f, gm = 0.f;
    {
        f32x4 a[8], b[8];
#pragma unroll
        for (int i = 0; i < 8; ++i) { a[i] = ((const GAS f32x4*)wg)[F.tid + i * NTHREADS]; b[i] = ((const GAS f32x4*)wu)[F.tid + i * NTHREADS]; }
        static_assert(8 * NTHREADS * 4 == 16384, "sample size");
        for (int i = F.tid; i < D; i += NTHREADS) gm = fmaxf(gm, fabsf(gn[i]));
#pragma unroll
        for (int i = 0; i < 8; ++i) ss += a[i][0] * a[i][0] + a[i][1] * a[i][1] + a[i][2] * a[i][2] + a[i][3] * a[i][3] + b[i][0] * b[i][0] + b[i][1] * b[i][1] + b[i][2] * b[i][2] + b[i][3] * b[i][3];
    }
    ss = wave_sum(ss);
    gm = fmaxf(gm, xsw<1>(gm)); gm = fmaxf(gm, xsw<2>(gm)); gm = fmaxf(gm, xsw<4>(gm)); gm = fmaxf(gm, xsw<8>(gm)); gm = fmaxf(gm, xsw<16>(gm)); gm = max32(gm);
    LAS float* red = (LAS float*)(F.lds + RING_OFF);
    if (F.lane == 0) { red[F.wave] = ss; red[8 + F.wave] = gm; }
    __syncthreads();
    float st = 0.f, gt = 0.f;
    for (int w = 0; w < NWAVES; ++w) { st += red[w]; gt = fmaxf(gt, red[8 + w]); }
    __syncthreads();
    const float sigma = sqrtf(st * (1.0f / (2.0f * 16384.0f)));
    return 127.0f / fmaxf(I8_WCLIP * sigma * gt, 1e-20f);
}
__device__ __forceinline__ float i8_scales(const Frame& F0, float& s0) {
    const Frame F = relaunder(F0);
    float s1 = 0.f; s0 = 0.f;
    if (I8ASLOT(0)) { s0 = i8_scale_block(F, 0); if (F.bid == 0 && F.tid == 0) *(GAS float*)(WSP() + WS_I8S) = s0; }
    if (I8ASLOT(1)) { s1 = i8_scale_block(F, 1); if (F.bid == 1 && F.tid == 0) *(GAS float*)(WSP() + WS_I8S + 4) = s1; }
    if (F.bid >= 2 && F.bid < 8 && I8ASLOT(F.bid)) { const float v = i8_scale_block(F, F.bid); if (F.tid == 0) *(GAS float*)(WSP() + WS_I8S + 4 * F.bid) = v; }
    return s1;
}
__device__ __forceinline__ void prologue_rows(const Frame& F0, float pro_s0) {
    const Frame F = relaunder(F0);
    unsigned char* ws = WSP();
    const int gw = F.bid * NWAVES + F.wave, NGW = F.G * NWAVES;
    bf16* XB = (bf16*)(ws + WS_XB); float* ssp = (float*)(ws + WS_SSP);
    const float swi = I8ASLOT(0) ? 1.0f / pro_s0 : 0.f;
    for (int m = gw; m < M; m += NGW) {
        const GAS f32x4* xr = (const GAS f32x4*)(AP(I_X) + (size_t)m * D) + F.lane;
        GAS unsigned long long* o8 = (GAS unsigned long long*)(XB + (size_t)m * D) + F.lane;
        f32x4 v[4];
#pragma unroll
        for (int j = 0; j < 4; ++j) v[j] = xr[64 * j];
        float s = 0.f, mx = 0.f;
#pragma unroll
        for (int j = 0; j < 4; ++j) { s += (v[j].x * v[j].x + v[j].y * v[j].y) + (v[j].z * v[j].z + v[j].w * v[j].w);
            o8[64 * j] = (unsigned long long)pk2(v[j].x, v[j].y) | ((unsigned long long)pk2(v[j].z, v[j].w) << 32);
            mx = fmaxf(fmaxf(mx, fmaxf(fabsf(v[j].x), fabsf(v[j].y))), fmaxf(fabsf(v[j].z), fabsf(v[j].w))); }
        s = wave_sum(s);
        if (I8ASLOT(0)) {
            mx = fmaxf(mx, xsw<1>(mx)); mx = fmaxf(mx, xsw<2>(mx)); mx = fmaxf(mx, xsw<4>(mx)); mx = fmaxf(mx, xsw<8>(mx)); mx = fmaxf(mx, xsw<16>(mx)); mx = max32(mx);
            mx = fmaxf(mx, 1e-20f);
            const float sx = 127.0f / mx;
            GAS unsigned* x8 = (GAS unsigned*)(ws + WS_X8 + (size_t)m * D) + F.lane;
#pragma unroll
            for (int j = 0; j < 4; ++j) x8[64 * j] = (unsigned)(((int)rintf(v[j].x * sx) & 0xff) | (((int)rintf(v[j].y * sx) & 0xff) << 8) | (((int)rintf(v[j].z * sx) & 0xff) << 16) | (((int)rintf(v[j].w * sx) & 0xff) << 24));
            const float rstd = 1.0f / sqrtf(s * (1.0f / D) + EPS), reff = rstd * mx * (1.0f / 127.0f) * swi;
            s = 1024.0f * (1.0f / (reff * reff) - EPS);
        }
        if (F.lane < 16) ssp[(size_t)m * 16 + F.lane] = (F.lane == 0) ? s : 0.f;
    }
    const int gt = F.bid * NTHREADS + F.tid, NGT = F.G * NTHREADS;
    float* rc = (float*)(ws + TAB_RC); float* rsn = (float*)(ws + TAB_RS); float* dc = (float*)(ws + TAB_DC); float* ds = (float*)(ws + TAB_DS);
    for (int e = gt; e < SEQ * 64; e += NGT) { const int t = e >> 6, i = e & 63; const float ang = (float)t * RET_FREQ[i];
        double rev = (double)ang * 0.15915494309189535; rev -= __builtin_rint(rev); const float r = (float)rev;
        rc[e] = __builtin_amdgcn_cosf(r); rsn[e] = __builtin_amdgcn_sinf(r); }
    for (int e = gt; e < SEQ * 8; e += NGT) { const int t = e >> 3, i = e & 7; const float ang = (float)t * ROPE_FREQ[i];
        double rev = (double)ang * 0.15915494309189535; rev -= __builtin_rint(rev); const float r = (float)rev;
        dc[e] = __builtin_amdgcn_cosf(r); ds[e] = __builtin_amdgcn_sinf(r); }
}

__device__ __forceinline__ void quant_rows(const Frame& F0, int slot) {
    const Frame F = relaunder(F0);
    unsigned char* ws = WSP();
    const int pan0 = (F.bid & 7) * 16 + ((F.bid >> 3) & 7), widx = (F.bid >> 6) * NWAVES + F.wave;
    const bf16* XBp = (const bf16*)(ws + WS_XB); unsigned char* X8 = ws + WS_X8; float* ssp = (float*)(ws + WS_SSP);
    const float swi = 1.0f / I8SW(slot);
    for (int k = 0; k < 16; ++k) {
        const int m = (pan0 + (k & 8)) * 256 + widx + 32 * (k & 7);
        const GAS v4u* xr = (const GAS v4u*)(XBp + (size_t)m * D) + 2 * F.lane;
        const v4u a = xr[0], b = xr[1];
        float v[16];
#pragma unroll
        for (int i = 0; i < 4; ++i) { v[2 * i] = bflo(a[i]); v[2 * i + 1] = bfhi(a[i]); v[8 + 2 * i] = bflo(b[i]); v[8 + 2 * i + 1] = bfhi(b[i]); }
        float ss = 0.f, mx = 0.f;
#pragma unroll
        for (int i = 0; i < 16; ++i) { ss += v[i] * v[i]; mx = fmaxf(mx, fabsf(v[i])); }
        ss = wave_sum(ss);
        mx = fmaxf(mx, xsw<1>(mx)); mx = fmaxf(mx, xsw<2>(mx)); mx = fmaxf(mx, xsw<4>(mx)); mx = fmaxf(mx, xsw<8>(mx)); mx = fmaxf(mx, xsw<16>(mx)); mx = max32(mx);
        mx = fmaxf(mx, 1e-20f);
        const float sx = 127.0f / mx;
        int q[16];
#pragma unroll
        for (int i = 0; i < 16; ++i) q[i] = (int)rintf(v[i] * sx) & 0xff;
        v4u o;
#pragma unroll
        for (int i = 0; i < 4; ++i) o[i] = (unsigned)(q[4 * i] | (q[4 * i + 1] << 8) | (q[4 * i + 2] << 16) | (q[4 * i + 3] << 24));
        *((GAS v4u*)(X8 + (size_t)m * D) + F.lane) = o;
        const float rstd = 1.0f / sqrtf(ss * (1.0f / D) + EPS), reff = rstd * mx * (1.0f / 127.0f) * swi;
        if (F.lane < 16) ssp[(size_t)m * 16 + F.lane] = (F.lane == 0) ? 1024.0f * (1.0f / (reff * reff) - EPS) : 0.f;
    }
}

__device__ __forceinline__ void final_norm(const Frame& F0) {
    const Frame F = relaunder(F0);
    const int gw = F.bid * NWAVES + F.wave, NGW = F.G * NWAVES;
    const bf16* XBp = (const bf16*)(WSP() + WS_XB); float* out = OUTP(); const GAS f32x4* gr = (const GAS f32x4*)AP(I_FINAL);
    for (int m = gw; m < M; m += NGW) {
        const v4u w0 = *(const GAS v4u*)(XBp + (size_t)m * D + F.lane * 8), w1 = *(const GAS v4u*)(XBp + (size_t)m * D + 512 + F.lane * 8);
        float v[16]; float s = 0.f;
#pragma unroll
        for (int i = 0; i < 4; ++i) { v[2 * i] = bflo(w0[i]); v[2 * i + 1] = bfhi(w0[i]); v[8 + 2 * i] = bflo(w1[i]); v[8 + 2 * i + 1] = bfhi(w1[i]); }
#pragma unroll
        for (int i = 0; i < 16; ++i) s += v[i] * v[i];
        const float rstd = 1.0f / sqrtf(wave_sum(s) * (1.0f / D) + EPS);
        GAS f32x4* o = (GAS f32x4*)(out + (size_t)m * D);
#pragma unroll
        for (int hh = 0; hh < 2; ++hh)
#pragma unroll
            for (int q = 0; q < 2; ++q) { const int c4 = hh * 128 + F.lane * 2 + q; const f32x4 g = gr[c4];
                o[c4] = (f32x4){v[hh * 8 + q * 4] * rstd * g[0], v[hh * 8 + q * 4 + 1] * rstd * g[1], v[hh * 8 + q * 4 + 2] * rstd * g[2], v[hh * 8 + q * 4 + 3] * rstd * g[3]}; }
    }
}


__device__ __forceinline__ float silu_f(float g) { return g * __builtin_amdgcn_rcpf(1.0f + __builtin_amdgcn_exp2f(-1.4426950408889634f * g)); }
typedef float f32x16 __attribute__((ext_vector_type(16)));
typedef short s16x4 __attribute__((ext_vector_type(4)));
typedef float f32x2_t __attribute__((ext_vector_type(2)));
typedef __bf16 bf16x2_t __attribute__((ext_vector_type(2)));
#define MFMA32(a, b, c) __builtin_amdgcn_mfma_f32_32x32x16_bf16((a), (b), (c), 0, 0, 0)
__device__ __forceinline__ int crow(int reg, int h) { return (reg & 3) + 8 * (reg >> 2) + 4 * h; }
__device__ __forceinline__ unsigned cvtpk(float lo, float hi) { f32x2_t v = {lo, hi}; bf16x2_t b = __builtin_convertvector(v, bf16x2_t); return __builtin_bit_cast(unsigned, b); }
__device__ __forceinline__ bf16 cvt1(float v) { return (bf16)(cvtpk(v, 0.f) & 0xffffu); }
#define PACK_STEP(x, s) __builtin_bit_cast(bf16x8, (v4u){cvtpk((x)[8 * (s)], (x)[8 * (s) + 1]), cvtpk((x)[8 * (s) + 2], (x)[8 * (s) + 3]), cvtpk((x)[8 * (s) + 4], (x)[8 * (s) + 5]), cvtpk((x)[8 * (s) + 6], (x)[8 * (s) + 7])})
typedef const LAS unsigned char* lcp;
__device__ __forceinline__ int lndv(int v) { asm volatile("" : "+v"(v)); return v; }
__device__ __forceinline__ bf16x8 ld_row(lcp img, int P, int row0, int k0, int r, int h) { return *(const LAS bf16x8*)(img + (row0 + r) * P + (k0 + 8 * h) * 2); }
__device__ __forceinline__ bf16x8 ld_row_perm(lcp img, int P, int row0, int k0, int r, int h) {
    const s16x4 lo = *(const LAS s16x4*)(img + (row0 + r) * P + (k0 + 4 * h) * 2), hi = *(const LAS s16x4*)(img + (row0 + r) * P + (k0 + 8 + 4 * h) * 2);
    return __builtin_shufflevector(lo, hi, 0, 1, 2, 3, 4, 5, 6, 7); }
__device__ __forceinline__ s16x4 trd(lcp p) { return __builtin_bit_cast(s16x4, __builtin_amdgcn_ds_read_tr16_b64_v4i16((LAS s16x4*)p)); }
__device__ __forceinline__ bf16x8 ld_tr(lcp img, int P, int k0, int c0, int lane) {
    const int i16 = lane & 15, q = i16 >> 2, p = i16 & 3, blk = (lane >> 4) & 1, h = lane >> 5;
    lcp a = img + (k0 + 8 * h + q) * P + (c0 + 16 * blk + 4 * p) * 2;
    const s16x4 lo = trd(a), hi = trd(a + 4 * P);
    return __builtin_shufflevector(lo, hi, 0, 1, 2, 3, 4, 5, 6, 7); }
__device__ __forceinline__ bf16x8 ld_tr_perm(lcp img, int P, int k0, int c0, int lane) {
    const int i16 = lane & 15, q = i16 >> 2, p = i16 & 3, blk = (lane >> 4) & 1, h = lane >> 5;
    lcp a = img + (k0 + 4 * h + q) * P + (c0 + 16 * blk + 4 * p) * 2;
    const s16x4 lo = trd(a), hi = trd(a + 8 * P);
    return __builtin_shufflevector(lo, hi, 0, 1, 2, 3, 4, 5, 6, 7); }
template <int R, int C> __device__ __forceinline__ void tile_ld(v4u (&v)[R * C / 8 / NTHREADS], const bf16* g, size_t gp, int tid) {
    constexpr int CPR = C / 8, RS = NTHREADS / CPR;
    static_assert(NTHREADS % CPR == 0, "tile shape");
    const unsigned voff = (unsigned)((tid / CPR) * (int)gp + (tid % CPR) * 8) * 2u;
    const GAS unsigned char* gb = (const GAS unsigned char*)g;
#pragma unroll
    for (int i = 0; i < R * C / 8 / NTHREADS; ++i) v[i] = *(const GAS v4u*)(gb + (size_t)i * RS * gp * 2 + voff);
}
template <int R, int C> __device__ __forceinline__ void tile_st(const v4u (&v)[R * C / 8 / NTHREADS], LAS unsigned char* img, int P, int tid) {
    constexpr int CPR = C / 8, RS = NTHREADS / CPR;
    LAS unsigned char* lb = img + (tid / CPR) * P + (tid % CPR) * 16;
#pragma unroll
    for (int i = 0; i < R * C / 8 / NTHREADS; ++i) *(LAS v4u*)(lb + i * RS * P) = v[i];
}
template <int R, int C> __device__ __forceinline__ void stage_tile(LAS unsigned char* img, int P, const bf16* g, size_t gp, int tid) { v4u t_[R * C / 8 / NTHREADS]; tile_ld<R, C>(t_, g, gp, tid); tile_st<R, C>(t_, img, P, tid); }
#define WG_BAR() do { asm volatile("s_waitcnt lgkmcnt(0)" ::: "memory"); __builtin_amdgcn_s_barrier(); asm volatile("" ::: "memory"); } while (0)

constexpr int PR = 272, PT = 320, PT256 = 576, PO256 = 528;
constexpr size_t WS_ALOW = 7 * MiB;
constexpr size_t WS_DEC = 6 * MiB;
constexpr float LOG2E = 1.4426950408889634f, LN2 = 0.6931471805599453f;
__device__ __forceinline__ void gla_cumsum(float (&Bc)[2][16], float& Blast, lcp AL, lcp W2, const LAS float* BA, LAS float* EX, int wave, int lane) {
    const int r = lane & 31, h = lane >> 5, db = wave & 3, jh = wave >> 2;
    const bf16x8 wf = *(const LAS bf16x8*)(W2 + (db * 32 + r) * 32 + h * 16);
    const float bias = BA[db * 32 + r];
    float run = 0.f;
    float c16 = 1.0f / 16.0f; asm volatile("" : "+v"(c16)); float ln2_ = LN2; asm volatile("" : "+v"(ln2_));
#pragma unroll
    for (int t = 0; t < 2; ++t) {
        const bf16x8 af = *(const LAS bf16x8*)(AL + ((jh * 2 + t) * 32 + r) * 32 + h * 16);
        f32x16 z = {0.f, 0.f, 0.f, 0.f, 0.f, 0.f, 0.f, 0.f, 0.f, 0.f, 0.f, 0.f, 0.f, 0.f, 0.f, 0.f};
        z = MFMA32(af, wf, z);
        float own[4], oth[4];
#pragma unroll
        for (int g = 0; g < 4; ++g) {
            float acc = 0.f;
#pragma unroll
            for (int i = 0; i < 4; ++i) { const float zz = z[4 * g + i] + bias;
                const float la = (fminf(zz, 0.f) - ln2_ * __builtin_amdgcn_logf(1.0f + __builtin_amdgcn_exp2f(-fabsf(zz) * LOG2E))) * c16;
                acc += la; Bc[t][4 * g + i] = acc; }
            own[g] = acc; oth[g] = oth32(acc, h);
        }
#pragma unroll
        for (int g = 0; g < 4; ++g) { const float off = run + (h ? oth[g] : 0.f);
#pragma unroll
            for (int i = 0; i < 4; ++i) Bc[t][4 * g + i] += off;
            run += own[g] + oth[g]; }
    }
    if (h == 0) EX[jh * 128 + db * 32 + r] = run;
    WG_BAR();
    const float t0 = EX[db * 32 + r], t1 = EX[128 + db * 32 + r];
    Blast = t0 + t1;
    if (jh == 1) {
#pragma unroll
        for (int t = 0; t < 2; ++t)
#pragma unroll
            for (int i = 0; i < 16; ++i) Bc[t][i] += t0; }
}
constexpr int GA_KI = 0, GA_VI = GA_KI + 128 * PR, GA_KD = GA_VI + 128 * PT256, GA_AL = GA_KD + 128 * PT, GA_W2 = GA_AL + 4096, GA_BA = GA_W2 + 4096, GA_EX = GA_BA + 512, GA_END = GA_EX + 1024;
constexpr int GA_OI = GA_VI;
constexpr int GC_QT = 0, GC_KT = GC_QT + 128 * PR, GC_SI = GC_KT + 128 * PR, GC_VI = GC_SI + 128 * PT, GC_AL = GC_VI + 128 * PT, GC_W2 = GC_AL + 4096, GC_BA = GC_W2 + 4096, GC_EX = GC_BA + 512, GC_END = GC_EX + 1024;
constexpr int GC_OI = 0;
static_assert(GA_END <= LDSCTL_OFF && GC_END <= LDSCTL_OFF && 128 * PO256 <= GC_SI && 128 * PO256 <= 128 * PT256, "GLA LDS maps");
__device__ __forceinline__ void gla_stage_w(const Frame& F, LAS unsigned char* W2, LAS float* BA, int li, int h) {
    if (F.tid < 128) { const int d = F.tid; const GAS float* w2 = (const GAS float*)AP(I_GLA_A2) + (size_t)li * 16 * 512 + h * 128 + d;
        v4u lo, hi; lo.x = cvtpk(w2[0], w2[512]); lo.y = cvtpk(w2[2 * 512], w2[3 * 512]); lo.z = cvtpk(w2[4 * 512], w2[5 * 512]); lo.w = cvtpk(w2[6 * 512], w2[7 * 512]);
        hi.x = cvtpk(w2[8 * 512], w2[9 * 512]); hi.y = cvtpk(w2[10 * 512], w2[11 * 512]); hi.z = cvtpk(w2[12 * 512], w2[13 * 512]); hi.w = cvtpk(w2[14 * 512], w2[15 * 512]);
        *(LAS v4u*)(W2 + d * 32) = lo; *(LAS v4u*)(W2 + d * 32 + 16) = hi; }
    else if (F.tid < 256) { const int d = F.tid - 128; BA[d] = ((const GAS float*)AP(I_GLA_BA))[(size_t)li * 512 + h * 128 + d]; }
}
__device__ __forceinline__ v4u gla_ld_alow(int tid, const bf16* Arow0) { const int t = tid & 255; return *(const GAS v4u*)(Arow0 + (size_t)(t >> 1) * 16 + (t & 1) * 8); }
__device__ __forceinline__ void gla_st_alow(int tid, v4u v, LAS unsigned char* AL) { if (tid < 256) *(LAS v4u*)(AL + (tid >> 1) * 32 + (tid & 1) * 16) = v; }

__device__ __forceinline__ void gla_alow(const Frame& F0) {
    const Frame F = relaunder(F0);
    unsigned char* ws = WSP();
    const bf16* XBp = (const bf16*)(ws + WS_XB); const bf16* Wa = (const bf16*)(ws + W_IN) + (size_t)3072 * D; const float* ssp = (const float*)(ws + WS_SSP); bf16* ALOW = (bf16*)(ws + WS_ALOW);
    LAS unsigned char* L = F.lds;
    const int lane = F.lane, r = lane & 31, h2 = lane >> 5, tb = F.wave & 3, kh = F.wave >> 2;
    for (int blk = F.bid; blk < M / 128; blk += F.G) {
        const int tok = blk * 128 + tb * 32 + r;
        const bf16* xa = XBp + (size_t)tok * D + kh * 512 + 8 * h2; const bf16* wa = Wa + (size_t)(r & 15) * D + kh * 512 + 8 * h2;
        f32x16 acc = {0.f, 0.f, 0.f, 0.f, 0.f, 0.f, 0.f, 0.f, 0.f, 0.f, 0.f, 0.f, 0.f, 0.f, 0.f, 0.f};
#pragma unroll 1
        for (int k8 = 0; k8 < 4; ++k8) {
            bf16x8 af[8], bfr[8];
#pragma unroll
            for (int ks = 0; ks < 8; ++ks) { af[ks] = *(const GAS bf16x8*)(wa + (k8 * 8 + ks) * 16); bfr[ks] = *(const GAS bf16x8*)(xa + (k8 * 8 + ks) * 16); }
#pragma unroll
            for (int ks = 0; ks < 8; ++ks) acc = MFMA32(af[ks], bfr[ks], acc);
        }
        LAS float* red = (LAS float*)L + tb * 1024;
        if (kh == 1) {
#pragma unroll
            for (int i = 0; i < 8; ++i) red[i * 64 + lane] = acc[i]; }
        WG_BAR();
        if (kh == 0) {
            const f32x4 p0 = *(const GAS f32x4*)(ssp + (size_t)tok * 16), p1 = *(const GAS f32x4*)(ssp + (size_t)tok * 16 + 4), p2 = *(const GAS f32x4*)(ssp + (size_t)tok * 16 + 8), p3 = *(const GAS f32x4*)(ssp + (size_t)tok * 16 + 12);
            const float ss = ((p0[0] + p0[1]) + (p0[2] + p0[3])) + ((p1[0] + p1[1]) + (p1[2] + p1[3])) + ((p2[0] + p2[1]) + (p2[2] + p2[3])) + ((p3[0] + p3[1]) + (p3[2] + p3[3]));
            const float rstd = __builtin_amdgcn_rsqf(ss * (1.0f / 1024.0f) + EPS);
            float v[8];
#pragma unroll
            for (int i = 0; i < 8; ++i) v[i] = (acc[i] + red[i * 64 + lane]) * rstd;
            typedef unsigned u2v __attribute__((ext_vector_type(2)));
            u2v w0, w1; w0.x = cvtpk(v[0], v[1]); w0.y = cvtpk(v[2], v[3]); w1.x = cvtpk(v[4], v[5]); w1.y = cvtpk(v[6], v[7]);
            *(GAS u2v*)(ALOW + (size_t)tok * 16 + 4 * h2) = w0; *(GAS u2v*)(ALOW + (size_t)tok * 16 + 8 + 4 * h2) = w1;
        }
        WG_BAR();
    }
}
__device__ __forceinline__ void gla_phase_a(const Frame& F0, int li) {
    const Frame F = relaunder(F0);
    unsigned char* ws = WSP();
    const bf16* P = (const bf16*)(ws + WS_ACT); bf16* SKV = (bf16*)OUTP(); float* DEC = (float*)(ws + WS_DEC); const bf16* ALOWP = (const bf16*)(ws + WS_ALOW);
    LAS unsigned char* L = F.lds;
    const int wave = F.wave, db = wave & 3, jh = wave >> 2;
    v4u kR[4], vR[8], aR; int hcur = -1;
    {   const int it = F.bid; if (it < 1024) { const int bh = it >> 5, g = it & 31, b = bh >> 2, h = bh & 3;
            tile_ld<128, 128>(kR, P + HM(G_K, 4, 128, b, h) + g * 128 * 128, 128, F.tid); tile_ld<128, 256>(vR, P + HM(G_V, 4, 256, b, h) + g * 128 * 256, 256, F.tid); aR = gla_ld_alow(F.tid, ALOWP + ((size_t)b * SEQ + g * 128) * 16); } }
    for (int it = F.bid; it < 1024; it += F.G) {
        const int bh = it >> 5, h = bh & 3;
        const int lane = lndv(F.lane), r = lane & 31, h2 = lane >> 5;
        tile_st<128, 128>(kR, L + GA_KI, PR, F.tid); tile_st<128, 256>(vR, L + GA_VI, PT256, F.tid); gla_st_alow(F.tid, aR, L + GA_AL);
        if (h != hcur) { gla_stage_w(F, L + GA_W2, (LAS float*)(L + GA_BA), li, h); hcur = h; }
        WG_BAR();
        {   const int nx = it + F.G; if (nx < 1024) { const int bh2 = nx >> 5, g2 = nx & 31, b2 = bh2 >> 2, h2n = bh2 & 3;
                tile_ld<128, 128>(kR, P + HM(G_K, 4, 128, b2, h2n) + g2 * 128 * 128, 128, F.tid); tile_ld<128, 256>(vR, P + HM(G_V, 4, 256, b2, h2n) + g2 * 128 * 256, 256, F.tid); aR = gla_ld_alow(F.tid, ALOWP + ((size_t)b2 * SEQ + g2 * 128) * 16); } }
        float Bc[2][16], Blast;
        gla_cumsum(Bc, Blast, L + GA_AL, L + GA_W2, (const LAS float*)(L + GA_BA), (LAS float*)(L + GA_EX), wave, lane);
#pragma unroll
        for (int t = 0; t < 2; ++t)
#pragma unroll
            for (int i = 0; i < 16; ++i) { const int row = (jh * 2 + t) * 32 + crow(i, h2), col = db * 32 + r;
                const float kv = bf2f(*(const LAS bf16*)(L + GA_KI + row * PR + col * 2)) * __builtin_amdgcn_exp2f((Blast - Bc[t][i]) * LOG2E);
                *(LAS bf16*)(L + GA_KD + row * PT + col * 2) = cvt1(kv); }
        if (jh == 0 && h2 == 0) DEC[(size_t)it * 128 + db * 32 + r] = __builtin_amdgcn_exp2f(Blast * LOG2E);
        WG_BAR();
        f32x16 acc[4];
#pragma unroll
        for (int t = 0; t < 4; ++t) acc[t] = (f32x16){0.f, 0.f, 0.f, 0.f, 0.f, 0.f, 0.f, 0.f, 0.f, 0.f, 0.f, 0.f, 0.f, 0.f, 0.f, 0.f};
#pragma unroll
        for (int ks = 0; ks < 8; ++ks) { const bf16x8 a = ld_tr(L + GA_KD, PT, 16 * ks, db * 32, lane);
#pragma unroll
            for (int t = 0; t < 4; ++t) acc[t] = MFMA32(a, ld_tr(L + GA_VI, PT256, 16 * ks, (4 * jh + t) * 32, lane), acc[t]); }
        WG_BAR();
#pragma unroll
        for (int t = 0; t < 4; ++t)
#pragma unroll
            for (int i = 0; i < 16; ++i) *(LAS bf16*)(L + GA_OI + (db * 32 + crow(i, h2)) * PO256 + ((4 * jh + t) * 32 + r) * 2) = cvt1(acc[t][i]);
        WG_BAR();
        {   bf16* out = SKV + (size_t)it * 128 * 256;
#pragma unroll
            for (int i = 0; i < 8; ++i) { const int c = F.tid + i * NTHREADS, row = c >> 5, cc = c & 31; *(GAS v4u*)(out + row * 256 + cc * 8) = *(const LAS v4u*)(L + GA_OI + row * PO256 + cc * 16); } }
        WG_BAR();
    }
}
__device__ __forceinline__ void gla_phase_b(const Frame& F0) {
    const Frame F = relaunder(F0);
    unsigned char* ws = WSP();
    bf16* SKV = (bf16*)OUTP(); const float* DEC = (const float*)(ws + WS_DEC);
    for (int gt = F.bid * NTHREADS + F.tid; gt < 32 * 128 * 32; gt += F.G * NTHREADS) {
        const int bh = gt >> 12, d = (gt >> 5) & 127, e8 = gt & 31;
        float s[8];
#pragma unroll
        for (int i = 0; i < 8; ++i) s[i] = 0.f;
        for (int g0 = 0; g0 < 32; g0 += 8) {
            v4u kv[8]; float dc[8];
#pragma unroll
            for (int u = 0; u < 8; ++u) { const size_t item = (size_t)bh * 32 + g0 + u; kv[u] = *(const GAS v4u*)(SKV + (item * 128 + d) * 256 + e8 * 8); dc[u] = ((const GAS float*)DEC)[item * 128 + d]; }
#pragma unroll
            for (int u = 0; u < 8; ++u) { const size_t item = (size_t)bh * 32 + g0 + u;
                v4u o; o.x = cvtpk(s[0], s[1]); o.y = cvtpk(s[2], s[3]); o.z = cvtpk(s[4], s[5]); o.w = cvtpk(s[6], s[7]);
                *(GAS v4u*)(SKV + (item * 128 + d) * 256 + e8 * 8) = o;
#pragma unroll
                for (int i = 0; i < 4; ++i) { s[2 * i] = dc[u] * s[2 * i] + bflo(kv[u][i]); s[2 * i + 1] = dc[u] * s[2 * i + 1] + bfhi(kv[u][i]); } }
        }
    }
}
__device__ __forceinline__ void gla_phase_c(const Frame& F0, int li) {
    const Frame F = relaunder(F0);
    unsigned char* ws = WSP();
    const bf16* P = (const bf16*)(ws + WS_ACT); const bf16* SKV = (const bf16*)OUTP(); bf16* CAT = (bf16*)(ws + WS_CAT); const bf16* ALOWP = (const bf16*)(ws + WS_ALOW);
    LAS unsigned char* L = F.lds;
    const int wave = F.wave, db = wave & 3, jh = wave >> 2;
    const int ib = wave & 3, eq = wave >> 2;
    v4u qR[4], kR[4], aR; int hcur = -1;
    {   const int it = F.bid; if (it < 1024) { const int bh = it >> 5, g = it & 31, b = bh >> 2, h = bh & 3;
            tile_ld<128, 128>(qR, P + HM(G_Q, 4, 128, b, h) + g * 128 * 128, 128, F.tid); tile_ld<128, 128>(kR, P + HM(G_K, 4, 128, b, h) + g * 128 * 128, 128, F.tid); aR = gla_ld_alow(F.tid, ALOWP + ((size_t)b * SEQ + g * 128) * 16); } }
    for (int it = F.bid; it < 1024; it += F.G) {
        const int bh = it >> 5, g = it & 31, b = bh >> 2, h = bh & 3;
        const int tidl = lndv(F.tid), lane = tidl & 63, r = lane & 31, h2 = lane >> 5;
        const bf16* Vs = P + HM(G_V, 4, 256, b, h) + (size_t)g * 128 * 256; const bf16* Rs = P + HM(G_R, 4, 256, b, h) + (size_t)g * 128 * 256;
        const bf16* Sg = SKV + (size_t)it * 128 * 256;
        {   v4u sR[4], vR[4]; tile_ld<128, 128>(sR, Sg, 256, tidl); tile_ld<128, 128>(vR, Vs, 256, tidl);
            tile_st<128, 128>(qR, L + GC_QT, PR, tidl); tile_st<128, 128>(kR, L + GC_KT, PR, tidl); tile_st<128, 128>(sR, L + GC_SI, PT, tidl); tile_st<128, 128>(vR, L + GC_VI, PT, tidl); }
        gla_st_alow(tidl, aR, L + GC_AL);
        if (h != hcur) { gla_stage_w(F, L + GC_W2, (LAS float*)(L + GC_BA), li, h); hcur = h; }
        WG_BAR();
        {
            float Bc[2][16], Blast;
            gla_cumsum(Bc, Blast, L + GC_AL, L + GC_W2, (const LAS float*)(L + GC_BA), (LAS float*)(L + GC_EX), wave, lane);
#pragma unroll
            for (int t = 0; t < 2; ++t)
#pragma unroll
                for (int i = 0; i < 16; ++i) { const int off = ((jh * 2 + t) * 32 + crow(i, h2)) * PR + (db * 32 + r) * 2;
                    const float eb = __builtin_amdgcn_exp2f(Bc[t][i] * LOG2E);
                    const float qv = bf2f(*(const LAS bf16*)(L + GC_QT + off)) * eb * 0.08838834764831845f;
                    const float kv = bf2f(*(const LAS bf16*)(L + GC_KT + off)) * __builtin_amdgcn_rcpf(eb);
                    *(LAS bf16*)(L + GC_QT + off) = cvt1(qv); *(LAS bf16*)(L + GC_KT + off) = cvt1(kv); }
        }
        WG_BAR();
        bf16x8 PA[4][2];
#pragma unroll
        for (int jb = 0; jb < 4; ++jb) {
            if (jb <= ib) {
                f32x16 x = {0.f, 0.f, 0.f, 0.f, 0.f, 0.f, 0.f, 0.f, 0.f, 0.f, 0.f, 0.f, 0.f, 0.f, 0.f, 0.f};
#pragma unroll
                for (int ks = 0; ks < 8; ++ks) x = MFMA32(ld_row(L + GC_KT, PR, jb * 32, 16 * ks, r, h2), ld_row(L + GC_QT, PR, ib * 32, 16 * ks, r, h2), x);
                if (jb == ib) {
#pragma unroll
                    for (int i = 0; i < 16; ++i) if (crow(i, h2) > r) x[i] = 0.f; }
                PA[jb][0] = PACK_STEP(x, 0); PA[jb][1] = PACK_STEP(x, 1);
            } else { PA[jb][0] = (bf16x8){0, 0, 0, 0, 0, 0, 0, 0}; PA[jb][1] = (bf16x8){0, 0, 0, 0, 0, 0, 0, 0}; }
        }
        f32x16 o[2][2];
        v4u s1R[4], v1R[4];
        tile_ld<128, 128>(s1R, Sg + 128, 256, tidl); tile_ld<128, 128>(v1R, Vs + 128, 256, tidl);
#pragma unroll
        for (int half = 0; half < 2; ++half) {
            if (half == 1) {
                WG_BAR();
                tile_st<128, 128>(s1R, L + GC_SI, PT, tidl); tile_st<128, 128>(v1R, L + GC_VI, PT, tidl);
                WG_BAR();
            }
#pragma unroll
            for (int t = 0; t < 2; ++t) {
                const int eb = 2 * eq + t;
                f32x16 acc = {0.f, 0.f, 0.f, 0.f, 0.f, 0.f, 0.f, 0.f, 0.f, 0.f, 0.f, 0.f, 0.f, 0.f, 0.f, 0.f};
#pragma unroll
                for (int jb = 0; jb < 4; ++jb) if (jb <= ib) {
#pragma unroll
                    for (int s = 0; s < 2; ++s) acc = MFMA32(PA[jb][s], ld_tr_perm(L + GC_VI, PT, jb * 32 + 16 * s, eb * 32, lane), acc); }
#pragma unroll
                for (int ks = 0; ks < 8; ++ks) acc = MFMA32(ld_row(L + GC_QT, PR, ib * 32, 16 * ks, r, h2), ld_tr(L + GC_SI, PT, 16 * ks, eb * 32, lane), acc);
                o[half][t] = acc;
            }
        }
        WG_BAR();
#pragma unroll
        for (int half = 0; half < 2; ++half)
#pragma unroll
            for (int t = 0; t < 2; ++t)
#pragma unroll
                for (int i = 0; i < 16; ++i) *(LAS bf16*)(L + GC_OI + (ib * 32 + crow(i, h2)) * PO256 + (half * 128 + (2 * eq + t) * 32 + r) * 2) = cvt1(o[half][t][i]);
        WG_BAR();
        {   const int nx = (it + F.G < 1024) ? it + F.G : it;
            const int bh2 = nx >> 5, g2 = nx & 31, hn = bh2 & 3, bn = bh2 >> 2;
            tile_ld<128, 128>(qR, P + HM(G_Q, 4, 128, bn, hn) + g2 * 128 * 128, 128, tidl); tile_ld<128, 128>(kR, P + HM(G_K, 4, 128, bn, hn) + g2 * 128 * 128, 128, tidl); aR = gla_ld_alow(tidl, ALOWP + ((size_t)bn * SEQ + g2 * 128) * 16); }
        {
            const int tid2 = lndv(tidl), row = tid2 >> 2, qtr = tid2 & 3;
            lcp orow = L + GC_OI + row * PO256 + qtr * 128;
            const bf16* gp = Rs + (size_t)row * 256 + qtr * 64;
            float sum = 0.f;
#pragma unroll
            for (int c = 0; c < 8; ++c) { const v4u w = *(const LAS v4u*)(orow + c * 16);
#pragma unroll
                for (int i = 0; i < 4; ++i) sum += bflo(w[i]) + bfhi(w[i]); }
            sum += xsw<1>(sum); sum += xsw<2>(sum);
            const float mu = sum * (1.0f / 256.0f); float sq = 0.f;
#pragma unroll
            for (int c = 0; c < 8; ++c) { const v4u w = *(const LAS v4u*)(orow + c * 16);
#pragma unroll
                for (int i = 0; i < 4; ++i) { const float d0 = bflo(w[i]) - mu, d1 = bfhi(w[i]) - mu; sq += d0 * d0 + d1 * d1; } }
            sq += xsw<1>(sq); sq += xsw<2>(sq);
            float eps_ = EPS; asm volatile("" : "+v"(eps_)); const float rstd = 1.0f / sqrtf(sq * (1.0f / 256.0f) + eps_);
            bf16* op = CAT + ((size_t)b * SEQ + g * 128 + row) * D + h * 256 + qtr * 64;
#pragma unroll
            for (int c = 0; c < 8; ++c) { const v4u gw = *(const GAS v4u*)(gp + c * 8); const v4u w = *(const LAS v4u*)(orow + c * 16); v4u ow;
#pragma unroll
                for (int i = 0; i < 4; ++i) { const float g0 = bflo(gw[i]), g1 = bfhi(gw[i]);
                    ow[i] = cvtpk((bflo(w[i]) - mu) * rstd * silu_f(g0), (bfhi(w[i]) - mu) * rstd * silu_f(g1)); }
                *(GAS v4u*)(op + c * 8) = ow; }
        }
        WG_BAR();
    }
}


constexpr size_t WS_OD = 408 * MiB;
constexpr size_t OUT_LSE = 32 * MiB;
constexpr size_t WS_END2 = 504 * MiB;
constexpr int RA_KI = 0, RA_VD = RA_KI + 128 * PT, RA_END = RA_VD + 128 * PT;
constexpr int RC_QI = 0, RC_KI = RC_QI + 128 * PR, RC_VI = RC_KI + 128 * PR, RC_SI = RC_VI + 128 * PT, RC_END = RC_SI + 128 * PT;
constexpr int DPK = 144, DPV = 192;
constexpr int DL_KI = 0, DL_VI = DL_KI + 384 * DPK, DL_LW = DL_VI + 384 * DPV, DL_END = DL_LW + 8 * 256;
constexpr int DL_ST = DL_KI;
static_assert(RC_END <= LDSCTL_OFF && DL_END <= LDSCTL_OFF && 8 * 32 * DPK <= 384 * DPK, "even mixer LDS maps");
__device__ __forceinline__ float ret_log2g(int h) { return log2f(1.0f - exp2f(-5.0f - (float)h)); }

__device__ __forceinline__ void ret_phase_a_items(const Frame& F, const bf16* P, bf16* RKV) {
    LAS unsigned char* L = F.lds;
    const int wave = F.wave, db = wave & 3, eh = wave >> 2;
    v4u kR[4], vR[4];
    {   const int it = F.bid < 1024 ? F.bid : 0; const int bh = it >> 5, n = it & 31;
        tile_ld<128, 128>(kR, P + HM(E_RK, 4, 128, bh >> 2, bh & 3) + n * 128 * 128, 128, F.tid); tile_ld<128, 128>(vR, P + HM(E_RV, 4, 128, bh >> 2, bh & 3) + n * 128 * 128, 128, F.tid); }
    for (int it = F.bid; it < 1024; it += F.G) {
        const int tidl = lndv(F.tid), lane = tidl & 63, r = lane & 31, h2 = lane >> 5;
        const int bh = it >> 5, h = bh & 3;
        const float lg = ret_log2g(h);
        tile_st<128, 128>(kR, L + RA_KI, PT, tidl);
        {
#pragma unroll
            for (int i = 0; i < 4; ++i) { const int row = (tidl >> 4) + 32 * i, cc = tidl & 15; const float f = __builtin_amdgcn_exp2f(lg * (float)(127 - row)); v4u o;
#pragma unroll
                for (int k = 0; k < 4; ++k) o[k] = cvtpk(bflo(vR[i][k]) * f, bfhi(vR[i][k]) * f);
                *(LAS v4u*)(L + RA_VD + row * PT + cc * 16) = o; }
        }
        WG_BAR();
        {   const int nx = (it + F.G < 1024) ? it + F.G : it; const int bh2 = nx >> 5, n2 = nx & 31;
            tile_ld<128, 128>(kR, P + HM(E_RK, 4, 128, bh2 >> 2, bh2 & 3) + n2 * 128 * 128, 128, tidl); tile_ld<128, 128>(vR, P + HM(E_RV, 4, 128, bh2 >> 2, bh2 & 3) + n2 * 128 * 128, 128, tidl); }
        f32x16 acc[2];
#pragma unroll
        for (int t = 0; t < 2; ++t) acc[t] = (f32x16){0.f, 0.f, 0.f, 0.f, 0.f, 0.f, 0.f, 0.f, 0.f, 0.f, 0.f, 0.f, 0.f, 0.f, 0.f, 0.f};
#pragma unroll
        for (int ks = 0; ks < 8; ++ks) { const bf16x8 a = ld_tr(L + RA_KI, PT, 16 * ks, db * 32, lane);
#pragma unroll
            for (int t = 0; t < 2; ++t) acc[t] = MFMA32(a, ld_tr(L + RA_VD, PT, 16 * ks, (2 * eh + t) * 32, lane), acc[t]); }
        WG_BAR();
#pragma unroll
        for (int t = 0; t < 2; ++t)
#pragma unroll
            for (int i = 0; i < 16; ++i) *(LAS bf16*)(L + RA_KI + (db * 32 + crow(i, h2)) * PR + ((2 * eh + t) * 32 + r) * 2) = cvt1(acc[t][i]);
        WG_BAR();
        bf16* out = RKV + (size_t)it * 128 * 128;
#pragma unroll
        for (int i = 0; i < 4; ++i) { const int row = (tidl >> 4) + 32 * i, cc = tidl & 15; *(GAS v4u*)(out + row * 128 + cc * 8) = *(const LAS v4u*)(L + RA_KI + row * PR + cc * 16); }
        WG_BAR();
    }
}
__device__ __forceinline__ void ret_scan(const Frame& F, bf16* RKV) {
    for (int gt = F.bid * NTHREADS + F.tid; gt < 32 * 128 * 32; gt += F.G * NTHREADS) {
        const int bh = gt >> 12, d = (gt >> 5) & 127, e4 = gt & 31, h = bh & 3;
        const float g128 = __builtin_amdgcn_exp2f(ret_log2g(h) * 128.0f);
        float s[4];
#pragma unroll
        for (int i = 0; i < 4; ++i) s[i] = 0.f;
        typedef unsigned u2v __attribute__((ext_vector_type(2)));
        for (int n0 = 0; n0 < 32; n0 += 8) {
            u2v kv[8];
#pragma unroll
            for (int u = 0; u < 8; ++u) kv[u] = *(const GAS u2v*)(RKV + (((size_t)bh * 32 + n0 + u) * 128 + d) * 128 + e4 * 4);
#pragma unroll
            for (int u = 0; u < 8; ++u) {
                u2v o; o.x = cvtpk(s[0], s[1]); o.y = cvtpk(s[2], s[3]);
                *(GAS u2v*)(RKV + (((size_t)bh * 32 + n0 + u) * 128 + d) * 128 + e4 * 4) = o;
#pragma unroll
                for (int i = 0; i < 2; ++i) { s[2 * i] = g128 * s[2 * i] + bflo(kv[u][i]); s[2 * i + 1] = g128 * s[2 * i + 1] + bfhi(kv[u][i]); } }
        }
    }
}
__device__ __forceinline__ void ret_phase_c_items(const Frame& F, const bf16* P, const bf16* RKV, bf16* CAT) {
    LAS unsigned char* L = F.lds;
    const int wave = F.wave, ib = wave & 3, eq = wave >> 2;
    v4u qR[4], kR[4];
    {   const int it = F.bid < 1024 ? F.bid : 0; const int bh = it >> 5, n = it & 31;
        tile_ld<128, 128>(qR, P + HM(E_RQ, 4, 128, bh >> 2, bh & 3) + n * 128 * 128, 128, F.tid); tile_ld<128, 128>(kR, P + HM(E_RK, 4, 128, bh >> 2, bh & 3) + n * 128 * 128, 128, F.tid); }
    for (int it = F.bid; it < 1024; it += F.G) {
        const int tidl = lndv(F.tid), lane = tidl & 63, r = lane & 31, h2 = lane >> 5;
        const int bh = it >> 5, n = it & 31, b = bh >> 2, h = bh & 3;
        const float lg = ret_log2g(h);
        {   v4u vR[4], sR[4]; tile_ld<128, 128>(vR, P + HM(E_RV, 4, 128, b, h) + n * 128 * 128, 128, tidl); tile_ld<128, 128>(sR, RKV + (size_t)it * 128 * 128, 128, tidl);
#pragma unroll
            for (int i = 0; i < 4; ++i) { const int row = (tidl >> 4) + 32 * i, cc = tidl & 15; const float fq = __builtin_amdgcn_exp2f(lg * (float)row), fk = __builtin_amdgcn_rcpf(fq); v4u oq, ok;
#pragma unroll
                for (int k = 0; k < 4; ++k) { oq[k] = cvtpk(bflo(qR[i][k]) * fq, bfhi(qR[i][k]) * fq); ok[k] = cvtpk(bflo(kR[i][k]) * fk, bfhi(kR[i][k]) * fk); }
                *(LAS v4u*)(L + RC_QI + row * PR + cc * 16) = oq; *(LAS v4u*)(L + RC_KI + row * PR + cc * 16) = ok; }
            tile_st<128, 128>(vR, L + RC_VI, PT, tidl); tile_st<128, 128>(sR, L + RC_SI, PT, tidl); }
        WG_BAR();
        bf16x8 PA[4][2];
#pragma unroll
        for (int jb = 0; jb < 4; ++jb) {
            if (jb <= ib) {
                f32x16 x = {0.f, 0.f, 0.f, 0.f, 0.f, 0.f, 0.f, 0.f, 0.f, 0.f, 0.f, 0.f, 0.f, 0.f, 0.f, 0.f};
#pragma unroll
                for (int ks = 0; ks < 8; ++ks) x = MFMA32(ld_row(L + RC_KI, PR, jb * 32, 16 * ks, r, h2), ld_row(L + RC_QI, PR, ib * 32, 16 * ks, r, h2), x);
                if (jb == ib) {
#pragma unroll
                    for (int i = 0; i < 16; ++i) if (crow(i, h2) > r) x[i] = 0.f; }
                PA[jb][0] = PACK_STEP(x, 0); PA[jb][1] = PACK_STEP(x, 1);
            } else { PA[jb][0] = (bf16x8){0, 0, 0, 0, 0, 0, 0, 0}; PA[jb][1] = (bf16x8){0, 0, 0, 0, 0, 0, 0, 0}; }
        }
        f32x16 o[2];
#pragma unroll
        for (int t = 0; t < 2; ++t) {
            const int eb = 2 * eq + t;
            f32x16 z = {0.f, 0.f, 0.f, 0.f, 0.f, 0.f, 0.f, 0.f, 0.f, 0.f, 0.f, 0.f, 0.f, 0.f, 0.f, 0.f}, y = z;
#pragma unroll
            for (int jb = 0; jb < 4; ++jb) if (jb <= ib) {
#pragma unroll
                for (int s = 0; s < 2; ++s) z = MFMA32(PA[jb][s], ld_tr_perm(L + RC_VI, PT, jb * 32 + 16 * s, eb * 32, lane), z); }
#pragma unroll
            for (int ks = 0; ks < 8; ++ks) y = MFMA32(ld_row(L + RC_QI, PR, ib * 32, 16 * ks, r, h2), ld_tr(L + RC_SI, PT, 16 * ks, eb * 32, lane), y);
            const float g1 = __builtin_amdgcn_exp2f(lg);
#pragma unroll
            for (int i = 0; i < 16; ++i) z[i] += y[i] * g1;
            o[t] = z;
        }
        WG_BAR();
#pragma unroll
        for (int t = 0; t < 2; ++t)
#pragma unroll
            for (int i = 0; i < 16; ++i) *(LAS bf16*)(L + RC_QI + (ib * 32 + crow(i, h2)) * PR + ((2 * eq + t) * 32 + r) * 2) = cvt1(o[t][i]);
        WG_BAR();
        {   const int nx = (it + F.G < 1024) ? it + F.G : it; const int bh2 = nx >> 5, n2 = nx & 31;
            tile_ld<128, 128>(qR, P + HM(E_RQ, 4, 128, bh2 >> 2, bh2 & 3) + n2 * 128 * 128, 128, tidl); tile_ld<128, 128>(kR, P + HM(E_RK, 4, 128, bh2 >> 2, bh2 & 3) + n2 * 128 * 128, 128, tidl); }
        {
            const int tid2 = lndv(tidl), row = tid2 >> 2, qtr = tid2 & 3;
            lcp orow = L + RC_QI + row * PR + qtr * 64;
            v4u w[4]; float sum = 0.f;
#pragma unroll
            for (int c = 0; c < 4; ++c) { w[c] = *(const LAS v4u*)(orow + c * 16);
#pragma unroll
                for (int i = 0; i < 4; ++i) sum += bflo(w[c][i]) + bfhi(w[c][i]); }
            sum += xsw<1>(sum); sum += xsw<2>(sum);
            const float mu = sum * (1.0f / 128.0f); float sq = 0.f;
#pragma unroll
            for (int c = 0; c < 4; ++c)
#pragma unroll
                for (int i = 0; i < 4; ++i) { const float d0 = bflo(w[c][i]) - mu, d1 = bfhi(w[c][i]) - mu; sq += d0 * d0 + d1 * d1; }
            sq += xsw<1>(sq); sq += xsw<2>(sq);
            float eps_ = EPS; asm volatile("" : "+v"(eps_)); const float rstd = 1.0f / sqrtf(sq * (1.0f / 128.0f) + eps_);
            const bf16* gp = P + HM(E_RG, 4, 128, b, h) + (size_t)(n * 128 + row) * 128 + qtr * 32;
            bf16* op = CAT + ((size_t)b * SEQ + n * 128 + row) * D + h * 128 + qtr * 32;
#pragma unroll
            for (int c = 0; c < 4; ++c) { const v4u gw = *(const GAS v4u*)(gp + c * 8); v4u ow;
#pragma unroll
                for (int i = 0; i < 4; ++i) { const float g0 = bflo(gw[i]), g1 = bfhi(gw[i]);
                    ow[i] = cvtpk((bflo(w[c][i]) - mu) * rstd * silu_f(g0), (bfhi(w[c][i]) - mu) * rstd * silu_f(g1)); }
                *(GAS v4u*)(op + c * 8) = ow; }
        }
        WG_BAR();
    }
}
struct DilTile { int b, head, p, dil, res, q0; };
template <bool FUSE> __device__ __forceinline__ DilTile dil_decode(int T) { DilTile t;
    if (FUSE) { t.b = T >> 7; t.head = T & 7; t.p = 0; t.dil = 1; t.res = 0; t.q0 = ((T >> 3) & 15) * 256; }
    else { t.b = T >> 8; t.head = (T >> 5) & 7; const int t32 = T & 31, hi = t32 >> 3, lo = t32 & 3;
        t.p = 1 + (((t32 >> 2) ^ t.b) & 1);
        if (t.p == 1) { t.dil = 4; t.res = lo; t.q0 = ((hi + (t.b >> 1)) & 3) * 256; }
        else { t.dil = 16; t.res = hi * 4 + lo; t.q0 = 0; } }
    return t; }
__device__ __forceinline__ void dil_ld(v4u (&kR)[6], v4u (&vR)[6], const DilTile& t, const bf16* P, int tid) {
    const bf16* Kb = P + HM(E_DK, 8, 64, t.b, t.head) + (tid & 7) * 8; const bf16* Vb = P + HM(E_DV, 8, 64, t.b, t.head) + (tid & 7) * 8;
#pragma unroll
    for (int i = 0; i < 6; ++i) { int kidx = t.q0 - 128 + (tid >> 3) + 64 * i; kidx = kidx < 0 ? 0 : kidx;
        const size_t ro = (size_t)(kidx * t.dil + t.res) * 64; kR[i] = *(const GAS v4u*)(Kb + ro); vR[i] = *(const GAS v4u*)(Vb + ro); }
}
template <bool FUSE> __device__ __forceinline__ void dil_tiles(const Frame& F, int T0, int T1, int step, const bf16* P, bf16* OD, float* LSE, bf16* CAT) {
    LAS unsigned char* L = F.lds;
    const int wave = F.wave;
    if (T0 >= T1) return;
    v4u kR[6], vR[6];
    { const DilTile t0 = dil_decode<FUSE>(T0); dil_ld(kR, vR, t0, P, F.tid); }
    for (int T = T0; T < T1; T += step) {
        const int tidl = lndv(F.tid), lane = tidl & 63, r = lane & 31, h2 = lane >> 5;
        const DilTile t = dil_decode<FUSE>(T);
#pragma unroll
        for (int i = 0; i < 6; ++i) { const int row = (tidl >> 3) + 64 * i, cc = tidl & 7; *(LAS v4u*)(L + DL_KI + row * DPK + cc * 16) = kR[i]; *(LAS v4u*)(L + DL_VI + row * DPV + cc * 16) = vR[i]; }
        bf16x8 qf[4];
        { const bf16* qsrc = P + HM(E_DQ, 8, 64, t.b, t.head) + (size_t)((t.q0 + 32 * wave + r) * t.dil + t.res) * 64 + 8 * h2;
#pragma unroll
          for (int ks = 0; ks < 4; ++ks) qf[ks] = *(const GAS bf16x8*)(qsrc + 16 * ks); }
        WG_BAR();
        { const DilTile tn = dil_decode<FUSE>(T + step < T1 ? T + step : T); dil_ld(kR, vR, tn, P, tidl); }
        f32x16 x[5];
        float ninf = -INFINITY; asm volatile("" : "+v"(ninf));
        float mx = ninf;
        bf16x8 kf[2][4];
#pragma unroll
        for (int ks = 0; ks < 4; ++ks) kf[0][ks] = ld_row(L + DL_KI, DPK, 32 * wave, 16 * ks, r, h2);
#pragma unroll
        for (int kb = 0; kb < 5; ++kb) {
            if (kb < 4) {
#pragma unroll
                for (int ks = 0; ks < 4; ++ks) kf[(kb + 1) & 1][ks] = ld_row(L + DL_KI, DPK, 32 * wave + 32 * (kb + 1), 16 * ks, r, h2); }
            f32x16 a = {0.f, 0.f, 0.f, 0.f, 0.f, 0.f, 0.f, 0.f, 0.f, 0.f, 0.f, 0.f, 0.f, 0.f, 0.f, 0.f};
#pragma unroll
            for (int ks = 0; ks < 4; ++ks) a = MFMA32(kf[kb & 1][ks], qf[ks], a);
            if (kb == 0) {
#pragma unroll
                for (int i = 0; i < 16; ++i) if (crow(i, h2) < r) a[i] = ninf; }
            if (kb == 4) {
#pragma unroll
                for (int i = 0; i < 16; ++i) if (crow(i, h2) > r) a[i] = ninf; }
            if (t.q0 == 0 && 32 * wave + 32 * kb < 128) {
#pragma unroll
                for (int i = 0; i < 16; ++i) a[i] = ninf; }
#pragma unroll
            for (int i = 0; i < 16; ++i) mx = fmaxf(mx, a[i]);
            x[kb] = a;
        }
        mx = max32(mx);
        constexpr float C2 = 0.125f * LOG2E;
        const float mc = mx * C2; float l = 0.f;
#pragma unroll
        for (int kb = 0; kb < 5; ++kb)
#pragma unroll
            for (int i = 0; i < 16; ++i) { const float pe = __builtin_amdgcn_exp2f(x[kb][i] * C2 - mc); x[kb][i] = pe; l += pe; }
        l = sum32(l);
        f32x16 o[2];
#pragma unroll
        for (int dbk = 0; dbk < 2; ++dbk) o[dbk] = (f32x16){0.f, 0.f, 0.f, 0.f, 0.f, 0.f, 0.f, 0.f, 0.f, 0.f, 0.f, 0.f, 0.f, 0.f, 0.f, 0.f};
        bf16x8 vf[2][2];
#pragma unroll
        for (int dbk = 0; dbk < 2; ++dbk) vf[0][dbk] = ld_tr_perm(L + DL_VI, DPV, 32 * wave, dbk * 32, lane);
#pragma unroll
        for (int idx = 0; idx < 10; ++idx) { const int kb = idx >> 1, s = idx & 1;
            if (idx < 9) {
#pragma unroll
                for (int dbk = 0; dbk < 2; ++dbk) vf[(idx + 1) & 1][dbk] = ld_tr_perm(L + DL_VI, DPV, 32 * wave + 16 * (idx + 1), dbk * 32, lane); }
            const bf16x8 pa = PACK_STEP(x[kb], s);
#pragma unroll
            for (int dbk = 0; dbk < 2; ++dbk) o[dbk] = MFMA32(pa, vf[idx & 1][dbk], o[dbk]); }
        LAS float* lw = (LAS float*)(L + DL_LW + wave * 256);
        const float lse = mx * 0.125f + LN2 * __builtin_amdgcn_logf(l);
        if (h2 == 0) { lw[r] = l; lw[32 + r] = lse; }
        WG_BAR();
        LAS unsigned char* st = L + DL_ST + wave * 32 * DPK;
#pragma unroll
        for (int i = 0; i < 16; ++i) { const float rl = __builtin_amdgcn_rcpf(lw[crow(i, h2)]);
#pragma unroll
            for (int dbk = 0; dbk < 2; ++dbk) *(LAS bf16*)(st + crow(i, h2) * DPK + (dbk * 32 + r) * 2) = cvt1(o[dbk][i] * rl); }
        const size_t tokbase = (size_t)t.b * SEQ;
        if (!FUSE) {
            bf16* odp = OD + (size_t)t.p * M * 512;
#pragma unroll
            for (int j = 0; j < 4; ++j) { const int c = lane + 64 * j, row = c >> 3, cc = c & 7; const size_t tok = tokbase + (size_t)(t.q0 + 32 * wave + row) * t.dil + t.res;
                *(GAS v4u*)(odp + tok * 512 + t.head * 64 + cc * 8) = *(const LAS v4u*)(st + row * DPK + cc * 16); }
            if (h2 == 0) { const size_t tok = tokbase + (size_t)(t.q0 + 32 * wave + r) * t.dil + t.res; LSE[((size_t)t.p * M + tok) * 8 + t.head] = lse; }
        } else {
#pragma unroll
            for (int j = 0; j < 4; ++j) { const int c = lane + 64 * j, row = c >> 3, cc = c & 7; const size_t tok = tokbase + (size_t)(t.q0 + 32 * wave + row);
                const float l0 = lw[32 + row], l1 = ((const GAS float*)LSE)[((size_t)M + tok) * 8 + t.head], l2 = ((const GAS float*)LSE)[((size_t)2 * M + tok) * 8 + t.head];
                const v4u a = *(const LAS v4u*)(st + row * DPK + cc * 16), bq = *(const GAS v4u*)(OD + ((size_t)M + tok) * 512 + t.head * 64 + cc * 8), cq = *(const GAS v4u*)(OD + ((size_t)2 * M + tok) * 512 + t.head * 64 + cc * 8);
                const float mxl = fmaxf(l0, fmaxf(l1, l2));
                float w0 = __builtin_amdgcn_exp2f((l0 - mxl) * LOG2E), w1 = __builtin_amdgcn_exp2f((l1 - mxl) * LOG2E), w2 = __builtin_amdgcn_exp2f((l2 - mxl) * LOG2E);
                const float rs = __builtin_amdgcn_rcpf(w0 + w1 + w2); w0 *= rs; w1 *= rs; w2 *= rs;
                v4u ov;
#pragma unroll
                for (int i = 0; i < 4; ++i) ov[i] = cvtpk(w0 * bflo(a[i]) + w1 * bflo(bq[i]) + w2 * bflo(cq[i]), w0 * bfhi(a[i]) + w1 * bfhi(bq[i]) + w2 * bfhi(cq[i]));
                *(GAS v4u*)(CAT + tok * D + 512 + t.head * 64 + cc * 8) = ov; }
        }
        WG_BAR();
    }
}
constexpr int DIL_TILES12 = 2048, DIL_TILES0 = 1024;
__device__ __forceinline__ void even_phase_a(const Frame& F0) {
    const Frame F = relaunder(F0);
    unsigned char* ws = WSP();
    const bf16* P = (const bf16*)(ws + WS_ACT); bf16* RKV = (bf16*)OUTP(); bf16* OD = (bf16*)(ws + WS_OD); float* LSE = (float*)((unsigned char*)OUTP() + OUT_LSE);
    ret_phase_a_items(F, P, RKV);
    dil_tiles<false>(F, F.bid, DIL_TILES12, F.G, P, OD, LSE, nullptr);
}
__device__ __forceinline__ void even_phase_b(const Frame& F0) {
    const Frame F = relaunder(F0);
    unsigned char* ws = WSP();
    const bf16* P = (const bf16*)(ws + WS_ACT); bf16* RKV = (bf16*)OUTP(); bf16* OD = (bf16*)(ws + WS_OD); float* LSE = (float*)((unsigned char*)OUTP() + OUT_LSE);
    ret_scan(F, RKV);
    dil_tiles<true>(F, F.bid, DIL_TILES0, F.G, P, OD, LSE, (bf16*)(ws + WS_CAT));
}
__device__ __forceinline__ void even_phase_c(const Frame& F0) {
    const Frame F = relaunder(F0);
    unsigned char* ws = WSP();
    const bf16* P = (const bf16*)(ws + WS_ACT); const bf16* RKV = (const bf16*)OUTP(); const bf16* OD = (const bf16*)(ws + WS_OD); const float* LSE = (const float*)((unsigned char*)OUTP() + OUT_LSE); bf16* CAT = (bf16*)(ws + WS_CAT);
    ret_phase_c_items(F, P, RKV, CAT);
}

static_assert(WS_X8 == WS_OD, "the e4m3 residual copy overlays the dilated-output buffer");
__global__ void __launch_bounds__(NTHREADS, 2) fwd_kernel(Args args) {
    extern __shared__ __attribute__((aligned(16))) unsigned char lds[];
    Frame F;
    F.lds = (LAS unsigned char*)lds;
    F.wave = __builtin_amdgcn_readfirstlane((int)(threadIdx.x >> 6)); F.lane = hw_lane(); F.tid = F.wave * 64 + F.lane; F.G = gridDim.x; F.bid = blockIdx.x;
    for (int u = F.tid; u < (LDS_BYTES - LDSCTL_OFF) / 4; u += NTHREADS) ((LAS unsigned*)(F.lds + LDSCTL_OFF))[u] = 0u;
    __syncthreads();
    if (F.tid < N_PTRS) { const unsigned long long v = (F.tid < 17) ? (unsigned long long)args.in[F.tid] : (F.tid == 17 ? (unsigned long long)args.out : (unsigned long long)args.ws);
        ((LAS unsigned*)(F.lds + PTR_OFF))[2 * F.tid] = (unsigned)v; ((LAS unsigned*)(F.lds + PTR_OFF))[2 * F.tid + 1] = (unsigned)(v >> 32); }
    __syncthreads();
    (void)xcd_barrier_post((unsigned*)(WSP() + WS_CTL) + CW_BAR, (volatile LAS unsigned*)(F.lds + MISC_OFF) + 8, F.tid);
#define GRID_BAR() do { XcdBarrier bar_; bar_.bar = (unsigned*)(WSP() + WS_CTL) + CW_BAR; bar_.x = (unsigned)__builtin_amdgcn_readfirstlane((int)xb_xcc_id()); \
        int mo_ = MISC_OFF + 32; asm volatile("" : "+s"(mo_)); bar_.st = (volatile LAS unsigned*)(F.lds + mo_); int t_ = F.wave * 64 + hw_lane_v(); xcd_barrier<0>(bar_, t_); } while (0)
#ifndef XCD_BAR_MODE
#define XCD_BAR_MODE 2
#endif
#ifdef NO_XCD_LOCAL
#define XCD_BAR() GRID_BAR()
#else
#define XCD_BAR() do { XcdBarrier bar_; bar_.bar = (unsigned*)(WSP() + WS_CTL) + CW_BAR; bar_.x = (unsigned)__builtin_amdgcn_readfirstlane((int)xb_xcc_id()); \
        int mo_ = MISC_OFF + 32; asm volatile("" : "+s"(mo_)); bar_.st = (volatile LAS unsigned*)(F.lds + mo_); int t_ = F.wave * 64 + hw_lane_v(); xcd_barrier<XCD_BAR_MODE>(bar_, t_); } while (0)
#endif
#define XB ((bf16*)(WSP() + WS_XB))
#define ACT ((bf16*)(WSP() + WS_ACT))
#define CAT ((bf16*)(WSP() + WS_CAT))
#define SSP ((float*)(WSP() + WS_SSP))
#define WPTR(off) ((const bf16*)(WSP() + (off)))

    float pro_s0; const float pro_s1 = i8_scales(F, pro_s0);
    prologue_rows(F, pro_s0);
    convert_weights(F, 0, 0, pro_s0, pro_s1);
    GRID_BAR();
    for (int s = 0; s < 8; ++s) {
        const int l = s >> 1; const bool post = (s & 1) != 0;
        if (I8ASLOT(s) && s != 0) { quant_rows(F, lnd(s)); XCD_BAR(); }
        {
            pg8::Gemm g{XB, WPTR(post ? W_GU1 : W_GU0), M, 2 * FF, D}; pg8::StaticOrder S; S.init(M, 2 * FF, lnd(F.G), lnd(F.bid));
            pg8::EpiSwiGLU E{ACT, FF, SSP, 1.0f};
            if (I8ASLOT(s)) {
                pg8::Gemm g8{(const bf16*)XB8, WPTR(post ? W_GU1 : W_GU0), M, 2 * FF, D};
                if (F8SLOT(s)) { pg8::EpiSwiGLU8I E8{ACT, FF, SSP, 1.0f}; pg8::gemm_phase<pg8::EpiSwiGLU8I, pg8::StaticOrder, true, true, false, true>(F.lds + RING_OFF, g8, S, E8, lnd(F.wave)); }
                else { pg8::EpiSwiGLUI EI{ACT, FF, SSP, 1.0f}; pg8::gemm_phase<pg8::EpiSwiGLUI, pg8::StaticOrder, true, true, false, true>(F.lds + RING_OFF, g8, S, EI, lnd(F.wave)); } }
            else if (F8ASLOT(s)) { pg8::Gemm g8{(const bf16*)XB8, WPTR(post ? W_GU1 : W_GU0), M, 2 * FF, D}; pg8::EpiSwiGLU8 E8{ACT, FF, SSP, 1.0f / (pg8::F8_XSCALE * pg8::F8_GUSCALE)};
                pg8::gemm_phase<pg8::EpiSwiGLU8, pg8::StaticOrder, true, true, true>(F.lds + RING_OFF, g8, S, E8, lnd(F.wave)); }
            else if (F8SLOT(s)) { pg8::EpiSwiGLU8 E8{ACT, FF, SSP, 1.0f}; pg8::gemm_phase<pg8::EpiSwiGLU8, pg8::StaticOrder, true, true>(F.lds + RING_OFF, g, S, E8, lnd(F.wave)); }
            else pg8::gemm_phase<pg8::EpiSwiGLU, pg8::StaticOrder, true, true>(F.lds + RING_OFF, g, S, E, lnd(F.wave));
            XCD_BAR();
        }
        {
            const bool do_conv = post ? (l + 1 < DEPTH) : (l >= 1); const int conv_l = post ? l + 1 : l, conv_part = post ? 1 : 2; const int grp = (lnd(F.bid) >> 3) & 1;
            for (int pass = 0; pass < 3; ++pass) {
                if (pass == 1) {
                    pg8::Gemm g{ACT, WPTR(post ? W_D1 : W_D0), M, D, FF}; pg8::RevOrder S; S.init(M, D, lnd(F.G), lnd(F.bid));
                    if (F8SLOT(s)) { pg8::EpiResid E{XB, SSP, 0.5f / (pg8::F8_HSCALE * pg8::F8_WSCALE), (post && F8ASLOT(s + 1)) ? XB8_D : 0}; pg8::gemm_phase<pg8::EpiResid, pg8::RevOrder, true, true, true>(F.lds + RING_OFF, g, S, E, lnd(F.wave)); }
                    else { pg8::EpiResid E{XB, SSP, 0.5f, (post && F8ASLOT(s + 1)) ? XB8_D : 0};
                    pg8::gemm_phase<pg8::EpiResid, pg8::RevOrder, true, true>(F.lds + RING_OFF, g, S, E, lnd(F.wave)); }
                } else if (do_conv && ((pass == 0) == (grp == 1))) {
                    convert_weights(F, conv_l, conv_part);
                    __syncthreads();
                }
            }
            GRID_BAR();
        }
        if (!post) {
            const bool odd = (l & 1) != 0; const int nin = odd ? 3072 : EVEN_IN;
            {
                pg8::Gemm g{XB, WPTR(W_IN), M, nin, D}; pg8::StaticOrder S; S.init(M, nin, lnd(F.G), lnd(F.bid));
                pg8::EpiInProj E{ACT, nin, SSP, (const float*)(WSP() + TAB_RC), (const float*)(WSP() + TAB_RS), (const float*)(WSP() + TAB_DC), (const float*)(WSP() + TAB_DS), odd ? 0 : 1};
                pg8::gemm_phase<pg8::EpiInProj, pg8::StaticOrder, true, true>(F.lds + RING_OFF, g, S, E, lnd(F.wave));
            }
            if (odd) gla_alow(F);
            GRID_BAR();
            if (!odd) { even_phase_a(F); GRID_BAR(); even_phase_b(F); GRID_BAR(); even_phase_c(F); }
            else { gla_phase_a(F, l >> 1); GRID_BAR(); gla_phase_b(F); GRID_BAR(); gla_phase_c(F, l >> 1); }
            GRID_BAR();
            {
                pg8::Gemm g{CAT, WPTR(W_OUT), M, D, D}; pg8::StaticOrder S; S.init(M, D, lnd(F.G), lnd(F.bid));
                pg8::EpiResid E{XB, SSP, 1.0f, F8ASLOT(s + 1) ? XB8_D : 0};
                pg8::gemm_phase<pg8::EpiResid, pg8::StaticOrder, true, true>(F.lds + RING_OFF, g, S, E, lnd(F.wave));
                XCD_BAR();
            }
        }
    }
    final_norm(F);
}

extern "C" void kernel_launch(void* const* d_in, const int* in_sizes, int n_in, void* d_out, int out_size, void* d_ws, size_t ws_size, hipStream_t stream) {
    static int grid = 0;
    if (grid == 0) {
        if (n_in != 17 || in_sizes[0] != M * D || out_size != M * D || ws_size < WS_END2) { fprintf(stderr, "kernel_launch: unexpected shapes (n_in %d, in0 %d, out %d, ws %zu)\n", n_in, n_in > 0 ? in_sizes[0] : -1, out_size, ws_size); grid = -1; return; }
        int dev = 0, cus = 0, per_cu = 0;
        if (hipGetDevice(&dev) != hipSuccess || hipDeviceGetAttribute(&cus, hipDeviceAttributeMultiprocessorCount, dev) != hipSuccess) { grid = -1; return; }
        if (hipFuncSetAttribute((const void*)fwd_kernel, hipFuncAttributeMaxDynamicSharedMemorySize, LDS_BYTES) != hipSuccess) { fprintf(stderr, "kernel_launch: hipFuncSetAttribute failed\n"); grid = -1; return; }
        if (hipOccupancyMaxActiveBlocksPerMultiprocessor(&per_cu, (const void*)fwd_kernel, NTHREADS, LDS_BYTES) != hipSuccess || per_cu < 1) { fprintf(stderr, "kernel_launch: occupancy query reports %d\n", per_cu); }
        (void)hipGetLastError();
        grid = cus;
        if (grid != 256) fprintf(stderr, "kernel_launch: %d CUs (expected 256)\n", grid);
    }
    if (grid < 0) return;
    if (hipMemsetAsync((char*)d_ws + WS_CTL, 0, CTL_ZERO_BYTES, stream) != hipSuccess) return;
    Args a{};
    for (int i = 0; i < 17; ++i) a.in[i] = (const float*)d_in[i];
    a.out = (float*)d_out; a.ws = (unsigned char*)d_ws;
    hipLaunchKernelGGL(fwd_kernel, dim3(grid), dim3(NTHREADS), LDS_BYTES, stream, a);
}
```

```cpp
#include <hip/hip_runtime.h>
#include <cstdio>
#include <cstdint>
#include <cmath>
template <int K> __device__ __forceinline__ float xsw(float v) { static_assert(K == 1 || K == 2 || K == 4 || K == 8 || K == 16, "xor mask inside a 32-lane half");
    return __builtin_bit_cast(float, __builtin_amdgcn_ds_swizzle(__builtin_bit_cast(int, v), 0x1F | (K << 10))); }
__device__ __forceinline__ float sum32(float v) { const unsigned u = __builtin_bit_cast(unsigned, v); auto rr = __builtin_amdgcn_permlane32_swap(u, u, false, false); return __builtin_bit_cast(float, (unsigned)rr[0]) + __builtin_bit_cast(float, (unsigned)rr[1]); }
__device__ __forceinline__ float max32(float v) { const unsigned u = __builtin_bit_cast(unsigned, v); auto rr = __builtin_amdgcn_permlane32_swap(u, u, false, false); return fmaxf(__builtin_bit_cast(float, (unsigned)rr[0]), __builtin_bit_cast(float, (unsigned)rr[1])); }
__device__ __forceinline__ float oth32(float v, int h) { const unsigned u = __builtin_bit_cast(unsigned, v); auto rr = __builtin_amdgcn_permlane32_swap(u, u, false, false); return __builtin_bit_cast(float, (unsigned)(h ? rr[0] : rr[1])); }
#ifndef PG8_WGM
#define PG8_WGM 8
#endif
namespace pg8 {
#define PG8_LAS __attribute__((address_space(3)))
typedef unsigned short bf16_t;
typedef short bf16x8 __attribute__((ext_vector_type(8)));
typedef float f32x4 __attribute__((ext_vector_type(4)));
typedef unsigned u32x4 __attribute__((ext_vector_type(4)));
constexpr int BM = 256, BK = 64, HALF = 128, HTB = HALF * BK * 2  , STAGE_BYTES = 8 * HTB, NXCD = 8, WGM = PG8_WGM;

__host__ __device__ __forceinline__ int lds_byte(int r, int c) { const int st = (r >> 4) * 2 + (c >> 5), rr = r & 15, cc = c & 31, ob = rr * 64 + cc * 2; return st * 1024 + (ob ^ (((ob >> 9) & 1) << 5)); }
__host__ __device__ __forceinline__ void stage_rc(int b, int& R, int& C) { const int st = b / 1024, sb = b % 1024, swz = sb ^ (((sb >> 9) & 1) << 5); R = (st >> 1) * 16 + swz / 64; C = (st & 1) * 32 + (swz % 64) / 2; }
__host__ __device__ __forceinline__ int perm32(int rho) { const int n = rho >> 4, i = rho & 15; return 8 * (i >> 2) + 4 * n + (i & 3); }

struct Unit { int pm, pn; };
struct Gemm { const bf16_t* A; const bf16_t* Bt; int M, N, K; };

struct StaticOrder {
    int nM, nN, nwg, G, c;
    __host__ __device__ void init(int M, int N, int G_, int c_) { nM = M / BM; nN = N / BM; nwg = nM * nN; G = G_; c = c_; }
    __host__ __device__ bool next(int i, Unit& u) const {
        const long L = (long)i * G + c; if (L >= nwg) return false;
        int wgid = (int)L; { const int q = nwg / NXCD, r = nwg % NXCD, xcd = wgid % NXCD, off = wgid / NXCD; wgid = (xcd < r ? xcd * (q + 1) : r * (q + 1) + (xcd - r) * q) + off; }
        const int nig = WGM * nN, gid = wgid / nig, fm = gid * WGM, gsz = (nM - fm) < WGM ? (nM - fm) : WGM;
        u.pm = fm + ((wgid % nig) % gsz); u.pn = (wgid % nig) / gsz; return true;
    }
    __device__ __forceinline__ void a_ready(const Unit&) const {}
    __device__ __forceinline__ void done(const Unit&) const {}
};
struct RevOrder : StaticOrder {
    __host__ __device__ bool next(int i, Unit& u) const { const int rounds = nwg / G; if (i >= rounds) return false; return StaticOrder::next(rounds - 1 - i, u); }
};

__device__ __forceinline__ unsigned cvt_pk_bf16(float lo, float hi) { unsigned r; asm volatile("v_cvt_pk_bf16_f32 %0, %1, %2" : "=v"(r) : "v"(lo), "v"(hi)); return r; }
constexpr int MROWS = 32768;
constexpr float RMS_EPS = 1e-6f;
__device__ __forceinline__ float c1024_() { float c = 1.0f / 1024.0f; asm volatile("" : "+v"(c)); return c; }
__device__ __forceinline__ void row_rstd(float (&rs)[2][4], const float* ssp, const Unit& u, int wr, int fr, int fq) {
#pragma unroll
    for (int ai = 0; ai < 2; ++ai)
#pragma unroll
        for (int m = 0; m < 4; ++m) {
            const int row = u.pm * BM + ai * HALF + wr * 64 + m * 16 + fr;
            const f32x4 p = *(const f32x4*)(ssp + (size_t)row * 16 + 4 * fq);
            float s = (p[0] + p[1]) + (p[2] + p[3]);
            s += xsw<16>(s); s = sum32(s);
            rs[ai][m] = __builtin_amdgcn_rsqf(s * c1024_() + RMS_EPS);
        }
}
struct RowPre { PG8_LAS unsigned char* tab; Unit nxt; bool has_next; int ui; };
__device__ __forceinline__ void rowpre_get(float (&rs)[2][4], const float* ssp, const Unit& u, const RowPre& rp, int wr, int fr, int fq) {
    const PG8_LAS float* t = (const PG8_LAS float*)rp.tab + (rp.ui & 1) * 128 + fr;
#pragma unroll
    for (int ai = 0; ai < 2; ++ai)
#pragma unroll
        for (int m = 0; m < 4; ++m) rs[ai][m] = t[(ai * 4 + m) * 16];
}
__device__ __forceinline__ void rowpre_issue(f32x4 (&p)[2][4], const float* ssp, const RowPre& rp, int wr, int fr, int fq) {
#pragma unroll
    for (int ai = 0; ai < 2; ++ai)
#pragma unroll
        for (int m = 0; m < 4; ++m) p[ai][m] = *(const f32x4*)(ssp + (size_t)(rp.nxt.pm * BM + ai * HALF + wr * 64 + m * 16 + fr) * 16 + 4 * fq);
}
__device__ __forceinline__ void rowpre_park(const f32x4 (&p)[2][4], const RowPre& rp, int fr, int fq) {
    PG8_LAS float* t = (PG8_LAS float*)rp.tab + ((rp.ui + 1) & 1) * 128 + fr;
#pragma unroll
    for (int ai = 0; ai < 2; ++ai)
#pragma unroll
        for (int m = 0; m < 4; ++m) { float s = (p[ai][m][0] + p[ai][m][1]) + (p[ai][m][2] + p[ai][m][3]); s += xsw<16>(s); s = sum32(s);
            if (fq == 0) t[(ai * 4 + m) * 16] = __builtin_amdgcn_rsqf(s * c1024_() + RMS_EPS); }
}
__device__ __forceinline__ void rowpre_prime_issue(f32x4 (&p)[2][4], const float* ssp, const Unit& u, int wr, int fr, int fq) {
#pragma unroll
    for (int ai = 0; ai < 2; ++ai)
#pragma unroll
        for (int m = 0; m < 4; ++m) p[ai][m] = *(const f32x4*)(ssp + (size_t)(u.pm * BM + ai * HALF + wr * 64 + m * 16 + fr) * 16 + 4 * fq);
}
__device__ __forceinline__ void rowpre_prime_park(const f32x4 (&p)[2][4], PG8_LAS unsigned char* tab, int fr, int fq) {
    PG8_LAS float* t = (PG8_LAS float*)tab + fr;
#pragma unroll
    for (int ai = 0; ai < 2; ++ai)
#pragma unroll
        for (int m = 0; m < 4; ++m) { float s = (p[ai][m][0] + p[ai][m][1]) + (p[ai][m][2] + p[ai][m][3]); s += xsw<16>(s); s = sum32(s);
            if (fq == 0) t[(ai * 4 + m) * 16] = __builtin_amdgcn_rsqf(s * c1024_() + RMS_EPS); }
}
__device__ __forceinline__ float silu_f(float g) { return g * __builtin_amdgcn_rcpf(1.0f + __builtin_amdgcn_exp2f(-1.4426950408889634f * g)); }

constexpr float F8_XSCALE = 8.0f, F8_GUSCALE = 16.0f;
constexpr float F8_HSCALE = 4.0f, F8_WSCALE = 32.0f;
template <bool OUT8, bool ACCI = false> struct EpiSwiGLUT {
    static constexpr bool PERM = true, AFTER_DRAIN = false, NEEDS_RSTD = true;
    bf16_t* H; int ldh; const float* ssp; float ascale;
    __device__ __forceinline__ void operator()(const f32x4 (&acc)[2][2][4][2], const Unit& u, int wr, int wc, int fr, int fq, const RowPre& rp) const {
        float rs[2][4]; rowpre_get(rs, ssp, u, rp, wr, fr, fq);
        f32x4 pre[2][4]; rowpre_issue(pre, ssp, rp, wr, fr, fq);
        const int col0 = u.pn * HALF + wc * 32 + 8 * fq;
#pragma unroll
        for (int ai = 0; ai < 2; ++ai)
#pragma unroll
            for (int m = 0; m < 4; ++m) {
                const int row = u.pm * BM + ai * HALF + wr * 64 + m * 16 + fr; const float r = rs[ai][m] * ascale, rn = -1.4426950408889634f * r, rr = OUT8 ? r * r * F8_HSCALE : r * r;
                float h[8];
                typedef float f32x2 __attribute__((ext_vector_type(2)));
#pragma unroll
                for (int n = 0; n < 2; ++n)
#pragma unroll
                    for (int i = 0; i < 4; i += 2) {
                        float g0 = acc[ai][0][m][n][i], g1 = acc[ai][0][m][n][i + 1], u0 = acc[ai][1][m][n][i], u1 = acc[ai][1][m][n][i + 1];
                        if constexpr (ACCI) { g0 = (float)__builtin_bit_cast(int, g0); g1 = (float)__builtin_bit_cast(int, g1); u0 = (float)__builtin_bit_cast(int, u0); u1 = (float)__builtin_bit_cast(int, u1); }
                        const f32x2 G = {g0, g1}, U = {u0, u1};
                        const f32x2 t = G * rn; f32x2 e; e.x = __builtin_amdgcn_exp2f(t.x); e.y = __builtin_amdgcn_exp2f(t.y);
                        const f32x2 d = e + 1.0f; f32x2 sg; sg.x = __builtin_amdgcn_rcpf(d.x); sg.y = __builtin_amdgcn_rcpf(d.y);
                        const f32x2 hv = ((G * U) * rr) * sg; h[4 * n + i] = hv.x; h[4 * n + i + 1] = hv.y;
                    }
                if constexpr (OUT8) {
                    int w0 = __builtin_amdgcn_cvt_pk_fp8_f32(h[0], h[1], 0, false); w0 = __builtin_amdgcn_cvt_pk_fp8_f32(h[2], h[3], w0, true);
                    int w1 = __builtin_amdgcn_cvt_pk_fp8_f32(h[4], h[5], 0, false); w1 = __builtin_amdgcn_cvt_pk_fp8_f32(h[6], h[7], w1, true);
                    typedef int i32x2 __attribute__((ext_vector_type(2)));
                    *(i32x2*)((unsigned char*)H + (size_t)row * ldh + col0) = (i32x2){w0, w1};
                } else {
                u32x4 w; w.x = cvt_pk_bf16(h[0], h[1]); w.y = cvt_pk_bf16(h[2], h[3]); w.z = cvt_pk_bf16(h[4], h[5]); w.w = cvt_pk_bf16(h[6], h[7]);
                *(u32x4*)(H + (size_t)row * ldh + col0) = w;
                }
                asm volatile("" ::: "memory");
            }
        rowpre_park(pre, rp, fr, fq);
    }
};
typedef EpiSwiGLUT<false> EpiSwiGLU;
typedef EpiSwiGLUT<true> EpiSwiGLU8;
typedef EpiSwiGLUT<false, true> EpiSwiGLUI;
typedef EpiSwiGLUT<true, true> EpiSwiGLU8I;
struct EpiInProj {
    static constexpr bool PERM = true, AFTER_DRAIN = false, NEEDS_RSTD = true;
    bf16_t* O; int ldc; const float* ssp; const float* rc; const float* rs; const float* dc; const float* ds; int even;
    __device__ __forceinline__ void operator()(const f32x4 (&acc)[2][2][4][2], const Unit& u, int wr, int wc, int fr, int fq, const RowPre& rp) const {
        float rsd[2][4]; rowpre_get(rsd, ssp, u, rp, wr, fr, fq);
        f32x4 pre[2][4]; rowpre_issue(pre, ssp, rp, wr, fr, fq);
        const int col0 = u.pn * BM + wc * 32 + 8 * fq;
        const int kind = even ? (u.pn < 4 ? 1 : ((u.pn >= 8 && u.pn < 12) ? 2 : 0)) : 0;
        const float ksc = (kind == 1 && u.pn >= 2) ? 0.08838834764831845f : 1.0f;
        const bool rot2 = (kind == 2) && ((wc & 1) == 0) && (fq < 2);
        const int b_ = (u.pm * BM) >> 12, t0 = (u.pm * BM) & 4095;
        size_t hb[2]; int dh, d0[2];
#pragma unroll
        for (int bj = 0; bj < 2; ++bj) {
            int c0, nh, head;
            if (even) { c0 = (u.pn >> 1) * 512; if (u.pn < 8) { nh = 4; dh = 128; head = (u.pn & 1) * 2 + bj; d0[bj] = wc * 32; } else { nh = 8; dh = 64; head = (u.pn & 1) * 4 + bj * 2 + (wc >> 1); d0[bj] = (wc & 1) * 32; } }
            else if (u.pn < 4) { c0 = (u.pn >> 1) * 512; nh = 4; dh = 128; head = (u.pn & 1) * 2 + bj; d0[bj] = wc * 32; }
            else if (u.pn < 12) { c0 = u.pn < 8 ? 1024 : 2048; nh = 4; dh = 256; head = u.pn & 3; d0[bj] = bj * 128 + wc * 32; }
            else { c0 = 3072; nh = 1; dh = 256; head = 0; d0[bj] = bj * 128 + wc * 32; }
            hb[bj] = (size_t)c0 * MROWS + ((size_t)(b_ * nh + head) * 4096 + t0) * dh;
        }
        const float* tc = (kind == 1) ? rc + wc * 16 + 4 * fq : dc + 4 * (fq & 1);
        const float* ts = (kind == 1) ? rs + wc * 16 + 4 * fq : ds + 4 * (fq & 1);
        const int tstride = (kind == 1) ? 64 : 8;
        typedef float f32x2 __attribute__((ext_vector_type(2)));
        if (kind == 0) {
#pragma unroll
            for (int ai = 0; ai < 2; ++ai)
#pragma unroll
                for (int m = 0; m < 4; ++m) {
                    const int row = u.pm * BM + ai * HALF + wr * 64 + m * 16 + fr; const float r = rsd[ai][m];
#pragma unroll
                    for (int bj = 0; bj < 2; ++bj) { const f32x4 v0 = acc[ai][bj][m][0] * r, v1 = acc[ai][bj][m][1] * r;
                        u32x4 w; w.x = cvt_pk_bf16(v0[0], v0[1]); w.y = cvt_pk_bf16(v0[2], v0[3]); w.z = cvt_pk_bf16(v1[0], v1[1]); w.w = cvt_pk_bf16(v1[2], v1[3]);
                        *(u32x4*)(O + hb[bj] + (size_t)(row - u.pm * BM) * dh + d0[bj] + 8 * fq) = w; }
                    asm volatile("" ::: "memory");
                }
        } else {
#pragma unroll
            for (int ai = 0; ai < 2; ++ai)
#pragma unroll
                for (int m = 0; m < 4; ++m) {
                    const int row = u.pm * BM + ai * HALF + wr * 64 + m * 16 + fr; const float r = rsd[ai][m] * ksc;
                    f32x4 c4 = {r, r, r, r}, s4 = {0.f, 0.f, 0.f, 0.f};
                    if (kind == 1 || rot2) { const int pos = row & 4095; c4 = *(const f32x4*)(tc + (size_t)pos * tstride) * r; s4 = *(const f32x4*)(ts + (size_t)pos * tstride) * r; }
#pragma unroll
                    for (int bj = 0; bj < 2; ++bj) { const f32x4 v0 = acc[ai][bj][m][0], v1 = acc[ai][bj][m][1];
                        const f32x2 a0 = {v0[0], v0[1]}, a1 = {v0[2], v0[3]}, a2 = {v1[0], v1[1]}, a3 = {v1[2], v1[3]};
                        const f32x2 b0 = {-v0[1], v0[0]}, b1 = {-v0[3], v0[2]}, b2 = {-v1[1], v1[0]}, b3 = {-v1[3], v1[2]};
                        const f32x2 o0 = a0 * c4[0] + b0 * s4[0], o1 = a1 * c4[1] + b1 * s4[1], o2 = a2 * c4[2] + b2 * s4[2], o3 = a3 * c4[3] + b3 * s4[3];
                        u32x4 w; w.x = cvt_pk_bf16(o0.x, o0.y); w.y = cvt_pk_bf16(o1.x, o1.y); w.z = cvt_pk_bf16(o2.x, o2.y); w.w = cvt_pk_bf16(o3.x, o3.y);
                        *(u32x4*)(O + hb[bj] + (size_t)(row - u.pm * BM) * dh + d0[bj] + 8 * fq) = w; }
                    asm volatile("" ::: "memory");
                }
        }
        rowpre_park(pre, rp, fr, fq);
    }
};
struct EpiResid {
    static constexpr bool PERM = true, AFTER_DRAIN = false, NEEDS_RSTD = false;
    bf16_t* xb; float* ssp; float scale; int x8d;
    __device__ __forceinline__ void operator()(const f32x4 (&acc)[2][2][4][2], const Unit& u, int wr, int wc, int fr, int fq, const RowPre&) const {
        const int col0 = u.pn * BM + wc * 32 + 8 * fq, rowb = u.pm * BM + wr * 64 + fr;
        u32x4 old[8][2];
#pragma unroll
        for (int g = 0; g < 8; ++g) { const size_t off = (size_t)(rowb + (g >> 2) * HALF + (g & 3) * 16) * 1024 + col0; old[g][0] = *(const u32x4*)(xb + off); old[g][1] = *(const u32x4*)(xb + off + HALF); }
#pragma unroll
        for (int g = 0; g < 8; ++g) {
            const int ai = g >> 2, m = g & 3, row = rowb + ai * HALF + m * 16; float ss = 0.f;
#pragma unroll
            for (int bj = 0; bj < 2; ++bj) { const size_t off = (size_t)row * 1024 + col0 + bj * HALF; const u32x4 o = old[g][bj];
                const f32x4 a0 = acc[ai][bj][m][0] * scale, a1 = acc[ai][bj][m][1] * scale;
                const float v0 = __builtin_bit_cast(float, o.x << 16) + a0[0], v1 = __builtin_bit_cast(float, o.x & 0xffff0000u) + a0[1], v2 = __builtin_bit_cast(float, o.y << 16) + a0[2], v3 = __builtin_bit_cast(float, o.y & 0xffff0000u) + a0[3];
                const float v4 = __builtin_bit_cast(float, o.z << 16) + a1[0], v5 = __builtin_bit_cast(float, o.z & 0xffff0000u) + a1[1], v6 = __builtin_bit_cast(float, o.w << 16) + a1[2], v7 = __builtin_bit_cast(float, o.w & 0xffff0000u) + a1[3];
                u32x4 w; w.x = cvt_pk_bf16(v0, v1); w.y = cvt_pk_bf16(v2, v3); w.z = cvt_pk_bf16(v4, v5); w.w = cvt_pk_bf16(v6, v7);
                *(u32x4*)(xb + off) = w;
                if (x8d) { int y0 = __builtin_amdgcn_cvt_pk_fp8_f32(v0 * F8_XSCALE, v1 * F8_XSCALE, 0, false); y0 = __builtin_amdgcn_cvt_pk_fp8_f32(v2 * F8_XSCALE, v3 * F8_XSCALE, y0, true);
                    int y1 = __builtin_amdgcn_cvt_pk_fp8_f32(v4 * F8_XSCALE, v5 * F8_XSCALE, 0, false); y1 = __builtin_amdgcn_cvt_pk_fp8_f32(v6 * F8_XSCALE, v7 * F8_XSCALE, y1, true);
                    typedef int i32x2r __attribute__((ext_vector_type(2))); *(i32x2r*)((unsigned char*)xb + x8d + off) = (i32x2r){y0, y1}; }
                ss += (v0 * v0 + v1 * v1) + (v2 * v2 + v3 * v3) + (v4 * v4 + v5 * v5) + (v6 * v6 + v7 * v7); }
            ss += xsw<16>(ss); ss = sum32(ss);
            if (fq == 0) ssp[(size_t)row * 16 + u.pn * 4 + wc] = ss;
        }
    }
};

typedef int pg8_v8i __attribute__((ext_vector_type(8)));
typedef int pg8_v4i __attribute__((ext_vector_type(4)));
__device__ __forceinline__ pg8_v8i pg8_cat(bf16x8 lo, bf16x8 hi) { const pg8_v4i a = __builtin_bit_cast(pg8_v4i, lo), b = __builtin_bit_cast(pg8_v4i, hi); return __builtin_shufflevector(a, b, 0, 1, 2, 3, 4, 5, 6, 7); }
template <class Epi, class Sched, bool ALIGN_EPI = false, bool SP2 = false, bool F8 = false, bool I8 = false>
__device__ __forceinline__ void gemm_phase(PG8_LAS unsigned char* lds, const Gemm g, const Sched& S, const Epi& E, int wave_in) {
    int tid_; { int l_; asm volatile("v_mbcnt_lo_u32_b32 %0, -1, 0\n\tv_mbcnt_hi_u32_b32 %0, -1, %0" : "=v"(l_)); tid_ = wave_in * 64 + l_; }
    const int tid = tid_, wid = __builtin_amdgcn_readfirstlane(tid >> 6), lane = tid & 63, wr = wid >> 2, wc = wid & 3, fr = lane & 15, fq = lane >> 4;
    constexpr int ES = (F8 || I8) ? 1 : 2;
    const int K = g.K, nt = K * ES / (BK * 2);
    unsigned voffA[2], voffB[2];
#pragma unroll
    for (int i = 0; i < 2; ++i) { int R, C; stage_rc(tid * 16 + i * 8192, R, C); const int Rb = Epi::PERM ? ((R & ~31) + perm32(R & 31)) : R;
        voffA[i] = (unsigned)(R * K * ES + C * 2); voffB[i] = (unsigned)(Rb * K * ES + C * 2); }
    const size_t kstep = (size_t)(BK * 2);
    const size_t hstep = (size_t)HALF * K * ES;
    const size_t tstep = 2 * hstep;
    const unsigned ldsw = (unsigned)wid * 1024u;
    const int aoff = lds_byte(wr * 64 + fr, fq * 8), boff = lds_byte(wc * 32 + fr, fq * 8);
#define PG8_SA(b, h) (((b) * 2 + (h)) * HTB)
#define PG8_SB(b, h) ((4 + (b) * 2 + (h)) * HTB)
#define PG8_STAGE(bufoff, gbase, voff) do { _Pragma("unroll") for (int _i = 0; _i < 2; ++_i) { if constexpr (F8) { unsigned vo_ = (voff)[0]; asm volatile("" : "+v"(vo_));     \
        __builtin_amdgcn_global_load_lds((const unsigned*)((const char*)(gbase) + (size_t)_i * 64 * K * ES + vo_), (PG8_LAS unsigned*)(lds + (bufoff) + ldsw + _i * 8192), 16, 0, 0); } else \
        __builtin_amdgcn_global_load_lds((const unsigned*)((const char*)(gbase) + (voff)[_i]), (PG8_LAS unsigned*)(lds + (bufoff) + ldsw + _i * 8192), 16, 0, 0); } } while (0)
#define PG8_LDA(dst, b, h) do { _Pragma("unroll") for (int m = 0; m < 4; ++m) _Pragma("unroll") for (int k = 0; k < 2; ++k) dst[m][k] = *(const PG8_LAS bf16x8*)(lds + PG8_SA(b, h) + aoff + m * 2048 + k * 1024); } while (0)
#define PG8_LDB(dst, b, h) do { _Pragma("unroll") for (int n = 0; n < 2; ++n) _Pragma("unroll") for (int k = 0; k < 2; ++k) dst[n][k] = *(const PG8_LAS bf16x8*)(lds + PG8_SB(b, h) + boff + n * 2048 + k * 1024); } while (0)
#define PG8_MMA(ai, bj, At, Bt) do { __builtin_amdgcn_s_setprio(1); if constexpr (F8) { _Pragma("unroll") for (int m = 0; m < 4; ++m) _Pragma("unroll") for (int n = 0; n < 2; ++n) \
        acc[ai][bj][m][n] = __builtin_amdgcn_mfma_scale_f32_16x16x128_f8f6f4(pg8_cat(Bt[n][0], Bt[n][1]), pg8_cat(At[m][0], At[m][1]), acc[ai][bj][m][n], 0, 0, 0, 0, 0, 0); } \
        else if constexpr (I8) { _Pragma("unroll") for (int m = 0; m < 4; ++m) _Pragma("unroll") for (int n = 0; n < 2; ++n) _Pragma("unroll") for (int k = 0; k < 2; ++k) \
        acc[ai][bj][m][n] = __builtin_bit_cast(f32x4, __builtin_amdgcn_mfma_i32_16x16x64_i8(__builtin_bit_cast(pg8_v4i, Bt[n][k]), __builtin_bit_cast(pg8_v4i, At[m][k]), __builtin_bit_cast(pg8_v4i, acc[ai][bj][m][n]), 0, 0, 0)); } \
        else { _Pragma("unroll") for (int m = 0; m < 4; ++m) _Pragma("unroll") for (int n = 0; n < 2; ++n) _Pragma("unroll") for (int k = 0; k < 2; ++k) \
        acc[ai][bj][m][n] = __builtin_amdgcn_mfma_f32_16x16x32_bf16(Bt[n][k], At[m][k], acc[ai][bj][m][n], 0, 0, 0); } __builtin_amdgcn_s_setprio(0); } while (0)
#define PG8_WAIT_V(n) asm volatile("s_waitcnt vmcnt(" #n ")" ::: "memory")
#define PG8_WAIT_L(n) asm volatile("s_waitcnt lgkmcnt(" #n ")" ::: "memory")
#define PG8_BAR __builtin_amdgcn_s_barrier()
#define PG8_SCHED __builtin_amdgcn_sched_barrier(0)
    Unit cur, nxt; int ui = 0;
    if (!S.next(0, cur)) return;
    f32x4 acc[2][2][4][2];
#pragma unroll
    for (int a = 0; a < 2; ++a)
#pragma unroll
        for (int b = 0; b < 2; ++b)
#pragma unroll
            for (int m = 0; m < 4; ++m)
#pragma unroll
                for (int n = 0; n < 2; ++n) acc[a][b][m][n] = (f32x4){0.f, 0.f, 0.f, 0.f};
    bf16x8 At[4][2], B0[2][2], B1[2][2];
    const char* cA = (const char*)g.A + (size_t)cur.pm * tstep; const char* cB = (const char*)g.Bt + (size_t)cur.pn * tstep;
    S.a_ready(cur);
    f32x4 p0[2][4];
    if constexpr (Epi::NEEDS_RSTD) rowpre_prime_issue(p0, E.ssp, cur, wr, fr, fq);
    if constexpr (SP2) {
        PG8_STAGE(PG8_SB(0, 0), cB, voffB); PG8_STAGE(PG8_SB(0, 1), cB + hstep, voffB); PG8_STAGE(PG8_SA(0, 0), cA, voffA); PG8_STAGE(PG8_SA(0, 1), cA + hstep, voffA);
        if constexpr (Epi::NEEDS_RSTD) rowpre_prime_park(p0, lds + STAGE_BYTES + wid * 1024, fr, fq);
        if (wr == 1) PG8_BAR;
        PG8_WAIT_V(2); PG8_BAR;
        PG8_STAGE(PG8_SB(1, 0), cB + kstep, voffB); PG8_STAGE(PG8_SA(1, 0), cA + kstep, voffA); PG8_STAGE(PG8_SB(1, 1), cB + hstep + kstep, voffB);
        PG8_WAIT_V(6); PG8_BAR;
    } else {
        PG8_STAGE(PG8_SB(0, 0), cB, voffB); PG8_STAGE(PG8_SA(0, 0), cA, voffA); PG8_STAGE(PG8_SB(0, 1), cB + hstep, voffB); PG8_STAGE(PG8_SA(0, 1), cA + hstep, voffA);
        if constexpr (Epi::NEEDS_RSTD) rowpre_prime_park(p0, lds + STAGE_BYTES + wid * 1024, fr, fq);
        if (wr == 1) PG8_BAR;
        PG8_WAIT_V(4); PG8_BAR;
        PG8_STAGE(PG8_SB(1, 0), cB + kstep, voffB); PG8_STAGE(PG8_SA(1, 0), cA + kstep, voffA); PG8_STAGE(PG8_SB(1, 1), cB + hstep + kstep, voffB);
        PG8_WAIT_V(6); PG8_BAR;
    }
    for (;;) {
        const bool has_next = S.next(ui + 1, nxt);
        const char* nA = has_next ? (const char*)g.A + (size_t)nxt.pm * tstep : cA; const char* nB = has_next ? (const char*)g.Bt + (size_t)nxt.pn * tstep : cB;
        for (int t = 0; t < nt; t += 2) {
            const bool last = (t == nt - 2);
            const char* a1 = cA + (size_t)(t + 1) * kstep;
            const char* a2 = last ? nA : cA + (size_t)(t + 2) * kstep; const char* b2 = last ? nB : cB + (size_t)(t + 2) * kstep;
            const char* a3 = a2 + kstep; const char* b3 = b2 + kstep;
            if (last && has_next) S.a_ready(nxt);
            if constexpr (SP2) {
            PG8_LDB(B0, 0, 0); PG8_LDB(B1, 0, 1); PG8_SCHED; PG8_LDA(At, 0, 0); PG8_STAGE(PG8_SA(1, 1), a1 + hstep, voffA);
            PG8_WAIT_V(8); PG8_WAIT_L(0); PG8_BAR; PG8_MMA(0, 0, At, B0); PG8_MMA(0, 1, At, B1); PG8_BAR; PG8_SCHED;
            PG8_LDA(At, 0, 1); PG8_STAGE(PG8_SB(0, 0), b2, voffB); PG8_STAGE(PG8_SB(0, 1), b2 + hstep, voffB); PG8_STAGE(PG8_SA(0, 0), a2, voffA);
            PG8_WAIT_V(8); PG8_WAIT_L(0); PG8_BAR; PG8_MMA(1, 0, At, B0); PG8_MMA(1, 1, At, B1); PG8_BAR; PG8_SCHED;
            PG8_LDB(B0, 1, 0); PG8_LDB(B1, 1, 1); PG8_SCHED; PG8_LDA(At, 1, 0); PG8_STAGE(PG8_SA(0, 1), a2 + hstep, voffA);
            PG8_WAIT_V(8); PG8_WAIT_L(0); PG8_BAR; PG8_MMA(0, 0, At, B0); PG8_MMA(0, 1, At, B1); PG8_BAR; PG8_SCHED;
            PG8_LDA(At, 1, 1); PG8_STAGE(PG8_SB(1, 0), b3, voffB); PG8_STAGE(PG8_SB(1, 1), b3 + hstep, voffB); PG8_STAGE(PG8_SA(1, 0), a3, voffA);
            PG8_WAIT_V(8); PG8_WAIT_L(0); PG8_BAR; PG8_MMA(1, 0, At, B0); PG8_MMA(1, 1, At, B1); PG8_BAR; PG8_SCHED;
            } else {
            PG8_LDB(B0, 0, 0); PG8_SCHED; PG8_LDA(At, 0, 0); PG8_STAGE(PG8_SA(1, 1), a1 + hstep, voffA);
            PG8_WAIT_L(8); PG8_BAR; PG8_WAIT_L(0); PG8_MMA(0, 0, At, B0); PG8_BAR; PG8_SCHED;
            PG8_LDB(B1, 0, 1); PG8_STAGE(PG8_SB(0, 0), b2, voffB);
            PG8_BAR; PG8_WAIT_L(0); PG8_MMA(0, 1, At, B1); PG8_BAR;
            PG8_LDA(At, 0, 1); PG8_STAGE(PG8_SA(0, 0), a2, voffA);
            PG8_BAR; PG8_WAIT_L(0); PG8_MMA(1, 0, At, B0); PG8_BAR; PG8_SCHED;
            PG8_STAGE(PG8_SB(0, 1), b2 + hstep, voffB);
            PG8_WAIT_V(6); PG8_BAR; PG8_MMA(1, 1, At, B1); PG8_BAR;
            PG8_LDB(B0, 1, 0); PG8_SCHED; PG8_LDA(At, 1, 0); PG8_STAGE(PG8_SA(0, 1), a2 + hstep, voffA);
            PG8_WAIT_L(8); PG8_BAR; PG8_WAIT_L(0); PG8_MMA(0, 0, At, B0); PG8_BAR; PG8_SCHED;
            PG8_LDB(B1, 1, 1); PG8_STAGE(PG8_SB(1, 0), b3, voffB);
            PG8_BAR; PG8_WAIT_L(0); PG8_MMA(0, 1, At, B1); PG8_BAR;
            PG8_LDA(At, 1, 1); PG8_STAGE(PG8_SA(1, 0), a3, voffA);
            PG8_BAR; PG8_WAIT_L(0); PG8_MMA(1, 0, At, B0); PG8_BAR; PG8_SCHED;
            PG8_STAGE(PG8_SB(1, 1), b3 + hstep, voffB);
            PG8_WAIT_V(6); PG8_BAR; PG8_MMA(1, 1, At, B1); PG8_BAR;
            }
        }
        if constexpr (ALIGN_EPI) { if (wr == 0) PG8_BAR; }
        if constexpr (!Epi::AFTER_DRAIN) {
            if constexpr (F8) { int l2; asm volatile("v_mbcnt_lo_u32_b32 %0, -1, 0\n\tv_mbcnt_hi_u32_b32 %0, -1, %0" : "=v"(l2));
                E(acc, cur, wr, wc, l2 & 15, l2 >> 4, RowPre{lds + STAGE_BYTES + wid * 1024, has_next ? nxt : cur, has_next, ui}); }
            else E(acc, cur, wr, wc, fr, fq, RowPre{lds + STAGE_BYTES + wid * 1024, has_next ? nxt : cur, has_next, ui});
            S.done(cur); }
        if (!has_next) break;
#pragma unroll
        for (int a = 0; a < 2; ++a)
#pragma unroll
            for (int b = 0; b < 2; ++b)
#pragma unroll
                for (int m = 0; m < 4; ++m)
#pragma unroll
                    for (int n = 0; n < 2; ++n) acc[a][b][m][n] = (f32x4){0.f, 0.f, 0.f, 0.f};
        cur = nxt; cA = nA; cB = nB; ++ui;
        if constexpr (ALIGN_EPI) { if (wr == 1) PG8_BAR; }
    }
    PG8_WAIT_V(0);
    if constexpr (!ALIGN_EPI) { if (wr == 0) PG8_BAR; }
    PG8_BAR;
    if constexpr (Epi::AFTER_DRAIN) { E.fused(acc, cur, wr, wc, fr, fq, lds, wid, lane); S.done(cur); }
#undef PG8_SA
#undef PG8_SB
#undef PG8_STAGE
#undef PG8_LDA
#undef PG8_LDB
#undef PG8_MMA
#undef PG8_WAIT_V
#undef PG8_WAIT_L
#undef PG8_BAR
#undef PG8_SCHED
}
}

constexpr int NWAVES = 8, NTHREADS = NWAVES * 64;
constexpr int BATCH = 8, SEQ = 4096, D = 1024, M = BATCH * SEQ, FF = 2816, DEPTH = 4;
constexpr int EVEN_IN = 3584, GLA_IN = 3088, GLA_INP = 3328;
static_assert(M == pg8::MROWS, "row count");
constexpr int E_RQ = 0, E_RK = 512, E_RV = 1024, E_RG = 1536, E_DQ = 2048, E_DK = 2560, E_DV = 3072;
constexpr int G_Q = 0, G_K = 512, G_V = 1024, G_R = 2048, G_A = 3072;
constexpr float EPS = 1e-6f;
#define HM(c0, nh, dh, b, h) ((size_t)(c0) * M + ((size_t)((b) * (nh) + (h)) * SEQ) * (dh))

constexpr size_t MiB = 1u << 20;
constexpr size_t WS_CTL = 0, CTL_ZERO_BYTES = 32768;
constexpr size_t WS_SSP = 1 * MiB;
constexpr size_t WS_TAB = 3 * MiB;
constexpr size_t TAB_RC = WS_TAB, TAB_RS = WS_TAB + 1 * MiB, TAB_DC = WS_TAB + 2 * MiB, TAB_DS = WS_TAB + 2 * MiB + 128 * 1024;
constexpr size_t WS_W = 8 * MiB;
constexpr size_t W_GU0 = WS_W, W_D0 = W_GU0 + (size_t)2 * FF * D * 2, W_GU1 = W_D0 + (size_t)D * FF * 2, W_D1 = W_GU1 + (size_t)2 * FF * D * 2,
                 W_IN = W_D1 + (size_t)D * FF * 2, W_OUT = W_IN + (size_t)EVEN_IN * D * 2, W_END = W_OUT + (size_t)D * D * 2;
constexpr size_t WS_XB = 56 * MiB;
constexpr size_t WS_ACT = 120 * MiB;
constexpr size_t WS_CAT = 344 * MiB;
constexpr size_t WS_END = 408 * MiB;
static_assert(W_END <= WS_XB && WS_XB + (size_t)M * D * 2 <= WS_ACT && WS_ACT + (size_t)M * EVEN_IN * 2 <= WS_CAT && WS_CAT + (size_t)M * D * 2 <= WS_END, "d_ws map");
constexpr int CW_BAR = 4096;

constexpr int RING_OFF = 0, RING_BYTES = 131072;
constexpr int LDSCTL_OFF = 161792, MISC_OFF = LDSCTL_OFF + 320, PTR_OFF = LDSCTL_OFF + 1024;
constexpr int LDS_BYTES = 163840;
static_assert(PTR_OFF + 19 * 8 <= LDS_BYTES && RING_BYTES <= LDSCTL_OFF, "LDS map");

#define GAS __attribute__((address_space(1)))
#define LAS __attribute__((address_space(3)))
typedef unsigned short bf16;
typedef unsigned v4u __attribute__((ext_vector_type(4)));
typedef float f32x4 __attribute__((ext_vector_type(4)));
typedef short bf16x8 __attribute__((ext_vector_type(8)));
typedef GAS unsigned gu32;
typedef GAS unsigned long long gu64;
#define RLX_AGENT __ATOMIC_RELAXED, __HIP_MEMORY_SCOPE_AGENT
#define LDS_WAIT() asm volatile("s_waitcnt lgkmcnt(0)" ::: "memory")
#define VM_WAIT() asm volatile("s_waitcnt vmcnt(0)" ::: "memory")
__device__ __forceinline__ unsigned long long rt() { return __builtin_amdgcn_s_memrealtime(); }
__device__ __forceinline__ unsigned f2bf(float f) { unsigned u = __builtin_bit_cast(unsigned, f); return (u + 0x7fffu + ((u >> 16) & 1u)) >> 16; }
__device__ __forceinline__ unsigned pk2(float lo, float hi) { return f2bf(lo) | (f2bf(hi) << 16); }

#define XB_TMO      128
#ifndef XB_MIS_EXPECT
#define XB_MIS_EXPECT 0u
#endif
#define XB_MIS      192
#define XB_XCNT(j)  (256  + 64 * (j))
#define XB_XSUB(j)  (1280 + 64 * (j))
#define XB_XGEN(j)  (2304 + 64 * (j))
#define XB_TOP      3328
#define XB_TOPGEN   3392
#define XB_TEAM(t)  (3520 + 8 * (t))
#define XCD_BAR_WORDS 4096
#define XB_SPIN_CAP (1u << 18)

__device__ __forceinline__ unsigned xb_ld(unsigned* p)              { return __hip_atomic_load(p, __ATOMIC_RELAXED, __HIP_MEMORY_SCOPE_AGENT); }
__device__ __forceinline__ unsigned xb_add(unsigned* p, unsigned v) { return __hip_atomic_fetch_add(p, v, __ATOMIC_RELAXED, __HIP_MEMORY_SCOPE_AGENT); }
__device__ __forceinline__ unsigned xb_xcc_id() { return (unsigned)__builtin_amdgcn_s_getreg((3 << 11) | 20) & 0xFu; }
#define XB_SPIN(cond, bar) do { unsigned _sp = 0; while (cond) { __builtin_amdgcn_s_sleep(1); \
    if ((++_sp & 255u) == 0u) { if (xb_ld(&(bar)[XB_TMO])) break; if (_sp > XB_SPIN_CAP) { atomicAdd(&(bar)[XB_TMO], 1u); break; } } } } while (0)

struct XcdBarrier {
    unsigned* bar; unsigned x;
    volatile LAS unsigned* st;
};

__device__ __forceinline__ XcdBarrier xcd_barrier_post(unsigned* bar, volatile LAS unsigned* st, int tid) {
    XcdBarrier b; b.bar = bar; b.x = xb_xcc_id(); b.st = st;
    if (tid == 0) { if ((blockIdx.x & 7u) != b.x) (void)xb_add(&bar[XB_MIS], 1u); (void)xb_add(&bar[XB_XCNT(b.x)], 1u); }
    return b;
}
__device__ __forceinline__ void xcd_barrier_complete(unsigned* bar, unsigned x, unsigned& nloc, unsigned& nx) {
    const unsigned G = gridDim.x * gridDim.y * gridDim.z;
    unsigned sum, cnt, mine, sp = 0u;
    for (;;) {
        sum = 0u; cnt = 0u; mine = 0u;
#pragma unroll
        for (unsigned j = 0; j < 16; ++j) { const unsigned c = xb_ld(&bar[XB_XCNT(j)]); sum += c; cnt += (c > 0u) ? 1u : 0u; mine = (j == x) ? c : mine; }
        if (sum == G) break;
        __builtin_amdgcn_s_sleep(1);
        if ((++sp & 255u) == 0u) { if (xb_ld(&bar[XB_TMO])) break; if (sp > XB_SPIN_CAP) { atomicAdd(&bar[XB_TMO], 1u); break; } }
    }
    nloc = mine > 0u ? mine : 1u; nx = cnt > 0u ? cnt : 1u;
}

template <int LOCAL = 0>
__device__ __forceinline__ void xcd_barrier(const XcdBarrier& b, int tid) {
    asm volatile("s_waitcnt vmcnt(0)" ::: "memory");
    __syncthreads();
    if (tid == 0) {
        unsigned* bar = b.bar;
        __builtin_amdgcn_s_waitcnt(0);
        unsigned nloc = b.st[0], nx = b.st[1];
        if (nloc == 0u) { xcd_barrier_complete(bar, b.x, nloc, nx); b.st[0] = nloc; b.st[1] = nx; }
        bool skip_top = false;
        if (LOCAL) { unsigned lk = b.st[2];
            if (lk == 0u) { lk = (xb_ld(&bar[XB_MIS]) == XB_MIS_EXPECT && nx == 8u && nloc == 32u && gridDim.x == 256u) ? 1u : 2u; b.st[2] = lk; }
            skip_top = lk == 1u; }
        if (LOCAL == 2 && skip_top) {
            unsigned* c = &bar[XB_TEAM((blockIdx.x & 7u) * 8u + ((blockIdx.x >> 3) & 7u))];
            const unsigned tgt = (xb_add(c, 1u) / 4u + 1u) * 4u;
            XB_SPIN(xb_ld(c) < tgt, bar);
            __builtin_amdgcn_fence(__ATOMIC_ACQUIRE, "agent");
            asm volatile("s_waitcnt vmcnt(0)" ::: "memory");
        } else {
        const unsigned old = xb_add(&bar[XB_XSUB(b.x)], 1u);
        const unsigned gen = old / nloc;
        if (old + 1u == (gen + 1u) * nloc) {
          if (!skip_top) {
            __builtin_amdgcn_fence(__ATOMIC_RELEASE, "agent");
            asm volatile("s_waitcnt vmcnt(0)" ::: "memory");
            const unsigned og = xb_add(&bar[XB_TOP], 1u);
            const unsigned tg = og / nx;
            if (og + 1u == (tg + 1u) * nx) xb_add(&bar[XB_TOPGEN], 1u);
            else XB_SPIN(xb_ld(&bar[XB_TOPGEN]) == tg, bar);
          }
            __builtin_amdgcn_fence(__ATOMIC_ACQUIRE, "agent");
            xb_add(&bar[XB_XGEN(b.x)], 1u);
            asm volatile("s_waitcnt vmcnt(0)" ::: "memory");
        } else {
            XB_SPIN(xb_ld(&bar[XB_XGEN(b.x)]) == gen, bar);
            __builtin_amdgcn_fence(__ATOMIC_ACQUIRE, "agent");
            asm volatile("s_waitcnt vmcnt(0)" ::: "memory");
        }
        }
    }
    __syncthreads();
}

__constant__ float RET_FREQ[64] = {1.000000000e+00f, 8.639884591e-01f, 7.464760542e-01f, 6.449466944e-01f, 5.572264791e-01f, 4.814372361e-01f, 4.159561992e-01f, 3.593813777e-01f, 3.105013371e-01f, 2.682695687e-01f, 2.317818105e-01f, 2.002568096e-01f, 1.730195731e-01f, 1.494869143e-01f, 1.291549653e-01f, 1.115883961e-01f, 9.641107172e-02f, 8.329805732e-02f, 7.196855545e-02f, 6.218000501e-02f, 5.372280627e-02f, 4.641588405e-02f, 4.010278732e-02f, 3.464834765e-02f, 2.993577160e-02f, 2.586415969e-02f, 2.234633639e-02f, 1.930697635e-02f, 1.668100432e-02f, 1.441219542e-02f, 1.245197095e-02f, 1.075835899e-02f, 9.295095690e-03f, 8.030855097e-03f, 6.938565988e-03f, 5.994840991e-03f, 5.179473665e-03f, 4.475005437e-03f, 3.866352839e-03f, 3.340484342e-03f, 2.886139788e-03f, 2.493591513e-03f, 2.154434333e-03f, 1.861406374e-03f, 1.608233666e-03f, 1.389495330e-03f, 1.200507861e-03f, 1.037224894e-03f, 8.961503627e-04f, 7.742635789e-04f, 6.689548027e-04f, 5.779692437e-04f, 4.993587499e-04f, 4.314401885e-04f, 3.727593285e-04f, 3.220597573e-04f, 2.782559313e-04f, 2.404099068e-04f, 2.077113895e-04f, 1.794602431e-04f, 1.550515735e-04f, 1.339627634e-04f, 1.157422885e-04f, 9.999999747e-05f};
__constant__ float ROPE_FREQ[8] = {1.000000000e+00f, 1.939227432e-01f, 3.760603070e-02f, 7.292664610e-03f, 1.414213562e-03f, 2.742481884e-04f, 5.318295734e-05f, 1.031338525e-05f};
static_assert((CW_BAR + XCD_BAR_WORDS) * 4 <= (int)CTL_ZERO_BYTES, "the grid barrier's words are inside the per-call memset");
struct Args { const float* in[17]; float* out; unsigned char* ws; };
enum { I_X = 0, I_PRE_NORM = 1, I_PRE_WG = 2, I_PRE_WU = 3, I_PRE_WD = 4, I_MIX_NORM = 5, I_AB_IN = 6, I_AB_OUT = 7, I_GLA_IN = 8, I_GLA_A2 = 9, I_GLA_BA = 10, I_GLA_OUT = 11,
       I_POST_NORM = 12, I_POST_WG = 13, I_POST_WU = 14, I_POST_WD = 15, I_FINAL = 16, I_OUT = 17, I_WS = 18, N_PTRS = 19 };
struct Frame {
    LAS unsigned char* lds;
    int tid, lane, wave, G, bid;
};
__device__ __forceinline__ unsigned char* tabp(const Frame& F, int idx) {
    int off_ = PTR_OFF + 8 * idx; asm volatile("" : "+s"(off_));
    const volatile LAS unsigned* T = (const volatile LAS unsigned*)(F.lds + off_);
    const unsigned lo = __builtin_amdgcn_readfirstlane(T[0]), hi = __builtin_amdgcn_readfirstlane(T[1]);
    GAS unsigned char* gp_ = (GAS unsigned char*)(((unsigned long long)hi << 32) | (unsigned long long)lo);
    return (unsigned char*)gp_;
}
#define AP(idx) ((const float*)tabp(F, idx))
#define WSP() tabp(F, I_WS)
#define OUTP() ((float*)tabp(F, I_OUT))
__device__ __forceinline__ int lnd(int v) { asm volatile("" : "+s"(v)); return v; }
__device__ __forceinline__ int hw_lane() { return (int)__builtin_amdgcn_mbcnt_hi(~0u, __builtin_amdgcn_mbcnt_lo(~0u, 0u)); }
__device__ __forceinline__ int hw_lane_v() { int l; asm volatile("v_mbcnt_lo_u32_b32 %0, -1, 0\n\tv_mbcnt_hi_u32_b32 %0, -1, %0" : "=v"(l)); return l; }
__device__ __forceinline__ Frame relaunder(const Frame& F0) { Frame F = F0; int t_ = F0.wave * 64 + hw_lane_v(); asm volatile("" : "+s"(F.bid)); F.tid = t_; F.lane = F.tid & 63; F.wave = __builtin_amdgcn_readfirstlane(F.tid >> 6);
    unsigned lb_ = 0u; asm volatile("" : "+s"(lb_)); F.lds = F0.lds + lb_; return F; }
__device__ __forceinline__ float wave_sum(float v) {
    v += xsw<1>(v); v += xsw<2>(v); v += xsw<4>(v); v += xsw<8>(v); v += xsw<16>(v);
    return sum32(v);
}
__device__ __forceinline__ float bf2f(bf16 h) { return __builtin_bit_cast(float, (unsigned)h << 16); }
__device__ __forceinline__ float bflo(unsigned w) { return __builtin_bit_cast(float, w << 16); }
__device__ __forceinline__ float bfhi(unsigned w) { return __builtin_bit_cast(float, w & 0xffff0000u); }
__device__ __forceinline__ bf16 f2bf_rne(float f) { return (bf16)f2bf(f); }

#ifndef F8_MASK
#define F8_MASK 0xE0
#endif
#define F8SLOT(s_) (((F8_MASK) >> (s_)) & 1)
#ifndef F8A_MASK
#define F8A_MASK 0x00
#endif
#define F8ASLOT(s_) ((s_) < 8 && (((F8A_MASK) >> (s_)) & 1))
#ifndef I8A_MASK
#define I8A_MASK 0xFF
#endif
#define I8ASLOT(s_) ((s_) < 8 && (((I8A_MASK) >> (s_)) & 1))
#define I8CONV(s_) I8ASLOT(s_)
#ifndef I8_WCLIP
#define I8_WCLIP 3.4f
#endif
constexpr size_t WS_I8S = 2048;
#define I8SW(s_) (*(const GAS float*)(WSP() + WS_I8S + 4 * (s_)))
static_assert((I8A_MASK & F8A_MASK) == 0, "a gate|up GEMM is int8 or fp8, not both");
static_assert((F8A_MASK & ~F8_MASK) == 0, "an fp8 gate|up GEMM writes e4m3 hidden rows: its down projection must be fp8 as well");
constexpr size_t WS_X8 = 408 * MiB;
#define XB8 (WSP() + WS_X8)
constexpr int XB8_D = (int)(WS_X8 - WS_XB);
__device__ __forceinline__ void tr_item(const float* W, int K, int N, int Npad, const float* gain, bf16* WT, int gu, LAS float* scr, int item, int lane, float f8s = 0.f) {
    const int nblk = Npad / 32, kb = item / nblk, nb = item % nblk, k0 = 64 * kb, n0 = 32 * nb;
    {
        const int c4 = lane & 7; const bool ok = n0 + 4 * c4 < N;
        const GAS float* src = (const GAS float*)W + (size_t)(k0 + (lane >> 3)) * N + n0 + 4 * c4;
        f32x4 v[8];
#pragma unroll
        for (int i = 0; i < 8; ++i) v[i] = ok ? __builtin_nontemporal_load((const GAS f32x4*)(src + (size_t)(8 * i) * N)) : (f32x4){0.f, 0.f, 0.f, 0.f};
#pragma unroll
        for (int i = 0; i < 8; ++i) { const int kk = 8 * i + (lane >> 3); const float gn = gain ? ((const GAS float*)gain)[k0 + kk] : 1.0f; LAS float* s = scr + kk * 33 + 4 * c4;
            s[0] = v[i][0] * gn; s[1] = v[i][1] * gn; s[2] = v[i][2] * gn; s[3] = v[i][3] * gn;
            }
    }
    LDS_WAIT(); asm volatile("" ::: "memory");
    const int c = lane & 7;
#pragma unroll
    for (int j = 0; j < 4; ++j) { const int n = (lane >> 3) + 8 * j; const LAS float* s = scr + (8 * c) * 33 + n;
        v4u o; o.x = pk2(s[0 * 33], s[1 * 33]); o.y = pk2(s[2 * 33], s[3 * 33]); o.z = pk2(s[4 * 33], s[5 * 33]); o.w = pk2(s[6 * 33], s[7 * 33]);
        int drow = n0 + n;
        if (gu == 3) {
            if (drow < 1024) { const int j = drow & 127; drow = (drow & ~127) + (j < 64 ? 2 * j : 2 * (j - 64) + 1); }
            else if (drow >= 2048 && drow < 3072) { const int j = drow & 63; drow = (drow & ~63) + (j < 8 ? 2 * j : (j < 16 ? 2 * (j - 8) + 1 : j)); }
        } else if (gu == 1 || gu == 2) drow = (drow >> 7) * 256 + (drow & 127) + (gu == 2 ? 128 : 0);
        if (f8s < 0.f) {
            int q[8];
#pragma unroll
            for (int e = 0; e < 8; ++e) q[e] = (int)fminf(fmaxf(rintf(s[e * 33] * -f8s), -127.f), 127.f) & 0xff;
            typedef int i32x2q __attribute__((ext_vector_type(2)));
            *(GAS i32x2q*)((GAS unsigned char*)WT + (size_t)drow * K + k0 + 8 * c) = (i32x2q){q[0] | (q[1] << 8) | (q[2] << 16) | (q[3] << 24), q[4] | (q[5] << 8) | (q[6] << 16) | (q[7] << 24)};
        } else
        if (f8s != 0.f) {
            const int w0 = __builtin_amdgcn_cvt_pk_fp8_f32(s[0 * 33] * f8s, s[1 * 33] * f8s, 0, false), w0b = __builtin_amdgcn_cvt_pk_fp8_f32(s[2 * 33] * f8s, s[3 * 33] * f8s, w0, true);
            const int w1 = __builtin_amdgcn_cvt_pk_fp8_f32(s[4 * 33] * f8s, s[5 * 33] * f8s, 0, false), w1b = __builtin_amdgcn_cvt_pk_fp8_f32(s[6 * 33] * f8s, s[7 * 33] * f8s, w1, true);
            typedef int i32x2_ __attribute__((ext_vector_type(2)));
            *(GAS i32x2_*)((GAS unsigned char*)WT + (size_t)drow * K + k0 + 8 * c) = (i32x2_){w0b, w1b};
        } else
        *(GAS v4u*)(WT + (size_t)drow * K + k0 + 8 * c) = o; }
    LDS_WAIT(); asm volatile("" ::: "memory");
}
__device__ __forceinline__ void convert_weights(const Frame& F0, int l, int part, float pro_s0 = 0.f, float pro_s1 = 0.f) {
    const Frame F = relaunder(F0);
    LAS float* scr = (LAS float*)(F.lds + RING_OFF + F.wave * 16384);
    const int gw = F.bid * NWAVES + F.wave, NGW = F.G * NWAVES;
    unsigned char* ws = WSP();
    constexpr int I_G = (D / 64) * (FF / 32), I_DN = (FF / 64) * (D / 32), I_O = (D / 64) * (D / 32);
    const bool odd = (l & 1) != 0; const int li = l >> 1;
    const int nin = odd ? GLA_IN : EVEN_IN, ninp = odd ? GLA_INP : EVEN_IN; const int I_IN = (D / 64) * (ninp / 32);
    const float* win = odd ? AP(I_GLA_IN) + (size_t)li * D * GLA_IN : AP(I_AB_IN) + (size_t)li * D * EVEN_IN;
    const float* wout = odd ? AP(I_GLA_OUT) + (size_t)li * D * D : AP(I_AB_OUT) + (size_t)li * D * D;
    const size_t fo = (size_t)l * D * FF;
    const int NITEMS = 6 * I_G + I_IN + I_O;
    static_assert(I_G == I_DN, "item counts");
    const int nitems = part == 0 ? NITEMS : (part == 1 ? 3 * I_G + I_IN : 3 * I_G + I_O);
    const float i8s0 = I8CONV(2 * l) ? (part == 0 ? -pro_s0 : -I8SW(2 * l)) : 0.f, i8s1 = I8CONV(2 * l + 1) ? (part == 0 ? -pro_s1 : -I8SW(2 * l + 1)) : 0.f;
    for (int it = gw; it < nitems; it += NGW) {
        int r = part == 2 ? (it < 3 * I_G ? it + 3 * I_G : it + 3 * I_G + I_IN) : ((part == 1 && it >= 3 * I_G) ? it + 3 * I_G : it);
        if (r < I_G) { tr_item(AP(I_PRE_WG) + fo, D, FF, FF, AP(I_PRE_NORM) + l * D, (bf16*)(ws + W_GU0), 1, scr, r, F.lane, I8CONV(2 * l) ? i8s0 : (F8ASLOT(2 * l) ? pg8::F8_GUSCALE : 0.f)); continue; } r -= I_G;
        if (r < I_G) { tr_item(AP(I_PRE_WU) + fo, D, FF, FF, AP(I_PRE_NORM) + l * D, (bf16*)(ws + W_GU0), 2, scr, r, F.lane, I8CONV(2 * l) ? i8s0 : (F8ASLOT(2 * l) ? pg8::F8_GUSCALE : 0.f)); continue; } r -= I_G;
        if (r < I_G) { tr_item(AP(I_PRE_WD) + fo, FF, D, D, nullptr, (bf16*)(ws + W_D0), 0, scr, r, F.lane, F8SLOT(2 * l) ? pg8::F8_WSCALE : 0.f); continue; } r -= I_G;
        if (r < I_G) { tr_item(AP(I_POST_WG) + fo, D, FF, FF, AP(I_POST_NORM) + l * D, (bf16*)(ws + W_GU1), 1, scr, r, F.lane, I8CONV(2 * l + 1) ? i8s1 : (F8ASLOT(2 * l + 1) ? pg8::F8_GUSCALE : 0.f)); continue; } r -= I_G;
        if (r < I_G) { tr_item(AP(I_POST_WU) + fo, D, FF, FF, AP(I_POST_NORM) + l * D, (bf16*)(ws + W_GU1), 2, scr, r, F.lane, I8CONV(2 * l + 1) ? i8s1 : (F8ASLOT(2 * l + 1) ? pg8::F8_GUSCALE : 0.f)); continue; } r -= I_G;
        if (r < I_G) { tr_item(AP(I_POST_WD) + fo, FF, D, D, nullptr, (bf16*)(ws + W_D1), 0, scr, r, F.lane, F8SLOT(2 * l + 1) ? pg8::F8_WSCALE : 0.f); continue; } r -= I_G;
        if (r < I_IN) { tr_item(win, D, nin, ninp, AP(I_MIX_NORM) + l * D, (bf16*)(ws + W_IN), odd ? 0 : 3, scr, r, F.lane); continue; } r -= I_IN;
        tr_item(wout, D, D, D, nullptr, (bf16*)(ws + W_OUT), 0, scr, r, F.lane);
    }
}
__device__ __forceinline__ float i8_scale_block(const Frame& F, int s) {
    const int l = s >> 1; const bool post = (s & 1) != 0; const size_t fo = (size_t)l * D * FF;
    const GAS float* wg = (const GAS float*)(AP(post ? I_POST_WG : I_PRE_WG) + fo); const GAS float* wu = (const GAS float*)(AP(post ? I_POST_WU : I_PRE_WU) + fo);
    const GAS float* gn = (const GAS float*)(AP(post ? I_POST_NORM : I_PRE_NORM) + l * D);
    float ss = 0.f, gm = 0.f;
    {
        f32x4 a[8], b[8];
#pragma unroll
        for (int i = 0; i < 8; ++i) { a[i] = ((const GAS f32x4*)wg)[F.tid + i * NTHREADS]; b[i] = ((const GAS f32x4*)wu)[F.tid + i * NTHREADS]; }
        static_assert(8 * NTHREADS * 4 == 16384, "sample size");
        for (int i = F.tid; i < D; i += NTHREADS) gm = fmaxf(gm, fabsf(gn[i]));
#pragma unroll
        for (int i = 0; i < 8; ++i) ss += a[i][0] * a[i][0] + a[i][1] * a[i][1] + a[i][2] * a[i][2] + a[i][3] * a[i][3] + b[i][0] * b[i][0] + b[i][1] * b[i][1] + b[i][2] * b[i][2] + b[i][3] * b[i][3];
    }
    ss = wave_sum(ss);
    gm = fmaxf(gm, xsw<1>(gm)); gm = fmaxf(gm, xsw<2>(gm)); gm = fmaxf(gm, xsw<4>(gm)); gm = fmaxf(gm, xsw<8>(gm)); gm = fmaxf(gm, xsw<16>(gm)); gm = max32(gm);
    LAS float* red = (LAS float*)(F.lds + RING_OFF);
    if (F.lane == 0) { red[F.wave] = ss; red[8 + F.wave] = gm; }
    __syncthreads();
    float st = 0.f, gt = 0.f;
    for (int w = 0; w < NWAVES; ++w) { st += red[w]; gt = fmaxf(gt, red[8 + w]); }
    __syncthreads();
    const float sigma = sqrtf(st * (1.0f / (2.0f * 16384.0f)));
    return 127.0f / fmaxf(I8_WCLIP * sigma * gt, 1e-20f);
}
__device__ __forceinline__ float i8_scales(const Frame& F0, float& s0) {
    const Frame F = relaunder(F0);
    float s1 = 0.f; s0 = 0.f;
    if (I8ASLOT(0)) { s0 = i8_scale_block(F, 0); if (F.bid == 0 && F.tid == 0) *(GAS float*)(WSP() + WS_I8S) = s0; }
    if (I8ASLOT(1)) { s1 = i8_scale_block(F, 1); if (F.bid == 1 && F.tid == 0) *(GAS float*)(WSP() + WS_I8S + 4) = s1; }
    if (F.bid >= 2 && F.bid < 8 && I8ASLOT(F.bid)) { const float v = i8_scale_block(F, F.bid); if (F.tid == 0) *(GAS float*)(WSP() + WS_I8S + 4 * F.bid) = v; }
    return s1;
}
__device__ __forceinline__ void prologue_rows(const Frame& F0, float pro_s0) {
    const Frame F = relaunder(F0);
    unsigned char* ws = WSP();
    const int gw = F.bid * NWAVES + F.wave, NGW = F.G * NWAVES;
    bf16* XB = (bf16*)(ws + WS_XB); float* ssp = (float*)(ws + WS_SSP);
    const float swi = I8ASLOT(0) ? 1.0f / pro_s0 : 0.f;
    for (int m = gw; m < M; m += NGW) {
        const GAS f32x4* xr = (const GAS f32x4*)(AP(I_X) + (size_t)m * D) + F.lane;
        GAS unsigned long long* o8 = (GAS unsigned long long*)(XB + (size_t)m * D) + F.lane;
        f32x4 v[4];
#pragma unroll
        for (int j = 0; j < 4; ++j) v[j] = xr[64 * j];
        float s = 0.f, mx = 0.f;
#pragma unroll
        for (int j = 0; j < 4; ++j) { s += (v[j].x * v[j].x + v[j].y * v[j].y) + (v[j].z * v[j].z + v[j].w * v[j].w);
            o8[64 * j] = (unsigned long long)pk2(v[j].x, v[j].y) | ((unsigned long long)pk2(v[j].z, v[j].w) << 32);
            mx = fmaxf(fmaxf(mx, fmaxf(fabsf(v[j].x), fabsf(v[j].y))), fmaxf(fabsf(v[j].z), fabsf(v[j].w))); }
        s = wave_sum(s);
        if (I8ASLOT(0)) {
            mx = fmaxf(mx, xsw<1>(mx)); mx = fmaxf(mx, xsw<2>(mx)); mx = fmaxf(mx, xsw<4>(mx)); mx = fmaxf(mx, xsw<8>(mx)); mx = fmaxf(mx, xsw<16>(mx)); mx = max32(mx);
            mx = fmaxf(mx, 1e-20f);
            const float sx = 127.0f / mx;
            GAS unsigned* x8 = (GAS unsigned*)(ws + WS_X8 + (size_t)m * D) + F.lane;
#pragma unroll
            for (int j = 0; j < 4; ++j) x8[64 * j] = (unsigned)(((int)rintf(v[j].x * sx) & 0xff) | (((int)rintf(v[j].y * sx) & 0xff) << 8) | (((int)rintf(v[j].z * sx) & 0xff) << 16) | (((int)rintf(v[j].w * sx) & 0xff) << 24));
            const float rstd = 1.0f / sqrtf(s * (1.0f / D) + EPS), reff = rstd * mx * (1.0f / 127.0f) * swi;
            s = 1024.0f * (1.0f / (reff * reff) - EPS);
        }
        if (F.lane < 16) ssp[(size_t)m * 16 + F.lane] = (F.lane == 0) ? s : 0.f;
    }
    const int gt = F.bid * NTHREADS + F.tid, NGT = F.G * NTHREADS;
    float* rc = (float*)(ws + TAB_RC); float* rsn = (float*)(ws + TAB_RS); float* dc = (float*)(ws + TAB_DC); float* ds = (float*)(ws + TAB_DS);
    for (int e = gt; e < SEQ * 64; e += NGT) { const int t = e >> 6, i = e & 63; const float ang = (float)t * RET_FREQ[i];
        double rev = (double)ang * 0.15915494309189535; rev -= __builtin_rint(rev); const float r = (float)rev;
        rc[e] = __builtin_amdgcn_cosf(r); rsn[e] = __builtin_amdgcn_sinf(r); }
    for (int e = gt; e < SEQ * 8; e += NGT) { const int t = e >> 3, i = e & 7; const float ang = (float)t * ROPE_FREQ[i];
        double rev = (double)ang * 0.15915494309189535; rev -= __builtin_rint(rev); const float r = (float)rev;
        dc[e] = __builtin_amdgcn_cosf(r); ds[e] = __builtin_amdgcn_sinf(r); }
}

__device__ __forceinline__ void quant_rows(const Frame& F0, int slot) {
    const Frame F = relaunder(F0);
    unsigned char* ws = WSP();
    const int pan0 = (F.bid & 7) * 16 + ((F.bid >> 3) & 7), widx = (F.bid >> 6) * NWAVES + F.wave;
    const bf16* XBp = (const bf16*)(ws + WS_XB); unsigned char* X8 = ws + WS_X8; float* ssp = (float*)(ws + WS_SSP);
    const float swi = 1.0f / I8SW(slot);
    for (int k = 0; k < 16; ++k) {
        const int m = (pan0 + (k & 8)) * 256 + widx + 32 * (k & 7);
        const GAS v4u* xr = (const GAS v4u*)(XBp + (size_t)m * D) + 2 * F.lane;
        const v4u a = xr[0], b = xr[1];
        float v[16];
#pragma unroll
        for (int i = 0; i < 4; ++i) { v[2 * i] = bflo(a[i]); v[2 * i + 1] = bfhi(a[i]); v[8 + 2 * i] = bflo(b[i]); v[8 + 2 * i + 1] = bfhi(b[i]); }
        float ss = 0.f, mx = 0.f;
#pragma unroll
        for (int i = 0; i < 16; ++i) { ss += v[i] * v[i]; mx = fmaxf(mx, fabsf(v[i])); }
        ss = wave_sum(ss);
        mx = fmaxf(mx, xsw<1>(mx)); mx = fmaxf(mx, xsw<2>(mx)); mx = fmaxf(mx, xsw<4>(mx)); mx = fmaxf(mx, xsw<8>(mx)); mx = fmaxf(mx, xsw<16>(mx)); mx = max32(mx);
        mx = fmaxf(mx, 1e-20f);
        const float sx = 127.0f / mx;
        int q[16];
#pragma unroll
        for (int i = 0; i < 16; ++i) q[i] = (int)rintf(v[i] * sx) & 0xff;
        v4u o;
#pragma unroll
        for (int i = 0; i < 4; ++i) o[i] = (unsigned)(q[4 * i] | (q[4 * i + 1] << 8) | (q[4 * i + 2] << 16) | (q[4 * i + 3] << 24));
        *((GAS v4u*)(X8 + (size_t)m * D) + F.lane) = o;
        const float rstd = 1.0f / sqrtf(ss * (1.0f / D) + EPS), reff = rstd * mx * (1.0f / 127.0f) * swi;
        if (F.lane < 16) ssp[(size_t)m * 16 + F.lane] = (F.lane == 0) ? 1024.0f * (1.0f / (reff * reff) - EPS) : 0.f;
    }
}

__device__ __forceinline__ void final_norm(const Frame& F0) {
    const Frame F = relaunder(F0);
    const int pan0 = (F.bid & 7) * 16 + ((F.bid >> 3) & 7), widx = (F.bid >> 6) * NWAVES + F.wave;
    const bf16* XBp = (const bf16*)(WSP() + WS_XB); float* out = OUTP(); const GAS f32x4* gr = (const GAS f32x4*)AP(I_FINAL);
    for (int k = 0; k < 16; ++k) {
        const int m = (pan0 + (k & 8)) * 256 + widx + 32 * (k & 7);
        const v4u w0 = *(const GAS v4u*)(XBp + (size_t)m * D + F.lane * 8), w1 = *(const GAS v4u*)(XBp + (size_t)m * D + 512 + F.lane * 8);
        float v[16]; float s = 0.f;
#pragma unroll
        for (int i = 0; i < 4; ++i) { v[2 * i] = bflo(w0[i]); v[2 * i + 1] = bfhi(w0[i]); v[8 + 2 * i] = bflo(w1[i]); v[8 + 2 * i + 1] = bfhi(w1[i]); }
#pragma unroll
        for (int i = 0; i < 16; ++i) s += v[i] * v[i];
        const float rstd = 1.0f / sqrtf(wave_sum(s) * (1.0f / D) + EPS);
        GAS f32x4* o = (GAS f32x4*)(out + (size_t)m * D);
#pragma unroll
        for (int hh = 0; hh < 2; ++hh)
#pragma unroll
            for (int q = 0; q < 2; ++q) { const int c4 = hh * 128 + F.lane * 2 + q; const f32x4 g = gr[c4];
                o[c4] = (f32x4){v[hh * 8 + q * 4] * rstd * g[0], v[hh * 8 + q * 4 + 1] * rstd * g[1], v[hh * 8 + q * 4 + 2] * rstd * g[2], v[hh * 8 + q * 4 + 3] * rstd * g[3]}; }
    }
}


__device__ __forceinline__ float silu_f(float g) { return g * __builtin_amdgcn_rcpf(1.0f + __builtin_amdgcn_exp2f(-1.4426950408889634f * g)); }
typedef float f32x16 __attribute__((ext_vector_type(16)));
typedef short s16x4 __attribute__((ext_vector_type(4)));
typedef float f32x2_t __attribute__((ext_vector_type(2)));
typedef __bf16 bf16x2_t __attribute__((ext_vector_type(2)));
#define MFMA32(a, b, c) __builtin_amdgcn_mfma_f32_32x32x16_bf16((a), (b), (c), 0, 0, 0)
__device__ __forceinline__ int crow(int reg, int h) { return (reg & 3) + 8 * (reg >> 2) + 4 * h; }
__device__ __forceinline__ unsigned cvtpk(float lo, float hi) { f32x2_t v = {lo, hi}; bf16x2_t b = __builtin_convertvector(v, bf16x2_t); return __builtin_bit_cast(unsigned, b); }
__device__ __forceinline__ bf16 cvt1(float v) { return (bf16)(cvtpk(v, 0.f) & 0xffffu); }
#define PACK_STEP(x, s) __builtin_bit_cast(bf16x8, (v4u){cvtpk((x)[8 * (s)], (x)[8 * (s) + 1]), cvtpk((x)[8 * (s) + 2], (x)[8 * (s) + 3]), cvtpk((x)[8 * (s) + 4], (x)[8 * (s) + 5]), cvtpk((x)[8 * (s) + 6], (x)[8 * (s) + 7])})
typedef const LAS unsigned char* lcp;
__device__ __forceinline__ int lndv(int v) { asm volatile("" : "+v"(v)); return v; }
__device__ __forceinline__ bf16x8 ld_row(lcp img, int P, int row0, int k0, int r, int h) { return *(const LAS bf16x8*)(img + (row0 + r) * P + (k0 + 8 * h) * 2); }
__device__ __forceinline__ bf16x8 ld_row_perm(lcp img, int P, int row0, int k0, int r, int h) {
    const s16x4 lo = *(const LAS s16x4*)(img + (row0 + r) * P + (k0 + 4 * h) * 2), hi = *(const LAS s16x4*)(img + (row0 + r) * P + (k0 + 8 + 4 * h) * 2);
    return __builtin_shufflevector(lo, hi, 0, 1, 2, 3, 4, 5, 6, 7); }
__device__ __forceinline__ s16x4 trd(lcp p) { return __builtin_bit_cast(s16x4, __builtin_amdgcn_ds_read_tr16_b64_v4i16((LAS s16x4*)p)); }
__device__ __forceinline__ bf16x8 ld_tr(lcp img, int P, int k0, int c0, int lane) {
    const int i16 = lane & 15, q = i16 >> 2, p = i16 & 3, blk = (lane >> 4) & 1, h = lane >> 5;
    lcp a = img + (k0 + 8 * h + q) * P + (c0 + 16 * blk + 4 * p) * 2;
    const s16x4 lo = trd(a), hi = trd(a + 4 * P);
    return __builtin_shufflevector(lo, hi, 0, 1, 2, 3, 4, 5, 6, 7); }
__device__ __forceinline__ bf16x8 ld_tr_perm(lcp img, int P, int k0, int c0, int lane) {
    const int i16 = lane & 15, q = i16 >> 2, p = i16 & 3, blk = (lane >> 4) & 1, h = lane >> 5;
    lcp a = img + (k0 + 4 * h + q) * P + (c0 + 16 * blk + 4 * p) * 2;
    const s16x4 lo = trd(a), hi = trd(a + 8 * P);
    return __builtin_shufflevector(lo, hi, 0, 1, 2, 3, 4, 5, 6, 7); }
template <int R, int C> __device__ __forceinline__ void tile_ld(v4u (&v)[R * C / 8 / NTHREADS], const bf16* g, size_t gp, int tid) {
    constexpr int CPR = C / 8, RS = NTHREADS / CPR;
    static_assert(NTHREADS % CPR == 0, "tile shape");
    const unsigned voff = (unsigned)((tid / CPR) * (int)gp + (tid % CPR) * 8) * 2u;
    const GAS unsigned char* gb = (const GAS unsigned char*)g;
#pragma unroll
    for (int i = 0; i < R * C / 8 / NTHREADS; ++i) v[i] = *(const GAS v4u*)(gb + (size_t)i * RS * gp * 2 + voff);
}
template <int R, int C> __device__ __forceinline__ void tile_st(const v4u (&v)[R * C / 8 / NTHREADS], LAS unsigned char* img, int P, int tid) {
    constexpr int CPR = C / 8, RS = NTHREADS / CPR;
    LAS unsigned char* lb = img + (tid / CPR) * P + (tid % CPR) * 16;
#pragma unroll
    for (int i = 0; i < R * C / 8 / NTHREADS; ++i) *(LAS v4u*)(lb + i * RS * P) = v[i];
}
template <int R, int C> __device__ __forceinline__ void stage_tile(LAS unsigned char* img, int P, const bf16* g, size_t gp, int tid) { v4u t_[R * C / 8 / NTHREADS]; tile_ld<R, C>(t_, g, gp, tid); tile_st<R, C>(t_, img, P, tid); }
#define WG_BAR() do { asm volatile("s_waitcnt lgkmcnt(0)" ::: "memory"); __builtin_amdgcn_s_barrier(); asm volatile("" ::: "memory"); } while (0)

constexpr int PR = 272, PT = 320, PT256 = 576, PO256 = 528;
constexpr size_t WS_ALOW = 7 * MiB;
constexpr size_t WS_DEC = 6 * MiB;
constexpr float LOG2E = 1.4426950408889634f, LN2 = 0.6931471805599453f;
__device__ __forceinline__ void gla_cumsum(float (&Bc)[2][16], float& Blast, lcp AL, lcp W2, const LAS float* BA, LAS float* EX, int wave, int lane) {
    const int r = lane & 31, h = lane >> 5, db = wave & 3, jh = wave >> 2;
    const bf16x8 wf = *(const LAS bf16x8*)(W2 + (db * 32 + r) * 32 + h * 16);
    const float bias = BA[db * 32 + r];
    float run = 0.f;
    float c16 = 1.0f / 16.0f; asm volatile("" : "+v"(c16)); float ln2_ = LN2; asm volatile("" : "+v"(ln2_));
#pragma unroll
    for (int t = 0; t < 2; ++t) {
        const bf16x8 af = *(const LAS bf16x8*)(AL + ((jh * 2 + t) * 32 + r) * 32 + h * 16);
        f32x16 z = {0.f, 0.f, 0.f, 0.f, 0.f, 0.f, 0.f, 0.f, 0.f, 0.f, 0.f, 0.f, 0.f, 0.f, 0.f, 0.f};
        z = MFMA32(af, wf, z);
        float own[4], oth[4];
#pragma unroll
        for (int g = 0; g < 4; ++g) {
            float acc = 0.f;
#pragma unroll
            for (int i = 0; i < 4; ++i) { const float zz = z[4 * g + i] + bias;
                const float la = (fminf(zz, 0.f) - ln2_ * __builtin_amdgcn_logf(1.0f + __builtin_amdgcn_exp2f(-fabsf(zz) * LOG2E))) * c16;
                acc += la; Bc[t][4 * g + i] = acc; }
            own[g] = acc; oth[g] = oth32(acc, h);
        }
#pragma unroll
        for (int g = 0; g < 4; ++g) { const float off = run + (h ? oth[g] : 0.f);
#pragma unroll
            for (int i = 0; i < 4; ++i) Bc[t][4 * g + i] += off;
            run += own[g] + oth[g]; }
    }
    if (h == 0) EX[jh * 128 + db * 32 + r] = run;
    WG_BAR();
    const float t0 = EX[db * 32 + r], t1 = EX[128 + db * 32 + r];
    Blast = t0 + t1;
    if (jh == 1) {
#pragma unroll
        for (int t = 0; t < 2; ++t)
#pragma unroll
            for (int i = 0; i < 16; ++i) Bc[t][i] += t0; }
}
constexpr int GA_KI = 0, GA_VI = GA_KI + 128 * PR, GA_KD = GA_VI + 128 * PT256, GA_AL = GA_KD + 128 * PT, GA_W2 = GA_AL + 4096, GA_BA = GA_W2 + 4096, GA_EX = GA_BA + 512, GA_END = GA_EX + 1024;
constexpr int GA_OI = GA_VI;
constexpr int GC_QT = 0, GC_KT = GC_QT + 128 * PR, GC_SI = GC_KT + 128 * PR, GC_VI = GC_SI + 128 * PT, GC_AL = GC_VI + 128 * PT, GC_W2 = GC_AL + 4096, GC_BA = GC_W2 + 4096, GC_EX = GC_BA + 512, GC_END = GC_EX + 1024;
constexpr int GC_OI = 0;
static_assert(GA_END <= LDSCTL_OFF && GC_END <= LDSCTL_OFF && 128 * PO256 <= GC_SI && 128 * PO256 <= 128 * PT256, "GLA LDS maps");
__device__ __forceinline__ void gla_stage_w(const Frame& F, LAS unsigned char* W2, LAS float* BA, int li, int h) {
    if (F.tid < 128) { const int d = F.tid; const GAS float* w2 = (const GAS float*)AP(I_GLA_A2) + (size_t)li * 16 * 512 + h * 128 + d;
        v4u lo, hi; lo.x = cvtpk(w2[0], w2[512]); lo.y = cvtpk(w2[2 * 512], w2[3 * 512]); lo.z = cvtpk(w2[4 * 512], w2[5 * 512]); lo.w = cvtpk(w2[6 * 512], w2[7 * 512]);
        hi.x = cvtpk(w2[8 * 512], w2[9 * 512]); hi.y = cvtpk(w2[10 * 512], w2[11 * 512]); hi.z = cvtpk(w2[12 * 512], w2[13 * 512]); hi.w = cvtpk(w2[14 * 512], w2[15 * 512]);
        *(LAS v4u*)(W2 + d * 32) = lo; *(LAS v4u*)(W2 + d * 32 + 16) = hi; }
    else if (F.tid < 256) { const int d = F.tid - 128; BA[d] = ((const GAS float*)AP(I_GLA_BA))[(size_t)li * 512 + h * 128 + d]; }
}
__device__ __forceinline__ v4u gla_ld_alow(int tid, const bf16* Arow0) { const int t = tid & 255; return *(const GAS v4u*)(Arow0 + (size_t)(t >> 1) * 16 + (t & 1) * 8); }
__device__ __forceinline__ void gla_st_alow(int tid, v4u v, LAS unsigned char* AL) { if (tid < 256) *(LAS v4u*)(AL + (tid >> 1) * 32 + (tid & 1) * 16) = v; }

__device__ __forceinline__ void gla_alow(const Frame& F0) {
    const Frame F = relaunder(F0);
    unsigned char* ws = WSP();
    const bf16* XBp = (const bf16*)(ws + WS_XB); const bf16* Wa = (const bf16*)(ws + W_IN) + (size_t)3072 * D; const float* ssp = (const float*)(ws + WS_SSP); bf16* ALOW = (bf16*)(ws + WS_ALOW);
    LAS unsigned char* L = F.lds;
    const int lane = F.lane, r = lane & 31, h2 = lane >> 5, tb = F.wave & 3, kh = F.wave >> 2;
    for (int blk = F.bid; blk < M / 128; blk += F.G) {
        const int tok = blk * 128 + tb * 32 + r;
        const bf16* xa = XBp + (size_t)tok * D + kh * 512 + 8 * h2; const bf16* wa = Wa + (size_t)(r & 15) * D + kh * 512 + 8 * h2;
        f32x16 acc = {0.f, 0.f, 0.f, 0.f, 0.f, 0.f, 0.f, 0.f, 0.f, 0.f, 0.f, 0.f, 0.f, 0.f, 0.f, 0.f};
#pragma unroll 1
        for (int k8 = 0; k8 < 4; ++k8) {
            bf16x8 af[8], bfr[8];
#pragma unroll
            for (int ks = 0; ks < 8; ++ks) { af[ks] = *(const GAS bf16x8*)(wa + (k8 * 8 + ks) * 16); bfr[ks] = *(const GAS bf16x8*)(xa + (k8 * 8 + ks) * 16); }
#pragma unroll
            for (int ks = 0; ks < 8; ++ks) acc = MFMA32(af[ks], bfr[ks], acc);
        }
        LAS float* red = (LAS float*)L + tb * 1024;
        if (kh == 1) {
#pragma unroll
            for (int i = 0; i < 8; ++i) red[i * 64 + lane] = acc[i]; }
        WG_BAR();
        if (kh == 0) {
            const f32x4 p0 = *(const GAS f32x4*)(ssp + (size_t)tok * 16), p1 = *(const GAS f32x4*)(ssp + (size_t)tok * 16 + 4), p2 = *(const GAS f32x4*)(ssp + (size_t)tok * 16 + 8), p3 = *(const GAS f32x4*)(ssp + (size_t)tok * 16 + 12);
            const float ss = ((p0[0] + p0[1]) + (p0[2] + p0[3])) + ((p1[0] + p1[1]) + (p1[2] + p1[3])) + ((p2[0] + p2[1]) + (p2[2] + p2[3])) + ((p3[0] + p3[1]) + (p3[2] + p3[3]));
            const float rstd = __builtin_amdgcn_rsqf(ss * (1.0f / 1024.0f) + EPS);
            float v[8];
#pragma unroll
            for (int i = 0; i < 8; ++i) v[i] = (acc[i] + red[i * 64 + lane]) * rstd;
            typedef unsigned u2v __attribute__((ext_vector_type(2)));
            u2v w0, w1; w0.x = cvtpk(v[0], v[1]); w0.y = cvtpk(v[2], v[3]); w1.x = cvtpk(v[4], v[5]); w1.y = cvtpk(v[6], v[7]);
            *(GAS u2v*)(ALOW + (size_t)tok * 16 + 4 * h2) = w0; *(GAS u2v*)(ALOW + (size_t)tok * 16 + 8 + 4 * h2) = w1;
        }
        WG_BAR();
    }
}
__device__ __forceinline__ void gla_phase_a(const Frame& F0, int li) {
    const Frame F = relaunder(F0);
    unsigned char* ws = WSP();
    const bf16* P = (const bf16*)(ws + WS_ACT); bf16* SKV = (bf16*)OUTP(); float* DEC = (float*)(ws + WS_DEC); const bf16* ALOWP = (const bf16*)(ws + WS_ALOW);
    LAS unsigned char* L = F.lds;
    const int wave = F.wave, db = wave & 3, jh = wave >> 2;
    v4u kR[4], vR[8], aR; int hcur = -1;
    {   const int it = F.bid; if (it < 1024) { const int bh = it >> 5, g = it & 31, b = bh >> 2, h = bh & 3;
            tile_ld<128, 128>(kR, P + HM(G_K, 4, 128, b, h) + g * 128 * 128, 128, F.tid); tile_ld<128, 256>(vR, P + HM(G_V, 4, 256, b, h) + g * 128 * 256, 256, F.tid); aR = gla_ld_alow(F.tid, ALOWP + ((size_t)b * SEQ + g * 128) * 16); } }
    for (int it = F.bid; it < 1024; it += F.G) {
        const int bh = it >> 5, h = bh & 3;
        const int lane = lndv(F.lane), r = lane & 31, h2 = lane >> 5;
        tile_st<128, 128>(kR, L + GA_KI, PR, F.tid); tile_st<128, 256>(vR, L + GA_VI, PT256, F.tid); gla_st_alow(F.tid, aR, L + GA_AL);
        if (h != hcur) { gla_stage_w(F, L + GA_W2, (LAS float*)(L + GA_BA), li, h); hcur = h; }
        WG_BAR();
        {   const int nx = it + F.G; if (nx < 1024) { const int bh2 = nx >> 5, g2 = nx & 31, b2 = bh2 >> 2, h2n = bh2 & 3;
                tile_ld<128, 128>(kR, P + HM(G_K, 4, 128, b2, h2n) + g2 * 128 * 128, 128, F.tid); tile_ld<128, 256>(vR, P + HM(G_V, 4, 256, b2, h2n) + g2 * 128 * 256, 256, F.tid); aR = gla_ld_alow(F.tid, ALOWP + ((size_t)b2 * SEQ + g2 * 128) * 16); } }
        float Bc[2][16], Blast;
        gla_cumsum(Bc, Blast, L + GA_AL, L + GA_W2, (const LAS float*)(L + GA_BA), (LAS float*)(L + GA_EX), wave, lane);
#pragma unroll
        for (int t = 0; t < 2; ++t)
#pragma unroll
            for (int i = 0; i < 16; ++i) { const int row = (jh * 2 + t) * 32 + crow(i, h2), col = db * 32 + r;
                const float kv = bf2f(*(const LAS bf16*)(L + GA_KI + row * PR + col * 2)) * __builtin_amdgcn_exp2f((Blast - Bc[t][i]) * LOG2E);
                *(LAS bf16*)(L + GA_KD + row * PT + col * 2) = cvt1(kv); }
        if (jh == 0 && h2 == 0) DEC[(size_t)it * 128 + db * 32 + r] = __builtin_amdgcn_exp2f(Blast * LOG2E);
        WG_BAR();
        f32x16 acc[4];
#pragma unroll
        for (int t = 0; t < 4; ++t) acc[t] = (f32x16){0.f, 0.f, 0.f, 0.f, 0.f, 0.f, 0.f, 0.f, 0.f, 0.f, 0.f, 0.f, 0.f, 0.f, 0.f, 0.f};
#pragma unroll
        for (int ks = 0; ks < 8; ++ks) { const bf16x8 a = ld_tr(L + GA_KD, PT, 16 * ks, db * 32, lane);
#pragma unroll
            for (int t = 0; t < 4; ++t) acc[t] = MFMA32(a, ld_tr(L + GA_VI, PT256, 16 * ks, (4 * jh + t) * 32, lane), acc[t]); }
        WG_BAR();
#pragma unroll
        for (int t = 0; t < 4; ++t)
#pragma unroll
            for (int i = 0; i < 16; ++i) *(LAS bf16*)(L + GA_OI + (db * 32 + crow(i, h2)) * PO256 + ((4 * jh + t) * 32 + r) * 2) = cvt1(acc[t][i]);
        WG_BAR();
        {   bf16* out = SKV + (size_t)it * 128 * 256;
#pragma unroll
            for (int i = 0; i < 8; ++i) { const int c = F.tid + i * NTHREADS, row = c >> 5, cc = c & 31; *(GAS v4u*)(out + row * 256 + cc * 8) = *(const LAS v4u*)(L + GA_OI + row * PO256 + cc * 16); } }
        WG_BAR();
    }
}
__device__ __forceinline__ void gla_phase_b(const Frame& F0) {
    const Frame F = relaunder(F0);
    unsigned char* ws = WSP();
    bf16* SKV = (bf16*)OUTP(); const float* DEC = (const float*)(ws + WS_DEC);
    for (int gt = F.bid * NTHREADS + F.tid; gt < 32 * 128 * 32; gt += F.G * NTHREADS) {
        const int bh = gt >> 12, d = (gt >> 5) & 127, e8 = gt & 31;
        float s[8];
#pragma unroll
        for (int i = 0; i < 8; ++i) s[i] = 0.f;
        for (int g0 = 0; g0 < 32; g0 += 8) {
            v4u kv[8]; float dc[8];
#pragma unroll
            for (int u = 0; u < 8; ++u) { const size_t item = (size_t)bh * 32 + g0 + u; kv[u] = *(const GAS v4u*)(SKV + (item * 128 + d) * 256 + e8 * 8); dc[u] = ((const GAS float*)DEC)[item * 128 + d]; }
#pragma unroll
            for (int u = 0; u < 8; ++u) { const size_t item = (size_t)bh * 32 + g0 + u;
                v4u o; o.x = cvtpk(s[0], s[1]); o.y = cvtpk(s[2], s[3]); o.z = cvtpk(s[4], s[5]); o.w = cvtpk(s[6], s[7]);
                *(GAS v4u*)(SKV + (item * 128 + d) * 256 + e8 * 8) = o;
#pragma unroll
                for (int i = 0; i < 4; ++i) { s[2 * i] = dc[u] * s[2 * i] + bflo(kv[u][i]); s[2 * i + 1] = dc[u] * s[2 * i + 1] + bfhi(kv[u][i]); } }
        }
    }
}
__device__ __forceinline__ void gla_phase_c(const Frame& F0, int li) {
    const Frame F = relaunder(F0);
    unsigned char* ws = WSP();
    const bf16* P = (const bf16*)(ws + WS_ACT); const bf16* SKV = (const bf16*)OUTP(); bf16* CAT = (bf16*)(ws + WS_CAT); const bf16* ALOWP = (const bf16*)(ws + WS_ALOW);
    LAS unsigned char* L = F.lds;
    const int wave = F.wave, db = wave & 3, jh = wave >> 2;
    const int ib = wave & 3, eq = wave >> 2;
    v4u qR[4], kR[4], aR; int hcur = -1;
    {   const int it = F.bid; if (it < 1024) { const int bh = it >> 5, g = it & 31, b = bh >> 2, h = bh & 3;
            tile_ld<128, 128>(qR, P + HM(G_Q, 4, 128, b, h) + g * 128 * 128, 128, F.tid); tile_ld<128, 128>(kR, P + HM(G_K, 4, 128, b, h) + g * 128 * 128, 128, F.tid); aR = gla_ld_alow(F.tid, ALOWP + ((size_t)b * SEQ + g * 128) * 16); } }
    for (int it = F.bid; it < 1024; it += F.G) {
        const int bh = it >> 5, g = it & 31, b = bh >> 2, h = bh & 3;
        const int tidl = lndv(F.tid), lane = tidl & 63, r = lane & 31, h2 = lane >> 5;
        const bf16* Vs = P + HM(G_V, 4, 256, b, h) + (size_t)g * 128 * 256; const bf16* Rs = P + HM(G_R, 4, 256, b, h) + (size_t)g * 128 * 256;
        const bf16* Sg = SKV + (size_t)it * 128 * 256;
        {   v4u sR[4], vR[4]; tile_ld<128, 128>(sR, Sg, 256, tidl); tile_ld<128, 128>(vR, Vs, 256, tidl);
            tile_st<128, 128>(qR, L + GC_QT, PR, tidl); tile_st<128, 128>(kR, L + GC_KT, PR, tidl); tile_st<128, 128>(sR, L + GC_SI, PT, tidl); tile_st<128, 128>(vR, L + GC_VI, PT, tidl); }
        gla_st_alow(tidl, aR, L + GC_AL);
        if (h != hcur) { gla_stage_w(F, L + GC_W2, (LAS float*)(L + GC_BA), li, h); hcur = h; }
        WG_BAR();
        {
            float Bc[2][16], Blast;
            gla_cumsum(Bc, Blast, L + GC_AL, L + GC_W2, (const LAS float*)(L + GC_BA), (LAS float*)(L + GC_EX), wave, lane);
#pragma unroll
            for (int t = 0; t < 2; ++t)
#pragma unroll
                for (int i = 0; i < 16; ++i) { const int off = ((jh * 2 + t) * 32 + crow(i, h2)) * PR + (db * 32 + r) * 2;
                    const float eb = __builtin_amdgcn_exp2f(Bc[t][i] * LOG2E);
                    const float qv = bf2f(*(const LAS bf16*)(L + GC_QT + off)) * eb * 0.08838834764831845f;
                    const float kv = bf2f(*(const LAS bf16*)(L + GC_KT + off)) * __builtin_amdgcn_rcpf(eb);
                    *(LAS bf16*)(L + GC_QT + off) = cvt1(qv); *(LAS bf16*)(L + GC_KT + off) = cvt1(kv); }
        }
        WG_BAR();
        bf16x8 PA[4][2];
#pragma unroll
        for (int jb = 0; jb < 4; ++jb) {
            if (jb <= ib) {
                f32x16 x = {0.f, 0.f, 0.f, 0.f, 0.f, 0.f, 0.f, 0.f, 0.f, 0.f, 0.f, 0.f, 0.f, 0.f, 0.f, 0.f};
#pragma unroll
                for (int ks = 0; ks < 8; ++ks) x = MFMA32(ld_row(L + GC_KT, PR, jb * 32, 16 * ks, r, h2), ld_row(L + GC_QT, PR, ib * 32, 16 * ks, r, h2), x);
                if (jb == ib) {
#pragma unroll
                    for (int i = 0; i < 16; ++i) if (crow(i, h2) > r) x[i] = 0.f; }
                PA[jb][0] = PACK_STEP(x, 0); PA[jb][1] = PACK_STEP(x, 1);
            } else { PA[jb][0] = (bf16x8){0, 0, 0, 0, 0, 0, 0, 0}; PA[jb][1] = (bf16x8){0, 0, 0, 0, 0, 0, 0, 0}; }
        }
        f32x16 o[2][2];
        v4u s1R[4], v1R[4];
        tile_ld<128, 128>(s1R, Sg + 128, 256, tidl); tile_ld<128, 128>(v1R, Vs + 128, 256, tidl);
#pragma unroll
        for (int half = 0; half < 2; ++half) {
            if (half == 1) {
                WG_BAR();
                tile_st<128, 128>(s1R, L + GC_SI, PT, tidl); tile_st<128, 128>(v1R, L + GC_VI, PT, tidl);
                WG_BAR();
            }
#pragma unroll
            for (int t = 0; t < 2; ++t) {
                const int eb = 2 * eq + t;
                f32x16 acc = {0.f, 0.f, 0.f, 0.f, 0.f, 0.f, 0.f, 0.f, 0.f, 0.f, 0.f, 0.f, 0.f, 0.f, 0.f, 0.f};
#pragma unroll
                for (int jb = 0; jb < 4; ++jb) if (jb <= ib) {
#pragma unroll
                    for (int s = 0; s < 2; ++s) acc = MFMA32(PA[jb][s], ld_tr_perm(L + GC_VI, PT, jb * 32 + 16 * s, eb * 32, lane), acc); }
#pragma unroll
                for (int ks = 0; ks < 8; ++ks) acc = MFMA32(ld_row(L + GC_QT, PR, ib * 32, 16 * ks, r, h2), ld_tr(L + GC_SI, PT, 16 * ks, eb * 32, lane), acc);
                o[half][t] = acc;
            }
        }
        WG_BAR();
#pragma unroll
        for (int half = 0; half < 2; ++half)
#pragma unroll
            for (int t = 0; t < 2; ++t)
#pragma unroll
                for (int i = 0; i < 16; ++i) *(LAS bf16*)(L + GC_OI + (ib * 32 + crow(i, h2)) * PO256 + (half * 128 + (2 * eq + t) * 32 + r) * 2) = cvt1(o[half][t][i]);
        WG_BAR();
        {   const int nx = (it + F.G < 1024) ? it + F.G : it;
            const int bh2 = nx >> 5, g2 = nx & 31, hn = bh2 & 3, bn = bh2 >> 2;
            tile_ld<128, 128>(qR, P + HM(G_Q, 4, 128, bn, hn) + g2 * 128 * 128, 128, tidl); tile_ld<128, 128>(kR, P + HM(G_K, 4, 128, bn, hn) + g2 * 128 * 128, 128, tidl); aR = gla_ld_alow(tidl, ALOWP + ((size_t)bn * SEQ + g2 * 128) * 16); }
        {
            const int tid2 = lndv(tidl), row = tid2 >> 2, qtr = tid2 & 3;
            lcp orow = L + GC_OI + row * PO256 + qtr * 128;
            const bf16* gp = Rs + (size_t)row * 256 + qtr * 64;
            float sum = 0.f;
#pragma unroll
            for (int c = 0; c < 8; ++c) { const v4u w = *(const LAS v4u*)(orow + c * 16);
#pragma unroll
                for (int i = 0; i < 4; ++i) sum += bflo(w[i]) + bfhi(w[i]); }
            sum += xsw<1>(sum); sum += xsw<2>(sum);
            const float mu = sum * (1.0f / 256.0f); float sq = 0.f;
#pragma unroll
            for (int c = 0; c < 8; ++c) { const v4u w = *(const LAS v4u*)(orow + c * 16);
#pragma unroll
                for (int i = 0; i < 4; ++i) { const float d0 = bflo(w[i]) - mu, d1 = bfhi(w[i]) - mu; sq += d0 * d0 + d1 * d1; } }
            sq += xsw<1>(sq); sq += xsw<2>(sq);
            float eps_ = EPS; asm volatile("" : "+v"(eps_)); const float rstd = 1.0f / sqrtf(sq * (1.0f / 256.0f) + eps_);
            bf16* op = CAT + ((size_t)b * SEQ + g * 128 + row) * D + h * 256 + qtr * 64;
#pragma unroll
            for (int c = 0; c < 8; ++c) { const v4u gw = *(const GAS v4u*)(gp + c * 8); const v4u w = *(const LAS v4u*)(orow + c * 16); v4u ow;
#pragma unroll
                for (int i = 0; i < 4; ++i) { const float g0 = bflo(gw[i]), g1 = bfhi(gw[i]);
                    ow[i] = cvtpk((bflo(w[i]) - mu) * rstd * silu_f(g0), (bfhi(w[i]) - mu) * rstd * silu_f(g1)); }
                *(GAS v4u*)(op + c * 8) = ow; }
        }
        WG_BAR();
    }
}


constexpr size_t WS_OD = 408 * MiB;
constexpr size_t OUT_LSE = 32 * MiB;
constexpr size_t WS_END2 = 504 * MiB;
constexpr int RA_KI = 0, RA_VD = RA_KI + 128 * PT, RA_END = RA_VD + 128 * PT;
constexpr int RC_QI = 0, RC_KI = RC_QI + 128 * PR, RC_VI = RC_KI + 128 * PR, RC_SI = RC_VI + 128 * PT, RC_END = RC_SI + 128 * PT;
constexpr int DPK = 144, DPV = 192;
constexpr int DL_KI = 0, DL_VI = DL_KI + 384 * DPK, DL_LW = DL_VI + 384 * DPV, DL_END = DL_LW + 8 * 256;
constexpr int DL_ST = DL_KI;
static_assert(RC_END <= LDSCTL_OFF && DL_END <= LDSCTL_OFF && 8 * 32 * DPK <= 384 * DPK, "even mixer LDS maps");
__device__ __forceinline__ float ret_log2g(int h) { return log2f(1.0f - exp2f(-5.0f - (float)h)); }

__device__ __forceinline__ void ret_phase_a_items(const Frame& F, const bf16* P, bf16* RKV) {
    LAS unsigned char* L = F.lds;
    const int wave = F.wave, db = wave & 3, eh = wave >> 2;
    v4u kR[4], vR[4];
    {   const int it = F.bid < 1024 ? F.bid : 0; const int bh = it >> 5, n = it & 31;
        tile_ld<128, 128>(kR, P + HM(E_RK, 4, 128, bh >> 2, bh & 3) + n * 128 * 128, 128, F.tid); tile_ld<128, 128>(vR, P + HM(E_RV, 4, 128, bh >> 2, bh & 3) + n * 128 * 128, 128, F.tid); }
    for (int it = F.bid; it < 1024; it += F.G) {
        const int tidl = lndv(F.tid), lane = tidl & 63, r = lane & 31, h2 = lane >> 5;
        const int bh = it >> 5, h = bh & 3;
        const float lg = ret_log2g(h);
        tile_st<128, 128>(kR, L + RA_KI, PT, tidl);
        {
#pragma unroll
            for (int i = 0; i < 4; ++i) { const int row = (tidl >> 4) + 32 * i, cc = tidl & 15; const float f = __builtin_amdgcn_exp2f(lg * (float)(127 - row)); v4u o;
#pragma unroll
                for (int k = 0; k < 4; ++k) o[k] = cvtpk(bflo(vR[i][k]) * f, bfhi(vR[i][k]) * f);
                *(LAS v4u*)(L + RA_VD + row * PT + cc * 16) = o; }
        }
        WG_BAR();
        {   const int nx = (it + F.G < 1024) ? it + F.G : it; const int bh2 = nx >> 5, n2 = nx & 31;
            tile_ld<128, 128>(kR, P + HM(E_RK, 4, 128, bh2 >> 2, bh2 & 3) + n2 * 128 * 128, 128, tidl); tile_ld<128, 128>(vR, P + HM(E_RV, 4, 128, bh2 >> 2, bh2 & 3) + n2 * 128 * 128, 128, tidl); }
        f32x16 acc[2];
#pragma unroll
        for (int t = 0; t < 2; ++t) acc[t] = (f32x16){0.f, 0.f, 0.f, 0.f, 0.f, 0.f, 0.f, 0.f, 0.f, 0.f, 0.f, 0.f, 0.f, 0.f, 0.f, 0.f};
#pragma unroll
        for (int ks = 0; ks < 8; ++ks) { const bf16x8 a = ld_tr(L + RA_KI, PT, 16 * ks, db * 32, lane);
#pragma unroll
            for (int t = 0; t < 2; ++t) acc[t] = MFMA32(a, ld_tr(L + RA_VD, PT, 16 * ks, (2 * eh + t) * 32, lane), acc[t]); }
        WG_BAR();
#pragma unroll
        for (int t = 0; t < 2; ++t)
#pragma unroll
            for (int i = 0; i < 16; ++i) *(LAS bf16*)(L + RA_KI + (db * 32 + crow(i, h2)) * PR + ((2 * eh + t) * 32 + r) * 2) = cvt1(acc[t][i]);
        WG_BAR();
        bf16* out = RKV + (size_t)it * 128 * 128;
#pragma unroll
        for (int i = 0; i < 4; ++i) { const int row = (tidl >> 4) + 32 * i, cc = tidl & 15; *(GAS v4u*)(out + row * 128 + cc * 8) = *(const LAS v4u*)(L + RA_KI + row * PR + cc * 16); }
        WG_BAR();
    }
}
__device__ __forceinline__ void ret_scan(const Frame& F, bf16* RKV) {
    for (int gt = F.bid * NTHREADS + F.tid; gt < 32 * 128 * 32; gt += F.G * NTHREADS) {
        const int bh = gt >> 12, d = (gt >> 5) & 127, e4 = gt & 31, h = bh & 3;
        const float g128 = __builtin_amdgcn_exp2f(ret_log2g(h) * 128.0f);
        float s[4];
#pragma unroll
        for (int i = 0; i < 4; ++i) s[i] = 0.f;
        typedef unsigned u2v __attribute__((ext_vector_type(2)));
        for (int n0 = 0; n0 < 32; n0 += 8) {
            u2v kv[8];
#pragma unroll
            for (int u = 0; u < 8; ++u) kv[u] = *(const GAS u2v*)(RKV + (((size_t)bh * 32 + n0 + u) * 128 + d) * 128 + e4 * 4);
#pragma unroll
            for (int u = 0; u < 8; ++u) {
                u2v o; o.x = cvtpk(s[0], s[1]); o.y = cvtpk(s[2], s[3]);
                *(GAS u2v*)(RKV + (((size_t)bh * 32 + n0 + u) * 128 + d) * 128 + e4 * 4) = o;
#pragma unroll
                for (int i = 0; i < 2; ++i) { s[2 * i] = g128 * s[2 * i] + bflo(kv[u][i]); s[2 * i + 1] = g128 * s[2 * i + 1] + bfhi(kv[u][i]); } }
        }
    }
}
__device__ __forceinline__ void ret_phase_c_items(const Frame& F, const bf16* P, const bf16* RKV, bf16* CAT) {
    LAS unsigned char* L = F.lds;
    const int wave = F.wave, ib = wave & 3, eq = wave >> 2;
    v4u qR[4], kR[4];
    {   const int it = F.bid < 1024 ? F.bid : 0; const int bh = it >> 5, n = it & 31;
        tile_ld<128, 128>(qR, P + HM(E_RQ, 4, 128, bh >> 2, bh & 3) + n * 128 * 128, 128, F.tid); tile_ld<128, 128>(kR, P + HM(E_RK, 4, 128, bh >> 2, bh & 3) + n * 128 * 128, 128, F.tid); }
    for (int it = F.bid; it < 1024; it += F.G) {
        const int tidl = lndv(F.tid), lane = tidl & 63, r = lane & 31, h2 = lane >> 5;
        const int bh = it >> 5, n = it & 31, b = bh >> 2, h = bh & 3;
        const float lg = ret_log2g(h);
        {   v4u vR[4], sR[4]; tile_ld<128, 128>(vR, P + HM(E_RV, 4, 128, b, h) + n * 128 * 128, 128, tidl); tile_ld<128, 128>(sR, RKV + (size_t)it * 128 * 128, 128, tidl);
#pragma unroll
            for (int i = 0; i < 4; ++i) { const int row = (tidl >> 4) + 32 * i, cc = tidl & 15; const float fq = __builtin_amdgcn_exp2f(lg * (float)row), fk = __builtin_amdgcn_rcpf(fq); v4u oq, ok;
#pragma unroll
                for (int k = 0; k < 4; ++k) { oq[k] = cvtpk(bflo(qR[i][k]) * fq, bfhi(qR[i][k]) * fq); ok[k] = cvtpk(bflo(kR[i][k]) * fk, bfhi(kR[i][k]) * fk); }
                *(LAS v4u*)(L + RC_QI + row * PR + cc * 16) = oq; *(LAS v4u*)(L + RC_KI + row * PR + cc * 16) = ok; }
            tile_st<128, 128>(vR, L + RC_VI, PT, tidl); tile_st<128, 128>(sR, L + RC_SI, PT, tidl); }
        WG_BAR();
        bf16x8 PA[4][2];
#pragma unroll
        for (int jb = 0; jb < 4; ++jb) {
            if (jb <= ib) {
                f32x16 x = {0.f, 0.f, 0.f, 0.f, 0.f, 0.f, 0.f, 0.f, 0.f, 0.f, 0.f, 0.f, 0.f, 0.f, 0.f, 0.f};
#pragma unroll
                for (int ks = 0; ks < 8; ++ks) x = MFMA32(ld_row(L + RC_KI, PR, jb * 32, 16 * ks, r, h2), ld_row(L + RC_QI, PR, ib * 32, 16 * ks, r, h2), x);
                if (jb == ib) {
#pragma unroll
                    for (int i = 0; i < 16; ++i) if (crow(i, h2) > r) x[i] = 0.f; }
                PA[jb][0] = PACK_STEP(x, 0); PA[jb][1] = PACK_STEP(x, 1);
            } else { PA[jb][0] = (bf16x8){0, 0, 0, 0, 0, 0, 0, 0}; PA[jb][1] = (bf16x8){0, 0, 0, 0, 0, 0, 0, 0}; }
        }
        f32x16 o[2];
#pragma unroll
        for (int t = 0; t < 2; ++t) {
            const int eb = 2 * eq + t;
            f32x16 z = {0.f, 0.f, 0.f, 0.f, 0.f, 0.f, 0.f, 0.f, 0.f, 0.f, 0.f, 0.f, 0.f, 0.f, 0.f, 0.f}, y = z;
#pragma unroll
            for (int jb = 0; jb < 4; ++jb) if (jb <= ib) {
#pragma unroll
                for (int s = 0; s < 2; ++s) z = MFMA32(PA[jb][s], ld_tr_perm(L + RC_VI, PT, jb * 32 + 16 * s, eb * 32, lane), z); }
#pragma unroll
            for (int ks = 0; ks < 8; ++ks) y = MFMA32(ld_row(L + RC_QI, PR, ib * 32, 16 * ks, r, h2), ld_tr(L + RC_SI, PT, 16 * ks, eb * 32, lane), y);
            const float g1 = __builtin_amdgcn_exp2f(lg);
#pragma unroll
            for (int i = 0; i < 16; ++i) z[i] += y[i] * g1;
            o[t] = z;
        }
        WG_BAR();
#pragma unroll
        for (int t = 0; t < 2; ++t)
#pragma unroll
            for (int i = 0; i < 16; ++i) *(LAS bf16*)(L + RC_QI + (ib * 32 + crow(i, h2)) * PR + ((2 * eq + t) * 32 + r) * 2) = cvt1(o[t][i]);
        WG_BAR();
        {   const int nx = (it + F.G < 1024) ? it + F.G : it; const int bh2 = nx >> 5, n2 = nx & 31;
            tile_ld<128, 128>(qR, P + HM(E_RQ, 4, 128, bh2 >> 2, bh2 & 3) + n2 * 128 * 128, 128, tidl); tile_ld<128, 128>(kR, P + HM(E_RK, 4, 128, bh2 >> 2, bh2 & 3) + n2 * 128 * 128, 128, tidl); }
        {
            const int tid2 = lndv(tidl), row = tid2 >> 2, qtr = tid2 & 3;
            lcp orow = L + RC_QI + row * PR + qtr * 64;
            v4u w[4]; float sum = 0.f;
#pragma unroll
            for (int c = 0; c < 4; ++c) { w[c] = *(const LAS v4u*)(orow + c * 16);
#pragma unroll
                for (int i = 0; i < 4; ++i) sum += bflo(w[c][i]) + bfhi(w[c][i]); }
            sum += xsw<1>(sum); sum += xsw<2>(sum);
            const float mu = sum * (1.0f / 128.0f); float sq = 0.f;
#pragma unroll
            for (int c = 0; c < 4; ++c)
#pragma unroll
                for (int i = 0; i < 4; ++i) { const float d0 = bflo(w[c][i]) - mu, d1 = bfhi(w[c][i]) - mu; sq += d0 * d0 + d1 * d1; }
            sq += xsw<1>(sq); sq += xsw<2>(sq);
            float eps_ = EPS; asm volatile("" : "+v"(eps_)); const float rstd = 1.0f / sqrtf(sq * (1.0f / 128.0f) + eps_);
            const bf16* gp = P + HM(E_RG, 4, 128, b, h) + (size_t)(n * 128 + row) * 128 + qtr * 32;
            bf16* op = CAT + ((size_t)b * SEQ + n * 128 + row) * D + h * 128 + qtr * 32;
#pragma unroll
            for (int c = 0; c < 4; ++c) { const v4u gw = *(const GAS v4u*)(gp + c * 8); v4u ow;
#pragma unroll
                for (int i = 0; i < 4; ++i) { const float g0 = bflo(gw[i]), g1 = bfhi(gw[i]);
                    ow[i] = cvtpk((bflo(w[c][i]) - mu) * rstd * silu_f(g0), (bfhi(w[c][i]) - mu) * rstd * silu_f(g1)); }
                *(GAS v4u*)(op + c * 8) = ow; }
        }
        WG_BAR();
    }
}
struct DilTile { int b, head, p, dil, res, q0; };
template <bool FUSE> __device__ __forceinline__ DilTile dil_decode(int T) { DilTile t;
    if (FUSE) { t.b = T >> 7; t.head = T & 7; t.p = 0; t.dil = 1; t.res = 0; t.q0 = ((T >> 3) & 15) * 256; }
    else { t.b = T >> 8; t.head = (T >> 5) & 7; const int t32 = T & 31, hi = t32 >> 3, lo = t32 & 3;
        t.p = 1 + (((t32 >> 2) ^ t.b) & 1);
        if (t.p == 1) { t.dil = 4; t.res = lo; t.q0 = ((hi + (t.b >> 1)) & 3) * 256; }
        else { t.dil = 16; t.res = hi * 4 + lo; t.q0 = 0; } }
    return t; }
__device__ __forceinline__ void dil_ld(v4u (&kR)[6], v4u (&vR)[6], const DilTile& t, const bf16* P, int tid) {
    const bf16* Kb = P + HM(E_DK, 8, 64, t.b, t.head) + (tid & 7) * 8; const bf16* Vb = P + HM(E_DV, 8, 64, t.b, t.head) + (tid & 7) * 8;
#pragma unroll
    for (int i = 0; i < 6; ++i) { int kidx = t.q0 - 128 + (tid >> 3) + 64 * i; kidx = kidx < 0 ? 0 : kidx;
        const size_t ro = (size_t)(kidx * t.dil + t.res) * 64; kR[i] = *(const GAS v4u*)(Kb + ro); vR[i] = *(const GAS v4u*)(Vb + ro); }
}
template <bool FUSE> __device__ __forceinline__ void dil_tiles(const Frame& F, int T0, int T1, int step, const bf16* P, bf16* OD, float* LSE, bf16* CAT) {
    LAS unsigned char* L = F.lds;
    const int wave = F.wave;
    if (T0 >= T1) return;
    v4u kR[6], vR[6];
    { const DilTile t0 = dil_decode<FUSE>(T0); dil_ld(kR, vR, t0, P, F.tid); }
    for (int T = T0; T < T1; T += step) {
        const int tidl = lndv(F.tid), lane = tidl & 63, r = lane & 31, h2 = lane >> 5;
        const DilTile t = dil_decode<FUSE>(T);
#pragma unroll
        for (int i = 0; i < 6; ++i) { const int row = (tidl >> 3) + 64 * i, cc = tidl & 7; *(LAS v4u*)(L + DL_KI + row * DPK + cc * 16) = kR[i]; *(LAS v4u*)(L + DL_VI + row * DPV + cc * 16) = vR[i]; }
        bf16x8 qf[4];
        { const bf16* qsrc = P + HM(E_DQ, 8, 64, t.b, t.head) + (size_t)((t.q0 + 32 * wave + r) * t.dil + t.res) * 64 + 8 * h2;
#pragma unroll
          for (int ks = 0; ks < 4; ++ks) qf[ks] = *(const GAS bf16x8*)(qsrc + 16 * ks); }
        WG_BAR();
        { const DilTile tn = dil_decode<FUSE>(T + step < T1 ? T + step : T); dil_ld(kR, vR, tn, P, tidl); }
        f32x16 x[5];
        float ninf = -INFINITY; asm volatile("" : "+v"(ninf));
        float mx = ninf;
        bf16x8 kf[2][4];
#pragma unroll
        for (int ks = 0; ks < 4; ++ks) kf[0][ks] = ld_row(L + DL_KI, DPK, 32 * wave, 16 * ks, r, h2);
#pragma unroll
        for (int kb = 0; kb < 5; ++kb) {
            if (kb < 4) {
#pragma unroll
                for (int ks = 0; ks < 4; ++ks) kf[(kb + 1) & 1][ks] = ld_row(L + DL_KI, DPK, 32 * wave + 32 * (kb + 1), 16 * ks, r, h2); }
            f32x16 a = {0.f, 0.f, 0.f, 0.f, 0.f, 0.f, 0.f, 0.f, 0.f, 0.f, 0.f, 0.f, 0.f, 0.f, 0.f, 0.f};
#pragma unroll
            for (int ks = 0; ks < 4; ++ks) a = MFMA32(kf[kb & 1][ks], qf[ks], a);
            if (kb == 0) {
#pragma unroll
                for (int i = 0; i < 16; ++i) if (crow(i, h2) < r) a[i] = ninf; }
            if (kb == 4) {
#pragma unroll
                for (int i = 0; i < 16; ++i) if (crow(i, h2) > r) a[i] = ninf; }
            if (t.q0 == 0 && 32 * wave + 32 * kb < 128) {
#pragma unroll
                for (int i = 0; i < 16; ++i) a[i] = ninf; }
#pragma unroll
            for (int i = 0; i < 16; ++i) mx = fmaxf(mx, a[i]);
            x[kb] = a;
        }
        mx = max32(mx);
        constexpr float C2 = 0.125f * LOG2E;
        const float mc = mx * C2; float l = 0.f;
#pragma unroll
        for (int kb = 0; kb < 5; ++kb)
#pragma unroll
            for (int i = 0; i < 16; ++i) { const float pe = __builtin_amdgcn_exp2f(x[kb][i] * C2 - mc); x[kb][i] = pe; l += pe; }
        l = sum32(l);
        f32x16 o[2];
#pragma unroll
        for (int dbk = 0; dbk < 2; ++dbk) o[dbk] = (f32x16){0.f, 0.f, 0.f, 0.f, 0.f, 0.f, 0.f, 0.f, 0.f, 0.f, 0.f, 0.f, 0.f, 0.f, 0.f, 0.f};
        bf16x8 vf[2][2];
#pragma unroll
        for (int dbk = 0; dbk < 2; ++dbk) vf[0][dbk] = ld_tr_perm(L + DL_VI, DPV, 32 * wave, dbk * 32, lane);
#pragma unroll
        for (int idx = 0; idx < 10; ++idx) { const int kb = idx >> 1, s = idx & 1;
            if (idx < 9) {
#pragma unroll
                for (int dbk = 0; dbk < 2; ++dbk) vf[(idx + 1) & 1][dbk] = ld_tr_perm(L + DL_VI, DPV, 32 * wave + 16 * (idx + 1), dbk * 32, lane); }
            const bf16x8 pa = PACK_STEP(x[kb], s);
#pragma unroll
            for (int dbk = 0; dbk < 2; ++dbk) o[dbk] = MFMA32(pa, vf[idx & 1][dbk], o[dbk]); }
        LAS float* lw = (LAS float*)(L + DL_LW + wave * 256);
        const float lse = mx * 0.125f + LN2 * __builtin_amdgcn_logf(l);
        if (h2 == 0) { lw[r] = l; lw[32 + r] = lse; }
        WG_BAR();
        LAS unsigned char* st = L + DL_ST + wave * 32 * DPK;
#pragma unroll
        for (int i = 0; i < 16; ++i) { const float rl = __builtin_amdgcn_rcpf(lw[crow(i, h2)]);
#pragma unroll
            for (int dbk = 0; dbk < 2; ++dbk) *(LAS bf16*)(st + crow(i, h2) * DPK + (dbk * 32 + r) * 2) = cvt1(o[dbk][i] * rl); }
        const size_t tokbase = (size_t)t.b * SEQ;
        if (!FUSE) {
            bf16* odp = OD + (size_t)t.p * M * 512;
#pragma unroll
            for (int j = 0; j < 4; ++j) { const int c = lane + 64 * j, row = c >> 3, cc = c & 7; const size_t tok = tokbase + (size_t)(t.q0 + 32 * wave + row) * t.dil + t.res;
                *(GAS v4u*)(odp + tok * 512 + t.head * 64 + cc * 8) = *(const LAS v4u*)(st + row * DPK + cc * 16); }
            if (h2 == 0) { const size_t tok = tokbase + (size_t)(t.q0 + 32 * wave + r) * t.dil + t.res; LSE[((size_t)t.p * M + tok) * 8 + t.head] = lse; }
        } else {
#pragma unroll
            for (int j = 0; j < 4; ++j) { const int c = lane + 64 * j, row = c >> 3, cc = c & 7; const size_t tok = tokbase + (size_t)(t.q0 + 32 * wave + row);
                const float l0 = lw[32 + row], l1 = ((const GAS float*)LSE)[((size_t)M + tok) * 8 + t.head], l2 = ((const GAS float*)LSE)[((size_t)2 * M + tok) * 8 + t.head];
                const v4u a = *(const LAS v4u*)(st + row * DPK + cc * 16), bq = *(const GAS v4u*)(OD + ((size_t)M + tok) * 512 + t.head * 64 + cc * 8), cq = *(const GAS v4u*)(OD + ((size_t)2 * M + tok) * 512 + t.head * 64 + cc * 8);
                const float mxl = fmaxf(l0, fmaxf(l1, l2));
                float w0 = __builtin_amdgcn_exp2f((l0 - mxl) * LOG2E), w1 = __builtin_amdgcn_exp2f((l1 - mxl) * LOG2E), w2 = __builtin_amdgcn_exp2f((l2 - mxl) * LOG2E);
                const float rs = __builtin_amdgcn_rcpf(w0 + w1 + w2); w0 *= rs; w1 *= rs; w2 *= rs;
                v4u ov;
#pragma unroll
                for (int i = 0; i < 4; ++i) ov[i] = cvtpk(w0 * bflo(a[i]) + w1 * bflo(bq[i]) + w2 * bflo(cq[i]), w0 * bfhi(a[i]) + w1 * bfhi(bq[i]) + w2 * bfhi(cq[i]));
                *(GAS v4u*)(CAT + tok * D + 512 + t.head * 64 + cc * 8) = ov; }
        }
        WG_BAR();
    }
}
constexpr int DIL_TILES12 = 2048, DIL_TILES0 = 1024;
__device__ __forceinline__ void even_phase_a(const Frame& F0) {
    const Frame F = relaunder(F0);
    unsigned char* ws = WSP();
    const bf16* P = (const bf16*)(ws + WS_ACT); bf16* RKV = (bf16*)OUTP(); bf16* OD = (bf16*)(ws + WS_OD); float* LSE = (float*)((unsigned char*)OUTP() + OUT_LSE);
    ret_phase_a_items(F, P, RKV);
    dil_tiles<false>(F, F.bid, DIL_TILES12, F.G, P, OD, LSE, nullptr);
}
__device__ __forceinline__ void even_phase_b(const Frame& F0) {
    const Frame F = relaunder(F0);
    unsigned char* ws = WSP();
    const bf16* P = (const bf16*)(ws + WS_ACT); bf16* RKV = (bf16*)OUTP(); bf16* OD = (bf16*)(ws + WS_OD); float* LSE = (float*)((unsigned char*)OUTP() + OUT_LSE);
    ret_scan(F, RKV);
    dil_tiles<true>(F, F.bid, DIL_TILES0, F.G, P, OD, LSE, (bf16*)(ws + WS_CAT));
}
__device__ __forceinline__ void even_phase_c(const Frame& F0) {
    const Frame F = relaunder(F0);
    unsigned char* ws = WSP();
    const bf16* P = (const bf16*)(ws + WS_ACT); const bf16* RKV = (const bf16*)OUTP(); const bf16* OD = (const bf16*)(ws + WS_OD); const float* LSE = (const float*)((unsigned char*)OUTP() + OUT_LSE); bf16* CAT = (bf16*)(ws + WS_CAT);
    ret_phase_c_items(F, P, RKV, CAT);
}

static_assert(WS_X8 == WS_OD, "the e4m3 residual copy overlays the dilated-output buffer");
__global__ void __launch_bounds__(NTHREADS, 2) fwd_kernel(Args args) {
    extern __shared__ __attribute__((aligned(16))) unsigned char lds[];
    Frame F;
    F.lds = (LAS unsigned char*)lds;
    F.wave = __builtin_amdgcn_readfirstlane((int)(threadIdx.x >> 6)); F.lane = hw_lane(); F.tid = F.wave * 64 + F.lane; F.G = gridDim.x; F.bid = blockIdx.x;
    for (int u = F.tid; u < (LDS_BYTES - LDSCTL_OFF) / 4; u += NTHREADS) ((LAS unsigned*)(F.lds + LDSCTL_OFF))[u] = 0u;
    __syncthreads();
    if (F.tid < N_PTRS) { const unsigned long long v = (F.tid < 17) ? (unsigned long long)args.in[F.tid] : (F.tid == 17 ? (unsigned long long)args.out : (unsigned long long)args.ws);
        ((LAS unsigned*)(F.lds + PTR_OFF))[2 * F.tid] = (unsigned)v; ((LAS unsigned*)(F.lds + PTR_OFF))[2 * F.tid + 1] = (unsigned)(v >> 32); }
    __syncthreads();
    (void)xcd_barrier_post((unsigned*)(WSP() + WS_CTL) + CW_BAR, (volatile LAS unsigned*)(F.lds + MISC_OFF) + 8, F.tid);
#define GRID_BAR() do { XcdBarrier bar_; bar_.bar = (unsigned*)(WSP() + WS_CTL) + CW_BAR; bar_.x = (unsigned)__builtin_amdgcn_readfirstlane((int)xb_xcc_id()); \
        int mo_ = MISC_OFF + 32; asm volatile("" : "+s"(mo_)); bar_.st = (volatile LAS unsigned*)(F.lds + mo_); int t_ = F.wave * 64 + hw_lane_v(); xcd_barrier<0>(bar_, t_); } while (0)
#ifndef XCD_BAR_MODE
#define XCD_BAR_MODE 2
#endif
#ifdef NO_XCD_LOCAL
#define XCD_BAR() GRID_BAR()
#else
#define XCD_BAR() do { XcdBarrier bar_; bar_.bar = (unsigned*)(WSP() + WS_CTL) + CW_BAR; bar_.x = (unsigned)__builtin_amdgcn_readfirstlane((int)xb_xcc_id()); \
        int mo_ = MISC_OFF + 32; asm volatile("" : "+s"(mo_)); bar_.st = (volatile LAS unsigned*)(F.lds + mo_); int t_ = F.wave * 64 + hw_lane_v(); xcd_barrier<XCD_BAR_MODE>(bar_, t_); } while (0)
#endif
#define XB ((bf16*)(WSP() + WS_XB))
#define ACT ((bf16*)(WSP() + WS_ACT))
#define CAT ((bf16*)(WSP() + WS_CAT))
#define SSP ((float*)(WSP() + WS_SSP))
#define WPTR(off) ((const bf16*)(WSP() + (off)))

    float pro_s0; const float pro_s1 = i8_scales(F, pro_s0);
    prologue_rows(F, pro_s0);
    convert_weights(F, 0, 0, pro_s0, pro_s1);
    GRID_BAR();
    for (int s = 0; s < 8; ++s) {
        const int l = s >> 1; const bool post = (s & 1) != 0;
        if (I8ASLOT(s) && s != 0) { quant_rows(F, lnd(s)); XCD_BAR(); }
        {
            pg8::Gemm g{XB, WPTR(post ? W_GU1 : W_GU0), M, 2 * FF, D}; pg8::StaticOrder S; S.init(M, 2 * FF, lnd(F.G), lnd(F.bid));
            pg8::EpiSwiGLU E{ACT, FF, SSP, 1.0f};
            if (I8ASLOT(s)) {
                pg8::Gemm g8{(const bf16*)XB8, WPTR(post ? W_GU1 : W_GU0), M, 2 * FF, D};
                if (F8SLOT(s)) { pg8::EpiSwiGLU8I E8{ACT, FF, SSP, 1.0f}; pg8::gemm_phase<pg8::EpiSwiGLU8I, pg8::StaticOrder, true, true, false, true>(F.lds + RING_OFF, g8, S, E8, lnd(F.wave)); }
                else { pg8::EpiSwiGLUI EI{ACT, FF, SSP, 1.0f}; pg8::gemm_phase<pg8::EpiSwiGLUI, pg8::StaticOrder, true, true, false, true>(F.lds + RING_OFF, g8, S, EI, lnd(F.wave)); } }
            else if (F8ASLOT(s)) { pg8::Gemm g8{(const bf16*)XB8, WPTR(post ? W_GU1 : W_GU0), M, 2 * FF, D}; pg8::EpiSwiGLU8 E8{ACT, FF, SSP, 1.0f / (pg8::F8_XSCALE * pg8::F8_GUSCALE)};
                pg8::gemm_phase<pg8::EpiSwiGLU8, pg8::StaticOrder, true, true, true>(F.lds + RING_OFF, g8, S, E8, lnd(F.wave)); }
            else if (F8SLOT(s)) { pg8::EpiSwiGLU8 E8{ACT, FF, SSP, 1.0f}; pg8::gemm_phase<pg8::EpiSwiGLU8, pg8::StaticOrder, true, true>(F.lds + RING_OFF, g, S, E8, lnd(F.wave)); }
            else pg8::gemm_phase<pg8::EpiSwiGLU, pg8::StaticOrder, true, true>(F.lds + RING_OFF, g, S, E, lnd(F.wave));
            XCD_BAR();
        }
        {
            const bool do_conv = post ? (l + 1 < DEPTH) : (l >= 1); const int conv_l = post ? l + 1 : l, conv_part = post ? 1 : 2; const int grp = (lnd(F.bid) >> 3) & 1;
            for (int pass = 0; pass < 3; ++pass) {
                if (pass == 1) {
                    pg8::Gemm g{ACT, WPTR(post ? W_D1 : W_D0), M, D, FF}; pg8::RevOrder S; S.init(M, D, lnd(F.G), lnd(F.bid));
                    if (F8SLOT(s)) { pg8::EpiResid E{XB, SSP, 0.5f / (pg8::F8_HSCALE * pg8::F8_WSCALE), (post && F8ASLOT(s + 1)) ? XB8_D : 0}; pg8::gemm_phase<pg8::EpiResid, pg8::RevOrder, true, true, true>(F.lds + RING_OFF, g, S, E, lnd(F.wave)); }
                    else { pg8::EpiResid E{XB, SSP, 0.5f, (post && F8ASLOT(s + 1)) ? XB8_D : 0};
                    pg8::gemm_phase<pg8::EpiResid, pg8::RevOrder, true, true>(F.lds + RING_OFF, g, S, E, lnd(F.wave)); }
                } else if (do_conv && ((pass == 0) == (grp == 1))) {
                    convert_weights(F, conv_l, conv_part);
                    __syncthreads();
                }
            }
            if (s == 7) XCD_BAR(); else GRID_BAR();
        }
        if (!post) {
            const bool odd = (l & 1) != 0; const int nin = odd ? 3072 : EVEN_IN;
            {
                pg8::Gemm g{XB, WPTR(W_IN), M, nin, D}; pg8::StaticOrder S; S.init(M, nin, lnd(F.G), lnd(F.bid));
                pg8::EpiInProj E{ACT, nin, SSP, (const float*)(WSP() + TAB_RC), (const float*)(WSP() + TAB_RS), (const float*)(WSP() + TAB_DC), (const float*)(WSP() + TAB_DS), odd ? 0 : 1};
                pg8::gemm_phase<pg8::EpiInProj, pg8::StaticOrder, true, true>(F.lds + RING_OFF, g, S, E, lnd(F.wave));
            }
            if (odd) gla_alow(F);
            GRID_BAR();
            if (!odd) { even_phase_a(F); GRID_BAR(); even_phase_b(F); GRID_BAR(); even_phase_c(F); }
            else { gla_phase_a(F, l >> 1); GRID_BAR(); gla_phase_b(F); GRID_BAR(); gla_phase_c(F, l >> 1); }
            GRID_BAR();
            {
                pg8::Gemm g{CAT, WPTR(W_OUT), M, D, D}; pg8::StaticOrder S; S.init(M, D, lnd(F.G), lnd(F.bid));
                pg8::EpiResid E{XB, SSP, 1.0f, F8ASLOT(s + 1) ? XB8_D : 0};
                pg8::gemm_phase<pg8::EpiResid, pg8::StaticOrder, true, true>(F.lds + RING_OFF, g, S, E, lnd(F.wave));
                XCD_BAR();
            }
        }
    }
    final_norm(F);
}

extern "C" void kernel_launch(void* const* d_in, const int* in_sizes, int n_in, void* d_out, int out_size, void* d_ws, size_t ws_size, hipStream_t stream) {
    static int grid = 0;
    if (grid == 0) {
        if (n_in != 17 || in_sizes[0] != M * D || out_size != M * D || ws_size < WS_END2) { fprintf(stderr, "kernel_launch: unexpected shapes (n_in %d, in0 %d, out %d, ws %zu)\n", n_in, n_in > 0 ? in_sizes[0] : -1, out_size, ws_size); grid = -1; return; }
        int dev = 0, cus = 0, per_cu = 0;
        if (hipGetDevice(&dev) != hipSuccess || hipDeviceGetAttribute(&cus, hipDeviceAttributeMultiprocessorCount, dev) != hipSuccess) { grid = -1; return; }
        if (hipFuncSetAttribute((const void*)fwd_kernel, hipFuncAttributeMaxDynamicSharedMemorySize, LDS_BYTES) != hipSuccess) { fprintf(stderr, "kernel_launch: hipFuncSetAttribute failed\n"); grid = -1; return; }
        if (hipOccupancyMaxActiveBlocksPerMultiprocessor(&per_cu, (const void*)fwd_kernel, NTHREADS, LDS_BYTES) != hipSuccess || per_cu < 1) { fprintf(stderr, "kernel_launch: occupancy query reports %d\n", per_cu); }
        (void)hipGetLastError();
        grid = cus;
        if (grid != 256) fprintf(stderr, "kernel_launch: %d CUs (expected 256)\n", grid);
    }
    if (grid < 0) return;
    if (hipMemsetAsync((char*)d_ws + WS_CTL, 0, CTL_ZERO_BYTES, stream) != hipSuccess) return;
    Args a{};
    for (int i = 0; i < 17; ++i) a.in[i] = (const float*)d_in[i];
    a.out = (float*)d_out; a.ws = (unsigned char*)d_ws;
    hipLaunchKernelGGL(fwd_kernel, dim3(grid), dim3(NTHREADS), LDS_BYTES, stream, a);
}
```

```cpp
#include <hip/hip_runtime.h>
#include <cstdio>
#include <cstdint>
#include <cmath>
template <int K> __device__ __forceinline__ float xsw(float v) { static_assert(K == 1 || K == 2 || K == 4 || K == 8 || K == 16, "xor mask inside a 32-lane half");
    return __builtin_bit_cast(float, __builtin_amdgcn_ds_swizzle(__builtin_bit_cast(int, v), 0x1F | (K << 10))); }
__device__ __forceinline__ float sum32(float v) { const unsigned u = __builtin_bit_cast(unsigned, v); auto rr = __builtin_amdgcn_permlane32_swap(u, u, false, false); return __builtin_bit_cast(float, (unsigned)rr[0]) + __builtin_bit_cast(float, (unsigned)rr[1]); }
__device__ __forceinline__ float max32(float v) { const unsigned u = __builtin_bit_cast(unsigned, v); auto rr = __builtin_amdgcn_permlane32_swap(u, u, false, false); return fmaxf(__builtin_bit_cast(float, (unsigned)rr[0]), __builtin_bit_cast(float, (unsigned)rr[1])); }
__device__ __forceinline__ float oth32(float v, int h) { const unsigned u = __builtin_bit_cast(unsigned, v); auto rr = __builtin_amdgcn_permlane32_swap(u, u, false, false); return __builtin_bit_cast(float, (unsigned)(h ? rr[0] : rr[1])); }
#ifndef PG8_WGM
#define PG8_WGM 8
#endif
namespace pg8 {
#define PG8_LAS __attribute__((address_space(3)))
typedef unsigned short bf16_t;
typedef short bf16x8 __attribute__((ext_vector_type(8)));
typedef float f32x4 __attribute__((ext_vector_type(4)));
typedef unsigned u32x4 __attribute__((ext_vector_type(4)));
constexpr int BM = 256, BK = 64, HALF = 128, HTB = HALF * BK * 2  , STAGE_BYTES = 8 * HTB, NXCD = 8, WGM = PG8_WGM;

__host__ __device__ __forceinline__ int lds_byte(int r, int c) { const int st = (r >> 4) * 2 + (c >> 5), rr = r & 15, cc = c & 31, ob = rr * 64 + cc * 2; return st * 1024 + (ob ^ (((ob >> 9) & 1) << 5)); }
__host__ __device__ __forceinline__ void stage_rc(int b, int& R, int& C) { const int st = b / 1024, sb = b % 1024, swz = sb ^ (((sb >> 9) & 1) << 5); R = (st >> 1) * 16 + swz / 64; C = (st & 1) * 32 + (swz % 64) / 2; }
__host__ __device__ __forceinline__ int perm32(int rho) { const int n = rho >> 4, i = rho & 15; return 8 * (i >> 2) + 4 * n + (i & 3); }

struct Unit { int pm, pn; };
struct Gemm { const bf16_t* A; const bf16_t* Bt; int M, N, K; };

struct StaticOrder {
    int nM, nN, nwg, G, c;
    __host__ __device__ void init(int M, int N, int G_, int c_) { nM = M / BM; nN = N / BM; nwg = nM * nN; G = G_; c = c_; }
    __host__ __device__ bool next(int i, Unit& u) const {
        const long L = (long)i * G + c; if (L >= nwg) return false;
        int wgid = (int)L; { const int q = nwg / NXCD, r = nwg % NXCD, xcd = wgid % NXCD, off = wgid / NXCD; wgid = (xcd < r ? xcd * (q + 1) : r * (q + 1) + (xcd - r) * q) + off; }
        const int nig = WGM * nN, gid = wgid / nig, fm = gid * WGM, gsz = (nM - fm) < WGM ? (nM - fm) : WGM;
        u.pm = fm + ((wgid % nig) % gsz); u.pn = (wgid % nig) / gsz; return true;
    }
    __device__ __forceinline__ void a_ready(const Unit&) const {}
    __device__ __forceinline__ void done(const Unit&) const {}
};
struct RevOrder : StaticOrder {
    __host__ __device__ bool next(int i, Unit& u) const { const int rounds = nwg / G; if (i >= rounds) return false; return StaticOrder::next(rounds - 1 - i, u); }
};

__device__ __forceinline__ unsigned cvt_pk_bf16(float lo, float hi) { unsigned r; asm volatile("v_cvt_pk_bf16_f32 %0, %1, %2" : "=v"(r) : "v"(lo), "v"(hi)); return r; }
constexpr int MROWS = 32768;
constexpr float RMS_EPS = 1e-6f;
__device__ __forceinline__ float c1024_() { float c = 1.0f / 1024.0f; asm volatile("" : "+v"(c)); return c; }
__device__ __forceinline__ void row_rstd(float (&rs)[2][4], const float* ssp, const Unit& u, int wr, int fr, int fq) {
#pragma unroll
    for (int ai = 0; ai < 2; ++ai)
#pragma unroll
        for (int m = 0; m < 4; ++m) {
            const int row = u.pm * BM + ai * HALF + wr * 64 + m * 16 + fr;
            const f32x4 p = *(const f32x4*)(ssp + (size_t)row * 16 + 4 * fq);
            float s = (p[0] + p[1]) + (p[2] + p[3]);
            s += xsw<16>(s); s = sum32(s);
            rs[ai][m] = __builtin_amdgcn_rsqf(s * c1024_() + RMS_EPS);
        }
}
struct RowPre { PG8_LAS unsigned char* tab; Unit nxt; bool has_next; int ui; };
__device__ __forceinline__ void rowpre_get(float (&rs)[2][4], const float* ssp, const Unit& u, const RowPre& rp, int wr, int fr, int fq) {
    const PG8_LAS float* t = (const PG8_LAS float*)rp.tab + (rp.ui & 1) * 128 + fr;
#pragma unroll
    for (int ai = 0; ai < 2; ++ai)
#pragma unroll
        for (int m = 0; m < 4; ++m) rs[ai][m] = t[(ai * 4 + m) * 16];
}
__device__ __forceinline__ void rowpre_issue(f32x4 (&p)[2][4], const float* ssp, const RowPre& rp, int wr, int fr, int fq) {
#pragma unroll
    for (int ai = 0; ai < 2; ++ai)
#pragma unroll
        for (int m = 0; m < 4; ++m) p[ai][m] = *(const f32x4*)(ssp + (size_t)(rp.nxt.pm * BM + ai * HALF + wr * 64 + m * 16 + fr) * 16 + 4 * fq);
}
__device__ __forceinline__ void rowpre_park(const f32x4 (&p)[2][4], const RowPre& rp, int fr, int fq) {
    PG8_LAS float* t = (PG8_LAS float*)rp.tab + ((rp.ui + 1) & 1) * 128 + fr;
#pragma unroll
    for (int ai = 0; ai < 2; ++ai)
#pragma unroll
        for (int m = 0; m < 4; ++m) { float s = (p[ai][m][0] + p[ai][m][1]) + (p[ai][m][2] + p[ai][m][3]); s += xsw<16>(s); s = sum32(s);
            if (fq == 0) t[(ai * 4 + m) * 16] = __builtin_amdgcn_rsqf(s * c1024_() + RMS_EPS); }
}
__device__ __forceinline__ void rowpre_prime_issue(f32x4 (&p)[2][4], const float* ssp, const Unit& u, int wr, int fr, int fq) {
#pragma unroll
    for (int ai = 0; ai < 2; ++ai)
#pragma unroll
        for (int m = 0; m < 4; ++m) p[ai][m] = *(const f32x4*)(ssp + (size_t)(u.pm * BM + ai * HALF + wr * 64 + m * 16 + fr) * 16 + 4 * fq);
}
__device__ __forceinline__ void rowpre_prime_park(const f32x4 (&p)[2][4], PG8_LAS unsigned char* tab, int fr, int fq) {
    PG8_LAS float* t = (PG8_LAS float*)tab + fr;
#pragma unroll
    for (int ai = 0; ai < 2; ++ai)
#pragma unroll
        for (int m = 0; m < 4; ++m) { float s = (p[ai][m][0] + p[ai][m][1]) + (p[ai][m][2] + p[ai][m][3]); s += xsw<16>(s); s = sum32(s);
            if (fq == 0) t[(ai * 4 + m) * 16] = __builtin_amdgcn_rsqf(s * c1024_() + RMS_EPS); }
}
__device__ __forceinline__ float silu_f(float g) { return g * __builtin_amdgcn_rcpf(1.0f + __builtin_amdgcn_exp2f(-1.4426950408889634f * g)); }

constexpr float F8_XSCALE = 8.0f, F8_GUSCALE = 16.0f;
constexpr float F8_HSCALE = 4.0f, F8_WSCALE = 32.0f;
template <bool OUT8, bool ACCI = false> struct EpiSwiGLUT {
    static constexpr bool PERM = true, AFTER_DRAIN = false, NEEDS_RSTD = true;
    bf16_t* H; int ldh; const float* ssp; float ascale;
    __device__ __forceinline__ void operator()(const f32x4 (&acc)[2][2][4][2], const Unit& u, int wr, int wc, int fr, int fq, const RowPre& rp) const {
        float rs[2][4]; rowpre_get(rs, ssp, u, rp, wr, fr, fq);
        f32x4 pre[2][4]; rowpre_issue(pre, ssp, rp, wr, fr, fq);
        const int col0 = u.pn * HALF + wc * 32 + 8 * fq;
#pragma unroll
        for (int ai = 0; ai < 2; ++ai)
#pragma unroll
            for (int m = 0; m < 4; ++m) {
                const int row = u.pm * BM + ai * HALF + wr * 64 + m * 16 + fr; const float r = rs[ai][m] * ascale, rn = -1.4426950408889634f * r, rr = OUT8 ? r * r * F8_HSCALE : r * r;
                float h[8];
                typedef float f32x2 __attribute__((ext_vector_type(2)));
#pragma unroll
                for (int n = 0; n < 2; ++n)
#pragma unroll
                    for (int i = 0; i < 4; i += 2) {
                        float g0 = acc[ai][0][m][n][i], g1 = acc[ai][0][m][n][i + 1], u0 = acc[ai][1][m][n][i], u1 = acc[ai][1][m][n][i + 1];
                        if constexpr (ACCI) { g0 = (float)__builtin_bit_cast(int, g0); g1 = (float)__builtin_bit_cast(int, g1); u0 = (float)__builtin_bit_cast(int, u0); u1 = (float)__builtin_bit_cast(int, u1); }
                        const f32x2 G = {g0, g1}, U = {u0, u1};
                        const f32x2 t = G * rn; f32x2 e; e.x = __builtin_amdgcn_exp2f(t.x); e.y = __builtin_amdgcn_exp2f(t.y);
                        const f32x2 d = e + 1.0f; f32x2 sg; sg.x = __builtin_amdgcn_rcpf(d.x); sg.y = __builtin_amdgcn_rcpf(d.y);
                        const f32x2 hv = ((G * U) * rr) * sg; h[4 * n + i] = hv.x; h[4 * n + i + 1] = hv.y;
                    }
                if constexpr (OUT8) {
                    int w0 = __builtin_amdgcn_cvt_pk_fp8_f32(h[0], h[1], 0, false); w0 = __builtin_amdgcn_cvt_pk_fp8_f32(h[2], h[3], w0, true);
                    int w1 = __builtin_amdgcn_cvt_pk_fp8_f32(h[4], h[5], 0, false); w1 = __builtin_amdgcn_cvt_pk_fp8_f32(h[6], h[7], w1, true);
                    typedef int i32x2 __attribute__((ext_vector_type(2)));
                    *(i32x2*)((unsigned char*)H + (size_t)row * ldh + col0) = (i32x2){w0, w1};
                } else {
                u32x4 w; w.x = cvt_pk_bf16(h[0], h[1]); w.y = cvt_pk_bf16(h[2], h[3]); w.z = cvt_pk_bf16(h[4], h[5]); w.w = cvt_pk_bf16(h[6], h[7]);
                *(u32x4*)(H + (size_t)row * ldh + col0) = w;
                }
                asm volatile("" ::: "memory");
            }
        rowpre_park(pre, rp, fr, fq);
    }
};
typedef EpiSwiGLUT<false> EpiSwiGLU;
typedef EpiSwiGLUT<true> EpiSwiGLU8;
typedef EpiSwiGLUT<false, true> EpiSwiGLUI;
typedef EpiSwiGLUT<true, true> EpiSwiGLU8I;
struct EpiInProj {
    static constexpr bool PERM = true, AFTER_DRAIN = false, NEEDS_RSTD = true;
    bf16_t* O; int ldc; const float* ssp; const float* rc; const float* rs; const float* dc; const float* ds; int even;
    __device__ __forceinline__ void operator()(const f32x4 (&acc)[2][2][4][2], const Unit& u, int wr, int wc, int fr, int fq, const RowPre& rp) const {
        float rsd[2][4]; rowpre_get(rsd, ssp, u, rp, wr, fr, fq);
        f32x4 pre[2][4]; rowpre_issue(pre, ssp, rp, wr, fr, fq);
        const int col0 = u.pn * BM + wc * 32 + 8 * fq;
        const int kind = even ? (u.pn < 4 ? 1 : ((u.pn >= 8 && u.pn < 12) ? 2 : 0)) : 0;
        const float ksc = (kind == 1 && u.pn >= 2) ? 0.08838834764831845f : 1.0f;
        const bool rot2 = (kind == 2) && ((wc & 1) == 0) && (fq < 2);
        const int b_ = (u.pm * BM) >> 12, t0 = (u.pm * BM) & 4095;
        size_t hb[2]; int dh, d0[2];
#pragma unroll
        for (int bj = 0; bj < 2; ++bj) {
            int c0, nh, head;
            if (even) { c0 = (u.pn >> 1) * 512; if (u.pn < 8) { nh = 4; dh = 128; head = (u.pn & 1) * 2 + bj; d0[bj] = wc * 32; } else { nh = 8; dh = 64; head = (u.pn & 1) * 4 + bj * 2 + (wc >> 1); d0[bj] = (wc & 1) * 32; } }
            else if (u.pn < 4) { c0 = (u.pn >> 1) * 512; nh = 4; dh = 128; head = (u.pn & 1) * 2 + bj; d0[bj] = wc * 32; }
            else if (u.pn < 12) { c0 = u.pn < 8 ? 1024 : 2048; nh = 4; dh = 256; head = u.pn & 3; d0[bj] = bj * 128 + wc * 32; }
            else { c0 = 3072; nh = 1; dh = 256; head = 0; d0[bj] = bj * 128 + wc * 32; }
            hb[bj] = (size_t)c0 * MROWS + ((size_t)(b_ * nh + head) * 4096 + t0) * dh;
        }
        const float* tc = (kind == 1) ? rc + wc * 16 + 4 * fq : dc + 4 * (fq & 1);
        const float* ts = (kind == 1) ? rs + wc * 16 + 4 * fq : ds + 4 * (fq & 1);
        const int tstride = (kind == 1) ? 64 : 8;
        typedef float f32x2 __attribute__((ext_vector_type(2)));
        if (kind == 0) {
#pragma unroll
            for (int ai = 0; ai < 2; ++ai)
#pragma unroll
                for (int m = 0; m < 4; ++m) {
                    const int row = u.pm * BM + ai * HALF + wr * 64 + m * 16 + fr; const float r = rsd[ai][m];
#pragma unroll
                    for (int bj = 0; bj < 2; ++bj) { const f32x4 v0 = acc[ai][bj][m][0] * r, v1 = acc[ai][bj][m][1] * r;
                        u32x4 w; w.x = cvt_pk_bf16(v0[0], v0[1]); w.y = cvt_pk_bf16(v0[2], v0[3]); w.z = cvt_pk_bf16(v1[0], v1[1]); w.w = cvt_pk_bf16(v1[2], v1[3]);
                        *(u32x4*)(O + hb[bj] + (size_t)(row - u.pm * BM) * dh + d0[bj] + 8 * fq) = w; }
                    asm volatile("" ::: "memory");
                }
        } else {
#pragma unroll
            for (int ai = 0; ai < 2; ++ai)
#pragma unroll
                for (int m = 0; m < 4; ++m) {
                    const int row = u.pm * BM + ai * HALF + wr * 64 + m * 16 + fr; const float r = rsd[ai][m] * ksc;
                    f32x4 c4 = {r, r, r, r}, s4 = {0.f, 0.f, 0.f, 0.f};
                    if (kind == 1 || rot2) { const int pos = row & 4095; c4 = *(const f32x4*)(tc + (size_t)pos * tstride) * r; s4 = *(const f32x4*)(ts + (size_t)pos * tstride) * r; }
#pragma unroll
                    for (int bj = 0; bj < 2; ++bj) { const f32x4 v0 = acc[ai][bj][m][0], v1 = acc[ai][bj][m][1];
                        const f32x2 a0 = {v0[0], v0[1]}, a1 = {v0[2], v0[3]}, a2 = {v1[0], v1[1]}, a3 = {v1[2], v1[3]};
                        const f32x2 b0 = {-v0[1], v0[0]}, b1 = {-v0[3], v0[2]}, b2 = {-v1[1], v1[0]}, b3 = {-v1[3], v1[2]};
                        const f32x2 o0 = a0 * c4[0] + b0 * s4[0], o1 = a1 * c4[1] + b1 * s4[1], o2 = a2 * c4[2] + b2 * s4[2], o3 = a3 * c4[3] + b3 * s4[3];
                        u32x4 w; w.x = cvt_pk_bf16(o0.x, o0.y); w.y = cvt_pk_bf16(o1.x, o1.y); w.z = cvt_pk_bf16(o2.x, o2.y); w.w = cvt_pk_bf16(o3.x, o3.y);
                        *(u32x4*)(O + hb[bj] + (size_t)(row - u.pm * BM) * dh + d0[bj] + 8 * fq) = w; }
                    asm volatile("" ::: "memory");
                }
        }
        rowpre_park(pre, rp, fr, fq);
    }
};
struct EpiResid {
    static constexpr bool PERM = true, AFTER_DRAIN = false, NEEDS_RSTD = false;
    bf16_t* xb; float* ssp; float scale; int x8d;
    __device__ __forceinline__ void operator()(const f32x4 (&acc)[2][2][4][2], const Unit& u, int wr, int wc, int fr, int fq, const RowPre&) const {
        const int col0 = u.pn * BM + wc * 32 + 8 * fq, rowb = u.pm * BM + wr * 64 + fr;
        u32x4 old[8][2];
#pragma unroll
        for (int g = 0; g < 8; ++g) { const size_t off = (size_t)(rowb + (g >> 2) * HALF + (g & 3) * 16) * 1024 + col0; old[g][0] = *(const u32x4*)(xb + off); old[g][1] = *(const u32x4*)(xb + off + HALF); }
#pragma unroll
        for (int g = 0; g < 8; ++g) {
            const int ai = g >> 2, m = g & 3, row = rowb + ai * HALF + m * 16; float ss = 0.f;
#pragma unroll
            for (int bj = 0; bj < 2; ++bj) { const size_t off = (size_t)row * 1024 + col0 + bj * HALF; const u32x4 o = old[g][bj];
                const f32x4 a0 = acc[ai][bj][m][0] * scale, a1 = acc[ai][bj][m][1] * scale;
                const float v0 = __builtin_bit_cast(float, o.x << 16) + a0[0], v1 = __builtin_bit_cast(float, o.x & 0xffff0000u) + a0[1], v2 = __builtin_bit_cast(float, o.y << 16) + a0[2], v3 = __builtin_bit_cast(float, o.y & 0xffff0000u) + a0[3];
                const float v4 = __builtin_bit_cast(float, o.z << 16) + a1[0], v5 = __builtin_bit_cast(float, o.z & 0xffff0000u) + a1[1], v6 = __builtin_bit_cast(float, o.w << 16) + a1[2], v7 = __builtin_bit_cast(float, o.w & 0xffff0000u) + a1[3];
                u32x4 w; w.x = cvt_pk_bf16(v0, v1); w.y = cvt_pk_bf16(v2, v3); w.z = cvt_pk_bf16(v4, v5); w.w = cvt_pk_bf16(v6, v7);
                *(u32x4*)(xb + off) = w;
                if (x8d) { int y0 = __builtin_amdgcn_cvt_pk_fp8_f32(v0 * F8_XSCALE, v1 * F8_XSCALE, 0, false); y0 = __builtin_amdgcn_cvt_pk_fp8_f32(v2 * F8_XSCALE, v3 * F8_XSCALE, y0, true);
                    int y1 = __builtin_amdgcn_cvt_pk_fp8_f32(v4 * F8_XSCALE, v5 * F8_XSCALE, 0, false); y1 = __builtin_amdgcn_cvt_pk_fp8_f32(v6 * F8_XSCALE, v7 * F8_XSCALE, y1, true);
                    typedef int i32x2r __attribute__((ext_vector_type(2))); *(i32x2r*)((unsigned char*)xb + x8d + off) = (i32x2r){y0, y1}; }
                ss += (v0 * v0 + v1 * v1) + (v2 * v2 + v3 * v3) + (v4 * v4 + v5 * v5) + (v6 * v6 + v7 * v7); }
            ss += xsw<16>(ss); ss = sum32(ss);
            if (fq == 0) ssp[(size_t)row * 16 + u.pn * 4 + wc] = ss;
        }
    }
};

typedef int pg8_v8i __attribute__((ext_vector_type(8)));
typedef int pg8_v4i __attribute__((ext_vector_type(4)));
__device__ __forceinline__ pg8_v8i pg8_cat(bf16x8 lo, bf16x8 hi) { const pg8_v4i a = __builtin_bit_cast(pg8_v4i, lo), b = __builtin_bit_cast(pg8_v4i, hi); return __builtin_shufflevector(a, b, 0, 1, 2, 3, 4, 5, 6, 7); }
template <class Epi, class Sched, bool ALIGN_EPI = false, bool SP2 = false, bool F8 = false, bool I8 = false>
__device__ __forceinline__ void gemm_phase(PG8_LAS unsigned char* lds, const Gemm g, const Sched& S, const Epi& E, int wave_in) {
    int tid_; { int l_; asm volatile("v_mbcnt_lo_u32_b32 %0, -1, 0\n\tv_mbcnt_hi_u32_b32 %0, -1, %0" : "=v"(l_)); tid_ = wave_in * 64 + l_; }
    const int tid = tid_, wid = __builtin_amdgcn_readfirstlane(tid >> 6), lane = tid & 63, wr = wid >> 2, wc = wid & 3, fr = lane & 15, fq = lane >> 4;
    constexpr int ES = (F8 || I8) ? 1 : 2;
    const int K = g.K, nt = K * ES / (BK * 2);
    unsigned voffA[2], voffB[2];
#pragma unroll
    for (int i = 0; i < 2; ++i) { int R, C; stage_rc(tid * 16 + i * 8192, R, C); const int Rb = Epi::PERM ? ((R & ~31) + perm32(R & 31)) : R;
        voffA[i] = (unsigned)(R * K * ES + C * 2); voffB[i] = (unsigned)(Rb * K * ES + C * 2); }
    const size_t kstep = (size_t)(BK * 2);
    const size_t hstep = (size_t)HALF * K * ES;
    const size_t tstep = 2 * hstep;
    const unsigned ldsw = (unsigned)wid * 1024u;
    const int aoff = lds_byte(wr * 64 + fr, fq * 8), boff = lds_byte(wc * 32 + fr, fq * 8);
#define PG8_SA(b, h) (((b) * 2 + (h)) * HTB)
#define PG8_SB(b, h) ((4 + (b) * 2 + (h)) * HTB)
#define PG8_STAGE(bufoff, gbase, voff) do { _Pragma("unroll") for (int _i = 0; _i < 2; ++_i) { if constexpr (F8) { unsigned vo_ = (voff)[0]; asm volatile("" : "+v"(vo_));     \
        __builtin_amdgcn_global_load_lds((const unsigned*)((const char*)(gbase) + (size_t)_i * 64 * K * ES + vo_), (PG8_LAS unsigned*)(lds + (bufoff) + ldsw + _i * 8192), 16, 0, 0); } else \
        __builtin_amdgcn_global_load_lds((const unsigned*)((const char*)(gbase) + (voff)[_i]), (PG8_LAS unsigned*)(lds + (bufoff) + ldsw + _i * 8192), 16, 0, 0); } } while (0)
#define PG8_LDA(dst, b, h) do { _Pragma("unroll") for (int m = 0; m < 4; ++m) _Pragma("unroll") for (int k = 0; k < 2; ++k) dst[m][k] = *(const PG8_LAS bf16x8*)(lds + PG8_SA(b, h) + aoff + m * 2048 + k * 1024); } while (0)
#define PG8_LDB(dst, b, h) do { _Pragma("unroll") for (int n = 0; n < 2; ++n) _Pragma("unroll") for (int k = 0; k < 2; ++k) dst[n][k] = *(const PG8_LAS bf16x8*)(lds + PG8_SB(b, h) + boff + n * 2048 + k * 1024); } while (0)
#define PG8_MMA(ai, bj, At, Bt) do { __builtin_amdgcn_s_setprio(1); if constexpr (F8) { _Pragma("unroll") for (int m = 0; m < 4; ++m) _Pragma("unroll") for (int n = 0; n < 2; ++n) \
        acc[ai][bj][m][n] = __builtin_amdgcn_mfma_scale_f32_16x16x128_f8f6f4(pg8_cat(Bt[n][0], Bt[n][1]), pg8_cat(At[m][0], At[m][1]), acc[ai][bj][m][n], 0, 0, 0, 0, 0, 0); } \
        else if constexpr (I8) { _Pragma("unroll") for (int m = 0; m < 4; ++m) _Pragma("unroll") for (int n = 0; n < 2; ++n) _Pragma("unroll") for (int k = 0; k < 2; ++k) \
        acc[ai][bj][m][n] = __builtin_bit_cast(f32x4, __builtin_amdgcn_mfma_i32_16x16x64_i8(__builtin_bit_cast(pg8_v4i, Bt[n][k]), __builtin_bit_cast(pg8_v4i, At[m][k]), __builtin_bit_cast(pg8_v4i, acc[ai][bj][m][n]), 0, 0, 0)); } \
        else { _Pragma("unroll") for (int m = 0; m < 4; ++m) _Pragma("unroll") for (int n = 0; n < 2; ++n) _Pragma("unroll") for (int k = 0; k < 2; ++k) \
        acc[ai][bj][m][n] = __builtin_amdgcn_mfma_f32_16x16x32_bf16(Bt[n][k], At[m][k], acc[ai][bj][m][n], 0, 0, 0); } __builtin_amdgcn_s_setprio(0); } while (0)
#define PG8_WAIT_V(n) asm volatile("s_waitcnt vmcnt(" #n ")" ::: "memory")
#define PG8_WAIT_L(n) asm volatile("s_waitcnt lgkmcnt(" #n ")" ::: "memory")
#define PG8_BAR __builtin_amdgcn_s_barrier()
#define PG8_SCHED __builtin_amdgcn_sched_barrier(0)
    Unit cur, nxt; int ui = 0;
    if (!S.next(0, cur)) return;
    f32x4 acc[2][2][4][2];
#pragma unroll
    for (int a = 0; a < 2; ++a)
#pragma unroll
        for (int b = 0; b < 2; ++b)
#pragma unroll
            for (int m = 0; m < 4; ++m)
#pragma unroll
                for (int n = 0; n < 2; ++n) acc[a][b][m][n] = (f32x4){0.f, 0.f, 0.f, 0.f};
    bf16x8 At[4][2], B0[2][2], B1[2][2];
    const char* cA = (const char*)g.A + (size_t)cur.pm * tstep; const char* cB = (const char*)g.Bt + (size_t)cur.pn * tstep;
    S.a_ready(cur);
    f32x4 p0[2][4];
    if constexpr (Epi::NEEDS_RSTD) rowpre_prime_issue(p0, E.ssp, cur, wr, fr, fq);
    if constexpr (SP2) {
        PG8_STAGE(PG8_SB(0, 0), cB, voffB); PG8_STAGE(PG8_SB(0, 1), cB + hstep, voffB); PG8_STAGE(PG8_SA(0, 0), cA, voffA); PG8_STAGE(PG8_SA(0, 1), cA + hstep, voffA);
        if constexpr (Epi::NEEDS_RSTD) rowpre_prime_park(p0, lds + STAGE_BYTES + wid * 1024, fr, fq);
        if (wr == 1) PG8_BAR;
        PG8_WAIT_V(2); PG8_BAR;
        PG8_STAGE(PG8_SB(1, 0), cB + kstep, voffB); PG8_STAGE(PG8_SA(1, 0), cA + kstep, voffA); PG8_STAGE(PG8_SB(1, 1), cB + hstep + kstep, voffB);
        PG8_WAIT_V(6); PG8_BAR;
    } else {
        PG8_STAGE(PG8_SB(0, 0), cB, voffB); PG8_STAGE(PG8_SA(0, 0), cA, voffA); PG8_STAGE(PG8_SB(0, 1), cB + hstep, voffB); PG8_STAGE(PG8_SA(0, 1), cA + hstep, voffA);
        if constexpr (Epi::NEEDS_RSTD) rowpre_prime_park(p0, lds + STAGE_BYTES + wid * 1024, fr, fq);
        if (wr == 1) PG8_BAR;
        PG8_WAIT_V(4); PG8_BAR;
        PG8_STAGE(PG8_SB(1, 0), cB + kstep, voffB); PG8_STAGE(PG8_SA(1, 0), cA + kstep, voffA); PG8_STAGE(PG8_SB(1, 1), cB + hstep + kstep, voffB);
        PG8_WAIT_V(6); PG8_BAR;
    }
    for (;;) {
        const bool has_next = S.next(ui + 1, nxt);
        const char* nA = has_next ? (const char*)g.A + (size_t)nxt.pm * tstep : cA; const char* nB = has_next ? (const char*)g.Bt + (size_t)nxt.pn * tstep : cB;
        for (int t = 0; t < nt; t += 2) {
            const bool last = (t == nt - 2);
            const char* a1 = cA + (size_t)(t + 1) * kstep;
            const char* a2 = last ? nA : cA + (size_t)(t + 2) * kstep; const char* b2 = last ? nB : cB + (size_t)(t + 2) * kstep;
            const char* a3 = a2 + kstep; const char* b3 = b2 + kstep;
            if (last && has_next) S.a_ready(nxt);
            if constexpr (SP2) {
            PG8_LDB(B0, 0, 0); PG8_LDB(B1, 0, 1); PG8_SCHED; PG8_LDA(At, 0, 0); PG8_STAGE(PG8_SA(1, 1), a1 + hstep, voffA);
            PG8_WAIT_V(8); PG8_WAIT_L(0); PG8_BAR; PG8_MMA(0, 0, At, B0); PG8_MMA(0, 1, At, B1); PG8_BAR; PG8_SCHED;
            PG8_LDA(At, 0, 1); PG8_STAGE(PG8_SB(0, 0), b2, voffB); PG8_STAGE(PG8_SB(0, 1), b2 + hstep, voffB); PG8_STAGE(PG8_SA(0, 0), a2, voffA);
            PG8_WAIT_V(8); PG8_WAIT_L(0); PG8_BAR; PG8_MMA(1, 0, At, B0); PG8_MMA(1, 1, At, B1); PG8_BAR; PG8_SCHED;
            PG8_LDB(B0, 1, 0); PG8_LDB(B1, 1, 1); PG8_SCHED; PG8_LDA(At, 1, 0); PG8_STAGE(PG8_SA(0, 1), a2 + hstep, voffA);
            PG8_WAIT_V(8); PG8_WAIT_L(0); PG8_BAR; PG8_MMA(0, 0, At, B0); PG8_MMA(0, 1, At, B1); PG8_BAR; PG8_SCHED;
            PG8_LDA(At, 1, 1); PG8_STAGE(PG8_SB(1, 0), b3, voffB); PG8_STAGE(PG8_SB(1, 1), b3 + hstep, voffB); PG8_STAGE(PG8_SA(1, 0), a3, voffA);
            PG8_WAIT_V(8); PG8_WAIT_L(0); PG8_BAR; PG8_MMA(1, 0, At, B0); PG8_MMA(1, 1, At, B1); PG8_BAR; PG8_SCHED;
            } else {
            PG8_LDB(B0, 0, 0); PG8_SCHED; PG8_LDA(At, 0, 0); PG8_STAGE(PG8_SA(1, 1), a1 + hstep, voffA);
            PG8_WAIT_L(8); PG8_BAR; PG8_WAIT_L(0); PG8_MMA(0, 0, At, B0); PG8_BAR; PG8_SCHED;
            PG8_LDB(B1, 0, 1); PG8_STAGE(PG8_SB(0, 0), b2, voffB);
            PG8_BAR; PG8_WAIT_L(0); PG8_MMA(0, 1, At, B1); PG8_BAR;
            PG8_LDA(At, 0, 1); PG8_STAGE(PG8_SA(0, 0), a2, voffA);
            PG8_BAR; PG8_WAIT_L(0); PG8_MMA(1, 0, At, B0); PG8_BAR; PG8_SCHED;
            PG8_STAGE(PG8_SB(0, 1), b2 + hstep, voffB);
            PG8_WAIT_V(6); PG8_BAR; PG8_MMA(1, 1, At, B1); PG8_BAR;
            PG8_LDB(B0, 1, 0); PG8_SCHED; PG8_LDA(At, 1, 0); PG8_STAGE(PG8_SA(0, 1), a2 + hstep, voffA);
            PG8_WAIT_L(8); PG8_BAR; PG8_WAIT_L(0); PG8_MMA(0, 0, At, B0); PG8_BAR; PG8_SCHED;
            PG8_LDB(B1, 1, 1); PG8_STAGE(PG8_SB(1, 0), b3, voffB);
            PG8_BAR; PG8_WAIT_L(0); PG8_MMA(0, 1, At, B1); PG8_BAR;
            PG8_LDA(At, 1, 1); PG8_STAGE(PG8_SA(1, 0), a3, voffA);
            PG8_BAR; PG8_WAIT_L(0); PG8_MMA(1, 0, At, B0); PG8_BAR; PG8_SCHED;
            PG8_STAGE(PG8_SB(1, 1), b3 + hstep, voffB);
            PG8_WAIT_V(6); PG8_BAR; PG8_MMA(1, 1, At, B1); PG8_BAR;
            }
        }
        if constexpr (ALIGN_EPI) { if (wr == 0) PG8_BAR; }
        if constexpr (!Epi::AFTER_DRAIN) {
            if constexpr (F8) { int l2; asm volatile("v_mbcnt_lo_u32_b32 %0, -1, 0\n\tv_mbcnt_hi_u32_b32 %0, -1, %0" : "=v"(l2));
                E(acc, cur, wr, wc, l2 & 15, l2 >> 4, RowPre{lds + STAGE_BYTES + wid * 1024, has_next ? nxt : cur, has_next, ui}); }
            else E(acc, cur, wr, wc, fr, fq, RowPre{lds + STAGE_BYTES + wid * 1024, has_next ? nxt : cur, has_next, ui});
            S.done(cur); }
        if (!has_next) break;
#pragma unroll
        for (int a = 0; a < 2; ++a)
#pragma unroll
            for (int b = 0; b < 2; ++b)
#pragma unroll
                for (int m = 0; m < 4; ++m)
#pragma unroll
                    for (int n = 0; n < 2; ++n) acc[a][b][m][n] = (f32x4){0.f, 0.f, 0.f, 0.f};
        cur = nxt; cA = nA; cB = nB; ++ui;
        if constexpr (ALIGN_EPI) { if (wr == 1) PG8_BAR; }
    }
    PG8_WAIT_V(0);
    if constexpr (!ALIGN_EPI) { if (wr == 0) PG8_BAR; }
    PG8_BAR;
    if constexpr (Epi::AFTER_DRAIN) { E.fused(acc, cur, wr, wc, fr, fq, lds, wid, lane); S.done(cur); }
#undef PG8_SA
#undef PG8_SB
#undef PG8_STAGE
#undef PG8_LDA
#undef PG8_LDB
#undef PG8_MMA
#undef PG8_WAIT_V
#undef PG8_WAIT_L
#undef PG8_BAR
#undef PG8_SCHED
}
}

constexpr int NWAVES = 8, NTHREADS = NWAVES * 64;
constexpr int BATCH = 8, SEQ = 4096, D = 1024, M = BATCH * SEQ, FF = 2816, DEPTH = 4;
constexpr int EVEN_IN = 3584, GLA_IN = 3088, GLA_INP = 3328;
static_assert(M == pg8::MROWS, "row count");
constexpr int E_RQ = 0, E_RK = 512, E_RV = 1024, E_RG = 1536, E_DQ = 2048, E_DK = 2560, E_DV = 3072;
constexpr int G_Q = 0, G_K = 512, G_V = 1024, G_R = 2048, G_A = 3072;
constexpr float EPS = 1e-6f;
#define HM(c0, nh, dh, b, h) ((size_t)(c0) * M + ((size_t)((b) * (nh) + (h)) * SEQ) * (dh))

constexpr size_t MiB = 1u << 20;
constexpr size_t WS_CTL = 0, CTL_ZERO_BYTES = 32768;
constexpr size_t WS_SSP = 1 * MiB;
constexpr size_t WS_TAB = 3 * MiB;
constexpr size_t TAB_RC = WS_TAB, TAB_RS = WS_TAB + 1 * MiB, TAB_DC = WS_TAB + 2 * MiB, TAB_DS = WS_TAB + 2 * MiB + 128 * 1024;
constexpr size_t WS_W = 8 * MiB;
constexpr size_t W_GU0 = WS_W, W_D0 = W_GU0 + (size_t)2 * FF * D * 2, W_GU1 = W_D0 + (size_t)D * FF * 2, W_D1 = W_GU1 + (size_t)2 * FF * D * 2,
                 W_IN = W_D1 + (size_t)D * FF * 2, W_OUT = W_IN + (size_t)EVEN_IN * D * 2, W_END = W_OUT + (size_t)D * D * 2;
constexpr size_t WS_XB = 56 * MiB;
constexpr size_t WS_ACT = 120 * MiB;
constexpr size_t WS_CAT = 344 * MiB;
constexpr size_t WS_END = 408 * MiB;
static_assert(W_END <= WS_XB && WS_XB + (size_t)M * D * 2 <= WS_ACT && WS_ACT + (size_t)M * EVEN_IN * 2 <= WS_CAT && WS_CAT + (size_t)M * D * 2 <= WS_END, "d_ws map");
constexpr int CW_BAR = 4096;

constexpr int RING_OFF = 0, RING_BYTES = 131072;
constexpr int LDSCTL_OFF = 161792, MISC_OFF = LDSCTL_OFF + 320, PTR_OFF = LDSCTL_OFF + 1024;
constexpr int LDS_BYTES = 163840;
static_assert(PTR_OFF + 19 * 8 <= LDS_BYTES && RING_BYTES <= LDSCTL_OFF, "LDS map");

#define GAS __attribute__((address_space(1)))
#define LAS __attribute__((address_space(3)))
typedef unsigned short bf16;
typedef unsigned v4u __attribute__((ext_vector_type(4)));
typedef float f32x4 __attribute__((ext_vector_type(4)));
typedef short bf16x8 __attribute__((ext_vector_type(8)));
typedef GAS unsigned gu32;
typedef GAS unsigned long long gu64;
#define RLX_AGENT __ATOMIC_RELAXED, __HIP_MEMORY_SCOPE_AGENT
#define LDS_WAIT() asm volatile("s_waitcnt lgkmcnt(0)" ::: "memory")
#define VM_WAIT() asm volatile("s_waitcnt vmcnt(0)" ::: "memory")
__device__ __forceinline__ unsigned long long rt() { return __builtin_amdgcn_s_memrealtime(); }
__device__ __forceinline__ unsigned f2bf(float f) { unsigned u = __builtin_bit_cast(unsigned, f); return (u + 0x7fffu + ((u >> 16) & 1u)) >> 16; }
__device__ __forceinline__ unsigned pk2(float lo, float hi) { return f2bf(lo) | (f2bf(hi) << 16); }

#define XB_TMO      128
#ifndef XB_MIS_EXPECT
#define XB_MIS_EXPECT 0u
#endif
#define XB_MIS      192
#define XB_XCNT(j)  (256  + 64 * (j))
#define XB_XSUB(j)  (1280 + 64 * (j))
#define XB_XGEN(j)  (2304 + 64 * (j))
#define XB_TOP      3328
#define XB_TOPGEN   3392
#define XB_TEAM(t)  (3520 + 8 * (t))
#define XCD_BAR_WORDS 4096
#define XB_SPIN_CAP (1u << 18)

__device__ __forceinline__ unsigned xb_ld(unsigned* p)              { return __hip_atomic_load(p, __ATOMIC_RELAXED, __HIP_MEMORY_SCOPE_AGENT); }
__device__ __forceinline__ unsigned xb_add(unsigned* p, unsigned v) { return __hip_atomic_fetch_add(p, v, __ATOMIC_RELAXED, __HIP_MEMORY_SCOPE_AGENT); }
__device__ __forceinline__ unsigned xb_xcc_id() { return (unsigned)__builtin_amdgcn_s_getreg((3 << 11) | 20) & 0xFu; }
#define XB_SPIN(cond, bar) do { unsigned _sp = 0; while (cond) { __builtin_amdgcn_s_sleep(1); \
    if ((++_sp & 255u) == 0u) { if (xb_ld(&(bar)[XB_TMO])) break; if (_sp > XB_SPIN_CAP) { atomicAdd(&(bar)[XB_TMO], 1u); break; } } } } while (0)

struct XcdBarrier {
    unsigned* bar; unsigned x;
    volatile LAS unsigned* st;
};

__device__ __forceinline__ XcdBarrier xcd_barrier_post(unsigned* bar, volatile LAS unsigned* st, int tid) {
    XcdBarrier b; b.bar = bar; b.x = xb_xcc_id(); b.st = st;
    if (tid == 0) { if ((blockIdx.x & 7u) != b.x) (void)xb_add(&bar[XB_MIS], 1u); (void)xb_add(&bar[XB_XCNT(b.x)], 1u); }
    return b;
}
__device__ __forceinline__ void xcd_barrier_complete(unsigned* bar, unsigned x, unsigned& nloc, unsigned& nx) {
    const unsigned G = gridDim.x * gridDim.y * gridDim.z;
    unsigned sum, cnt, mine, sp = 0u;
    for (;;) {
        sum = 0u; cnt = 0u; mine = 0u;
#pragma unroll
        for (unsigned j = 0; j < 16; ++j) { const unsigned c = xb_ld(&bar[XB_XCNT(j)]); sum += c; cnt += (c > 0u) ? 1u : 0u; mine = (j == x) ? c : mine; }
        if (sum == G) break;
        __builtin_amdgcn_s_sleep(1);
        if ((++sp & 255u) == 0u) { if (xb_ld(&bar[XB_TMO])) break; if (sp > XB_SPIN_CAP) { atomicAdd(&bar[XB_TMO], 1u); break; } }
    }
    nloc = mine > 0u ? mine : 1u; nx = cnt > 0u ? cnt : 1u;
}

template <int LOCAL = 0>
__device__ __forceinline__ void xcd_barrier(const XcdBarrier& b, int tid) {
    asm volatile("s_waitcnt vmcnt(0)" ::: "memory");
    __syncthreads();
    if (tid == 0) {
        unsigned* bar = b.bar;
        __builtin_amdgcn_s_waitcnt(0);
        unsigned nloc = b.st[0], nx = b.st[1];
        if (nloc == 0u) { xcd_barrier_complete(bar, b.x, nloc, nx); b.st[0] = nloc; b.st[1] = nx; }
        bool skip_top = false;
        if (LOCAL) { unsigned lk = b.st[2];
            if (lk == 0u) { lk = (xb_ld(&bar[XB_MIS]) == XB_MIS_EXPECT && nx == 8u && nloc == 32u && gridDim.x == 256u) ? 1u : 2u; b.st[2] = lk; }
            skip_top = lk == 1u; }
        if (LOCAL == 2 && skip_top) {
            unsigned* c = &bar[XB_TEAM((blockIdx.x & 7u) * 8u + ((blockIdx.x >> 3) & 7u))];
            const unsigned tgt = (xb_add(c, 1u) / 4u + 1u) * 4u;
            XB_SPIN(xb_ld(c) < tgt, bar);
            __builtin_amdgcn_fence(__ATOMIC_ACQUIRE, "agent");
            asm volatile("s_waitcnt vmcnt(0)" ::: "memory");
        } else {
        const unsigned old = xb_add(&bar[XB_XSUB(b.x)], 1u);
        const unsigned gen = old / nloc;
        if (old + 1u == (gen + 1u) * nloc) {
          if (!skip_top) {
            __builtin_amdgcn_fence(__ATOMIC_RELEASE, "agent");
            asm volatile("s_waitcnt vmcnt(0)" ::: "memory");
            const unsigned og = xb_add(&bar[XB_TOP], 1u);
            const unsigned tg = og / nx;
            if (og + 1u == (tg + 1u) * nx) xb_add(&bar[XB_TOPGEN], 1u);
            else XB_SPIN(xb_ld(&bar[XB_TOPGEN]) == tg, bar);
          }
            __builtin_amdgcn_fence(__ATOMIC_ACQUIRE, "agent");
            xb_add(&bar[XB_XGEN(b.x)], 1u);
            asm volatile("s_waitcnt vmcnt(0)" ::: "memory");
        } else {
            XB_SPIN(xb_ld(&bar[XB_XGEN(b.x)]) == gen, bar);
            __builtin_amdgcn_fence(__ATOMIC_ACQUIRE, "agent");
            asm volatile("s_waitcnt vmcnt(0)" ::: "memory");
        }
        }
    }
    __syncthreads();
}

__constant__ float RET_FREQ[64] = {1.000000000e+00f, 8.639884591e-01f, 7.464760542e-01f, 6.449466944e-01f, 5.572264791e-01f, 4.814372361e-01f, 4.159561992e-01f, 3.593813777e-01f, 3.105013371e-01f, 2.682695687e-01f, 2.317818105e-01f, 2.002568096e-01f, 1.730195731e-01f, 1.494869143e-01f, 1.291549653e-01f, 1.115883961e-01f, 9.641107172e-02f, 8.329805732e-02f, 7.196855545e-02f, 6.218000501e-02f, 5.372280627e-02f, 4.641588405e-02f, 4.010278732e-02f, 3.464834765e-02f, 2.993577160e-02f, 2.586415969e-02f, 2.234633639e-02f, 1.930697635e-02f, 1.668100432e-02f, 1.441219542e-02f, 1.245197095e-02f, 1.075835899e-02f, 9.295095690e-03f, 8.030855097e-03f, 6.938565988e-03f, 5.994840991e-03f, 5.179473665e-03f, 4.475005437e-03f, 3.866352839e-03f, 3.340484342e-03f, 2.886139788e-03f, 2.493591513e-03f, 2.154434333e-03f, 1.861406374e-03f, 1.608233666e-03f, 1.389495330e-03f, 1.200507861e-03f, 1.037224894e-03f, 8.961503627e-04f, 7.742635789e-04f, 6.689548027e-04f, 5.779692437e-04f, 4.993587499e-04f, 4.314401885e-04f, 3.727593285e-04f, 3.220597573e-04f, 2.782559313e-04f, 2.404099068e-04f, 2.077113895e-04f, 1.794602431e-04f, 1.550515735e-04f, 1.339627634e-04f, 1.157422885e-04f, 9.999999747e-05f};
__constant__ float ROPE_FREQ[8] = {1.000000000e+00f, 1.939227432e-01f, 3.760603070e-02f, 7.292664610e-03f, 1.414213562e-03f, 2.742481884e-04f, 5.318295734e-05f, 1.031338525e-05f};
static_assert((CW_BAR + XCD_BAR_WORDS) * 4 <= (int)CTL_ZERO_BYTES, "the grid barrier's words are inside the per-call memset");
struct Args { const float* in[17]; float* out; unsigned char* ws; };
enum { I_X = 0, I_PRE_NORM = 1, I_PRE_WG = 2, I_PRE_WU = 3, I_PRE_WD = 4, I_MIX_NORM = 5, I_AB_IN = 6, I_AB_OUT = 7, I_GLA_IN = 8, I_GLA_A2 = 9, I_GLA_BA = 10, I_GLA_OUT = 11,
       I_POST_NORM = 12, I_POST_WG = 13, I_POST_WU = 14, I_POST_WD = 15, I_FINAL = 16, I_OUT = 17, I_WS = 18, N_PTRS = 19 };
struct Frame {
    LAS unsigned char* lds;
    int tid, lane, wave, G, bid;
};
__device__ __forceinline__ unsigned char* tabp(const Frame& F, int idx) {
    int off_ = PTR_OFF + 8 * idx; asm volatile("" : "+s"(off_));
    const volatile LAS unsigned* T = (const volatile LAS unsigned*)(F.lds + off_);
    const unsigned lo = __builtin_amdgcn_readfirstlane(T[0]), hi = __builtin_amdgcn_readfirstlane(T[1]);
    GAS unsigned char* gp_ = (GAS unsigned char*)(((unsigned long long)hi << 32) | (unsigned long long)lo);
    return (unsigned char*)gp_;
}
#define AP(idx) ((const float*)tabp(F, idx))
#define WSP() tabp(F, I_WS)
#define OUTP() ((float*)tabp(F, I_OUT))
__device__ __forceinline__ int lnd(int v) { asm volatile("" : "+s"(v)); return v; }
__device__ __forceinline__ int hw_lane() { return (int)__builtin_amdgcn_mbcnt_hi(~0u, __builtin_amdgcn_mbcnt_lo(~0u, 0u)); }
__device__ __forceinline__ int hw_lane_v() { int l; asm volatile("v_mbcnt_lo_u32_b32 %0, -1, 0\n\tv_mbcnt_hi_u32_b32 %0, -1, %0" : "=v"(l)); return l; }
__device__ __forceinline__ Frame relaunder(const Frame& F0) { Frame F = F0; int t_ = F0.wave * 64 + hw_lane_v(); asm volatile("" : "+s"(F.bid)); F.tid = t_; F.lane = F.tid & 63; F.wave = __builtin_amdgcn_readfirstlane(F.tid >> 6);
    unsigned lb_ = 0u; asm volatile("" : "+s"(lb_)); F.lds = F0.lds + lb_; return F; }
__device__ __forceinline__ float wave_sum(float v) {
    v += xsw<1>(v); v += xsw<2>(v); v += xsw<4>(v); v += xsw<8>(v); v += xsw<16>(v);
    return sum32(v);
}
__device__ __forceinline__ float bf2f(bf16 h) { return __builtin_bit_cast(float, (unsigned)h << 16); }
__device__ __forceinline__ float bflo(unsigned w) { return __builtin_bit_cast(float, w << 16); }
__device__ __forceinline__ float bfhi(unsigned w) { return __builtin_bit_cast(float, w & 0xffff0000u); }
__device__ __forceinline__ bf16 f2bf_rne(float f) { return (bf16)f2bf(f); }

#ifndef F8_MASK
#define F8_MASK 0xE0
#endif
#define F8SLOT(s_) (((F8_MASK) >> (s_)) & 1)
#ifndef F8A_MASK
#define F8A_MASK 0x00
#endif
#define F8ASLOT(s_) ((s_) < 8 && (((F8A_MASK) >> (s_)) & 1))
#ifndef I8A_MASK
#define I8A_MASK 0xFF
#endif
#define I8ASLOT(s_) ((s_) < 8 && (((I8A_MASK) >> (s_)) & 1))
#define I8CONV(s_) I8ASLOT(s_)
#ifndef I8_WCLIP
#define I8_WCLIP 3.4f
#endif
constexpr size_t WS_I8S = 2048;
#define I8SW(s_) (*(const GAS float*)(WSP() + WS_I8S + 4 * (s_)))
static_assert((I8A_MASK & F8A_MASK) == 0, "a gate|up GEMM is int8 or fp8, not both");
static_assert((F8A_MASK & ~F8_MASK) == 0, "an fp8 gate|up GEMM writes e4m3 hidden rows: its down projection must be fp8 as well");
constexpr size_t WS_X8 = 408 * MiB;
#define XB8 (WSP() + WS_X8)
constexpr int XB8_D = (int)(WS_X8 - WS_XB);
__device__ __forceinline__ void tr_item(const float* W, int K, int N, int Npad, const float* gain, bf16* WT, int gu, LAS float* scr, int item, int lane, float f8s = 0.f) {
    const int nblk = Npad / 32, kb = item / nblk, nb = item % nblk, k0 = 64 * kb, n0 = 32 * nb;
    {
        const int c4 = lane & 7; const bool ok = n0 + 4 * c4 < N;
        const GAS float* src = (const GAS float*)W + (size_t)(k0 + (lane >> 3)) * N + n0 + 4 * c4;
        f32x4 v[8];
#pragma unroll
        for (int i = 0; i < 8; ++i) v[i] = ok ? __builtin_nontemporal_load((const GAS f32x4*)(src + (size_t)(8 * i) * N)) : (f32x4){0.f, 0.f, 0.f, 0.f};
#pragma unroll
        for (int i = 0; i < 8; ++i) { const int kk = 8 * i + (lane >> 3); const float gn = gain ? ((const GAS float*)gain)[k0 + kk] : 1.0f; LAS float* s = scr + kk * 33 + 4 * c4;
            s[0] = v[i][0] * gn; s[1] = v[i][1] * gn; s[2] = v[i][2] * gn; s[3] = v[i][3] * gn;
            }
    }
    LDS_WAIT(); asm volatile("" ::: "memory");
    const int c = lane & 7;
#pragma unroll
    for (int j = 0; j < 4; ++j) { const int n = (lane >> 3) + 8 * j; const LAS float* s = scr + (8 * c) * 33 + n;
        v4u o; o.x = pk2(s[0 * 33], s[1 * 33]); o.y = pk2(s[2 * 33], s[3 * 33]); o.z = pk2(s[4 * 33], s[5 * 33]); o.w = pk2(s[6 * 33], s[7 * 33]);
        int drow = n0 + n;
        if (gu == 3) {
            if (drow < 1024) { const int j = drow & 127; drow = (drow & ~127) + (j < 64 ? 2 * j : 2 * (j - 64) + 1); }
            else if (drow >= 2048 && drow < 3072) { const int j = drow & 63; drow = (drow & ~63) + (j < 8 ? 2 * j : (j < 16 ? 2 * (j - 8) + 1 : j)); }
        } else if (gu == 1 || gu == 2) drow = (drow >> 7) * 256 + (drow & 127) + (gu == 2 ? 128 : 0);
        if (f8s < 0.f) {
            int q[8];
#pragma unroll
            for (int e = 0; e < 8; ++e) q[e] = (int)fminf(fmaxf(rintf(s[e * 33] * -f8s), -127.f), 127.f) & 0xff;
            typedef int i32x2q __attribute__((ext_vector_type(2)));
            *(GAS i32x2q*)((GAS unsigned char*)WT + (size_t)drow * K + k0 + 8 * c) = (i32x2q){q[0] | (q[1] << 8) | (q[2] << 16) | (q[3] << 24), q[4] | (q[5] << 8) | (q[6] << 16) | (q[7] << 24)};
        } else
        if (f8s != 0.f) {
            const int w0 = __builtin_amdgcn_cvt_pk_fp8_f32(s[0 * 33] * f8s, s[1 * 33] * f8s, 0, false), w0b = __builtin_amdgcn_cvt_pk_fp8_f32(s[2 * 33] * f8s, s[3 * 33] * f8s, w0, true);
            const int w1 = __builtin_amdgcn_cvt_pk_fp8_f32(s[4 * 33] * f8s, s[5 * 33] * f8s, 0, false), w1b = __builtin_amdgcn_cvt_pk_fp8_f32(s[6 * 33] * f8s, s[7 * 33] * f8s, w1, true);
            typedef int i32x2_ __attribute__((ext_vector_type(2)));
            *(GAS i32x2_*)((GAS unsigned char*)WT + (size_t)drow * K + k0 + 8 * c) = (i32x2_){w0b, w1b};
        } else
        *(GAS v4u*)(WT + (size_t)drow * K + k0 + 8 * c) = o; }
    LDS_WAIT(); asm volatile("" ::: "memory");
}
__device__ __forceinline__ void convert_weights(const Frame& F0, int l, int part, float pro_s0 = 0.f, float pro_s1 = 0.f) {
    const Frame F = relaunder(F0);
    LAS float* scr = (LAS float*)(F.lds + RING_OFF + F.wave * 16384);
    const int gw = F.bid * NWAVES + F.wave, NGW = F.G * NWAVES;
    unsigned char* ws = WSP();
    constexpr int I_G = (D / 64) * (FF / 32), I_DN = (FF / 64) * (D / 32), I_O = (D / 64) * (D / 32);
    const bool odd = (l & 1) != 0; const int li = l >> 1;
    const int nin = odd ? GLA_IN : EVEN_IN, ninp = odd ? GLA_INP : EVEN_IN; const int I_IN = (D / 64) * (ninp / 32);
    const float* win = odd ? AP(I_GLA_IN) + (size_t)li * D * GLA_IN : AP(I_AB_IN) + (size_t)li * D * EVEN_IN;
    const float* wout = odd ? AP(I_GLA_OUT) + (size_t)li * D * D : AP(I_AB_OUT) + (size_t)li * D * D;
    const size_t fo = (size_t)l * D * FF;
    const int NITEMS = 6 * I_G + I_IN + I_O;
    static_assert(I_G == I_DN, "item counts");
    const int nitems = part == 0 ? NITEMS : (part == 1 ? 3 * I_G + I_IN : 3 * I_G + I_O);
    const float i8s0 = I8CONV(2 * l) ? (part == 0 ? -pro_s0 : -I8SW(2 * l)) : 0.f, i8s1 = I8CONV(2 * l + 1) ? (part == 0 ? -pro_s1 : -I8SW(2 * l + 1)) : 0.f;
    for (int it = gw; it < nitems; it += NGW) {
        int r = part == 2 ? (it < 3 * I_G ? it + 3 * I_G : it + 3 * I_G + I_IN) : ((part == 1 && it >= 3 * I_G) ? it + 3 * I_G : it);
        if (r < I_G) { tr_item(AP(I_PRE_WG) + fo, D, FF, FF, AP(I_PRE_NORM) + l * D, (bf16*)(ws + W_GU0), 1, scr, r, F.lane, I8CONV(2 * l) ? i8s0 : (F8ASLOT(2 * l) ? pg8::F8_GUSCALE : 0.f)); continue; } r -= I_G;
        if (r < I_G) { tr_item(AP(I_PRE_WU) + fo, D, FF, FF, AP(I_PRE_NORM) + l * D, (bf16*)(ws + W_GU0), 2, scr, r, F.lane, I8CONV(2 * l) ? i8s0 : (F8ASLOT(2 * l) ? pg8::F8_GUSCALE : 0.f)); continue; } r -= I_G;
        if (r < I_G) { tr_item(AP(I_PRE_WD) + fo, FF, D, D, nullptr, (bf16*)(ws + W_D0), 0, scr, r, F.lane, F8SLOT(2 * l) ? pg8::F8_WSCALE : 0.f); continue; } r -= I_G;
        if (r < I_G) { tr_item(AP(I_POST_WG) + fo, D, FF, FF, AP(I_POST_NORM) + l * D, (bf16*)(ws + W_GU1), 1, scr, r, F.lane, I8CONV(2 * l + 1) ? i8s1 : (F8ASLOT(2 * l + 1) ? pg8::F8_GUSCALE : 0.f)); continue; } r -= I_G;
        if (r < I_G) { tr_item(AP(I_POST_WU) + fo, D, FF, FF, AP(I_POST_NORM) + l * D, (bf16*)(ws + W_GU1), 2, scr, r, F.lane, I8CONV(2 * l + 1) ? i8s1 : (F8ASLOT(2 * l + 1) ? pg8::F8_GUSCALE : 0.f)); continue; } r -= I_G;
        if (r < I_G) { tr_item(AP(I_POST_WD) + fo, FF, D, D, nullptr, (bf16*)(ws + W_D1), 0, scr, r, F.lane, F8SLOT(2 * l + 1) ? pg8::F8_WSCALE : 0.f); continue; } r -= I_G;
        if (r < I_IN) { tr_item(win, D, nin, ninp, AP(I_MIX_NORM) + l * D, (bf16*)(ws + W_IN), odd ? 0 : 3, scr, r, F.lane); continue; } r -= I_IN;
        tr_item(wout, D, D, D, nullptr, (bf16*)(ws + W_OUT), 0, scr, r, F.lane);
    }
}
__device__ __forceinline__ float i8_scale_block(const Frame& F, int s) {
    const int l = s >> 1; const bool post = (s & 1) != 0; const size_t fo = (size_t)l * D * FF;
    const GAS float* wg = (const GAS float*)(AP(post ? I_POST_WG : I_PRE_WG) + fo); const GAS float* wu = (const GAS float*)(AP(post ? I_POST_WU : I_PRE_WU) + fo);
    const GAS float* gn = (const GAS float*)(AP(post ? I_POST_NORM : I_PRE_NORM) + l * D);
    float ss = 0.f, gm = 0.f;
    {
        f32x4 a[8], b[8];
#pragma unroll
        for (int i = 0; i < 8; ++i) { a[i] = ((const GAS f32x4*)wg)[F.tid + i * NTHREADS]; b[i] = ((const GAS f32x4*)wu)[F.tid + i * NTHREADS]; }
        static_assert(8 * NTHREADS * 4 == 16384, "sample size");
        for (int i = F.tid; i < D; i += NTHREADS) gm = fmaxf(gm, fabsf(gn[i]));
#pragma unroll
        for (int i = 0; i < 8; ++i) ss += a[i][0] * a[i][0] + a[i][1] * a[i][1] + a[i][2] * a[i][2] + a[i][3] * a[i][3] + b[i][0] * b[i][0] + b[i][1] * b[i][1] + b[i][2] * b[i][2] + b[i][3] * b[i][3];
    }
    ss = wave_sum(ss);
    gm = fmaxf(gm, xsw<1>(gm)); gm = fmaxf(gm, xsw<2>(gm)); gm = fmaxf(gm, xsw<4>(gm)); gm = fmaxf(gm, xsw<8>(gm)); gm = fmaxf(gm, xsw<16>(gm)); gm = max32(gm);
    LAS float* red = (LAS float*)(F.lds + RING_OFF);
    if (F.lane == 0) { red[F.wave] = ss; red[8 + F.wave] = gm; }
    __syncthreads();
    float st = 0.f, gt = 0.f;
    for (int w = 0; w < NWAVES; ++w) { st += red[w]; gt = fmaxf(gt, red[8 + w]); }
    __syncthreads();
    const float sigma = sqrtf(st * (1.0f / (2.0f * 16384.0f)));
    return 127.0f / fmaxf(I8_WCLIP * sigma * gt, 1e-20f);
}
__device__ __forceinline__ float i8_scales(const Frame& F0, float& s0) {
    const Frame F = relaunder(F0);
    float s1 = 0.f; s0 = 0.f;
    if (I8ASLOT(0)) { s0 = i8_scale_block(F, 0); if (F.bid == 0 && F.tid == 0) *(GAS float*)(WSP() + WS_I8S) = s0; }
    if (I8ASLOT(1)) { s1 = i8_scale_block(F, 1); if (F.bid == 1 && F.tid == 0) *(GAS float*)(WSP() + WS_I8S + 4) = s1; }
    if (F.bid >= 2 && F.bid < 8 && I8ASLOT(F.bid)) { const float v = i8_scale_block(F, F.bid); if (F.tid == 0) *(GAS float*)(WSP() + WS_I8S + 4 * F.bid) = v; }
    return s1;
}
__device__ __forceinline__ void prologue_rows(const Frame& F0, float pro_s0) {
    const Frame F = relaunder(F0);
    unsigned char* ws = WSP();
    const int gw = F.bid * NWAVES + F.wave, NGW = F.G * NWAVES;
    bf16* XB = (bf16*)(ws + WS_XB); float* ssp = (float*)(ws + WS_SSP);
    const float swi = I8ASLOT(0) ? 1.0f / pro_s0 : 0.f;
    for (int m = gw; m < M; m += NGW) {
        const GAS f32x4* xr = (const GAS f32x4*)(AP(I_X) + (size_t)m * D) + F.lane;
        GAS unsigned long long* o8 = (GAS unsigned long long*)(XB + (size_t)m * D) + F.lane;
        f32x4 v[4];
#pragma unroll
        for (int j = 0; j < 4; ++j) v[j] = xr[64 * j];
        float s = 0.f, mx = 0.f;
#pragma unroll
        for (int j = 0; j < 4; ++j) { s += (v[j].x * v[j].x + v[j].y * v[j].y) + (v[j].z * v[j].z + v[j].w * v[j].w);
            o8[64 * j] = (unsigned long long)pk2(v[j].x, v[j].y) | ((unsigned long long)pk2(v[j].z, v[j].w) << 32);
            mx = fmaxf(fmaxf(mx, fmaxf(fabsf(v[j].x), fabsf(v[j].y))), fmaxf(fabsf(v[j].z), fabsf(v[j].w))); }
        s = wave_sum(s);
        if (I8ASLOT(0)) {
            mx = fmaxf(mx, xsw<1>(mx)); mx = fmaxf(mx, xsw<2>(mx)); mx = fmaxf(mx, xsw<4>(mx)); mx = fmaxf(mx, xsw<8>(mx)); mx = fmaxf(mx, xsw<16>(mx)); mx = max32(mx);
            mx = fmaxf(mx, 1e-20f);
            const float sx = 127.0f / mx;
            GAS unsigned* x8 = (GAS unsigned*)(ws + WS_X8 + (size_t)m * D) + F.lane;
#pragma unroll
            for (int j = 0; j < 4; ++j) x8[64 * j] = (unsigned)(((int)rintf(v[j].x * sx) & 0xff) | (((int)rintf(v[j].y * sx) & 0xff) << 8) | (((int)rintf(v[j].z * sx) & 0xff) << 16) | (((int)rintf(v[j].w * sx) & 0xff) << 24));
            const float rstd = 1.0f / sqrtf(s * (1.0f / D) + EPS), reff = rstd * mx * (1.0f / 127.0f) * swi;
            s = 1024.0f * (1.0f / (reff * reff) - EPS);
        }
        if (F.lane < 16) ssp[(size_t)m * 16 + F.lane] = (F.lane == 0) ? s : 0.f;
    }
    const int gt = F.bid * NTHREADS + F.tid, NGT = F.G * NTHREADS;
    float* rc = (float*)(ws + TAB_RC); float* rsn = (float*)(ws + TAB_RS); float* dc = (float*)(ws + TAB_DC); float* ds = (float*)(ws + TAB_DS);
    for (int e = gt; e < SEQ * 64; e += NGT) { const int t = e >> 6, i = e & 63; const float ang = (float)t * RET_FREQ[i];
        double rev = (double)ang * 0.15915494309189535; rev -= __builtin_rint(rev); const float r = (float)rev;
        rc[e] = __builtin_amdgcn_cosf(r); rsn[e] = __builtin_amdgcn_sinf(r); }
    for (int e = gt; e < SEQ * 8; e += NGT) { const int t = e >> 3, i = e & 7; const float ang = (float)t * ROPE_FREQ[i];
        double rev = (double)ang * 0.15915494309189535; rev -= __builtin_rint(rev); const float r = (float)rev;
        dc[e] = __builtin_amdgcn_cosf(r); ds[e] = __builtin_amdgcn_sinf(r); }
}

__device__ __forceinline__ void quant_rows(const Frame& F0, int slot) {
    const Frame F = relaunder(F0);
    unsigned char* ws = WSP();
    const int pan0 = (F.bid & 7) * 16 + ((F.bid >> 3) & 7), widx = (F.bid >> 6) * NWAVES + F.wave;
    const bf16* XBp = (const bf16*)(ws + WS_XB); unsigned char* X8 = ws + WS_X8; float* ssp = (float*)(ws + WS_SSP);
    const float swi = 1.0f / I8SW(slot);
    for (int k = 0; k < 16; ++k) {
        const int m = (pan0 + (k & 8)) * 256 + widx + 32 * (k & 7);
        const GAS v4u* xr = (const GAS v4u*)(XBp + (size_t)m * D) + 2 * F.lane;
        const v4u a = xr[0], b = xr[1];
        float v[16];
#pragma unroll
        for (int i = 0; i < 4; ++i) { v[2 * i] = bflo(a[i]); v[2 * i + 1] = bfhi(a[i]); v[8 + 2 * i] = bflo(b[i]); v[8 + 2 * i + 1] = bfhi(b[i]); }
        float ss = 0.f, mx = 0.f;
#pragma unroll
        for (int i = 0; i < 16; ++i) { ss += v[i] * v[i]; mx = fmaxf(mx, fabsf(v[i])); }
        ss = wave_sum(ss);
        mx = fmaxf(mx, xsw<1>(mx)); mx = fmaxf(mx, xsw<2>(mx)); mx = fmaxf(mx, xsw<4>(mx)); mx = fmaxf(mx, xsw<8>(mx)); mx = fmaxf(mx, xsw<16>(mx)); mx = max32(mx);
        mx = fmaxf(mx, 1e-20f);
        const float sx = 127.0f / mx;
        int q[16];
#pragma unroll
        for (int i = 0; i < 16; ++i) q[i] = (int)rintf(v[i] * sx) & 0xff;
        v4u o;
#pragma unroll
        for (int i = 0; i < 4; ++i) o[i] = (unsigned)(q[4 * i] | (q[4 * i + 1] << 8) | (q[4 * i + 2] << 16) | (q[4 * i + 3] << 24));
        *((GAS v4u*)(X8 + (size_t)m * D) + F.lane) = o;
        const float rstd = 1.0f / sqrtf(ss * (1.0f / D) + EPS), reff = rstd * mx * (1.0f / 127.0f) * swi;
        if (F.lane < 16) ssp[(size_t)m * 16 + F.lane] = (F.lane == 0) ? 1024.0f * (1.0f / (reff * reff) - EPS) : 0.f;
    }
}

__device__ __forceinline__ void final_norm(const Frame& F0) {
    const Frame F = relaunder(F0);
    const int pan0 = (F.bid & 7) * 16 + ((F.bid >> 3) & 7), widx = (F.bid >> 6) * NWAVES + F.wave;
    const bf16* XBp = (const bf16*)(WSP() + WS_XB); float* out = OUTP(); const GAS f32x4* gr = (const GAS f32x4*)AP(I_FINAL);
    for (int k = 0; k < 16; ++k) {
        const int m = (pan0 + (k & 8)) * 256 + widx + 32 * (k & 7);
        const v4u w0 = *(const GAS v4u*)(XBp + (size_t)m * D + F.lane * 8), w1 = *(const GAS v4u*)(XBp + (size_t)m * D + 512 + F.lane * 8);
        float v[16]; float s = 0.f;
#pragma unroll
        for (int i = 0; i < 4; ++i) { v[2 * i] = bflo(w0[i]); v[2 * i + 1] = bfhi(w0[i]); v[8 + 2 * i] = bflo(w1[i]); v[8 + 2 * i + 1] = bfhi(w1[i]); }
#pragma unroll
        for (int i = 0; i < 16; ++i) s += v[i] * v[i];
        const float rstd = 1.0f / sqrtf(wave_sum(s) * (1.0f / D) + EPS);
        GAS f32x4* o = (GAS f32x4*)(out + (size_t)m * D);
#pragma unroll
        for (int hh = 0; hh < 2; ++hh)
#pragma unroll
            for (int q = 0; q < 2; ++q) { const int c4 = hh * 128 + F.lane * 2 + q; const f32x4 g = gr[c4];
                o[c4] = (f32x4){v[hh * 8 + q * 4] * rstd * g[0], v[hh * 8 + q * 4 + 1] * rstd * g[1], v[hh * 8 + q * 4 + 2] * rstd * g[2], v[hh * 8 + q * 4 + 3] * rstd * g[3]}; }
    }
}


__device__ __forceinline__ float silu_f(float g) { return g * __builtin_amdgcn_rcpf(1.0f + __builtin_amdgcn_exp2f(-1.4426950408889634f * g)); }
typedef float f32x16 __attribute__((ext_vector_type(16)));
typedef short s16x4 __attribute__((ext_vector_type(4)));
typedef float f32x2_t __attribute__((ext_vector_type(2)));
typedef __bf16 bf16x2_t __attribute__((ext_vector_type(2)));
#define MFMA32(a, b, c) __builtin_amdgcn_mfma_f32_32x32x16_bf16((a), (b), (c), 0, 0, 0)
__device__ __forceinline__ int crow(int reg, int h) { return (reg & 3) + 8 * (reg >> 2) + 4 * h; }
__device__ __forceinline__ unsigned cvtpk(float lo, float hi) { f32x2_t v = {lo, hi}; bf16x2_t b = __builtin_convertvector(v, bf16x2_t); return __builtin_bit_cast(unsigned, b); }
__device__ __forceinline__ bf16 cvt1(float v) { return (bf16)(cvtpk(v, 0.f) & 0xffffu); }
#define PACK_STEP(x, s) __builtin_bit_cast(bf16x8, (v4u){cvtpk((x)[8 * (s)], (x)[8 * (s) + 1]), cvtpk((x)[8 * (s) + 2], (x)[8 * (s) + 3]), cvtpk((x)[8 * (s) + 4], (x)[8 * (s) + 5]), cvtpk((x)[8 * (s) + 6], (x)[8 * (s) + 7])})
typedef const LAS unsigned char* lcp;
__device__ __forceinline__ int lndv(int v) { asm volatile("" : "+v"(v)); return v; }
__device__ __forceinline__ bf16x8 ld_row(lcp img, int P, int row0, int k0, int r, int h) { return *(const LAS bf16x8*)(img + (row0 + r) * P + (k0 + 8 * h) * 2); }
__device__ __forceinline__ bf16x8 ld_row_perm(lcp img, int P, int row0, int k0, int r, int h) {
    const s16x4 lo = *(const LAS s16x4*)(img + (row0 + r) * P + (k0 + 4 * h) * 2), hi = *(const LAS s16x4*)(img + (row0 + r) * P + (k0 + 8 + 4 * h) * 2);
    return __builtin_shufflevector(lo, hi, 0, 1, 2, 3, 4, 5, 6, 7); }
__device__ __forceinline__ s16x4 trd(lcp p) { return __builtin_bit_cast(s16x4, __builtin_amdgcn_ds_read_tr16_b64_v4i16((LAS s16x4*)p)); }
__device__ __forceinline__ bf16x8 ld_tr(lcp img, int P, int k0, int c0, int lane) {
    const int i16 = lane & 15, q = i16 >> 2, p = i16 & 3, blk = (lane >> 4) & 1, h = lane >> 5;
    lcp a = img + (k0 + 8 * h + q) * P + (c0 + 16 * blk + 4 * p) * 2;
    const s16x4 lo = trd(a), hi = trd(a + 4 * P);
    return __builtin_shufflevector(lo, hi, 0, 1, 2, 3, 4, 5, 6, 7); }
__device__ __forceinline__ bf16x8 ld_tr_perm(lcp img, int P, int k0, int c0, int lane) {
    const int i16 = lane & 15, q = i16 >> 2, p = i16 & 3, blk = (lane >> 4) & 1, h = lane >> 5;
    lcp a = img + (k0 + 4 * h + q) * P + (c0 + 16 * blk + 4 * p) * 2;
    const s16x4 lo = trd(a), hi = trd(a + 8 * P);
    return __builtin_shufflevector(lo, hi, 0, 1, 2, 3, 4, 5, 6, 7); }
template <int R, int C> __device__ __forceinline__ void tile_ld(v4u (&v)[R * C / 8 / NTHREADS], const bf16* g, size_t gp, int tid) {
    constexpr int CPR = C / 8, RS = NTHREADS / CPR;
    static_assert(NTHREADS % CPR == 0, "tile shape");
    const unsigned voff = (unsigned)((tid / CPR) * (int)gp + (tid % CPR) * 8) * 2u;
    const GAS unsigned char* gb = (const GAS unsigned char*)g;
#pragma unroll
    for (int i = 0; i < R * C / 8 / NTHREADS; ++i) v[i] = *(const GAS v4u*)(gb + (size_t)i * RS * gp * 2 + voff);
}
template <int R, int C> __device__ __forceinline__ void tile_st(const v4u (&v)[R * C / 8 / NTHREADS], LAS unsigned char* img, int P, int tid) {
    constexpr int CPR = C / 8, RS = NTHREADS / CPR;
    LAS unsigned char* lb = img + (tid / CPR) * P + (tid % CPR) * 16;
#pragma unroll
    for (int i = 0; i < R * C / 8 / NTHREADS; ++i) *(LAS v4u*)(lb + i * RS * P) = v[i];
}
template <int R, int C> __device__ __forceinline__ void stage_tile(LAS unsigned char* img, int P, const bf16* g, size_t gp, int tid) { v4u t_[R * C / 8 / NTHREADS]; tile_ld<R, C>(t_, g, gp, tid); tile_st<R, C>(t_, img, P, tid); }
#define WG_BAR() do { asm volatile("s_waitcnt lgkmcnt(0)" ::: "memory"); __builtin_amdgcn_s_barrier(); asm volatile("" ::: "memory"); } while (0)

constexpr int PR = 272, PT = 320, PT256 = 576, PO256 = 528;
constexpr size_t WS_ALOW = 7 * MiB;
constexpr size_t WS_DEC = 6 * MiB;
constexpr float LOG2E = 1.4426950408889634f, LN2 = 0.6931471805599453f;
__device__ __forceinline__ void gla_cumsum(float (&Bc)[2][16], float& Blast, lcp AL, lcp W2, const LAS float* BA, LAS float* EX, int wave, int lane) {
    const int r = lane & 31, h = lane >> 5, db = wave & 3, jh = wave >> 2;
    const bf16x8 wf = *(const LAS bf16x8*)(W2 + (db * 32 + r) * 32 + h * 16);
    const float bias = BA[db * 32 + r];
    float run = 0.f;
    float c16 = 1.0f / 16.0f; asm volatile("" : "+v"(c16)); float ln2_ = LN2; asm volatile("" : "+v"(ln2_));
#pragma unroll
    for (int t = 0; t < 2; ++t) {
        const bf16x8 af = *(const LAS bf16x8*)(AL + ((jh * 2 + t) * 32 + r) * 32 + h * 16);
        f32x16 z = {0.f, 0.f, 0.f, 0.f, 0.f, 0.f, 0.f, 0.f, 0.f, 0.f, 0.f, 0.f, 0.f, 0.f, 0.f, 0.f};
        z = MFMA32(af, wf, z);
        float own[4], oth[4];
#pragma unroll
        for (int g = 0; g < 4; ++g) {
            float acc = 0.f;
#pragma unroll
            for (int i = 0; i < 4; ++i) { const float zz = z[4 * g + i] + bias;
                const float la = (fminf(zz, 0.f) - ln2_ * __builtin_amdgcn_logf(1.0f + __builtin_amdgcn_exp2f(-fabsf(zz) * LOG2E))) * c16;
                acc += la; Bc[t][4 * g + i] = acc; }
            own[g] = acc; oth[g] = oth32(acc, h);
        }
#pragma unroll
        for (int g = 0; g < 4; ++g) { const float off = run + (h ? oth[g] : 0.f);
#pragma unroll
            for (int i = 0; i < 4; ++i) Bc[t][4 * g + i] += off;
            run += own[g] + oth[g]; }
    }
    if (h == 0) EX[jh * 128 + db * 32 + r] = run;
    WG_BAR();
    const float t0 = EX[db * 32 + r], t1 = EX[128 + db * 32 + r];
    Blast = t0 + t1;
    if (jh == 1) {
#pragma unroll
        for (int t = 0; t < 2; ++t)
#pragma unroll
            for (int i = 0; i < 16; ++i) Bc[t][i] += t0; }
}
constexpr int GA_KI = 0, GA_VI = GA_KI + 128 * PR, GA_KD = GA_VI + 128 * PT256, GA_AL = GA_KD + 128 * PT, GA_W2 = GA_AL + 4096, GA_BA = GA_W2 + 4096, GA_EX = GA_BA + 512, GA_END = GA_EX + 1024;
constexpr int GA_OI = GA_VI;
constexpr int GC_QT = 0, GC_KT = GC_QT + 128 * PR, GC_SI = GC_KT + 128 * PR, GC_VI = GC_SI + 128 * PT, GC_AL = GC_VI + 128 * PT, GC_W2 = GC_AL + 4096, GC_BA = GC_W2 + 4096, GC_EX = GC_BA + 512, GC_END = GC_EX + 1024;
constexpr int GC_OI = 0;
static_assert(GA_END <= LDSCTL_OFF && GC_END <= LDSCTL_OFF && 128 * PO256 <= GC_SI && 128 * PO256 <= 128 * PT256, "GLA LDS maps");
__device__ __forceinline__ void gla_stage_w(const Frame& F, LAS unsigned char* W2, LAS float* BA, int li, int h) {
    if (F.tid < 128) { const int d = F.tid; const GAS float* w2 = (const GAS float*)AP(I_GLA_A2) + (size_t)li * 16 * 512 + h * 128 + d;
        v4u lo, hi; lo.x = cvtpk(w2[0], w2[512]); lo.y = cvtpk(w2[2 * 512], w2[3 * 512]); lo.z = cvtpk(w2[4 * 512], w2[5 * 512]); lo.w = cvtpk(w2[6 * 512], w2[7 * 512]);
        hi.x = cvtpk(w2[8 * 512], w2[9 * 512]); hi.y = cvtpk(w2[10 * 512], w2[11 * 512]); hi.z = cvtpk(w2[12 * 512], w2[13 * 512]); hi.w = cvtpk(w2[14 * 512], w2[15 * 512]);
        *(LAS v4u*)(W2 + d * 32) = lo; *(LAS v4u*)(W2 + d * 32 + 16) = hi; }
    else if (F.tid < 256) { const int d = F.tid - 128; BA[d] = ((const GAS float*)AP(I_GLA_BA))[(size_t)li * 512 + h * 128 + d]; }
}
__device__ __forceinline__ v4u gla_ld_alow(int tid, const bf16* Arow0) { const int t = tid & 255; return *(const GAS v4u*)(Arow0 + (size_t)(t >> 1) * 16 + (t & 1) * 8); }
__device__ __forceinline__ void gla_st_alow(int tid, v4u v, LAS unsigned char* AL) { if (tid < 256) *(LAS v4u*)(AL + (tid >> 1) * 32 + (tid & 1) * 16) = v; }

__device__ __forceinline__ void gla_alow(const Frame& F0) {
    const Frame F = relaunder(F0);
    unsigned char* ws = WSP();
    const bf16* XBp = (const bf16*)(ws + WS_XB); const bf16* Wa = (const bf16*)(ws + W_IN) + (size_t)3072 * D; const float* ssp = (const float*)(ws + WS_SSP); bf16* ALOW = (bf16*)(ws + WS_ALOW);
    LAS unsigned char* L = F.lds;
    const int lane = F.lane, r = lane & 31, h2 = lane >> 5, tb = F.wave & 3, kh = F.wave >> 2;
    for (int it = F.bid; it < M / 128; it += F.G) {
        const int tj = it >> 3, blk = (((it & 7) * 16 + (tj & 7) + ((tj >> 4) & 1) * 8) * 2 + ((tj >> 3) & 1)) & (M / 128 - 1);
        const int tok = blk * 128 + tb * 32 + r;
        const bf16* xa = XBp + (size_t)tok * D + kh * 512 + 8 * h2; const bf16* wa = Wa + (size_t)(r & 15) * D + kh * 512 + 8 * h2;
        f32x16 acc = {0.f, 0.f, 0.f, 0.f, 0.f, 0.f, 0.f, 0.f, 0.f, 0.f, 0.f, 0.f, 0.f, 0.f, 0.f, 0.f};
#pragma unroll 1
        for (int k8 = 0; k8 < 4; ++k8) {
            bf16x8 af[8], bfr[8];
#pragma unroll
            for (int ks = 0; ks < 8; ++ks) { af[ks] = *(const GAS bf16x8*)(wa + (k8 * 8 + ks) * 16); bfr[ks] = *(const GAS bf16x8*)(xa + (k8 * 8 + ks) * 16); }
#pragma unroll
            for (int ks = 0; ks < 8; ++ks) acc = MFMA32(af[ks], bfr[ks], acc);
        }
        LAS float* red = (LAS float*)L + tb * 1024;
        if (kh == 1) {
#pragma unroll
            for (int i = 0; i < 8; ++i) red[i * 64 + lane] = acc[i]; }
        WG_BAR();
        if (kh == 0) {
            const f32x4 p0 = *(const GAS f32x4*)(ssp + (size_t)tok * 16), p1 = *(const GAS f32x4*)(ssp + (size_t)tok * 16 + 4), p2 = *(const GAS f32x4*)(ssp + (size_t)tok * 16 + 8), p3 = *(const GAS f32x4*)(ssp + (size_t)tok * 16 + 12);
            const float ss = ((p0[0] + p0[1]) + (p0[2] + p0[3])) + ((p1[0] + p1[1]) + (p1[2] + p1[3])) + ((p2[0] + p2[1]) + (p2[2] + p2[3])) + ((p3[0] + p3[1]) + (p3[2] + p3[3]));
            const float rstd = __builtin_amdgcn_rsqf(ss * (1.0f / 1024.0f) + EPS);
            float v[8];
#pragma unroll
            for (int i = 0; i < 8; ++i) v[i] = (acc[i] + red[i * 64 + lane]) * rstd;
            typedef unsigned u2v __attribute__((ext_vector_type(2)));
            u2v w0, w1; w0.x = cvtpk(v[0], v[1]); w0.y = cvtpk(v[2], v[3]); w1.x = cvtpk(v[4], v[5]); w1.y = cvtpk(v[6], v[7]);
            *(GAS u2v*)(ALOW + (size_t)tok * 16 + 4 * h2) = w0; *(GAS u2v*)(ALOW + (size_t)tok * 16 + 8 + 4 * h2) = w1;
        }
        WG_BAR();
    }
}
__device__ __forceinline__ void gla_phase_a(const Frame& F0, int li) {
    const Frame F = relaunder(F0);
    unsigned char* ws = WSP();
    const bf16* P = (const bf16*)(ws + WS_ACT); bf16* SKV = (bf16*)OUTP(); float* DEC = (float*)(ws + WS_DEC); const bf16* ALOWP = (const bf16*)(ws + WS_ALOW);
    LAS unsigned char* L = F.lds;
    const int wave = F.wave, db = wave & 3, jh = wave >> 2;
    v4u kR[4], vR[8], aR; int hcur = -1;
    {   const int it = F.bid; if (it < 1024) { const int bh = it >> 5, g = it & 31, b = bh >> 2, h = bh & 3;
            tile_ld<128, 128>(kR, P + HM(G_K, 4, 128, b, h) + g * 128 * 128, 128, F.tid); tile_ld<128, 256>(vR, P + HM(G_V, 4, 256, b, h) + g * 128 * 256, 256, F.tid); aR = gla_ld_alow(F.tid, ALOWP + ((size_t)b * SEQ + g * 128) * 16); } }
    for (int it = F.bid; it < 1024; it += F.G) {
        const int bh = it >> 5, h = bh & 3;
        const int lane = lndv(F.lane), r = lane & 31, h2 = lane >> 5;
        tile_st<128, 128>(kR, L + GA_KI, PR, F.tid); tile_st<128, 256>(vR, L + GA_VI, PT256, F.tid); gla_st_alow(F.tid, aR, L + GA_AL);
        if (h != hcur) { gla_stage_w(F, L + GA_W2, (LAS float*)(L + GA_BA), li, h); hcur = h; }
        WG_BAR();
        {   const int nx = it + F.G; if (nx < 1024) { const int bh2 = nx >> 5, g2 = nx & 31, b2 = bh2 >> 2, h2n = bh2 & 3;
                tile_ld<128, 128>(kR, P + HM(G_K, 4, 128, b2, h2n) + g2 * 128 * 128, 128, F.tid); tile_ld<128, 256>(vR, P + HM(G_V, 4, 256, b2, h2n) + g2 * 128 * 256, 256, F.tid); aR = gla_ld_alow(F.tid, ALOWP + ((size_t)b2 * SEQ + g2 * 128) * 16); } }
        float Bc[2][16], Blast;
        gla_cumsum(Bc, Blast, L + GA_AL, L + GA_W2, (const LAS float*)(L + GA_BA), (LAS float*)(L + GA_EX), wave, lane);
#pragma unroll
        for (int t = 0; t < 2; ++t)
#pragma unroll
            for (int i = 0; i < 16; ++i) { const int row = (jh * 2 + t) * 32 + crow(i, h2), col = db * 32 + r;
                const float kv = bf2f(*(const LAS bf16*)(L + GA_KI + row * PR + col * 2)) * __builtin_amdgcn_exp2f((Blast - Bc[t][i]) * LOG2E);
                *(LAS bf16*)(L + GA_KD + row * PT + col * 2) = cvt1(kv); }
        if (jh == 0 && h2 == 0) DEC[(size_t)it * 128 + db * 32 + r] = __builtin_amdgcn_exp2f(Blast * LOG2E);
        WG_BAR();
        f32x16 acc[4];
#pragma unroll
        for (int t = 0; t < 4; ++t) acc[t] = (f32x16){0.f, 0.f, 0.f, 0.f, 0.f, 0.f, 0.f, 0.f, 0.f, 0.f, 0.f, 0.f, 0.f, 0.f, 0.f, 0.f};
#pragma unroll
        for (int ks = 0; ks < 8; ++ks) { const bf16x8 a = ld_tr(L + GA_KD, PT, 16 * ks, db * 32, lane);
#pragma unroll
            for (int t = 0; t < 4; ++t) acc[t] = MFMA32(a, ld_tr(L + GA_VI, PT256, 16 * ks, (4 * jh + t) * 32, lane), acc[t]); }
        WG_BAR();
#pragma unroll
        for (int t = 0; t < 4; ++t)
#pragma unroll
            for (int i = 0; i < 16; ++i) *(LAS bf16*)(L + GA_OI + (db * 32 + crow(i, h2)) * PO256 + ((4 * jh + t) * 32 + r) * 2) = cvt1(acc[t][i]);
        WG_BAR();
        {   bf16* out = SKV + (size_t)it * 128 * 256;
#pragma unroll
            for (int i = 0; i < 8; ++i) { const int c = F.tid + i * NTHREADS, row = c >> 5, cc = c & 31; *(GAS v4u*)(out + row * 256 + cc * 8) = *(const LAS v4u*)(L + GA_OI + row * PO256 + cc * 16); } }
        WG_BAR();
    }
}
__device__ __forceinline__ void gla_phase_b(const Frame& F0) {
    const Frame F = relaunder(F0);
    unsigned char* ws = WSP();
    bf16* SKV = (bf16*)OUTP(); const float* DEC = (const float*)(ws + WS_DEC);
    for (int gt = F.bid * NTHREADS + F.tid; gt < 32 * 128 * 32; gt += F.G * NTHREADS) {
        const int bh = gt >> 12, d = (gt >> 5) & 127, e8 = gt & 31;
        float s[8];
#pragma unroll
        for (int i = 0; i < 8; ++i) s[i] = 0.f;
        for (int g0 = 0; g0 < 32; g0 += 8) {
            v4u kv[8]; float dc[8];
#pragma unroll
            for (int u = 0; u < 8; ++u) { const size_t item = (size_t)bh * 32 + g0 + u; kv[u] = *(const GAS v4u*)(SKV + (item * 128 + d) * 256 + e8 * 8); dc[u] = ((const GAS float*)DEC)[item * 128 + d]; }
#pragma unroll
            for (int u = 0; u < 8; ++u) { const size_t item = (size_t)bh * 32 + g0 + u;
                v4u o; o.x = cvtpk(s[0], s[1]); o.y = cvtpk(s[2], s[3]); o.z = cvtpk(s[4], s[5]); o.w = cvtpk(s[6], s[7]);
                *(GAS v4u*)(SKV + (item * 128 + d) * 256 + e8 * 8) = o;
#pragma unroll
                for (int i = 0; i < 4; ++i) { s[2 * i] = dc[u] * s[2 * i] + bflo(kv[u][i]); s[2 * i + 1] = dc[u] * s[2 * i + 1] + bfhi(kv[u][i]); } }
        }
    }
}
__device__ __forceinline__ void gla_phase_c(const Frame& F0, int li) {
    const Frame F = relaunder(F0);
    unsigned char* ws = WSP();
    const bf16* P = (const bf16*)(ws + WS_ACT); const bf16* SKV = (const bf16*)OUTP(); bf16* CAT = (bf16*)(ws + WS_CAT); const bf16* ALOWP = (const bf16*)(ws + WS_ALOW);
    LAS unsigned char* L = F.lds;
    const int wave = F.wave, db = wave & 3, jh = wave >> 2;
    const int ib = wave & 3, eq = wave >> 2;
    v4u qR[4], kR[4], aR; int hcur = -1;
    {   const int it = F.bid; if (it < 1024) { const int bh = it >> 5, g = it & 31, b = bh >> 2, h = bh & 3;
            tile_ld<128, 128>(qR, P + HM(G_Q, 4, 128, b, h) + g * 128 * 128, 128, F.tid); tile_ld<128, 128>(kR, P + HM(G_K, 4, 128, b, h) + g * 128 * 128, 128, F.tid); aR = gla_ld_alow(F.tid, ALOWP + ((size_t)b * SEQ + g * 128) * 16); } }
    for (int it = F.bid; it < 1024; it += F.G) {
        const int bh = it >> 5, g = it & 31, b = bh >> 2, h = bh & 3;
        const int tidl = lndv(F.tid), lane = tidl & 63, r = lane & 31, h2 = lane >> 5;
        const bf16* Vs = P + HM(G_V, 4, 256, b, h) + (size_t)g * 128 * 256; const bf16* Rs = P + HM(G_R, 4, 256, b, h) + (size_t)g * 128 * 256;
        const bf16* Sg = SKV + (size_t)it * 128 * 256;
        {   v4u sR[4], vR[4]; tile_ld<128, 128>(sR, Sg, 256, tidl); tile_ld<128, 128>(vR, Vs, 256, tidl);
            tile_st<128, 128>(qR, L + GC_QT, PR, tidl); tile_st<128, 128>(kR, L + GC_KT, PR, tidl); tile_st<128, 128>(sR, L + GC_SI, PT, tidl); tile_st<128, 128>(vR, L + GC_VI, PT, tidl); }
        gla_st_alow(tidl, aR, L + GC_AL);
        if (h != hcur) { gla_stage_w(F, L + GC_W2, (LAS float*)(L + GC_BA), li, h); hcur = h; }
        WG_BAR();
        {
            float Bc[2][16], Blast;
            gla_cumsum(Bc, Blast, L + GC_AL, L + GC_W2, (const LAS float*)(L + GC_BA), (LAS float*)(L + GC_EX), wave, lane);
#pragma unroll
            for (int t = 0; t < 2; ++t)
#pragma unroll
                for (int i = 0; i < 16; ++i) { const int off = ((jh * 2 + t) * 32 + crow(i, h2)) * PR + (db * 32 + r) * 2;
                    const float eb = __builtin_amdgcn_exp2f(Bc[t][i] * LOG2E);
                    const float qv = bf2f(*(const LAS bf16*)(L + GC_QT + off)) * eb * 0.08838834764831845f;
                    const float kv = bf2f(*(const LAS bf16*)(L + GC_KT + off)) * __builtin_amdgcn_rcpf(eb);
                    *(LAS bf16*)(L + GC_QT + off) = cvt1(qv); *(LAS bf16*)(L + GC_KT + off) = cvt1(kv); }
        }
        WG_BAR();
        bf16x8 PA[4][2];
#pragma unroll
        for (int jb = 0; jb < 4; ++jb) {
            if (jb <= ib) {
                f32x16 x = {0.f, 0.f, 0.f, 0.f, 0.f, 0.f, 0.f, 0.f, 0.f, 0.f, 0.f, 0.f, 0.f, 0.f, 0.f, 0.f};
#pragma unroll
                for (int ks = 0; ks < 8; ++ks) x = MFMA32(ld_row(L + GC_KT, PR, jb * 32, 16 * ks, r, h2), ld_row(L + GC_QT, PR, ib * 32, 16 * ks, r, h2), x);
                if (jb == ib) {
#pragma unroll
                    for (int i = 0; i < 16; ++i) if (crow(i, h2) > r) x[i] = 0.f; }
                PA[jb][0] = PACK_STEP(x, 0); PA[jb][1] = PACK_STEP(x, 1);
            } else { PA[jb][0] = (bf16x8){0, 0, 0, 0, 0, 0, 0, 0}; PA[jb][1] = (bf16x8){0, 0, 0, 0, 0, 0, 0, 0}; }
        }
        f32x16 o[2][2];
        v4u s1R[4], v1R[4];
        tile_ld<128, 128>(s1R, Sg + 128, 256, tidl); tile_ld<128, 128>(v1R, Vs + 128, 256, tidl);
#pragma unroll
        for (int half = 0; half < 2; ++half) {
            if (half == 1) {
                WG_BAR();
                tile_st<128, 128>(s1R, L + GC_SI, PT, tidl); tile_st<128, 128>(v1R, L + GC_VI, PT, tidl);
                WG_BAR();
            }
#pragma unroll
            for (int t = 0; t < 2; ++t) {
                const int eb = 2 * eq + t;
                f32x16 acc = {0.f, 0.f, 0.f, 0.f, 0.f, 0.f, 0.f, 0.f, 0.f, 0.f, 0.f, 0.f, 0.f, 0.f, 0.f, 0.f};
#pragma unroll
                for (int jb = 0; jb < 4; ++jb) if (jb <= ib) {
#pragma unroll
                    for (int s = 0; s < 2; ++s) acc = MFMA32(PA[jb][s], ld_tr_perm(L + GC_VI, PT, jb * 32 + 16 * s, eb * 32, lane), acc); }
#pragma unroll
                for (int ks = 0; ks < 8; ++ks) acc = MFMA32(ld_row(L + GC_QT, PR, ib * 32, 16 * ks, r, h2), ld_tr(L + GC_SI, PT, 16 * ks, eb * 32, lane), acc);
                o[half][t] = acc;
            }
        }
        WG_BAR();
#pragma unroll
        for (int half = 0; half < 2; ++half)
#pragma unroll
            for (int t = 0; t < 2; ++t)
#pragma unroll
                for (int i = 0; i < 16; ++i) *(LAS bf16*)(L + GC_OI + (ib * 32 + crow(i, h2)) * PO256 + (half * 128 + (2 * eq + t) * 32 + r) * 2) = cvt1(o[half][t][i]);
        WG_BAR();
        {   const int nx = (it + F.G < 1024) ? it + F.G : it;
            const int bh2 = nx >> 5, g2 = nx & 31, hn = bh2 & 3, bn = bh2 >> 2;
            tile_ld<128, 128>(qR, P + HM(G_Q, 4, 128, bn, hn) + g2 * 128 * 128, 128, tidl); tile_ld<128, 128>(kR, P + HM(G_K, 4, 128, bn, hn) + g2 * 128 * 128, 128, tidl); aR = gla_ld_alow(tidl, ALOWP + ((size_t)bn * SEQ + g2 * 128) * 16); }
        {
            const int tid2 = lndv(tidl), row = tid2 >> 2, qtr = tid2 & 3;
            lcp orow = L + GC_OI + row * PO256 + qtr * 128;
            const bf16* gp = Rs + (size_t)row * 256 + qtr * 64;
            float sum = 0.f;
#pragma unroll
            for (int c = 0; c < 8; ++c) { const v4u w = *(const LAS v4u*)(orow + c * 16);
#pragma unroll
                for (int i = 0; i < 4; ++i) sum += bflo(w[i]) + bfhi(w[i]); }
            sum += xsw<1>(sum); sum += xsw<2>(sum);
            const float mu = sum * (1.0f / 256.0f); float sq = 0.f;
#pragma unroll
            for (int c = 0; c < 8; ++c) { const v4u w = *(const LAS v4u*)(orow + c * 16);
#pragma unroll
                for (int i = 0; i < 4; ++i) { const float d0 = bflo(w[i]) - mu, d1 = bfhi(w[i]) - mu; sq += d0 * d0 + d1 * d1; } }
            sq += xsw<1>(sq); sq += xsw<2>(sq);
            float eps_ = EPS; asm volatile("" : "+v"(eps_)); const float rstd = 1.0f / sqrtf(sq * (1.0f / 256.0f) + eps_);
            bf16* op = CAT + ((size_t)b * SEQ + g * 128 + row) * D + h * 256 + qtr * 64;
#pragma unroll
            for (int c = 0; c < 8; ++c) { const v4u gw = *(const GAS v4u*)(gp + c * 8); const v4u w = *(const LAS v4u*)(orow + c * 16); v4u ow;
#pragma unroll
                for (int i = 0; i < 4; ++i) { const float g0 = bflo(gw[i]), g1 = bfhi(gw[i]);
                    ow[i] = cvtpk((bflo(w[i]) - mu) * rstd * silu_f(g0), (bfhi(w[i]) - mu) * rstd * silu_f(g1)); }
                *(GAS v4u*)(op + c * 8) = ow; }
        }
        WG_BAR();
    }
}


constexpr size_t WS_OD = 408 * MiB;
constexpr size_t OUT_LSE = 32 * MiB;
constexpr size_t WS_END2 = 504 * MiB;
constexpr int RA_KI = 0, RA_VD = RA_KI + 128 * PT, RA_END = RA_VD + 128 * PT;
constexpr int RC_QI = 0, RC_KI = RC_QI + 128 * PR, RC_VI = RC_KI + 128 * PR, RC_SI = RC_VI + 128 * PT, RC_END = RC_SI + 128 * PT;
constexpr int DPK = 144, DPV = 192;
constexpr int DL_KI = 0, DL_VI = DL_KI + 384 * DPK, DL_LW = DL_VI + 384 * DPV, DL_END = DL_LW + 8 * 256;
constexpr int DL_ST = DL_KI;
static_assert(RC_END <= LDSCTL_OFF && DL_END <= LDSCTL_OFF && 8 * 32 * DPK <= 384 * DPK, "even mixer LDS maps");
__device__ __forceinline__ float ret_log2g(int h) { return log2f(1.0f - exp2f(-5.0f - (float)h)); }

__device__ __forceinline__ void ret_phase_a_items(const Frame& F, const bf16* P, bf16* RKV) {
    LAS unsigned char* L = F.lds;
    const int wave = F.wave, db = wave & 3, eh = wave >> 2;
    v4u kR[4], vR[4];
    {   const int it = F.bid < 1024 ? F.bid : 0; const int bh = it >> 5, n = it & 31;
        tile_ld<128, 128>(kR, P + HM(E_RK, 4, 128, bh >> 2, bh & 3) + n * 128 * 128, 128, F.tid); tile_ld<128, 128>(vR, P + HM(E_RV, 4, 128, bh >> 2, bh & 3) + n * 128 * 128, 128, F.tid); }
    for (int it = F.bid; it < 1024; it += F.G) {
        const int tidl = lndv(F.tid), lane = tidl & 63, r = lane & 31, h2 = lane >> 5;
        const int bh = it >> 5, h = bh & 3;
        const float lg = ret_log2g(h);
        tile_st<128, 128>(kR, L + RA_KI, PT, tidl);
        {
#pragma unroll
            for (int i = 0; i < 4; ++i) { const int row = (tidl >> 4) + 32 * i, cc = tidl & 15; const float f = __builtin_amdgcn_exp2f(lg * (float)(127 - row)); v4u o;
#pragma unroll
                for (int k = 0; k < 4; ++k) o[k] = cvtpk(bflo(vR[i][k]) * f, bfhi(vR[i][k]) * f);
                *(LAS v4u*)(L + RA_VD + row * PT + cc * 16) = o; }
        }
        WG_BAR();
        {   const int nx = (it + F.G < 1024) ? it + F.G : it; const int bh2 = nx >> 5, n2 = nx & 31;
            tile_ld<128, 128>(kR, P + HM(E_RK, 4, 128, bh2 >> 2, bh2 & 3) + n2 * 128 * 128, 128, tidl); tile_ld<128, 128>(vR, P + HM(E_RV, 4, 128, bh2 >> 2, bh2 & 3) + n2 * 128 * 128, 128, tidl); }
        f32x16 acc[2];
#pragma unroll
        for (int t = 0; t < 2; ++t) acc[t] = (f32x16){0.f, 0.f, 0.f, 0.f, 0.f, 0.f, 0.f, 0.f, 0.f, 0.f, 0.f, 0.f, 0.f, 0.f, 0.f, 0.f};
#pragma unroll
        for (int ks = 0; ks < 8; ++ks) { const bf16x8 a = ld_tr(L + RA_KI, PT, 16 * ks, db * 32, lane);
#pragma unroll
            for (int t = 0; t < 2; ++t) acc[t] = MFMA32(a, ld_tr(L + RA_VD, PT, 16 * ks, (2 * eh + t) * 32, lane), acc[t]); }
        WG_BAR();
#pragma unroll
        for (int t = 0; t < 2; ++t)
#pragma unroll
            for (int i = 0; i < 16; ++i) *(LAS bf16*)(L + RA_KI + (db * 32 + crow(i, h2)) * PR + ((2 * eh + t) * 32 + r) * 2) = cvt1(acc[t][i]);
        WG_BAR();
        bf16* out = RKV + (size_t)it * 128 * 128;
#pragma unroll
        for (int i = 0; i < 4; ++i) { const int row = (tidl >> 4) + 32 * i, cc = tidl & 15; *(GAS v4u*)(out + row * 128 + cc * 8) = *(const LAS v4u*)(L + RA_KI + row * PR + cc * 16); }
        WG_BAR();
    }
}
__device__ __forceinline__ void ret_scan(const Frame& F, bf16* RKV) {
    for (int gt = F.bid * NTHREADS + F.tid; gt < 32 * 128 * 32; gt += F.G * NTHREADS) {
        const int bh = gt >> 12, d = (gt >> 5) & 127, e4 = gt & 31, h = bh & 3;
        const float g128 = __builtin_amdgcn_exp2f(ret_log2g(h) * 128.0f);
        float s[4];
#pragma unroll
        for (int i = 0; i < 4; ++i) s[i] = 0.f;
        typedef unsigned u2v __attribute__((ext_vector_type(2)));
        for (int n0 = 0; n0 < 32; n0 += 8) {
            u2v kv[8];
#pragma unroll
            for (int u = 0; u < 8; ++u) kv[u] = *(const GAS u2v*)(RKV + (((size_t)bh * 32 + n0 + u) * 128 + d) * 128 + e4 * 4);
#pragma unroll
            for (int u = 0; u < 8; ++u) {
                u2v o; o.x = cvtpk(s[0], s[1]); o.y = cvtpk(s[2], s[3]);
                *(GAS u2v*)(RKV + (((size_t)bh * 32 + n0 + u) * 128 + d) * 128 + e4 * 4) = o;
#pragma unroll
                for (int i = 0; i < 2; ++i) { s[2 * i] = g128 * s[2 * i] + bflo(kv[u][i]); s[2 * i + 1] = g128 * s[2 * i + 1] + bfhi(kv[u][i]); } }
        }
    }
}
__device__ __forceinline__ void ret_phase_c_items(const Frame& F, const bf16* P, const bf16* RKV, bf16* CAT) {
    LAS unsigned char* L = F.lds;
    const int wave = F.wave, ib = wave & 3, eq = wave >> 2;
    v4u qR[4], kR[4];
    {   const int it = F.bid < 1024 ? F.bid : 0; const int bh = it >> 5, n = it & 31;
        tile_ld<128, 128>(qR, P + HM(E_RQ, 4, 128, bh >> 2, bh & 3) + n * 128 * 128, 128, F.tid); tile_ld<128, 128>(kR, P + HM(E_RK, 4, 128, bh >> 2, bh & 3) + n * 128 * 128, 128, F.tid); }
    for (int it = F.bid; it < 1024; it += F.G) {
        const int tidl = lndv(F.tid), lane = tidl & 63, r = lane & 31, h2 = lane >> 5;
        const int bh = it >> 5, n = it & 31, b = bh >> 2, h = bh & 3;
        const float lg = ret_log2g(h);
        {   v4u vR[4], sR[4]; tile_ld<128, 128>(vR, P + HM(E_RV, 4, 128, b, h) + n * 128 * 128, 128, tidl); tile_ld<128, 128>(sR, RKV + (size_t)it * 128 * 128, 128, tidl);
#pragma unroll
            for (int i = 0; i < 4; ++i) { const int row = (tidl >> 4) + 32 * i, cc = tidl & 15; const float fq = __builtin_amdgcn_exp2f(lg * (float)row), fk = __builtin_amdgcn_rcpf(fq); v4u oq, ok;
#pragma unroll
                for (int k = 0; k < 4; ++k) { oq[k] = cvtpk(bflo(qR[i][k]) * fq, bfhi(qR[i][k]) * fq); ok[k] = cvtpk(bflo(kR[i][k]) * fk, bfhi(kR[i][k]) * fk); }
                *(LAS v4u*)(L + RC_QI + row * PR + cc * 16) = oq; *(LAS v4u*)(L + RC_KI + row * PR + cc * 16) = ok; }
            tile_st<128, 128>(vR, L + RC_VI, PT, tidl); tile_st<128, 128>(sR, L + RC_SI, PT, tidl); }
        WG_BAR();
        bf16x8 PA[4][2];
#pragma unroll
        for (int jb = 0; jb < 4; ++jb) {
            if (jb <= ib) {
                f32x16 x = {0.f, 0.f, 0.f, 0.f, 0.f, 0.f, 0.f, 0.f, 0.f, 0.f, 0.f, 0.f, 0.f, 0.f, 0.f, 0.f};
#pragma unroll
                for (int ks = 0; ks < 8; ++ks) x = MFMA32(ld_row(L + RC_KI, PR, jb * 32, 16 * ks, r, h2), ld_row(L + RC_QI, PR, ib * 32, 16 * ks, r, h2), x);
                if (jb == ib) {
#pragma unroll
                    for (int i = 0; i < 16; ++i) if (crow(i, h2) > r) x[i] = 0.f; }
                PA[jb][0] = PACK_STEP(x, 0); PA[jb][1] = PACK_STEP(x, 1);
            } else { PA[jb][0] = (bf16x8){0, 0, 0, 0, 0, 0, 0, 0}; PA[jb][1] = (bf16x8){0, 0, 0, 0, 0, 0, 0, 0}; }
        }
        f32x16 o[2];
#pragma unroll
        for (int t = 0; t < 2; ++t) {
            const int eb = 2 * eq + t;
            f32x16 z = {0.f, 0.f, 0.f, 0.f, 0.f, 0.f, 0.f, 0.f, 0.f, 0.f, 0.f, 0.f, 0.f, 0.f, 0.f, 0.f}, y = z;
#pragma unroll
            for (int jb = 0; jb < 4; ++jb) if (jb <= ib) {
#pragma unroll
                for (int s = 0; s < 2; ++s) z = MFMA32(PA[jb][s], ld_tr_perm(L + RC_VI, PT, jb * 32 + 16 * s, eb * 32, lane), z); }
#pragma unroll
            for (int ks = 0; ks < 8; ++ks) y = MFMA32(ld_row(L + RC_QI, PR, ib * 32, 16 * ks, r, h2), ld_tr(L + RC_SI, PT, 16 * ks, eb * 32, lane), y);
            const float g1 = __builtin_amdgcn_exp2f(lg);
#pragma unroll
            for (int i = 0; i < 16; ++i) z[i] += y[i] * g1;
            o[t] = z;
        }
        WG_BAR();
#pragma unroll
        for (int t = 0; t < 2; ++t)
#pragma unroll
            for (int i = 0; i < 16; ++i) *(LAS bf16*)(L + RC_QI + (ib * 32 + crow(i, h2)) * PR + ((2 * eq + t) * 32 + r) * 2) = cvt1(o[t][i]);
        WG_BAR();
        {   const int nx = (it + F.G < 1024) ? it + F.G : it; const int bh2 = nx >> 5, n2 = nx & 31;
            tile_ld<128, 128>(qR, P + HM(E_RQ, 4, 128, bh2 >> 2, bh2 & 3) + n2 * 128 * 128, 128, tidl); tile_ld<128, 128>(kR, P + HM(E_RK, 4, 128, bh2 >> 2, bh2 & 3) + n2 * 128 * 128, 128, tidl); }
        {
            const int tid2 = lndv(tidl), row = tid2 >> 2, qtr = tid2 & 3;
            lcp orow = L + RC_QI + row * PR + qtr * 64;
            v4u w[4]; float sum = 0.f;
#pragma unroll
            for (int c = 0; c < 4; ++c) { w[c] = *(const LAS v4u*)(orow + c * 16);
#pragma unroll
                for (int i = 0; i < 4; ++i) sum += bflo(w[c][i]) + bfhi(w[c][i]); }
            sum += xsw<1>(sum); sum += xsw<2>(sum);
            const float mu = sum * (1.0f / 128.0f); float sq = 0.f;
#pragma unroll
            for (int c = 0; c < 4; ++c)
#pragma unroll
                for (int i = 0; i < 4; ++i) { const float d0 = bflo(w[c][i]) - mu, d1 = bfhi(w[c][i]) - mu; sq += d0 * d0 + d1 * d1; }
            sq += xsw<1>(sq); sq += xsw<2>(sq);
            float eps_ = EPS; asm volatile("" : "+v"(eps_)); const float rstd = 1.0f / sqrtf(sq * (1.0f / 128.0f) + eps_);
            const bf16* gp = P + HM(E_RG, 4, 128, b, h) + (size_t)(n * 128 + row) * 128 + qtr * 32;
            bf16* op = CAT + ((size_t)b * SEQ + n * 128 + row) * D + h * 128 + qtr * 32;
#pragma unroll
            for (int c = 0; c < 4; ++c) { const v4u gw = *(const GAS v4u*)(gp + c * 8); v4u ow;
#pragma unroll
                for (int i = 0; i < 4; ++i) { const float g0 = bflo(gw[i]), g1 = bfhi(gw[i]);
                    ow[i] = cvtpk((bflo(w[c][i]) - mu) * rstd * silu_f(g0), (bfhi(w[c][i]) - mu) * rstd * silu_f(g1)); }
                *(GAS v4u*)(op + c * 8) = ow; }
        }
        WG_BAR();
    }
}
struct DilTile { int b, head, p, dil, res, q0; };
template <bool FUSE> __device__ __forceinline__ DilTile dil_decode(int T) { DilTile t;
    if (FUSE) { t.b = T >> 7; t.head = T & 7; t.p = 0; t.dil = 1; t.res = 0; t.q0 = ((T >> 3) & 15) * 256; }
    else { t.b = T >> 8; t.head = (T >> 5) & 7; const int t32 = T & 31, hi = t32 >> 3, lo = t32 & 3;
        t.p = 1 + (((t32 >> 2) ^ t.b) & 1);
        if (t.p == 1) { t.dil = 4; t.res = lo; t.q0 = ((hi + (t.b >> 1)) & 3) * 256; }
        else { t.dil = 16; t.res = hi * 4 + lo; t.q0 = 0; } }
    return t; }
__device__ __forceinline__ void dil_ld(v4u (&kR)[6], v4u (&vR)[6], const DilTile& t, const bf16* P, int tid) {
    const bf16* Kb = P + HM(E_DK, 8, 64, t.b, t.head) + (tid & 7) * 8; const bf16* Vb = P + HM(E_DV, 8, 64, t.b, t.head) + (tid & 7) * 8;
#pragma unroll
    for (int i = 0; i < 6; ++i) { int kidx = t.q0 - 128 + (tid >> 3) + 64 * i; kidx = kidx < 0 ? 0 : kidx;
        const size_t ro = (size_t)(kidx * t.dil + t.res) * 64; kR[i] = *(const GAS v4u*)(Kb + ro); vR[i] = *(const GAS v4u*)(Vb + ro); }
}
template <bool FUSE> __device__ __forceinline__ void dil_tiles(const Frame& F, int T0, int T1, int step, const bf16* P, bf16* OD, float* LSE, bf16* CAT) {
    LAS unsigned char* L = F.lds;
    const int wave = F.wave;
    if (T0 >= T1) return;
    v4u kR[6], vR[6];
    { const DilTile t0 = dil_decode<FUSE>(T0); dil_ld(kR, vR, t0, P, F.tid); }
    for (int T = T0; T < T1; T += step) {
        const int tidl = lndv(F.tid), lane = tidl & 63, r = lane & 31, h2 = lane >> 5;
        const DilTile t = dil_decode<FUSE>(T);
#pragma unroll
        for (int i = 0; i < 6; ++i) { const int row = (tidl >> 3) + 64 * i, cc = tidl & 7; *(LAS v4u*)(L + DL_KI + row * DPK + cc * 16) = kR[i]; *(LAS v4u*)(L + DL_VI + row * DPV + cc * 16) = vR[i]; }
        bf16x8 qf[4];
        { const bf16* qsrc = P + HM(E_DQ, 8, 64, t.b, t.head) + (size_t)((t.q0 + 32 * wave + r) * t.dil + t.res) * 64 + 8 * h2;
#pragma unroll
          for (int ks = 0; ks < 4; ++ks) qf[ks] = *(const GAS bf16x8*)(qsrc + 16 * ks); }
        WG_BAR();
        { const DilTile tn = dil_decode<FUSE>(T + step < T1 ? T + step : T); dil_ld(kR, vR, tn, P, tidl); }
        f32x16 x[5];
        float ninf = -INFINITY; asm volatile("" : "+v"(ninf));
        float mx = ninf;
        bf16x8 kf[2][4];
#pragma unroll
        for (int ks = 0; ks < 4; ++ks) kf[0][ks] = ld_row(L + DL_KI, DPK, 32 * wave, 16 * ks, r, h2);
#pragma unroll
        for (int kb = 0; kb < 5; ++kb) {
            if (kb < 4) {
#pragma unroll
                for (int ks = 0; ks < 4; ++ks) kf[(kb + 1) & 1][ks] = ld_row(L + DL_KI, DPK, 32 * wave + 32 * (kb + 1), 16 * ks, r, h2); }
            f32x16 a = {0.f, 0.f, 0.f, 0.f, 0.f, 0.f, 0.f, 0.f, 0.f, 0.f, 0.f, 0.f, 0.f, 0.f, 0.f, 0.f};
#pragma unroll
            for (int ks = 0; ks < 4; ++ks) a = MFMA32(kf[kb & 1][ks], qf[ks], a);
            if (kb == 0) {
#pragma unroll
                for (int i = 0; i < 16; ++i) if (crow(i, h2) < r) a[i] = ninf; }
            if (kb == 4) {
#pragma unroll
                for (int i = 0; i < 16; ++i) if (crow(i, h2) > r) a[i] = ninf; }
            if (t.q0 == 0 && 32 * wave + 32 * kb < 128) {
#pragma unroll
                for (int i = 0; i < 16; ++i) a[i] = ninf; }
#pragma unroll
            for (int i = 0; i < 16; ++i) mx = fmaxf(mx, a[i]);
            x[kb] = a;
        }
        mx = max32(mx);
        constexpr float C2 = 0.125f * LOG2E;
        const float mc = mx * C2; float l = 0.f;
#pragma unroll
        for (int kb = 0; kb < 5; ++kb)
#pragma unroll
            for (int i = 0; i < 16; ++i) { const float pe = __builtin_amdgcn_exp2f(x[kb][i] * C2 - mc); x[kb][i] = pe; l += pe; }
        l = sum32(l);
        f32x16 o[2];
#pragma unroll
        for (int dbk = 0; dbk < 2; ++dbk) o[dbk] = (f32x16){0.f, 0.f, 0.f, 0.f, 0.f, 0.f, 0.f, 0.f, 0.f, 0.f, 0.f, 0.f, 0.f, 0.f, 0.f, 0.f};
        bf16x8 vf[2][2];
#pragma unroll
        for (int dbk = 0; dbk < 2; ++dbk) vf[0][dbk] = ld_tr_perm(L + DL_VI, DPV, 32 * wave, dbk * 32, lane);
#pragma unroll
        for (int idx = 0; idx < 10; ++idx) { const int kb = idx >> 1, s = idx & 1;
            if (idx < 9) {
#pragma unroll
                for (int dbk = 0; dbk < 2; ++dbk) vf[(idx + 1) & 1][dbk] = ld_tr_perm(L + DL_VI, DPV, 32 * wave + 16 * (idx + 1), dbk * 32, lane); }
            const bf16x8 pa = PACK_STEP(x[kb], s);
#pragma unroll
            for (int dbk = 0; dbk < 2; ++dbk) o[dbk] = MFMA32(pa, vf[idx & 1][dbk], o[dbk]); }
        LAS float* lw = (LAS float*)(L + DL_LW + wave * 256);
        const float lse = mx * 0.125f + LN2 * __builtin_amdgcn_logf(l);
        if (h2 == 0) { lw[r] = l; lw[32 + r] = lse; }
        WG_BAR();
        LAS unsigned char* st = L + DL_ST + wave * 32 * DPK;
#pragma unroll
        for (int i = 0; i < 16; ++i) { const float rl = __builtin_amdgcn_rcpf(lw[crow(i, h2)]);
#pragma unroll
            for (int dbk = 0; dbk < 2; ++dbk) *(LAS bf16*)(st + crow(i, h2) * DPK + (dbk * 32 + r) * 2) = cvt1(o[dbk][i] * rl); }
        const size_t tokbase = (size_t)t.b * SEQ;
        if (!FUSE) {
            bf16* odp = OD + (size_t)t.p * M * 512;
#pragma unroll
            for (int j = 0; j < 4; ++j) { const int c = lane + 64 * j, row = c >> 3, cc = c & 7; const size_t tok = tokbase + (size_t)(t.q0 + 32 * wave + row) * t.dil + t.res;
                *(GAS v4u*)(odp + tok * 512 + t.head * 64 + cc * 8) = *(const LAS v4u*)(st + row * DPK + cc * 16); }
            if (h2 == 0) { const size_t tok = tokbase + (size_t)(t.q0 + 32 * wave + r) * t.dil + t.res; LSE[((size_t)t.p * M + tok) * 8 + t.head] = lse; }
        } else {
#pragma unroll
            for (int j = 0; j < 4; ++j) { const int c = lane + 64 * j, row = c >> 3, cc = c & 7; const size_t tok = tokbase + (size_t)(t.q0 + 32 * wave + row);
                const float l0 = lw[32 + row], l1 = ((const GAS float*)LSE)[((size_t)M + tok) * 8 + t.head], l2 = ((const GAS float*)LSE)[((size_t)2 * M + tok) * 8 + t.head];
                const v4u a = *(const LAS v4u*)(st + row * DPK + cc * 16), bq = *(const GAS v4u*)(OD + ((size_t)M + tok) * 512 + t.head * 64 + cc * 8), cq = *(const GAS v4u*)(OD + ((size_t)2 * M + tok) * 512 + t.head * 64 + cc * 8);
                const float mxl = fmaxf(l0, fmaxf(l1, l2));
                float w0 = __builtin_amdgcn_exp2f((l0 - mxl) * LOG2E), w1 = __builtin_amdgcn_exp2f((l1 - mxl) * LOG2E), w2 = __builtin_amdgcn_exp2f((l2 - mxl) * LOG2E);
                const float rs = __builtin_amdgcn_rcpf(w0 + w1 + w2); w0 *= rs; w1 *= rs; w2 *= rs;
                v4u ov;
#pragma unroll
                for (int i = 0; i < 4; ++i) ov[i] = cvtpk(w0 * bflo(a[i]) + w1 * bflo(bq[i]) + w2 * bflo(cq[i]), w0 * bfhi(a[i]) + w1 * bfhi(bq[i]) + w2 * bfhi(cq[i]));
                *(GAS v4u*)(CAT + tok * D + 512 + t.head * 64 + cc * 8) = ov; }
        }
        WG_BAR();
    }
}
constexpr int DIL_TILES12 = 2048, DIL_TILES0 = 1024;
__device__ __forceinline__ void even_phase_a(const Frame& F0) {
    const Frame F = relaunder(F0);
    unsigned char* ws = WSP();
    const bf16* P = (const bf16*)(ws + WS_ACT); bf16* RKV = (bf16*)OUTP(); bf16* OD = (bf16*)(ws + WS_OD); float* LSE = (float*)((unsigned char*)OUTP() + OUT_LSE);
    ret_phase_a_items(F, P, RKV);
    dil_tiles<false>(F, F.bid, DIL_TILES12, F.G, P, OD, LSE, nullptr);
}
__device__ __forceinline__ void even_phase_b(const Frame& F0) {
    const Frame F = relaunder(F0);
    unsigned char* ws = WSP();
    const bf16* P = (const bf16*)(ws + WS_ACT); bf16* RKV = (bf16*)OUTP(); bf16* OD = (bf16*)(ws + WS_OD); float* LSE = (float*)((unsigned char*)OUTP() + OUT_LSE);
    ret_scan(F, RKV);
    dil_tiles<true>(F, F.bid, DIL_TILES0, F.G, P, OD, LSE, (bf16*)(ws + WS_CAT));
}
__device__ __forceinline__ void even_phase_c(const Frame& F0) {
    const Frame F = relaunder(F0);
    unsigned char* ws = WSP();
    const bf16* P = (const bf16*)(ws + WS_ACT); const bf16* RKV = (const bf16*)OUTP(); const bf16* OD = (const bf16*)(ws + WS_OD); const float* LSE = (const float*)((unsigned char*)OUTP() + OUT_LSE); bf16* CAT = (bf16*)(ws + WS_CAT);
    ret_phase_c_items(F, P, RKV, CAT);
}

static_assert(WS_X8 == WS_OD, "the e4m3 residual copy overlays the dilated-output buffer");
__global__ void __launch_bounds__(NTHREADS, 2) fwd_kernel(Args args) {
    extern __shared__ __attribute__((aligned(16))) unsigned char lds[];
    Frame F;
    F.lds = (LAS unsigned char*)lds;
    F.wave = __builtin_amdgcn_readfirstlane((int)(threadIdx.x >> 6)); F.lane = hw_lane(); F.tid = F.wave * 64 + F.lane; F.G = gridDim.x; F.bid = blockIdx.x;
    for (int u = F.tid; u < (LDS_BYTES - LDSCTL_OFF) / 4; u += NTHREADS) ((LAS unsigned*)(F.lds + LDSCTL_OFF))[u] = 0u;
    __syncthreads();
    if (F.tid < N_PTRS) { const unsigned long long v = (F.tid < 17) ? (unsigned long long)args.in[F.tid] : (F.tid == 17 ? (unsigned long long)args.out : (unsigned long long)args.ws);
        ((LAS unsigned*)(F.lds + PTR_OFF))[2 * F.tid] = (unsigned)v; ((LAS unsigned*)(F.lds + PTR_OFF))[2 * F.tid + 1] = (unsigned)(v >> 32); }
    __syncthreads();
    (void)xcd_barrier_post((unsigned*)(WSP() + WS_CTL) + CW_BAR, (volatile LAS unsigned*)(F.lds + MISC_OFF) + 8, F.tid);
#define GRID_BAR() do { XcdBarrier bar_; bar_.bar = (unsigned*)(WSP() + WS_CTL) + CW_BAR; bar_.x = (unsigned)__builtin_amdgcn_readfirstlane((int)xb_xcc_id()); \
        int mo_ = MISC_OFF + 32; asm volatile("" : "+s"(mo_)); bar_.st = (volatile LAS unsigned*)(F.lds + mo_); int t_ = F.wave * 64 + hw_lane_v(); xcd_barrier<0>(bar_, t_); } while (0)
#ifndef XCD_BAR_MODE
#define XCD_BAR_MODE 2
#endif
#ifdef NO_XCD_LOCAL
#define XCD_BAR() GRID_BAR()
#else
#define XCD_BAR() do { XcdBarrier bar_; bar_.bar = (unsigned*)(WSP() + WS_CTL) + CW_BAR; bar_.x = (unsigned)__builtin_amdgcn_readfirstlane((int)xb_xcc_id()); \
        int mo_ = MISC_OFF + 32; asm volatile("" : "+s"(mo_)); bar_.st = (volatile LAS unsigned*)(F.lds + mo_); int t_ = F.wave * 64 + hw_lane_v(); xcd_barrier<XCD_BAR_MODE>(bar_, t_); } while (0)
#endif
#define XB ((bf16*)(WSP() + WS_XB))
#define ACT ((bf16*)(WSP() + WS_ACT))
#define CAT ((bf16*)(WSP() + WS_CAT))
#define SSP ((float*)(WSP() + WS_SSP))
#define WPTR(off) ((const bf16*)(WSP() + (off)))

    float pro_s0; const float pro_s1 = i8_scales(F, pro_s0);
    prologue_rows(F, pro_s0);
    convert_weights(F, 0, 0, pro_s0, pro_s1);
    GRID_BAR();
    for (int s = 0; s < 8; ++s) {
        const int l = s >> 1; const bool post = (s & 1) != 0;
        if (I8ASLOT(s) && s != 0) { quant_rows(F, lnd(s)); XCD_BAR(); }
        {
            pg8::Gemm g{XB, WPTR(post ? W_GU1 : W_GU0), M, 2 * FF, D}; pg8::StaticOrder S; S.init(M, 2 * FF, lnd(F.G), lnd(F.bid));
            pg8::EpiSwiGLU E{ACT, FF, SSP, 1.0f};
            if (I8ASLOT(s)) {
                pg8::Gemm g8{(const bf16*)XB8, WPTR(post ? W_GU1 : W_GU0), M, 2 * FF, D};
                if (F8SLOT(s)) { pg8::EpiSwiGLU8I E8{ACT, FF, SSP, 1.0f}; pg8::gemm_phase<pg8::EpiSwiGLU8I, pg8::StaticOrder, true, true, false, true>(F.lds + RING_OFF, g8, S, E8, lnd(F.wave)); }
                else { pg8::EpiSwiGLUI EI{ACT, FF, SSP, 1.0f}; pg8::gemm_phase<pg8::EpiSwiGLUI, pg8::StaticOrder, true, true, false, true>(F.lds + RING_OFF, g8, S, EI, lnd(F.wave)); } }
            else if (F8ASLOT(s)) { pg8::Gemm g8{(const bf16*)XB8, WPTR(post ? W_GU1 : W_GU0), M, 2 * FF, D}; pg8::EpiSwiGLU8 E8{ACT, FF, SSP, 1.0f / (pg8::F8_XSCALE * pg8::F8_GUSCALE)};
                pg8::gemm_phase<pg8::EpiSwiGLU8, pg8::StaticOrder, true, true, true>(F.lds + RING_OFF, g8, S, E8, lnd(F.wave)); }
            else if (F8SLOT(s)) { pg8::EpiSwiGLU8 E8{ACT, FF, SSP, 1.0f}; pg8::gemm_phase<pg8::EpiSwiGLU8, pg8::StaticOrder, true, true>(F.lds + RING_OFF, g, S, E8, lnd(F.wave)); }
            else pg8::gemm_phase<pg8::EpiSwiGLU, pg8::StaticOrder, true, true>(F.lds + RING_OFF, g, S, E, lnd(F.wave));
            XCD_BAR();
        }
        {
            const bool do_conv = post ? (l + 1 < DEPTH) : (l >= 1); const int conv_l = post ? l + 1 : l, conv_part = post ? 1 : 2; const int grp = (lnd(F.bid) >> 3) & 1;
            for (int pass = 0; pass < 3; ++pass) {
                if (pass == 1) {
                    pg8::Gemm g{ACT, WPTR(post ? W_D1 : W_D0), M, D, FF}; pg8::RevOrder S; S.init(M, D, lnd(F.G), lnd(F.bid));
                    if (F8SLOT(s)) { pg8::EpiResid E{XB, SSP, 0.5f / (pg8::F8_HSCALE * pg8::F8_WSCALE), (post && F8ASLOT(s + 1)) ? XB8_D : 0}; pg8::gemm_phase<pg8::EpiResid, pg8::RevOrder, true, true, true>(F.lds + RING_OFF, g, S, E, lnd(F.wave)); }
                    else { pg8::EpiResid E{XB, SSP, 0.5f, (post && F8ASLOT(s + 1)) ? XB8_D : 0};
                    pg8::gemm_phase<pg8::EpiResid, pg8::RevOrder, true, true>(F.lds + RING_OFF, g, S, E, lnd(F.wave)); }
                } else if (do_conv && ((pass == 0) == (grp == 1))) {
                    convert_weights(F, conv_l, conv_part);
                    __syncthreads();
                }
            }
            if (s == 7) XCD_BAR(); else GRID_BAR();
        }
        if (!post) {
            const bool odd = (l & 1) != 0; const int nin = odd ? 3072 : EVEN_IN;
            {
                pg8::Gemm g{XB, WPTR(W_IN), M, nin, D}; pg8::StaticOrder S; S.init(M, nin, lnd(F.G), lnd(F.bid));
                pg8::EpiInProj E{ACT, nin, SSP, (const float*)(WSP() + TAB_RC), (const float*)(WSP() + TAB_RS), (const float*)(WSP() + TAB_DC), (const float*)(WSP() + TAB_DS), odd ? 0 : 1};
                pg8::gemm_phase<pg8::EpiInProj, pg8::StaticOrder, true, true>(F.lds + RING_OFF, g, S, E, lnd(F.wave));
            }
            if (odd) gla_alow(F);
            GRID_BAR();
            if (!odd) { even_phase_a(F); GRID_BAR(); even_phase_b(F); GRID_BAR(); even_phase_c(F); }
            else { gla_phase_a(F, l >> 1); GRID_BAR(); gla_phase_b(F); GRID_BAR(); gla_phase_c(F, l >> 1); }
            GRID_BAR();
            {
                pg8::Gemm g{CAT, WPTR(W_OUT), M, D, D}; pg8::StaticOrder S; S.init(M, D, lnd(F.G), lnd(F.bid));
                pg8::EpiResid E{XB, SSP, 1.0f, F8ASLOT(s + 1) ? XB8_D : 0};
                pg8::gemm_phase<pg8::EpiResid, pg8::StaticOrder, true, true>(F.lds + RING_OFF, g, S, E, lnd(F.wave));
                XCD_BAR();
            }
        }
    }
    final_norm(F);
}

extern "C" void kernel_launch(void* const* d_in, const int* in_sizes, int n_in, void* d_out, int out_size, void* d_ws, size_t ws_size, hipStream_t stream) {
    static int grid = 0;
    if (grid == 0) {
        if (n_in != 17 || in_sizes[0] != M * D || out_size != M * D || ws_size < WS_END2) { fprintf(stderr, "kernel_launch: unexpected shapes (n_in %d, in0 %d, out %d, ws %zu)\n", n_in, n_in > 0 ? in_sizes[0] : -1, out_size, ws_size); grid = -1; return; }
        int dev = 0, cus = 0, per_cu = 0;
        if (hipGetDevice(&dev) != hipSuccess || hipDeviceGetAttribute(&cus, hipDeviceAttributeMultiprocessorCount, dev) != hipSuccess) { grid = -1; return; }
        if (hipFuncSetAttribute((const void*)fwd_kernel, hipFuncAttributeMaxDynamicSharedMemorySize, LDS_BYTES) != hipSuccess) { fprintf(stderr, "kernel_launch: hipFuncSetAttribute failed\n"); grid = -1; return; }
        if (hipOccupancyMaxActiveBlocksPerMultiprocessor(&per_cu, (const void*)fwd_kernel, NTHREADS, LDS_BYTES) != hipSuccess || per_cu < 1) { fprintf(stderr, "kernel_launch: occupancy query reports %d\n", per_cu); }
        (void)hipGetLastError();
        grid = cus;
        if (grid != 256) fprintf(stderr, "kernel_launch: %d CUs (expected 256)\n", grid);
    }
    if (grid < 0) return;
    if (hipMemsetAsync((char*)d_ws + WS_CTL, 0, CTL_ZERO_BYTES, stream) != hipSuccess) return;
    Args a{};
    for (int i = 0; i < 17; ++i) a.in[i] = (const float*)d_in[i];
    a.out = (float*)d_out; a.ws = (unsigned char*)d_ws;
    hipLaunchKernelGGL(fwd_kernel, dim3(grid), dim3(NTHREADS), LDS_BYTES, stream, a);
}
```
